# Optimizing an MI355X kernel written in HIP

```python
import jax, jax.numpy as jnp
from jax import lax
import numpy as np

D_MODEL = 2048
BATCH = 2
SEQ = 4096
DEPTH = 4
DEC_BATCH = 8
DEC_SEQ = 1
PAST_LEN = 16384
PAGE_SIZE = 128

N_MIXERS = 3
N_LAYERS_A = (DEPTH + 2) // 3
N_LAYERS_B = (DEPTH + 1) // 3
N_LAYERS_C = DEPTH // 3
N_META = 16
ALPHA = (2 * DEPTH) ** 0.25
OUT_INIT_SCALE = (8 * DEPTH) ** -0.25
LN_EPS = 1e-5
RMS_EPS = 1e-6
D_FF = 4 * D_MODEL
CONV_A = 3
HEAD_DIM = 128
N_HEADS = D_MODEL // HEAD_DIM
N_KV_HEADS = 4
N_IDX_HEADS = 16
D_IDX = 64
TOPK_MAX = 256
Q_BLOCK = 128
ROPE_THETA = 10000.0
DSA_Q = N_HEADS * HEAD_DIM
DSA_KV = N_KV_HEADS * HEAD_DIM
DSA_QI = N_IDX_HEADS * D_IDX
DSA_SPLITS = [DSA_Q, DSA_Q + DSA_KV, DSA_Q + 2 * DSA_KV, DSA_Q + 2 * DSA_KV + DSA_QI, DSA_Q + 2 * DSA_KV + DSA_QI + D_IDX]
DSA_IN = DSA_SPLITS[-1] + N_IDX_HEADS
DN_QK_HEADS = 16
DN_V_HEADS = 32
DN_DK = 128
DN_DV = 128
DN_CONV = 4
DN_CHUNK = 64
DN_QK = DN_QK_HEADS * DN_DK
DN_VW = DN_V_HEADS * DN_DV
DN_CONV_DIM = 2 * DN_QK + DN_VW
DN_SPLITS = [DN_CONV_DIM, DN_CONV_DIM + DN_VW, DN_CONV_DIM + DN_VW + DN_V_HEADS]
DN_IN = DN_SPLITS[-1] + DN_V_HEADS

kernel_name = 'dsa_deltanet_shortconv_hybrid_step'


def layer_norm(x, g, b):
    xf = x.astype(jnp.float32)
    mu = jnp.mean(xf, -1, keepdims=True)
    var = jnp.mean(jnp.square(xf - mu), -1, keepdims=True)
    return ((xf - mu) * lax.rsqrt(var + LN_EPS) * g + b).astype(x.dtype)


def l2norm(x):
    return x * lax.rsqrt(jnp.sum(jnp.square(x), -1, keepdims=True) + RMS_EPS)


def rope(x, pos):
    d = x.shape[-1]
    inv = ROPE_THETA ** (-jnp.arange(0, d, 2, dtype=jnp.float32) / d)
    ang = pos.astype(jnp.float32)[:, None] * inv[None, :]
    cos = jnp.cos(ang)[:, None, :]
    sin = jnp.sin(ang)[:, None, :]
    x1, x2 = jnp.split(x.astype(jnp.float32), 2, axis=-1)
    return jnp.concatenate([x1 * cos - x2 * sin, x2 * cos + x1 * sin], axis=-1).astype(x.dtype)


def causal_dwconv(u_ext, w):
    width = w.shape[0]
    t = u_ext.shape[1] - (width - 1)
    return sum(u_ext[:, j:j + t] * w[j] for j in range(width))


def take_rows(a, idx):
    return jax.vmap(lambda a_b, i_b: a_b[i_b])(a, idx)


def sq_relu_mlp(x, w1, w2):
    return jnp.square(jax.nn.relu(x @ w1)) @ w2


def shortconv_mixer(x, conv_hist, w_in, conv_w, w_out):
    b_gate, c_gate, h = jnp.split(x @ w_in, 3, axis=-1)
    u_ext = jnp.concatenate([conv_hist, c_gate * h], axis=1)
    y = b_gate * causal_dwconv(u_ext, conv_w)
    return y @ w_out, u_ext[:, -(CONV_A - 1):]


def dsa_project(x, w_in, pos):
    bn, t, _ = x.shape
    q, k, v, qi, ki, wi = jnp.split(x @ w_in, DSA_SPLITS, axis=-1)
    q = rope(q.reshape(bn, t, N_HEADS, HEAD_DIM), pos)
    k = rope(k.reshape(bn, t, N_KV_HEADS, HEAD_DIM), pos)
    v = v.reshape(bn, t, N_KV_HEADS, HEAD_DIM)
    qi = rope(qi.reshape(bn, t, N_IDX_HEADS, D_IDX), pos)
    ki = rope(ki[:, :, None, :], pos)[:, :, 0]
    return q, k, v, qi, ki, wi


def indexer_scores(qi, wi, ki):
    dots = jax.nn.relu(jnp.einsum('bthd,bsd->bths', qi, ki).astype(jnp.float32) * D_IDX ** -0.5)
    return jnp.einsum('bths,bth->bts', dots, wi.astype(jnp.float32) * N_IDX_HEADS ** -0.5)


def sparse_attend(q, k_sel, v_sel, valid):
    bn, t = q.shape[:2]
    qg = q.reshape(bn, t, N_KV_HEADS, N_HEADS // N_KV_HEADS, HEAD_DIM)
    s = jnp.einsum('btngd,btsnd->btngs', qg, k_sel).astype(jnp.float32) * HEAD_DIM ** -0.5
    s = jnp.where(valid[:, :, None, None, :], s, -jnp.inf)
    p = jax.nn.softmax(s, axis=-1).astype(v_sel.dtype)
    o = jnp.einsum('btngs,btsnd->btngd', p, v_sel)
    return o.reshape(bn, t, N_HEADS * HEAD_DIM)


def dsa_prompt(x, w_in, w_out):
    bn, t, _ = x.shape
    pos = jnp.arange(t, dtype=jnp.int32)
    q, k, v, qi, ki, wi = dsa_project(x, w_in, pos)
    k_keep = min(TOPK_MAX, (t - N_META) // 4)
    n_blk = -(-t // Q_BLOCK)
    t_pad = n_blk * Q_BLOCK - t

    def blocks(a):
        a = jnp.pad(a, ((0, 0), (0, t_pad)) + ((0, 0),) * (a.ndim - 2))
        return jnp.moveaxis(a.reshape((bn, n_blk, Q_BLOCK) + a.shape[2:]), 1, 0)

    pos_blk = jnp.arange(n_blk * Q_BLOCK, dtype=jnp.int32).reshape(n_blk, Q_BLOCK)

    def attend_block(args):
        q_b, qi_b, wi_b, pos_b = args
        sc = indexer_scores(qi_b, wi_b, ki)
        sc = jnp.where(pos[None, None, :] <= pos_b[None, :, None], sc, -jnp.inf)
        _, idx = lax.top_k(sc, k_keep)
        valid = idx <= pos_b[None, :, None]
        return sparse_attend(q_b, take_rows(k, idx), take_rows(v, idx), valid)

    o = lax.map(attend_block, (blocks(q), blocks(qi), blocks(wi), pos_blk))
    o = jnp.moveaxis(o, 0, 1).reshape(bn, n_blk * Q_BLOCK, N_HEADS * HEAD_DIM)[:, :t]
    return o @ w_out, k, v, ki


def dsa_sample(x, cache_k, cache_v, cache_ki, page_table, w_in, w_out):
    bn, t, _ = x.shape
    past = page_table.shape[1] * PAGE_SIZE
    pos = past + jnp.arange(t, dtype=jnp.int32)
    q, k, v, qi, ki, wi = dsa_project(x, w_in, pos)
    ki_all = jnp.concatenate([cache_ki[page_table].reshape(bn, past, D_IDX), ki], axis=1)
    k_keep = min(TOPK_MAX, (past + t) // 4)
    key_pos = jnp.arange(past + t, dtype=jnp.int32)
    sc = indexer_scores(qi, wi, ki_all)
    sc = jnp.where(key_pos[None, None, :] <= pos[None, :, None], sc, -jnp.inf)
    _, idx = lax.top_k(sc, k_keep)
    valid = idx <= pos[None, :, None]
    in_past = idx < past
    idx_past = jnp.minimum(idx, past - 1)
    phys = page_table[jnp.arange(bn)[:, None, None], idx_past // PAGE_SIZE]
    slot = idx_past % PAGE_SIZE
    idx_new = jnp.clip(idx - past, 0, t - 1)

    def select(cache, new):
        return jnp.where(in_past[..., None, None], cache[phys, slot], take_rows(new, idx_new))

    o = sparse_attend(q, select(cache_k, k), select(cache_v, v), valid)
    return o @ w_out, k, v, ki


def gated_delta_chunked(q, k, v, g, beta, s0):
    bn, t, h, _ = q.shape
    n_pad = (-t) % DN_CHUNK
    c = DN_CHUNK

    def prep(a):
        a = jnp.pad(a, ((0, 0), (n_pad, 0)) + ((0, 0),) * (a.ndim - 2))
        a = a.reshape((bn, a.shape[1] // c, c) + a.shape[2:])
        return jnp.moveaxis(a, 3, 2)

    q, k, v, g, beta = (prep(a) for a in (q, k, v, g, beta))
    gc = jnp.cumsum(g, axis=-1)
    causal = jnp.tril(jnp.ones((c, c), bool))
    strict = jnp.tril(jnp.ones((c, c), bool), -1)
    decay = jnp.exp(jnp.where(causal, gc[..., :, None] - gc[..., None, :], -jnp.inf))
    a_mat = jnp.where(strict, beta[..., :, None] * decay * jnp.einsum('bnhid,bnhjd->bnhij', k, k), 0.0)
    rhs = jnp.concatenate([beta[..., None] * v, (beta * jnp.exp(gc))[..., None] * k], axis=-1)
    sol = lax.linalg.triangular_solve(a_mat + jnp.eye(c, dtype=a_mat.dtype), rhs,
                                      left_side=True, lower=True, unit_diagonal=True)
    u, w = jnp.split(sol, [v.shape[-1]], axis=-1)
    p = jnp.einsum('bnhid,bnhjd->bnhij', q, k) * decay
    qg = q * jnp.exp(gc)[..., None]
    kd = k * jnp.exp(gc[..., -1:] - gc)[..., None]
    g_last = jnp.exp(gc[..., -1])

    def step(s, xs):
        u_c, w_c, p_c, qg_c, kd_c, gl_c = xs
        delta = u_c - jnp.einsum('bhck,bhkv->bhcv', w_c, s)
        o_c = jnp.einsum('bhck,bhkv->bhcv', qg_c, s) + jnp.einsum('bhij,bhjv->bhiv', p_c, delta)
        s = gl_c[..., None, None] * s + jnp.einsum('bhck,bhcv->bhkv', kd_c, delta)
        return s, o_c

    xs = tuple(jnp.moveaxis(a, 1, 0) for a in (u, w, p, qg, kd, g_last))
    s, o = lax.scan(step, s0, xs)
    o = jnp.moveaxis(jnp.moveaxis(o, 0, 1), 2, 3)
    o = o.reshape(bn, -1, h, o.shape[-1])[:, n_pad:]
    return o, s


def gated_delta_recurrent(q, k, v, g, beta, s0):
    def step(s, xs):
        q_t, k_t, v_t, g_t, b_t = xs
        s = jnp.exp(g_t)[..., None, None] * s
        v_old = jnp.einsum('bhkv,bhk->bhv', s, k_t)
        s = s + jnp.einsum('bhk,bhv->bhkv', k_t, b_t[..., None] * (v_t - v_old))
        return s, jnp.einsum('bhkv,bhk->bhv', s, q_t)

    xs = tuple(jnp.moveaxis(a, 1, 0) for a in (q, k, v, g, beta))
    s, o = lax.scan(step, s0, xs)
    return jnp.moveaxis(o, 0, 1), s


def deltanet_mixer(x, conv_hist, s0, w_in, conv_w, a_log, dt_bias, norm_w, w_out, chunked):
    bn, t, _ = x.shape
    qkv, z, b_raw, a_raw = jnp.split(x @ w_in, DN_SPLITS, axis=-1)
    qkv_ext = jnp.concatenate([conv_hist, qkv], axis=1)
    qkv_c = jax.nn.silu(causal_dwconv(qkv_ext, conv_w)).astype(jnp.float32)
    q, k, v = jnp.split(qkv_c, [DN_QK, 2 * DN_QK], axis=-1)
    rep = DN_V_HEADS // DN_QK_HEADS
    q = jnp.repeat(l2norm(q.reshape(bn, t, DN_QK_HEADS, DN_DK)), rep, axis=2) * DN_DK ** -0.5
    k = jnp.repeat(l2norm(k.reshape(bn, t, DN_QK_HEADS, DN_DK)), rep, axis=2)
    v = v.reshape(bn, t, DN_V_HEADS, DN_DV)
    beta = jax.nn.sigmoid(b_raw.astype(jnp.float32))
    g = -jnp.exp(a_log.astype(jnp.float32)) * jax.nn.softplus(a_raw.astype(jnp.float32) + dt_bias.astype(jnp.float32))
    core = gated_delta_chunked if chunked else gated_delta_recurrent
    o, s = core(q, k, v, g, beta, s0.astype(jnp.float32))
    o = o * lax.rsqrt(jnp.mean(jnp.square(o), -1, keepdims=True) + RMS_EPS) * norm_w.astype(jnp.float32)
    o = o * jax.nn.silu(z.astype(jnp.float32).reshape(bn, t, DN_V_HEADS, DN_DV))
    y = o.reshape(bn, t, DN_VW).astype(x.dtype) @ w_out
    return y, qkv_ext[:, -(DN_CONV - 1):], s.astype(s0.dtype)


def setup_inputs(seed: int = 0) -> dict:
    key = jax.random.key(seed)
    keys = iter(jax.random.split(key, 40))

    def nrm(shape, scale=1.0):
        return jax.random.normal(next(keys), shape, jnp.float32) * scale

    n_pages = PAST_LEN // PAGE_SIZE
    n_pool = (DEC_BATCH * n_pages * 5) // 4
    x_prompt = nrm((BATCH, SEQ, D_MODEL))
    x_sample = nrm((DEC_BATCH, DEC_SEQ, D_MODEL))
    state_conv_a = nrm((N_LAYERS_A, DEC_BATCH, CONV_A - 1, D_MODEL))
    cache_k = nrm((N_LAYERS_B, n_pool, PAGE_SIZE, N_KV_HEADS, HEAD_DIM))
    cache_v = nrm((N_LAYERS_B, n_pool, PAGE_SIZE, N_KV_HEADS, HEAD_DIM))
    cache_idx_k = nrm((N_LAYERS_B, n_pool, PAGE_SIZE, D_IDX))
    state_conv_c = nrm((N_LAYERS_C, DEC_BATCH, DN_CONV - 1, DN_CONV_DIM))
    state_delta = nrm((N_LAYERS_C, DEC_BATCH, DN_V_HEADS, DN_DK, DN_DV), 0.1)
    page_table = jax.random.permutation(next(keys), n_pool)[:DEC_BATCH * n_pages].reshape(DEC_BATCH, n_pages).astype(jnp.int32)
    meta_tokens = nrm((N_META, D_MODEL))
    w_in_a = nrm((N_LAYERS_A, D_MODEL, 3 * D_MODEL), D_MODEL ** -0.5)
    conv_w_a = nrm((N_LAYERS_A, CONV_A, D_MODEL), CONV_A ** -0.5)
    w_out_a = nrm((N_LAYERS_A, D_MODEL, D_MODEL), OUT_INIT_SCALE * D_MODEL ** -0.5)
    w_in_b = nrm((N_LAYERS_B, D_MODEL, DSA_IN), D_MODEL ** -0.5)
    w_out_b = nrm((N_LAYERS_B, DSA_Q, D_MODEL), OUT_INIT_SCALE * DSA_Q ** -0.5)
    w_in_c = nrm((N_LAYERS_C, D_MODEL, DN_IN), D_MODEL ** -0.5)
    conv_w_c = nrm((N_LAYERS_C, DN_CONV, DN_CONV_DIM), DN_CONV ** -0.5)
    a_log_c = jnp.log(jax.random.uniform(next(keys), (N_LAYERS_C, DN_V_HEADS), jnp.float32, 1.0, 16.0))
    dt_c = jax.random.uniform(next(keys), (N_LAYERS_C, DN_V_HEADS), jnp.float32, 0.001, 0.1)
    dt_bias_c = jnp.log(jnp.expm1(dt_c))
    norm_w_c = 1.0 + nrm((N_LAYERS_C, DN_DV), 0.01)
    w_out_c = nrm((N_LAYERS_C, DN_VW, D_MODEL), OUT_INIT_SCALE * DN_VW ** -0.5)
    ln1_g = 1.0 + nrm((DEPTH, D_MODEL), 0.01)
    ln1_b = nrm((DEPTH, D_MODEL), 0.01)
    w1 = nrm((DEPTH, D_MODEL, D_FF), D_MODEL ** -0.5)
    w2 = nrm((DEPTH, D_FF, D_MODEL), OUT_INIT_SCALE * D_FF ** -0.5)
    ln2_g = 1.0 + nrm((DEPTH, D_MODEL), 0.01)
    ln2_b = nrm((DEPTH, D_MODEL), 0.01)
    return {'x_prompt': x_prompt, 'x_sample': x_sample, 'state_conv_a': state_conv_a,
            'cache_k': cache_k, 'cache_v': cache_v, 'cache_idx_k': cache_idx_k,
            'state_conv_c': state_conv_c, 'state_delta': state_delta, 'page_table': page_table,
            'meta_tokens': meta_tokens, 'w_in_a': w_in_a, 'conv_w_a': conv_w_a, 'w_out_a': w_out_a,
            'w_in_b': w_in_b, 'w_out_b': w_out_b, 'w_in_c': w_in_c, 'conv_w_c': conv_w_c,
            'a_log_c': a_log_c, 'dt_bias_c': dt_bias_c, 'norm_w_c': norm_w_c, 'w_out_c': w_out_c,
            'ln1_g': ln1_g, 'ln1_b': ln1_b, 'w1': w1, 'w2': w2, 'ln2_g': ln2_g, 'ln2_b': ln2_b}


def reference(x_prompt, x_sample, state_conv_a, cache_k, cache_v, cache_idx_k, state_conv_c,
              state_delta, page_table, meta_tokens, w_in_a, conv_w_a, w_out_a, w_in_b, w_out_b,
              w_in_c, conv_w_c, a_log_c, dt_bias_c, norm_w_c, w_out_c, ln1_g, ln1_b, w1, w2,
              ln2_g, ln2_b):
    bp = x_prompt.shape[0]
    meta = jnp.broadcast_to(meta_tokens[None].astype(x_prompt.dtype), (bp, N_META, D_MODEL))
    xp = jnp.concatenate([meta, x_prompt], axis=1)
    xs = x_sample
    conv_a_p, conv_a_s = [], []
    k_p, v_p, ki_p, k_s, v_s, ki_s = [], [], [], [], [], []
    conv_c_p, conv_c_s, delta_p, delta_s = [], [], [], []
    for i in range(DEPTH):
        j = i // N_MIXERS
        kind = i % N_MIXERS
        if kind == 0:
            hp, cp = shortconv_mixer(xp, jnp.zeros((bp, CONV_A - 1, D_MODEL), xp.dtype), w_in_a[j], conv_w_a[j], w_out_a[j])
            hs, cs = shortconv_mixer(xs, state_conv_a[j], w_in_a[j], conv_w_a[j], w_out_a[j])
            conv_a_p.append(cp)
            conv_a_s.append(cs)
        elif kind == 1:
            hp, kp, vp, kip = dsa_prompt(xp, w_in_b[j], w_out_b[j])
            hs, ks, vs, kis = dsa_sample(xs, cache_k[j], cache_v[j], cache_idx_k[j], page_table, w_in_b[j], w_out_b[j])
            k_p.append(kp)
            v_p.append(vp)
            ki_p.append(kip)
            k_s.append(ks)
            v_s.append(vs)
            ki_s.append(kis)
        else:
            hp, cp, sp = deltanet_mixer(xp, jnp.zeros((bp, DN_CONV - 1, DN_CONV_DIM), xp.dtype),
                                        jnp.zeros((bp, DN_V_HEADS, DN_DK, DN_DV), xp.dtype),
                                        w_in_c[j], conv_w_c[j], a_log_c[j], dt_bias_c[j], norm_w_c[j], w_out_c[j], True)
            hs, cs, ss = deltanet_mixer(xs, state_conv_c[j], state_delta[j], w_in_c[j], conv_w_c[j],
                                        a_log_c[j], dt_bias_c[j], norm_w_c[j], w_out_c[j], False)
            conv_c_p.append(cp)
            conv_c_s.append(cs)
            delta_p.append(sp)
            delta_s.append(ss)
        xp = layer_norm(ALPHA * xp + hp, ln1_g[i], ln1_b[i])
        xs = layer_norm(ALPHA * xs + hs, ln1_g[i], ln1_b[i])
        xp = layer_norm(ALPHA * xp + sq_relu_mlp(xp, w1[i], w2[i]), ln2_g[i], ln2_b[i])
        xs = layer_norm(ALPHA * xs + sq_relu_mlp(xs, w1[i], w2[i]), ln2_g[i], ln2_b[i])
    return (xp[:, N_META:], xs,
            jnp.stack(conv_a_p), jnp.stack(conv_a_s),
            jnp.stack(k_p), jnp.stack(v_p), jnp.stack(ki_p),
            jnp.stack(k_s), jnp.stack(v_s), jnp.stack(ki_s),
            jnp.stack(conv_c_p), jnp.stack(conv_c_s),
            jnp.stack(delta_p), jnp.stack(delta_s))
```

```cpp
#include <hip/hip_runtime.h>
#include <cstdio>
#include <cstdint>
#include <cmath>
namespace pg8 {
#define PG8_LAS __attribute__((address_space(3)))
typedef unsigned short bf16_t;
typedef short bf16x8 __attribute__((ext_vector_type(8)));
typedef float f32x4 __attribute__((ext_vector_type(4)));
typedef unsigned u32x4 __attribute__((ext_vector_type(4)));
constexpr int BM = 256, BK = 64, HALF = 128, HTB = HALF * BK * 2  , STAGE_BYTES = 8 * HTB, NXCD = 8, WGM = 8;

__host__ __device__ __forceinline__ int lds_byte(int r, int c) { const int st = (r >> 4) * 2 + (c >> 5), rr = r & 15, cc = c & 31, ob = rr * 64 + cc * 2; return st * 1024 + (ob ^ (((ob >> 9) & 1) << 5)); }
__host__ __device__ __forceinline__ void stage_rc(int b, int& R, int& C) { const int st = b / 1024, sb = b % 1024, swz = sb ^ (((sb >> 9) & 1) << 5); R = (st >> 1) * 16 + swz / 64; C = (st & 1) * 32 + (swz % 64) / 2; }
__host__ __device__ __forceinline__ int perm32(int rho) { const int n = rho >> 4, i = rho & 15; return 8 * (i >> 2) + 4 * n + (i & 3); }

struct Unit { int pm, pn; };
struct Gemm { const bf16_t* A; const bf16_t* Bt; int M, N, K; };

struct StaticOrder {
    int nM, nN, nwg, G, c;
    __host__ __device__ void init(int M, int N, int G_, int c_) { nM = M / BM; nN = N / BM; nwg = nM * nN; G = G_; c = c_; }
    __host__ __device__ bool next(int i, Unit& u) const {
        const long L = (long)i * G + c; if (L >= nwg) return false;
        int wgid = (int)L; { const int q = nwg / NXCD, r = nwg % NXCD, xcd = wgid % NXCD, off = wgid / NXCD; wgid = (xcd < r ? xcd * (q + 1) : r * (q + 1) + (xcd - r) * q) + off; }
        const int nig = WGM * nN, gid = wgid / nig, fm = gid * WGM, gsz = (nM - fm) < WGM ? (nM - fm) : WGM;
        u.pm = fm + ((wgid % nig) % gsz); u.pn = (wgid % nig) / gsz; return true;
    }
    __device__ __forceinline__ void a_ready(const Unit&) const {}
    __device__ __forceinline__ void done(const Unit&) const {}
};

__device__ __forceinline__ unsigned cvt_pk_bf16(float lo, float hi) { unsigned r; asm volatile("v_cvt_pk_bf16_f32 %0, %1, %2" : "=v"(r) : "v"(lo), "v"(hi)); return r; }
typedef float f32x2 __attribute__((ext_vector_type(2)));
__device__ __forceinline__ f32x2 gelu_pk(f32x2 v) {
    const f32x2 av = __builtin_elementwise_abs(v), d = av * 0.2316418882f + 1.0f;
    f32x2 t; t.x = __builtin_amdgcn_rcpf(d.x); t.y = __builtin_amdgcn_rcpf(d.y);
    f32x2 q = t * 0.5307027145f + (-0.7265760135f); q = q * t + 0.7107068705f; q = q * t + (-0.142248368f); q = q * t + 0.127414796f; q = q * t;
    const f32x2 s = (v * v) * (-0.72134752044f);
    f32x2 e; e.x = __builtin_amdgcn_exp2f(s.x); e.y = __builtin_amdgcn_exp2f(s.y);
    const f32x2 m = v * (q * e), r = v - m;
    f32x2 o; o.x = v.x < 0.f ? m.x : r.x; o.y = v.y < 0.f ? m.y : r.y; return o;
}

template <int ACT  > struct EpiBf16 {
    static constexpr bool PERM = true, AFTER_DRAIN = false; static_assert(ACT == 0 || ACT == 1 || ACT == 2, "EpiBf16: ACT is 0 (none), 1 (gelu_pk) or 2 (relu^2)");
    bf16_t* O; int ldc; const float* bias; int split_cols; size_t split_stride; float scale0;
    __device__ __forceinline__ void operator()(const f32x4 (&acc)[2][2][4][2], const Unit& u, int wr, int wc, int fr, int fq) const {
        const int row0 = u.pm * BM + wr * 64 + fr; int colt = u.pn * BM; bf16_t* base = O;
        float sc = 1.f; if (split_cols) { const int t = colt / split_cols; base += (size_t)t * split_stride; colt -= t * split_cols; if (t == 0) sc = scale0; }
        const int col0 = colt + wc * 32 + 8 * fq, bcol0 = u.pn * BM + wc * 32 + 8 * fq;
        f32x4 bv[2][2];
#pragma unroll
        for (int bj = 0; bj < 2; ++bj)
#pragma unroll
            for (int n = 0; n < 2; ++n) bv[bj][n] = bias ? *(const f32x4*)(bias + bcol0 + bj * HALF + 4 * n) : (f32x4){0.f, 0.f, 0.f, 0.f};
#pragma unroll
        for (int ai = 0; ai < 2; ++ai)
#pragma unroll
            for (int m = 0; m < 4; ++m) { bf16_t* rowp = base + (size_t)(row0 + ai * HALF + m * 16) * ldc + col0;
#pragma unroll
                for (int bj = 0; bj < 2; ++bj) { f32x4 v0 = acc[ai][bj][m][0] + bv[bj][0], v1 = acc[ai][bj][m][1] + bv[bj][1];
                    if (ACT == 1) { f32x2 a = gelu_pk((f32x2){v0[0], v0[1]}), b = gelu_pk((f32x2){v0[2], v0[3]}), c = gelu_pk((f32x2){v1[0], v1[1]}), d = gelu_pk((f32x2){v1[2], v1[3]});
                        v0 = (f32x4){a.x, a.y, b.x, b.y}; v1 = (f32x4){c.x, c.y, d.x, d.y}; }
                    if (ACT == 2) { _Pragma("unroll") for (int q_ = 0; q_ < 4; ++q_) { const float a_ = v0[q_] > 0.f ? v0[q_] : 0.f, b_ = v1[q_] > 0.f ? v1[q_] : 0.f; v0[q_] = a_ * a_; v1[q_] = b_ * b_; } }
                    v0 = v0 * sc; v1 = v1 * sc; u32x4 w; w.x = cvt_pk_bf16(v0[0], v0[1]); w.y = cvt_pk_bf16(v0[2], v0[3]); w.z = cvt_pk_bf16(v1[0], v1[1]); w.w = cvt_pk_bf16(v1[2], v1[3]);
                    *(u32x4*)(rowp + bj * HALF) = w; } }
    }
};


struct EpiF32 {
    static constexpr bool PERM = false, AFTER_DRAIN = false;
    float* C; int ldc;
    __device__ __forceinline__ void operator()(const f32x4 (&acc)[2][2][4][2], const Unit& u, int wr, int wc, int fr, int fq) const {
        const int row0 = u.pm * BM + wr * 64 + fr, col0 = u.pn * BM + wc * 32 + 4 * fq;
#pragma unroll
        for (int ai = 0; ai < 2; ++ai)
#pragma unroll
            for (int m = 0; m < 4; ++m) { float* rowp = C + (size_t)(row0 + ai * HALF + m * 16) * ldc + col0;
#pragma unroll
                for (int bj = 0; bj < 2; ++bj)
#pragma unroll
                    for (int n = 0; n < 2; ++n) *(f32x4*)(rowp + bj * HALF + n * 16) = acc[ai][bj][m][n]; }
    }
};
struct PanelStats {
    unsigned* xbuf;
    unsigned* cnt;
    unsigned* tmo;
    int ntn; float eps;
    unsigned code;
    __device__ __forceinline__ bool run(const f32x4 (&v)[2][2][4][2], const Unit& u, int wr, int wc, int fr, int fq, PG8_LAS unsigned char* lds, int wid, int lane) const {
        typedef float f32x2v __attribute__((ext_vector_type(2)));
        PG8_LAS f32x2v* P = (PG8_LAS f32x2v*)lds;
        PG8_LAS f32x2v* S = (PG8_LAS f32x2v*)(lds + 8192);
        PG8_LAS unsigned* flag = (PG8_LAS unsigned*)(lds + 8192 + 2048);
#pragma unroll
        for (int ai = 0; ai < 2; ++ai)
#pragma unroll
            for (int m = 0; m < 4; ++m) {
                float s = 0.f;
#pragma unroll
                for (int bj = 0; bj < 2; ++bj)
#pragma unroll
                    for (int n = 0; n < 2; ++n) { const f32x4 x = v[ai][bj][m][n]; s += (x[0] + x[1]) + (x[2] + x[3]); }
                s += __shfl_xor(s, 16); s += __shfl_xor(s, 32);
                const float mw = s * (1.0f / 64.0f); float q = 0.f;
#pragma unroll
                for (int bj = 0; bj < 2; ++bj)
#pragma unroll
                    for (int n = 0; n < 2; ++n) { const f32x4 d = v[ai][bj][m][n] - mw; q += (d[0] * d[0] + d[1] * d[1]) + (d[2] * d[2] + d[3] * d[3]); }
                q += __shfl_xor(q, 16); q += __shfl_xor(q, 32);
                if (fq == 0) P[(ai * HALF + wr * 64 + m * 16 + fr) * 4 + wc] = (f32x2v){mw, q};
            }
        asm volatile("s_waitcnt lgkmcnt(0)" ::: "memory"); __builtin_amdgcn_s_barrier(); asm volatile("" ::: "memory");
#if defined(BROKEN_EXCHANGE_NO_WAIT)
#warning BROKEN CONTROL BUILD: the row-statistics exchange does not wait; results are wrong by design
        if (blockIdx.x >= 64) { const long long t0_ = clock64(); while (clock64() - t0_ < 60000) __builtin_amdgcn_s_sleep(8); }
#endif
        const int row = wid * 32 + (lane & 31);
        if (lane < 32) {
            const f32x2v a = P[row * 4 + 0], b = P[row * 4 + 1], c = P[row * 4 + 2], d = P[row * 4 + 3];
            const float mt = (a.x + b.x + c.x + d.x) * 0.25f;
            const float da = a.x - mt, db = b.x - mt, dc = c.x - mt, dd = d.x - mt;
            const float m2 = (a.y + b.y) + (c.y + d.y) + 64.0f * ((da * da + db * db) + (dc * dc + dd * dd));
            unsigned long long* slot = (unsigned long long*)xbuf + ((size_t)(u.pm * BM + row) * 4 + u.pn);
            __hip_atomic_store(slot, ((unsigned long long)__float_as_uint(m2) << 32) | __float_as_uint(mt), __ATOMIC_RELAXED, __HIP_MEMORY_SCOPE_AGENT);
        }
        asm volatile("s_waitcnt vmcnt(0)" ::: "memory");
        if (lane == 0) __hip_atomic_fetch_add(cnt + 64 * u.pm, 1u, __ATOMIC_RELAXED, __HIP_MEMORY_SCOPE_AGENT);
        if (wid == 0) {
            bool dead = false; const unsigned long long t0 = __builtin_amdgcn_s_memrealtime(); const unsigned want = 8u * (unsigned)ntn;
            for (;;) {
#if defined(BROKEN_EXCHANGE_NO_WAIT)
                break;
#endif
                if ((unsigned)__builtin_amdgcn_readfirstlane(__hip_atomic_load(cnt + 64 * u.pm, __ATOMIC_RELAXED, __HIP_MEMORY_SCOPE_AGENT)) >= want) break;
                if (__builtin_amdgcn_s_memrealtime() - t0 > 2000000ull) {
                    if (lane == 0) { unsigned expect = 0u; __hip_atomic_compare_exchange_strong(tmo + 1, &expect, code | (unsigned)(u.pm & 0xff), __ATOMIC_RELAXED, __ATOMIC_RELAXED, __HIP_MEMORY_SCOPE_AGENT);
                                     __hip_atomic_store(tmo, 1u, __ATOMIC_RELAXED, __HIP_MEMORY_SCOPE_AGENT); }
                    dead = true; break; }
                __builtin_amdgcn_s_sleep(2);
            }
            __builtin_amdgcn_fence(__ATOMIC_ACQUIRE, "agent");
            if (lane == 0) flag[0] = dead ? 1u : 0u;
        }
        asm volatile("s_waitcnt vmcnt(0) lgkmcnt(0)" ::: "memory"); __builtin_amdgcn_s_barrier(); asm volatile("" ::: "memory");
        const bool bad = flag[0] != 0u;
        if (lane < 32) {
            const unsigned long long* slot = (const unsigned long long*)xbuf + (size_t)(u.pm * BM + row) * 4; float mt[4], m2[4]; float ms = 0.f;
#pragma unroll
            for (int t = 0; t < 4; ++t) { if (t < ntn) { const unsigned long long w = __hip_atomic_load(slot + t, __ATOMIC_RELAXED, __HIP_MEMORY_SCOPE_AGENT); mt[t] = __uint_as_float((unsigned)w); m2[t] = __uint_as_float((unsigned)(w >> 32)); } else { mt[t] = 0.f; m2[t] = 0.f; } ms += mt[t]; }
            const float mean = ms / (float)ntn; float q = 0.f;
#pragma unroll
            for (int t = 0; t < 4; ++t) if (t < ntn) { const float dm = mt[t] - mean; q += m2[t] + 256.0f * dm * dm; }
            S[row] = (f32x2v){mean, 1.0f / sqrtf(q / (256.0f * (float)ntn) + eps)};
        }
        asm volatile("s_waitcnt lgkmcnt(0)" ::: "memory"); __builtin_amdgcn_s_barrier(); asm volatile("" ::: "memory");
        return bad;
    }
};
struct EpiLnRes {
    static constexpr bool PERM = false, AFTER_DRAIN = true;
    const float* base; float* out; int ldc; const float* bias; PanelStats st; unsigned poison;
    __device__ __forceinline__ void fused(f32x4 (&acc)[2][2][4][2], const Unit& u, int wr, int wc, int fr, int fq, PG8_LAS unsigned char* lds, int wid, int lane) const {
        typedef float f32x2v __attribute__((ext_vector_type(2)));
        const PG8_LAS f32x2v* S = (const PG8_LAS f32x2v*)(lds + 8192);
        const int col0 = u.pn * BM + wc * 32 + 4 * fq;
#pragma unroll
        for (int bj = 0; bj < 2; ++bj)
#pragma unroll
            for (int n = 0; n < 2; ++n) { const f32x4 bv = bias ? *(const f32x4*)(bias + col0 + bj * HALF + n * 16) : (f32x4){0.f, 0.f, 0.f, 0.f};
#pragma unroll
                for (int ai = 0; ai < 2; ++ai)
#pragma unroll
                    for (int m = 0; m < 4; ++m) acc[ai][bj][m][n] += bv; }
        f32x4 pre[4][2][2];
#pragma unroll
        for (int m = 0; m < 4; ++m) { const size_t off = (size_t)(u.pm * BM + wr * 64 + m * 16 + fr) * ldc + col0;
#pragma unroll
            for (int bj = 0; bj < 2; ++bj)
#pragma unroll
                for (int n = 0; n < 2; ++n) pre[m][bj][n] = *(const f32x4*)(base + off + bj * HALF + n * 16); }
        const bool bad = st.run(acc, u, wr, wc, fr, fq, lds, wid, lane) || poison != 0u;
        const float qnan = __builtin_nanf("");
#pragma unroll
        for (int ai = 0; ai < 2; ++ai)
#pragma unroll
            for (int m = 0; m < 4; ++m) { const int r = ai * HALF + wr * 64 + m * 16 + fr; const f32x2v sr = S[r]; const size_t off = (size_t)(u.pm * BM + r) * ldc + col0;
#pragma unroll
                for (int bj = 0; bj < 2; ++bj)
#pragma unroll
                    for (int n = 0; n < 2; ++n) { const f32x4 bs = ai == 0 ? pre[m][bj][n] : *(const f32x4*)(base + off + bj * HALF + n * 16); f32x4 o = bs + (acc[ai][bj][m][n] - sr.x) * sr.y;
                        if (bad) o = (f32x4){qnan, qnan, qnan, qnan}; *(f32x4*)(out + off + bj * HALF + n * 16) = o; }
                if (m & 1) asm volatile("" ::: "memory"); }
    }
};
struct EpiLnResLn {
    static constexpr bool PERM = false, AFTER_DRAIN = true;
    const float* base; float* out; bf16_t* xn; int ldc; const float* bias; PanelStats st1, st2; unsigned poison;
    __device__ __forceinline__ void fused(f32x4 (&acc)[2][2][4][2], const Unit& u, int wr, int wc, int fr, int fq, PG8_LAS unsigned char* lds, int wid, int lane) const {
        typedef float f32x2v __attribute__((ext_vector_type(2))); typedef unsigned u32x2v __attribute__((ext_vector_type(2)));
        const PG8_LAS f32x2v* S = (const PG8_LAS f32x2v*)(lds + 8192);
        const int col0 = u.pn * BM + wc * 32 + 4 * fq;
#pragma unroll
        for (int bj = 0; bj < 2; ++bj)
#pragma unroll
            for (int n = 0; n < 2; ++n) { const f32x4 bv = bias ? *(const f32x4*)(bias + col0 + bj * HALF + n * 16) : (f32x4){0.f, 0.f, 0.f, 0.f};
#pragma unroll
                for (int ai = 0; ai < 2; ++ai)
#pragma unroll
                    for (int m = 0; m < 4; ++m) acc[ai][bj][m][n] += bv; }
        bool bad = st1.run(acc, u, wr, wc, fr, fq, lds, wid, lane) || poison != 0u;
        const float qnan = __builtin_nanf("");
#pragma unroll
        for (int ai = 0; ai < 2; ++ai)
#pragma unroll
            for (int m = 0; m < 4; ++m) { const int r = ai * HALF + wr * 64 + m * 16 + fr; const f32x2v sr = S[r]; const size_t off = (size_t)(u.pm * BM + r) * ldc + col0;
#pragma unroll
                for (int bj = 0; bj < 2; ++bj)
#pragma unroll
                    for (int n = 0; n < 2; ++n) { const f32x4 bs = *(const f32x4*)(base + off + bj * HALF + n * 16); acc[ai][bj][m][n] = bs + (acc[ai][bj][m][n] - sr.x) * sr.y; }
                asm volatile("" : "+v"(acc[ai][0][m][0]), "+v"(acc[ai][0][m][1]), "+v"(acc[ai][1][m][0]), "+v"(acc[ai][1][m][1]));
                if (m & 1) asm volatile("" ::: "memory"); }
        const bool bad1 = bad;
        bad = st2.run(acc, u, wr, wc, fr, fq, lds, wid, lane) || bad;
#pragma unroll
        for (int ai = 0; ai < 2; ++ai)
#pragma unroll
            for (int m = 0; m < 4; ++m) { const int r = ai * HALF + wr * 64 + m * 16 + fr; const f32x2v sr = S[r]; const size_t off = (size_t)(u.pm * BM + r) * ldc + col0;
#pragma unroll
                for (int bj = 0; bj < 2; ++bj)
#pragma unroll
                    for (int n = 0; n < 2; ++n) { const f32x4 x1 = acc[ai][bj][m][n]; *(f32x4*)(out + off + bj * HALF + n * 16) = bad1 ? (f32x4){qnan, qnan, qnan, qnan} : x1;
                        const f32x4 o = (x1 - sr.x) * sr.y; u32x2v w; w.x = cvt_pk_bf16(o[0], o[1]); w.y = cvt_pk_bf16(o[2], o[3]);
                        if (bad) { w.x = 0x7fc07fc0u; w.y = 0x7fc07fc0u; } *(u32x2v*)(xn + off + bj * HALF + n * 16) = w; }
                asm volatile("" ::: "memory"); }
    }
};

template <class Epi, class Sched, bool ALIGN_EPI = false, bool SP2 = false>
__device__ __forceinline__ void gemm_phase(PG8_LAS unsigned char* lds, const Gemm g, const Sched& S, const Epi& E) {
    int tid0_ = threadIdx.x; asm volatile("" : "+v"(tid0_));
    const int tid = tid0_, wid = __builtin_amdgcn_readfirstlane(tid >> 6), lane = tid & 63, wr = wid >> 2, wc = wid & 3, fr = lane & 15, fq = lane >> 4;
    const int K = g.K, nt = K / BK;
    unsigned voffA[2], voffB[2];
#pragma unroll
    for (int i = 0; i < 2; ++i) { int R, C; stage_rc(tid * 16 + i * 8192, R, C); const int Rb = Epi::PERM ? ((R & ~31) + perm32(R & 31)) : R;
        voffA[i] = (unsigned)(R * K + C) * 2u; voffB[i] = (unsigned)(Rb * K + C) * 2u; }
    const size_t kstep = (size_t)(BK * 2);
    const size_t hstep = (size_t)HALF * K * 2;
    const size_t tstep = 2 * hstep;
    const unsigned ldsw = (unsigned)wid * 1024u;
    const int aoff = lds_byte(wr * 64 + fr, fq * 8), boff = lds_byte(wc * 32 + fr, fq * 8);
#define PG8_SA(b, h) (((b) * 2 + (h)) * HTB)
#define PG8_SB(b, h) ((4 + (b) * 2 + (h)) * HTB)
#define PG8_STAGE(bufoff, gbase, voff) do { _Pragma("unroll") for (int _i = 0; _i < 2; ++_i) \
        __builtin_amdgcn_global_load_lds((const unsigned*)((const char*)(gbase) + (voff)[_i]), (PG8_LAS unsigned*)(lds + (bufoff) + ldsw + _i * 8192), 16, 0, 0); } while (0)
#define PG8_LDA(dst, b, h) do { _Pragma("unroll") for (int m = 0; m < 4; ++m) _Pragma("unroll") for (int k = 0; k < 2; ++k) dst[m][k] = *(const PG8_LAS bf16x8*)(lds + PG8_SA(b, h) + aoff + m * 2048 + k * 1024); } while (0)
#define PG8_LDB(dst, b, h) do { _Pragma("unroll") for (int n = 0; n < 2; ++n) _Pragma("unroll") for (int k = 0; k < 2; ++k) dst[n][k] = *(const PG8_LAS bf16x8*)(lds + PG8_SB(b, h) + boff + n * 2048 + k * 1024); } while (0)
#define PG8_MMA(ai, bj, At, Bt) do { __builtin_amdgcn_s_setprio(1); _Pragma("unroll") for (int m = 0; m < 4; ++m) _Pragma("unroll") for (int n = 0; n < 2; ++n) _Pragma("unroll") for (int k = 0; k < 2; ++k) \
        acc[ai][bj][m][n] = __builtin_amdgcn_mfma_f32_16x16x32_bf16(Bt[n][k], At[m][k], acc[ai][bj][m][n], 0, 0, 0); __builtin_amdgcn_s_setprio(0); } while (0)
#define PG8_WAIT_V(n) asm volatile("s_waitcnt vmcnt(" #n ")" ::: "memory")
#define PG8_WAIT_L(n) asm volatile("s_waitcnt lgkmcnt(" #n ")" ::: "memory")
#define PG8_BAR __builtin_amdgcn_s_barrier()
#define PG8_SCHED __builtin_amdgcn_sched_barrier(0)
    Unit cur, nxt; int ui = 0;
    if (!S.next(0, cur)) return;
    f32x4 acc[2][2][4][2];
#pragma unroll
    for (int a = 0; a < 2; ++a)
#pragma unroll
        for (int b = 0; b < 2; ++b)
#pragma unroll
            for (int m = 0; m < 4; ++m)
#pragma unroll
                for (int n = 0; n < 2; ++n) acc[a][b][m][n] = (f32x4){0.f, 0.f, 0.f, 0.f};
    bf16x8 At[4][2], B0[2][2], B1[2][2];
    const char* cA = (const char*)g.A + (size_t)cur.pm * tstep; const char* cB = (const char*)g.Bt + (size_t)cur.pn * tstep;
    S.a_ready(cur);
    if constexpr (SP2) {
        PG8_STAGE(PG8_SB(0, 0), cB, voffB); PG8_STAGE(PG8_SB(0, 1), cB + hstep, voffB); PG8_STAGE(PG8_SA(0, 0), cA, voffA); PG8_STAGE(PG8_SA(0, 1), cA + hstep, voffA);
        if (wr == 1) PG8_BAR;
        PG8_WAIT_V(2); PG8_BAR;
        PG8_STAGE(PG8_SB(1, 0), cB + kstep, voffB); PG8_STAGE(PG8_SA(1, 0), cA + kstep, voffA); PG8_STAGE(PG8_SB(1, 1), cB + hstep + kstep, voffB);
        PG8_WAIT_V(6); PG8_BAR;
    } else {
        PG8_STAGE(PG8_SB(0, 0), cB, voffB); PG8_STAGE(PG8_SA(0, 0), cA, voffA); PG8_STAGE(PG8_SB(0, 1), cB + hstep, voffB); PG8_STAGE(PG8_SA(0, 1), cA + hstep, voffA);
        if (wr == 1) PG8_BAR;
        PG8_WAIT_V(4); PG8_BAR;
        PG8_STAGE(PG8_SB(1, 0), cB + kstep, voffB); PG8_STAGE(PG8_SA(1, 0), cA + kstep, voffA); PG8_STAGE(PG8_SB(1, 1), cB + hstep + kstep, voffB);
        PG8_WAIT_V(6); PG8_BAR;
    }
    for (;;) {
        const bool has_next = S.next(ui + 1, nxt);
        const char* nA = has_next ? (const char*)g.A + (size_t)nxt.pm * tstep : cA; const char* nB = has_next ? (const char*)g.Bt + (size_t)nxt.pn * tstep : cB;
        for (int t = 0; t < nt; t += 2) {
            const bool last = (t == nt - 2);
            const char* a1 = cA + (size_t)(t + 1) * kstep;
            const char* a2 = last ? nA : cA + (size_t)(t + 2) * kstep; const char* b2 = last ? nB : cB + (size_t)(t + 2) * kstep;
            const char* a3 = a2 + kstep; const char* b3 = b2 + kstep;
            if (last && has_next) S.a_ready(nxt);
            if constexpr (SP2) {
            PG8_LDB(B0, 0, 0); PG8_LDB(B1, 0, 1); PG8_SCHED; PG8_LDA(At, 0, 0); PG8_STAGE(PG8_SA(1, 1), a1 + hstep, voffA);
            PG8_WAIT_V(8); PG8_WAIT_L(0); PG8_BAR; PG8_MMA(0, 0, At, B0); PG8_MMA(0, 1, At, B1); PG8_BAR; PG8_SCHED;
            PG8_LDA(At, 0, 1); PG8_STAGE(PG8_SB(0, 0), b2, voffB); PG8_STAGE(PG8_SB(0, 1), b2 + hstep, voffB); PG8_STAGE(PG8_SA(0, 0), a2, voffA);
            PG8_WAIT_V(8); PG8_WAIT_L(0); PG8_BAR; PG8_MMA(1, 0, At, B0); PG8_MMA(1, 1, At, B1); PG8_BAR; PG8_SCHED;
            PG8_LDB(B0, 1, 0); PG8_LDB(B1, 1, 1); PG8_SCHED; PG8_LDA(At, 1, 0); PG8_STAGE(PG8_SA(0, 1), a2 + hstep, voffA);
            PG8_WAIT_V(8); PG8_WAIT_L(0); PG8_BAR; PG8_MMA(0, 0, At, B0); PG8_MMA(0, 1, At, B1); PG8_BAR; PG8_SCHED;
            PG8_LDA(At, 1, 1); PG8_STAGE(PG8_SB(1, 0), b3, voffB); PG8_STAGE(PG8_SB(1, 1), b3 + hstep, voffB); PG8_STAGE(PG8_SA(1, 0), a3, voffA);
            PG8_WAIT_V(8); PG8_WAIT_L(0); PG8_BAR; PG8_MMA(1, 0, At, B0); PG8_MMA(1, 1, At, B1); PG8_BAR; PG8_SCHED;
            } else {
            PG8_LDB(B0, 0, 0); PG8_SCHED; PG8_LDA(At, 0, 0); PG8_STAGE(PG8_SA(1, 1), a1 + hstep, voffA);
            PG8_WAIT_L(8); PG8_BAR; PG8_WAIT_L(0); PG8_MMA(0, 0, At, B0); PG8_BAR; PG8_SCHED;
            PG8_LDB(B1, 0, 1); PG8_STAGE(PG8_SB(0, 0), b2, voffB);
            PG8_BAR; PG8_WAIT_L(0); PG8_MMA(0, 1, At, B1); PG8_BAR;
            PG8_LDA(At, 0, 1); PG8_STAGE(PG8_SA(0, 0), a2, voffA);
            PG8_BAR; PG8_WAIT_L(0); PG8_MMA(1, 0, At, B0); PG8_BAR; PG8_SCHED;
            PG8_STAGE(PG8_SB(0, 1), b2 + hstep, voffB);
            PG8_WAIT_V(6); PG8_BAR; PG8_MMA(1, 1, At, B1); PG8_BAR;
            PG8_LDB(B0, 1, 0); PG8_SCHED; PG8_LDA(At, 1, 0); PG8_STAGE(PG8_SA(0, 1), a2 + hstep, voffA);
            PG8_WAIT_L(8); PG8_BAR; PG8_WAIT_L(0); PG8_MMA(0, 0, At, B0); PG8_BAR; PG8_SCHED;
            PG8_LDB(B1, 1, 1); PG8_STAGE(PG8_SB(1, 0), b3, voffB);
            PG8_BAR; PG8_WAIT_L(0); PG8_MMA(0, 1, At, B1); PG8_BAR;
            PG8_LDA(At, 1, 1); PG8_STAGE(PG8_SA(1, 0), a3, voffA);
            PG8_BAR; PG8_WAIT_L(0); PG8_MMA(1, 0, At, B0); PG8_BAR; PG8_SCHED;
            PG8_STAGE(PG8_SB(1, 1), b3 + hstep, voffB);
            PG8_WAIT_V(6); PG8_BAR; PG8_MMA(1, 1, At, B1); PG8_BAR;
            }
        }
        if constexpr (ALIGN_EPI) { if (wr == 0) PG8_BAR; }
        if constexpr (!Epi::AFTER_DRAIN) { E(acc, cur, wr, wc, fr, fq); S.done(cur); }
        if (!has_next) break;
#pragma unroll
        for (int a = 0; a < 2; ++a)
#pragma unroll
            for (int b = 0; b < 2; ++b)
#pragma unroll
                for (int m = 0; m < 4; ++m)
#pragma unroll
                    for (int n = 0; n < 2; ++n) acc[a][b][m][n] = (f32x4){0.f, 0.f, 0.f, 0.f};
        cur = nxt; cA = nA; cB = nB; ++ui;
        if constexpr (ALIGN_EPI) { if (wr == 1) PG8_BAR; }
    }
    PG8_WAIT_V(0);
    if constexpr (!ALIGN_EPI) { if (wr == 0) PG8_BAR; }
    PG8_BAR;
    if constexpr (Epi::AFTER_DRAIN) { E.fused(acc, cur, wr, wc, fr, fq, lds, wid, lane); S.done(cur); }
#undef PG8_SA
#undef PG8_SB
#undef PG8_STAGE
#undef PG8_LDA
#undef PG8_LDB
#undef PG8_MMA
#undef PG8_WAIT_V
#undef PG8_WAIT_L
#undef PG8_BAR
#undef PG8_SCHED
}
}

#ifndef PG8_SP2
#define PG8_SP2 true
#endif
#ifndef PG8_ALIGN
#define PG8_ALIGN true
#endif
#define GAS __attribute__((address_space(1)))
#define LAS __attribute__((address_space(3)))
#define XB_TMO      128
#define XB_XCNT(j)  (256  + 64 * (j))
#define XB_XSUB(j)  (1280 + 64 * (j))
#define XB_XGEN(j)  (2304 + 64 * (j))
#define XB_TOP      3328
#define XB_TOPGEN   3392
#define XCD_BAR_WORDS 3456
#define XB_SPIN_CAP (1u << 18)

__device__ __forceinline__ unsigned xb_ld(unsigned* p)              { return __hip_atomic_load(p, __ATOMIC_RELAXED, __HIP_MEMORY_SCOPE_AGENT); }
__device__ __forceinline__ unsigned xb_add(unsigned* p, unsigned v) { return __hip_atomic_fetch_add(p, v, __ATOMIC_RELAXED, __HIP_MEMORY_SCOPE_AGENT); }
__device__ __forceinline__ unsigned xb_xcc_id() { return (unsigned)__builtin_amdgcn_s_getreg((3 << 11) | 20) & 0xFu; }
#define XB_SPIN(cond, bar) do { unsigned _sp = 0; while (cond) { __builtin_amdgcn_s_sleep(1); \
    if ((++_sp & 255u) == 0u) { if (xb_ld(&(bar)[XB_TMO])) break; if (_sp > XB_SPIN_CAP) { atomicAdd(&(bar)[XB_TMO], 1u); break; } } } } while (0)

struct XcdBarrier {
    unsigned* bar; unsigned x;
    volatile LAS unsigned* st;
};

__device__ __forceinline__ XcdBarrier xcd_barrier_post(unsigned* bar, volatile LAS unsigned* st) {
    XcdBarrier b; b.bar = bar; b.x = xb_xcc_id(); b.st = st;
    if (threadIdx.x == 0) (void)xb_add(&bar[XB_XCNT(b.x)], 1u);
    return b;
}
__device__ __forceinline__ void xcd_barrier_complete(unsigned* bar, unsigned x, unsigned& nloc, unsigned& nx) {
    const unsigned G = gridDim.x * gridDim.y * gridDim.z;
    unsigned sum, cnt, mine, sp = 0u;
    for (;;) {
        sum = 0u; cnt = 0u; mine = 0u;
#pragma unroll
        for (unsigned j = 0; j < 16; ++j) { const unsigned c = xb_ld(&bar[XB_XCNT(j)]); sum += c; cnt += (c > 0u) ? 1u : 0u; mine = (j == x) ? c : mine; }
        if (sum == G) break;
        __builtin_amdgcn_s_sleep(1);
        if ((++sp & 255u) == 0u) { if (xb_ld(&bar[XB_TMO])) break; if (sp > XB_SPIN_CAP) { atomicAdd(&bar[XB_TMO], 1u); break; } }
    }
    nloc = mine > 0u ? mine : 1u; nx = cnt > 0u ? cnt : 1u;
}

__device__ __forceinline__ void xcd_barrier(const XcdBarrier& b) {
    asm volatile("s_waitcnt vmcnt(0)" ::: "memory");
    __syncthreads();
    if (threadIdx.x == 0) {
        unsigned* bar = b.bar;
        __builtin_amdgcn_s_waitcnt(0);
        unsigned nloc = b.st[0], nx = b.st[1];
        if (nloc == 0u) { xcd_barrier_complete(bar, b.x, nloc, nx); b.st[0] = nloc; b.st[1] = nx; }
        const unsigned old = xb_add(&bar[XB_XSUB(b.x)], 1u);
        const unsigned gen = old / nloc;
        if (old + 1u == (gen + 1u) * nloc) {
            __builtin_amdgcn_fence(__ATOMIC_RELEASE, "agent");
            asm volatile("s_waitcnt vmcnt(0)" ::: "memory");
            const unsigned og = xb_add(&bar[XB_TOP], 1u);
            const unsigned tg = og / nx;
            if (og + 1u == (tg + 1u) * nx) xb_add(&bar[XB_TOPGEN], 1u);
            else XB_SPIN(xb_ld(&bar[XB_TOPGEN]) == tg, bar);
            __builtin_amdgcn_fence(__ATOMIC_ACQUIRE, "agent");
            xb_add(&bar[XB_XGEN(b.x)], 1u);
            asm volatile("s_waitcnt vmcnt(0)" ::: "memory");
        } else {
            XB_SPIN(xb_ld(&bar[XB_XGEN(b.x)]) == gen, bar);
            __builtin_amdgcn_fence(__ATOMIC_ACQUIRE, "agent");
            asm volatile("s_waitcnt vmcnt(0)" ::: "memory");
        }
    }
    __syncthreads();
}

constexpr int NWAVES = 8, NTHREADS = 512;
constexpr int DM = 2048, SEQ = 4096, NMETA = 16, TP = 4112, NBP = 2, SBN = 8, PAST = 16384, NPG = 128;
constexpr int XROW0 = 8192, SROW0 = 8224, NROWS = 8232, MPAD = 8448, FF = 8192;
constexpr int NA_IN = 6144, NB_IN = 4176, NB_PAD = 4352, NC_IN = 12352, NC_PAD = 12544, DVW = 4096, CDIM = 8192;
constexpr float ALPHA = 1.6817928305074292f;
constexpr float LN_EPS = 1e-5f, RMS_EPS = 1e-6f;
constexpr int SCW = 4160, SCSW = 16448, KIROWS = 4128, NSKEY = PAST + 1;
constexpr int POS_SAMPLE_IDX = TP;

constexpr size_t O_YP = 0, O_YS = O_YP + (size_t)NBP * SEQ * DM, O_CAP = O_YS + (size_t)SBN * DM, O_CAS = O_CAP + 2 * NBP * 2 * DM,
                 O_KP = O_CAS + 2 * SBN * 2 * DM, O_VP = O_KP + (size_t)NBP * TP * 512, O_IKP = O_VP + (size_t)NBP * TP * 512,
                 O_KS = O_IKP + (size_t)NBP * TP * 64, O_VS = O_KS + SBN * 512, O_IKS = O_VS + SBN * 512, O_CCP = O_IKS + SBN * 64,
                 O_CCS = O_CCP + (size_t)NBP * 3 * CDIM, O_DP = O_CCS + (size_t)SBN * 3 * CDIM, O_DS = O_DP + (size_t)NBP * 32 * 128 * 128,
                 O_END = O_DS + (size_t)SBN * 32 * 128 * 128;

constexpr size_t MiB = 1u << 20;
constexpr size_t WS_CTL = 0, CTL_ZERO_BYTES = 1 * MiB;
constexpr size_t WS_TAB128 = 1 * MiB, WS_TAB64 = 4 * MiB, WS_WI = 6 * MiB, WS_G = 7 * MiB, WS_BETA = 9 * MiB, WS_CNT = 11 * MiB, WS_KIB = 12 * MiB,
                 WS_SCS = 14 * MiB, WS_IDXL = 16 * MiB, WS_X = 26 * MiB, WS_QR = 60 * MiB, WS_QI = 94 * MiB, WS_Z = 112 * MiB, WS_Y = 180 * MiB,
                 WS_BIG = 248 * MiB, WS_QKVC = 452 * MiB, WS_SC = 584 * MiB, WS_W = 716 * MiB;
constexpr size_t WSZ_A_IN = (size_t)NA_IN * DM * 2, WSZ_A_OUT = (size_t)DM * DM * 2, WSZ_B_IN = (size_t)NB_PAD * DM * 2, WSZ_B_OUT = (size_t)DM * DM * 2,
                 WSZ_C_IN = (size_t)NC_PAD * DM * 2, WSZ_C_OUT = (size_t)DM * DVW * 2, WSZ_W1 = (size_t)FF * DM * 2, WSZ_W2 = (size_t)DM * FF * 2;
constexpr size_t WS_WA_IN = WS_W, WS_WA_OUT = WS_WA_IN + 2 * WSZ_A_IN, WS_WB_IN = WS_WA_OUT + 2 * WSZ_A_OUT, WS_WB_OUT = WS_WB_IN + WSZ_B_IN,
                 WS_WC_IN = WS_WB_OUT + WSZ_B_OUT, WS_WC_OUT = WS_WC_IN + WSZ_C_IN, WS_W1 = WS_WC_OUT + WSZ_C_OUT, WS_W2 = WS_W1 + 4 * WSZ_W1,
                 WS_END = WS_W2 + 4 * WSZ_W2;
constexpr int CW_BAR = 4096;

constexpr int RING_BYTES = 131072, LDSCTL_OFF = RING_BYTES, MISC_OFF = LDSCTL_OFF + 320, LDS_BYTES = 147456;

typedef unsigned short bf16;
typedef unsigned v4u __attribute__((ext_vector_type(4)));
typedef unsigned v2u __attribute__((ext_vector_type(2)));
typedef float f32x4 __attribute__((ext_vector_type(4)));
typedef float f32x2 __attribute__((ext_vector_type(2)));
typedef short bf16x8 __attribute__((ext_vector_type(8)));
typedef float f32x16 __attribute__((ext_vector_type(16)));
typedef __bf16 bf16x2_t __attribute__((ext_vector_type(2)));

#define LDS_WAIT() asm volatile("s_waitcnt lgkmcnt(0)" ::: "memory")
#define WAVE_SYNC() do { asm volatile("s_waitcnt lgkmcnt(0)" ::: "memory"); __builtin_amdgcn_wave_barrier(); } while (0)

__device__ __forceinline__ float bflo(unsigned w) { return __uint_as_float(w << 16); }
__device__ __forceinline__ float bfhi(unsigned w) { return __uint_as_float(w & 0xffff0000u); }
__device__ __forceinline__ float bf2f(bf16 h) { return __uint_as_float((unsigned)h << 16); }
__device__ __forceinline__ unsigned pk2(float lo, float hi) { f32x2 v = {lo, hi}; bf16x2_t b = __builtin_convertvector(v, bf16x2_t); return __builtin_bit_cast(unsigned, b); }
__device__ __forceinline__ bf16 f2bf(float f) { return (bf16)(pk2(f, 0.f) & 0xffffu); }
__device__ __forceinline__ float wave_sum(float v) {
#pragma unroll
    for (int o = 1; o < 64; o <<= 1) v += __shfl_xor(v, o);
    return v;
}
__device__ __forceinline__ float wave_max(float v) {
#pragma unroll
    for (int o = 1; o < 64; o <<= 1) v = fmaxf(v, __shfl_xor(v, o));
    return v;
}
__device__ __forceinline__ int wave_sum_i(int v) {
#pragma unroll
    for (int o = 1; o < 64; o <<= 1) v += __shfl_xor(v, o);
    return v;
}
__device__ __forceinline__ float row16_sum(float v) {
    v += __int_as_float(__builtin_amdgcn_update_dpp(0, __float_as_int(v), 0x128, 0xf, 0xf, false));
    v += __int_as_float(__builtin_amdgcn_update_dpp(0, __float_as_int(v), 0x124, 0xf, 0xf, false));
    v += __int_as_float(__builtin_amdgcn_update_dpp(0, __float_as_int(v), 0x122, 0xf, 0xf, false));
    v += __int_as_float(__builtin_amdgcn_update_dpp(0, __float_as_int(v), 0x121, 0xf, 0xf, false));
    return v;
}
__device__ __forceinline__ float silu_f(float x) { return x / (1.f + __expf(-x)); }
__device__ __forceinline__ int prow(int b, int t) { return t >= NMETA ? b * SEQ + (t - NMETA) : XROW0 + b * NMETA + t; }
__device__ __forceinline__ void row_bt(int r, int& b, int& t) { if (r < XROW0) { b = r >> 12; t = (r & 4095) + NMETA; } else { b = (r - XROW0) >> 4; t = (r - XROW0) & 15; } }
__device__ __forceinline__ void unpack8(const v4u w, float (&f)[8]) {
    f[0] = bflo(w.x); f[1] = bfhi(w.x); f[2] = bflo(w.y); f[3] = bfhi(w.y); f[4] = bflo(w.z); f[5] = bfhi(w.z); f[6] = bflo(w.w); f[7] = bfhi(w.w);
}
__device__ __forceinline__ v4u pack8(const float (&f)[8]) { v4u w; w.x = pk2(f[0], f[1]); w.y = pk2(f[2], f[3]); w.z = pk2(f[4], f[5]); w.w = pk2(f[6], f[7]); return w; }

__device__ __forceinline__ void transpose_item(const float* W, int K, int N, int Npad, bf16* WT, LAS float* scr, int item, int lane) {
    const int nblk = Npad / 32, kb = item / nblk, nb = item % nblk, k0 = 64 * kb, n0 = 32 * nb;
    const int n = n0 + (lane & 31); const bool ok = n < N;
#pragma unroll 8
    for (int i = 0; i < 32; ++i) { const int kk = 2 * i + (lane >> 5); scr[kk * 33 + (lane & 31)] = ok ? W[(size_t)(k0 + kk) * N + n] : 0.f; }
    LDS_WAIT(); __builtin_amdgcn_wave_barrier();
    const int c = lane & 7;
#pragma unroll
    for (int j = 0; j < 4; ++j) { const int nn = (lane >> 3) + 8 * j; const LAS float* s = scr + (8 * c) * 33 + nn;
        v4u o; o.x = pk2(s[0 * 33], s[1 * 33]); o.y = pk2(s[2 * 33], s[3 * 33]); o.z = pk2(s[4 * 33], s[5 * 33]); o.w = pk2(s[6 * 33], s[7 * 33]);
        *(v4u*)(WT + (size_t)(n0 + nn) * K + k0 + 8 * c) = o; }
    LDS_WAIT(); __builtin_amdgcn_wave_barrier();
}

struct Ptrs {
    const float *x_prompt, *x_sample, *state_conv_a, *cache_k, *cache_v, *cache_ik, *state_conv_c, *state_delta;
    const int* page_table;
    const float *meta, *w_in_a, *conv_w_a, *w_out_a, *w_in_b, *w_out_b, *w_in_c, *conv_w_c, *a_log, *dt_bias, *norm_w, *w_out_c, *ln1_g, *ln1_b, *w1, *w2, *ln2_g, *ln2_b;
    float* out; unsigned char* ws;
};

__device__ __forceinline__ void p0_prologue(const Ptrs& P, LAS unsigned char* lds, int gw, int NGW, int wave, int lane) {
    LAS float* scr = (LAS float*)(lds + wave * 16384);
    unsigned char* ws = P.ws;
    constexpr int I_A_IN = (DM / 64) * (NA_IN / 32), I_A_OUT = (DM / 64) * (DM / 32), I_B_IN = (DM / 64) * (NB_PAD / 32), I_B_OUT = I_A_OUT,
                  I_C_IN = (DM / 64) * (NC_PAD / 32), I_C_OUT = (DVW / 64) * (DM / 32), I_W1 = (DM / 64) * (FF / 32), I_W2 = (FF / 64) * (DM / 32);
    constexpr int NITEMS = 2 * I_A_IN + 2 * I_A_OUT + I_B_IN + I_B_OUT + I_C_IN + I_C_OUT + 4 * I_W1 + 4 * I_W2;
#define TR_(cnt, Wp, Kk, Nn, Np, WTp) if (r < (cnt)) { transpose_item((Wp), (Kk), (Nn), (Np), (bf16*)(WTp), scr, r, lane); continue; } r -= (cnt);
    for (int it = gw; it < NITEMS; it += NGW) {
        int r = it;
        TR_(I_A_IN, P.w_in_a, DM, NA_IN, NA_IN, ws + WS_WA_IN)
        TR_(I_A_IN, P.w_in_a + (size_t)DM * NA_IN, DM, NA_IN, NA_IN, ws + WS_WA_IN + WSZ_A_IN)
        TR_(I_A_OUT, P.w_out_a, DM, DM, DM, ws + WS_WA_OUT)
        TR_(I_A_OUT, P.w_out_a + (size_t)DM * DM, DM, DM, DM, ws + WS_WA_OUT + WSZ_A_OUT)
        TR_(I_B_IN, P.w_in_b, DM, NB_IN, NB_PAD, ws + WS_WB_IN)
        TR_(I_B_OUT, P.w_out_b, DM, DM, DM, ws + WS_WB_OUT)
        TR_(I_C_IN, P.w_in_c, DM, NC_IN, NC_PAD, ws + WS_WC_IN)
        TR_(I_C_OUT, P.w_out_c, DVW, DM, DM, ws + WS_WC_OUT)
        TR_(I_W1, P.w1, DM, FF, FF, ws + WS_W1)
        TR_(I_W1, P.w1 + (size_t)DM * FF, DM, FF, FF, ws + WS_W1 + WSZ_W1)
        TR_(I_W1, P.w1 + 2 * (size_t)DM * FF, DM, FF, FF, ws + WS_W1 + 2 * WSZ_W1)
        TR_(I_W1, P.w1 + 3 * (size_t)DM * FF, DM, FF, FF, ws + WS_W1 + 3 * WSZ_W1)
        TR_(I_W2, P.w2, FF, DM, DM, ws + WS_W2)
        TR_(I_W2, P.w2 + (size_t)DM * FF, FF, DM, DM, ws + WS_W2 + WSZ_W2)
        TR_(I_W2, P.w2 + 2 * (size_t)DM * FF, FF, DM, DM, ws + WS_W2 + 2 * WSZ_W2)
        transpose_item(P.w2 + 3 * (size_t)DM * FF, FF, DM, DM, (bf16*)(ws + WS_W2 + 3 * WSZ_W2), scr, r, lane);
    }
#undef TR_
    bf16* X = (bf16*)(ws + WS_X);
    for (int r = gw; r < MPAD; r += NGW) {
        const float* src = nullptr;
        if (r < XROW0) src = P.x_prompt + (size_t)r * DM;
        else if (r < SROW0) src = P.meta + (size_t)((r - XROW0) & 15) * DM;
        else if (r < NROWS) src = P.x_sample + (size_t)(r - SROW0) * DM;
#pragma unroll
        for (int j = 0; j < 4; ++j) { const int c = 512 * j + 8 * lane; v4u o = {0u, 0u, 0u, 0u};
            if (src) { const f32x4 a = *(const f32x4*)(src + c), b = *(const f32x4*)(src + c + 4); o.x = pk2(a.x, a.y); o.y = pk2(a.z, a.w); o.z = pk2(b.x, b.y); o.w = pk2(b.z, b.w); }
            *(v4u*)(X + (size_t)r * DM + c) = o; }
    }
    f32x2* t128 = (f32x2*)(ws + WS_TAB128); f32x2* t64 = (f32x2*)(ws + WS_TAB64);
    const int gt = gw * 64 + lane, NGT = NGW * 64;
    for (int e = gt; e < (TP + 1) * 96; e += NGT) {
        const int pi = e / 96, i = e % 96; const float pos = (float)(pi == TP ? PAST : pi);
        float inv; if (i < 64) inv = powf(10000.f, -(float)(2 * i) / 128.f); else inv = powf(10000.f, -(float)(2 * (i - 64)) / 64.f);
        const float ang = pos * inv; float sn, cs; sincosf(ang, &sn, &cs);
        if (i < 64) t128[pi * 64 + i] = (f32x2){cs, sn}; else t64[pi * 32 + (i - 64)] = (f32x2){cs, sn};
    }
}

__device__ __forceinline__ void ln_phase(const float* Z, bf16* X, const float* gam, const float* bet, float* yp, float* ys, int gw, int NGW, int lane) {
    for (int r = gw; r < NROWS; r += NGW) {
        const float* zr = Z + (size_t)r * DM; bf16* xr = X + (size_t)r * DM;
        float v[32]; float s = 0.f;
#pragma unroll
        for (int j = 0; j < 4; ++j) { const int c = 512 * j + 8 * lane; const f32x4 z0 = *(const f32x4*)(zr + c), z1 = *(const f32x4*)(zr + c + 4); const v4u xv = *(const v4u*)(xr + c);
            float xf[8]; unpack8(xv, xf);
            v[8 * j + 0] = ALPHA * xf[0] + z0.x; v[8 * j + 1] = ALPHA * xf[1] + z0.y; v[8 * j + 2] = ALPHA * xf[2] + z0.z; v[8 * j + 3] = ALPHA * xf[3] + z0.w;
            v[8 * j + 4] = ALPHA * xf[4] + z1.x; v[8 * j + 5] = ALPHA * xf[5] + z1.y; v[8 * j + 6] = ALPHA * xf[6] + z1.z; v[8 * j + 7] = ALPHA * xf[7] + z1.w;
#pragma unroll
            for (int i = 0; i < 8; ++i) s += v[8 * j + i]; }
        const float mean = wave_sum(s) * (1.f / DM); float s2 = 0.f;
#pragma unroll
        for (int i = 0; i < 32; ++i) { v[i] -= mean; s2 += v[i] * v[i]; }
        const float rstd = 1.f / sqrtf(wave_sum(s2) * (1.f / DM) + LN_EPS);
        float* of = nullptr;
        if (yp) { if (r < XROW0) of = yp + (size_t)r * DM; else if (r >= SROW0) of = ys + (size_t)(r - SROW0) * DM; }
#pragma unroll
        for (int j = 0; j < 4; ++j) { const int c = 512 * j + 8 * lane; const f32x4 g0 = *(const f32x4*)(gam + c), g1 = *(const f32x4*)(gam + c + 4), b0 = *(const f32x4*)(bet + c), b1 = *(const f32x4*)(bet + c + 4);
            float o[8];
            o[0] = v[8 * j + 0] * rstd * g0.x + b0.x; o[1] = v[8 * j + 1] * rstd * g0.y + b0.y; o[2] = v[8 * j + 2] * rstd * g0.z + b0.z; o[3] = v[8 * j + 3] * rstd * g0.w + b0.w;
            o[4] = v[8 * j + 4] * rstd * g1.x + b1.x; o[5] = v[8 * j + 5] * rstd * g1.y + b1.y; o[6] = v[8 * j + 6] * rstd * g1.z + b1.z; o[7] = v[8 * j + 7] * rstd * g1.w + b1.w;
            *(v4u*)(xr + c) = pack8(o);
            if (of) { *(f32x4*)(of + c) = (f32x4){o[0], o[1], o[2], o[3]}; *(f32x4*)(of + c + 4) = (f32x4){o[4], o[5], o[6], o[7]}; } }
    }
}

__device__ __forceinline__ void load_u(const bf16* BCH, int row, int c0, float (&u)[8]) {
    const v4u cg = *(const v4u*)(BCH + (size_t)row * NA_IN + DM + c0), hh = *(const v4u*)(BCH + (size_t)row * NA_IN + 2 * DM + c0);
    float a[8], b[8]; unpack8(cg, a); unpack8(hh, b);
#pragma unroll
    for (int i = 0; i < 8; ++i) u[i] = a[i] * b[i];
}
__device__ __forceinline__ void convA_phase(const bf16* BCH, bf16* Y, const float* cw, const float* hist, float* outp, float* outs, int gtid, int NT) {
    for (int it = gtid; it < NROWS * 256; it += NT) {
        const int r = it >> 8, c0 = (it & 255) * 8;
        float u0[8], u1[8], u2[8];
        load_u(BCH, r, c0, u2);
        if (r < SROW0) {
            int b, t; row_bt(r, b, t);
            if (t >= 1) load_u(BCH, prow(b, t - 1), c0, u1); else {
#pragma unroll
                for (int i = 0; i < 8; ++i) u1[i] = 0.f; }
            if (t >= 2) load_u(BCH, prow(b, t - 2), c0, u0); else {
#pragma unroll
                for (int i = 0; i < 8; ++i) u0[i] = 0.f; }
            if (t >= TP - 2) { float* o = outp + ((size_t)(b * 2 + (t - (TP - 2)))) * DM + c0; *(f32x4*)o = (f32x4){u2[0], u2[1], u2[2], u2[3]}; *(f32x4*)(o + 4) = (f32x4){u2[4], u2[5], u2[6], u2[7]}; }
        } else {
            const int sb = r - SROW0; const float* h0 = hist + ((size_t)(sb * 2 + 0)) * DM + c0; const float* h1 = hist + ((size_t)(sb * 2 + 1)) * DM + c0;
            const f32x4 a0 = *(const f32x4*)h0, a1 = *(const f32x4*)(h0 + 4), b0 = *(const f32x4*)h1, b1 = *(const f32x4*)(h1 + 4);
            u0[0] = a0.x; u0[1] = a0.y; u0[2] = a0.z; u0[3] = a0.w; u0[4] = a1.x; u0[5] = a1.y; u0[6] = a1.z; u0[7] = a1.w;
            u1[0] = b0.x; u1[1] = b0.y; u1[2] = b0.z; u1[3] = b0.w; u1[4] = b1.x; u1[5] = b1.y; u1[6] = b1.z; u1[7] = b1.w;
            float* o0 = outs + ((size_t)(sb * 2 + 0)) * DM + c0; float* o1 = outs + ((size_t)(sb * 2 + 1)) * DM + c0;
            *(f32x4*)o0 = b0; *(f32x4*)(o0 + 4) = b1;
            *(f32x4*)o1 = (f32x4){u2[0], u2[1], u2[2], u2[3]}; *(f32x4*)(o1 + 4) = (f32x4){u2[4], u2[5], u2[6], u2[7]};
        }
        float bg[8]; unpack8(*(const v4u*)(BCH + (size_t)r * NA_IN + c0), bg);
        float w0[8], w1[8], w2[8];
        { const f32x4 a = *(const f32x4*)(cw + c0), b = *(const f32x4*)(cw + c0 + 4); w0[0] = a.x; w0[1] = a.y; w0[2] = a.z; w0[3] = a.w; w0[4] = b.x; w0[5] = b.y; w0[6] = b.z; w0[7] = b.w; }
        { const f32x4 a = *(const f32x4*)(cw + DM + c0), b = *(const f32x4*)(cw + DM + c0 + 4); w1[0] = a.x; w1[1] = a.y; w1[2] = a.z; w1[3] = a.w; w1[4] = b.x; w1[5] = b.y; w1[6] = b.z; w1[7] = b.w; }
        { const f32x4 a = *(const f32x4*)(cw + 2 * DM + c0), b = *(const f32x4*)(cw + 2 * DM + c0 + 4); w2[0] = a.x; w2[1] = a.y; w2[2] = a.z; w2[3] = a.w; w2[4] = b.x; w2[5] = b.y; w2[6] = b.z; w2[7] = b.w; }
        float y[8];
#pragma unroll
        for (int i = 0; i < 8; ++i) y[i] = bg[i] * (w0[i] * u0[i] + w1[i] * u1[i] + w2[i] * u2[i]);
        *(v4u*)(Y + (size_t)r * DM + c0) = pack8(y);
    }
}

constexpr float QSCALE = 0.08838834764831845f;
__device__ __forceinline__ void rope_phase(const bf16* PROJ, const Ptrs& P, int gw, int NGW, int lane) {
    unsigned char* ws = P.ws;
    const f32x2* t128 = (const f32x2*)(ws + WS_TAB128); const f32x2* t64 = (const f32x2*)(ws + WS_TAB64);
    bf16* Qr = (bf16*)(ws + WS_QR); bf16* QI = (bf16*)(ws + WS_QI); bf16* KIb = (bf16*)(ws + WS_KIB); float* WI = (float*)(ws + WS_WI);
    for (int r = gw; r < NROWS; r += NGW) {
        const bf16* pr = PROJ + (size_t)r * NB_PAD;
        int pi; float *ko, *vo, *iko; bf16* kib = nullptr;
        if (r < SROW0) { int b, t; row_bt(r, b, t); pi = t; ko = P.out + O_KP + ((size_t)(b * TP + t)) * 512; vo = P.out + O_VP + ((size_t)(b * TP + t)) * 512; iko = P.out + O_IKP + ((size_t)(b * TP + t)) * 64; kib = KIb + ((size_t)(b * KIROWS + t)) * 64; }
        else { const int sb = r - SROW0; pi = POS_SAMPLE_IDX; ko = P.out + O_KS + (size_t)sb * 512; vo = P.out + O_VS + (size_t)sb * 512; iko = P.out + O_IKS + (size_t)sb * 64; }
        const f32x2* c128 = t128 + (size_t)pi * 64; const f32x2* c64 = t64 + (size_t)pi * 32;
        for (int e = lane; e < 1024; e += 64) { const int hd = e >> 6, i = e & 63; const float x1 = bf2f(pr[hd * 128 + i]), x2 = bf2f(pr[hd * 128 + 64 + i]); const f32x2 cs = c128[i];
            Qr[(size_t)r * DM + hd * 128 + i] = f2bf((x1 * cs.x - x2 * cs.y) * QSCALE); Qr[(size_t)r * DM + hd * 128 + 64 + i] = f2bf((x2 * cs.x + x1 * cs.y) * QSCALE); }
        for (int e = lane; e < 256; e += 64) { const int hd = e >> 6, i = e & 63; const float x1 = bf2f(pr[2048 + hd * 128 + i]), x2 = bf2f(pr[2048 + hd * 128 + 64 + i]); const f32x2 cs = c128[i];
            ko[hd * 128 + i] = x1 * cs.x - x2 * cs.y; ko[hd * 128 + 64 + i] = x2 * cs.x + x1 * cs.y; }
        for (int e = lane; e < 512; e += 64) vo[e] = bf2f(pr[2560 + e]);
        for (int e = lane; e < 512; e += 64) { const int hd = e >> 5, i = e & 31; const float x1 = bf2f(pr[3072 + hd * 64 + i]), x2 = bf2f(pr[3072 + hd * 64 + 32 + i]); const f32x2 cs = c64[i];
            QI[(size_t)r * 1024 + hd * 64 + i] = f2bf(x1 * cs.x - x2 * cs.y); QI[(size_t)r * 1024 + hd * 64 + 32 + i] = f2bf(x2 * cs.x + x1 * cs.y); }
        if (lane < 32) { const int i = lane; const float x1 = bf2f(pr[4096 + i]), x2 = bf2f(pr[4096 + 32 + i]); const f32x2 cs = c64[i]; const float o1 = x1 * cs.x - x2 * cs.y, o2 = x2 * cs.x + x1 * cs.y;
            iko[i] = o1; iko[32 + i] = o2; if (kib) { kib[i] = f2bf(o1); kib[32 + i] = f2bf(o2); } }
        else if (lane < 48) { const int i = lane - 32; WI[(size_t)r * 16 + i] = bf2f(pr[4160 + i]); }
    }
}

__device__ __forceinline__ void indexer_prompt(const Ptrs& P, int gw, int NGW, int lane) {
    unsigned char* ws = P.ws;
    const bf16* QI = (const bf16*)(ws + WS_QI); const bf16* KIb = (const bf16*)(ws + WS_KIB); const float* WI = (const float*)(ws + WS_WI); float* SC = (float*)(ws + WS_SC);
    const int n = lane & 31, h8 = lane >> 5;
    const int qsel = (n >> 2) & 1, head = (n & 3) + 4 * (n >> 3);
    constexpr int NIT = NBP * (TP / 2);
    for (int k = gw; k < NIT; k += NGW) {
        const int idx = (k < NIT / 2) ? k : (NIT - 1) - (k - NIT / 2);
        const int b = idx & 1, p = idx >> 1, t0 = 2 * p;
        const bf16* qa = QI + (size_t)prow(b, t0 + qsel) * 1024 + head * 64 + 8 * h8;
        bf16x8 a[4];
#pragma unroll
        for (int kk = 0; kk < 4; ++kk) a[kk] = *(const bf16x8*)(qa + 16 * kk);
        const int tq = t0 + h8;
        const float* wp = WI + (size_t)prow(b, tq) * 16;
        float w[16];
#pragma unroll
        for (int i = 0; i < 4; ++i) { const f32x4 x = *(const f32x4*)(wp + 4 * i); w[4 * i] = x.x; w[4 * i + 1] = x.y; w[4 * i + 2] = x.z; w[4 * i + 3] = x.w; }
        const int ntile = ((t0 + 1) >> 5) + 1;
        const bf16* kb = KIb + ((size_t)b * KIROWS + n) * 64 + 8 * h8;
        float* scrow = SC + ((size_t)(b * TP + tq)) * SCW;
        for (int kt = 0; kt < ntile; ++kt) {
            const bf16* kp = kb + (size_t)kt * 32 * 64;
            bf16x8 bb[4];
#pragma unroll
            for (int kk = 0; kk < 4; ++kk) bb[kk] = *(const bf16x8*)(kp + 16 * kk);
            f32x16 acc;
#pragma unroll
            for (int i = 0; i < 16; ++i) acc[i] = 0.f;
#pragma unroll
            for (int kk = 0; kk < 4; ++kk) acc = __builtin_amdgcn_mfma_f32_32x32x16_bf16(a[kk], bb[kk], acc, 0, 0, 0);
            float sc = 0.f;
#pragma unroll
            for (int i = 0; i < 16; ++i) sc += w[i] * fmaxf(acc[i], 0.f);
            const int s = 32 * kt + n;
            if (s <= tq) scrow[s] = sc;
        }
    }
}

__device__ __forceinline__ void indexer_sample(const Ptrs& P, LAS unsigned char* lds, int tid) {
    unsigned char* ws = P.ws;
    const bf16* QI = (const bf16*)(ws + WS_QI); const float* WI = (const float*)(ws + WS_WI); float* SCS = (float*)(ws + WS_SCS);
    LAS float* lq = (LAS float*)lds;
    LAS float* lw = lq + 1024;
    constexpr int NCH = (NSKEY + 511) / 512;
    for (int item = blockIdx.x; item < SBN * NCH; item += gridDim.x) {
        const int sb = item / NCH, ch = item % NCH, r = SROW0 + sb;
        __syncthreads();
        for (int e = tid; e < 1024; e += NTHREADS) lq[e] = bf2f(QI[(size_t)r * 1024 + e]);
        if (tid < 16) lw[tid] = WI[(size_t)r * 16 + tid];
        __syncthreads();
        const int s = ch * 512 + tid;
        if (s < NSKEY) {
            const float* kr = (s < PAST) ? P.cache_ik + ((size_t)P.page_table[sb * NPG + (s >> 7)] * 128 + (s & 127)) * 64 : P.out + O_IKS + (size_t)sb * 64;
            f32x4 kv[16];
#pragma unroll
            for (int i = 0; i < 16; ++i) kv[i] = *(const f32x4*)(kr + 4 * i);
            float sc = 0.f;
            for (int h = 0; h < 16; ++h) { float d = 0.f;
#pragma unroll
                for (int i = 0; i < 16; ++i) { const f32x4 q = *(const LAS f32x4*)(lq + h * 64 + 4 * i); d += q.x * kv[i].x + q.y * kv[i].y + q.z * kv[i].z + q.w * kv[i].w; }
                sc += lw[h] * fmaxf(d, 0.f); }
            SCS[(size_t)sb * SCSW + s] = sc;
        }
    }
    __syncthreads();
}

__device__ __forceinline__ unsigned ordkey(float f) { const unsigned u = __float_as_uint(f); return (u & 0x80000000u) ? ~u : (u | 0x80000000u); }
constexpr int TOPK = 256;
__device__ __forceinline__ void topk_wave(const float* sc, int n, int* outIdx, int* outCnt, int lane) {
    if (n <= TOPK) { for (int e = lane; e < n; e += 64) outIdx[e] = e; if (lane == 0) *outCnt = n; return; }
    constexpr int NS = 65;
    unsigned key[NS];
#pragma unroll
    for (int m = 0; m < NS; ++m) { const int e = lane + 64 * m; key[m] = (e < n) ? ordkey(sc[e]) : 0u; }
    unsigned T = 0u;
    for (int bit = 31; bit >= 0; --bit) {
        const unsigned cand = T | (1u << bit); int c = 0;
#pragma unroll
        for (int m = 0; m < NS; ++m) c += (key[m] >= cand) ? 1 : 0;
        c = wave_sum_i(c);
        if (c >= TOPK) T = cand;
    }
    int cg = 0;
#pragma unroll
    for (int m = 0; m < NS; ++m) cg += (key[m] > T) ? 1 : 0;
    cg = wave_sum_i(cg);
    const int need = TOPK - cg;
    int base_g = 0, base_e = 0;
    const unsigned long long lt = (1ull << lane) - 1ull;
#pragma unroll
    for (int m = 0; m < NS; ++m) {
        const int e = lane + 64 * m; const bool pg = key[m] > T, pe = key[m] == T;
        const unsigned long long mg = __ballot(pg), me = __ballot(pe);
        const int pre_g = __popcll(mg & lt), pre_e = __popcll(me & lt);
        if (pg) outIdx[base_g + pre_g] = e;
        if (pe && (base_e + pre_e) < need) outIdx[cg + base_e + pre_e] = e;
        base_g += __popcll(mg); base_e += __popcll(me);
    }
    if (lane == 0) *outCnt = TOPK;
}
__device__ __forceinline__ void topk_block(const float* sc, int n, int* outIdx, int* outCnt, LAS unsigned* ls, int tid, int wave, int lane) {
    constexpr int NS = (NSKEY + NTHREADS - 1) / NTHREADS;
    unsigned key[NS];
#pragma unroll
    for (int m = 0; m < NS; ++m) { const int e = tid + NTHREADS * m; key[m] = (e < n) ? ordkey(sc[e]) : 0u; }
    unsigned T = 0u;
    for (int bit = 31; bit >= 0; --bit) {
        const unsigned cand = T | (1u << bit); int c = 0;
#pragma unroll
        for (int m = 0; m < NS; ++m) c += (key[m] >= cand) ? 1 : 0;
        c = wave_sum_i(c);
        LAS unsigned* buf = ls + (bit & 1) * 8;
        if (lane == 0) buf[wave] = (unsigned)c;
        __syncthreads();
        int tot = 0;
#pragma unroll
        for (int w = 0; w < 8; ++w) tot += (int)buf[w];
        if (tot >= TOPK) T = cand;
    }
    __syncthreads();
    if (tid == 0) { ls[16] = 0u; ls[17] = 0u; }
    __syncthreads();
#pragma unroll
    for (int m = 0; m < NS; ++m) { const int e = tid + NTHREADS * m; if (key[m] > T) { const unsigned pos = atomicAdd((unsigned*)(ls + 16), 1u); if (pos < (unsigned)TOPK) outIdx[pos] = e; } }
    __syncthreads();
    const unsigned cg = ls[16];
    const unsigned need = (unsigned)TOPK - cg;
#pragma unroll
    for (int m = 0; m < NS; ++m) { const int e = tid + NTHREADS * m; if (key[m] == T) { const unsigned pos = atomicAdd((unsigned*)(ls + 17), 1u); if (pos < need) outIdx[cg + pos] = e; } }
    if (tid == 0) *outCnt = TOPK;
    __syncthreads();
}
__device__ __forceinline__ void select_phase(const Ptrs& P, LAS unsigned char* lds, int gw, int NGW, int tid, int wave, int lane) {
    unsigned char* ws = P.ws;
    const float* SC = (const float*)(ws + WS_SC); const float* SCS = (const float*)(ws + WS_SCS); int* IDXL = (int*)(ws + WS_IDXL); int* CNT = (int*)(ws + WS_CNT);
    for (int sb = blockIdx.x; sb < SBN; sb += gridDim.x) topk_block(SCS + (size_t)sb * SCSW, NSKEY, IDXL + (size_t)(SROW0 + sb) * TOPK, CNT + SROW0 + sb, (LAS unsigned*)lds, tid, wave, lane);
    for (int r = gw; r < SROW0; r += NGW) { int b, t; row_bt(r, b, t); topk_wave(SC + ((size_t)(b * TP + t)) * SCW, t + 1, IDXL + (size_t)r * TOPK, CNT + r, lane); }
}

__device__ __forceinline__ void attn_phase(const Ptrs& P, bf16* O, LAS unsigned char* lds, int gw, int NGW, int wave, int lane) {
    unsigned char* ws = P.ws;
    const bf16* Qr = (const bf16*)(ws + WS_QR); const int* IDXL = (const int*)(ws + WS_IDXL); const int* CNT = (const int*)(ws + WS_CNT);
    LAS float* lq = (LAS float*)(lds + wave * 12288);
    LAS f32x4* lp = (LAS f32x4*)(lds + wave * 12288 + 2048);
    LAS unsigned long long* lkp = (LAS unsigned long long*)(lds + wave * 12288 + 6144);
    LAS unsigned long long* lvp = (LAS unsigned long long*)(lds + wave * 12288 + 8192);
    for (int item = gw; item < NROWS * 4; item += NGW) {
        const int r = item >> 2, n = item & 3;
        const int cnt = CNT[r];
        WAVE_SYNC();
        { float qf[8]; unpack8(*(const v4u*)(Qr + (size_t)r * DM + n * 512 + 8 * lane), qf);
          *(LAS f32x4*)(lq + 8 * lane) = (f32x4){qf[0], qf[1], qf[2], qf[3]}; *(LAS f32x4*)(lq + 8 * lane + 4) = (f32x4){qf[4], qf[5], qf[6], qf[7]}; }
        const float* kp[4];
#pragma unroll
        for (int j = 0; j < 4; ++j) {
            const int e = lane + 64 * j; const int s = (e < cnt) ? IDXL[(size_t)r * TOPK + e] : 0;
            const float *kq, *vq;
            if (r < SROW0) { const int b = (r < XROW0) ? (r >> 12) : ((r - XROW0) >> 4); kq = P.out + O_KP + ((size_t)(b * TP + s)) * 512; vq = P.out + O_VP + ((size_t)(b * TP + s)) * 512; }
            else { const int sb = r - SROW0;
                if (s < PAST) { const size_t off = ((size_t)P.page_table[sb * NPG + (s >> 7)] * 128 + (s & 127)) * 512; kq = P.cache_k + off; vq = P.cache_v + off; }
                else { kq = P.out + O_KS + (size_t)sb * 512; vq = P.out + O_VS + (size_t)sb * 512; } }
            kp[j] = kq + n * 128; lkp[e] = (unsigned long long)(kq + n * 128); lvp[e] = (unsigned long long)(vq + n * 128);
        }
        WAVE_SYNC();
        float acc[4][4];
#pragma unroll
        for (int g = 0; g < 4; ++g)
#pragma unroll
            for (int j = 0; j < 4; ++j) acc[g][j] = 0.f;
#pragma unroll 4
        for (int d4 = 0; d4 < 32; ++d4) {
            f32x4 qv[4];
#pragma unroll
            for (int g = 0; g < 4; ++g) qv[g] = *(const LAS f32x4*)(lq + g * 128 + 4 * d4);
#pragma unroll
            for (int j = 0; j < 4; ++j) { const f32x4 kv = *(const f32x4*)(kp[j] + 4 * d4);
#pragma unroll
                for (int g = 0; g < 4; ++g) acc[g][j] += qv[g].x * kv.x + qv[g].y * kv.y + qv[g].z * kv.z + qv[g].w * kv.w; }
        }
        float linv[4];
#pragma unroll
        for (int g = 0; g < 4; ++g) {
            float m = -INFINITY;
#pragma unroll
            for (int j = 0; j < 4; ++j) { if (lane + 64 * j >= cnt) acc[g][j] = -INFINITY; m = fmaxf(m, acc[g][j]); }
            m = wave_max(m); float l = 0.f;
#pragma unroll
            for (int j = 0; j < 4; ++j) { acc[g][j] = __expf(acc[g][j] - m); l += acc[g][j]; }
            linv[g] = 1.f / wave_sum(l);
        }
#pragma unroll
        for (int j = 0; j < 4; ++j) lp[lane + 64 * j] = (f32x4){acc[0][j], acc[1][j], acc[2][j], acc[3][j]};
        WAVE_SYNC();
        float o[4][2];
#pragma unroll
        for (int g = 0; g < 4; ++g) { o[g][0] = 0.f; o[g][1] = 0.f; }
#pragma unroll 8
        for (int e = 0; e < cnt; ++e) {
            const float* vp = (const float*)lvp[e]; const f32x2 vv = *(const f32x2*)(vp + 2 * lane); const f32x4 p = lp[e];
            o[0][0] += p.x * vv.x; o[0][1] += p.x * vv.y; o[1][0] += p.y * vv.x; o[1][1] += p.y * vv.y; o[2][0] += p.z * vv.x; o[2][1] += p.z * vv.y; o[3][0] += p.w * vv.x; o[3][1] += p.w * vv.y;
        }
#pragma unroll
        for (int g = 0; g < 4; ++g) *(unsigned*)(O + (size_t)r * DM + (4 * n + g) * 128 + 2 * lane) = pk2(o[g][0] * linv[g], o[g][1] * linv[g]);
    }
}

__device__ __forceinline__ void convC_phase(const bf16* PROJC, const Ptrs& P, int gw, int NGW, int lane) {
    unsigned char* ws = P.ws;
    bf16* QKVC = (bf16*)(ws + WS_QKVC); float* G = (float*)(ws + WS_G); float* BETA = (float*)(ws + WS_BETA);
    const float* cw = P.conv_w_c;
    for (int r = gw; r < NROWS; r += NGW) {
        int b = 0, t = 0, sb = 0; const bool samp = r >= SROW0;
        if (samp) sb = r - SROW0; else row_bt(r, b, t);
        int rr[3];
#pragma unroll
        for (int j = 0; j < 3; ++j) rr[j] = (!samp && t - 3 + j >= 0) ? prow(b, t - 3 + j) : -1;
        for (int it = 0; it < 16; ++it) {
            const int ch0 = it * 512 + 8 * lane;
            float x[4][8];
#pragma unroll
            for (int j = 0; j < 3; ++j) {
                if (samp) { const float* hp = P.state_conv_c + ((size_t)(sb * 3 + j)) * CDIM + ch0; const f32x4 a = *(const f32x4*)hp, c = *(const f32x4*)(hp + 4);
                    x[j][0] = a.x; x[j][1] = a.y; x[j][2] = a.z; x[j][3] = a.w; x[j][4] = c.x; x[j][5] = c.y; x[j][6] = c.z; x[j][7] = c.w; }
                else if (rr[j] >= 0) unpack8(*(const v4u*)(PROJC + (size_t)rr[j] * NC_PAD + ch0), x[j]);
                else {
#pragma unroll
                    for (int i = 0; i < 8; ++i) x[j][i] = 0.f; }
            }
            unpack8(*(const v4u*)(PROJC + (size_t)r * NC_PAD + ch0), x[3]);
            float acc[8];
#pragma unroll
            for (int i = 0; i < 8; ++i) acc[i] = 0.f;
#pragma unroll
            for (int j = 0; j < 4; ++j) { const f32x4 w0 = *(const f32x4*)(cw + (size_t)j * CDIM + ch0), w1 = *(const f32x4*)(cw + (size_t)j * CDIM + ch0 + 4);
                acc[0] += w0.x * x[j][0]; acc[1] += w0.y * x[j][1]; acc[2] += w0.z * x[j][2]; acc[3] += w0.w * x[j][3];
                acc[4] += w1.x * x[j][4]; acc[5] += w1.y * x[j][5]; acc[6] += w1.z * x[j][6]; acc[7] += w1.w * x[j][7]; }
            float ss = 0.f;
#pragma unroll
            for (int i = 0; i < 8; ++i) { acc[i] = silu_f(acc[i]); ss += acc[i] * acc[i]; }
            if (it < 8) { ss = row16_sum(ss); float rn = 1.f / sqrtf(ss + RMS_EPS); if (it < 4) rn *= QSCALE;
#pragma unroll
                for (int i = 0; i < 8; ++i) acc[i] *= rn; }
            *(v4u*)(QKVC + (size_t)r * CDIM + ch0) = pack8(acc);
            if (samp) {
                float* o = P.out + O_CCS + ((size_t)(sb * 3)) * CDIM + ch0;
#pragma unroll
                for (int j = 0; j < 3; ++j) { *(f32x4*)(o + (size_t)j * CDIM) = (f32x4){x[j + 1][0], x[j + 1][1], x[j + 1][2], x[j + 1][3]}; *(f32x4*)(o + (size_t)j * CDIM + 4) = (f32x4){x[j + 1][4], x[j + 1][5], x[j + 1][6], x[j + 1][7]}; }
            } else if (t >= TP - 3) {
                float* o = P.out + O_CCP + ((size_t)(b * 3 + (t - (TP - 3)))) * CDIM + ch0;
                *(f32x4*)o = (f32x4){x[3][0], x[3][1], x[3][2], x[3][3]}; *(f32x4*)(o + 4) = (f32x4){x[3][4], x[3][5], x[3][6], x[3][7]};
            }
        }
        if (lane < 32) {
            const float braw = bf2f(PROJC[(size_t)r * NC_PAD + 12288 + lane]), araw = bf2f(PROJC[(size_t)r * NC_PAD + 12320 + lane]);
            const float xx = araw + P.dt_bias[lane]; const float sp = xx > 20.f ? xx : log1pf(expf(xx));
            G[(size_t)r * 32 + lane] = -expf(P.a_log[lane]) * sp; BETA[(size_t)r * 32 + lane] = 1.f / (1.f + expf(-braw));
        }
    }
}

struct Tok { v4u k, q; float v, g, b; };
__device__ __forceinline__ void tok_load(Tok& T, const bf16* QKVC, const float* G, const float* BETA, int row, int h, int rg, int col) {
    const bf16* base = QKVC + (size_t)row * CDIM;
    T.q = *(const v4u*)(base + (h >> 1) * 128 + 8 * rg);
    T.k = *(const v4u*)(base + 2048 + (h >> 1) * 128 + 8 * rg);
    T.v = bf2f(base[4096 + h * 128 + col]);
    T.g = G[(size_t)row * 32 + h]; T.b = BETA[(size_t)row * 32 + h];
}
__device__ __forceinline__ float tok_step(float (&S)[8], const Tok& T) {
    float kk[8], qq[8]; unpack8(T.k, kk); unpack8(T.q, qq);
    const float a = __expf(T.g);
    float d = 0.f;
#pragma unroll
    for (int i = 0; i < 8; ++i) d += S[i] * kk[i];
    d = row16_sum(d);
    const float dl = T.b * (T.v - a * d);
    float o = 0.f;
#pragma unroll
    for (int i = 0; i < 8; ++i) { S[i] = a * S[i] + kk[i] * dl; o += S[i] * qq[i]; }
    return row16_sum(o);
}
constexpr int DBK = 4;
__device__ __forceinline__ void delta_segment(float (&S)[8], const bf16* QKVC, const float* G, const float* BETA, float* OF, int rowbase, int ntok, int h, int rg, int col) {
    Tok cur[DBK], nxt[DBK];
#pragma unroll
    for (int i = 0; i < DBK; ++i) tok_load(cur[i], QKVC, G, BETA, rowbase + i, h, rg, col);
    for (int t0 = 0; t0 < ntok; t0 += DBK) {
        const bool more = t0 + DBK < ntok;
        if (more) {
#pragma unroll
            for (int i = 0; i < DBK; ++i) tok_load(nxt[i], QKVC, G, BETA, rowbase + t0 + DBK + i, h, rg, col); }
#pragma unroll
        for (int i = 0; i < DBK; ++i) { const float o = tok_step(S, cur[i]); if (rg == 0) OF[(size_t)(rowbase + t0 + i) * DVW + h * 128 + col] = o; }
        if (more) {
#pragma unroll
            for (int i = 0; i < DBK; ++i) cur[i] = nxt[i]; }
    }
}
__device__ __forceinline__ void delta_phase(const Ptrs& P, int gw, int NGW, int lane) {
    unsigned char* ws = P.ws;
    const bf16* QKVC = (const bf16*)(ws + WS_QKVC); const float* G = (const float*)(ws + WS_G); const float* BETA = (const float*)(ws + WS_BETA); float* OF = (float*)(ws + WS_SC);
    const int cg = lane >> 4, rg = lane & 15;
    for (int item = gw; item < NBP * 32 * 32; item += NGW) {
        const int b = item >> 10, h = (item >> 5) & 31, col = 4 * (item & 31) + cg;
        float S[8];
#pragma unroll
        for (int i = 0; i < 8; ++i) S[i] = 0.f;
        delta_segment(S, QKVC, G, BETA, OF, XROW0 + b * NMETA, NMETA, h, rg, col);
        delta_segment(S, QKVC, G, BETA, OF, b * SEQ, SEQ, h, rg, col);
        float* o = P.out + O_DP + ((size_t)((b * 32 + h) * 128 + 8 * rg)) * 128 + col;
#pragma unroll
        for (int i = 0; i < 8; ++i) o[(size_t)i * 128] = S[i];
    }
    for (int item = gw; item < SBN * 32 * 32; item += NGW) {
        const int sb = item >> 10, h = (item >> 5) & 31, col = 4 * (item & 31) + cg;
        const size_t so = ((size_t)((sb * 32 + h) * 128 + 8 * rg)) * 128 + col;
        float S[8];
#pragma unroll
        for (int i = 0; i < 8; ++i) S[i] = P.state_delta[so + (size_t)i * 128];
        Tok T; tok_load(T, QKVC, G, BETA, SROW0 + sb, h, rg, col);
        const float o = tok_step(S, T);
        if (rg == 0) OF[(size_t)(SROW0 + sb) * DVW + h * 128 + col] = o;
        float* op = P.out + O_DS + so;
#pragma unroll
        for (int i = 0; i < 8; ++i) op[(size_t)i * 128] = S[i];
    }
}
__device__ __forceinline__ void normC_phase(const bf16* PROJC, bf16* Y, const Ptrs& P, int gw, int NGW, int lane) {
    const float* OF = (const float*)(P.ws + WS_SC);
    const int d0 = 8 * (lane & 15);
    float nw[8];
    { const f32x4 a = *(const f32x4*)(P.norm_w + d0), b = *(const f32x4*)(P.norm_w + d0 + 4); nw[0] = a.x; nw[1] = a.y; nw[2] = a.z; nw[3] = a.w; nw[4] = b.x; nw[5] = b.y; nw[6] = b.z; nw[7] = b.w; }
    for (int r = gw; r < NROWS; r += NGW) {
#pragma unroll 2
        for (int it = 0; it < 8; ++it) {
            const int hd = it * 4 + (lane >> 4);
            const float* op = OF + (size_t)r * DVW + hd * 128 + d0;
            const f32x4 a = *(const f32x4*)op, b = *(const f32x4*)(op + 4);
            float o[8] = {a.x, a.y, a.z, a.w, b.x, b.y, b.z, b.w};
            float ss = 0.f;
#pragma unroll
            for (int i = 0; i < 8; ++i) ss += o[i] * o[i];
            ss = row16_sum(ss);
            const float rs = 1.f / sqrtf(ss * (1.f / 128.f) + RMS_EPS);
            float z[8]; unpack8(*(const v4u*)(PROJC + (size_t)r * NC_PAD + 8192 + hd * 128 + d0), z);
#pragma unroll
            for (int i = 0; i < 8; ++i) o[i] = o[i] * rs * nw[i] * silu_f(z[i]);
            *(v4u*)(Y + (size_t)r * DVW + hd * 128 + d0) = pack8(o);
        }
    }
}

struct Args { const void* in[27]; float* out; unsigned char* ws; int ph_lo, ph_hi; };
constexpr int PH_PER_LAYER = 12, PH_END = 1 + 4 * PH_PER_LAYER;

__global__ void __launch_bounds__(NTHREADS, 2) mega_fwd(Args args) {
    extern __shared__ __attribute__((aligned(16))) unsigned char lds_raw[];
    LAS unsigned char* lds = (LAS unsigned char*)lds_raw;
    const int tid = threadIdx.x, lane = tid & 63, wave = __builtin_amdgcn_readfirstlane(tid >> 6);
    const int G_ = gridDim.x, gw = blockIdx.x * NWAVES + wave, NGW = G_ * NWAVES, gtid = blockIdx.x * NTHREADS + tid, NT = G_ * NTHREADS;
    Ptrs P;
    P.x_prompt = (const float*)args.in[0]; P.x_sample = (const float*)args.in[1]; P.state_conv_a = (const float*)args.in[2]; P.cache_k = (const float*)args.in[3];
    P.cache_v = (const float*)args.in[4]; P.cache_ik = (const float*)args.in[5]; P.state_conv_c = (const float*)args.in[6]; P.state_delta = (const float*)args.in[7];
    P.page_table = (const int*)args.in[8]; P.meta = (const float*)args.in[9]; P.w_in_a = (const float*)args.in[10]; P.conv_w_a = (const float*)args.in[11];
    P.w_out_a = (const float*)args.in[12]; P.w_in_b = (const float*)args.in[13]; P.w_out_b = (const float*)args.in[14]; P.w_in_c = (const float*)args.in[15];
    P.conv_w_c = (const float*)args.in[16]; P.a_log = (const float*)args.in[17]; P.dt_bias = (const float*)args.in[18]; P.norm_w = (const float*)args.in[19];
    P.w_out_c = (const float*)args.in[20]; P.ln1_g = (const float*)args.in[21]; P.ln1_b = (const float*)args.in[22]; P.w1 = (const float*)args.in[23];
    P.w2 = (const float*)args.in[24]; P.ln2_g = (const float*)args.in[25]; P.ln2_b = (const float*)args.in[26];
    P.out = args.out; P.ws = args.ws;
    unsigned char* ws = args.ws;
    const int lo = args.ph_lo, hi = args.ph_hi;
    const bool fused = (hi - lo) > 1;

    for (int u = tid; u < (LDS_BYTES - LDSCTL_OFF) / 4; u += NTHREADS) ((LAS unsigned*)(lds + LDSCTL_OFF))[u] = 0u;
    __syncthreads();
    volatile LAS unsigned* MISC = (volatile LAS unsigned*)(lds + MISC_OFF);
    XcdBarrier bar; bar.bar = (unsigned*)(ws + WS_CTL) + CW_BAR; bar.x = 0; bar.st = nullptr;
    if (fused) bar = xcd_barrier_post((unsigned*)(ws + WS_CTL) + CW_BAR, MISC + 8);

#ifndef MK_SITES
#define MK_SITES 0xffffffffu
#endif
#define SITE(n) (((MK_SITES) >> (n)) & 1u)
#define IN(k) (lo <= (k) && (k) < hi)
#define LOCALS int tid_ = threadIdx.x; asm volatile("" : "+v"(tid_)); const int lane_ = tid_ & 63, wave_ = __builtin_amdgcn_readfirstlane(tid_ >> 6), gw_ = blockIdx.x * NWAVES + wave_, gtid_ = blockIdx.x * NTHREADS + tid_; (void)lane_; (void)wave_; (void)gw_; (void)gtid_
#define SEAM(k) do { if (fused && (k) + 1 < PH_END) xcd_barrier(bar); else __syncthreads(); } while (0)

    bf16* X = (bf16*)(ws + WS_X); float* Z = (float*)(ws + WS_Z); bf16* Y = (bf16*)(ws + WS_Y); bf16* BIG = (bf16*)(ws + WS_BIG);

    if (SITE(0) && IN(0)) { LOCALS; p0_prologue(P, lds, gw_, NGW, wave_, lane_); SEAM(0); }

    for (int layer = 0; layer < 4; ++layer) {
        const int kind = layer % 3, j = layer / 3, base = 1 + layer * PH_PER_LAYER;
        if (kind == 0) {
            if (SITE(1) && IN(base + 0)) {
                pg8::Gemm g{X, (const bf16*)(ws + WS_WA_IN + (size_t)j * WSZ_A_IN), MPAD, NA_IN, DM}; pg8::StaticOrder S; S.init(MPAD, NA_IN, G_, (int)blockIdx.x);
                pg8::EpiBf16<0> E{BIG, NA_IN, nullptr, 0, 0, 1.f};
                pg8::gemm_phase<pg8::EpiBf16<0>, pg8::StaticOrder, true, true>(lds, g, S, E);
                SEAM(base + 0);
            }
            if (SITE(2) && IN(base + 1)) {
                LOCALS; convA_phase(BIG, Y, P.conv_w_a + (size_t)j * 3 * DM, P.state_conv_a + (size_t)j * SBN * 2 * DM, P.out + O_CAP + (size_t)j * NBP * 2 * DM, P.out + O_CAS + (size_t)j * SBN * 2 * DM, gtid_, NT);
                SEAM(base + 1);
            }
            if (SITE(3) && IN(base + 2)) {
                pg8::Gemm g{Y, (const bf16*)(ws + WS_WA_OUT + (size_t)j * WSZ_A_OUT), MPAD, DM, DM}; pg8::StaticOrder S; S.init(MPAD, DM, G_, (int)blockIdx.x);
                pg8::EpiF32 E{Z, DM};
                pg8::gemm_phase<pg8::EpiF32, pg8::StaticOrder, true, true>(lds, g, S, E);
                SEAM(base + 2);
            }
        } else if (kind == 1) {
            if (SITE(4) && IN(base + 0)) {
                pg8::Gemm g{X, (const bf16*)(ws + WS_WB_IN), MPAD, NB_PAD, DM}; pg8::StaticOrder S; S.init(MPAD, NB_PAD, G_, (int)blockIdx.x);
                pg8::EpiBf16<0> E{BIG, NB_PAD, nullptr, 0, 0, 1.f};
                pg8::gemm_phase<pg8::EpiBf16<0>, pg8::StaticOrder, true, true>(lds, g, S, E);
                SEAM(base + 0);
            }
            if (SITE(5) && IN(base + 1)) { LOCALS; rope_phase(BIG, P, gw_, NGW, lane_); SEAM(base + 1); }
            if (SITE(6) && IN(base + 2)) { LOCALS; indexer_sample(P, lds, tid_); indexer_prompt(P, gw_, NGW, lane_); SEAM(base + 2); }
            if (SITE(7) && IN(base + 3)) { LOCALS; select_phase(P, lds, gw_, NGW, tid_, wave_, lane_); SEAM(base + 3); }
            if (SITE(8) && IN(base + 4)) { LOCALS; attn_phase(P, Y, lds, gw_, NGW, wave_, lane_); SEAM(base + 4); }
            if (SITE(9) && IN(base + 5)) {
                pg8::Gemm g{Y, (const bf16*)(ws + WS_WB_OUT), MPAD, DM, DM}; pg8::StaticOrder S; S.init(MPAD, DM, G_, (int)blockIdx.x);
                pg8::EpiF32 E{Z, DM};
                pg8::gemm_phase<pg8::EpiF32, pg8::StaticOrder, true, true>(lds, g, S, E);
                SEAM(base + 5);
            }
        } else {
            if (SITE(10) && IN(base + 0)) {
                pg8::Gemm g{X, (const bf16*)(ws + WS_WC_IN), MPAD, NC_PAD, DM}; pg8::StaticOrder S; S.init(MPAD, NC_PAD, G_, (int)blockIdx.x);
                pg8::EpiBf16<0> E{BIG, NC_PAD, nullptr, 0, 0, 1.f};
                pg8::gemm_phase<pg8::EpiBf16<0>, pg8::StaticOrder, true, true>(lds, g, S, E);
                SEAM(base + 0);
            }
            if (SITE(11) && IN(base + 1)) { LOCALS; convC_phase(BIG, P, gw_, NGW, lane_); SEAM(base + 1); }
            if (SITE(12) && IN(base + 2)) { LOCALS; delta_phase(P, gw_, NGW, lane_); SEAM(base + 2); }
            if (SITE(13) && IN(base + 3)) { LOCALS; normC_phase(BIG, Y, P, gw_, NGW, lane_); SEAM(base + 3); }
            if (SITE(14) && IN(base + 4)) {
                pg8::Gemm g{Y, (const bf16*)(ws + WS_WC_OUT), MPAD, DM, DVW}; pg8::StaticOrder S; S.init(MPAD, DM, G_, (int)blockIdx.x);
                pg8::EpiF32 E{Z, DM};
                pg8::gemm_phase<pg8::EpiF32, pg8::StaticOrder, true, true>(lds, g, S, E);
                SEAM(base + 4);
            }
        }
        if (SITE(15) && IN(base + 6)) { LOCALS; ln_phase(Z, X, P.ln1_g + (size_t)layer * DM, P.ln1_b + (size_t)layer * DM, nullptr, nullptr, gw_, NGW, lane_); SEAM(base + 6); }
        if (SITE(16) && IN(base + 7)) {
            pg8::Gemm g{X, (const bf16*)(ws + WS_W1 + (size_t)layer * WSZ_W1), MPAD, FF, DM}; pg8::StaticOrder S; S.init(MPAD, FF, G_, (int)blockIdx.x);
            pg8::EpiBf16<2> E{BIG, FF, nullptr, 0, 0, 1.f};
            pg8::gemm_phase<pg8::EpiBf16<2>, pg8::StaticOrder, true, true>(lds, g, S, E);
            SEAM(base + 7);
        }
        if (SITE(17) && IN(base + 8)) {
            pg8::Gemm g{BIG, (const bf16*)(ws + WS_W2 + (size_t)layer * WSZ_W2), MPAD, DM, FF}; pg8::StaticOrder S; S.init(MPAD, DM, G_, (int)blockIdx.x);
            pg8::EpiF32 E{Z, DM};
            pg8::gemm_phase<pg8::EpiF32, pg8::StaticOrder, true, true>(lds, g, S, E);
            SEAM(base + 8);
        }
        if (SITE(18) && IN(base + 9)) {
            const bool last = layer == 3;
            LOCALS; ln_phase(Z, X, P.ln2_g + (size_t)layer * DM, P.ln2_b + (size_t)layer * DM, last ? P.out + O_YP : nullptr, last ? P.out + O_YS : nullptr, gw_, NGW, lane_);
            if (!last) SEAM(base + 9);
        }
    }
#undef IN
#undef SEAM
}

#ifndef MK_SPLIT
#define MK_SPLIT 1
#endif
extern "C" void kernel_launch(void* const* d_in, const int* in_sizes, int n_in, void* d_out, int out_size, void* d_ws, size_t ws_size, hipStream_t stream) {
    static int grid = 0;
    if (grid == 0) {
        if (n_in != 27 || (size_t)out_size != O_END || ws_size < WS_END) { fprintf(stderr, "kernel_launch: unexpected shapes: n_in %d out %d (want %zu) ws %zu (want >= %zu)\n", n_in, out_size, (size_t)O_END, ws_size, (size_t)WS_END); grid = -1; return; }
        int dev = 0, cus = 0;
        if (hipGetDevice(&dev) != hipSuccess || hipDeviceGetAttribute(&cus, hipDeviceAttributeMultiprocessorCount, dev) != hipSuccess) { grid = -1; return; }
        if (hipFuncSetAttribute((const void*)mega_fwd, hipFuncAttributeMaxDynamicSharedMemorySize, LDS_BYTES) != hipSuccess) { fprintf(stderr, "kernel_launch: hipFuncSetAttribute failed\n"); grid = -1; return; }
        int per_cu = 0;
        if (hipOccupancyMaxActiveBlocksPerMultiprocessor(&per_cu, (const void*)mega_fwd, NTHREADS, LDS_BYTES) != hipSuccess || per_cu < 1) fprintf(stderr, "kernel_launch: occupancy query reports %d\n", per_cu);
        (void)hipGetLastError();
        grid = cus;
    }
    if (grid < 0) return;
    (void)hipMemsetAsync((char*)d_ws + WS_CTL, 0, CTL_ZERO_BYTES, stream);
    Args a{};
    for (int i = 0; i < 27; ++i) a.in[i] = d_in[i];
    a.out = (float*)d_out; a.ws = (unsigned char*)d_ws;
#if MK_SPLIT
    for (int ph = 0; ph < PH_END; ++ph) {
        bool exists = (ph == 0);
        if (ph > 0) { const int layer = (ph - 1) / PH_PER_LAYER, l = (ph - 1) % PH_PER_LAYER, kind = layer % 3; const int nmix = kind == 0 ? 3 : (kind == 1 ? 6 : 5); exists = (l < nmix) || (l >= 6 && l <= 9); }
        if (!exists) continue;
        a.ph_lo = ph; a.ph_hi = ph + 1;
        hipLaunchKernelGGL(mega_fwd, dim3(grid), dim3(NTHREADS), LDS_BYTES, stream, a);
    }
#else
    a.ph_lo = 0; a.ph_hi = PH_END;
    hipLaunchKernelGGL(mega_fwd, dim3(grid), dim3(NTHREADS), LDS_BYTES, stream, a);
#endif
    const hipError_t le = hipPeekAtLastError();
    if (le != hipSuccess) fprintf(stderr, "kernel_launch: launch failed: %s\n", hipGetErrorName(le));
}
```

```cpp
#include <hip/hip_runtime.h>
#include <cstdio>
#include <cstdint>
#include <cmath>
__device__ __forceinline__ int flane() { return (int)__builtin_amdgcn_mbcnt_hi(~0u, __builtin_amdgcn_mbcnt_lo(~0u, 0u)); }
namespace pg8 {
#define PG8_LAS __attribute__((address_space(3)))
typedef unsigned short bf16_t;
typedef short bf16x8 __attribute__((ext_vector_type(8)));
typedef float f32x4 __attribute__((ext_vector_type(4)));
typedef unsigned u32x4 __attribute__((ext_vector_type(4)));
constexpr int BM = 256, BK = 64, HALF = 128, HTB = HALF * BK * 2  , STAGE_BYTES = 8 * HTB, NXCD = 8, WGM = 8;

__host__ __device__ __forceinline__ int lds_byte(int r, int c) { const int st = (r >> 4) * 2 + (c >> 5), rr = r & 15, cc = c & 31, ob = rr * 64 + cc * 2; return st * 1024 + (ob ^ (((ob >> 9) & 1) << 5)); }
__host__ __device__ __forceinline__ void stage_rc(int b, int& R, int& C) { const int st = b / 1024, sb = b % 1024, swz = sb ^ (((sb >> 9) & 1) << 5); R = (st >> 1) * 16 + swz / 64; C = (st & 1) * 32 + (swz % 64) / 2; }
__host__ __device__ __forceinline__ int perm32(int rho) { const int n = rho >> 4, i = rho & 15; return 8 * (i >> 2) + 4 * n + (i & 3); }

struct Unit { int pm, pn; };
struct Gemm { const bf16_t* A; const bf16_t* Bt; int M, N, K; };

struct StaticOrder {
    int nM, nN, nwg, G, c;
    __host__ __device__ void init(int M, int N, int G_, int c_) { nM = M / BM; nN = N / BM; nwg = nM * nN; G = G_; c = c_; }
    __host__ __device__ bool next(int i, Unit& u) const {
        const long L = (long)i * G + c; if (L >= nwg) return false;
        int wgid = (int)L; { const int q = nwg / NXCD, r = nwg % NXCD, xcd = wgid % NXCD, off = wgid / NXCD; wgid = (xcd < r ? xcd * (q + 1) : r * (q + 1) + (xcd - r) * q) + off; }
        const int nig = WGM * nN, gid = wgid / nig, fm = gid * WGM, gsz = (nM - fm) < WGM ? (nM - fm) : WGM;
        u.pm = fm + ((wgid % nig) % gsz); u.pn = (wgid % nig) / gsz; return true;
    }
    __device__ __forceinline__ void a_ready(const Unit&) const {}
    __device__ __forceinline__ void done(const Unit&) const {}
};

__device__ __forceinline__ unsigned cvt_pk_bf16(float lo, float hi) { unsigned r; asm volatile("v_cvt_pk_bf16_f32 %0, %1, %2" : "=v"(r) : "v"(lo), "v"(hi)); return r; }
typedef float f32x2 __attribute__((ext_vector_type(2)));
__device__ __forceinline__ f32x2 gelu_pk(f32x2 v) {
    const f32x2 av = __builtin_elementwise_abs(v), d = av * 0.2316418882f + 1.0f;
    f32x2 t; t.x = __builtin_amdgcn_rcpf(d.x); t.y = __builtin_amdgcn_rcpf(d.y);
    f32x2 q = t * 0.5307027145f + (-0.7265760135f); q = q * t + 0.7107068705f; q = q * t + (-0.142248368f); q = q * t + 0.127414796f; q = q * t;
    const f32x2 s = (v * v) * (-0.72134752044f);
    f32x2 e; e.x = __builtin_amdgcn_exp2f(s.x); e.y = __builtin_amdgcn_exp2f(s.y);
    const f32x2 m = v * (q * e), r = v - m;
    f32x2 o; o.x = v.x < 0.f ? m.x : r.x; o.y = v.y < 0.f ? m.y : r.y; return o;
}

template <int ACT  > struct EpiBf16 {
    static constexpr bool PERM = true, AFTER_DRAIN = false; static_assert(ACT == 0 || ACT == 1 || ACT == 2, "EpiBf16: ACT is 0 (none), 1 (gelu_pk) or 2 (relu^2)");
    bf16_t* O; int ldc; const float* bias; int split_cols; size_t split_stride; float scale0;
    __device__ __forceinline__ void operator()(const f32x4 (&acc)[2][2][4][2], const Unit& u, int wr, int wc, int fr, int fq) const {
        const int row0 = u.pm * BM + wr * 64 + fr; int colt = u.pn * BM; bf16_t* base = O;
        float sc = 1.f; if (split_cols) { const int t = colt / split_cols; base += (size_t)t * split_stride; colt -= t * split_cols; if (t == 0) sc = scale0; }
        const int col0 = colt + wc * 32 + 8 * fq, bcol0 = u.pn * BM + wc * 32 + 8 * fq;
        f32x4 bv[2][2];
#pragma unroll
        for (int bj = 0; bj < 2; ++bj)
#pragma unroll
            for (int n = 0; n < 2; ++n) bv[bj][n] = bias ? *(const f32x4*)(bias + bcol0 + bj * HALF + 4 * n) : (f32x4){0.f, 0.f, 0.f, 0.f};
#pragma unroll
        for (int ai = 0; ai < 2; ++ai)
#pragma unroll
            for (int m = 0; m < 4; ++m) { bf16_t* rowp = base + (size_t)(row0 + ai * HALF + m * 16) * ldc + col0;
#pragma unroll
                for (int bj = 0; bj < 2; ++bj) { f32x4 v0 = acc[ai][bj][m][0] + bv[bj][0], v1 = acc[ai][bj][m][1] + bv[bj][1];
                    if (ACT == 1) { f32x2 a = gelu_pk((f32x2){v0[0], v0[1]}), b = gelu_pk((f32x2){v0[2], v0[3]}), c = gelu_pk((f32x2){v1[0], v1[1]}), d = gelu_pk((f32x2){v1[2], v1[3]});
                        v0 = (f32x4){a.x, a.y, b.x, b.y}; v1 = (f32x4){c.x, c.y, d.x, d.y}; }
                    if (ACT == 2) { _Pragma("unroll") for (int q_ = 0; q_ < 4; ++q_) { const float a_ = v0[q_] > 0.f ? v0[q_] : 0.f, b_ = v1[q_] > 0.f ? v1[q_] : 0.f; v0[q_] = a_ * a_; v1[q_] = b_ * b_; } }
                    v0 = v0 * sc; v1 = v1 * sc; u32x4 w; w.x = cvt_pk_bf16(v0[0], v0[1]); w.y = cvt_pk_bf16(v0[2], v0[3]); w.z = cvt_pk_bf16(v1[0], v1[1]); w.w = cvt_pk_bf16(v1[2], v1[3]);
                    *(u32x4*)(rowp + bj * HALF) = w; } }
    }
};


struct EpiF32 {
    static constexpr bool PERM = false, AFTER_DRAIN = false;
    float* C; int ldc;
    __device__ __forceinline__ void operator()(const f32x4 (&acc)[2][2][4][2], const Unit& u, int wr, int wc, int fr, int fq) const {
        const int row0 = u.pm * BM + wr * 64 + fr, col0 = u.pn * BM + wc * 32 + 4 * fq;
#pragma unroll
        for (int ai = 0; ai < 2; ++ai)
#pragma unroll
            for (int m = 0; m < 4; ++m) { float* rowp = C + (size_t)(row0 + ai * HALF + m * 16) * ldc + col0;
#pragma unroll
                for (int bj = 0; bj < 2; ++bj)
#pragma unroll
                    for (int n = 0; n < 2; ++n) *(f32x4*)(rowp + bj * HALF + n * 16) = acc[ai][bj][m][n]; }
    }
};
struct PanelStats {
    unsigned* xbuf;
    unsigned* cnt;
    unsigned* tmo;
    int ntn; float eps;
    unsigned code;
    __device__ __forceinline__ bool run(const f32x4 (&v)[2][2][4][2], const Unit& u, int wr, int wc, int fr, int fq, PG8_LAS unsigned char* lds, int wid, int lane) const {
        typedef float f32x2v __attribute__((ext_vector_type(2)));
        PG8_LAS f32x2v* P = (PG8_LAS f32x2v*)lds;
        PG8_LAS f32x2v* S = (PG8_LAS f32x2v*)(lds + 8192);
        PG8_LAS unsigned* flag = (PG8_LAS unsigned*)(lds + 8192 + 2048);
#pragma unroll
        for (int ai = 0; ai < 2; ++ai)
#pragma unroll
            for (int m = 0; m < 4; ++m) {
                float s = 0.f;
#pragma unroll
                for (int bj = 0; bj < 2; ++bj)
#pragma unroll
                    for (int n = 0; n < 2; ++n) { const f32x4 x = v[ai][bj][m][n]; s += (x[0] + x[1]) + (x[2] + x[3]); }
                s += __shfl_xor(s, 16); s += __shfl_xor(s, 32);
                const float mw = s * (1.0f / 64.0f); float q = 0.f;
#pragma unroll
                for (int bj = 0; bj < 2; ++bj)
#pragma unroll
                    for (int n = 0; n < 2; ++n) { const f32x4 d = v[ai][bj][m][n] - mw; q += (d[0] * d[0] + d[1] * d[1]) + (d[2] * d[2] + d[3] * d[3]); }
                q += __shfl_xor(q, 16); q += __shfl_xor(q, 32);
                if (fq == 0) P[(ai * HALF + wr * 64 + m * 16 + fr) * 4 + wc] = (f32x2v){mw, q};
            }
        asm volatile("s_waitcnt lgkmcnt(0)" ::: "memory"); __builtin_amdgcn_s_barrier(); asm volatile("" ::: "memory");
#if defined(BROKEN_EXCHANGE_NO_WAIT)
#warning BROKEN CONTROL BUILD: the row-statistics exchange does not wait; results are wrong by design
        if (blockIdx.x >= 64) { const long long t0_ = clock64(); while (clock64() - t0_ < 60000) __builtin_amdgcn_s_sleep(8); }
#endif
        const int row = wid * 32 + (lane & 31);
        if (lane < 32) {
            const f32x2v a = P[row * 4 + 0], b = P[row * 4 + 1], c = P[row * 4 + 2], d = P[row * 4 + 3];
            const float mt = (a.x + b.x + c.x + d.x) * 0.25f;
            const float da = a.x - mt, db = b.x - mt, dc = c.x - mt, dd = d.x - mt;
            const float m2 = (a.y + b.y) + (c.y + d.y) + 64.0f * ((da * da + db * db) + (dc * dc + dd * dd));
            unsigned long long* slot = (unsigned long long*)xbuf + ((size_t)(u.pm * BM + row) * 4 + u.pn);
            __hip_atomic_store(slot, ((unsigned long long)__float_as_uint(m2) << 32) | __float_as_uint(mt), __ATOMIC_RELAXED, __HIP_MEMORY_SCOPE_AGENT);
        }
        asm volatile("s_waitcnt vmcnt(0)" ::: "memory");
        if (lane == 0) __hip_atomic_fetch_add(cnt + 64 * u.pm, 1u, __ATOMIC_RELAXED, __HIP_MEMORY_SCOPE_AGENT);
        if (wid == 0) {
            bool dead = false; const unsigned long long t0 = __builtin_amdgcn_s_memrealtime(); const unsigned want = 8u * (unsigned)ntn;
            for (;;) {
#if defined(BROKEN_EXCHANGE_NO_WAIT)
                break;
#endif
                if ((unsigned)__builtin_amdgcn_readfirstlane(__hip_atomic_load(cnt + 64 * u.pm, __ATOMIC_RELAXED, __HIP_MEMORY_SCOPE_AGENT)) >= want) break;
                if (__builtin_amdgcn_s_memrealtime() - t0 > 2000000ull) {
                    if (lane == 0) { unsigned expect = 0u; __hip_atomic_compare_exchange_strong(tmo + 1, &expect, code | (unsigned)(u.pm & 0xff), __ATOMIC_RELAXED, __ATOMIC_RELAXED, __HIP_MEMORY_SCOPE_AGENT);
                                     __hip_atomic_store(tmo, 1u, __ATOMIC_RELAXED, __HIP_MEMORY_SCOPE_AGENT); }
                    dead = true; break; }
                __builtin_amdgcn_s_sleep(2);
            }
            __builtin_amdgcn_fence(__ATOMIC_ACQUIRE, "agent");
            if (lane == 0) flag[0] = dead ? 1u : 0u;
        }
        asm volatile("s_waitcnt vmcnt(0) lgkmcnt(0)" ::: "memory"); __builtin_amdgcn_s_barrier(); asm volatile("" ::: "memory");
        const bool bad = flag[0] != 0u;
        if (lane < 32) {
            const unsigned long long* slot = (const unsigned long long*)xbuf + (size_t)(u.pm * BM + row) * 4; float mt[4], m2[4]; float ms = 0.f;
#pragma unroll
            for (int t = 0; t < 4; ++t) { if (t < ntn) { const unsigned long long w = __hip_atomic_load(slot + t, __ATOMIC_RELAXED, __HIP_MEMORY_SCOPE_AGENT); mt[t] = __uint_as_float((unsigned)w); m2[t] = __uint_as_float((unsigned)(w >> 32)); } else { mt[t] = 0.f; m2[t] = 0.f; } ms += mt[t]; }
            const float mean = ms / (float)ntn; float q = 0.f;
#pragma unroll
            for (int t = 0; t < 4; ++t) if (t < ntn) { const float dm = mt[t] - mean; q += m2[t] + 256.0f * dm * dm; }
            S[row] = (f32x2v){mean, 1.0f / sqrtf(q / (256.0f * (float)ntn) + eps)};
        }
        asm volatile("s_waitcnt lgkmcnt(0)" ::: "memory"); __builtin_amdgcn_s_barrier(); asm volatile("" ::: "memory");
        return bad;
    }
};
struct EpiLnRes {
    static constexpr bool PERM = false, AFTER_DRAIN = true;
    const float* base; float* out; int ldc; const float* bias; PanelStats st; unsigned poison;
    __device__ __forceinline__ void fused(f32x4 (&acc)[2][2][4][2], const Unit& u, int wr, int wc, int fr, int fq, PG8_LAS unsigned char* lds, int wid, int lane) const {
        typedef float f32x2v __attribute__((ext_vector_type(2)));
        const PG8_LAS f32x2v* S = (const PG8_LAS f32x2v*)(lds + 8192);
        const int col0 = u.pn * BM + wc * 32 + 4 * fq;
#pragma unroll
        for (int bj = 0; bj < 2; ++bj)
#pragma unroll
            for (int n = 0; n < 2; ++n) { const f32x4 bv = bias ? *(const f32x4*)(bias + col0 + bj * HALF + n * 16) : (f32x4){0.f, 0.f, 0.f, 0.f};
#pragma unroll
                for (int ai = 0; ai < 2; ++ai)
#pragma unroll
                    for (int m = 0; m < 4; ++m) acc[ai][bj][m][n] += bv; }
        f32x4 pre[4][2][2];
#pragma unroll
        for (int m = 0; m < 4; ++m) { const size_t off = (size_t)(u.pm * BM + wr * 64 + m * 16 + fr) * ldc + col0;
#pragma unroll
            for (int bj = 0; bj < 2; ++bj)
#pragma unroll
                for (int n = 0; n < 2; ++n) pre[m][bj][n] = *(const f32x4*)(base + off + bj * HALF + n * 16); }
        const bool bad = st.run(acc, u, wr, wc, fr, fq, lds, wid, lane) || poison != 0u;
        const float qnan = __builtin_nanf("");
#pragma unroll
        for (int ai = 0; ai < 2; ++ai)
#pragma unroll
            for (int m = 0; m < 4; ++m) { const int r = ai * HALF + wr * 64 + m * 16 + fr; const f32x2v sr = S[r]; const size_t off = (size_t)(u.pm * BM + r) * ldc + col0;
#pragma unroll
                for (int bj = 0; bj < 2; ++bj)
#pragma unroll
                    for (int n = 0; n < 2; ++n) { const f32x4 bs = ai == 0 ? pre[m][bj][n] : *(const f32x4*)(base + off + bj * HALF + n * 16); f32x4 o = bs + (acc[ai][bj][m][n] - sr.x) * sr.y;
                        if (bad) o = (f32x4){qnan, qnan, qnan, qnan}; *(f32x4*)(out + off + bj * HALF + n * 16) = o; }
                if (m & 1) asm volatile("" ::: "memory"); }
    }
};
struct EpiLnResLn {
    static constexpr bool PERM = false, AFTER_DRAIN = true;
    const float* base; float* out; bf16_t* xn; int ldc; const float* bias; PanelStats st1, st2; unsigned poison;
    __device__ __forceinline__ void fused(f32x4 (&acc)[2][2][4][2], const Unit& u, int wr, int wc, int fr, int fq, PG8_LAS unsigned char* lds, int wid, int lane) const {
        typedef float f32x2v __attribute__((ext_vector_type(2))); typedef unsigned u32x2v __attribute__((ext_vector_type(2)));
        const PG8_LAS f32x2v* S = (const PG8_LAS f32x2v*)(lds + 8192);
        const int col0 = u.pn * BM + wc * 32 + 4 * fq;
#pragma unroll
        for (int bj = 0; bj < 2; ++bj)
#pragma unroll
            for (int n = 0; n < 2; ++n) { const f32x4 bv = bias ? *(const f32x4*)(bias + col0 + bj * HALF + n * 16) : (f32x4){0.f, 0.f, 0.f, 0.f};
#pragma unroll
                for (int ai = 0; ai < 2; ++ai)
#pragma unroll
                    for (int m = 0; m < 4; ++m) acc[ai][bj][m][n] += bv; }
        bool bad = st1.run(acc, u, wr, wc, fr, fq, lds, wid, lane) || poison != 0u;
        const float qnan = __builtin_nanf("");
#pragma unroll
        for (int ai = 0; ai < 2; ++ai)
#pragma unroll
            for (int m = 0; m < 4; ++m) { const int r = ai * HALF + wr * 64 + m * 16 + fr; const f32x2v sr = S[r]; const size_t off = (size_t)(u.pm * BM + r) * ldc + col0;
#pragma unroll
                for (int bj = 0; bj < 2; ++bj)
#pragma unroll
                    for (int n = 0; n < 2; ++n) { const f32x4 bs = *(const f32x4*)(base + off + bj * HALF + n * 16); acc[ai][bj][m][n] = bs + (acc[ai][bj][m][n] - sr.x) * sr.y; }
                asm volatile("" : "+v"(acc[ai][0][m][0]), "+v"(acc[ai][0][m][1]), "+v"(acc[ai][1][m][0]), "+v"(acc[ai][1][m][1]));
                if (m & 1) asm volatile("" ::: "memory"); }
        const bool bad1 = bad;
        bad = st2.run(acc, u, wr, wc, fr, fq, lds, wid, lane) || bad;
#pragma unroll
        for (int ai = 0; ai < 2; ++ai)
#pragma unroll
            for (int m = 0; m < 4; ++m) { const int r = ai * HALF + wr * 64 + m * 16 + fr; const f32x2v sr = S[r]; const size_t off = (size_t)(u.pm * BM + r) * ldc + col0;
#pragma unroll
                for (int bj = 0; bj < 2; ++bj)
#pragma unroll
                    for (int n = 0; n < 2; ++n) { const f32x4 x1 = acc[ai][bj][m][n]; *(f32x4*)(out + off + bj * HALF + n * 16) = bad1 ? (f32x4){qnan, qnan, qnan, qnan} : x1;
                        const f32x4 o = (x1 - sr.x) * sr.y; u32x2v w; w.x = cvt_pk_bf16(o[0], o[1]); w.y = cvt_pk_bf16(o[2], o[3]);
                        if (bad) { w.x = 0x7fc07fc0u; w.y = 0x7fc07fc0u; } *(u32x2v*)(xn + off + bj * HALF + n * 16) = w; }
                asm volatile("" ::: "memory"); }
    }
};

template <class Epi, class Sched, bool ALIGN_EPI = false, bool SP2 = false>
__device__ __forceinline__ void gemm_phase(PG8_LAS unsigned char* lds, const Gemm g, const Sched& S, const Epi& E, int wv) {
    int tid0_ = threadIdx.x; asm volatile("" : "+v"(tid0_)); (void)wv;
    const int tid = tid0_, wid = __builtin_amdgcn_readfirstlane(tid >> 6), lane = tid & 63, wr = wid >> 2, wc = wid & 3, fr = lane & 15, fq = lane >> 4;
    const int K = g.K, nt = K / BK;
    unsigned voffA[2], voffB[2];
#pragma unroll
    for (int i = 0; i < 2; ++i) { int R, C; stage_rc(tid * 16 + i * 8192, R, C); const int Rb = Epi::PERM ? ((R & ~31) + perm32(R & 31)) : R;
        voffA[i] = (unsigned)(R * K + C) * 2u; voffB[i] = (unsigned)(Rb * K + C) * 2u; }
    const size_t kstep = (size_t)(BK * 2);
    const size_t hstep = (size_t)HALF * K * 2;
    const size_t tstep = 2 * hstep;
    const unsigned ldsw = (unsigned)wid * 1024u;
    const int aoff = lds_byte(wr * 64 + fr, fq * 8), boff = lds_byte(wc * 32 + fr, fq * 8);
#define PG8_SA(b, h) (((b) * 2 + (h)) * HTB)
#define PG8_SB(b, h) ((4 + (b) * 2 + (h)) * HTB)
#define PG8_STAGE(bufoff, gbase, voff) do { _Pragma("unroll") for (int _i = 0; _i < 2; ++_i) \
        __builtin_amdgcn_global_load_lds((const unsigned*)((const char*)(gbase) + (voff)[_i]), (PG8_LAS unsigned*)(lds + (bufoff) + ldsw + _i * 8192), 16, 0, 0); } while (0)
#define PG8_LDA(dst, b, h) do { _Pragma("unroll") for (int m = 0; m < 4; ++m) _Pragma("unroll") for (int k = 0; k < 2; ++k) dst[m][k] = *(const PG8_LAS bf16x8*)(lds + PG8_SA(b, h) + aoff + m * 2048 + k * 1024); } while (0)
#define PG8_LDB(dst, b, h) do { _Pragma("unroll") for (int n = 0; n < 2; ++n) _Pragma("unroll") for (int k = 0; k < 2; ++k) dst[n][k] = *(const PG8_LAS bf16x8*)(lds + PG8_SB(b, h) + boff + n * 2048 + k * 1024); } while (0)
#define PG8_MMA(ai, bj, At, Bt) do { __builtin_amdgcn_s_setprio(1); _Pragma("unroll") for (int m = 0; m < 4; ++m) _Pragma("unroll") for (int n = 0; n < 2; ++n) _Pragma("unroll") for (int k = 0; k < 2; ++k) \
        acc[ai][bj][m][n] = __builtin_amdgcn_mfma_f32_16x16x32_bf16(Bt[n][k], At[m][k], acc[ai][bj][m][n], 0, 0, 0); __builtin_amdgcn_s_setprio(0); } while (0)
#define PG8_WAIT_V(n) asm volatile("s_waitcnt vmcnt(" #n ")" ::: "memory")
#define PG8_WAIT_L(n) asm volatile("s_waitcnt lgkmcnt(" #n ")" ::: "memory")
#define PG8_BAR __builtin_amdgcn_s_barrier()
#define PG8_SCHED __builtin_amdgcn_sched_barrier(0)
    Unit cur, nxt; int ui = 0;
    if (!S.next(0, cur)) return;
    f32x4 acc[2][2][4][2];
#pragma unroll
    for (int a = 0; a < 2; ++a)
#pragma unroll
        for (int b = 0; b < 2; ++b)
#pragma unroll
            for (int m = 0; m < 4; ++m)
#pragma unroll
                for (int n = 0; n < 2; ++n) acc[a][b][m][n] = (f32x4){0.f, 0.f, 0.f, 0.f};
    bf16x8 At[4][2], B0[2][2], B1[2][2];
    const char* cA = (const char*)g.A + (size_t)cur.pm * tstep; const char* cB = (const char*)g.Bt + (size_t)cur.pn * tstep;
    S.a_ready(cur);
    if constexpr (SP2) {
        PG8_STAGE(PG8_SB(0, 0), cB, voffB); PG8_STAGE(PG8_SB(0, 1), cB + hstep, voffB); PG8_STAGE(PG8_SA(0, 0), cA, voffA); PG8_STAGE(PG8_SA(0, 1), cA + hstep, voffA);
        if (wr == 1) PG8_BAR;
        PG8_WAIT_V(2); PG8_BAR;
        PG8_STAGE(PG8_SB(1, 0), cB + kstep, voffB); PG8_STAGE(PG8_SA(1, 0), cA + kstep, voffA); PG8_STAGE(PG8_SB(1, 1), cB + hstep + kstep, voffB);
        PG8_WAIT_V(6); PG8_BAR;
    } else {
        PG8_STAGE(PG8_SB(0, 0), cB, voffB); PG8_STAGE(PG8_SA(0, 0), cA, voffA); PG8_STAGE(PG8_SB(0, 1), cB + hstep, voffB); PG8_STAGE(PG8_SA(0, 1), cA + hstep, voffA);
        if (wr == 1) PG8_BAR;
        PG8_WAIT_V(4); PG8_BAR;
        PG8_STAGE(PG8_SB(1, 0), cB + kstep, voffB); PG8_STAGE(PG8_SA(1, 0), cA + kstep, voffA); PG8_STAGE(PG8_SB(1, 1), cB + hstep + kstep, voffB);
        PG8_WAIT_V(6); PG8_BAR;
    }
    for (;;) {
        const bool has_next = S.next(ui + 1, nxt);
        const char* nA = has_next ? (const char*)g.A + (size_t)nxt.pm * tstep : cA; const char* nB = has_next ? (const char*)g.Bt + (size_t)nxt.pn * tstep : cB;
        for (int t = 0; t < nt; t += 2) {
            const bool last = (t == nt - 2);
            const char* a1 = cA + (size_t)(t + 1) * kstep;
            const char* a2 = last ? nA : cA + (size_t)(t + 2) * kstep; const char* b2 = last ? nB : cB + (size_t)(t + 2) * kstep;
            const char* a3 = a2 + kstep; const char* b3 = b2 + kstep;
            if (last && has_next) S.a_ready(nxt);
            if constexpr (SP2) {
            PG8_LDB(B0, 0, 0); PG8_LDB(B1, 0, 1); PG8_SCHED; PG8_LDA(At, 0, 0); PG8_STAGE(PG8_SA(1, 1), a1 + hstep, voffA);
            PG8_WAIT_V(8); PG8_WAIT_L(0); PG8_BAR; PG8_MMA(0, 0, At, B0); PG8_MMA(0, 1, At, B1); PG8_BAR; PG8_SCHED;
            PG8_LDA(At, 0, 1); PG8_STAGE(PG8_SB(0, 0), b2, voffB); PG8_STAGE(PG8_SB(0, 1), b2 + hstep, voffB); PG8_STAGE(PG8_SA(0, 0), a2, voffA);
            PG8_WAIT_V(8); PG8_WAIT_L(0); PG8_BAR; PG8_MMA(1, 0, At, B0); PG8_MMA(1, 1, At, B1); PG8_BAR; PG8_SCHED;
            PG8_LDB(B0, 1, 0); PG8_LDB(B1, 1, 1); PG8_SCHED; PG8_LDA(At, 1, 0); PG8_STAGE(PG8_SA(0, 1), a2 + hstep, voffA);
            PG8_WAIT_V(8); PG8_WAIT_L(0); PG8_BAR; PG8_MMA(0, 0, At, B0); PG8_MMA(0, 1, At, B1); PG8_BAR; PG8_SCHED;
            PG8_LDA(At, 1, 1); PG8_STAGE(PG8_SB(1, 0), b3, voffB); PG8_STAGE(PG8_SB(1, 1), b3 + hstep, voffB); PG8_STAGE(PG8_SA(1, 0), a3, voffA);
            PG8_WAIT_V(8); PG8_WAIT_L(0); PG8_BAR; PG8_MMA(1, 0, At, B0); PG8_MMA(1, 1, At, B1); PG8_BAR; PG8_SCHED;
            } else {
            PG8_LDB(B0, 0, 0); PG8_SCHED; PG8_LDA(At, 0, 0); PG8_STAGE(PG8_SA(1, 1), a1 + hstep, voffA);
            PG8_WAIT_L(8); PG8_BAR; PG8_WAIT_L(0); PG8_MMA(0, 0, At, B0); PG8_BAR; PG8_SCHED;
            PG8_LDB(B1, 0, 1); PG8_STAGE(PG8_SB(0, 0), b2, voffB);
            PG8_BAR; PG8_WAIT_L(0); PG8_MMA(0, 1, At, B1); PG8_BAR;
            PG8_LDA(At, 0, 1); PG8_STAGE(PG8_SA(0, 0), a2, voffA);
            PG8_BAR; PG8_WAIT_L(0); PG8_MMA(1, 0, At, B0); PG8_BAR; PG8_SCHED;
            PG8_STAGE(PG8_SB(0, 1), b2 + hstep, voffB);
            PG8_WAIT_V(6); PG8_BAR; PG8_MMA(1, 1, At, B1); PG8_BAR;
            PG8_LDB(B0, 1, 0); PG8_SCHED; PG8_LDA(At, 1, 0); PG8_STAGE(PG8_SA(0, 1), a2 + hstep, voffA);
            PG8_WAIT_L(8); PG8_BAR; PG8_WAIT_L(0); PG8_MMA(0, 0, At, B0); PG8_BAR; PG8_SCHED;
            PG8_LDB(B1, 1, 1); PG8_STAGE(PG8_SB(1, 0), b3, voffB);
            PG8_BAR; PG8_WAIT_L(0); PG8_MMA(0, 1, At, B1); PG8_BAR;
            PG8_LDA(At, 1, 1); PG8_STAGE(PG8_SA(1, 0), a3, voffA);
            PG8_BAR; PG8_WAIT_L(0); PG8_MMA(1, 0, At, B0); PG8_BAR; PG8_SCHED;
            PG8_STAGE(PG8_SB(1, 1), b3 + hstep, voffB);
            PG8_WAIT_V(6); PG8_BAR; PG8_MMA(1, 1, At, B1); PG8_BAR;
            }
        }
        if constexpr (ALIGN_EPI) { if (wr == 0) PG8_BAR; }
        if constexpr (!Epi::AFTER_DRAIN) { E(acc, cur, wr, wc, fr, fq); S.done(cur); }
        if (!has_next) break;
#pragma unroll
        for (int a = 0; a < 2; ++a)
#pragma unroll
            for (int b = 0; b < 2; ++b)
#pragma unroll
                for (int m = 0; m < 4; ++m)
#pragma unroll
                    for (int n = 0; n < 2; ++n) acc[a][b][m][n] = (f32x4){0.f, 0.f, 0.f, 0.f};
        cur = nxt; cA = nA; cB = nB; ++ui;
        if constexpr (ALIGN_EPI) { if (wr == 1) PG8_BAR; }
    }
    PG8_WAIT_V(0);
    if constexpr (!ALIGN_EPI) { if (wr == 0) PG8_BAR; }
    PG8_BAR;
    if constexpr (Epi::AFTER_DRAIN) { E.fused(acc, cur, wr, wc, fr, fq, lds, wid, lane); S.done(cur); }
#undef PG8_SA
#undef PG8_SB
#undef PG8_STAGE
#undef PG8_LDA
#undef PG8_LDB
#undef PG8_MMA
#undef PG8_WAIT_V
#undef PG8_WAIT_L
#undef PG8_BAR
#undef PG8_SCHED
}
}

#ifndef PG8_SP2
#define PG8_SP2 true
#endif
#ifndef PG8_ALIGN
#define PG8_ALIGN true
#endif
#define GAS __attribute__((address_space(1)))
#define LAS __attribute__((address_space(3)))
#define XB_TMO      128
#define XB_XCNT(j)  (256  + 64 * (j))
#define XB_XSUB(j)  (1280 + 64 * (j))
#define XB_XGEN(j)  (2304 + 64 * (j))
#define XB_TOP      3328
#define XB_TOPGEN   3392
#define XCD_BAR_WORDS 3456
#define XB_SPIN_CAP (1u << 18)

__device__ __forceinline__ unsigned xb_ld(unsigned* p)              { return __hip_atomic_load(p, __ATOMIC_RELAXED, __HIP_MEMORY_SCOPE_AGENT); }
__device__ __forceinline__ unsigned xb_add(unsigned* p, unsigned v) { return __hip_atomic_fetch_add(p, v, __ATOMIC_RELAXED, __HIP_MEMORY_SCOPE_AGENT); }
__device__ __forceinline__ unsigned xb_xcc_id() { return (unsigned)__builtin_amdgcn_s_getreg((3 << 11) | 20) & 0xFu; }
#define XB_SPIN(cond, bar) do { unsigned _sp = 0; while (cond) { __builtin_amdgcn_s_sleep(1); \
    if ((++_sp & 255u) == 0u) { if (xb_ld(&(bar)[XB_TMO])) break; if (_sp > XB_SPIN_CAP) { atomicAdd(&(bar)[XB_TMO], 1u); break; } } } } while (0)

struct XcdBarrier {
    unsigned* bar; unsigned x;
    volatile LAS unsigned* st;
    int wv;
};

__device__ __forceinline__ XcdBarrier xcd_barrier_post(unsigned* bar, volatile LAS unsigned* st) {
    XcdBarrier b; b.bar = bar; b.x = xb_xcc_id(); b.st = st;
    if (threadIdx.x == 0) (void)xb_add(&bar[XB_XCNT(b.x)], 1u);
    return b;
}
__device__ __forceinline__ void xcd_barrier_complete(unsigned* bar, unsigned x, unsigned& nloc, unsigned& nx) {
    asm volatile("" : "+s"(x));
    const unsigned G = gridDim.x * gridDim.y * gridDim.z;
    unsigned sum, cnt, mine, sp = 0u;
    for (;;) {
        sum = 0u; cnt = 0u; mine = 0u;
#pragma unroll
        for (unsigned j = 0; j < 16; ++j) { const unsigned c = xb_ld(&bar[XB_XCNT(j)]); sum += c; cnt += (c > 0u) ? 1u : 0u; mine = (j == x) ? c : mine; }
        if (sum == G) break;
        __builtin_amdgcn_s_sleep(1);
        if ((++sp & 255u) == 0u) { if (xb_ld(&bar[XB_TMO])) break; if (sp > XB_SPIN_CAP) { atomicAdd(&bar[XB_TMO], 1u); break; } }
    }
    nloc = mine > 0u ? mine : 1u; nx = cnt > 0u ? cnt : 1u;
}

__device__ __forceinline__ void xcd_barrier(const XcdBarrier& b) {
    asm volatile("s_waitcnt vmcnt(0)" ::: "memory");
    __syncthreads();
    if (threadIdx.x == 0) {
        unsigned* bar = b.bar; asm volatile("" : "+s"(bar));
        __builtin_amdgcn_s_waitcnt(0);
        unsigned nloc = b.st[0], nx = b.st[1];
        if (nloc == 0u) { xcd_barrier_complete(bar, b.x, nloc, nx); b.st[0] = nloc; b.st[1] = nx; }
        const unsigned old = xb_add(&bar[XB_XSUB(b.x)], 1u);
        const unsigned gen = old / nloc;
        if (old + 1u == (gen + 1u) * nloc) {
            __builtin_amdgcn_fence(__ATOMIC_RELEASE, "agent");
            asm volatile("s_waitcnt vmcnt(0)" ::: "memory");
            const unsigned og = xb_add(&bar[XB_TOP], 1u);
            const unsigned tg = og / nx;
            if (og + 1u == (tg + 1u) * nx) xb_add(&bar[XB_TOPGEN], 1u);
            else XB_SPIN(xb_ld(&bar[XB_TOPGEN]) == tg, bar);
            __builtin_amdgcn_fence(__ATOMIC_ACQUIRE, "agent");
            xb_add(&bar[XB_XGEN(b.x)], 1u);
            asm volatile("s_waitcnt vmcnt(0)" ::: "memory");
        } else {
            XB_SPIN(xb_ld(&bar[XB_XGEN(b.x)]) == gen, bar);
            __builtin_amdgcn_fence(__ATOMIC_ACQUIRE, "agent");
            asm volatile("s_waitcnt vmcnt(0)" ::: "memory");
        }
    }
    __syncthreads();
}
namespace dattn {
constexpr int D = 128, QST = 2048, KVS = 512, OST = 2048, MTW = 68, JLO = 3;
constexpr float THR = 8.f; constexpr bool WSKIP = false;
typedef unsigned short bf16;
constexpr float SCALE = 1.0f;
constexpr int NW = 8, QBLK = 32, KVBLK = 64, QB = NW * QBLK;
constexpr int SHM_V = KVBLK * D * 2, SHM_K = KVBLK * D * 2;
constexpr int LDS_BYTES = 2 * SHM_V + 2 * SHM_K + NW * 64 * 4;

typedef short bf16x8 __attribute__((ext_vector_type(8)));
typedef short s16x4 __attribute__((ext_vector_type(4)));
typedef float f32x16 __attribute__((ext_vector_type(16)));
typedef float f32x4 __attribute__((ext_vector_type(4)));
typedef unsigned u32x4 __attribute__((ext_vector_type(4)));
template <class A, class Bt> struct same_t { static constexpr bool v = false; };
template <class A> struct same_t<A, A> { static constexpr bool v = true; };

#define KSWZ(row, colB) ((row) * 256 + ((colB) ^ (((row) & 7) << 4)))
#define SBAR() __builtin_amdgcn_sched_barrier(0)
__device__ __forceinline__ int v_st(int k, int c) { const int kk = (k & ~0xC) | ((k & 4) << 1) | ((k & 8) >> 1); return ((kk >> 3) * 4 + (c >> 5)) * 512 + ((kk & 7) * 32 + (c & 31)) * 2; }
__device__ __forceinline__ int v_rd_base(int lane) { return ((lane & 3) << 3) | (((lane >> 2) & 3) << 6) | (((lane >> 4) & 1) << 5) | (((lane >> 5) & 1) << 8); }
constexpr int v_rd_off(int d0, int ks, int half) { return d0 * 512 + ks * 4096 + half * 2048; }
__device__ __forceinline__ int crow(int r, int hi) { return (r & 3) + 8 * (r >> 2) + 4 * hi; }
__device__ __forceinline__ unsigned cvtpk(float lo, float hi) {
    unsigned r; asm volatile("v_cvt_pk_bf16_f32 %0, %1, %2" : "=v"(r) : "v"(lo), "v"(hi)); return r;
}
__device__ __forceinline__ bf16x8 pack8(f32x4 a, f32x4 b) {
    u32x4 w = {cvtpk(a[0], a[1]), cvtpk(a[2], a[3]), cvtpk(b[0], b[1]), cvtpk(b[2], b[3])};
    return *reinterpret_cast<bf16x8*>(&w);
}
template <class T> __device__ __forceinline__ bf16x8 load8(const T* p) {
    if constexpr (same_t<T, float>::v) { return pack8(*(const f32x4*)p, *(const f32x4*)(p + 4)); }
    else { return *reinterpret_cast<const bf16x8*>(p); }
}
__device__ __forceinline__ void mask_tile(f32x16& p0, f32x16& p1, int dq, unsigned W) {
    const float NEG = -__builtin_inff();
#pragma unroll
    for (int r = 0; r < 16; ++r) {
        const int c = (r & 3) + 8 * (r >> 2);
        if ((unsigned)(dq - c) >= W) p0[r] = NEG;
        if ((unsigned)(dq - c - 32) >= W) p1[r] = NEG;
    }
}
__device__ __forceinline__ void mask_bits(f32x16& p0, f32x16& p1, unsigned long long mw, int hi) {
    const float NEG = -__builtin_inff();
    const unsigned lo = (unsigned)(mw >> (4 * hi)), up = (unsigned)(mw >> (32 + 4 * hi));
#pragma unroll
    for (int r = 0; r < 16; ++r) {
        const int c = (r & 3) + 8 * (r >> 2);
        if (!((lo >> c) & 1u)) p0[r] = NEG;
        if (!((up >> c) & 1u)) p1[r] = NEG;
    }
}
__device__ __forceinline__ void partialSM(f32x16& p0, f32x16& p1, float& m_reg, float& mn, float& alpha) {
    float pmax = p0[0]; for (int r = 1; r < 16; ++r) pmax = fmaxf(pmax, p0[r]); for (int r = 0; r < 16; ++r) pmax = fmaxf(pmax, p1[r]);
    { auto rr = __builtin_amdgcn_permlane32_swap(__float_as_uint(pmax), __float_as_uint(pmax), false, false);
      pmax = fmaxf(__uint_as_float(rr[0]), __uint_as_float(rr[1])); }
    constexpr float C2 = 1.4426950408889634f * SCALE;
    if (__builtin_expect(__all((pmax - m_reg) * SCALE <= THR), 1)) { mn = m_reg; alpha = 1.f; }
    else { mn = fmaxf(m_reg, pmax); alpha = __builtin_amdgcn_exp2f((m_reg - mn) * C2); m_reg = mn; }
    const float mnL = -mn * C2;
    for (int r = 0; r < 16; ++r) p0[r] = fmaf(p0[r], C2, mnL); for (int r = 0; r < 16; ++r) p1[r] = fmaf(p1[r], C2, mnL);
    for (int r = 0; r < 16; ++r) p0[r] = __builtin_amdgcn_exp2f(p0[r]);
}
__device__ __forceinline__ void finishSM(f32x16& p0, f32x16& p1, float alpha, float& l_reg, bf16x8& pa0, bf16x8& pa1, bf16x8& pa2, bf16x8& pa3) {
    for (int r = 0; r < 16; ++r) p1[r] = __builtin_amdgcn_exp2f(p1[r]);
    float ps = 0; for (int r = 0; r < 16; ++r) ps += p0[r]; for (int r = 0; r < 16; ++r) ps += p1[r];
    { auto rr = __builtin_amdgcn_permlane32_swap(__float_as_uint(ps), __float_as_uint(ps), false, false);
      ps = __uint_as_float(rr[0]) + __uint_as_float(rr[1]); }
    l_reg = l_reg * alpha + ps;
#define PK4(P, B_, OUT) do { unsigned a0 = cvtpk(P[B_+0], P[B_+1]), a1 = cvtpk(P[B_+2], P[B_+3]);                          \
        unsigned b0 = cvtpk(P[B_+4], P[B_+5]), b1 = cvtpk(P[B_+6], P[B_+7]);                                             \
        auto r0 = __builtin_amdgcn_permlane32_swap(a0, b0, false, false); auto r1 = __builtin_amdgcn_permlane32_swap(a1, b1, false, false); \
        u32x4 w = {r0[0], r1[0], r0[1], r1[1]}; OUT = *reinterpret_cast<bf16x8*>(&w); } while (0)
    PK4(p0, 0, pa0); PK4(p0, 8, pa1); PK4(p1, 0, pa2); PK4(p1, 8, pa3);
#undef PK4
}
template <int KB, bool SK>
__device__ __forceinline__ void qkt(f32x16& p0, f32x16& p1, const char* K_lds, int r32, int hi, const bf16x8* qr, bool act) {
    if (SK && !act) { const float NEG = -__builtin_inff();
#pragma unroll
        for (int r = 0; r < 16; ++r) { p0[r] = NEG; p1[r] = NEG; } return; }
    p0 = f32x16{}; p1 = f32x16{};
    const char* kb[4];
#pragma unroll
    for (int dd = 0; dd < 4; ++dd) kb[dd] = K_lds + KB * SHM_K + KSWZ(r32, (dd * 16 + hi * 8) * 2);
#pragma unroll
    for (int d0 = 0; d0 < 8; ++d0) { const char* a = kb[d0 & 3] + (d0 >> 2) * 128;
        bf16x8 b0 = *reinterpret_cast<const bf16x8*>(a);
        bf16x8 b1 = *reinterpret_cast<const bf16x8*>(a + 32 * 256);
        p0 = __builtin_amdgcn_mfma_f32_32x32x16_bf16(b0, qr[d0], p0, 0, 0, 0);
        p1 = __builtin_amdgcn_mfma_f32_32x32x16_bf16(b1, qr[d0], p1, 0, 0, 0); }
}
template <int VB, bool SK>
__device__ __forceinline__ void pv_tile(f32x16* o, int vb0, bf16x8 pa0, bf16x8 pa1, bf16x8 pa2, bf16x8 pa3, bool act) {
    if (SK && !act) return;
#define TRRD(dst, off) asm volatile("ds_read_b64_tr_b16 %0, %1 offset:%2" : "=&v"(dst) : "v"(vb0), "i"(off) : "memory")
#define PV_D0(d0) do { s16x4 l0, l1, l2, l3, h0, h1, h2, h3; constexpr int b_ = VB * SHM_V + v_rd_off(d0, 0, 0);     \
        TRRD(l0, b_); TRRD(h0, b_ + 2048); TRRD(l1, b_ + 4096); TRRD(h1, b_ + 6144); TRRD(l2, b_ + 8192); TRRD(h2, b_ + 10240); TRRD(l3, b_ + 12288); TRRD(h3, b_ + 14336); \
        asm volatile("s_waitcnt lgkmcnt(0)" ::: "memory"); SBAR();                 \
        o[d0] = __builtin_amdgcn_mfma_f32_32x32x16_bf16(pa0, (bf16x8){l0[0], l0[1], l0[2], l0[3], h0[0], h0[1], h0[2], h0[3]}, o[d0], 0, 0, 0);   \
        o[d0] = __builtin_amdgcn_mfma_f32_32x32x16_bf16(pa1, (bf16x8){l1[0], l1[1], l1[2], l1[3], h1[0], h1[1], h1[2], h1[3]}, o[d0], 0, 0, 0);   \
        o[d0] = __builtin_amdgcn_mfma_f32_32x32x16_bf16(pa2, (bf16x8){l2[0], l2[1], l2[2], l2[3], h2[0], h2[1], h2[2], h2[3]}, o[d0], 0, 0, 0);   \
        o[d0] = __builtin_amdgcn_mfma_f32_32x32x16_bf16(pa3, (bf16x8){l3[0], l3[1], l3[2], l3[3], h3[0], h3[1], h3[2], h3[3]}, o[d0], 0, 0, 0); } while (0)
    PV_D0(0); PV_D0(1); PV_D0(2); PV_D0(3);
#undef PV_D0
#undef TRRD
}

template <class TIn, class TOut> struct BlockRef { const TIn* Q; const TIn* K; const TIn* V; TOut* O; const unsigned long long* M; int P0; };
template <class TIn> struct Seam {
    bf16x8 qr[8];
    bf16x8 st_v0, st_v1, st_k0, st_k1; f32x4 sf0, sf1, sf2, sf3;
    f32x4 tq[16];
};
__device__ __forceinline__ int swa_jlo(int, int) { return JLO; }
#define ROW(p, k0, rr) ((p) + (size_t)((k0) + (rr)) * KVS + sc)
#define VMW() asm volatile("s_waitcnt vmcnt(0)" ::: "memory")
#define VMWN(n) asm volatile("s_waitcnt vmcnt(%0)" :: "i"(n) : "memory")
#define SLOAD_H(Kp, Vp, k0) do { S.st_v0 = load8<TIn>(ROW(Vp, k0, sr)); S.st_v1 = load8<TIn>(ROW(Vp, k0, 32 + sr));              \
                         S.st_k0 = load8<TIn>(ROW(Kp, k0, sr)); S.st_k1 = load8<TIn>(ROW(Kp, k0, 32 + sr)); } while (0)
#define SWRITE_HK(bf) do { *(bf16x8*)(K_lds + (bf) * SHM_K + kws) = S.st_k0; *(bf16x8*)(K_lds + (bf) * SHM_K + kws + 32 * 256) = S.st_k1; } while (0)
#define SWRITE_HV(bf) do { *(bf16x8*)(V_lds + (bf) * SHM_V + vst0) = S.st_v0; *(bf16x8*)(V_lds + (bf) * SHM_V + vst1) = S.st_v1; } while (0)
#define SWRITE_H(bf) do { SWRITE_HV(bf); SWRITE_HK(bf); } while (0)
#define SLOAD_F(p, k0) do { S.sf0 = *(const f32x4*)ROW(p, k0, sr); S.sf1 = *(const f32x4*)(ROW(p, k0, sr) + 4);                \
                            S.sf2 = *(const f32x4*)ROW(p, k0, 32 + sr); S.sf3 = *(const f32x4*)(ROW(p, k0, 32 + sr) + 4); } while (0)
#define SWRITE_KF(bf) do { *(bf16x8*)(K_lds + (bf) * SHM_K + kws) = pack8(S.sf0, S.sf1); *(bf16x8*)(K_lds + (bf) * SHM_K + kws + 32 * 256) = pack8(S.sf2, S.sf3); } while (0)
#define SWRITE_VF(bf) do { *(bf16x8*)(V_lds + (bf) * SHM_V + vst0) = pack8(S.sf0, S.sf1); *(bf16x8*)(V_lds + (bf) * SHM_V + vst1) = pack8(S.sf2, S.sf3); } while (0)
template <class TIn, class TOut>
__device__ __forceinline__ void causal_swa_prime(const BlockRef<TIn, TOut>& cur, int W, char* lds, Seam<TIn>& S, int wv) {
    constexpr bool F32 = same_t<TIn, float>::v;
    int tid0_ = threadIdx.x; asm volatile("" : "+v"(tid0_)); (void)wv;
    const int tid = tid0_, wid = __builtin_amdgcn_readfirstlane(tid >> 6), lane = tid & 63, r32 = lane & 31, hi = lane >> 5;
    const int sr = tid >> 4, sc = (tid & 15) * 8, kws = KSWZ(sr, sc * 2); char* K_lds = lds + 2 * SHM_V;
    const int kb0 = swa_jlo(cur.P0, W) * KVBLK;
    for (int d0 = 0; d0 < 8; ++d0) S.qr[d0] = load8<TIn>(cur.Q + (size_t)(wid * QBLK + r32) * QST + d0 * 16 + hi * 8);
    if constexpr (F32) { SLOAD_F((const float*)cur.K, kb0); VMW(); SWRITE_KF(0); SBAR(); SLOAD_F((const float*)cur.V, kb0); }
    else { SLOAD_H(cur.K, cur.V, kb0); VMW(); SWRITE_HK(0); }
    __syncthreads();
}
template <class TIn, class TOut>
__device__ __forceinline__ void causal_swa_block(const BlockRef<TIn, TOut>& cur, const BlockRef<TIn, TOut>& nxt, int skv, int W, char* lds, Seam<TIn>& S, int wv) {
    constexpr bool F32 = same_t<TIn, float>::v;
    int tid0_ = threadIdx.x; asm volatile("" : "+v"(tid0_)); (void)wv;
    const int tid = tid0_, wid = __builtin_amdgcn_readfirstlane(tid >> 6), lane = tid & 63, r32 = lane & 31, hi = lane >> 5;
    const int j_lo = swa_jlo(cur.P0, W);
    int j_hi = (cur.P0 + QB - 1) / KVBLK + 1; if (j_hi > skv / KVBLK) j_hi = skv / KVBLK;
    const int NT = j_hi - j_lo;
    const int kbn = swa_jlo(nxt.P0, W) * KVBLK;
    const int qlo = cur.P0 + wid * QBLK; (void)qlo;
    const unsigned long long* mrow = cur.M + (size_t)(wid * QBLK + r32) * MTW;
    const int qm_unused = 0; (void)qm_unused;
    char* V_lds = lds; char* K_lds = lds + 2 * SHM_V;
    float* ws = (float*)(lds + 2 * SHM_V + 2 * SHM_K) + wid * 64; float* li_l = ws, * al_l = ws + 32;
    float m_reg = -1e30f, l_reg = 0; f32x16 o[4] = {};
    const int sr = tid >> 4, sc = (tid & 15) * 8, vst0 = v_st(sr, sc), vst1 = v_st(32 + sr, sc), kws = KSWZ(sr, sc * 2);
    const int vb0 = (int)(uintptr_t)V_lds + v_rd_base(lane);
    const TIn* Kh = cur.K; const TIn* Vh = cur.V;
#define RESC(a) do { if (__any((a) < 1.f)) { if (hi == 0) al_l[r32] = (a); asm volatile("s_waitcnt lgkmcnt(0)" ::: "memory");              \
                     for (int d_ = 0; d_ < 4; ++d_) for (int r = 0; r < 16; ++r) o[d_][r] *= al_l[crow(r, hi)]; } } while (0)
#define KBASE(t) ((j_lo + (t)) * KVBLK)
#define ACT(t) (KBASE(t) <= qlo + QBLK - 1 && KBASE(t) + KVBLK - 1 >= qlo - W + 1)
#define MASKT(P0_, P1_, t) mask_bits(P0_, P1_, mrow[j_lo + (t)], hi)
    constexpr int NQL = F32 ? 16 : 8;
    constexpr bool SK = WSKIP && !F32;
#define SEAM_K0() do { VMWN(NQL); if constexpr (F32) { SWRITE_KF(0); SBAR(); SLOAD_F((const float*)nxt.V, kbn); } else { SWRITE_HK(0); } SBAR(); } while (0)
    f32x16 pA0, pA1, pB0, pB1; float mnA, mnB, alA, alB; bf16x8 pa0, pa1, pa2, pa3;
    if constexpr (F32) { VMW(); SWRITE_VF(0); SBAR(); } else { SWRITE_HV(0); SBAR(); }
    if (NT > 1) { if constexpr (F32) SLOAD_F((const float*)Kh, KBASE(1)); else SLOAD_H(Kh, Vh, KBASE(1)); }
    SBAR(); qkt<0, SK>(pA0, pA1, K_lds, r32, hi, S.qr, ACT(0));
    if constexpr (F32) { if (NT > 1) { VMW(); SWRITE_KF(1); SBAR(); SLOAD_F((const float*)Vh, KBASE(1)); } }
    MASKT(pA0, pA1, 0); partialSM(pA0, pA1, m_reg, mnA, alA);
    if (NT > 1) { VMW(); if constexpr (F32) { SWRITE_VF(1); SBAR(); if (NT > 2) SLOAD_F((const float*)Kh, KBASE(2)); } else SWRITE_H(1); }
    __syncthreads();
#define HALF_STEP(PX0, PX1, mnX, alX, PY0, PY1, alY, t, KB, VB, SB) do {                                                      \
        SBAR(); qkt<KB, SK>(PX0, PX1, K_lds, r32, hi, S.qr, ACT(t));                                             \
        finishSM(PY0, PY1, alY, l_reg, pa0, pa1, pa2, pa3); SBAR();                                                           \
        if ((t) + 1 < NT) { if constexpr (F32) { VMW(); SWRITE_KF(SB); SBAR(); SLOAD_F((const float*)Vh, KBASE((t) + 1)); }  \
                            else { SLOAD_H(Kh, Vh, KBASE((t) + 1)); } SBAR(); }                                               \
        pv_tile<VB, SK>(o, vb0, pa0, pa1, pa2, pa3, ACT((t) - 1)); MASKT(PX0, PX1, (t)); partialSM(PX0, PX1, m_reg, mnX, alX);                                        \
        __syncthreads();                                                                                                      \
        if ((t) + 1 < NT) { VMW(); if constexpr (F32) { SWRITE_VF(SB); SBAR(); if ((t) + 2 < NT) SLOAD_F((const float*)Kh, KBASE((t) + 2)); } \
                            else { SWRITE_H(SB); } }                                                                          \
        RESC(alX); __syncthreads(); } while (0)
    for (int t = 1; t + 1 < NT; t += 2) {
        HALF_STEP(pB0, pB1, mnB, alB, pA0, pA1, alA, t, 1, 0, 0);
        HALF_STEP(pA0, pA1, mnA, alA, pB0, pB1, alB, t + 1, 0, 1, 1);
    }
    const bool even = (NT & 1) == 0;
    if (even) { SBAR(); qkt<1, SK>(pB0, pB1, K_lds, r32, hi, S.qr, ACT(NT - 1)); SBAR(); }
#define QROW(e) (nxt.Q + (size_t)(wid * QBLK + r32) * QST + ((e) >> 1) * 16 + hi * 8 + ((e) & 1) * 4)
    if constexpr (F32) { SLOAD_F((const float*)nxt.K, kbn); SBAR();
#pragma unroll
        for (int e = 0; e < 8; ++e) S.tq[e] = *(const f32x4*)QROW(e); }
    else { SLOAD_H(nxt.K, nxt.V, kbn); SBAR();
#pragma unroll
        for (int d0 = 0; d0 < 8; ++d0) S.qr[d0] = load8<TIn>(nxt.Q + (size_t)(wid * QBLK + r32) * QST + d0 * 16 + hi * 8); }
    SBAR();
    finishSM(pA0, pA1, alA, l_reg, pa0, pa1, pa2, pa3); SBAR();
    if constexpr (F32) {
#pragma unroll
        for (int e = 8; e < 16; ++e) S.tq[e] = *(const f32x4*)QROW(e); SBAR(); }
#undef QROW
    pv_tile<0, SK>(o, vb0, pa0, pa1, pa2, pa3, ACT(even ? NT - 2 : NT - 1));
    if (even) { MASKT(pB0, pB1, NT - 1); partialSM(pB0, pB1, m_reg, mnB, alB); __syncthreads(); RESC(alB);
        finishSM(pB0, pB1, alB, l_reg, pa0, pa1, pa2, pa3); SBAR(); pv_tile<1, SK>(o, vb0, pa0, pa1, pa2, pa3, ACT(NT - 1)); }
    SBAR(); SEAM_K0();
    if (hi == 0) li_l[r32] = l_reg; asm volatile("s_waitcnt lgkmcnt(0)" ::: "memory");
    float rli[16];
#pragma unroll
    for (int r = 0; r < 16; ++r) rli[r] = __builtin_amdgcn_rcpf(li_l[crow(r, hi)]);
    TOut* Ow = cur.O + (size_t)(wid * QBLK) * OST;
#pragma unroll
    for (int r = 0; r < 16; ++r) { const int orow = crow(r, hi);
#pragma unroll
        for (int d0 = 0; d0 < 4; ++d0) { const float v = o[d0][r] * rli[r];
            if constexpr (same_t<TOut, float>::v) { Ow[(size_t)orow * OST + d0 * 32 + r32] = v; }
            else { const float vn = __shfl_xor(v, 1);
                   if ((r32 & 1) == 0) *(unsigned*)(Ow + (size_t)orow * OST + d0 * 32 + r32) = cvtpk(v, vn); } } }
    if constexpr (F32) {
#pragma unroll
        for (int d0 = 0; d0 < 8; ++d0) S.qr[d0] = pack8(S.tq[2 * d0], S.tq[2 * d0 + 1]); }
    __syncthreads();
#undef RESC
#undef KBASE
#undef ACT
#undef MASKT
#undef SEAM_K0
#undef HALF_STEP
}
#undef ROW
#undef VMW
#undef VMWN
#undef SLOAD_H
#undef SWRITE_HK
#undef SWRITE_HV
#undef SWRITE_H
#undef SLOAD_F
#undef SWRITE_KF
#undef SWRITE_VF

}

constexpr int NWAVES = 8, NTHREADS = 512;
constexpr int DM = 2048, SEQ = 4096, NMETA = 16, TP = 4112, NBP = 2, SBN = 8, PAST = 16384, NPG = 128;
constexpr int XROW0 = 8192, SROW0 = 8224, NROWS = 8232, MPAD = 8448, FF = 8192, MAINM = 8192, XR = 48;
constexpr int NA_IN = 6144, NB_IN = 4176, NB_PAD = 4352, NC_IN = 12352, NC_PAD = 12544, DVW = 4096, CDIM = 8192;
constexpr float ALPHA = 1.6817928305074292f;
constexpr float LN_EPS = 1e-5f, RMS_EPS = 1e-6f;
constexpr int SCW = 4160, SCSW = 16448, KIROWS = 4128, NSKEY = PAST + 1;
constexpr int POS_SAMPLE_IDX = TP;

constexpr size_t O_YP = 0, O_YS = O_YP + (size_t)NBP * SEQ * DM, O_CAP = O_YS + (size_t)SBN * DM, O_CAS = O_CAP + 2 * NBP * 2 * DM,
                 O_KP = O_CAS + 2 * SBN * 2 * DM, O_VP = O_KP + (size_t)NBP * TP * 512, O_IKP = O_VP + (size_t)NBP * TP * 512,
                 O_KS = O_IKP + (size_t)NBP * TP * 64, O_VS = O_KS + SBN * 512, O_IKS = O_VS + SBN * 512, O_CCP = O_IKS + SBN * 64,
                 O_CCS = O_CCP + (size_t)NBP * 3 * CDIM, O_DP = O_CCS + (size_t)SBN * 3 * CDIM, O_DS = O_DP + (size_t)NBP * 32 * 128 * 128,
                 O_END = O_DS + (size_t)SBN * 32 * 128 * 128;

constexpr size_t MiB = 1u << 20;
constexpr size_t WS_CTL = 0, CTL_ZERO_BYTES = 1 * MiB;
constexpr size_t WS_TAB128 = 1 * MiB, WS_TAB64 = 4 * MiB, WS_WI = 6 * MiB, WS_G = 7 * MiB, WS_BETA = 9 * MiB, WS_CNT = 11 * MiB, WS_KIB = 12 * MiB,
                 WS_SCS = 14 * MiB, WS_IDXL = 16 * MiB, WS_X = 26 * MiB, WS_QR = 60 * MiB, WS_QI = 94 * MiB, WS_Z = 112 * MiB, WS_Y = 180 * MiB,
                 WS_BIG = 248 * MiB, WS_QKVC = 452 * MiB, WS_SC = 584 * MiB, WS_W = 716 * MiB;
constexpr size_t WSZ_A_IN = (size_t)NA_IN * DM * 2, WSZ_A_OUT = (size_t)DM * DM * 2, WSZ_B_IN = (size_t)NB_PAD * DM * 2, WSZ_B_OUT = (size_t)DM * DM * 2,
                 WSZ_C_IN = (size_t)NC_PAD * DM * 2, WSZ_C_OUT = (size_t)DM * DVW * 2, WSZ_W1 = (size_t)FF * DM * 2, WSZ_W2 = (size_t)DM * FF * 2;
constexpr size_t WS_WA_IN = WS_W, WS_WA_OUT = WS_WA_IN + 2 * WSZ_A_IN, WS_WB_IN = WS_WA_OUT + 2 * WSZ_A_OUT, WS_WB_OUT = WS_WB_IN + WSZ_B_IN,
                 WS_WC_IN = WS_WB_OUT + WSZ_B_OUT, WS_WC_OUT = WS_WC_IN + WSZ_C_IN, WS_W1 = WS_WC_OUT + WSZ_C_OUT, WS_W2 = WS_W1 + 4 * WSZ_W1,
                 WS_ZP = WS_W2 + 4 * WSZ_W2, WS_QKF = WS_ZP + 4 * MiB, WS_END = WS_QKF + 130 * MiB;
constexpr size_t WS_MASK = WS_IDXL, WS_KS = WS_Z, WS_VS = WS_Z + 9 * MiB;
constexpr int SP = 4352, SPAD = 240, MTW = 68;
constexpr int CW_BAR = 4096;

constexpr int RING_BYTES = 131072, LDSCTL_OFF = RING_BYTES, MISC_OFF = LDSCTL_OFF + 320, LDS_BYTES = 147456;

typedef unsigned short bf16;
typedef unsigned v4u __attribute__((ext_vector_type(4)));
typedef unsigned v2u __attribute__((ext_vector_type(2)));
typedef float f32x4 __attribute__((ext_vector_type(4)));
typedef float f32x2 __attribute__((ext_vector_type(2)));
typedef short bf16x8 __attribute__((ext_vector_type(8)));
typedef float f32x16 __attribute__((ext_vector_type(16)));
typedef __bf16 bf16x2_t __attribute__((ext_vector_type(2)));

#define LDS_WAIT() asm volatile("s_waitcnt lgkmcnt(0)" ::: "memory")
#define WAVE_SYNC() do { asm volatile("s_waitcnt lgkmcnt(0)" ::: "memory"); __builtin_amdgcn_wave_barrier(); } while (0)

__device__ __forceinline__ float bflo(unsigned w) { return __uint_as_float(w << 16); }
__device__ __forceinline__ float bfhi(unsigned w) { return __uint_as_float(w & 0xffff0000u); }
__device__ __forceinline__ float bf2f(bf16 h) { return __uint_as_float((unsigned)h << 16); }
__device__ __forceinline__ unsigned pk2(float lo, float hi) { f32x2 v = {lo, hi}; bf16x2_t b = __builtin_convertvector(v, bf16x2_t); return __builtin_bit_cast(unsigned, b); }
__device__ __forceinline__ bf16 f2bf(float f) { return (bf16)(pk2(f, 0.f) & 0xffffu); }
__device__ __forceinline__ float wave_sum(float v) {
#pragma unroll
    for (int o = 1; o < 64; o <<= 1) v += __shfl_xor(v, o);
    return v;
}
__device__ __forceinline__ float wave_max(float v) {
#pragma unroll
    for (int o = 1; o < 64; o <<= 1) v = fmaxf(v, __shfl_xor(v, o));
    return v;
}
__device__ __forceinline__ int wave_sum_i(int v) {
#pragma unroll
    for (int o = 1; o < 64; o <<= 1) v += __shfl_xor(v, o);
    return v;
}
__device__ __forceinline__ float row16_sum(float v) {
    v += __int_as_float(__builtin_amdgcn_update_dpp(0, __float_as_int(v), 0x128, 0xf, 0xf, false));
    v += __int_as_float(__builtin_amdgcn_update_dpp(0, __float_as_int(v), 0x124, 0xf, 0xf, false));
    v += __int_as_float(__builtin_amdgcn_update_dpp(0, __float_as_int(v), 0x122, 0xf, 0xf, false));
    v += __int_as_float(__builtin_amdgcn_update_dpp(0, __float_as_int(v), 0x121, 0xf, 0xf, false));
    return v;
}
__device__ __forceinline__ float silu_f(float x) { return x / (1.f + __expf(-x)); }
__device__ __forceinline__ int prow(int b, int t) { return t >= NMETA ? b * SEQ + (t - NMETA) : XROW0 + b * NMETA + t; }
__device__ __forceinline__ void row_bt(int r, int& b, int& t) { if (r < XROW0) { b = r >> 12; t = (r & 4095) + NMETA; } else { b = (r - XROW0) >> 4; t = (r - XROW0) & 15; } }
__device__ __forceinline__ void unpack8(const v4u w, float (&f)[8]) {
    f[0] = bflo(w.x); f[1] = bfhi(w.x); f[2] = bflo(w.y); f[3] = bfhi(w.y); f[4] = bflo(w.z); f[5] = bfhi(w.z); f[6] = bflo(w.w); f[7] = bfhi(w.w);
}
__device__ __forceinline__ v4u pack8(const float (&f)[8]) { v4u w; w.x = pk2(f[0], f[1]); w.y = pk2(f[2], f[3]); w.z = pk2(f[4], f[5]); w.w = pk2(f[6], f[7]); return w; }

__device__ __forceinline__ void transpose_item(const float* W, int K, int N, int Npad, bf16* WT, LAS float* scr, int item, int lane) {
    const int nblk = Npad / 32, kb = item / nblk, nb = item % nblk, k0 = 64 * kb, n0 = 32 * nb;
    const int n = n0 + (lane & 31); const bool ok = n < N;
#pragma unroll 8
    for (int i = 0; i < 32; ++i) { const int kk = 2 * i + (lane >> 5); scr[kk * 33 + (lane & 31)] = ok ? W[(size_t)(k0 + kk) * N + n] : 0.f; }
    LDS_WAIT(); __builtin_amdgcn_wave_barrier();
    const int c = lane & 7;
#pragma unroll
    for (int j = 0; j < 4; ++j) { const int nn = (lane >> 3) + 8 * j; const LAS float* s = scr + (8 * c) * 33 + nn;
        v4u o; o.x = pk2(s[0 * 33], s[1 * 33]); o.y = pk2(s[2 * 33], s[3 * 33]); o.z = pk2(s[4 * 33], s[5 * 33]); o.w = pk2(s[6 * 33], s[7 * 33]);
        *(v4u*)(WT + (size_t)(n0 + nn) * K + k0 + 8 * c) = o; }
    LDS_WAIT(); __builtin_amdgcn_wave_barrier();
}

struct Ptrs {
    const float *x_prompt, *x_sample, *state_conv_a, *cache_k, *cache_v, *cache_ik, *state_conv_c, *state_delta;
    const int* page_table;
    const float *meta, *w_in_a, *conv_w_a, *w_out_a, *w_in_b, *w_out_b, *w_in_c, *conv_w_c, *a_log, *dt_bias, *norm_w, *w_out_c, *ln1_g, *ln1_b, *w1, *w2, *ln2_g, *ln2_b;
    float* out; unsigned char* ws;
};

__device__ __forceinline__ void p0_prologue(const Ptrs& P, LAS unsigned char* lds, int gw, int NGW, int wave, int lane) {
    LAS float* scr = (LAS float*)(lds + wave * 16384);
    unsigned char* ws = P.ws;
    constexpr int I_A_IN = (DM / 64) * (NA_IN / 32), I_A_OUT = (DM / 64) * (DM / 32), I_B_IN = (DM / 64) * (NB_PAD / 32), I_B_OUT = I_A_OUT,
                  I_C_IN = (DM / 64) * (NC_PAD / 32), I_C_OUT = (DVW / 64) * (DM / 32), I_W1 = (DM / 64) * (FF / 32), I_W2 = (FF / 64) * (DM / 32);
    constexpr int NITEMS = 2 * I_A_IN + 2 * I_A_OUT + I_B_IN + I_B_OUT + I_C_IN + I_C_OUT + 4 * I_W1 + 4 * I_W2;
#define TR_(cnt, Wp, Kk, Nn, Np, WTp) if (r < (cnt)) { transpose_item((Wp), (Kk), (Nn), (Np), (bf16*)(WTp), scr, r, lane); continue; } r -= (cnt);
    for (int it = gw; it < NITEMS; it += NGW) {
        int r = it;
        TR_(I_A_IN, P.w_in_a, DM, NA_IN, NA_IN, ws + WS_WA_IN)
        TR_(I_A_IN, P.w_in_a + (size_t)DM * NA_IN, DM, NA_IN, NA_IN, ws + WS_WA_IN + WSZ_A_IN)
        TR_(I_A_OUT, P.w_out_a, DM, DM, DM, ws + WS_WA_OUT)
        TR_(I_A_OUT, P.w_out_a + (size_t)DM * DM, DM, DM, DM, ws + WS_WA_OUT + WSZ_A_OUT)
        TR_(I_B_IN, P.w_in_b, DM, NB_IN, NB_PAD, ws + WS_WB_IN)
        TR_(I_B_OUT, P.w_out_b, DM, DM, DM, ws + WS_WB_OUT)
        TR_(I_C_IN, P.w_in_c, DM, NC_IN, NC_PAD, ws + WS_WC_IN)
        TR_(I_C_OUT, P.w_out_c, DVW, DM, DM, ws + WS_WC_OUT)
        TR_(I_W1, P.w1, DM, FF, FF, ws + WS_W1)
        TR_(I_W1, P.w1 + (size_t)DM * FF, DM, FF, FF, ws + WS_W1 + WSZ_W1)
        TR_(I_W1, P.w1 + 2 * (size_t)DM * FF, DM, FF, FF, ws + WS_W1 + 2 * WSZ_W1)
        TR_(I_W1, P.w1 + 3 * (size_t)DM * FF, DM, FF, FF, ws + WS_W1 + 3 * WSZ_W1)
        TR_(I_W2, P.w2, FF, DM, DM, ws + WS_W2)
        TR_(I_W2, P.w2 + (size_t)DM * FF, FF, DM, DM, ws + WS_W2 + WSZ_W2)
        TR_(I_W2, P.w2 + 2 * (size_t)DM * FF, FF, DM, DM, ws + WS_W2 + 2 * WSZ_W2)
        transpose_item(P.w2 + 3 * (size_t)DM * FF, FF, DM, DM, (bf16*)(ws + WS_W2 + 3 * WSZ_W2), scr, r, lane);
    }
#undef TR_
    bf16* X = (bf16*)(ws + WS_X);
    for (int r = gw; r < MPAD; r += NGW) {
        const float* src = nullptr;
        if (r < XROW0) src = P.x_prompt + (size_t)r * DM;
        else if (r < SROW0) src = P.meta + (size_t)((r - XROW0) & 15) * DM;
        else if (r < NROWS) src = P.x_sample + (size_t)(r - SROW0) * DM;
#pragma unroll
        for (int j = 0; j < 4; ++j) { const int c = 512 * j + 8 * lane; v4u o = {0u, 0u, 0u, 0u};
            if (src) { const f32x4 a = *(const f32x4*)(src + c), b = *(const f32x4*)(src + c + 4); o.x = pk2(a.x, a.y); o.y = pk2(a.z, a.w); o.z = pk2(b.x, b.y); o.w = pk2(b.z, b.w); }
            *(v4u*)(X + (size_t)r * DM + c) = o; }
    }
    f32x2* t128 = (f32x2*)(ws + WS_TAB128); f32x2* t64 = (f32x2*)(ws + WS_TAB64);
    const int gt = gw * 64 + lane, NGT = NGW * 64;
    for (int e = gt; e < (TP + 1) * 96; e += NGT) {
        const int pi = e / 96, i = e % 96; const float pos = (float)(pi == TP ? PAST : pi);
        const float ex = (i < 64) ? (float)(2 * i) * (1.f / 128.f) : (float)(2 * (i - 64)) * (1.f / 64.f);
        const float inv = __builtin_amdgcn_exp2f(-ex * 13.287712379549449f);
        const float angf = pos * inv;
        double rev = (double)angf * 0.15915494309189535; rev -= __builtin_rint(rev);
        const float rf = (float)rev; const float sn = __builtin_amdgcn_sinf(rf), cs = __builtin_amdgcn_cosf(rf);
        if (i < 64) t128[pi * 64 + i] = (f32x2){cs, sn}; else t64[pi * 32 + (i - 64)] = (f32x2){cs, sn};
    }
}

__device__ __forceinline__ void ln_phase(const float* Z, const float* ZP, bf16* X, const float* gam, const float* bet, float* yp, float* ys, int gw, int NGW, int lane) {
    for (int r = gw; r < NROWS; r += NGW) {
        const bool ext = r >= XROW0; const float* zr = ext ? ZP + (size_t)(r - XROW0) * DM : Z + (size_t)r * DM; bf16* xr = X + (size_t)r * DM;
        float v[32]; float s = 0.f;
#pragma unroll
        for (int j = 0; j < 4; ++j) { const int c = 512 * j + 8 * lane; f32x4 z0 = *(const f32x4*)(zr + c), z1 = *(const f32x4*)(zr + c + 4); const v4u xv = *(const v4u*)(xr + c);
            if (ext) {
#pragma unroll
                for (int sl = 1; sl < 8; ++sl) { z0 += *(const f32x4*)(zr + (size_t)sl * XR * DM + c); z1 += *(const f32x4*)(zr + (size_t)sl * XR * DM + c + 4); } }
            float xf[8]; unpack8(xv, xf);
            v[8 * j + 0] = ALPHA * xf[0] + z0.x; v[8 * j + 1] = ALPHA * xf[1] + z0.y; v[8 * j + 2] = ALPHA * xf[2] + z0.z; v[8 * j + 3] = ALPHA * xf[3] + z0.w;
            v[8 * j + 4] = ALPHA * xf[4] + z1.x; v[8 * j + 5] = ALPHA * xf[5] + z1.y; v[8 * j + 6] = ALPHA * xf[6] + z1.z; v[8 * j + 7] = ALPHA * xf[7] + z1.w;
#pragma unroll
            for (int i = 0; i < 8; ++i) s += v[8 * j + i]; }
        const float mean = wave_sum(s) * (1.f / DM); float s2 = 0.f;
#pragma unroll
        for (int i = 0; i < 32; ++i) { v[i] -= mean; s2 += v[i] * v[i]; }
        const float rstd = 1.f / sqrtf(wave_sum(s2) * (1.f / DM) + LN_EPS);
        float* of = nullptr;
        if (yp) { if (r < XROW0) of = yp + (size_t)r * DM; else if (r >= SROW0) of = ys + (size_t)(r - SROW0) * DM; }
#pragma unroll
        for (int j = 0; j < 4; ++j) { const int c = 512 * j + 8 * lane; const f32x4 g0 = *(const f32x4*)(gam + c), g1 = *(const f32x4*)(gam + c + 4), b0 = *(const f32x4*)(bet + c), b1 = *(const f32x4*)(bet + c + 4);
            float o[8];
            o[0] = v[8 * j + 0] * rstd * g0.x + b0.x; o[1] = v[8 * j + 1] * rstd * g0.y + b0.y; o[2] = v[8 * j + 2] * rstd * g0.z + b0.z; o[3] = v[8 * j + 3] * rstd * g0.w + b0.w;
            o[4] = v[8 * j + 4] * rstd * g1.x + b1.x; o[5] = v[8 * j + 5] * rstd * g1.y + b1.y; o[6] = v[8 * j + 6] * rstd * g1.z + b1.z; o[7] = v[8 * j + 7] * rstd * g1.w + b1.w;
            *(v4u*)(xr + c) = pack8(o);
            if (of) { *(f32x4*)(of + c) = (f32x4){o[0], o[1], o[2], o[3]}; *(f32x4*)(of + c + 4) = (f32x4){o[4], o[5], o[6], o[7]}; } }
    }
}

__device__ __forceinline__ void load_u(const bf16* BCH, int row, int c0, float (&u)[8]) {
    const v4u cg = *(const v4u*)(BCH + (size_t)row * NA_IN + DM + c0), hh = *(const v4u*)(BCH + (size_t)row * NA_IN + 2 * DM + c0);
    float a[8], b[8]; unpack8(cg, a); unpack8(hh, b);
#pragma unroll
    for (int i = 0; i < 8; ++i) u[i] = a[i] * b[i];
}
__device__ __forceinline__ void convA_phase(const bf16* BCH, bf16* Y, const float* cw, const float* hist, float* outp, float* outs, int gtid, int NT) {
    for (int it = gtid; it < NROWS * 256; it += NT) {
        const int r = it >> 8, c0 = (it & 255) * 8;
        float u0[8], u1[8], u2[8];
        load_u(BCH, r, c0, u2);
        if (r < SROW0) {
            int b, t; row_bt(r, b, t);
            if (t >= 1) load_u(BCH, prow(b, t - 1), c0, u1); else {
#pragma unroll
                for (int i = 0; i < 8; ++i) u1[i] = 0.f; }
            if (t >= 2) load_u(BCH, prow(b, t - 2), c0, u0); else {
#pragma unroll
                for (int i = 0; i < 8; ++i) u0[i] = 0.f; }
            if (t >= TP - 2) { float* o = outp + ((size_t)(b * 2 + (t - (TP - 2)))) * DM + c0; *(f32x4*)o = (f32x4){u2[0], u2[1], u2[2], u2[3]}; *(f32x4*)(o + 4) = (f32x4){u2[4], u2[5], u2[6], u2[7]}; }
        } else {
            const int sb = r - SROW0; const float* h0 = hist + ((size_t)(sb * 2 + 0)) * DM + c0; const float* h1 = hist + ((size_t)(sb * 2 + 1)) * DM + c0;
            const f32x4 a0 = *(const f32x4*)h0, a1 = *(const f32x4*)(h0 + 4), b0 = *(const f32x4*)h1, b1 = *(const f32x4*)(h1 + 4);
            u0[0] = a0.x; u0[1] = a0.y; u0[2] = a0.z; u0[3] = a0.w; u0[4] = a1.x; u0[5] = a1.y; u0[6] = a1.z; u0[7] = a1.w;
            u1[0] = b0.x; u1[1] = b0.y; u1[2] = b0.z; u1[3] = b0.w; u1[4] = b1.x; u1[5] = b1.y; u1[6] = b1.z; u1[7] = b1.w;
            float* o0 = outs + ((size_t)(sb * 2 + 0)) * DM + c0; float* o1 = outs + ((size_t)(sb * 2 + 1)) * DM + c0;
            *(f32x4*)o0 = b0; *(f32x4*)(o0 + 4) = b1;
            *(f32x4*)o1 = (f32x4){u2[0], u2[1], u2[2], u2[3]}; *(f32x4*)(o1 + 4) = (f32x4){u2[4], u2[5], u2[6], u2[7]};
        }
        float bg[8]; unpack8(*(const v4u*)(BCH + (size_t)r * NA_IN + c0), bg);
        float w0[8], w1[8], w2[8];
        { const f32x4 a = *(const f32x4*)(cw + c0), b = *(const f32x4*)(cw + c0 + 4); w0[0] = a.x; w0[1] = a.y; w0[2] = a.z; w0[3] = a.w; w0[4] = b.x; w0[5] = b.y; w0[6] = b.z; w0[7] = b.w; }
        { const f32x4 a = *(const f32x4*)(cw + DM + c0), b = *(const f32x4*)(cw + DM + c0 + 4); w1[0] = a.x; w1[1] = a.y; w1[2] = a.z; w1[3] = a.w; w1[4] = b.x; w1[5] = b.y; w1[6] = b.z; w1[7] = b.w; }
        { const f32x4 a = *(const f32x4*)(cw + 2 * DM + c0), b = *(const f32x4*)(cw + 2 * DM + c0 + 4); w2[0] = a.x; w2[1] = a.y; w2[2] = a.z; w2[3] = a.w; w2[4] = b.x; w2[5] = b.y; w2[6] = b.z; w2[7] = b.w; }
        float y[8];
#pragma unroll
        for (int i = 0; i < 8; ++i) y[i] = bg[i] * (w0[i] * u0[i] + w1[i] * u1[i] + w2[i] * u2[i]);
        *(v4u*)(Y + (size_t)r * DM + c0) = pack8(y);
    }
}

constexpr float QSCALE = 0.08838834764831845f;
__device__ __forceinline__ void rope_phase(const bf16* PROJ, const Ptrs& P, int gw, int NGW, int lane) {
    unsigned char* ws = P.ws;
    const f32x2* t128 = (const f32x2*)(ws + WS_TAB128); const f32x2* t64 = (const f32x2*)(ws + WS_TAB64);
    bf16* Qr = (bf16*)(ws + WS_QR); bf16* QI = (bf16*)(ws + WS_QI); bf16* KIb = (bf16*)(ws + WS_KIB); float* WI = (float*)(ws + WS_WI);
    bf16* Ks = (bf16*)(ws + WS_KS); bf16* Vs = (bf16*)(ws + WS_VS);
    for (int pr_ = gw; pr_ < NBP * SPAD; pr_ += NGW) {
        const size_t o = ((size_t)((pr_ / SPAD) * SP + (pr_ % SPAD))) * 512 + 8 * lane; *(v4u*)(Ks + o) = (v4u){0u, 0u, 0u, 0u}; *(v4u*)(Vs + o) = (v4u){0u, 0u, 0u, 0u}; }
    for (int r = gw; r < NROWS; r += NGW) {
        const bf16* pr = PROJ + (size_t)r * NB_PAD;
        int pi; float *ko, *vo, *iko; bf16* kib = nullptr; bf16 *ksq = nullptr, *vsq = nullptr;
        if (r < SROW0) { int b, t; row_bt(r, b, t); pi = t; ksq = Ks + ((size_t)(b * SP + t + SPAD)) * 512; vsq = Vs + ((size_t)(b * SP + t + SPAD)) * 512; ko = P.out + O_KP + ((size_t)(b * TP + t)) * 512; vo = P.out + O_VP + ((size_t)(b * TP + t)) * 512; iko = P.out + O_IKP + ((size_t)(b * TP + t)) * 64; kib = KIb + ((size_t)(b * KIROWS + t)) * 64; }
        else { const int sb = r - SROW0; pi = POS_SAMPLE_IDX; ko = P.out + O_KS + (size_t)sb * 512; vo = P.out + O_VS + (size_t)sb * 512; iko = P.out + O_IKS + (size_t)sb * 64; }
        const f32x2* c128 = t128 + (size_t)pi * 64; const f32x2* c64 = t64 + (size_t)pi * 32;
        for (int e = lane; e < 1024; e += 64) { const int hd = e >> 6, i = e & 63; const float x1 = bf2f(pr[hd * 128 + i]), x2 = bf2f(pr[hd * 128 + 64 + i]); const f32x2 cs = c128[i];
            Qr[(size_t)r * DM + hd * 128 + i] = f2bf((x1 * cs.x - x2 * cs.y) * QSCALE); Qr[(size_t)r * DM + hd * 128 + 64 + i] = f2bf((x2 * cs.x + x1 * cs.y) * QSCALE); }
        for (int e = lane; e < 256; e += 64) { const int hd = e >> 6, i = e & 63; const float x1 = bf2f(pr[2048 + hd * 128 + i]), x2 = bf2f(pr[2048 + hd * 128 + 64 + i]); const f32x2 cs = c128[i];
            const float o1 = x1 * cs.x - x2 * cs.y, o2 = x2 * cs.x + x1 * cs.y; ko[hd * 128 + i] = o1; ko[hd * 128 + 64 + i] = o2;
            if (ksq) { ksq[hd * 128 + i] = f2bf(o1); ksq[hd * 128 + 64 + i] = f2bf(o2); } }
        for (int e = lane; e < 512; e += 64) { vo[e] = bf2f(pr[2560 + e]); if (vsq) vsq[e] = pr[2560 + e]; }
        for (int e = lane; e < 512; e += 64) { const int hd = e >> 5, i = e & 31; const float x1 = bf2f(pr[3072 + hd * 64 + i]), x2 = bf2f(pr[3072 + hd * 64 + 32 + i]); const f32x2 cs = c64[i];
            QI[(size_t)r * 1024 + hd * 64 + i] = f2bf(x1 * cs.x - x2 * cs.y); QI[(size_t)r * 1024 + hd * 64 + 32 + i] = f2bf(x2 * cs.x + x1 * cs.y); }
        if (lane < 32) { const int i = lane; const float x1 = bf2f(pr[4096 + i]), x2 = bf2f(pr[4096 + 32 + i]); const f32x2 cs = c64[i]; const float o1 = x1 * cs.x - x2 * cs.y, o2 = x2 * cs.x + x1 * cs.y;
            iko[i] = o1; iko[32 + i] = o2; if (kib) { kib[i] = f2bf(o1); kib[32 + i] = f2bf(o2); } }
        else if (lane < 48) { const int i = lane - 32; WI[(size_t)r * 16 + i] = bf2f(pr[4160 + i]); }
    }
}

__device__ __forceinline__ void indexer_prompt(const Ptrs& P, int gw, int NGW, int lane) {
    unsigned char* ws = P.ws;
    const bf16* QI = (const bf16*)(ws + WS_QI); const bf16* KIb = (const bf16*)(ws + WS_KIB); const float* WI = (const float*)(ws + WS_WI); float* SC = (float*)(ws + WS_SC);
    const int n = lane & 31, h8 = lane >> 5;
    const int qsel = (n >> 2) & 1, head = (n & 3) + 4 * (n >> 3);
    constexpr int NIT = NBP * (TP / 2);
    for (int k = gw; k < NIT; k += NGW) {
        const int idx = (k < NIT / 2) ? k : (NIT - 1) - (k - NIT / 2);
        const int b = idx & 1, p = idx >> 1, t0 = 2 * p;
        const bf16* qa = QI + (size_t)prow(b, t0 + qsel) * 1024 + head * 64 + 8 * h8;
        bf16x8 a[4];
#pragma unroll
        for (int kk = 0; kk < 4; ++kk) a[kk] = *(const bf16x8*)(qa + 16 * kk);
        const int tq = t0 + h8;
        const float* wp = WI + (size_t)prow(b, tq) * 16;
        float w[16];
#pragma unroll
        for (int i = 0; i < 4; ++i) { const f32x4 x = *(const f32x4*)(wp + 4 * i); w[4 * i] = x.x; w[4 * i + 1] = x.y; w[4 * i + 2] = x.z; w[4 * i + 3] = x.w; }
        const int ntile = ((t0 + 1) >> 5) + 1;
        const bf16* kb = KIb + ((size_t)b * KIROWS + n) * 64 + 8 * h8;
        float* scrow = SC + ((size_t)(b * TP + tq)) * SCW;
        for (int kt0 = 0; kt0 < ntile; kt0 += 4) {
            bf16x8 bb[4][4];
#pragma unroll
            for (int u = 0; u < 4; ++u) { const int ktc = (kt0 + u < 129) ? kt0 + u : 128; const bf16* kp = kb + (size_t)ktc * 32 * 64;
#pragma unroll
                for (int kk = 0; kk < 4; ++kk) bb[u][kk] = *(const bf16x8*)(kp + 16 * kk); }
#pragma unroll
            for (int u = 0; u < 4; ++u) {
                f32x16 acc;
#pragma unroll
                for (int i = 0; i < 16; ++i) acc[i] = 0.f;
#pragma unroll
                for (int kk = 0; kk < 4; ++kk) acc = __builtin_amdgcn_mfma_f32_32x32x16_bf16(a[kk], bb[u][kk], acc, 0, 0, 0);
                float sc = 0.f;
#pragma unroll
                for (int i = 0; i < 16; ++i) sc += w[i] * fmaxf(acc[i], 0.f);
                const int s = 32 * (kt0 + u) + n;
                if (s <= tq) scrow[s] = sc;
            }
        }
    }
}

__device__ __forceinline__ void indexer_sample(const Ptrs& P, LAS unsigned char* lds, int tid) {
    unsigned char* ws = P.ws;
    const bf16* QI = (const bf16*)(ws + WS_QI); const float* WI = (const float*)(ws + WS_WI); float* SCS = (float*)(ws + WS_SCS);
    LAS float* lq = (LAS float*)lds;
    LAS float* lw = lq + 1024;
    constexpr int NCH = (NSKEY + 511) / 512;
    for (int item = blockIdx.x; item < SBN * NCH; item += gridDim.x) {
        const int sb = item / NCH, ch = item % NCH, r = SROW0 + sb;
        __syncthreads();
        for (int e = tid; e < 1024; e += NTHREADS) lq[e] = bf2f(QI[(size_t)r * 1024 + e]);
        if (tid < 16) lw[tid] = WI[(size_t)r * 16 + tid];
        __syncthreads();
        const int s = ch * 512 + tid;
        if (s < NSKEY) {
            const float* kr = (s < PAST) ? P.cache_ik + ((size_t)P.page_table[sb * NPG + (s >> 7)] * 128 + (s & 127)) * 64 : P.out + O_IKS + (size_t)sb * 64;
            f32x4 kv[16];
#pragma unroll
            for (int i = 0; i < 16; ++i) kv[i] = *(const f32x4*)(kr + 4 * i);
            float sc = 0.f;
            for (int h = 0; h < 16; ++h) { float d = 0.f;
#pragma unroll
                for (int i = 0; i < 16; ++i) { const f32x4 q = *(const LAS f32x4*)(lq + h * 64 + 4 * i); d += q.x * kv[i].x + q.y * kv[i].y + q.z * kv[i].z + q.w * kv[i].w; }
                sc += lw[h] * fmaxf(d, 0.f); }
            SCS[(size_t)sb * SCSW + s] = sc;
        }
    }
    __syncthreads();
}

__device__ __forceinline__ unsigned ordkey(float f) { const unsigned u = __float_as_uint(f); return (u & 0x80000000u) ? ~u : (u | 0x80000000u); }
constexpr int TOPK = 256;
__device__ __forceinline__ void topk_wave_mask(const float* sc, int n, unsigned long long* mrow, int lane) {
    constexpr int NS = MTW, M0 = SPAD / 64;
    static_assert(M0 == dattn::JLO, "first real key tile");
    unsigned key[NS];
#pragma unroll
    for (int m = M0; m < NS; ++m) { const int sidx = lane + 64 * m - SPAD; const int ci = sidx < 0 ? 0 : (sidx < n ? sidx : n - 1); const float v = sc[ci]; key[m] = (sidx >= 0 && sidx < n) ? ordkey(v) : 0u; }
    if (n <= TOPK) {
#pragma unroll
        for (int m = M0; m < NS; ++m) { const unsigned long long w = __ballot(key[m] != 0u); if (lane == 0) mrow[m] = w; }
        return;
    }
    unsigned T = 0u;
    for (int bit = 31; bit >= 0; --bit) {
        const unsigned cand = T | (1u << bit); int c = 0;
#pragma unroll
        for (int m = M0; m < NS; ++m) c += __popcll(__ballot(key[m] >= cand));
        if (c >= TOPK) T = cand;
    }
    int cg = 0;
#pragma unroll
    for (int m = M0; m < NS; ++m) cg += __popcll(__ballot(key[m] > T));
    const int need = TOPK - cg;
    int base_e = 0;
    const unsigned long long lt = (1ull << lane) - 1ull;
#pragma unroll
    for (int m = M0; m < NS; ++m) {
        const bool pg = key[m] > T, pe = key[m] == T;
        const unsigned long long me = __ballot(pe);
        const int pre_e = __popcll(me & lt);
        const unsigned long long w = __ballot(pg || (pe && (base_e + pre_e) < need));
        if (lane == 0) mrow[m] = w;
        base_e += __popcll(me);
    }
}
__device__ __forceinline__ void topk_block(const float* sc, int n, int* outIdx, int* outCnt, LAS unsigned* ls, int tid, int wave, int lane) {
    constexpr int NS = (NSKEY + NTHREADS - 1) / NTHREADS;
    unsigned key[NS];
#pragma unroll
    for (int m = 0; m < NS; ++m) { const int e = tid + NTHREADS * m; const float v = sc[e < n ? e : n - 1]; key[m] = (e < n) ? ordkey(v) : 0u; }
    unsigned T = 0u;
    for (int bit = 31; bit >= 0; --bit) {
        const unsigned cand = T | (1u << bit); int c = 0;
#pragma unroll
        for (int m = 0; m < NS; ++m) c += (key[m] >= cand) ? 1 : 0;
        c = wave_sum_i(c);
        LAS unsigned* buf = ls + (bit & 1) * 8;
        if (lane == 0) buf[wave] = (unsigned)c;
        __syncthreads();
        int tot = 0;
#pragma unroll
        for (int w = 0; w < 8; ++w) tot += (int)buf[w];
        if (tot >= TOPK) T = cand;
    }
    __syncthreads();
    if (tid == 0) { unsigned z_ = 0u; asm volatile("" : "+v"(z_)); ls[16] = z_; ls[17] = z_; }
    __syncthreads();
#pragma unroll
    for (int m = 0; m < NS; ++m) { const int e = tid + NTHREADS * m; if (key[m] > T) { const unsigned pos = atomicAdd((unsigned*)(ls + 16), 1u); if (pos < (unsigned)TOPK) outIdx[pos] = e; } }
    __syncthreads();
    const unsigned cg = ls[16];
    const unsigned need = (unsigned)TOPK - cg;
#pragma unroll
    for (int m = 0; m < NS; ++m) { const int e = tid + NTHREADS * m; if (key[m] == T) { const unsigned pos = atomicAdd((unsigned*)(ls + 17), 1u); if (pos < need) outIdx[cg + pos] = e; } }
    if (tid == 0) *outCnt = TOPK;
    __syncthreads();
}
__device__ __forceinline__ void select_phase(const Ptrs& P, LAS unsigned char* lds, int gw, int NGW, int tid, int wave, int lane) {
    unsigned char* ws = P.ws;
    const float* SC = (const float*)(ws + WS_SC); const float* SCS = (const float*)(ws + WS_SCS); int* IDXL = (int*)(ws + WS_IDXL); int* CNT = (int*)(ws + WS_CNT);
    for (int sb = blockIdx.x; sb < SBN; sb += gridDim.x) topk_block(SCS + (size_t)sb * SCSW, NSKEY, IDXL + (size_t)(SROW0 + sb) * TOPK, CNT + SROW0 + sb, (LAS unsigned*)lds, tid, wave, lane);
    unsigned long long* MASK = (unsigned long long*)(ws + WS_MASK);
    for (int r = gw; r < SROW0; r += NGW) { int b, t; row_bt(r, b, t);
        if (r < XROW0) topk_wave_mask(SC + ((size_t)(b * TP + t)) * SCW, t + 1, MASK + ((size_t)(b * SP + t + SPAD)) * MTW, lane);
        else { if (lane <= t) IDXL[(size_t)r * TOPK + lane] = lane; if (lane == 0) CNT[r] = t + 1; } }
}

__device__ __forceinline__ void attn_phase(const Ptrs& P, bf16* O, LAS unsigned char* lds, int gw, int NGW, int wave, int lane) {
    unsigned char* ws = P.ws;
    const bf16* Qr = (const bf16*)(ws + WS_QR); const int* IDXL = (const int*)(ws + WS_IDXL); const int* CNT = (const int*)(ws + WS_CNT);
    LAS float* lq = (LAS float*)(lds + wave * 12288);
    LAS f32x4* lp = (LAS f32x4*)(lds + wave * 12288 + 2048);
    LAS unsigned long long* lkp = (LAS unsigned long long*)(lds + wave * 12288 + 6144);
    LAS unsigned long long* lvp = (LAS unsigned long long*)(lds + wave * 12288 + 8192);
    for (int item = gw; item < (NROWS - XROW0) * 4; item += NGW) {
        const int r = XROW0 + (item >> 2), n = item & 3;
        const int cnt = CNT[r];
        WAVE_SYNC();
        { float qf[8]; unpack8(*(const v4u*)(Qr + (size_t)r * DM + n * 512 + 8 * lane), qf);
          *(LAS f32x4*)(lq + 8 * lane) = (f32x4){qf[0], qf[1], qf[2], qf[3]}; *(LAS f32x4*)(lq + 8 * lane + 4) = (f32x4){qf[4], qf[5], qf[6], qf[7]}; }
        const float* kp[4];
#pragma unroll
        for (int j = 0; j < 4; ++j) {
            const int e = lane + 64 * j; const int s = (e < cnt) ? IDXL[(size_t)r * TOPK + e] : 0;
            const float *kq, *vq;
            if (r < SROW0) { const int b = (r < XROW0) ? (r >> 12) : ((r - XROW0) >> 4); kq = P.out + O_KP + ((size_t)(b * TP + s)) * 512; vq = P.out + O_VP + ((size_t)(b * TP + s)) * 512; }
            else { const int sb = r - SROW0;
                if (s < PAST) { const size_t off = ((size_t)P.page_table[sb * NPG + (s >> 7)] * 128 + (s & 127)) * 512; kq = P.cache_k + off; vq = P.cache_v + off; }
                else { kq = P.out + O_KS + (size_t)sb * 512; vq = P.out + O_VS + (size_t)sb * 512; } }
            kp[j] = kq + n * 128; lkp[e] = (unsigned long long)(kq + n * 128); lvp[e] = (unsigned long long)(vq + n * 128);
        }
        WAVE_SYNC();
        float acc[4][4];
#pragma unroll
        for (int g = 0; g < 4; ++g)
#pragma unroll
            for (int j = 0; j < 4; ++j) acc[g][j] = 0.f;
#pragma unroll 4
        for (int d4 = 0; d4 < 32; ++d4) {
            f32x4 qv[4];
#pragma unroll
            for (int g = 0; g < 4; ++g) qv[g] = *(const LAS f32x4*)(lq + g * 128 + 4 * d4);
#pragma unroll
            for (int j = 0; j < 4; ++j) { const f32x4 kv = *(const f32x4*)(kp[j] + 4 * d4);
#pragma unroll
                for (int g = 0; g < 4; ++g) acc[g][j] += qv[g].x * kv.x + qv[g].y * kv.y + qv[g].z * kv.z + qv[g].w * kv.w; }
        }
        float linv[4];
#pragma unroll
        for (int g = 0; g < 4; ++g) {
            float m = -INFINITY;
#pragma unroll
            for (int j = 0; j < 4; ++j) { if (lane + 64 * j >= cnt) acc[g][j] = -INFINITY; m = fmaxf(m, acc[g][j]); }
            m = wave_max(m); float l = 0.f;
#pragma unroll
            for (int j = 0; j < 4; ++j) { acc[g][j] = __expf(acc[g][j] - m); l += acc[g][j]; }
            linv[g] = 1.f / wave_sum(l);
        }
#pragma unroll
        for (int j = 0; j < 4; ++j) lp[lane + 64 * j] = (f32x4){acc[0][j], acc[1][j], acc[2][j], acc[3][j]};
        WAVE_SYNC();
        float o[4][2];
#pragma unroll
        for (int g = 0; g < 4; ++g) { o[g][0] = 0.f; o[g][1] = 0.f; }
#pragma unroll 8
        for (int e = 0; e < cnt; ++e) {
            const float* vp = (const float*)lvp[e]; const f32x2 vv = *(const f32x2*)(vp + 2 * lane); const f32x4 p = lp[e];
            o[0][0] += p.x * vv.x; o[0][1] += p.x * vv.y; o[1][0] += p.y * vv.x; o[1][1] += p.y * vv.y; o[2][0] += p.z * vv.x; o[2][1] += p.z * vv.y; o[3][0] += p.w * vv.x; o[3][1] += p.w * vv.y;
        }
#pragma unroll
        for (int g = 0; g < 4; ++g) *(unsigned*)(O + (size_t)r * DM + (4 * n + g) * 128 + 2 * lane) = pk2(o[g][0] * linv[g], o[g][1] * linv[g]);
    }
}

__device__ __forceinline__ void convC_phase(const bf16* PROJC, const Ptrs& P, int gw, int NGW, int lane) {
    unsigned char* ws = P.ws;
    bf16* QKVC = (bf16*)(ws + WS_QKVC); float* QKF = (float*)(ws + WS_QKF); float* G = (float*)(ws + WS_G); float* BETA = (float*)(ws + WS_BETA);
    const float* cw = P.conv_w_c;
    for (int r = gw; r < NROWS; r += NGW) {
        int b = 0, t = 0, sb = 0; const bool samp = r >= SROW0;
        if (samp) sb = r - SROW0; else row_bt(r, b, t);
        int rr[3];
#pragma unroll
        for (int j = 0; j < 3; ++j) rr[j] = (!samp && t - 3 + j >= 0) ? prow(b, t - 3 + j) : -1;
        for (int it = 0; it < 16; ++it) {
            const int ch0 = it * 512 + 8 * lane;
            float x[4][8];
#pragma unroll
            for (int j = 0; j < 3; ++j) {
                if (samp) { const float* hp = P.state_conv_c + ((size_t)(sb * 3 + j)) * CDIM + ch0; const f32x4 a = *(const f32x4*)hp, c = *(const f32x4*)(hp + 4);
                    x[j][0] = a.x; x[j][1] = a.y; x[j][2] = a.z; x[j][3] = a.w; x[j][4] = c.x; x[j][5] = c.y; x[j][6] = c.z; x[j][7] = c.w; }
                else if (rr[j] >= 0) unpack8(*(const v4u*)(PROJC + (size_t)rr[j] * NC_PAD + ch0), x[j]);
                else {
#pragma unroll
                    for (int i = 0; i < 8; ++i) x[j][i] = 0.f; }
            }
            unpack8(*(const v4u*)(PROJC + (size_t)r * NC_PAD + ch0), x[3]);
            float acc[8];
#pragma unroll
            for (int i = 0; i < 8; ++i) acc[i] = 0.f;
#pragma unroll
            for (int j = 0; j < 4; ++j) { const f32x4 w0 = *(const f32x4*)(cw + (size_t)j * CDIM + ch0), w1 = *(const f32x4*)(cw + (size_t)j * CDIM + ch0 + 4);
                acc[0] += w0.x * x[j][0]; acc[1] += w0.y * x[j][1]; acc[2] += w0.z * x[j][2]; acc[3] += w0.w * x[j][3];
                acc[4] += w1.x * x[j][4]; acc[5] += w1.y * x[j][5]; acc[6] += w1.z * x[j][6]; acc[7] += w1.w * x[j][7]; }
            float ss = 0.f;
#pragma unroll
            for (int i = 0; i < 8; ++i) { acc[i] = silu_f(acc[i]); ss += acc[i] * acc[i]; }
            if (it < 8) { ss = row16_sum(ss); float rn = 1.f / sqrtf(ss + RMS_EPS); if (it < 4) rn *= QSCALE;
#pragma unroll
                for (int i = 0; i < 8; ++i) acc[i] *= rn; }
            if (it < 8) { float* qk = QKF + (size_t)r * 4096 + ch0; *(f32x4*)qk = (f32x4){acc[0], acc[1], acc[2], acc[3]}; *(f32x4*)(qk + 4) = (f32x4){acc[4], acc[5], acc[6], acc[7]}; }
            else *(v4u*)(QKVC + (size_t)r * CDIM + ch0) = pack8(acc);
            if (samp) {
                float* o = P.out + O_CCS + ((size_t)(sb * 3)) * CDIM + ch0;
#pragma unroll
                for (int j = 0; j < 3; ++j) { *(f32x4*)(o + (size_t)j * CDIM) = (f32x4){x[j + 1][0], x[j + 1][1], x[j + 1][2], x[j + 1][3]}; *(f32x4*)(o + (size_t)j * CDIM + 4) = (f32x4){x[j + 1][4], x[j + 1][5], x[j + 1][6], x[j + 1][7]}; }
            } else if (t >= TP - 3) {
                float* o = P.out + O_CCP + ((size_t)(b * 3 + (t - (TP - 3)))) * CDIM + ch0;
                *(f32x4*)o = (f32x4){x[3][0], x[3][1], x[3][2], x[3][3]}; *(f32x4*)(o + 4) = (f32x4){x[3][4], x[3][5], x[3][6], x[3][7]};
            }
        }
        if (lane < 32) {
            const float braw = bf2f(PROJC[(size_t)r * NC_PAD + 12288 + lane]), araw = bf2f(PROJC[(size_t)r * NC_PAD + 12320 + lane]);
            const float xx = araw + P.dt_bias[lane]; const float sp = xx > 20.f ? xx : __logf(1.f + __expf(xx));
            G[(size_t)r * 32 + lane] = -__expf(P.a_log[lane]) * sp; BETA[(size_t)r * 32 + lane] = 1.f / (1.f + __expf(-braw));
        }
    }
}

struct Tok { f32x4 k0, k1, q0, q1; unsigned v; float g, b; };
__device__ __forceinline__ void tok_load(Tok& T, const float* QKF, const bf16* QKVC, const float* G, const float* BETA, int row, int h, int rg, int col0) {
    const float* base = QKF + (size_t)row * 4096 + (h >> 1) * 128 + 8 * rg;
    T.q0 = *(const f32x4*)base; T.q1 = *(const f32x4*)(base + 4); T.k0 = *(const f32x4*)(base + 2048); T.k1 = *(const f32x4*)(base + 2052);
    T.v = *(const unsigned*)(QKVC + (size_t)row * CDIM + 4096 + h * 128 + col0);
    T.g = G[(size_t)row * 32 + h]; T.b = BETA[(size_t)row * 32 + h];
}
__device__ __forceinline__ f32x2 tok_step(f32x2 (&S)[8], const Tok& T) {
    const float kk[8] = {T.k0.x, T.k0.y, T.k0.z, T.k0.w, T.k1.x, T.k1.y, T.k1.z, T.k1.w};
    const float qq[8] = {T.q0.x, T.q0.y, T.q0.z, T.q0.w, T.q1.x, T.q1.y, T.q1.z, T.q1.w};
    const float a = __expf(T.g);
    f32x2 d0 = S[0] * kk[0], d1 = S[1] * kk[1];
#pragma unroll
    for (int i = 2; i < 8; i += 2) { d0 += S[i] * kk[i]; d1 += S[i + 1] * kk[i + 1]; }
    f32x2 d = d0 + d1;
    d.x = row16_sum(d.x); d.y = row16_sum(d.y);
    const f32x2 tv = {bflo(T.v), bfhi(T.v)};
    const f32x2 dl = (tv - d * a) * T.b;
    f32x2 o0 = {0.f, 0.f}, o1 = {0.f, 0.f};
#pragma unroll
    for (int i = 0; i < 8; i += 2) { S[i] = S[i] * a + dl * kk[i]; o0 += S[i] * qq[i]; S[i + 1] = S[i + 1] * a + dl * kk[i + 1]; o1 += S[i + 1] * qq[i + 1]; }
    f32x2 o = o0 + o1;
    o.x = row16_sum(o.x); o.y = row16_sum(o.y);
    return o;
}
constexpr int DBK = 2;
__device__ __forceinline__ void delta_segment(f32x2 (&S)[8], const float* QKF, const bf16* QKVC, const float* G, const float* BETA, float* OF, int rowbase, int ntok, int h, int rg, int col0) {
    Tok A[DBK], B[DBK];
#pragma unroll
    for (int i = 0; i < DBK; ++i) tok_load(A[i], QKF, QKVC, G, BETA, rowbase + i, h, rg, col0);
    for (int t0 = 0; t0 < ntok; t0 += 2 * DBK) {
        f32x2 o[DBK];
#pragma unroll
        for (int i = 0; i < DBK; ++i) tok_load(B[i], QKF, QKVC, G, BETA, rowbase + t0 + DBK + i, h, rg, col0);
#pragma unroll
        for (int i = 0; i < DBK; ++i) o[i] = tok_step(S, A[i]);
        if (rg == 0) {
#pragma unroll
            for (int i = 0; i < DBK; ++i) *(f32x2*)(OF + (size_t)(rowbase + t0 + i) * DVW + h * 128 + col0) = o[i]; }
        if (t0 + 2 * DBK < ntok) {
#pragma unroll
            for (int i = 0; i < DBK; ++i) tok_load(A[i], QKF, QKVC, G, BETA, rowbase + t0 + 2 * DBK + i, h, rg, col0); }
#pragma unroll
        for (int i = 0; i < DBK; ++i) o[i] = tok_step(S, B[i]);
        if (rg == 0) {
#pragma unroll
            for (int i = 0; i < DBK; ++i) *(f32x2*)(OF + (size_t)(rowbase + t0 + DBK + i) * DVW + h * 128 + col0) = o[i]; }
    }
}
__device__ __forceinline__ void delta_phase(const Ptrs& P, int wave, int lane) {
    unsigned char* ws = P.ws;
    const bf16* QKVC = (const bf16*)(ws + WS_QKVC); const float* QKF = (const float*)(ws + WS_QKF); const float* G = (const float*)(ws + WS_G); const float* BETA = (const float*)(ws + WS_BETA); float* OF = (float*)(ws + WS_SC);
    const int cg = lane >> 4, rg = lane & 15;
    if (wave < 4) {
        for (int item = blockIdx.x * 4 + wave; item < NBP * 32 * 16; item += gridDim.x * 4) {
            const int b = item >> 9, h = (item >> 4) & 31, col0 = 8 * (item & 15) + 2 * cg;
            f32x2 S[8];
#pragma unroll
            for (int i = 0; i < 8; ++i) S[i] = (f32x2){0.f, 0.f};
            delta_segment(S, QKF, QKVC, G, BETA, OF, XROW0 + b * NMETA, NMETA, h, rg, col0);
            delta_segment(S, QKF, QKVC, G, BETA, OF, b * SEQ, SEQ, h, rg, col0);
            float* o = P.out + O_DP + ((size_t)((b * 32 + h) * 128 + 8 * rg)) * 128 + col0;
#pragma unroll
            for (int i = 0; i < 8; ++i) *(f32x2*)(o + (size_t)i * 128) = S[i];
        }
    } else {
        for (int item = blockIdx.x * 4 + (wave - 4); item < SBN * 32 * 16; item += gridDim.x * 4) {
            const int sb = item >> 9, h = (item >> 4) & 31, col0 = 8 * (item & 15) + 2 * cg;
            const size_t so = ((size_t)((sb * 32 + h) * 128 + 8 * rg)) * 128 + col0;
            f32x2 S[8];
#pragma unroll
            for (int i = 0; i < 8; ++i) S[i] = *(const f32x2*)(P.state_delta + so + (size_t)i * 128);
            Tok T; tok_load(T, QKF, QKVC, G, BETA, SROW0 + sb, h, rg, col0);
            const f32x2 o = tok_step(S, T);
            if (rg == 0) *(f32x2*)(OF + (size_t)(SROW0 + sb) * DVW + h * 128 + col0) = o;
            float* op = P.out + O_DS + so;
#pragma unroll
            for (int i = 0; i < 8; ++i) *(f32x2*)(op + (size_t)i * 128) = S[i];
        }
    }
}
__device__ __forceinline__ void normC_phase(const bf16* PROJC, bf16* Y, const Ptrs& P, int gw, int NGW, int lane) {
    const float* OF = (const float*)(P.ws + WS_SC);
    const int d0 = 8 * (lane & 15);
    float nw[8];
    { const f32x4 a = *(const f32x4*)(P.norm_w + d0), b = *(const f32x4*)(P.norm_w + d0 + 4); nw[0] = a.x; nw[1] = a.y; nw[2] = a.z; nw[3] = a.w; nw[4] = b.x; nw[5] = b.y; nw[6] = b.z; nw[7] = b.w; }
    for (int r = gw; r < NROWS; r += NGW) {
#pragma unroll 2
        for (int it = 0; it < 8; ++it) {
            const int hd = it * 4 + (lane >> 4);
            const float* op = OF + (size_t)r * DVW + hd * 128 + d0;
            const f32x4 a = *(const f32x4*)op, b = *(const f32x4*)(op + 4);
            float o[8] = {a.x, a.y, a.z, a.w, b.x, b.y, b.z, b.w};
            float ss = 0.f;
#pragma unroll
            for (int i = 0; i < 8; ++i) ss += o[i] * o[i];
            ss = row16_sum(ss);
            const float rs = 1.f / sqrtf(ss * (1.f / 128.f) + RMS_EPS);
            float z[8]; unpack8(*(const v4u*)(PROJC + (size_t)r * NC_PAD + 8192 + hd * 128 + d0), z);
#pragma unroll
            for (int i = 0; i < 8; ++i) o[i] = o[i] * rs * nw[i] * silu_f(z[i]);
            *(v4u*)(Y + (size_t)r * DVW + hd * 128 + d0) = pack8(o);
        }
    }
}


__device__ __forceinline__ void dense_attn_phase(const Ptrs& P, bf16* O, char* lds, int wv) {
    unsigned char* ws = P.ws;
    const bf16* Qr = (const bf16*)(ws + WS_QR); const bf16* Ks = (const bf16*)(ws + WS_KS); const bf16* Vs = (const bf16*)(ws + WS_VS);
    const unsigned long long* MASK = (const unsigned long long*)(ws + WS_MASK);
    typedef dattn::BlockRef<bf16, bf16> BR;
    for (int it0 = blockIdx.x; it0 < 256; it0 += gridDim.x) {
        const int grp = it0 & 7, idx = it0 >> 3;
        const int b = grp >> 2, kvh = grp & 3, h = kvh * 4 + (idx >> 3), x = idx & 7;
        BR A, B;
        const int qa = 1 + x, qb = 16 - x;
        A.Q = Qr + ((size_t)(b * SEQ + 256 * (qa - 1))) * DM + h * 128; A.O = O + ((size_t)(b * SEQ + 256 * (qa - 1))) * DM + h * 128;
        B.Q = Qr + ((size_t)(b * SEQ + 256 * (qb - 1))) * DM + h * 128; B.O = O + ((size_t)(b * SEQ + 256 * (qb - 1))) * DM + h * 128;
        A.K = B.K = Ks + (size_t)b * SP * 512 + kvh * 128; A.V = B.V = Vs + (size_t)b * SP * 512 + kvh * 128;
        A.P0 = 256 * qa; B.P0 = 256 * qb;
        A.M = MASK + ((size_t)(b * SP + A.P0)) * MTW; B.M = MASK + ((size_t)(b * SP + B.P0)) * MTW;
        dattn::Seam<bf16> S;
        dattn::causal_swa_prime<bf16, bf16>(A, SP, lds, S, wv);
        dattn::causal_swa_block<bf16, bf16>(A, B, SP, SP, lds, S, wv);
        dattn::causal_swa_block<bf16, bf16>(B, B, SP, SP, lds, S, wv);
    }
}
template <int RT, int CT, class Epi>
__device__ __forceinline__ void small_gemm_unit(const bf16* A, int lda, const bf16* Bt, int ldb, int k0, int klen, LAS unsigned char* lds, const Epi& E, int tid, int wave, int lane) {
    const int r16 = lane & 15, q = lane >> 4;
    const int kw = klen >> 3;
    const bf16* ap = A + (size_t)r16 * lda + k0 + wave * kw + 8 * q;
    const bf16* bp = Bt + (size_t)r16 * ldb + k0 + wave * kw + 8 * q;
    pg8::f32x4 acc[RT][CT];
#pragma unroll
    for (int i = 0; i < RT; ++i)
#pragma unroll
        for (int j = 0; j < CT; ++j) acc[i][j] = (pg8::f32x4){0.f, 0.f, 0.f, 0.f};
#pragma unroll 2
    for (int ks = 0; ks < kw; ks += 32) {
        bf16x8 a[RT], b[CT];
#pragma unroll
        for (int i = 0; i < RT; ++i) a[i] = *(const bf16x8*)(ap + (size_t)(16 * i) * lda + ks);
#pragma unroll
        for (int j = 0; j < CT; ++j) b[j] = *(const bf16x8*)(bp + (size_t)(16 * j) * ldb + ks);
#pragma unroll
        for (int i = 0; i < RT; ++i)
#pragma unroll
            for (int j = 0; j < CT; ++j) acc[i][j] = __builtin_amdgcn_mfma_f32_16x16x32_bf16(a[i], b[j], acc[i][j], 0, 0, 0);
    }
    constexpr int NOUT = 256 * RT * CT;
    LAS float* part = (LAS float*)lds + wave * NOUT;
#pragma unroll
    for (int i = 0; i < RT; ++i)
#pragma unroll
        for (int j = 0; j < CT; ++j)
#pragma unroll
            for (int e = 0; e < 4; ++e) part[(16 * i + 4 * q + e) * (16 * CT) + 16 * j + r16] = acc[i][j][e];
    __syncthreads();
    for (int o = tid; o < NOUT; o += NTHREADS) { float sum = 0.f;
#pragma unroll
        for (int w = 0; w < 8; ++w) sum += ((LAS float*)lds)[w * NOUT + o];
        E(o / (16 * CT), o % (16 * CT), sum); }
    __syncthreads();
}
template <int ACT> struct SEpiRowsBf16 { bf16* O; int ldc; __device__ __forceinline__ void operator()(int row, int col, float v) const { if (ACT == 2) { v = v > 0.f ? v : 0.f; v = v * v; } O[(size_t)row * ldc + col] = f2bf(v); } };
struct SEpiF32 { float* O; int ldc; __device__ __forceinline__ void operator()(int row, int col, float v) const { O[(size_t)row * ldc + col] = v; } };
struct SEpiColsBf16 { bf16* O; int ldc; __device__ __forceinline__ void operator()(int row, int col, float v) const { O[(size_t)col * ldc + row] = f2bf(v); } };
template <int ACT> __device__ __forceinline__ void skinny_rows_bf16(const bf16* A, const bf16* Wt, int K, int nunits, bf16* O, int ldc, LAS unsigned char* lds, int tid, int wave, int lane) {
    for (int u = blockIdx.x; u < nunits; u += gridDim.x) { SEpiRowsBf16<ACT> E{O + (size_t)XROW0 * ldc + u * 64, ldc};
        small_gemm_unit<3, 4>(A + (size_t)XROW0 * K, K, Wt + (size_t)u * 64 * K, K, 0, K, lds, E, tid, wave, lane); }
}
__device__ __forceinline__ void skinny_rows_part(const bf16* A, const bf16* Wt, int K, float* ZP, LAS unsigned char* lds, int tid, int wave, int lane) {
    for (int u = blockIdx.x; u < 256; u += gridDim.x) { const int cgp = u & 31, ksl = u >> 5; SEpiF32 E{ZP + (size_t)ksl * XR * DM + cgp * 64, DM};
        small_gemm_unit<3, 4>(A + (size_t)XROW0 * K, K, Wt + (size_t)cgp * 64 * K, K, ksl * (K >> 3), K >> 3, lds, E, tid, wave, lane); }
}
template <int RT> __device__ __forceinline__ void tail_cols_bf16(const bf16* A, const bf16* Wt, int K, int c0, bf16* O, int ldc, LAS unsigned char* lds, int tid, int wave, int lane) {
    for (int u = blockIdx.x; u < MAINM / 32; u += gridDim.x) { SEpiColsBf16 E{O + (size_t)u * 32 * ldc + c0, ldc};
        small_gemm_unit<RT, 2>(Wt + (size_t)c0 * K, K, A + (size_t)u * 32 * K, K, 0, K, lds, E, tid, wave, lane); }
}

typedef __attribute__((address_space(4))) const unsigned long long* kargq_t;
#define KPF_(k) ((const float*)(const GAS float*)(q_[k]))
__device__ __forceinline__ void load_ptrs(Ptrs& P) {
    kargq_t q_ = (kargq_t)__builtin_amdgcn_kernarg_segment_ptr();
    asm volatile("" : "+s"(q_));
    P.x_prompt = KPF_(0); P.x_sample = KPF_(1); P.state_conv_a = KPF_(2); P.cache_k = KPF_(3);
    P.cache_v = KPF_(4); P.cache_ik = KPF_(5); P.state_conv_c = KPF_(6); P.state_delta = KPF_(7);
    P.page_table = ((const int*)(const GAS int*)(q_[8])); P.meta = KPF_(9); P.w_in_a = KPF_(10); P.conv_w_a = KPF_(11);
    P.w_out_a = KPF_(12); P.w_in_b = KPF_(13); P.w_out_b = KPF_(14); P.w_in_c = KPF_(15);
    P.conv_w_c = KPF_(16); P.a_log = KPF_(17); P.dt_bias = KPF_(18); P.norm_w = KPF_(19);
    P.w_out_c = KPF_(20); P.ln1_g = KPF_(21); P.ln1_b = KPF_(22); P.w1 = KPF_(23);
    P.w2 = KPF_(24); P.ln2_g = KPF_(25); P.ln2_b = KPF_(26);
    P.out = (float*)(GAS float*)(q_[27]); P.ws = (unsigned char*)(GAS unsigned char*)(q_[28]);
}
struct Args { const void* in[27]; float* out; unsigned char* ws; int ph_lo, ph_hi; };
constexpr int PH_PER_LAYER = 12, PH_END = 1 + 4 * PH_PER_LAYER;

__global__ void __launch_bounds__(NTHREADS, 2) mega_fwd(Args args) {
    extern __shared__ __attribute__((aligned(16))) unsigned char lds_raw[];
    LAS unsigned char* lds = (LAS unsigned char*)lds_raw;
    const int tid = threadIdx.x, lane = tid & 63, wave = __builtin_amdgcn_readfirstlane(tid >> 6);
    const int G_ = gridDim.x, NGW = G_ * NWAVES, NT = G_ * NTHREADS; (void)lane;
    unsigned char* ws = args.ws;
    const int lo = args.ph_lo, hi = args.ph_hi;
    const bool fused = (hi - lo) > 1;

    for (int u = tid; u < (LDS_BYTES - LDSCTL_OFF) / 4; u += NTHREADS) ((LAS unsigned*)(lds + LDSCTL_OFF))[u] = 0u;
    __syncthreads();
    volatile LAS unsigned* MISC = (volatile LAS unsigned*)(lds + MISC_OFF);
    XcdBarrier bar; bar.bar = (unsigned*)(ws + WS_CTL) + CW_BAR; bar.x = 0; bar.st = nullptr;
    if (fused) bar = xcd_barrier_post((unsigned*)(ws + WS_CTL) + CW_BAR, MISC + 8);
    bar.wv = wave;

#ifndef MK_SITES
#define MK_SITES 0xffffffffu
#endif
#define SITE(n) (((MK_SITES) >> (n)) & 1u)
#define IN(k) (lo <= (k) && (k) < hi)
#ifndef MK_DUP
#define MK_DUP 0u
#endif
#define NREP(n) ((((MK_DUP) >> (n)) & 1u) ? 2 : 1)
#define BEGIN_SITE(n, id) if (SITE(n) && IN(id)) { for (int rp_ = 0; rp_ < NREP(n); ++rp_) { Ptrs P; load_ptrs(P); unsigned char* ws = P.ws; (void)ws; \
    bf16* X = (bf16*)(P.ws + WS_X); float* Z = (float*)(P.ws + WS_Z); float* ZP = (float*)(P.ws + WS_ZP); bf16* Y = (bf16*)(P.ws + WS_Y); bf16* BIG = (bf16*)(P.ws + WS_BIG); (void)X; (void)Z; (void)ZP; (void)Y; (void)BIG;
#define END_SITE(id) SEAM(id); } }
#define LOCALS int tid_ = threadIdx.x; asm volatile("" : "+v"(tid_)); const int lane_ = tid_ & 63, wave_ = __builtin_amdgcn_readfirstlane(tid_ >> 6), gw_ = blockIdx.x * NWAVES + wave_, gtid_ = blockIdx.x * NTHREADS + tid_; (void)lane_; (void)wave_; (void)gw_; (void)gtid_
#define SEAM(k) do { if (fused && (k) + 1 < PH_END) xcd_barrier(bar); else __syncthreads(); } while (0)


    BEGIN_SITE(0, 0) LOCALS; p0_prologue(P, lds, gw_, NGW, wave_, lane_); END_SITE(0)

    for (int layer = 0; layer < 4; ++layer) {
        const int kind = layer % 3, j = layer / 3, base = 1 + layer * PH_PER_LAYER;
        if (kind == 0) {
            BEGIN_SITE(1, base + 0)
                const bf16* Wt = (const bf16*)(ws + WS_WA_IN + (size_t)j * WSZ_A_IN); pg8::Gemm g{X, Wt, MAINM, NA_IN, DM}; pg8::StaticOrder S; S.init(MAINM, NA_IN, G_, (int)blockIdx.x);
                pg8::EpiBf16<0> E{BIG, NA_IN, nullptr, 0, 0, 1.f};
                pg8::gemm_phase<pg8::EpiBf16<0>, pg8::StaticOrder, true, true>(lds, g, S, E, wave);
                { LOCALS; skinny_rows_bf16<0>(X, Wt, DM, NA_IN / 64, BIG, NA_IN, lds, tid_, wave_, lane_); }
                END_SITE(base + 0)
            BEGIN_SITE(2, base + 1)
                LOCALS; convA_phase(BIG, Y, P.conv_w_a + (size_t)j * 3 * DM, P.state_conv_a + (size_t)j * SBN * 2 * DM, P.out + O_CAP + (size_t)j * NBP * 2 * DM, P.out + O_CAS + (size_t)j * SBN * 2 * DM, gtid_, NT);
                END_SITE(base + 1)
            BEGIN_SITE(3, base + 2)
                const bf16* Wt = (const bf16*)(ws + WS_WA_OUT + (size_t)j * WSZ_A_OUT); pg8::Gemm g{Y, Wt, MAINM, DM, DM}; pg8::StaticOrder S; S.init(MAINM, DM, G_, (int)blockIdx.x);
                pg8::EpiF32 E{Z, DM};
                pg8::gemm_phase<pg8::EpiF32, pg8::StaticOrder, true, true>(lds, g, S, E, wave);
                { LOCALS; skinny_rows_part(Y, Wt, DM, ZP, lds, tid_, wave_, lane_); }
                END_SITE(base + 2)
        } else if (kind == 1) {
            BEGIN_SITE(4, base + 0)
                const bf16* Wt = (const bf16*)(ws + WS_WB_IN); pg8::Gemm g{X, Wt, MAINM, 4096, DM}; pg8::StaticOrder S; S.init(MAINM, 4096, G_, (int)blockIdx.x);
                pg8::EpiBf16<0> E{BIG, NB_PAD, nullptr, 0, 0, 1.f};
                pg8::gemm_phase<pg8::EpiBf16<0>, pg8::StaticOrder, true, true>(lds, g, S, E, wave);
                { LOCALS; tail_cols_bf16<5>(X, Wt, DM, 4096, BIG, NB_PAD, lds, tid_, wave_, lane_); skinny_rows_bf16<0>(X, Wt, DM, 4224 / 64, BIG, NB_PAD, lds, tid_, wave_, lane_); }
                END_SITE(base + 0)
            BEGIN_SITE(5, base + 1) LOCALS; rope_phase(BIG, P, gw_, NGW, lane_); END_SITE(base + 1)
            BEGIN_SITE(6, base + 2) LOCALS; indexer_sample(P, lds, tid_); indexer_prompt(P, gw_, NGW, lane_); END_SITE(base + 2)
            BEGIN_SITE(7, base + 3) LOCALS; select_phase(P, lds, gw_, NGW, tid_, wave_, lane_); END_SITE(base + 3)
            BEGIN_SITE(8, base + 4) LOCALS; dense_attn_phase(P, Y, (char*)lds_raw, wave_); attn_phase(P, Y, lds, gw_, NGW, wave_, lane_); END_SITE(base + 4)
            BEGIN_SITE(9, base + 5)
                const bf16* Wt = (const bf16*)(ws + WS_WB_OUT); pg8::Gemm g{Y, Wt, MAINM, DM, DM}; pg8::StaticOrder S; S.init(MAINM, DM, G_, (int)blockIdx.x);
                pg8::EpiF32 E{Z, DM};
                pg8::gemm_phase<pg8::EpiF32, pg8::StaticOrder, true, true>(lds, g, S, E, wave);
                { LOCALS; skinny_rows_part(Y, Wt, DM, ZP, lds, tid_, wave_, lane_); }
                END_SITE(base + 5)
        } else {
            BEGIN_SITE(10, base + 0)
                const bf16* Wt = (const bf16*)(ws + WS_WC_IN); pg8::Gemm g{X, Wt, MAINM, 12288, DM}; pg8::StaticOrder S; S.init(MAINM, 12288, G_, (int)blockIdx.x);
                pg8::EpiBf16<0> E{BIG, NC_PAD, nullptr, 0, 0, 1.f};
                pg8::gemm_phase<pg8::EpiBf16<0>, pg8::StaticOrder, true, true>(lds, g, S, E, wave);
                { LOCALS; tail_cols_bf16<4>(X, Wt, DM, 12288, BIG, NC_PAD, lds, tid_, wave_, lane_); skinny_rows_bf16<0>(X, Wt, DM, NC_IN / 64, BIG, NC_PAD, lds, tid_, wave_, lane_); }
                END_SITE(base + 0)
            BEGIN_SITE(11, base + 1) LOCALS; convC_phase(BIG, P, gw_, NGW, lane_); END_SITE(base + 1)
            BEGIN_SITE(12, base + 2) LOCALS; delta_phase(P, wave_, lane_); END_SITE(base + 2)
            BEGIN_SITE(13, base + 3) LOCALS; normC_phase(BIG, Y, P, gw_, NGW, lane_); END_SITE(base + 3)
            BEGIN_SITE(14, base + 4)
                const bf16* Wt = (const bf16*)(ws + WS_WC_OUT); pg8::Gemm g{Y, Wt, MAINM, DM, DVW}; pg8::StaticOrder S; S.init(MAINM, DM, G_, (int)blockIdx.x);
                pg8::EpiF32 E{Z, DM};
                pg8::gemm_phase<pg8::EpiF32, pg8::StaticOrder, true, true>(lds, g, S, E, wave);
                { LOCALS; skinny_rows_part(Y, Wt, DVW, ZP, lds, tid_, wave_, lane_); }
                END_SITE(base + 4)
        }
        BEGIN_SITE(15, base + 6) LOCALS; ln_phase(Z, ZP, X, P.ln1_g + (size_t)layer * DM, P.ln1_b + (size_t)layer * DM, nullptr, nullptr, gw_, NGW, lane_); END_SITE(base + 6)
        BEGIN_SITE(16, base + 7)
            const bf16* Wt = (const bf16*)(ws + WS_W1 + (size_t)layer * WSZ_W1); pg8::Gemm g{X, Wt, MAINM, FF, DM}; pg8::StaticOrder S; S.init(MAINM, FF, G_, (int)blockIdx.x);
            pg8::EpiBf16<2> E{BIG, FF, nullptr, 0, 0, 1.f};
            pg8::gemm_phase<pg8::EpiBf16<2>, pg8::StaticOrder, true, true>(lds, g, S, E, wave);
            { LOCALS; skinny_rows_bf16<2>(X, Wt, DM, FF / 64, BIG, FF, lds, tid_, wave_, lane_); }
            END_SITE(base + 7)
        BEGIN_SITE(17, base + 8)
            const bf16* Wt = (const bf16*)(ws + WS_W2 + (size_t)layer * WSZ_W2); pg8::Gemm g{BIG, Wt, MAINM, DM, FF}; pg8::StaticOrder S; S.init(MAINM, DM, G_, (int)blockIdx.x);
            pg8::EpiF32 E{Z, DM};
            pg8::gemm_phase<pg8::EpiF32, pg8::StaticOrder, true, true>(lds, g, S, E, wave);
            { LOCALS; skinny_rows_part(BIG, Wt, FF, ZP, lds, tid_, wave_, lane_); }
            END_SITE(base + 8)
        BEGIN_SITE(18, base + 9)
            const bool last = layer == 3;
            LOCALS; ln_phase(Z, ZP, X, P.ln2_g + (size_t)layer * DM, P.ln2_b + (size_t)layer * DM, last ? P.out + O_YP : nullptr, last ? P.out + O_YS : nullptr, gw_, NGW, lane_);
            if (!last) SEAM(base + 9); } }
    }
#undef IN
#undef SEAM
}

#ifndef MK_SPLIT
#define MK_SPLIT 0
#endif
extern "C" void kernel_launch(void* const* d_in, const int* in_sizes, int n_in, void* d_out, int out_size, void* d_ws, size_t ws_size, hipStream_t stream) {
    static int grid = 0;
    if (grid == 0) {
        if (n_in != 27 || (size_t)out_size != O_END || ws_size < WS_END) { fprintf(stderr, "kernel_launch: unexpected shapes: n_in %d out %d (want %zu) ws %zu (want >= %zu)\n", n_in, out_size, (size_t)O_END, ws_size, (size_t)WS_END); grid = -1; return; }
        int dev = 0, cus = 0;
        if (hipGetDevice(&dev) != hipSuccess || hipDeviceGetAttribute(&cus, hipDeviceAttributeMultiprocessorCount, dev) != hipSuccess) { grid = -1; return; }
        if (hipFuncSetAttribute((const void*)mega_fwd, hipFuncAttributeMaxDynamicSharedMemorySize, LDS_BYTES) != hipSuccess) { fprintf(stderr, "kernel_launch: hipFuncSetAttribute failed\n"); grid = -1; return; }
        int per_cu = 0;
        if (hipOccupancyMaxActiveBlocksPerMultiprocessor(&per_cu, (const void*)mega_fwd, NTHREADS, LDS_BYTES) != hipSuccess || per_cu < 1) fprintf(stderr, "kernel_launch: occupancy query reports %d\n", per_cu);
        (void)hipGetLastError();
        grid = cus;
    }
    if (grid < 0) return;
    (void)hipMemsetAsync((char*)d_ws + WS_CTL, 0, CTL_ZERO_BYTES, stream);
    Args a{};
    for (int i = 0; i < 27; ++i) a.in[i] = d_in[i];
    a.out = (float*)d_out; a.ws = (unsigned char*)d_ws;
#if MK_SPLIT
    for (int ph = 0; ph < PH_END; ++ph) {
        bool exists = (ph == 0);
        if (ph > 0) { const int layer = (ph - 1) / PH_PER_LAYER, l = (ph - 1) % PH_PER_LAYER, kind = layer % 3; const int nmix = kind == 0 ? 3 : (kind == 1 ? 6 : 5); exists = (l < nmix) || (l >= 6 && l <= 9); }
        if (!exists) continue;
        a.ph_lo = ph; a.ph_hi = ph + 1;
        hipLaunchKernelGGL(mega_fwd, dim3(grid), dim3(NTHREADS), LDS_BYTES, stream, a);
    }
#else
    a.ph_lo = 0; a.ph_hi = PH_END;
    hipLaunchKernelGGL(mega_fwd, dim3(grid), dim3(NTHREADS), LDS_BYTES, stream, a);
#endif
    const hipError_t le = hipPeekAtLastError();
    if (le != hipSuccess) fprintf(stderr, "kernel_launch: launch failed: %s\n", hipGetErrorName(le));
}
```

```cpp
#include <hip/hip_runtime.h>
#include <cstdio>
#include <cstdint>
#include <cmath>
__device__ __forceinline__ int flane() { return (int)__builtin_amdgcn_mbcnt_hi(~0u, __builtin_amdgcn_mbcnt_lo(~0u, 0u)); }
namespace pg8 {
#define PG8_LAS __attribute__((address_space(3)))
typedef unsigned short bf16_t;
typedef short bf16x8 __attribute__((ext_vector_type(8)));
typedef float f32x4 __attribute__((ext_vector_type(4)));
typedef unsigned u32x4 __attribute__((ext_vector_type(4)));
constexpr int BM = 256, BK = 64, HALF = 128, HTB = HALF * BK * 2  , STAGE_BYTES = 8 * HTB, NXCD = 8, WGM = 8;

__host__ __device__ __forceinline__ int lds_byte(int r, int c) { const int st = (r >> 4) * 2 + (c >> 5), rr = r & 15, cc = c & 31, ob = rr * 64 + cc * 2; return st * 1024 + (ob ^ (((ob >> 9) & 1) << 5)); }
__host__ __device__ __forceinline__ void stage_rc(int b, int& R, int& C) { const int st = b / 1024, sb = b % 1024, swz = sb ^ (((sb >> 9) & 1) << 5); R = (st >> 1) * 16 + swz / 64; C = (st & 1) * 32 + (swz % 64) / 2; }
__host__ __device__ __forceinline__ int perm32(int rho) { const int n = rho >> 4, i = rho & 15; return 8 * (i >> 2) + 4 * n + (i & 3); }

struct Unit { int pm, pn; };
struct Gemm { const bf16_t* A; const bf16_t* Bt; int M, N, K; };

struct StaticOrder {
    int nM, nN, nwg, G, c;
    __host__ __device__ void init(int M, int N, int G_, int c_) { nM = M / BM; nN = N / BM; nwg = nM * nN; G = G_; c = c_; }
    __host__ __device__ bool next(int i, Unit& u) const {
        const long L = (long)i * G + c; if (L >= nwg) return false;
        int wgid = (int)L; { const int q = nwg / NXCD, r = nwg % NXCD, xcd = wgid % NXCD, off = wgid / NXCD; wgid = (xcd < r ? xcd * (q + 1) : r * (q + 1) + (xcd - r) * q) + off; }
        const int nig = WGM * nN, gid = wgid / nig, fm = gid * WGM, gsz = (nM - fm) < WGM ? (nM - fm) : WGM;
        u.pm = fm + ((wgid % nig) % gsz); u.pn = (wgid % nig) / gsz; return true;
    }
    __device__ __forceinline__ void a_ready(const Unit&) const {}
    __device__ __forceinline__ void done(const Unit&) const {}
};

__device__ __forceinline__ unsigned cvt_pk_bf16(float lo, float hi) { unsigned r; asm volatile("v_cvt_pk_bf16_f32 %0, %1, %2" : "=v"(r) : "v"(lo), "v"(hi)); return r; }
typedef float f32x2 __attribute__((ext_vector_type(2)));
__device__ __forceinline__ f32x2 gelu_pk(f32x2 v) {
    const f32x2 av = __builtin_elementwise_abs(v), d = av * 0.2316418882f + 1.0f;
    f32x2 t; t.x = __builtin_amdgcn_rcpf(d.x); t.y = __builtin_amdgcn_rcpf(d.y);
    f32x2 q = t * 0.5307027145f + (-0.7265760135f); q = q * t + 0.7107068705f; q = q * t + (-0.142248368f); q = q * t + 0.127414796f; q = q * t;
    const f32x2 s = (v * v) * (-0.72134752044f);
    f32x2 e; e.x = __builtin_amdgcn_exp2f(s.x); e.y = __builtin_amdgcn_exp2f(s.y);
    const f32x2 m = v * (q * e), r = v - m;
    f32x2 o; o.x = v.x < 0.f ? m.x : r.x; o.y = v.y < 0.f ? m.y : r.y; return o;
}

template <int ACT  > struct EpiBf16 {
    static constexpr bool PERM = true, AFTER_DRAIN = false; static_assert(ACT == 0 || ACT == 1 || ACT == 2, "EpiBf16: ACT is 0 (none), 1 (gelu_pk) or 2 (relu^2)");
    bf16_t* O; int ldc; const float* bias; int split_cols; size_t split_stride; float scale0;
    __device__ __forceinline__ void operator()(const f32x4 (&acc)[2][2][4][2], const Unit& u, int wr, int wc, int fr, int fq) const {
        const int row0 = u.pm * BM + wr * 64 + fr; int colt = u.pn * BM; bf16_t* base = O;
        float sc = 1.f; if (split_cols) { const int t = colt / split_cols; base += (size_t)t * split_stride; colt -= t * split_cols; if (t == 0) sc = scale0; }
        const int col0 = colt + wc * 32 + 8 * fq, bcol0 = u.pn * BM + wc * 32 + 8 * fq;
        f32x4 bv[2][2];
#pragma unroll
        for (int bj = 0; bj < 2; ++bj)
#pragma unroll
            for (int n = 0; n < 2; ++n) bv[bj][n] = bias ? *(const f32x4*)(bias + bcol0 + bj * HALF + 4 * n) : (f32x4){0.f, 0.f, 0.f, 0.f};
#pragma unroll
        for (int ai = 0; ai < 2; ++ai)
#pragma unroll
            for (int m = 0; m < 4; ++m) { bf16_t* rowp = base + (size_t)(row0 + ai * HALF + m * 16) * ldc + col0;
#pragma unroll
                for (int bj = 0; bj < 2; ++bj) { f32x4 v0 = acc[ai][bj][m][0] + bv[bj][0], v1 = acc[ai][bj][m][1] + bv[bj][1];
                    if (ACT == 1) { f32x2 a = gelu_pk((f32x2){v0[0], v0[1]}), b = gelu_pk((f32x2){v0[2], v0[3]}), c = gelu_pk((f32x2){v1[0], v1[1]}), d = gelu_pk((f32x2){v1[2], v1[3]});
                        v0 = (f32x4){a.x, a.y, b.x, b.y}; v1 = (f32x4){c.x, c.y, d.x, d.y}; }
                    if (ACT == 2) { _Pragma("unroll") for (int q_ = 0; q_ < 4; ++q_) { const float a_ = v0[q_] > 0.f ? v0[q_] : 0.f, b_ = v1[q_] > 0.f ? v1[q_] : 0.f; v0[q_] = a_ * a_; v1[q_] = b_ * b_; } }
                    v0 = v0 * sc; v1 = v1 * sc; u32x4 w; w.x = cvt_pk_bf16(v0[0], v0[1]); w.y = cvt_pk_bf16(v0[2], v0[3]); w.z = cvt_pk_bf16(v1[0], v1[1]); w.w = cvt_pk_bf16(v1[2], v1[3]);
                    *(u32x4*)(rowp + bj * HALF) = w; } }
    }
};


struct EpiF32 {
    static constexpr bool PERM = false, AFTER_DRAIN = false;
    float* C; int ldc;
    __device__ __forceinline__ void operator()(const f32x4 (&acc)[2][2][4][2], const Unit& u, int wr, int wc, int fr, int fq) const {
        const int row0 = u.pm * BM + wr * 64 + fr, col0 = u.pn * BM + wc * 32 + 4 * fq;
#pragma unroll
        for (int ai = 0; ai < 2; ++ai)
#pragma unroll
            for (int m = 0; m < 4; ++m) { float* rowp = C + (size_t)(row0 + ai * HALF + m * 16) * ldc + col0;
#pragma unroll
                for (int bj = 0; bj < 2; ++bj)
#pragma unroll
                    for (int n = 0; n < 2; ++n) *(f32x4*)(rowp + bj * HALF + n * 16) = acc[ai][bj][m][n]; }
    }
};
struct PanelStats {
    unsigned* xbuf;
    unsigned* cnt;
    unsigned* tmo;
    int ntn; float eps;
    unsigned code;
    __device__ __forceinline__ bool run(const f32x4 (&v)[2][2][4][2], const Unit& u, int wr, int wc, int fr, int fq, PG8_LAS unsigned char* lds, int wid, int lane) const {
        typedef float f32x2v __attribute__((ext_vector_type(2)));
        PG8_LAS f32x2v* P = (PG8_LAS f32x2v*)lds;
        PG8_LAS f32x2v* S = (PG8_LAS f32x2v*)(lds + 8192);
        PG8_LAS unsigned* flag = (PG8_LAS unsigned*)(lds + 8192 + 2048);
#pragma unroll
        for (int ai = 0; ai < 2; ++ai)
#pragma unroll
            for (int m = 0; m < 4; ++m) {
                float s = 0.f;
#pragma unroll
                for (int bj = 0; bj < 2; ++bj)
#pragma unroll
                    for (int n = 0; n < 2; ++n) { const f32x4 x = v[ai][bj][m][n]; s += (x[0] + x[1]) + (x[2] + x[3]); }
                s += __shfl_xor(s, 16); s += __shfl_xor(s, 32);
                const float mw = s * (1.0f / 64.0f); float q = 0.f;
#pragma unroll
                for (int bj = 0; bj < 2; ++bj)
#pragma unroll
                    for (int n = 0; n < 2; ++n) { const f32x4 d = v[ai][bj][m][n] - mw; q += (d[0] * d[0] + d[1] * d[1]) + (d[2] * d[2] + d[3] * d[3]); }
                q += __shfl_xor(q, 16); q += __shfl_xor(q, 32);
                if (fq == 0) P[(ai * HALF + wr * 64 + m * 16 + fr) * 4 + wc] = (f32x2v){mw, q};
            }
        asm volatile("s_waitcnt lgkmcnt(0)" ::: "memory"); __builtin_amdgcn_s_barrier(); asm volatile("" ::: "memory");
#if defined(BROKEN_EXCHANGE_NO_WAIT)
#warning BROKEN CONTROL BUILD: the row-statistics exchange does not wait; results are wrong by design
        if (blockIdx.x >= 64) { const long long t0_ = clock64(); while (clock64() - t0_ < 60000) __builtin_amdgcn_s_sleep(8); }
#endif
        const int row = wid * 32 + (lane & 31);
        if (lane < 32) {
            const f32x2v a = P[row * 4 + 0], b = P[row * 4 + 1], c = P[row * 4 + 2], d = P[row * 4 + 3];
            const float mt = (a.x + b.x + c.x + d.x) * 0.25f;
            const float da = a.x - mt, db = b.x - mt, dc = c.x - mt, dd = d.x - mt;
            const float m2 = (a.y + b.y) + (c.y + d.y) + 64.0f * ((da * da + db * db) + (dc * dc + dd * dd));
            unsigned long long* slot = (unsigned long long*)xbuf + ((size_t)(u.pm * BM + row) * 4 + u.pn);
            __hip_atomic_store(slot, ((unsigned long long)__float_as_uint(m2) << 32) | __float_as_uint(mt), __ATOMIC_RELAXED, __HIP_MEMORY_SCOPE_AGENT);
        }
        asm volatile("s_waitcnt vmcnt(0)" ::: "memory");
        if (lane == 0) __hip_atomic_fetch_add(cnt + 64 * u.pm, 1u, __ATOMIC_RELAXED, __HIP_MEMORY_SCOPE_AGENT);
        if (wid == 0) {
            bool dead = false; const unsigned long long t0 = __builtin_amdgcn_s_memrealtime(); const unsigned want = 8u * (unsigned)ntn;
            for (;;) {
#if defined(BROKEN_EXCHANGE_NO_WAIT)
                break;
#endif
                if ((unsigned)__builtin_amdgcn_readfirstlane(__hip_atomic_load(cnt + 64 * u.pm, __ATOMIC_RELAXED, __HIP_MEMORY_SCOPE_AGENT)) >= want) break;
                if (__builtin_amdgcn_s_memrealtime() - t0 > 2000000ull) {
                    if (lane == 0) { unsigned expect = 0u; __hip_atomic_compare_exchange_strong(tmo + 1, &expect, code | (unsigned)(u.pm & 0xff), __ATOMIC_RELAXED, __ATOMIC_RELAXED, __HIP_MEMORY_SCOPE_AGENT);
                                     __hip_atomic_store(tmo, 1u, __ATOMIC_RELAXED, __HIP_MEMORY_SCOPE_AGENT); }
                    dead = true; break; }
                __builtin_amdgcn_s_sleep(2);
            }
            __builtin_amdgcn_fence(__ATOMIC_ACQUIRE, "agent");
            if (lane == 0) flag[0] = dead ? 1u : 0u;
        }
        asm volatile("s_waitcnt vmcnt(0) lgkmcnt(0)" ::: "memory"); __builtin_amdgcn_s_barrier(); asm volatile("" ::: "memory");
        const bool bad = flag[0] != 0u;
        if (lane < 32) {
            const unsigned long long* slot = (const unsigned long long*)xbuf + (size_t)(u.pm * BM + row) * 4; float mt[4], m2[4]; float ms = 0.f;
#pragma unroll
            for (int t = 0; t < 4; ++t) { if (t < ntn) { const unsigned long long w = __hip_atomic_load(slot + t, __ATOMIC_RELAXED, __HIP_MEMORY_SCOPE_AGENT); mt[t] = __uint_as_float((unsigned)w); m2[t] = __uint_as_float((unsigned)(w >> 32)); } else { mt[t] = 0.f; m2[t] = 0.f; } ms += mt[t]; }
            const float mean = ms / (float)ntn; float q = 0.f;
#pragma unroll
            for (int t = 0; t < 4; ++t) if (t < ntn) { const float dm = mt[t] - mean; q += m2[t] + 256.0f * dm * dm; }
            S[row] = (f32x2v){mean, 1.0f / sqrtf(q / (256.0f * (float)ntn) + eps)};
        }
        asm volatile("s_waitcnt lgkmcnt(0)" ::: "memory"); __builtin_amdgcn_s_barrier(); asm volatile("" ::: "memory");
        return bad;
    }
};
struct EpiLnRes {
    static constexpr bool PERM = false, AFTER_DRAIN = true;
    const float* base; float* out; int ldc; const float* bias; PanelStats st; unsigned poison;
    __device__ __forceinline__ void fused(f32x4 (&acc)[2][2][4][2], const Unit& u, int wr, int wc, int fr, int fq, PG8_LAS unsigned char* lds, int wid, int lane) const {
        typedef float f32x2v __attribute__((ext_vector_type(2)));
        const PG8_LAS f32x2v* S = (const PG8_LAS f32x2v*)(lds + 8192);
        const int col0 = u.pn * BM + wc * 32 + 4 * fq;
#pragma unroll
        for (int bj = 0; bj < 2; ++bj)
#pragma unroll
            for (int n = 0; n < 2; ++n) { const f32x4 bv = bias ? *(const f32x4*)(bias + col0 + bj * HALF + n * 16) : (f32x4){0.f, 0.f, 0.f, 0.f};
#pragma unroll
                for (int ai = 0; ai < 2; ++ai)
#pragma unroll
                    for (int m = 0; m < 4; ++m) acc[ai][bj][m][n] += bv; }
        f32x4 pre[4][2][2];
#pragma unroll
        for (int m = 0; m < 4; ++m) { const size_t off = (size_t)(u.pm * BM + wr * 64 + m * 16 + fr) * ldc + col0;
#pragma unroll
            for (int bj = 0; bj < 2; ++bj)
#pragma unroll
                for (int n = 0; n < 2; ++n) pre[m][bj][n] = *(const f32x4*)(base + off + bj * HALF + n * 16); }
        const bool bad = st.run(acc, u, wr, wc, fr, fq, lds, wid, lane) || poison != 0u;
        const float qnan = __builtin_nanf("");
#pragma unroll
        for (int ai = 0; ai < 2; ++ai)
#pragma unroll
            for (int m = 0; m < 4; ++m) { const int r = ai * HALF + wr * 64 + m * 16 + fr; const f32x2v sr = S[r]; const size_t off = (size_t)(u.pm * BM + r) * ldc + col0;
#pragma unroll
                for (int bj = 0; bj < 2; ++bj)
#pragma unroll
                    for (int n = 0; n < 2; ++n) { const f32x4 bs = ai == 0 ? pre[m][bj][n] : *(const f32x4*)(base + off + bj * HALF + n * 16); f32x4 o = bs + (acc[ai][bj][m][n] - sr.x) * sr.y;
                        if (bad) o = (f32x4){qnan, qnan, qnan, qnan}; *(f32x4*)(out + off + bj * HALF + n * 16) = o; }
                if (m & 1) asm volatile("" ::: "memory"); }
    }
};
struct EpiLnResLn {
    static constexpr bool PERM = false, AFTER_DRAIN = true;
    const float* base; float* out; bf16_t* xn; int ldc; const float* bias; PanelStats st1, st2; unsigned poison;
    __device__ __forceinline__ void fused(f32x4 (&acc)[2][2][4][2], const Unit& u, int wr, int wc, int fr, int fq, PG8_LAS unsigned char* lds, int wid, int lane) const {
        typedef float f32x2v __attribute__((ext_vector_type(2))); typedef unsigned u32x2v __attribute__((ext_vector_type(2)));
        const PG8_LAS f32x2v* S = (const PG8_LAS f32x2v*)(lds + 8192);
        const int col0 = u.pn * BM + wc * 32 + 4 * fq;
#pragma unroll
        for (int bj = 0; bj < 2; ++bj)
#pragma unroll
            for (int n = 0; n < 2; ++n) { const f32x4 bv = bias ? *(const f32x4*)(bias + col0 + bj * HALF + n * 16) : (f32x4){0.f, 0.f, 0.f, 0.f};
#pragma unroll
                for (int ai = 0; ai < 2; ++ai)
#pragma unroll
                    for (int m = 0; m < 4; ++m) acc[ai][bj][m][n] += bv; }
        bool bad = st1.run(acc, u, wr, wc, fr, fq, lds, wid, lane) || poison != 0u;
        const float qnan = __builtin_nanf("");
#pragma unroll
        for (int ai = 0; ai < 2; ++ai)
#pragma unroll
            for (int m = 0; m < 4; ++m) { const int r = ai * HALF + wr * 64 + m * 16 + fr; const f32x2v sr = S[r]; const size_t off = (size_t)(u.pm * BM + r) * ldc + col0;
#pragma unroll
                for (int bj = 0; bj < 2; ++bj)
#pragma unroll
                    for (int n = 0; n < 2; ++n) { const f32x4 bs = *(const f32x4*)(base + off + bj * HALF + n * 16); acc[ai][bj][m][n] = bs + (acc[ai][bj][m][n] - sr.x) * sr.y; }
                asm volatile("" : "+v"(acc[ai][0][m][0]), "+v"(acc[ai][0][m][1]), "+v"(acc[ai][1][m][0]), "+v"(acc[ai][1][m][1]));
                if (m & 1) asm volatile("" ::: "memory"); }
        const bool bad1 = bad;
        bad = st2.run(acc, u, wr, wc, fr, fq, lds, wid, lane) || bad;
#pragma unroll
        for (int ai = 0; ai < 2; ++ai)
#pragma unroll
            for (int m = 0; m < 4; ++m) { const int r = ai * HALF + wr * 64 + m * 16 + fr; const f32x2v sr = S[r]; const size_t off = (size_t)(u.pm * BM + r) * ldc + col0;
#pragma unroll
                for (int bj = 0; bj < 2; ++bj)
#pragma unroll
                    for (int n = 0; n < 2; ++n) { const f32x4 x1 = acc[ai][bj][m][n]; *(f32x4*)(out + off + bj * HALF + n * 16) = bad1 ? (f32x4){qnan, qnan, qnan, qnan} : x1;
                        const f32x4 o = (x1 - sr.x) * sr.y; u32x2v w; w.x = cvt_pk_bf16(o[0], o[1]); w.y = cvt_pk_bf16(o[2], o[3]);
                        if (bad) { w.x = 0x7fc07fc0u; w.y = 0x7fc07fc0u; } *(u32x2v*)(xn + off + bj * HALF + n * 16) = w; }
                asm volatile("" ::: "memory"); }
    }
};

template <class Epi, class Sched, bool ALIGN_EPI = false, bool SP2 = false>
__device__ __forceinline__ void gemm_phase(PG8_LAS unsigned char* lds, const Gemm g, const Sched& S, const Epi& E, int wv) {
    int tid0_ = threadIdx.x; asm volatile("" : "+v"(tid0_)); (void)wv;
    const int tid = tid0_, wid = __builtin_amdgcn_readfirstlane(tid >> 6), lane = tid & 63, wr = wid >> 2, wc = wid & 3, fr = lane & 15, fq = lane >> 4;
    const int K = g.K, nt = K / BK;
    unsigned voffA[2], voffB[2];
#pragma unroll
    for (int i = 0; i < 2; ++i) { int R, C; stage_rc(tid * 16 + i * 8192, R, C); const int Rb = Epi::PERM ? ((R & ~31) + perm32(R & 31)) : R;
        voffA[i] = (unsigned)(R * K + C) * 2u; voffB[i] = (unsigned)(Rb * K + C) * 2u; }
    const size_t kstep = (size_t)(BK * 2);
    const size_t hstep = (size_t)HALF * K * 2;
    const size_t tstep = 2 * hstep;
    const unsigned ldsw = (unsigned)wid * 1024u;
    const int aoff = lds_byte(wr * 64 + fr, fq * 8), boff = lds_byte(wc * 32 + fr, fq * 8);
#define PG8_SA(b, h) (((b) * 2 + (h)) * HTB)
#define PG8_SB(b, h) ((4 + (b) * 2 + (h)) * HTB)
#define PG8_STAGE(bufoff, gbase, voff) do { _Pragma("unroll") for (int _i = 0; _i < 2; ++_i) \
        __builtin_amdgcn_global_load_lds((const unsigned*)((const char*)(gbase) + (voff)[_i]), (PG8_LAS unsigned*)(lds + (bufoff) + ldsw + _i * 8192), 16, 0, 0); } while (0)
#define PG8_LDA(dst, b, h) do { _Pragma("unroll") for (int m = 0; m < 4; ++m) _Pragma("unroll") for (int k = 0; k < 2; ++k) dst[m][k] = *(const PG8_LAS bf16x8*)(lds + PG8_SA(b, h) + aoff + m * 2048 + k * 1024); } while (0)
#define PG8_LDB(dst, b, h) do { _Pragma("unroll") for (int n = 0; n < 2; ++n) _Pragma("unroll") for (int k = 0; k < 2; ++k) dst[n][k] = *(const PG8_LAS bf16x8*)(lds + PG8_SB(b, h) + boff + n * 2048 + k * 1024); } while (0)
#define PG8_MMA(ai, bj, At, Bt) do { __builtin_amdgcn_s_setprio(1); _Pragma("unroll") for (int m = 0; m < 4; ++m) _Pragma("unroll") for (int n = 0; n < 2; ++n) _Pragma("unroll") for (int k = 0; k < 2; ++k) \
        acc[ai][bj][m][n] = __builtin_amdgcn_mfma_f32_16x16x32_bf16(Bt[n][k], At[m][k], acc[ai][bj][m][n], 0, 0, 0); __builtin_amdgcn_s_setprio(0); } while (0)
#define PG8_WAIT_V(n) asm volatile("s_waitcnt vmcnt(" #n ")" ::: "memory")
#define PG8_WAIT_L(n) asm volatile("s_waitcnt lgkmcnt(" #n ")" ::: "memory")
#define PG8_BAR __builtin_amdgcn_s_barrier()
#define PG8_SCHED __builtin_amdgcn_sched_barrier(0)
    Unit cur, nxt; int ui = 0;
    if (!S.next(0, cur)) return;
    f32x4 acc[2][2][4][2];
#pragma unroll
    for (int a = 0; a < 2; ++a)
#pragma unroll
        for (int b = 0; b < 2; ++b)
#pragma unroll
            for (int m = 0; m < 4; ++m)
#pragma unroll
                for (int n = 0; n < 2; ++n) acc[a][b][m][n] = (f32x4){0.f, 0.f, 0.f, 0.f};
    bf16x8 At[4][2], B0[2][2], B1[2][2];
    const char* cA = (const char*)g.A + (size_t)cur.pm * tstep; const char* cB = (const char*)g.Bt + (size_t)cur.pn * tstep;
    S.a_ready(cur);
    if constexpr (SP2) {
        PG8_STAGE(PG8_SB(0, 0), cB, voffB); PG8_STAGE(PG8_SB(0, 1), cB + hstep, voffB); PG8_STAGE(PG8_SA(0, 0), cA, voffA); PG8_STAGE(PG8_SA(0, 1), cA + hstep, voffA);
        if (wr == 1) PG8_BAR;
        PG8_WAIT_V(2); PG8_BAR;
        PG8_STAGE(PG8_SB(1, 0), cB + kstep, voffB); PG8_STAGE(PG8_SA(1, 0), cA + kstep, voffA); PG8_STAGE(PG8_SB(1, 1), cB + hstep + kstep, voffB);
        PG8_WAIT_V(6); PG8_BAR;
    } else {
        PG8_STAGE(PG8_SB(0, 0), cB, voffB); PG8_STAGE(PG8_SA(0, 0), cA, voffA); PG8_STAGE(PG8_SB(0, 1), cB + hstep, voffB); PG8_STAGE(PG8_SA(0, 1), cA + hstep, voffA);
        if (wr == 1) PG8_BAR;
        PG8_WAIT_V(4); PG8_BAR;
        PG8_STAGE(PG8_SB(1, 0), cB + kstep, voffB); PG8_STAGE(PG8_SA(1, 0), cA + kstep, voffA); PG8_STAGE(PG8_SB(1, 1), cB + hstep + kstep, voffB);
        PG8_WAIT_V(6); PG8_BAR;
    }
    for (;;) {
        const bool has_next = S.next(ui + 1, nxt);
        const char* nA = has_next ? (const char*)g.A + (size_t)nxt.pm * tstep : cA; const char* nB = has_next ? (const char*)g.Bt + (size_t)nxt.pn * tstep : cB;
        for (int t = 0; t < nt; t += 2) {
            const bool last = (t == nt - 2);
            const char* a1 = cA + (size_t)(t + 1) * kstep;
            const char* a2 = last ? nA : cA + (size_t)(t + 2) * kstep; const char* b2 = last ? nB : cB + (size_t)(t + 2) * kstep;
            const char* a3 = a2 + kstep; const char* b3 = b2 + kstep;
            if (last && has_next) S.a_ready(nxt);
            if constexpr (SP2) {
            PG8_LDB(B0, 0, 0); PG8_LDB(B1, 0, 1); PG8_SCHED; PG8_LDA(At, 0, 0); PG8_STAGE(PG8_SA(1, 1), a1 + hstep, voffA);
            PG8_WAIT_V(8); PG8_WAIT_L(0); PG8_BAR; PG8_MMA(0, 0, At, B0); PG8_MMA(0, 1, At, B1); PG8_BAR; PG8_SCHED;
            PG8_LDA(At, 0, 1); PG8_STAGE(PG8_SB(0, 0), b2, voffB); PG8_STAGE(PG8_SB(0, 1), b2 + hstep, voffB); PG8_STAGE(PG8_SA(0, 0), a2, voffA);
            PG8_WAIT_V(8); PG8_WAIT_L(0); PG8_BAR; PG8_MMA(1, 0, At, B0); PG8_MMA(1, 1, At, B1); PG8_BAR; PG8_SCHED;
            PG8_LDB(B0, 1, 0); PG8_LDB(B1, 1, 1); PG8_SCHED; PG8_LDA(At, 1, 0); PG8_STAGE(PG8_SA(0, 1), a2 + hstep, voffA);
            PG8_WAIT_V(8); PG8_WAIT_L(0); PG8_BAR; PG8_MMA(0, 0, At, B0); PG8_MMA(0, 1, At, B1); PG8_BAR; PG8_SCHED;
            PG8_LDA(At, 1, 1); PG8_STAGE(PG8_SB(1, 0), b3, voffB); PG8_STAGE(PG8_SB(1, 1), b3 + hstep, voffB); PG8_STAGE(PG8_SA(1, 0), a3, voffA);
            PG8_WAIT_V(8); PG8_WAIT_L(0); PG8_BAR; PG8_MMA(1, 0, At, B0); PG8_MMA(1, 1, At, B1); PG8_BAR; PG8_SCHED;
            } else {
            PG8_LDB(B0, 0, 0); PG8_SCHED; PG8_LDA(At, 0, 0); PG8_STAGE(PG8_SA(1, 1), a1 + hstep, voffA);
            PG8_WAIT_L(8); PG8_BAR; PG8_WAIT_L(0); PG8_MMA(0, 0, At, B0); PG8_BAR; PG8_SCHED;
            PG8_LDB(B1, 0, 1); PG8_STAGE(PG8_SB(0, 0), b2, voffB);
            PG8_BAR; PG8_WAIT_L(0); PG8_MMA(0, 1, At, B1); PG8_BAR;
            PG8_LDA(At, 0, 1); PG8_STAGE(PG8_SA(0, 0), a2, voffA);
            PG8_BAR; PG8_WAIT_L(0); PG8_MMA(1, 0, At, B0); PG8_BAR; PG8_SCHED;
            PG8_STAGE(PG8_SB(0, 1), b2 + hstep, voffB);
            PG8_WAIT_V(6); PG8_BAR; PG8_MMA(1, 1, At, B1); PG8_BAR;
            PG8_LDB(B0, 1, 0); PG8_SCHED; PG8_LDA(At, 1, 0); PG8_STAGE(PG8_SA(0, 1), a2 + hstep, voffA);
            PG8_WAIT_L(8); PG8_BAR; PG8_WAIT_L(0); PG8_MMA(0, 0, At, B0); PG8_BAR; PG8_SCHED;
            PG8_LDB(B1, 1, 1); PG8_STAGE(PG8_SB(1, 0), b3, voffB);
            PG8_BAR; PG8_WAIT_L(0); PG8_MMA(0, 1, At, B1); PG8_BAR;
            PG8_LDA(At, 1, 1); PG8_STAGE(PG8_SA(1, 0), a3, voffA);
            PG8_BAR; PG8_WAIT_L(0); PG8_MMA(1, 0, At, B0); PG8_BAR; PG8_SCHED;
            PG8_STAGE(PG8_SB(1, 1), b3 + hstep, voffB);
            PG8_WAIT_V(6); PG8_BAR; PG8_MMA(1, 1, At, B1); PG8_BAR;
            }
        }
        if constexpr (ALIGN_EPI) { if (wr == 0) PG8_BAR; }
        if constexpr (!Epi::AFTER_DRAIN) { E(acc, cur, wr, wc, fr, fq); S.done(cur); }
        if (!has_next) break;
#pragma unroll
        for (int a = 0; a < 2; ++a)
#pragma unroll
            for (int b = 0; b < 2; ++b)
#pragma unroll
                for (int m = 0; m < 4; ++m)
#pragma unroll
                    for (int n = 0; n < 2; ++n) acc[a][b][m][n] = (f32x4){0.f, 0.f, 0.f, 0.f};
        cur = nxt; cA = nA; cB = nB; ++ui;
        if constexpr (ALIGN_EPI) { if (wr == 1) PG8_BAR; }
    }
    PG8_WAIT_V(0);
    if constexpr (!ALIGN_EPI) { if (wr == 0) PG8_BAR; }
    PG8_BAR;
    if constexpr (Epi::AFTER_DRAIN) { E.fused(acc, cur, wr, wc, fr, fq, lds, wid, lane); S.done(cur); }
#undef PG8_SA
#undef PG8_SB
#undef PG8_STAGE
#undef PG8_LDA
#undef PG8_LDB
#undef PG8_MMA
#undef PG8_WAIT_V
#undef PG8_WAIT_L
#undef PG8_BAR
#undef PG8_SCHED
}
}

#ifndef PG8_SP2
#define PG8_SP2 true
#endif
#ifndef PG8_ALIGN
#define PG8_ALIGN true
#endif
#define GAS __attribute__((address_space(1)))
#define LAS __attribute__((address_space(3)))
#define XB_TMO      128
#define XB_XCNT(j)  (256  + 64 * (j))
#define XB_XSUB(j)  (1280 + 64 * (j))
#define XB_XGEN(j)  (2304 + 64 * (j))
#define XB_TOP      3328
#define XB_TOPGEN   3392
#define XCD_BAR_WORDS 3456
#define XB_SPIN_CAP (1u << 18)

__device__ __forceinline__ unsigned xb_ld(unsigned* p)              { return __hip_atomic_load(p, __ATOMIC_RELAXED, __HIP_MEMORY_SCOPE_AGENT); }
__device__ __forceinline__ unsigned xb_add(unsigned* p, unsigned v) { return __hip_atomic_fetch_add(p, v, __ATOMIC_RELAXED, __HIP_MEMORY_SCOPE_AGENT); }
__device__ __forceinline__ unsigned xb_xcc_id() { return (unsigned)__builtin_amdgcn_s_getreg((3 << 11) | 20) & 0xFu; }
#define XB_SPIN(cond, bar) do { unsigned _sp = 0; while (cond) { __builtin_amdgcn_s_sleep(1); \
    if ((++_sp & 255u) == 0u) { if (xb_ld(&(bar)[XB_TMO])) break; if (_sp > XB_SPIN_CAP) { atomicAdd(&(bar)[XB_TMO], 1u); break; } } } } while (0)

struct XcdBarrier {
    unsigned* bar; unsigned x;
    volatile LAS unsigned* st;
    int wv;
};

__device__ __forceinline__ XcdBarrier xcd_barrier_post(unsigned* bar, volatile LAS unsigned* st) {
    XcdBarrier b; b.bar = bar; b.x = xb_xcc_id(); b.st = st;
    if (threadIdx.x == 0) (void)xb_add(&bar[XB_XCNT(b.x)], 1u);
    return b;
}
__device__ __forceinline__ void xcd_barrier_complete(unsigned* bar, unsigned x, unsigned& nloc, unsigned& nx) {
    asm volatile("" : "+s"(x));
    const unsigned G = gridDim.x * gridDim.y * gridDim.z;
    unsigned sum, cnt, mine, sp = 0u;
    for (;;) {
        sum = 0u; cnt = 0u; mine = 0u;
#pragma unroll
        for (unsigned j = 0; j < 16; ++j) { const unsigned c = xb_ld(&bar[XB_XCNT(j)]); sum += c; cnt += (c > 0u) ? 1u : 0u; mine = (j == x) ? c : mine; }
        if (sum == G) break;
        __builtin_amdgcn_s_sleep(1);
        if ((++sp & 255u) == 0u) { if (xb_ld(&bar[XB_TMO])) break; if (sp > XB_SPIN_CAP) { atomicAdd(&bar[XB_TMO], 1u); break; } }
    }
    nloc = mine > 0u ? mine : 1u; nx = cnt > 0u ? cnt : 1u;
}

__device__ __forceinline__ void xcd_barrier(const XcdBarrier& b) {
    asm volatile("s_waitcnt vmcnt(0)" ::: "memory");
    __syncthreads();
    if (threadIdx.x == 0) {
        unsigned* bar = b.bar; asm volatile("" : "+s"(bar));
        __builtin_amdgcn_s_waitcnt(0);
        unsigned nloc = b.st[0], nx = b.st[1];
        if (nloc == 0u) { xcd_barrier_complete(bar, b.x, nloc, nx); b.st[0] = nloc; b.st[1] = nx; }
        const unsigned old = xb_add(&bar[XB_XSUB(b.x)], 1u);
        const unsigned gen = old / nloc;
        if (old + 1u == (gen + 1u) * nloc) {
            __builtin_amdgcn_fence(__ATOMIC_RELEASE, "agent");
            asm volatile("s_waitcnt vmcnt(0)" ::: "memory");
            const unsigned og = xb_add(&bar[XB_TOP], 1u);
            const unsigned tg = og / nx;
            if (og + 1u == (tg + 1u) * nx) xb_add(&bar[XB_TOPGEN], 1u);
            else XB_SPIN(xb_ld(&bar[XB_TOPGEN]) == tg, bar);
            __builtin_amdgcn_fence(__ATOMIC_ACQUIRE, "agent");
            xb_add(&bar[XB_XGEN(b.x)], 1u);
            asm volatile("s_waitcnt vmcnt(0)" ::: "memory");
        } else {
            XB_SPIN(xb_ld(&bar[XB_XGEN(b.x)]) == gen, bar);
            __builtin_amdgcn_fence(__ATOMIC_ACQUIRE, "agent");
            asm volatile("s_waitcnt vmcnt(0)" ::: "memory");
        }
    }
    __syncthreads();
}
namespace dattn {
constexpr int D = 128, QST = 2048, KVS = 512, OST = 2048, MTW = 68, JLO = 3;
constexpr float THR = 8.f; constexpr bool WSKIP = false;
typedef unsigned short bf16;
constexpr float SCALE = 1.0f;
constexpr int NW = 8, QBLK = 32, KVBLK = 64, QB = NW * QBLK;
constexpr int SHM_V = KVBLK * D * 2, SHM_K = KVBLK * D * 2;
constexpr int LDS_BYTES = 2 * SHM_V + 2 * SHM_K + NW * 64 * 4;

typedef short bf16x8 __attribute__((ext_vector_type(8)));
typedef short s16x4 __attribute__((ext_vector_type(4)));
typedef float f32x16 __attribute__((ext_vector_type(16)));
typedef float f32x4 __attribute__((ext_vector_type(4)));
typedef unsigned u32x4 __attribute__((ext_vector_type(4)));
template <class A, class Bt> struct same_t { static constexpr bool v = false; };
template <class A> struct same_t<A, A> { static constexpr bool v = true; };

#define KSWZ(row, colB) ((row) * 256 + ((colB) ^ (((row) & 7) << 4)))
#define SBAR() __builtin_amdgcn_sched_barrier(0)
__device__ __forceinline__ int v_st(int k, int c) { const int kk = (k & ~0xC) | ((k & 4) << 1) | ((k & 8) >> 1); return ((kk >> 3) * 4 + (c >> 5)) * 512 + ((kk & 7) * 32 + (c & 31)) * 2; }
__device__ __forceinline__ int v_rd_base(int lane) { return ((lane & 3) << 3) | (((lane >> 2) & 3) << 6) | (((lane >> 4) & 1) << 5) | (((lane >> 5) & 1) << 8); }
constexpr int v_rd_off(int d0, int ks, int half) { return d0 * 512 + ks * 4096 + half * 2048; }
__device__ __forceinline__ int crow(int r, int hi) { return (r & 3) + 8 * (r >> 2) + 4 * hi; }
__device__ __forceinline__ unsigned cvtpk(float lo, float hi) {
    unsigned r; asm volatile("v_cvt_pk_bf16_f32 %0, %1, %2" : "=v"(r) : "v"(lo), "v"(hi)); return r;
}
__device__ __forceinline__ bf16x8 pack8(f32x4 a, f32x4 b) {
    u32x4 w = {cvtpk(a[0], a[1]), cvtpk(a[2], a[3]), cvtpk(b[0], b[1]), cvtpk(b[2], b[3])};
    return *reinterpret_cast<bf16x8*>(&w);
}
template <class T> __device__ __forceinline__ bf16x8 load8(const T* p) {
    if constexpr (same_t<T, float>::v) { return pack8(*(const f32x4*)p, *(const f32x4*)(p + 4)); }
    else { return *reinterpret_cast<const bf16x8*>(p); }
}
__device__ __forceinline__ void mask_tile(f32x16& p0, f32x16& p1, int dq, unsigned W) {
    const float NEG = -__builtin_inff();
#pragma unroll
    for (int r = 0; r < 16; ++r) {
        const int c = (r & 3) + 8 * (r >> 2);
        if ((unsigned)(dq - c) >= W) p0[r] = NEG;
        if ((unsigned)(dq - c - 32) >= W) p1[r] = NEG;
    }
}
__device__ __forceinline__ void mask_bits(f32x16& p0, f32x16& p1, unsigned long long mw, int hi) {
    const float NEG = -__builtin_inff();
    const unsigned lo = (unsigned)(mw >> (4 * hi)), up = (unsigned)(mw >> (32 + 4 * hi));
#pragma unroll
    for (int r = 0; r < 16; ++r) {
        const int c = (r & 3) + 8 * (r >> 2);
        if (!((lo >> c) & 1u)) p0[r] = NEG;
        if (!((up >> c) & 1u)) p1[r] = NEG;
    }
}
__device__ __forceinline__ void partialSM(f32x16& p0, f32x16& p1, float& m_reg, float& mn, float& alpha) {
    float pmax = p0[0]; for (int r = 1; r < 16; ++r) pmax = fmaxf(pmax, p0[r]); for (int r = 0; r < 16; ++r) pmax = fmaxf(pmax, p1[r]);
    { auto rr = __builtin_amdgcn_permlane32_swap(__float_as_uint(pmax), __float_as_uint(pmax), false, false);
      pmax = fmaxf(__uint_as_float(rr[0]), __uint_as_float(rr[1])); }
    constexpr float C2 = 1.4426950408889634f * SCALE;
    if (__builtin_expect(__all((pmax - m_reg) * SCALE <= THR), 1)) { mn = m_reg; alpha = 1.f; }
    else { mn = fmaxf(m_reg, pmax); alpha = __builtin_amdgcn_exp2f((m_reg - mn) * C2); m_reg = mn; }
    const float mnL = -mn * C2;
    for (int r = 0; r < 16; ++r) p0[r] = fmaf(p0[r], C2, mnL); for (int r = 0; r < 16; ++r) p1[r] = fmaf(p1[r], C2, mnL);
    for (int r = 0; r < 16; ++r) p0[r] = __builtin_amdgcn_exp2f(p0[r]);
}
__device__ __forceinline__ void finishSM(f32x16& p0, f32x16& p1, float alpha, float& l_reg, bf16x8& pa0, bf16x8& pa1, bf16x8& pa2, bf16x8& pa3) {
    for (int r = 0; r < 16; ++r) p1[r] = __builtin_amdgcn_exp2f(p1[r]);
    float ps = 0; for (int r = 0; r < 16; ++r) ps += p0[r]; for (int r = 0; r < 16; ++r) ps += p1[r];
    { auto rr = __builtin_amdgcn_permlane32_swap(__float_as_uint(ps), __float_as_uint(ps), false, false);
      ps = __uint_as_float(rr[0]) + __uint_as_float(rr[1]); }
    l_reg = l_reg * alpha + ps;
#define PK4(P, B_, OUT) do { unsigned a0 = cvtpk(P[B_+0], P[B_+1]), a1 = cvtpk(P[B_+2], P[B_+3]);                          \
        unsigned b0 = cvtpk(P[B_+4], P[B_+5]), b1 = cvtpk(P[B_+6], P[B_+7]);                                             \
        auto r0 = __builtin_amdgcn_permlane32_swap(a0, b0, false, false); auto r1 = __builtin_amdgcn_permlane32_swap(a1, b1, false, false); \
        u32x4 w = {r0[0], r1[0], r0[1], r1[1]}; OUT = *reinterpret_cast<bf16x8*>(&w); } while (0)
    PK4(p0, 0, pa0); PK4(p0, 8, pa1); PK4(p1, 0, pa2); PK4(p1, 8, pa3);
#undef PK4
}
template <int KB, bool SK>
__device__ __forceinline__ void qkt(f32x16& p0, f32x16& p1, const char* K_lds, int r32, int hi, const bf16x8* qr, bool act) {
    if (SK && !act) { const float NEG = -__builtin_inff();
#pragma unroll
        for (int r = 0; r < 16; ++r) { p0[r] = NEG; p1[r] = NEG; } return; }
    p0 = f32x16{}; p1 = f32x16{};
    const char* kb[4];
#pragma unroll
    for (int dd = 0; dd < 4; ++dd) kb[dd] = K_lds + KB * SHM_K + KSWZ(r32, (dd * 16 + hi * 8) * 2);
#pragma unroll
    for (int d0 = 0; d0 < 8; ++d0) { const char* a = kb[d0 & 3] + (d0 >> 2) * 128;
        bf16x8 b0 = *reinterpret_cast<const bf16x8*>(a);
        bf16x8 b1 = *reinterpret_cast<const bf16x8*>(a + 32 * 256);
        p0 = __builtin_amdgcn_mfma_f32_32x32x16_bf16(b0, qr[d0], p0, 0, 0, 0);
        p1 = __builtin_amdgcn_mfma_f32_32x32x16_bf16(b1, qr[d0], p1, 0, 0, 0); }
}
template <int VB, bool SK>
__device__ __forceinline__ void pv_tile(f32x16* o, int vb0, bf16x8 pa0, bf16x8 pa1, bf16x8 pa2, bf16x8 pa3, bool act) {
    if (SK && !act) return;
#define TRRD(dst, off) asm volatile("ds_read_b64_tr_b16 %0, %1 offset:%2" : "=&v"(dst) : "v"(vb0), "i"(off) : "memory")
#define PV_D0(d0) do { s16x4 l0, l1, l2, l3, h0, h1, h2, h3; constexpr int b_ = VB * SHM_V + v_rd_off(d0, 0, 0);     \
        TRRD(l0, b_); TRRD(h0, b_ + 2048); TRRD(l1, b_ + 4096); TRRD(h1, b_ + 6144); TRRD(l2, b_ + 8192); TRRD(h2, b_ + 10240); TRRD(l3, b_ + 12288); TRRD(h3, b_ + 14336); \
        asm volatile("s_waitcnt lgkmcnt(0)" ::: "memory"); SBAR();                 \
        o[d0] = __builtin_amdgcn_mfma_f32_32x32x16_bf16(pa0, (bf16x8){l0[0], l0[1], l0[2], l0[3], h0[0], h0[1], h0[2], h0[3]}, o[d0], 0, 0, 0);   \
        o[d0] = __builtin_amdgcn_mfma_f32_32x32x16_bf16(pa1, (bf16x8){l1[0], l1[1], l1[2], l1[3], h1[0], h1[1], h1[2], h1[3]}, o[d0], 0, 0, 0);   \
        o[d0] = __builtin_amdgcn_mfma_f32_32x32x16_bf16(pa2, (bf16x8){l2[0], l2[1], l2[2], l2[3], h2[0], h2[1], h2[2], h2[3]}, o[d0], 0, 0, 0);   \
        o[d0] = __builtin_amdgcn_mfma_f32_32x32x16_bf16(pa3, (bf16x8){l3[0], l3[1], l3[2], l3[3], h3[0], h3[1], h3[2], h3[3]}, o[d0], 0, 0, 0); } while (0)
    PV_D0(0); PV_D0(1); PV_D0(2); PV_D0(3);
#undef PV_D0
#undef TRRD
}

template <class TIn, class TOut> struct BlockRef { const TIn* Q; const TIn* K; const TIn* V; TOut* O; const unsigned long long* M; int P0; };
template <class TIn> struct Seam {
    bf16x8 qr[8];
    bf16x8 st_v0, st_v1, st_k0, st_k1; f32x4 sf0, sf1, sf2, sf3;
    f32x4 tq[16];
};
__device__ __forceinline__ int swa_jlo(int, int) { return JLO; }
#define ROW(p, k0, rr) ((p) + (size_t)((k0) + (rr)) * KVS + sc)
#define VMW() asm volatile("s_waitcnt vmcnt(0)" ::: "memory")
#define VMWN(n) asm volatile("s_waitcnt vmcnt(%0)" :: "i"(n) : "memory")
#define SLOAD_H(Kp, Vp, k0) do { S.st_v0 = load8<TIn>(ROW(Vp, k0, sr)); S.st_v1 = load8<TIn>(ROW(Vp, k0, 32 + sr));              \
                         S.st_k0 = load8<TIn>(ROW(Kp, k0, sr)); S.st_k1 = load8<TIn>(ROW(Kp, k0, 32 + sr)); } while (0)
#define SWRITE_HK(bf) do { *(bf16x8*)(K_lds + (bf) * SHM_K + kws) = S.st_k0; *(bf16x8*)(K_lds + (bf) * SHM_K + kws + 32 * 256) = S.st_k1; } while (0)
#define SWRITE_HV(bf) do { *(bf16x8*)(V_lds + (bf) * SHM_V + vst0) = S.st_v0; *(bf16x8*)(V_lds + (bf) * SHM_V + vst1) = S.st_v1; } while (0)
#define SWRITE_H(bf) do { SWRITE_HV(bf); SWRITE_HK(bf); } while (0)
#define SLOAD_F(p, k0) do { S.sf0 = *(const f32x4*)ROW(p, k0, sr); S.sf1 = *(const f32x4*)(ROW(p, k0, sr) + 4);                \
                            S.sf2 = *(const f32x4*)ROW(p, k0, 32 + sr); S.sf3 = *(const f32x4*)(ROW(p, k0, 32 + sr) + 4); } while (0)
#define SWRITE_KF(bf) do { *(bf16x8*)(K_lds + (bf) * SHM_K + kws) = pack8(S.sf0, S.sf1); *(bf16x8*)(K_lds + (bf) * SHM_K + kws + 32 * 256) = pack8(S.sf2, S.sf3); } while (0)
#define SWRITE_VF(bf) do { *(bf16x8*)(V_lds + (bf) * SHM_V + vst0) = pack8(S.sf0, S.sf1); *(bf16x8*)(V_lds + (bf) * SHM_V + vst1) = pack8(S.sf2, S.sf3); } while (0)
template <class TIn, class TOut>
__device__ __forceinline__ void causal_swa_prime(const BlockRef<TIn, TOut>& cur, int W, char* lds, Seam<TIn>& S, int wv) {
    constexpr bool F32 = same_t<TIn, float>::v;
    int tid0_ = threadIdx.x; asm volatile("" : "+v"(tid0_)); (void)wv;
    const int tid = tid0_, wid = __builtin_amdgcn_readfirstlane(tid >> 6), lane = tid & 63, r32 = lane & 31, hi = lane >> 5;
    const int sr = tid >> 4, sc = (tid & 15) * 8, kws = KSWZ(sr, sc * 2); char* K_lds = lds + 2 * SHM_V;
    const int kb0 = swa_jlo(cur.P0, W) * KVBLK;
    for (int d0 = 0; d0 < 8; ++d0) S.qr[d0] = load8<TIn>(cur.Q + (size_t)(wid * QBLK + r32) * QST + d0 * 16 + hi * 8);
    if constexpr (F32) { SLOAD_F((const float*)cur.K, kb0); VMW(); SWRITE_KF(0); SBAR(); SLOAD_F((const float*)cur.V, kb0); }
    else { SLOAD_H(cur.K, cur.V, kb0); VMW(); SWRITE_HK(0); }
    __syncthreads();
}
template <class TIn, class TOut>
__device__ __forceinline__ void causal_swa_block(const BlockRef<TIn, TOut>& cur, const BlockRef<TIn, TOut>& nxt, int skv, int W, char* lds, Seam<TIn>& S, int wv) {
    constexpr bool F32 = same_t<TIn, float>::v;
    int tid0_ = threadIdx.x; asm volatile("" : "+v"(tid0_)); (void)wv;
    const int tid = tid0_, wid = __builtin_amdgcn_readfirstlane(tid >> 6), lane = tid & 63, r32 = lane & 31, hi = lane >> 5;
    const int j_lo = swa_jlo(cur.P0, W);
    int j_hi = (cur.P0 + QB - 1) / KVBLK + 1; if (j_hi > skv / KVBLK) j_hi = skv / KVBLK;
    const int NT = j_hi - j_lo;
    const int kbn = swa_jlo(nxt.P0, W) * KVBLK;
    const int qlo = cur.P0 + wid * QBLK; (void)qlo;
    const unsigned long long* mrow = cur.M + (size_t)(wid * QBLK + r32) * MTW;
    const int qm_unused = 0; (void)qm_unused;
    char* V_lds = lds; char* K_lds = lds + 2 * SHM_V;
    float* ws = (float*)(lds + 2 * SHM_V + 2 * SHM_K) + wid * 64; float* li_l = ws, * al_l = ws + 32;
    float m_reg = -1e30f, l_reg = 0; f32x16 o[4] = {};
    const int sr = tid >> 4, sc = (tid & 15) * 8, vst0 = v_st(sr, sc), vst1 = v_st(32 + sr, sc), kws = KSWZ(sr, sc * 2);
    const int vb0 = (int)(uintptr_t)V_lds + v_rd_base(lane);
    const TIn* Kh = cur.K; const TIn* Vh = cur.V;
#define RESC(a) do { if (__any((a) < 1.f)) { if (hi == 0) al_l[r32] = (a); asm volatile("s_waitcnt lgkmcnt(0)" ::: "memory");              \
                     for (int d_ = 0; d_ < 4; ++d_) for (int r = 0; r < 16; ++r) o[d_][r] *= al_l[crow(r, hi)]; } } while (0)
#define KBASE(t) ((j_lo + (t)) * KVBLK)
#define ACT(t) (KBASE(t) <= qlo + QBLK - 1 && KBASE(t) + KVBLK - 1 >= qlo - W + 1)
#define MASKT(P0_, P1_, t) mask_bits(P0_, P1_, mrow[j_lo + (t)], hi)
    constexpr int NQL = F32 ? 16 : 8;
    constexpr bool SK = WSKIP && !F32;
#define SEAM_K0() do { VMWN(NQL); if constexpr (F32) { SWRITE_KF(0); SBAR(); SLOAD_F((const float*)nxt.V, kbn); } else { SWRITE_HK(0); } SBAR(); } while (0)
    f32x16 pA0, pA1, pB0, pB1; float mnA, mnB, alA, alB; bf16x8 pa0, pa1, pa2, pa3;
    if constexpr (F32) { VMW(); SWRITE_VF(0); SBAR(); } else { SWRITE_HV(0); SBAR(); }
    if (NT > 1) { if constexpr (F32) SLOAD_F((const float*)Kh, KBASE(1)); else SLOAD_H(Kh, Vh, KBASE(1)); }
    SBAR(); qkt<0, SK>(pA0, pA1, K_lds, r32, hi, S.qr, ACT(0));
    if constexpr (F32) { if (NT > 1) { VMW(); SWRITE_KF(1); SBAR(); SLOAD_F((const float*)Vh, KBASE(1)); } }
    MASKT(pA0, pA1, 0); partialSM(pA0, pA1, m_reg, mnA, alA);
    if (NT > 1) { VMW(); if constexpr (F32) { SWRITE_VF(1); SBAR(); if (NT > 2) SLOAD_F((const float*)Kh, KBASE(2)); } else SWRITE_H(1); }
    __syncthreads();
#define HALF_STEP(PX0, PX1, mnX, alX, PY0, PY1, alY, t, KB, VB, SB) do {                                                      \
        SBAR(); qkt<KB, SK>(PX0, PX1, K_lds, r32, hi, S.qr, ACT(t));                                             \
        finishSM(PY0, PY1, alY, l_reg, pa0, pa1, pa2, pa3); SBAR();                                                           \
        if ((t) + 1 < NT) { if constexpr (F32) { VMW(); SWRITE_KF(SB); SBAR(); SLOAD_F((const float*)Vh, KBASE((t) + 1)); }  \
                            else { SLOAD_H(Kh, Vh, KBASE((t) + 1)); } SBAR(); }                                               \
        pv_tile<VB, SK>(o, vb0, pa0, pa1, pa2, pa3, ACT((t) - 1)); MASKT(PX0, PX1, (t)); partialSM(PX0, PX1, m_reg, mnX, alX);                                        \
        __syncthreads();                                                                                                      \
        if ((t) + 1 < NT) { VMW(); if constexpr (F32) { SWRITE_VF(SB); SBAR(); if ((t) + 2 < NT) SLOAD_F((const float*)Kh, KBASE((t) + 2)); } \
                            else { SWRITE_H(SB); } }                                                                          \
        RESC(alX); __syncthreads(); } while (0)
    for (int t = 1; t + 1 < NT; t += 2) {
        HALF_STEP(pB0, pB1, mnB, alB, pA0, pA1, alA, t, 1, 0, 0);
        HALF_STEP(pA0, pA1, mnA, alA, pB0, pB1, alB, t + 1, 0, 1, 1);
    }
    const bool even = (NT & 1) == 0;
    if (even) { SBAR(); qkt<1, SK>(pB0, pB1, K_lds, r32, hi, S.qr, ACT(NT - 1)); SBAR(); }
#define QROW(e) (nxt.Q + (size_t)(wid * QBLK + r32) * QST + ((e) >> 1) * 16 + hi * 8 + ((e) & 1) * 4)
    if constexpr (F32) { SLOAD_F((const float*)nxt.K, kbn); SBAR();
#pragma unroll
        for (int e = 0; e < 8; ++e) S.tq[e] = *(const f32x4*)QROW(e); }
    else { SLOAD_H(nxt.K, nxt.V, kbn); SBAR();
#pragma unroll
        for (int d0 = 0; d0 < 8; ++d0) S.qr[d0] = load8<TIn>(nxt.Q + (size_t)(wid * QBLK + r32) * QST + d0 * 16 + hi * 8); }
    SBAR();
    finishSM(pA0, pA1, alA, l_reg, pa0, pa1, pa2, pa3); SBAR();
    if constexpr (F32) {
#pragma unroll
        for (int e = 8; e < 16; ++e) S.tq[e] = *(const f32x4*)QROW(e); SBAR(); }
#undef QROW
    pv_tile<0, SK>(o, vb0, pa0, pa1, pa2, pa3, ACT(even ? NT - 2 : NT - 1));
    if (even) { MASKT(pB0, pB1, NT - 1); partialSM(pB0, pB1, m_reg, mnB, alB); __syncthreads(); RESC(alB);
        finishSM(pB0, pB1, alB, l_reg, pa0, pa1, pa2, pa3); SBAR(); pv_tile<1, SK>(o, vb0, pa0, pa1, pa2, pa3, ACT(NT - 1)); }
    SBAR(); SEAM_K0();
    if (hi == 0) li_l[r32] = l_reg; asm volatile("s_waitcnt lgkmcnt(0)" ::: "memory");
    float rli[16];
#pragma unroll
    for (int r = 0; r < 16; ++r) rli[r] = __builtin_amdgcn_rcpf(li_l[crow(r, hi)]);
    TOut* Ow = cur.O + (size_t)(wid * QBLK) * OST;
#pragma unroll
    for (int r = 0; r < 16; ++r) { const int orow = crow(r, hi);
#pragma unroll
        for (int d0 = 0; d0 < 4; ++d0) { const float v = o[d0][r] * rli[r];
            if constexpr (same_t<TOut, float>::v) { Ow[(size_t)orow * OST + d0 * 32 + r32] = v; }
            else { const float vn = __shfl_xor(v, 1);
                   if ((r32 & 1) == 0) *(unsigned*)(Ow + (size_t)orow * OST + d0 * 32 + r32) = cvtpk(v, vn); } } }
    if constexpr (F32) {
#pragma unroll
        for (int d0 = 0; d0 < 8; ++d0) S.qr[d0] = pack8(S.tq[2 * d0], S.tq[2 * d0 + 1]); }
    __syncthreads();
#undef RESC
#undef KBASE
#undef ACT
#undef MASKT
#undef SEAM_K0
#undef HALF_STEP
}
#undef ROW
#undef VMW
#undef VMWN
#undef SLOAD_H
#undef SWRITE_HK
#undef SWRITE_HV
#undef SWRITE_H
#undef SLOAD_F
#undef SWRITE_KF
#undef SWRITE_VF

}

constexpr int NWAVES = 8, NTHREADS = 512;
constexpr int DM = 2048, SEQ = 4096, NMETA = 16, TP = 4112, NBP = 2, SBN = 8, PAST = 16384, NPG = 128;
constexpr int XROW0 = 8192, SROW0 = 8224, NROWS = 8232, MPAD = 8448, FF = 8192, MAINM = 8192, XR = 48;
constexpr int NA_IN = 6144, NB_IN = 4176, NB_PAD = 4352, NC_IN = 12352, NC_PAD = 12544, DVW = 4096, CDIM = 8192;
constexpr float ALPHA = 1.6817928305074292f;
constexpr float LN_EPS = 1e-5f, RMS_EPS = 1e-6f;
constexpr int SCW = 4160, SCSW = 16448, KIROWS = 4128, NSKEY = PAST + 1;
constexpr int POS_SAMPLE_IDX = TP;

constexpr size_t O_YP = 0, O_YS = O_YP + (size_t)NBP * SEQ * DM, O_CAP = O_YS + (size_t)SBN * DM, O_CAS = O_CAP + 2 * NBP * 2 * DM,
                 O_KP = O_CAS + 2 * SBN * 2 * DM, O_VP = O_KP + (size_t)NBP * TP * 512, O_IKP = O_VP + (size_t)NBP * TP * 512,
                 O_KS = O_IKP + (size_t)NBP * TP * 64, O_VS = O_KS + SBN * 512, O_IKS = O_VS + SBN * 512, O_CCP = O_IKS + SBN * 64,
                 O_CCS = O_CCP + (size_t)NBP * 3 * CDIM, O_DP = O_CCS + (size_t)SBN * 3 * CDIM, O_DS = O_DP + (size_t)NBP * 32 * 128 * 128,
                 O_END = O_DS + (size_t)SBN * 32 * 128 * 128;

constexpr size_t MiB = 1u << 20;
constexpr size_t WS_CTL = 0, CTL_ZERO_BYTES = 1 * MiB;
constexpr size_t WS_TAB128 = 1 * MiB, WS_TAB64 = 4 * MiB, WS_WI = 6 * MiB, WS_G = 7 * MiB, WS_BETA = 9 * MiB, WS_CNT = 11 * MiB, WS_KIB = 12 * MiB,
                 WS_SCS = 14 * MiB, WS_IDXL = 16 * MiB, WS_X = 26 * MiB, WS_QR = 60 * MiB, WS_QI = 94 * MiB, WS_Z = 112 * MiB, WS_Y = 180 * MiB,
                 WS_BIG = 248 * MiB, WS_QKVC = 452 * MiB, WS_SC = 584 * MiB, WS_W = 716 * MiB;
constexpr size_t WSZ_A_IN = (size_t)NA_IN * DM * 2, WSZ_A_OUT = (size_t)DM * DM * 2, WSZ_B_IN = (size_t)NB_PAD * DM * 2, WSZ_B_OUT = (size_t)DM * DM * 2,
                 WSZ_C_IN = (size_t)NC_PAD * DM * 2, WSZ_C_OUT = (size_t)DM * DVW * 2, WSZ_W1 = (size_t)FF * DM * 2, WSZ_W2 = (size_t)DM * FF * 2;
constexpr size_t WS_WA_IN = WS_W, WS_WA_OUT = WS_WA_IN + 2 * WSZ_A_IN, WS_WB_IN = WS_WA_OUT + 2 * WSZ_A_OUT, WS_WB_OUT = WS_WB_IN + WSZ_B_IN,
                 WS_WC_IN = WS_WB_OUT + WSZ_B_OUT, WS_WC_OUT = WS_WC_IN + WSZ_C_IN, WS_W1 = WS_WC_OUT + WSZ_C_OUT, WS_W2 = WS_W1 + 4 * WSZ_W1,
                 WS_ZP = WS_W2 + 4 * WSZ_W2, WS_QKF = WS_ZP + 4 * MiB, WS_DWG = WS_QKF + 130 * MiB, WS_DUG = WS_DWG + 66 * MiB, WS_END = WS_DUG + 66 * MiB;
constexpr size_t WS_MASK = WS_IDXL, WS_KS = WS_Z, WS_VS = WS_Z + 9 * MiB;
constexpr size_t WS_DAF = WS_Z, WS_DTG = WS_Y, WS_DTB = WS_Y + 33 * MiB, WS_DPG = WS_QR, WS_DKT = WS_QKF, WS_DVT = WS_QKF + 33 * MiB, WS_DGC = WS_QI, WS_DBT = WS_QI + 2 * MiB;
constexpr int SP = 4352, SPAD = 240, MTW = 68;
constexpr int CW_BAR = 4096;

constexpr int RING_BYTES = 131072, LDSCTL_OFF = RING_BYTES, MISC_OFF = LDSCTL_OFF + 320, LDS_BYTES = 147456;

typedef unsigned short bf16;
typedef unsigned v4u __attribute__((ext_vector_type(4)));
typedef unsigned v2u __attribute__((ext_vector_type(2)));
typedef float f32x4 __attribute__((ext_vector_type(4)));
typedef float f32x2 __attribute__((ext_vector_type(2)));
typedef short bf16x8 __attribute__((ext_vector_type(8)));
typedef float f32x16 __attribute__((ext_vector_type(16)));
typedef __bf16 bf16x2_t __attribute__((ext_vector_type(2)));

#define LDS_WAIT() asm volatile("s_waitcnt lgkmcnt(0)" ::: "memory")
#define WAVE_SYNC() do { asm volatile("s_waitcnt lgkmcnt(0)" ::: "memory"); __builtin_amdgcn_wave_barrier(); } while (0)

__device__ __forceinline__ float bflo(unsigned w) { return __uint_as_float(w << 16); }
__device__ __forceinline__ float bfhi(unsigned w) { return __uint_as_float(w & 0xffff0000u); }
__device__ __forceinline__ float bf2f(bf16 h) { return __uint_as_float((unsigned)h << 16); }
__device__ __forceinline__ unsigned pk2(float lo, float hi) { f32x2 v = {lo, hi}; bf16x2_t b = __builtin_convertvector(v, bf16x2_t); return __builtin_bit_cast(unsigned, b); }
__device__ __forceinline__ bf16 f2bf(float f) { return (bf16)(pk2(f, 0.f) & 0xffffu); }
__device__ __forceinline__ float wave_sum(float v) {
#pragma unroll
    for (int o = 1; o < 64; o <<= 1) v += __shfl_xor(v, o);
    return v;
}
__device__ __forceinline__ float wave_max(float v) {
#pragma unroll
    for (int o = 1; o < 64; o <<= 1) v = fmaxf(v, __shfl_xor(v, o));
    return v;
}
__device__ __forceinline__ int wave_sum_i(int v) {
#pragma unroll
    for (int o = 1; o < 64; o <<= 1) v += __shfl_xor(v, o);
    return v;
}
__device__ __forceinline__ float row16_sum(float v) {
    v += __int_as_float(__builtin_amdgcn_update_dpp(0, __float_as_int(v), 0x128, 0xf, 0xf, false));
    v += __int_as_float(__builtin_amdgcn_update_dpp(0, __float_as_int(v), 0x124, 0xf, 0xf, false));
    v += __int_as_float(__builtin_amdgcn_update_dpp(0, __float_as_int(v), 0x122, 0xf, 0xf, false));
    v += __int_as_float(__builtin_amdgcn_update_dpp(0, __float_as_int(v), 0x121, 0xf, 0xf, false));
    return v;
}
__device__ __forceinline__ float silu_f(float x) { return x / (1.f + __expf(-x)); }
__device__ __forceinline__ int prow(int b, int t) { return t >= NMETA ? b * SEQ + (t - NMETA) : XROW0 + b * NMETA + t; }
__device__ __forceinline__ void row_bt(int r, int& b, int& t) { if (r < XROW0) { b = r >> 12; t = (r & 4095) + NMETA; } else { b = (r - XROW0) >> 4; t = (r - XROW0) & 15; } }
__device__ __forceinline__ void unpack8(const v4u w, float (&f)[8]) {
    f[0] = bflo(w.x); f[1] = bfhi(w.x); f[2] = bflo(w.y); f[3] = bfhi(w.y); f[4] = bflo(w.z); f[5] = bfhi(w.z); f[6] = bflo(w.w); f[7] = bfhi(w.w);
}
__device__ __forceinline__ v4u pack8(const float (&f)[8]) { v4u w; w.x = pk2(f[0], f[1]); w.y = pk2(f[2], f[3]); w.z = pk2(f[4], f[5]); w.w = pk2(f[6], f[7]); return w; }

__device__ __forceinline__ void transpose_item(const float* W, int K, int N, int Npad, bf16* WT, LAS float* scr, int item, int lane) {
    const int nblk = Npad / 32, kb = item / nblk, nb = item % nblk, k0 = 64 * kb, n0 = 32 * nb;
    const int n = n0 + (lane & 31); const bool ok = n < N;
#pragma unroll 8
    for (int i = 0; i < 32; ++i) { const int kk = 2 * i + (lane >> 5); scr[kk * 33 + (lane & 31)] = ok ? W[(size_t)(k0 + kk) * N + n] : 0.f; }
    LDS_WAIT(); __builtin_amdgcn_wave_barrier();
    const int c = lane & 7;
#pragma unroll
    for (int j = 0; j < 4; ++j) { const int nn = (lane >> 3) + 8 * j; const LAS float* s = scr + (8 * c) * 33 + nn;
        v4u o; o.x = pk2(s[0 * 33], s[1 * 33]); o.y = pk2(s[2 * 33], s[3 * 33]); o.z = pk2(s[4 * 33], s[5 * 33]); o.w = pk2(s[6 * 33], s[7 * 33]);
        *(v4u*)(WT + (size_t)(n0 + nn) * K + k0 + 8 * c) = o; }
    LDS_WAIT(); __builtin_amdgcn_wave_barrier();
}

struct Ptrs {
    const float *x_prompt, *x_sample, *state_conv_a, *cache_k, *cache_v, *cache_ik, *state_conv_c, *state_delta;
    const int* page_table;
    const float *meta, *w_in_a, *conv_w_a, *w_out_a, *w_in_b, *w_out_b, *w_in_c, *conv_w_c, *a_log, *dt_bias, *norm_w, *w_out_c, *ln1_g, *ln1_b, *w1, *w2, *ln2_g, *ln2_b;
    float* out; unsigned char* ws;
};

__device__ __forceinline__ void p0_prologue(const Ptrs& P, LAS unsigned char* lds, int gw, int NGW, int wave, int lane) {
    LAS float* scr = (LAS float*)(lds + wave * 16384);
    unsigned char* ws = P.ws;
    constexpr int I_A_IN = (DM / 64) * (NA_IN / 32), I_A_OUT = (DM / 64) * (DM / 32), I_B_IN = (DM / 64) * (NB_PAD / 32), I_B_OUT = I_A_OUT,
                  I_C_IN = (DM / 64) * (NC_PAD / 32), I_C_OUT = (DVW / 64) * (DM / 32), I_W1 = (DM / 64) * (FF / 32), I_W2 = (FF / 64) * (DM / 32);
    constexpr int NITEMS = 2 * I_A_IN + 2 * I_A_OUT + I_B_IN + I_B_OUT + I_C_IN + I_C_OUT + 4 * I_W1 + 4 * I_W2;
#define TR_(cnt, Wp, Kk, Nn, Np, WTp) if (r < (cnt)) { transpose_item((Wp), (Kk), (Nn), (Np), (bf16*)(WTp), scr, r, lane); continue; } r -= (cnt);
    for (int it = gw; it < NITEMS; it += NGW) {
        int r = it;
        TR_(I_A_IN, P.w_in_a, DM, NA_IN, NA_IN, ws + WS_WA_IN)
        TR_(I_A_IN, P.w_in_a + (size_t)DM * NA_IN, DM, NA_IN, NA_IN, ws + WS_WA_IN + WSZ_A_IN)
        TR_(I_A_OUT, P.w_out_a, DM, DM, DM, ws + WS_WA_OUT)
        TR_(I_A_OUT, P.w_out_a + (size_t)DM * DM, DM, DM, DM, ws + WS_WA_OUT + WSZ_A_OUT)
        TR_(I_B_IN, P.w_in_b, DM, NB_IN, NB_PAD, ws + WS_WB_IN)
        TR_(I_B_OUT, P.w_out_b, DM, DM, DM, ws + WS_WB_OUT)
        TR_(I_C_IN, P.w_in_c, DM, NC_IN, NC_PAD, ws + WS_WC_IN)
        TR_(I_C_OUT, P.w_out_c, DVW, DM, DM, ws + WS_WC_OUT)
        TR_(I_W1, P.w1, DM, FF, FF, ws + WS_W1)
        TR_(I_W1, P.w1 + (size_t)DM * FF, DM, FF, FF, ws + WS_W1 + WSZ_W1)
        TR_(I_W1, P.w1 + 2 * (size_t)DM * FF, DM, FF, FF, ws + WS_W1 + 2 * WSZ_W1)
        TR_(I_W1, P.w1 + 3 * (size_t)DM * FF, DM, FF, FF, ws + WS_W1 + 3 * WSZ_W1)
        TR_(I_W2, P.w2, FF, DM, DM, ws + WS_W2)
        TR_(I_W2, P.w2 + (size_t)DM * FF, FF, DM, DM, ws + WS_W2 + WSZ_W2)
        TR_(I_W2, P.w2 + 2 * (size_t)DM * FF, FF, DM, DM, ws + WS_W2 + 2 * WSZ_W2)
        transpose_item(P.w2 + 3 * (size_t)DM * FF, FF, DM, DM, (bf16*)(ws + WS_W2 + 3 * WSZ_W2), scr, r, lane);
    }
#undef TR_
    bf16* X = (bf16*)(ws + WS_X);
    for (int r = gw; r < MPAD; r += NGW) {
        const float* src = nullptr;
        if (r < XROW0) src = P.x_prompt + (size_t)r * DM;
        else if (r < SROW0) src = P.meta + (size_t)((r - XROW0) & 15) * DM;
        else if (r < NROWS) src = P.x_sample + (size_t)(r - SROW0) * DM;
#pragma unroll
        for (int j = 0; j < 4; ++j) { const int c = 512 * j + 8 * lane; v4u o = {0u, 0u, 0u, 0u};
            if (src) { const f32x4 a = *(const f32x4*)(src + c), b = *(const f32x4*)(src + c + 4); o.x = pk2(a.x, a.y); o.y = pk2(a.z, a.w); o.z = pk2(b.x, b.y); o.w = pk2(b.z, b.w); }
            *(v4u*)(X + (size_t)r * DM + c) = o; }
    }
    f32x2* t128 = (f32x2*)(ws + WS_TAB128); f32x2* t64 = (f32x2*)(ws + WS_TAB64);
    const int gt = gw * 64 + lane, NGT = NGW * 64;
    for (int e = gt; e < (TP + 1) * 96; e += NGT) {
        const int pi = e / 96, i = e % 96; const float pos = (float)(pi == TP ? PAST : pi);
        const float ex = (i < 64) ? (float)(2 * i) * (1.f / 128.f) : (float)(2 * (i - 64)) * (1.f / 64.f);
        const float inv = __builtin_amdgcn_exp2f(-ex * 13.287712379549449f);
        const float angf = pos * inv;
        double rev = (double)angf * 0.15915494309189535; rev -= __builtin_rint(rev);
        const float rf = (float)rev; const float sn = __builtin_amdgcn_sinf(rf), cs = __builtin_amdgcn_cosf(rf);
        if (i < 64) t128[pi * 64 + i] = (f32x2){cs, sn}; else t64[pi * 32 + (i - 64)] = (f32x2){cs, sn};
    }
}

__device__ __forceinline__ void ln_phase(const float* Z, const float* ZP, bf16* X, const float* gam, const float* bet, float* yp, float* ys, int gw, int NGW, int lane) {
    for (int r = gw; r < NROWS; r += NGW) {
        const bool ext = r >= XROW0; const float* zr = ext ? ZP + (size_t)(r - XROW0) * DM : Z + (size_t)r * DM; bf16* xr = X + (size_t)r * DM;
        float v[32]; float s = 0.f;
#pragma unroll
        for (int j = 0; j < 4; ++j) { const int c = 512 * j + 8 * lane; f32x4 z0 = *(const f32x4*)(zr + c), z1 = *(const f32x4*)(zr + c + 4); const v4u xv = *(const v4u*)(xr + c);
            if (ext) {
#pragma unroll
                for (int sl = 1; sl < 8; ++sl) { z0 += *(const f32x4*)(zr + (size_t)sl * XR * DM + c); z1 += *(const f32x4*)(zr + (size_t)sl * XR * DM + c + 4); } }
            float xf[8]; unpack8(xv, xf);
            v[8 * j + 0] = ALPHA * xf[0] + z0.x; v[8 * j + 1] = ALPHA * xf[1] + z0.y; v[8 * j + 2] = ALPHA * xf[2] + z0.z; v[8 * j + 3] = ALPHA * xf[3] + z0.w;
            v[8 * j + 4] = ALPHA * xf[4] + z1.x; v[8 * j + 5] = ALPHA * xf[5] + z1.y; v[8 * j + 6] = ALPHA * xf[6] + z1.z; v[8 * j + 7] = ALPHA * xf[7] + z1.w;
#pragma unroll
            for (int i = 0; i < 8; ++i) s += v[8 * j + i]; }
        const float mean = wave_sum(s) * (1.f / DM); float s2 = 0.f;
#pragma unroll
        for (int i = 0; i < 32; ++i) { v[i] -= mean; s2 += v[i] * v[i]; }
        const float rstd = 1.f / sqrtf(wave_sum(s2) * (1.f / DM) + LN_EPS);
        float* of = nullptr;
        if (yp) { if (r < XROW0) of = yp + (size_t)r * DM; else if (r >= SROW0) of = ys + (size_t)(r - SROW0) * DM; }
#pragma unroll
        for (int j = 0; j < 4; ++j) { const int c = 512 * j + 8 * lane; const f32x4 g0 = *(const f32x4*)(gam + c), g1 = *(const f32x4*)(gam + c + 4), b0 = *(const f32x4*)(bet + c), b1 = *(const f32x4*)(bet + c + 4);
            float o[8];
            o[0] = v[8 * j + 0] * rstd * g0.x + b0.x; o[1] = v[8 * j + 1] * rstd * g0.y + b0.y; o[2] = v[8 * j + 2] * rstd * g0.z + b0.z; o[3] = v[8 * j + 3] * rstd * g0.w + b0.w;
            o[4] = v[8 * j + 4] * rstd * g1.x + b1.x; o[5] = v[8 * j + 5] * rstd * g1.y + b1.y; o[6] = v[8 * j + 6] * rstd * g1.z + b1.z; o[7] = v[8 * j + 7] * rstd * g1.w + b1.w;
            *(v4u*)(xr + c) = pack8(o);
            if (of) { *(f32x4*)(of + c) = (f32x4){o[0], o[1], o[2], o[3]}; *(f32x4*)(of + c + 4) = (f32x4){o[4], o[5], o[6], o[7]}; } }
    }
}

__device__ __forceinline__ void load_u(const bf16* BCH, int row, int c0, float (&u)[8]) {
    const v4u cg = *(const v4u*)(BCH + (size_t)row * NA_IN + DM + c0), hh = *(const v4u*)(BCH + (size_t)row * NA_IN + 2 * DM + c0);
    float a[8], b[8]; unpack8(cg, a); unpack8(hh, b);
#pragma unroll
    for (int i = 0; i < 8; ++i) u[i] = a[i] * b[i];
}
__device__ __forceinline__ void convA_phase(const bf16* BCH, bf16* Y, const float* cw, const float* hist, float* outp, float* outs, int gtid, int NT) {
    for (int it = gtid; it < NROWS * 256; it += NT) {
        const int r = it >> 8, c0 = (it & 255) * 8;
        float u0[8], u1[8], u2[8];
        load_u(BCH, r, c0, u2);
        if (r < SROW0) {
            int b, t; row_bt(r, b, t);
            if (t >= 1) load_u(BCH, prow(b, t - 1), c0, u1); else {
#pragma unroll
                for (int i = 0; i < 8; ++i) u1[i] = 0.f; }
            if (t >= 2) load_u(BCH, prow(b, t - 2), c0, u0); else {
#pragma unroll
                for (int i = 0; i < 8; ++i) u0[i] = 0.f; }
            if (t >= TP - 2) { float* o = outp + ((size_t)(b * 2 + (t - (TP - 2)))) * DM + c0; *(f32x4*)o = (f32x4){u2[0], u2[1], u2[2], u2[3]}; *(f32x4*)(o + 4) = (f32x4){u2[4], u2[5], u2[6], u2[7]}; }
        } else {
            const int sb = r - SROW0; const float* h0 = hist + ((size_t)(sb * 2 + 0)) * DM + c0; const float* h1 = hist + ((size_t)(sb * 2 + 1)) * DM + c0;
            const f32x4 a0 = *(const f32x4*)h0, a1 = *(const f32x4*)(h0 + 4), b0 = *(const f32x4*)h1, b1 = *(const f32x4*)(h1 + 4);
            u0[0] = a0.x; u0[1] = a0.y; u0[2] = a0.z; u0[3] = a0.w; u0[4] = a1.x; u0[5] = a1.y; u0[6] = a1.z; u0[7] = a1.w;
            u1[0] = b0.x; u1[1] = b0.y; u1[2] = b0.z; u1[3] = b0.w; u1[4] = b1.x; u1[5] = b1.y; u1[6] = b1.z; u1[7] = b1.w;
            float* o0 = outs + ((size_t)(sb * 2 + 0)) * DM + c0; float* o1 = outs + ((size_t)(sb * 2 + 1)) * DM + c0;
            *(f32x4*)o0 = b0; *(f32x4*)(o0 + 4) = b1;
            *(f32x4*)o1 = (f32x4){u2[0], u2[1], u2[2], u2[3]}; *(f32x4*)(o1 + 4) = (f32x4){u2[4], u2[5], u2[6], u2[7]};
        }
        float bg[8]; unpack8(*(const v4u*)(BCH + (size_t)r * NA_IN + c0), bg);
        float w0[8], w1[8], w2[8];
        { const f32x4 a = *(const f32x4*)(cw + c0), b = *(const f32x4*)(cw + c0 + 4); w0[0] = a.x; w0[1] = a.y; w0[2] = a.z; w0[3] = a.w; w0[4] = b.x; w0[5] = b.y; w0[6] = b.z; w0[7] = b.w; }
        { const f32x4 a = *(const f32x4*)(cw + DM + c0), b = *(const f32x4*)(cw + DM + c0 + 4); w1[0] = a.x; w1[1] = a.y; w1[2] = a.z; w1[3] = a.w; w1[4] = b.x; w1[5] = b.y; w1[6] = b.z; w1[7] = b.w; }
        { const f32x4 a = *(const f32x4*)(cw + 2 * DM + c0), b = *(const f32x4*)(cw + 2 * DM + c0 + 4); w2[0] = a.x; w2[1] = a.y; w2[2] = a.z; w2[3] = a.w; w2[4] = b.x; w2[5] = b.y; w2[6] = b.z; w2[7] = b.w; }
        float y[8];
#pragma unroll
        for (int i = 0; i < 8; ++i) y[i] = bg[i] * (w0[i] * u0[i] + w1[i] * u1[i] + w2[i] * u2[i]);
        *(v4u*)(Y + (size_t)r * DM + c0) = pack8(y);
    }
}

constexpr float QSCALE = 0.08838834764831845f;
__device__ __forceinline__ void rope_phase(const bf16* PROJ, const Ptrs& P, int gw, int NGW, int lane) {
    unsigned char* ws = P.ws;
    const f32x2* t128 = (const f32x2*)(ws + WS_TAB128); const f32x2* t64 = (const f32x2*)(ws + WS_TAB64);
    bf16* Qr = (bf16*)(ws + WS_QR); bf16* QI = (bf16*)(ws + WS_QI); bf16* KIb = (bf16*)(ws + WS_KIB); float* WI = (float*)(ws + WS_WI);
    bf16* Ks = (bf16*)(ws + WS_KS); bf16* Vs = (bf16*)(ws + WS_VS);
    for (int pr_ = gw; pr_ < NBP * SPAD; pr_ += NGW) {
        const size_t o = ((size_t)((pr_ / SPAD) * SP + (pr_ % SPAD))) * 512 + 8 * lane; *(v4u*)(Ks + o) = (v4u){0u, 0u, 0u, 0u}; *(v4u*)(Vs + o) = (v4u){0u, 0u, 0u, 0u}; }
    for (int r = gw; r < NROWS; r += NGW) {
        const bf16* pr = PROJ + (size_t)r * NB_PAD;
        int pi; float *ko, *vo, *iko; bf16* kib = nullptr; bf16 *ksq = nullptr, *vsq = nullptr;
        if (r < SROW0) { int b, t; row_bt(r, b, t); pi = t; ksq = Ks + ((size_t)(b * SP + t + SPAD)) * 512; vsq = Vs + ((size_t)(b * SP + t + SPAD)) * 512; ko = P.out + O_KP + ((size_t)(b * TP + t)) * 512; vo = P.out + O_VP + ((size_t)(b * TP + t)) * 512; iko = P.out + O_IKP + ((size_t)(b * TP + t)) * 64; kib = KIb + ((size_t)(b * KIROWS + t)) * 64; }
        else { const int sb = r - SROW0; pi = POS_SAMPLE_IDX; ko = P.out + O_KS + (size_t)sb * 512; vo = P.out + O_VS + (size_t)sb * 512; iko = P.out + O_IKS + (size_t)sb * 64; }
        const f32x2* c128 = t128 + (size_t)pi * 64; const f32x2* c64 = t64 + (size_t)pi * 32;
        for (int e = lane; e < 1024; e += 64) { const int hd = e >> 6, i = e & 63; const float x1 = bf2f(pr[hd * 128 + i]), x2 = bf2f(pr[hd * 128 + 64 + i]); const f32x2 cs = c128[i];
            Qr[(size_t)r * DM + hd * 128 + i] = f2bf((x1 * cs.x - x2 * cs.y) * QSCALE); Qr[(size_t)r * DM + hd * 128 + 64 + i] = f2bf((x2 * cs.x + x1 * cs.y) * QSCALE); }
        for (int e = lane; e < 256; e += 64) { const int hd = e >> 6, i = e & 63; const float x1 = bf2f(pr[2048 + hd * 128 + i]), x2 = bf2f(pr[2048 + hd * 128 + 64 + i]); const f32x2 cs = c128[i];
            const float o1 = x1 * cs.x - x2 * cs.y, o2 = x2 * cs.x + x1 * cs.y; ko[hd * 128 + i] = o1; ko[hd * 128 + 64 + i] = o2;
            if (ksq) { ksq[hd * 128 + i] = f2bf(o1); ksq[hd * 128 + 64 + i] = f2bf(o2); } }
        for (int e = lane; e < 512; e += 64) { vo[e] = bf2f(pr[2560 + e]); if (vsq) vsq[e] = pr[2560 + e]; }
        for (int e = lane; e < 512; e += 64) { const int hd = e >> 5, i = e & 31; const float x1 = bf2f(pr[3072 + hd * 64 + i]), x2 = bf2f(pr[3072 + hd * 64 + 32 + i]); const f32x2 cs = c64[i];
            QI[(size_t)r * 1024 + hd * 64 + i] = f2bf(x1 * cs.x - x2 * cs.y); QI[(size_t)r * 1024 + hd * 64 + 32 + i] = f2bf(x2 * cs.x + x1 * cs.y); }
        if (lane < 32) { const int i = lane; const float x1 = bf2f(pr[4096 + i]), x2 = bf2f(pr[4096 + 32 + i]); const f32x2 cs = c64[i]; const float o1 = x1 * cs.x - x2 * cs.y, o2 = x2 * cs.x + x1 * cs.y;
            iko[i] = o1; iko[32 + i] = o2; if (kib) { kib[i] = f2bf(o1); kib[32 + i] = f2bf(o2); } }
        else if (lane < 48) { const int i = lane - 32; WI[(size_t)r * 16 + i] = bf2f(pr[4160 + i]); }
    }
}

__device__ __forceinline__ void indexer_prompt(const Ptrs& P, int gw, int NGW, int lane) {
    unsigned char* ws = P.ws;
    const bf16* QI = (const bf16*)(ws + WS_QI); const bf16* KIb = (const bf16*)(ws + WS_KIB); const float* WI = (const float*)(ws + WS_WI); float* SC = (float*)(ws + WS_SC);
    const int n = lane & 31, h8 = lane >> 5;
    const int qsel = (n >> 2) & 1, head = (n & 3) + 4 * (n >> 3);
    constexpr int NIT = NBP * (TP / 2);
    for (int k = gw; k < NIT; k += NGW) {
        const int idx = (k < NIT / 2) ? k : (NIT - 1) - (k - NIT / 2);
        const int b = idx & 1, p = idx >> 1, t0 = 2 * p;
        const bf16* qa = QI + (size_t)prow(b, t0 + qsel) * 1024 + head * 64 + 8 * h8;
        bf16x8 a[4];
#pragma unroll
        for (int kk = 0; kk < 4; ++kk) a[kk] = *(const bf16x8*)(qa + 16 * kk);
        const int tq = t0 + h8;
        const float* wp = WI + (size_t)prow(b, tq) * 16;
        float w[16];
#pragma unroll
        for (int i = 0; i < 4; ++i) { const f32x4 x = *(const f32x4*)(wp + 4 * i); w[4 * i] = x.x; w[4 * i + 1] = x.y; w[4 * i + 2] = x.z; w[4 * i + 3] = x.w; }
        const int ntile = ((t0 + 1) >> 5) + 1;
        const bf16* kb = KIb + ((size_t)b * KIROWS + n) * 64 + 8 * h8;
        float* scrow = SC + ((size_t)(b * TP + tq)) * SCW;
        for (int kt0 = 0; kt0 < ntile; kt0 += 4) {
            bf16x8 bb[4][4];
#pragma unroll
            for (int u = 0; u < 4; ++u) { const int ktc = (kt0 + u < 129) ? kt0 + u : 128; const bf16* kp = kb + (size_t)ktc * 32 * 64;
#pragma unroll
                for (int kk = 0; kk < 4; ++kk) bb[u][kk] = *(const bf16x8*)(kp + 16 * kk); }
#pragma unroll
            for (int u = 0; u < 4; ++u) {
                f32x16 acc;
#pragma unroll
                for (int i = 0; i < 16; ++i) acc[i] = 0.f;
#pragma unroll
                for (int kk = 0; kk < 4; ++kk) acc = __builtin_amdgcn_mfma_f32_32x32x16_bf16(a[kk], bb[u][kk], acc, 0, 0, 0);
                float sc = 0.f;
#pragma unroll
                for (int i = 0; i < 16; ++i) sc += w[i] * fmaxf(acc[i], 0.f);
                const int s = 32 * (kt0 + u) + n;
                if (s <= tq) scrow[s] = sc;
            }
        }
    }
}

__device__ __forceinline__ void indexer_sample(const Ptrs& P, LAS unsigned char* lds, int tid) {
    unsigned char* ws = P.ws;
    const bf16* QI = (const bf16*)(ws + WS_QI); const float* WI = (const float*)(ws + WS_WI); float* SCS = (float*)(ws + WS_SCS);
    LAS float* lq = (LAS float*)lds;
    LAS float* lw = lq + 1024;
    constexpr int NCH = (NSKEY + 511) / 512;
    for (int item = blockIdx.x; item < SBN * NCH; item += gridDim.x) {
        const int sb = item / NCH, ch = item % NCH, r = SROW0 + sb;
        __syncthreads();
        for (int e = tid; e < 1024; e += NTHREADS) lq[e] = bf2f(QI[(size_t)r * 1024 + e]);
        if (tid < 16) lw[tid] = WI[(size_t)r * 16 + tid];
        __syncthreads();
        const int s = ch * 512 + tid;
        if (s < NSKEY) {
            const float* kr = (s < PAST) ? P.cache_ik + ((size_t)P.page_table[sb * NPG + (s >> 7)] * 128 + (s & 127)) * 64 : P.out + O_IKS + (size_t)sb * 64;
            f32x4 kv[16];
#pragma unroll
            for (int i = 0; i < 16; ++i) kv[i] = *(const f32x4*)(kr + 4 * i);
            float sc = 0.f;
            for (int h = 0; h < 16; ++h) { float d = 0.f;
#pragma unroll
                for (int i = 0; i < 16; ++i) { const f32x4 q = *(const LAS f32x4*)(lq + h * 64 + 4 * i); d += q.x * kv[i].x + q.y * kv[i].y + q.z * kv[i].z + q.w * kv[i].w; }
                sc += lw[h] * fmaxf(d, 0.f); }
            SCS[(size_t)sb * SCSW + s] = sc;
        }
    }
    __syncthreads();
}

__device__ __forceinline__ unsigned ordkey(float f) { const unsigned u = __float_as_uint(f); return (u & 0x80000000u) ? ~u : (u | 0x80000000u); }
constexpr int TOPK = 256;
__device__ __forceinline__ void topk_wave_mask(const float* sc, int n, unsigned long long* mrow, int lane) {
    constexpr int NS = MTW, M0 = SPAD / 64;
    static_assert(M0 == dattn::JLO, "first real key tile");
    unsigned key[NS];
#pragma unroll
    for (int m = M0; m < NS; ++m) { const int sidx = lane + 64 * m - SPAD; const int ci = sidx < 0 ? 0 : (sidx < n ? sidx : n - 1); const float v = sc[ci]; key[m] = (sidx >= 0 && sidx < n) ? ordkey(v) : 0u; }
    if (n <= TOPK) {
#pragma unroll
        for (int m = M0; m < NS; ++m) { const unsigned long long w = __ballot(key[m] != 0u); if (lane == 0) mrow[m] = w; }
        return;
    }
    unsigned T = 0u;
    for (int bit = 31; bit >= 0; --bit) {
        const unsigned cand = T | (1u << bit); int c = 0;
#pragma unroll
        for (int m = M0; m < NS; ++m) c += __popcll(__ballot(key[m] >= cand));
        if (c >= TOPK) T = cand;
    }
    int cg = 0;
#pragma unroll
    for (int m = M0; m < NS; ++m) cg += __popcll(__ballot(key[m] > T));
    const int need = TOPK - cg;
    int base_e = 0;
    const unsigned long long lt = (1ull << lane) - 1ull;
#pragma unroll
    for (int m = M0; m < NS; ++m) {
        const bool pg = key[m] > T, pe = key[m] == T;
        const unsigned long long me = __ballot(pe);
        const int pre_e = __popcll(me & lt);
        const unsigned long long w = __ballot(pg || (pe && (base_e + pre_e) < need));
        if (lane == 0) mrow[m] = w;
        base_e += __popcll(me);
    }
}
__device__ __forceinline__ void topk_block(const float* sc, int n, int* outIdx, int* outCnt, LAS unsigned* ls, int tid, int wave, int lane) {
    constexpr int NS = (NSKEY + NTHREADS - 1) / NTHREADS;
    unsigned key[NS];
#pragma unroll
    for (int m = 0; m < NS; ++m) { const int e = tid + NTHREADS * m; const float v = sc[e < n ? e : n - 1]; key[m] = (e < n) ? ordkey(v) : 0u; }
    unsigned T = 0u;
    for (int bit = 31; bit >= 0; --bit) {
        const unsigned cand = T | (1u << bit); int c = 0;
#pragma unroll
        for (int m = 0; m < NS; ++m) c += (key[m] >= cand) ? 1 : 0;
        c = wave_sum_i(c);
        LAS unsigned* buf = ls + (bit & 1) * 8;
        if (lane == 0) buf[wave] = (unsigned)c;
        __syncthreads();
        int tot = 0;
#pragma unroll
        for (int w = 0; w < 8; ++w) tot += (int)buf[w];
        if (tot >= TOPK) T = cand;
    }
    __syncthreads();
    if (tid == 0) { unsigned z_ = 0u; asm volatile("" : "+v"(z_)); ls[16] = z_; ls[17] = z_; }
    __syncthreads();
#pragma unroll
    for (int m = 0; m < NS; ++m) { const int e = tid + NTHREADS * m; if (key[m] > T) { const unsigned pos = atomicAdd((unsigned*)(ls + 16), 1u); if (pos < (unsigned)TOPK) outIdx[pos] = e; } }
    __syncthreads();
    const unsigned cg = ls[16];
    const unsigned need = (unsigned)TOPK - cg;
#pragma unroll
    for (int m = 0; m < NS; ++m) { const int e = tid + NTHREADS * m; if (key[m] == T) { const unsigned pos = atomicAdd((unsigned*)(ls + 17), 1u); if (pos < need) outIdx[cg + pos] = e; } }
    if (tid == 0) *outCnt = TOPK;
    __syncthreads();
}
__device__ __forceinline__ void select_phase(const Ptrs& P, LAS unsigned char* lds, int gw, int NGW, int tid, int wave, int lane) {
    unsigned char* ws = P.ws;
    const float* SC = (const float*)(ws + WS_SC); const float* SCS = (const float*)(ws + WS_SCS); int* IDXL = (int*)(ws + WS_IDXL); int* CNT = (int*)(ws + WS_CNT);
    for (int sb = blockIdx.x; sb < SBN; sb += gridDim.x) topk_block(SCS + (size_t)sb * SCSW, NSKEY, IDXL + (size_t)(SROW0 + sb) * TOPK, CNT + SROW0 + sb, (LAS unsigned*)lds, tid, wave, lane);
    unsigned long long* MASK = (unsigned long long*)(ws + WS_MASK);
    for (int r = gw; r < SROW0; r += NGW) { int b, t; row_bt(r, b, t);
        if (r < XROW0) topk_wave_mask(SC + ((size_t)(b * TP + t)) * SCW, t + 1, MASK + ((size_t)(b * SP + t + SPAD)) * MTW, lane);
        else { if (lane <= t) IDXL[(size_t)r * TOPK + lane] = lane; if (lane == 0) CNT[r] = t + 1; } }
}

__device__ __forceinline__ void attn_phase(const Ptrs& P, bf16* O, LAS unsigned char* lds, int gw, int NGW, int wave, int lane) {
    unsigned char* ws = P.ws;
    const bf16* Qr = (const bf16*)(ws + WS_QR); const int* IDXL = (const int*)(ws + WS_IDXL); const int* CNT = (const int*)(ws + WS_CNT);
    LAS float* lq = (LAS float*)(lds + wave * 12288);
    LAS f32x4* lp = (LAS f32x4*)(lds + wave * 12288 + 2048);
    LAS unsigned long long* lkp = (LAS unsigned long long*)(lds + wave * 12288 + 6144);
    LAS unsigned long long* lvp = (LAS unsigned long long*)(lds + wave * 12288 + 8192);
    for (int item = gw; item < (NROWS - XROW0) * 4; item += NGW) {
        const int r = XROW0 + (item >> 2), n = item & 3;
        const int cnt = CNT[r];
        WAVE_SYNC();
        { float qf[8]; unpack8(*(const v4u*)(Qr + (size_t)r * DM + n * 512 + 8 * lane), qf);
          *(LAS f32x4*)(lq + 8 * lane) = (f32x4){qf[0], qf[1], qf[2], qf[3]}; *(LAS f32x4*)(lq + 8 * lane + 4) = (f32x4){qf[4], qf[5], qf[6], qf[7]}; }
        const float* kp[4];
#pragma unroll
        for (int j = 0; j < 4; ++j) {
            const int e = lane + 64 * j; const int s = (e < cnt) ? IDXL[(size_t)r * TOPK + e] : 0;
            const float *kq, *vq;
            if (r < SROW0) { const int b = (r < XROW0) ? (r >> 12) : ((r - XROW0) >> 4); kq = P.out + O_KP + ((size_t)(b * TP + s)) * 512; vq = P.out + O_VP + ((size_t)(b * TP + s)) * 512; }
            else { const int sb = r - SROW0;
                if (s < PAST) { const size_t off = ((size_t)P.page_table[sb * NPG + (s >> 7)] * 128 + (s & 127)) * 512; kq = P.cache_k + off; vq = P.cache_v + off; }
                else { kq = P.out + O_KS + (size_t)sb * 512; vq = P.out + O_VS + (size_t)sb * 512; } }
            kp[j] = kq + n * 128; lkp[e] = (unsigned long long)(kq + n * 128); lvp[e] = (unsigned long long)(vq + n * 128);
        }
        WAVE_SYNC();
        float acc[4][4];
#pragma unroll
        for (int g = 0; g < 4; ++g)
#pragma unroll
            for (int j = 0; j < 4; ++j) acc[g][j] = 0.f;
#pragma unroll 4
        for (int d4 = 0; d4 < 32; ++d4) {
            f32x4 qv[4];
#pragma unroll
            for (int g = 0; g < 4; ++g) qv[g] = *(const LAS f32x4*)(lq + g * 128 + 4 * d4);
#pragma unroll
            for (int j = 0; j < 4; ++j) { const f32x4 kv = *(const f32x4*)(kp[j] + 4 * d4);
#pragma unroll
                for (int g = 0; g < 4; ++g) acc[g][j] += qv[g].x * kv.x + qv[g].y * kv.y + qv[g].z * kv.z + qv[g].w * kv.w; }
        }
        float linv[4];
#pragma unroll
        for (int g = 0; g < 4; ++g) {
            float m = -INFINITY;
#pragma unroll
            for (int j = 0; j < 4; ++j) { if (lane + 64 * j >= cnt) acc[g][j] = -INFINITY; m = fmaxf(m, acc[g][j]); }
            m = wave_max(m); float l = 0.f;
#pragma unroll
            for (int j = 0; j < 4; ++j) { acc[g][j] = __expf(acc[g][j] - m); l += acc[g][j]; }
            linv[g] = 1.f / wave_sum(l);
        }
#pragma unroll
        for (int j = 0; j < 4; ++j) lp[lane + 64 * j] = (f32x4){acc[0][j], acc[1][j], acc[2][j], acc[3][j]};
        WAVE_SYNC();
        float o[4][2];
#pragma unroll
        for (int g = 0; g < 4; ++g) { o[g][0] = 0.f; o[g][1] = 0.f; }
#pragma unroll 8
        for (int e = 0; e < cnt; ++e) {
            const float* vp = (const float*)lvp[e]; const f32x2 vv = *(const f32x2*)(vp + 2 * lane); const f32x4 p = lp[e];
            o[0][0] += p.x * vv.x; o[0][1] += p.x * vv.y; o[1][0] += p.y * vv.x; o[1][1] += p.y * vv.y; o[2][0] += p.z * vv.x; o[2][1] += p.z * vv.y; o[3][0] += p.w * vv.x; o[3][1] += p.w * vv.y;
        }
#pragma unroll
        for (int g = 0; g < 4; ++g) *(unsigned*)(O + (size_t)r * DM + (4 * n + g) * 128 + 2 * lane) = pk2(o[g][0] * linv[g], o[g][1] * linv[g]);
    }
}

__device__ __forceinline__ void convC_phase(const bf16* PROJC, const Ptrs& P, int gw, int NGW, int lane) {
    unsigned char* ws = P.ws;
    bf16* QKVC = (bf16*)(ws + WS_QKVC); float* QKF = (float*)(ws + WS_QKF); float* G = (float*)(ws + WS_G); float* BETA = (float*)(ws + WS_BETA);
    const float* cw = P.conv_w_c;
    for (int r = gw; r < NROWS; r += NGW) {
        int b = 0, t = 0, sb = 0; const bool samp = r >= SROW0;
        if (samp) sb = r - SROW0; else row_bt(r, b, t);
        int rr[3];
#pragma unroll
        for (int j = 0; j < 3; ++j) rr[j] = (!samp && t - 3 + j >= 0) ? prow(b, t - 3 + j) : -1;
        for (int it = 0; it < 16; ++it) {
            const int ch0 = it * 512 + 8 * lane;
            float x[4][8];
#pragma unroll
            for (int j = 0; j < 3; ++j) {
                if (samp) { const float* hp = P.state_conv_c + ((size_t)(sb * 3 + j)) * CDIM + ch0; const f32x4 a = *(const f32x4*)hp, c = *(const f32x4*)(hp + 4);
                    x[j][0] = a.x; x[j][1] = a.y; x[j][2] = a.z; x[j][3] = a.w; x[j][4] = c.x; x[j][5] = c.y; x[j][6] = c.z; x[j][7] = c.w; }
                else if (rr[j] >= 0) unpack8(*(const v4u*)(PROJC + (size_t)rr[j] * NC_PAD + ch0), x[j]);
                else {
#pragma unroll
                    for (int i = 0; i < 8; ++i) x[j][i] = 0.f; }
            }
            unpack8(*(const v4u*)(PROJC + (size_t)r * NC_PAD + ch0), x[3]);
            float acc[8];
#pragma unroll
            for (int i = 0; i < 8; ++i) acc[i] = 0.f;
#pragma unroll
            for (int j = 0; j < 4; ++j) { const f32x4 w0 = *(const f32x4*)(cw + (size_t)j * CDIM + ch0), w1 = *(const f32x4*)(cw + (size_t)j * CDIM + ch0 + 4);
                acc[0] += w0.x * x[j][0]; acc[1] += w0.y * x[j][1]; acc[2] += w0.z * x[j][2]; acc[3] += w0.w * x[j][3];
                acc[4] += w1.x * x[j][4]; acc[5] += w1.y * x[j][5]; acc[6] += w1.z * x[j][6]; acc[7] += w1.w * x[j][7]; }
            float ss = 0.f;
#pragma unroll
            for (int i = 0; i < 8; ++i) { acc[i] = silu_f(acc[i]); ss += acc[i] * acc[i]; }
            if (it < 8) { ss = row16_sum(ss); float rn = 1.f / sqrtf(ss + RMS_EPS); if (it < 4) rn *= QSCALE;
#pragma unroll
                for (int i = 0; i < 8; ++i) acc[i] *= rn; }
            if (it < 8 && samp) { float* qk = QKF + (size_t)r * 4096 + ch0; *(f32x4*)qk = (f32x4){acc[0], acc[1], acc[2], acc[3]}; *(f32x4*)(qk + 4) = (f32x4){acc[4], acc[5], acc[6], acc[7]}; }
            *(v4u*)(QKVC + (size_t)r * CDIM + ch0) = pack8(acc);
            if (samp) {
                float* o = P.out + O_CCS + ((size_t)(sb * 3)) * CDIM + ch0;
#pragma unroll
                for (int j = 0; j < 3; ++j) { *(f32x4*)(o + (size_t)j * CDIM) = (f32x4){x[j + 1][0], x[j + 1][1], x[j + 1][2], x[j + 1][3]}; *(f32x4*)(o + (size_t)j * CDIM + 4) = (f32x4){x[j + 1][4], x[j + 1][5], x[j + 1][6], x[j + 1][7]}; }
            } else if (t >= TP - 3) {
                float* o = P.out + O_CCP + ((size_t)(b * 3 + (t - (TP - 3)))) * CDIM + ch0;
                *(f32x4*)o = (f32x4){x[3][0], x[3][1], x[3][2], x[3][3]}; *(f32x4*)(o + 4) = (f32x4){x[3][4], x[3][5], x[3][6], x[3][7]};
            }
        }
        if (lane < 32) {
            const float braw = bf2f(PROJC[(size_t)r * NC_PAD + 12288 + lane]), araw = bf2f(PROJC[(size_t)r * NC_PAD + 12320 + lane]);
            const float xx = araw + P.dt_bias[lane]; const float sp = xx > 20.f ? xx : __logf(1.f + __expf(xx));
            G[(size_t)r * 32 + lane] = -__expf(P.a_log[lane]) * sp; BETA[(size_t)r * 32 + lane] = 1.f / (1.f + __expf(-braw));
        }
    }
}

struct Tok { f32x4 k0, k1, q0, q1; unsigned v; float g, b; };
__device__ __forceinline__ void tok_load(Tok& T, const float* QKF, const bf16* QKVC, const float* G, const float* BETA, int row, int h, int rg, int col0) {
    const float* base = QKF + (size_t)row * 4096 + (h >> 1) * 128 + 8 * rg;
    T.q0 = *(const f32x4*)base; T.q1 = *(const f32x4*)(base + 4); T.k0 = *(const f32x4*)(base + 2048); T.k1 = *(const f32x4*)(base + 2052);
    T.v = *(const unsigned*)(QKVC + (size_t)row * CDIM + 4096 + h * 128 + col0);
    T.g = G[(size_t)row * 32 + h]; T.b = BETA[(size_t)row * 32 + h];
}
__device__ __forceinline__ f32x2 tok_step(f32x2 (&S)[8], const Tok& T) {
    const float kk[8] = {T.k0.x, T.k0.y, T.k0.z, T.k0.w, T.k1.x, T.k1.y, T.k1.z, T.k1.w};
    const float qq[8] = {T.q0.x, T.q0.y, T.q0.z, T.q0.w, T.q1.x, T.q1.y, T.q1.z, T.q1.w};
    const float a = __expf(T.g);
    f32x2 d0 = S[0] * kk[0], d1 = S[1] * kk[1];
#pragma unroll
    for (int i = 2; i < 8; i += 2) { d0 += S[i] * kk[i]; d1 += S[i + 1] * kk[i + 1]; }
    f32x2 d = d0 + d1;
    d.x = row16_sum(d.x); d.y = row16_sum(d.y);
    const f32x2 tv = {bflo(T.v), bfhi(T.v)};
    const f32x2 dl = (tv - d * a) * T.b;
    f32x2 o0 = {0.f, 0.f}, o1 = {0.f, 0.f};
#pragma unroll
    for (int i = 0; i < 8; i += 2) { S[i] = S[i] * a + dl * kk[i]; o0 += S[i] * qq[i]; S[i + 1] = S[i + 1] * a + dl * kk[i + 1]; o1 += S[i + 1] * qq[i + 1]; }
    f32x2 o = o0 + o1;
    o.x = row16_sum(o.x); o.y = row16_sum(o.y);
    return o;
}
constexpr int DBK = 2;
__device__ __forceinline__ void delta_segment(f32x2 (&S)[8], const float* QKF, const bf16* QKVC, const float* G, const float* BETA, float* OF, int rowbase, int ntok, int h, int rg, int col0) {
    Tok A[DBK], B[DBK];
#pragma unroll
    for (int i = 0; i < DBK; ++i) tok_load(A[i], QKF, QKVC, G, BETA, rowbase + i, h, rg, col0);
    for (int t0 = 0; t0 < ntok; t0 += 2 * DBK) {
        f32x2 o[DBK];
#pragma unroll
        for (int i = 0; i < DBK; ++i) tok_load(B[i], QKF, QKVC, G, BETA, rowbase + t0 + DBK + i, h, rg, col0);
#pragma unroll
        for (int i = 0; i < DBK; ++i) o[i] = tok_step(S, A[i]);
        if (rg == 0) {
#pragma unroll
            for (int i = 0; i < DBK; ++i) *(f32x2*)(OF + (size_t)(rowbase + t0 + i) * DVW + h * 128 + col0) = o[i]; }
        if (t0 + 2 * DBK < ntok) {
#pragma unroll
            for (int i = 0; i < DBK; ++i) tok_load(A[i], QKF, QKVC, G, BETA, rowbase + t0 + 2 * DBK + i, h, rg, col0); }
#pragma unroll
        for (int i = 0; i < DBK; ++i) o[i] = tok_step(S, B[i]);
        if (rg == 0) {
#pragma unroll
            for (int i = 0; i < DBK; ++i) *(f32x2*)(OF + (size_t)(rowbase + t0 + DBK + i) * DVW + h * 128 + col0) = o[i]; }
    }
}
__device__ __forceinline__ void delta_phase(const Ptrs& P, int wave, int lane) {
    unsigned char* ws = P.ws;
    const bf16* QKVC = (const bf16*)(ws + WS_QKVC); const float* QKF = (const float*)(ws + WS_QKF); const float* G = (const float*)(ws + WS_G); const float* BETA = (const float*)(ws + WS_BETA); float* OF = (float*)(ws + WS_SC);
    const int cg = lane >> 4, rg = lane & 15;
    {
        for (int item = blockIdx.x * 8 + wave; item < SBN * 32 * 16; item += gridDim.x * 8) {
            const int sb = item >> 9, h = (item >> 4) & 31, col0 = 8 * (item & 15) + 2 * cg;
            const size_t so = ((size_t)((sb * 32 + h) * 128 + 8 * rg)) * 128 + col0;
            f32x2 S[8];
#pragma unroll
            for (int i = 0; i < 8; ++i) S[i] = *(const f32x2*)(P.state_delta + so + (size_t)i * 128);
            Tok T; tok_load(T, QKF, QKVC, G, BETA, SROW0 + sb, h, rg, col0);
            const f32x2 o = tok_step(S, T);
            if (rg == 0) *(f32x2*)(OF + (size_t)(SROW0 + sb) * DVW + h * 128 + col0) = o;
            float* op = P.out + O_DS + so;
#pragma unroll
            for (int i = 0; i < 8; ++i) *(f32x2*)(op + (size_t)i * 128) = S[i];
        }
    }
}
__device__ __forceinline__ void normC_phase(const bf16* PROJC, bf16* Y, const Ptrs& P, int gw, int NGW, int lane) {
    const float* OF = (const float*)(P.ws + WS_SC);
    const int d0 = 8 * (lane & 15);
    float nw[8];
    { const f32x4 a = *(const f32x4*)(P.norm_w + d0), b = *(const f32x4*)(P.norm_w + d0 + 4); nw[0] = a.x; nw[1] = a.y; nw[2] = a.z; nw[3] = a.w; nw[4] = b.x; nw[5] = b.y; nw[6] = b.z; nw[7] = b.w; }
    for (int r = gw; r < NROWS; r += NGW) {
#pragma unroll 2
        for (int it = 0; it < 8; ++it) {
            const int hd = it * 4 + (lane >> 4);
            const float* op = OF + (size_t)r * DVW + hd * 128 + d0;
            const f32x4 a = *(const f32x4*)op, b = *(const f32x4*)(op + 4);
            float o[8] = {a.x, a.y, a.z, a.w, b.x, b.y, b.z, b.w};
            float ss = 0.f;
#pragma unroll
            for (int i = 0; i < 8; ++i) ss += o[i] * o[i];
            ss = row16_sum(ss);
            const float rs = 1.f / sqrtf(ss * (1.f / 128.f) + RMS_EPS);
            float z[8]; unpack8(*(const v4u*)(PROJC + (size_t)r * NC_PAD + 8192 + hd * 128 + d0), z);
#pragma unroll
            for (int i = 0; i < 8; ++i) o[i] = o[i] * rs * nw[i] * silu_f(z[i]);
            *(v4u*)(Y + (size_t)r * DVW + hd * 128 + d0) = pack8(o);
        }
    }
}


__device__ __forceinline__ void dense_attn_phase(const Ptrs& P, bf16* O, char* lds, int wv) {
    unsigned char* ws = P.ws;
    const bf16* Qr = (const bf16*)(ws + WS_QR); const bf16* Ks = (const bf16*)(ws + WS_KS); const bf16* Vs = (const bf16*)(ws + WS_VS);
    const unsigned long long* MASK = (const unsigned long long*)(ws + WS_MASK);
    typedef dattn::BlockRef<bf16, bf16> BR;
    for (int it0 = blockIdx.x; it0 < 256; it0 += gridDim.x) {
        const int grp = it0 & 7, idx = it0 >> 3;
        const int b = grp >> 2, kvh = grp & 3, h = kvh * 4 + (idx >> 3), x = idx & 7;
        BR A, B;
        const int qa = 1 + x, qb = 16 - x;
        A.Q = Qr + ((size_t)(b * SEQ + 256 * (qa - 1))) * DM + h * 128; A.O = O + ((size_t)(b * SEQ + 256 * (qa - 1))) * DM + h * 128;
        B.Q = Qr + ((size_t)(b * SEQ + 256 * (qb - 1))) * DM + h * 128; B.O = O + ((size_t)(b * SEQ + 256 * (qb - 1))) * DM + h * 128;
        A.K = B.K = Ks + (size_t)b * SP * 512 + kvh * 128; A.V = B.V = Vs + (size_t)b * SP * 512 + kvh * 128;
        A.P0 = 256 * qa; B.P0 = 256 * qb;
        A.M = MASK + ((size_t)(b * SP + A.P0)) * MTW; B.M = MASK + ((size_t)(b * SP + B.P0)) * MTW;
        dattn::Seam<bf16> S;
        dattn::causal_swa_prime<bf16, bf16>(A, SP, lds, S, wv);
        dattn::causal_swa_block<bf16, bf16>(A, B, SP, SP, lds, S, wv);
        dattn::causal_swa_block<bf16, bf16>(B, B, SP, SP, lds, S, wv);
    }
}

constexpr int NCH = 65, CPAD = 48;
constexpr int NUQ = NBP * 16 * NCH, NUH = NBP * 32 * NCH;
__device__ __forceinline__ int crow32(int r, int hi) { return (r & 3) + 8 * (r >> 2) + 4 * hi; }
__device__ __forceinline__ int chunk_row(int b, int c, int i) { const int t = 64 * c + i - CPAD; return t >= 0 ? prow(b, t) : -1; }
__device__ __forceinline__ float incl_scan64(float v, int lane) {
#pragma unroll
    for (int o = 1; o < 64; o <<= 1) { const float u = __shfl_up(v, o); if (lane >= o) v += u; }
    return v;
}
#define MFMA32(a, b, c) __builtin_amdgcn_mfma_f32_32x32x16_bf16((a), (b), (c), 0, 0, 0)

__device__ __forceinline__ void delta_d1(unsigned char* ws, LAS unsigned char* lds, int gw, int NGW, int wave, int lane) {
    const bf16* QKVC = (const bf16*)(ws + WS_QKVC); const float* G = (const float*)(ws + WS_G); const float* BETA = (const float*)(ws + WS_BETA);
    float* AF = (float*)(ws + WS_DAF); bf16* PG = (bf16*)(ws + WS_DPG); bf16* KT = (bf16*)(ws + WS_DKT); bf16* VT = (bf16*)(ws + WS_DVT);
    float* GC = (float*)(ws + WS_DGC); float* BT = (float*)(ws + WS_DBT);
    LAS float* lg = (LAS float*)(lds + wave * 1024);
    const int m = lane & 31, half = lane >> 5;
    const bf16x8 zf = {0, 0, 0, 0, 0, 0, 0, 0};
    for (int uq = gw; uq < NUQ; uq += NGW) {
        const int c = uq % NCH, bh = uq / NCH, hq = bh & 15, b = bh >> 4;
        { const int row = chunk_row(b, c, lane);
#pragma unroll
          for (int hh = 0; hh < 2; ++hh) { const int h = 2 * hq + hh; const float g = row >= 0 ? G[(size_t)row * 32 + h] : 0.f, bt = row >= 0 ? BETA[(size_t)row * 32 + h] : 0.f;
              const float gc = incl_scan64(g, lane); lg[hh * 64 + lane] = gc; lg[128 + hh * 64 + lane] = bt;
              const size_t uh = ((size_t)(b * 32 + h)) * NCH + c; GC[uh * 64 + lane] = gc; BT[uh * 64 + lane] = bt; } }
        const int row0 = chunk_row(b, c, m), row1 = chunk_row(b, c, 32 + m);
        const bf16* r0 = QKVC + (size_t)(row0 < 0 ? 0 : row0) * CDIM; const bf16* r1 = QKVC + (size_t)(row1 < 0 ? 0 : row1) * CDIM;
        f32x16 kk00, kk10, kk11, qk00, qk10, qk11;
#pragma unroll
        for (int i = 0; i < 16; ++i) { kk00[i] = 0.f; kk10[i] = 0.f; kk11[i] = 0.f; qk00[i] = 0.f; qk10[i] = 0.f; qk11[i] = 0.f; }
        bf16* kt = KT + (size_t)uq * 128 * 64;
#pragma unroll 1
        for (int ks = 0; ks < 8; ++ks) {
            const int off = hq * 128 + 16 * ks + 8 * half;
            const bf16x8 k0 = row0 >= 0 ? *(const bf16x8*)(r0 + 2048 + off) : zf, k1 = row1 >= 0 ? *(const bf16x8*)(r1 + 2048 + off) : zf;
            const bf16x8 q0 = row0 >= 0 ? *(const bf16x8*)(r0 + off) : zf, q1 = row1 >= 0 ? *(const bf16x8*)(r1 + off) : zf;
            kk00 = MFMA32(k0, k0, kk00); kk10 = MFMA32(k1, k0, kk10); kk11 = MFMA32(k1, k1, kk11);
            qk00 = MFMA32(q0, k0, qk00); qk10 = MFMA32(q1, k0, qk10); qk11 = MFMA32(q1, k1, qk11);
#pragma unroll
            for (int e = 0; e < 8; ++e) { kt[(size_t)(16 * ks + 8 * half + e) * 64 + m] = (bf16)k0[e]; kt[(size_t)(16 * ks + 8 * half + e) * 64 + 32 + m] = (bf16)k1[e]; }
        }
#pragma unroll 1
        for (int hh = 0; hh < 2; ++hh) { const int h = 2 * hq + hh; bf16* vt = VT + (((size_t)(b * 32 + h)) * NCH + c) * 128 * 64;
#pragma unroll 1
            for (int ks = 0; ks < 8; ++ks) { const int off = 4096 + h * 128 + 16 * ks + 8 * half;
                const bf16x8 v0 = row0 >= 0 ? *(const bf16x8*)(r0 + off) : zf, v1 = row1 >= 0 ? *(const bf16x8*)(r1 + off) : zf;
#pragma unroll
                for (int e = 0; e < 8; ++e) { vt[(size_t)(16 * ks + 8 * half + e) * 64 + m] = (bf16)v0[e]; vt[(size_t)(16 * ks + 8 * half + e) * 64 + 32 + m] = (bf16)v1[e]; } } }
        WAVE_SYNC();
#pragma unroll 1
        for (int hh = 0; hh < 2; ++hh) { const int h = 2 * hq + hh; const size_t uh = ((size_t)(b * 32 + h)) * NCH + c;
            float* af = AF + uh * 4096; bf16* pg = PG + uh * 4096;
            const float gcj0 = lg[hh * 64 + m], gcj1 = lg[hh * 64 + 32 + m];
#pragma unroll
            for (int r = 0; r < 16; ++r) { const int ir = crow32(r, half);
                const float gi0 = lg[hh * 64 + ir], gi1 = lg[hh * 64 + 32 + ir], bi0 = lg[128 + hh * 64 + ir], bi1 = lg[128 + hh * 64 + 32 + ir];
                { const int i = ir, j = m; const float dec = __expf(fminf(gi0 - gcj0, 0.f)); af[i * 64 + j] = (j < i) ? bi0 * dec * kk00[r] : 0.f; pg[i * 64 + j] = f2bf((j <= i) ? dec * qk00[r] : 0.f); }
                { const int i = 32 + ir, j = m; const float dec = __expf(fminf(gi1 - gcj0, 0.f)); af[i * 64 + j] = bi1 * dec * kk10[r]; pg[i * 64 + j] = f2bf(dec * qk10[r]); }
                { const int i = 32 + ir, j = 32 + m; const float dec = __expf(fminf(gi1 - gcj1, 0.f)); af[i * 64 + j] = (j < i) ? bi1 * dec * kk11[r] : 0.f; pg[i * 64 + j] = f2bf((j <= i) ? dec * qk11[r] : 0.f); }
            } }
        WAVE_SYNC();
    }
}
__device__ __forceinline__ void delta_d2(unsigned char* ws, int gw, int NGW, int lane) {
    const float* AF = (const float*)(ws + WS_DAF); const float* GC = (const float*)(ws + WS_DGC); const float* BT = (const float*)(ws + WS_DBT);
    bf16* TG = (bf16*)(ws + WS_DTG); bf16* TB = (bf16*)(ws + WS_DTB);
    for (int uh = gw; uh < NUH; uh += NGW) {
        const float* af = AF + (size_t)uh * 4096;
        const float bc = BT[(size_t)uh * 64 + lane], gmc = __expf(GC[(size_t)uh * 64 + lane]);
        float T[64];
#pragma unroll
        for (int i0 = 0; i0 < 64; i0 += 16) {
            float ar[16];
#pragma unroll
            for (int u = 0; u < 16; ++u) ar[u] = af[(i0 + u) * 64 + lane];
#pragma unroll
            for (int u = 0; u < 16; ++u) { const int i = i0 + u; float acc = (lane == i) ? 1.f : 0.f;
#pragma unroll
                for (int j = 0; j < i; ++j) acc -= __int_as_float(__builtin_amdgcn_readlane(__float_as_int(ar[u]), j)) * T[j];
                T[i] = acc; }
        }
        bf16* tg = TG + (size_t)uh * 4096; bf16* tb = TB + (size_t)uh * 4096;
        const float sg = bc * gmc;
#pragma unroll
        for (int i = 0; i < 64; ++i) { tg[i * 64 + lane] = f2bf(T[i] * sg); tb[i * 64 + lane] = f2bf(T[i] * bc); }
    }
}
__device__ __forceinline__ void delta_d3(unsigned char* ws, int gw, int NGW, int lane) {
    const bf16* TG = (const bf16*)(ws + WS_DTG); const bf16* TB = (const bf16*)(ws + WS_DTB); const bf16* KT = (const bf16*)(ws + WS_DKT); const bf16* VT = (const bf16*)(ws + WS_DVT);
    bf16* WG = (bf16*)(ws + WS_DWG); bf16* UG = (bf16*)(ws + WS_DUG);
    const int m = lane & 31, half = lane >> 5;
    for (int uh = gw; uh < NUH; uh += NGW) {
        const int c = uh % NCH, bh = uh / NCH, h = bh & 31, b = bh >> 5;
        const size_t uq = ((size_t)(b * 16 + (h >> 1))) * NCH + c;
#pragma unroll
        for (int pass = 0; pass < 2; ++pass) {
            const bf16* Tm = (pass == 0 ? TG : TB) + (size_t)uh * 4096; const bf16* Bt = pass == 0 ? KT + uq * 8192 : VT + (size_t)uh * 8192;
            f32x16 acc[2][4];
#pragma unroll
            for (int ti = 0; ti < 2; ++ti)
#pragma unroll
                for (int dn = 0; dn < 4; ++dn)
#pragma unroll
                    for (int i = 0; i < 16; ++i) acc[ti][dn][i] = 0.f;
#pragma unroll
            for (int ks = 0; ks < 4; ++ks) {
                bf16x8 a[2], bb[4];
#pragma unroll
                for (int ti = 0; ti < 2; ++ti) a[ti] = *(const bf16x8*)(Tm + (32 * ti + m) * 64 + 16 * ks + 8 * half);
#pragma unroll
                for (int dn = 0; dn < 4; ++dn) bb[dn] = *(const bf16x8*)(Bt + (32 * dn + m) * 64 + 16 * ks + 8 * half);
#pragma unroll
                for (int ti = 0; ti < 2; ++ti)
#pragma unroll
                    for (int dn = 0; dn < 4; ++dn) acc[ti][dn] = MFMA32(a[ti], bb[dn], acc[ti][dn]);
            }
            if (pass == 0) { bf16* wg = WG + (size_t)uh * 8192;
#pragma unroll
                for (int ti = 0; ti < 2; ++ti)
#pragma unroll
                    for (int dn = 0; dn < 4; ++dn)
#pragma unroll
                        for (int r = 0; r < 16; ++r) wg[(32 * ti + crow32(r, half)) * 128 + 32 * dn + m] = f2bf(acc[ti][dn][r]);
            } else { bf16* ug = UG + (size_t)uh * 8192;
#pragma unroll
                for (int ti = 0; ti < 2; ++ti)
#pragma unroll
                    for (int dn = 0; dn < 4; ++dn) { v4u w0, w1;
                        w0.x = pk2(acc[ti][dn][0], acc[ti][dn][1]); w0.y = pk2(acc[ti][dn][2], acc[ti][dn][3]); w0.z = pk2(acc[ti][dn][4], acc[ti][dn][5]); w0.w = pk2(acc[ti][dn][6], acc[ti][dn][7]);
                        w1.x = pk2(acc[ti][dn][8], acc[ti][dn][9]); w1.y = pk2(acc[ti][dn][10], acc[ti][dn][11]); w1.z = pk2(acc[ti][dn][12], acc[ti][dn][13]); w1.w = pk2(acc[ti][dn][14], acc[ti][dn][15]);
                        bf16* p = ug + ((size_t)((ti * 4 + dn) * 64 + lane)) * 16; *(v4u*)p = w0; *(v4u*)(p + 8) = w1; }
            }
        }
    }
}
__device__ __forceinline__ bf16x8 afrag_perm(const bf16* rowp, int blk, int s, int half) {
    const v2u lo = *(const v2u*)(rowp + 32 * blk + 16 * s + 4 * half), hi2 = *(const v2u*)(rowp + 32 * blk + 16 * s + 8 + 4 * half);
    v4u w; w.x = lo.x; w.y = lo.y; w.z = hi2.x; w.w = hi2.y; return __builtin_bit_cast(bf16x8, w);
}
__device__ __forceinline__ v4u pack_frag(const f32x16& x, int s) { v4u w; w.x = pk2(x[8 * s], x[8 * s + 1]); w.y = pk2(x[8 * s + 2], x[8 * s + 3]); w.z = pk2(x[8 * s + 4], x[8 * s + 5]); w.w = pk2(x[8 * s + 6], x[8 * s + 7]); return w; }
__device__ __forceinline__ void delta_d4(unsigned char* ws, float* out_state, LAS unsigned char* lds, int tid, int wave, int lane) {
    const bf16* QKVC = (const bf16*)(ws + WS_QKVC); const bf16* KT = (const bf16*)(ws + WS_DKT); const bf16* PG = (const bf16*)(ws + WS_DPG);
    const bf16* WG = (const bf16*)(ws + WS_DWG); const bf16* UG = (const bf16*)(ws + WS_DUG); const float* GC = (const float*)(ws + WS_DGC);
    float* OF = (float*)(ws + WS_SC);
    LAS v4u* Sfr = (LAS v4u*)lds;
    LAS v4u* Dfr = (LAS v4u*)(lds + 16384);
    LAS v4u* Dtf = (LAS v4u*)(lds + 16384 + 4096);
    LAS float* gam = (LAS float*)(lds + 16384 + 8192);
    const int m = lane & 31, half = lane >> 5;
    for (int item = blockIdx.x; item < NBP * 32 * 4; item += gridDim.x) {
        const int q = item & 3, bh = item >> 2, h = bh & 31, b = bh >> 5;
        const size_t uh0 = ((size_t)(b * 32 + h)) * NCH, uq0 = ((size_t)(b * 16 + (h >> 1))) * NCH;
        f32x16 S;
#pragma unroll
        for (int i = 0; i < 16; ++i) S[i] = 0.f;
        __syncthreads();
        if (wave < 4) { const v4u z = {0u, 0u, 0u, 0u}; Sfr[(0 * 4 + wave) * 128 + lane] = z; Sfr[(0 * 4 + wave) * 128 + 64 + lane] = z; }
        if (wave == 4) { const float gc = GC[(uh0 + 0) * 64 + lane], gl = __shfl(gc, 63); gam[lane] = __expf(gc); gam[128 + lane] = __expf(gl - gc); }
        for (int c = 0; c < NCH; ++c) {
            const int bufc = c & 1;
            const size_t uh = uh0 + c, uq = uq0 + c;
            __syncthreads();
            f32x16 acc;
            if (wave >= 4) {
                const int rt = wave & 1; const bool isq = wave >= 6;
                const int row = chunk_row(b, c, 32 * rt + m);
                const bf16* arow = isq ? QKVC + (size_t)(row < 0 ? 0 : row) * CDIM + (h >> 1) * 128 : WG + uh * 8192 + (size_t)(32 * rt + m) * 128;
#pragma unroll
                for (int i = 0; i < 16; ++i) acc[i] = 0.f;
                const bool rowok = !isq || row >= 0;
#pragma unroll
                for (int blk = 0; blk < 4; ++blk)
#pragma unroll
                    for (int s = 0; s < 2; ++s) { bf16x8 a = afrag_perm(arow, blk, s, half); if (!rowok) a = (bf16x8){0, 0, 0, 0, 0, 0, 0, 0};
                        const bf16x8 bfr = __builtin_bit_cast(bf16x8, Sfr[(bufc * 4 + blk) * 128 + s * 64 + lane]); acc = MFMA32(a, bfr, acc); }
                if (!isq) {
                    const bf16* up = UG + uh * 8192 + ((size_t)((rt * 4 + q) * 64 + lane)) * 16; const v4u u0 = *(const v4u*)up, u1 = *(const v4u*)(up + 8);
                    float uf[16]; { float t8[8]; unpack8(u0, t8);
#pragma unroll
                        for (int i = 0; i < 8; ++i) uf[i] = t8[i]; unpack8(u1, t8);
#pragma unroll
                        for (int i = 0; i < 8; ++i) uf[8 + i] = t8[i]; }
                    f32x16 dt;
#pragma unroll
                    for (int r = 0; r < 16; ++r) { acc[r] = uf[r] - acc[r]; dt[r] = acc[r] * gam[128 + bufc * 64 + 32 * rt + crow32(r, half)]; }
#pragma unroll
                    for (int s = 0; s < 2; ++s) { Dfr[(rt * 2 + s) * 64 + lane] = pack_frag(acc, s); Dtf[(rt * 2 + s) * 64 + lane] = pack_frag(dt, s); }
                }
            }
            __syncthreads();
            if (wave < 4) {
                const float gl = gam[bufc * 64 + 63];
#pragma unroll
                for (int i = 0; i < 16; ++i) S[i] *= gl;
                const bf16* krow = KT + uq * 8192 + (size_t)(32 * wave + m) * 64;
#pragma unroll
                for (int blk = 0; blk < 2; ++blk)
#pragma unroll
                    for (int s = 0; s < 2; ++s) S = MFMA32(afrag_perm(krow, blk, s, half), __builtin_bit_cast(bf16x8, Dtf[(blk * 2 + s) * 64 + lane]), S);
#pragma unroll
                for (int s = 0; s < 2; ++s) Sfr[((bufc ^ 1) * 4 + wave) * 128 + s * 64 + lane] = pack_frag(S, s);
            } else if (wave >= 6) {
                const int rt = wave & 1;
#pragma unroll
                for (int r = 0; r < 16; ++r) acc[r] *= gam[bufc * 64 + 32 * rt + crow32(r, half)];
                const bf16* prow_ = PG + uh * 4096 + (size_t)(32 * rt + m) * 64;
                for (int blk = 0; blk <= rt; ++blk)
#pragma unroll
                    for (int s = 0; s < 2; ++s) acc = MFMA32(afrag_perm(prow_, blk, s, half), __builtin_bit_cast(bf16x8, Dfr[(blk * 2 + s) * 64 + lane]), acc);
#pragma unroll
                for (int r = 0; r < 16; ++r) { const int row = chunk_row(b, c, 32 * rt + crow32(r, half)); if (row >= 0) OF[(size_t)row * DVW + h * 128 + 32 * q + m] = acc[r]; }
            } else if (wave == 4 && c + 1 < NCH) {
                const float gc = GC[(uh + 1) * 64 + lane], gl = __shfl(gc, 63); gam[(bufc ^ 1) * 64 + lane] = __expf(gc); gam[128 + (bufc ^ 1) * 64 + lane] = __expf(gl - gc);
            }
        }
        if (wave < 4) { float* o = out_state + ((size_t)((b * 32 + h) * 128 + 32 * wave)) * 128 + 32 * q + m;
#pragma unroll
            for (int r = 0; r < 16; ++r) o[(size_t)crow32(r, half) * 128] = S[r]; }
    }
    __syncthreads();
}
#undef MFMA32
template <int RT, int CT, class Epi>
__device__ __forceinline__ void small_gemm_unit(const bf16* A, int lda, const bf16* Bt, int ldb, int k0, int klen, LAS unsigned char* lds, const Epi& E, int tid, int wave, int lane) {
    const int r16 = lane & 15, q = lane >> 4;
    const int kw = klen >> 3;
    const bf16* ap = A + (size_t)r16 * lda + k0 + wave * kw + 8 * q;
    const bf16* bp = Bt + (size_t)r16 * ldb + k0 + wave * kw + 8 * q;
    pg8::f32x4 acc[RT][CT];
#pragma unroll
    for (int i = 0; i < RT; ++i)
#pragma unroll
        for (int j = 0; j < CT; ++j) acc[i][j] = (pg8::f32x4){0.f, 0.f, 0.f, 0.f};
#pragma unroll 2
    for (int ks = 0; ks < kw; ks += 32) {
        bf16x8 a[RT], b[CT];
#pragma unroll
        for (int i = 0; i < RT; ++i) a[i] = *(const bf16x8*)(ap + (size_t)(16 * i) * lda + ks);
#pragma unroll
        for (int j = 0; j < CT; ++j) b[j] = *(const bf16x8*)(bp + (size_t)(16 * j) * ldb + ks);
#pragma unroll
        for (int i = 0; i < RT; ++i)
#pragma unroll
            for (int j = 0; j < CT; ++j) acc[i][j] = __builtin_amdgcn_mfma_f32_16x16x32_bf16(a[i], b[j], acc[i][j], 0, 0, 0);
    }
    constexpr int NOUT = 256 * RT * CT;
    LAS float* part = (LAS float*)lds + wave * NOUT;
#pragma unroll
    for (int i = 0; i < RT; ++i)
#pragma unroll
        for (int j = 0; j < CT; ++j)
#pragma unroll
            for (int e = 0; e < 4; ++e) part[(16 * i + 4 * q + e) * (16 * CT) + 16 * j + r16] = acc[i][j][e];
    __syncthreads();
    for (int o = tid; o < NOUT; o += NTHREADS) { float sum = 0.f;
#pragma unroll
        for (int w = 0; w < 8; ++w) sum += ((LAS float*)lds)[w * NOUT + o];
        E(o / (16 * CT), o % (16 * CT), sum); }
    __syncthreads();
}
template <int ACT> struct SEpiRowsBf16 { bf16* O; int ldc; __device__ __forceinline__ void operator()(int row, int col, float v) const { if (ACT == 2) { v = v > 0.f ? v : 0.f; v = v * v; } O[(size_t)row * ldc + col] = f2bf(v); } };
struct SEpiF32 { float* O; int ldc; __device__ __forceinline__ void operator()(int row, int col, float v) const { O[(size_t)row * ldc + col] = v; } };
struct SEpiColsBf16 { bf16* O; int ldc; __device__ __forceinline__ void operator()(int row, int col, float v) const { O[(size_t)col * ldc + row] = f2bf(v); } };
template <int ACT> __device__ __forceinline__ void skinny_rows_bf16(const bf16* A, const bf16* Wt, int K, int nunits, bf16* O, int ldc, LAS unsigned char* lds, int tid, int wave, int lane) {
    for (int u = blockIdx.x; u < nunits; u += gridDim.x) { SEpiRowsBf16<ACT> E{O + (size_t)XROW0 * ldc + u * 64, ldc};
        small_gemm_unit<3, 4>(A + (size_t)XROW0 * K, K, Wt + (size_t)u * 64 * K, K, 0, K, lds, E, tid, wave, lane); }
}
__device__ __forceinline__ void skinny_rows_part(const bf16* A, const bf16* Wt, int K, float* ZP, LAS unsigned char* lds, int tid, int wave, int lane) {
    for (int u = blockIdx.x; u < 256; u += gridDim.x) { const int cgp = u & 31, ksl = u >> 5; SEpiF32 E{ZP + (size_t)ksl * XR * DM + cgp * 64, DM};
        small_gemm_unit<3, 4>(A + (size_t)XROW0 * K, K, Wt + (size_t)cgp * 64 * K, K, ksl * (K >> 3), K >> 3, lds, E, tid, wave, lane); }
}
template <int RT> __device__ __forceinline__ void tail_cols_bf16(const bf16* A, const bf16* Wt, int K, int c0, bf16* O, int ldc, LAS unsigned char* lds, int tid, int wave, int lane) {
    for (int u = blockIdx.x; u < MAINM / 32; u += gridDim.x) { SEpiColsBf16 E{O + (size_t)u * 32 * ldc + c0, ldc};
        small_gemm_unit<RT, 2>(Wt + (size_t)c0 * K, K, A + (size_t)u * 32 * K, K, 0, K, lds, E, tid, wave, lane); }
}

typedef __attribute__((address_space(4))) const unsigned long long* kargq_t;
#define KPF_(k) ((const float*)(const GAS float*)(q_[k]))
__device__ __forceinline__ void load_ptrs(Ptrs& P) {
    kargq_t q_ = (kargq_t)__builtin_amdgcn_kernarg_segment_ptr();
    asm volatile("" : "+s"(q_));
    P.x_prompt = KPF_(0); P.x_sample = KPF_(1); P.state_conv_a = KPF_(2); P.cache_k = KPF_(3);
    P.cache_v = KPF_(4); P.cache_ik = KPF_(5); P.state_conv_c = KPF_(6); P.state_delta = KPF_(7);
    P.page_table = ((const int*)(const GAS int*)(q_[8])); P.meta = KPF_(9); P.w_in_a = KPF_(10); P.conv_w_a = KPF_(11);
    P.w_out_a = KPF_(12); P.w_in_b = KPF_(13); P.w_out_b = KPF_(14); P.w_in_c = KPF_(15);
    P.conv_w_c = KPF_(16); P.a_log = KPF_(17); P.dt_bias = KPF_(18); P.norm_w = KPF_(19);
    P.w_out_c = KPF_(20); P.ln1_g = KPF_(21); P.ln1_b = KPF_(22); P.w1 = KPF_(23);
    P.w2 = KPF_(24); P.ln2_g = KPF_(25); P.ln2_b = KPF_(26);
    P.out = (float*)(GAS float*)(q_[27]); P.ws = (unsigned char*)(GAS unsigned char*)(q_[28]);
}
struct Args { const void* in[27]; float* out; unsigned char* ws; int ph_lo, ph_hi; };
constexpr int PH_PER_LAYER = 12, PH_END = 1 + 4 * PH_PER_LAYER;

__global__ void __launch_bounds__(NTHREADS, 2) mega_fwd(Args args) {
    extern __shared__ __attribute__((aligned(16))) unsigned char lds_raw[];
    LAS unsigned char* lds = (LAS unsigned char*)lds_raw;
    const int tid = threadIdx.x, lane = tid & 63, wave = __builtin_amdgcn_readfirstlane(tid >> 6);
    const int G_ = gridDim.x, NGW = G_ * NWAVES, NT = G_ * NTHREADS; (void)lane;
    unsigned char* ws = args.ws;
    const int lo = args.ph_lo, hi = args.ph_hi;
    const bool fused = (hi - lo) > 1;

    for (int u = tid; u < (LDS_BYTES - LDSCTL_OFF) / 4; u += NTHREADS) ((LAS unsigned*)(lds + LDSCTL_OFF))[u] = 0u;
    __syncthreads();
    volatile LAS unsigned* MISC = (volatile LAS unsigned*)(lds + MISC_OFF);
    XcdBarrier bar; bar.bar = (unsigned*)(ws + WS_CTL) + CW_BAR; bar.x = 0; bar.st = nullptr;
    if (fused) bar = xcd_barrier_post((unsigned*)(ws + WS_CTL) + CW_BAR, MISC + 8);
    bar.wv = wave;

#ifndef MK_SITES
#define MK_SITES 0xffffffffu
#endif
#define SITE(n) (((MK_SITES) >> (n)) & 1u)
#define IN(k) (lo <= (k) && (k) < hi)
#ifndef MK_DUP
#define MK_DUP 0u
#endif
#define NREP(n) ((((MK_DUP) >> (n)) & 1u) ? 2 : 1)
#define BEGIN_SITE(n, id) if (SITE(n) && IN(id)) { for (int rp_ = 0; rp_ < NREP(n); ++rp_) { Ptrs P; load_ptrs(P); unsigned char* ws = P.ws; (void)ws; \
    bf16* X = (bf16*)(P.ws + WS_X); float* Z = (float*)(P.ws + WS_Z); float* ZP = (float*)(P.ws + WS_ZP); bf16* Y = (bf16*)(P.ws + WS_Y); bf16* BIG = (bf16*)(P.ws + WS_BIG); (void)X; (void)Z; (void)ZP; (void)Y; (void)BIG;
#define END_SITE(id) SEAM(id); } }
#define LOCALS int tid_ = threadIdx.x; asm volatile("" : "+v"(tid_)); const int lane_ = tid_ & 63, wave_ = __builtin_amdgcn_readfirstlane(tid_ >> 6), gw_ = blockIdx.x * NWAVES + wave_, gtid_ = blockIdx.x * NTHREADS + tid_; (void)lane_; (void)wave_; (void)gw_; (void)gtid_
#define SEAM(k) do { if (fused && (k) + 1 < PH_END) xcd_barrier(bar); else __syncthreads(); } while (0)


    BEGIN_SITE(0, 0) LOCALS; p0_prologue(P, lds, gw_, NGW, wave_, lane_); END_SITE(0)

    for (int layer = 0; layer < 4; ++layer) {
        const int kind = layer % 3, j = layer / 3, base = 1 + layer * PH_PER_LAYER;
        if (kind == 0) {
            BEGIN_SITE(1, base + 0)
                const bf16* Wt = (const bf16*)(ws + WS_WA_IN + (size_t)j * WSZ_A_IN); pg8::Gemm g{X, Wt, MAINM, NA_IN, DM}; pg8::StaticOrder S; S.init(MAINM, NA_IN, G_, (int)blockIdx.x);
                pg8::EpiBf16<0> E{BIG, NA_IN, nullptr, 0, 0, 1.f};
                pg8::gemm_phase<pg8::EpiBf16<0>, pg8::StaticOrder, true, true>(lds, g, S, E, wave);
                { LOCALS; skinny_rows_bf16<0>(X, Wt, DM, NA_IN / 64, BIG, NA_IN, lds, tid_, wave_, lane_); }
                END_SITE(base + 0)
            BEGIN_SITE(2, base + 1)
                LOCALS; convA_phase(BIG, Y, P.conv_w_a + (size_t)j * 3 * DM, P.state_conv_a + (size_t)j * SBN * 2 * DM, P.out + O_CAP + (size_t)j * NBP * 2 * DM, P.out + O_CAS + (size_t)j * SBN * 2 * DM, gtid_, NT);
                END_SITE(base + 1)
            BEGIN_SITE(3, base + 2)
                const bf16* Wt = (const bf16*)(ws + WS_WA_OUT + (size_t)j * WSZ_A_OUT); pg8::Gemm g{Y, Wt, MAINM, DM, DM}; pg8::StaticOrder S; S.init(MAINM, DM, G_, (int)blockIdx.x);
                pg8::EpiF32 E{Z, DM};
                pg8::gemm_phase<pg8::EpiF32, pg8::StaticOrder, true, true>(lds, g, S, E, wave);
                { LOCALS; skinny_rows_part(Y, Wt, DM, ZP, lds, tid_, wave_, lane_); }
                END_SITE(base + 2)
        } else if (kind == 1) {
            BEGIN_SITE(4, base + 0)
                const bf16* Wt = (const bf16*)(ws + WS_WB_IN); pg8::Gemm g{X, Wt, MAINM, 4096, DM}; pg8::StaticOrder S; S.init(MAINM, 4096, G_, (int)blockIdx.x);
                pg8::EpiBf16<0> E{BIG, NB_PAD, nullptr, 0, 0, 1.f};
                pg8::gemm_phase<pg8::EpiBf16<0>, pg8::StaticOrder, true, true>(lds, g, S, E, wave);
                { LOCALS; tail_cols_bf16<5>(X, Wt, DM, 4096, BIG, NB_PAD, lds, tid_, wave_, lane_); skinny_rows_bf16<0>(X, Wt, DM, 4224 / 64, BIG, NB_PAD, lds, tid_, wave_, lane_); }
                END_SITE(base + 0)
            BEGIN_SITE(5, base + 1) LOCALS; rope_phase(BIG, P, gw_, NGW, lane_); END_SITE(base + 1)
            BEGIN_SITE(6, base + 2) LOCALS; indexer_sample(P, lds, tid_); indexer_prompt(P, gw_, NGW, lane_); END_SITE(base + 2)
            BEGIN_SITE(7, base + 3) LOCALS; select_phase(P, lds, gw_, NGW, tid_, wave_, lane_); END_SITE(base + 3)
            BEGIN_SITE(8, base + 4) LOCALS; dense_attn_phase(P, Y, (char*)lds_raw, wave_); attn_phase(P, Y, lds, gw_, NGW, wave_, lane_); END_SITE(base + 4)
            BEGIN_SITE(9, base + 5)
                const bf16* Wt = (const bf16*)(ws + WS_WB_OUT); pg8::Gemm g{Y, Wt, MAINM, DM, DM}; pg8::StaticOrder S; S.init(MAINM, DM, G_, (int)blockIdx.x);
                pg8::EpiF32 E{Z, DM};
                pg8::gemm_phase<pg8::EpiF32, pg8::StaticOrder, true, true>(lds, g, S, E, wave);
                { LOCALS; skinny_rows_part(Y, Wt, DM, ZP, lds, tid_, wave_, lane_); }
                END_SITE(base + 5)
        } else {
            BEGIN_SITE(10, base + 0)
                const bf16* Wt = (const bf16*)(ws + WS_WC_IN); pg8::Gemm g{X, Wt, MAINM, 12288, DM}; pg8::StaticOrder S; S.init(MAINM, 12288, G_, (int)blockIdx.x);
                pg8::EpiBf16<0> E{BIG, NC_PAD, nullptr, 0, 0, 1.f};
                pg8::gemm_phase<pg8::EpiBf16<0>, pg8::StaticOrder, true, true>(lds, g, S, E, wave);
                { LOCALS; tail_cols_bf16<4>(X, Wt, DM, 12288, BIG, NC_PAD, lds, tid_, wave_, lane_); skinny_rows_bf16<0>(X, Wt, DM, NC_IN / 64, BIG, NC_PAD, lds, tid_, wave_, lane_); }
                END_SITE(base + 0)
            BEGIN_SITE(11, base + 1) LOCALS; convC_phase(BIG, P, gw_, NGW, lane_); END_SITE(base + 1)
            BEGIN_SITE(19, base + 2) LOCALS; delta_d1(P.ws, lds, gw_, NGW, wave_, lane_); delta_phase(P, wave_, lane_); END_SITE(base + 2)
            BEGIN_SITE(20, base + 3) LOCALS; delta_d2(P.ws, gw_, NGW, lane_); END_SITE(base + 3)
            BEGIN_SITE(21, base + 4) LOCALS; delta_d3(P.ws, gw_, NGW, lane_); END_SITE(base + 4)
            BEGIN_SITE(22, base + 5) LOCALS; delta_d4(P.ws, P.out + O_DP, lds, tid_, wave_, lane_); END_SITE(base + 5)
            BEGIN_SITE(13, base + 6) LOCALS; normC_phase(BIG, Y, P, gw_, NGW, lane_); END_SITE(base + 6)
            BEGIN_SITE(14, base + 7)
                const bf16* Wt = (const bf16*)(ws + WS_WC_OUT); pg8::Gemm g{Y, Wt, MAINM, DM, DVW}; pg8::StaticOrder S; S.init(MAINM, DM, G_, (int)blockIdx.x);
                pg8::EpiF32 E{Z, DM};
                pg8::gemm_phase<pg8::EpiF32, pg8::StaticOrder, true, true>(lds, g, S, E, wave);
                { LOCALS; skinny_rows_part(Y, Wt, DVW, ZP, lds, tid_, wave_, lane_); }
                END_SITE(base + 7)
        }
        BEGIN_SITE(15, base + 8) LOCALS; ln_phase(Z, ZP, X, P.ln1_g + (size_t)layer * DM, P.ln1_b + (size_t)layer * DM, nullptr, nullptr, gw_, NGW, lane_); END_SITE(base + 10)
        BEGIN_SITE(16, base + 9)
            const bf16* Wt = (const bf16*)(ws + WS_W1 + (size_t)layer * WSZ_W1); pg8::Gemm g{X, Wt, MAINM, FF, DM}; pg8::StaticOrder S; S.init(MAINM, FF, G_, (int)blockIdx.x);
            pg8::EpiBf16<2> E{BIG, FF, nullptr, 0, 0, 1.f};
            pg8::gemm_phase<pg8::EpiBf16<2>, pg8::StaticOrder, true, true>(lds, g, S, E, wave);
            { LOCALS; skinny_rows_bf16<2>(X, Wt, DM, FF / 64, BIG, FF, lds, tid_, wave_, lane_); }
            END_SITE(base + 9)
        BEGIN_SITE(17, base + 10)
            const bf16* Wt = (const bf16*)(ws + WS_W2 + (size_t)layer * WSZ_W2); pg8::Gemm g{BIG, Wt, MAINM, DM, FF}; pg8::StaticOrder S; S.init(MAINM, DM, G_, (int)blockIdx.x);
            pg8::EpiF32 E{Z, DM};
            pg8::gemm_phase<pg8::EpiF32, pg8::StaticOrder, true, true>(lds, g, S, E, wave);
            { LOCALS; skinny_rows_part(BIG, Wt, FF, ZP, lds, tid_, wave_, lane_); }
            END_SITE(base + 10)
        BEGIN_SITE(18, base + 11)
            const bool last = layer == 3;
            LOCALS; ln_phase(Z, ZP, X, P.ln2_g + (size_t)layer * DM, P.ln2_b + (size_t)layer * DM, last ? P.out + O_YP : nullptr, last ? P.out + O_YS : nullptr, gw_, NGW, lane_);
            if (!last) SEAM(base + 11); } }
    }
#undef IN
#undef SEAM
}

#ifndef MK_SPLIT
#define MK_SPLIT 0
#endif
extern "C" void kernel_launch(void* const* d_in, const int* in_sizes, int n_in, void* d_out, int out_size, void* d_ws, size_t ws_size, hipStream_t stream) {
    static int grid = 0;
    if (grid == 0) {
        if (n_in != 27 || (size_t)out_size != O_END || ws_size < WS_END) { fprintf(stderr, "kernel_launch: unexpected shapes: n_in %d out %d (want %zu) ws %zu (want >= %zu)\n", n_in, out_size, (size_t)O_END, ws_size, (size_t)WS_END); grid = -1; return; }
        int dev = 0, cus = 0;
        if (hipGetDevice(&dev) != hipSuccess || hipDeviceGetAttribute(&cus, hipDeviceAttributeMultiprocessorCount, dev) != hipSuccess) { grid = -1; return; }
        if (hipFuncSetAttribute((const void*)mega_fwd, hipFuncAttributeMaxDynamicSharedMemorySize, LDS_BYTES) != hipSuccess) { fprintf(stderr, "kernel_launch: hipFuncSetAttribute failed\n"); grid = -1; return; }
        int per_cu = 0;
        if (hipOccupancyMaxActiveBlocksPerMultiprocessor(&per_cu, (const void*)mega_fwd, NTHREADS, LDS_BYTES) != hipSuccess || per_cu < 1) fprintf(stderr, "kernel_launch: occupancy query reports %d\n", per_cu);
        (void)hipGetLastError();
        grid = cus;
    }
    if (grid < 0) return;
    (void)hipMemsetAsync((char*)d_ws + WS_CTL, 0, CTL_ZERO_BYTES, stream);
    Args a{};
    for (int i = 0; i < 27; ++i) a.in[i] = d_in[i];
    a.out = (float*)d_out; a.ws = (unsigned char*)d_ws;
#if MK_SPLIT
    for (int ph = 0; ph < PH_END; ++ph) {
        bool exists = (ph == 0);
        if (ph > 0) { const int layer = (ph - 1) / PH_PER_LAYER, l = (ph - 1) % PH_PER_LAYER, kind = layer % 3; const int nmix = kind == 0 ? 3 : (kind == 1 ? 6 : 8); exists = (l < nmix) || (l >= 8 && l <= 11); }
        if (!exists) continue;
        a.ph_lo = ph; a.ph_hi = ph + 1;
        hipLaunchKernelGGL(mega_fwd, dim3(grid), dim3(NTHREADS), LDS_BYTES, stream, a);
    }
#else
    a.ph_lo = 0; a.ph_hi = PH_END;
    hipLaunchKernelGGL(mega_fwd, dim3(grid), dim3(NTHREADS), LDS_BYTES, stream, a);
#endif
    const hipError_t le = hipPeekAtLastError();
    if (le != hipSuccess) fprintf(stderr, "kernel_launch: launch failed: %s\n", hipGetErrorName(le));
}
```

```cpp
#include <hip/hip_runtime.h>
#include <cstdio>
#include <cstdint>
#include <cmath>
__device__ __forceinline__ int flane() { return (int)__builtin_amdgcn_mbcnt_hi(~0u, __builtin_amdgcn_mbcnt_lo(~0u, 0u)); }
namespace pg8 {
#define PG8_LAS __attribute__((address_space(3)))
typedef unsigned short bf16_t;
typedef short bf16x8 __attribute__((ext_vector_type(8)));
typedef float f32x4 __attribute__((ext_vector_type(4)));
typedef unsigned u32x4 __attribute__((ext_vector_type(4)));
constexpr int BM = 256, BK = 64, HALF = 128, HTB = HALF * BK * 2  , STAGE_BYTES = 8 * HTB, NXCD = 8, WGM = 8;

__host__ __device__ __forceinline__ int lds_byte(int r, int c) { const int st = (r >> 4) * 2 + (c >> 5), rr = r & 15, cc = c & 31, ob = rr * 64 + cc * 2; return st * 1024 + (ob ^ (((ob >> 9) & 1) << 5)); }
__host__ __device__ __forceinline__ void stage_rc(int b, int& R, int& C) { const int st = b / 1024, sb = b % 1024, swz = sb ^ (((sb >> 9) & 1) << 5); R = (st >> 1) * 16 + swz / 64; C = (st & 1) * 32 + (swz % 64) / 2; }
__host__ __device__ __forceinline__ int perm32(int rho) { const int n = rho >> 4, i = rho & 15; return 8 * (i >> 2) + 4 * n + (i & 3); }

struct Unit { int pm, pn; };
struct Gemm { const bf16_t* A; const bf16_t* Bt; int M, N, K; };

struct StaticOrder {
    int nM, nN, nwg, G, c;
    __host__ __device__ void init(int M, int N, int G_, int c_) { nM = M / BM; nN = N / BM; nwg = nM * nN; G = G_; c = c_; }
    __host__ __device__ bool next(int i, Unit& u) const {
        const long L = (long)i * G + c; if (L >= nwg) return false;
        int wgid = (int)L; { const int q = nwg / NXCD, r = nwg % NXCD, xcd = wgid % NXCD, off = wgid / NXCD; wgid = (xcd < r ? xcd * (q + 1) : r * (q + 1) + (xcd - r) * q) + off; }
        const int nig = WGM * nN, gid = wgid / nig, fm = gid * WGM, gsz = (nM - fm) < WGM ? (nM - fm) : WGM;
        u.pm = fm + ((wgid % nig) % gsz); u.pn = (wgid % nig) / gsz; return true;
    }
    __device__ __forceinline__ void a_ready(const Unit&) const {}
    __device__ __forceinline__ void done(const Unit&) const {}
};

__device__ __forceinline__ unsigned cvt_pk_bf16(float lo, float hi) { unsigned r; asm volatile("v_cvt_pk_bf16_f32 %0, %1, %2" : "=v"(r) : "v"(lo), "v"(hi)); return r; }
typedef float f32x2 __attribute__((ext_vector_type(2)));
__device__ __forceinline__ f32x2 gelu_pk(f32x2 v) {
    const f32x2 av = __builtin_elementwise_abs(v), d = av * 0.2316418882f + 1.0f;
    f32x2 t; t.x = __builtin_amdgcn_rcpf(d.x); t.y = __builtin_amdgcn_rcpf(d.y);
    f32x2 q = t * 0.5307027145f + (-0.7265760135f); q = q * t + 0.7107068705f; q = q * t + (-0.142248368f); q = q * t + 0.127414796f; q = q * t;
    const f32x2 s = (v * v) * (-0.72134752044f);
    f32x2 e; e.x = __builtin_amdgcn_exp2f(s.x); e.y = __builtin_amdgcn_exp2f(s.y);
    const f32x2 m = v * (q * e), r = v - m;
    f32x2 o; o.x = v.x < 0.f ? m.x : r.x; o.y = v.y < 0.f ? m.y : r.y; return o;
}

template <int ACT  > struct EpiBf16 {
    static constexpr bool PERM = true, AFTER_DRAIN = false; static_assert(ACT == 0 || ACT == 1 || ACT == 2, "EpiBf16: ACT is 0 (none), 1 (gelu_pk) or 2 (relu^2)");
    bf16_t* O; int ldc; const float* bias; int split_cols; size_t split_stride; float scale0;
    __device__ __forceinline__ void operator()(const f32x4 (&acc)[2][2][4][2], const Unit& u, int wr, int wc, int fr, int fq) const {
        const int row0 = u.pm * BM + wr * 64 + fr; int colt = u.pn * BM; bf16_t* base = O;
        float sc = 1.f; if (split_cols) { const int t = colt / split_cols; base += (size_t)t * split_stride; colt -= t * split_cols; if (t == 0) sc = scale0; }
        const int col0 = colt + wc * 32 + 8 * fq, bcol0 = u.pn * BM + wc * 32 + 8 * fq;
        f32x4 bv[2][2];
#pragma unroll
        for (int bj = 0; bj < 2; ++bj)
#pragma unroll
            for (int n = 0; n < 2; ++n) bv[bj][n] = bias ? *(const f32x4*)(bias + bcol0 + bj * HALF + 4 * n) : (f32x4){0.f, 0.f, 0.f, 0.f};
#pragma unroll
        for (int ai = 0; ai < 2; ++ai)
#pragma unroll
            for (int m = 0; m < 4; ++m) { bf16_t* rowp = base + (size_t)(row0 + ai * HALF + m * 16) * ldc + col0;
#pragma unroll
                for (int bj = 0; bj < 2; ++bj) { f32x4 v0 = acc[ai][bj][m][0] + bv[bj][0], v1 = acc[ai][bj][m][1] + bv[bj][1];
                    if (ACT == 1) { f32x2 a = gelu_pk((f32x2){v0[0], v0[1]}), b = gelu_pk((f32x2){v0[2], v0[3]}), c = gelu_pk((f32x2){v1[0], v1[1]}), d = gelu_pk((f32x2){v1[2], v1[3]});
                        v0 = (f32x4){a.x, a.y, b.x, b.y}; v1 = (f32x4){c.x, c.y, d.x, d.y}; }
                    if (ACT == 2) { _Pragma("unroll") for (int q_ = 0; q_ < 4; ++q_) { const float a_ = v0[q_] > 0.f ? v0[q_] : 0.f, b_ = v1[q_] > 0.f ? v1[q_] : 0.f; v0[q_] = a_ * a_; v1[q_] = b_ * b_; } }
                    v0 = v0 * sc; v1 = v1 * sc; u32x4 w; w.x = cvt_pk_bf16(v0[0], v0[1]); w.y = cvt_pk_bf16(v0[2], v0[3]); w.z = cvt_pk_bf16(v1[0], v1[1]); w.w = cvt_pk_bf16(v1[2], v1[3]);
                    *(u32x4*)(rowp + bj * HALF) = w; } }
    }
};


struct EpiF32 {
    static constexpr bool PERM = false, AFTER_DRAIN = false;
    float* C; int ldc;
    __device__ __forceinline__ void operator()(const f32x4 (&acc)[2][2][4][2], const Unit& u, int wr, int wc, int fr, int fq) const {
        const int row0 = u.pm * BM + wr * 64 + fr, col0 = u.pn * BM + wc * 32 + 4 * fq;
#pragma unroll
        for (int ai = 0; ai < 2; ++ai)
#pragma unroll
            for (int m = 0; m < 4; ++m) { float* rowp = C + (size_t)(row0 + ai * HALF + m * 16) * ldc + col0;
#pragma unroll
                for (int bj = 0; bj < 2; ++bj)
#pragma unroll
                    for (int n = 0; n < 2; ++n) *(f32x4*)(rowp + bj * HALF + n * 16) = acc[ai][bj][m][n]; }
    }
};
struct PanelStats {
    unsigned* xbuf;
    unsigned* cnt;
    unsigned* tmo;
    int ntn; float eps;
    unsigned code;
    __device__ __forceinline__ bool run(const f32x4 (&v)[2][2][4][2], const Unit& u, int wr, int wc, int fr, int fq, PG8_LAS unsigned char* lds, int wid, int lane) const {
        typedef float f32x2v __attribute__((ext_vector_type(2)));
        PG8_LAS f32x2v* P = (PG8_LAS f32x2v*)lds;
        PG8_LAS f32x2v* S = (PG8_LAS f32x2v*)(lds + 8192);
        PG8_LAS unsigned* flag = (PG8_LAS unsigned*)(lds + 8192 + 2048);
#pragma unroll
        for (int ai = 0; ai < 2; ++ai)
#pragma unroll
            for (int m = 0; m < 4; ++m) {
                float s = 0.f;
#pragma unroll
                for (int bj = 0; bj < 2; ++bj)
#pragma unroll
                    for (int n = 0; n < 2; ++n) { const f32x4 x = v[ai][bj][m][n]; s += (x[0] + x[1]) + (x[2] + x[3]); }
                s += __shfl_xor(s, 16); s += __shfl_xor(s, 32);
                const float mw = s * (1.0f / 64.0f); float q = 0.f;
#pragma unroll
                for (int bj = 0; bj < 2; ++bj)
#pragma unroll
                    for (int n = 0; n < 2; ++n) { const f32x4 d = v[ai][bj][m][n] - mw; q += (d[0] * d[0] + d[1] * d[1]) + (d[2] * d[2] + d[3] * d[3]); }
                q += __shfl_xor(q, 16); q += __shfl_xor(q, 32);
                if (fq == 0) P[(ai * HALF + wr * 64 + m * 16 + fr) * 4 + wc] = (f32x2v){mw, q};
            }
        asm volatile("s_waitcnt lgkmcnt(0)" ::: "memory"); __builtin_amdgcn_s_barrier(); asm volatile("" ::: "memory");
#if defined(BROKEN_EXCHANGE_NO_WAIT)
#warning BROKEN CONTROL BUILD: the row-statistics exchange does not wait; results are wrong by design
        if (blockIdx.x >= 64) { const long long t0_ = clock64(); while (clock64() - t0_ < 60000) __builtin_amdgcn_s_sleep(8); }
#endif
        const int row = wid * 32 + (lane & 31);
        if (lane < 32) {
            const f32x2v a = P[row * 4 + 0], b = P[row * 4 + 1], c = P[row * 4 + 2], d = P[row * 4 + 3];
            const float mt = (a.x + b.x + c.x + d.x) * 0.25f;
            const float da = a.x - mt, db = b.x - mt, dc = c.x - mt, dd = d.x - mt;
            const float m2 = (a.y + b.y) + (c.y + d.y) + 64.0f * ((da * da + db * db) + (dc * dc + dd * dd));
            unsigned long long* slot = (unsigned long long*)xbuf + ((size_t)(u.pm * BM + row) * 4 + u.pn);
            __hip_atomic_store(slot, ((unsigned long long)__float_as_uint(m2) << 32) | __float_as_uint(mt), __ATOMIC_RELAXED, __HIP_MEMORY_SCOPE_AGENT);
        }
        asm volatile("s_waitcnt vmcnt(0)" ::: "memory");
        if (lane == 0) __hip_atomic_fetch_add(cnt + 64 * u.pm, 1u, __ATOMIC_RELAXED, __HIP_MEMORY_SCOPE_AGENT);
        if (wid == 0) {
            bool dead = false; const unsigned long long t0 = __builtin_amdgcn_s_memrealtime(); const unsigned want = 8u * (unsigned)ntn;
            for (;;) {
#if defined(BROKEN_EXCHANGE_NO_WAIT)
                break;
#endif
                if ((unsigned)__builtin_amdgcn_readfirstlane(__hip_atomic_load(cnt + 64 * u.pm, __ATOMIC_RELAXED, __HIP_MEMORY_SCOPE_AGENT)) >= want) break;
                if (__builtin_amdgcn_s_memrealtime() - t0 > 2000000ull) {
                    if (lane == 0) { unsigned expect = 0u; __hip_atomic_compare_exchange_strong(tmo + 1, &expect, code | (unsigned)(u.pm & 0xff), __ATOMIC_RELAXED, __ATOMIC_RELAXED, __HIP_MEMORY_SCOPE_AGENT);
                                     __hip_atomic_store(tmo, 1u, __ATOMIC_RELAXED, __HIP_MEMORY_SCOPE_AGENT); }
                    dead = true; break; }
                __builtin_amdgcn_s_sleep(2);
            }
            __builtin_amdgcn_fence(__ATOMIC_ACQUIRE, "agent");
            if (lane == 0) flag[0] = dead ? 1u : 0u;
        }
        asm volatile("s_waitcnt vmcnt(0) lgkmcnt(0)" ::: "memory"); __builtin_amdgcn_s_barrier(); asm volatile("" ::: "memory");
        const bool bad = flag[0] != 0u;
        if (lane < 32) {
            const unsigned long long* slot = (const unsigned long long*)xbuf + (size_t)(u.pm * BM + row) * 4; float mt[4], m2[4]; float ms = 0.f;
#pragma unroll
            for (int t = 0; t < 4; ++t) { if (t < ntn) { const unsigned long long w = __hip_atomic_load(slot + t, __ATOMIC_RELAXED, __HIP_MEMORY_SCOPE_AGENT); mt[t] = __uint_as_float((unsigned)w); m2[t] = __uint_as_float((unsigned)(w >> 32)); } else { mt[t] = 0.f; m2[t] = 0.f; } ms += mt[t]; }
            const float mean = ms / (float)ntn; float q = 0.f;
#pragma unroll
            for (int t = 0; t < 4; ++t) if (t < ntn) { const float dm = mt[t] - mean; q += m2[t] + 256.0f * dm * dm; }
            S[row] = (f32x2v){mean, 1.0f / sqrtf(q / (256.0f * (float)ntn) + eps)};
        }
        asm volatile("s_waitcnt lgkmcnt(0)" ::: "memory"); __builtin_amdgcn_s_barrier(); asm volatile("" ::: "memory");
        return bad;
    }
};
struct EpiLnRes {
    static constexpr bool PERM = false, AFTER_DRAIN = true;
    const float* base; float* out; int ldc; const float* bias; PanelStats st; unsigned poison;
    __device__ __forceinline__ void fused(f32x4 (&acc)[2][2][4][2], const Unit& u, int wr, int wc, int fr, int fq, PG8_LAS unsigned char* lds, int wid, int lane) const {
        typedef float f32x2v __attribute__((ext_vector_type(2)));
        const PG8_LAS f32x2v* S = (const PG8_LAS f32x2v*)(lds + 8192);
        const int col0 = u.pn * BM + wc * 32 + 4 * fq;
#pragma unroll
        for (int bj = 0; bj < 2; ++bj)
#pragma unroll
            for (int n = 0; n < 2; ++n) { const f32x4 bv = bias ? *(const f32x4*)(bias + col0 + bj * HALF + n * 16) : (f32x4){0.f, 0.f, 0.f, 0.f};
#pragma unroll
                for (int ai = 0; ai < 2; ++ai)
#pragma unroll
                    for (int m = 0; m < 4; ++m) acc[ai][bj][m][n] += bv; }
        f32x4 pre[4][2][2];
#pragma unroll
        for (int m = 0; m < 4; ++m) { const size_t off = (size_t)(u.pm * BM + wr * 64 + m * 16 + fr) * ldc + col0;
#pragma unroll
            for (int bj = 0; bj < 2; ++bj)
#pragma unroll
                for (int n = 0; n < 2; ++n) pre[m][bj][n] = *(const f32x4*)(base + off + bj * HALF + n * 16); }
        const bool bad = st.run(acc, u, wr, wc, fr, fq, lds, wid, lane) || poison != 0u;
        const float qnan = __builtin_nanf("");
#pragma unroll
        for (int ai = 0; ai < 2; ++ai)
#pragma unroll
            for (int m = 0; m < 4; ++m) { const int r = ai * HALF + wr * 64 + m * 16 + fr; const f32x2v sr = S[r]; const size_t off = (size_t)(u.pm * BM + r) * ldc + col0;
#pragma unroll
                for (int bj = 0; bj < 2; ++bj)
#pragma unroll
                    for (int n = 0; n < 2; ++n) { const f32x4 bs = ai == 0 ? pre[m][bj][n] : *(const f32x4*)(base + off + bj * HALF + n * 16); f32x4 o = bs + (acc[ai][bj][m][n] - sr.x) * sr.y;
                        if (bad) o = (f32x4){qnan, qnan, qnan, qnan}; *(f32x4*)(out + off + bj * HALF + n * 16) = o; }
                if (m & 1) asm volatile("" ::: "memory"); }
    }
};
struct EpiLnResLn {
    static constexpr bool PERM = false, AFTER_DRAIN = true;
    const float* base; float* out; bf16_t* xn; int ldc; const float* bias; PanelStats st1, st2; unsigned poison;
    __device__ __forceinline__ void fused(f32x4 (&acc)[2][2][4][2], const Unit& u, int wr, int wc, int fr, int fq, PG8_LAS unsigned char* lds, int wid, int lane) const {
        typedef float f32x2v __attribute__((ext_vector_type(2))); typedef unsigned u32x2v __attribute__((ext_vector_type(2)));
        const PG8_LAS f32x2v* S = (const PG8_LAS f32x2v*)(lds + 8192);
        const int col0 = u.pn * BM + wc * 32 + 4 * fq;
#pragma unroll
        for (int bj = 0; bj < 2; ++bj)
#pragma unroll
            for (int n = 0; n < 2; ++n) { const f32x4 bv = bias ? *(const f32x4*)(bias + col0 + bj * HALF + n * 16) : (f32x4){0.f, 0.f, 0.f, 0.f};
#pragma unroll
                for (int ai = 0; ai < 2; ++ai)
#pragma unroll
                    for (int m = 0; m < 4; ++m) acc[ai][bj][m][n] += bv; }
        bool bad = st1.run(acc, u, wr, wc, fr, fq, lds, wid, lane) || poison != 0u;
        const float qnan = __builtin_nanf("");
#pragma unroll
        for (int ai = 0; ai < 2; ++ai)
#pragma unroll
            for (int m = 0; m < 4; ++m) { const int r = ai * HALF + wr * 64 + m * 16 + fr; const f32x2v sr = S[r]; const size_t off = (size_t)(u.pm * BM + r) * ldc + col0;
#pragma unroll
                for (int bj = 0; bj < 2; ++bj)
#pragma unroll
                    for (int n = 0; n < 2; ++n) { const f32x4 bs = *(const f32x4*)(base + off + bj * HALF + n * 16); acc[ai][bj][m][n] = bs + (acc[ai][bj][m][n] - sr.x) * sr.y; }
                asm volatile("" : "+v"(acc[ai][0][m][0]), "+v"(acc[ai][0][m][1]), "+v"(acc[ai][1][m][0]), "+v"(acc[ai][1][m][1]));
                if (m & 1) asm volatile("" ::: "memory"); }
        const bool bad1 = bad;
        bad = st2.run(acc, u, wr, wc, fr, fq, lds, wid, lane) || bad;
#pragma unroll
        for (int ai = 0; ai < 2; ++ai)
#pragma unroll
            for (int m = 0; m < 4; ++m) { const int r = ai * HALF + wr * 64 + m * 16 + fr; const f32x2v sr = S[r]; const size_t off = (size_t)(u.pm * BM + r) * ldc + col0;
#pragma unroll
                for (int bj = 0; bj < 2; ++bj)
#pragma unroll
                    for (int n = 0; n < 2; ++n) { const f32x4 x1 = acc[ai][bj][m][n]; *(f32x4*)(out + off + bj * HALF + n * 16) = bad1 ? (f32x4){qnan, qnan, qnan, qnan} : x1;
                        const f32x4 o = (x1 - sr.x) * sr.y; u32x2v w; w.x = cvt_pk_bf16(o[0], o[1]); w.y = cvt_pk_bf16(o[2], o[3]);
                        if (bad) { w.x = 0x7fc07fc0u; w.y = 0x7fc07fc0u; } *(u32x2v*)(xn + off + bj * HALF + n * 16) = w; }
                asm volatile("" ::: "memory"); }
    }
};

template <class Epi, class Sched, bool ALIGN_EPI = false, bool SP2 = false>
__device__ __forceinline__ void gemm_phase(PG8_LAS unsigned char* lds, const Gemm g, const Sched& S, const Epi& E, int wv) {
    int tid0_ = threadIdx.x; asm volatile("" : "+v"(tid0_)); (void)wv;
    const int tid = tid0_, wid = __builtin_amdgcn_readfirstlane(tid >> 6), lane = tid & 63, wr = wid >> 2, wc = wid & 3, fr = lane & 15, fq = lane >> 4;
    const int K = g.K, nt = K / BK;
    unsigned voffA[2], voffB[2];
#pragma unroll
    for (int i = 0; i < 2; ++i) { int R, C; stage_rc(tid * 16 + i * 8192, R, C); const int Rb = Epi::PERM ? ((R & ~31) + perm32(R & 31)) : R;
        voffA[i] = (unsigned)(R * K + C) * 2u; voffB[i] = (unsigned)(Rb * K + C) * 2u; }
    const size_t kstep = (size_t)(BK * 2);
    const size_t hstep = (size_t)HALF * K * 2;
    const size_t tstep = 2 * hstep;
    const unsigned ldsw = (unsigned)wid * 1024u;
    const int aoff = lds_byte(wr * 64 + fr, fq * 8), boff = lds_byte(wc * 32 + fr, fq * 8);
#define PG8_SA(b, h) (((b) * 2 + (h)) * HTB)
#define PG8_SB(b, h) ((4 + (b) * 2 + (h)) * HTB)
#define PG8_STAGE(bufoff, gbase, voff) do { _Pragma("unroll") for (int _i = 0; _i < 2; ++_i) \
        __builtin_amdgcn_global_load_lds((const unsigned*)((const char*)(gbase) + (voff)[_i]), (PG8_LAS unsigned*)(lds + (bufoff) + ldsw + _i * 8192), 16, 0, 0); } while (0)
#define PG8_LDA(dst, b, h) do { _Pragma("unroll") for (int m = 0; m < 4; ++m) _Pragma("unroll") for (int k = 0; k < 2; ++k) dst[m][k] = *(const PG8_LAS bf16x8*)(lds + PG8_SA(b, h) + aoff + m * 2048 + k * 1024); } while (0)
#define PG8_LDB(dst, b, h) do { _Pragma("unroll") for (int n = 0; n < 2; ++n) _Pragma("unroll") for (int k = 0; k < 2; ++k) dst[n][k] = *(const PG8_LAS bf16x8*)(lds + PG8_SB(b, h) + boff + n * 2048 + k * 1024); } while (0)
#define PG8_MMA(ai, bj, At, Bt) do { __builtin_amdgcn_s_setprio(1); _Pragma("unroll") for (int m = 0; m < 4; ++m) _Pragma("unroll") for (int n = 0; n < 2; ++n) _Pragma("unroll") for (int k = 0; k < 2; ++k) \
        acc[ai][bj][m][n] = __builtin_amdgcn_mfma_f32_16x16x32_bf16(Bt[n][k], At[m][k], acc[ai][bj][m][n], 0, 0, 0); __builtin_amdgcn_s_setprio(0); } while (0)
#define PG8_WAIT_V(n) asm volatile("s_waitcnt vmcnt(" #n ")" ::: "memory")
#define PG8_WAIT_L(n) asm volatile("s_waitcnt lgkmcnt(" #n ")" ::: "memory")
#define PG8_BAR __builtin_amdgcn_s_barrier()
#define PG8_SCHED __builtin_amdgcn_sched_barrier(0)
    Unit cur, nxt; int ui = 0;
    if (!S.next(0, cur)) return;
    f32x4 acc[2][2][4][2];
#pragma unroll
    for (int a = 0; a < 2; ++a)
#pragma unroll
        for (int b = 0; b < 2; ++b)
#pragma unroll
            for (int m = 0; m < 4; ++m)
#pragma unroll
                for (int n = 0; n < 2; ++n) acc[a][b][m][n] = (f32x4){0.f, 0.f, 0.f, 0.f};
    bf16x8 At[4][2], B0[2][2], B1[2][2];
    const char* cA = (const char*)g.A + (size_t)cur.pm * tstep; const char* cB = (const char*)g.Bt + (size_t)cur.pn * tstep;
    S.a_ready(cur);
    if constexpr (SP2) {
        PG8_STAGE(PG8_SB(0, 0), cB, voffB); PG8_STAGE(PG8_SB(0, 1), cB + hstep, voffB); PG8_STAGE(PG8_SA(0, 0), cA, voffA); PG8_STAGE(PG8_SA(0, 1), cA + hstep, voffA);
        if (wr == 1) PG8_BAR;
        PG8_WAIT_V(2); PG8_BAR;
        PG8_STAGE(PG8_SB(1, 0), cB + kstep, voffB); PG8_STAGE(PG8_SA(1, 0), cA + kstep, voffA); PG8_STAGE(PG8_SB(1, 1), cB + hstep + kstep, voffB);
        PG8_WAIT_V(6); PG8_BAR;
    } else {
        PG8_STAGE(PG8_SB(0, 0), cB, voffB); PG8_STAGE(PG8_SA(0, 0), cA, voffA); PG8_STAGE(PG8_SB(0, 1), cB + hstep, voffB); PG8_STAGE(PG8_SA(0, 1), cA + hstep, voffA);
        if (wr == 1) PG8_BAR;
        PG8_WAIT_V(4); PG8_BAR;
        PG8_STAGE(PG8_SB(1, 0), cB + kstep, voffB); PG8_STAGE(PG8_SA(1, 0), cA + kstep, voffA); PG8_STAGE(PG8_SB(1, 1), cB + hstep + kstep, voffB);
        PG8_WAIT_V(6); PG8_BAR;
    }
    for (;;) {
        const bool has_next = S.next(ui + 1, nxt);
        const char* nA = has_next ? (const char*)g.A + (size_t)nxt.pm * tstep : cA; const char* nB = has_next ? (const char*)g.Bt + (size_t)nxt.pn * tstep : cB;
        for (int t = 0; t < nt; t += 2) {
            const bool last = (t == nt - 2);
            const char* a1 = cA + (size_t)(t + 1) * kstep;
            const char* a2 = last ? nA : cA + (size_t)(t + 2) * kstep; const char* b2 = last ? nB : cB + (size_t)(t + 2) * kstep;
            const char* a3 = a2 + kstep; const char* b3 = b2 + kstep;
            if (last && has_next) S.a_ready(nxt);
            if constexpr (SP2) {
            PG8_LDB(B0, 0, 0); PG8_LDB(B1, 0, 1); PG8_SCHED; PG8_LDA(At, 0, 0); PG8_STAGE(PG8_SA(1, 1), a1 + hstep, voffA);
            PG8_WAIT_V(8); PG8_WAIT_L(0); PG8_BAR; PG8_MMA(0, 0, At, B0); PG8_MMA(0, 1, At, B1); PG8_BAR; PG8_SCHED;
            PG8_LDA(At, 0, 1); PG8_STAGE(PG8_SB(0, 0), b2, voffB); PG8_STAGE(PG8_SB(0, 1), b2 + hstep, voffB); PG8_STAGE(PG8_SA(0, 0), a2, voffA);
            PG8_WAIT_V(8); PG8_WAIT_L(0); PG8_BAR; PG8_MMA(1, 0, At, B0); PG8_MMA(1, 1, At, B1); PG8_BAR; PG8_SCHED;
            PG8_LDB(B0, 1, 0); PG8_LDB(B1, 1, 1); PG8_SCHED; PG8_LDA(At, 1, 0); PG8_STAGE(PG8_SA(0, 1), a2 + hstep, voffA);
            PG8_WAIT_V(8); PG8_WAIT_L(0); PG8_BAR; PG8_MMA(0, 0, At, B0); PG8_MMA(0, 1, At, B1); PG8_BAR; PG8_SCHED;
            PG8_LDA(At, 1, 1); PG8_STAGE(PG8_SB(1, 0), b3, voffB); PG8_STAGE(PG8_SB(1, 1), b3 + hstep, voffB); PG8_STAGE(PG8_SA(1, 0), a3, voffA);
            PG8_WAIT_V(8); PG8_WAIT_L(0); PG8_BAR; PG8_MMA(1, 0, At, B0); PG8_MMA(1, 1, At, B1); PG8_BAR; PG8_SCHED;
            } else {
            PG8_LDB(B0, 0, 0); PG8_SCHED; PG8_LDA(At, 0, 0); PG8_STAGE(PG8_SA(1, 1), a1 + hstep, voffA);
            PG8_WAIT_L(8); PG8_BAR; PG8_WAIT_L(0); PG8_MMA(0, 0, At, B0); PG8_BAR; PG8_SCHED;
            PG8_LDB(B1, 0, 1); PG8_STAGE(PG8_SB(0, 0), b2, voffB);
            PG8_BAR; PG8_WAIT_L(0); PG8_MMA(0, 1, At, B1); PG8_BAR;
            PG8_LDA(At, 0, 1); PG8_STAGE(PG8_SA(0, 0), a2, voffA);
            PG8_BAR; PG8_WAIT_L(0); PG8_MMA(1, 0, At, B0); PG8_BAR; PG8_SCHED;
            PG8_STAGE(PG8_SB(0, 1), b2 + hstep, voffB);
            PG8_WAIT_V(6); PG8_BAR; PG8_MMA(1, 1, At, B1); PG8_BAR;
            PG8_LDB(B0, 1, 0); PG8_SCHED; PG8_LDA(At, 1, 0); PG8_STAGE(PG8_SA(0, 1), a2 + hstep, voffA);
            PG8_WAIT_L(8); PG8_BAR; PG8_WAIT_L(0); PG8_MMA(0, 0, At, B0); PG8_BAR; PG8_SCHED;
            PG8_LDB(B1, 1, 1); PG8_STAGE(PG8_SB(1, 0), b3, voffB);
            PG8_BAR; PG8_WAIT_L(0); PG8_MMA(0, 1, At, B1); PG8_BAR;
            PG8_LDA(At, 1, 1); PG8_STAGE(PG8_SA(1, 0), a3, voffA);
            PG8_BAR; PG8_WAIT_L(0); PG8_MMA(1, 0, At, B0); PG8_BAR; PG8_SCHED;
            PG8_STAGE(PG8_SB(1, 1), b3 + hstep, voffB);
            PG8_WAIT_V(6); PG8_BAR; PG8_MMA(1, 1, At, B1); PG8_BAR;
            }
        }
        if constexpr (ALIGN_EPI) { if (wr == 0) PG8_BAR; }
        if constexpr (!Epi::AFTER_DRAIN) { E(acc, cur, wr, wc, fr, fq); S.done(cur); }
        if (!has_next) break;
#pragma unroll
        for (int a = 0; a < 2; ++a)
#pragma unroll
            for (int b = 0; b < 2; ++b)
#pragma unroll
                for (int m = 0; m < 4; ++m)
#pragma unroll
                    for (int n = 0; n < 2; ++n) acc[a][b][m][n] = (f32x4){0.f, 0.f, 0.f, 0.f};
        cur = nxt; cA = nA; cB = nB; ++ui;
        if constexpr (ALIGN_EPI) { if (wr == 1) PG8_BAR; }
    }
    PG8_WAIT_V(0);
    if constexpr (!ALIGN_EPI) { if (wr == 0) PG8_BAR; }
    PG8_BAR;
    if constexpr (Epi::AFTER_DRAIN) { E.fused(acc, cur, wr, wc, fr, fq, lds, wid, lane); S.done(cur); }
#undef PG8_SA
#undef PG8_SB
#undef PG8_STAGE
#undef PG8_LDA
#undef PG8_LDB
#undef PG8_MMA
#undef PG8_WAIT_V
#undef PG8_WAIT_L
#undef PG8_BAR
#undef PG8_SCHED
}
}

#ifndef PG8_SP2
#define PG8_SP2 true
#endif
#ifndef PG8_ALIGN
#define PG8_ALIGN true
#endif
#define GAS __attribute__((address_space(1)))
#define LAS __attribute__((address_space(3)))
#define XB_TMO      128
#define XB_XCNT(j)  (256  + 64 * (j))
#define XB_XSUB(j)  (1280 + 64 * (j))
#define XB_XGEN(j)  (2304 + 64 * (j))
#define XB_TOP      3328
#define XB_TOPGEN   3392
#define XCD_BAR_WORDS 3456
#define XB_SPIN_CAP (1u << 18)

__device__ __forceinline__ unsigned xb_ld(unsigned* p)              { return __hip_atomic_load(p, __ATOMIC_RELAXED, __HIP_MEMORY_SCOPE_AGENT); }
__device__ __forceinline__ unsigned xb_add(unsigned* p, unsigned v) { return __hip_atomic_fetch_add(p, v, __ATOMIC_RELAXED, __HIP_MEMORY_SCOPE_AGENT); }
__device__ __forceinline__ unsigned xb_xcc_id() { return (unsigned)__builtin_amdgcn_s_getreg((3 << 11) | 20) & 0xFu; }
#define XB_SPIN(cond, bar) do { unsigned _sp = 0; while (cond) { __builtin_amdgcn_s_sleep(1); \
    if ((++_sp & 255u) == 0u) { if (xb_ld(&(bar)[XB_TMO])) break; if (_sp > XB_SPIN_CAP) { atomicAdd(&(bar)[XB_TMO], 1u); break; } } } } while (0)

struct XcdBarrier {
    unsigned* bar; unsigned x;
    volatile LAS unsigned* st;
    int wv;
};

__device__ __forceinline__ XcdBarrier xcd_barrier_post(unsigned* bar, volatile LAS unsigned* st) {
    XcdBarrier b; b.bar = bar; b.x = xb_xcc_id(); b.st = st;
    if (threadIdx.x == 0) (void)xb_add(&bar[XB_XCNT(b.x)], 1u);
    return b;
}
__device__ __forceinline__ void xcd_barrier_complete(unsigned* bar, unsigned x, unsigned& nloc, unsigned& nx) {
    asm volatile("" : "+s"(x));
    const unsigned G = gridDim.x * gridDim.y * gridDim.z;
    unsigned sum, cnt, mine, sp = 0u;
    for (;;) {
        sum = 0u; cnt = 0u; mine = 0u;
#pragma unroll
        for (unsigned j = 0; j < 16; ++j) { const unsigned c = xb_ld(&bar[XB_XCNT(j)]); sum += c; cnt += (c > 0u) ? 1u : 0u; mine = (j == x) ? c : mine; }
        if (sum == G) break;
        __builtin_amdgcn_s_sleep(1);
        if ((++sp & 255u) == 0u) { if (xb_ld(&bar[XB_TMO])) break; if (sp > XB_SPIN_CAP) { atomicAdd(&bar[XB_TMO], 1u); break; } }
    }
    nloc = mine > 0u ? mine : 1u; nx = cnt > 0u ? cnt : 1u;
}

__device__ __forceinline__ void xcd_barrier(const XcdBarrier& b) {
    asm volatile("s_waitcnt vmcnt(0)" ::: "memory");
    __syncthreads();
    if (threadIdx.x == 0) {
        unsigned* bar = b.bar; asm volatile("" : "+s"(bar));
        __builtin_amdgcn_s_waitcnt(0);
        unsigned nloc = b.st[0], nx = b.st[1];
        if (nloc == 0u) { xcd_barrier_complete(bar, b.x, nloc, nx); b.st[0] = nloc; b.st[1] = nx; }
        const unsigned old = xb_add(&bar[XB_XSUB(b.x)], 1u);
        const unsigned gen = old / nloc;
        if (old + 1u == (gen + 1u) * nloc) {
            __builtin_amdgcn_fence(__ATOMIC_RELEASE, "agent");
            asm volatile("s_waitcnt vmcnt(0)" ::: "memory");
            const unsigned og = xb_add(&bar[XB_TOP], 1u);
            const unsigned tg = og / nx;
            if (og + 1u == (tg + 1u) * nx) xb_add(&bar[XB_TOPGEN], 1u);
            else XB_SPIN(xb_ld(&bar[XB_TOPGEN]) == tg, bar);
            __builtin_amdgcn_fence(__ATOMIC_ACQUIRE, "agent");
            xb_add(&bar[XB_XGEN(b.x)], 1u);
            asm volatile("s_waitcnt vmcnt(0)" ::: "memory");
        } else {
            XB_SPIN(xb_ld(&bar[XB_XGEN(b.x)]) == gen, bar);
            __builtin_amdgcn_fence(__ATOMIC_ACQUIRE, "agent");
            asm volatile("s_waitcnt vmcnt(0)" ::: "memory");
        }
    }
    __syncthreads();
}
namespace dattn {
constexpr int D = 128, QST = 2048, KVS = 512, OST = 2048, MTW = 68, JLO = 3;
constexpr float THR = 8.f; constexpr bool WSKIP = false;
typedef unsigned short bf16;
constexpr float SCALE = 1.0f;
constexpr int NW = 8, QBLK = 32, KVBLK = 64, QB = NW * QBLK;
constexpr int SHM_V = KVBLK * D * 2, SHM_K = KVBLK * D * 2;
constexpr int LDS_BYTES = 2 * SHM_V + 2 * SHM_K + NW * 64 * 4;

typedef short bf16x8 __attribute__((ext_vector_type(8)));
typedef short s16x4 __attribute__((ext_vector_type(4)));
typedef float f32x16 __attribute__((ext_vector_type(16)));
typedef float f32x4 __attribute__((ext_vector_type(4)));
typedef unsigned u32x4 __attribute__((ext_vector_type(4)));
template <class A, class Bt> struct same_t { static constexpr bool v = false; };
template <class A> struct same_t<A, A> { static constexpr bool v = true; };

#define KSWZ(row, colB) ((row) * 256 + ((colB) ^ (((row) & 7) << 4)))
#define SBAR() __builtin_amdgcn_sched_barrier(0)
__device__ __forceinline__ int v_st(int k, int c) { const int kk = (k & ~0xC) | ((k & 4) << 1) | ((k & 8) >> 1); return ((kk >> 3) * 4 + (c >> 5)) * 512 + ((kk & 7) * 32 + (c & 31)) * 2; }
__device__ __forceinline__ int v_rd_base(int lane) { return ((lane & 3) << 3) | (((lane >> 2) & 3) << 6) | (((lane >> 4) & 1) << 5) | (((lane >> 5) & 1) << 8); }
constexpr int v_rd_off(int d0, int ks, int half) { return d0 * 512 + ks * 4096 + half * 2048; }
__device__ __forceinline__ int crow(int r, int hi) { return (r & 3) + 8 * (r >> 2) + 4 * hi; }
__device__ __forceinline__ unsigned cvtpk(float lo, float hi) {
    unsigned r; asm volatile("v_cvt_pk_bf16_f32 %0, %1, %2" : "=v"(r) : "v"(lo), "v"(hi)); return r;
}
__device__ __forceinline__ bf16x8 pack8(f32x4 a, f32x4 b) {
    u32x4 w = {cvtpk(a[0], a[1]), cvtpk(a[2], a[3]), cvtpk(b[0], b[1]), cvtpk(b[2], b[3])};
    return *reinterpret_cast<bf16x8*>(&w);
}
template <class T> __device__ __forceinline__ bf16x8 load8(const T* p) {
    if constexpr (same_t<T, float>::v) { return pack8(*(const f32x4*)p, *(const f32x4*)(p + 4)); }
    else { return *reinterpret_cast<const bf16x8*>(p); }
}
__device__ __forceinline__ void mask_tile(f32x16& p0, f32x16& p1, int dq, unsigned W) {
    const float NEG = -__builtin_inff();
#pragma unroll
    for (int r = 0; r < 16; ++r) {
        const int c = (r & 3) + 8 * (r >> 2);
        if ((unsigned)(dq - c) >= W) p0[r] = NEG;
        if ((unsigned)(dq - c - 32) >= W) p1[r] = NEG;
    }
}
__device__ __forceinline__ void mask_bits(f32x16& p0, f32x16& p1, unsigned long long mw, int hi) {
    const float NEG = -__builtin_inff();
    const unsigned lo = (unsigned)(mw >> (4 * hi)), up = (unsigned)(mw >> (32 + 4 * hi));
#pragma unroll
    for (int r = 0; r < 16; ++r) {
        const int c = (r & 3) + 8 * (r >> 2);
        if (!((lo >> c) & 1u)) p0[r] = NEG;
        if (!((up >> c) & 1u)) p1[r] = NEG;
    }
}
__device__ __forceinline__ void partialSM(f32x16& p0, f32x16& p1, float& m_reg, float& mn, float& alpha) {
    float pmax = p0[0]; for (int r = 1; r < 16; ++r) pmax = fmaxf(pmax, p0[r]); for (int r = 0; r < 16; ++r) pmax = fmaxf(pmax, p1[r]);
    { auto rr = __builtin_amdgcn_permlane32_swap(__float_as_uint(pmax), __float_as_uint(pmax), false, false);
      pmax = fmaxf(__uint_as_float(rr[0]), __uint_as_float(rr[1])); }
    constexpr float C2 = 1.4426950408889634f * SCALE;
    if (__builtin_expect(__all((pmax - m_reg) * SCALE <= THR), 1)) { mn = m_reg; alpha = 1.f; }
    else { mn = fmaxf(m_reg, pmax); alpha = __builtin_amdgcn_exp2f((m_reg - mn) * C2); m_reg = mn; }
    const float mnL = -mn * C2;
    for (int r = 0; r < 16; ++r) p0[r] = fmaf(p0[r], C2, mnL); for (int r = 0; r < 16; ++r) p1[r] = fmaf(p1[r], C2, mnL);
    for (int r = 0; r < 16; ++r) p0[r] = __builtin_amdgcn_exp2f(p0[r]);
}
__device__ __forceinline__ void finishSM(f32x16& p0, f32x16& p1, float alpha, float& l_reg, bf16x8& pa0, bf16x8& pa1, bf16x8& pa2, bf16x8& pa3) {
    for (int r = 0; r < 16; ++r) p1[r] = __builtin_amdgcn_exp2f(p1[r]);
    float ps = 0; for (int r = 0; r < 16; ++r) ps += p0[r]; for (int r = 0; r < 16; ++r) ps += p1[r];
    { auto rr = __builtin_amdgcn_permlane32_swap(__float_as_uint(ps), __float_as_uint(ps), false, false);
      ps = __uint_as_float(rr[0]) + __uint_as_float(rr[1]); }
    l_reg = l_reg * alpha + ps;
#define PK4(P, B_, OUT) do { unsigned a0 = cvtpk(P[B_+0], P[B_+1]), a1 = cvtpk(P[B_+2], P[B_+3]);                          \
        unsigned b0 = cvtpk(P[B_+4], P[B_+5]), b1 = cvtpk(P[B_+6], P[B_+7]);                                             \
        auto r0 = __builtin_amdgcn_permlane32_swap(a0, b0, false, false); auto r1 = __builtin_amdgcn_permlane32_swap(a1, b1, false, false); \
        u32x4 w = {r0[0], r1[0], r0[1], r1[1]}; OUT = *reinterpret_cast<bf16x8*>(&w); } while (0)
    PK4(p0, 0, pa0); PK4(p0, 8, pa1); PK4(p1, 0, pa2); PK4(p1, 8, pa3);
#undef PK4
}
template <int KB, bool SK>
__device__ __forceinline__ void qkt(f32x16& p0, f32x16& p1, const char* K_lds, int r32, int hi, const bf16x8* qr, bool act) {
    if (SK && !act) { const float NEG = -__builtin_inff();
#pragma unroll
        for (int r = 0; r < 16; ++r) { p0[r] = NEG; p1[r] = NEG; } return; }
    p0 = f32x16{}; p1 = f32x16{};
    const char* kb[4];
#pragma unroll
    for (int dd = 0; dd < 4; ++dd) kb[dd] = K_lds + KB * SHM_K + KSWZ(r32, (dd * 16 + hi * 8) * 2);
#pragma unroll
    for (int d0 = 0; d0 < 8; ++d0) { const char* a = kb[d0 & 3] + (d0 >> 2) * 128;
        bf16x8 b0 = *reinterpret_cast<const bf16x8*>(a);
        bf16x8 b1 = *reinterpret_cast<const bf16x8*>(a + 32 * 256);
        p0 = __builtin_amdgcn_mfma_f32_32x32x16_bf16(b0, qr[d0], p0, 0, 0, 0);
        p1 = __builtin_amdgcn_mfma_f32_32x32x16_bf16(b1, qr[d0], p1, 0, 0, 0); }
}
template <int VB, bool SK>
__device__ __forceinline__ void pv_tile(f32x16* o, int vb0, bf16x8 pa0, bf16x8 pa1, bf16x8 pa2, bf16x8 pa3, bool act) {
    if (SK && !act) return;
#define TRRD(dst, off) asm volatile("ds_read_b64_tr_b16 %0, %1 offset:%2" : "=&v"(dst) : "v"(vb0), "i"(off) : "memory")
#define PV_D0(d0) do { s16x4 l0, l1, l2, l3, h0, h1, h2, h3; constexpr int b_ = VB * SHM_V + v_rd_off(d0, 0, 0);     \
        TRRD(l0, b_); TRRD(h0, b_ + 2048); TRRD(l1, b_ + 4096); TRRD(h1, b_ + 6144); TRRD(l2, b_ + 8192); TRRD(h2, b_ + 10240); TRRD(l3, b_ + 12288); TRRD(h3, b_ + 14336); \
        asm volatile("s_waitcnt lgkmcnt(0)" ::: "memory"); SBAR();                 \
        o[d0] = __builtin_amdgcn_mfma_f32_32x32x16_bf16(pa0, (bf16x8){l0[0], l0[1], l0[2], l0[3], h0[0], h0[1], h0[2], h0[3]}, o[d0], 0, 0, 0);   \
        o[d0] = __builtin_amdgcn_mfma_f32_32x32x16_bf16(pa1, (bf16x8){l1[0], l1[1], l1[2], l1[3], h1[0], h1[1], h1[2], h1[3]}, o[d0], 0, 0, 0);   \
        o[d0] = __builtin_amdgcn_mfma_f32_32x32x16_bf16(pa2, (bf16x8){l2[0], l2[1], l2[2], l2[3], h2[0], h2[1], h2[2], h2[3]}, o[d0], 0, 0, 0);   \
        o[d0] = __builtin_amdgcn_mfma_f32_32x32x16_bf16(pa3, (bf16x8){l3[0], l3[1], l3[2], l3[3], h3[0], h3[1], h3[2], h3[3]}, o[d0], 0, 0, 0); } while (0)
    PV_D0(0); PV_D0(1); PV_D0(2); PV_D0(3);
#undef PV_D0
#undef TRRD
}

template <class TIn, class TOut> struct BlockRef { const TIn* Q; const TIn* K; const TIn* V; TOut* O; const unsigned long long* M; int P0; };
template <class TIn> struct Seam {
    bf16x8 qr[8];
    bf16x8 st_v0, st_v1, st_k0, st_k1; f32x4 sf0, sf1, sf2, sf3;
    f32x4 tq[16];
};
__device__ __forceinline__ int swa_jlo(int, int) { return JLO; }
#define ROW(p, k0, rr) ((p) + (size_t)((k0) + (rr)) * KVS + sc)
#define VMW() asm volatile("s_waitcnt vmcnt(0)" ::: "memory")
#define VMWN(n) asm volatile("s_waitcnt vmcnt(%0)" :: "i"(n) : "memory")
#define SLOAD_H(Kp, Vp, k0) do { S.st_v0 = load8<TIn>(ROW(Vp, k0, sr)); S.st_v1 = load8<TIn>(ROW(Vp, k0, 32 + sr));              \
                         S.st_k0 = load8<TIn>(ROW(Kp, k0, sr)); S.st_k1 = load8<TIn>(ROW(Kp, k0, 32 + sr)); } while (0)
#define SWRITE_HK(bf) do { *(bf16x8*)(K_lds + (bf) * SHM_K + kws) = S.st_k0; *(bf16x8*)(K_lds + (bf) * SHM_K + kws + 32 * 256) = S.st_k1; } while (0)
#define SWRITE_HV(bf) do { *(bf16x8*)(V_lds + (bf) * SHM_V + vst0) = S.st_v0; *(bf16x8*)(V_lds + (bf) * SHM_V + vst1) = S.st_v1; } while (0)
#define SWRITE_H(bf) do { SWRITE_HV(bf); SWRITE_HK(bf); } while (0)
#define SLOAD_F(p, k0) do { S.sf0 = *(const f32x4*)ROW(p, k0, sr); S.sf1 = *(const f32x4*)(ROW(p, k0, sr) + 4);                \
                            S.sf2 = *(const f32x4*)ROW(p, k0, 32 + sr); S.sf3 = *(const f32x4*)(ROW(p, k0, 32 + sr) + 4); } while (0)
#define SWRITE_KF(bf) do { *(bf16x8*)(K_lds + (bf) * SHM_K + kws) = pack8(S.sf0, S.sf1); *(bf16x8*)(K_lds + (bf) * SHM_K + kws + 32 * 256) = pack8(S.sf2, S.sf3); } while (0)
#define SWRITE_VF(bf) do { *(bf16x8*)(V_lds + (bf) * SHM_V + vst0) = pack8(S.sf0, S.sf1); *(bf16x8*)(V_lds + (bf) * SHM_V + vst1) = pack8(S.sf2, S.sf3); } while (0)
template <class TIn, class TOut>
__device__ __forceinline__ void causal_swa_prime(const BlockRef<TIn, TOut>& cur, int W, char* lds, Seam<TIn>& S, int wv) {
    constexpr bool F32 = same_t<TIn, float>::v;
    int tid0_ = threadIdx.x; asm volatile("" : "+v"(tid0_)); (void)wv;
    const int tid = tid0_, wid = __builtin_amdgcn_readfirstlane(tid >> 6), lane = tid & 63, r32 = lane & 31, hi = lane >> 5;
    const int sr = tid >> 4, sc = (tid & 15) * 8, kws = KSWZ(sr, sc * 2); char* K_lds = lds + 2 * SHM_V;
    const int kb0 = swa_jlo(cur.P0, W) * KVBLK;
    for (int d0 = 0; d0 < 8; ++d0) S.qr[d0] = load8<TIn>(cur.Q + (size_t)(wid * QBLK + r32) * QST + d0 * 16 + hi * 8);
    if constexpr (F32) { SLOAD_F((const float*)cur.K, kb0); VMW(); SWRITE_KF(0); SBAR(); SLOAD_F((const float*)cur.V, kb0); }
    else { SLOAD_H(cur.K, cur.V, kb0); VMW(); SWRITE_HK(0); }
    __syncthreads();
}
template <class TIn, class TOut>
__device__ __forceinline__ void causal_swa_block(const BlockRef<TIn, TOut>& cur, const BlockRef<TIn, TOut>& nxt, int skv, int W, char* lds, Seam<TIn>& S, int wv) {
    constexpr bool F32 = same_t<TIn, float>::v;
    int tid0_ = threadIdx.x; asm volatile("" : "+v"(tid0_)); (void)wv;
    const int tid = tid0_, wid = __builtin_amdgcn_readfirstlane(tid >> 6), lane = tid & 63, r32 = lane & 31, hi = lane >> 5;
    const int j_lo = swa_jlo(cur.P0, W);
    int j_hi = (cur.P0 + QB - 1) / KVBLK + 1; if (j_hi > skv / KVBLK) j_hi = skv / KVBLK;
    const int NT = j_hi - j_lo;
    const int kbn = swa_jlo(nxt.P0, W) * KVBLK;
    const int qlo = cur.P0 + wid * QBLK; (void)qlo;
    const unsigned long long* mrow = cur.M + (size_t)(wid * QBLK + r32) * MTW;
    const int qm_unused = 0; (void)qm_unused;
    char* V_lds = lds; char* K_lds = lds + 2 * SHM_V;
    float* ws = (float*)(lds + 2 * SHM_V + 2 * SHM_K) + wid * 64; float* li_l = ws, * al_l = ws + 32;
    float m_reg = -1e30f, l_reg = 0; f32x16 o[4] = {};
    const int sr = tid >> 4, sc = (tid & 15) * 8, vst0 = v_st(sr, sc), vst1 = v_st(32 + sr, sc), kws = KSWZ(sr, sc * 2);
    const int vb0 = (int)(uintptr_t)V_lds + v_rd_base(lane);
    const TIn* Kh = cur.K; const TIn* Vh = cur.V;
#define RESC(a) do { if (__any((a) < 1.f)) { if (hi == 0) al_l[r32] = (a); asm volatile("s_waitcnt lgkmcnt(0)" ::: "memory");              \
                     for (int d_ = 0; d_ < 4; ++d_) for (int r = 0; r < 16; ++r) o[d_][r] *= al_l[crow(r, hi)]; } } while (0)
#define KBASE(t) ((j_lo + (t)) * KVBLK)
#define ACT(t) (KBASE(t) <= qlo + QBLK - 1 && KBASE(t) + KVBLK - 1 >= qlo - W + 1)
#define MASKT(P0_, P1_, t) mask_bits(P0_, P1_, mrow[j_lo + (t)], hi)
    constexpr int NQL = F32 ? 16 : 8;
    constexpr bool SK = WSKIP && !F32;
#define SEAM_K0() do { VMWN(NQL); if constexpr (F32) { SWRITE_KF(0); SBAR(); SLOAD_F((const float*)nxt.V, kbn); } else { SWRITE_HK(0); } SBAR(); } while (0)
    f32x16 pA0, pA1, pB0, pB1; float mnA, mnB, alA, alB; bf16x8 pa0, pa1, pa2, pa3;
    if constexpr (F32) { VMW(); SWRITE_VF(0); SBAR(); } else { SWRITE_HV(0); SBAR(); }
    if (NT > 1) { if constexpr (F32) SLOAD_F((const float*)Kh, KBASE(1)); else SLOAD_H(Kh, Vh, KBASE(1)); }
    SBAR(); qkt<0, SK>(pA0, pA1, K_lds, r32, hi, S.qr, ACT(0));
    if constexpr (F32) { if (NT > 1) { VMW(); SWRITE_KF(1); SBAR(); SLOAD_F((const float*)Vh, KBASE(1)); } }
    MASKT(pA0, pA1, 0); partialSM(pA0, pA1, m_reg, mnA, alA);
    if (NT > 1) { VMW(); if constexpr (F32) { SWRITE_VF(1); SBAR(); if (NT > 2) SLOAD_F((const float*)Kh, KBASE(2)); } else SWRITE_H(1); }
    __syncthreads();
#define HALF_STEP(PX0, PX1, mnX, alX, PY0, PY1, alY, t, KB, VB, SB) do {                                                      \
        SBAR(); qkt<KB, SK>(PX0, PX1, K_lds, r32, hi, S.qr, ACT(t));                                             \
        finishSM(PY0, PY1, alY, l_reg, pa0, pa1, pa2, pa3); SBAR();                                                           \
        if ((t) + 1 < NT) { if constexpr (F32) { VMW(); SWRITE_KF(SB); SBAR(); SLOAD_F((const float*)Vh, KBASE((t) + 1)); }  \
                            else { SLOAD_H(Kh, Vh, KBASE((t) + 1)); } SBAR(); }                                               \
        pv_tile<VB, SK>(o, vb0, pa0, pa1, pa2, pa3, ACT((t) - 1)); MASKT(PX0, PX1, (t)); partialSM(PX0, PX1, m_reg, mnX, alX);                                        \
        __syncthreads();                                                                                                      \
        if ((t) + 1 < NT) { VMW(); if constexpr (F32) { SWRITE_VF(SB); SBAR(); if ((t) + 2 < NT) SLOAD_F((const float*)Kh, KBASE((t) + 2)); } \
                            else { SWRITE_H(SB); } }                                                                          \
        RESC(alX); __syncthreads(); } while (0)
    for (int t = 1; t + 1 < NT; t += 2) {
        HALF_STEP(pB0, pB1, mnB, alB, pA0, pA1, alA, t, 1, 0, 0);
        HALF_STEP(pA0, pA1, mnA, alA, pB0, pB1, alB, t + 1, 0, 1, 1);
    }
    const bool even = (NT & 1) == 0;
    if (even) { SBAR(); qkt<1, SK>(pB0, pB1, K_lds, r32, hi, S.qr, ACT(NT - 1)); SBAR(); }
#define QROW(e) (nxt.Q + (size_t)(wid * QBLK + r32) * QST + ((e) >> 1) * 16 + hi * 8 + ((e) & 1) * 4)
    if constexpr (F32) { SLOAD_F((const float*)nxt.K, kbn); SBAR();
#pragma unroll
        for (int e = 0; e < 8; ++e) S.tq[e] = *(const f32x4*)QROW(e); }
    else { SLOAD_H(nxt.K, nxt.V, kbn); SBAR();
#pragma unroll
        for (int d0 = 0; d0 < 8; ++d0) S.qr[d0] = load8<TIn>(nxt.Q + (size_t)(wid * QBLK + r32) * QST + d0 * 16 + hi * 8); }
    SBAR();
    finishSM(pA0, pA1, alA, l_reg, pa0, pa1, pa2, pa3); SBAR();
    if constexpr (F32) {
#pragma unroll
        for (int e = 8; e < 16; ++e) S.tq[e] = *(const f32x4*)QROW(e); SBAR(); }
#undef QROW
    pv_tile<0, SK>(o, vb0, pa0, pa1, pa2, pa3, ACT(even ? NT - 2 : NT - 1));
    if (even) { MASKT(pB0, pB1, NT - 1); partialSM(pB0, pB1, m_reg, mnB, alB); __syncthreads(); RESC(alB);
        finishSM(pB0, pB1, alB, l_reg, pa0, pa1, pa2, pa3); SBAR(); pv_tile<1, SK>(o, vb0, pa0, pa1, pa2, pa3, ACT(NT - 1)); }
    SBAR(); SEAM_K0();
    if (hi == 0) li_l[r32] = l_reg; asm volatile("s_waitcnt lgkmcnt(0)" ::: "memory");
    float rli[16];
#pragma unroll
    for (int r = 0; r < 16; ++r) rli[r] = __builtin_amdgcn_rcpf(li_l[crow(r, hi)]);
    TOut* Ow = cur.O + (size_t)(wid * QBLK) * OST;
#pragma unroll
    for (int r = 0; r < 16; ++r) { const int orow = crow(r, hi);
#pragma unroll
        for (int d0 = 0; d0 < 4; ++d0) { const float v = o[d0][r] * rli[r];
            if constexpr (same_t<TOut, float>::v) { Ow[(size_t)orow * OST + d0 * 32 + r32] = v; }
            else { const float vn = __shfl_xor(v, 1);
                   if ((r32 & 1) == 0) *(unsigned*)(Ow + (size_t)orow * OST + d0 * 32 + r32) = cvtpk(v, vn); } } }
    if constexpr (F32) {
#pragma unroll
        for (int d0 = 0; d0 < 8; ++d0) S.qr[d0] = pack8(S.tq[2 * d0], S.tq[2 * d0 + 1]); }
    __syncthreads();
#undef RESC
#undef KBASE
#undef ACT
#undef MASKT
#undef SEAM_K0
#undef HALF_STEP
}
#undef ROW
#undef VMW
#undef VMWN
#undef SLOAD_H
#undef SWRITE_HK
#undef SWRITE_HV
#undef SWRITE_H
#undef SLOAD_F
#undef SWRITE_KF
#undef SWRITE_VF

}

constexpr int NWAVES = 8, NTHREADS = 512;
constexpr int DM = 2048, SEQ = 4096, NMETA = 16, TP = 4112, NBP = 2, SBN = 8, PAST = 16384, NPG = 128;
constexpr int XROW0 = 8192, SROW0 = 8224, NROWS = 8232, MPAD = 8448, FF = 8192, MAINM = 8192, XR = 48;
constexpr int NA_IN = 6144, NB_IN = 4176, NB_PAD = 4352, NC_IN = 12352, NC_PAD = 12544, DVW = 4096, CDIM = 8192;
constexpr float ALPHA = 1.6817928305074292f;
constexpr float LN_EPS = 1e-5f, RMS_EPS = 1e-6f;
constexpr int SCW = 4160, SCSW = 16448, KIROWS = 4128, NSKEY = PAST + 1;
constexpr int POS_SAMPLE_IDX = TP;

constexpr size_t O_YP = 0, O_YS = O_YP + (size_t)NBP * SEQ * DM, O_CAP = O_YS + (size_t)SBN * DM, O_CAS = O_CAP + 2 * NBP * 2 * DM,
                 O_KP = O_CAS + 2 * SBN * 2 * DM, O_VP = O_KP + (size_t)NBP * TP * 512, O_IKP = O_VP + (size_t)NBP * TP * 512,
                 O_KS = O_IKP + (size_t)NBP * TP * 64, O_VS = O_KS + SBN * 512, O_IKS = O_VS + SBN * 512, O_CCP = O_IKS + SBN * 64,
                 O_CCS = O_CCP + (size_t)NBP * 3 * CDIM, O_DP = O_CCS + (size_t)SBN * 3 * CDIM, O_DS = O_DP + (size_t)NBP * 32 * 128 * 128,
                 O_END = O_DS + (size_t)SBN * 32 * 128 * 128;

constexpr size_t MiB = 1u << 20;
constexpr size_t WS_CTL = 0, CTL_ZERO_BYTES = 1 * MiB;
constexpr size_t WS_TAB128 = 1 * MiB, WS_TAB64 = 4 * MiB, WS_WI = 6 * MiB, WS_G = 7 * MiB, WS_BETA = 9 * MiB, WS_CNT = 11 * MiB, WS_KIB = 12 * MiB,
                 WS_SCS = 14 * MiB, WS_IDXL = 16 * MiB, WS_X = 26 * MiB, WS_QR = 60 * MiB, WS_QI = 94 * MiB, WS_Z = 112 * MiB, WS_Y = 180 * MiB,
                 WS_BIG = 248 * MiB, WS_QKVC = 452 * MiB, WS_SC = 584 * MiB, WS_W = 716 * MiB;
constexpr size_t WSZ_A_IN = (size_t)NA_IN * DM * 2, WSZ_A_OUT = (size_t)DM * DM * 2, WSZ_B_IN = (size_t)NB_PAD * DM * 2, WSZ_B_OUT = (size_t)DM * DM * 2,
                 WSZ_C_IN = (size_t)NC_PAD * DM * 2, WSZ_C_OUT = (size_t)DM * DVW * 2, WSZ_W1 = (size_t)FF * DM * 2, WSZ_W2 = (size_t)DM * FF * 2;
constexpr size_t WS_WA_IN = WS_W, WS_WA_OUT = WS_WA_IN + 2 * WSZ_A_IN, WS_WB_IN = WS_WA_OUT + 2 * WSZ_A_OUT, WS_WB_OUT = WS_WB_IN + WSZ_B_IN,
                 WS_WC_IN = WS_WB_OUT + WSZ_B_OUT, WS_WC_OUT = WS_WC_IN + WSZ_C_IN, WS_W1 = WS_WC_OUT + WSZ_C_OUT, WS_W2 = WS_W1 + 4 * WSZ_W1,
                 WS_ZP = WS_W2 + 4 * WSZ_W2, WS_QKF = WS_ZP + 4 * MiB, WS_DWG = WS_QKF + 130 * MiB, WS_DUG = WS_DWG + 66 * MiB, WS_END = WS_DUG + 66 * MiB;
constexpr size_t WS_MASK = WS_IDXL, WS_KS = WS_Z, WS_VS = WS_Z + 9 * MiB;
constexpr size_t WS_DAF = WS_Z, WS_DTG = WS_Y, WS_DTB = WS_Y + 33 * MiB, WS_DPG = WS_QR, WS_DKT = WS_QKF, WS_DVT = WS_QKF + 33 * MiB, WS_DGC = WS_QI, WS_DBT = WS_QI + 2 * MiB;
constexpr int SP = 4352, SPAD = 240, MTW = 68;
constexpr int CW_BAR = 4096;

constexpr int RING_BYTES = 131072, LDSCTL_OFF = RING_BYTES, MISC_OFF = LDSCTL_OFF + 320, LDS_BYTES = 147456;

typedef unsigned short bf16;
typedef unsigned v4u __attribute__((ext_vector_type(4)));
typedef unsigned v2u __attribute__((ext_vector_type(2)));
typedef float f32x4 __attribute__((ext_vector_type(4)));
typedef float f32x2 __attribute__((ext_vector_type(2)));
typedef short bf16x8 __attribute__((ext_vector_type(8)));
typedef float f32x16 __attribute__((ext_vector_type(16)));
typedef __bf16 bf16x2_t __attribute__((ext_vector_type(2)));

#define LDS_WAIT() asm volatile("s_waitcnt lgkmcnt(0)" ::: "memory")
#define WAVE_SYNC() do { asm volatile("s_waitcnt lgkmcnt(0)" ::: "memory"); __builtin_amdgcn_wave_barrier(); } while (0)

__device__ __forceinline__ float bflo(unsigned w) { return __uint_as_float(w << 16); }
__device__ __forceinline__ float bfhi(unsigned w) { return __uint_as_float(w & 0xffff0000u); }
__device__ __forceinline__ float bf2f(bf16 h) { return __uint_as_float((unsigned)h << 16); }
__device__ __forceinline__ unsigned pk2(float lo, float hi) { f32x2 v = {lo, hi}; bf16x2_t b = __builtin_convertvector(v, bf16x2_t); return __builtin_bit_cast(unsigned, b); }
__device__ __forceinline__ bf16 f2bf(float f) { return (bf16)(pk2(f, 0.f) & 0xffffu); }
__device__ __forceinline__ float wave_sum(float v) {
#pragma unroll
    for (int o = 1; o < 64; o <<= 1) v += __shfl_xor(v, o);
    return v;
}
__device__ __forceinline__ float wave_max(float v) {
#pragma unroll
    for (int o = 1; o < 64; o <<= 1) v = fmaxf(v, __shfl_xor(v, o));
    return v;
}
__device__ __forceinline__ int wave_sum_i(int v) {
#pragma unroll
    for (int o = 1; o < 64; o <<= 1) v += __shfl_xor(v, o);
    return v;
}
__device__ __forceinline__ float row16_sum(float v) {
    v += __int_as_float(__builtin_amdgcn_update_dpp(0, __float_as_int(v), 0x128, 0xf, 0xf, false));
    v += __int_as_float(__builtin_amdgcn_update_dpp(0, __float_as_int(v), 0x124, 0xf, 0xf, false));
    v += __int_as_float(__builtin_amdgcn_update_dpp(0, __float_as_int(v), 0x122, 0xf, 0xf, false));
    v += __int_as_float(__builtin_amdgcn_update_dpp(0, __float_as_int(v), 0x121, 0xf, 0xf, false));
    return v;
}
__device__ __forceinline__ float silu_f(float x) { return x / (1.f + __expf(-x)); }
__device__ __forceinline__ int prow(int b, int t) { return t >= NMETA ? b * SEQ + (t - NMETA) : XROW0 + b * NMETA + t; }
__device__ __forceinline__ void row_bt(int r, int& b, int& t) { if (r < XROW0) { b = r >> 12; t = (r & 4095) + NMETA; } else { b = (r - XROW0) >> 4; t = (r - XROW0) & 15; } }
__device__ __forceinline__ void unpack8(const v4u w, float (&f)[8]) {
    f[0] = bflo(w.x); f[1] = bfhi(w.x); f[2] = bflo(w.y); f[3] = bfhi(w.y); f[4] = bflo(w.z); f[5] = bfhi(w.z); f[6] = bflo(w.w); f[7] = bfhi(w.w);
}
__device__ __forceinline__ v4u pack8(const float (&f)[8]) { v4u w; w.x = pk2(f[0], f[1]); w.y = pk2(f[2], f[3]); w.z = pk2(f[4], f[5]); w.w = pk2(f[6], f[7]); return w; }

__device__ __forceinline__ void transpose_item(const float* W, int K, int N, int Npad, bf16* WT, LAS float* scr, int item, int lane) {
    const int nblk = Npad / 32, kb = item / nblk, nb = item % nblk, k0 = 64 * kb, n0 = 32 * nb;
    const int n = n0 + (lane & 31); const bool ok = n < N;
#pragma unroll 8
    for (int i = 0; i < 32; ++i) { const int kk = 2 * i + (lane >> 5); scr[kk * 33 + (lane & 31)] = ok ? W[(size_t)(k0 + kk) * N + n] : 0.f; }
    LDS_WAIT(); __builtin_amdgcn_wave_barrier();
    const int c = lane & 7;
#pragma unroll
    for (int j = 0; j < 4; ++j) { const int nn = (lane >> 3) + 8 * j; const LAS float* s = scr + (8 * c) * 33 + nn;
        v4u o; o.x = pk2(s[0 * 33], s[1 * 33]); o.y = pk2(s[2 * 33], s[3 * 33]); o.z = pk2(s[4 * 33], s[5 * 33]); o.w = pk2(s[6 * 33], s[7 * 33]);
        *(v4u*)(WT + (size_t)(n0 + nn) * K + k0 + 8 * c) = o; }
    LDS_WAIT(); __builtin_amdgcn_wave_barrier();
}

struct Ptrs {
    const float *x_prompt, *x_sample, *state_conv_a, *cache_k, *cache_v, *cache_ik, *state_conv_c, *state_delta;
    const int* page_table;
    const float *meta, *w_in_a, *conv_w_a, *w_out_a, *w_in_b, *w_out_b, *w_in_c, *conv_w_c, *a_log, *dt_bias, *norm_w, *w_out_c, *ln1_g, *ln1_b, *w1, *w2, *ln2_g, *ln2_b;
    float* out; unsigned char* ws;
};

__device__ __forceinline__ void p0_prologue(const Ptrs& P, LAS unsigned char* lds, int gw, int NGW, int wave, int lane) {
    LAS float* scr = (LAS float*)(lds + wave * 16384);
    unsigned char* ws = P.ws;
    constexpr int I_A_IN = (DM / 64) * (NA_IN / 32), I_A_OUT = (DM / 64) * (DM / 32), I_B_IN = (DM / 64) * (NB_PAD / 32), I_B_OUT = I_A_OUT,
                  I_C_IN = (DM / 64) * (NC_PAD / 32), I_C_OUT = (DVW / 64) * (DM / 32), I_W1 = (DM / 64) * (FF / 32), I_W2 = (FF / 64) * (DM / 32);
    constexpr int NITEMS = 2 * I_A_IN + 2 * I_A_OUT + I_B_IN + I_B_OUT + I_C_IN + I_C_OUT + 4 * I_W1 + 4 * I_W2;
#define TR_(cnt, Wp, Kk, Nn, Np, WTp) if (r < (cnt)) { transpose_item((Wp), (Kk), (Nn), (Np), (bf16*)(WTp), scr, r, lane); continue; } r -= (cnt);
    for (int it = gw; it < NITEMS; it += NGW) {
        int r = it;
        TR_(I_A_IN, P.w_in_a, DM, NA_IN, NA_IN, ws + WS_WA_IN)
        TR_(I_A_IN, P.w_in_a + (size_t)DM * NA_IN, DM, NA_IN, NA_IN, ws + WS_WA_IN + WSZ_A_IN)
        TR_(I_A_OUT, P.w_out_a, DM, DM, DM, ws + WS_WA_OUT)
        TR_(I_A_OUT, P.w_out_a + (size_t)DM * DM, DM, DM, DM, ws + WS_WA_OUT + WSZ_A_OUT)
        TR_(I_B_IN, P.w_in_b, DM, NB_IN, NB_PAD, ws + WS_WB_IN)
        TR_(I_B_OUT, P.w_out_b, DM, DM, DM, ws + WS_WB_OUT)
        TR_(I_C_IN, P.w_in_c, DM, NC_IN, NC_PAD, ws + WS_WC_IN)
        TR_(I_C_OUT, P.w_out_c, DVW, DM, DM, ws + WS_WC_OUT)
        TR_(I_W1, P.w1, DM, FF, FF, ws + WS_W1)
        TR_(I_W1, P.w1 + (size_t)DM * FF, DM, FF, FF, ws + WS_W1 + WSZ_W1)
        TR_(I_W1, P.w1 + 2 * (size_t)DM * FF, DM, FF, FF, ws + WS_W1 + 2 * WSZ_W1)
        TR_(I_W1, P.w1 + 3 * (size_t)DM * FF, DM, FF, FF, ws + WS_W1 + 3 * WSZ_W1)
        TR_(I_W2, P.w2, FF, DM, DM, ws + WS_W2)
        TR_(I_W2, P.w2 + (size_t)DM * FF, FF, DM, DM, ws + WS_W2 + WSZ_W2)
        TR_(I_W2, P.w2 + 2 * (size_t)DM * FF, FF, DM, DM, ws + WS_W2 + 2 * WSZ_W2)
        transpose_item(P.w2 + 3 * (size_t)DM * FF, FF, DM, DM, (bf16*)(ws + WS_W2 + 3 * WSZ_W2), scr, r, lane);
    }
#undef TR_
    bf16* X = (bf16*)(ws + WS_X);
    for (int r = gw; r < MPAD; r += NGW) {
        const float* src = nullptr;
        if (r < XROW0) src = P.x_prompt + (size_t)r * DM;
        else if (r < SROW0) src = P.meta + (size_t)((r - XROW0) & 15) * DM;
        else if (r < NROWS) src = P.x_sample + (size_t)(r - SROW0) * DM;
#pragma unroll
        for (int j = 0; j < 4; ++j) { const int c = 512 * j + 8 * lane; v4u o = {0u, 0u, 0u, 0u};
            if (src) { const f32x4 a = *(const f32x4*)(src + c), b = *(const f32x4*)(src + c + 4); o.x = pk2(a.x, a.y); o.y = pk2(a.z, a.w); o.z = pk2(b.x, b.y); o.w = pk2(b.z, b.w); }
            *(v4u*)(X + (size_t)r * DM + c) = o; }
    }
    f32x2* t128 = (f32x2*)(ws + WS_TAB128); f32x2* t64 = (f32x2*)(ws + WS_TAB64);
    const int gt = gw * 64 + lane, NGT = NGW * 64;
    for (int e = gt; e < (TP + 1) * 96; e += NGT) {
        const int pi = e / 96, i = e % 96; const float pos = (float)(pi == TP ? PAST : pi);
        const float ex = (i < 64) ? (float)(2 * i) * (1.f / 128.f) : (float)(2 * (i - 64)) * (1.f / 64.f);
        const float inv = __builtin_amdgcn_exp2f(-ex * 13.287712379549449f);
        const float angf = pos * inv;
        double rev = (double)angf * 0.15915494309189535; rev -= __builtin_rint(rev);
        const float rf = (float)rev; const float sn = __builtin_amdgcn_sinf(rf), cs = __builtin_amdgcn_cosf(rf);
        if (i < 64) t128[pi * 64 + i] = (f32x2){cs, sn}; else t64[pi * 32 + (i - 64)] = (f32x2){cs, sn};
    }
}

__device__ __forceinline__ void ln_phase(const float* Z, const float* ZP, bf16* X, bf16* Xo, const float* gam, const float* bet, float* yp, float* ys, int gw, int NGW, int lane) {
    for (int r = gw; r < NROWS; r += NGW) {
        const bool ext = r >= XROW0; const float* zr = ext ? ZP + (size_t)(r - XROW0) * DM : Z + (size_t)r * DM; bf16* xr = X + (size_t)r * DM;
        float v[32]; float s = 0.f;
#pragma unroll
        for (int j = 0; j < 4; ++j) { const int c = 512 * j + 8 * lane; f32x4 z0 = *(const f32x4*)(zr + c), z1 = *(const f32x4*)(zr + c + 4); const v4u xv = *(const v4u*)(xr + c);
            if (ext) {
#pragma unroll
                for (int sl = 1; sl < 8; ++sl) { z0 += *(const f32x4*)(zr + (size_t)sl * XR * DM + c); z1 += *(const f32x4*)(zr + (size_t)sl * XR * DM + c + 4); } }
            float xf[8]; unpack8(xv, xf);
            v[8 * j + 0] = ALPHA * xf[0] + z0.x; v[8 * j + 1] = ALPHA * xf[1] + z0.y; v[8 * j + 2] = ALPHA * xf[2] + z0.z; v[8 * j + 3] = ALPHA * xf[3] + z0.w;
            v[8 * j + 4] = ALPHA * xf[4] + z1.x; v[8 * j + 5] = ALPHA * xf[5] + z1.y; v[8 * j + 6] = ALPHA * xf[6] + z1.z; v[8 * j + 7] = ALPHA * xf[7] + z1.w;
#pragma unroll
            for (int i = 0; i < 8; ++i) s += v[8 * j + i]; }
        const float mean = wave_sum(s) * (1.f / DM); float s2 = 0.f;
#pragma unroll
        for (int i = 0; i < 32; ++i) { v[i] -= mean; s2 += v[i] * v[i]; }
        const float rstd = 1.f / sqrtf(wave_sum(s2) * (1.f / DM) + LN_EPS);
        float* of = nullptr;
        if (yp) { if (r < XROW0) of = yp + (size_t)r * DM; else if (r >= SROW0) of = ys + (size_t)(r - SROW0) * DM; }
#pragma unroll
        for (int j = 0; j < 4; ++j) { const int c = 512 * j + 8 * lane; const f32x4 g0 = *(const f32x4*)(gam + c), g1 = *(const f32x4*)(gam + c + 4), b0 = *(const f32x4*)(bet + c), b1 = *(const f32x4*)(bet + c + 4);
            float o[8];
            o[0] = v[8 * j + 0] * rstd * g0.x + b0.x; o[1] = v[8 * j + 1] * rstd * g0.y + b0.y; o[2] = v[8 * j + 2] * rstd * g0.z + b0.z; o[3] = v[8 * j + 3] * rstd * g0.w + b0.w;
            o[4] = v[8 * j + 4] * rstd * g1.x + b1.x; o[5] = v[8 * j + 5] * rstd * g1.y + b1.y; o[6] = v[8 * j + 6] * rstd * g1.z + b1.z; o[7] = v[8 * j + 7] * rstd * g1.w + b1.w;
            *(v4u*)(Xo + (size_t)r * DM + c) = pack8(o);
            if (of) { *(f32x4*)(of + c) = (f32x4){o[0], o[1], o[2], o[3]}; *(f32x4*)(of + c + 4) = (f32x4){o[4], o[5], o[6], o[7]}; } }
    }
}

__device__ __forceinline__ void load_u(const bf16* BCH, int row, int c0, float (&u)[8]) {
    const v4u cg = *(const v4u*)(BCH + (size_t)row * NA_IN + DM + c0), hh = *(const v4u*)(BCH + (size_t)row * NA_IN + 2 * DM + c0);
    float a[8], b[8]; unpack8(cg, a); unpack8(hh, b);
#pragma unroll
    for (int i = 0; i < 8; ++i) u[i] = a[i] * b[i];
}
__device__ __forceinline__ void convA_phase(const bf16* BCH, bf16* Y, const float* cw, const float* hist, float* outp, float* outs, int gtid, int NT) {
    for (int it = gtid; it < NROWS * 256; it += NT) {
        const int r = it >> 8, c0 = (it & 255) * 8;
        float u0[8], u1[8], u2[8];
        load_u(BCH, r, c0, u2);
        if (r < SROW0) {
            int b, t; row_bt(r, b, t);
            if (t >= 1) load_u(BCH, prow(b, t - 1), c0, u1); else {
#pragma unroll
                for (int i = 0; i < 8; ++i) u1[i] = 0.f; }
            if (t >= 2) load_u(BCH, prow(b, t - 2), c0, u0); else {
#pragma unroll
                for (int i = 0; i < 8; ++i) u0[i] = 0.f; }
            if (t >= TP - 2) { float* o = outp + ((size_t)(b * 2 + (t - (TP - 2)))) * DM + c0; *(f32x4*)o = (f32x4){u2[0], u2[1], u2[2], u2[3]}; *(f32x4*)(o + 4) = (f32x4){u2[4], u2[5], u2[6], u2[7]}; }
        } else {
            const int sb = r - SROW0; const float* h0 = hist + ((size_t)(sb * 2 + 0)) * DM + c0; const float* h1 = hist + ((size_t)(sb * 2 + 1)) * DM + c0;
            const f32x4 a0 = *(const f32x4*)h0, a1 = *(const f32x4*)(h0 + 4), b0 = *(const f32x4*)h1, b1 = *(const f32x4*)(h1 + 4);
            u0[0] = a0.x; u0[1] = a0.y; u0[2] = a0.z; u0[3] = a0.w; u0[4] = a1.x; u0[5] = a1.y; u0[6] = a1.z; u0[7] = a1.w;
            u1[0] = b0.x; u1[1] = b0.y; u1[2] = b0.z; u1[3] = b0.w; u1[4] = b1.x; u1[5] = b1.y; u1[6] = b1.z; u1[7] = b1.w;
            float* o0 = outs + ((size_t)(sb * 2 + 0)) * DM + c0; float* o1 = outs + ((size_t)(sb * 2 + 1)) * DM + c0;
            *(f32x4*)o0 = b0; *(f32x4*)(o0 + 4) = b1;
            *(f32x4*)o1 = (f32x4){u2[0], u2[1], u2[2], u2[3]}; *(f32x4*)(o1 + 4) = (f32x4){u2[4], u2[5], u2[6], u2[7]};
        }
        float bg[8]; unpack8(*(const v4u*)(BCH + (size_t)r * NA_IN + c0), bg);
        float w0[8], w1[8], w2[8];
        { const f32x4 a = *(const f32x4*)(cw + c0), b = *(const f32x4*)(cw + c0 + 4); w0[0] = a.x; w0[1] = a.y; w0[2] = a.z; w0[3] = a.w; w0[4] = b.x; w0[5] = b.y; w0[6] = b.z; w0[7] = b.w; }
        { const f32x4 a = *(const f32x4*)(cw + DM + c0), b = *(const f32x4*)(cw + DM + c0 + 4); w1[0] = a.x; w1[1] = a.y; w1[2] = a.z; w1[3] = a.w; w1[4] = b.x; w1[5] = b.y; w1[6] = b.z; w1[7] = b.w; }
        { const f32x4 a = *(const f32x4*)(cw + 2 * DM + c0), b = *(const f32x4*)(cw + 2 * DM + c0 + 4); w2[0] = a.x; w2[1] = a.y; w2[2] = a.z; w2[3] = a.w; w2[4] = b.x; w2[5] = b.y; w2[6] = b.z; w2[7] = b.w; }
        float y[8];
#pragma unroll
        for (int i = 0; i < 8; ++i) y[i] = bg[i] * (w0[i] * u0[i] + w1[i] * u1[i] + w2[i] * u2[i]);
        *(v4u*)(Y + (size_t)r * DM + c0) = pack8(y);
    }
}

constexpr float QSCALE = 0.08838834764831845f;
__device__ __forceinline__ void rope_phase(const bf16* PROJ, const Ptrs& P, int gw, int NGW, int lane) {
    unsigned char* ws = P.ws;
    const f32x2* t128 = (const f32x2*)(ws + WS_TAB128); const f32x2* t64 = (const f32x2*)(ws + WS_TAB64);
    bf16* Qr = (bf16*)(ws + WS_QR); bf16* QI = (bf16*)(ws + WS_QI); bf16* KIb = (bf16*)(ws + WS_KIB); float* WI = (float*)(ws + WS_WI);
    bf16* Ks = (bf16*)(ws + WS_KS); bf16* Vs = (bf16*)(ws + WS_VS);
    for (int pr_ = gw; pr_ < NBP * SPAD; pr_ += NGW) {
        const size_t o = ((size_t)((pr_ / SPAD) * SP + (pr_ % SPAD))) * 512 + 8 * lane; *(v4u*)(Ks + o) = (v4u){0u, 0u, 0u, 0u}; *(v4u*)(Vs + o) = (v4u){0u, 0u, 0u, 0u}; }
    for (int r = gw; r < NROWS; r += NGW) {
        const bf16* pr = PROJ + (size_t)r * NB_PAD;
        int pi; float *ko, *vo, *iko; bf16* kib = nullptr; bf16 *ksq = nullptr, *vsq = nullptr;
        if (r < SROW0) { int b, t; row_bt(r, b, t); pi = t; ksq = Ks + ((size_t)(b * SP + t + SPAD)) * 512; vsq = Vs + ((size_t)(b * SP + t + SPAD)) * 512; ko = P.out + O_KP + ((size_t)(b * TP + t)) * 512; vo = P.out + O_VP + ((size_t)(b * TP + t)) * 512; iko = P.out + O_IKP + ((size_t)(b * TP + t)) * 64; kib = KIb + ((size_t)(b * KIROWS + t)) * 64; }
        else { const int sb = r - SROW0; pi = POS_SAMPLE_IDX; ko = P.out + O_KS + (size_t)sb * 512; vo = P.out + O_VS + (size_t)sb * 512; iko = P.out + O_IKS + (size_t)sb * 64; }
        const f32x2* c128 = t128 + (size_t)pi * 64; const f32x2* c64 = t64 + (size_t)pi * 32;
        for (int e = lane; e < 1024; e += 64) { const int hd = e >> 6, i = e & 63; const float x1 = bf2f(pr[hd * 128 + i]), x2 = bf2f(pr[hd * 128 + 64 + i]); const f32x2 cs = c128[i];
            Qr[(size_t)r * DM + hd * 128 + i] = f2bf((x1 * cs.x - x2 * cs.y) * QSCALE); Qr[(size_t)r * DM + hd * 128 + 64 + i] = f2bf((x2 * cs.x + x1 * cs.y) * QSCALE); }
        for (int e = lane; e < 256; e += 64) { const int hd = e >> 6, i = e & 63; const float x1 = bf2f(pr[2048 + hd * 128 + i]), x2 = bf2f(pr[2048 + hd * 128 + 64 + i]); const f32x2 cs = c128[i];
            const float o1 = x1 * cs.x - x2 * cs.y, o2 = x2 * cs.x + x1 * cs.y; ko[hd * 128 + i] = o1; ko[hd * 128 + 64 + i] = o2;
            if (ksq) { ksq[hd * 128 + i] = f2bf(o1); ksq[hd * 128 + 64 + i] = f2bf(o2); } }
        for (int e = lane; e < 512; e += 64) { vo[e] = bf2f(pr[2560 + e]); if (vsq) vsq[e] = pr[2560 + e]; }
        for (int e = lane; e < 512; e += 64) { const int hd = e >> 5, i = e & 31; const float x1 = bf2f(pr[3072 + hd * 64 + i]), x2 = bf2f(pr[3072 + hd * 64 + 32 + i]); const f32x2 cs = c64[i];
            QI[(size_t)r * 1024 + hd * 64 + i] = f2bf(x1 * cs.x - x2 * cs.y); QI[(size_t)r * 1024 + hd * 64 + 32 + i] = f2bf(x2 * cs.x + x1 * cs.y); }
        if (lane < 32) { const int i = lane; const float x1 = bf2f(pr[4096 + i]), x2 = bf2f(pr[4096 + 32 + i]); const f32x2 cs = c64[i]; const float o1 = x1 * cs.x - x2 * cs.y, o2 = x2 * cs.x + x1 * cs.y;
            iko[i] = o1; iko[32 + i] = o2; if (kib) { kib[i] = f2bf(o1); kib[32 + i] = f2bf(o2); } }
        else if (lane < 48) { const int i = lane - 32; WI[(size_t)r * 16 + i] = bf2f(pr[4160 + i]); }
    }
}

__device__ __forceinline__ void indexer_prompt(const Ptrs& P, int gw, int NGW, int lane) {
    unsigned char* ws = P.ws;
    const bf16* QI = (const bf16*)(ws + WS_QI); const bf16* KIb = (const bf16*)(ws + WS_KIB); const float* WI = (const float*)(ws + WS_WI); float* SC = (float*)(ws + WS_SC);
    const int n = lane & 31, h8 = lane >> 5;
    const int qsel = (n >> 2) & 1, head = (n & 3) + 4 * (n >> 3);
    constexpr int NIT = NBP * (TP / 2);
    for (int k = gw; k < NIT; k += NGW) {
        const int idx = (k < NIT / 2) ? k : (NIT - 1) - (k - NIT / 2);
        const int b = idx & 1, p = idx >> 1, t0 = 2 * p;
        const bf16* qa = QI + (size_t)prow(b, t0 + qsel) * 1024 + head * 64 + 8 * h8;
        bf16x8 a[4];
#pragma unroll
        for (int kk = 0; kk < 4; ++kk) a[kk] = *(const bf16x8*)(qa + 16 * kk);
        const int tq = t0 + h8;
        const float* wp = WI + (size_t)prow(b, tq) * 16;
        float w[16];
#pragma unroll
        for (int i = 0; i < 4; ++i) { const f32x4 x = *(const f32x4*)(wp + 4 * i); w[4 * i] = x.x; w[4 * i + 1] = x.y; w[4 * i + 2] = x.z; w[4 * i + 3] = x.w; }
        const int ntile = ((t0 + 1) >> 5) + 1;
        const bf16* kb = KIb + ((size_t)b * KIROWS + n) * 64 + 8 * h8;
        float* scrow = SC + ((size_t)(b * TP + tq)) * SCW;
        for (int kt0 = 0; kt0 < ntile; kt0 += 4) {
            bf16x8 bb[4][4];
#pragma unroll
            for (int u = 0; u < 4; ++u) { const int ktc = (kt0 + u < 129) ? kt0 + u : 128; const bf16* kp = kb + (size_t)ktc * 32 * 64;
#pragma unroll
                for (int kk = 0; kk < 4; ++kk) bb[u][kk] = *(const bf16x8*)(kp + 16 * kk); }
#pragma unroll
            for (int u = 0; u < 4; ++u) {
                f32x16 acc;
#pragma unroll
                for (int i = 0; i < 16; ++i) acc[i] = 0.f;
#pragma unroll
                for (int kk = 0; kk < 4; ++kk) acc = __builtin_amdgcn_mfma_f32_32x32x16_bf16(a[kk], bb[u][kk], acc, 0, 0, 0);
                float sc = 0.f;
#pragma unroll
                for (int i = 0; i < 16; ++i) sc += w[i] * fmaxf(acc[i], 0.f);
                const int s = 32 * (kt0 + u) + n;
                if (s <= tq) scrow[s] = sc;
            }
        }
    }
}

__device__ __forceinline__ void indexer_sample(const Ptrs& P, LAS unsigned char* lds, int tid) {
    unsigned char* ws = P.ws;
    const bf16* QI = (const bf16*)(ws + WS_QI); const float* WI = (const float*)(ws + WS_WI); float* SCS = (float*)(ws + WS_SCS);
    LAS float* lq = (LAS float*)lds;
    LAS float* lw = lq + 1024;
    constexpr int NCH = (NSKEY + 511) / 512;
    for (int item = blockIdx.x; item < SBN * NCH; item += gridDim.x) {
        const int sb = item / NCH, ch = item % NCH, r = SROW0 + sb;
        __syncthreads();
        for (int e = tid; e < 1024; e += NTHREADS) lq[e] = bf2f(QI[(size_t)r * 1024 + e]);
        if (tid < 16) lw[tid] = WI[(size_t)r * 16 + tid];
        __syncthreads();
        const int s = ch * 512 + tid;
        if (s < NSKEY) {
            const float* kr = (s < PAST) ? P.cache_ik + ((size_t)P.page_table[sb * NPG + (s >> 7)] * 128 + (s & 127)) * 64 : P.out + O_IKS + (size_t)sb * 64;
            f32x4 kv[16];
#pragma unroll
            for (int i = 0; i < 16; ++i) kv[i] = *(const f32x4*)(kr + 4 * i);
            float sc = 0.f;
            for (int h = 0; h < 16; ++h) { float d = 0.f;
#pragma unroll
                for (int i = 0; i < 16; ++i) { const f32x4 q = *(const LAS f32x4*)(lq + h * 64 + 4 * i); d += q.x * kv[i].x + q.y * kv[i].y + q.z * kv[i].z + q.w * kv[i].w; }
                sc += lw[h] * fmaxf(d, 0.f); }
            SCS[(size_t)sb * SCSW + s] = sc;
        }
    }
    __syncthreads();
}

__device__ __forceinline__ unsigned ordkey(float f) { const unsigned u = __float_as_uint(f); return (u & 0x80000000u) ? ~u : (u | 0x80000000u); }
constexpr int TOPK = 256;
__device__ __forceinline__ void topk_wave_mask(const float* sc, int n, unsigned long long* mrow, int lane) {
    constexpr int NS = MTW, M0 = SPAD / 64;
    static_assert(M0 == dattn::JLO, "first real key tile");
    unsigned key[NS];
#pragma unroll
    for (int m = M0; m < NS; ++m) { const int sidx = lane + 64 * m - SPAD; const int ci = sidx < 0 ? 0 : (sidx < n ? sidx : n - 1); const float v = sc[ci]; key[m] = (sidx >= 0 && sidx < n) ? ordkey(v) : 0u; }
    if (n <= TOPK) {
#pragma unroll
        for (int m = M0; m < NS; ++m) { const unsigned long long w = __ballot(key[m] != 0u); if (lane == 0) mrow[m] = w; }
        return;
    }
    unsigned T = 0u;
    for (int bit = 31; bit >= 0; --bit) {
        const unsigned cand = T | (1u << bit); int c = 0;
#pragma unroll
        for (int m = M0; m < NS; ++m) c += __popcll(__ballot(key[m] >= cand));
        if (c >= TOPK) T = cand;
    }
    int cg = 0;
#pragma unroll
    for (int m = M0; m < NS; ++m) cg += __popcll(__ballot(key[m] > T));
    const int need = TOPK - cg;
    int base_e = 0;
    const unsigned long long lt = (1ull << lane) - 1ull;
#pragma unroll
    for (int m = M0; m < NS; ++m) {
        const bool pg = key[m] > T, pe = key[m] == T;
        const unsigned long long me = __ballot(pe);
        const int pre_e = __popcll(me & lt);
        const unsigned long long w = __ballot(pg || (pe && (base_e + pre_e) < need));
        if (lane == 0) mrow[m] = w;
        base_e += __popcll(me);
    }
}
__device__ __forceinline__ void topk_block(const float* sc, int n, int* outIdx, int* outCnt, LAS unsigned* ls, int tid, int wave, int lane) {
    constexpr int NS = (NSKEY + NTHREADS - 1) / NTHREADS;
    unsigned key[NS];
#pragma unroll
    for (int m = 0; m < NS; ++m) { const int e = tid + NTHREADS * m; const float v = sc[e < n ? e : n - 1]; key[m] = (e < n) ? ordkey(v) : 0u; }
    unsigned T = 0u;
    for (int bit = 31; bit >= 0; --bit) {
        const unsigned cand = T | (1u << bit); int c = 0;
#pragma unroll
        for (int m = 0; m < NS; ++m) c += (key[m] >= cand) ? 1 : 0;
        c = wave_sum_i(c);
        LAS unsigned* buf = ls + (bit & 1) * 8;
        if (lane == 0) buf[wave] = (unsigned)c;
        __syncthreads();
        int tot = 0;
#pragma unroll
        for (int w = 0; w < 8; ++w) tot += (int)buf[w];
        if (tot >= TOPK) T = cand;
    }
    __syncthreads();
    if (tid == 0) { unsigned z_ = 0u; asm volatile("" : "+v"(z_)); ls[16] = z_; ls[17] = z_; }
    __syncthreads();
#pragma unroll
    for (int m = 0; m < NS; ++m) { const int e = tid + NTHREADS * m; if (key[m] > T) { const unsigned pos = atomicAdd((unsigned*)(ls + 16), 1u); if (pos < (unsigned)TOPK) outIdx[pos] = e; } }
    __syncthreads();
    const unsigned cg = ls[16];
    const unsigned need = (unsigned)TOPK - cg;
#pragma unroll
    for (int m = 0; m < NS; ++m) { const int e = tid + NTHREADS * m; if (key[m] == T) { const unsigned pos = atomicAdd((unsigned*)(ls + 17), 1u); if (pos < need) outIdx[cg + pos] = e; } }
    if (tid == 0) *outCnt = TOPK;
    __syncthreads();
}
__device__ __forceinline__ void select_phase(const Ptrs& P, LAS unsigned char* lds, int gw, int NGW, int tid, int wave, int lane) {
    unsigned char* ws = P.ws;
    const float* SC = (const float*)(ws + WS_SC); const float* SCS = (const float*)(ws + WS_SCS); int* IDXL = (int*)(ws + WS_IDXL); int* CNT = (int*)(ws + WS_CNT);
    for (int sb = blockIdx.x; sb < SBN; sb += gridDim.x) topk_block(SCS + (size_t)sb * SCSW, NSKEY, IDXL + (size_t)(SROW0 + sb) * TOPK, CNT + SROW0 + sb, (LAS unsigned*)lds, tid, wave, lane);
    unsigned long long* MASK = (unsigned long long*)(ws + WS_MASK);
    for (int r = gw; r < SROW0; r += NGW) { int b, t; row_bt(r, b, t);
        if (r < XROW0) topk_wave_mask(SC + ((size_t)(b * TP + t)) * SCW, t + 1, MASK + ((size_t)(b * SP + t + SPAD)) * MTW, lane);
        else { if (lane <= t) IDXL[(size_t)r * TOPK + lane] = lane; if (lane == 0) CNT[r] = t + 1; } }
}

__device__ __forceinline__ void attn_phase(const Ptrs& P, bf16* O, LAS unsigned char* lds, int gw, int NGW, int wave, int lane) {
    unsigned char* ws = P.ws;
    const bf16* Qr = (const bf16*)(ws + WS_QR); const int* IDXL = (const int*)(ws + WS_IDXL); const int* CNT = (const int*)(ws + WS_CNT);
    LAS float* lq = (LAS float*)(lds + wave * 12288);
    LAS f32x4* lp = (LAS f32x4*)(lds + wave * 12288 + 2048);
    LAS unsigned long long* lkp = (LAS unsigned long long*)(lds + wave * 12288 + 6144);
    LAS unsigned long long* lvp = (LAS unsigned long long*)(lds + wave * 12288 + 8192);
    for (int item = gw; item < (NROWS - XROW0) * 4; item += NGW) {
        const int r = XROW0 + (item >> 2), n = item & 3;
        const int cnt = CNT[r];
        WAVE_SYNC();
        { float qf[8]; unpack8(*(const v4u*)(Qr + (size_t)r * DM + n * 512 + 8 * lane), qf);
          *(LAS f32x4*)(lq + 8 * lane) = (f32x4){qf[0], qf[1], qf[2], qf[3]}; *(LAS f32x4*)(lq + 8 * lane + 4) = (f32x4){qf[4], qf[5], qf[6], qf[7]}; }
        const float* kp[4];
#pragma unroll
        for (int j = 0; j < 4; ++j) {
            const int e = lane + 64 * j; const int s = (e < cnt) ? IDXL[(size_t)r * TOPK + e] : 0;
            const float *kq, *vq;
            if (r < SROW0) { const int b = (r < XROW0) ? (r >> 12) : ((r - XROW0) >> 4); kq = P.out + O_KP + ((size_t)(b * TP + s)) * 512; vq = P.out + O_VP + ((size_t)(b * TP + s)) * 512; }
            else { const int sb = r - SROW0;
                if (s < PAST) { const size_t off = ((size_t)P.page_table[sb * NPG + (s >> 7)] * 128 + (s & 127)) * 512; kq = P.cache_k + off; vq = P.cache_v + off; }
                else { kq = P.out + O_KS + (size_t)sb * 512; vq = P.out + O_VS + (size_t)sb * 512; } }
            kp[j] = kq + n * 128; lkp[e] = (unsigned long long)(kq + n * 128); lvp[e] = (unsigned long long)(vq + n * 128);
        }
        WAVE_SYNC();
        float acc[4][4];
#pragma unroll
        for (int g = 0; g < 4; ++g)
#pragma unroll
            for (int j = 0; j < 4; ++j) acc[g][j] = 0.f;
#pragma unroll 4
        for (int d4 = 0; d4 < 32; ++d4) {
            f32x4 qv[4];
#pragma unroll
            for (int g = 0; g < 4; ++g) qv[g] = *(const LAS f32x4*)(lq + g * 128 + 4 * d4);
#pragma unroll
            for (int j = 0; j < 4; ++j) { const f32x4 kv = *(const f32x4*)(kp[j] + 4 * d4);
#pragma unroll
                for (int g = 0; g < 4; ++g) acc[g][j] += qv[g].x * kv.x + qv[g].y * kv.y + qv[g].z * kv.z + qv[g].w * kv.w; }
        }
        float linv[4];
#pragma unroll
        for (int g = 0; g < 4; ++g) {
            float m = -INFINITY;
#pragma unroll
            for (int j = 0; j < 4; ++j) { if (lane + 64 * j >= cnt) acc[g][j] = -INFINITY; m = fmaxf(m, acc[g][j]); }
            m = wave_max(m); float l = 0.f;
#pragma unroll
            for (int j = 0; j < 4; ++j) { acc[g][j] = __expf(acc[g][j] - m); l += acc[g][j]; }
            linv[g] = 1.f / wave_sum(l);
        }
#pragma unroll
        for (int j = 0; j < 4; ++j) lp[lane + 64 * j] = (f32x4){acc[0][j], acc[1][j], acc[2][j], acc[3][j]};
        WAVE_SYNC();
        float o[4][2];
#pragma unroll
        for (int g = 0; g < 4; ++g) { o[g][0] = 0.f; o[g][1] = 0.f; }
#pragma unroll 8
        for (int e = 0; e < cnt; ++e) {
            const float* vp = (const float*)lvp[e]; const f32x2 vv = *(const f32x2*)(vp + 2 * lane); const f32x4 p = lp[e];
            o[0][0] += p.x * vv.x; o[0][1] += p.x * vv.y; o[1][0] += p.y * vv.x; o[1][1] += p.y * vv.y; o[2][0] += p.z * vv.x; o[2][1] += p.z * vv.y; o[3][0] += p.w * vv.x; o[3][1] += p.w * vv.y;
        }
#pragma unroll
        for (int g = 0; g < 4; ++g) *(unsigned*)(O + (size_t)r * DM + (4 * n + g) * 128 + 2 * lane) = pk2(o[g][0] * linv[g], o[g][1] * linv[g]);
    }
}

__device__ __forceinline__ void convC_phase(const bf16* PROJC, const Ptrs& P, int gw, int NGW, int lane) {
    unsigned char* ws = P.ws;
    bf16* QKVC = (bf16*)(ws + WS_QKVC); float* QKF = (float*)(ws + WS_QKF); float* G = (float*)(ws + WS_G); float* BETA = (float*)(ws + WS_BETA);
    const float* cw = P.conv_w_c;
    for (int r = gw; r < NROWS; r += NGW) {
        int b = 0, t = 0, sb = 0; const bool samp = r >= SROW0;
        if (samp) sb = r - SROW0; else row_bt(r, b, t);
        int rr[3];
#pragma unroll
        for (int j = 0; j < 3; ++j) rr[j] = (!samp && t - 3 + j >= 0) ? prow(b, t - 3 + j) : -1;
        for (int it = 0; it < 16; ++it) {
            const int ch0 = it * 512 + 8 * lane;
            float x[4][8];
#pragma unroll
            for (int j = 0; j < 3; ++j) {
                if (samp) { const float* hp = P.state_conv_c + ((size_t)(sb * 3 + j)) * CDIM + ch0; const f32x4 a = *(const f32x4*)hp, c = *(const f32x4*)(hp + 4);
                    x[j][0] = a.x; x[j][1] = a.y; x[j][2] = a.z; x[j][3] = a.w; x[j][4] = c.x; x[j][5] = c.y; x[j][6] = c.z; x[j][7] = c.w; }
                else if (rr[j] >= 0) unpack8(*(const v4u*)(PROJC + (size_t)rr[j] * NC_PAD + ch0), x[j]);
                else {
#pragma unroll
                    for (int i = 0; i < 8; ++i) x[j][i] = 0.f; }
            }
            unpack8(*(const v4u*)(PROJC + (size_t)r * NC_PAD + ch0), x[3]);
            float acc[8];
#pragma unroll
            for (int i = 0; i < 8; ++i) acc[i] = 0.f;
#pragma unroll
            for (int j = 0; j < 4; ++j) { const f32x4 w0 = *(const f32x4*)(cw + (size_t)j * CDIM + ch0), w1 = *(const f32x4*)(cw + (size_t)j * CDIM + ch0 + 4);
                acc[0] += w0.x * x[j][0]; acc[1] += w0.y * x[j][1]; acc[2] += w0.z * x[j][2]; acc[3] += w0.w * x[j][3];
                acc[4] += w1.x * x[j][4]; acc[5] += w1.y * x[j][5]; acc[6] += w1.z * x[j][6]; acc[7] += w1.w * x[j][7]; }
            float ss = 0.f;
#pragma unroll
            for (int i = 0; i < 8; ++i) { acc[i] = silu_f(acc[i]); ss += acc[i] * acc[i]; }
            if (it < 8) { ss = row16_sum(ss); float rn = 1.f / sqrtf(ss + RMS_EPS); if (it < 4) rn *= QSCALE;
#pragma unroll
                for (int i = 0; i < 8; ++i) acc[i] *= rn; }
            if (it < 8 && samp) { float* qk = QKF + (size_t)r * 4096 + ch0; *(f32x4*)qk = (f32x4){acc[0], acc[1], acc[2], acc[3]}; *(f32x4*)(qk + 4) = (f32x4){acc[4], acc[5], acc[6], acc[7]}; }
            *(v4u*)(QKVC + (size_t)r * CDIM + ch0) = pack8(acc);
            if (samp) {
                float* o = P.out + O_CCS + ((size_t)(sb * 3)) * CDIM + ch0;
#pragma unroll
                for (int j = 0; j < 3; ++j) { *(f32x4*)(o + (size_t)j * CDIM) = (f32x4){x[j + 1][0], x[j + 1][1], x[j + 1][2], x[j + 1][3]}; *(f32x4*)(o + (size_t)j * CDIM + 4) = (f32x4){x[j + 1][4], x[j + 1][5], x[j + 1][6], x[j + 1][7]}; }
            } else if (t >= TP - 3) {
                float* o = P.out + O_CCP + ((size_t)(b * 3 + (t - (TP - 3)))) * CDIM + ch0;
                *(f32x4*)o = (f32x4){x[3][0], x[3][1], x[3][2], x[3][3]}; *(f32x4*)(o + 4) = (f32x4){x[3][4], x[3][5], x[3][6], x[3][7]};
            }
        }
        if (lane < 32) {
            const float braw = bf2f(PROJC[(size_t)r * NC_PAD + 12288 + lane]), araw = bf2f(PROJC[(size_t)r * NC_PAD + 12320 + lane]);
            const float xx = araw + P.dt_bias[lane]; const float sp = xx > 20.f ? xx : __logf(1.f + __expf(xx));
            G[(size_t)r * 32 + lane] = -__expf(P.a_log[lane]) * sp; BETA[(size_t)r * 32 + lane] = 1.f / (1.f + __expf(-braw));
        }
    }
}

struct Tok { f32x4 k0, k1, q0, q1; unsigned v; float g, b; };
__device__ __forceinline__ void tok_load(Tok& T, const float* QKF, const bf16* QKVC, const float* G, const float* BETA, int row, int h, int rg, int col0) {
    const float* base = QKF + (size_t)row * 4096 + (h >> 1) * 128 + 8 * rg;
    T.q0 = *(const f32x4*)base; T.q1 = *(const f32x4*)(base + 4); T.k0 = *(const f32x4*)(base + 2048); T.k1 = *(const f32x4*)(base + 2052);
    T.v = *(const unsigned*)(QKVC + (size_t)row * CDIM + 4096 + h * 128 + col0);
    T.g = G[(size_t)row * 32 + h]; T.b = BETA[(size_t)row * 32 + h];
}
__device__ __forceinline__ f32x2 tok_step(f32x2 (&S)[8], const Tok& T) {
    const float kk[8] = {T.k0.x, T.k0.y, T.k0.z, T.k0.w, T.k1.x, T.k1.y, T.k1.z, T.k1.w};
    const float qq[8] = {T.q0.x, T.q0.y, T.q0.z, T.q0.w, T.q1.x, T.q1.y, T.q1.z, T.q1.w};
    const float a = __expf(T.g);
    f32x2 d0 = S[0] * kk[0], d1 = S[1] * kk[1];
#pragma unroll
    for (int i = 2; i < 8; i += 2) { d0 += S[i] * kk[i]; d1 += S[i + 1] * kk[i + 1]; }
    f32x2 d = d0 + d1;
    d.x = row16_sum(d.x); d.y = row16_sum(d.y);
    const f32x2 tv = {bflo(T.v), bfhi(T.v)};
    const f32x2 dl = (tv - d * a) * T.b;
    f32x2 o0 = {0.f, 0.f}, o1 = {0.f, 0.f};
#pragma unroll
    for (int i = 0; i < 8; i += 2) { S[i] = S[i] * a + dl * kk[i]; o0 += S[i] * qq[i]; S[i + 1] = S[i + 1] * a + dl * kk[i + 1]; o1 += S[i + 1] * qq[i + 1]; }
    f32x2 o = o0 + o1;
    o.x = row16_sum(o.x); o.y = row16_sum(o.y);
    return o;
}
constexpr int DBK = 2;
__device__ __forceinline__ void delta_segment(f32x2 (&S)[8], const float* QKF, const bf16* QKVC, const float* G, const float* BETA, float* OF, int rowbase, int ntok, int h, int rg, int col0) {
    Tok A[DBK], B[DBK];
#pragma unroll
    for (int i = 0; i < DBK; ++i) tok_load(A[i], QKF, QKVC, G, BETA, rowbase + i, h, rg, col0);
    for (int t0 = 0; t0 < ntok; t0 += 2 * DBK) {
        f32x2 o[DBK];
#pragma unroll
        for (int i = 0; i < DBK; ++i) tok_load(B[i], QKF, QKVC, G, BETA, rowbase + t0 + DBK + i, h, rg, col0);
#pragma unroll
        for (int i = 0; i < DBK; ++i) o[i] = tok_step(S, A[i]);
        if (rg == 0) {
#pragma unroll
            for (int i = 0; i < DBK; ++i) *(f32x2*)(OF + (size_t)(rowbase + t0 + i) * DVW + h * 128 + col0) = o[i]; }
        if (t0 + 2 * DBK < ntok) {
#pragma unroll
            for (int i = 0; i < DBK; ++i) tok_load(A[i], QKF, QKVC, G, BETA, rowbase + t0 + 2 * DBK + i, h, rg, col0); }
#pragma unroll
        for (int i = 0; i < DBK; ++i) o[i] = tok_step(S, B[i]);
        if (rg == 0) {
#pragma unroll
            for (int i = 0; i < DBK; ++i) *(f32x2*)(OF + (size_t)(rowbase + t0 + DBK + i) * DVW + h * 128 + col0) = o[i]; }
    }
}
__device__ __forceinline__ void delta_phase(const Ptrs& P, int wave, int lane) {
    unsigned char* ws = P.ws;
    const bf16* QKVC = (const bf16*)(ws + WS_QKVC); const float* QKF = (const float*)(ws + WS_QKF); const float* G = (const float*)(ws + WS_G); const float* BETA = (const float*)(ws + WS_BETA); float* OF = (float*)(ws + WS_SC);
    const int cg = lane >> 4, rg = lane & 15;
    {
        for (int item = blockIdx.x * 8 + wave; item < SBN * 32 * 16; item += gridDim.x * 8) {
            const int sb = item >> 9, h = (item >> 4) & 31, col0 = 8 * (item & 15) + 2 * cg;
            const size_t so = ((size_t)((sb * 32 + h) * 128 + 8 * rg)) * 128 + col0;
            f32x2 S[8];
#pragma unroll
            for (int i = 0; i < 8; ++i) S[i] = *(const f32x2*)(P.state_delta + so + (size_t)i * 128);
            Tok T; tok_load(T, QKF, QKVC, G, BETA, SROW0 + sb, h, rg, col0);
            const f32x2 o = tok_step(S, T);
            if (rg == 0) *(f32x2*)(OF + (size_t)(SROW0 + sb) * DVW + h * 128 + col0) = o;
            float* op = P.out + O_DS + so;
#pragma unroll
            for (int i = 0; i < 8; ++i) *(f32x2*)(op + (size_t)i * 128) = S[i];
        }
    }
}
__device__ __forceinline__ void normC_phase(const bf16* PROJC, bf16* Y, const Ptrs& P, int gw, int NGW, int lane) {
    const float* OF = (const float*)(P.ws + WS_SC);
    const int d0 = 8 * (lane & 15);
    float nw[8];
    { const f32x4 a = *(const f32x4*)(P.norm_w + d0), b = *(const f32x4*)(P.norm_w + d0 + 4); nw[0] = a.x; nw[1] = a.y; nw[2] = a.z; nw[3] = a.w; nw[4] = b.x; nw[5] = b.y; nw[6] = b.z; nw[7] = b.w; }
    for (int r = gw; r < NROWS; r += NGW) {
#pragma unroll 2
        for (int it = 0; it < 8; ++it) {
            const int hd = it * 4 + (lane >> 4);
            const float* op = OF + (size_t)r * DVW + hd * 128 + d0;
            const f32x4 a = *(const f32x4*)op, b = *(const f32x4*)(op + 4);
            float o[8] = {a.x, a.y, a.z, a.w, b.x, b.y, b.z, b.w};
            float ss = 0.f;
#pragma unroll
            for (int i = 0; i < 8; ++i) ss += o[i] * o[i];
            ss = row16_sum(ss);
            const float rs = 1.f / sqrtf(ss * (1.f / 128.f) + RMS_EPS);
            float z[8]; unpack8(*(const v4u*)(PROJC + (size_t)r * NC_PAD + 8192 + hd * 128 + d0), z);
#pragma unroll
            for (int i = 0; i < 8; ++i) o[i] = o[i] * rs * nw[i] * silu_f(z[i]);
            *(v4u*)(Y + (size_t)r * DVW + hd * 128 + d0) = pack8(o);
        }
    }
}


__device__ __forceinline__ void dense_attn_phase(const Ptrs& P, bf16* O, char* lds, int wv) {
    unsigned char* ws = P.ws;
    const bf16* Qr = (const bf16*)(ws + WS_QR); const bf16* Ks = (const bf16*)(ws + WS_KS); const bf16* Vs = (const bf16*)(ws + WS_VS);
    const unsigned long long* MASK = (const unsigned long long*)(ws + WS_MASK);
    typedef dattn::BlockRef<bf16, bf16> BR;
    for (int it0 = blockIdx.x; it0 < 256; it0 += gridDim.x) {
        const int grp = it0 & 7, idx = it0 >> 3;
        const int b = grp >> 2, kvh = grp & 3, h = kvh * 4 + (idx >> 3), x = idx & 7;
        BR A, B;
        const int qa = 1 + x, qb = 16 - x;
        A.Q = Qr + ((size_t)(b * SEQ + 256 * (qa - 1))) * DM + h * 128; A.O = O + ((size_t)(b * SEQ + 256 * (qa - 1))) * DM + h * 128;
        B.Q = Qr + ((size_t)(b * SEQ + 256 * (qb - 1))) * DM + h * 128; B.O = O + ((size_t)(b * SEQ + 256 * (qb - 1))) * DM + h * 128;
        A.K = B.K = Ks + (size_t)b * SP * 512 + kvh * 128; A.V = B.V = Vs + (size_t)b * SP * 512 + kvh * 128;
        A.P0 = 256 * qa; B.P0 = 256 * qb;
        A.M = MASK + ((size_t)(b * SP + A.P0)) * MTW; B.M = MASK + ((size_t)(b * SP + B.P0)) * MTW;
        dattn::Seam<bf16> S;
        dattn::causal_swa_prime<bf16, bf16>(A, SP, lds, S, wv);
        dattn::causal_swa_block<bf16, bf16>(A, B, SP, SP, lds, S, wv);
        dattn::causal_swa_block<bf16, bf16>(B, B, SP, SP, lds, S, wv);
    }
}

constexpr int NCH = 65, CPAD = 48;
constexpr int NUQ = NBP * 16 * NCH, NUH = NBP * 32 * NCH;
__device__ __forceinline__ int crow32(int r, int hi) { return (r & 3) + 8 * (r >> 2) + 4 * hi; }
__device__ __forceinline__ int chunk_row(int b, int c, int i) { const int t = 64 * c + i - CPAD; return t >= 0 ? prow(b, t) : -1; }
__device__ __forceinline__ float incl_scan64(float v, int lane) {
#pragma unroll
    for (int o = 1; o < 64; o <<= 1) { const float u = __shfl_up(v, o); if (lane >= o) v += u; }
    return v;
}
#define MFMA32(a, b, c) __builtin_amdgcn_mfma_f32_32x32x16_bf16((a), (b), (c), 0, 0, 0)
__device__ __forceinline__ int sw23(int x) { return (x & ~12) | ((x & 4) << 1) | ((x & 8) >> 1); }
__device__ __forceinline__ int fidx64(int row, int xs) { return ((((row >> 5) * 2 + (xs >> 5)) * 2 + ((xs >> 4) & 1)) * 64 + (row & 31) + 32 * ((xs >> 3) & 1)) * 8 + (xs & 7); }

__device__ __forceinline__ v4u pack_frag(const f32x16& x, int s) { v4u w; w.x = pk2(x[8 * s], x[8 * s + 1]); w.y = pk2(x[8 * s + 2], x[8 * s + 3]); w.z = pk2(x[8 * s + 4], x[8 * s + 5]); w.w = pk2(x[8 * s + 6], x[8 * s + 7]); return w; }
__device__ __forceinline__ void delta_d1_unit(unsigned char* ws, LAS unsigned char* lds, int uq, int wave, int lane) {
    asm volatile("" : "+v"(lane));
    const bf16* QKVC = (const bf16*)(ws + WS_QKVC); const float* G = (const float*)(ws + WS_G); const float* BETA = (const float*)(ws + WS_BETA);
    float* AF = (float*)(ws + WS_DAF); bf16* PG = (bf16*)(ws + WS_DPG); bf16* KT = (bf16*)(ws + WS_DKT); bf16* VT = (bf16*)(ws + WS_DVT);
    float* GC = (float*)(ws + WS_DGC); float* BT = (float*)(ws + WS_DBT);
    LAS float* lg = (LAS float*)(lds + wave * 1024);
    const int m = lane & 31, half = lane >> 5;
    const bf16x8 zf = {0, 0, 0, 0, 0, 0, 0, 0};
    {
        const int c = uq % NCH, bh = uq / NCH, hq = bh & 15, b = bh >> 4;
        { const int row = chunk_row(b, c, lane);
#pragma unroll
          for (int hh = 0; hh < 2; ++hh) { const int h = 2 * hq + hh; const float g = row >= 0 ? G[(size_t)row * 32 + h] : 0.f, bt = row >= 0 ? BETA[(size_t)row * 32 + h] : 0.f;
              const float gc = incl_scan64(g, lane); lg[hh * 64 + lane] = gc; lg[128 + hh * 64 + lane] = bt;
              const size_t uh = ((size_t)(b * 32 + h)) * NCH + c; GC[uh * 64 + lane] = gc; BT[uh * 64 + lane] = bt; } }
        const int row0 = chunk_row(b, c, m), row1 = chunk_row(b, c, 32 + m);
        const bf16* r0 = QKVC + (size_t)(row0 < 0 ? 0 : row0) * CDIM; const bf16* r1 = QKVC + (size_t)(row1 < 0 ? 0 : row1) * CDIM;
        f32x16 kk00, kk10, kk11, qk00, qk10, qk11;
#pragma unroll
        for (int i = 0; i < 16; ++i) { kk00[i] = 0.f; kk10[i] = 0.f; kk11[i] = 0.f; qk00[i] = 0.f; qk10[i] = 0.f; qk11[i] = 0.f; }
        const int sm = sw23(m);
        bf16* kt0 = KT + (size_t)uq * 128 * 64 + half * 32 + ((sm >> 4) & 1) * 512 + ((sm >> 3) & 1) * 256 + (sm & 7);
#pragma unroll 1
        for (int ks = 0; ks < 8; ++ks) {
            const int off = hq * 128 + 16 * ks + 8 * half;
            const bf16x8 k0 = row0 >= 0 ? *(const bf16x8*)(r0 + 2048 + off) : zf, k1 = row1 >= 0 ? *(const bf16x8*)(r1 + 2048 + off) : zf;
            const bf16x8 q0 = row0 >= 0 ? *(const bf16x8*)(r0 + off) : zf, q1 = row1 >= 0 ? *(const bf16x8*)(r1 + off) : zf;
            kk00 = MFMA32(k0, k0, kk00); kk10 = MFMA32(k1, k0, kk10); kk11 = MFMA32(k1, k1, kk11);
            qk00 = MFMA32(q0, k0, qk00); qk10 = MFMA32(q1, k0, qk10); qk11 = MFMA32(q1, k1, qk11);
            { bf16* kb = kt0 + (ks >> 1) * 2048 + (ks & 1) * 128;
#pragma unroll
              for (int e = 0; e < 8; ++e) { kb[(8 * (e >> 2) + (e & 3)) * 8] = (bf16)k0[e]; kb[1024 + (8 * (e >> 2) + (e & 3)) * 8] = (bf16)k1[e]; } }
        }
#pragma unroll 1
        for (int hh = 0; hh < 2; ++hh) { const int h = 2 * hq + hh; bf16* vt = VT + (((size_t)(b * 32 + h)) * NCH + c) * 128 * 64 + half * 512 + sm;
#pragma unroll 1
            for (int ks = 0; ks < 8; ++ks) { const int off = 4096 + h * 128 + 16 * ks + 8 * half;
                const bf16x8 v0 = row0 >= 0 ? *(const bf16x8*)(r0 + off) : zf, v1 = row1 >= 0 ? *(const bf16x8*)(r1 + off) : zf;
#pragma unroll
                for (int e = 0; e < 8; ++e) { vt[ks * 1024 + e * 64] = (bf16)v0[e]; vt[ks * 1024 + e * 64 + 32] = (bf16)v1[e]; } } }
        WAVE_SYNC();
#pragma unroll 1
        for (int hh = 0; hh < 2; ++hh) { const int h = 2 * hq + hh; const size_t uh = ((size_t)(b * 32 + h)) * NCH + c;
            float* af = AF + uh * 4096 + half * 256 + m;
            bf16* pg = PG + uh * 4096 + half * 32 + ((sm >> 4) & 1) * 512 + ((sm >> 3) & 1) * 256 + (sm & 7);
            const float gcj0 = lg[hh * 64 + m], gcj1 = lg[hh * 64 + 32 + m];
#pragma unroll
            for (int r = 0; r < 16; ++r) { const int ir = crow32(r, half), rc = (r & 3) + 8 * (r >> 2);
                const float gi0 = lg[hh * 64 + ir], gi1 = lg[hh * 64 + 32 + ir], bi0 = lg[128 + hh * 64 + ir], bi1 = lg[128 + hh * 64 + 32 + ir];
                { const int i = ir, j = m; const float dec = __expf(fminf(gi0 - gcj0, 0.f)); af[rc * 64] = (j < i) ? bi0 * dec * kk00[r] : 0.f; pg[rc * 8] = f2bf((j <= i) ? dec * qk00[r] : 0.f); }
                { const int i = 32 + ir, j = m; const float dec = __expf(fminf(gi1 - gcj0, 0.f)); af[2048 + rc * 64] = bi1 * dec * kk10[r]; pg[2048 + rc * 8] = f2bf(dec * qk10[r]); }
                { const int i = 32 + ir, j = 32 + m; const float dec = __expf(fminf(gi1 - gcj1, 0.f)); af[2048 + 32 + rc * 64] = (j < i) ? bi1 * dec * kk11[r] : 0.f; pg[2048 + 1024 + rc * 8] = f2bf((j <= i) ? dec * qk11[r] : 0.f); }
            } }
        WAVE_SYNC();
    }
}
__device__ __forceinline__ void delta_d2_unit(unsigned char* ws, int uh, int lane) {
    asm volatile("" : "+v"(lane));
    const float* AF = (const float*)(ws + WS_DAF); const float* GC = (const float*)(ws + WS_DGC); const float* BT = (const float*)(ws + WS_DBT);
    bf16* TG = (bf16*)(ws + WS_DTG); bf16* TB = (bf16*)(ws + WS_DTB);
    {
        const float* af = AF + (size_t)uh * 4096;
        const float bc = BT[(size_t)uh * 64 + lane], gmc = __expf(GC[(size_t)uh * 64 + lane]);
        float T[64];
#pragma unroll
        for (int i0 = 0; i0 < 64; i0 += 16) {
            float ar[16];
#pragma unroll
            for (int u = 0; u < 16; ++u) ar[u] = af[(i0 + u) * 64 + lane];
#pragma unroll
            for (int u = 0; u < 16; ++u) { const int i = i0 + u; float acc = (lane == i) ? 1.f : 0.f;
#pragma unroll
                for (int j = 0; j < i; ++j) acc -= __int_as_float(__builtin_amdgcn_readlane(__float_as_int(ar[u]), j)) * T[j];
                T[i] = acc; }
        }
        bf16* tg = TG + (size_t)uh * 4096; bf16* tb = TB + (size_t)uh * 4096;
        const float sg = bc * gmc;
        const int cs = (lane & ~31) + sw23(lane & 31);
#pragma unroll
        for (int i = 0; i < 64; ++i) { tg[i * 64 + cs] = f2bf(T[i] * sg); tb[i * 64 + cs] = f2bf(T[i] * bc); }
    }
}
__device__ __forceinline__ void delta_d3_unit(unsigned char* ws, int uh, int lane) {
    asm volatile("" : "+v"(lane));
    const bf16* TG = (const bf16*)(ws + WS_DTG); const bf16* TB = (const bf16*)(ws + WS_DTB); const bf16* KT = (const bf16*)(ws + WS_DKT); const bf16* VT = (const bf16*)(ws + WS_DVT);
    bf16* WG = (bf16*)(ws + WS_DWG); bf16* UG = (bf16*)(ws + WS_DUG);
    const int m = lane & 31, half = lane >> 5;
    const int c = uh % NCH, bh = uh / NCH, h = bh & 31, b = bh >> 5;
    const size_t uq = ((size_t)(b * 16 + (h >> 1))) * NCH + c;
    {
        const bf16* Tm = TG + (size_t)uh * 4096; const bf16* Kf = KT + uq * 8192;
        f32x16 acc[4][2];
#pragma unroll
        for (int dn = 0; dn < 4; ++dn)
#pragma unroll
            for (int ti = 0; ti < 2; ++ti)
#pragma unroll
                for (int i = 0; i < 16; ++i) acc[dn][ti][i] = 0.f;
#pragma unroll
        for (int ks = 0; ks < 4; ++ks) {
            bf16x8 a[4], bb[2];
#pragma unroll
            for (int dn = 0; dn < 4; ++dn) a[dn] = *(const bf16x8*)(Kf + ((size_t)(((dn * 2 + (ks >> 1)) * 2 + (ks & 1)) * 64 + lane)) * 8);
#pragma unroll
            for (int ti = 0; ti < 2; ++ti) bb[ti] = *(const bf16x8*)(Tm + (32 * ti + m) * 64 + 16 * ks + 8 * half);
#pragma unroll
            for (int dn = 0; dn < 4; ++dn)
#pragma unroll
                for (int ti = 0; ti < 2; ++ti) acc[dn][ti] = MFMA32(a[dn], bb[ti], acc[dn][ti]);
        }
        bf16* wg = WG + (size_t)uh * 8192;
#pragma unroll
        for (int dn = 0; dn < 4; ++dn)
#pragma unroll
            for (int ti = 0; ti < 2; ++ti)
#pragma unroll
                for (int s2 = 0; s2 < 2; ++s2) *(v4u*)(wg + ((size_t)(((ti * 4 + dn) * 2 + s2) * 64 + lane)) * 8) = pack_frag(acc[dn][ti], s2);
    }
    {
        const bf16* Tm = TB + (size_t)uh * 4096; const bf16* Bt = VT + (size_t)uh * 8192;
        f32x16 acc[2][4];
#pragma unroll
        for (int ti = 0; ti < 2; ++ti)
#pragma unroll
            for (int dn = 0; dn < 4; ++dn)
#pragma unroll
                for (int i = 0; i < 16; ++i) acc[ti][dn][i] = 0.f;
#pragma unroll
        for (int ks = 0; ks < 4; ++ks) {
            bf16x8 a[2], bb[4];
#pragma unroll
            for (int ti = 0; ti < 2; ++ti) a[ti] = *(const bf16x8*)(Tm + (32 * ti + m) * 64 + 16 * ks + 8 * half);
#pragma unroll
            for (int dn = 0; dn < 4; ++dn) bb[dn] = *(const bf16x8*)(Bt + (32 * dn + m) * 64 + 16 * ks + 8 * half);
#pragma unroll
            for (int ti = 0; ti < 2; ++ti)
#pragma unroll
                for (int dn = 0; dn < 4; ++dn) acc[ti][dn] = MFMA32(a[ti], bb[dn], acc[ti][dn]);
        }
        bf16* ug = UG + (size_t)uh * 8192;
#pragma unroll
        for (int ti = 0; ti < 2; ++ti)
#pragma unroll
            for (int dn = 0; dn < 4; ++dn) { bf16* p = ug + ((size_t)((ti * 4 + dn) * 64 + lane)) * 16; *(v4u*)p = pack_frag(acc[ti][dn], 0); *(v4u*)(p + 8) = pack_frag(acc[ti][dn], 1); }
    }
}
__device__ __forceinline__ void delta_pre(unsigned char* ws, LAS unsigned char* lds, int gw, int NGW, int wave, int lane) {
    for (int uq = gw; uq < NUQ; uq += NGW) {
#ifndef NO_D1
        delta_d1_unit(ws, lds, uq, wave, lane);
#endif
        asm volatile("s_waitcnt vmcnt(0)" ::: "memory");
        const int c = uq % NCH, bh = uq / NCH, hq = bh & 15, b = bh >> 4;
#pragma unroll 1
        for (int hh = 0; hh < 2; ++hh) { const int uh = (b * 32 + 2 * hq + hh) * NCH + c;
#ifndef NO_D2
            delta_d2_unit(ws, uh, lane);
#endif
            asm volatile("s_waitcnt vmcnt(0)" ::: "memory");
#ifndef NO_D3
            delta_d3_unit(ws, uh, lane);
#endif
        }
    }
}
__device__ __forceinline__ bf16x8 afrag_perm(const bf16* rowp, int blk, int s, int half) {
    const v2u lo = *(const v2u*)(rowp + 32 * blk + 16 * s + 4 * half), hi2 = *(const v2u*)(rowp + 32 * blk + 16 * s + 8 + 4 * half);
    v4u w; w.x = lo.x; w.y = lo.y; w.z = hi2.x; w.w = hi2.y; return __builtin_bit_cast(bf16x8, w);
}
#define LBAR() asm volatile("s_waitcnt lgkmcnt(0)\n\ts_barrier" ::: "memory")
__device__ __forceinline__ void delta_d4(unsigned char* ws, float* out_state, LAS unsigned char* lds, int tid, int wave, int lane) {
    const bf16* QKVC = (const bf16*)(ws + WS_QKVC); const bf16* KT = (const bf16*)(ws + WS_DKT); const bf16* PG = (const bf16*)(ws + WS_DPG);
    const bf16* WG = (const bf16*)(ws + WS_DWG); const bf16* UG = (const bf16*)(ws + WS_DUG); const float* GC = (const float*)(ws + WS_DGC);
    float* OF = (float*)(ws + WS_SC);
    LAS v4u* Sfr = (LAS v4u*)lds;
    LAS v4u* Dfr = (LAS v4u*)(lds + 16384);
    LAS v4u* Dtf = (LAS v4u*)(lds + 16384 + 4096);
    LAS float* gam = (LAS float*)(lds + 16384 + 8192);
    const int m = lane & 31, half = lane >> 5;
    const bf16x8 zf = {0, 0, 0, 0, 0, 0, 0, 0};
    for (int item = blockIdx.x; item < NBP * 32 * 4; item += gridDim.x) {
        const int q = item & 3, bh = item >> 2, h = bh & 31, b = bh >> 5;
        const size_t uh0 = ((size_t)(b * 32 + h)) * NCH, uq0 = ((size_t)(b * 16 + (h >> 1))) * NCH;
        const int rt = wave & 1; const bool isq = wave >= 6;
        f32x16 S;
#pragma unroll
        for (int i = 0; i < 16; ++i) S[i] = 0.f;
        bf16x8 afr[8], afn[8], xfr[4], xfn[4]; float gcn = 0.f;
#pragma unroll
        for (int i = 0; i < 8; ++i) { afr[i] = zf; afn[i] = zf; }
#pragma unroll
        for (int i = 0; i < 4; ++i) { xfr[i] = zf; xfn[i] = zf; }
#define LOAD_NEXT(cc) do { if (wave < 4) { const bf16* kr_ = KT + (uq0 + (cc)) * 8192; \
                _Pragma("unroll") for (int blk = 0; blk < 2; ++blk) _Pragma("unroll") for (int s_ = 0; s_ < 2; ++s_) afn[blk * 2 + s_] = *(const bf16x8*)(kr_ + ((size_t)(((wave * 2 + blk) * 2 + s_) * 64 + lane)) * 8); } \
            else { const int row_ = chunk_row(b, (cc), 32 * rt + m); const bool ok_ = !isq || row_ >= 0; \
                const bf16* ar_ = QKVC + (size_t)(row_ < 0 ? 0 : row_) * CDIM + (h >> 1) * 128; const bf16* wf_ = WG + (uh0 + (cc)) * 8192; \
                _Pragma("unroll") for (int blk = 0; blk < 4; ++blk) _Pragma("unroll") for (int s_ = 0; s_ < 2; ++s_) afn[blk * 2 + s_] = !ok_ ? zf : (isq ? *(const bf16x8*)(ar_ + 32 * blk + 16 * s_ + 8 * half) : *(const bf16x8*)(wf_ + ((size_t)(((rt * 4 + blk) * 2 + s_) * 64 + lane)) * 8)); \
                if (!isq) { const bf16* up_ = UG + (uh0 + (cc)) * 8192 + ((size_t)((rt * 4 + q) * 64 + lane)) * 16; xfn[0] = *(const bf16x8*)up_; xfn[1] = *(const bf16x8*)(up_ + 8); if (wave == 4) gcn = GC[(uh0 + (cc)) * 64 + lane]; } \
                else { const bf16* pr_ = PG + (uh0 + (cc)) * 4096; \
                    _Pragma("unroll") for (int blk = 0; blk < 2; ++blk) _Pragma("unroll") for (int s_ = 0; s_ < 2; ++s_) xfn[blk * 2 + s_] = (blk <= rt) ? *(const bf16x8*)(pr_ + ((size_t)(((rt * 2 + blk) * 2 + s_) * 64 + lane)) * 8) : zf; } } } while (0)
#define ROTATE() do { _Pragma("unroll") for (int i_ = 0; i_ < 8; ++i_) afr[i_] = afn[i_]; _Pragma("unroll") for (int i_ = 0; i_ < 4; ++i_) xfr[i_] = xfn[i_]; } while (0)
        LBAR();
        if (wave < 4) { const v4u z = {0u, 0u, 0u, 0u}; Sfr[(0 * 4 + wave) * 128 + lane] = z; Sfr[(0 * 4 + wave) * 128 + 64 + lane] = z; }
        if (wave == 4) { const float gc = GC[(uh0 + 0) * 64 + lane], gl = __shfl(gc, 63); gam[lane] = __expf(gc); gam[128 + lane] = __expf(gl - gc); }
        LOAD_NEXT(0); ROTATE();
        for (int c = 0; c < NCH; ++c) {
            const int bufc = c & 1;
            const size_t uh = uh0 + c, uq = uq0 + c;
            LBAR();
            f32x16 acc;
            if (c + 1 < NCH) LOAD_NEXT(c + 1);
            if (wave >= 4) {
#pragma unroll
                for (int i = 0; i < 16; ++i) acc[i] = 0.f;
#pragma unroll
                for (int blk = 0; blk < 4; ++blk)
#pragma unroll
                    for (int s = 0; s < 2; ++s) acc = MFMA32(afr[blk * 2 + s], __builtin_bit_cast(bf16x8, Sfr[(bufc * 4 + blk) * 128 + s * 64 + lane]), acc);
                if (!isq) {
                    float uf[16]; { float t8[8]; unpack8(__builtin_bit_cast(v4u, xfr[0]), t8);
#pragma unroll
                        for (int i = 0; i < 8; ++i) uf[i] = t8[i]; unpack8(__builtin_bit_cast(v4u, xfr[1]), t8);
#pragma unroll
                        for (int i = 0; i < 8; ++i) uf[8 + i] = t8[i]; }
                    f32x16 dt;
#pragma unroll
                    for (int r = 0; r < 16; ++r) { acc[r] = uf[r] - acc[r]; dt[r] = acc[r] * gam[128 + bufc * 64 + 32 * rt + crow32(r, half)]; }
#pragma unroll
                    for (int s = 0; s < 2; ++s) { Dfr[(rt * 2 + s) * 64 + lane] = pack_frag(acc, s); Dtf[(rt * 2 + s) * 64 + lane] = pack_frag(dt, s); }
                }
            }
            LBAR();
            if (wave < 4) {
                const float gl = gam[bufc * 64 + 63];
#pragma unroll
                for (int i = 0; i < 16; ++i) S[i] *= gl;
#pragma unroll
                for (int blk = 0; blk < 2; ++blk)
#pragma unroll
                    for (int s = 0; s < 2; ++s) S = MFMA32(afr[blk * 2 + s], __builtin_bit_cast(bf16x8, Dtf[(blk * 2 + s) * 64 + lane]), S);
#pragma unroll
                for (int s = 0; s < 2; ++s) Sfr[((bufc ^ 1) * 4 + wave) * 128 + s * 64 + lane] = pack_frag(S, s);
            } else if (isq) {
#pragma unroll
                for (int r = 0; r < 16; ++r) acc[r] *= gam[bufc * 64 + 32 * rt + crow32(r, half)];
#pragma unroll
                for (int blk = 0; blk < 2; ++blk)
#pragma unroll
                    for (int s = 0; s < 2; ++s) acc = MFMA32(xfr[blk * 2 + s], __builtin_bit_cast(bf16x8, Dfr[(blk * 2 + s) * 64 + lane]), acc);
#pragma unroll
                for (int r = 0; r < 16; ++r) { const int row = chunk_row(b, c, 32 * rt + crow32(r, half)); if (row >= 0) OF[(size_t)row * DVW + h * 128 + 32 * q + m] = acc[r]; }
            } else if (wave == 4 && c + 1 < NCH) {
                const float gl = __shfl(gcn, 63); gam[(bufc ^ 1) * 64 + lane] = __expf(gcn); gam[128 + (bufc ^ 1) * 64 + lane] = __expf(gl - gcn);
            }
            ROTATE();
        }
        if (wave < 4) { float* o = out_state + ((size_t)((b * 32 + h) * 128 + 32 * wave)) * 128 + 32 * q + m;
#pragma unroll
            for (int r = 0; r < 16; ++r) o[(size_t)sw23(crow32(r, half)) * 128] = S[r]; }
#undef LOAD_NEXT
#undef ROTATE
    }
    LBAR();
}
#undef LBAR
#undef MFMA32
template <int RT, int CT, class Epi>
__device__ __forceinline__ void small_gemm_unit(const bf16* A, int lda, const bf16* Bt, int ldb, int k0, int klen, LAS unsigned char* lds, const Epi& E, int tid, int wave, int lane) {
    const int r16 = lane & 15, q = lane >> 4;
    const int kw = klen >> 3;
    const bf16* ap = A + (size_t)r16 * lda + k0 + wave * kw + 8 * q;
    const bf16* bp = Bt + (size_t)r16 * ldb + k0 + wave * kw + 8 * q;
    pg8::f32x4 acc[RT][CT];
#pragma unroll
    for (int i = 0; i < RT; ++i)
#pragma unroll
        for (int j = 0; j < CT; ++j) acc[i][j] = (pg8::f32x4){0.f, 0.f, 0.f, 0.f};
#pragma unroll 2
    for (int ks = 0; ks < kw; ks += 32) {
        bf16x8 a[RT], b[CT];
#pragma unroll
        for (int i = 0; i < RT; ++i) a[i] = *(const bf16x8*)(ap + (size_t)(16 * i) * lda + ks);
#pragma unroll
        for (int j = 0; j < CT; ++j) b[j] = *(const bf16x8*)(bp + (size_t)(16 * j) * ldb + ks);
#pragma unroll
        for (int i = 0; i < RT; ++i)
#pragma unroll
            for (int j = 0; j < CT; ++j) acc[i][j] = __builtin_amdgcn_mfma_f32_16x16x32_bf16(a[i], b[j], acc[i][j], 0, 0, 0);
    }
    constexpr int NOUT = 256 * RT * CT;
    LAS float* part = (LAS float*)lds + wave * NOUT;
#pragma unroll
    for (int i = 0; i < RT; ++i)
#pragma unroll
        for (int j = 0; j < CT; ++j)
#pragma unroll
            for (int e = 0; e < 4; ++e) part[(16 * i + 4 * q + e) * (16 * CT) + 16 * j + r16] = acc[i][j][e];
    __syncthreads();
    for (int o = tid; o < NOUT; o += NTHREADS) { float sum = 0.f;
#pragma unroll
        for (int w = 0; w < 8; ++w) sum += ((LAS float*)lds)[w * NOUT + o];
        E(o / (16 * CT), o % (16 * CT), sum); }
    __syncthreads();
}
template <int ACT> struct SEpiRowsBf16 { bf16* O; int ldc; __device__ __forceinline__ void operator()(int row, int col, float v) const { if (ACT == 2) { v = v > 0.f ? v : 0.f; v = v * v; } O[(size_t)row * ldc + col] = f2bf(v); } };
struct SEpiF32 { float* O; int ldc; __device__ __forceinline__ void operator()(int row, int col, float v) const { O[(size_t)row * ldc + col] = v; } };
struct SEpiColsBf16 { bf16* O; int ldc; __device__ __forceinline__ void operator()(int row, int col, float v) const { O[(size_t)col * ldc + row] = f2bf(v); } };
template <int ACT> __device__ __forceinline__ void skinny_rows_bf16(const bf16* A, const bf16* Wt, int K, int nunits, bf16* O, int ldc, LAS unsigned char* lds, int tid, int wave, int lane) {
    for (int u = blockIdx.x; u < nunits; u += gridDim.x) { SEpiRowsBf16<ACT> E{O + (size_t)XROW0 * ldc + u * 64, ldc};
        small_gemm_unit<3, 4>(A + (size_t)XROW0 * K, K, Wt + (size_t)u * 64 * K, K, 0, K, lds, E, tid, wave, lane); }
}
__device__ __forceinline__ void skinny_rows_part(const bf16* A, const bf16* Wt, int K, float* ZP, LAS unsigned char* lds, int tid, int wave, int lane) {
    for (int u = blockIdx.x; u < 256; u += gridDim.x) { const int cgp = u & 31, ksl = u >> 5; SEpiF32 E{ZP + (size_t)ksl * XR * DM + cgp * 64, DM};
        small_gemm_unit<3, 4>(A + (size_t)XROW0 * K, K, Wt + (size_t)cgp * 64 * K, K, ksl * (K >> 3), K >> 3, lds, E, tid, wave, lane); }
}
template <int RT> __device__ __forceinline__ void tail_cols_bf16(const bf16* A, const bf16* Wt, int K, int c0, bf16* O, int ldc, LAS unsigned char* lds, int tid, int wave, int lane) {
    for (int u = blockIdx.x; u < MAINM / 32; u += gridDim.x) { SEpiColsBf16 E{O + (size_t)u * 32 * ldc + c0, ldc};
        small_gemm_unit<RT, 2>(Wt + (size_t)c0 * K, K, A + (size_t)u * 32 * K, K, 0, K, lds, E, tid, wave, lane); }
}

typedef __attribute__((address_space(4))) const unsigned long long* kargq_t;
#define KPF_(k) ((const float*)(const GAS float*)(q_[k]))
__device__ __forceinline__ void load_ptrs(Ptrs& P) {
    kargq_t q_ = (kargq_t)__builtin_amdgcn_kernarg_segment_ptr();
    asm volatile("" : "+s"(q_));
    P.x_prompt = KPF_(0); P.x_sample = KPF_(1); P.state_conv_a = KPF_(2); P.cache_k = KPF_(3);
    P.cache_v = KPF_(4); P.cache_ik = KPF_(5); P.state_conv_c = KPF_(6); P.state_delta = KPF_(7);
    P.page_table = ((const int*)(const GAS int*)(q_[8])); P.meta = KPF_(9); P.w_in_a = KPF_(10); P.conv_w_a = KPF_(11);
    P.w_out_a = KPF_(12); P.w_in_b = KPF_(13); P.w_out_b = KPF_(14); P.w_in_c = KPF_(15);
    P.conv_w_c = KPF_(16); P.a_log = KPF_(17); P.dt_bias = KPF_(18); P.norm_w = KPF_(19);
    P.w_out_c = KPF_(20); P.ln1_g = KPF_(21); P.ln1_b = KPF_(22); P.w1 = KPF_(23);
    P.w2 = KPF_(24); P.ln2_g = KPF_(25); P.ln2_b = KPF_(26);
    P.out = (float*)(GAS float*)(q_[27]); P.ws = (unsigned char*)(GAS unsigned char*)(q_[28]);
}
struct Args { const void* in[27]; float* out; unsigned char* ws; int ph_lo, ph_hi; };
constexpr int PH_PER_LAYER = 12, PH_END = 1 + 4 * PH_PER_LAYER;

__global__ void __launch_bounds__(NTHREADS, 2) mega_fwd(Args args) {
    extern __shared__ __attribute__((aligned(16))) unsigned char lds_raw[];
    LAS unsigned char* lds = (LAS unsigned char*)lds_raw;
    const int tid = threadIdx.x, lane = tid & 63, wave = __builtin_amdgcn_readfirstlane(tid >> 6);
    const int G_ = gridDim.x, NGW = G_ * NWAVES, NT = G_ * NTHREADS; (void)lane;
    unsigned char* ws = args.ws;
    const int lo = args.ph_lo, hi = args.ph_hi;
    const bool fused = (hi - lo) > 1;

    for (int u = tid; u < (LDS_BYTES - LDSCTL_OFF) / 4; u += NTHREADS) ((LAS unsigned*)(lds + LDSCTL_OFF))[u] = 0u;
    __syncthreads();
    volatile LAS unsigned* MISC = (volatile LAS unsigned*)(lds + MISC_OFF);
    XcdBarrier bar; bar.bar = (unsigned*)(ws + WS_CTL) + CW_BAR; bar.x = 0; bar.st = nullptr;
    if (fused) bar = xcd_barrier_post((unsigned*)(ws + WS_CTL) + CW_BAR, MISC + 8);
    bar.wv = wave;

#ifndef MK_SITES
#define MK_SITES 0xffffffffu
#endif
#define SITE(n) (((MK_SITES) >> (n)) & 1u)
#define IN(k) (lo <= (k) && (k) < hi)
#ifndef MK_DUP
#define MK_DUP 0u
#endif
#define NREP(n) ((((MK_DUP) >> (n)) & 1u) ? 2 : 1)
#define BEGIN_SITE(n, id) if (SITE(n) && IN(id)) { for (int rp_ = 0; rp_ < NREP(n); ++rp_) { Ptrs P; load_ptrs(P); unsigned char* ws = P.ws; (void)ws; \
    bf16* X = (bf16*)(P.ws + WS_X); float* Z = (float*)(P.ws + WS_Z); float* ZP = (float*)(P.ws + WS_ZP); bf16* Y = (bf16*)(P.ws + WS_Y); bf16* BIG = (bf16*)(P.ws + WS_BIG); (void)X; (void)Z; (void)ZP; (void)Y; (void)BIG;
#define END_SITE(id) SEAM(id); } }
#define LOCALS int tid_ = threadIdx.x; asm volatile("" : "+v"(tid_)); const int lane_ = tid_ & 63, wave_ = __builtin_amdgcn_readfirstlane(tid_ >> 6), gw_ = blockIdx.x * NWAVES + wave_, gtid_ = blockIdx.x * NTHREADS + tid_; (void)lane_; (void)wave_; (void)gw_; (void)gtid_
#define SEAM(k) do { if (fused && (k) + 1 < PH_END) xcd_barrier(bar); else __syncthreads(); } while (0)


    BEGIN_SITE(0, 0) LOCALS; p0_prologue(P, lds, gw_, NGW, wave_, lane_); END_SITE(0)

    for (int layer = 0; layer < 4; ++layer) {
        const int kind = layer % 3, j = layer / 3, base = 1 + layer * PH_PER_LAYER;
        if (kind == 0) {
            BEGIN_SITE(1, base + 0)
                const bf16* Wt = (const bf16*)(ws + WS_WA_IN + (size_t)j * WSZ_A_IN); pg8::Gemm g{X, Wt, MAINM, NA_IN, DM}; pg8::StaticOrder S; S.init(MAINM, NA_IN, G_, (int)blockIdx.x);
                pg8::EpiBf16<0> E{BIG, NA_IN, nullptr, 0, 0, 1.f};
                pg8::gemm_phase<pg8::EpiBf16<0>, pg8::StaticOrder, true, true>(lds, g, S, E, wave);
                { LOCALS; skinny_rows_bf16<0>(X, Wt, DM, NA_IN / 64, BIG, NA_IN, lds, tid_, wave_, lane_); }
                END_SITE(base + 0)
            BEGIN_SITE(2, base + 1)
                LOCALS; convA_phase(BIG, Y, P.conv_w_a + (size_t)j * 3 * DM, P.state_conv_a + (size_t)j * SBN * 2 * DM, P.out + O_CAP + (size_t)j * NBP * 2 * DM, P.out + O_CAS + (size_t)j * SBN * 2 * DM, gtid_, NT);
                END_SITE(base + 1)
            BEGIN_SITE(3, base + 2)
                const bf16* Wt = (const bf16*)(ws + WS_WA_OUT + (size_t)j * WSZ_A_OUT); pg8::Gemm g{Y, Wt, MAINM, DM, DM}; pg8::StaticOrder S; S.init(MAINM, DM, G_, (int)blockIdx.x);
                pg8::EpiF32 E{Z, DM};
                pg8::gemm_phase<pg8::EpiF32, pg8::StaticOrder, true, true>(lds, g, S, E, wave);
                { LOCALS; skinny_rows_part(Y, Wt, DM, ZP, lds, tid_, wave_, lane_); }
                END_SITE(base + 2)
        } else if (kind == 1) {
            BEGIN_SITE(4, base + 0)
                const bf16* Wt = (const bf16*)(ws + WS_WB_IN); pg8::Gemm g{X, Wt, MAINM, 4096, DM}; pg8::StaticOrder S; S.init(MAINM, 4096, G_, (int)blockIdx.x);
                pg8::EpiBf16<0> E{BIG, NB_PAD, nullptr, 0, 0, 1.f};
                pg8::gemm_phase<pg8::EpiBf16<0>, pg8::StaticOrder, true, true>(lds, g, S, E, wave);
                { LOCALS; tail_cols_bf16<5>(X, Wt, DM, 4096, BIG, NB_PAD, lds, tid_, wave_, lane_); skinny_rows_bf16<0>(X, Wt, DM, 4224 / 64, BIG, NB_PAD, lds, tid_, wave_, lane_); }
                END_SITE(base + 0)
            BEGIN_SITE(5, base + 1) LOCALS; rope_phase(BIG, P, gw_, NGW, lane_); END_SITE(base + 1)
            BEGIN_SITE(6, base + 2) LOCALS; indexer_sample(P, lds, tid_); indexer_prompt(P, gw_, NGW, lane_); END_SITE(base + 2)
            BEGIN_SITE(7, base + 3) LOCALS; select_phase(P, lds, gw_, NGW, tid_, wave_, lane_); END_SITE(base + 3)
            BEGIN_SITE(8, base + 4) LOCALS; dense_attn_phase(P, Y, (char*)lds_raw, wave_); attn_phase(P, Y, lds, gw_, NGW, wave_, lane_); END_SITE(base + 4)
            BEGIN_SITE(9, base + 5)
                const bf16* Wt = (const bf16*)(ws + WS_WB_OUT); pg8::Gemm g{Y, Wt, MAINM, DM, DM}; pg8::StaticOrder S; S.init(MAINM, DM, G_, (int)blockIdx.x);
                pg8::EpiF32 E{Z, DM};
                pg8::gemm_phase<pg8::EpiF32, pg8::StaticOrder, true, true>(lds, g, S, E, wave);
                { LOCALS; skinny_rows_part(Y, Wt, DM, ZP, lds, tid_, wave_, lane_); }
                END_SITE(base + 5)
        } else {
            BEGIN_SITE(10, base + 0)
                const bf16* Wt = (const bf16*)(ws + WS_WC_IN); pg8::Gemm g{X, Wt, MAINM, 12288, DM}; pg8::StaticOrder S; S.init(MAINM, 12288, G_, (int)blockIdx.x);
                pg8::EpiBf16<0> E{BIG, NC_PAD, nullptr, 0, 0, 1.f};
                pg8::gemm_phase<pg8::EpiBf16<0>, pg8::StaticOrder, true, true>(lds, g, S, E, wave);
                { LOCALS; tail_cols_bf16<4>(X, Wt, DM, 12288, BIG, NC_PAD, lds, tid_, wave_, lane_); skinny_rows_bf16<0>(X, Wt, DM, NC_IN / 64, BIG, NC_PAD, lds, tid_, wave_, lane_); }
                END_SITE(base + 0)
            BEGIN_SITE(11, base + 1) LOCALS; convC_phase(BIG, P, gw_, NGW, lane_); END_SITE(base + 1)
            BEGIN_SITE(19, base + 2) LOCALS; delta_pre(P.ws, lds, gw_, NGW, wave_, lane_); delta_phase(P, wave_, lane_); END_SITE(base + 2)
            BEGIN_SITE(22, base + 5) LOCALS; delta_d4(P.ws, P.out + O_DP, lds, tid_, wave_, lane_); END_SITE(base + 5)
            BEGIN_SITE(13, base + 6) LOCALS; normC_phase(BIG, Y, P, gw_, NGW, lane_); END_SITE(base + 6)
            BEGIN_SITE(14, base + 7)
                const bf16* Wt = (const bf16*)(ws + WS_WC_OUT); pg8::Gemm g{Y, Wt, MAINM, DM, DVW}; pg8::StaticOrder S; S.init(MAINM, DM, G_, (int)blockIdx.x);
                pg8::EpiF32 E{Z, DM};
                pg8::gemm_phase<pg8::EpiF32, pg8::StaticOrder, true, true>(lds, g, S, E, wave);
                { LOCALS; skinny_rows_part(Y, Wt, DVW, ZP, lds, tid_, wave_, lane_); }
                END_SITE(base + 7)
        }
        BEGIN_SITE(15, base + 8) LOCALS; ln_phase(Z, ZP, X, rp_ == 0 ? X : (bf16*)(P.ws + WS_QR), P.ln1_g + (size_t)layer * DM, P.ln1_b + (size_t)layer * DM, nullptr, nullptr, gw_, NGW, lane_); END_SITE(base + 8)
        BEGIN_SITE(16, base + 9)
            const bf16* Wt = (const bf16*)(ws + WS_W1 + (size_t)layer * WSZ_W1); pg8::Gemm g{X, Wt, MAINM, FF, DM}; pg8::StaticOrder S; S.init(MAINM, FF, G_, (int)blockIdx.x);
            pg8::EpiBf16<2> E{BIG, FF, nullptr, 0, 0, 1.f};
            pg8::gemm_phase<pg8::EpiBf16<2>, pg8::StaticOrder, true, true>(lds, g, S, E, wave);
            { LOCALS; skinny_rows_bf16<2>(X, Wt, DM, FF / 64, BIG, FF, lds, tid_, wave_, lane_); }
            END_SITE(base + 9)
        BEGIN_SITE(17, base + 10)
            const bf16* Wt = (const bf16*)(ws + WS_W2 + (size_t)layer * WSZ_W2); pg8::Gemm g{BIG, Wt, MAINM, DM, FF}; pg8::StaticOrder S; S.init(MAINM, DM, G_, (int)blockIdx.x);
            pg8::EpiF32 E{Z, DM};
            pg8::gemm_phase<pg8::EpiF32, pg8::StaticOrder, true, true>(lds, g, S, E, wave);
            { LOCALS; skinny_rows_part(BIG, Wt, FF, ZP, lds, tid_, wave_, lane_); }
            END_SITE(base + 10)
        BEGIN_SITE(18, base + 11)
            const bool last = layer == 3;
            LOCALS; ln_phase(Z, ZP, X, rp_ == 0 ? X : (bf16*)(P.ws + WS_QR), P.ln2_g + (size_t)layer * DM, P.ln2_b + (size_t)layer * DM, last ? P.out + O_YP : nullptr, last ? P.out + O_YS : nullptr, gw_, NGW, lane_);
            if (!last) SEAM(base + 11); } }
    }
#undef IN
#undef SEAM
}

#ifndef MK_SPLIT
#define MK_SPLIT 0
#endif
extern "C" void kernel_launch(void* const* d_in, const int* in_sizes, int n_in, void* d_out, int out_size, void* d_ws, size_t ws_size, hipStream_t stream) {
    static int grid = 0;
    if (grid == 0) {
        if (n_in != 27 || (size_t)out_size != O_END || ws_size < WS_END) { fprintf(stderr, "kernel_launch: unexpected shapes: n_in %d out %d (want %zu) ws %zu (want >= %zu)\n", n_in, out_size, (size_t)O_END, ws_size, (size_t)WS_END); grid = -1; return; }
        int dev = 0, cus = 0;
        if (hipGetDevice(&dev) != hipSuccess || hipDeviceGetAttribute(&cus, hipDeviceAttributeMultiprocessorCount, dev) != hipSuccess) { grid = -1; return; }
        if (hipFuncSetAttribute((const void*)mega_fwd, hipFuncAttributeMaxDynamicSharedMemorySize, LDS_BYTES) != hipSuccess) { fprintf(stderr, "kernel_launch: hipFuncSetAttribute failed\n"); grid = -1; return; }
        int per_cu = 0;
        if (hipOccupancyMaxActiveBlocksPerMultiprocessor(&per_cu, (const void*)mega_fwd, NTHREADS, LDS_BYTES) != hipSuccess || per_cu < 1) fprintf(stderr, "kernel_launch: occupancy query reports %d\n", per_cu);
        (void)hipGetLastError();
        grid = cus;
    }
    if (grid < 0) return;
    (void)hipMemsetAsync((char*)d_ws + WS_CTL, 0, CTL_ZERO_BYTES, stream);
    Args a{};
    for (int i = 0; i < 27; ++i) a.in[i] = d_in[i];
    a.out = (float*)d_out; a.ws = (unsigned char*)d_ws;
#if MK_SPLIT
    for (int ph = 0; ph < PH_END; ++ph) {
        bool exists = (ph == 0);
        if (ph > 0) { const int layer = (ph - 1) / PH_PER_LAYER, l = (ph - 1) % PH_PER_LAYER, kind = layer % 3; const int nmix = kind == 0 ? 3 : (kind == 1 ? 6 : 8); exists = (l < nmix) || (l >= 8 && l <= 11); }
        if (!exists) continue;
        a.ph_lo = ph; a.ph_hi = ph + 1;
        hipLaunchKernelGGL(mega_fwd, dim3(grid), dim3(NTHREADS), LDS_BYTES, stream, a);
    }
#else
    a.ph_lo = 0; a.ph_hi = PH_END;
    hipLaunchKernelGGL(mega_fwd, dim3(grid), dim3(NTHREADS), LDS_BYTES, stream, a);
#endif
    const hipError_t le = hipPeekAtLastError();
    if (le != hipSuccess) fprintf(stderr, "kernel_launch: launch failed: %s\n", hipGetErrorName(le));
}
```

```cpp
#include <hip/hip_runtime.h>
#include <cstdio>
#include <cstdint>
#include <cmath>
__device__ __forceinline__ int flane() { return (int)__builtin_amdgcn_mbcnt_hi(~0u, __builtin_amdgcn_mbcnt_lo(~0u, 0u)); }
namespace pg8 {
#define PG8_LAS __attribute__((address_space(3)))
typedef unsigned short bf16_t;
typedef short bf16x8 __attribute__((ext_vector_type(8)));
typedef float f32x4 __attribute__((ext_vector_type(4)));
typedef unsigned u32x4 __attribute__((ext_vector_type(4)));
constexpr int BM = 256, BK = 64, HALF = 128, HTB = HALF * BK * 2  , STAGE_BYTES = 8 * HTB, NXCD = 8, WGM = 8;

__host__ __device__ __forceinline__ int lds_byte(int r, int c) { const int st = (r >> 4) * 2 + (c >> 5), rr = r & 15, cc = c & 31, ob = rr * 64 + cc * 2; return st * 1024 + (ob ^ (((ob >> 9) & 1) << 5)); }
__host__ __device__ __forceinline__ void stage_rc(int b, int& R, int& C) { const int st = b / 1024, sb = b % 1024, swz = sb ^ (((sb >> 9) & 1) << 5); R = (st >> 1) * 16 + swz / 64; C = (st & 1) * 32 + (swz % 64) / 2; }
__host__ __device__ __forceinline__ int perm32(int rho) { const int n = rho >> 4, i = rho & 15; return 8 * (i >> 2) + 4 * n + (i & 3); }

struct Unit { int pm, pn; };
struct Gemm { const bf16_t* A; const bf16_t* Bt; int M, N, K; };

struct StaticOrder {
    int nM, nN, nwg, G, c;
    __host__ __device__ void init(int M, int N, int G_, int c_) { nM = M / BM; nN = N / BM; nwg = nM * nN; G = G_; c = c_; }
    __host__ __device__ bool next(int i, Unit& u) const {
        const long L = (long)i * G + c; if (L >= nwg) return false;
        int wgid = (int)L; { const int q = nwg / NXCD, r = nwg % NXCD, xcd = wgid % NXCD, off = wgid / NXCD; wgid = (xcd < r ? xcd * (q + 1) : r * (q + 1) + (xcd - r) * q) + off; }
        const int nig = WGM * nN, gid = wgid / nig, fm = gid * WGM, gsz = (nM - fm) < WGM ? (nM - fm) : WGM;
        u.pm = fm + ((wgid % nig) % gsz); u.pn = (wgid % nig) / gsz; return true;
    }
    __device__ __forceinline__ void a_ready(const Unit&) const {}
    __device__ __forceinline__ void done(const Unit&) const {}
};

__device__ __forceinline__ unsigned cvt_pk_bf16(float lo, float hi) { unsigned r; asm volatile("v_cvt_pk_bf16_f32 %0, %1, %2" : "=v"(r) : "v"(lo), "v"(hi)); return r; }
typedef float f32x2 __attribute__((ext_vector_type(2)));
__device__ __forceinline__ f32x2 gelu_pk(f32x2 v) {
    const f32x2 av = __builtin_elementwise_abs(v), d = av * 0.2316418882f + 1.0f;
    f32x2 t; t.x = __builtin_amdgcn_rcpf(d.x); t.y = __builtin_amdgcn_rcpf(d.y);
    f32x2 q = t * 0.5307027145f + (-0.7265760135f); q = q * t + 0.7107068705f; q = q * t + (-0.142248368f); q = q * t + 0.127414796f; q = q * t;
    const f32x2 s = (v * v) * (-0.72134752044f);
    f32x2 e; e.x = __builtin_amdgcn_exp2f(s.x); e.y = __builtin_amdgcn_exp2f(s.y);
    const f32x2 m = v * (q * e), r = v - m;
    f32x2 o; o.x = v.x < 0.f ? m.x : r.x; o.y = v.y < 0.f ? m.y : r.y; return o;
}

template <int ACT  > struct EpiBf16 {
    static constexpr bool PERM = true, AFTER_DRAIN = false; static_assert(ACT == 0 || ACT == 1 || ACT == 2, "EpiBf16: ACT is 0 (none), 1 (gelu_pk) or 2 (relu^2)");
    bf16_t* O; int ldc; const float* bias; int split_cols; size_t split_stride; float scale0;
    __device__ __forceinline__ void operator()(const f32x4 (&acc)[2][2][4][2], const Unit& u, int wr, int wc, int fr, int fq) const {
        const int row0 = u.pm * BM + wr * 64 + fr; int colt = u.pn * BM; bf16_t* base = O;
        float sc = 1.f; if (split_cols) { const int t = colt / split_cols; base += (size_t)t * split_stride; colt -= t * split_cols; if (t == 0) sc = scale0; }
        const int col0 = colt + wc * 32 + 8 * fq, bcol0 = u.pn * BM + wc * 32 + 8 * fq;
        f32x4 bv[2][2];
#pragma unroll
        for (int bj = 0; bj < 2; ++bj)
#pragma unroll
            for (int n = 0; n < 2; ++n) bv[bj][n] = bias ? *(const f32x4*)(bias + bcol0 + bj * HALF + 4 * n) : (f32x4){0.f, 0.f, 0.f, 0.f};
#pragma unroll
        for (int ai = 0; ai < 2; ++ai)
#pragma unroll
            for (int m = 0; m < 4; ++m) { bf16_t* rowp = base + (size_t)(row0 + ai * HALF + m * 16) * ldc + col0;
#pragma unroll
                for (int bj = 0; bj < 2; ++bj) { f32x4 v0 = acc[ai][bj][m][0] + bv[bj][0], v1 = acc[ai][bj][m][1] + bv[bj][1];
                    if (ACT == 1) { f32x2 a = gelu_pk((f32x2){v0[0], v0[1]}), b = gelu_pk((f32x2){v0[2], v0[3]}), c = gelu_pk((f32x2){v1[0], v1[1]}), d = gelu_pk((f32x2){v1[2], v1[3]});
                        v0 = (f32x4){a.x, a.y, b.x, b.y}; v1 = (f32x4){c.x, c.y, d.x, d.y}; }
                    if (ACT == 2) { _Pragma("unroll") for (int q_ = 0; q_ < 4; ++q_) { const float a_ = v0[q_] > 0.f ? v0[q_] : 0.f, b_ = v1[q_] > 0.f ? v1[q_] : 0.f; v0[q_] = a_ * a_; v1[q_] = b_ * b_; } }
                    v0 = v0 * sc; v1 = v1 * sc; u32x4 w; w.x = cvt_pk_bf16(v0[0], v0[1]); w.y = cvt_pk_bf16(v0[2], v0[3]); w.z = cvt_pk_bf16(v1[0], v1[1]); w.w = cvt_pk_bf16(v1[2], v1[3]);
                    *(u32x4*)(rowp + bj * HALF) = w; } }
    }
};


struct EpiF32 {
    static constexpr bool PERM = false, AFTER_DRAIN = false;
    float* C; int ldc;
    __device__ __forceinline__ void operator()(const f32x4 (&acc)[2][2][4][2], const Unit& u, int wr, int wc, int fr, int fq) const {
        const int row0 = u.pm * BM + wr * 64 + fr, col0 = u.pn * BM + wc * 32 + 4 * fq;
#pragma unroll
        for (int ai = 0; ai < 2; ++ai)
#pragma unroll
            for (int m = 0; m < 4; ++m) { float* rowp = C + (size_t)(row0 + ai * HALF + m * 16) * ldc + col0;
#pragma unroll
                for (int bj = 0; bj < 2; ++bj)
#pragma unroll
                    for (int n = 0; n < 2; ++n) *(f32x4*)(rowp + bj * HALF + n * 16) = acc[ai][bj][m][n]; }
    }
};
struct PanelStats {
    unsigned* xbuf;
    unsigned* cnt;
    unsigned* tmo;
    int ntn; float eps;
    unsigned code;
    __device__ __forceinline__ bool run(const f32x4 (&v)[2][2][4][2], const Unit& u, int wr, int wc, int fr, int fq, PG8_LAS unsigned char* lds, int wid, int lane) const {
        typedef float f32x2v __attribute__((ext_vector_type(2)));
        PG8_LAS f32x2v* P = (PG8_LAS f32x2v*)lds;
        PG8_LAS f32x2v* S = (PG8_LAS f32x2v*)(lds + 8192);
        PG8_LAS unsigned* flag = (PG8_LAS unsigned*)(lds + 8192 + 2048);
#pragma unroll
        for (int ai = 0; ai < 2; ++ai)
#pragma unroll
            for (int m = 0; m < 4; ++m) {
                float s = 0.f;
#pragma unroll
                for (int bj = 0; bj < 2; ++bj)
#pragma unroll
                    for (int n = 0; n < 2; ++n) { const f32x4 x = v[ai][bj][m][n]; s += (x[0] + x[1]) + (x[2] + x[3]); }
                s += __shfl_xor(s, 16); s += __shfl_xor(s, 32);
                const float mw = s * (1.0f / 64.0f); float q = 0.f;
#pragma unroll
                for (int bj = 0; bj < 2; ++bj)
#pragma unroll
                    for (int n = 0; n < 2; ++n) { const f32x4 d = v[ai][bj][m][n] - mw; q += (d[0] * d[0] + d[1] * d[1]) + (d[2] * d[2] + d[3] * d[3]); }
                q += __shfl_xor(q, 16); q += __shfl_xor(q, 32);
                if (fq == 0) P[(ai * HALF + wr * 64 + m * 16 + fr) * 4 + wc] = (f32x2v){mw, q};
            }
        asm volatile("s_waitcnt lgkmcnt(0)" ::: "memory"); __builtin_amdgcn_s_barrier(); asm volatile("" ::: "memory");
#if defined(BROKEN_EXCHANGE_NO_WAIT)
#warning BROKEN CONTROL BUILD: the row-statistics exchange does not wait; results are wrong by design
        if (blockIdx.x >= 64) { const long long t0_ = clock64(); while (clock64() - t0_ < 60000) __builtin_amdgcn_s_sleep(8); }
#endif
        const int row = wid * 32 + (lane & 31);
        if (lane < 32) {
            const f32x2v a = P[row * 4 + 0], b = P[row * 4 + 1], c = P[row * 4 + 2], d = P[row * 4 + 3];
            const float mt = (a.x + b.x + c.x + d.x) * 0.25f;
            const float da = a.x - mt, db = b.x - mt, dc = c.x - mt, dd = d.x - mt;
            const float m2 = (a.y + b.y) + (c.y + d.y) + 64.0f * ((da * da + db * db) + (dc * dc + dd * dd));
            unsigned long long* slot = (unsigned long long*)xbuf + ((size_t)(u.pm * BM + row) * 4 + u.pn);
            __hip_atomic_store(slot, ((unsigned long long)__float_as_uint(m2) << 32) | __float_as_uint(mt), __ATOMIC_RELAXED, __HIP_MEMORY_SCOPE_AGENT);
        }
        asm volatile("s_waitcnt vmcnt(0)" ::: "memory");
        if (lane == 0) __hip_atomic_fetch_add(cnt + 64 * u.pm, 1u, __ATOMIC_RELAXED, __HIP_MEMORY_SCOPE_AGENT);
        if (wid == 0) {
            bool dead = false; const unsigned long long t0 = __builtin_amdgcn_s_memrealtime(); const unsigned want = 8u * (unsigned)ntn;
            for (;;) {
#if defined(BROKEN_EXCHANGE_NO_WAIT)
                break;
#endif
                if ((unsigned)__builtin_amdgcn_readfirstlane(__hip_atomic_load(cnt + 64 * u.pm, __ATOMIC_RELAXED, __HIP_MEMORY_SCOPE_AGENT)) >= want) break;
                if (__builtin_amdgcn_s_memrealtime() - t0 > 2000000ull) {
                    if (lane == 0) { unsigned expect = 0u; __hip_atomic_compare_exchange_strong(tmo + 1, &expect, code | (unsigned)(u.pm & 0xff), __ATOMIC_RELAXED, __ATOMIC_RELAXED, __HIP_MEMORY_SCOPE_AGENT);
                                     __hip_atomic_store(tmo, 1u, __ATOMIC_RELAXED, __HIP_MEMORY_SCOPE_AGENT); }
                    dead = true; break; }
                __builtin_amdgcn_s_sleep(2);
            }
            __builtin_amdgcn_fence(__ATOMIC_ACQUIRE, "agent");
            if (lane == 0) flag[0] = dead ? 1u : 0u;
        }
        asm volatile("s_waitcnt vmcnt(0) lgkmcnt(0)" ::: "memory"); __builtin_amdgcn_s_barrier(); asm volatile("" ::: "memory");
        const bool bad = flag[0] != 0u;
        if (lane < 32) {
            const unsigned long long* slot = (const unsigned long long*)xbuf + (size_t)(u.pm * BM + row) * 4; float mt[4], m2[4]; float ms = 0.f;
#pragma unroll
            for (int t = 0; t < 4; ++t) { if (t < ntn) { const unsigned long long w = __hip_atomic_load(slot + t, __ATOMIC_RELAXED, __HIP_MEMORY_SCOPE_AGENT); mt[t] = __uint_as_float((unsigned)w); m2[t] = __uint_as_float((unsigned)(w >> 32)); } else { mt[t] = 0.f; m2[t] = 0.f; } ms += mt[t]; }
            const float mean = ms / (float)ntn; float q = 0.f;
#pragma unroll
            for (int t = 0; t < 4; ++t) if (t < ntn) { const float dm = mt[t] - mean; q += m2[t] + 256.0f * dm * dm; }
            S[row] = (f32x2v){mean, 1.0f / sqrtf(q / (256.0f * (float)ntn) + eps)};
        }
        asm volatile("s_waitcnt lgkmcnt(0)" ::: "memory"); __builtin_amdgcn_s_barrier(); asm volatile("" ::: "memory");
        return bad;
    }
};
struct EpiLnRes {
    static constexpr bool PERM = false, AFTER_DRAIN = true;
    const float* base; float* out; int ldc; const float* bias; PanelStats st; unsigned poison;
    __device__ __forceinline__ void fused(f32x4 (&acc)[2][2][4][2], const Unit& u, int wr, int wc, int fr, int fq, PG8_LAS unsigned char* lds, int wid, int lane) const {
        typedef float f32x2v __attribute__((ext_vector_type(2)));
        const PG8_LAS f32x2v* S = (const PG8_LAS f32x2v*)(lds + 8192);
        const int col0 = u.pn * BM + wc * 32 + 4 * fq;
#pragma unroll
        for (int bj = 0; bj < 2; ++bj)
#pragma unroll
            for (int n = 0; n < 2; ++n) { const f32x4 bv = bias ? *(const f32x4*)(bias + col0 + bj * HALF + n * 16) : (f32x4){0.f, 0.f, 0.f, 0.f};
#pragma unroll
                for (int ai = 0; ai < 2; ++ai)
#pragma unroll
                    for (int m = 0; m < 4; ++m) acc[ai][bj][m][n] += bv; }
        f32x4 pre[4][2][2];
#pragma unroll
        for (int m = 0; m < 4; ++m) { const size_t off = (size_t)(u.pm * BM + wr * 64 + m * 16 + fr) * ldc + col0;
#pragma unroll
            for (int bj = 0; bj < 2; ++bj)
#pragma unroll
                for (int n = 0; n < 2; ++n) pre[m][bj][n] = *(const f32x4*)(base + off + bj * HALF + n * 16); }
        const bool bad = st.run(acc, u, wr, wc, fr, fq, lds, wid, lane) || poison != 0u;
        const float qnan = __builtin_nanf("");
#pragma unroll
        for (int ai = 0; ai < 2; ++ai)
#pragma unroll
            for (int m = 0; m < 4; ++m) { const int r = ai * HALF + wr * 64 + m * 16 + fr; const f32x2v sr = S[r]; const size_t off = (size_t)(u.pm * BM + r) * ldc + col0;
#pragma unroll
                for (int bj = 0; bj < 2; ++bj)
#pragma unroll
                    for (int n = 0; n < 2; ++n) { const f32x4 bs = ai == 0 ? pre[m][bj][n] : *(const f32x4*)(base + off + bj * HALF + n * 16); f32x4 o = bs + (acc[ai][bj][m][n] - sr.x) * sr.y;
                        if (bad) o = (f32x4){qnan, qnan, qnan, qnan}; *(f32x4*)(out + off + bj * HALF + n * 16) = o; }
                if (m & 1) asm volatile("" ::: "memory"); }
    }
};
struct EpiLnResLn {
    static constexpr bool PERM = false, AFTER_DRAIN = true;
    const float* base; float* out; bf16_t* xn; int ldc; const float* bias; PanelStats st1, st2; unsigned poison;
    __device__ __forceinline__ void fused(f32x4 (&acc)[2][2][4][2], const Unit& u, int wr, int wc, int fr, int fq, PG8_LAS unsigned char* lds, int wid, int lane) const {
        typedef float f32x2v __attribute__((ext_vector_type(2))); typedef unsigned u32x2v __attribute__((ext_vector_type(2)));
        const PG8_LAS f32x2v* S = (const PG8_LAS f32x2v*)(lds + 8192);
        const int col0 = u.pn * BM + wc * 32 + 4 * fq;
#pragma unroll
        for (int bj = 0; bj < 2; ++bj)
#pragma unroll
            for (int n = 0; n < 2; ++n) { const f32x4 bv = bias ? *(const f32x4*)(bias + col0 + bj * HALF + n * 16) : (f32x4){0.f, 0.f, 0.f, 0.f};
#pragma unroll
                for (int ai = 0; ai < 2; ++ai)
#pragma unroll
                    for (int m = 0; m < 4; ++m) acc[ai][bj][m][n] += bv; }
        bool bad = st1.run(acc, u, wr, wc, fr, fq, lds, wid, lane) || poison != 0u;
        const float qnan = __builtin_nanf("");
#pragma unroll
        for (int ai = 0; ai < 2; ++ai)
#pragma unroll
            for (int m = 0; m < 4; ++m) { const int r = ai * HALF + wr * 64 + m * 16 + fr; const f32x2v sr = S[r]; const size_t off = (size_t)(u.pm * BM + r) * ldc + col0;
#pragma unroll
                for (int bj = 0; bj < 2; ++bj)
#pragma unroll
                    for (int n = 0; n < 2; ++n) { const f32x4 bs = *(const f32x4*)(base + off + bj * HALF + n * 16); acc[ai][bj][m][n] = bs + (acc[ai][bj][m][n] - sr.x) * sr.y; }
                asm volatile("" : "+v"(acc[ai][0][m][0]), "+v"(acc[ai][0][m][1]), "+v"(acc[ai][1][m][0]), "+v"(acc[ai][1][m][1]));
                if (m & 1) asm volatile("" ::: "memory"); }
        const bool bad1 = bad;
        bad = st2.run(acc, u, wr, wc, fr, fq, lds, wid, lane) || bad;
#pragma unroll
        for (int ai = 0; ai < 2; ++ai)
#pragma unroll
            for (int m = 0; m < 4; ++m) { const int r = ai * HALF + wr * 64 + m * 16 + fr; const f32x2v sr = S[r]; const size_t off = (size_t)(u.pm * BM + r) * ldc + col0;
#pragma unroll
                for (int bj = 0; bj < 2; ++bj)
#pragma unroll
                    for (int n = 0; n < 2; ++n) { const f32x4 x1 = acc[ai][bj][m][n]; *(f32x4*)(out + off + bj * HALF + n * 16) = bad1 ? (f32x4){qnan, qnan, qnan, qnan} : x1;
                        const f32x4 o = (x1 - sr.x) * sr.y; u32x2v w; w.x = cvt_pk_bf16(o[0], o[1]); w.y = cvt_pk_bf16(o[2], o[3]);
                        if (bad) { w.x = 0x7fc07fc0u; w.y = 0x7fc07fc0u; } *(u32x2v*)(xn + off + bj * HALF + n * 16) = w; }
                asm volatile("" ::: "memory"); }
    }
};

template <class Epi, class Sched, bool ALIGN_EPI = false, bool SP2 = false>
__device__ __forceinline__ void gemm_phase(PG8_LAS unsigned char* lds, const Gemm g, const Sched& S, const Epi& E, int wv) {
    int tid0_ = threadIdx.x; asm volatile("" : "+v"(tid0_)); (void)wv;
    const int tid = tid0_, wid = __builtin_amdgcn_readfirstlane(tid >> 6), lane = tid & 63, wr = wid >> 2, wc = wid & 3, fr = lane & 15, fq = lane >> 4;
    const int K = g.K, nt = K / BK;
    unsigned voffA[2], voffB[2];
#pragma unroll
    for (int i = 0; i < 2; ++i) { int R, C; stage_rc(tid * 16 + i * 8192, R, C); const int Rb = Epi::PERM ? ((R & ~31) + perm32(R & 31)) : R;
        voffA[i] = (unsigned)(R * K + C) * 2u; voffB[i] = (unsigned)(Rb * K + C) * 2u; }
    const size_t kstep = (size_t)(BK * 2);
    const size_t hstep = (size_t)HALF * K * 2;
    const size_t tstep = 2 * hstep;
    const unsigned ldsw = (unsigned)wid * 1024u;
    const int aoff = lds_byte(wr * 64 + fr, fq * 8), boff = lds_byte(wc * 32 + fr, fq * 8);
#define PG8_SA(b, h) (((b) * 2 + (h)) * HTB)
#define PG8_SB(b, h) ((4 + (b) * 2 + (h)) * HTB)
#define PG8_STAGE(bufoff, gbase, voff) do { _Pragma("unroll") for (int _i = 0; _i < 2; ++_i) \
        __builtin_amdgcn_global_load_lds((const unsigned*)((const char*)(gbase) + (voff)[_i]), (PG8_LAS unsigned*)(lds + (bufoff) + ldsw + _i * 8192), 16, 0, 0); } while (0)
#define PG8_LDA(dst, b, h) do { _Pragma("unroll") for (int m = 0; m < 4; ++m) _Pragma("unroll") for (int k = 0; k < 2; ++k) dst[m][k] = *(const PG8_LAS bf16x8*)(lds + PG8_SA(b, h) + aoff + m * 2048 + k * 1024); } while (0)
#define PG8_LDB(dst, b, h) do { _Pragma("unroll") for (int n = 0; n < 2; ++n) _Pragma("unroll") for (int k = 0; k < 2; ++k) dst[n][k] = *(const PG8_LAS bf16x8*)(lds + PG8_SB(b, h) + boff + n * 2048 + k * 1024); } while (0)
#define PG8_MMA(ai, bj, At, Bt) do { __builtin_amdgcn_s_setprio(1); _Pragma("unroll") for (int m = 0; m < 4; ++m) _Pragma("unroll") for (int n = 0; n < 2; ++n) _Pragma("unroll") for (int k = 0; k < 2; ++k) \
        acc[ai][bj][m][n] = __builtin_amdgcn_mfma_f32_16x16x32_bf16(Bt[n][k], At[m][k], acc[ai][bj][m][n], 0, 0, 0); __builtin_amdgcn_s_setprio(0); } while (0)
#define PG8_WAIT_V(n) asm volatile("s_waitcnt vmcnt(" #n ")" ::: "memory")
#define PG8_WAIT_L(n) asm volatile("s_waitcnt lgkmcnt(" #n ")" ::: "memory")
#define PG8_BAR __builtin_amdgcn_s_barrier()
#define PG8_SCHED __builtin_amdgcn_sched_barrier(0)
    Unit cur, nxt; int ui = 0;
    if (!S.next(0, cur)) return;
    f32x4 acc[2][2][4][2];
#pragma unroll
    for (int a = 0; a < 2; ++a)
#pragma unroll
        for (int b = 0; b < 2; ++b)
#pragma unroll
            for (int m = 0; m < 4; ++m)
#pragma unroll
                for (int n = 0; n < 2; ++n) acc[a][b][m][n] = (f32x4){0.f, 0.f, 0.f, 0.f};
    bf16x8 At[4][2], B0[2][2], B1[2][2];
    const char* cA = (const char*)g.A + (size_t)cur.pm * tstep; const char* cB = (const char*)g.Bt + (size_t)cur.pn * tstep;
    S.a_ready(cur);
    if constexpr (SP2) {
        PG8_STAGE(PG8_SB(0, 0), cB, voffB); PG8_STAGE(PG8_SB(0, 1), cB + hstep, voffB); PG8_STAGE(PG8_SA(0, 0), cA, voffA); PG8_STAGE(PG8_SA(0, 1), cA + hstep, voffA);
        if (wr == 1) PG8_BAR;
        PG8_WAIT_V(2); PG8_BAR;
        PG8_STAGE(PG8_SB(1, 0), cB + kstep, voffB); PG8_STAGE(PG8_SA(1, 0), cA + kstep, voffA); PG8_STAGE(PG8_SB(1, 1), cB + hstep + kstep, voffB);
        PG8_WAIT_V(6); PG8_BAR;
    } else {
        PG8_STAGE(PG8_SB(0, 0), cB, voffB); PG8_STAGE(PG8_SA(0, 0), cA, voffA); PG8_STAGE(PG8_SB(0, 1), cB + hstep, voffB); PG8_STAGE(PG8_SA(0, 1), cA + hstep, voffA);
        if (wr == 1) PG8_BAR;
        PG8_WAIT_V(4); PG8_BAR;
        PG8_STAGE(PG8_SB(1, 0), cB + kstep, voffB); PG8_STAGE(PG8_SA(1, 0), cA + kstep, voffA); PG8_STAGE(PG8_SB(1, 1), cB + hstep + kstep, voffB);
        PG8_WAIT_V(6); PG8_BAR;
    }
    for (;;) {
        const bool has_next = S.next(ui + 1, nxt);
        const char* nA = has_next ? (const char*)g.A + (size_t)nxt.pm * tstep : cA; const char* nB = has_next ? (const char*)g.Bt + (size_t)nxt.pn * tstep : cB;
        for (int t = 0; t < nt; t += 2) {
            const bool last = (t == nt - 2);
            const char* a1 = cA + (size_t)(t + 1) * kstep;
            const char* a2 = last ? nA : cA + (size_t)(t + 2) * kstep; const char* b2 = last ? nB : cB + (size_t)(t + 2) * kstep;
            const char* a3 = a2 + kstep; const char* b3 = b2 + kstep;
            if (last && has_next) S.a_ready(nxt);
            if constexpr (SP2) {
            PG8_LDB(B0, 0, 0); PG8_LDB(B1, 0, 1); PG8_SCHED; PG8_LDA(At, 0, 0); PG8_STAGE(PG8_SA(1, 1), a1 + hstep, voffA);
            PG8_WAIT_V(8); PG8_WAIT_L(0); PG8_BAR; PG8_MMA(0, 0, At, B0); PG8_MMA(0, 1, At, B1); PG8_BAR; PG8_SCHED;
            PG8_LDA(At, 0, 1); PG8_STAGE(PG8_SB(0, 0), b2, voffB); PG8_STAGE(PG8_SB(0, 1), b2 + hstep, voffB); PG8_STAGE(PG8_SA(0, 0), a2, voffA);
            PG8_WAIT_V(8); PG8_WAIT_L(0); PG8_BAR; PG8_MMA(1, 0, At, B0); PG8_MMA(1, 1, At, B1); PG8_BAR; PG8_SCHED;
            PG8_LDB(B0, 1, 0); PG8_LDB(B1, 1, 1); PG8_SCHED; PG8_LDA(At, 1, 0); PG8_STAGE(PG8_SA(0, 1), a2 + hstep, voffA);
            PG8_WAIT_V(8); PG8_WAIT_L(0); PG8_BAR; PG8_MMA(0, 0, At, B0); PG8_MMA(0, 1, At, B1); PG8_BAR; PG8_SCHED;
            PG8_LDA(At, 1, 1); PG8_STAGE(PG8_SB(1, 0), b3, voffB); PG8_STAGE(PG8_SB(1, 1), b3 + hstep, voffB); PG8_STAGE(PG8_SA(1, 0), a3, voffA);
            PG8_WAIT_V(8); PG8_WAIT_L(0); PG8_BAR; PG8_MMA(1, 0, At, B0); PG8_MMA(1, 1, At, B1); PG8_BAR; PG8_SCHED;
            } else {
            PG8_LDB(B0, 0, 0); PG8_SCHED; PG8_LDA(At, 0, 0); PG8_STAGE(PG8_SA(1, 1), a1 + hstep, voffA);
            PG8_WAIT_L(8); PG8_BAR; PG8_WAIT_L(0); PG8_MMA(0, 0, At, B0); PG8_BAR; PG8_SCHED;
            PG8_LDB(B1, 0, 1); PG8_STAGE(PG8_SB(0, 0), b2, voffB);
            PG8_BAR; PG8_WAIT_L(0); PG8_MMA(0, 1, At, B1); PG8_BAR;
            PG8_LDA(At, 0, 1); PG8_STAGE(PG8_SA(0, 0), a2, voffA);
            PG8_BAR; PG8_WAIT_L(0); PG8_MMA(1, 0, At, B0); PG8_BAR; PG8_SCHED;
            PG8_STAGE(PG8_SB(0, 1), b2 + hstep, voffB);
            PG8_WAIT_V(6); PG8_BAR; PG8_MMA(1, 1, At, B1); PG8_BAR;
            PG8_LDB(B0, 1, 0); PG8_SCHED; PG8_LDA(At, 1, 0); PG8_STAGE(PG8_SA(0, 1), a2 + hstep, voffA);
            PG8_WAIT_L(8); PG8_BAR; PG8_WAIT_L(0); PG8_MMA(0, 0, At, B0); PG8_BAR; PG8_SCHED;
            PG8_LDB(B1, 1, 1); PG8_STAGE(PG8_SB(1, 0), b3, voffB);
            PG8_BAR; PG8_WAIT_L(0); PG8_MMA(0, 1, At, B1); PG8_BAR;
            PG8_LDA(At, 1, 1); PG8_STAGE(PG8_SA(1, 0), a3, voffA);
            PG8_BAR; PG8_WAIT_L(0); PG8_MMA(1, 0, At, B0); PG8_BAR; PG8_SCHED;
            PG8_STAGE(PG8_SB(1, 1), b3 + hstep, voffB);
            PG8_WAIT_V(6); PG8_BAR; PG8_MMA(1, 1, At, B1); PG8_BAR;
            }
        }
        if constexpr (ALIGN_EPI) { if (wr == 0) PG8_BAR; }
        if constexpr (!Epi::AFTER_DRAIN) { E(acc, cur, wr, wc, fr, fq); S.done(cur); }
        if (!has_next) break;
#pragma unroll
        for (int a = 0; a < 2; ++a)
#pragma unroll
            for (int b = 0; b < 2; ++b)
#pragma unroll
                for (int m = 0; m < 4; ++m)
#pragma unroll
                    for (int n = 0; n < 2; ++n) acc[a][b][m][n] = (f32x4){0.f, 0.f, 0.f, 0.f};
        cur = nxt; cA = nA; cB = nB; ++ui;
        if constexpr (ALIGN_EPI) { if (wr == 1) PG8_BAR; }
    }
    PG8_WAIT_V(0);
    if constexpr (!ALIGN_EPI) { if (wr == 0) PG8_BAR; }
    PG8_BAR;
    if constexpr (Epi::AFTER_DRAIN) { E.fused(acc, cur, wr, wc, fr, fq, lds, wid, lane); S.done(cur); }
#undef PG8_SA
#undef PG8_SB
#undef PG8_STAGE
#undef PG8_LDA
#undef PG8_LDB
#undef PG8_MMA
#undef PG8_WAIT_V
#undef PG8_WAIT_L
#undef PG8_BAR
#undef PG8_SCHED
}
}

#ifndef PG8_SP2
#define PG8_SP2 true
#endif
#ifndef PG8_ALIGN
#define PG8_ALIGN true
#endif
#define GAS __attribute__((address_space(1)))
#define LAS __attribute__((address_space(3)))
#define XB_TMO      128
#define XB_XCNT(j)  (256  + 64 * (j))
#define XB_XSUB(j)  (1280 + 64 * (j))
#define XB_XGEN(j)  (2304 + 64 * (j))
#define XB_TOP      3328
#define XB_TOPGEN   3392
#define XCD_BAR_WORDS 3456
#define XB_SPIN_CAP (1u << 18)

__device__ __forceinline__ unsigned xb_ld(unsigned* p)              { return __hip_atomic_load(p, __ATOMIC_RELAXED, __HIP_MEMORY_SCOPE_AGENT); }
__device__ __forceinline__ unsigned xb_add(unsigned* p, unsigned v) { return __hip_atomic_fetch_add(p, v, __ATOMIC_RELAXED, __HIP_MEMORY_SCOPE_AGENT); }
__device__ __forceinline__ unsigned xb_xcc_id() { return (unsigned)__builtin_amdgcn_s_getreg((3 << 11) | 20) & 0xFu; }
#define XB_SPIN(cond, bar) do { unsigned _sp = 0; while (cond) { __builtin_amdgcn_s_sleep(1); \
    if ((++_sp & 255u) == 0u) { if (xb_ld(&(bar)[XB_TMO])) break; if (_sp > XB_SPIN_CAP) { atomicAdd(&(bar)[XB_TMO], 1u); break; } } } } while (0)

struct XcdBarrier {
    unsigned* bar; unsigned x;
    volatile LAS unsigned* st;
    int wv;
};

__device__ __forceinline__ XcdBarrier xcd_barrier_post(unsigned* bar, volatile LAS unsigned* st) {
    XcdBarrier b; b.bar = bar; b.x = xb_xcc_id(); b.st = st;
    if (threadIdx.x == 0) (void)xb_add(&bar[XB_XCNT(b.x)], 1u);
    return b;
}
__device__ __forceinline__ void xcd_barrier_complete(unsigned* bar, unsigned x, unsigned& nloc, unsigned& nx) {
    asm volatile("" : "+s"(x));
    const unsigned G = gridDim.x * gridDim.y * gridDim.z;
    unsigned sum, cnt, mine, sp = 0u;
    for (;;) {
        sum = 0u; cnt = 0u; mine = 0u;
#pragma unroll
        for (unsigned j = 0; j < 16; ++j) { const unsigned c = xb_ld(&bar[XB_XCNT(j)]); sum += c; cnt += (c > 0u) ? 1u : 0u; mine = (j == x) ? c : mine; }
        if (sum == G) break;
        __builtin_amdgcn_s_sleep(1);
        if ((++sp & 255u) == 0u) { if (xb_ld(&bar[XB_TMO])) break; if (sp > XB_SPIN_CAP) { atomicAdd(&bar[XB_TMO], 1u); break; } }
    }
    nloc = mine > 0u ? mine : 1u; nx = cnt > 0u ? cnt : 1u;
}

__device__ __forceinline__ void xcd_barrier(const XcdBarrier& b) {
    asm volatile("s_waitcnt vmcnt(0)" ::: "memory");
    __syncthreads();
    if (threadIdx.x == 0) {
        unsigned* bar = b.bar; asm volatile("" : "+s"(bar));
        __builtin_amdgcn_s_waitcnt(0);
        unsigned nloc = b.st[0], nx = b.st[1];
        if (nloc == 0u) { xcd_barrier_complete(bar, b.x, nloc, nx); b.st[0] = nloc; b.st[1] = nx; }
        const unsigned old = xb_add(&bar[XB_XSUB(b.x)], 1u);
        const unsigned gen = old / nloc;
        if (old + 1u == (gen + 1u) * nloc) {
            __builtin_amdgcn_fence(__ATOMIC_RELEASE, "agent");
            asm volatile("s_waitcnt vmcnt(0)" ::: "memory");
            const unsigned og = xb_add(&bar[XB_TOP], 1u);
            const unsigned tg = og / nx;
            if (og + 1u == (tg + 1u) * nx) xb_add(&bar[XB_TOPGEN], 1u);
            else XB_SPIN(xb_ld(&bar[XB_TOPGEN]) == tg, bar);
            __builtin_amdgcn_fence(__ATOMIC_ACQUIRE, "agent");
            xb_add(&bar[XB_XGEN(b.x)], 1u);
            asm volatile("s_waitcnt vmcnt(0)" ::: "memory");
        } else {
            XB_SPIN(xb_ld(&bar[XB_XGEN(b.x)]) == gen, bar);
            __builtin_amdgcn_fence(__ATOMIC_ACQUIRE, "agent");
            asm volatile("s_waitcnt vmcnt(0)" ::: "memory");
        }
    }
    __syncthreads();
}
namespace dattn {
constexpr int D = 128, QST = 2048, KVS = 512, OST = 2048, MTW = 68, JLO = 3;
constexpr float THR = 8.f; constexpr bool WSKIP = false;
typedef unsigned short bf16;
constexpr float SCALE = 1.0f;
constexpr int NW = 8, QBLK = 32, KVBLK = 64, QB = NW * QBLK;
constexpr int SHM_V = KVBLK * D * 2, SHM_K = KVBLK * D * 2;
constexpr int LDS_BYTES = 2 * SHM_V + 2 * SHM_K + NW * 64 * 4;

typedef short bf16x8 __attribute__((ext_vector_type(8)));
typedef short s16x4 __attribute__((ext_vector_type(4)));
typedef float f32x16 __attribute__((ext_vector_type(16)));
typedef float f32x4 __attribute__((ext_vector_type(4)));
typedef unsigned u32x4 __attribute__((ext_vector_type(4)));
template <class A, class Bt> struct same_t { static constexpr bool v = false; };
template <class A> struct same_t<A, A> { static constexpr bool v = true; };

#define KSWZ(row, colB) ((row) * 256 + ((colB) ^ (((row) & 7) << 4)))
#define SBAR() __builtin_amdgcn_sched_barrier(0)
__device__ __forceinline__ int v_st(int k, int c) { const int kk = (k & ~0xC) | ((k & 4) << 1) | ((k & 8) >> 1); return ((kk >> 3) * 4 + (c >> 5)) * 512 + ((kk & 7) * 32 + (c & 31)) * 2; }
__device__ __forceinline__ int v_rd_base(int lane) { return ((lane & 3) << 3) | (((lane >> 2) & 3) << 6) | (((lane >> 4) & 1) << 5) | (((lane >> 5) & 1) << 8); }
constexpr int v_rd_off(int d0, int ks, int half) { return d0 * 512 + ks * 4096 + half * 2048; }
__device__ __forceinline__ int crow(int r, int hi) { return (r & 3) + 8 * (r >> 2) + 4 * hi; }
__device__ __forceinline__ unsigned cvtpk(float lo, float hi) {
    unsigned r; asm volatile("v_cvt_pk_bf16_f32 %0, %1, %2" : "=v"(r) : "v"(lo), "v"(hi)); return r;
}
__device__ __forceinline__ bf16x8 pack8(f32x4 a, f32x4 b) {
    u32x4 w = {cvtpk(a[0], a[1]), cvtpk(a[2], a[3]), cvtpk(b[0], b[1]), cvtpk(b[2], b[3])};
    return *reinterpret_cast<bf16x8*>(&w);
}
template <class T> __device__ __forceinline__ bf16x8 load8(const T* p) {
    if constexpr (same_t<T, float>::v) { return pack8(*(const f32x4*)p, *(const f32x4*)(p + 4)); }
    else { return *reinterpret_cast<const bf16x8*>(p); }
}
__device__ __forceinline__ void mask_tile(f32x16& p0, f32x16& p1, int dq, unsigned W) {
    const float NEG = -__builtin_inff();
#pragma unroll
    for (int r = 0; r < 16; ++r) {
        const int c = (r & 3) + 8 * (r >> 2);
        if ((unsigned)(dq - c) >= W) p0[r] = NEG;
        if ((unsigned)(dq - c - 32) >= W) p1[r] = NEG;
    }
}
__device__ __forceinline__ void mask_bits(f32x16& p0, f32x16& p1, unsigned long long mw, int hi) {
    const float NEG = -__builtin_inff();
    const unsigned lo = (unsigned)(mw >> (4 * hi)), up = (unsigned)(mw >> (32 + 4 * hi));
#pragma unroll
    for (int r = 0; r < 16; ++r) {
        const int c = (r & 3) + 8 * (r >> 2);
        if (!((lo >> c) & 1u)) p0[r] = NEG;
        if (!((up >> c) & 1u)) p1[r] = NEG;
    }
}
__device__ __forceinline__ void partialSM(f32x16& p0, f32x16& p1, float& m_reg, float& mn, float& alpha) {
    float pmax = p0[0]; for (int r = 1; r < 16; ++r) pmax = fmaxf(pmax, p0[r]); for (int r = 0; r < 16; ++r) pmax = fmaxf(pmax, p1[r]);
    { auto rr = __builtin_amdgcn_permlane32_swap(__float_as_uint(pmax), __float_as_uint(pmax), false, false);
      pmax = fmaxf(__uint_as_float(rr[0]), __uint_as_float(rr[1])); }
    constexpr float C2 = 1.4426950408889634f * SCALE;
    if (__builtin_expect(__all((pmax - m_reg) * SCALE <= THR), 1)) { mn = m_reg; alpha = 1.f; }
    else { mn = fmaxf(m_reg, pmax); alpha = __builtin_amdgcn_exp2f((m_reg - mn) * C2); m_reg = mn; }
    const float mnL = -mn * C2;
    for (int r = 0; r < 16; ++r) p0[r] = fmaf(p0[r], C2, mnL); for (int r = 0; r < 16; ++r) p1[r] = fmaf(p1[r], C2, mnL);
    for (int r = 0; r < 16; ++r) p0[r] = __builtin_amdgcn_exp2f(p0[r]);
}
__device__ __forceinline__ void finishSM(f32x16& p0, f32x16& p1, float alpha, float& l_reg, bf16x8& pa0, bf16x8& pa1, bf16x8& pa2, bf16x8& pa3) {
    for (int r = 0; r < 16; ++r) p1[r] = __builtin_amdgcn_exp2f(p1[r]);
    float ps = 0; for (int r = 0; r < 16; ++r) ps += p0[r]; for (int r = 0; r < 16; ++r) ps += p1[r];
    { auto rr = __builtin_amdgcn_permlane32_swap(__float_as_uint(ps), __float_as_uint(ps), false, false);
      ps = __uint_as_float(rr[0]) + __uint_as_float(rr[1]); }
    l_reg = l_reg * alpha + ps;
#define PK4(P, B_, OUT) do { unsigned a0 = cvtpk(P[B_+0], P[B_+1]), a1 = cvtpk(P[B_+2], P[B_+3]);                          \
        unsigned b0 = cvtpk(P[B_+4], P[B_+5]), b1 = cvtpk(P[B_+6], P[B_+7]);                                             \
        auto r0 = __builtin_amdgcn_permlane32_swap(a0, b0, false, false); auto r1 = __builtin_amdgcn_permlane32_swap(a1, b1, false, false); \
        u32x4 w = {r0[0], r1[0], r0[1], r1[1]}; OUT = *reinterpret_cast<bf16x8*>(&w); } while (0)
    PK4(p0, 0, pa0); PK4(p0, 8, pa1); PK4(p1, 0, pa2); PK4(p1, 8, pa3);
#undef PK4
}
template <int KB, bool SK>
__device__ __forceinline__ void qkt(f32x16& p0, f32x16& p1, const char* K_lds, int r32, int hi, const bf16x8* qr, bool act) {
    if (SK && !act) { const float NEG = -__builtin_inff();
#pragma unroll
        for (int r = 0; r < 16; ++r) { p0[r] = NEG; p1[r] = NEG; } return; }
    p0 = f32x16{}; p1 = f32x16{};
    const char* kb[4];
#pragma unroll
    for (int dd = 0; dd < 4; ++dd) kb[dd] = K_lds + KB * SHM_K + KSWZ(r32, (dd * 16 + hi * 8) * 2);
#pragma unroll
    for (int d0 = 0; d0 < 8; ++d0) { const char* a = kb[d0 & 3] + (d0 >> 2) * 128;
        bf16x8 b0 = *reinterpret_cast<const bf16x8*>(a);
        bf16x8 b1 = *reinterpret_cast<const bf16x8*>(a + 32 * 256);
        p0 = __builtin_amdgcn_mfma_f32_32x32x16_bf16(b0, qr[d0], p0, 0, 0, 0);
        p1 = __builtin_amdgcn_mfma_f32_32x32x16_bf16(b1, qr[d0], p1, 0, 0, 0); }
}
template <int VB, bool SK>
__device__ __forceinline__ void pv_tile(f32x16* o, int vb0, bf16x8 pa0, bf16x8 pa1, bf16x8 pa2, bf16x8 pa3, bool act) {
    if (SK && !act) return;
#define TRRD(dst, off) asm volatile("ds_read_b64_tr_b16 %0, %1 offset:%2" : "=&v"(dst) : "v"(vb0), "i"(off) : "memory")
#define PV_D0(d0) do { s16x4 l0, l1, l2, l3, h0, h1, h2, h3; constexpr int b_ = VB * SHM_V + v_rd_off(d0, 0, 0);     \
        TRRD(l0, b_); TRRD(h0, b_ + 2048); TRRD(l1, b_ + 4096); TRRD(h1, b_ + 6144); TRRD(l2, b_ + 8192); TRRD(h2, b_ + 10240); TRRD(l3, b_ + 12288); TRRD(h3, b_ + 14336); \
        asm volatile("s_waitcnt lgkmcnt(0)" ::: "memory"); SBAR();                 \
        o[d0] = __builtin_amdgcn_mfma_f32_32x32x16_bf16(pa0, (bf16x8){l0[0], l0[1], l0[2], l0[3], h0[0], h0[1], h0[2], h0[3]}, o[d0], 0, 0, 0);   \
        o[d0] = __builtin_amdgcn_mfma_f32_32x32x16_bf16(pa1, (bf16x8){l1[0], l1[1], l1[2], l1[3], h1[0], h1[1], h1[2], h1[3]}, o[d0], 0, 0, 0);   \
        o[d0] = __builtin_amdgcn_mfma_f32_32x32x16_bf16(pa2, (bf16x8){l2[0], l2[1], l2[2], l2[3], h2[0], h2[1], h2[2], h2[3]}, o[d0], 0, 0, 0);   \
        o[d0] = __builtin_amdgcn_mfma_f32_32x32x16_bf16(pa3, (bf16x8){l3[0], l3[1], l3[2], l3[3], h3[0], h3[1], h3[2], h3[3]}, o[d0], 0, 0, 0); } while (0)
    PV_D0(0); PV_D0(1); PV_D0(2); PV_D0(3);
#undef PV_D0
#undef TRRD
}

template <class TIn, class TOut> struct BlockRef { const TIn* Q; const TIn* K; const TIn* V; TOut* O; const unsigned long long* M; int P0; };
template <class TIn> struct Seam {
    bf16x8 qr[8];
    bf16x8 st_v0, st_v1, st_k0, st_k1; f32x4 sf0, sf1, sf2, sf3;
    f32x4 tq[16];
};
__device__ __forceinline__ int swa_jlo(int, int) { return JLO; }
#define ROW(p, k0, rr) ((p) + (size_t)((k0) + (rr)) * KVS + sc)
#define VMW() asm volatile("s_waitcnt vmcnt(0)" ::: "memory")
#define VMWN(n) asm volatile("s_waitcnt vmcnt(%0)" :: "i"(n) : "memory")
#define SLOAD_H(Kp, Vp, k0) do { S.st_v0 = load8<TIn>(ROW(Vp, k0, sr)); S.st_v1 = load8<TIn>(ROW(Vp, k0, 32 + sr));              \
                         S.st_k0 = load8<TIn>(ROW(Kp, k0, sr)); S.st_k1 = load8<TIn>(ROW(Kp, k0, 32 + sr)); } while (0)
#define SWRITE_HK(bf) do { *(bf16x8*)(K_lds + (bf) * SHM_K + kws) = S.st_k0; *(bf16x8*)(K_lds + (bf) * SHM_K + kws + 32 * 256) = S.st_k1; } while (0)
#define SWRITE_HV(bf) do { *(bf16x8*)(V_lds + (bf) * SHM_V + vst0) = S.st_v0; *(bf16x8*)(V_lds + (bf) * SHM_V + vst1) = S.st_v1; } while (0)
#define SWRITE_H(bf) do { SWRITE_HV(bf); SWRITE_HK(bf); } while (0)
#define SLOAD_F(p, k0) do { S.sf0 = *(const f32x4*)ROW(p, k0, sr); S.sf1 = *(const f32x4*)(ROW(p, k0, sr) + 4);                \
                            S.sf2 = *(const f32x4*)ROW(p, k0, 32 + sr); S.sf3 = *(const f32x4*)(ROW(p, k0, 32 + sr) + 4); } while (0)
#define SWRITE_KF(bf) do { *(bf16x8*)(K_lds + (bf) * SHM_K + kws) = pack8(S.sf0, S.sf1); *(bf16x8*)(K_lds + (bf) * SHM_K + kws + 32 * 256) = pack8(S.sf2, S.sf3); } while (0)
#define SWRITE_VF(bf) do { *(bf16x8*)(V_lds + (bf) * SHM_V + vst0) = pack8(S.sf0, S.sf1); *(bf16x8*)(V_lds + (bf) * SHM_V + vst1) = pack8(S.sf2, S.sf3); } while (0)
template <class TIn, class TOut>
__device__ __forceinline__ void causal_swa_prime(const BlockRef<TIn, TOut>& cur, int W, char* lds, Seam<TIn>& S, int wv) {
    constexpr bool F32 = same_t<TIn, float>::v;
    int tid0_ = threadIdx.x; asm volatile("" : "+v"(tid0_)); (void)wv;
    const int tid = tid0_, wid = __builtin_amdgcn_readfirstlane(tid >> 6), lane = tid & 63, r32 = lane & 31, hi = lane >> 5;
    const int sr = tid >> 4, sc = (tid & 15) * 8, kws = KSWZ(sr, sc * 2); char* K_lds = lds + 2 * SHM_V;
    const int kb0 = swa_jlo(cur.P0, W) * KVBLK;
    for (int d0 = 0; d0 < 8; ++d0) S.qr[d0] = load8<TIn>(cur.Q + (size_t)(wid * QBLK + r32) * QST + d0 * 16 + hi * 8);
    if constexpr (F32) { SLOAD_F((const float*)cur.K, kb0); VMW(); SWRITE_KF(0); SBAR(); SLOAD_F((const float*)cur.V, kb0); }
    else { SLOAD_H(cur.K, cur.V, kb0); VMW(); SWRITE_HK(0); }
    __syncthreads();
}
template <class TIn, class TOut>
__device__ __forceinline__ void causal_swa_block(const BlockRef<TIn, TOut>& cur, const BlockRef<TIn, TOut>& nxt, int skv, int W, char* lds, Seam<TIn>& S, int wv) {
    constexpr bool F32 = same_t<TIn, float>::v;
    int tid0_ = threadIdx.x; asm volatile("" : "+v"(tid0_)); (void)wv;
    const int tid = tid0_, wid = __builtin_amdgcn_readfirstlane(tid >> 6), lane = tid & 63, r32 = lane & 31, hi = lane >> 5;
    const int j_lo = swa_jlo(cur.P0, W);
    int j_hi = (cur.P0 + QB - 1) / KVBLK + 1; if (j_hi > skv / KVBLK) j_hi = skv / KVBLK;
    const int NT = j_hi - j_lo;
    const int kbn = swa_jlo(nxt.P0, W) * KVBLK;
    const int qlo = cur.P0 + wid * QBLK; (void)qlo;
    const unsigned long long* mrow = cur.M + (size_t)(wid * QBLK + r32) * MTW;
    const int qm_unused = 0; (void)qm_unused;
    char* V_lds = lds; char* K_lds = lds + 2 * SHM_V;
    float* ws = (float*)(lds + 2 * SHM_V + 2 * SHM_K) + wid * 64; float* li_l = ws, * al_l = ws + 32;
    float m_reg = -1e30f, l_reg = 0; f32x16 o[4] = {};
    const int sr = tid >> 4, sc = (tid & 15) * 8, vst0 = v_st(sr, sc), vst1 = v_st(32 + sr, sc), kws = KSWZ(sr, sc * 2);
    const int vb0 = (int)(uintptr_t)V_lds + v_rd_base(lane);
    const TIn* Kh = cur.K; const TIn* Vh = cur.V;
#define RESC(a) do { if (__any((a) < 1.f)) { if (hi == 0) al_l[r32] = (a); asm volatile("s_waitcnt lgkmcnt(0)" ::: "memory");              \
                     for (int d_ = 0; d_ < 4; ++d_) for (int r = 0; r < 16; ++r) o[d_][r] *= al_l[crow(r, hi)]; } } while (0)
#define KBASE(t) ((j_lo + (t)) * KVBLK)
#define ACT(t) (KBASE(t) <= qlo + QBLK - 1 && KBASE(t) + KVBLK - 1 >= qlo - W + 1)
#define MASKT(P0_, P1_, t) mask_bits(P0_, P1_, mrow[j_lo + (t)], hi)
    constexpr int NQL = F32 ? 16 : 8;
    constexpr bool SK = WSKIP && !F32;
#define SEAM_K0() do { VMWN(NQL); if constexpr (F32) { SWRITE_KF(0); SBAR(); SLOAD_F((const float*)nxt.V, kbn); } else { SWRITE_HK(0); } SBAR(); } while (0)
    f32x16 pA0, pA1, pB0, pB1; float mnA, mnB, alA, alB; bf16x8 pa0, pa1, pa2, pa3;
    if constexpr (F32) { VMW(); SWRITE_VF(0); SBAR(); } else { SWRITE_HV(0); SBAR(); }
    if (NT > 1) { if constexpr (F32) SLOAD_F((const float*)Kh, KBASE(1)); else SLOAD_H(Kh, Vh, KBASE(1)); }
    SBAR(); qkt<0, SK>(pA0, pA1, K_lds, r32, hi, S.qr, ACT(0));
    if constexpr (F32) { if (NT > 1) { VMW(); SWRITE_KF(1); SBAR(); SLOAD_F((const float*)Vh, KBASE(1)); } }
    MASKT(pA0, pA1, 0); partialSM(pA0, pA1, m_reg, mnA, alA);
    if (NT > 1) { VMW(); if constexpr (F32) { SWRITE_VF(1); SBAR(); if (NT > 2) SLOAD_F((const float*)Kh, KBASE(2)); } else SWRITE_H(1); }
    __syncthreads();
#define HALF_STEP(PX0, PX1, mnX, alX, PY0, PY1, alY, t, KB, VB, SB) do {                                                      \
        SBAR(); qkt<KB, SK>(PX0, PX1, K_lds, r32, hi, S.qr, ACT(t));                                             \
        finishSM(PY0, PY1, alY, l_reg, pa0, pa1, pa2, pa3); SBAR();                                                           \
        if ((t) + 1 < NT) { if constexpr (F32) { VMW(); SWRITE_KF(SB); SBAR(); SLOAD_F((const float*)Vh, KBASE((t) + 1)); }  \
                            else { SLOAD_H(Kh, Vh, KBASE((t) + 1)); } SBAR(); }                                               \
        pv_tile<VB, SK>(o, vb0, pa0, pa1, pa2, pa3, ACT((t) - 1)); MASKT(PX0, PX1, (t)); partialSM(PX0, PX1, m_reg, mnX, alX);                                        \
        __syncthreads();                                                                                                      \
        if ((t) + 1 < NT) { VMW(); if constexpr (F32) { SWRITE_VF(SB); SBAR(); if ((t) + 2 < NT) SLOAD_F((const float*)Kh, KBASE((t) + 2)); } \
                            else { SWRITE_H(SB); } }                                                                          \
        RESC(alX); __syncthreads(); } while (0)
    for (int t = 1; t + 1 < NT; t += 2) {
        HALF_STEP(pB0, pB1, mnB, alB, pA0, pA1, alA, t, 1, 0, 0);
        HALF_STEP(pA0, pA1, mnA, alA, pB0, pB1, alB, t + 1, 0, 1, 1);
    }
    const bool even = (NT & 1) == 0;
    if (even) { SBAR(); qkt<1, SK>(pB0, pB1, K_lds, r32, hi, S.qr, ACT(NT - 1)); SBAR(); }
#define QROW(e) (nxt.Q + (size_t)(wid * QBLK + r32) * QST + ((e) >> 1) * 16 + hi * 8 + ((e) & 1) * 4)
    if constexpr (F32) { SLOAD_F((const float*)nxt.K, kbn); SBAR();
#pragma unroll
        for (int e = 0; e < 8; ++e) S.tq[e] = *(const f32x4*)QROW(e); }
    else { SLOAD_H(nxt.K, nxt.V, kbn); SBAR();
#pragma unroll
        for (int d0 = 0; d0 < 8; ++d0) S.qr[d0] = load8<TIn>(nxt.Q + (size_t)(wid * QBLK + r32) * QST + d0 * 16 + hi * 8); }
    SBAR();
    finishSM(pA0, pA1, alA, l_reg, pa0, pa1, pa2, pa3); SBAR();
    if constexpr (F32) {
#pragma unroll
        for (int e = 8; e < 16; ++e) S.tq[e] = *(const f32x4*)QROW(e); SBAR(); }
#undef QROW
    pv_tile<0, SK>(o, vb0, pa0, pa1, pa2, pa3, ACT(even ? NT - 2 : NT - 1));
    if (even) { MASKT(pB0, pB1, NT - 1); partialSM(pB0, pB1, m_reg, mnB, alB); __syncthreads(); RESC(alB);
        finishSM(pB0, pB1, alB, l_reg, pa0, pa1, pa2, pa3); SBAR(); pv_tile<1, SK>(o, vb0, pa0, pa1, pa2, pa3, ACT(NT - 1)); }
    SBAR(); SEAM_K0();
    if (hi == 0) li_l[r32] = l_reg; asm volatile("s_waitcnt lgkmcnt(0)" ::: "memory");
    float rli[16];
#pragma unroll
    for (int r = 0; r < 16; ++r) rli[r] = __builtin_amdgcn_rcpf(li_l[crow(r, hi)]);
    TOut* Ow = cur.O + (size_t)(wid * QBLK) * OST;
#pragma unroll
    for (int r = 0; r < 16; ++r) { const int orow = crow(r, hi);
#pragma unroll
        for (int d0 = 0; d0 < 4; ++d0) { const float v = o[d0][r] * rli[r];
            if constexpr (same_t<TOut, float>::v) { Ow[(size_t)orow * OST + d0 * 32 + r32] = v; }
            else { const float vn = __shfl_xor(v, 1);
                   if ((r32 & 1) == 0) *(unsigned*)(Ow + (size_t)orow * OST + d0 * 32 + r32) = cvtpk(v, vn); } } }
    if constexpr (F32) {
#pragma unroll
        for (int d0 = 0; d0 < 8; ++d0) S.qr[d0] = pack8(S.tq[2 * d0], S.tq[2 * d0 + 1]); }
    __syncthreads();
#undef RESC
#undef KBASE
#undef ACT
#undef MASKT
#undef SEAM_K0
#undef HALF_STEP
}
#undef ROW
#undef VMW
#undef VMWN
#undef SLOAD_H
#undef SWRITE_HK
#undef SWRITE_HV
#undef SWRITE_H
#undef SLOAD_F
#undef SWRITE_KF
#undef SWRITE_VF

}

constexpr int NWAVES = 8, NTHREADS = 512;
constexpr int DM = 2048, SEQ = 4096, NMETA = 16, TP = 4112, NBP = 2, SBN = 8, PAST = 16384, NPG = 128;
constexpr int XROW0 = 8192, SROW0 = 8224, NROWS = 8232, MPAD = 8448, FF = 8192, MAINM = 8192, XR = 48;
constexpr int NA_IN = 6144, NB_IN = 4176, NB_PAD = 4352, NC_IN = 12352, NC_PAD = 12544, DVW = 4096, CDIM = 8192;
constexpr float ALPHA = 1.6817928305074292f;
constexpr float LN_EPS = 1e-5f, RMS_EPS = 1e-6f;
constexpr int SCW = 4160, SCSW = 16448, KIROWS = 4128, NSKEY = PAST + 1;
constexpr int POS_SAMPLE_IDX = TP;

constexpr size_t O_YP = 0, O_YS = O_YP + (size_t)NBP * SEQ * DM, O_CAP = O_YS + (size_t)SBN * DM, O_CAS = O_CAP + 2 * NBP * 2 * DM,
                 O_KP = O_CAS + 2 * SBN * 2 * DM, O_VP = O_KP + (size_t)NBP * TP * 512, O_IKP = O_VP + (size_t)NBP * TP * 512,
                 O_KS = O_IKP + (size_t)NBP * TP * 64, O_VS = O_KS + SBN * 512, O_IKS = O_VS + SBN * 512, O_CCP = O_IKS + SBN * 64,
                 O_CCS = O_CCP + (size_t)NBP * 3 * CDIM, O_DP = O_CCS + (size_t)SBN * 3 * CDIM, O_DS = O_DP + (size_t)NBP * 32 * 128 * 128,
                 O_END = O_DS + (size_t)SBN * 32 * 128 * 128;

constexpr size_t MiB = 1u << 20;
constexpr size_t WS_CTL = 0, CTL_ZERO_BYTES = 1 * MiB;
constexpr size_t WS_TAB128 = 1 * MiB, WS_TAB64 = 4 * MiB, WS_WI = 6 * MiB, WS_G = 7 * MiB, WS_BETA = 9 * MiB, WS_CNT = 11 * MiB, WS_KIB = 12 * MiB,
                 WS_SCS = 14 * MiB, WS_IDXL = 16 * MiB, WS_X = 26 * MiB, WS_QR = 60 * MiB, WS_QI = 94 * MiB, WS_Z = 112 * MiB, WS_Y = 180 * MiB,
                 WS_BIG = 248 * MiB, WS_QKVC = 452 * MiB, WS_SC = 584 * MiB, WS_W = 716 * MiB;
constexpr size_t WSZ_A_IN = (size_t)NA_IN * DM * 2, WSZ_A_OUT = (size_t)DM * DM * 2, WSZ_B_IN = (size_t)NB_PAD * DM * 2, WSZ_B_OUT = (size_t)DM * DM * 2,
                 WSZ_C_IN = (size_t)NC_PAD * DM * 2, WSZ_C_OUT = (size_t)DM * DVW * 2, WSZ_W1 = (size_t)FF * DM * 2, WSZ_W2 = (size_t)DM * FF * 2;
constexpr size_t WS_WA_IN = WS_W, WS_WA_OUT = WS_WA_IN + 2 * WSZ_A_IN, WS_WB_IN = WS_WA_OUT + 2 * WSZ_A_OUT, WS_WB_OUT = WS_WB_IN + WSZ_B_IN,
                 WS_WC_IN = WS_WB_OUT + WSZ_B_OUT, WS_WC_OUT = WS_WC_IN + WSZ_C_IN, WS_W1 = WS_WC_OUT + WSZ_C_OUT, WS_W2 = WS_W1 + 4 * WSZ_W1,
                 WS_ZP = WS_W2 + 4 * WSZ_W2, WS_QKF = WS_ZP + 4 * MiB, WS_DWG = WS_QKF + 130 * MiB, WS_DUG = WS_DWG + 66 * MiB, WS_END = WS_DUG + 66 * MiB;
constexpr size_t WS_MASK = WS_IDXL, WS_KS = WS_Z, WS_VS = WS_Z + 9 * MiB;
constexpr size_t WS_DAF = WS_Z, WS_DTG = WS_Y, WS_DTB = WS_Y + 33 * MiB, WS_DPG = WS_QR, WS_DKT = WS_QKF, WS_DVT = WS_QKF + 33 * MiB, WS_DGC = WS_QI, WS_DBT = WS_QI + 2 * MiB;
constexpr int SP = 4352, SPAD = 240, MTW = 68;
constexpr int CW_BAR = 4096;

constexpr int RING_BYTES = 131072, LDSCTL_OFF = RING_BYTES, MISC_OFF = LDSCTL_OFF + 320, LDS_BYTES = 147456;

typedef unsigned short bf16;
typedef unsigned v4u __attribute__((ext_vector_type(4)));
typedef unsigned v2u __attribute__((ext_vector_type(2)));
typedef float f32x4 __attribute__((ext_vector_type(4)));
typedef float f32x2 __attribute__((ext_vector_type(2)));
typedef short bf16x8 __attribute__((ext_vector_type(8)));
typedef float f32x16 __attribute__((ext_vector_type(16)));
typedef __bf16 bf16x2_t __attribute__((ext_vector_type(2)));

#define LDS_WAIT() asm volatile("s_waitcnt lgkmcnt(0)" ::: "memory")
#define WAVE_SYNC() do { asm volatile("s_waitcnt lgkmcnt(0)" ::: "memory"); __builtin_amdgcn_wave_barrier(); } while (0)

__device__ __forceinline__ float bflo(unsigned w) { return __uint_as_float(w << 16); }
__device__ __forceinline__ float bfhi(unsigned w) { return __uint_as_float(w & 0xffff0000u); }
__device__ __forceinline__ float bf2f(bf16 h) { return __uint_as_float((unsigned)h << 16); }
__device__ __forceinline__ unsigned pk2(float lo, float hi) { f32x2 v = {lo, hi}; bf16x2_t b = __builtin_convertvector(v, bf16x2_t); return __builtin_bit_cast(unsigned, b); }
__device__ __forceinline__ bf16 f2bf(float f) { return (bf16)(pk2(f, 0.f) & 0xffffu); }
__device__ __forceinline__ float wave_sum(float v) {
#pragma unroll
    for (int o = 1; o < 64; o <<= 1) v += __shfl_xor(v, o);
    return v;
}
__device__ __forceinline__ float wave_max(float v) {
#pragma unroll
    for (int o = 1; o < 64; o <<= 1) v = fmaxf(v, __shfl_xor(v, o));
    return v;
}
__device__ __forceinline__ int wave_sum_i(int v) {
#pragma unroll
    for (int o = 1; o < 64; o <<= 1) v += __shfl_xor(v, o);
    return v;
}
__device__ __forceinline__ float row16_sum(float v) {
    v += __int_as_float(__builtin_amdgcn_update_dpp(0, __float_as_int(v), 0x128, 0xf, 0xf, false));
    v += __int_as_float(__builtin_amdgcn_update_dpp(0, __float_as_int(v), 0x124, 0xf, 0xf, false));
    v += __int_as_float(__builtin_amdgcn_update_dpp(0, __float_as_int(v), 0x122, 0xf, 0xf, false));
    v += __int_as_float(__builtin_amdgcn_update_dpp(0, __float_as_int(v), 0x121, 0xf, 0xf, false));
    return v;
}
__device__ __forceinline__ float silu_f(float x) { return x / (1.f + __expf(-x)); }
__device__ __forceinline__ int prow(int b, int t) { return t >= NMETA ? b * SEQ + (t - NMETA) : XROW0 + b * NMETA + t; }
__device__ __forceinline__ void row_bt(int r, int& b, int& t) { if (r < XROW0) { b = r >> 12; t = (r & 4095) + NMETA; } else { b = (r - XROW0) >> 4; t = (r - XROW0) & 15; } }
__device__ __forceinline__ void unpack8(const v4u w, float (&f)[8]) {
    f[0] = bflo(w.x); f[1] = bfhi(w.x); f[2] = bflo(w.y); f[3] = bfhi(w.y); f[4] = bflo(w.z); f[5] = bfhi(w.z); f[6] = bflo(w.w); f[7] = bfhi(w.w);
}
__device__ __forceinline__ v4u pack8(const float (&f)[8]) { v4u w; w.x = pk2(f[0], f[1]); w.y = pk2(f[2], f[3]); w.z = pk2(f[4], f[5]); w.w = pk2(f[6], f[7]); return w; }

__device__ __forceinline__ void transpose_item(const float* W, int K, int N, int Npad, bf16* WT, LAS float* scr, int item, int lane) {
    const int nblk = Npad / 32, kb = item / nblk, nb = item % nblk, k0 = 64 * kb, n0 = 32 * nb;
    const int n = n0 + (lane & 31); const bool ok = n < N;
#pragma unroll 8
    for (int i = 0; i < 32; ++i) { const int kk = 2 * i + (lane >> 5); scr[kk * 33 + (lane & 31)] = ok ? W[(size_t)(k0 + kk) * N + n] : 0.f; }
    LDS_WAIT(); __builtin_amdgcn_wave_barrier();
    const int c = lane & 7;
#pragma unroll
    for (int j = 0; j < 4; ++j) { const int nn = (lane >> 3) + 8 * j; const LAS float* s = scr + (8 * c) * 33 + nn;
        v4u o; o.x = pk2(s[0 * 33], s[1 * 33]); o.y = pk2(s[2 * 33], s[3 * 33]); o.z = pk2(s[4 * 33], s[5 * 33]); o.w = pk2(s[6 * 33], s[7 * 33]);
        *(v4u*)(WT + (size_t)(n0 + nn) * K + k0 + 8 * c) = o; }
    LDS_WAIT(); __builtin_amdgcn_wave_barrier();
}

struct Ptrs {
    const float *x_prompt, *x_sample, *state_conv_a, *cache_k, *cache_v, *cache_ik, *state_conv_c, *state_delta;
    const int* page_table;
    const float *meta, *w_in_a, *conv_w_a, *w_out_a, *w_in_b, *w_out_b, *w_in_c, *conv_w_c, *a_log, *dt_bias, *norm_w, *w_out_c, *ln1_g, *ln1_b, *w1, *w2, *ln2_g, *ln2_b;
    float* out; unsigned char* ws;
};

__device__ __forceinline__ void p0_prologue(const Ptrs& P, LAS unsigned char* lds, int gw, int NGW, int wave, int lane) {
    LAS float* scr = (LAS float*)(lds + wave * 16384);
    unsigned char* ws = P.ws;
    constexpr int I_A_IN = (DM / 64) * (NA_IN / 32), I_A_OUT = (DM / 64) * (DM / 32), I_B_IN = (DM / 64) * (NB_PAD / 32), I_B_OUT = I_A_OUT,
                  I_C_IN = (DM / 64) * (NC_PAD / 32), I_C_OUT = (DVW / 64) * (DM / 32), I_W1 = (DM / 64) * (FF / 32), I_W2 = (FF / 64) * (DM / 32);
    constexpr int NITEMS = 2 * I_A_IN + 2 * I_A_OUT + I_B_IN + I_B_OUT + I_C_IN + I_C_OUT + 4 * I_W1 + 4 * I_W2;
#define TR_(cnt, Wp, Kk, Nn, Np, WTp) if (r < (cnt)) { transpose_item((Wp), (Kk), (Nn), (Np), (bf16*)(WTp), scr, r, lane); continue; } r -= (cnt);
    for (int it = gw; it < NITEMS; it += NGW) {
        int r = it;
        TR_(I_A_IN, P.w_in_a, DM, NA_IN, NA_IN, ws + WS_WA_IN)
        TR_(I_A_IN, P.w_in_a + (size_t)DM * NA_IN, DM, NA_IN, NA_IN, ws + WS_WA_IN + WSZ_A_IN)
        TR_(I_A_OUT, P.w_out_a, DM, DM, DM, ws + WS_WA_OUT)
        TR_(I_A_OUT, P.w_out_a + (size_t)DM * DM, DM, DM, DM, ws + WS_WA_OUT + WSZ_A_OUT)
        TR_(I_B_IN, P.w_in_b, DM, NB_IN, NB_PAD, ws + WS_WB_IN)
        TR_(I_B_OUT, P.w_out_b, DM, DM, DM, ws + WS_WB_OUT)
        TR_(I_C_IN, P.w_in_c, DM, NC_IN, NC_PAD, ws + WS_WC_IN)
        TR_(I_C_OUT, P.w_out_c, DVW, DM, DM, ws + WS_WC_OUT)
        TR_(I_W1, P.w1, DM, FF, FF, ws + WS_W1)
        TR_(I_W1, P.w1 + (size_t)DM * FF, DM, FF, FF, ws + WS_W1 + WSZ_W1)
        TR_(I_W1, P.w1 + 2 * (size_t)DM * FF, DM, FF, FF, ws + WS_W1 + 2 * WSZ_W1)
        TR_(I_W1, P.w1 + 3 * (size_t)DM * FF, DM, FF, FF, ws + WS_W1 + 3 * WSZ_W1)
        TR_(I_W2, P.w2, FF, DM, DM, ws + WS_W2)
        TR_(I_W2, P.w2 + (size_t)DM * FF, FF, DM, DM, ws + WS_W2 + WSZ_W2)
        TR_(I_W2, P.w2 + 2 * (size_t)DM * FF, FF, DM, DM, ws + WS_W2 + 2 * WSZ_W2)
        transpose_item(P.w2 + 3 * (size_t)DM * FF, FF, DM, DM, (bf16*)(ws + WS_W2 + 3 * WSZ_W2), scr, r, lane);
    }
#undef TR_
    bf16* X = (bf16*)(ws + WS_X);
    for (int r = gw; r < MPAD; r += NGW) {
        const float* src = nullptr;
        if (r < XROW0) src = P.x_prompt + (size_t)r * DM;
        else if (r < SROW0) src = P.meta + (size_t)((r - XROW0) & 15) * DM;
        else if (r < NROWS) src = P.x_sample + (size_t)(r - SROW0) * DM;
#pragma unroll
        for (int j = 0; j < 4; ++j) { const int c = 512 * j + 8 * lane; v4u o = {0u, 0u, 0u, 0u};
            if (src) { const f32x4 a = *(const f32x4*)(src + c), b = *(const f32x4*)(src + c + 4); o.x = pk2(a.x, a.y); o.y = pk2(a.z, a.w); o.z = pk2(b.x, b.y); o.w = pk2(b.z, b.w); }
            *(v4u*)(X + (size_t)r * DM + c) = o; }
    }
    f32x2* t128 = (f32x2*)(ws + WS_TAB128); f32x2* t64 = (f32x2*)(ws + WS_TAB64);
    const int gt = gw * 64 + lane, NGT = NGW * 64;
    for (int e = gt; e < (TP + 1) * 96; e += NGT) {
        const int pi = e / 96, i = e % 96; const float pos = (float)(pi == TP ? PAST : pi);
        const float ex = (i < 64) ? (float)(2 * i) * (1.f / 128.f) : (float)(2 * (i - 64)) * (1.f / 64.f);
        const float inv = __builtin_amdgcn_exp2f(-ex * 13.287712379549449f);
        const float angf = pos * inv;
        double rev = (double)angf * 0.15915494309189535; rev -= __builtin_rint(rev);
        const float rf = (float)rev; const float sn = __builtin_amdgcn_sinf(rf), cs = __builtin_amdgcn_cosf(rf);
        if (i < 64) t128[pi * 64 + i] = (f32x2){cs, sn}; else t64[pi * 32 + (i - 64)] = (f32x2){cs, sn};
    }
}

__device__ __forceinline__ void ln_phase(const float* Z, const float* ZP, bf16* X, bf16* Xo, const float* gam, const float* bet, float* yp, float* ys, int gw, int NGW, int lane) {
    for (int r = gw; r < NROWS; r += NGW) {
        const bool ext = r >= XROW0; const float* zr = ext ? ZP + (size_t)(r - XROW0) * DM : Z + (size_t)r * DM; bf16* xr = X + (size_t)r * DM;
        float v[32]; float s = 0.f;
#pragma unroll
        for (int j = 0; j < 4; ++j) { const int c = 512 * j + 8 * lane; f32x4 z0 = *(const f32x4*)(zr + c), z1 = *(const f32x4*)(zr + c + 4); const v4u xv = *(const v4u*)(xr + c);
            if (ext) {
#pragma unroll
                for (int sl = 1; sl < 8; ++sl) { z0 += *(const f32x4*)(zr + (size_t)sl * XR * DM + c); z1 += *(const f32x4*)(zr + (size_t)sl * XR * DM + c + 4); } }
            float xf[8]; unpack8(xv, xf);
            v[8 * j + 0] = ALPHA * xf[0] + z0.x; v[8 * j + 1] = ALPHA * xf[1] + z0.y; v[8 * j + 2] = ALPHA * xf[2] + z0.z; v[8 * j + 3] = ALPHA * xf[3] + z0.w;
            v[8 * j + 4] = ALPHA * xf[4] + z1.x; v[8 * j + 5] = ALPHA * xf[5] + z1.y; v[8 * j + 6] = ALPHA * xf[6] + z1.z; v[8 * j + 7] = ALPHA * xf[7] + z1.w;
#pragma unroll
            for (int i = 0; i < 8; ++i) s += v[8 * j + i]; }
        const float mean = wave_sum(s) * (1.f / DM); float s2 = 0.f;
#pragma unroll
        for (int i = 0; i < 32; ++i) { v[i] -= mean; s2 += v[i] * v[i]; }
        const float rstd = 1.f / sqrtf(wave_sum(s2) * (1.f / DM) + LN_EPS);
        float* of = nullptr;
        if (yp) { if (r < XROW0) of = yp + (size_t)r * DM; else if (r >= SROW0) of = ys + (size_t)(r - SROW0) * DM; }
#pragma unroll
        for (int j = 0; j < 4; ++j) { const int c = 512 * j + 8 * lane; const f32x4 g0 = *(const f32x4*)(gam + c), g1 = *(const f32x4*)(gam + c + 4), b0 = *(const f32x4*)(bet + c), b1 = *(const f32x4*)(bet + c + 4);
            float o[8];
            o[0] = v[8 * j + 0] * rstd * g0.x + b0.x; o[1] = v[8 * j + 1] * rstd * g0.y + b0.y; o[2] = v[8 * j + 2] * rstd * g0.z + b0.z; o[3] = v[8 * j + 3] * rstd * g0.w + b0.w;
            o[4] = v[8 * j + 4] * rstd * g1.x + b1.x; o[5] = v[8 * j + 5] * rstd * g1.y + b1.y; o[6] = v[8 * j + 6] * rstd * g1.z + b1.z; o[7] = v[8 * j + 7] * rstd * g1.w + b1.w;
            *(v4u*)(Xo + (size_t)r * DM + c) = pack8(o);
            if (of) { *(f32x4*)(of + c) = (f32x4){o[0], o[1], o[2], o[3]}; *(f32x4*)(of + c + 4) = (f32x4){o[4], o[5], o[6], o[7]}; } }
    }
}

__device__ __forceinline__ void load_u(const bf16* BCH, int row, int c0, float (&u)[8]) {
    const v4u cg = *(const v4u*)(BCH + (size_t)row * NA_IN + DM + c0), hh = *(const v4u*)(BCH + (size_t)row * NA_IN + 2 * DM + c0);
    float a[8], b[8]; unpack8(cg, a); unpack8(hh, b);
#pragma unroll
    for (int i = 0; i < 8; ++i) u[i] = a[i] * b[i];
}
__device__ __forceinline__ void convA_phase(const bf16* BCH, bf16* Y, const float* cw, const float* hist, float* outp, float* outs, int gtid, int NT) {
    constexpr int RUN = 8, NRUN = TP / RUN;
    for (int it = gtid; it < (NBP * NRUN + SBN) * 256; it += NT) {
        const int c0 = (it & 255) * 8, ru = it >> 8;
        float w0[8], w1[8], w2[8];
        { const f32x4 a = *(const f32x4*)(cw + c0), b = *(const f32x4*)(cw + c0 + 4); w0[0] = a.x; w0[1] = a.y; w0[2] = a.z; w0[3] = a.w; w0[4] = b.x; w0[5] = b.y; w0[6] = b.z; w0[7] = b.w; }
        { const f32x4 a = *(const f32x4*)(cw + DM + c0), b = *(const f32x4*)(cw + DM + c0 + 4); w1[0] = a.x; w1[1] = a.y; w1[2] = a.z; w1[3] = a.w; w1[4] = b.x; w1[5] = b.y; w1[6] = b.z; w1[7] = b.w; }
        { const f32x4 a = *(const f32x4*)(cw + 2 * DM + c0), b = *(const f32x4*)(cw + 2 * DM + c0 + 4); w2[0] = a.x; w2[1] = a.y; w2[2] = a.z; w2[3] = a.w; w2[4] = b.x; w2[5] = b.y; w2[6] = b.z; w2[7] = b.w; }
        float u0[8], u1[8], u2[8];
        if (ru < NBP * NRUN) {
            const int b = ru / NRUN, t0 = (ru % NRUN) * RUN;
            if (t0 >= 1) load_u(BCH, prow(b, t0 - 1), c0, u1); else {
#pragma unroll
                for (int i = 0; i < 8; ++i) u1[i] = 0.f; }
            if (t0 >= 2) load_u(BCH, prow(b, t0 - 2), c0, u0); else {
#pragma unroll
                for (int i = 0; i < 8; ++i) u0[i] = 0.f; }
            const int r0 = prow(b, t0);
            v4u bq[RUN], cq[RUN], hq_[RUN];
#pragma unroll
            for (int k = 0; k < RUN; ++k) { const bf16* rp = BCH + (size_t)(r0 + k) * NA_IN + c0; bq[k] = *(const v4u*)rp; cq[k] = *(const v4u*)(rp + DM); hq_[k] = *(const v4u*)(rp + 2 * DM); }
#pragma unroll
            for (int k = 0; k < RUN; ++k) {
                const int r = r0 + k, t = t0 + k;
                { float ca[8], ha[8]; unpack8(cq[k], ca); unpack8(hq_[k], ha);
#pragma unroll
                  for (int i = 0; i < 8; ++i) u2[i] = ca[i] * ha[i]; }
                float bg[8]; unpack8(bq[k], bg);
                float y[8];
#pragma unroll
                for (int i = 0; i < 8; ++i) y[i] = bg[i] * (w0[i] * u0[i] + w1[i] * u1[i] + w2[i] * u2[i]);
                *(v4u*)(Y + (size_t)r * DM + c0) = pack8(y);
                if (t >= TP - 2) { float* o = outp + ((size_t)(b * 2 + (t - (TP - 2)))) * DM + c0; *(f32x4*)o = (f32x4){u2[0], u2[1], u2[2], u2[3]}; *(f32x4*)(o + 4) = (f32x4){u2[4], u2[5], u2[6], u2[7]}; }
#pragma unroll
                for (int i = 0; i < 8; ++i) { u0[i] = u1[i]; u1[i] = u2[i]; }
            }
        } else {
            const int sb = ru - NBP * NRUN, r = SROW0 + sb;
            load_u(BCH, r, c0, u2);
            const float* h0 = hist + ((size_t)(sb * 2 + 0)) * DM + c0; const float* h1 = hist + ((size_t)(sb * 2 + 1)) * DM + c0;
            const f32x4 a0 = *(const f32x4*)h0, a1 = *(const f32x4*)(h0 + 4), b0 = *(const f32x4*)h1, b1 = *(const f32x4*)(h1 + 4);
            u0[0] = a0.x; u0[1] = a0.y; u0[2] = a0.z; u0[3] = a0.w; u0[4] = a1.x; u0[5] = a1.y; u0[6] = a1.z; u0[7] = a1.w;
            u1[0] = b0.x; u1[1] = b0.y; u1[2] = b0.z; u1[3] = b0.w; u1[4] = b1.x; u1[5] = b1.y; u1[6] = b1.z; u1[7] = b1.w;
            float* o0 = outs + ((size_t)(sb * 2 + 0)) * DM + c0; float* o1 = outs + ((size_t)(sb * 2 + 1)) * DM + c0;
            *(f32x4*)o0 = b0; *(f32x4*)(o0 + 4) = b1;
            *(f32x4*)o1 = (f32x4){u2[0], u2[1], u2[2], u2[3]}; *(f32x4*)(o1 + 4) = (f32x4){u2[4], u2[5], u2[6], u2[7]};
            float bg[8]; unpack8(*(const v4u*)(BCH + (size_t)r * NA_IN + c0), bg);
            float y[8];
#pragma unroll
            for (int i = 0; i < 8; ++i) y[i] = bg[i] * (w0[i] * u0[i] + w1[i] * u1[i] + w2[i] * u2[i]);
            *(v4u*)(Y + (size_t)r * DM + c0) = pack8(y);
        }
    }
}

constexpr float QSCALE = 0.08838834764831845f;
__device__ __forceinline__ void rope_phase(const bf16* PROJ, const Ptrs& P, int gw, int NGW, int lane) {
    unsigned char* ws = P.ws;
    const f32x2* t128 = (const f32x2*)(ws + WS_TAB128); const f32x2* t64 = (const f32x2*)(ws + WS_TAB64);
    bf16* Qr = (bf16*)(ws + WS_QR); bf16* QI = (bf16*)(ws + WS_QI); bf16* KIb = (bf16*)(ws + WS_KIB); float* WI = (float*)(ws + WS_WI);
    bf16* Ks = (bf16*)(ws + WS_KS); bf16* Vs = (bf16*)(ws + WS_VS);
    for (int pr_ = gw; pr_ < NBP * SPAD; pr_ += NGW) {
        const size_t o = ((size_t)((pr_ / SPAD) * SP + (pr_ % SPAD))) * 512 + 8 * lane; *(v4u*)(Ks + o) = (v4u){0u, 0u, 0u, 0u}; *(v4u*)(Vs + o) = (v4u){0u, 0u, 0u, 0u}; }
    for (int r = gw; r < NROWS; r += NGW) {
        const bf16* pr = PROJ + (size_t)r * NB_PAD;
        int pi; float *ko, *vo, *iko; bf16* kib = nullptr; bf16 *ksq = nullptr, *vsq = nullptr;
        if (r < SROW0) { int b, t; row_bt(r, b, t); pi = t; ksq = Ks + ((size_t)(b * SP + t + SPAD)) * 512; vsq = Vs + ((size_t)(b * SP + t + SPAD)) * 512; ko = P.out + O_KP + ((size_t)(b * TP + t)) * 512; vo = P.out + O_VP + ((size_t)(b * TP + t)) * 512; iko = P.out + O_IKP + ((size_t)(b * TP + t)) * 64; kib = KIb + ((size_t)(b * KIROWS + t)) * 64; }
        else { const int sb = r - SROW0; pi = POS_SAMPLE_IDX; ko = P.out + O_KS + (size_t)sb * 512; vo = P.out + O_VS + (size_t)sb * 512; iko = P.out + O_IKS + (size_t)sb * 64; }
        const f32x2* c128 = t128 + (size_t)pi * 64; const f32x2* c64 = t64 + (size_t)pi * 32;
        const int hd = lane >> 2, sub = lane & 3;
        {
            float x1[16], x2[16], o1[16], o2[16];
            { float t8[8]; unpack8(*(const v4u*)(pr + hd * 128 + 16 * sub), t8);
#pragma unroll
              for (int i = 0; i < 8; ++i) x1[i] = t8[i]; unpack8(*(const v4u*)(pr + hd * 128 + 16 * sub + 8), t8);
#pragma unroll
              for (int i = 0; i < 8; ++i) x1[8 + i] = t8[i]; unpack8(*(const v4u*)(pr + hd * 128 + 64 + 16 * sub), t8);
#pragma unroll
              for (int i = 0; i < 8; ++i) x2[i] = t8[i]; unpack8(*(const v4u*)(pr + hd * 128 + 64 + 16 * sub + 8), t8);
#pragma unroll
              for (int i = 0; i < 8; ++i) x2[8 + i] = t8[i]; }
#pragma unroll
            for (int i = 0; i < 16; i += 2) { const f32x4 cs = *(const f32x4*)(c128 + 16 * sub + i);
                o1[i] = (x1[i] * cs.x - x2[i] * cs.y) * QSCALE; o2[i] = (x2[i] * cs.x + x1[i] * cs.y) * QSCALE;
                o1[i + 1] = (x1[i + 1] * cs.z - x2[i + 1] * cs.w) * QSCALE; o2[i + 1] = (x2[i + 1] * cs.z + x1[i + 1] * cs.w) * QSCALE; }
            bf16* qo = Qr + (size_t)r * DM + hd * 128 + 16 * sub;
            { float t8[8];
#pragma unroll
              for (int i = 0; i < 8; ++i) t8[i] = o1[i]; *(v4u*)qo = pack8(t8);
#pragma unroll
              for (int i = 0; i < 8; ++i) t8[i] = o1[8 + i]; *(v4u*)(qo + 8) = pack8(t8);
#pragma unroll
              for (int i = 0; i < 8; ++i) t8[i] = o2[i]; *(v4u*)(qo + 64) = pack8(t8);
#pragma unroll
              for (int i = 0; i < 8; ++i) t8[i] = o2[8 + i]; *(v4u*)(qo + 72) = pack8(t8); }
        }
        if (lane < 16) {
            const bf16* kp = pr + 2048 + hd * 128 + 16 * sub;
#pragma unroll
            for (int hf = 0; hf < 2; ++hf) { float x1[8], x2[8], o1[8], o2[8]; unpack8(*(const v4u*)(kp + 8 * hf), x1); unpack8(*(const v4u*)(kp + 64 + 8 * hf), x2);
#pragma unroll
                for (int i = 0; i < 8; i += 2) { const f32x4 cs = *(const f32x4*)(c128 + 16 * sub + 8 * hf + i);
                    o1[i] = x1[i] * cs.x - x2[i] * cs.y; o2[i] = x2[i] * cs.x + x1[i] * cs.y; o1[i + 1] = x1[i + 1] * cs.z - x2[i + 1] * cs.w; o2[i + 1] = x2[i + 1] * cs.z + x1[i + 1] * cs.w; }
                float* kq = ko + hd * 128 + 16 * sub + 8 * hf;
                *(f32x4*)kq = (f32x4){o1[0], o1[1], o1[2], o1[3]}; *(f32x4*)(kq + 4) = (f32x4){o1[4], o1[5], o1[6], o1[7]};
                *(f32x4*)(kq + 64) = (f32x4){o2[0], o2[1], o2[2], o2[3]}; *(f32x4*)(kq + 68) = (f32x4){o2[4], o2[5], o2[6], o2[7]};
                if (ksq) { *(v4u*)(ksq + hd * 128 + 16 * sub + 8 * hf) = pack8(o1); *(v4u*)(ksq + hd * 128 + 64 + 16 * sub + 8 * hf) = pack8(o2); } }
        }
        {
            const v4u vv = *(const v4u*)(pr + 2560 + 8 * lane); float vf[8]; unpack8(vv, vf);
            *(f32x4*)(vo + 8 * lane) = (f32x4){vf[0], vf[1], vf[2], vf[3]}; *(f32x4*)(vo + 8 * lane + 4) = (f32x4){vf[4], vf[5], vf[6], vf[7]};
            if (vsq) *(v4u*)(vsq + 8 * lane) = vv;
        }
        {
            float x1[8], x2[8], o1[8], o2[8]; unpack8(*(const v4u*)(pr + 3072 + hd * 64 + 8 * sub), x1); unpack8(*(const v4u*)(pr + 3072 + hd * 64 + 32 + 8 * sub), x2);
#pragma unroll
            for (int i = 0; i < 8; i += 2) { const f32x4 cs = *(const f32x4*)(c64 + 8 * sub + i);
                o1[i] = x1[i] * cs.x - x2[i] * cs.y; o2[i] = x2[i] * cs.x + x1[i] * cs.y; o1[i + 1] = x1[i + 1] * cs.z - x2[i + 1] * cs.w; o2[i + 1] = x2[i + 1] * cs.z + x1[i + 1] * cs.w; }
            *(v4u*)(QI + (size_t)r * 1024 + hd * 64 + 8 * sub) = pack8(o1); *(v4u*)(QI + (size_t)r * 1024 + hd * 64 + 32 + 8 * sub) = pack8(o2);
        }
        if (lane < 4) {
            float x1[8], x2[8], o1[8], o2[8]; unpack8(*(const v4u*)(pr + 4096 + 8 * sub), x1); unpack8(*(const v4u*)(pr + 4096 + 32 + 8 * sub), x2);
#pragma unroll
            for (int i = 0; i < 8; i += 2) { const f32x4 cs = *(const f32x4*)(c64 + 8 * sub + i);
                o1[i] = x1[i] * cs.x - x2[i] * cs.y; o2[i] = x2[i] * cs.x + x1[i] * cs.y; o1[i + 1] = x1[i + 1] * cs.z - x2[i + 1] * cs.w; o2[i + 1] = x2[i + 1] * cs.z + x1[i + 1] * cs.w; }
            float* io = iko + 8 * sub;
            *(f32x4*)io = (f32x4){o1[0], o1[1], o1[2], o1[3]}; *(f32x4*)(io + 4) = (f32x4){o1[4], o1[5], o1[6], o1[7]};
            *(f32x4*)(io + 32) = (f32x4){o2[0], o2[1], o2[2], o2[3]}; *(f32x4*)(io + 36) = (f32x4){o2[4], o2[5], o2[6], o2[7]};
            if (kib) { *(v4u*)(kib + 8 * sub) = pack8(o1); *(v4u*)(kib + 32 + 8 * sub) = pack8(o2); }
        } else if (lane < 6) {
            float wv[8]; unpack8(*(const v4u*)(pr + 4160 + 8 * (lane - 4)), wv); float* wo = WI + (size_t)r * 16 + 8 * (lane - 4);
            *(f32x4*)wo = (f32x4){wv[0], wv[1], wv[2], wv[3]}; *(f32x4*)(wo + 4) = (f32x4){wv[4], wv[5], wv[6], wv[7]};
        }
    }
}

__device__ __forceinline__ void indexer_prompt(const Ptrs& P, int gw, int NGW, int lane) {
    unsigned char* ws = P.ws;
    const bf16* QI = (const bf16*)(ws + WS_QI); const bf16* KIb = (const bf16*)(ws + WS_KIB); const float* WI = (const float*)(ws + WS_WI); float* SC = (float*)(ws + WS_SC);
    const int n = lane & 31, h8 = lane >> 5;
    const int qsel = (n >> 2) & 1, head = (n & 3) + 4 * (n >> 3);
    constexpr int NIT = NBP * (TP / 2);
    for (int k = gw; k < NIT; k += NGW) {
        const int idx = (k < NIT / 2) ? k : (NIT - 1) - (k - NIT / 2);
        const int b = idx & 1, p = idx >> 1, t0 = 2 * p;
        const bf16* qa = QI + (size_t)prow(b, t0 + qsel) * 1024 + head * 64 + 8 * h8;
        bf16x8 a[4];
#pragma unroll
        for (int kk = 0; kk < 4; ++kk) a[kk] = *(const bf16x8*)(qa + 16 * kk);
        const int tq = t0 + h8;
        const float* wp = WI + (size_t)prow(b, tq) * 16;
        float w[16];
#pragma unroll
        for (int i = 0; i < 4; ++i) { const f32x4 x = *(const f32x4*)(wp + 4 * i); w[4 * i] = x.x; w[4 * i + 1] = x.y; w[4 * i + 2] = x.z; w[4 * i + 3] = x.w; }
        const int ntile = ((t0 + 1) >> 5) + 1;
        const bf16* kb = KIb + ((size_t)b * KIROWS + n) * 64 + 8 * h8;
        float* scrow = SC + ((size_t)(b * TP + tq)) * SCW;
        for (int kt0 = 0; kt0 < ntile; kt0 += 4) {
            bf16x8 bb[4][4];
#pragma unroll
            for (int u = 0; u < 4; ++u) { const int ktc = (kt0 + u < 129) ? kt0 + u : 128; const bf16* kp = kb + (size_t)ktc * 32 * 64;
#pragma unroll
                for (int kk = 0; kk < 4; ++kk) bb[u][kk] = *(const bf16x8*)(kp + 16 * kk); }
#pragma unroll
            for (int u = 0; u < 4; ++u) {
                f32x16 acc;
#pragma unroll
                for (int i = 0; i < 16; ++i) acc[i] = 0.f;
#pragma unroll
                for (int kk = 0; kk < 4; ++kk) acc = __builtin_amdgcn_mfma_f32_32x32x16_bf16(a[kk], bb[u][kk], acc, 0, 0, 0);
                float sc = 0.f;
#pragma unroll
                for (int i = 0; i < 16; ++i) sc += w[i] * fmaxf(acc[i], 0.f);
                const int s = 32 * (kt0 + u) + n;
                if (s <= tq) scrow[s] = sc;
            }
        }
    }
}

__device__ __forceinline__ void indexer_sample(const Ptrs& P, LAS unsigned char* lds, int tid) {
    unsigned char* ws = P.ws;
    const bf16* QI = (const bf16*)(ws + WS_QI); const float* WI = (const float*)(ws + WS_WI); float* SCS = (float*)(ws + WS_SCS);
    LAS float* lq = (LAS float*)lds;
    LAS float* lw = lq + 1024;
    constexpr int NCH = (NSKEY + 511) / 512;
    for (int item = blockIdx.x; item < SBN * NCH; item += gridDim.x) {
        const int sb = item / NCH, ch = item % NCH, r = SROW0 + sb;
        __syncthreads();
        for (int e = tid; e < 1024; e += NTHREADS) lq[e] = bf2f(QI[(size_t)r * 1024 + e]);
        if (tid < 16) lw[tid] = WI[(size_t)r * 16 + tid];
        __syncthreads();
        const int s = ch * 512 + tid;
        if (s < NSKEY) {
            const float* kr = (s < PAST) ? P.cache_ik + ((size_t)P.page_table[sb * NPG + (s >> 7)] * 128 + (s & 127)) * 64 : P.out + O_IKS + (size_t)sb * 64;
            f32x4 kv[16];
#pragma unroll
            for (int i = 0; i < 16; ++i) kv[i] = *(const f32x4*)(kr + 4 * i);
            float sc = 0.f;
            for (int h = 0; h < 16; ++h) { float d = 0.f;
#pragma unroll
                for (int i = 0; i < 16; ++i) { const f32x4 q = *(const LAS f32x4*)(lq + h * 64 + 4 * i); d += q.x * kv[i].x + q.y * kv[i].y + q.z * kv[i].z + q.w * kv[i].w; }
                sc += lw[h] * fmaxf(d, 0.f); }
            SCS[(size_t)sb * SCSW + s] = sc;
        }
    }
    __syncthreads();
}

__device__ __forceinline__ unsigned ordkey(float f) { const unsigned u = __float_as_uint(f); return (u & 0x80000000u) ? ~u : (u | 0x80000000u); }
constexpr int TOPK = 256;
__device__ __forceinline__ void topk_wave_mask(const float* sc, int n, unsigned long long* mrow, int lane) {
    constexpr int NS = MTW, M0 = SPAD / 64;
    static_assert(M0 == dattn::JLO, "first real key tile");
    unsigned key[NS];
#pragma unroll
    for (int m = M0; m < NS; ++m) { const int sidx = lane + 64 * m - SPAD; const int ci = sidx < 0 ? 0 : (sidx < n ? sidx : n - 1); const float v = sc[ci]; key[m] = (sidx >= 0 && sidx < n) ? ordkey(v) : 0u; }
    if (n <= TOPK) {
#pragma unroll
        for (int m = M0; m < NS; ++m) { const unsigned long long w = __ballot(key[m] != 0u); if (lane == 0) mrow[m] = w; }
        return;
    }
    unsigned T = 0u;
    for (int bit = 31; bit >= 0; --bit) {
        const unsigned cand = T | (1u << bit); int c = 0;
#pragma unroll
        for (int m = M0; m < NS; ++m) c += __popcll(__ballot(key[m] >= cand));
        if (c >= TOPK) T = cand;
    }
    int cg = 0;
#pragma unroll
    for (int m = M0; m < NS; ++m) cg += __popcll(__ballot(key[m] > T));
    const int need = TOPK - cg;
    int base_e = 0;
    const unsigned long long lt = (1ull << lane) - 1ull;
#pragma unroll
    for (int m = M0; m < NS; ++m) {
        const bool pg = key[m] > T, pe = key[m] == T;
        const unsigned long long me = __ballot(pe);
        const int pre_e = __popcll(me & lt);
        const unsigned long long w = __ballot(pg || (pe && (base_e + pre_e) < need));
        if (lane == 0) mrow[m] = w;
        base_e += __popcll(me);
    }
}
__device__ __forceinline__ void topk_block(const float* sc, int n, int* outIdx, int* outCnt, LAS unsigned* ls, int tid, int wave, int lane) {
    constexpr int NS = (NSKEY + NTHREADS - 1) / NTHREADS;
    unsigned key[NS];
#pragma unroll
    for (int m = 0; m < NS; ++m) { const int e = tid + NTHREADS * m; const float v = sc[e < n ? e : n - 1]; key[m] = (e < n) ? ordkey(v) : 0u; }
    unsigned T = 0u;
    for (int bit = 31; bit >= 0; --bit) {
        const unsigned cand = T | (1u << bit); int c = 0;
#pragma unroll
        for (int m = 0; m < NS; ++m) c += (key[m] >= cand) ? 1 : 0;
        c = wave_sum_i(c);
        LAS unsigned* buf = ls + (bit & 1) * 8;
        if (lane == 0) buf[wave] = (unsigned)c;
        __syncthreads();
        int tot = 0;
#pragma unroll
        for (int w = 0; w < 8; ++w) tot += (int)buf[w];
        if (tot >= TOPK) T = cand;
    }
    __syncthreads();
    if (tid == 0) { unsigned z_ = 0u; asm volatile("" : "+v"(z_)); ls[16] = z_; ls[17] = z_; }
    __syncthreads();
#pragma unroll
    for (int m = 0; m < NS; ++m) { const int e = tid + NTHREADS * m; if (key[m] > T) { const unsigned pos = atomicAdd((unsigned*)(ls + 16), 1u); if (pos < (unsigned)TOPK) outIdx[pos] = e; } }
    __syncthreads();
    const unsigned cg = ls[16];
    const unsigned need = (unsigned)TOPK - cg;
#pragma unroll
    for (int m = 0; m < NS; ++m) { const int e = tid + NTHREADS * m; if (key[m] == T) { const unsigned pos = atomicAdd((unsigned*)(ls + 17), 1u); if (pos < need) outIdx[cg + pos] = e; } }
    if (tid == 0) *outCnt = TOPK;
    __syncthreads();
}
__device__ __forceinline__ void select_phase(const Ptrs& P, LAS unsigned char* lds, int gw, int NGW, int tid, int wave, int lane) {
    unsigned char* ws = P.ws;
    const float* SC = (const float*)(ws + WS_SC); const float* SCS = (const float*)(ws + WS_SCS); int* IDXL = (int*)(ws + WS_IDXL); int* CNT = (int*)(ws + WS_CNT);
    for (int sb = blockIdx.x; sb < SBN; sb += gridDim.x) topk_block(SCS + (size_t)sb * SCSW, NSKEY, IDXL + (size_t)(SROW0 + sb) * TOPK, CNT + SROW0 + sb, (LAS unsigned*)lds, tid, wave, lane);
    unsigned long long* MASK = (unsigned long long*)(ws + WS_MASK);
    for (int r = gw; r < SROW0; r += NGW) { int b, t; row_bt(r, b, t);
        if (r < XROW0) topk_wave_mask(SC + ((size_t)(b * TP + t)) * SCW, t + 1, MASK + ((size_t)(b * SP + t + SPAD)) * MTW, lane);
        else { if (lane <= t) IDXL[(size_t)r * TOPK + lane] = lane; if (lane == 0) CNT[r] = t + 1; } }
}

__device__ __forceinline__ void attn_phase(const Ptrs& P, bf16* O, LAS unsigned char* lds, int gw, int NGW, int wave, int lane) {
    unsigned char* ws = P.ws;
    const bf16* Qr = (const bf16*)(ws + WS_QR); const int* IDXL = (const int*)(ws + WS_IDXL); const int* CNT = (const int*)(ws + WS_CNT);
    LAS float* lq = (LAS float*)(lds + wave * 12288);
    LAS f32x4* lp = (LAS f32x4*)(lds + wave * 12288 + 2048);
    LAS unsigned long long* lkp = (LAS unsigned long long*)(lds + wave * 12288 + 6144);
    LAS unsigned long long* lvp = (LAS unsigned long long*)(lds + wave * 12288 + 8192);
    for (int item = gw; item < (NROWS - XROW0) * 4; item += NGW) {
        const int r = XROW0 + (item >> 2), n = item & 3;
        const int cnt = CNT[r];
        WAVE_SYNC();
        { float qf[8]; unpack8(*(const v4u*)(Qr + (size_t)r * DM + n * 512 + 8 * lane), qf);
          *(LAS f32x4*)(lq + 8 * lane) = (f32x4){qf[0], qf[1], qf[2], qf[3]}; *(LAS f32x4*)(lq + 8 * lane + 4) = (f32x4){qf[4], qf[5], qf[6], qf[7]}; }
        const float* kp[4];
#pragma unroll
        for (int j = 0; j < 4; ++j) {
            const int e = lane + 64 * j; const int s = (e < cnt) ? IDXL[(size_t)r * TOPK + e] : 0;
            const float *kq, *vq;
            if (r < SROW0) { const int b = (r < XROW0) ? (r >> 12) : ((r - XROW0) >> 4); kq = P.out + O_KP + ((size_t)(b * TP + s)) * 512; vq = P.out + O_VP + ((size_t)(b * TP + s)) * 512; }
            else { const int sb = r - SROW0;
                if (s < PAST) { const size_t off = ((size_t)P.page_table[sb * NPG + (s >> 7)] * 128 + (s & 127)) * 512; kq = P.cache_k + off; vq = P.cache_v + off; }
                else { kq = P.out + O_KS + (size_t)sb * 512; vq = P.out + O_VS + (size_t)sb * 512; } }
            kp[j] = kq + n * 128; lkp[e] = (unsigned long long)(kq + n * 128); lvp[e] = (unsigned long long)(vq + n * 128);
        }
        WAVE_SYNC();
        float acc[4][4];
#pragma unroll
        for (int g = 0; g < 4; ++g)
#pragma unroll
            for (int j = 0; j < 4; ++j) acc[g][j] = 0.f;
#pragma unroll 4
        for (int d4 = 0; d4 < 32; ++d4) {
            f32x4 qv[4];
#pragma unroll
            for (int g = 0; g < 4; ++g) qv[g] = *(const LAS f32x4*)(lq + g * 128 + 4 * d4);
#pragma unroll
            for (int j = 0; j < 4; ++j) { const f32x4 kv = *(const f32x4*)(kp[j] + 4 * d4);
#pragma unroll
                for (int g = 0; g < 4; ++g) acc[g][j] += qv[g].x * kv.x + qv[g].y * kv.y + qv[g].z * kv.z + qv[g].w * kv.w; }
        }
        float linv[4];
#pragma unroll
        for (int g = 0; g < 4; ++g) {
            float m = -INFINITY;
#pragma unroll
            for (int j = 0; j < 4; ++j) { if (lane + 64 * j >= cnt) acc[g][j] = -INFINITY; m = fmaxf(m, acc[g][j]); }
            m = wave_max(m); float l = 0.f;
#pragma unroll
            for (int j = 0; j < 4; ++j) { acc[g][j] = __expf(acc[g][j] - m); l += acc[g][j]; }
            linv[g] = 1.f / wave_sum(l);
        }
#pragma unroll
        for (int j = 0; j < 4; ++j) lp[lane + 64 * j] = (f32x4){acc[0][j], acc[1][j], acc[2][j], acc[3][j]};
        WAVE_SYNC();
        float o[4][2];
#pragma unroll
        for (int g = 0; g < 4; ++g) { o[g][0] = 0.f; o[g][1] = 0.f; }
#pragma unroll 8
        for (int e = 0; e < cnt; ++e) {
            const float* vp = (const float*)lvp[e]; const f32x2 vv = *(const f32x2*)(vp + 2 * lane); const f32x4 p = lp[e];
            o[0][0] += p.x * vv.x; o[0][1] += p.x * vv.y; o[1][0] += p.y * vv.x; o[1][1] += p.y * vv.y; o[2][0] += p.z * vv.x; o[2][1] += p.z * vv.y; o[3][0] += p.w * vv.x; o[3][1] += p.w * vv.y;
        }
#pragma unroll
        for (int g = 0; g < 4; ++g) *(unsigned*)(O + (size_t)r * DM + (4 * n + g) * 128 + 2 * lane) = pk2(o[g][0] * linv[g], o[g][1] * linv[g]);
    }
}

__device__ __forceinline__ void convC_finish(float (&acc)[8], int it) {
    float ss = 0.f;
#pragma unroll
    for (int i = 0; i < 8; ++i) { acc[i] = silu_f(acc[i]); ss += acc[i] * acc[i]; }
    if (it < 8) { ss = row16_sum(ss); float rn = 1.f / sqrtf(ss + RMS_EPS); if (it < 4) rn *= QSCALE;
#pragma unroll
        for (int i = 0; i < 8; ++i) acc[i] *= rn; }
}
__device__ __forceinline__ void convC_phase(const bf16* PROJC, const Ptrs& P, int gw, int NGW, int lane) {
    unsigned char* ws = P.ws;
    bf16* QKVC = (bf16*)(ws + WS_QKVC); float* QKF = (float*)(ws + WS_QKF); float* G = (float*)(ws + WS_G); float* BETA = (float*)(ws + WS_BETA);
    const float* cw = P.conv_w_c;
    constexpr int RUN = 8, NRUN = TP / RUN;
    for (int item = gw; item < 16 * NBP * NRUN; item += NGW) {
        const int it = item & 15, ru = item >> 4, b = ru / NRUN, t0 = (ru % NRUN) * RUN, ch0 = it * 512 + 8 * lane;
        float w[4][8];
#pragma unroll
        for (int j = 0; j < 4; ++j) { const f32x4 w0 = *(const f32x4*)(cw + (size_t)j * CDIM + ch0), w1 = *(const f32x4*)(cw + (size_t)j * CDIM + ch0 + 4);
            w[j][0] = w0.x; w[j][1] = w0.y; w[j][2] = w0.z; w[j][3] = w0.w; w[j][4] = w1.x; w[j][5] = w1.y; w[j][6] = w1.z; w[j][7] = w1.w; }
        const int r0 = prow(b, t0);
        v4u xr[RUN + 3];
#pragma unroll
        for (int j = 0; j < 3; ++j) { const int tt = t0 - 3 + j; xr[j] = tt >= 0 ? *(const v4u*)(PROJC + (size_t)prow(b, tt) * NC_PAD + ch0) : (v4u){0u, 0u, 0u, 0u}; }
#pragma unroll
        for (int k = 0; k < RUN; ++k) xr[3 + k] = *(const v4u*)(PROJC + (size_t)(r0 + k) * NC_PAD + ch0);
        float x[RUN + 3][8];
#pragma unroll
        for (int j = 0; j < RUN + 3; ++j) unpack8(xr[j], x[j]);
#pragma unroll
        for (int k = 0; k < RUN; ++k) {
            float acc[8];
#pragma unroll
            for (int i = 0; i < 8; ++i) acc[i] = w[0][i] * x[k][i] + w[1][i] * x[k + 1][i] + w[2][i] * x[k + 2][i] + w[3][i] * x[k + 3][i];
            convC_finish(acc, it);
            *(v4u*)(QKVC + (size_t)(r0 + k) * CDIM + ch0) = pack8(acc);
            const int t = t0 + k;
            if (t >= TP - 3) { float* o = P.out + O_CCP + ((size_t)(b * 3 + (t - (TP - 3)))) * CDIM + ch0;
                *(f32x4*)o = (f32x4){x[k + 3][0], x[k + 3][1], x[k + 3][2], x[k + 3][3]}; *(f32x4*)(o + 4) = (f32x4){x[k + 3][4], x[k + 3][5], x[k + 3][6], x[k + 3][7]}; }
        }
    }
    for (int item = gw; item < 16 * SBN; item += NGW) {
        const int it = item & 15, sb = item >> 4, r = SROW0 + sb, ch0 = it * 512 + 8 * lane;
        float x[4][8];
#pragma unroll
        for (int j = 0; j < 3; ++j) { const float* hp = P.state_conv_c + ((size_t)(sb * 3 + j)) * CDIM + ch0; const f32x4 a = *(const f32x4*)hp, c = *(const f32x4*)(hp + 4);
            x[j][0] = a.x; x[j][1] = a.y; x[j][2] = a.z; x[j][3] = a.w; x[j][4] = c.x; x[j][5] = c.y; x[j][6] = c.z; x[j][7] = c.w; }
        unpack8(*(const v4u*)(PROJC + (size_t)r * NC_PAD + ch0), x[3]);
        float acc[8];
#pragma unroll
        for (int i = 0; i < 8; ++i) acc[i] = 0.f;
#pragma unroll
        for (int j = 0; j < 4; ++j) { const f32x4 w0 = *(const f32x4*)(cw + (size_t)j * CDIM + ch0), w1 = *(const f32x4*)(cw + (size_t)j * CDIM + ch0 + 4);
            acc[0] += w0.x * x[j][0]; acc[1] += w0.y * x[j][1]; acc[2] += w0.z * x[j][2]; acc[3] += w0.w * x[j][3];
            acc[4] += w1.x * x[j][4]; acc[5] += w1.y * x[j][5]; acc[6] += w1.z * x[j][6]; acc[7] += w1.w * x[j][7]; }
        convC_finish(acc, it);
        if (it < 8) { float* qk = QKF + (size_t)r * 4096 + ch0; *(f32x4*)qk = (f32x4){acc[0], acc[1], acc[2], acc[3]}; *(f32x4*)(qk + 4) = (f32x4){acc[4], acc[5], acc[6], acc[7]}; }
        *(v4u*)(QKVC + (size_t)r * CDIM + ch0) = pack8(acc);
        float* o = P.out + O_CCS + ((size_t)(sb * 3)) * CDIM + ch0;
#pragma unroll
        for (int j = 0; j < 3; ++j) { *(f32x4*)(o + (size_t)j * CDIM) = (f32x4){x[j + 1][0], x[j + 1][1], x[j + 1][2], x[j + 1][3]}; *(f32x4*)(o + (size_t)j * CDIM + 4) = (f32x4){x[j + 1][4], x[j + 1][5], x[j + 1][6], x[j + 1][7]}; }
    }
    for (int e = gw * 64 + lane; e < NROWS * 32; e += NGW * 64) {
        const int r = e >> 5, h = e & 31;
        const float braw = bf2f(PROJC[(size_t)r * NC_PAD + 12288 + h]), araw = bf2f(PROJC[(size_t)r * NC_PAD + 12320 + h]);
        const float xx = araw + P.dt_bias[h]; const float sp = xx > 20.f ? xx : __logf(1.f + __expf(xx));
        G[e] = -__expf(P.a_log[h]) * sp; BETA[e] = 1.f / (1.f + __expf(-braw));
    }
}

struct Tok { f32x4 k0, k1, q0, q1; unsigned v; float g, b; };
__device__ __forceinline__ void tok_load(Tok& T, const float* QKF, const bf16* QKVC, const float* G, const float* BETA, int row, int h, int rg, int col0) {
    const float* base = QKF + (size_t)row * 4096 + (h >> 1) * 128 + 8 * rg;
    T.q0 = *(const f32x4*)base; T.q1 = *(const f32x4*)(base + 4); T.k0 = *(const f32x4*)(base + 2048); T.k1 = *(const f32x4*)(base + 2052);
    T.v = *(const unsigned*)(QKVC + (size_t)row * CDIM + 4096 + h * 128 + col0);
    T.g = G[(size_t)row * 32 + h]; T.b = BETA[(size_t)row * 32 + h];
}
__device__ __forceinline__ f32x2 tok_step(f32x2 (&S)[8], const Tok& T) {
    const float kk[8] = {T.k0.x, T.k0.y, T.k0.z, T.k0.w, T.k1.x, T.k1.y, T.k1.z, T.k1.w};
    const float qq[8] = {T.q0.x, T.q0.y, T.q0.z, T.q0.w, T.q1.x, T.q1.y, T.q1.z, T.q1.w};
    const float a = __expf(T.g);
    f32x2 d0 = S[0] * kk[0], d1 = S[1] * kk[1];
#pragma unroll
    for (int i = 2; i < 8; i += 2) { d0 += S[i] * kk[i]; d1 += S[i + 1] * kk[i + 1]; }
    f32x2 d = d0 + d1;
    d.x = row16_sum(d.x); d.y = row16_sum(d.y);
    const f32x2 tv = {bflo(T.v), bfhi(T.v)};
    const f32x2 dl = (tv - d * a) * T.b;
    f32x2 o0 = {0.f, 0.f}, o1 = {0.f, 0.f};
#pragma unroll
    for (int i = 0; i < 8; i += 2) { S[i] = S[i] * a + dl * kk[i]; o0 += S[i] * qq[i]; S[i + 1] = S[i + 1] * a + dl * kk[i + 1]; o1 += S[i + 1] * qq[i + 1]; }
    f32x2 o = o0 + o1;
    o.x = row16_sum(o.x); o.y = row16_sum(o.y);
    return o;
}
constexpr int DBK = 2;
__device__ __forceinline__ void delta_segment(f32x2 (&S)[8], const float* QKF, const bf16* QKVC, const float* G, const float* BETA, float* OF, int rowbase, int ntok, int h, int rg, int col0) {
    Tok A[DBK], B[DBK];
#pragma unroll
    for (int i = 0; i < DBK; ++i) tok_load(A[i], QKF, QKVC, G, BETA, rowbase + i, h, rg, col0);
    for (int t0 = 0; t0 < ntok; t0 += 2 * DBK) {
        f32x2 o[DBK];
#pragma unroll
        for (int i = 0; i < DBK; ++i) tok_load(B[i], QKF, QKVC, G, BETA, rowbase + t0 + DBK + i, h, rg, col0);
#pragma unroll
        for (int i = 0; i < DBK; ++i) o[i] = tok_step(S, A[i]);
        if (rg == 0) {
#pragma unroll
            for (int i = 0; i < DBK; ++i) *(f32x2*)(OF + (size_t)(rowbase + t0 + i) * DVW + h * 128 + col0) = o[i]; }
        if (t0 + 2 * DBK < ntok) {
#pragma unroll
            for (int i = 0; i < DBK; ++i) tok_load(A[i], QKF, QKVC, G, BETA, rowbase + t0 + 2 * DBK + i, h, rg, col0); }
#pragma unroll
        for (int i = 0; i < DBK; ++i) o[i] = tok_step(S, B[i]);
        if (rg == 0) {
#pragma unroll
            for (int i = 0; i < DBK; ++i) *(f32x2*)(OF + (size_t)(rowbase + t0 + DBK + i) * DVW + h * 128 + col0) = o[i]; }
    }
}
__device__ __forceinline__ void delta_phase(const Ptrs& P, int wave, int lane) {
    unsigned char* ws = P.ws;
    const bf16* QKVC = (const bf16*)(ws + WS_QKVC); const float* QKF = (const float*)(ws + WS_QKF); const float* G = (const float*)(ws + WS_G); const float* BETA = (const float*)(ws + WS_BETA); float* OF = (float*)(ws + WS_SC);
    const int cg = lane >> 4, rg = lane & 15;
    {
        for (int item = blockIdx.x * 8 + wave; item < SBN * 32 * 16; item += gridDim.x * 8) {
            const int sb = item >> 9, h = (item >> 4) & 31, col0 = 8 * (item & 15) + 2 * cg;
            const size_t so = ((size_t)((sb * 32 + h) * 128 + 8 * rg)) * 128 + col0;
            f32x2 S[8];
#pragma unroll
            for (int i = 0; i < 8; ++i) S[i] = *(const f32x2*)(P.state_delta + so + (size_t)i * 128);
            Tok T; tok_load(T, QKF, QKVC, G, BETA, SROW0 + sb, h, rg, col0);
            const f32x2 o = tok_step(S, T);
            if (rg == 0) *(f32x2*)(OF + (size_t)(SROW0 + sb) * DVW + h * 128 + col0) = o;
            float* op = P.out + O_DS + so;
#pragma unroll
            for (int i = 0; i < 8; ++i) *(f32x2*)(op + (size_t)i * 128) = S[i];
        }
    }
}
__device__ __forceinline__ void normC_phase(const bf16* PROJC, bf16* Y, const Ptrs& P, int gw, int NGW, int lane) {
    const float* OF = (const float*)(P.ws + WS_SC);
    const int d0 = 8 * (lane & 15);
    float nw[8];
    { const f32x4 a = *(const f32x4*)(P.norm_w + d0), b = *(const f32x4*)(P.norm_w + d0 + 4); nw[0] = a.x; nw[1] = a.y; nw[2] = a.z; nw[3] = a.w; nw[4] = b.x; nw[5] = b.y; nw[6] = b.z; nw[7] = b.w; }
    for (int r = gw; r < NROWS; r += NGW) {
        f32x4 oa[8], ob[8]; v4u zz[8];
#pragma unroll
        for (int it = 0; it < 8; ++it) { const int hd = it * 4 + (lane >> 4); const float* op = OF + (size_t)r * DVW + hd * 128 + d0;
            oa[it] = *(const f32x4*)op; ob[it] = *(const f32x4*)(op + 4); zz[it] = *(const v4u*)(PROJC + (size_t)r * NC_PAD + 8192 + hd * 128 + d0); }
#pragma unroll
        for (int it = 0; it < 8; ++it) {
            const int hd = it * 4 + (lane >> 4);
            float o[8] = {oa[it].x, oa[it].y, oa[it].z, oa[it].w, ob[it].x, ob[it].y, ob[it].z, ob[it].w};
            float ss = 0.f;
#pragma unroll
            for (int i = 0; i < 8; ++i) ss += o[i] * o[i];
            ss = row16_sum(ss);
            const float rs = 1.f / sqrtf(ss * (1.f / 128.f) + RMS_EPS);
            float z[8]; unpack8(zz[it], z);
#pragma unroll
            for (int i = 0; i < 8; ++i) o[i] = o[i] * rs * nw[i] * silu_f(z[i]);
            *(v4u*)(Y + (size_t)r * DVW + hd * 128 + d0) = pack8(o);
        }
    }
}


__device__ __forceinline__ void dense_attn_phase(const Ptrs& P, bf16* O, char* lds, int wv) {
    unsigned char* ws = P.ws;
    const bf16* Qr = (const bf16*)(ws + WS_QR); const bf16* Ks = (const bf16*)(ws + WS_KS); const bf16* Vs = (const bf16*)(ws + WS_VS);
    const unsigned long long* MASK = (const unsigned long long*)(ws + WS_MASK);
    typedef dattn::BlockRef<bf16, bf16> BR;
    for (int it0 = blockIdx.x; it0 < 256; it0 += gridDim.x) {
        const int grp = it0 & 7, idx = it0 >> 3;
        const int b = grp >> 2, kvh = grp & 3, h = kvh * 4 + (idx >> 3), x = idx & 7;
        BR A, B;
        const int qa = 1 + x, qb = 16 - x;
        A.Q = Qr + ((size_t)(b * SEQ + 256 * (qa - 1))) * DM + h * 128; A.O = O + ((size_t)(b * SEQ + 256 * (qa - 1))) * DM + h * 128;
        B.Q = Qr + ((size_t)(b * SEQ + 256 * (qb - 1))) * DM + h * 128; B.O = O + ((size_t)(b * SEQ + 256 * (qb - 1))) * DM + h * 128;
        A.K = B.K = Ks + (size_t)b * SP * 512 + kvh * 128; A.V = B.V = Vs + (size_t)b * SP * 512 + kvh * 128;
        A.P0 = 256 * qa; B.P0 = 256 * qb;
        A.M = MASK + ((size_t)(b * SP + A.P0)) * MTW; B.M = MASK + ((size_t)(b * SP + B.P0)) * MTW;
        dattn::Seam<bf16> S;
        dattn::causal_swa_prime<bf16, bf16>(A, SP, lds, S, wv);
        dattn::causal_swa_block<bf16, bf16>(A, B, SP, SP, lds, S, wv);
        dattn::causal_swa_block<bf16, bf16>(B, B, SP, SP, lds, S, wv);
    }
}

constexpr int NCH = 65, CPAD = 48;
constexpr int NUQ = NBP * 16 * NCH, NUH = NBP * 32 * NCH;
__device__ __forceinline__ int crow32(int r, int hi) { return (r & 3) + 8 * (r >> 2) + 4 * hi; }
__device__ __forceinline__ int chunk_row(int b, int c, int i) { const int t = 64 * c + i - CPAD; return t >= 0 ? prow(b, t) : -1; }
__device__ __forceinline__ float incl_scan64(float v, int lane) {
#pragma unroll
    for (int o = 1; o < 64; o <<= 1) { const float u = __shfl_up(v, o); if (lane >= o) v += u; }
    return v;
}
#define MFMA32(a, b, c) __builtin_amdgcn_mfma_f32_32x32x16_bf16((a), (b), (c), 0, 0, 0)
__device__ __forceinline__ int sw23(int x) { return (x & ~12) | ((x & 4) << 1) | ((x & 8) >> 1); }
__device__ __forceinline__ int fidx64(int row, int xs) { return ((((row >> 5) * 2 + (xs >> 5)) * 2 + ((xs >> 4) & 1)) * 64 + (row & 31) + 32 * ((xs >> 3) & 1)) * 8 + (xs & 7); }

__device__ __forceinline__ v4u pack_frag(const f32x16& x, int s) { v4u w; w.x = pk2(x[8 * s], x[8 * s + 1]); w.y = pk2(x[8 * s + 2], x[8 * s + 3]); w.z = pk2(x[8 * s + 4], x[8 * s + 5]); w.w = pk2(x[8 * s + 6], x[8 * s + 7]); return w; }
__device__ __forceinline__ void delta_d1_unit(unsigned char* ws, LAS unsigned char* lds, int uq, int wave, int lane) {
    asm volatile("" : "+v"(lane));
    const bf16* QKVC = (const bf16*)(ws + WS_QKVC); const float* G = (const float*)(ws + WS_G); const float* BETA = (const float*)(ws + WS_BETA);
    float* AF = (float*)(ws + WS_DAF); bf16* PG = (bf16*)(ws + WS_DPG); bf16* KT = (bf16*)(ws + WS_DKT); bf16* VT = (bf16*)(ws + WS_DVT);
    float* GC = (float*)(ws + WS_DGC); float* BT = (float*)(ws + WS_DBT);
    LAS float* lg = (LAS float*)(lds + wave * 1024);
    const int m = lane & 31, half = lane >> 5;
    const bf16x8 zf = {0, 0, 0, 0, 0, 0, 0, 0};
    {
        const int c = uq % NCH, bh = uq / NCH, hq = bh & 15, b = bh >> 4;
        { const int row = chunk_row(b, c, lane);
#pragma unroll
          for (int hh = 0; hh < 2; ++hh) { const int h = 2 * hq + hh; const float g = row >= 0 ? G[(size_t)row * 32 + h] : 0.f, bt = row >= 0 ? BETA[(size_t)row * 32 + h] : 0.f;
              const float gc = incl_scan64(g, lane); lg[hh * 64 + lane] = gc; lg[128 + hh * 64 + lane] = bt;
              const size_t uh = ((size_t)(b * 32 + h)) * NCH + c; GC[uh * 64 + lane] = gc; BT[uh * 64 + lane] = bt; } }
        const int row0 = chunk_row(b, c, m), row1 = chunk_row(b, c, 32 + m);
        const bf16* r0 = QKVC + (size_t)(row0 < 0 ? 0 : row0) * CDIM; const bf16* r1 = QKVC + (size_t)(row1 < 0 ? 0 : row1) * CDIM;
        f32x16 kk00, kk10, kk11, qk00, qk10, qk11;
#pragma unroll
        for (int i = 0; i < 16; ++i) { kk00[i] = 0.f; kk10[i] = 0.f; kk11[i] = 0.f; qk00[i] = 0.f; qk10[i] = 0.f; qk11[i] = 0.f; }
        const int sm = sw23(m);
        bf16* kt0 = KT + (size_t)uq * 128 * 64 + half * 32 + ((sm >> 4) & 1) * 512 + ((sm >> 3) & 1) * 256 + (sm & 7);
#pragma unroll 2
        for (int ks = 0; ks < 8; ++ks) {
            const int off = hq * 128 + 16 * ks + 8 * half;
            const bf16x8 k0 = row0 >= 0 ? *(const bf16x8*)(r0 + 2048 + off) : zf, k1 = row1 >= 0 ? *(const bf16x8*)(r1 + 2048 + off) : zf;
            const bf16x8 q0 = row0 >= 0 ? *(const bf16x8*)(r0 + off) : zf, q1 = row1 >= 0 ? *(const bf16x8*)(r1 + off) : zf;
            kk00 = MFMA32(k0, k0, kk00); kk10 = MFMA32(k1, k0, kk10); kk11 = MFMA32(k1, k1, kk11);
            qk00 = MFMA32(q0, k0, qk00); qk10 = MFMA32(q1, k0, qk10); qk11 = MFMA32(q1, k1, qk11);
            { bf16* kb = kt0 + (ks >> 1) * 2048 + (ks & 1) * 128;
#pragma unroll
              for (int e = 0; e < 8; ++e) { kb[(8 * (e >> 2) + (e & 3)) * 8] = (bf16)k0[e]; kb[1024 + (8 * (e >> 2) + (e & 3)) * 8] = (bf16)k1[e]; } }
        }
#pragma unroll 1
        for (int hh = 0; hh < 2; ++hh) { const int h = 2 * hq + hh; bf16* vt = VT + (((size_t)(b * 32 + h)) * NCH + c) * 128 * 64 + half * 512 + sm;
#pragma unroll 4
            for (int ks = 0; ks < 8; ++ks) { const int off = 4096 + h * 128 + 16 * ks + 8 * half;
                const bf16x8 v0 = row0 >= 0 ? *(const bf16x8*)(r0 + off) : zf, v1 = row1 >= 0 ? *(const bf16x8*)(r1 + off) : zf;
#pragma unroll
                for (int e = 0; e < 8; ++e) { vt[ks * 1024 + e * 64] = (bf16)v0[e]; vt[ks * 1024 + e * 64 + 32] = (bf16)v1[e]; } } }
        WAVE_SYNC();
#pragma unroll 1
        for (int hh = 0; hh < 2; ++hh) { const int h = 2 * hq + hh; const size_t uh = ((size_t)(b * 32 + h)) * NCH + c;
            float* af = AF + uh * 4096 + half * 256 + m;
            bf16* pg = PG + uh * 4096 + half * 32 + ((sm >> 4) & 1) * 512 + ((sm >> 3) & 1) * 256 + (sm & 7);
            const float gcj0 = lg[hh * 64 + m], gcj1 = lg[hh * 64 + 32 + m];
#pragma unroll
            for (int r = 0; r < 16; ++r) { const int ir = crow32(r, half), rc = (r & 3) + 8 * (r >> 2);
                const float gi0 = lg[hh * 64 + ir], gi1 = lg[hh * 64 + 32 + ir], bi0 = lg[128 + hh * 64 + ir], bi1 = lg[128 + hh * 64 + 32 + ir];
                { const int i = ir, j = m; const float dec = __expf(fminf(gi0 - gcj0, 0.f)); af[rc * 64] = (j < i) ? bi0 * dec * kk00[r] : 0.f; pg[rc * 8] = f2bf((j <= i) ? dec * qk00[r] : 0.f); }
                { const int i = 32 + ir, j = m; const float dec = __expf(fminf(gi1 - gcj0, 0.f)); af[2048 + rc * 64] = bi1 * dec * kk10[r]; pg[2048 + rc * 8] = f2bf(dec * qk10[r]); }
                { const int i = 32 + ir, j = 32 + m; const float dec = __expf(fminf(gi1 - gcj1, 0.f)); af[2048 + 32 + rc * 64] = (j < i) ? bi1 * dec * kk11[r] : 0.f; pg[2048 + 1024 + rc * 8] = f2bf((j <= i) ? dec * qk11[r] : 0.f); }
            } }
        WAVE_SYNC();
    }
}
__device__ __forceinline__ void delta_d2_unit(unsigned char* ws, int uh, int lane) {
    asm volatile("" : "+v"(lane));
    const float* AF = (const float*)(ws + WS_DAF); const float* GC = (const float*)(ws + WS_DGC); const float* BT = (const float*)(ws + WS_DBT);
    bf16* TG = (bf16*)(ws + WS_DTG); bf16* TB = (bf16*)(ws + WS_DTB);
    {
        const float* af = AF + (size_t)uh * 4096;
        const float bc = BT[(size_t)uh * 64 + lane], gmc = __expf(GC[(size_t)uh * 64 + lane]);
        float T[64];
        const bool pad0 = (uh % NCH) == 0;
#pragma unroll
        for (int i0 = 0; i0 < 64; i0 += 32) {
            float ar[32];
#pragma unroll
            for (int u = 0; u < 32; ++u) ar[u] = af[(i0 + u) * 64 + lane];
            if (pad0 && i0 == 0) {
#pragma unroll
                for (int u = 0; u < 32; ++u) T[u] = (lane == u) ? 1.f : 0.f;
            } else {
#pragma unroll
                for (int u = 0; u < 32; ++u) { const int i = i0 + u; float pa[4] = {(lane == i) ? 1.f : 0.f, 0.f, 0.f, 0.f};
#pragma unroll
                    for (int j = 0; j < i; ++j) pa[j & 3] -= __int_as_float(__builtin_amdgcn_readlane(__float_as_int(ar[u]), j)) * T[j];
                    T[i] = (pa[0] + pa[1]) + (pa[2] + pa[3]); }
            }
        }
        bf16* tg = TG + (size_t)uh * 4096; bf16* tb = TB + (size_t)uh * 4096;
        const float sg = bc * gmc;
        const int cs = (lane & ~31) + sw23(lane & 31);
#pragma unroll
        for (int i = 0; i < 64; ++i) { tg[i * 64 + cs] = f2bf(T[i] * sg); tb[i * 64 + cs] = f2bf(T[i] * bc); }
    }
}
__device__ __forceinline__ void delta_d3_unit(unsigned char* ws, int uh, int lane) {
    asm volatile("" : "+v"(lane));
    const bf16* TG = (const bf16*)(ws + WS_DTG); const bf16* TB = (const bf16*)(ws + WS_DTB); const bf16* KT = (const bf16*)(ws + WS_DKT); const bf16* VT = (const bf16*)(ws + WS_DVT);
    bf16* WG = (bf16*)(ws + WS_DWG); bf16* UG = (bf16*)(ws + WS_DUG);
    const int m = lane & 31, half = lane >> 5;
    const int c = uh % NCH, bh = uh / NCH, h = bh & 31, b = bh >> 5;
    const size_t uq = ((size_t)(b * 16 + (h >> 1))) * NCH + c;
    {
        const bf16* Tm = TG + (size_t)uh * 4096; const bf16* Kf = KT + uq * 8192;
        f32x16 acc[4][2];
#pragma unroll
        for (int dn = 0; dn < 4; ++dn)
#pragma unroll
            for (int ti = 0; ti < 2; ++ti)
#pragma unroll
                for (int i = 0; i < 16; ++i) acc[dn][ti][i] = 0.f;
#pragma unroll
        for (int ks = 0; ks < 4; ++ks) {
            bf16x8 a[4], bb[2];
#pragma unroll
            for (int dn = 0; dn < 4; ++dn) a[dn] = *(const bf16x8*)(Kf + ((size_t)(((dn * 2 + (ks >> 1)) * 2 + (ks & 1)) * 64 + lane)) * 8);
#pragma unroll
            for (int ti = 0; ti < 2; ++ti) bb[ti] = *(const bf16x8*)(Tm + (32 * ti + m) * 64 + 16 * ks + 8 * half);
#pragma unroll
            for (int dn = 0; dn < 4; ++dn)
#pragma unroll
                for (int ti = 0; ti < 2; ++ti) acc[dn][ti] = MFMA32(a[dn], bb[ti], acc[dn][ti]);
        }
        bf16* wg = WG + (size_t)uh * 8192;
#pragma unroll
        for (int dn = 0; dn < 4; ++dn)
#pragma unroll
            for (int ti = 0; ti < 2; ++ti)
#pragma unroll
                for (int s2 = 0; s2 < 2; ++s2) *(v4u*)(wg + ((size_t)(((ti * 4 + dn) * 2 + s2) * 64 + lane)) * 8) = pack_frag(acc[dn][ti], s2);
    }
    {
        const bf16* Tm = TB + (size_t)uh * 4096; const bf16* Bt = VT + (size_t)uh * 8192;
        f32x16 acc[2][4];
#pragma unroll
        for (int ti = 0; ti < 2; ++ti)
#pragma unroll
            for (int dn = 0; dn < 4; ++dn)
#pragma unroll
                for (int i = 0; i < 16; ++i) acc[ti][dn][i] = 0.f;
#pragma unroll
        for (int ks = 0; ks < 4; ++ks) {
            bf16x8 a[2], bb[4];
#pragma unroll
            for (int ti = 0; ti < 2; ++ti) a[ti] = *(const bf16x8*)(Tm + (32 * ti + m) * 64 + 16 * ks + 8 * half);
#pragma unroll
            for (int dn = 0; dn < 4; ++dn) bb[dn] = *(const bf16x8*)(Bt + (32 * dn + m) * 64 + 16 * ks + 8 * half);
#pragma unroll
            for (int ti = 0; ti < 2; ++ti)
#pragma unroll
                for (int dn = 0; dn < 4; ++dn) acc[ti][dn] = MFMA32(a[ti], bb[dn], acc[ti][dn]);
        }
        bf16* ug = UG + (size_t)uh * 8192;
#pragma unroll
        for (int ti = 0; ti < 2; ++ti)
#pragma unroll
            for (int dn = 0; dn < 4; ++dn) { bf16* p = ug + ((size_t)((ti * 4 + dn) * 64 + lane)) * 16; *(v4u*)p = pack_frag(acc[ti][dn], 0); *(v4u*)(p + 8) = pack_frag(acc[ti][dn], 1); }
    }
}
__device__ __forceinline__ void delta_pre(unsigned char* ws, LAS unsigned char* lds, int gw, int NGW, int wave, int lane) {
    for (int uq = gw; uq < NUQ; uq += NGW) {
#ifndef NO_D1
        delta_d1_unit(ws, lds, uq, wave, lane);
#endif
        asm volatile("s_waitcnt vmcnt(0)" ::: "memory");
        const int c = uq % NCH, bh = uq / NCH, hq = bh & 15, b = bh >> 4;
#pragma unroll 1
        for (int hh = 0; hh < 2; ++hh) { const int uh = (b * 32 + 2 * hq + hh) * NCH + c;
#ifndef NO_D2
            delta_d2_unit(ws, uh, lane);
#endif
            asm volatile("s_waitcnt vmcnt(0)" ::: "memory");
#ifndef NO_D3
            delta_d3_unit(ws, uh, lane);
#endif
        }
    }
}
__device__ __forceinline__ bf16x8 afrag_perm(const bf16* rowp, int blk, int s, int half) {
    const v2u lo = *(const v2u*)(rowp + 32 * blk + 16 * s + 4 * half), hi2 = *(const v2u*)(rowp + 32 * blk + 16 * s + 8 + 4 * half);
    v4u w; w.x = lo.x; w.y = lo.y; w.z = hi2.x; w.w = hi2.y; return __builtin_bit_cast(bf16x8, w);
}
#define LBAR() asm volatile("s_waitcnt lgkmcnt(0)\n\ts_barrier" ::: "memory")
__device__ __forceinline__ void delta_d4(unsigned char* ws, float* out_state, LAS unsigned char* lds, int tid, int wave, int lane) {
    const bf16* QKVC = (const bf16*)(ws + WS_QKVC); const bf16* KT = (const bf16*)(ws + WS_DKT); const bf16* PG = (const bf16*)(ws + WS_DPG);
    const bf16* WG = (const bf16*)(ws + WS_DWG); const bf16* UG = (const bf16*)(ws + WS_DUG); const float* GC = (const float*)(ws + WS_DGC);
    float* OF = (float*)(ws + WS_SC);
    LAS v4u* Sfr = (LAS v4u*)lds;
    LAS v4u* Dfr = (LAS v4u*)(lds + 16384);
    LAS v4u* Dtf = (LAS v4u*)(lds + 16384 + 4096);
    LAS float* gam = (LAS float*)(lds + 16384 + 8192);
    const int m = lane & 31, half = lane >> 5;
    const bf16x8 zf = {0, 0, 0, 0, 0, 0, 0, 0};
    for (int item = blockIdx.x; item < NBP * 32 * 4; item += gridDim.x) {
        const int q = item & 3, bh = item >> 2, h = bh & 31, b = bh >> 5;
        const size_t uh0 = ((size_t)(b * 32 + h)) * NCH, uq0 = ((size_t)(b * 16 + (h >> 1))) * NCH;
        const int rt = wave & 1; const bool isq = wave >= 6;
        f32x16 S;
#pragma unroll
        for (int i = 0; i < 16; ++i) S[i] = 0.f;
        bf16x8 afr[8], afn[8], xfr[4], xfn[4]; float gcn = 0.f;
#pragma unroll
        for (int i = 0; i < 8; ++i) { afr[i] = zf; afn[i] = zf; }
#pragma unroll
        for (int i = 0; i < 4; ++i) { xfr[i] = zf; xfn[i] = zf; }
#define LOAD_NEXT(cc) do { if (wave < 4) { const bf16* kr_ = KT + (uq0 + (cc)) * 8192; \
                _Pragma("unroll") for (int blk = 0; blk < 2; ++blk) _Pragma("unroll") for (int s_ = 0; s_ < 2; ++s_) afn[blk * 2 + s_] = *(const bf16x8*)(kr_ + ((size_t)(((wave * 2 + blk) * 2 + s_) * 64 + lane)) * 8); } \
            else { const int row_ = chunk_row(b, (cc), 32 * rt + m); const bool ok_ = !isq || row_ >= 0; \
                const bf16* ar_ = QKVC + (size_t)(row_ < 0 ? 0 : row_) * CDIM + (h >> 1) * 128; const bf16* wf_ = WG + (uh0 + (cc)) * 8192; \
                _Pragma("unroll") for (int blk = 0; blk < 4; ++blk) _Pragma("unroll") for (int s_ = 0; s_ < 2; ++s_) afn[blk * 2 + s_] = !ok_ ? zf : (isq ? *(const bf16x8*)(ar_ + 32 * blk + 16 * s_ + 8 * half) : *(const bf16x8*)(wf_ + ((size_t)(((rt * 4 + blk) * 2 + s_) * 64 + lane)) * 8)); \
                if (!isq) { const bf16* up_ = UG + (uh0 + (cc)) * 8192 + ((size_t)((rt * 4 + q) * 64 + lane)) * 16; xfn[0] = *(const bf16x8*)up_; xfn[1] = *(const bf16x8*)(up_ + 8); if (wave == 4) gcn = GC[(uh0 + (cc)) * 64 + lane]; } \
                else { const bf16* pr_ = PG + (uh0 + (cc)) * 4096; \
                    _Pragma("unroll") for (int blk = 0; blk < 2; ++blk) _Pragma("unroll") for (int s_ = 0; s_ < 2; ++s_) xfn[blk * 2 + s_] = (blk <= rt) ? *(const bf16x8*)(pr_ + ((size_t)(((rt * 2 + blk) * 2 + s_) * 64 + lane)) * 8) : zf; } } } while (0)
#define ROTATE() do { _Pragma("unroll") for (int i_ = 0; i_ < 8; ++i_) afr[i_] = afn[i_]; _Pragma("unroll") for (int i_ = 0; i_ < 4; ++i_) xfr[i_] = xfn[i_]; } while (0)
        LBAR();
        if (wave < 4) { const v4u z = {0u, 0u, 0u, 0u}; Sfr[(0 * 4 + wave) * 128 + lane] = z; Sfr[(0 * 4 + wave) * 128 + 64 + lane] = z; }
        if (wave == 4) { const float gc = GC[(uh0 + 0) * 64 + lane], gl = __shfl(gc, 63); gam[lane] = __expf(gc); gam[128 + lane] = __expf(gl - gc); }
        LOAD_NEXT(0); ROTATE();
        for (int c = 0; c < NCH; ++c) {
            const int bufc = c & 1;
            const size_t uh = uh0 + c, uq = uq0 + c;
            LBAR();
            f32x16 acc;
            if (c + 1 < NCH) LOAD_NEXT(c + 1);
            if (wave >= 4) {
#pragma unroll
                for (int i = 0; i < 16; ++i) acc[i] = 0.f;
#pragma unroll
                for (int blk = 0; blk < 4; ++blk)
#pragma unroll
                    for (int s = 0; s < 2; ++s) acc = MFMA32(afr[blk * 2 + s], __builtin_bit_cast(bf16x8, Sfr[(bufc * 4 + blk) * 128 + s * 64 + lane]), acc);
                if (!isq) {
                    float uf[16]; { float t8[8]; unpack8(__builtin_bit_cast(v4u, xfr[0]), t8);
#pragma unroll
                        for (int i = 0; i < 8; ++i) uf[i] = t8[i]; unpack8(__builtin_bit_cast(v4u, xfr[1]), t8);
#pragma unroll
                        for (int i = 0; i < 8; ++i) uf[8 + i] = t8[i]; }
                    f32x16 dt;
#pragma unroll
                    for (int r = 0; r < 16; ++r) { acc[r] = uf[r] - acc[r]; dt[r] = acc[r] * gam[128 + bufc * 64 + 32 * rt + crow32(r, half)]; }
#pragma unroll
                    for (int s = 0; s < 2; ++s) { Dfr[(rt * 2 + s) * 64 + lane] = pack_frag(acc, s); Dtf[(rt * 2 + s) * 64 + lane] = pack_frag(dt, s); }
                }
            }
            LBAR();
            if (wave < 4) {
                const float gl = gam[bufc * 64 + 63];
#pragma unroll
                for (int i = 0; i < 16; ++i) S[i] *= gl;
#pragma unroll
                for (int blk = 0; blk < 2; ++blk)
#pragma unroll
                    for (int s = 0; s < 2; ++s) S = MFMA32(afr[blk * 2 + s], __builtin_bit_cast(bf16x8, Dtf[(blk * 2 + s) * 64 + lane]), S);
#pragma unroll
                for (int s = 0; s < 2; ++s) Sfr[((bufc ^ 1) * 4 + wave) * 128 + s * 64 + lane] = pack_frag(S, s);
            } else if (isq) {
#pragma unroll
                for (int r = 0; r < 16; ++r) acc[r] *= gam[bufc * 64 + 32 * rt + crow32(r, half)];
#pragma unroll
                for (int blk = 0; blk < 2; ++blk)
#pragma unroll
                    for (int s = 0; s < 2; ++s) acc = MFMA32(xfr[blk * 2 + s], __builtin_bit_cast(bf16x8, Dfr[(blk * 2 + s) * 64 + lane]), acc);
#pragma unroll
                for (int r = 0; r < 16; ++r) { const int row = chunk_row(b, c, 32 * rt + crow32(r, half)); if (row >= 0) OF[(size_t)row * DVW + h * 128 + 32 * q + m] = acc[r]; }
            } else if (wave == 4 && c + 1 < NCH) {
                const float gl = __shfl(gcn, 63); gam[(bufc ^ 1) * 64 + lane] = __expf(gcn); gam[128 + (bufc ^ 1) * 64 + lane] = __expf(gl - gcn);
            }
            ROTATE();
        }
        if (wave < 4) { float* o = out_state + ((size_t)((b * 32 + h) * 128 + 32 * wave)) * 128 + 32 * q + m;
#pragma unroll
            for (int r = 0; r < 16; ++r) o[(size_t)sw23(crow32(r, half)) * 128] = S[r]; }
#undef LOAD_NEXT
#undef ROTATE
    }
    LBAR();
}
#undef LBAR
#undef MFMA32
template <int RT, int CT, class Epi>
__device__ __forceinline__ void small_gemm_unit(const bf16* A, int lda, const bf16* Bt, int ldb, int k0, int klen, LAS unsigned char* lds, const Epi& E, int tid, int wave, int lane) {
    const int r16 = lane & 15, q = lane >> 4;
    const int kw = klen >> 3;
    const bf16* ap = A + (size_t)r16 * lda + k0 + wave * kw + 8 * q;
    const bf16* bp = Bt + (size_t)r16 * ldb + k0 + wave * kw + 8 * q;
    pg8::f32x4 acc[RT][CT];
#pragma unroll
    for (int i = 0; i < RT; ++i)
#pragma unroll
        for (int j = 0; j < CT; ++j) acc[i][j] = (pg8::f32x4){0.f, 0.f, 0.f, 0.f};
#pragma unroll 2
    for (int ks = 0; ks < kw; ks += 32) {
        bf16x8 a[RT], b[CT];
#pragma unroll
        for (int i = 0; i < RT; ++i) a[i] = *(const bf16x8*)(ap + (size_t)(16 * i) * lda + ks);
#pragma unroll
        for (int j = 0; j < CT; ++j) b[j] = *(const bf16x8*)(bp + (size_t)(16 * j) * ldb + ks);
#pragma unroll
        for (int i = 0; i < RT; ++i)
#pragma unroll
            for (int j = 0; j < CT; ++j) acc[i][j] = __builtin_amdgcn_mfma_f32_16x16x32_bf16(a[i], b[j], acc[i][j], 0, 0, 0);
    }
    constexpr int NOUT = 256 * RT * CT;
    LAS float* part = (LAS float*)lds + wave * NOUT;
#pragma unroll
    for (int i = 0; i < RT; ++i)
#pragma unroll
        for (int j = 0; j < CT; ++j)
#pragma unroll
            for (int e = 0; e < 4; ++e) part[(16 * i + 4 * q + e) * (16 * CT) + 16 * j + r16] = acc[i][j][e];
    __syncthreads();
    for (int o = tid; o < NOUT; o += NTHREADS) { float sum = 0.f;
#pragma unroll
        for (int w = 0; w < 8; ++w) sum += ((LAS float*)lds)[w * NOUT + o];
        E(o / (16 * CT), o % (16 * CT), sum); }
    __syncthreads();
}
template <int ACT> struct SEpiRowsBf16 { bf16* O; int ldc; __device__ __forceinline__ void operator()(int row, int col, float v) const { if (ACT == 2) { v = v > 0.f ? v : 0.f; v = v * v; } O[(size_t)row * ldc + col] = f2bf(v); } };
struct SEpiF32 { float* O; int ldc; __device__ __forceinline__ void operator()(int row, int col, float v) const { O[(size_t)row * ldc + col] = v; } };
struct SEpiColsBf16 { bf16* O; int ldc; __device__ __forceinline__ void operator()(int row, int col, float v) const { O[(size_t)col * ldc + row] = f2bf(v); } };
template <int ACT> __device__ __forceinline__ void skinny_rows_bf16(const bf16* A, const bf16* Wt, int K, int nunits, bf16* O, int ldc, LAS unsigned char* lds, int tid, int wave, int lane) {
    for (int u = blockIdx.x; u < nunits; u += gridDim.x) { SEpiRowsBf16<ACT> E{O + (size_t)XROW0 * ldc + u * 64, ldc};
        small_gemm_unit<3, 4>(A + (size_t)XROW0 * K, K, Wt + (size_t)u * 64 * K, K, 0, K, lds, E, tid, wave, lane); }
}
__device__ __forceinline__ void skinny_rows_part(const bf16* A, const bf16* Wt, int K, float* ZP, LAS unsigned char* lds, int tid, int wave, int lane) {
    for (int u = blockIdx.x; u < 256; u += gridDim.x) { const int cgp = u & 31, ksl = u >> 5; SEpiF32 E{ZP + (size_t)ksl * XR * DM + cgp * 64, DM};
        small_gemm_unit<3, 4>(A + (size_t)XROW0 * K, K, Wt + (size_t)cgp * 64 * K, K, ksl * (K >> 3), K >> 3, lds, E, tid, wave, lane); }
}
template <int RT> __device__ __forceinline__ void tail_cols_bf16(const bf16* A, const bf16* Wt, int K, int c0, bf16* O, int ldc, LAS unsigned char* lds, int tid, int wave, int lane) {
    for (int u = blockIdx.x; u < MAINM / 32; u += gridDim.x) { SEpiColsBf16 E{O + (size_t)u * 32 * ldc + c0, ldc};
        small_gemm_unit<RT, 2>(Wt + (size_t)c0 * K, K, A + (size_t)u * 32 * K, K, 0, K, lds, E, tid, wave, lane); }
}

typedef __attribute__((address_space(4))) const unsigned long long* kargq_t;
#define KPF_(k) ((const float*)(const GAS float*)(q_[k]))
__device__ __forceinline__ void load_ptrs(Ptrs& P) {
    kargq_t q_ = (kargq_t)__builtin_amdgcn_kernarg_segment_ptr();
    asm volatile("" : "+s"(q_));
    P.x_prompt = KPF_(0); P.x_sample = KPF_(1); P.state_conv_a = KPF_(2); P.cache_k = KPF_(3);
    P.cache_v = KPF_(4); P.cache_ik = KPF_(5); P.state_conv_c = KPF_(6); P.state_delta = KPF_(7);
    P.page_table = ((const int*)(const GAS int*)(q_[8])); P.meta = KPF_(9); P.w_in_a = KPF_(10); P.conv_w_a = KPF_(11);
    P.w_out_a = KPF_(12); P.w_in_b = KPF_(13); P.w_out_b = KPF_(14); P.w_in_c = KPF_(15);
    P.conv_w_c = KPF_(16); P.a_log = KPF_(17); P.dt_bias = KPF_(18); P.norm_w = KPF_(19);
    P.w_out_c = KPF_(20); P.ln1_g = KPF_(21); P.ln1_b = KPF_(22); P.w1 = KPF_(23);
    P.w2 = KPF_(24); P.ln2_g = KPF_(25); P.ln2_b = KPF_(26);
    P.out = (float*)(GAS float*)(q_[27]); P.ws = (unsigned char*)(GAS unsigned char*)(q_[28]);
}
struct Args { const void* in[27]; float* out; unsigned char* ws; int ph_lo, ph_hi; };
constexpr int PH_PER_LAYER = 12, PH_END = 1 + 4 * PH_PER_LAYER;

__global__ void __launch_bounds__(NTHREADS, 2) mega_fwd(Args args) {
    extern __shared__ __attribute__((aligned(16))) unsigned char lds_raw[];
    LAS unsigned char* lds = (LAS unsigned char*)lds_raw;
    const int tid = threadIdx.x, lane = tid & 63, wave = __builtin_amdgcn_readfirstlane(tid >> 6);
    const int G_ = gridDim.x, NGW = G_ * NWAVES, NT = G_ * NTHREADS; (void)lane;
    unsigned char* ws = args.ws;
    const int lo = args.ph_lo, hi = args.ph_hi;
    const bool fused = (hi - lo) > 1;

    for (int u = tid; u < (LDS_BYTES - LDSCTL_OFF) / 4; u += NTHREADS) ((LAS unsigned*)(lds + LDSCTL_OFF))[u] = 0u;
    __syncthreads();
    volatile LAS unsigned* MISC = (volatile LAS unsigned*)(lds + MISC_OFF);
    XcdBarrier bar; bar.bar = (unsigned*)(ws + WS_CTL) + CW_BAR; bar.x = 0; bar.st = nullptr;
    if (fused) bar = xcd_barrier_post((unsigned*)(ws + WS_CTL) + CW_BAR, MISC + 8);
    bar.wv = wave;

#ifndef MK_SITES
#define MK_SITES 0xffffffffu
#endif
#define SITE(n) (((MK_SITES) >> (n)) & 1u)
#define IN(k) (lo <= (k) && (k) < hi)
#ifndef MK_DUP
#define MK_DUP 0u
#endif
#define NREP(n) ((((MK_DUP) >> (n)) & 1u) ? 2 : 1)
#define BEGIN_SITE(n, id) if (SITE(n) && IN(id)) { for (int rp_ = 0; rp_ < NREP(n); ++rp_) { Ptrs P; load_ptrs(P); unsigned char* ws = P.ws; (void)ws; \
    bf16* X = (bf16*)(P.ws + WS_X); float* Z = (float*)(P.ws + WS_Z); float* ZP = (float*)(P.ws + WS_ZP); bf16* Y = (bf16*)(P.ws + WS_Y); bf16* BIG = (bf16*)(P.ws + WS_BIG); (void)X; (void)Z; (void)ZP; (void)Y; (void)BIG;
#define END_SITE(id) SEAM(id); } }
#define LOCALS int tid_ = threadIdx.x; asm volatile("" : "+v"(tid_)); const int lane_ = tid_ & 63, wave_ = __builtin_amdgcn_readfirstlane(tid_ >> 6), gw_ = blockIdx.x * NWAVES + wave_, gtid_ = blockIdx.x * NTHREADS + tid_; (void)lane_; (void)wave_; (void)gw_; (void)gtid_
#define SEAM(k) do { if (fused && (k) + 1 < PH_END) xcd_barrier(bar); else __syncthreads(); } while (0)


    BEGIN_SITE(0, 0) LOCALS; p0_prologue(P, lds, gw_, NGW, wave_, lane_); END_SITE(0)

    for (int layer = 0; layer < 4; ++layer) {
        const int kind = layer % 3, j = layer / 3, base = 1 + layer * PH_PER_LAYER;
        if (kind == 0) {
            BEGIN_SITE(1, base + 0)
                const bf16* Wt = (const bf16*)(ws + WS_WA_IN + (size_t)j * WSZ_A_IN); pg8::Gemm g{X, Wt, MAINM, NA_IN, DM}; pg8::StaticOrder S; S.init(MAINM, NA_IN, G_, (int)blockIdx.x);
                pg8::EpiBf16<0> E{BIG, NA_IN, nullptr, 0, 0, 1.f};
                pg8::gemm_phase<pg8::EpiBf16<0>, pg8::StaticOrder, true, true>(lds, g, S, E, wave);
                { LOCALS; skinny_rows_bf16<0>(X, Wt, DM, NA_IN / 64, BIG, NA_IN, lds, tid_, wave_, lane_); }
                END_SITE(base + 0)
            BEGIN_SITE(2, base + 1)
                LOCALS; convA_phase(BIG, Y, P.conv_w_a + (size_t)j * 3 * DM, P.state_conv_a + (size_t)j * SBN * 2 * DM, P.out + O_CAP + (size_t)j * NBP * 2 * DM, P.out + O_CAS + (size_t)j * SBN * 2 * DM, gtid_, NT);
                END_SITE(base + 1)
            BEGIN_SITE(3, base + 2)
                const bf16* Wt = (const bf16*)(ws + WS_WA_OUT + (size_t)j * WSZ_A_OUT); pg8::Gemm g{Y, Wt, MAINM, DM, DM}; pg8::StaticOrder S; S.init(MAINM, DM, G_, (int)blockIdx.x);
                pg8::EpiF32 E{Z, DM};
                pg8::gemm_phase<pg8::EpiF32, pg8::StaticOrder, true, true>(lds, g, S, E, wave);
                { LOCALS; skinny_rows_part(Y, Wt, DM, ZP, lds, tid_, wave_, lane_); }
                END_SITE(base + 2)
        } else if (kind == 1) {
            BEGIN_SITE(4, base + 0)
                const bf16* Wt = (const bf16*)(ws + WS_WB_IN); pg8::Gemm g{X, Wt, MAINM, 4096, DM}; pg8::StaticOrder S; S.init(MAINM, 4096, G_, (int)blockIdx.x);
                pg8::EpiBf16<0> E{BIG, NB_PAD, nullptr, 0, 0, 1.f};
                pg8::gemm_phase<pg8::EpiBf16<0>, pg8::StaticOrder, true, true>(lds, g, S, E, wave);
                { LOCALS; tail_cols_bf16<5>(X, Wt, DM, 4096, BIG, NB_PAD, lds, tid_, wave_, lane_); skinny_rows_bf16<0>(X, Wt, DM, 4224 / 64, BIG, NB_PAD, lds, tid_, wave_, lane_); }
                END_SITE(base + 0)
            BEGIN_SITE(5, base + 1) LOCALS; rope_phase(BIG, P, gw_, NGW, lane_); END_SITE(base + 1)
            BEGIN_SITE(6, base + 2) LOCALS; indexer_sample(P, lds, tid_); indexer_prompt(P, gw_, NGW, lane_); END_SITE(base + 2)
            BEGIN_SITE(7, base + 3) LOCALS; select_phase(P, lds, gw_, NGW, tid_, wave_, lane_); END_SITE(base + 3)
            BEGIN_SITE(8, base + 4) LOCALS; dense_attn_phase(P, Y, (char*)lds_raw, wave_); attn_phase(P, Y, lds, gw_, NGW, wave_, lane_); END_SITE(base + 4)
            BEGIN_SITE(9, base + 5)
                const bf16* Wt = (const bf16*)(ws + WS_WB_OUT); pg8::Gemm g{Y, Wt, MAINM, DM, DM}; pg8::StaticOrder S; S.init(MAINM, DM, G_, (int)blockIdx.x);
                pg8::EpiF32 E{Z, DM};
                pg8::gemm_phase<pg8::EpiF32, pg8::StaticOrder, true, true>(lds, g, S, E, wave);
                { LOCALS; skinny_rows_part(Y, Wt, DM, ZP, lds, tid_, wave_, lane_); }
                END_SITE(base + 5)
        } else {
            BEGIN_SITE(10, base + 0)
                const bf16* Wt = (const bf16*)(ws + WS_WC_IN); pg8::Gemm g{X, Wt, MAINM, 12288, DM}; pg8::StaticOrder S; S.init(MAINM, 12288, G_, (int)blockIdx.x);
                pg8::EpiBf16<0> E{BIG, NC_PAD, nullptr, 0, 0, 1.f};
                pg8::gemm_phase<pg8::EpiBf16<0>, pg8::StaticOrder, true, true>(lds, g, S, E, wave);
                { LOCALS; tail_cols_bf16<4>(X, Wt, DM, 12288, BIG, NC_PAD, lds, tid_, wave_, lane_); skinny_rows_bf16<0>(X, Wt, DM, NC_IN / 64, BIG, NC_PAD, lds, tid_, wave_, lane_); }
                END_SITE(base + 0)
            BEGIN_SITE(11, base + 1) LOCALS; convC_phase(BIG, P, gw_, NGW, lane_); END_SITE(base + 1)
            BEGIN_SITE(19, base + 2) LOCALS; delta_pre(P.ws, lds, gw_, NGW, wave_, lane_); delta_phase(P, wave_, lane_); END_SITE(base + 2)
            BEGIN_SITE(22, base + 5) LOCALS; delta_d4(P.ws, P.out + O_DP, lds, tid_, wave_, lane_); END_SITE(base + 5)
            BEGIN_SITE(13, base + 6) LOCALS; normC_phase(BIG, Y, P, gw_, NGW, lane_); END_SITE(base + 6)
            BEGIN_SITE(14, base + 7)
                const bf16* Wt = (const bf16*)(ws + WS_WC_OUT); pg8::Gemm g{Y, Wt, MAINM, DM, DVW}; pg8::StaticOrder S; S.init(MAINM, DM, G_, (int)blockIdx.x);
                pg8::EpiF32 E{Z, DM};
                pg8::gemm_phase<pg8::EpiF32, pg8::StaticOrder, true, true>(lds, g, S, E, wave);
                { LOCALS; skinny_rows_part(Y, Wt, DVW, ZP, lds, tid_, wave_, lane_); }
                END_SITE(base + 7)
        }
        BEGIN_SITE(15, base + 8) LOCALS; ln_phase(Z, ZP, X, rp_ == 0 ? X : (bf16*)(P.ws + WS_QR), P.ln1_g + (size_t)layer * DM, P.ln1_b + (size_t)layer * DM, nullptr, nullptr, gw_, NGW, lane_); END_SITE(base + 8)
        BEGIN_SITE(16, base + 9)
            const bf16* Wt = (const bf16*)(ws + WS_W1 + (size_t)layer * WSZ_W1); pg8::Gemm g{X, Wt, MAINM, FF, DM}; pg8::StaticOrder S; S.init(MAINM, FF, G_, (int)blockIdx.x);
            pg8::EpiBf16<2> E{BIG, FF, nullptr, 0, 0, 1.f};
            pg8::gemm_phase<pg8::EpiBf16<2>, pg8::StaticOrder, true, true>(lds, g, S, E, wave);
            { LOCALS; skinny_rows_bf16<2>(X, Wt, DM, FF / 64, BIG, FF, lds, tid_, wave_, lane_); }
            END_SITE(base + 9)
        BEGIN_SITE(17, base + 10)
            const bf16* Wt = (const bf16*)(ws + WS_W2 + (size_t)layer * WSZ_W2); pg8::Gemm g{BIG, Wt, MAINM, DM, FF}; pg8::StaticOrder S; S.init(MAINM, DM, G_, (int)blockIdx.x);
            pg8::EpiF32 E{Z, DM};
            pg8::gemm_phase<pg8::EpiF32, pg8::StaticOrder, true, true>(lds, g, S, E, wave);
            { LOCALS; skinny_rows_part(BIG, Wt, FF, ZP, lds, tid_, wave_, lane_); }
            END_SITE(base + 10)
        BEGIN_SITE(18, base + 11)
            const bool last = layer == 3;
            LOCALS; ln_phase(Z, ZP, X, rp_ == 0 ? X : (bf16*)(P.ws + WS_QR), P.ln2_g + (size_t)layer * DM, P.ln2_b + (size_t)layer * DM, last ? P.out + O_YP : nullptr, last ? P.out + O_YS : nullptr, gw_, NGW, lane_);
            if (!last) SEAM(base + 11); } }
    }
#undef IN
#undef SEAM
}

#ifndef MK_SPLIT
#define MK_SPLIT 0
#endif
extern "C" void kernel_launch(void* const* d_in, const int* in_sizes, int n_in, void* d_out, int out_size, void* d_ws, size_t ws_size, hipStream_t stream) {
    static int grid = 0;
    if (grid == 0) {
        if (n_in != 27 || (size_t)out_size != O_END || ws_size < WS_END) { fprintf(stderr, "kernel_launch: unexpected shapes: n_in %d out %d (want %zu) ws %zu (want >= %zu)\n", n_in, out_size, (size_t)O_END, ws_size, (size_t)WS_END); grid = -1; return; }
        int dev = 0, cus = 0;
        if (hipGetDevice(&dev) != hipSuccess || hipDeviceGetAttribute(&cus, hipDeviceAttributeMultiprocessorCount, dev) != hipSuccess) { grid = -1; return; }
        if (hipFuncSetAttribute((const void*)mega_fwd, hipFuncAttributeMaxDynamicSharedMemorySize, LDS_BYTES) != hipSuccess) { fprintf(stderr, "kernel_launch: hipFuncSetAttribute failed\n"); grid = -1; return; }
        int per_cu = 0;
        if (hipOccupancyMaxActiveBlocksPerMultiprocessor(&per_cu, (const void*)mega_fwd, NTHREADS, LDS_BYTES) != hipSuccess || per_cu < 1) fprintf(stderr, "kernel_launch: occupancy query reports %d\n", per_cu);
        (void)hipGetLastError();
        grid = cus;
    }
    if (grid < 0) return;
    (void)hipMemsetAsync((char*)d_ws + WS_CTL, 0, CTL_ZERO_BYTES, stream);
    Args a{};
    for (int i = 0; i < 27; ++i) a.in[i] = d_in[i];
    a.out = (float*)d_out; a.ws = (unsigned char*)d_ws;
#if MK_SPLIT
    for (int ph = 0; ph < PH_END; ++ph) {
        bool exists = (ph == 0);
        if (ph > 0) { const int layer = (ph - 1) / PH_PER_LAYER, l = (ph - 1) % PH_PER_LAYER, kind = layer % 3; const int nmix = kind == 0 ? 3 : (kind == 1 ? 6 : 8); exists = (l < nmix) || (l >= 8 && l <= 11); }
        if (!exists) continue;
        a.ph_lo = ph; a.ph_hi = ph + 1;
        hipLaunchKernelGGL(mega_fwd, dim3(grid), dim3(NTHREADS), LDS_BYTES, stream, a);
    }
#else
    a.ph_lo = 0; a.ph_hi = PH_END;
    hipLaunchKernelGGL(mega_fwd, dim3(grid), dim3(NTHREADS), LDS_BYTES, stream, a);
#endif
    const hipError_t le = hipPeekAtLastError();
    if (le != hipSuccess) fprintf(stderr, "kernel_launch: launch failed: %s\n", hipGetErrorName(le));
}
```

```cpp
#include <hip/hip_runtime.h>
#include <cstdio>
#include <cstdint>
#include <cmath>
__device__ __forceinline__ int flane() { return (int)__builtin_amdgcn_mbcnt_hi(~0u, __builtin_amdgcn_mbcnt_lo(~0u, 0u)); }
namespace pg8 {
#define PG8_LAS __attribute__((address_space(3)))
typedef unsigned short bf16_t;
typedef short bf16x8 __attribute__((ext_vector_type(8)));
typedef float f32x4 __attribute__((ext_vector_type(4)));
typedef unsigned u32x4 __attribute__((ext_vector_type(4)));
constexpr int BM = 256, BK = 64, HALF = 128, HTB = HALF * BK * 2  , STAGE_BYTES = 8 * HTB, NXCD = 8, WGM = 8;

__host__ __device__ __forceinline__ int lds_byte(int r, int c) { const int st = (r >> 4) * 2 + (c >> 5), rr = r & 15, cc = c & 31, ob = rr * 64 + cc * 2; return st * 1024 + (ob ^ (((ob >> 9) & 1) << 5)); }
__host__ __device__ __forceinline__ void stage_rc(int b, int& R, int& C) { const int st = b / 1024, sb = b % 1024, swz = sb ^ (((sb >> 9) & 1) << 5); R = (st >> 1) * 16 + swz / 64; C = (st & 1) * 32 + (swz % 64) / 2; }
__host__ __device__ __forceinline__ int perm32(int rho) { const int n = rho >> 4, i = rho & 15; return 8 * (i >> 2) + 4 * n + (i & 3); }

struct Unit { int pm, pn; };
struct Gemm { const bf16_t* A; const bf16_t* Bt; int M, N, K; };

struct StaticOrder {
    int nM, nN, nwg, G, c;
    __host__ __device__ void init(int M, int N, int G_, int c_) { nM = M / BM; nN = N / BM; nwg = nM * nN; G = G_; c = c_; }
    __host__ __device__ bool next(int i, Unit& u) const {
        const long L = (long)i * G + c; if (L >= nwg) return false;
        int wgid = (int)L; { const int q = nwg / NXCD, r = nwg % NXCD, xcd = wgid % NXCD, off = wgid / NXCD; wgid = (xcd < r ? xcd * (q + 1) : r * (q + 1) + (xcd - r) * q) + off; }
        const int nig = WGM * nN, gid = wgid / nig, fm = gid * WGM, gsz = (nM - fm) < WGM ? (nM - fm) : WGM;
        u.pm = fm + ((wgid % nig) % gsz); u.pn = (wgid % nig) / gsz; return true;
    }
    __device__ __forceinline__ void a_ready(const Unit&) const {}
    __device__ __forceinline__ void done(const Unit&) const {}
};

__device__ __forceinline__ unsigned cvt_pk_bf16(float lo, float hi) { unsigned r; asm volatile("v_cvt_pk_bf16_f32 %0, %1, %2" : "=v"(r) : "v"(lo), "v"(hi)); return r; }
typedef float f32x2 __attribute__((ext_vector_type(2)));
__device__ __forceinline__ f32x2 gelu_pk(f32x2 v) {
    const f32x2 av = __builtin_elementwise_abs(v), d = av * 0.2316418882f + 1.0f;
    f32x2 t; t.x = __builtin_amdgcn_rcpf(d.x); t.y = __builtin_amdgcn_rcpf(d.y);
    f32x2 q = t * 0.5307027145f + (-0.7265760135f); q = q * t + 0.7107068705f; q = q * t + (-0.142248368f); q = q * t + 0.127414796f; q = q * t;
    const f32x2 s = (v * v) * (-0.72134752044f);
    f32x2 e; e.x = __builtin_amdgcn_exp2f(s.x); e.y = __builtin_amdgcn_exp2f(s.y);
    const f32x2 m = v * (q * e), r = v - m;
    f32x2 o; o.x = v.x < 0.f ? m.x : r.x; o.y = v.y < 0.f ? m.y : r.y; return o;
}

template <int ACT  > struct EpiBf16 {
    static constexpr bool PERM = true, AFTER_DRAIN = false; static_assert(ACT == 0 || ACT == 1 || ACT == 2, "EpiBf16: ACT is 0 (none), 1 (gelu_pk) or 2 (relu^2)");
    bf16_t* O; int ldc; const float* bias; int split_cols; size_t split_stride; float scale0;
    __device__ __forceinline__ void operator()(const f32x4 (&acc)[2][2][4][2], const Unit& u, int wr, int wc, int fr, int fq) const {
        const int row0 = u.pm * BM + wr * 64 + fr; int colt = u.pn * BM; bf16_t* base = O;
        float sc = 1.f; if (split_cols) { const int t = colt / split_cols; base += (size_t)t * split_stride; colt -= t * split_cols; if (t == 0) sc = scale0; }
        const int col0 = colt + wc * 32 + 8 * fq, bcol0 = u.pn * BM + wc * 32 + 8 * fq;
        f32x4 bv[2][2];
#pragma unroll
        for (int bj = 0; bj < 2; ++bj)
#pragma unroll
            for (int n = 0; n < 2; ++n) bv[bj][n] = bias ? *(const f32x4*)(bias + bcol0 + bj * HALF + 4 * n) : (f32x4){0.f, 0.f, 0.f, 0.f};
#pragma unroll
        for (int ai = 0; ai < 2; ++ai)
#pragma unroll
            for (int m = 0; m < 4; ++m) { bf16_t* rowp = base + (size_t)(row0 + ai * HALF + m * 16) * ldc + col0;
#pragma unroll
                for (int bj = 0; bj < 2; ++bj) { f32x4 v0 = acc[ai][bj][m][0] + bv[bj][0], v1 = acc[ai][bj][m][1] + bv[bj][1];
                    if (ACT == 1) { f32x2 a = gelu_pk((f32x2){v0[0], v0[1]}), b = gelu_pk((f32x2){v0[2], v0[3]}), c = gelu_pk((f32x2){v1[0], v1[1]}), d = gelu_pk((f32x2){v1[2], v1[3]});
                        v0 = (f32x4){a.x, a.y, b.x, b.y}; v1 = (f32x4){c.x, c.y, d.x, d.y}; }
                    if (ACT == 2) { _Pragma("unroll") for (int q_ = 0; q_ < 4; ++q_) { const float a_ = v0[q_] > 0.f ? v0[q_] : 0.f, b_ = v1[q_] > 0.f ? v1[q_] : 0.f; v0[q_] = a_ * a_; v1[q_] = b_ * b_; } }
                    v0 = v0 * sc; v1 = v1 * sc; u32x4 w; w.x = cvt_pk_bf16(v0[0], v0[1]); w.y = cvt_pk_bf16(v0[2], v0[3]); w.z = cvt_pk_bf16(v1[0], v1[1]); w.w = cvt_pk_bf16(v1[2], v1[3]);
                    *(u32x4*)(rowp + bj * HALF) = w; } }
    }
};


struct EpiF32 {
    static constexpr bool PERM = false, AFTER_DRAIN = false;
    float* C; int ldc;
    __device__ __forceinline__ void operator()(const f32x4 (&acc)[2][2][4][2], const Unit& u, int wr, int wc, int fr, int fq) const {
        const int row0 = u.pm * BM + wr * 64 + fr, col0 = u.pn * BM + wc * 32 + 4 * fq;
#pragma unroll
        for (int ai = 0; ai < 2; ++ai)
#pragma unroll
            for (int m = 0; m < 4; ++m) { float* rowp = C + (size_t)(row0 + ai * HALF + m * 16) * ldc + col0;
#pragma unroll
                for (int bj = 0; bj < 2; ++bj)
#pragma unroll
                    for (int n = 0; n < 2; ++n) *(f32x4*)(rowp + bj * HALF + n * 16) = acc[ai][bj][m][n]; }
    }
};
struct PanelStats {
    unsigned* xbuf;
    unsigned* cnt;
    unsigned* tmo;
    int ntn; float eps;
    unsigned code;
    __device__ __forceinline__ bool run(const f32x4 (&v)[2][2][4][2], const Unit& u, int wr, int wc, int fr, int fq, PG8_LAS unsigned char* lds, int wid, int lane) const {
        typedef float f32x2v __attribute__((ext_vector_type(2)));
        PG8_LAS f32x2v* P = (PG8_LAS f32x2v*)lds;
        PG8_LAS f32x2v* S = (PG8_LAS f32x2v*)(lds + 8192);
        PG8_LAS unsigned* flag = (PG8_LAS unsigned*)(lds + 8192 + 2048);
#pragma unroll
        for (int ai = 0; ai < 2; ++ai)
#pragma unroll
            for (int m = 0; m < 4; ++m) {
                float s = 0.f;
#pragma unroll
                for (int bj = 0; bj < 2; ++bj)
#pragma unroll
                    for (int n = 0; n < 2; ++n) { const f32x4 x = v[ai][bj][m][n]; s += (x[0] + x[1]) + (x[2] + x[3]); }
                s += __shfl_xor(s, 16); s += __shfl_xor(s, 32);
                const float mw = s * (1.0f / 64.0f); float q = 0.f;
#pragma unroll
                for (int bj = 0; bj < 2; ++bj)
#pragma unroll
                    for (int n = 0; n < 2; ++n) { const f32x4 d = v[ai][bj][m][n] - mw; q += (d[0] * d[0] + d[1] * d[1]) + (d[2] * d[2] + d[3] * d[3]); }
                q += __shfl_xor(q, 16); q += __shfl_xor(q, 32);
                if (fq == 0) P[(ai * HALF + wr * 64 + m * 16 + fr) * 4 + wc] = (f32x2v){mw, q};
            }
        asm volatile("s_waitcnt lgkmcnt(0)" ::: "memory"); __builtin_amdgcn_s_barrier(); asm volatile("" ::: "memory");
#if defined(BROKEN_EXCHANGE_NO_WAIT)
#warning BROKEN CONTROL BUILD: the row-statistics exchange does not wait; results are wrong by design
        if (blockIdx.x >= 64) { const long long t0_ = clock64(); while (clock64() - t0_ < 60000) __builtin_amdgcn_s_sleep(8); }
#endif
        const int row = wid * 32 + (lane & 31);
        if (lane < 32) {
            const f32x2v a = P[row * 4 + 0], b = P[row * 4 + 1], c = P[row * 4 + 2], d = P[row * 4 + 3];
            const float mt = (a.x + b.x + c.x + d.x) * 0.25f;
            const float da = a.x - mt, db = b.x - mt, dc = c.x - mt, dd = d.x - mt;
            const float m2 = (a.y + b.y) + (c.y + d.y) + 64.0f * ((da * da + db * db) + (dc * dc + dd * dd));
            unsigned long long* slot = (unsigned long long*)xbuf + ((size_t)(u.pm * BM + row) * 4 + u.pn);
            __hip_atomic_store(slot, ((unsigned long long)__float_as_uint(m2) << 32) | __float_as_uint(mt), __ATOMIC_RELAXED, __HIP_MEMORY_SCOPE_AGENT);
        }
        asm volatile("s_waitcnt vmcnt(0)" ::: "memory");
        if (lane == 0) __hip_atomic_fetch_add(cnt + 64 * u.pm, 1u, __ATOMIC_RELAXED, __HIP_MEMORY_SCOPE_AGENT);
        if (wid == 0) {
            bool dead = false; const unsigned long long t0 = __builtin_amdgcn_s_memrealtime(); const unsigned want = 8u * (unsigned)ntn;
            for (;;) {
#if defined(BROKEN_EXCHANGE_NO_WAIT)
                break;
#endif
                if ((unsigned)__builtin_amdgcn_readfirstlane(__hip_atomic_load(cnt + 64 * u.pm, __ATOMIC_RELAXED, __HIP_MEMORY_SCOPE_AGENT)) >= want) break;
                if (__builtin_amdgcn_s_memrealtime() - t0 > 2000000ull) {
                    if (lane == 0) { unsigned expect = 0u; __hip_atomic_compare_exchange_strong(tmo + 1, &expect, code | (unsigned)(u.pm & 0xff), __ATOMIC_RELAXED, __ATOMIC_RELAXED, __HIP_MEMORY_SCOPE_AGENT);
                                     __hip_atomic_store(tmo, 1u, __ATOMIC_RELAXED, __HIP_MEMORY_SCOPE_AGENT); }
                    dead = true; break; }
                __builtin_amdgcn_s_sleep(2);
            }
            __builtin_amdgcn_fence(__ATOMIC_ACQUIRE, "agent");
            if (lane == 0) flag[0] = dead ? 1u : 0u;
        }
        asm volatile("s_waitcnt vmcnt(0) lgkmcnt(0)" ::: "memory"); __builtin_amdgcn_s_barrier(); asm volatile("" ::: "memory");
        const bool bad = flag[0] != 0u;
        if (lane < 32) {
            const unsigned long long* slot = (const unsigned long long*)xbuf + (size_t)(u.pm * BM + row) * 4; float mt[4], m2[4]; float ms = 0.f;
#pragma unroll
            for (int t = 0; t < 4; ++t) { if (t < ntn) { const unsigned long long w = __hip_atomic_load(slot + t, __ATOMIC_RELAXED, __HIP_MEMORY_SCOPE_AGENT); mt[t] = __uint_as_float((unsigned)w); m2[t] = __uint_as_float((unsigned)(w >> 32)); } else { mt[t] = 0.f; m2[t] = 0.f; } ms += mt[t]; }
            const float mean = ms / (float)ntn; float q = 0.f;
#pragma unroll
            for (int t = 0; t < 4; ++t) if (t < ntn) { const float dm = mt[t] - mean; q += m2[t] + 256.0f * dm * dm; }
            S[row] = (f32x2v){mean, 1.0f / sqrtf(q / (256.0f * (float)ntn) + eps)};
        }
        asm volatile("s_waitcnt lgkmcnt(0)" ::: "memory"); __builtin_amdgcn_s_barrier(); asm volatile("" ::: "memory");
        return bad;
    }
};
struct EpiLnRes {
    static constexpr bool PERM = false, AFTER_DRAIN = true;
    const float* base; float* out; int ldc; const float* bias; PanelStats st; unsigned poison;
    __device__ __forceinline__ void fused(f32x4 (&acc)[2][2][4][2], const Unit& u, int wr, int wc, int fr, int fq, PG8_LAS unsigned char* lds, int wid, int lane) const {
        typedef float f32x2v __attribute__((ext_vector_type(2)));
        const PG8_LAS f32x2v* S = (const PG8_LAS f32x2v*)(lds + 8192);
        const int col0 = u.pn * BM + wc * 32 + 4 * fq;
#pragma unroll
        for (int bj = 0; bj < 2; ++bj)
#pragma unroll
            for (int n = 0; n < 2; ++n) { const f32x4 bv = bias ? *(const f32x4*)(bias + col0 + bj * HALF + n * 16) : (f32x4){0.f, 0.f, 0.f, 0.f};
#pragma unroll
                for (int ai = 0; ai < 2; ++ai)
#pragma unroll
                    for (int m = 0; m < 4; ++m) acc[ai][bj][m][n] += bv; }
        f32x4 pre[4][2][2];
#pragma unroll
        for (int m = 0; m < 4; ++m) { const size_t off = (size_t)(u.pm * BM + wr * 64 + m * 16 + fr) * ldc + col0;
#pragma unroll
            for (int bj = 0; bj < 2; ++bj)
#pragma unroll
                for (int n = 0; n < 2; ++n) pre[m][bj][n] = *(const f32x4*)(base + off + bj * HALF + n * 16); }
        const bool bad = st.run(acc, u, wr, wc, fr, fq, lds, wid, lane) || poison != 0u;
        const float qnan = __builtin_nanf("");
#pragma unroll
        for (int ai = 0; ai < 2; ++ai)
#pragma unroll
            for (int m = 0; m < 4; ++m) { const int r = ai * HALF + wr * 64 + m * 16 + fr; const f32x2v sr = S[r]; const size_t off = (size_t)(u.pm * BM + r) * ldc + col0;
#pragma unroll
                for (int bj = 0; bj < 2; ++bj)
#pragma unroll
                    for (int n = 0; n < 2; ++n) { const f32x4 bs = ai == 0 ? pre[m][bj][n] : *(const f32x4*)(base + off + bj * HALF + n * 16); f32x4 o = bs + (acc[ai][bj][m][n] - sr.x) * sr.y;
                        if (bad) o = (f32x4){qnan, qnan, qnan, qnan}; *(f32x4*)(out + off + bj * HALF + n * 16) = o; }
                if (m & 1) asm volatile("" ::: "memory"); }
    }
};
struct EpiLnResLn {
    static constexpr bool PERM = false, AFTER_DRAIN = true;
    const float* base; float* out; bf16_t* xn; int ldc; const float* bias; PanelStats st1, st2; unsigned poison;
    __device__ __forceinline__ void fused(f32x4 (&acc)[2][2][4][2], const Unit& u, int wr, int wc, int fr, int fq, PG8_LAS unsigned char* lds, int wid, int lane) const {
        typedef float f32x2v __attribute__((ext_vector_type(2))); typedef unsigned u32x2v __attribute__((ext_vector_type(2)));
        const PG8_LAS f32x2v* S = (const PG8_LAS f32x2v*)(lds + 8192);
        const int col0 = u.pn * BM + wc * 32 + 4 * fq;
#pragma unroll
        for (int bj = 0; bj < 2; ++bj)
#pragma unroll
            for (int n = 0; n < 2; ++n) { const f32x4 bv = bias ? *(const f32x4*)(bias + col0 + bj * HALF + n * 16) : (f32x4){0.f, 0.f, 0.f, 0.f};
#pragma unroll
                for (int ai = 0; ai < 2; ++ai)
#pragma unroll
                    for (int m = 0; m < 4; ++m) acc[ai][bj][m][n] += bv; }
        bool bad = st1.run(acc, u, wr, wc, fr, fq, lds, wid, lane) || poison != 0u;
        const float qnan = __builtin_nanf("");
#pragma unroll
        for (int ai = 0; ai < 2; ++ai)
#pragma unroll
            for (int m = 0; m < 4; ++m) { const int r = ai * HALF + wr * 64 + m * 16 + fr; const f32x2v sr = S[r]; const size_t off = (size_t)(u.pm * BM + r) * ldc + col0;
#pragma unroll
                for (int bj = 0; bj < 2; ++bj)
#pragma unroll
                    for (int n = 0; n < 2; ++n) { const f32x4 bs = *(const f32x4*)(base + off + bj * HALF + n * 16); acc[ai][bj][m][n] = bs + (acc[ai][bj][m][n] - sr.x) * sr.y; }
                asm volatile("" : "+v"(acc[ai][0][m][0]), "+v"(acc[ai][0][m][1]), "+v"(acc[ai][1][m][0]), "+v"(acc[ai][1][m][1]));
                if (m & 1) asm volatile("" ::: "memory"); }
        const bool bad1 = bad;
        bad = st2.run(acc, u, wr, wc, fr, fq, lds, wid, lane) || bad;
#pragma unroll
        for (int ai = 0; ai < 2; ++ai)
#pragma unroll
            for (int m = 0; m < 4; ++m) { const int r = ai * HALF + wr * 64 + m * 16 + fr; const f32x2v sr = S[r]; const size_t off = (size_t)(u.pm * BM + r) * ldc + col0;
#pragma unroll
                for (int bj = 0; bj < 2; ++bj)
#pragma unroll
                    for (int n = 0; n < 2; ++n) { const f32x4 x1 = acc[ai][bj][m][n]; *(f32x4*)(out + off + bj * HALF + n * 16) = bad1 ? (f32x4){qnan, qnan, qnan, qnan} : x1;
                        const f32x4 o = (x1 - sr.x) * sr.y; u32x2v w; w.x = cvt_pk_bf16(o[0], o[1]); w.y = cvt_pk_bf16(o[2], o[3]);
                        if (bad) { w.x = 0x7fc07fc0u; w.y = 0x7fc07fc0u; } *(u32x2v*)(xn + off + bj * HALF + n * 16) = w; }
                asm volatile("" ::: "memory"); }
    }
};

template <class Epi, class Sched, bool ALIGN_EPI = false, bool SP2 = false>
__device__ __forceinline__ void gemm_phase(PG8_LAS unsigned char* lds, const Gemm g, const Sched& S, const Epi& E, int wv) {
    int tid0_ = threadIdx.x; asm volatile("" : "+v"(tid0_)); (void)wv;
    const int tid = tid0_, wid = __builtin_amdgcn_readfirstlane(tid >> 6), lane = tid & 63, wr = wid >> 2, wc = wid & 3, fr = lane & 15, fq = lane >> 4;
    const int K = g.K, nt = K / BK;
    unsigned voffA[2], voffB[2];
#pragma unroll
    for (int i = 0; i < 2; ++i) { int R, C; stage_rc(tid * 16 + i * 8192, R, C); const int Rb = Epi::PERM ? ((R & ~31) + perm32(R & 31)) : R;
        voffA[i] = (unsigned)(R * K + C) * 2u; voffB[i] = (unsigned)(Rb * K + C) * 2u; }
    const size_t kstep = (size_t)(BK * 2);
    const size_t hstep = (size_t)HALF * K * 2;
    const size_t tstep = 2 * hstep;
    const unsigned ldsw = (unsigned)wid * 1024u;
    const int aoff = lds_byte(wr * 64 + fr, fq * 8), boff = lds_byte(wc * 32 + fr, fq * 8);
#define PG8_SA(b, h) (((b) * 2 + (h)) * HTB)
#define PG8_SB(b, h) ((4 + (b) * 2 + (h)) * HTB)
#define PG8_STAGE(bufoff, gbase, voff) do { _Pragma("unroll") for (int _i = 0; _i < 2; ++_i) \
        __builtin_amdgcn_global_load_lds((const unsigned*)((const char*)(gbase) + (voff)[_i]), (PG8_LAS unsigned*)(lds + (bufoff) + ldsw + _i * 8192), 16, 0, 0); } while (0)
#define PG8_LDA(dst, b, h) do { _Pragma("unroll") for (int m = 0; m < 4; ++m) _Pragma("unroll") for (int k = 0; k < 2; ++k) dst[m][k] = *(const PG8_LAS bf16x8*)(lds + PG8_SA(b, h) + aoff + m * 2048 + k * 1024); } while (0)
#define PG8_LDB(dst, b, h) do { _Pragma("unroll") for (int n = 0; n < 2; ++n) _Pragma("unroll") for (int k = 0; k < 2; ++k) dst[n][k] = *(const PG8_LAS bf16x8*)(lds + PG8_SB(b, h) + boff + n * 2048 + k * 1024); } while (0)
#define PG8_MMA(ai, bj, At, Bt) do { __builtin_amdgcn_s_setprio(1); _Pragma("unroll") for (int m = 0; m < 4; ++m) _Pragma("unroll") for (int n = 0; n < 2; ++n) _Pragma("unroll") for (int k = 0; k < 2; ++k) \
        acc[ai][bj][m][n] = __builtin_amdgcn_mfma_f32_16x16x32_bf16(Bt[n][k], At[m][k], acc[ai][bj][m][n], 0, 0, 0); __builtin_amdgcn_s_setprio(0); } while (0)
#define PG8_WAIT_V(n) asm volatile("s_waitcnt vmcnt(" #n ")" ::: "memory")
#define PG8_WAIT_L(n) asm volatile("s_waitcnt lgkmcnt(" #n ")" ::: "memory")
#define PG8_BAR __builtin_amdgcn_s_barrier()
#define PG8_SCHED __builtin_amdgcn_sched_barrier(0)
    Unit cur, nxt; int ui = 0;
    if (!S.next(0, cur)) return;
    f32x4 acc[2][2][4][2];
#pragma unroll
    for (int a = 0; a < 2; ++a)
#pragma unroll
        for (int b = 0; b < 2; ++b)
#pragma unroll
            for (int m = 0; m < 4; ++m)
#pragma unroll
                for (int n = 0; n < 2; ++n) acc[a][b][m][n] = (f32x4){0.f, 0.f, 0.f, 0.f};
    bf16x8 At[4][2], B0[2][2], B1[2][2];
    const char* cA = (const char*)g.A + (size_t)cur.pm * tstep; const char* cB = (const char*)g.Bt + (size_t)cur.pn * tstep;
    S.a_ready(cur);
    if constexpr (SP2) {
        PG8_STAGE(PG8_SB(0, 0), cB, voffB); PG8_STAGE(PG8_SB(0, 1), cB + hstep, voffB); PG8_STAGE(PG8_SA(0, 0), cA, voffA); PG8_STAGE(PG8_SA(0, 1), cA + hstep, voffA);
        if (wr == 1) PG8_BAR;
        PG8_WAIT_V(2); PG8_BAR;
        PG8_STAGE(PG8_SB(1, 0), cB + kstep, voffB); PG8_STAGE(PG8_SA(1, 0), cA + kstep, voffA); PG8_STAGE(PG8_SB(1, 1), cB + hstep + kstep, voffB);
        PG8_WAIT_V(6); PG8_BAR;
    } else {
        PG8_STAGE(PG8_SB(0, 0), cB, voffB); PG8_STAGE(PG8_SA(0, 0), cA, voffA); PG8_STAGE(PG8_SB(0, 1), cB + hstep, voffB); PG8_STAGE(PG8_SA(0, 1), cA + hstep, voffA);
        if (wr == 1) PG8_BAR;
        PG8_WAIT_V(4); PG8_BAR;
        PG8_STAGE(PG8_SB(1, 0), cB + kstep, voffB); PG8_STAGE(PG8_SA(1, 0), cA + kstep, voffA); PG8_STAGE(PG8_SB(1, 1), cB + hstep + kstep, voffB);
        PG8_WAIT_V(6); PG8_BAR;
    }
    for (;;) {
        const bool has_next = S.next(ui + 1, nxt);
        const char* nA = has_next ? (const char*)g.A + (size_t)nxt.pm * tstep : cA; const char* nB = has_next ? (const char*)g.Bt + (size_t)nxt.pn * tstep : cB;
        for (int t = 0; t < nt; t += 2) {
            const bool last = (t == nt - 2);
            const char* a1 = cA + (size_t)(t + 1) * kstep;
            const char* a2 = last ? nA : cA + (size_t)(t + 2) * kstep; const char* b2 = last ? nB : cB + (size_t)(t + 2) * kstep;
            const char* a3 = a2 + kstep; const char* b3 = b2 + kstep;
            if (last && has_next) S.a_ready(nxt);
            if constexpr (SP2) {
            PG8_LDB(B0, 0, 0); PG8_LDB(B1, 0, 1); PG8_SCHED; PG8_LDA(At, 0, 0); PG8_STAGE(PG8_SA(1, 1), a1 + hstep, voffA);
            PG8_WAIT_V(8); PG8_WAIT_L(0); PG8_BAR; PG8_MMA(0, 0, At, B0); PG8_MMA(0, 1, At, B1); PG8_BAR; PG8_SCHED;
            PG8_LDA(At, 0, 1); PG8_STAGE(PG8_SB(0, 0), b2, voffB); PG8_STAGE(PG8_SB(0, 1), b2 + hstep, voffB); PG8_STAGE(PG8_SA(0, 0), a2, voffA);
            PG8_WAIT_V(8); PG8_WAIT_L(0); PG8_BAR; PG8_MMA(1, 0, At, B0); PG8_MMA(1, 1, At, B1); PG8_BAR; PG8_SCHED;
            PG8_LDB(B0, 1, 0); PG8_LDB(B1, 1, 1); PG8_SCHED; PG8_LDA(At, 1, 0); PG8_STAGE(PG8_SA(0, 1), a2 + hstep, voffA);
            PG8_WAIT_V(8); PG8_WAIT_L(0); PG8_BAR; PG8_MMA(0, 0, At, B0); PG8_MMA(0, 1, At, B1); PG8_BAR; PG8_SCHED;
            PG8_LDA(At, 1, 1); PG8_STAGE(PG8_SB(1, 0), b3, voffB); PG8_STAGE(PG8_SB(1, 1), b3 + hstep, voffB); PG8_STAGE(PG8_SA(1, 0), a3, voffA);
            PG8_WAIT_V(8); PG8_WAIT_L(0); PG8_BAR; PG8_MMA(1, 0, At, B0); PG8_MMA(1, 1, At, B1); PG8_BAR; PG8_SCHED;
            } else {
            PG8_LDB(B0, 0, 0); PG8_SCHED; PG8_LDA(At, 0, 0); PG8_STAGE(PG8_SA(1, 1), a1 + hstep, voffA);
            PG8_WAIT_L(8); PG8_BAR; PG8_WAIT_L(0); PG8_MMA(0, 0, At, B0); PG8_BAR; PG8_SCHED;
            PG8_LDB(B1, 0, 1); PG8_STAGE(PG8_SB(0, 0), b2, voffB);
            PG8_BAR; PG8_WAIT_L(0); PG8_MMA(0, 1, At, B1); PG8_BAR;
            PG8_LDA(At, 0, 1); PG8_STAGE(PG8_SA(0, 0), a2, voffA);
            PG8_BAR; PG8_WAIT_L(0); PG8_MMA(1, 0, At, B0); PG8_BAR; PG8_SCHED;
            PG8_STAGE(PG8_SB(0, 1), b2 + hstep, voffB);
            PG8_WAIT_V(6); PG8_BAR; PG8_MMA(1, 1, At, B1); PG8_BAR;
            PG8_LDB(B0, 1, 0); PG8_SCHED; PG8_LDA(At, 1, 0); PG8_STAGE(PG8_SA(0, 1), a2 + hstep, voffA);
            PG8_WAIT_L(8); PG8_BAR; PG8_WAIT_L(0); PG8_MMA(0, 0, At, B0); PG8_BAR; PG8_SCHED;
            PG8_LDB(B1, 1, 1); PG8_STAGE(PG8_SB(1, 0), b3, voffB);
            PG8_BAR; PG8_WAIT_L(0); PG8_MMA(0, 1, At, B1); PG8_BAR;
            PG8_LDA(At, 1, 1); PG8_STAGE(PG8_SA(1, 0), a3, voffA);
            PG8_BAR; PG8_WAIT_L(0); PG8_MMA(1, 0, At, B0); PG8_BAR; PG8_SCHED;
            PG8_STAGE(PG8_SB(1, 1), b3 + hstep, voffB);
            PG8_WAIT_V(6); PG8_BAR; PG8_MMA(1, 1, At, B1); PG8_BAR;
            }
        }
        if constexpr (ALIGN_EPI) { if (wr == 0) PG8_BAR; }
        if constexpr (!Epi::AFTER_DRAIN) { E(acc, cur, wr, wc, fr, fq); S.done(cur); }
        if (!has_next) break;
#pragma unroll
        for (int a = 0; a < 2; ++a)
#pragma unroll
            for (int b = 0; b < 2; ++b)
#pragma unroll
                for (int m = 0; m < 4; ++m)
#pragma unroll
                    for (int n = 0; n < 2; ++n) acc[a][b][m][n] = (f32x4){0.f, 0.f, 0.f, 0.f};
        cur = nxt; cA = nA; cB = nB; ++ui;
        if constexpr (ALIGN_EPI) { if (wr == 1) PG8_BAR; }
    }
    PG8_WAIT_V(0);
    if constexpr (!ALIGN_EPI) { if (wr == 0) PG8_BAR; }
    PG8_BAR;
    if constexpr (Epi::AFTER_DRAIN) { E.fused(acc, cur, wr, wc, fr, fq, lds, wid, lane); S.done(cur); }
#undef PG8_SA
#undef PG8_SB
#undef PG8_STAGE
#undef PG8_LDA
#undef PG8_LDB
#undef PG8_MMA
#undef PG8_WAIT_V
#undef PG8_WAIT_L
#undef PG8_BAR
#undef PG8_SCHED
}
}

#ifndef PG8_SP2
#define PG8_SP2 true
#endif
#ifndef PG8_ALIGN
#define PG8_ALIGN true
#endif
#define GAS __attribute__((address_space(1)))
#define LAS __attribute__((address_space(3)))
#define XB_TMO      128
#define XB_XCNT(j)  (256  + 64 * (j))
#define XB_XSUB(j)  (1280 + 64 * (j))
#define XB_XGEN(j)  (2304 + 64 * (j))
#define XB_TOP      3328
#define XB_TOPGEN   3392
#define XCD_BAR_WORDS 3456
#define XB_SPIN_CAP (1u << 18)

__device__ __forceinline__ unsigned xb_ld(unsigned* p)              { return __hip_atomic_load(p, __ATOMIC_RELAXED, __HIP_MEMORY_SCOPE_AGENT); }
__device__ __forceinline__ unsigned xb_add(unsigned* p, unsigned v) { return __hip_atomic_fetch_add(p, v, __ATOMIC_RELAXED, __HIP_MEMORY_SCOPE_AGENT); }
__device__ __forceinline__ unsigned xb_xcc_id() { return (unsigned)__builtin_amdgcn_s_getreg((3 << 11) | 20) & 0xFu; }
#define XB_SPIN(cond, bar) do { unsigned _sp = 0; while (cond) { __builtin_amdgcn_s_sleep(1); \
    if ((++_sp & 255u) == 0u) { if (xb_ld(&(bar)[XB_TMO])) break; if (_sp > XB_SPIN_CAP) { atomicAdd(&(bar)[XB_TMO], 1u); break; } } } } while (0)

struct XcdBarrier {
    unsigned* bar; unsigned x;
    volatile LAS unsigned* st;
    int wv;
};

__device__ __forceinline__ XcdBarrier xcd_barrier_post(unsigned* bar, volatile LAS unsigned* st) {
    XcdBarrier b; b.bar = bar; b.x = xb_xcc_id(); b.st = st;
    if (threadIdx.x == 0) (void)xb_add(&bar[XB_XCNT(b.x)], 1u);
    return b;
}
__device__ __forceinline__ void xcd_barrier_complete(unsigned* bar, unsigned x, unsigned& nloc, unsigned& nx) {
    asm volatile("" : "+s"(x));
    const unsigned G = gridDim.x * gridDim.y * gridDim.z;
    unsigned sum, cnt, mine, sp = 0u;
    for (;;) {
        sum = 0u; cnt = 0u; mine = 0u;
#pragma unroll
        for (unsigned j = 0; j < 16; ++j) { const unsigned c = xb_ld(&bar[XB_XCNT(j)]); sum += c; cnt += (c > 0u) ? 1u : 0u; mine = (j == x) ? c : mine; }
        if (sum == G) break;
        __builtin_amdgcn_s_sleep(1);
        if ((++sp & 255u) == 0u) { if (xb_ld(&bar[XB_TMO])) break; if (sp > XB_SPIN_CAP) { atomicAdd(&bar[XB_TMO], 1u); break; } }
    }
    nloc = mine > 0u ? mine : 1u; nx = cnt > 0u ? cnt : 1u;
}

__device__ __forceinline__ void xcd_barrier(const XcdBarrier& b) {
    asm volatile("s_waitcnt vmcnt(0)" ::: "memory");
    __syncthreads();
    if (threadIdx.x == 0) {
        unsigned* bar = b.bar; asm volatile("" : "+s"(bar));
        __builtin_amdgcn_s_waitcnt(0);
        unsigned nloc = b.st[0], nx = b.st[1];
        if (nloc == 0u) { xcd_barrier_complete(bar, b.x, nloc, nx); b.st[0] = nloc; b.st[1] = nx; }
        const unsigned old = xb_add(&bar[XB_XSUB(b.x)], 1u);
        const unsigned gen = old / nloc;
        if (old + 1u == (gen + 1u) * nloc) {
            __builtin_amdgcn_fence(__ATOMIC_RELEASE, "agent");
            asm volatile("s_waitcnt vmcnt(0)" ::: "memory");
            const unsigned og = xb_add(&bar[XB_TOP], 1u);
            const unsigned tg = og / nx;
            if (og + 1u == (tg + 1u) * nx) xb_add(&bar[XB_TOPGEN], 1u);
            else XB_SPIN(xb_ld(&bar[XB_TOPGEN]) == tg, bar);
            __builtin_amdgcn_fence(__ATOMIC_ACQUIRE, "agent");
            xb_add(&bar[XB_XGEN(b.x)], 1u);
            asm volatile("s_waitcnt vmcnt(0)" ::: "memory");
        } else {
            XB_SPIN(xb_ld(&bar[XB_XGEN(b.x)]) == gen, bar);
            __builtin_amdgcn_fence(__ATOMIC_ACQUIRE, "agent");
            asm volatile("s_waitcnt vmcnt(0)" ::: "memory");
        }
    }
    __syncthreads();
}
namespace dattn {
constexpr int D = 128, QST = 2048, KVS = 512, OST = 2048, MTW = 68, JLO = 3;
constexpr float THR = 8.f; constexpr bool WSKIP = false;
typedef unsigned short bf16;
constexpr float SCALE = 1.0f;
constexpr int NW = 8, QBLK = 32, KVBLK = 64, QB = NW * QBLK;
constexpr int SHM_V = KVBLK * D * 2, SHM_K = KVBLK * D * 2;
constexpr int LDS_BYTES = 2 * SHM_V + 2 * SHM_K + NW * 64 * 4;

typedef short bf16x8 __attribute__((ext_vector_type(8)));
typedef short s16x4 __attribute__((ext_vector_type(4)));
typedef float f32x16 __attribute__((ext_vector_type(16)));
typedef float f32x4 __attribute__((ext_vector_type(4)));
typedef unsigned u32x4 __attribute__((ext_vector_type(4)));
template <class A, class Bt> struct same_t { static constexpr bool v = false; };
template <class A> struct same_t<A, A> { static constexpr bool v = true; };

#define KSWZ(row, colB) ((row) * 256 + ((colB) ^ (((row) & 7) << 4)))
#define SBAR() __builtin_amdgcn_sched_barrier(0)
__device__ __forceinline__ int v_st(int k, int c) { const int kk = (k & ~0xC) | ((k & 4) << 1) | ((k & 8) >> 1); return ((kk >> 3) * 4 + (c >> 5)) * 512 + ((kk & 7) * 32 + (c & 31)) * 2; }
__device__ __forceinline__ int v_rd_base(int lane) { return ((lane & 3) << 3) | (((lane >> 2) & 3) << 6) | (((lane >> 4) & 1) << 5) | (((lane >> 5) & 1) << 8); }
constexpr int v_rd_off(int d0, int ks, int half) { return d0 * 512 + ks * 4096 + half * 2048; }
__device__ __forceinline__ int crow(int r, int hi) { return (r & 3) + 8 * (r >> 2) + 4 * hi; }
__device__ __forceinline__ unsigned cvtpk(float lo, float hi) {
    unsigned r; asm volatile("v_cvt_pk_bf16_f32 %0, %1, %2" : "=v"(r) : "v"(lo), "v"(hi)); return r;
}
__device__ __forceinline__ bf16x8 pack8(f32x4 a, f32x4 b) {
    u32x4 w = {cvtpk(a[0], a[1]), cvtpk(a[2], a[3]), cvtpk(b[0], b[1]), cvtpk(b[2], b[3])};
    return *reinterpret_cast<bf16x8*>(&w);
}
template <class T> __device__ __forceinline__ bf16x8 load8(const T* p) {
    if constexpr (same_t<T, float>::v) { return pack8(*(const f32x4*)p, *(const f32x4*)(p + 4)); }
    else { return *reinterpret_cast<const bf16x8*>(p); }
}
__device__ __forceinline__ void mask_tile(f32x16& p0, f32x16& p1, int dq, unsigned W) {
    const float NEG = -__builtin_inff();
#pragma unroll
    for (int r = 0; r < 16; ++r) {
        const int c = (r & 3) + 8 * (r >> 2);
        if ((unsigned)(dq - c) >= W) p0[r] = NEG;
        if ((unsigned)(dq - c - 32) >= W) p1[r] = NEG;
    }
}
__device__ __forceinline__ void mask_bits(f32x16& p0, f32x16& p1, unsigned long long mw, int hi) {
    const float NEG = -__builtin_inff();
    const unsigned lo = (unsigned)(mw >> (4 * hi)), up = (unsigned)(mw >> (32 + 4 * hi));
#pragma unroll
    for (int r = 0; r < 16; ++r) {
        const int c = (r & 3) + 8 * (r >> 2);
        if (!((lo >> c) & 1u)) p0[r] = NEG;
        if (!((up >> c) & 1u)) p1[r] = NEG;
    }
}
__device__ __forceinline__ void partialSM(f32x16& p0, f32x16& p1, float& m_reg, float& mn, float& alpha) {
    float pmax = p0[0]; for (int r = 1; r < 16; ++r) pmax = fmaxf(pmax, p0[r]); for (int r = 0; r < 16; ++r) pmax = fmaxf(pmax, p1[r]);
    { auto rr = __builtin_amdgcn_permlane32_swap(__float_as_uint(pmax), __float_as_uint(pmax), false, false);
      pmax = fmaxf(__uint_as_float(rr[0]), __uint_as_float(rr[1])); }
    constexpr float C2 = 1.4426950408889634f * SCALE;
    if (__builtin_expect(__all((pmax - m_reg) * SCALE <= THR), 1)) { mn = m_reg; alpha = 1.f; }
    else { mn = fmaxf(m_reg, pmax); alpha = __builtin_amdgcn_exp2f((m_reg - mn) * C2); m_reg = mn; }
    const float mnL = -mn * C2;
    for (int r = 0; r < 16; ++r) p0[r] = fmaf(p0[r], C2, mnL); for (int r = 0; r < 16; ++r) p1[r] = fmaf(p1[r], C2, mnL);
    for (int r = 0; r < 16; ++r) p0[r] = __builtin_amdgcn_exp2f(p0[r]);
}
__device__ __forceinline__ void finishSM(f32x16& p0, f32x16& p1, float alpha, float& l_reg, bf16x8& pa0, bf16x8& pa1, bf16x8& pa2, bf16x8& pa3) {
    for (int r = 0; r < 16; ++r) p1[r] = __builtin_amdgcn_exp2f(p1[r]);
    float ps = 0; for (int r = 0; r < 16; ++r) ps += p0[r]; for (int r = 0; r < 16; ++r) ps += p1[r];
    { auto rr = __builtin_amdgcn_permlane32_swap(__float_as_uint(ps), __float_as_uint(ps), false, false);
      ps = __uint_as_float(rr[0]) + __uint_as_float(rr[1]); }
    l_reg = l_reg * alpha + ps;
#define PK4(P, B_, OUT) do { unsigned a0 = cvtpk(P[B_+0], P[B_+1]), a1 = cvtpk(P[B_+2], P[B_+3]);                          \
        unsigned b0 = cvtpk(P[B_+4], P[B_+5]), b1 = cvtpk(P[B_+6], P[B_+7]);                                             \
        auto r0 = __builtin_amdgcn_permlane32_swap(a0, b0, false, false); auto r1 = __builtin_amdgcn_permlane32_swap(a1, b1, false, false); \
        u32x4 w = {r0[0], r1[0], r0[1], r1[1]}; OUT = *reinterpret_cast<bf16x8*>(&w); } while (0)
    PK4(p0, 0, pa0); PK4(p0, 8, pa1); PK4(p1, 0, pa2); PK4(p1, 8, pa3);
#undef PK4
}
template <int KB, bool SK>
__device__ __forceinline__ void qkt(f32x16& p0, f32x16& p1, const char* K_lds, int r32, int hi, const bf16x8* qr, bool act) {
    if (SK && !act) { const float NEG = -__builtin_inff();
#pragma unroll
        for (int r = 0; r < 16; ++r) { p0[r] = NEG; p1[r] = NEG; } return; }
    p0 = f32x16{}; p1 = f32x16{};
    const char* kb[4];
#pragma unroll
    for (int dd = 0; dd < 4; ++dd) kb[dd] = K_lds + KB * SHM_K + KSWZ(r32, (dd * 16 + hi * 8) * 2);
#pragma unroll
    for (int d0 = 0; d0 < 8; ++d0) { const char* a = kb[d0 & 3] + (d0 >> 2) * 128;
        bf16x8 b0 = *reinterpret_cast<const bf16x8*>(a);
        bf16x8 b1 = *reinterpret_cast<const bf16x8*>(a + 32 * 256);
        p0 = __builtin_amdgcn_mfma_f32_32x32x16_bf16(b0, qr[d0], p0, 0, 0, 0);
        p1 = __builtin_amdgcn_mfma_f32_32x32x16_bf16(b1, qr[d0], p1, 0, 0, 0); }
}
template <int VB, bool SK>
__device__ __forceinline__ void pv_tile(f32x16* o, int vb0, bf16x8 pa0, bf16x8 pa1, bf16x8 pa2, bf16x8 pa3, bool act) {
    if (SK && !act) return;
#define TRRD(dst, off) asm volatile("ds_read_b64_tr_b16 %0, %1 offset:%2" : "=&v"(dst) : "v"(vb0), "i"(off) : "memory")
#define PV_D0(d0) do { s16x4 l0, l1, l2, l3, h0, h1, h2, h3; constexpr int b_ = VB * SHM_V + v_rd_off(d0, 0, 0);     \
        TRRD(l0, b_); TRRD(h0, b_ + 2048); TRRD(l1, b_ + 4096); TRRD(h1, b_ + 6144); TRRD(l2, b_ + 8192); TRRD(h2, b_ + 10240); TRRD(l3, b_ + 12288); TRRD(h3, b_ + 14336); \
        asm volatile("s_waitcnt lgkmcnt(0)" ::: "memory"); SBAR();                 \
        o[d0] = __builtin_amdgcn_mfma_f32_32x32x16_bf16(pa0, (bf16x8){l0[0], l0[1], l0[2], l0[3], h0[0], h0[1], h0[2], h0[3]}, o[d0], 0, 0, 0);   \
        o[d0] = __builtin_amdgcn_mfma_f32_32x32x16_bf16(pa1, (bf16x8){l1[0], l1[1], l1[2], l1[3], h1[0], h1[1], h1[2], h1[3]}, o[d0], 0, 0, 0);   \
        o[d0] = __builtin_amdgcn_mfma_f32_32x32x16_bf16(pa2, (bf16x8){l2[0], l2[1], l2[2], l2[3], h2[0], h2[1], h2[2], h2[3]}, o[d0], 0, 0, 0);   \
        o[d0] = __builtin_amdgcn_mfma_f32_32x32x16_bf16(pa3, (bf16x8){l3[0], l3[1], l3[2], l3[3], h3[0], h3[1], h3[2], h3[3]}, o[d0], 0, 0, 0); } while (0)
    PV_D0(0); PV_D0(1); PV_D0(2); PV_D0(3);
#undef PV_D0
#undef TRRD
}

template <class TIn, class TOut> struct BlockRef { const TIn* Q; const TIn* K; const TIn* V; TOut* O; const unsigned long long* M; int P0; };
template <class TIn> struct Seam {
    bf16x8 qr[8];
    bf16x8 st_v0, st_v1, st_k0, st_k1; f32x4 sf0, sf1, sf2, sf3;
    f32x4 tq[16];
};
__device__ __forceinline__ int swa_jlo(int, int) { return JLO; }
#define ROW(p, k0, rr) ((p) + (size_t)((k0) + (rr)) * KVS + sc)
#define VMW() asm volatile("s_waitcnt vmcnt(0)" ::: "memory")
#define VMWN(n) asm volatile("s_waitcnt vmcnt(%0)" :: "i"(n) : "memory")
#define SLOAD_H(Kp, Vp, k0) do { S.st_v0 = load8<TIn>(ROW(Vp, k0, sr)); S.st_v1 = load8<TIn>(ROW(Vp, k0, 32 + sr));              \
                         S.st_k0 = load8<TIn>(ROW(Kp, k0, sr)); S.st_k1 = load8<TIn>(ROW(Kp, k0, 32 + sr)); } while (0)
#define SWRITE_HK(bf) do { *(bf16x8*)(K_lds + (bf) * SHM_K + kws) = S.st_k0; *(bf16x8*)(K_lds + (bf) * SHM_K + kws + 32 * 256) = S.st_k1; } while (0)
#define SWRITE_HV(bf) do { *(bf16x8*)(V_lds + (bf) * SHM_V + vst0) = S.st_v0; *(bf16x8*)(V_lds + (bf) * SHM_V + vst1) = S.st_v1; } while (0)
#define SWRITE_H(bf) do { SWRITE_HV(bf); SWRITE_HK(bf); } while (0)
#define SLOAD_F(p, k0) do { S.sf0 = *(const f32x4*)ROW(p, k0, sr); S.sf1 = *(const f32x4*)(ROW(p, k0, sr) + 4);                \
                            S.sf2 = *(const f32x4*)ROW(p, k0, 32 + sr); S.sf3 = *(const f32x4*)(ROW(p, k0, 32 + sr) + 4); } while (0)
#define SWRITE_KF(bf) do { *(bf16x8*)(K_lds + (bf) * SHM_K + kws) = pack8(S.sf0, S.sf1); *(bf16x8*)(K_lds + (bf) * SHM_K + kws + 32 * 256) = pack8(S.sf2, S.sf3); } while (0)
#define SWRITE_VF(bf) do { *(bf16x8*)(V_lds + (bf) * SHM_V + vst0) = pack8(S.sf0, S.sf1); *(bf16x8*)(V_lds + (bf) * SHM_V + vst1) = pack8(S.sf2, S.sf3); } while (0)
template <class TIn, class TOut>
__device__ __forceinline__ void causal_swa_prime(const BlockRef<TIn, TOut>& cur, int W, char* lds, Seam<TIn>& S, int wv) {
    constexpr bool F32 = same_t<TIn, float>::v;
    int tid0_ = threadIdx.x; asm volatile("" : "+v"(tid0_)); (void)wv;
    const int tid = tid0_, wid = __builtin_amdgcn_readfirstlane(tid >> 6), lane = tid & 63, r32 = lane & 31, hi = lane >> 5;
    const int sr = tid >> 4, sc = (tid & 15) * 8, kws = KSWZ(sr, sc * 2); char* K_lds = lds + 2 * SHM_V;
    const int kb0 = swa_jlo(cur.P0, W) * KVBLK;
    for (int d0 = 0; d0 < 8; ++d0) S.qr[d0] = load8<TIn>(cur.Q + (size_t)(wid * QBLK + r32) * QST + d0 * 16 + hi * 8);
    if constexpr (F32) { SLOAD_F((const float*)cur.K, kb0); VMW(); SWRITE_KF(0); SBAR(); SLOAD_F((const float*)cur.V, kb0); }
    else { SLOAD_H(cur.K, cur.V, kb0); VMW(); SWRITE_HK(0); }
    __syncthreads();
}
template <class TIn, class TOut>
__device__ __forceinline__ void causal_swa_block(const BlockRef<TIn, TOut>& cur, const BlockRef<TIn, TOut>& nxt, int skv, int W, char* lds, Seam<TIn>& S, int wv) {
    constexpr bool F32 = same_t<TIn, float>::v;
    int tid0_ = threadIdx.x; asm volatile("" : "+v"(tid0_)); (void)wv;
    const int tid = tid0_, wid = __builtin_amdgcn_readfirstlane(tid >> 6), lane = tid & 63, r32 = lane & 31, hi = lane >> 5;
    const int j_lo = swa_jlo(cur.P0, W);
    int j_hi = (cur.P0 + QB - 1) / KVBLK + 1; if (j_hi > skv / KVBLK) j_hi = skv / KVBLK;
    const int NT = j_hi - j_lo;
    const int kbn = swa_jlo(nxt.P0, W) * KVBLK;
    const int qlo = cur.P0 + wid * QBLK; (void)qlo;
    const unsigned long long* mrow = cur.M + (size_t)(wid * QBLK + r32) * MTW;
    const int qm_unused = 0; (void)qm_unused;
    char* V_lds = lds; char* K_lds = lds + 2 * SHM_V;
    float* ws = (float*)(lds + 2 * SHM_V + 2 * SHM_K) + wid * 64; float* li_l = ws, * al_l = ws + 32;
    float m_reg = -1e30f, l_reg = 0; f32x16 o[4] = {};
    const int sr = tid >> 4, sc = (tid & 15) * 8, vst0 = v_st(sr, sc), vst1 = v_st(32 + sr, sc), kws = KSWZ(sr, sc * 2);
    const int vb0 = (int)(uintptr_t)V_lds + v_rd_base(lane);
    const TIn* Kh = cur.K; const TIn* Vh = cur.V;
#define RESC(a) do { if (__any((a) < 1.f)) { if (hi == 0) al_l[r32] = (a); asm volatile("s_waitcnt lgkmcnt(0)" ::: "memory");              \
                     for (int d_ = 0; d_ < 4; ++d_) for (int r = 0; r < 16; ++r) o[d_][r] *= al_l[crow(r, hi)]; } } while (0)
#define KBASE(t) ((j_lo + (t)) * KVBLK)
#define ACT(t) (KBASE(t) <= qlo + QBLK - 1 && KBASE(t) + KVBLK - 1 >= qlo - W + 1)
#define MASKT(P0_, P1_, t) mask_bits(P0_, P1_, (((t) & 1) ? mwB : mwA), hi)
#define MWLOAD(t) do { const int tt_ = (t) < NT ? (t) : NT - 1; if ((t) & 1) mwB = mrow[j_lo + tt_]; else mwA = mrow[j_lo + tt_]; } while (0)
    constexpr int NQL = F32 ? 16 : 8;
    constexpr bool SK = WSKIP && !F32;
#define SEAM_K0() do { VMWN(NQL); if constexpr (F32) { SWRITE_KF(0); SBAR(); SLOAD_F((const float*)nxt.V, kbn); } else { SWRITE_HK(0); } SBAR(); } while (0)
    f32x16 pA0, pA1, pB0, pB1; float mnA, mnB, alA, alB; bf16x8 pa0, pa1, pa2, pa3;
    unsigned long long mwA = mrow[j_lo], mwB = mrow[j_lo + (NT > 1 ? 1 : 0)];
    if constexpr (F32) { VMW(); SWRITE_VF(0); SBAR(); } else { SWRITE_HV(0); SBAR(); }
    if (NT > 1) { if constexpr (F32) SLOAD_F((const float*)Kh, KBASE(1)); else SLOAD_H(Kh, Vh, KBASE(1)); }
    SBAR(); qkt<0, SK>(pA0, pA1, K_lds, r32, hi, S.qr, ACT(0));
    if constexpr (F32) { if (NT > 1) { VMW(); SWRITE_KF(1); SBAR(); SLOAD_F((const float*)Vh, KBASE(1)); } }
    MASKT(pA0, pA1, 0); MWLOAD(2); partialSM(pA0, pA1, m_reg, mnA, alA);
    if (NT > 1) { VMW(); if constexpr (F32) { SWRITE_VF(1); SBAR(); if (NT > 2) SLOAD_F((const float*)Kh, KBASE(2)); } else SWRITE_H(1); }
    __syncthreads();
#define HALF_STEP(PX0, PX1, mnX, alX, PY0, PY1, alY, t, KB, VB, SB) do {                                                      \
        SBAR(); qkt<KB, SK>(PX0, PX1, K_lds, r32, hi, S.qr, ACT(t));                                             \
        finishSM(PY0, PY1, alY, l_reg, pa0, pa1, pa2, pa3); SBAR();                                                           \
        if ((t) + 1 < NT) { if constexpr (F32) { VMW(); SWRITE_KF(SB); SBAR(); SLOAD_F((const float*)Vh, KBASE((t) + 1)); }  \
                            else { SLOAD_H(Kh, Vh, KBASE((t) + 1)); } SBAR(); }                                               \
        pv_tile<VB, SK>(o, vb0, pa0, pa1, pa2, pa3, ACT((t) - 1)); MASKT(PX0, PX1, (t)); MWLOAD((t) + 2); partialSM(PX0, PX1, m_reg, mnX, alX);                                        \
        __syncthreads();                                                                                                      \
        if ((t) + 1 < NT) { VMW(); if constexpr (F32) { SWRITE_VF(SB); SBAR(); if ((t) + 2 < NT) SLOAD_F((const float*)Kh, KBASE((t) + 2)); } \
                            else { SWRITE_H(SB); } }                                                                          \
        RESC(alX); __syncthreads(); } while (0)
    for (int t = 1; t + 1 < NT; t += 2) {
        HALF_STEP(pB0, pB1, mnB, alB, pA0, pA1, alA, t, 1, 0, 0);
        HALF_STEP(pA0, pA1, mnA, alA, pB0, pB1, alB, t + 1, 0, 1, 1);
    }
    const bool even = (NT & 1) == 0;
    if (even) { SBAR(); qkt<1, SK>(pB0, pB1, K_lds, r32, hi, S.qr, ACT(NT - 1)); SBAR(); }
#define QROW(e) (nxt.Q + (size_t)(wid * QBLK + r32) * QST + ((e) >> 1) * 16 + hi * 8 + ((e) & 1) * 4)
    if constexpr (F32) { SLOAD_F((const float*)nxt.K, kbn); SBAR();
#pragma unroll
        for (int e = 0; e < 8; ++e) S.tq[e] = *(const f32x4*)QROW(e); }
    else { SLOAD_H(nxt.K, nxt.V, kbn); SBAR();
#pragma unroll
        for (int d0 = 0; d0 < 8; ++d0) S.qr[d0] = load8<TIn>(nxt.Q + (size_t)(wid * QBLK + r32) * QST + d0 * 16 + hi * 8); }
    SBAR();
    finishSM(pA0, pA1, alA, l_reg, pa0, pa1, pa2, pa3); SBAR();
    if constexpr (F32) {
#pragma unroll
        for (int e = 8; e < 16; ++e) S.tq[e] = *(const f32x4*)QROW(e); SBAR(); }
#undef QROW
    pv_tile<0, SK>(o, vb0, pa0, pa1, pa2, pa3, ACT(even ? NT - 2 : NT - 1));
    if (even) { MASKT(pB0, pB1, NT - 1); partialSM(pB0, pB1, m_reg, mnB, alB); __syncthreads(); RESC(alB);
        finishSM(pB0, pB1, alB, l_reg, pa0, pa1, pa2, pa3); SBAR(); pv_tile<1, SK>(o, vb0, pa0, pa1, pa2, pa3, ACT(NT - 1)); }
    SBAR(); SEAM_K0();
    if (hi == 0) li_l[r32] = l_reg; asm volatile("s_waitcnt lgkmcnt(0)" ::: "memory");
    float rli[16];
#pragma unroll
    for (int r = 0; r < 16; ++r) rli[r] = __builtin_amdgcn_rcpf(li_l[crow(r, hi)]);
    TOut* Ow = cur.O + (size_t)(wid * QBLK) * OST;
#pragma unroll
    for (int r = 0; r < 16; ++r) { const int orow = crow(r, hi);
#pragma unroll
        for (int d0 = 0; d0 < 4; ++d0) { const float v = o[d0][r] * rli[r];
            if constexpr (same_t<TOut, float>::v) { Ow[(size_t)orow * OST + d0 * 32 + r32] = v; }
            else { const float vn = __shfl_xor(v, 1);
                   if ((r32 & 1) == 0) *(unsigned*)(Ow + (size_t)orow * OST + d0 * 32 + r32) = cvtpk(v, vn); } } }
    if constexpr (F32) {
#pragma unroll
        for (int d0 = 0; d0 < 8; ++d0) S.qr[d0] = pack8(S.tq[2 * d0], S.tq[2 * d0 + 1]); }
    __syncthreads();
#undef RESC
#undef KBASE
#undef ACT
#undef MASKT
#undef MWLOAD
#undef SEAM_K0
#undef HALF_STEP
}
#undef ROW
#undef VMW
#undef VMWN
#undef SLOAD_H
#undef SWRITE_HK
#undef SWRITE_HV
#undef SWRITE_H
#undef SLOAD_F
#undef SWRITE_KF
#undef SWRITE_VF

}

constexpr int NWAVES = 8, NTHREADS = 512;
constexpr int DM = 2048, SEQ = 4096, NMETA = 16, TP = 4112, NBP = 2, SBN = 8, PAST = 16384, NPG = 128;
constexpr int XROW0 = 8192, SROW0 = 8224, NROWS = 8232, MPAD = 8448, FF = 8192, MAINM = 8192, XR = 48;
constexpr int NA_IN = 6144, NB_IN = 4176, NB_PAD = 4352, NC_IN = 12352, NC_PAD = 12544, DVW = 4096, CDIM = 8192;
constexpr float ALPHA = 1.6817928305074292f;
constexpr float LN_EPS = 1e-5f, RMS_EPS = 1e-6f;
constexpr int SCW = 4160, SCSW = 16448, KIROWS = 4128, NSKEY = PAST + 1;
constexpr int POS_SAMPLE_IDX = TP;

constexpr size_t O_YP = 0, O_YS = O_YP + (size_t)NBP * SEQ * DM, O_CAP = O_YS + (size_t)SBN * DM, O_CAS = O_CAP + 2 * NBP * 2 * DM,
                 O_KP = O_CAS + 2 * SBN * 2 * DM, O_VP = O_KP + (size_t)NBP * TP * 512, O_IKP = O_VP + (size_t)NBP * TP * 512,
                 O_KS = O_IKP + (size_t)NBP * TP * 64, O_VS = O_KS + SBN * 512, O_IKS = O_VS + SBN * 512, O_CCP = O_IKS + SBN * 64,
                 O_CCS = O_CCP + (size_t)NBP * 3 * CDIM, O_DP = O_CCS + (size_t)SBN * 3 * CDIM, O_DS = O_DP + (size_t)NBP * 32 * 128 * 128,
                 O_END = O_DS + (size_t)SBN * 32 * 128 * 128;

constexpr size_t MiB = 1u << 20;
constexpr size_t WS_CTL = 0, CTL_ZERO_BYTES = 1 * MiB;
constexpr size_t WS_TAB128 = 1 * MiB, WS_TAB64 = 4 * MiB, WS_WI = 6 * MiB, WS_G = 7 * MiB, WS_BETA = 9 * MiB, WS_CNT = 11 * MiB, WS_KIB = 12 * MiB,
                 WS_SCS = 14 * MiB, WS_IDXL = 16 * MiB, WS_X = 26 * MiB, WS_QR = 60 * MiB, WS_QI = 94 * MiB, WS_Z = 112 * MiB, WS_Y = 180 * MiB,
                 WS_BIG = 248 * MiB, WS_QKVC = 452 * MiB, WS_SC = 584 * MiB, WS_W = 716 * MiB;
constexpr size_t WSZ_A_IN = (size_t)NA_IN * DM * 2, WSZ_A_OUT = (size_t)DM * DM * 2, WSZ_B_IN = (size_t)NB_PAD * DM * 2, WSZ_B_OUT = (size_t)DM * DM * 2,
                 WSZ_C_IN = (size_t)NC_PAD * DM * 2, WSZ_C_OUT = (size_t)DM * DVW * 2, WSZ_W1 = (size_t)FF * DM * 2, WSZ_W2 = (size_t)DM * FF * 2;
constexpr size_t WS_WA_IN = WS_W, WS_WA_OUT = WS_WA_IN + 2 * WSZ_A_IN, WS_WB_IN = WS_WA_OUT + 2 * WSZ_A_OUT, WS_WB_OUT = WS_WB_IN + WSZ_B_IN,
                 WS_WC_IN = WS_WB_OUT + WSZ_B_OUT, WS_WC_OUT = WS_WC_IN + WSZ_C_IN, WS_W1 = WS_WC_OUT + WSZ_C_OUT, WS_W2 = WS_W1 + 4 * WSZ_W1,
                 WS_ZP = WS_W2 + 4 * WSZ_W2, WS_QKF = WS_ZP + 4 * MiB, WS_DWG = WS_QKF + 130 * MiB, WS_DUG = WS_DWG + 66 * MiB, WS_END = WS_DUG + 66 * MiB;
constexpr size_t WS_MASK = WS_IDXL, WS_KS = WS_Z, WS_VS = WS_Z + 9 * MiB;
constexpr size_t WS_DAF = WS_Z, WS_DTG = WS_Y, WS_DTB = WS_Y + 33 * MiB, WS_DPG = WS_QR, WS_DKT = WS_QKF, WS_DVT = WS_QKF + 33 * MiB, WS_DGC = WS_QI, WS_DBT = WS_QI + 2 * MiB;
constexpr int SP = 4352, SPAD = 240, MTW = 68;
constexpr int CW_BAR = 4096;

constexpr int RING_BYTES = 131072, LDSCTL_OFF = RING_BYTES, MISC_OFF = LDSCTL_OFF + 320, LDS_BYTES = 147456;

typedef unsigned short bf16;
typedef unsigned v4u __attribute__((ext_vector_type(4)));
typedef unsigned v2u __attribute__((ext_vector_type(2)));
typedef float f32x4 __attribute__((ext_vector_type(4)));
typedef float f32x2 __attribute__((ext_vector_type(2)));
typedef short bf16x8 __attribute__((ext_vector_type(8)));
typedef float f32x16 __attribute__((ext_vector_type(16)));
typedef __bf16 bf16x2_t __attribute__((ext_vector_type(2)));

#define LDS_WAIT() asm volatile("s_waitcnt lgkmcnt(0)" ::: "memory")
#define WAVE_SYNC() do { asm volatile("s_waitcnt lgkmcnt(0)" ::: "memory"); __builtin_amdgcn_wave_barrier(); } while (0)

__device__ __forceinline__ float bflo(unsigned w) { return __uint_as_float(w << 16); }
__device__ __forceinline__ float bfhi(unsigned w) { return __uint_as_float(w & 0xffff0000u); }
__device__ __forceinline__ float bf2f(bf16 h) { return __uint_as_float((unsigned)h << 16); }
__device__ __forceinline__ unsigned pk2(float lo, float hi) { f32x2 v = {lo, hi}; bf16x2_t b = __builtin_convertvector(v, bf16x2_t); return __builtin_bit_cast(unsigned, b); }
__device__ __forceinline__ bf16 f2bf(float f) { return (bf16)(pk2(f, 0.f) & 0xffffu); }
__device__ __forceinline__ float wave_sum(float v) {
#pragma unroll
    for (int o = 1; o < 64; o <<= 1) v += __shfl_xor(v, o);
    return v;
}
__device__ __forceinline__ float wave_max(float v) {
#pragma unroll
    for (int o = 1; o < 64; o <<= 1) v = fmaxf(v, __shfl_xor(v, o));
    return v;
}
__device__ __forceinline__ int wave_sum_i(int v) {
#pragma unroll
    for (int o = 1; o < 64; o <<= 1) v += __shfl_xor(v, o);
    return v;
}
__device__ __forceinline__ float row16_sum(float v) {
    v += __int_as_float(__builtin_amdgcn_update_dpp(0, __float_as_int(v), 0x128, 0xf, 0xf, false));
    v += __int_as_float(__builtin_amdgcn_update_dpp(0, __float_as_int(v), 0x124, 0xf, 0xf, false));
    v += __int_as_float(__builtin_amdgcn_update_dpp(0, __float_as_int(v), 0x122, 0xf, 0xf, false));
    v += __int_as_float(__builtin_amdgcn_update_dpp(0, __float_as_int(v), 0x121, 0xf, 0xf, false));
    return v;
}
__device__ __forceinline__ float silu_f(float x) { return x / (1.f + __expf(-x)); }
__device__ __forceinline__ int prow(int b, int t) { return t >= NMETA ? b * SEQ + (t - NMETA) : XROW0 + b * NMETA + t; }
__device__ __forceinline__ void row_bt(int r, int& b, int& t) { if (r < XROW0) { b = r >> 12; t = (r & 4095) + NMETA; } else { b = (r - XROW0) >> 4; t = (r - XROW0) & 15; } }
__device__ __forceinline__ void unpack8(const v4u w, float (&f)[8]) {
    f[0] = bflo(w.x); f[1] = bfhi(w.x); f[2] = bflo(w.y); f[3] = bfhi(w.y); f[4] = bflo(w.z); f[5] = bfhi(w.z); f[6] = bflo(w.w); f[7] = bfhi(w.w);
}
__device__ __forceinline__ v4u pack8(const float (&f)[8]) { v4u w; w.x = pk2(f[0], f[1]); w.y = pk2(f[2], f[3]); w.z = pk2(f[4], f[5]); w.w = pk2(f[6], f[7]); return w; }

__device__ __forceinline__ void transpose_item(const float* W, int K, int N, int Npad, bf16* WT, LAS float* scr, int item, int lane) {
    const int nblk = Npad / 32, kb = item / nblk, nb = item % nblk, k0 = 64 * kb, n0 = 32 * nb;
    const int n = n0 + (lane & 31); const bool ok = n < N;
    float wv_[32];
#pragma unroll
    for (int i = 0; i < 32; ++i) { const int kk = 2 * i + (lane >> 5); wv_[i] = W[(size_t)(k0 + kk) * N + (ok ? n : N - 1)]; }
#pragma unroll
    for (int i = 0; i < 32; ++i) { const int kk = 2 * i + (lane >> 5); scr[kk * 33 + (lane & 31)] = ok ? wv_[i] : 0.f; }
    LDS_WAIT(); __builtin_amdgcn_wave_barrier();
    const int c = lane & 7;
#pragma unroll
    for (int j = 0; j < 4; ++j) { const int nn = (lane >> 3) + 8 * j; const LAS float* s = scr + (8 * c) * 33 + nn;
        v4u o; o.x = pk2(s[0 * 33], s[1 * 33]); o.y = pk2(s[2 * 33], s[3 * 33]); o.z = pk2(s[4 * 33], s[5 * 33]); o.w = pk2(s[6 * 33], s[7 * 33]);
        *(v4u*)(WT + (size_t)(n0 + nn) * K + k0 + 8 * c) = o; }
    LDS_WAIT(); __builtin_amdgcn_wave_barrier();
}

struct Ptrs {
    const float *x_prompt, *x_sample, *state_conv_a, *cache_k, *cache_v, *cache_ik, *state_conv_c, *state_delta;
    const int* page_table;
    const float *meta, *w_in_a, *conv_w_a, *w_out_a, *w_in_b, *w_out_b, *w_in_c, *conv_w_c, *a_log, *dt_bias, *norm_w, *w_out_c, *ln1_g, *ln1_b, *w1, *w2, *ln2_g, *ln2_b;
    float* out; unsigned char* ws;
};

__device__ __forceinline__ void p0_prologue(const Ptrs& P, LAS unsigned char* lds, int gw, int NGW, int wave, int lane) {
    LAS float* scr = (LAS float*)(lds + wave * 16384);
    unsigned char* ws = P.ws;
    constexpr int I_A_IN = (DM / 64) * (NA_IN / 32), I_A_OUT = (DM / 64) * (DM / 32), I_B_IN = (DM / 64) * (NB_PAD / 32), I_B_OUT = I_A_OUT,
                  I_C_IN = (DM / 64) * (NC_PAD / 32), I_C_OUT = (DVW / 64) * (DM / 32), I_W1 = (DM / 64) * (FF / 32), I_W2 = (FF / 64) * (DM / 32);
    constexpr int NITEMS = 2 * I_A_IN + 2 * I_A_OUT + I_B_IN + I_B_OUT + I_C_IN + I_C_OUT + 4 * I_W1 + 4 * I_W2;
#define TR_(cnt, Wp, Kk, Nn, Np, WTp) if (r < (cnt)) { transpose_item((Wp), (Kk), (Nn), (Np), (bf16*)(WTp), scr, r, lane); continue; } r -= (cnt);
    for (int it = gw; it < NITEMS; it += NGW) {
        int r = it;
        TR_(I_A_IN, P.w_in_a, DM, NA_IN, NA_IN, ws + WS_WA_IN)
        TR_(I_A_IN, P.w_in_a + (size_t)DM * NA_IN, DM, NA_IN, NA_IN, ws + WS_WA_IN + WSZ_A_IN)
        TR_(I_A_OUT, P.w_out_a, DM, DM, DM, ws + WS_WA_OUT)
        TR_(I_A_OUT, P.w_out_a + (size_t)DM * DM, DM, DM, DM, ws + WS_WA_OUT + WSZ_A_OUT)
        TR_(I_B_IN, P.w_in_b, DM, NB_IN, NB_PAD, ws + WS_WB_IN)
        TR_(I_B_OUT, P.w_out_b, DM, DM, DM, ws + WS_WB_OUT)
        TR_(I_C_IN, P.w_in_c, DM, NC_IN, NC_PAD, ws + WS_WC_IN)
        TR_(I_C_OUT, P.w_out_c, DVW, DM, DM, ws + WS_WC_OUT)
        TR_(I_W1, P.w1, DM, FF, FF, ws + WS_W1)
        TR_(I_W1, P.w1 + (size_t)DM * FF, DM, FF, FF, ws + WS_W1 + WSZ_W1)
        TR_(I_W1, P.w1 + 2 * (size_t)DM * FF, DM, FF, FF, ws + WS_W1 + 2 * WSZ_W1)
        TR_(I_W1, P.w1 + 3 * (size_t)DM * FF, DM, FF, FF, ws + WS_W1 + 3 * WSZ_W1)
        TR_(I_W2, P.w2, FF, DM, DM, ws + WS_W2)
        TR_(I_W2, P.w2 + (size_t)DM * FF, FF, DM, DM, ws + WS_W2 + WSZ_W2)
        TR_(I_W2, P.w2 + 2 * (size_t)DM * FF, FF, DM, DM, ws + WS_W2 + 2 * WSZ_W2)
        transpose_item(P.w2 + 3 * (size_t)DM * FF, FF, DM, DM, (bf16*)(ws + WS_W2 + 3 * WSZ_W2), scr, r, lane);
    }
#undef TR_
    bf16* X = (bf16*)(ws + WS_X);
    for (int r = gw; r < MPAD; r += NGW) {
        const float* src = nullptr;
        if (r < XROW0) src = P.x_prompt + (size_t)r * DM;
        else if (r < SROW0) src = P.meta + (size_t)((r - XROW0) & 15) * DM;
        else if (r < NROWS) src = P.x_sample + (size_t)(r - SROW0) * DM;
#pragma unroll
        for (int j = 0; j < 4; ++j) { const int c = 512 * j + 8 * lane; v4u o = {0u, 0u, 0u, 0u};
            if (src) { const f32x4 a = *(const f32x4*)(src + c), b = *(const f32x4*)(src + c + 4); o.x = pk2(a.x, a.y); o.y = pk2(a.z, a.w); o.z = pk2(b.x, b.y); o.w = pk2(b.z, b.w); }
            *(v4u*)(X + (size_t)r * DM + c) = o; }
    }
    f32x2* t128 = (f32x2*)(ws + WS_TAB128); f32x2* t64 = (f32x2*)(ws + WS_TAB64);
    const int gt = gw * 64 + lane, NGT = NGW * 64;
    for (int e = gt; e < (TP + 1) * 96; e += NGT) {
        const int pi = e / 96, i = e % 96; const float pos = (float)(pi == TP ? PAST : pi);
        const float ex = (i < 64) ? (float)(2 * i) * (1.f / 128.f) : (float)(2 * (i - 64)) * (1.f / 64.f);
        const float inv = __builtin_amdgcn_exp2f(-ex * 13.287712379549449f);
        const float angf = pos * inv;
        double rev = (double)angf * 0.15915494309189535; rev -= __builtin_rint(rev);
        const float rf = (float)rev; const float sn = __builtin_amdgcn_sinf(rf), cs = __builtin_amdgcn_cosf(rf);
        if (i < 64) t128[pi * 64 + i] = (f32x2){cs, sn}; else t64[pi * 32 + (i - 64)] = (f32x2){cs, sn};
    }
}

__device__ __forceinline__ void ln_phase(const float* Z, const float* ZP, bf16* X, bf16* Xo, const float* gam, const float* bet, float* yp, float* ys, int gw, int NGW, int lane) {
    for (int r = gw; r < NROWS; r += NGW) {
        const bool ext = r >= XROW0; const float* zr = ext ? ZP + (size_t)(r - XROW0) * DM : Z + (size_t)r * DM; bf16* xr = X + (size_t)r * DM;
        f32x4 gq[8], bq_[8];
#pragma unroll
        for (int j = 0; j < 4; ++j) { const int c = 512 * j + 8 * lane; gq[2 * j] = *(const f32x4*)(gam + c); gq[2 * j + 1] = *(const f32x4*)(gam + c + 4); bq_[2 * j] = *(const f32x4*)(bet + c); bq_[2 * j + 1] = *(const f32x4*)(bet + c + 4); }
        float v[32]; float s = 0.f;
#pragma unroll
        for (int j = 0; j < 4; ++j) { const int c = 512 * j + 8 * lane; f32x4 z0 = *(const f32x4*)(zr + c), z1 = *(const f32x4*)(zr + c + 4); const v4u xv = *(const v4u*)(xr + c);
            if (ext) {
#pragma unroll
                for (int sl = 1; sl < 8; ++sl) { z0 += *(const f32x4*)(zr + (size_t)sl * XR * DM + c); z1 += *(const f32x4*)(zr + (size_t)sl * XR * DM + c + 4); } }
            float xf[8]; unpack8(xv, xf);
            v[8 * j + 0] = ALPHA * xf[0] + z0.x; v[8 * j + 1] = ALPHA * xf[1] + z0.y; v[8 * j + 2] = ALPHA * xf[2] + z0.z; v[8 * j + 3] = ALPHA * xf[3] + z0.w;
            v[8 * j + 4] = ALPHA * xf[4] + z1.x; v[8 * j + 5] = ALPHA * xf[5] + z1.y; v[8 * j + 6] = ALPHA * xf[6] + z1.z; v[8 * j + 7] = ALPHA * xf[7] + z1.w;
#pragma unroll
            for (int i = 0; i < 8; ++i) s += v[8 * j + i]; }
        const float mean = wave_sum(s) * (1.f / DM); float s2 = 0.f;
#pragma unroll
        for (int i = 0; i < 32; ++i) { v[i] -= mean; s2 += v[i] * v[i]; }
        const float rstd = 1.f / sqrtf(wave_sum(s2) * (1.f / DM) + LN_EPS);
        float* of = nullptr;
        if (yp) { if (r < XROW0) of = yp + (size_t)r * DM; else if (r >= SROW0) of = ys + (size_t)(r - SROW0) * DM; }
#pragma unroll
        for (int j = 0; j < 4; ++j) { const int c = 512 * j + 8 * lane; const f32x4 g0 = gq[2 * j], g1 = gq[2 * j + 1], b0 = bq_[2 * j], b1 = bq_[2 * j + 1];
            float o[8];
            o[0] = v[8 * j + 0] * rstd * g0.x + b0.x; o[1] = v[8 * j + 1] * rstd * g0.y + b0.y; o[2] = v[8 * j + 2] * rstd * g0.z + b0.z; o[3] = v[8 * j + 3] * rstd * g0.w + b0.w;
            o[4] = v[8 * j + 4] * rstd * g1.x + b1.x; o[5] = v[8 * j + 5] * rstd * g1.y + b1.y; o[6] = v[8 * j + 6] * rstd * g1.z + b1.z; o[7] = v[8 * j + 7] * rstd * g1.w + b1.w;
            *(v4u*)(Xo + (size_t)r * DM + c) = pack8(o);
            if (of) { *(f32x4*)(of + c) = (f32x4){o[0], o[1], o[2], o[3]}; *(f32x4*)(of + c + 4) = (f32x4){o[4], o[5], o[6], o[7]}; } }
    }
}

__device__ __forceinline__ void load_u(const bf16* BCH, int row, int c0, float (&u)[8]) {
    const v4u cg = *(const v4u*)(BCH + (size_t)row * NA_IN + DM + c0), hh = *(const v4u*)(BCH + (size_t)row * NA_IN + 2 * DM + c0);
    float a[8], b[8]; unpack8(cg, a); unpack8(hh, b);
#pragma unroll
    for (int i = 0; i < 8; ++i) u[i] = a[i] * b[i];
}
__device__ __forceinline__ void convA_phase(const bf16* BCH, bf16* Y, const float* cw, const float* hist, float* outp, float* outs, int gtid, int NT) {
    constexpr int RUN = 8, NRUN = TP / RUN;
    for (int it = gtid; it < (NBP * NRUN + SBN) * 256; it += NT) {
        const int c0 = (it & 255) * 8, ru = it >> 8;
        float w0[8], w1[8], w2[8];
        { const f32x4 a = *(const f32x4*)(cw + c0), b = *(const f32x4*)(cw + c0 + 4); w0[0] = a.x; w0[1] = a.y; w0[2] = a.z; w0[3] = a.w; w0[4] = b.x; w0[5] = b.y; w0[6] = b.z; w0[7] = b.w; }
        { const f32x4 a = *(const f32x4*)(cw + DM + c0), b = *(const f32x4*)(cw + DM + c0 + 4); w1[0] = a.x; w1[1] = a.y; w1[2] = a.z; w1[3] = a.w; w1[4] = b.x; w1[5] = b.y; w1[6] = b.z; w1[7] = b.w; }
        { const f32x4 a = *(const f32x4*)(cw + 2 * DM + c0), b = *(const f32x4*)(cw + 2 * DM + c0 + 4); w2[0] = a.x; w2[1] = a.y; w2[2] = a.z; w2[3] = a.w; w2[4] = b.x; w2[5] = b.y; w2[6] = b.z; w2[7] = b.w; }
        float u0[8], u1[8], u2[8];
        if (ru < NBP * NRUN) {
            const int b = ru / NRUN, t0 = (ru % NRUN) * RUN;
            if (t0 >= 1) load_u(BCH, prow(b, t0 - 1), c0, u1); else {
#pragma unroll
                for (int i = 0; i < 8; ++i) u1[i] = 0.f; }
            if (t0 >= 2) load_u(BCH, prow(b, t0 - 2), c0, u0); else {
#pragma unroll
                for (int i = 0; i < 8; ++i) u0[i] = 0.f; }
            const int r0 = prow(b, t0);
            v4u bq[RUN], cq[RUN], hq_[RUN];
#pragma unroll
            for (int k = 0; k < RUN; ++k) { const bf16* rp = BCH + (size_t)(r0 + k) * NA_IN + c0; bq[k] = *(const v4u*)rp; cq[k] = *(const v4u*)(rp + DM); hq_[k] = *(const v4u*)(rp + 2 * DM); }
#pragma unroll
            for (int k = 0; k < RUN; ++k) {
                const int r = r0 + k, t = t0 + k;
                { float ca[8], ha[8]; unpack8(cq[k], ca); unpack8(hq_[k], ha);
#pragma unroll
                  for (int i = 0; i < 8; ++i) u2[i] = ca[i] * ha[i]; }
                float bg[8]; unpack8(bq[k], bg);
                float y[8];
#pragma unroll
                for (int i = 0; i < 8; ++i) y[i] = bg[i] * (w0[i] * u0[i] + w1[i] * u1[i] + w2[i] * u2[i]);
                *(v4u*)(Y + (size_t)r * DM + c0) = pack8(y);
                if (t >= TP - 2) { float* o = outp + ((size_t)(b * 2 + (t - (TP - 2)))) * DM + c0; *(f32x4*)o = (f32x4){u2[0], u2[1], u2[2], u2[3]}; *(f32x4*)(o + 4) = (f32x4){u2[4], u2[5], u2[6], u2[7]}; }
#pragma unroll
                for (int i = 0; i < 8; ++i) { u0[i] = u1[i]; u1[i] = u2[i]; }
            }
        } else {
            const int sb = ru - NBP * NRUN, r = SROW0 + sb;
            load_u(BCH, r, c0, u2);
            const float* h0 = hist + ((size_t)(sb * 2 + 0)) * DM + c0; const float* h1 = hist + ((size_t)(sb * 2 + 1)) * DM + c0;
            const f32x4 a0 = *(const f32x4*)h0, a1 = *(const f32x4*)(h0 + 4), b0 = *(const f32x4*)h1, b1 = *(const f32x4*)(h1 + 4);
            u0[0] = a0.x; u0[1] = a0.y; u0[2] = a0.z; u0[3] = a0.w; u0[4] = a1.x; u0[5] = a1.y; u0[6] = a1.z; u0[7] = a1.w;
            u1[0] = b0.x; u1[1] = b0.y; u1[2] = b0.z; u1[3] = b0.w; u1[4] = b1.x; u1[5] = b1.y; u1[6] = b1.z; u1[7] = b1.w;
            float* o0 = outs + ((size_t)(sb * 2 + 0)) * DM + c0; float* o1 = outs + ((size_t)(sb * 2 + 1)) * DM + c0;
            *(f32x4*)o0 = b0; *(f32x4*)(o0 + 4) = b1;
            *(f32x4*)o1 = (f32x4){u2[0], u2[1], u2[2], u2[3]}; *(f32x4*)(o1 + 4) = (f32x4){u2[4], u2[5], u2[6], u2[7]};
            float bg[8]; unpack8(*(const v4u*)(BCH + (size_t)r * NA_IN + c0), bg);
            float y[8];
#pragma unroll
            for (int i = 0; i < 8; ++i) y[i] = bg[i] * (w0[i] * u0[i] + w1[i] * u1[i] + w2[i] * u2[i]);
            *(v4u*)(Y + (size_t)r * DM + c0) = pack8(y);
        }
    }
}

constexpr float QSCALE = 0.08838834764831845f;
__device__ __forceinline__ void rope_phase(const bf16* PROJ, const Ptrs& P, int gw, int NGW, int lane) {
    unsigned char* ws = P.ws;
    const f32x2* t128 = (const f32x2*)(ws + WS_TAB128); const f32x2* t64 = (const f32x2*)(ws + WS_TAB64);
    bf16* Qr = (bf16*)(ws + WS_QR); bf16* QI = (bf16*)(ws + WS_QI); bf16* KIb = (bf16*)(ws + WS_KIB); float* WI = (float*)(ws + WS_WI);
    bf16* Ks = (bf16*)(ws + WS_KS); bf16* Vs = (bf16*)(ws + WS_VS);
    for (int pr_ = gw; pr_ < NBP * SPAD; pr_ += NGW) {
        const size_t o = ((size_t)((pr_ / SPAD) * SP + (pr_ % SPAD))) * 512 + 8 * lane; *(v4u*)(Ks + o) = (v4u){0u, 0u, 0u, 0u}; *(v4u*)(Vs + o) = (v4u){0u, 0u, 0u, 0u}; }
    for (int r = gw; r < NROWS; r += NGW) {
        const bf16* pr = PROJ + (size_t)r * NB_PAD;
        int pi; float *ko, *vo, *iko; bf16* kib = nullptr; bf16 *ksq = nullptr, *vsq = nullptr;
        if (r < SROW0) { int b, t; row_bt(r, b, t); pi = t; ksq = Ks + ((size_t)(b * SP + t + SPAD)) * 512; vsq = Vs + ((size_t)(b * SP + t + SPAD)) * 512; ko = P.out + O_KP + ((size_t)(b * TP + t)) * 512; vo = P.out + O_VP + ((size_t)(b * TP + t)) * 512; iko = P.out + O_IKP + ((size_t)(b * TP + t)) * 64; kib = KIb + ((size_t)(b * KIROWS + t)) * 64; }
        else { const int sb = r - SROW0; pi = POS_SAMPLE_IDX; ko = P.out + O_KS + (size_t)sb * 512; vo = P.out + O_VS + (size_t)sb * 512; iko = P.out + O_IKS + (size_t)sb * 64; }
        const f32x2* c128 = t128 + (size_t)pi * 64; const f32x2* c64 = t64 + (size_t)pi * 32;
        const int hd = lane >> 2, sub = lane & 3;
        {
            float x1[16], x2[16], o1[16], o2[16];
            { float t8[8]; unpack8(*(const v4u*)(pr + hd * 128 + 16 * sub), t8);
#pragma unroll
              for (int i = 0; i < 8; ++i) x1[i] = t8[i]; unpack8(*(const v4u*)(pr + hd * 128 + 16 * sub + 8), t8);
#pragma unroll
              for (int i = 0; i < 8; ++i) x1[8 + i] = t8[i]; unpack8(*(const v4u*)(pr + hd * 128 + 64 + 16 * sub), t8);
#pragma unroll
              for (int i = 0; i < 8; ++i) x2[i] = t8[i]; unpack8(*(const v4u*)(pr + hd * 128 + 64 + 16 * sub + 8), t8);
#pragma unroll
              for (int i = 0; i < 8; ++i) x2[8 + i] = t8[i]; }
#pragma unroll
            for (int i = 0; i < 16; i += 2) { const f32x4 cs = *(const f32x4*)(c128 + 16 * sub + i);
                o1[i] = (x1[i] * cs.x - x2[i] * cs.y) * QSCALE; o2[i] = (x2[i] * cs.x + x1[i] * cs.y) * QSCALE;
                o1[i + 1] = (x1[i + 1] * cs.z - x2[i + 1] * cs.w) * QSCALE; o2[i + 1] = (x2[i + 1] * cs.z + x1[i + 1] * cs.w) * QSCALE; }
            bf16* qo = Qr + (size_t)r * DM + hd * 128 + 16 * sub;
            { float t8[8];
#pragma unroll
              for (int i = 0; i < 8; ++i) t8[i] = o1[i]; *(v4u*)qo = pack8(t8);
#pragma unroll
              for (int i = 0; i < 8; ++i) t8[i] = o1[8 + i]; *(v4u*)(qo + 8) = pack8(t8);
#pragma unroll
              for (int i = 0; i < 8; ++i) t8[i] = o2[i]; *(v4u*)(qo + 64) = pack8(t8);
#pragma unroll
              for (int i = 0; i < 8; ++i) t8[i] = o2[8 + i]; *(v4u*)(qo + 72) = pack8(t8); }
        }
        if (lane < 16) {
            const bf16* kp = pr + 2048 + hd * 128 + 16 * sub;
#pragma unroll
            for (int hf = 0; hf < 2; ++hf) { float x1[8], x2[8], o1[8], o2[8]; unpack8(*(const v4u*)(kp + 8 * hf), x1); unpack8(*(const v4u*)(kp + 64 + 8 * hf), x2);
#pragma unroll
                for (int i = 0; i < 8; i += 2) { const f32x4 cs = *(const f32x4*)(c128 + 16 * sub + 8 * hf + i);
                    o1[i] = x1[i] * cs.x - x2[i] * cs.y; o2[i] = x2[i] * cs.x + x1[i] * cs.y; o1[i + 1] = x1[i + 1] * cs.z - x2[i + 1] * cs.w; o2[i + 1] = x2[i + 1] * cs.z + x1[i + 1] * cs.w; }
                float* kq = ko + hd * 128 + 16 * sub + 8 * hf;
                *(f32x4*)kq = (f32x4){o1[0], o1[1], o1[2], o1[3]}; *(f32x4*)(kq + 4) = (f32x4){o1[4], o1[5], o1[6], o1[7]};
                *(f32x4*)(kq + 64) = (f32x4){o2[0], o2[1], o2[2], o2[3]}; *(f32x4*)(kq + 68) = (f32x4){o2[4], o2[5], o2[6], o2[7]};
                if (ksq) { *(v4u*)(ksq + hd * 128 + 16 * sub + 8 * hf) = pack8(o1); *(v4u*)(ksq + hd * 128 + 64 + 16 * sub + 8 * hf) = pack8(o2); } }
        }
        {
            const v4u vv = *(const v4u*)(pr + 2560 + 8 * lane); float vf[8]; unpack8(vv, vf);
            *(f32x4*)(vo + 8 * lane) = (f32x4){vf[0], vf[1], vf[2], vf[3]}; *(f32x4*)(vo + 8 * lane + 4) = (f32x4){vf[4], vf[5], vf[6], vf[7]};
            if (vsq) *(v4u*)(vsq + 8 * lane) = vv;
        }
        {
            float x1[8], x2[8], o1[8], o2[8]; unpack8(*(const v4u*)(pr + 3072 + hd * 64 + 8 * sub), x1); unpack8(*(const v4u*)(pr + 3072 + hd * 64 + 32 + 8 * sub), x2);
#pragma unroll
            for (int i = 0; i < 8; i += 2) { const f32x4 cs = *(const f32x4*)(c64 + 8 * sub + i);
                o1[i] = x1[i] * cs.x - x2[i] * cs.y; o2[i] = x2[i] * cs.x + x1[i] * cs.y; o1[i + 1] = x1[i + 1] * cs.z - x2[i + 1] * cs.w; o2[i + 1] = x2[i + 1] * cs.z + x1[i + 1] * cs.w; }
            *(v4u*)(QI + (size_t)r * 1024 + hd * 64 + 8 * sub) = pack8(o1); *(v4u*)(QI + (size_t)r * 1024 + hd * 64 + 32 + 8 * sub) = pack8(o2);
        }
        if (lane < 4) {
            float x1[8], x2[8], o1[8], o2[8]; unpack8(*(const v4u*)(pr + 4096 + 8 * sub), x1); unpack8(*(const v4u*)(pr + 4096 + 32 + 8 * sub), x2);
#pragma unroll
            for (int i = 0; i < 8; i += 2) { const f32x4 cs = *(const f32x4*)(c64 + 8 * sub + i);
                o1[i] = x1[i] * cs.x - x2[i] * cs.y; o2[i] = x2[i] * cs.x + x1[i] * cs.y; o1[i + 1] = x1[i + 1] * cs.z - x2[i + 1] * cs.w; o2[i + 1] = x2[i + 1] * cs.z + x1[i + 1] * cs.w; }
            float* io = iko + 8 * sub;
            *(f32x4*)io = (f32x4){o1[0], o1[1], o1[2], o1[3]}; *(f32x4*)(io + 4) = (f32x4){o1[4], o1[5], o1[6], o1[7]};
            *(f32x4*)(io + 32) = (f32x4){o2[0], o2[1], o2[2], o2[3]}; *(f32x4*)(io + 36) = (f32x4){o2[4], o2[5], o2[6], o2[7]};
            if (kib) { *(v4u*)(kib + 8 * sub) = pack8(o1); *(v4u*)(kib + 32 + 8 * sub) = pack8(o2); }
        } else if (lane < 6) {
            float wv[8]; unpack8(*(const v4u*)(pr + 4160 + 8 * (lane - 4)), wv); float* wo = WI + (size_t)r * 16 + 8 * (lane - 4);
            *(f32x4*)wo = (f32x4){wv[0], wv[1], wv[2], wv[3]}; *(f32x4*)(wo + 4) = (f32x4){wv[4], wv[5], wv[6], wv[7]};
        }
    }
}

__device__ __forceinline__ void indexer_prompt(const Ptrs& P, LAS unsigned char* lds, int tid, int wave, int lane) {
    unsigned char* ws = P.ws;
    const bf16* QI = (const bf16*)(ws + WS_QI); const bf16* KIb = (const bf16*)(ws + WS_KIB); const float* WI = (const float*)(ws + WS_WI); float* SC = (float*)(ws + WS_SC);
    const int n = lane & 31, h8 = lane >> 5;
    const int qsel = (n >> 2) & 1, head = (n & 3) + 4 * (n >> 3);
    constexpr int NG = TP / 16;
    constexpr int KROW = 144, TBUF = 128 * KROW;
    for (int it = blockIdx.x; it < 2 * NG; it += gridDim.x) {
        int b, qg;
        if (it < 256) { b = it & 1; qg = it >> 1; } else if (it < 512) { b = it & 1; qg = 256 - ((it - 256) >> 1); } else { b = it - 512; qg = 128; }
        const int t0 = 16 * qg + 2 * wave;
        const bf16* qa = QI + (size_t)prow(b, t0 + qsel) * 1024 + head * 64 + 8 * h8;
        bf16x8 a[4];
#pragma unroll
        for (int kk = 0; kk < 4; ++kk) a[kk] = *(const bf16x8*)(qa + 16 * kk);
        const int tq = t0 + h8;
        const float* wp = WI + (size_t)prow(b, tq) * 16;
        float w[16];
#pragma unroll
        for (int i = 0; i < 4; ++i) { const f32x4 x = *(const f32x4*)(wp + 4 * i); w[4 * i] = x.x; w[4 * i + 1] = x.y; w[4 * i + 2] = x.z; w[4 * i + 3] = x.w; }
        const int ntile = ((16 * qg + 15) >> 5) + 1, ntrip = (ntile + 3) >> 2;
        float* scrow = SC + ((size_t)(b * TP + tq)) * SCW;
        const bf16* kbase = KIb + (size_t)b * KIROWS * 64;
        const int p0 = tid, p1 = tid + 512;
        const int l0 = (p0 >> 3) * KROW + (p0 & 7) * 16, l1 = (p1 >> 3) * KROW + (p1 & 7) * 16;
        asm volatile("s_waitcnt lgkmcnt(0)\n\ts_barrier" ::: "memory");
        v4u g0 = *(const v4u*)(kbase + (size_t)p0 * 8), g1 = *(const v4u*)(kbase + (size_t)p1 * 8);
        *(LAS v4u*)(lds + l0) = g0; *(LAS v4u*)(lds + l1) = g1;
        for (int tr = 0; tr < ntrip; ++tr) {
            const int cur = tr & 1;
            if (tr + 1 < ntrip) { const size_t ko = (size_t)(tr + 1) * 128 * 64;
                const int kmax = KIROWS * 64 - 8;
                const size_t o0 = ko + (size_t)p0 * 8, o1 = ko + (size_t)p1 * 8;
                g0 = *(const v4u*)(kbase + (o0 <= (size_t)kmax ? o0 : (size_t)kmax)); g1 = *(const v4u*)(kbase + (o1 <= (size_t)kmax ? o1 : (size_t)kmax)); }
            asm volatile("s_waitcnt lgkmcnt(0)\n\ts_barrier" ::: "memory");
            const LAS unsigned char* kb = lds + cur * TBUF + n * KROW + h8 * 16;
#pragma unroll
            for (int u = 0; u < 4; ++u) {
                f32x16 acc;
#pragma unroll
                for (int i = 0; i < 16; ++i) acc[i] = 0.f;
#pragma unroll
                for (int kk = 0; kk < 4; ++kk) acc = __builtin_amdgcn_mfma_f32_32x32x16_bf16(a[kk], *(const LAS bf16x8*)(kb + u * 32 * KROW + kk * 32), acc, 0, 0, 0);
                float sc = 0.f;
#pragma unroll
                for (int i = 0; i < 16; ++i) sc += w[i] * fmaxf(acc[i], 0.f);
                const int s = 32 * (4 * tr + u) + n;
                if (s <= tq) scrow[s] = sc;
            }
            if (tr + 1 < ntrip) { *(LAS v4u*)(lds + (cur ^ 1) * TBUF + l0) = g0; *(LAS v4u*)(lds + (cur ^ 1) * TBUF + l1) = g1; }
        }
    }
    asm volatile("s_waitcnt lgkmcnt(0)\n\ts_barrier" ::: "memory");
}

__device__ __forceinline__ void indexer_sample(const Ptrs& P, LAS unsigned char* lds, int tid) {
    unsigned char* ws = P.ws;
    const bf16* QI = (const bf16*)(ws + WS_QI); const float* WI = (const float*)(ws + WS_WI); float* SCS = (float*)(ws + WS_SCS);
    LAS float* lq = (LAS float*)lds;
    LAS float* lw = lq + 1024;
    constexpr int NCH = (NSKEY + 511) / 512;
    for (int item = blockIdx.x; item < SBN * NCH; item += gridDim.x) {
        const int sb = item / NCH, ch = item % NCH, r = SROW0 + sb;
        __syncthreads();
        for (int e = tid; e < 1024; e += NTHREADS) lq[e] = bf2f(QI[(size_t)r * 1024 + e]);
        if (tid < 16) lw[tid] = WI[(size_t)r * 16 + tid];
        __syncthreads();
        const int s = ch * 512 + tid;
        if (s < NSKEY) {
            const float* kr = (s < PAST) ? P.cache_ik + ((size_t)P.page_table[sb * NPG + (s >> 7)] * 128 + (s & 127)) * 64 : P.out + O_IKS + (size_t)sb * 64;
            f32x4 kv[16];
#pragma unroll
            for (int i = 0; i < 16; ++i) kv[i] = *(const f32x4*)(kr + 4 * i);
            float sc = 0.f;
            for (int h = 0; h < 16; ++h) { float d = 0.f;
#pragma unroll
                for (int i = 0; i < 16; ++i) { const f32x4 q = *(const LAS f32x4*)(lq + h * 64 + 4 * i); d += q.x * kv[i].x + q.y * kv[i].y + q.z * kv[i].z + q.w * kv[i].w; }
                sc += lw[h] * fmaxf(d, 0.f); }
            SCS[(size_t)sb * SCSW + s] = sc;
        }
    }
    __syncthreads();
}

__device__ __forceinline__ unsigned ordkey(float f) { const unsigned u = __float_as_uint(f); return (u & 0x80000000u) ? ~u : (u | 0x80000000u); }
constexpr int TOPK = 256;
__device__ __forceinline__ void topk_wave_mask(const float* sc, int n, unsigned long long* mrow, int lane) {
    constexpr int NS = MTW, M0 = SPAD / 64;
    static_assert(M0 == dattn::JLO, "first real key tile");
    unsigned key[NS];
#pragma unroll
    for (int m = M0; m < NS; ++m) { const int sidx = lane + 64 * m - SPAD; const int ci = sidx < 0 ? 0 : (sidx < n ? sidx : n - 1); const float v = sc[ci]; key[m] = (sidx >= 0 && sidx < n) ? ordkey(v) : 0u; }
    if (n <= TOPK) {
#pragma unroll
        for (int m = M0; m < NS; ++m) { const unsigned long long w = __ballot(key[m] != 0u); if (lane == 0) mrow[m] = w; }
        return;
    }
    unsigned T = 0u;
    for (int bit = 31; bit >= 0; --bit) {
        const unsigned cand = T | (1u << bit); int c = 0;
#pragma unroll
        for (int m = M0; m < NS; ++m) c += __popcll(__ballot(key[m] >= cand));
        if (c >= TOPK) T = cand;
    }
    int cg = 0;
#pragma unroll
    for (int m = M0; m < NS; ++m) cg += __popcll(__ballot(key[m] > T));
    const int need = TOPK - cg;
    int base_e = 0;
    const unsigned long long lt = (1ull << lane) - 1ull;
#pragma unroll
    for (int m = M0; m < NS; ++m) {
        const bool pg = key[m] > T, pe = key[m] == T;
        const unsigned long long me = __ballot(pe);
        const int pre_e = __popcll(me & lt);
        const unsigned long long w = __ballot(pg || (pe && (base_e + pre_e) < need));
        if (lane == 0) mrow[m] = w;
        base_e += __popcll(me);
    }
}
__device__ __forceinline__ void topk_block(const float* sc, int n, int* outIdx, int* outCnt, LAS unsigned* ls, int tid, int wave, int lane) {
    constexpr int NS = (NSKEY + NTHREADS - 1) / NTHREADS;
    unsigned key[NS];
#pragma unroll
    for (int m = 0; m < NS; ++m) { const int e = tid + NTHREADS * m; const float v = sc[e < n ? e : n - 1]; key[m] = (e < n) ? ordkey(v) : 0u; }
    unsigned T = 0u;
    for (int bit = 31; bit >= 0; --bit) {
        const unsigned cand = T | (1u << bit); int c = 0;
#pragma unroll
        for (int m = 0; m < NS; ++m) c += (key[m] >= cand) ? 1 : 0;
        c = wave_sum_i(c);
        LAS unsigned* buf = ls + (bit & 1) * 8;
        if (lane == 0) buf[wave] = (unsigned)c;
        __syncthreads();
        int tot = 0;
#pragma unroll
        for (int w = 0; w < 8; ++w) tot += (int)buf[w];
        if (tot >= TOPK) T = cand;
    }
    __syncthreads();
    if (tid == 0) { unsigned z_ = 0u; asm volatile("" : "+v"(z_)); ls[16] = z_; ls[17] = z_; }
    __syncthreads();
#pragma unroll
    for (int m = 0; m < NS; ++m) { const int e = tid + NTHREADS * m; if (key[m] > T) { const unsigned pos = atomicAdd((unsigned*)(ls + 16), 1u); if (pos < (unsigned)TOPK) outIdx[pos] = e; } }
    __syncthreads();
    const unsigned cg = ls[16];
    const unsigned need = (unsigned)TOPK - cg;
#pragma unroll
    for (int m = 0; m < NS; ++m) { const int e = tid + NTHREADS * m; if (key[m] == T) { const unsigned pos = atomicAdd((unsigned*)(ls + 17), 1u); if (pos < need) outIdx[cg + pos] = e; } }
    if (tid == 0) *outCnt = TOPK;
    __syncthreads();
}
__device__ __forceinline__ void select_phase(const Ptrs& P, LAS unsigned char* lds, int gw, int NGW, int tid, int wave, int lane) {
    unsigned char* ws = P.ws;
    const float* SC = (const float*)(ws + WS_SC); const float* SCS = (const float*)(ws + WS_SCS); int* IDXL = (int*)(ws + WS_IDXL); int* CNT = (int*)(ws + WS_CNT);
    for (int sb = blockIdx.x; sb < SBN; sb += gridDim.x) topk_block(SCS + (size_t)sb * SCSW, NSKEY, IDXL + (size_t)(SROW0 + sb) * TOPK, CNT + SROW0 + sb, (LAS unsigned*)lds, tid, wave, lane);
    unsigned long long* MASK = (unsigned long long*)(ws + WS_MASK);
    for (int r = gw; r < SROW0; r += NGW) { int b, t; row_bt(r, b, t);
        if (r < XROW0) topk_wave_mask(SC + ((size_t)(b * TP + t)) * SCW, t + 1, MASK + ((size_t)(b * SP + t + SPAD)) * MTW, lane);
        else { if (lane <= t) IDXL[(size_t)r * TOPK + lane] = lane; if (lane == 0) CNT[r] = t + 1; } }
}

__device__ __forceinline__ void attn_phase(const Ptrs& P, bf16* O, LAS unsigned char* lds, int gw, int NGW, int wave, int lane) {
    unsigned char* ws = P.ws;
    const bf16* Qr = (const bf16*)(ws + WS_QR); const int* IDXL = (const int*)(ws + WS_IDXL); const int* CNT = (const int*)(ws + WS_CNT);
    LAS float* lq = (LAS float*)(lds + wave * 12288);
    LAS f32x4* lp = (LAS f32x4*)(lds + wave * 12288 + 2048);
    LAS unsigned long long* lkp = (LAS unsigned long long*)(lds + wave * 12288 + 6144);
    LAS unsigned long long* lvp = (LAS unsigned long long*)(lds + wave * 12288 + 8192);
    for (int item = gw; item < (NROWS - XROW0) * 4; item += NGW) {
        const int r = XROW0 + (item >> 2), n = item & 3;
        const int cnt = CNT[r];
        WAVE_SYNC();
        { float qf[8]; unpack8(*(const v4u*)(Qr + (size_t)r * DM + n * 512 + 8 * lane), qf);
          *(LAS f32x4*)(lq + 8 * lane) = (f32x4){qf[0], qf[1], qf[2], qf[3]}; *(LAS f32x4*)(lq + 8 * lane + 4) = (f32x4){qf[4], qf[5], qf[6], qf[7]}; }
        const float* kp[4];
#pragma unroll
        for (int j = 0; j < 4; ++j) {
            const int e = lane + 64 * j; const int s = (e < cnt) ? IDXL[(size_t)r * TOPK + e] : 0;
            const float *kq, *vq;
            if (r < SROW0) { const int b = (r < XROW0) ? (r >> 12) : ((r - XROW0) >> 4); kq = P.out + O_KP + ((size_t)(b * TP + s)) * 512; vq = P.out + O_VP + ((size_t)(b * TP + s)) * 512; }
            else { const int sb = r - SROW0;
                if (s < PAST) { const size_t off = ((size_t)P.page_table[sb * NPG + (s >> 7)] * 128 + (s & 127)) * 512; kq = P.cache_k + off; vq = P.cache_v + off; }
                else { kq = P.out + O_KS + (size_t)sb * 512; vq = P.out + O_VS + (size_t)sb * 512; } }
            kp[j] = kq + n * 128; lkp[e] = (unsigned long long)(kq + n * 128); lvp[e] = (unsigned long long)(vq + n * 128);
        }
        WAVE_SYNC();
        float acc[4][4];
#pragma unroll
        for (int g = 0; g < 4; ++g)
#pragma unroll
            for (int j = 0; j < 4; ++j) acc[g][j] = 0.f;
#pragma unroll 4
        for (int d4 = 0; d4 < 32; ++d4) {
            f32x4 qv[4];
#pragma unroll
            for (int g = 0; g < 4; ++g) qv[g] = *(const LAS f32x4*)(lq + g * 128 + 4 * d4);
#pragma unroll
            for (int j = 0; j < 4; ++j) { const f32x4 kv = *(const f32x4*)(kp[j] + 4 * d4);
#pragma unroll
                for (int g = 0; g < 4; ++g) acc[g][j] += qv[g].x * kv.x + qv[g].y * kv.y + qv[g].z * kv.z + qv[g].w * kv.w; }
        }
        float linv[4];
#pragma unroll
        for (int g = 0; g < 4; ++g) {
            float m = -INFINITY;
#pragma unroll
            for (int j = 0; j < 4; ++j) { if (lane + 64 * j >= cnt) acc[g][j] = -INFINITY; m = fmaxf(m, acc[g][j]); }
            m = wave_max(m); float l = 0.f;
#pragma unroll
            for (int j = 0; j < 4; ++j) { acc[g][j] = __expf(acc[g][j] - m); l += acc[g][j]; }
            linv[g] = 1.f / wave_sum(l);
        }
#pragma unroll
        for (int j = 0; j < 4; ++j) lp[lane + 64 * j] = (f32x4){acc[0][j], acc[1][j], acc[2][j], acc[3][j]};
        WAVE_SYNC();
        float o[4][2];
#pragma unroll
        for (int g = 0; g < 4; ++g) { o[g][0] = 0.f; o[g][1] = 0.f; }
#pragma unroll 8
        for (int e = 0; e < cnt; ++e) {
            const float* vp = (const float*)lvp[e]; const f32x2 vv = *(const f32x2*)(vp + 2 * lane); const f32x4 p = lp[e];
            o[0][0] += p.x * vv.x; o[0][1] += p.x * vv.y; o[1][0] += p.y * vv.x; o[1][1] += p.y * vv.y; o[2][0] += p.z * vv.x; o[2][1] += p.z * vv.y; o[3][0] += p.w * vv.x; o[3][1] += p.w * vv.y;
        }
#pragma unroll
        for (int g = 0; g < 4; ++g) *(unsigned*)(O + (size_t)r * DM + (4 * n + g) * 128 + 2 * lane) = pk2(o[g][0] * linv[g], o[g][1] * linv[g]);
    }
}

__device__ __forceinline__ void convC_finish(float (&acc)[8], int it) {
    float ss = 0.f;
#pragma unroll
    for (int i = 0; i < 8; ++i) { acc[i] = silu_f(acc[i]); ss += acc[i] * acc[i]; }
    if (it < 8) { ss = row16_sum(ss); float rn = 1.f / sqrtf(ss + RMS_EPS); if (it < 4) rn *= QSCALE;
#pragma unroll
        for (int i = 0; i < 8; ++i) acc[i] *= rn; }
}
__device__ __forceinline__ void convC_phase(const bf16* PROJC, const Ptrs& P, int gw, int NGW, int lane) {
    unsigned char* ws = P.ws;
    bf16* QKVC = (bf16*)(ws + WS_QKVC); float* QKF = (float*)(ws + WS_QKF); float* G = (float*)(ws + WS_G); float* BETA = (float*)(ws + WS_BETA);
    const float* cw = P.conv_w_c;
    constexpr int RUN = 8, NRUN = TP / RUN;
    for (int item = gw; item < 16 * NBP * NRUN; item += NGW) {
        const int it = item & 15, ru = item >> 4, b = ru / NRUN, t0 = (ru % NRUN) * RUN, ch0 = it * 512 + 8 * lane;
        float w[4][8];
#pragma unroll
        for (int j = 0; j < 4; ++j) { const f32x4 w0 = *(const f32x4*)(cw + (size_t)j * CDIM + ch0), w1 = *(const f32x4*)(cw + (size_t)j * CDIM + ch0 + 4);
            w[j][0] = w0.x; w[j][1] = w0.y; w[j][2] = w0.z; w[j][3] = w0.w; w[j][4] = w1.x; w[j][5] = w1.y; w[j][6] = w1.z; w[j][7] = w1.w; }
        const int r0 = prow(b, t0);
        v4u xr[RUN + 3];
#pragma unroll
        for (int j = 0; j < 3; ++j) { const int tt = t0 - 3 + j; xr[j] = tt >= 0 ? *(const v4u*)(PROJC + (size_t)prow(b, tt) * NC_PAD + ch0) : (v4u){0u, 0u, 0u, 0u}; }
#pragma unroll
        for (int k = 0; k < RUN; ++k) xr[3 + k] = *(const v4u*)(PROJC + (size_t)(r0 + k) * NC_PAD + ch0);
        float x[RUN + 3][8];
#pragma unroll
        for (int j = 0; j < RUN + 3; ++j) unpack8(xr[j], x[j]);
#pragma unroll
        for (int k = 0; k < RUN; ++k) {
            float acc[8];
#pragma unroll
            for (int i = 0; i < 8; ++i) acc[i] = w[0][i] * x[k][i] + w[1][i] * x[k + 1][i] + w[2][i] * x[k + 2][i] + w[3][i] * x[k + 3][i];
            convC_finish(acc, it);
            *(v4u*)(QKVC + (size_t)(r0 + k) * CDIM + ch0) = pack8(acc);
            const int t = t0 + k;
            if (t >= TP - 3) { float* o = P.out + O_CCP + ((size_t)(b * 3 + (t - (TP - 3)))) * CDIM + ch0;
                *(f32x4*)o = (f32x4){x[k + 3][0], x[k + 3][1], x[k + 3][2], x[k + 3][3]}; *(f32x4*)(o + 4) = (f32x4){x[k + 3][4], x[k + 3][5], x[k + 3][6], x[k + 3][7]}; }
        }
    }
    for (int item = gw; item < 16 * SBN; item += NGW) {
        const int it = item & 15, sb = item >> 4, r = SROW0 + sb, ch0 = it * 512 + 8 * lane;
        float x[4][8];
#pragma unroll
        for (int j = 0; j < 3; ++j) { const float* hp = P.state_conv_c + ((size_t)(sb * 3 + j)) * CDIM + ch0; const f32x4 a = *(const f32x4*)hp, c = *(const f32x4*)(hp + 4);
            x[j][0] = a.x; x[j][1] = a.y; x[j][2] = a.z; x[j][3] = a.w; x[j][4] = c.x; x[j][5] = c.y; x[j][6] = c.z; x[j][7] = c.w; }
        unpack8(*(const v4u*)(PROJC + (size_t)r * NC_PAD + ch0), x[3]);
        float acc[8];
#pragma unroll
        for (int i = 0; i < 8; ++i) acc[i] = 0.f;
#pragma unroll
        for (int j = 0; j < 4; ++j) { const f32x4 w0 = *(const f32x4*)(cw + (size_t)j * CDIM + ch0), w1 = *(const f32x4*)(cw + (size_t)j * CDIM + ch0 + 4);
            acc[0] += w0.x * x[j][0]; acc[1] += w0.y * x[j][1]; acc[2] += w0.z * x[j][2]; acc[3] += w0.w * x[j][3];
            acc[4] += w1.x * x[j][4]; acc[5] += w1.y * x[j][5]; acc[6] += w1.z * x[j][6]; acc[7] += w1.w * x[j][7]; }
        convC_finish(acc, it);
        if (it < 8) { float* qk = QKF + (size_t)r * 4096 + ch0; *(f32x4*)qk = (f32x4){acc[0], acc[1], acc[2], acc[3]}; *(f32x4*)(qk + 4) = (f32x4){acc[4], acc[5], acc[6], acc[7]}; }
        *(v4u*)(QKVC + (size_t)r * CDIM + ch0) = pack8(acc);
        float* o = P.out + O_CCS + ((size_t)(sb * 3)) * CDIM + ch0;
#pragma unroll
        for (int j = 0; j < 3; ++j) { *(f32x4*)(o + (size_t)j * CDIM) = (f32x4){x[j + 1][0], x[j + 1][1], x[j + 1][2], x[j + 1][3]}; *(f32x4*)(o + (size_t)j * CDIM + 4) = (f32x4){x[j + 1][4], x[j + 1][5], x[j + 1][6], x[j + 1][7]}; }
    }
    for (int e = gw * 64 + lane; e < NROWS * 32; e += NGW * 64) {
        const int r = e >> 5, h = e & 31;
        const float braw = bf2f(PROJC[(size_t)r * NC_PAD + 12288 + h]), araw = bf2f(PROJC[(size_t)r * NC_PAD + 12320 + h]);
        const float xx = araw + P.dt_bias[h]; const float sp = xx > 20.f ? xx : __logf(1.f + __expf(xx));
        G[e] = -__expf(P.a_log[h]) * sp; BETA[e] = 1.f / (1.f + __expf(-braw));
    }
}

struct Tok { f32x4 k0, k1, q0, q1; unsigned v; float g, b; };
__device__ __forceinline__ void tok_load(Tok& T, const float* QKF, const bf16* QKVC, const float* G, const float* BETA, int row, int h, int rg, int col0) {
    const float* base = QKF + (size_t)row * 4096 + (h >> 1) * 128 + 8 * rg;
    T.q0 = *(const f32x4*)base; T.q1 = *(const f32x4*)(base + 4); T.k0 = *(const f32x4*)(base + 2048); T.k1 = *(const f32x4*)(base + 2052);
    T.v = *(const unsigned*)(QKVC + (size_t)row * CDIM + 4096 + h * 128 + col0);
    T.g = G[(size_t)row * 32 + h]; T.b = BETA[(size_t)row * 32 + h];
}
__device__ __forceinline__ f32x2 tok_step(f32x2 (&S)[8], const Tok& T) {
    const float kk[8] = {T.k0.x, T.k0.y, T.k0.z, T.k0.w, T.k1.x, T.k1.y, T.k1.z, T.k1.w};
    const float qq[8] = {T.q0.x, T.q0.y, T.q0.z, T.q0.w, T.q1.x, T.q1.y, T.q1.z, T.q1.w};
    const float a = __expf(T.g);
    f32x2 d0 = S[0] * kk[0], d1 = S[1] * kk[1];
#pragma unroll
    for (int i = 2; i < 8; i += 2) { d0 += S[i] * kk[i]; d1 += S[i + 1] * kk[i + 1]; }
    f32x2 d = d0 + d1;
    d.x = row16_sum(d.x); d.y = row16_sum(d.y);
    const f32x2 tv = {bflo(T.v), bfhi(T.v)};
    const f32x2 dl = (tv - d * a) * T.b;
    f32x2 o0 = {0.f, 0.f}, o1 = {0.f, 0.f};
#pragma unroll
    for (int i = 0; i < 8; i += 2) { S[i] = S[i] * a + dl * kk[i]; o0 += S[i] * qq[i]; S[i + 1] = S[i + 1] * a + dl * kk[i + 1]; o1 += S[i + 1] * qq[i + 1]; }
    f32x2 o = o0 + o1;
    o.x = row16_sum(o.x); o.y = row16_sum(o.y);
    return o;
}
constexpr int DBK = 2;
__device__ __forceinline__ void delta_segment(f32x2 (&S)[8], const float* QKF, const bf16* QKVC, const float* G, const float* BETA, float* OF, int rowbase, int ntok, int h, int rg, int col0) {
    Tok A[DBK], B[DBK];
#pragma unroll
    for (int i = 0; i < DBK; ++i) tok_load(A[i], QKF, QKVC, G, BETA, rowbase + i, h, rg, col0);
    for (int t0 = 0; t0 < ntok; t0 += 2 * DBK) {
        f32x2 o[DBK];
#pragma unroll
        for (int i = 0; i < DBK; ++i) tok_load(B[i], QKF, QKVC, G, BETA, rowbase + t0 + DBK + i, h, rg, col0);
#pragma unroll
        for (int i = 0; i < DBK; ++i) o[i] = tok_step(S, A[i]);
        if (rg == 0) {
#pragma unroll
            for (int i = 0; i < DBK; ++i) *(f32x2*)(OF + (size_t)(rowbase + t0 + i) * DVW + h * 128 + col0) = o[i]; }
        if (t0 + 2 * DBK < ntok) {
#pragma unroll
            for (int i = 0; i < DBK; ++i) tok_load(A[i], QKF, QKVC, G, BETA, rowbase + t0 + 2 * DBK + i, h, rg, col0); }
#pragma unroll
        for (int i = 0; i < DBK; ++i) o[i] = tok_step(S, B[i]);
        if (rg == 0) {
#pragma unroll
            for (int i = 0; i < DBK; ++i) *(f32x2*)(OF + (size_t)(rowbase + t0 + DBK + i) * DVW + h * 128 + col0) = o[i]; }
    }
}
__device__ __forceinline__ void delta_phase(const Ptrs& P, int wave, int lane) {
    unsigned char* ws = P.ws;
    const bf16* QKVC = (const bf16*)(ws + WS_QKVC); const float* QKF = (const float*)(ws + WS_QKF); const float* G = (const float*)(ws + WS_G); const float* BETA = (const float*)(ws + WS_BETA); float* OF = (float*)(ws + WS_SC);
    const int cg = lane >> 4, rg = lane & 15;
    {
        for (int item = blockIdx.x * 8 + wave; item < SBN * 32 * 16; item += gridDim.x * 8) {
            const int sb = item >> 9, h = (item >> 4) & 31, col0 = 8 * (item & 15) + 2 * cg;
            const size_t so = ((size_t)((sb * 32 + h) * 128 + 8 * rg)) * 128 + col0;
            f32x2 S[8];
#pragma unroll
            for (int i = 0; i < 8; ++i) S[i] = *(const f32x2*)(P.state_delta + so + (size_t)i * 128);
            Tok T; tok_load(T, QKF, QKVC, G, BETA, SROW0 + sb, h, rg, col0);
            const f32x2 o = tok_step(S, T);
            if (rg == 0) *(f32x2*)(OF + (size_t)(SROW0 + sb) * DVW + h * 128 + col0) = o;
            float* op = P.out + O_DS + so;
#pragma unroll
            for (int i = 0; i < 8; ++i) *(f32x2*)(op + (size_t)i * 128) = S[i];
        }
    }
}
__device__ __forceinline__ void normC_phase(const bf16* PROJC, bf16* Y, const Ptrs& P, int gw, int NGW, int lane) {
    const float* OF = (const float*)(P.ws + WS_SC);
    const int d0 = 8 * (lane & 15);
    float nw[8];
    { const f32x4 a = *(const f32x4*)(P.norm_w + d0), b = *(const f32x4*)(P.norm_w + d0 + 4); nw[0] = a.x; nw[1] = a.y; nw[2] = a.z; nw[3] = a.w; nw[4] = b.x; nw[5] = b.y; nw[6] = b.z; nw[7] = b.w; }
    for (int r = gw; r < NROWS; r += NGW) {
        f32x4 oa[8], ob[8]; v4u zz[8];
#pragma unroll
        for (int it = 0; it < 8; ++it) { const int hd = it * 4 + (lane >> 4); const float* op = OF + (size_t)r * DVW + hd * 128 + d0;
            oa[it] = *(const f32x4*)op; ob[it] = *(const f32x4*)(op + 4); zz[it] = *(const v4u*)(PROJC + (size_t)r * NC_PAD + 8192 + hd * 128 + d0); }
#pragma unroll
        for (int it = 0; it < 8; ++it) {
            const int hd = it * 4 + (lane >> 4);
            float o[8] = {oa[it].x, oa[it].y, oa[it].z, oa[it].w, ob[it].x, ob[it].y, ob[it].z, ob[it].w};
            float ss = 0.f;
#pragma unroll
            for (int i = 0; i < 8; ++i) ss += o[i] * o[i];
            ss = row16_sum(ss);
            const float rs = 1.f / sqrtf(ss * (1.f / 128.f) + RMS_EPS);
            float z[8]; unpack8(zz[it], z);
#pragma unroll
            for (int i = 0; i < 8; ++i) o[i] = o[i] * rs * nw[i] * silu_f(z[i]);
            *(v4u*)(Y + (size_t)r * DVW + hd * 128 + d0) = pack8(o);
        }
    }
}


__device__ __forceinline__ void dense_attn_phase(const Ptrs& P, bf16* O, char* lds, int wv) {
    unsigned char* ws = P.ws;
    const bf16* Qr = (const bf16*)(ws + WS_QR); const bf16* Ks = (const bf16*)(ws + WS_KS); const bf16* Vs = (const bf16*)(ws + WS_VS);
    const unsigned long long* MASK = (const unsigned long long*)(ws + WS_MASK);
    typedef dattn::BlockRef<bf16, bf16> BR;
    for (int it0 = blockIdx.x; it0 < 256; it0 += gridDim.x) {
        const int grp = it0 & 7, idx = it0 >> 3;
        const int b = grp >> 2, kvh = grp & 3, h = kvh * 4 + (idx >> 3), x = idx & 7;
        BR A, B;
        const int qa = 1 + x, qb = 16 - x;
        A.Q = Qr + ((size_t)(b * SEQ + 256 * (qa - 1))) * DM + h * 128; A.O = O + ((size_t)(b * SEQ + 256 * (qa - 1))) * DM + h * 128;
        B.Q = Qr + ((size_t)(b * SEQ + 256 * (qb - 1))) * DM + h * 128; B.O = O + ((size_t)(b * SEQ + 256 * (qb - 1))) * DM + h * 128;
        A.K = B.K = Ks + (size_t)b * SP * 512 + kvh * 128; A.V = B.V = Vs + (size_t)b * SP * 512 + kvh * 128;
        A.P0 = 256 * qa; B.P0 = 256 * qb;
        A.M = MASK + ((size_t)(b * SP + A.P0)) * MTW; B.M = MASK + ((size_t)(b * SP + B.P0)) * MTW;
        dattn::Seam<bf16> S;
        dattn::causal_swa_prime<bf16, bf16>(A, SP, lds, S, wv);
        dattn::causal_swa_block<bf16, bf16>(A, B, SP, SP, lds, S, wv);
        dattn::causal_swa_block<bf16, bf16>(B, B, SP, SP, lds, S, wv);
    }
}

constexpr int NCH = 65, CPAD = 48;
constexpr int NUQ = NBP * 16 * NCH, NUH = NBP * 32 * NCH;
__device__ __forceinline__ int crow32(int r, int hi) { return (r & 3) + 8 * (r >> 2) + 4 * hi; }
__device__ __forceinline__ int chunk_row(int b, int c, int i) { const int t = 64 * c + i - CPAD; return t >= 0 ? prow(b, t) : -1; }
__device__ __forceinline__ float incl_scan64(float v, int lane) {
#pragma unroll
    for (int o = 1; o < 64; o <<= 1) { const float u = __shfl_up(v, o); if (lane >= o) v += u; }
    return v;
}
#define MFMA32(a, b, c) __builtin_amdgcn_mfma_f32_32x32x16_bf16((a), (b), (c), 0, 0, 0)
__device__ __forceinline__ bf16x8 sel8(bool ok, bf16x8 v) { const bf16x8 z = {0, 0, 0, 0, 0, 0, 0, 0}; return ok ? v : z; }
__device__ __forceinline__ int sw23(int x) { return (x & ~12) | ((x & 4) << 1) | ((x & 8) >> 1); }
__device__ __forceinline__ int fidx64(int row, int xs) { return ((((row >> 5) * 2 + (xs >> 5)) * 2 + ((xs >> 4) & 1)) * 64 + (row & 31) + 32 * ((xs >> 3) & 1)) * 8 + (xs & 7); }

__device__ __forceinline__ v4u pack_frag(const f32x16& x, int s) { v4u w; w.x = pk2(x[8 * s], x[8 * s + 1]); w.y = pk2(x[8 * s + 2], x[8 * s + 3]); w.z = pk2(x[8 * s + 4], x[8 * s + 5]); w.w = pk2(x[8 * s + 6], x[8 * s + 7]); return w; }
__device__ __forceinline__ void delta_d1_unit(unsigned char* ws, LAS unsigned char* lds, int uq, int wave, int lane) {
    asm volatile("" : "+v"(lane));
    const bf16* QKVC = (const bf16*)(ws + WS_QKVC); const float* G = (const float*)(ws + WS_G); const float* BETA = (const float*)(ws + WS_BETA);
    float* AF = (float*)(ws + WS_DAF); bf16* PG = (bf16*)(ws + WS_DPG); bf16* KT = (bf16*)(ws + WS_DKT); bf16* VT = (bf16*)(ws + WS_DVT);
    float* GC = (float*)(ws + WS_DGC); float* BT = (float*)(ws + WS_DBT);
    LAS float* lg = (LAS float*)(lds + wave * 1024);
    const int m = lane & 31, half = lane >> 5;
    const bf16x8 zf = {0, 0, 0, 0, 0, 0, 0, 0};
    {
        const int c = uq % NCH, bh = uq / NCH, hq = bh & 15, b = bh >> 4;
        { const int row = chunk_row(b, c, lane);
#pragma unroll
          for (int hh = 0; hh < 2; ++hh) { const int h = 2 * hq + hh; const float g = row >= 0 ? G[(size_t)row * 32 + h] : 0.f, bt = row >= 0 ? BETA[(size_t)row * 32 + h] : 0.f;
              const float gc = incl_scan64(g, lane); lg[hh * 64 + lane] = gc; lg[128 + hh * 64 + lane] = bt;
              const size_t uh = ((size_t)(b * 32 + h)) * NCH + c; GC[uh * 64 + lane] = gc; BT[uh * 64 + lane] = bt; } }
        const int row0 = chunk_row(b, c, m), row1 = chunk_row(b, c, 32 + m);
        const bf16* r0 = QKVC + (size_t)(row0 < 0 ? 0 : row0) * CDIM; const bf16* r1 = QKVC + (size_t)(row1 < 0 ? 0 : row1) * CDIM;
        f32x16 kk00, kk10, kk11, qk00, qk10, qk11;
#pragma unroll
        for (int i = 0; i < 16; ++i) { kk00[i] = 0.f; kk10[i] = 0.f; kk11[i] = 0.f; qk00[i] = 0.f; qk10[i] = 0.f; qk11[i] = 0.f; }
        const int sm = sw23(m);
        bf16* kt0 = KT + (size_t)uq * 128 * 64 + half * 32 + ((sm >> 4) & 1) * 512 + ((sm >> 3) & 1) * 256 + (sm & 7);
#pragma unroll 1
        for (int kh = 0; kh < 2; ++kh) {
            bf16x8 kf0[4], kf1[4], qf0[4], qf1[4];
#pragma unroll
            for (int u = 0; u < 4; ++u) { const int off = hq * 128 + 16 * (4 * kh + u) + 8 * half;
                kf0[u] = sel8(row0 >= 0, *(const bf16x8*)(r0 + 2048 + off)); kf1[u] = sel8(row1 >= 0, *(const bf16x8*)(r1 + 2048 + off));
                qf0[u] = sel8(row0 >= 0, *(const bf16x8*)(r0 + off)); qf1[u] = sel8(row1 >= 0, *(const bf16x8*)(r1 + off)); }
#pragma unroll
            for (int u = 0; u < 4; ++u) { const int ks = 4 * kh + u; const bf16x8 k0 = kf0[u], k1 = kf1[u], q0 = qf0[u], q1 = qf1[u];
                kk00 = MFMA32(k0, k0, kk00); kk10 = MFMA32(k1, k0, kk10); kk11 = MFMA32(k1, k1, kk11);
                qk00 = MFMA32(q0, k0, qk00); qk10 = MFMA32(q1, k0, qk10); qk11 = MFMA32(q1, k1, qk11);
                bf16* kb = kt0 + (ks >> 1) * 2048 + (ks & 1) * 128;
#pragma unroll
                for (int e = 0; e < 8; ++e) { kb[(8 * (e >> 2) + (e & 3)) * 8] = (bf16)k0[e]; kb[1024 + (8 * (e >> 2) + (e & 3)) * 8] = (bf16)k1[e]; } }
        }
#pragma unroll 1
        for (int hh = 0; hh < 2; ++hh) { const int h = 2 * hq + hh; bf16* vt = VT + (((size_t)(b * 32 + h)) * NCH + c) * 128 * 64 + half * 512 + sm;
            bf16x8 vf0[8], vf1[8];
#pragma unroll
            for (int ks = 0; ks < 8; ++ks) { const int off = 4096 + h * 128 + 16 * ks + 8 * half; vf0[ks] = sel8(row0 >= 0, *(const bf16x8*)(r0 + off)); vf1[ks] = sel8(row1 >= 0, *(const bf16x8*)(r1 + off)); }
#pragma unroll
            for (int ks = 0; ks < 8; ++ks) {
#pragma unroll
                for (int e = 0; e < 8; ++e) { vt[ks * 1024 + e * 64] = (bf16)vf0[ks][e]; vt[ks * 1024 + e * 64 + 32] = (bf16)vf1[ks][e]; } } }
        WAVE_SYNC();
#pragma unroll 1
        for (int hh = 0; hh < 2; ++hh) { const int h = 2 * hq + hh; const size_t uh = ((size_t)(b * 32 + h)) * NCH + c;
            float* af = AF + uh * 4096 + half * 256 + m;
            bf16* pg = PG + uh * 4096 + half * 32 + ((sm >> 4) & 1) * 512 + ((sm >> 3) & 1) * 256 + (sm & 7);
            const float gcj0 = lg[hh * 64 + m], gcj1 = lg[hh * 64 + 32 + m];
#pragma unroll
            for (int r = 0; r < 16; ++r) { const int ir = crow32(r, half), rc = (r & 3) + 8 * (r >> 2);
                const float gi0 = lg[hh * 64 + ir], gi1 = lg[hh * 64 + 32 + ir], bi0 = lg[128 + hh * 64 + ir], bi1 = lg[128 + hh * 64 + 32 + ir];
                { const int i = ir, j = m; const float dec = __expf(fminf(gi0 - gcj0, 0.f)); af[rc * 64] = (j < i) ? bi0 * dec * kk00[r] : 0.f; pg[rc * 8] = f2bf((j <= i) ? dec * qk00[r] : 0.f); }
                { const int i = 32 + ir, j = m; const float dec = __expf(fminf(gi1 - gcj0, 0.f)); af[2048 + rc * 64] = bi1 * dec * kk10[r]; pg[2048 + rc * 8] = f2bf(dec * qk10[r]); }
                { const int i = 32 + ir, j = 32 + m; const float dec = __expf(fminf(gi1 - gcj1, 0.f)); af[2048 + 32 + rc * 64] = (j < i) ? bi1 * dec * kk11[r] : 0.f; pg[2048 + 1024 + rc * 8] = f2bf((j <= i) ? dec * qk11[r] : 0.f); }
            } }
        WAVE_SYNC();
    }
}
__device__ __forceinline__ void delta_d2_unit(unsigned char* ws, int uh, int lane) {
    asm volatile("" : "+v"(lane));
    const float* AF = (const float*)(ws + WS_DAF); const float* GC = (const float*)(ws + WS_DGC); const float* BT = (const float*)(ws + WS_DBT);
    bf16* TG = (bf16*)(ws + WS_DTG); bf16* TB = (bf16*)(ws + WS_DTB);
    {
        const float* af = AF + (size_t)uh * 4096;
        const float bc = BT[(size_t)uh * 64 + lane], gmc = __expf(GC[(size_t)uh * 64 + lane]);
        float T[64];
        const bool pad0 = (uh % NCH) == 0;
#pragma unroll
        for (int i0 = 0; i0 < 64; i0 += 32) {
            float ar[32];
#pragma unroll
            for (int u = 0; u < 32; ++u) ar[u] = af[(i0 + u) * 64 + lane];
            if (pad0 && i0 == 0) {
#pragma unroll
                for (int u = 0; u < 32; ++u) T[u] = (lane == u) ? 1.f : 0.f;
            } else {
#pragma unroll
                for (int u = 0; u < 32; ++u) { const int i = i0 + u; float pa[4] = {(lane == i) ? 1.f : 0.f, 0.f, 0.f, 0.f};
#pragma unroll
                    for (int j = 0; j < i; ++j) pa[j & 3] -= __int_as_float(__builtin_amdgcn_readlane(__float_as_int(ar[u]), j)) * T[j];
                    T[i] = (pa[0] + pa[1]) + (pa[2] + pa[3]); }
            }
        }
        bf16* tg = TG + (size_t)uh * 4096; bf16* tb = TB + (size_t)uh * 4096;
        const float sg = bc * gmc;
        const int cs = (lane & ~31) + sw23(lane & 31);
#pragma unroll
        for (int i = 0; i < 64; ++i) { tg[i * 64 + cs] = f2bf(T[i] * sg); tb[i * 64 + cs] = f2bf(T[i] * bc); }
    }
}
__device__ __forceinline__ void delta_d3_unit(unsigned char* ws, int uh, int lane) {
    asm volatile("" : "+v"(lane));
    const bf16* TG = (const bf16*)(ws + WS_DTG); const bf16* TB = (const bf16*)(ws + WS_DTB); const bf16* KT = (const bf16*)(ws + WS_DKT); const bf16* VT = (const bf16*)(ws + WS_DVT);
    bf16* WG = (bf16*)(ws + WS_DWG); bf16* UG = (bf16*)(ws + WS_DUG);
    const int m = lane & 31, half = lane >> 5;
    const int c = uh % NCH, bh = uh / NCH, h = bh & 31, b = bh >> 5;
    const size_t uq = ((size_t)(b * 16 + (h >> 1))) * NCH + c;
    {
        const bf16* Tm = TG + (size_t)uh * 4096; const bf16* Kf = KT + uq * 8192;
        f32x16 acc[4][2];
#pragma unroll
        for (int dn = 0; dn < 4; ++dn)
#pragma unroll
            for (int ti = 0; ti < 2; ++ti)
#pragma unroll
                for (int i = 0; i < 16; ++i) acc[dn][ti][i] = 0.f;
#pragma unroll
        for (int ks = 0; ks < 4; ++ks) {
            bf16x8 a[4], bb[2];
#pragma unroll
            for (int dn = 0; dn < 4; ++dn) a[dn] = *(const bf16x8*)(Kf + ((size_t)(((dn * 2 + (ks >> 1)) * 2 + (ks & 1)) * 64 + lane)) * 8);
#pragma unroll
            for (int ti = 0; ti < 2; ++ti) bb[ti] = *(const bf16x8*)(Tm + (32 * ti + m) * 64 + 16 * ks + 8 * half);
#pragma unroll
            for (int dn = 0; dn < 4; ++dn)
#pragma unroll
                for (int ti = 0; ti < 2; ++ti) acc[dn][ti] = MFMA32(a[dn], bb[ti], acc[dn][ti]);
        }
        bf16* wg = WG + (size_t)uh * 8192;
#pragma unroll
        for (int dn = 0; dn < 4; ++dn)
#pragma unroll
            for (int ti = 0; ti < 2; ++ti)
#pragma unroll
                for (int s2 = 0; s2 < 2; ++s2) *(v4u*)(wg + ((size_t)(((ti * 4 + dn) * 2 + s2) * 64 + lane)) * 8) = pack_frag(acc[dn][ti], s2);
    }
    {
        const bf16* Tm = TB + (size_t)uh * 4096; const bf16* Bt = VT + (size_t)uh * 8192;
        f32x16 acc[2][4];
#pragma unroll
        for (int ti = 0; ti < 2; ++ti)
#pragma unroll
            for (int dn = 0; dn < 4; ++dn)
#pragma unroll
                for (int i = 0; i < 16; ++i) acc[ti][dn][i] = 0.f;
#pragma unroll
        for (int ks = 0; ks < 4; ++ks) {
            bf16x8 a[2], bb[4];
#pragma unroll
            for (int ti = 0; ti < 2; ++ti) a[ti] = *(const bf16x8*)(Tm + (32 * ti + m) * 64 + 16 * ks + 8 * half);
#pragma unroll
            for (int dn = 0; dn < 4; ++dn) bb[dn] = *(const bf16x8*)(Bt + (32 * dn + m) * 64 + 16 * ks + 8 * half);
#pragma unroll
            for (int ti = 0; ti < 2; ++ti)
#pragma unroll
                for (int dn = 0; dn < 4; ++dn) acc[ti][dn] = MFMA32(a[ti], bb[dn], acc[ti][dn]);
        }
        bf16* ug = UG + (size_t)uh * 8192;
#pragma unroll
        for (int ti = 0; ti < 2; ++ti)
#pragma unroll
            for (int dn = 0; dn < 4; ++dn) { bf16* p = ug + ((size_t)((ti * 4 + dn) * 64 + lane)) * 16; *(v4u*)p = pack_frag(acc[ti][dn], 0); *(v4u*)(p + 8) = pack_frag(acc[ti][dn], 1); }
    }
}
__device__ __forceinline__ void delta_pre(unsigned char* ws, LAS unsigned char* lds, int gw, int NGW, int wave, int lane) {
    for (int uq = gw; uq < NUQ; uq += NGW) {
#ifndef NO_D1
        delta_d1_unit(ws, lds, uq, wave, lane);
#endif
        asm volatile("s_waitcnt vmcnt(0)" ::: "memory");
        const int c = uq % NCH, bh = uq / NCH, hq = bh & 15, b = bh >> 4;
#pragma unroll 1
        for (int hh = 0; hh < 2; ++hh) { const int uh = (b * 32 + 2 * hq + hh) * NCH + c;
#ifndef NO_D2
            delta_d2_unit(ws, uh, lane);
#endif
            asm volatile("s_waitcnt vmcnt(0)" ::: "memory");
#ifndef NO_D3
            delta_d3_unit(ws, uh, lane);
#endif
        }
    }
}
__device__ __forceinline__ bf16x8 afrag_perm(const bf16* rowp, int blk, int s, int half) {
    const v2u lo = *(const v2u*)(rowp + 32 * blk + 16 * s + 4 * half), hi2 = *(const v2u*)(rowp + 32 * blk + 16 * s + 8 + 4 * half);
    v4u w; w.x = lo.x; w.y = lo.y; w.z = hi2.x; w.w = hi2.y; return __builtin_bit_cast(bf16x8, w);
}
#define LBAR() asm volatile("s_waitcnt lgkmcnt(0)\n\ts_barrier" ::: "memory")
__device__ __forceinline__ void delta_d4(unsigned char* ws, float* out_state, LAS unsigned char* lds, int tid, int wave, int lane) {
    const bf16* QKVC = (const bf16*)(ws + WS_QKVC); const bf16* KT = (const bf16*)(ws + WS_DKT); const bf16* PG = (const bf16*)(ws + WS_DPG);
    const bf16* WG = (const bf16*)(ws + WS_DWG); const bf16* UG = (const bf16*)(ws + WS_DUG); const float* GC = (const float*)(ws + WS_DGC);
    float* OF = (float*)(ws + WS_SC);
    LAS v4u* Sfr = (LAS v4u*)lds;
    LAS v4u* Dfr = (LAS v4u*)(lds + 16384);
    LAS v4u* Dtf = (LAS v4u*)(lds + 16384 + 4096);
    LAS float* gam = (LAS float*)(lds + 16384 + 8192);
    const int m = lane & 31, half = lane >> 5;
    const bf16x8 zf = {0, 0, 0, 0, 0, 0, 0, 0};
    for (int item = blockIdx.x; item < NBP * 32 * 4; item += gridDim.x) {
        const int q = item & 3, bh = item >> 2, h = bh & 31, b = bh >> 5;
        const size_t uh0 = ((size_t)(b * 32 + h)) * NCH, uq0 = ((size_t)(b * 16 + (h >> 1))) * NCH;
        const int rt = wave & 1; const bool isq = wave >= 6;
        f32x16 S;
#pragma unroll
        for (int i = 0; i < 16; ++i) S[i] = 0.f;
        bf16x8 afr[8], afn[8], xfr[4], xfn[4]; float gcn = 0.f;
#pragma unroll
        for (int i = 0; i < 8; ++i) { afr[i] = zf; afn[i] = zf; }
#pragma unroll
        for (int i = 0; i < 4; ++i) { xfr[i] = zf; xfn[i] = zf; }
#define LOAD_NEXT(cc) do { if (wave < 4) { const bf16* kr_ = KT + (uq0 + (cc)) * 8192; \
                _Pragma("unroll") for (int blk = 0; blk < 2; ++blk) _Pragma("unroll") for (int s_ = 0; s_ < 2; ++s_) afn[blk * 2 + s_] = *(const bf16x8*)(kr_ + ((size_t)(((wave * 2 + blk) * 2 + s_) * 64 + lane)) * 8); } \
            else { const int row_ = chunk_row(b, (cc), 32 * rt + m); const bool ok_ = !isq || row_ >= 0; \
                  \
                const bf16* ab_ = isq ? QKVC + (size_t)(row_ < 0 ? 0 : row_) * CDIM + (h >> 1) * 128 + 8 * half : WG + (uh0 + (cc)) * 8192 + ((size_t)(rt * 512 + lane)) * 8; \
                const int sb_ = isq ? 32 : 1024, ss_ = isq ? 16 : 512; \
                _Pragma("unroll") for (int blk = 0; blk < 4; ++blk) _Pragma("unroll") for (int s_ = 0; s_ < 2; ++s_) afn[blk * 2 + s_] = sel8(ok_, *(const bf16x8*)(ab_ + blk * sb_ + s_ * ss_)); \
                const bf16* xb_ = isq ? PG + (uh0 + (cc)) * 4096 + ((size_t)(rt * 256 + lane)) * 8 : UG + (uh0 + (cc)) * 8192 + ((size_t)((rt * 4 + q) * 64 + lane)) * 16; \
                  \
                if (isq) { _Pragma("unroll") for (int blk = 0; blk < 2; ++blk) _Pragma("unroll") for (int s_ = 0; s_ < 2; ++s_) xfn[blk * 2 + s_] = sel8(blk <= rt, *(const bf16x8*)(xb_ + blk * 1024 + s_ * 512)); } \
                else { xfn[0] = *(const bf16x8*)xb_; xfn[1] = *(const bf16x8*)(xb_ + 8); if (wave == 4) gcn = GC[(uh0 + (cc)) * 64 + lane]; } } } while (0)
#define ROTATE() do { _Pragma("unroll") for (int i_ = 0; i_ < 8; ++i_) afr[i_] = afn[i_]; _Pragma("unroll") for (int i_ = 0; i_ < 4; ++i_) xfr[i_] = xfn[i_]; } while (0)
        LBAR();
        if (wave < 4) { const v4u z = {0u, 0u, 0u, 0u}; Sfr[(0 * 4 + wave) * 128 + lane] = z; Sfr[(0 * 4 + wave) * 128 + 64 + lane] = z; }
        if (wave == 4) { const float gc = GC[(uh0 + 0) * 64 + lane], gl = __shfl(gc, 63); gam[lane] = __expf(gc); gam[128 + lane] = __expf(gl - gc); }
        LOAD_NEXT(0); ROTATE();
        for (int c = 0; c < NCH; ++c) {
            const int bufc = c & 1;
            const size_t uh = uh0 + c, uq = uq0 + c;
            LBAR();
            f32x16 acc;
            if (c + 1 < NCH) LOAD_NEXT(c + 1);
            if (wave >= 4) {
#pragma unroll
                for (int i = 0; i < 16; ++i) acc[i] = 0.f;
#pragma unroll
                for (int blk = 0; blk < 4; ++blk)
#pragma unroll
                    for (int s = 0; s < 2; ++s) acc = MFMA32(afr[blk * 2 + s], __builtin_bit_cast(bf16x8, Sfr[(bufc * 4 + blk) * 128 + s * 64 + lane]), acc);
                if (!isq) {
                    float uf[16]; { float t8[8]; unpack8(__builtin_bit_cast(v4u, xfr[0]), t8);
#pragma unroll
                        for (int i = 0; i < 8; ++i) uf[i] = t8[i]; unpack8(__builtin_bit_cast(v4u, xfr[1]), t8);
#pragma unroll
                        for (int i = 0; i < 8; ++i) uf[8 + i] = t8[i]; }
                    f32x16 dt;
#pragma unroll
                    for (int r = 0; r < 16; ++r) { acc[r] = uf[r] - acc[r]; dt[r] = acc[r] * gam[128 + bufc * 64 + 32 * rt + crow32(r, half)]; }
#pragma unroll
                    for (int s = 0; s < 2; ++s) { Dfr[(rt * 2 + s) * 64 + lane] = pack_frag(acc, s); Dtf[(rt * 2 + s) * 64 + lane] = pack_frag(dt, s); }
                }
            }
            LBAR();
            if (wave < 4) {
                const float gl = gam[bufc * 64 + 63];
#pragma unroll
                for (int i = 0; i < 16; ++i) S[i] *= gl;
#pragma unroll
                for (int blk = 0; blk < 2; ++blk)
#pragma unroll
                    for (int s = 0; s < 2; ++s) S = MFMA32(afr[blk * 2 + s], __builtin_bit_cast(bf16x8, Dtf[(blk * 2 + s) * 64 + lane]), S);
#pragma unroll
                for (int s = 0; s < 2; ++s) Sfr[((bufc ^ 1) * 4 + wave) * 128 + s * 64 + lane] = pack_frag(S, s);
            } else if (isq) {
#pragma unroll
                for (int r = 0; r < 16; ++r) acc[r] *= gam[bufc * 64 + 32 * rt + crow32(r, half)];
#pragma unroll
                for (int blk = 0; blk < 2; ++blk)
#pragma unroll
                    for (int s = 0; s < 2; ++s) acc = MFMA32(xfr[blk * 2 + s], __builtin_bit_cast(bf16x8, Dfr[(blk * 2 + s) * 64 + lane]), acc);
#pragma unroll
                for (int r = 0; r < 16; ++r) { const int row = chunk_row(b, c, 32 * rt + crow32(r, half)); if (row >= 0) OF[(size_t)row * DVW + h * 128 + 32 * q + m] = acc[r]; }
            } else if (wave == 4 && c + 1 < NCH) {
                const float gl = __shfl(gcn, 63); gam[(bufc ^ 1) * 64 + lane] = __expf(gcn); gam[128 + (bufc ^ 1) * 64 + lane] = __expf(gl - gcn);
            }
            ROTATE();
        }
        if (wave < 4) { float* o = out_state + ((size_t)((b * 32 + h) * 128 + 32 * wave)) * 128 + 32 * q + m;
#pragma unroll
            for (int r = 0; r < 16; ++r) o[(size_t)sw23(crow32(r, half)) * 128] = S[r]; }
#undef LOAD_NEXT
#undef ROTATE
    }
    LBAR();
}
#undef LBAR
#undef MFMA32
template <int RT, int CT, class Epi>
__device__ __forceinline__ void small_gemm_unit(const bf16* A, int lda, const bf16* Bt, int ldb, int k0, int klen, LAS unsigned char* lds, const Epi& E, int tid, int wave, int lane) {
    const int r16 = lane & 15, q = lane >> 4;
    const int kw = klen >> 3;
    const bf16* ap = A + (size_t)r16 * lda + k0 + wave * kw + 8 * q;
    const bf16* bp = Bt + (size_t)r16 * ldb + k0 + wave * kw + 8 * q;
    pg8::f32x4 acc[RT][CT];
#pragma unroll
    for (int i = 0; i < RT; ++i)
#pragma unroll
        for (int j = 0; j < CT; ++j) acc[i][j] = (pg8::f32x4){0.f, 0.f, 0.f, 0.f};
#pragma unroll 4
    for (int ks = 0; ks < kw; ks += 32) {
        bf16x8 a[RT], b[CT];
#pragma unroll
        for (int i = 0; i < RT; ++i) a[i] = *(const bf16x8*)(ap + (size_t)(16 * i) * lda + ks);
#pragma unroll
        for (int j = 0; j < CT; ++j) b[j] = *(const bf16x8*)(bp + (size_t)(16 * j) * ldb + ks);
#pragma unroll
        for (int i = 0; i < RT; ++i)
#pragma unroll
            for (int j = 0; j < CT; ++j) acc[i][j] = __builtin_amdgcn_mfma_f32_16x16x32_bf16(a[i], b[j], acc[i][j], 0, 0, 0);
    }
    constexpr int NOUT = 256 * RT * CT;
    LAS float* part = (LAS float*)lds + wave * NOUT;
#pragma unroll
    for (int i = 0; i < RT; ++i)
#pragma unroll
        for (int j = 0; j < CT; ++j)
#pragma unroll
            for (int e = 0; e < 4; ++e) part[(16 * i + 4 * q + e) * (16 * CT) + 16 * j + r16] = acc[i][j][e];
    __syncthreads();
    for (int o = tid; o < NOUT; o += NTHREADS) { float sum = 0.f;
#pragma unroll
        for (int w = 0; w < 8; ++w) sum += ((LAS float*)lds)[w * NOUT + o];
        E(o / (16 * CT), o % (16 * CT), sum); }
    __syncthreads();
}
template <int ACT> struct SEpiRowsBf16 { bf16* O; int ldc; __device__ __forceinline__ void operator()(int row, int col, float v) const { if (ACT == 2) { v = v > 0.f ? v : 0.f; v = v * v; } O[(size_t)row * ldc + col] = f2bf(v); } };
struct SEpiF32 { float* O; int ldc; __device__ __forceinline__ void operator()(int row, int col, float v) const { O[(size_t)row * ldc + col] = v; } };
struct SEpiColsBf16 { bf16* O; int ldc; __device__ __forceinline__ void operator()(int row, int col, float v) const { O[(size_t)col * ldc + row] = f2bf(v); } };
template <int ACT> __device__ __forceinline__ void skinny_rows_bf16(const bf16* A, const bf16* Wt, int K, int nunits, bf16* O, int ldc, LAS unsigned char* lds, int tid, int wave, int lane) {
    for (int u = blockIdx.x; u < nunits; u += gridDim.x) { SEpiRowsBf16<ACT> E{O + (size_t)XROW0 * ldc + u * 64, ldc};
        small_gemm_unit<3, 4>(A + (size_t)XROW0 * K, K, Wt + (size_t)u * 64 * K, K, 0, K, lds, E, tid, wave, lane); }
}
__device__ __forceinline__ void skinny_rows_part(const bf16* A, const bf16* Wt, int K, float* ZP, LAS unsigned char* lds, int tid, int wave, int lane) {
    for (int u = blockIdx.x; u < 256; u += gridDim.x) { const int cgp = u & 31, ksl = u >> 5; SEpiF32 E{ZP + (size_t)ksl * XR * DM + cgp * 64, DM};
        small_gemm_unit<3, 4>(A + (size_t)XROW0 * K, K, Wt + (size_t)cgp * 64 * K, K, ksl * (K >> 3), K >> 3, lds, E, tid, wave, lane); }
}
template <int RT> __device__ __forceinline__ void tail_cols_bf16(const bf16* A, const bf16* Wt, int K, int c0, bf16* O, int ldc, LAS unsigned char* lds, int tid, int wave, int lane) {
    for (int u = blockIdx.x; u < MAINM / 32; u += gridDim.x) { SEpiColsBf16 E{O + (size_t)u * 32 * ldc + c0, ldc};
        small_gemm_unit<RT, 2>(Wt + (size_t)c0 * K, K, A + (size_t)u * 32 * K, K, 0, K, lds, E, tid, wave, lane); }
}

typedef __attribute__((address_space(4))) const unsigned long long* kargq_t;
#define KPF_(k) ((const float*)(const GAS float*)(q_[k]))
__device__ __forceinline__ void load_ptrs(Ptrs& P) {
    kargq_t q_ = (kargq_t)__builtin_amdgcn_kernarg_segment_ptr();
    asm volatile("" : "+s"(q_));
    P.x_prompt = KPF_(0); P.x_sample = KPF_(1); P.state_conv_a = KPF_(2); P.cache_k = KPF_(3);
    P.cache_v = KPF_(4); P.cache_ik = KPF_(5); P.state_conv_c = KPF_(6); P.state_delta = KPF_(7);
    P.page_table = ((const int*)(const GAS int*)(q_[8])); P.meta = KPF_(9); P.w_in_a = KPF_(10); P.conv_w_a = KPF_(11);
    P.w_out_a = KPF_(12); P.w_in_b = KPF_(13); P.w_out_b = KPF_(14); P.w_in_c = KPF_(15);
    P.conv_w_c = KPF_(16); P.a_log = KPF_(17); P.dt_bias = KPF_(18); P.norm_w = KPF_(19);
    P.w_out_c = KPF_(20); P.ln1_g = KPF_(21); P.ln1_b = KPF_(22); P.w1 = KPF_(23);
    P.w2 = KPF_(24); P.ln2_g = KPF_(25); P.ln2_b = KPF_(26);
    P.out = (float*)(GAS float*)(q_[27]); P.ws = (unsigned char*)(GAS unsigned char*)(q_[28]);
}
struct Args { const void* in[27]; float* out; unsigned char* ws; int ph_lo, ph_hi; };
constexpr int PH_PER_LAYER = 12, PH_END = 1 + 4 * PH_PER_LAYER;

__global__ void __launch_bounds__(NTHREADS, 2) mega_fwd(Args args) {
    extern __shared__ __attribute__((aligned(16))) unsigned char lds_raw[];
    LAS unsigned char* lds = (LAS unsigned char*)lds_raw;
    const int tid = threadIdx.x, lane = tid & 63, wave = __builtin_amdgcn_readfirstlane(tid >> 6);
    const int G_ = gridDim.x, NGW = G_ * NWAVES, NT = G_ * NTHREADS; (void)lane;
    unsigned char* ws = args.ws;
    const int lo = args.ph_lo, hi = args.ph_hi;
    const bool fused = (hi - lo) > 1;

    for (int u = tid; u < (LDS_BYTES - LDSCTL_OFF) / 4; u += NTHREADS) ((LAS unsigned*)(lds + LDSCTL_OFF))[u] = 0u;
    __syncthreads();
    volatile LAS unsigned* MISC = (volatile LAS unsigned*)(lds + MISC_OFF);
    XcdBarrier bar; bar.bar = (unsigned*)(ws + WS_CTL) + CW_BAR; bar.x = 0; bar.st = nullptr;
    if (fused) bar = xcd_barrier_post((unsigned*)(ws + WS_CTL) + CW_BAR, MISC + 8);
    bar.wv = wave;

#ifndef MK_SITES
#define MK_SITES 0xffffffffu
#endif
#define SITE(n) (((MK_SITES) >> (n)) & 1u)
#define IN(k) (lo <= (k) && (k) < hi)
#ifndef MK_DUP
#define MK_DUP 0u
#endif
#define NREP(n) ((((MK_DUP) >> (n)) & 1u) ? 2 : 1)
#define BEGIN_SITE(n, id) if (SITE(n) && IN(id)) { for (int rp_ = 0; rp_ < NREP(n); ++rp_) { Ptrs P; load_ptrs(P); unsigned char* ws = P.ws; (void)ws; \
    bf16* X = (bf16*)(P.ws + WS_X); float* Z = (float*)(P.ws + WS_Z); float* ZP = (float*)(P.ws + WS_ZP); bf16* Y = (bf16*)(P.ws + WS_Y); bf16* BIG = (bf16*)(P.ws + WS_BIG); (void)X; (void)Z; (void)ZP; (void)Y; (void)BIG;
#define END_SITE(id) SEAM(id); } }
#define LOCALS int tid_ = threadIdx.x; asm volatile("" : "+v"(tid_)); const int lane_ = tid_ & 63, wave_ = __builtin_amdgcn_readfirstlane(tid_ >> 6), gw_ = blockIdx.x * NWAVES + wave_, gtid_ = blockIdx.x * NTHREADS + tid_; (void)lane_; (void)wave_; (void)gw_; (void)gtid_
#define SEAM(k) do { if (fused && (k) + 1 < PH_END) xcd_barrier(bar); else __syncthreads(); } while (0)


    BEGIN_SITE(0, 0) LOCALS; p0_prologue(P, lds, gw_, NGW, wave_, lane_); END_SITE(0)
#ifdef MK_XBAR
    if (fused) { for (int xb_ = 0; xb_ < MK_XBAR; ++xb_) xcd_barrier(bar); }
#endif

    for (int layer = 0; layer < 4; ++layer) {
        const int kind = layer % 3, j = layer / 3, base = 1 + layer * PH_PER_LAYER;
        if (kind == 0) {
            BEGIN_SITE(1, base + 0)
                const bf16* Wt = (const bf16*)(ws + WS_WA_IN + (size_t)j * WSZ_A_IN); pg8::Gemm g{X, Wt, MAINM, NA_IN, DM}; pg8::StaticOrder S; S.init(MAINM, NA_IN, G_, (int)blockIdx.x);
                pg8::EpiBf16<0> E{BIG, NA_IN, nullptr, 0, 0, 1.f};
                pg8::gemm_phase<pg8::EpiBf16<0>, pg8::StaticOrder, true, true>(lds, g, S, E, wave);
                { LOCALS; skinny_rows_bf16<0>(X, Wt, DM, NA_IN / 64, BIG, NA_IN, lds, tid_, wave_, lane_); }
                END_SITE(base + 0)
            BEGIN_SITE(2, base + 1)
                LOCALS; convA_phase(BIG, Y, P.conv_w_a + (size_t)j * 3 * DM, P.state_conv_a + (size_t)j * SBN * 2 * DM, P.out + O_CAP + (size_t)j * NBP * 2 * DM, P.out + O_CAS + (size_t)j * SBN * 2 * DM, gtid_, NT);
                END_SITE(base + 1)
            BEGIN_SITE(3, base + 2)
                const bf16* Wt = (const bf16*)(ws + WS_WA_OUT + (size_t)j * WSZ_A_OUT); pg8::Gemm g{Y, Wt, MAINM, DM, DM}; pg8::StaticOrder S; S.init(MAINM, DM, G_, (int)blockIdx.x);
                pg8::EpiF32 E{Z, DM};
                pg8::gemm_phase<pg8::EpiF32, pg8::StaticOrder, true, true>(lds, g, S, E, wave);
                { LOCALS; skinny_rows_part(Y, Wt, DM, ZP, lds, tid_, wave_, lane_); }
                END_SITE(base + 2)
        } else if (kind == 1) {
            BEGIN_SITE(4, base + 0)
                const bf16* Wt = (const bf16*)(ws + WS_WB_IN); pg8::Gemm g{X, Wt, MAINM, 4096, DM}; pg8::StaticOrder S; S.init(MAINM, 4096, G_, (int)blockIdx.x);
                pg8::EpiBf16<0> E{BIG, NB_PAD, nullptr, 0, 0, 1.f};
                pg8::gemm_phase<pg8::EpiBf16<0>, pg8::StaticOrder, true, true>(lds, g, S, E, wave);
                { LOCALS; tail_cols_bf16<5>(X, Wt, DM, 4096, BIG, NB_PAD, lds, tid_, wave_, lane_); skinny_rows_bf16<0>(X, Wt, DM, 4224 / 64, BIG, NB_PAD, lds, tid_, wave_, lane_); }
                END_SITE(base + 0)
            BEGIN_SITE(5, base + 1) LOCALS; rope_phase(BIG, P, gw_, NGW, lane_); END_SITE(base + 1)
            BEGIN_SITE(6, base + 2) LOCALS; indexer_sample(P, lds, tid_); indexer_prompt(P, lds, tid_, wave_, lane_); END_SITE(base + 2)
            BEGIN_SITE(7, base + 3) LOCALS; select_phase(P, lds, gw_, NGW, tid_, wave_, lane_); END_SITE(base + 3)
            BEGIN_SITE(8, base + 4) LOCALS; dense_attn_phase(P, Y, (char*)lds_raw, wave_); attn_phase(P, Y, lds, gw_, NGW, wave_, lane_); END_SITE(base + 4)
            BEGIN_SITE(9, base + 5)
                const bf16* Wt = (const bf16*)(ws + WS_WB_OUT); pg8::Gemm g{Y, Wt, MAINM, DM, DM}; pg8::StaticOrder S; S.init(MAINM, DM, G_, (int)blockIdx.x);
                pg8::EpiF32 E{Z, DM};
                pg8::gemm_phase<pg8::EpiF32, pg8::StaticOrder, true, true>(lds, g, S, E, wave);
                { LOCALS; skinny_rows_part(Y, Wt, DM, ZP, lds, tid_, wave_, lane_); }
                END_SITE(base + 5)
        } else {
            BEGIN_SITE(10, base + 0)
                const bf16* Wt = (const bf16*)(ws + WS_WC_IN); pg8::Gemm g{X, Wt, MAINM, 12288, DM}; pg8::StaticOrder S; S.init(MAINM, 12288, G_, (int)blockIdx.x);
                pg8::EpiBf16<0> E{BIG, NC_PAD, nullptr, 0, 0, 1.f};
                pg8::gemm_phase<pg8::EpiBf16<0>, pg8::StaticOrder, true, true>(lds, g, S, E, wave);
                { LOCALS; tail_cols_bf16<4>(X, Wt, DM, 12288, BIG, NC_PAD, lds, tid_, wave_, lane_); skinny_rows_bf16<0>(X, Wt, DM, NC_IN / 64, BIG, NC_PAD, lds, tid_, wave_, lane_); }
                END_SITE(base + 0)
            BEGIN_SITE(11, base + 1) LOCALS; convC_phase(BIG, P, gw_, NGW, lane_); END_SITE(base + 1)
            BEGIN_SITE(19, base + 2) LOCALS; delta_pre(P.ws, lds, gw_, NGW, wave_, lane_); delta_phase(P, wave_, lane_); END_SITE(base + 2)
            BEGIN_SITE(22, base + 5) LOCALS; delta_d4(P.ws, P.out + O_DP, lds, tid_, wave_, lane_); END_SITE(base + 5)
            BEGIN_SITE(13, base + 6) LOCALS; normC_phase(BIG, Y, P, gw_, NGW, lane_); END_SITE(base + 6)
            BEGIN_SITE(14, base + 7)
                const bf16* Wt = (const bf16*)(ws + WS_WC_OUT); pg8::Gemm g{Y, Wt, MAINM, DM, DVW}; pg8::StaticOrder S; S.init(MAINM, DM, G_, (int)blockIdx.x);
                pg8::EpiF32 E{Z, DM};
                pg8::gemm_phase<pg8::EpiF32, pg8::StaticOrder, true, true>(lds, g, S, E, wave);
                { LOCALS; skinny_rows_part(Y, Wt, DVW, ZP, lds, tid_, wave_, lane_); }
                END_SITE(base + 7)
        }
        BEGIN_SITE(15, base + 8) LOCALS; ln_phase(Z, ZP, X, rp_ == 0 ? X : (bf16*)(P.ws + WS_QR), P.ln1_g + (size_t)layer * DM, P.ln1_b + (size_t)layer * DM, nullptr, nullptr, gw_, NGW, lane_); END_SITE(base + 8)
        BEGIN_SITE(16, base + 9)
            const bf16* Wt = (const bf16*)(ws + WS_W1 + (size_t)layer * WSZ_W1); pg8::Gemm g{X, Wt, MAINM, FF, DM}; pg8::StaticOrder S; S.init(MAINM, FF, G_, (int)blockIdx.x);
            pg8::EpiBf16<2> E{BIG, FF, nullptr, 0, 0, 1.f};
            pg8::gemm_phase<pg8::EpiBf16<2>, pg8::StaticOrder, true, true>(lds, g, S, E, wave);
            { LOCALS; skinny_rows_bf16<2>(X, Wt, DM, FF / 64, BIG, FF, lds, tid_, wave_, lane_); }
            END_SITE(base + 9)
        BEGIN_SITE(17, base + 10)
            const bf16* Wt = (const bf16*)(ws + WS_W2 + (size_t)layer * WSZ_W2); pg8::Gemm g{BIG, Wt, MAINM, DM, FF}; pg8::StaticOrder S; S.init(MAINM, DM, G_, (int)blockIdx.x);
            pg8::EpiF32 E{Z, DM};
            pg8::gemm_phase<pg8::EpiF32, pg8::StaticOrder, true, true>(lds, g, S, E, wave);
            { LOCALS; skinny_rows_part(BIG, Wt, FF, ZP, lds, tid_, wave_, lane_); }
            END_SITE(base + 10)
        BEGIN_SITE(18, base + 11)
            const bool last = layer == 3;
            LOCALS; ln_phase(Z, ZP, X, rp_ == 0 ? X : (bf16*)(P.ws + WS_QR), P.ln2_g + (size_t)layer * DM, P.ln2_b + (size_t)layer * DM, last ? P.out + O_YP : nullptr, last ? P.out + O_YS : nullptr, gw_, NGW, lane_);
            if (!last) SEAM(base + 11); } }
    }
#undef IN
#undef SEAM
}

#ifndef MK_SPLIT
#define MK_SPLIT 0
#endif
extern "C" void kernel_launch(void* const* d_in, const int* in_sizes, int n_in, void* d_out, int out_size, void* d_ws, size_t ws_size, hipStream_t stream) {
    static int grid = 0;
    if (grid == 0) {
        if (n_in != 27 || (size_t)out_size != O_END || ws_size < WS_END) { fprintf(stderr, "kernel_launch: unexpected shapes: n_in %d out %d (want %zu) ws %zu (want >= %zu)\n", n_in, out_size, (size_t)O_END, ws_size, (size_t)WS_END); grid = -1; return; }
        int dev = 0, cus = 0;
        if (hipGetDevice(&dev) != hipSuccess || hipDeviceGetAttribute(&cus, hipDeviceAttributeMultiprocessorCount, dev) != hipSuccess) { grid = -1; return; }
        if (hipFuncSetAttribute((const void*)mega_fwd, hipFuncAttributeMaxDynamicSharedMemorySize, LDS_BYTES) != hipSuccess) { fprintf(stderr, "kernel_launch: hipFuncSetAttribute failed\n"); grid = -1; return; }
        int per_cu = 0;
        if (hipOccupancyMaxActiveBlocksPerMultiprocessor(&per_cu, (const void*)mega_fwd, NTHREADS, LDS_BYTES) != hipSuccess || per_cu < 1) fprintf(stderr, "kernel_launch: occupancy query reports %d\n", per_cu);
        (void)hipGetLastError();
        grid = cus;
    }
    if (grid < 0) return;
    (void)hipMemsetAsync((char*)d_ws + WS_CTL, 0, CTL_ZERO_BYTES, stream);
    Args a{};
    for (int i = 0; i < 27; ++i) a.in[i] = d_in[i];
    a.out = (float*)d_out; a.ws = (unsigned char*)d_ws;
#if MK_SPLIT
    for (int ph = 0; ph < PH_END; ++ph) {
        bool exists = (ph == 0);
        if (ph > 0) { const int layer = (ph - 1) / PH_PER_LAYER, l = (ph - 1) % PH_PER_LAYER, kind = layer % 3; const int nmix = kind == 0 ? 3 : (kind == 1 ? 6 : 8); exists = (l < nmix) || (l >= 8 && l <= 11); }
        if (!exists) continue;
        a.ph_lo = ph; a.ph_hi = ph + 1;
        hipLaunchKernelGGL(mega_fwd, dim3(grid), dim3(NTHREADS), LDS_BYTES, stream, a);
    }
#else
    a.ph_lo = 0; a.ph_hi = PH_END;
    hipLaunchKernelGGL(mega_fwd, dim3(grid), dim3(NTHREADS), LDS_BYTES, stream, a);
#endif
    const hipError_t le = hipPeekAtLastError();
    if (le != hipSuccess) fprintf(stderr, "kernel_launch: launch failed: %s\n", hipGetErrorName(le));
}
```

```cpp
#include <hip/hip_runtime.h>
#include <cstdio>
#include <cstdint>
#include <cmath>
__device__ __forceinline__ int flane() { return (int)__builtin_amdgcn_mbcnt_hi(~0u, __builtin_amdgcn_mbcnt_lo(~0u, 0u)); }
namespace pg8 {
#define PG8_LAS __attribute__((address_space(3)))
typedef unsigned short bf16_t;
typedef short bf16x8 __attribute__((ext_vector_type(8)));
typedef float f32x4 __attribute__((ext_vector_type(4)));
typedef unsigned u32x4 __attribute__((ext_vector_type(4)));
constexpr int BM = 256, BK = 64, HALF = 128, HTB = HALF * BK * 2  , STAGE_BYTES = 8 * HTB, NXCD = 8, WGM = 8;

__host__ __device__ __forceinline__ int lds_byte(int r, int c) { const int st = (r >> 4) * 2 + (c >> 5), rr = r & 15, cc = c & 31, ob = rr * 64 + cc * 2; return st * 1024 + (ob ^ (((ob >> 9) & 1) << 5)); }
__host__ __device__ __forceinline__ void stage_rc(int b, int& R, int& C) { const int st = b / 1024, sb = b % 1024, swz = sb ^ (((sb >> 9) & 1) << 5); R = (st >> 1) * 16 + swz / 64; C = (st & 1) * 32 + (swz % 64) / 2; }
__host__ __device__ __forceinline__ int perm32(int rho) { const int n = rho >> 4, i = rho & 15; return 8 * (i >> 2) + 4 * n + (i & 3); }

struct Unit { int pm, pn; };
struct Gemm { const bf16_t* A; const bf16_t* Bt; int M, N, K; };

struct StaticOrder {
    int nM, nN, nwg, G, c;
    __host__ __device__ void init(int M, int N, int G_, int c_) { nM = M / BM; nN = N / BM; nwg = nM * nN; G = G_; c = c_; }
    __host__ __device__ bool next(int i, Unit& u) const {
        const long L = (long)i * G + c; if (L >= nwg) return false;
        int wgid = (int)L; { const int q = nwg / NXCD, r = nwg % NXCD, xcd = wgid % NXCD, off = wgid / NXCD; wgid = (xcd < r ? xcd * (q + 1) : r * (q + 1) + (xcd - r) * q) + off; }
        const int nig = WGM * nN, gid = wgid / nig, fm = gid * WGM, gsz = (nM - fm) < WGM ? (nM - fm) : WGM;
        u.pm = fm + ((wgid % nig) % gsz); u.pn = (wgid % nig) / gsz; return true;
    }
    __device__ __forceinline__ void a_ready(const Unit&) const {}
    __device__ __forceinline__ void done(const Unit&) const {}
};

__device__ __forceinline__ unsigned cvt_pk_bf16(float lo, float hi) { unsigned r; asm volatile("v_cvt_pk_bf16_f32 %0, %1, %2" : "=v"(r) : "v"(lo), "v"(hi)); return r; }
typedef float f32x2 __attribute__((ext_vector_type(2)));
__device__ __forceinline__ f32x2 gelu_pk(f32x2 v) {
    const f32x2 av = __builtin_elementwise_abs(v), d = av * 0.2316418882f + 1.0f;
    f32x2 t; t.x = __builtin_amdgcn_rcpf(d.x); t.y = __builtin_amdgcn_rcpf(d.y);
    f32x2 q = t * 0.5307027145f + (-0.7265760135f); q = q * t + 0.7107068705f; q = q * t + (-0.142248368f); q = q * t + 0.127414796f; q = q * t;
    const f32x2 s = (v * v) * (-0.72134752044f);
    f32x2 e; e.x = __builtin_amdgcn_exp2f(s.x); e.y = __builtin_amdgcn_exp2f(s.y);
    const f32x2 m = v * (q * e), r = v - m;
    f32x2 o; o.x = v.x < 0.f ? m.x : r.x; o.y = v.y < 0.f ? m.y : r.y; return o;
}

template <int ACT  > struct EpiBf16 {
    static constexpr bool PERM = true, AFTER_DRAIN = false; static_assert(ACT == 0 || ACT == 1 || ACT == 2, "EpiBf16: ACT is 0 (none), 1 (gelu_pk) or 2 (relu^2)");
    bf16_t* O; int ldc; const float* bias; int split_cols; size_t split_stride; float scale0;
    __device__ __forceinline__ void operator()(const f32x4 (&acc)[2][2][4][2], const Unit& u, int wr, int wc, int fr, int fq) const {
        const int row0 = u.pm * BM + wr * 64 + fr; int colt = u.pn * BM; bf16_t* base = O;
        float sc = 1.f; if (split_cols) { const int t = colt / split_cols; base += (size_t)t * split_stride; colt -= t * split_cols; if (t == 0) sc = scale0; }
        const int col0 = colt + wc * 32 + 8 * fq, bcol0 = u.pn * BM + wc * 32 + 8 * fq;
        f32x4 bv[2][2];
#pragma unroll
        for (int bj = 0; bj < 2; ++bj)
#pragma unroll
            for (int n = 0; n < 2; ++n) bv[bj][n] = bias ? *(const f32x4*)(bias + bcol0 + bj * HALF + 4 * n) : (f32x4){0.f, 0.f, 0.f, 0.f};
#pragma unroll
        for (int ai = 0; ai < 2; ++ai)
#pragma unroll
            for (int m = 0; m < 4; ++m) { bf16_t* rowp = base + (size_t)(row0 + ai * HALF + m * 16) * ldc + col0;
#pragma unroll
                for (int bj = 0; bj < 2; ++bj) { f32x4 v0 = acc[ai][bj][m][0] + bv[bj][0], v1 = acc[ai][bj][m][1] + bv[bj][1];
                    if (ACT == 1) { f32x2 a = gelu_pk((f32x2){v0[0], v0[1]}), b = gelu_pk((f32x2){v0[2], v0[3]}), c = gelu_pk((f32x2){v1[0], v1[1]}), d = gelu_pk((f32x2){v1[2], v1[3]});
                        v0 = (f32x4){a.x, a.y, b.x, b.y}; v1 = (f32x4){c.x, c.y, d.x, d.y}; }
                    if (ACT == 2) { _Pragma("unroll") for (int q_ = 0; q_ < 4; ++q_) { const float a_ = v0[q_] > 0.f ? v0[q_] : 0.f, b_ = v1[q_] > 0.f ? v1[q_] : 0.f; v0[q_] = a_ * a_; v1[q_] = b_ * b_; } }
                    v0 = v0 * sc; v1 = v1 * sc; u32x4 w; w.x = cvt_pk_bf16(v0[0], v0[1]); w.y = cvt_pk_bf16(v0[2], v0[3]); w.z = cvt_pk_bf16(v1[0], v1[1]); w.w = cvt_pk_bf16(v1[2], v1[3]);
                    *(u32x4*)(rowp + bj * HALF) = w; } }
    }
};


struct EpiResBf16 {
    static constexpr bool PERM = true, AFTER_DRAIN = false;
    bf16_t* X; int ldc; float alpha;
    __device__ __forceinline__ void operator()(const f32x4 (&acc)[2][2][4][2], const Unit& u, int wr, int wc, int fr, int fq) const {
        const int row0 = u.pm * BM + wr * 64 + fr, col0 = u.pn * BM + wc * 32 + 8 * fq;
#pragma unroll
        for (int ai = 0; ai < 2; ++ai) {
            u32x4 xin[4][2];
#pragma unroll
            for (int m = 0; m < 4; ++m)
#pragma unroll
                for (int bj = 0; bj < 2; ++bj) xin[m][bj] = *(const u32x4*)(X + (size_t)(row0 + ai * HALF + m * 16) * ldc + col0 + bj * HALF);
#pragma unroll
            for (int m = 0; m < 4; ++m) { bf16_t* rowp = X + (size_t)(row0 + ai * HALF + m * 16) * ldc + col0;
#pragma unroll
                for (int bj = 0; bj < 2; ++bj) { const u32x4 xi = xin[m][bj]; const f32x4 a0 = acc[ai][bj][m][0], a1 = acc[ai][bj][m][1];
                    float x[8] = {__uint_as_float(xi.x << 16), __uint_as_float(xi.x & 0xffff0000u), __uint_as_float(xi.y << 16), __uint_as_float(xi.y & 0xffff0000u),
                                  __uint_as_float(xi.z << 16), __uint_as_float(xi.z & 0xffff0000u), __uint_as_float(xi.w << 16), __uint_as_float(xi.w & 0xffff0000u)};
                    u32x4 w; w.x = cvt_pk_bf16(alpha * x[0] + a0[0], alpha * x[1] + a0[1]); w.y = cvt_pk_bf16(alpha * x[2] + a0[2], alpha * x[3] + a0[3]);
                    w.z = cvt_pk_bf16(alpha * x[4] + a1[0], alpha * x[5] + a1[1]); w.w = cvt_pk_bf16(alpha * x[6] + a1[2], alpha * x[7] + a1[3]);
                    *(u32x4*)(rowp + bj * HALF) = w; } }
        }
    }
};

struct EpiF32 {
    static constexpr bool PERM = false, AFTER_DRAIN = false;
    float* C; int ldc;
    __device__ __forceinline__ void operator()(const f32x4 (&acc)[2][2][4][2], const Unit& u, int wr, int wc, int fr, int fq) const {
        const int row0 = u.pm * BM + wr * 64 + fr, col0 = u.pn * BM + wc * 32 + 4 * fq;
#pragma unroll
        for (int ai = 0; ai < 2; ++ai)
#pragma unroll
            for (int m = 0; m < 4; ++m) { float* rowp = C + (size_t)(row0 + ai * HALF + m * 16) * ldc + col0;
#pragma unroll
                for (int bj = 0; bj < 2; ++bj)
#pragma unroll
                    for (int n = 0; n < 2; ++n) *(f32x4*)(rowp + bj * HALF + n * 16) = acc[ai][bj][m][n]; }
    }
};
struct PanelStats {
    unsigned* xbuf;
    unsigned* cnt;
    unsigned* tmo;
    int ntn; float eps;
    unsigned code;
    __device__ __forceinline__ bool run(const f32x4 (&v)[2][2][4][2], const Unit& u, int wr, int wc, int fr, int fq, PG8_LAS unsigned char* lds, int wid, int lane) const {
        typedef float f32x2v __attribute__((ext_vector_type(2)));
        PG8_LAS f32x2v* P = (PG8_LAS f32x2v*)lds;
        PG8_LAS f32x2v* S = (PG8_LAS f32x2v*)(lds + 8192);
        PG8_LAS unsigned* flag = (PG8_LAS unsigned*)(lds + 8192 + 2048);
#pragma unroll
        for (int ai = 0; ai < 2; ++ai)
#pragma unroll
            for (int m = 0; m < 4; ++m) {
                float s = 0.f;
#pragma unroll
                for (int bj = 0; bj < 2; ++bj)
#pragma unroll
                    for (int n = 0; n < 2; ++n) { const f32x4 x = v[ai][bj][m][n]; s += (x[0] + x[1]) + (x[2] + x[3]); }
                s += __shfl_xor(s, 16); s += __shfl_xor(s, 32);
                const float mw = s * (1.0f / 64.0f); float q = 0.f;
#pragma unroll
                for (int bj = 0; bj < 2; ++bj)
#pragma unroll
                    for (int n = 0; n < 2; ++n) { const f32x4 d = v[ai][bj][m][n] - mw; q += (d[0] * d[0] + d[1] * d[1]) + (d[2] * d[2] + d[3] * d[3]); }
                q += __shfl_xor(q, 16); q += __shfl_xor(q, 32);
                if (fq == 0) P[(ai * HALF + wr * 64 + m * 16 + fr) * 4 + wc] = (f32x2v){mw, q};
            }
        asm volatile("s_waitcnt lgkmcnt(0)" ::: "memory"); __builtin_amdgcn_s_barrier(); asm volatile("" ::: "memory");
#if defined(BROKEN_EXCHANGE_NO_WAIT)
#warning BROKEN CONTROL BUILD: the row-statistics exchange does not wait; results are wrong by design
        if (blockIdx.x >= 64) { const long long t0_ = clock64(); while (clock64() - t0_ < 60000) __builtin_amdgcn_s_sleep(8); }
#endif
        const int row = wid * 32 + (lane & 31);
        if (lane < 32) {
            const f32x2v a = P[row * 4 + 0], b = P[row * 4 + 1], c = P[row * 4 + 2], d = P[row * 4 + 3];
            const float mt = (a.x + b.x + c.x + d.x) * 0.25f;
            const float da = a.x - mt, db = b.x - mt, dc = c.x - mt, dd = d.x - mt;
            const float m2 = (a.y + b.y) + (c.y + d.y) + 64.0f * ((da * da + db * db) + (dc * dc + dd * dd));
            unsigned long long* slot = (unsigned long long*)xbuf + ((size_t)(u.pm * BM + row) * 4 + u.pn);
            __hip_atomic_store(slot, ((unsigned long long)__float_as_uint(m2) << 32) | __float_as_uint(mt), __ATOMIC_RELAXED, __HIP_MEMORY_SCOPE_AGENT);
        }
        asm volatile("s_waitcnt vmcnt(0)" ::: "memory");
        if (lane == 0) __hip_atomic_fetch_add(cnt + 64 * u.pm, 1u, __ATOMIC_RELAXED, __HIP_MEMORY_SCOPE_AGENT);
        if (wid == 0) {
            bool dead = false; const unsigned long long t0 = __builtin_amdgcn_s_memrealtime(); const unsigned want = 8u * (unsigned)ntn;
            for (;;) {
#if defined(BROKEN_EXCHANGE_NO_WAIT)
                break;
#endif
                if ((unsigned)__builtin_amdgcn_readfirstlane(__hip_atomic_load(cnt + 64 * u.pm, __ATOMIC_RELAXED, __HIP_MEMORY_SCOPE_AGENT)) >= want) break;
                if (__builtin_amdgcn_s_memrealtime() - t0 > 2000000ull) {
                    if (lane == 0) { unsigned expect = 0u; __hip_atomic_compare_exchange_strong(tmo + 1, &expect, code | (unsigned)(u.pm & 0xff), __ATOMIC_RELAXED, __ATOMIC_RELAXED, __HIP_MEMORY_SCOPE_AGENT);
                                     __hip_atomic_store(tmo, 1u, __ATOMIC_RELAXED, __HIP_MEMORY_SCOPE_AGENT); }
                    dead = true; break; }
                __builtin_amdgcn_s_sleep(2);
            }
            __builtin_amdgcn_fence(__ATOMIC_ACQUIRE, "agent");
            if (lane == 0) flag[0] = dead ? 1u : 0u;
        }
        asm volatile("s_waitcnt vmcnt(0) lgkmcnt(0)" ::: "memory"); __builtin_amdgcn_s_barrier(); asm volatile("" ::: "memory");
        const bool bad = flag[0] != 0u;
        if (lane < 32) {
            const unsigned long long* slot = (const unsigned long long*)xbuf + (size_t)(u.pm * BM + row) * 4; float mt[4], m2[4]; float ms = 0.f;
#pragma unroll
            for (int t = 0; t < 4; ++t) { if (t < ntn) { const unsigned long long w = __hip_atomic_load(slot + t, __ATOMIC_RELAXED, __HIP_MEMORY_SCOPE_AGENT); mt[t] = __uint_as_float((unsigned)w); m2[t] = __uint_as_float((unsigned)(w >> 32)); } else { mt[t] = 0.f; m2[t] = 0.f; } ms += mt[t]; }
            const float mean = ms / (float)ntn; float q = 0.f;
#pragma unroll
            for (int t = 0; t < 4; ++t) if (t < ntn) { const float dm = mt[t] - mean; q += m2[t] + 256.0f * dm * dm; }
            S[row] = (f32x2v){mean, 1.0f / sqrtf(q / (256.0f * (float)ntn) + eps)};
        }
        asm volatile("s_waitcnt lgkmcnt(0)" ::: "memory"); __builtin_amdgcn_s_barrier(); asm volatile("" ::: "memory");
        return bad;
    }
};
struct EpiLnRes {
    static constexpr bool PERM = false, AFTER_DRAIN = true;
    const float* base; float* out; int ldc; const float* bias; PanelStats st; unsigned poison;
    __device__ __forceinline__ void fused(f32x4 (&acc)[2][2][4][2], const Unit& u, int wr, int wc, int fr, int fq, PG8_LAS unsigned char* lds, int wid, int lane) const {
        typedef float f32x2v __attribute__((ext_vector_type(2)));
        const PG8_LAS f32x2v* S = (const PG8_LAS f32x2v*)(lds + 8192);
        const int col0 = u.pn * BM + wc * 32 + 4 * fq;
#pragma unroll
        for (int bj = 0; bj < 2; ++bj)
#pragma unroll
            for (int n = 0; n < 2; ++n) { const f32x4 bv = bias ? *(const f32x4*)(bias + col0 + bj * HALF + n * 16) : (f32x4){0.f, 0.f, 0.f, 0.f};
#pragma unroll
                for (int ai = 0; ai < 2; ++ai)
#pragma unroll
                    for (int m = 0; m < 4; ++m) acc[ai][bj][m][n] += bv; }
        f32x4 pre[4][2][2];
#pragma unroll
        for (int m = 0; m < 4; ++m) { const size_t off = (size_t)(u.pm * BM + wr * 64 + m * 16 + fr) * ldc + col0;
#pragma unroll
            for (int bj = 0; bj < 2; ++bj)
#pragma unroll
                for (int n = 0; n < 2; ++n) pre[m][bj][n] = *(const f32x4*)(base + off + bj * HALF + n * 16); }
        const bool bad = st.run(acc, u, wr, wc, fr, fq, lds, wid, lane) || poison != 0u;
        const float qnan = __builtin_nanf("");
#pragma unroll
        for (int ai = 0; ai < 2; ++ai)
#pragma unroll
            for (int m = 0; m < 4; ++m) { const int r = ai * HALF + wr * 64 + m * 16 + fr; const f32x2v sr = S[r]; const size_t off = (size_t)(u.pm * BM + r) * ldc + col0;
#pragma unroll
                for (int bj = 0; bj < 2; ++bj)
#pragma unroll
                    for (int n = 0; n < 2; ++n) { const f32x4 bs = ai == 0 ? pre[m][bj][n] : *(const f32x4*)(base + off + bj * HALF + n * 16); f32x4 o = bs + (acc[ai][bj][m][n] - sr.x) * sr.y;
                        if (bad) o = (f32x4){qnan, qnan, qnan, qnan}; *(f32x4*)(out + off + bj * HALF + n * 16) = o; }
                if (m & 1) asm volatile("" ::: "memory"); }
    }
};
struct EpiLnResLn {
    static constexpr bool PERM = false, AFTER_DRAIN = true;
    const float* base; float* out; bf16_t* xn; int ldc; const float* bias; PanelStats st1, st2; unsigned poison;
    __device__ __forceinline__ void fused(f32x4 (&acc)[2][2][4][2], const Unit& u, int wr, int wc, int fr, int fq, PG8_LAS unsigned char* lds, int wid, int lane) const {
        typedef float f32x2v __attribute__((ext_vector_type(2))); typedef unsigned u32x2v __attribute__((ext_vector_type(2)));
        const PG8_LAS f32x2v* S = (const PG8_LAS f32x2v*)(lds + 8192);
        const int col0 = u.pn * BM + wc * 32 + 4 * fq;
#pragma unroll
        for (int bj = 0; bj < 2; ++bj)
#pragma unroll
            for (int n = 0; n < 2; ++n) { const f32x4 bv = bias ? *(const f32x4*)(bias + col0 + bj * HALF + n * 16) : (f32x4){0.f, 0.f, 0.f, 0.f};
#pragma unroll
                for (int ai = 0; ai < 2; ++ai)
#pragma unroll
                    for (int m = 0; m < 4; ++m) acc[ai][bj][m][n] += bv; }
        bool bad = st1.run(acc, u, wr, wc, fr, fq, lds, wid, lane) || poison != 0u;
        const float qnan = __builtin_nanf("");
#pragma unroll
        for (int ai = 0; ai < 2; ++ai)
#pragma unroll
            for (int m = 0; m < 4; ++m) { const int r = ai * HALF + wr * 64 + m * 16 + fr; const f32x2v sr = S[r]; const size_t off = (size_t)(u.pm * BM + r) * ldc + col0;
#pragma unroll
                for (int bj = 0; bj < 2; ++bj)
#pragma unroll
                    for (int n = 0; n < 2; ++n) { const f32x4 bs = *(const f32x4*)(base + off + bj * HALF + n * 16); acc[ai][bj][m][n] = bs + (acc[ai][bj][m][n] - sr.x) * sr.y; }
                asm volatile("" : "+v"(acc[ai][0][m][0]), "+v"(acc[ai][0][m][1]), "+v"(acc[ai][1][m][0]), "+v"(acc[ai][1][m][1]));
                if (m & 1) asm volatile("" ::: "memory"); }
        const bool bad1 = bad;
        bad = st2.run(acc, u, wr, wc, fr, fq, lds, wid, lane) || bad;
#pragma unroll
        for (int ai = 0; ai < 2; ++ai)
#pragma unroll
            for (int m = 0; m < 4; ++m) { const int r = ai * HALF + wr * 64 + m * 16 + fr; const f32x2v sr = S[r]; const size_t off = (size_t)(u.pm * BM + r) * ldc + col0;
#pragma unroll
                for (int bj = 0; bj < 2; ++bj)
#pragma unroll
                    for (int n = 0; n < 2; ++n) { const f32x4 x1 = acc[ai][bj][m][n]; *(f32x4*)(out + off + bj * HALF + n * 16) = bad1 ? (f32x4){qnan, qnan, qnan, qnan} : x1;
                        const f32x4 o = (x1 - sr.x) * sr.y; u32x2v w; w.x = cvt_pk_bf16(o[0], o[1]); w.y = cvt_pk_bf16(o[2], o[3]);
                        if (bad) { w.x = 0x7fc07fc0u; w.y = 0x7fc07fc0u; } *(u32x2v*)(xn + off + bj * HALF + n * 16) = w; }
                asm volatile("" ::: "memory"); }
    }
};

template <class Epi, class Sched, bool ALIGN_EPI = false, bool SP2 = false>
__device__ __forceinline__ void gemm_phase(PG8_LAS unsigned char* lds, const Gemm g, const Sched& S, const Epi& E, int wv) {
    int tid0_ = threadIdx.x; asm volatile("" : "+v"(tid0_)); (void)wv;
    const int tid = tid0_, wid = __builtin_amdgcn_readfirstlane(tid >> 6), lane = tid & 63, wr = wid >> 2, wc = wid & 3, fr = lane & 15, fq = lane >> 4;
    const int K = g.K, nt = K / BK;
    unsigned voffA[2], voffB[2];
#pragma unroll
    for (int i = 0; i < 2; ++i) { int R, C; stage_rc(tid * 16 + i * 8192, R, C); const int Rb = Epi::PERM ? ((R & ~31) + perm32(R & 31)) : R;
        voffA[i] = (unsigned)(R * K + C) * 2u; voffB[i] = (unsigned)(Rb * K + C) * 2u; }
    const size_t kstep = (size_t)(BK * 2);
    const size_t hstep = (size_t)HALF * K * 2;
    const size_t tstep = 2 * hstep;
    const unsigned ldsw = (unsigned)wid * 1024u;
    const int aoff = lds_byte(wr * 64 + fr, fq * 8), boff = lds_byte(wc * 32 + fr, fq * 8);
#define PG8_SA(b, h) (((b) * 2 + (h)) * HTB)
#define PG8_SB(b, h) ((4 + (b) * 2 + (h)) * HTB)
#define PG8_STAGE(bufoff, gbase, voff) do { _Pragma("unroll") for (int _i = 0; _i < 2; ++_i) \
        __builtin_amdgcn_global_load_lds((const unsigned*)((const char*)(gbase) + (voff)[_i]), (PG8_LAS unsigned*)(lds + (bufoff) + ldsw + _i * 8192), 16, 0, 0); } while (0)
#define PG8_LDA(dst, b, h) do { _Pragma("unroll") for (int m = 0; m < 4; ++m) _Pragma("unroll") for (int k = 0; k < 2; ++k) dst[m][k] = *(const PG8_LAS bf16x8*)(lds + PG8_SA(b, h) + aoff + m * 2048 + k * 1024); } while (0)
#define PG8_LDB(dst, b, h) do { _Pragma("unroll") for (int n = 0; n < 2; ++n) _Pragma("unroll") for (int k = 0; k < 2; ++k) dst[n][k] = *(const PG8_LAS bf16x8*)(lds + PG8_SB(b, h) + boff + n * 2048 + k * 1024); } while (0)
#define PG8_MMA(ai, bj, At, Bt) do { __builtin_amdgcn_s_setprio(1); _Pragma("unroll") for (int m = 0; m < 4; ++m) _Pragma("unroll") for (int n = 0; n < 2; ++n) _Pragma("unroll") for (int k = 0; k < 2; ++k) \
        acc[ai][bj][m][n] = __builtin_amdgcn_mfma_f32_16x16x32_bf16(Bt[n][k], At[m][k], acc[ai][bj][m][n], 0, 0, 0); __builtin_amdgcn_s_setprio(0); } while (0)
#define PG8_WAIT_V(n) asm volatile("s_waitcnt vmcnt(" #n ")" ::: "memory")
#define PG8_WAIT_L(n) asm volatile("s_waitcnt lgkmcnt(" #n ")" ::: "memory")
#define PG8_BAR __builtin_amdgcn_s_barrier()
#define PG8_SCHED __builtin_amdgcn_sched_barrier(0)
    Unit cur, nxt; int ui = 0;
    if (!S.next(0, cur)) return;
    f32x4 acc[2][2][4][2];
#pragma unroll
    for (int a = 0; a < 2; ++a)
#pragma unroll
        for (int b = 0; b < 2; ++b)
#pragma unroll
            for (int m = 0; m < 4; ++m)
#pragma unroll
                for (int n = 0; n < 2; ++n) acc[a][b][m][n] = (f32x4){0.f, 0.f, 0.f, 0.f};
    bf16x8 At[4][2], B0[2][2], B1[2][2];
    const char* cA = (const char*)g.A + (size_t)cur.pm * tstep; const char* cB = (const char*)g.Bt + (size_t)cur.pn * tstep;
    S.a_ready(cur);
    if constexpr (SP2) {
        PG8_STAGE(PG8_SB(0, 0), cB, voffB); PG8_STAGE(PG8_SB(0, 1), cB + hstep, voffB); PG8_STAGE(PG8_SA(0, 0), cA, voffA); PG8_STAGE(PG8_SA(0, 1), cA + hstep, voffA);
        if (wr == 1) PG8_BAR;
        PG8_WAIT_V(2); PG8_BAR;
        PG8_STAGE(PG8_SB(1, 0), cB + kstep, voffB); PG8_STAGE(PG8_SA(1, 0), cA + kstep, voffA); PG8_STAGE(PG8_SB(1, 1), cB + hstep + kstep, voffB);
        PG8_WAIT_V(6); PG8_BAR;
    } else {
        PG8_STAGE(PG8_SB(0, 0), cB, voffB); PG8_STAGE(PG8_SA(0, 0), cA, voffA); PG8_STAGE(PG8_SB(0, 1), cB + hstep, voffB); PG8_STAGE(PG8_SA(0, 1), cA + hstep, voffA);
        if (wr == 1) PG8_BAR;
        PG8_WAIT_V(4); PG8_BAR;
        PG8_STAGE(PG8_SB(1, 0), cB + kstep, voffB); PG8_STAGE(PG8_SA(1, 0), cA + kstep, voffA); PG8_STAGE(PG8_SB(1, 1), cB + hstep + kstep, voffB);
        PG8_WAIT_V(6); PG8_BAR;
    }
    for (;;) {
        const bool has_next = S.next(ui + 1, nxt);
        const char* nA = has_next ? (const char*)g.A + (size_t)nxt.pm * tstep : cA; const char* nB = has_next ? (const char*)g.Bt + (size_t)nxt.pn * tstep : cB;
        for (int t = 0; t < nt; t += 2) {
            const bool last = (t == nt - 2);
            const char* a1 = cA + (size_t)(t + 1) * kstep;
            const char* a2 = last ? nA : cA + (size_t)(t + 2) * kstep; const char* b2 = last ? nB : cB + (size_t)(t + 2) * kstep;
            const char* a3 = a2 + kstep; const char* b3 = b2 + kstep;
            if (last && has_next) S.a_ready(nxt);
            if constexpr (SP2) {
            PG8_LDB(B0, 0, 0); PG8_LDB(B1, 0, 1); PG8_SCHED; PG8_LDA(At, 0, 0); PG8_STAGE(PG8_SA(1, 1), a1 + hstep, voffA);
            PG8_WAIT_V(8); PG8_WAIT_L(0); PG8_BAR; PG8_MMA(0, 0, At, B0); PG8_MMA(0, 1, At, B1); PG8_BAR; PG8_SCHED;
            PG8_LDA(At, 0, 1); PG8_STAGE(PG8_SB(0, 0), b2, voffB); PG8_STAGE(PG8_SB(0, 1), b2 + hstep, voffB); PG8_STAGE(PG8_SA(0, 0), a2, voffA);
            PG8_WAIT_V(8); PG8_WAIT_L(0); PG8_BAR; PG8_MMA(1, 0, At, B0); PG8_MMA(1, 1, At, B1); PG8_BAR; PG8_SCHED;
            PG8_LDB(B0, 1, 0); PG8_LDB(B1, 1, 1); PG8_SCHED; PG8_LDA(At, 1, 0); PG8_STAGE(PG8_SA(0, 1), a2 + hstep, voffA);
            PG8_WAIT_V(8); PG8_WAIT_L(0); PG8_BAR; PG8_MMA(0, 0, At, B0); PG8_MMA(0, 1, At, B1); PG8_BAR; PG8_SCHED;
            PG8_LDA(At, 1, 1); PG8_STAGE(PG8_SB(1, 0), b3, voffB); PG8_STAGE(PG8_SB(1, 1), b3 + hstep, voffB); PG8_STAGE(PG8_SA(1, 0), a3, voffA);
            PG8_WAIT_V(8); PG8_WAIT_L(0); PG8_BAR; PG8_MMA(1, 0, At, B0); PG8_MMA(1, 1, At, B1); PG8_BAR; PG8_SCHED;
            } else {
            PG8_LDB(B0, 0, 0); PG8_SCHED; PG8_LDA(At, 0, 0); PG8_STAGE(PG8_SA(1, 1), a1 + hstep, voffA);
            PG8_WAIT_L(8); PG8_BAR; PG8_WAIT_L(0); PG8_MMA(0, 0, At, B0); PG8_BAR; PG8_SCHED;
            PG8_LDB(B1, 0, 1); PG8_STAGE(PG8_SB(0, 0), b2, voffB);
            PG8_BAR; PG8_WAIT_L(0); PG8_MMA(0, 1, At, B1); PG8_BAR;
            PG8_LDA(At, 0, 1); PG8_STAGE(PG8_SA(0, 0), a2, voffA);
            PG8_BAR; PG8_WAIT_L(0); PG8_MMA(1, 0, At, B0); PG8_BAR; PG8_SCHED;
            PG8_STAGE(PG8_SB(0, 1), b2 + hstep, voffB);
            PG8_WAIT_V(6); PG8_BAR; PG8_MMA(1, 1, At, B1); PG8_BAR;
            PG8_LDB(B0, 1, 0); PG8_SCHED; PG8_LDA(At, 1, 0); PG8_STAGE(PG8_SA(0, 1), a2 + hstep, voffA);
            PG8_WAIT_L(8); PG8_BAR; PG8_WAIT_L(0); PG8_MMA(0, 0, At, B0); PG8_BAR; PG8_SCHED;
            PG8_LDB(B1, 1, 1); PG8_STAGE(PG8_SB(1, 0), b3, voffB);
            PG8_BAR; PG8_WAIT_L(0); PG8_MMA(0, 1, At, B1); PG8_BAR;
            PG8_LDA(At, 1, 1); PG8_STAGE(PG8_SA(1, 0), a3, voffA);
            PG8_BAR; PG8_WAIT_L(0); PG8_MMA(1, 0, At, B0); PG8_BAR; PG8_SCHED;
            PG8_STAGE(PG8_SB(1, 1), b3 + hstep, voffB);
            PG8_WAIT_V(6); PG8_BAR; PG8_MMA(1, 1, At, B1); PG8_BAR;
            }
        }
        if constexpr (ALIGN_EPI) { if (wr == 0) PG8_BAR; }
        if constexpr (!Epi::AFTER_DRAIN) { E(acc, cur, wr, wc, fr, fq); S.done(cur); }
        if (!has_next) break;
#pragma unroll
        for (int a = 0; a < 2; ++a)
#pragma unroll
            for (int b = 0; b < 2; ++b)
#pragma unroll
                for (int m = 0; m < 4; ++m)
#pragma unroll
                    for (int n = 0; n < 2; ++n) acc[a][b][m][n] = (f32x4){0.f, 0.f, 0.f, 0.f};
        cur = nxt; cA = nA; cB = nB; ++ui;
        if constexpr (ALIGN_EPI) { if (wr == 1) PG8_BAR; }
    }
    PG8_WAIT_V(0);
    if constexpr (!ALIGN_EPI) { if (wr == 0) PG8_BAR; }
    PG8_BAR;
    if constexpr (Epi::AFTER_DRAIN) { E.fused(acc, cur, wr, wc, fr, fq, lds, wid, lane); S.done(cur); }
#undef PG8_SA
#undef PG8_SB
#undef PG8_STAGE
#undef PG8_LDA
#undef PG8_LDB
#undef PG8_MMA
#undef PG8_WAIT_V
#undef PG8_WAIT_L
#undef PG8_BAR
#undef PG8_SCHED
}
}

#ifndef PG8_SP2
#define PG8_SP2 true
#endif
#ifndef PG8_ALIGN
#define PG8_ALIGN true
#endif
#define GAS __attribute__((address_space(1)))
#define LAS __attribute__((address_space(3)))
#define XB_TMO      128
#define XB_XCNT(j)  (256  + 64 * (j))
#define XB_XSUB(j)  (1280 + 64 * (j))
#define XB_XGEN(j)  (2304 + 64 * (j))
#define XB_TOP      3328
#define XB_TOPGEN   3392
#define XCD_BAR_WORDS 3456
#define XB_SPIN_CAP (1u << 18)

__device__ __forceinline__ unsigned xb_ld(unsigned* p)              { return __hip_atomic_load(p, __ATOMIC_RELAXED, __HIP_MEMORY_SCOPE_AGENT); }
__device__ __forceinline__ unsigned xb_add(unsigned* p, unsigned v) { return __hip_atomic_fetch_add(p, v, __ATOMIC_RELAXED, __HIP_MEMORY_SCOPE_AGENT); }
__device__ __forceinline__ unsigned xb_xcc_id() { return (unsigned)__builtin_amdgcn_s_getreg((3 << 11) | 20) & 0xFu; }
#define XB_SPIN(cond, bar) do { unsigned _sp = 0; while (cond) { __builtin_amdgcn_s_sleep(1); \
    if ((++_sp & 255u) == 0u) { if (xb_ld(&(bar)[XB_TMO])) break; if (_sp > XB_SPIN_CAP) { atomicAdd(&(bar)[XB_TMO], 1u); break; } } } } while (0)

struct XcdBarrier {
    unsigned* bar; unsigned x;
    volatile LAS unsigned* st;
    int wv;
};

__device__ __forceinline__ XcdBarrier xcd_barrier_post(unsigned* bar, volatile LAS unsigned* st) {
    XcdBarrier b; b.bar = bar; b.x = xb_xcc_id(); b.st = st;
    if (threadIdx.x == 0) (void)xb_add(&bar[XB_XCNT(b.x)], 1u);
    return b;
}
__device__ __forceinline__ void xcd_barrier_complete(unsigned* bar, unsigned x, unsigned& nloc, unsigned& nx) {
    asm volatile("" : "+s"(x));
    const unsigned G = gridDim.x * gridDim.y * gridDim.z;
    unsigned sum, cnt, mine, sp = 0u;
    for (;;) {
        sum = 0u; cnt = 0u; mine = 0u;
#pragma unroll
        for (unsigned j = 0; j < 16; ++j) { const unsigned c = xb_ld(&bar[XB_XCNT(j)]); sum += c; cnt += (c > 0u) ? 1u : 0u; mine = (j == x) ? c : mine; }
        if (sum == G) break;
        __builtin_amdgcn_s_sleep(1);
        if ((++sp & 255u) == 0u) { if (xb_ld(&bar[XB_TMO])) break; if (sp > XB_SPIN_CAP) { atomicAdd(&bar[XB_TMO], 1u); break; } }
    }
    nloc = mine > 0u ? mine : 1u; nx = cnt > 0u ? cnt : 1u;
}

__device__ __forceinline__ void xcd_barrier(const XcdBarrier& b) {
    asm volatile("s_waitcnt vmcnt(0)" ::: "memory");
    __syncthreads();
    if (threadIdx.x == 0) {
        unsigned* bar = b.bar; asm volatile("" : "+s"(bar));
        __builtin_amdgcn_s_waitcnt(0);
        unsigned nloc = b.st[0], nx = b.st[1];
        if (nloc == 0u) { xcd_barrier_complete(bar, b.x, nloc, nx); b.st[0] = nloc; b.st[1] = nx; }
        const unsigned old = xb_add(&bar[XB_XSUB(b.x)], 1u);
        const unsigned gen = old / nloc;
        if (old + 1u == (gen + 1u) * nloc) {
            __builtin_amdgcn_fence(__ATOMIC_RELEASE, "agent");
            asm volatile("s_waitcnt vmcnt(0)" ::: "memory");
            const unsigned og = xb_add(&bar[XB_TOP], 1u);
            const unsigned tg = og / nx;
            if (og + 1u == (tg + 1u) * nx) xb_add(&bar[XB_TOPGEN], 1u);
            else XB_SPIN(xb_ld(&bar[XB_TOPGEN]) == tg, bar);
            __builtin_amdgcn_fence(__ATOMIC_ACQUIRE, "agent");
            xb_add(&bar[XB_XGEN(b.x)], 1u);
            asm volatile("s_waitcnt vmcnt(0)" ::: "memory");
        } else {
            XB_SPIN(xb_ld(&bar[XB_XGEN(b.x)]) == gen, bar);
            __builtin_amdgcn_fence(__ATOMIC_ACQUIRE, "agent");
            asm volatile("s_waitcnt vmcnt(0)" ::: "memory");
        }
    }
    __syncthreads();
}
namespace dattn {
constexpr int D = 128, QST = 2048, KVS = 512, OST = 2048, MTW = 68, JLO = 3;
constexpr float THR = 8.f; constexpr bool WSKIP = false;
typedef unsigned short bf16;
constexpr float SCALE = 1.0f;
constexpr int NW = 8, QBLK = 32, KVBLK = 64, QB = NW * QBLK;
constexpr int SHM_V = KVBLK * D * 2, SHM_K = KVBLK * D * 2;
constexpr int LDS_BYTES = 2 * SHM_V + 2 * SHM_K + NW * 64 * 4;

typedef short bf16x8 __attribute__((ext_vector_type(8)));
typedef short s16x4 __attribute__((ext_vector_type(4)));
typedef float f32x16 __attribute__((ext_vector_type(16)));
typedef float f32x4 __attribute__((ext_vector_type(4)));
typedef unsigned u32x4 __attribute__((ext_vector_type(4)));
template <class A, class Bt> struct same_t { static constexpr bool v = false; };
template <class A> struct same_t<A, A> { static constexpr bool v = true; };

#define KSWZ(row, colB) ((row) * 256 + ((colB) ^ (((row) & 7) << 4)))
#define SBAR() __builtin_amdgcn_sched_barrier(0)
__device__ __forceinline__ int v_st(int k, int c) { const int kk = (k & ~0xC) | ((k & 4) << 1) | ((k & 8) >> 1); return ((kk >> 3) * 4 + (c >> 5)) * 512 + ((kk & 7) * 32 + (c & 31)) * 2; }
__device__ __forceinline__ int v_rd_base(int lane) { return ((lane & 3) << 3) | (((lane >> 2) & 3) << 6) | (((lane >> 4) & 1) << 5) | (((lane >> 5) & 1) << 8); }
constexpr int v_rd_off(int d0, int ks, int half) { return d0 * 512 + ks * 4096 + half * 2048; }
__device__ __forceinline__ int crow(int r, int hi) { return (r & 3) + 8 * (r >> 2) + 4 * hi; }
__device__ __forceinline__ unsigned cvtpk(float lo, float hi) {
    unsigned r; asm volatile("v_cvt_pk_bf16_f32 %0, %1, %2" : "=v"(r) : "v"(lo), "v"(hi)); return r;
}
__device__ __forceinline__ bf16x8 pack8(f32x4 a, f32x4 b) {
    u32x4 w = {cvtpk(a[0], a[1]), cvtpk(a[2], a[3]), cvtpk(b[0], b[1]), cvtpk(b[2], b[3])};
    return *reinterpret_cast<bf16x8*>(&w);
}
template <class T> __device__ __forceinline__ bf16x8 load8(const T* p) {
    if constexpr (same_t<T, float>::v) { return pack8(*(const f32x4*)p, *(const f32x4*)(p + 4)); }
    else { return *reinterpret_cast<const bf16x8*>(p); }
}
__device__ __forceinline__ void mask_tile(f32x16& p0, f32x16& p1, int dq, unsigned W) {
    const float NEG = -__builtin_inff();
#pragma unroll
    for (int r = 0; r < 16; ++r) {
        const int c = (r & 3) + 8 * (r >> 2);
        if ((unsigned)(dq - c) >= W) p0[r] = NEG;
        if ((unsigned)(dq - c - 32) >= W) p1[r] = NEG;
    }
}
__device__ __forceinline__ void mask_bits(f32x16& p0, f32x16& p1, unsigned long long mw, int hi) {
    const float NEG = -__builtin_inff();
    const unsigned lo = (unsigned)(mw >> (4 * hi)), up = (unsigned)(mw >> (32 + 4 * hi));
#pragma unroll
    for (int r = 0; r < 16; ++r) {
        const int c = (r & 3) + 8 * (r >> 2);
        if (!((lo >> c) & 1u)) p0[r] = NEG;
        if (!((up >> c) & 1u)) p1[r] = NEG;
    }
}
__device__ __forceinline__ void partialSM(f32x16& p0, f32x16& p1, float& m_reg, float& mn, float& alpha) {
    float pmax = p0[0]; for (int r = 1; r < 16; ++r) pmax = fmaxf(pmax, p0[r]); for (int r = 0; r < 16; ++r) pmax = fmaxf(pmax, p1[r]);
    { auto rr = __builtin_amdgcn_permlane32_swap(__float_as_uint(pmax), __float_as_uint(pmax), false, false);
      pmax = fmaxf(__uint_as_float(rr[0]), __uint_as_float(rr[1])); }
    constexpr float C2 = 1.4426950408889634f * SCALE;
    if (__builtin_expect(__all((pmax - m_reg) * SCALE <= THR), 1)) { mn = m_reg; alpha = 1.f; }
    else { mn = fmaxf(m_reg, pmax); alpha = __builtin_amdgcn_exp2f((m_reg - mn) * C2); m_reg = mn; }
    const float mnL = -mn * C2;
    for (int r = 0; r < 16; ++r) p0[r] = fmaf(p0[r], C2, mnL); for (int r = 0; r < 16; ++r) p1[r] = fmaf(p1[r], C2, mnL);
    for (int r = 0; r < 16; ++r) p0[r] = __builtin_amdgcn_exp2f(p0[r]);
}
__device__ __forceinline__ void finishSM(f32x16& p0, f32x16& p1, float alpha, float& l_reg, bf16x8& pa0, bf16x8& pa1, bf16x8& pa2, bf16x8& pa3) {
    for (int r = 0; r < 16; ++r) p1[r] = __builtin_amdgcn_exp2f(p1[r]);
    float ps = 0; for (int r = 0; r < 16; ++r) ps += p0[r]; for (int r = 0; r < 16; ++r) ps += p1[r];
    { auto rr = __builtin_amdgcn_permlane32_swap(__float_as_uint(ps), __float_as_uint(ps), false, false);
      ps = __uint_as_float(rr[0]) + __uint_as_float(rr[1]); }
    l_reg = l_reg * alpha + ps;
#define PK4(P, B_, OUT) do { unsigned a0 = cvtpk(P[B_+0], P[B_+1]), a1 = cvtpk(P[B_+2], P[B_+3]);                          \
        unsigned b0 = cvtpk(P[B_+4], P[B_+5]), b1 = cvtpk(P[B_+6], P[B_+7]);                                             \
        auto r0 = __builtin_amdgcn_permlane32_swap(a0, b0, false, false); auto r1 = __builtin_amdgcn_permlane32_swap(a1, b1, false, false); \
        u32x4 w = {r0[0], r1[0], r0[1], r1[1]}; OUT = *reinterpret_cast<bf16x8*>(&w); } while (0)
    PK4(p0, 0, pa0); PK4(p0, 8, pa1); PK4(p1, 0, pa2); PK4(p1, 8, pa3);
#undef PK4
}
template <int KB, bool SK>
__device__ __forceinline__ void qkt(f32x16& p0, f32x16& p1, const char* K_lds, int r32, int hi, const bf16x8* qr, bool act) {
    if (SK && !act) { const float NEG = -__builtin_inff();
#pragma unroll
        for (int r = 0; r < 16; ++r) { p0[r] = NEG; p1[r] = NEG; } return; }
    p0 = f32x16{}; p1 = f32x16{};
    const char* kb[4];
#pragma unroll
    for (int dd = 0; dd < 4; ++dd) kb[dd] = K_lds + KB * SHM_K + KSWZ(r32, (dd * 16 + hi * 8) * 2);
#pragma unroll
    for (int d0 = 0; d0 < 8; ++d0) { const char* a = kb[d0 & 3] + (d0 >> 2) * 128;
        bf16x8 b0 = *reinterpret_cast<const bf16x8*>(a);
        bf16x8 b1 = *reinterpret_cast<const bf16x8*>(a + 32 * 256);
        p0 = __builtin_amdgcn_mfma_f32_32x32x16_bf16(b0, qr[d0], p0, 0, 0, 0);
        p1 = __builtin_amdgcn_mfma_f32_32x32x16_bf16(b1, qr[d0], p1, 0, 0, 0); }
}
template <int VB, bool SK>
__device__ __forceinline__ void pv_tile(f32x16* o, int vb0, bf16x8 pa0, bf16x8 pa1, bf16x8 pa2, bf16x8 pa3, bool act) {
    if (SK && !act) return;
#define TRRD(dst, off) asm volatile("ds_read_b64_tr_b16 %0, %1 offset:%2" : "=&v"(dst) : "v"(vb0), "i"(off) : "memory")
#define PV_D0(d0) do { s16x4 l0, l1, l2, l3, h0, h1, h2, h3; constexpr int b_ = VB * SHM_V + v_rd_off(d0, 0, 0);     \
        TRRD(l0, b_); TRRD(h0, b_ + 2048); TRRD(l1, b_ + 4096); TRRD(h1, b_ + 6144); TRRD(l2, b_ + 8192); TRRD(h2, b_ + 10240); TRRD(l3, b_ + 12288); TRRD(h3, b_ + 14336); \
        asm volatile("s_waitcnt lgkmcnt(0)" ::: "memory"); SBAR();                 \
        o[d0] = __builtin_amdgcn_mfma_f32_32x32x16_bf16(pa0, (bf16x8){l0[0], l0[1], l0[2], l0[3], h0[0], h0[1], h0[2], h0[3]}, o[d0], 0, 0, 0);   \
        o[d0] = __builtin_amdgcn_mfma_f32_32x32x16_bf16(pa1, (bf16x8){l1[0], l1[1], l1[2], l1[3], h1[0], h1[1], h1[2], h1[3]}, o[d0], 0, 0, 0);   \
        o[d0] = __builtin_amdgcn_mfma_f32_32x32x16_bf16(pa2, (bf16x8){l2[0], l2[1], l2[2], l2[3], h2[0], h2[1], h2[2], h2[3]}, o[d0], 0, 0, 0);   \
        o[d0] = __builtin_amdgcn_mfma_f32_32x32x16_bf16(pa3, (bf16x8){l3[0], l3[1], l3[2], l3[3], h3[0], h3[1], h3[2], h3[3]}, o[d0], 0, 0, 0); } while (0)
    PV_D0(0); PV_D0(1); PV_D0(2); PV_D0(3);
#undef PV_D0
#undef TRRD
}

template <class TIn, class TOut> struct BlockRef { const TIn* Q; const TIn* K; const TIn* V; TOut* O; const unsigned long long* M; int P0; };
template <class TIn> struct Seam {
    bf16x8 qr[8];
    bf16x8 st_v0, st_v1, st_k0, st_k1; f32x4 sf0, sf1, sf2, sf3;
    f32x4 tq[16];
};
__device__ __forceinline__ int swa_jlo(int, int) { return JLO; }
#define ROW(p, k0, rr) ((p) + (size_t)((k0) + (rr)) * KVS + sc)
#define VMW() asm volatile("s_waitcnt vmcnt(0)" ::: "memory")
#define VMWN(n) asm volatile("s_waitcnt vmcnt(%0)" :: "i"(n) : "memory")
#define SLOAD_H(Kp, Vp, k0) do { S.st_v0 = load8<TIn>(ROW(Vp, k0, sr)); S.st_v1 = load8<TIn>(ROW(Vp, k0, 32 + sr));              \
                         S.st_k0 = load8<TIn>(ROW(Kp, k0, sr)); S.st_k1 = load8<TIn>(ROW(Kp, k0, 32 + sr)); } while (0)
#define SWRITE_HK(bf) do { *(bf16x8*)(K_lds + (bf) * SHM_K + kws) = S.st_k0; *(bf16x8*)(K_lds + (bf) * SHM_K + kws + 32 * 256) = S.st_k1; } while (0)
#define SWRITE_HV(bf) do { *(bf16x8*)(V_lds + (bf) * SHM_V + vst0) = S.st_v0; *(bf16x8*)(V_lds + (bf) * SHM_V + vst1) = S.st_v1; } while (0)
#define SWRITE_H(bf) do { SWRITE_HV(bf); SWRITE_HK(bf); } while (0)
#define SLOAD_F(p, k0) do { S.sf0 = *(const f32x4*)ROW(p, k0, sr); S.sf1 = *(const f32x4*)(ROW(p, k0, sr) + 4);                \
                            S.sf2 = *(const f32x4*)ROW(p, k0, 32 + sr); S.sf3 = *(const f32x4*)(ROW(p, k0, 32 + sr) + 4); } while (0)
#define SWRITE_KF(bf) do { *(bf16x8*)(K_lds + (bf) * SHM_K + kws) = pack8(S.sf0, S.sf1); *(bf16x8*)(K_lds + (bf) * SHM_K + kws + 32 * 256) = pack8(S.sf2, S.sf3); } while (0)
#define SWRITE_VF(bf) do { *(bf16x8*)(V_lds + (bf) * SHM_V + vst0) = pack8(S.sf0, S.sf1); *(bf16x8*)(V_lds + (bf) * SHM_V + vst1) = pack8(S.sf2, S.sf3); } while (0)
template <class TIn, class TOut>
__device__ __forceinline__ void causal_swa_prime(const BlockRef<TIn, TOut>& cur, int W, char* lds, Seam<TIn>& S, int wv) {
    constexpr bool F32 = same_t<TIn, float>::v;
    int tid0_ = threadIdx.x; asm volatile("" : "+v"(tid0_)); (void)wv;
    const int tid = tid0_, wid = __builtin_amdgcn_readfirstlane(tid >> 6), lane = tid & 63, r32 = lane & 31, hi = lane >> 5;
    const int sr = tid >> 4, sc = (tid & 15) * 8, kws = KSWZ(sr, sc * 2); char* K_lds = lds + 2 * SHM_V;
    const int kb0 = swa_jlo(cur.P0, W) * KVBLK;
    for (int d0 = 0; d0 < 8; ++d0) S.qr[d0] = load8<TIn>(cur.Q + (size_t)(wid * QBLK + r32) * QST + d0 * 16 + hi * 8);
    if constexpr (F32) { SLOAD_F((const float*)cur.K, kb0); VMW(); SWRITE_KF(0); SBAR(); SLOAD_F((const float*)cur.V, kb0); }
    else { SLOAD_H(cur.K, cur.V, kb0); VMW(); SWRITE_HK(0); }
    __syncthreads();
}
template <class TIn, class TOut>
__device__ __forceinline__ void causal_swa_block(const BlockRef<TIn, TOut>& cur, const BlockRef<TIn, TOut>& nxt, int skv, int W, char* lds, Seam<TIn>& S, int wv) {
    constexpr bool F32 = same_t<TIn, float>::v;
    int tid0_ = threadIdx.x; asm volatile("" : "+v"(tid0_)); (void)wv;
    const int tid = tid0_, wid = __builtin_amdgcn_readfirstlane(tid >> 6), lane = tid & 63, r32 = lane & 31, hi = lane >> 5;
    const int j_lo = swa_jlo(cur.P0, W);
    int j_hi = (cur.P0 + QB - 1) / KVBLK + 1; if (j_hi > skv / KVBLK) j_hi = skv / KVBLK;
    const int NT = j_hi - j_lo;
    const int kbn = swa_jlo(nxt.P0, W) * KVBLK;
    const int qlo = cur.P0 + wid * QBLK; (void)qlo;
    const unsigned long long* mrow = cur.M + (size_t)(wid * QBLK + r32) * MTW;
    const int qm_unused = 0; (void)qm_unused;
    char* V_lds = lds; char* K_lds = lds + 2 * SHM_V;
    float* ws = (float*)(lds + 2 * SHM_V + 2 * SHM_K) + wid * 64; float* li_l = ws, * al_l = ws + 32;
    float m_reg = -1e30f, l_reg = 0; f32x16 o[4] = {};
    const int sr = tid >> 4, sc = (tid & 15) * 8, vst0 = v_st(sr, sc), vst1 = v_st(32 + sr, sc), kws = KSWZ(sr, sc * 2);
    const int vb0 = (int)(uintptr_t)V_lds + v_rd_base(lane);
    const TIn* Kh = cur.K; const TIn* Vh = cur.V;
#define RESC(a) do { if (__any((a) < 1.f)) { if (hi == 0) al_l[r32] = (a); asm volatile("s_waitcnt lgkmcnt(0)" ::: "memory");              \
                     for (int d_ = 0; d_ < 4; ++d_) for (int r = 0; r < 16; ++r) o[d_][r] *= al_l[crow(r, hi)]; } } while (0)
#define KBASE(t) ((j_lo + (t)) * KVBLK)
#define ACT(t) (KBASE(t) <= qlo + QBLK - 1 && KBASE(t) + KVBLK - 1 >= qlo - W + 1)
#define MASKT(P0_, P1_, t) mask_bits(P0_, P1_, (((t) & 1) ? mwB : mwA), hi)
#define MWLOAD(t) do { const int tt_ = (t) < NT ? (t) : NT - 1; if ((t) & 1) mwB = mrow[j_lo + tt_]; else mwA = mrow[j_lo + tt_]; } while (0)
    constexpr int NQL = F32 ? 16 : 8;
    constexpr bool SK = WSKIP && !F32;
#define SEAM_K0() do { VMWN(NQL); if constexpr (F32) { SWRITE_KF(0); SBAR(); SLOAD_F((const float*)nxt.V, kbn); } else { SWRITE_HK(0); } SBAR(); } while (0)
    f32x16 pA0, pA1, pB0, pB1; float mnA, mnB, alA, alB; bf16x8 pa0, pa1, pa2, pa3;
    unsigned long long mwA = mrow[j_lo], mwB = mrow[j_lo + (NT > 1 ? 1 : 0)];
    if constexpr (F32) { VMW(); SWRITE_VF(0); SBAR(); } else { SWRITE_HV(0); SBAR(); }
    if (NT > 1) { if constexpr (F32) SLOAD_F((const float*)Kh, KBASE(1)); else SLOAD_H(Kh, Vh, KBASE(1)); }
    SBAR(); qkt<0, SK>(pA0, pA1, K_lds, r32, hi, S.qr, ACT(0));
    if constexpr (F32) { if (NT > 1) { VMW(); SWRITE_KF(1); SBAR(); SLOAD_F((const float*)Vh, KBASE(1)); } }
    MASKT(pA0, pA1, 0); MWLOAD(2); partialSM(pA0, pA1, m_reg, mnA, alA);
    if (NT > 1) { VMW(); if constexpr (F32) { SWRITE_VF(1); SBAR(); if (NT > 2) SLOAD_F((const float*)Kh, KBASE(2)); } else SWRITE_H(1); }
    __syncthreads();
#define HALF_STEP(PX0, PX1, mnX, alX, PY0, PY1, alY, t, KB, VB, SB) do {                                                      \
        SBAR(); qkt<KB, SK>(PX0, PX1, K_lds, r32, hi, S.qr, ACT(t));                                             \
        finishSM(PY0, PY1, alY, l_reg, pa0, pa1, pa2, pa3); SBAR();                                                           \
        if ((t) + 1 < NT) { if constexpr (F32) { VMW(); SWRITE_KF(SB); SBAR(); SLOAD_F((const float*)Vh, KBASE((t) + 1)); }  \
                            else { SLOAD_H(Kh, Vh, KBASE((t) + 1)); } SBAR(); }                                               \
        pv_tile<VB, SK>(o, vb0, pa0, pa1, pa2, pa3, ACT((t) - 1)); MASKT(PX0, PX1, (t)); MWLOAD((t) + 2); partialSM(PX0, PX1, m_reg, mnX, alX);                                        \
        __syncthreads();                                                                                                      \
        if ((t) + 1 < NT) { VMW(); if constexpr (F32) { SWRITE_VF(SB); SBAR(); if ((t) + 2 < NT) SLOAD_F((const float*)Kh, KBASE((t) + 2)); } \
                            else { SWRITE_H(SB); } }                                                                          \
        RESC(alX); __syncthreads(); } while (0)
    for (int t = 1; t + 1 < NT; t += 2) {
        HALF_STEP(pB0, pB1, mnB, alB, pA0, pA1, alA, t, 1, 0, 0);
        HALF_STEP(pA0, pA1, mnA, alA, pB0, pB1, alB, t + 1, 0, 1, 1);
    }
    const bool even = (NT & 1) == 0;
    if (even) { SBAR(); qkt<1, SK>(pB0, pB1, K_lds, r32, hi, S.qr, ACT(NT - 1)); SBAR(); }
#define QROW(e) (nxt.Q + (size_t)(wid * QBLK + r32) * QST + ((e) >> 1) * 16 + hi * 8 + ((e) & 1) * 4)
    if constexpr (F32) { SLOAD_F((const float*)nxt.K, kbn); SBAR();
#pragma unroll
        for (int e = 0; e < 8; ++e) S.tq[e] = *(const f32x4*)QROW(e); }
    else { SLOAD_H(nxt.K, nxt.V, kbn); SBAR();
#pragma unroll
        for (int d0 = 0; d0 < 8; ++d0) S.qr[d0] = load8<TIn>(nxt.Q + (size_t)(wid * QBLK + r32) * QST + d0 * 16 + hi * 8); }
    SBAR();
    finishSM(pA0, pA1, alA, l_reg, pa0, pa1, pa2, pa3); SBAR();
    if constexpr (F32) {
#pragma unroll
        for (int e = 8; e < 16; ++e) S.tq[e] = *(const f32x4*)QROW(e); SBAR(); }
#undef QROW
    pv_tile<0, SK>(o, vb0, pa0, pa1, pa2, pa3, ACT(even ? NT - 2 : NT - 1));
    if (even) { MASKT(pB0, pB1, NT - 1); partialSM(pB0, pB1, m_reg, mnB, alB); __syncthreads(); RESC(alB);
        finishSM(pB0, pB1, alB, l_reg, pa0, pa1, pa2, pa3); SBAR(); pv_tile<1, SK>(o, vb0, pa0, pa1, pa2, pa3, ACT(NT - 1)); }
    SBAR(); SEAM_K0();
    if (hi == 0) li_l[r32] = l_reg; asm volatile("s_waitcnt lgkmcnt(0)" ::: "memory");
    float rli[16];
#pragma unroll
    for (int r = 0; r < 16; ++r) rli[r] = __builtin_amdgcn_rcpf(li_l[crow(r, hi)]);
    TOut* Ow = cur.O + (size_t)(wid * QBLK) * OST;
#pragma unroll
    for (int r = 0; r < 16; ++r) { const int orow = crow(r, hi);
#pragma unroll
        for (int d0 = 0; d0 < 4; ++d0) { const float v = o[d0][r] * rli[r];
            if constexpr (same_t<TOut, float>::v) { Ow[(size_t)orow * OST + d0 * 32 + r32] = v; }
            else { const float vn = __shfl_xor(v, 1);
                   if ((r32 & 1) == 0) *(unsigned*)(Ow + (size_t)orow * OST + d0 * 32 + r32) = cvtpk(v, vn); } } }
    if constexpr (F32) {
#pragma unroll
        for (int d0 = 0; d0 < 8; ++d0) S.qr[d0] = pack8(S.tq[2 * d0], S.tq[2 * d0 + 1]); }
    __syncthreads();
#undef RESC
#undef KBASE
#undef ACT
#undef MASKT
#undef MWLOAD
#undef SEAM_K0
#undef HALF_STEP
}
#undef ROW
#undef VMW
#undef VMWN
#undef SLOAD_H
#undef SWRITE_HK
#undef SWRITE_HV
#undef SWRITE_H
#undef SLOAD_F
#undef SWRITE_KF
#undef SWRITE_VF

}

constexpr int NWAVES = 8, NTHREADS = 512;
constexpr int DM = 2048, SEQ = 4096, NMETA = 16, TP = 4112, NBP = 2, SBN = 8, PAST = 16384, NPG = 128;
constexpr int XROW0 = 8192, SROW0 = 8224, NROWS = 8232, MPAD = 8448, FF = 8192, MAINM = 8192, XR = 48;
constexpr int NA_IN = 6144, NB_IN = 4176, NB_PAD = 4352, NC_IN = 12352, NC_PAD = 12544, DVW = 4096, CDIM = 8192;
constexpr float ALPHA = 1.6817928305074292f;
constexpr float LN_EPS = 1e-5f, RMS_EPS = 1e-6f;
constexpr int SCW = 4160, SCSW = 16448, KIROWS = 4128, NSKEY = PAST + 1;
constexpr int POS_SAMPLE_IDX = TP;

constexpr size_t O_YP = 0, O_YS = O_YP + (size_t)NBP * SEQ * DM, O_CAP = O_YS + (size_t)SBN * DM, O_CAS = O_CAP + 2 * NBP * 2 * DM,
                 O_KP = O_CAS + 2 * SBN * 2 * DM, O_VP = O_KP + (size_t)NBP * TP * 512, O_IKP = O_VP + (size_t)NBP * TP * 512,
                 O_KS = O_IKP + (size_t)NBP * TP * 64, O_VS = O_KS + SBN * 512, O_IKS = O_VS + SBN * 512, O_CCP = O_IKS + SBN * 64,
                 O_CCS = O_CCP + (size_t)NBP * 3 * CDIM, O_DP = O_CCS + (size_t)SBN * 3 * CDIM, O_DS = O_DP + (size_t)NBP * 32 * 128 * 128,
                 O_END = O_DS + (size_t)SBN * 32 * 128 * 128;

constexpr size_t MiB = 1u << 20;
constexpr size_t WS_CTL = 0, CTL_ZERO_BYTES = 1 * MiB;
constexpr size_t WS_TAB128 = 1 * MiB, WS_TAB64 = 4 * MiB, WS_WI = 6 * MiB, WS_G = 7 * MiB, WS_BETA = 9 * MiB, WS_CNT = 11 * MiB, WS_KIB = 12 * MiB,
                 WS_SCS = 14 * MiB, WS_IDXL = 16 * MiB, WS_X = 26 * MiB, WS_QR = 60 * MiB, WS_QI = 94 * MiB, WS_Z = 112 * MiB, WS_Y = 180 * MiB,
                 WS_BIG = 248 * MiB, WS_QKVC = 452 * MiB, WS_SC = 584 * MiB, WS_W = 716 * MiB;
constexpr size_t WSZ_A_IN = (size_t)NA_IN * DM * 2, WSZ_A_OUT = (size_t)DM * DM * 2, WSZ_B_IN = (size_t)NB_PAD * DM * 2, WSZ_B_OUT = (size_t)DM * DM * 2,
                 WSZ_C_IN = (size_t)NC_PAD * DM * 2, WSZ_C_OUT = (size_t)DM * DVW * 2, WSZ_W1 = (size_t)FF * DM * 2, WSZ_W2 = (size_t)DM * FF * 2;
constexpr size_t WS_WA_IN = WS_W, WS_WA_OUT = WS_WA_IN + 2 * WSZ_A_IN, WS_WB_IN = WS_WA_OUT + 2 * WSZ_A_OUT, WS_WB_OUT = WS_WB_IN + WSZ_B_IN,
                 WS_WC_IN = WS_WB_OUT + WSZ_B_OUT, WS_WC_OUT = WS_WC_IN + WSZ_C_IN, WS_W1 = WS_WC_OUT + WSZ_C_OUT, WS_W2 = WS_W1 + 4 * WSZ_W1,
                 WS_ZP = WS_W2 + 4 * WSZ_W2, WS_QKF = WS_ZP + 4 * MiB, WS_DWG = WS_QKF + 130 * MiB, WS_DUG = WS_DWG + 66 * MiB, WS_END = WS_DUG + 66 * MiB;
constexpr size_t WS_MASK = WS_IDXL, WS_KS = WS_Z, WS_VS = WS_Z + 9 * MiB;
constexpr size_t WS_DAF = WS_Z, WS_DTG = WS_Y, WS_DTB = WS_Y + 33 * MiB, WS_DPG = WS_QR, WS_DKT = WS_QKF, WS_DVT = WS_QKF + 33 * MiB, WS_DGC = WS_QI, WS_DBT = WS_QI + 2 * MiB;
constexpr int SP = 4352, SPAD = 240, MTW = 68;
constexpr int CW_BAR = 4096;

constexpr int RING_BYTES = 131072, LDSCTL_OFF = RING_BYTES, MISC_OFF = LDSCTL_OFF + 320, LDS_BYTES = 147456;

typedef unsigned short bf16;
typedef unsigned v4u __attribute__((ext_vector_type(4)));
typedef unsigned v2u __attribute__((ext_vector_type(2)));
typedef float f32x4 __attribute__((ext_vector_type(4)));
typedef float f32x2 __attribute__((ext_vector_type(2)));
typedef short bf16x8 __attribute__((ext_vector_type(8)));
typedef float f32x16 __attribute__((ext_vector_type(16)));
typedef __bf16 bf16x2_t __attribute__((ext_vector_type(2)));

#define LDS_WAIT() asm volatile("s_waitcnt lgkmcnt(0)" ::: "memory")
#define WAVE_SYNC() do { asm volatile("s_waitcnt lgkmcnt(0)" ::: "memory"); __builtin_amdgcn_wave_barrier(); } while (0)

__device__ __forceinline__ float bflo(unsigned w) { return __uint_as_float(w << 16); }
__device__ __forceinline__ float bfhi(unsigned w) { return __uint_as_float(w & 0xffff0000u); }
__device__ __forceinline__ float bf2f(bf16 h) { return __uint_as_float((unsigned)h << 16); }
__device__ __forceinline__ unsigned pk2(float lo, float hi) { f32x2 v = {lo, hi}; bf16x2_t b = __builtin_convertvector(v, bf16x2_t); return __builtin_bit_cast(unsigned, b); }
__device__ __forceinline__ bf16 f2bf(float f) { return (bf16)(pk2(f, 0.f) & 0xffffu); }
__device__ __forceinline__ float wave_sum(float v) {
#pragma unroll
    for (int o = 1; o < 64; o <<= 1) v += __shfl_xor(v, o);
    return v;
}
__device__ __forceinline__ float wave_max(float v) {
#pragma unroll
    for (int o = 1; o < 64; o <<= 1) v = fmaxf(v, __shfl_xor(v, o));
    return v;
}
__device__ __forceinline__ int wave_sum_i(int v) {
#pragma unroll
    for (int o = 1; o < 64; o <<= 1) v += __shfl_xor(v, o);
    return v;
}
__device__ __forceinline__ float row16_sum(float v) {
    v += __int_as_float(__builtin_amdgcn_update_dpp(0, __float_as_int(v), 0x128, 0xf, 0xf, false));
    v += __int_as_float(__builtin_amdgcn_update_dpp(0, __float_as_int(v), 0x124, 0xf, 0xf, false));
    v += __int_as_float(__builtin_amdgcn_update_dpp(0, __float_as_int(v), 0x122, 0xf, 0xf, false));
    v += __int_as_float(__builtin_amdgcn_update_dpp(0, __float_as_int(v), 0x121, 0xf, 0xf, false));
    return v;
}
__device__ __forceinline__ float silu_f(float x) { return x / (1.f + __expf(-x)); }
__device__ __forceinline__ int prow(int b, int t) { return t >= NMETA ? b * SEQ + (t - NMETA) : XROW0 + b * NMETA + t; }
__device__ __forceinline__ void row_bt(int r, int& b, int& t) { if (r < XROW0) { b = r >> 12; t = (r & 4095) + NMETA; } else { b = (r - XROW0) >> 4; t = (r - XROW0) & 15; } }
__device__ __forceinline__ void unpack8(const v4u w, float (&f)[8]) {
    f[0] = bflo(w.x); f[1] = bfhi(w.x); f[2] = bflo(w.y); f[3] = bfhi(w.y); f[4] = bflo(w.z); f[5] = bfhi(w.z); f[6] = bflo(w.w); f[7] = bfhi(w.w);
}
__device__ __forceinline__ v4u pack8(const float (&f)[8]) { v4u w; w.x = pk2(f[0], f[1]); w.y = pk2(f[2], f[3]); w.z = pk2(f[4], f[5]); w.w = pk2(f[6], f[7]); return w; }

__device__ __forceinline__ void transpose_item(const float* W, int K, int N, int Npad, bf16* WT, LAS float* scr, int item, int lane) {
    const int nblk = Npad / 32, kb = item / nblk, nb = item % nblk, k0 = 64 * kb, n0 = 32 * nb;
    const int n = n0 + (lane & 31); const bool ok = n < N;
    float wv_[32];
#pragma unroll
    for (int i = 0; i < 32; ++i) { const int kk = 2 * i + (lane >> 5); wv_[i] = W[(size_t)(k0 + kk) * N + (ok ? n : N - 1)]; }
#pragma unroll
    for (int i = 0; i < 32; ++i) { const int kk = 2 * i + (lane >> 5); scr[kk * 33 + (lane & 31)] = ok ? wv_[i] : 0.f; }
    LDS_WAIT(); __builtin_amdgcn_wave_barrier();
    const int c = lane & 7;
#pragma unroll
    for (int j = 0; j < 4; ++j) { const int nn = (lane >> 3) + 8 * j; const LAS float* s = scr + (8 * c) * 33 + nn;
        v4u o; o.x = pk2(s[0 * 33], s[1 * 33]); o.y = pk2(s[2 * 33], s[3 * 33]); o.z = pk2(s[4 * 33], s[5 * 33]); o.w = pk2(s[6 * 33], s[7 * 33]);
        *(v4u*)(WT + (size_t)(n0 + nn) * K + k0 + 8 * c) = o; }
    LDS_WAIT(); __builtin_amdgcn_wave_barrier();
}

struct Ptrs {
    const float *x_prompt, *x_sample, *state_conv_a, *cache_k, *cache_v, *cache_ik, *state_conv_c, *state_delta;
    const int* page_table;
    const float *meta, *w_in_a, *conv_w_a, *w_out_a, *w_in_b, *w_out_b, *w_in_c, *conv_w_c, *a_log, *dt_bias, *norm_w, *w_out_c, *ln1_g, *ln1_b, *w1, *w2, *ln2_g, *ln2_b;
    float* out; unsigned char* ws;
};

__device__ __forceinline__ void p0_prologue(const Ptrs& P, LAS unsigned char* lds, int gw, int NGW, int wave, int lane) {
    LAS float* scr = (LAS float*)(lds + wave * 16384);
    unsigned char* ws = P.ws;
    constexpr int I_A_IN = (DM / 64) * (NA_IN / 32), I_A_OUT = (DM / 64) * (DM / 32), I_B_IN = (DM / 64) * (NB_PAD / 32), I_B_OUT = I_A_OUT,
                  I_C_IN = (DM / 64) * (NC_PAD / 32), I_C_OUT = (DVW / 64) * (DM / 32), I_W1 = (DM / 64) * (FF / 32), I_W2 = (FF / 64) * (DM / 32);
    constexpr int NITEMS = 2 * I_A_IN + 2 * I_A_OUT + I_B_IN + I_B_OUT + I_C_IN + I_C_OUT + 4 * I_W1 + 4 * I_W2;
#define TR_(cnt, Wp, Kk, Nn, Np, WTp) if (r < (cnt)) { transpose_item((Wp), (Kk), (Nn), (Np), (bf16*)(WTp), scr, r, lane); continue; } r -= (cnt);
    for (int it = gw; it < NITEMS; it += NGW) {
        int r = it;
        TR_(I_A_IN, P.w_in_a, DM, NA_IN, NA_IN, ws + WS_WA_IN)
        TR_(I_A_IN, P.w_in_a + (size_t)DM * NA_IN, DM, NA_IN, NA_IN, ws + WS_WA_IN + WSZ_A_IN)
        TR_(I_A_OUT, P.w_out_a, DM, DM, DM, ws + WS_WA_OUT)
        TR_(I_A_OUT, P.w_out_a + (size_t)DM * DM, DM, DM, DM, ws + WS_WA_OUT + WSZ_A_OUT)
        TR_(I_B_IN, P.w_in_b, DM, NB_IN, NB_PAD, ws + WS_WB_IN)
        TR_(I_B_OUT, P.w_out_b, DM, DM, DM, ws + WS_WB_OUT)
        TR_(I_C_IN, P.w_in_c, DM, NC_IN, NC_PAD, ws + WS_WC_IN)
        TR_(I_C_OUT, P.w_out_c, DVW, DM, DM, ws + WS_WC_OUT)
        TR_(I_W1, P.w1, DM, FF, FF, ws + WS_W1)
        TR_(I_W1, P.w1 + (size_t)DM * FF, DM, FF, FF, ws + WS_W1 + WSZ_W1)
        TR_(I_W1, P.w1 + 2 * (size_t)DM * FF, DM, FF, FF, ws + WS_W1 + 2 * WSZ_W1)
        TR_(I_W1, P.w1 + 3 * (size_t)DM * FF, DM, FF, FF, ws + WS_W1 + 3 * WSZ_W1)
        TR_(I_W2, P.w2, FF, DM, DM, ws + WS_W2)
        TR_(I_W2, P.w2 + (size_t)DM * FF, FF, DM, DM, ws + WS_W2 + WSZ_W2)
        TR_(I_W2, P.w2 + 2 * (size_t)DM * FF, FF, DM, DM, ws + WS_W2 + 2 * WSZ_W2)
        transpose_item(P.w2 + 3 * (size_t)DM * FF, FF, DM, DM, (bf16*)(ws + WS_W2 + 3 * WSZ_W2), scr, r, lane);
    }
#undef TR_
    bf16* X = (bf16*)(ws + WS_X);
    for (int r = gw; r < MPAD; r += NGW) {
        const float* src = nullptr;
        if (r < XROW0) src = P.x_prompt + (size_t)r * DM;
        else if (r < SROW0) src = P.meta + (size_t)((r - XROW0) & 15) * DM;
        else if (r < NROWS) src = P.x_sample + (size_t)(r - SROW0) * DM;
#pragma unroll
        for (int j = 0; j < 4; ++j) { const int c = 512 * j + 8 * lane; v4u o = {0u, 0u, 0u, 0u};
            if (src) { const f32x4 a = *(const f32x4*)(src + c), b = *(const f32x4*)(src + c + 4); o.x = pk2(a.x, a.y); o.y = pk2(a.z, a.w); o.z = pk2(b.x, b.y); o.w = pk2(b.z, b.w); }
            *(v4u*)(X + (size_t)r * DM + c) = o; }
    }
    f32x2* t128 = (f32x2*)(ws + WS_TAB128); f32x2* t64 = (f32x2*)(ws + WS_TAB64);
    const int gt = gw * 64 + lane, NGT = NGW * 64;
    for (int e = gt; e < (TP + 1) * 96; e += NGT) {
        const int pi = e / 96, i = e % 96; const float pos = (float)(pi == TP ? PAST : pi);
        const float ex = (i < 64) ? (float)(2 * i) * (1.f / 128.f) : (float)(2 * (i - 64)) * (1.f / 64.f);
        const float inv = __builtin_amdgcn_exp2f(-ex * 13.287712379549449f);
        const float angf = pos * inv;
        double rev = (double)angf * 0.15915494309189535; rev -= __builtin_rint(rev);
        const float rf = (float)rev; const float sn = __builtin_amdgcn_sinf(rf), cs = __builtin_amdgcn_cosf(rf);
        if (i < 64) t128[pi * 64 + i] = (f32x2){cs, sn}; else t64[pi * 32 + (i - 64)] = (f32x2){cs, sn};
    }
}

__device__ __forceinline__ void ln_phase(const float* Z, const float* ZP, bf16* X, bf16* Xo, const float* gam, const float* bet, float* yp, float* ys, int gw, int NGW, int lane) {
    for (int r = gw; r < NROWS; r += NGW) {
        const bool ext = r >= XROW0; bf16* xr = X + (size_t)r * DM;
        f32x4 gq[8], bq_[8];
#pragma unroll
        for (int j = 0; j < 4; ++j) { const int c = 512 * j + 8 * lane; gq[2 * j] = *(const f32x4*)(gam + c); gq[2 * j + 1] = *(const f32x4*)(gam + c + 4); bq_[2 * j] = *(const f32x4*)(bet + c); bq_[2 * j + 1] = *(const f32x4*)(bet + c + 4); }
        float v[32]; float s = 0.f;
#pragma unroll
        for (int j = 0; j < 4; ++j) { const int c = 512 * j + 8 * lane; const v4u xv = *(const v4u*)(xr + c);
            float xf[8]; unpack8(xv, xf);
            if (ext) {
                const float* zr = ZP + (size_t)(r - XROW0) * DM; f32x4 z0 = *(const f32x4*)(zr + c), z1 = *(const f32x4*)(zr + c + 4);
#pragma unroll
                for (int sl = 1; sl < 8; ++sl) { z0 += *(const f32x4*)(zr + (size_t)sl * XR * DM + c); z1 += *(const f32x4*)(zr + (size_t)sl * XR * DM + c + 4); }
                xf[0] = ALPHA * xf[0] + z0.x; xf[1] = ALPHA * xf[1] + z0.y; xf[2] = ALPHA * xf[2] + z0.z; xf[3] = ALPHA * xf[3] + z0.w;
                xf[4] = ALPHA * xf[4] + z1.x; xf[5] = ALPHA * xf[5] + z1.y; xf[6] = ALPHA * xf[6] + z1.z; xf[7] = ALPHA * xf[7] + z1.w;
            }
#pragma unroll
            for (int i = 0; i < 8; ++i) { v[8 * j + i] = xf[i]; s += xf[i]; } }
        const float mean = wave_sum(s) * (1.f / DM); float s2 = 0.f;
#pragma unroll
        for (int i = 0; i < 32; ++i) { v[i] -= mean; s2 += v[i] * v[i]; }
        const float rstd = 1.f / sqrtf(wave_sum(s2) * (1.f / DM) + LN_EPS);
        float* of = nullptr;
        if (yp) { if (r < XROW0) of = yp + (size_t)r * DM; else if (r >= SROW0) of = ys + (size_t)(r - SROW0) * DM; }
#pragma unroll
        for (int j = 0; j < 4; ++j) { const int c = 512 * j + 8 * lane; const f32x4 g0 = gq[2 * j], g1 = gq[2 * j + 1], b0 = bq_[2 * j], b1 = bq_[2 * j + 1];
            float o[8];
            o[0] = v[8 * j + 0] * rstd * g0.x + b0.x; o[1] = v[8 * j + 1] * rstd * g0.y + b0.y; o[2] = v[8 * j + 2] * rstd * g0.z + b0.z; o[3] = v[8 * j + 3] * rstd * g0.w + b0.w;
            o[4] = v[8 * j + 4] * rstd * g1.x + b1.x; o[5] = v[8 * j + 5] * rstd * g1.y + b1.y; o[6] = v[8 * j + 6] * rstd * g1.z + b1.z; o[7] = v[8 * j + 7] * rstd * g1.w + b1.w;
            *(v4u*)(Xo + (size_t)r * DM + c) = pack8(o);
            if (of) { *(f32x4*)(of + c) = (f32x4){o[0], o[1], o[2], o[3]}; *(f32x4*)(of + c + 4) = (f32x4){o[4], o[5], o[6], o[7]}; } }
    }
}

__device__ __forceinline__ void load_u(const bf16* BCH, int row, int c0, float (&u)[8]) {
    const v4u cg = *(const v4u*)(BCH + (size_t)row * NA_IN + DM + c0), hh = *(const v4u*)(BCH + (size_t)row * NA_IN + 2 * DM + c0);
    float a[8], b[8]; unpack8(cg, a); unpack8(hh, b);
#pragma unroll
    for (int i = 0; i < 8; ++i) u[i] = a[i] * b[i];
}
__device__ __forceinline__ void convA_phase(const bf16* BCH, bf16* Y, const float* cw, const float* hist, float* outp, float* outs, int gtid, int NT) {
    constexpr int RUN = 8, NRUN = TP / RUN;
    for (int it = gtid; it < (NBP * NRUN + SBN) * 256; it += NT) {
        const int c0 = (it & 255) * 8, ru = it >> 8;
        float w0[8], w1[8], w2[8];
        { const f32x4 a = *(const f32x4*)(cw + c0), b = *(const f32x4*)(cw + c0 + 4); w0[0] = a.x; w0[1] = a.y; w0[2] = a.z; w0[3] = a.w; w0[4] = b.x; w0[5] = b.y; w0[6] = b.z; w0[7] = b.w; }
        { const f32x4 a = *(const f32x4*)(cw + DM + c0), b = *(const f32x4*)(cw + DM + c0 + 4); w1[0] = a.x; w1[1] = a.y; w1[2] = a.z; w1[3] = a.w; w1[4] = b.x; w1[5] = b.y; w1[6] = b.z; w1[7] = b.w; }
        { const f32x4 a = *(const f32x4*)(cw + 2 * DM + c0), b = *(const f32x4*)(cw + 2 * DM + c0 + 4); w2[0] = a.x; w2[1] = a.y; w2[2] = a.z; w2[3] = a.w; w2[4] = b.x; w2[5] = b.y; w2[6] = b.z; w2[7] = b.w; }
        float u0[8], u1[8], u2[8];
        if (ru < NBP * NRUN) {
            const int b = ru / NRUN, t0 = (ru % NRUN) * RUN;
            if (t0 >= 1) load_u(BCH, prow(b, t0 - 1), c0, u1); else {
#pragma unroll
                for (int i = 0; i < 8; ++i) u1[i] = 0.f; }
            if (t0 >= 2) load_u(BCH, prow(b, t0 - 2), c0, u0); else {
#pragma unroll
                for (int i = 0; i < 8; ++i) u0[i] = 0.f; }
            const int r0 = prow(b, t0);
            v4u bq[RUN], cq[RUN], hq_[RUN];
#pragma unroll
            for (int k = 0; k < RUN; ++k) { const bf16* rp = BCH + (size_t)(r0 + k) * NA_IN + c0; bq[k] = *(const v4u*)rp; cq[k] = *(const v4u*)(rp + DM); hq_[k] = *(const v4u*)(rp + 2 * DM); }
#pragma unroll
            for (int k = 0; k < RUN; ++k) {
                const int r = r0 + k, t = t0 + k;
                { float ca[8], ha[8]; unpack8(cq[k], ca); unpack8(hq_[k], ha);
#pragma unroll
                  for (int i = 0; i < 8; ++i) u2[i] = ca[i] * ha[i]; }
                float bg[8]; unpack8(bq[k], bg);
                float y[8];
#pragma unroll
                for (int i = 0; i < 8; ++i) y[i] = bg[i] * (w0[i] * u0[i] + w1[i] * u1[i] + w2[i] * u2[i]);
                *(v4u*)(Y + (size_t)r * DM + c0) = pack8(y);
                if (t >= TP - 2) { float* o = outp + ((size_t)(b * 2 + (t - (TP - 2)))) * DM + c0; *(f32x4*)o = (f32x4){u2[0], u2[1], u2[2], u2[3]}; *(f32x4*)(o + 4) = (f32x4){u2[4], u2[5], u2[6], u2[7]}; }
#pragma unroll
                for (int i = 0; i < 8; ++i) { u0[i] = u1[i]; u1[i] = u2[i]; }
            }
        } else {
            const int sb = ru - NBP * NRUN, r = SROW0 + sb;
            load_u(BCH, r, c0, u2);
            const float* h0 = hist + ((size_t)(sb * 2 + 0)) * DM + c0; const float* h1 = hist + ((size_t)(sb * 2 + 1)) * DM + c0;
            const f32x4 a0 = *(const f32x4*)h0, a1 = *(const f32x4*)(h0 + 4), b0 = *(const f32x4*)h1, b1 = *(const f32x4*)(h1 + 4);
            u0[0] = a0.x; u0[1] = a0.y; u0[2] = a0.z; u0[3] = a0.w; u0[4] = a1.x; u0[5] = a1.y; u0[6] = a1.z; u0[7] = a1.w;
            u1[0] = b0.x; u1[1] = b0.y; u1[2] = b0.z; u1[3] = b0.w; u1[4] = b1.x; u1[5] = b1.y; u1[6] = b1.z; u1[7] = b1.w;
            float* o0 = outs + ((size_t)(sb * 2 + 0)) * DM + c0; float* o1 = outs + ((size_t)(sb * 2 + 1)) * DM + c0;
            *(f32x4*)o0 = b0; *(f32x4*)(o0 + 4) = b1;
            *(f32x4*)o1 = (f32x4){u2[0], u2[1], u2[2], u2[3]}; *(f32x4*)(o1 + 4) = (f32x4){u2[4], u2[5], u2[6], u2[7]};
            float bg[8]; unpack8(*(const v4u*)(BCH + (size_t)r * NA_IN + c0), bg);
            float y[8];
#pragma unroll
            for (int i = 0; i < 8; ++i) y[i] = bg[i] * (w0[i] * u0[i] + w1[i] * u1[i] + w2[i] * u2[i]);
            *(v4u*)(Y + (size_t)r * DM + c0) = pack8(y);
        }
    }
}

constexpr float QSCALE = 0.08838834764831845f;
__device__ __forceinline__ void rope_phase(const bf16* PROJ, const Ptrs& P, int gw, int NGW, int lane) {
    unsigned char* ws = P.ws;
    const f32x2* t128 = (const f32x2*)(ws + WS_TAB128); const f32x2* t64 = (const f32x2*)(ws + WS_TAB64);
    bf16* Qr = (bf16*)(ws + WS_QR); bf16* QI = (bf16*)(ws + WS_QI); bf16* KIb = (bf16*)(ws + WS_KIB); float* WI = (float*)(ws + WS_WI);
    bf16* Ks = (bf16*)(ws + WS_KS); bf16* Vs = (bf16*)(ws + WS_VS);
    for (int pr_ = gw; pr_ < NBP * SPAD; pr_ += NGW) {
        const size_t o = ((size_t)((pr_ / SPAD) * SP + (pr_ % SPAD))) * 512 + 8 * lane; *(v4u*)(Ks + o) = (v4u){0u, 0u, 0u, 0u}; *(v4u*)(Vs + o) = (v4u){0u, 0u, 0u, 0u}; }
    for (int r = gw; r < NROWS; r += NGW) {
        const bf16* pr = PROJ + (size_t)r * NB_PAD;
        int pi; float *ko, *vo, *iko; bf16* kib = nullptr; bf16 *ksq = nullptr, *vsq = nullptr;
        if (r < SROW0) { int b, t; row_bt(r, b, t); pi = t; ksq = Ks + ((size_t)(b * SP + t + SPAD)) * 512; vsq = Vs + ((size_t)(b * SP + t + SPAD)) * 512; ko = P.out + O_KP + ((size_t)(b * TP + t)) * 512; vo = P.out + O_VP + ((size_t)(b * TP + t)) * 512; iko = P.out + O_IKP + ((size_t)(b * TP + t)) * 64; kib = KIb + ((size_t)(b * KIROWS + t)) * 64; }
        else { const int sb = r - SROW0; pi = POS_SAMPLE_IDX; ko = P.out + O_KS + (size_t)sb * 512; vo = P.out + O_VS + (size_t)sb * 512; iko = P.out + O_IKS + (size_t)sb * 64; }
        const f32x2* c128 = t128 + (size_t)pi * 64; const f32x2* c64 = t64 + (size_t)pi * 32;
        const int hd = lane >> 2, sub = lane & 3;
        {
            float x1[16], x2[16], o1[16], o2[16];
            { float t8[8]; unpack8(*(const v4u*)(pr + hd * 128 + 16 * sub), t8);
#pragma unroll
              for (int i = 0; i < 8; ++i) x1[i] = t8[i]; unpack8(*(const v4u*)(pr + hd * 128 + 16 * sub + 8), t8);
#pragma unroll
              for (int i = 0; i < 8; ++i) x1[8 + i] = t8[i]; unpack8(*(const v4u*)(pr + hd * 128 + 64 + 16 * sub), t8);
#pragma unroll
              for (int i = 0; i < 8; ++i) x2[i] = t8[i]; unpack8(*(const v4u*)(pr + hd * 128 + 64 + 16 * sub + 8), t8);
#pragma unroll
              for (int i = 0; i < 8; ++i) x2[8 + i] = t8[i]; }
#pragma unroll
            for (int i = 0; i < 16; i += 2) { const f32x4 cs = *(const f32x4*)(c128 + 16 * sub + i);
                o1[i] = (x1[i] * cs.x - x2[i] * cs.y) * QSCALE; o2[i] = (x2[i] * cs.x + x1[i] * cs.y) * QSCALE;
                o1[i + 1] = (x1[i + 1] * cs.z - x2[i + 1] * cs.w) * QSCALE; o2[i + 1] = (x2[i + 1] * cs.z + x1[i + 1] * cs.w) * QSCALE; }
            bf16* qo = Qr + (size_t)r * DM + hd * 128 + 16 * sub;
            { float t8[8];
#pragma unroll
              for (int i = 0; i < 8; ++i) t8[i] = o1[i]; *(v4u*)qo = pack8(t8);
#pragma unroll
              for (int i = 0; i < 8; ++i) t8[i] = o1[8 + i]; *(v4u*)(qo + 8) = pack8(t8);
#pragma unroll
              for (int i = 0; i < 8; ++i) t8[i] = o2[i]; *(v4u*)(qo + 64) = pack8(t8);
#pragma unroll
              for (int i = 0; i < 8; ++i) t8[i] = o2[8 + i]; *(v4u*)(qo + 72) = pack8(t8); }
        }
        if (lane < 16) {
            const bf16* kp = pr + 2048 + hd * 128 + 16 * sub;
#pragma unroll
            for (int hf = 0; hf < 2; ++hf) { float x1[8], x2[8], o1[8], o2[8]; unpack8(*(const v4u*)(kp + 8 * hf), x1); unpack8(*(const v4u*)(kp + 64 + 8 * hf), x2);
#pragma unroll
                for (int i = 0; i < 8; i += 2) { const f32x4 cs = *(const f32x4*)(c128 + 16 * sub + 8 * hf + i);
                    o1[i] = x1[i] * cs.x - x2[i] * cs.y; o2[i] = x2[i] * cs.x + x1[i] * cs.y; o1[i + 1] = x1[i + 1] * cs.z - x2[i + 1] * cs.w; o2[i + 1] = x2[i + 1] * cs.z + x1[i + 1] * cs.w; }
                float* kq = ko + hd * 128 + 16 * sub + 8 * hf;
                *(f32x4*)kq = (f32x4){o1[0], o1[1], o1[2], o1[3]}; *(f32x4*)(kq + 4) = (f32x4){o1[4], o1[5], o1[6], o1[7]};
                *(f32x4*)(kq + 64) = (f32x4){o2[0], o2[1], o2[2], o2[3]}; *(f32x4*)(kq + 68) = (f32x4){o2[4], o2[5], o2[6], o2[7]};
                if (ksq) { *(v4u*)(ksq + hd * 128 + 16 * sub + 8 * hf) = pack8(o1); *(v4u*)(ksq + hd * 128 + 64 + 16 * sub + 8 * hf) = pack8(o2); } }
        }
        {
            const v4u vv = *(const v4u*)(pr + 2560 + 8 * lane); float vf[8]; unpack8(vv, vf);
            *(f32x4*)(vo + 8 * lane) = (f32x4){vf[0], vf[1], vf[2], vf[3]}; *(f32x4*)(vo + 8 * lane + 4) = (f32x4){vf[4], vf[5], vf[6], vf[7]};
            if (vsq) *(v4u*)(vsq + 8 * lane) = vv;
        }
        {
            float x1[8], x2[8], o1[8], o2[8]; unpack8(*(const v4u*)(pr + 3072 + hd * 64 + 8 * sub), x1); unpack8(*(const v4u*)(pr + 3072 + hd * 64 + 32 + 8 * sub), x2);
#pragma unroll
            for (int i = 0; i < 8; i += 2) { const f32x4 cs = *(const f32x4*)(c64 + 8 * sub + i);
                o1[i] = x1[i] * cs.x - x2[i] * cs.y; o2[i] = x2[i] * cs.x + x1[i] * cs.y; o1[i + 1] = x1[i + 1] * cs.z - x2[i + 1] * cs.w; o2[i + 1] = x2[i + 1] * cs.z + x1[i + 1] * cs.w; }
            *(v4u*)(QI + (size_t)r * 1024 + hd * 64 + 8 * sub) = pack8(o1); *(v4u*)(QI + (size_t)r * 1024 + hd * 64 + 32 + 8 * sub) = pack8(o2);
        }
        if (lane < 4) {
            float x1[8], x2[8], o1[8], o2[8]; unpack8(*(const v4u*)(pr + 4096 + 8 * sub), x1); unpack8(*(const v4u*)(pr + 4096 + 32 + 8 * sub), x2);
#pragma unroll
            for (int i = 0; i < 8; i += 2) { const f32x4 cs = *(const f32x4*)(c64 + 8 * sub + i);
                o1[i] = x1[i] * cs.x - x2[i] * cs.y; o2[i] = x2[i] * cs.x + x1[i] * cs.y; o1[i + 1] = x1[i + 1] * cs.z - x2[i + 1] * cs.w; o2[i + 1] = x2[i + 1] * cs.z + x1[i + 1] * cs.w; }
            float* io = iko + 8 * sub;
            *(f32x4*)io = (f32x4){o1[0], o1[1], o1[2], o1[3]}; *(f32x4*)(io + 4) = (f32x4){o1[4], o1[5], o1[6], o1[7]};
            *(f32x4*)(io + 32) = (f32x4){o2[0], o2[1], o2[2], o2[3]}; *(f32x4*)(io + 36) = (f32x4){o2[4], o2[5], o2[6], o2[7]};
            if (kib) { *(v4u*)(kib + 8 * sub) = pack8(o1); *(v4u*)(kib + 32 + 8 * sub) = pack8(o2); }
        } else if (lane < 6) {
            float wv[8]; unpack8(*(const v4u*)(pr + 4160 + 8 * (lane - 4)), wv); float* wo = WI + (size_t)r * 16 + 8 * (lane - 4);
            *(f32x4*)wo = (f32x4){wv[0], wv[1], wv[2], wv[3]}; *(f32x4*)(wo + 4) = (f32x4){wv[4], wv[5], wv[6], wv[7]};
        }
    }
}

__device__ __forceinline__ void indexer_prompt(const Ptrs& P, LAS unsigned char* lds, int tid, int wave, int lane) {
    unsigned char* ws = P.ws;
    const bf16* QI = (const bf16*)(ws + WS_QI); const bf16* KIb = (const bf16*)(ws + WS_KIB); const float* WI = (const float*)(ws + WS_WI); float* SC = (float*)(ws + WS_SC);
    const int n = lane & 31, h8 = lane >> 5;
    const int qsel = (n >> 2) & 1, head = (n & 3) + 4 * (n >> 3);
    constexpr int NG = TP / 16;
    constexpr int KROW = 144, TBUF = 128 * KROW;
    for (int it = blockIdx.x; it < 2 * NG; it += gridDim.x) {
        int b, qg;
        if (it < 256) { b = it & 1; qg = it >> 1; } else if (it < 512) { b = it & 1; qg = 256 - ((it - 256) >> 1); } else { b = it - 512; qg = 128; }
        const int t0 = 16 * qg + 2 * wave;
        const bf16* qa = QI + (size_t)prow(b, t0 + qsel) * 1024 + head * 64 + 8 * h8;
        bf16x8 a[4];
#pragma unroll
        for (int kk = 0; kk < 4; ++kk) a[kk] = *(const bf16x8*)(qa + 16 * kk);
        const int tq = t0 + h8;
        const float* wp = WI + (size_t)prow(b, tq) * 16;
        float w[16];
#pragma unroll
        for (int i = 0; i < 4; ++i) { const f32x4 x = *(const f32x4*)(wp + 4 * i); w[4 * i] = x.x; w[4 * i + 1] = x.y; w[4 * i + 2] = x.z; w[4 * i + 3] = x.w; }
        const int ntile = ((16 * qg + 15) >> 5) + 1, ntrip = (ntile + 3) >> 2;
        float* scrow = SC + ((size_t)(b * TP + tq)) * SCW;
        const bf16* kbase = KIb + (size_t)b * KIROWS * 64;
        const int p0 = tid, p1 = tid + 512;
        const int l0 = (p0 >> 3) * KROW + (p0 & 7) * 16, l1 = (p1 >> 3) * KROW + (p1 & 7) * 16;
        asm volatile("s_waitcnt lgkmcnt(0)\n\ts_barrier" ::: "memory");
        v4u g0 = *(const v4u*)(kbase + (size_t)p0 * 8), g1 = *(const v4u*)(kbase + (size_t)p1 * 8);
        *(LAS v4u*)(lds + l0) = g0; *(LAS v4u*)(lds + l1) = g1;
        for (int tr = 0; tr < ntrip; ++tr) {
            const int cur = tr & 1;
            if (tr + 1 < ntrip) { const size_t ko = (size_t)(tr + 1) * 128 * 64;
                const int kmax = KIROWS * 64 - 8;
                const size_t o0 = ko + (size_t)p0 * 8, o1 = ko + (size_t)p1 * 8;
                g0 = *(const v4u*)(kbase + (o0 <= (size_t)kmax ? o0 : (size_t)kmax)); g1 = *(const v4u*)(kbase + (o1 <= (size_t)kmax ? o1 : (size_t)kmax)); }
            asm volatile("s_waitcnt lgkmcnt(0)\n\ts_barrier" ::: "memory");
            const LAS unsigned char* kb = lds + cur * TBUF + n * KROW + h8 * 16;
#pragma unroll
            for (int u = 0; u < 4; ++u) {
                f32x16 acc;
#pragma unroll
                for (int i = 0; i < 16; ++i) acc[i] = 0.f;
#pragma unroll
                for (int kk = 0; kk < 4; ++kk) acc = __builtin_amdgcn_mfma_f32_32x32x16_bf16(a[kk], *(const LAS bf16x8*)(kb + u * 32 * KROW + kk * 32), acc, 0, 0, 0);
                float sc = 0.f;
#pragma unroll
                for (int i = 0; i < 16; ++i) sc += w[i] * fmaxf(acc[i], 0.f);
                const int s = 32 * (4 * tr + u) + n;
                if (s <= tq) scrow[s] = sc;
            }
            if (tr + 1 < ntrip) { *(LAS v4u*)(lds + (cur ^ 1) * TBUF + l0) = g0; *(LAS v4u*)(lds + (cur ^ 1) * TBUF + l1) = g1; }
        }
    }
    asm volatile("s_waitcnt lgkmcnt(0)\n\ts_barrier" ::: "memory");
}

__device__ __forceinline__ void indexer_sample(const Ptrs& P, LAS unsigned char* lds, int tid) {
    unsigned char* ws = P.ws;
    const bf16* QI = (const bf16*)(ws + WS_QI); const float* WI = (const float*)(ws + WS_WI); float* SCS = (float*)(ws + WS_SCS);
    LAS float* lq = (LAS float*)lds;
    LAS float* lw = lq + 1024;
    constexpr int NCH = (NSKEY + 511) / 512;
    for (int item = blockIdx.x; item < SBN * NCH; item += gridDim.x) {
        const int sb = item / NCH, ch = item % NCH, r = SROW0 + sb;
        __syncthreads();
        for (int e = tid; e < 1024; e += NTHREADS) lq[e] = bf2f(QI[(size_t)r * 1024 + e]);
        if (tid < 16) lw[tid] = WI[(size_t)r * 16 + tid];
        __syncthreads();
        const int s = ch * 512 + tid;
        if (s < NSKEY) {
            const float* kr = (s < PAST) ? P.cache_ik + ((size_t)P.page_table[sb * NPG + (s >> 7)] * 128 + (s & 127)) * 64 : P.out + O_IKS + (size_t)sb * 64;
            f32x4 kv[16];
#pragma unroll
            for (int i = 0; i < 16; ++i) kv[i] = *(const f32x4*)(kr + 4 * i);
            float sc = 0.f;
            for (int h = 0; h < 16; ++h) { float d = 0.f;
#pragma unroll
                for (int i = 0; i < 16; ++i) { const f32x4 q = *(const LAS f32x4*)(lq + h * 64 + 4 * i); d += q.x * kv[i].x + q.y * kv[i].y + q.z * kv[i].z + q.w * kv[i].w; }
                sc += lw[h] * fmaxf(d, 0.f); }
            SCS[(size_t)sb * SCSW + s] = sc;
        }
    }
    __syncthreads();
}

__device__ __forceinline__ unsigned ordkey(float f) { const unsigned u = __float_as_uint(f); return (u & 0x80000000u) ? ~u : (u | 0x80000000u); }
constexpr int TOPK = 256;
__device__ __forceinline__ void topk_wave_mask(const float* sc, int n, unsigned long long* mrow, int lane) {
    constexpr int NS = MTW, M0 = SPAD / 64;
    static_assert(M0 == dattn::JLO, "first real key tile");
    unsigned key[NS];
#pragma unroll
    for (int m = M0; m < NS; ++m) { const int sidx = lane + 64 * m - SPAD; const int ci = sidx < 0 ? 0 : (sidx < n ? sidx : n - 1); const float v = sc[ci]; key[m] = (sidx >= 0 && sidx < n) ? ordkey(v) : 0u; }
    if (n <= TOPK) {
#pragma unroll
        for (int m = M0; m < NS; ++m) { const unsigned long long w = __ballot(key[m] != 0u); if (lane == 0) mrow[m] = w; }
        return;
    }
    unsigned T = 0u;
    for (int bit = 31; bit >= 0; --bit) {
        const unsigned cand = T | (1u << bit); int c = 0;
#pragma unroll
        for (int m = M0; m < NS; ++m) c += __popcll(__ballot(key[m] >= cand));
        if (c >= TOPK) T = cand;
    }
    int cg = 0;
#pragma unroll
    for (int m = M0; m < NS; ++m) cg += __popcll(__ballot(key[m] > T));
    const int need = TOPK - cg;
    int base_e = 0;
    const unsigned long long lt = (1ull << lane) - 1ull;
#pragma unroll
    for (int m = M0; m < NS; ++m) {
        const bool pg = key[m] > T, pe = key[m] == T;
        const unsigned long long me = __ballot(pe);
        const int pre_e = __popcll(me & lt);
        const unsigned long long w = __ballot(pg || (pe && (base_e + pre_e) < need));
        if (lane == 0) mrow[m] = w;
        base_e += __popcll(me);
    }
}
__device__ __forceinline__ void topk_block(const float* sc, int n, int* outIdx, int* outCnt, LAS unsigned* ls, int tid, int wave, int lane) {
    constexpr int NS = (NSKEY + NTHREADS - 1) / NTHREADS;
    unsigned key[NS];
#pragma unroll
    for (int m = 0; m < NS; ++m) { const int e = tid + NTHREADS * m; const float v = sc[e < n ? e : n - 1]; key[m] = (e < n) ? ordkey(v) : 0u; }
    unsigned T = 0u;
    for (int bit = 31; bit >= 0; --bit) {
        const unsigned cand = T | (1u << bit); int c = 0;
#pragma unroll
        for (int m = 0; m < NS; ++m) c += (key[m] >= cand) ? 1 : 0;
        c = wave_sum_i(c);
        LAS unsigned* buf = ls + (bit & 1) * 8;
        if (lane == 0) buf[wave] = (unsigned)c;
        __syncthreads();
        int tot = 0;
#pragma unroll
        for (int w = 0; w < 8; ++w) tot += (int)buf[w];
        if (tot >= TOPK) T = cand;
    }
    __syncthreads();
    if (tid == 0) { unsigned z_ = 0u; asm volatile("" : "+v"(z_)); ls[16] = z_; ls[17] = z_; }
    __syncthreads();
#pragma unroll
    for (int m = 0; m < NS; ++m) { const int e = tid + NTHREADS * m; if (key[m] > T) { const unsigned pos = atomicAdd((unsigned*)(ls + 16), 1u); if (pos < (unsigned)TOPK) outIdx[pos] = e; } }
    __syncthreads();
    const unsigned cg = ls[16];
    const unsigned need = (unsigned)TOPK - cg;
#pragma unroll
    for (int m = 0; m < NS; ++m) { const int e = tid + NTHREADS * m; if (key[m] == T) { const unsigned pos = atomicAdd((unsigned*)(ls + 17), 1u); if (pos < need) outIdx[cg + pos] = e; } }
    if (tid == 0) *outCnt = TOPK;
    __syncthreads();
}
__device__ __forceinline__ void select_phase(const Ptrs& P, LAS unsigned char* lds, int gw, int NGW, int tid, int wave, int lane) {
    unsigned char* ws = P.ws;
    const float* SC = (const float*)(ws + WS_SC); const float* SCS = (const float*)(ws + WS_SCS); int* IDXL = (int*)(ws + WS_IDXL); int* CNT = (int*)(ws + WS_CNT);
    for (int sb = blockIdx.x; sb < SBN; sb += gridDim.x) topk_block(SCS + (size_t)sb * SCSW, NSKEY, IDXL + (size_t)(SROW0 + sb) * TOPK, CNT + SROW0 + sb, (LAS unsigned*)lds, tid, wave, lane);
    unsigned long long* MASK = (unsigned long long*)(ws + WS_MASK);
    for (int r = gw; r < SROW0; r += NGW) { int b, t; row_bt(r, b, t);
        if (r < XROW0) topk_wave_mask(SC + ((size_t)(b * TP + t)) * SCW, t + 1, MASK + ((size_t)(b * SP + t + SPAD)) * MTW, lane);
        else { if (lane <= t) IDXL[(size_t)r * TOPK + lane] = lane; if (lane == 0) CNT[r] = t + 1; } }
}

__device__ __forceinline__ void attn_phase(const Ptrs& P, bf16* O, LAS unsigned char* lds, int gw, int NGW, int wave, int lane) {
    unsigned char* ws = P.ws;
    const bf16* Qr = (const bf16*)(ws + WS_QR); const int* IDXL = (const int*)(ws + WS_IDXL); const int* CNT = (const int*)(ws + WS_CNT);
    LAS float* lq = (LAS float*)(lds + wave * 12288);
    LAS f32x4* lp = (LAS f32x4*)(lds + wave * 12288 + 2048);
    LAS unsigned long long* lkp = (LAS unsigned long long*)(lds + wave * 12288 + 6144);
    LAS unsigned long long* lvp = (LAS unsigned long long*)(lds + wave * 12288 + 8192);
    for (int item = gw; item < (NROWS - XROW0) * 4; item += NGW) {
        const int r = XROW0 + (item >> 2), n = item & 3;
        const int cnt = CNT[r];
        WAVE_SYNC();
        { float qf[8]; unpack8(*(const v4u*)(Qr + (size_t)r * DM + n * 512 + 8 * lane), qf);
          *(LAS f32x4*)(lq + 8 * lane) = (f32x4){qf[0], qf[1], qf[2], qf[3]}; *(LAS f32x4*)(lq + 8 * lane + 4) = (f32x4){qf[4], qf[5], qf[6], qf[7]}; }
        const float* kp[4];
#pragma unroll
        for (int j = 0; j < 4; ++j) {
            const int e = lane + 64 * j; const int s = (e < cnt) ? IDXL[(size_t)r * TOPK + e] : 0;
            const float *kq, *vq;
            if (r < SROW0) { const int b = (r < XROW0) ? (r >> 12) : ((r - XROW0) >> 4); kq = P.out + O_KP + ((size_t)(b * TP + s)) * 512; vq = P.out + O_VP + ((size_t)(b * TP + s)) * 512; }
            else { const int sb = r - SROW0;
                if (s < PAST) { const size_t off = ((size_t)P.page_table[sb * NPG + (s >> 7)] * 128 + (s & 127)) * 512; kq = P.cache_k + off; vq = P.cache_v + off; }
                else { kq = P.out + O_KS + (size_t)sb * 512; vq = P.out + O_VS + (size_t)sb * 512; } }
            kp[j] = kq + n * 128; lkp[e] = (unsigned long long)(kq + n * 128); lvp[e] = (unsigned long long)(vq + n * 128);
        }
        WAVE_SYNC();
        float acc[4][4];
#pragma unroll
        for (int g = 0; g < 4; ++g)
#pragma unroll
            for (int j = 0; j < 4; ++j) acc[g][j] = 0.f;
#pragma unroll 4
        for (int d4 = 0; d4 < 32; ++d4) {
            f32x4 qv[4];
#pragma unroll
            for (int g = 0; g < 4; ++g) qv[g] = *(const LAS f32x4*)(lq + g * 128 + 4 * d4);
#pragma unroll
            for (int j = 0; j < 4; ++j) { const f32x4 kv = *(const f32x4*)(kp[j] + 4 * d4);
#pragma unroll
                for (int g = 0; g < 4; ++g) acc[g][j] += qv[g].x * kv.x + qv[g].y * kv.y + qv[g].z * kv.z + qv[g].w * kv.w; }
        }
        float linv[4];
#pragma unroll
        for (int g = 0; g < 4; ++g) {
            float m = -INFINITY;
#pragma unroll
            for (int j = 0; j < 4; ++j) { if (lane + 64 * j >= cnt) acc[g][j] = -INFINITY; m = fmaxf(m, acc[g][j]); }
            m = wave_max(m); float l = 0.f;
#pragma unroll
            for (int j = 0; j < 4; ++j) { acc[g][j] = __expf(acc[g][j] - m); l += acc[g][j]; }
            linv[g] = 1.f / wave_sum(l);
        }
#pragma unroll
        for (int j = 0; j < 4; ++j) lp[lane + 64 * j] = (f32x4){acc[0][j], acc[1][j], acc[2][j], acc[3][j]};
        WAVE_SYNC();
        float o[4][2];
#pragma unroll
        for (int g = 0; g < 4; ++g) { o[g][0] = 0.f; o[g][1] = 0.f; }
#pragma unroll 8
        for (int e = 0; e < cnt; ++e) {
            const float* vp = (const float*)lvp[e]; const f32x2 vv = *(const f32x2*)(vp + 2 * lane); const f32x4 p = lp[e];
            o[0][0] += p.x * vv.x; o[0][1] += p.x * vv.y; o[1][0] += p.y * vv.x; o[1][1] += p.y * vv.y; o[2][0] += p.z * vv.x; o[2][1] += p.z * vv.y; o[3][0] += p.w * vv.x; o[3][1] += p.w * vv.y;
        }
#pragma unroll
        for (int g = 0; g < 4; ++g) *(unsigned*)(O + (size_t)r * DM + (4 * n + g) * 128 + 2 * lane) = pk2(o[g][0] * linv[g], o[g][1] * linv[g]);
    }
}

__device__ __forceinline__ void convC_finish(float (&acc)[8], int it) {
    float ss = 0.f;
#pragma unroll
    for (int i = 0; i < 8; ++i) { acc[i] = silu_f(acc[i]); ss += acc[i] * acc[i]; }
    if (it < 8) { ss = row16_sum(ss); float rn = 1.f / sqrtf(ss + RMS_EPS); if (it < 4) rn *= QSCALE;
#pragma unroll
        for (int i = 0; i < 8; ++i) acc[i] *= rn; }
}
__device__ __forceinline__ void convC_phase(const bf16* PROJC, const Ptrs& P, int gw, int NGW, int lane) {
    unsigned char* ws = P.ws;
    bf16* QKVC = (bf16*)(ws + WS_QKVC); float* QKF = (float*)(ws + WS_QKF); float* G = (float*)(ws + WS_G); float* BETA = (float*)(ws + WS_BETA);
    const float* cw = P.conv_w_c;
    constexpr int RUN = 8, NRUN = TP / RUN;
    for (int item = gw; item < 16 * NBP * NRUN; item += NGW) {
        const int it = item & 15, ru = item >> 4, b = ru / NRUN, t0 = (ru % NRUN) * RUN, ch0 = it * 512 + 8 * lane;
        float w[4][8];
#pragma unroll
        for (int j = 0; j < 4; ++j) { const f32x4 w0 = *(const f32x4*)(cw + (size_t)j * CDIM + ch0), w1 = *(const f32x4*)(cw + (size_t)j * CDIM + ch0 + 4);
            w[j][0] = w0.x; w[j][1] = w0.y; w[j][2] = w0.z; w[j][3] = w0.w; w[j][4] = w1.x; w[j][5] = w1.y; w[j][6] = w1.z; w[j][7] = w1.w; }
        const int r0 = prow(b, t0);
        v4u xr[RUN + 3];
#pragma unroll
        for (int j = 0; j < 3; ++j) { const int tt = t0 - 3 + j; xr[j] = tt >= 0 ? *(const v4u*)(PROJC + (size_t)prow(b, tt) * NC_PAD + ch0) : (v4u){0u, 0u, 0u, 0u}; }
#pragma unroll
        for (int k = 0; k < RUN; ++k) xr[3 + k] = *(const v4u*)(PROJC + (size_t)(r0 + k) * NC_PAD + ch0);
        float x[RUN + 3][8];
#pragma unroll
        for (int j = 0; j < RUN + 3; ++j) unpack8(xr[j], x[j]);
#pragma unroll
        for (int k = 0; k < RUN; ++k) {
            float acc[8];
#pragma unroll
            for (int i = 0; i < 8; ++i) acc[i] = w[0][i] * x[k][i] + w[1][i] * x[k + 1][i] + w[2][i] * x[k + 2][i] + w[3][i] * x[k + 3][i];
            convC_finish(acc, it);
            *(v4u*)(QKVC + (size_t)(r0 + k) * CDIM + ch0) = pack8(acc);
            const int t = t0 + k;
            if (t >= TP - 3) { float* o = P.out + O_CCP + ((size_t)(b * 3 + (t - (TP - 3)))) * CDIM + ch0;
                *(f32x4*)o = (f32x4){x[k + 3][0], x[k + 3][1], x[k + 3][2], x[k + 3][3]}; *(f32x4*)(o + 4) = (f32x4){x[k + 3][4], x[k + 3][5], x[k + 3][6], x[k + 3][7]}; }
        }
    }
    for (int item = gw; item < 16 * SBN; item += NGW) {
        const int it = item & 15, sb = item >> 4, r = SROW0 + sb, ch0 = it * 512 + 8 * lane;
        float x[4][8];
#pragma unroll
        for (int j = 0; j < 3; ++j) { const float* hp = P.state_conv_c + ((size_t)(sb * 3 + j)) * CDIM + ch0; const f32x4 a = *(const f32x4*)hp, c = *(const f32x4*)(hp + 4);
            x[j][0] = a.x; x[j][1] = a.y; x[j][2] = a.z; x[j][3] = a.w; x[j][4] = c.x; x[j][5] = c.y; x[j][6] = c.z; x[j][7] = c.w; }
        unpack8(*(const v4u*)(PROJC + (size_t)r * NC_PAD + ch0), x[3]);
        float acc[8];
#pragma unroll
        for (int i = 0; i < 8; ++i) acc[i] = 0.f;
#pragma unroll
        for (int j = 0; j < 4; ++j) { const f32x4 w0 = *(const f32x4*)(cw + (size_t)j * CDIM + ch0), w1 = *(const f32x4*)(cw + (size_t)j * CDIM + ch0 + 4);
            acc[0] += w0.x * x[j][0]; acc[1] += w0.y * x[j][1]; acc[2] += w0.z * x[j][2]; acc[3] += w0.w * x[j][3];
            acc[4] += w1.x * x[j][4]; acc[5] += w1.y * x[j][5]; acc[6] += w1.z * x[j][6]; acc[7] += w1.w * x[j][7]; }
        convC_finish(acc, it);
        if (it < 8) { float* qk = QKF + (size_t)r * 4096 + ch0; *(f32x4*)qk = (f32x4){acc[0], acc[1], acc[2], acc[3]}; *(f32x4*)(qk + 4) = (f32x4){acc[4], acc[5], acc[6], acc[7]}; }
        *(v4u*)(QKVC + (size_t)r * CDIM + ch0) = pack8(acc);
        float* o = P.out + O_CCS + ((size_t)(sb * 3)) * CDIM + ch0;
#pragma unroll
        for (int j = 0; j < 3; ++j) { *(f32x4*)(o + (size_t)j * CDIM) = (f32x4){x[j + 1][0], x[j + 1][1], x[j + 1][2], x[j + 1][3]}; *(f32x4*)(o + (size_t)j * CDIM + 4) = (f32x4){x[j + 1][4], x[j + 1][5], x[j + 1][6], x[j + 1][7]}; }
    }
    for (int e = gw * 64 + lane; e < NROWS * 32; e += NGW * 64) {
        const int r = e >> 5, h = e & 31;
        const float braw = bf2f(PROJC[(size_t)r * NC_PAD + 12288 + h]), araw = bf2f(PROJC[(size_t)r * NC_PAD + 12320 + h]);
        const float xx = araw + P.dt_bias[h]; const float sp = xx > 20.f ? xx : __logf(1.f + __expf(xx));
        G[e] = -__expf(P.a_log[h]) * sp; BETA[e] = 1.f / (1.f + __expf(-braw));
    }
}

struct Tok { f32x4 k0, k1, q0, q1; unsigned v; float g, b; };
__device__ __forceinline__ void tok_load(Tok& T, const float* QKF, const bf16* QKVC, const float* G, const float* BETA, int row, int h, int rg, int col0) {
    const float* base = QKF + (size_t)row * 4096 + (h >> 1) * 128 + 8 * rg;
    T.q0 = *(const f32x4*)base; T.q1 = *(const f32x4*)(base + 4); T.k0 = *(const f32x4*)(base + 2048); T.k1 = *(const f32x4*)(base + 2052);
    T.v = *(const unsigned*)(QKVC + (size_t)row * CDIM + 4096 + h * 128 + col0);
    T.g = G[(size_t)row * 32 + h]; T.b = BETA[(size_t)row * 32 + h];
}
__device__ __forceinline__ f32x2 tok_step(f32x2 (&S)[8], const Tok& T) {
    const float kk[8] = {T.k0.x, T.k0.y, T.k0.z, T.k0.w, T.k1.x, T.k1.y, T.k1.z, T.k1.w};
    const float qq[8] = {T.q0.x, T.q0.y, T.q0.z, T.q0.w, T.q1.x, T.q1.y, T.q1.z, T.q1.w};
    const float a = __expf(T.g);
    f32x2 d0 = S[0] * kk[0], d1 = S[1] * kk[1];
#pragma unroll
    for (int i = 2; i < 8; i += 2) { d0 += S[i] * kk[i]; d1 += S[i + 1] * kk[i + 1]; }
    f32x2 d = d0 + d1;
    d.x = row16_sum(d.x); d.y = row16_sum(d.y);
    const f32x2 tv = {bflo(T.v), bfhi(T.v)};
    const f32x2 dl = (tv - d * a) * T.b;
    f32x2 o0 = {0.f, 0.f}, o1 = {0.f, 0.f};
#pragma unroll
    for (int i = 0; i < 8; i += 2) { S[i] = S[i] * a + dl * kk[i]; o0 += S[i] * qq[i]; S[i + 1] = S[i + 1] * a + dl * kk[i + 1]; o1 += S[i + 1] * qq[i + 1]; }
    f32x2 o = o0 + o1;
    o.x = row16_sum(o.x); o.y = row16_sum(o.y);
    return o;
}
constexpr int DBK = 2;
__device__ __forceinline__ void delta_segment(f32x2 (&S)[8], const float* QKF, const bf16* QKVC, const float* G, const float* BETA, float* OF, int rowbase, int ntok, int h, int rg, int col0) {
    Tok A[DBK], B[DBK];
#pragma unroll
    for (int i = 0; i < DBK; ++i) tok_load(A[i], QKF, QKVC, G, BETA, rowbase + i, h, rg, col0);
    for (int t0 = 0; t0 < ntok; t0 += 2 * DBK) {
        f32x2 o[DBK];
#pragma unroll
        for (int i = 0; i < DBK; ++i) tok_load(B[i], QKF, QKVC, G, BETA, rowbase + t0 + DBK + i, h, rg, col0);
#pragma unroll
        for (int i = 0; i < DBK; ++i) o[i] = tok_step(S, A[i]);
        if (rg == 0) {
#pragma unroll
            for (int i = 0; i < DBK; ++i) *(f32x2*)(OF + (size_t)(rowbase + t0 + i) * DVW + h * 128 + col0) = o[i]; }
        if (t0 + 2 * DBK < ntok) {
#pragma unroll
            for (int i = 0; i < DBK; ++i) tok_load(A[i], QKF, QKVC, G, BETA, rowbase + t0 + 2 * DBK + i, h, rg, col0); }
#pragma unroll
        for (int i = 0; i < DBK; ++i) o[i] = tok_step(S, B[i]);
        if (rg == 0) {
#pragma unroll
            for (int i = 0; i < DBK; ++i) *(f32x2*)(OF + (size_t)(rowbase + t0 + DBK + i) * DVW + h * 128 + col0) = o[i]; }
    }
}
__device__ __forceinline__ void delta_phase(const Ptrs& P, int wave, int lane) {
    unsigned char* ws = P.ws;
    const bf16* QKVC = (const bf16*)(ws + WS_QKVC); const float* QKF = (const float*)(ws + WS_QKF); const float* G = (const float*)(ws + WS_G); const float* BETA = (const float*)(ws + WS_BETA); float* OF = (float*)(ws + WS_SC);
    const int cg = lane >> 4, rg = lane & 15;
    {
        for (int item = blockIdx.x * 8 + wave; item < SBN * 32 * 16; item += gridDim.x * 8) {
            const int sb = item >> 9, h = (item >> 4) & 31, col0 = 8 * (item & 15) + 2 * cg;
            const size_t so = ((size_t)((sb * 32 + h) * 128 + 8 * rg)) * 128 + col0;
            f32x2 S[8];
#pragma unroll
            for (int i = 0; i < 8; ++i) S[i] = *(const f32x2*)(P.state_delta + so + (size_t)i * 128);
            Tok T; tok_load(T, QKF, QKVC, G, BETA, SROW0 + sb, h, rg, col0);
            const f32x2 o = tok_step(S, T);
            if (rg == 0) *(f32x2*)(OF + (size_t)(SROW0 + sb) * DVW + h * 128 + col0) = o;
            float* op = P.out + O_DS + so;
#pragma unroll
            for (int i = 0; i < 8; ++i) *(f32x2*)(op + (size_t)i * 128) = S[i];
        }
    }
}
__device__ __forceinline__ void normC_phase(const bf16* PROJC, bf16* Y, const Ptrs& P, int gw, int NGW, int lane) {
    const float* OF = (const float*)(P.ws + WS_SC);
    const int d0 = 8 * (lane & 15);
    float nw[8];
    { const f32x4 a = *(const f32x4*)(P.norm_w + d0), b = *(const f32x4*)(P.norm_w + d0 + 4); nw[0] = a.x; nw[1] = a.y; nw[2] = a.z; nw[3] = a.w; nw[4] = b.x; nw[5] = b.y; nw[6] = b.z; nw[7] = b.w; }
    for (int r = gw; r < NROWS; r += NGW) {
        f32x4 oa[8], ob[8]; v4u zz[8];
#pragma unroll
        for (int it = 0; it < 8; ++it) { const int hd = it * 4 + (lane >> 4); const float* op = OF + (size_t)r * DVW + hd * 128 + d0;
            oa[it] = *(const f32x4*)op; ob[it] = *(const f32x4*)(op + 4); zz[it] = *(const v4u*)(PROJC + (size_t)r * NC_PAD + 8192 + hd * 128 + d0); }
#pragma unroll
        for (int it = 0; it < 8; ++it) {
            const int hd = it * 4 + (lane >> 4);
            float o[8] = {oa[it].x, oa[it].y, oa[it].z, oa[it].w, ob[it].x, ob[it].y, ob[it].z, ob[it].w};
            float ss = 0.f;
#pragma unroll
            for (int i = 0; i < 8; ++i) ss += o[i] * o[i];
            ss = row16_sum(ss);
            const float rs = 1.f / sqrtf(ss * (1.f / 128.f) + RMS_EPS);
            float z[8]; unpack8(zz[it], z);
#pragma unroll
            for (int i = 0; i < 8; ++i) o[i] = o[i] * rs * nw[i] * silu_f(z[i]);
            *(v4u*)(Y + (size_t)r * DVW + hd * 128 + d0) = pack8(o);
        }
    }
}


__device__ __forceinline__ void dense_attn_phase(const Ptrs& P, bf16* O, char* lds, int wv) {
    unsigned char* ws = P.ws;
    const bf16* Qr = (const bf16*)(ws + WS_QR); const bf16* Ks = (const bf16*)(ws + WS_KS); const bf16* Vs = (const bf16*)(ws + WS_VS);
    const unsigned long long* MASK = (const unsigned long long*)(ws + WS_MASK);
    typedef dattn::BlockRef<bf16, bf16> BR;
    for (int it0 = blockIdx.x; it0 < 256; it0 += gridDim.x) {
        const int grp = it0 & 7, idx = it0 >> 3;
        const int b = grp >> 2, kvh = grp & 3, h = kvh * 4 + (idx >> 3), x = idx & 7;
        BR A, B;
        const int qa = 1 + x, qb = 16 - x;
        A.Q = Qr + ((size_t)(b * SEQ + 256 * (qa - 1))) * DM + h * 128; A.O = O + ((size_t)(b * SEQ + 256 * (qa - 1))) * DM + h * 128;
        B.Q = Qr + ((size_t)(b * SEQ + 256 * (qb - 1))) * DM + h * 128; B.O = O + ((size_t)(b * SEQ + 256 * (qb - 1))) * DM + h * 128;
        A.K = B.K = Ks + (size_t)b * SP * 512 + kvh * 128; A.V = B.V = Vs + (size_t)b * SP * 512 + kvh * 128;
        A.P0 = 256 * qa; B.P0 = 256 * qb;
        A.M = MASK + ((size_t)(b * SP + A.P0)) * MTW; B.M = MASK + ((size_t)(b * SP + B.P0)) * MTW;
        dattn::Seam<bf16> S;
        dattn::causal_swa_prime<bf16, bf16>(A, SP, lds, S, wv);
        dattn::causal_swa_block<bf16, bf16>(A, B, SP, SP, lds, S, wv);
        dattn::causal_swa_block<bf16, bf16>(B, B, SP, SP, lds, S, wv);
    }
}

constexpr int NCH = 65, CPAD = 48;
constexpr int NUQ = NBP * 16 * NCH, NUH = NBP * 32 * NCH;
__device__ __forceinline__ int crow32(int r, int hi) { return (r & 3) + 8 * (r >> 2) + 4 * hi; }
__device__ __forceinline__ int chunk_row(int b, int c, int i) { const int t = 64 * c + i - CPAD; return t >= 0 ? prow(b, t) : -1; }
__device__ __forceinline__ float incl_scan64(float v, int lane) {
#pragma unroll
    for (int o = 1; o < 64; o <<= 1) { const float u = __shfl_up(v, o); if (lane >= o) v += u; }
    return v;
}
#define MFMA32(a, b, c) __builtin_amdgcn_mfma_f32_32x32x16_bf16((a), (b), (c), 0, 0, 0)
__device__ __forceinline__ bf16x8 sel8(bool ok, bf16x8 v) { const bf16x8 z = {0, 0, 0, 0, 0, 0, 0, 0}; return ok ? v : z; }
__device__ __forceinline__ int sw23(int x) { return (x & ~12) | ((x & 4) << 1) | ((x & 8) >> 1); }
__device__ __forceinline__ int fidx64(int row, int xs) { return ((((row >> 5) * 2 + (xs >> 5)) * 2 + ((xs >> 4) & 1)) * 64 + (row & 31) + 32 * ((xs >> 3) & 1)) * 8 + (xs & 7); }

__device__ __forceinline__ v4u pack_frag(const f32x16& x, int s) { v4u w; w.x = pk2(x[8 * s], x[8 * s + 1]); w.y = pk2(x[8 * s + 2], x[8 * s + 3]); w.z = pk2(x[8 * s + 4], x[8 * s + 5]); w.w = pk2(x[8 * s + 6], x[8 * s + 7]); return w; }
__device__ __forceinline__ void delta_d1_unit(unsigned char* ws, LAS unsigned char* lds, int uq, int wave, int lane) {
    asm volatile("" : "+v"(lane));
    const bf16* QKVC = (const bf16*)(ws + WS_QKVC); const float* G = (const float*)(ws + WS_G); const float* BETA = (const float*)(ws + WS_BETA);
    float* AF = (float*)(ws + WS_DAF); bf16* PG = (bf16*)(ws + WS_DPG); bf16* KT = (bf16*)(ws + WS_DKT); bf16* VT = (bf16*)(ws + WS_DVT);
    float* GC = (float*)(ws + WS_DGC); float* BT = (float*)(ws + WS_DBT);
    LAS float* lg = (LAS float*)(lds + wave * 1024);
    const int m = lane & 31, half = lane >> 5;
    const bf16x8 zf = {0, 0, 0, 0, 0, 0, 0, 0};
    {
        const int c = uq % NCH, bh = uq / NCH, hq = bh & 15, b = bh >> 4;
        { const int row = chunk_row(b, c, lane);
#pragma unroll
          for (int hh = 0; hh < 2; ++hh) { const int h = 2 * hq + hh; const float g = row >= 0 ? G[(size_t)row * 32 + h] : 0.f, bt = row >= 0 ? BETA[(size_t)row * 32 + h] : 0.f;
              const float gc = incl_scan64(g, lane); lg[hh * 64 + lane] = gc; lg[128 + hh * 64 + lane] = bt;
              const size_t uh = ((size_t)(b * 32 + h)) * NCH + c; GC[uh * 64 + lane] = gc; BT[uh * 64 + lane] = bt; } }
        const int row0 = chunk_row(b, c, m), row1 = chunk_row(b, c, 32 + m);
        const bf16* r0 = QKVC + (size_t)(row0 < 0 ? 0 : row0) * CDIM; const bf16* r1 = QKVC + (size_t)(row1 < 0 ? 0 : row1) * CDIM;
        f32x16 kk00, kk10, kk11, qk00, qk10, qk11;
#pragma unroll
        for (int i = 0; i < 16; ++i) { kk00[i] = 0.f; kk10[i] = 0.f; kk11[i] = 0.f; qk00[i] = 0.f; qk10[i] = 0.f; qk11[i] = 0.f; }
        const int sm = sw23(m);
        bf16* kt0 = KT + (size_t)uq * 128 * 64 + half * 32 + ((sm >> 4) & 1) * 512 + ((sm >> 3) & 1) * 256 + (sm & 7);
#pragma unroll 1
        for (int kh = 0; kh < 2; ++kh) {
            bf16x8 kf0[4], kf1[4], qf0[4], qf1[4];
#pragma unroll
            for (int u = 0; u < 4; ++u) { const int off = hq * 128 + 16 * (4 * kh + u) + 8 * half;
                kf0[u] = sel8(row0 >= 0, *(const bf16x8*)(r0 + 2048 + off)); kf1[u] = sel8(row1 >= 0, *(const bf16x8*)(r1 + 2048 + off));
                qf0[u] = sel8(row0 >= 0, *(const bf16x8*)(r0 + off)); qf1[u] = sel8(row1 >= 0, *(const bf16x8*)(r1 + off)); }
#pragma unroll
            for (int u = 0; u < 4; ++u) { const int ks = 4 * kh + u; const bf16x8 k0 = kf0[u], k1 = kf1[u], q0 = qf0[u], q1 = qf1[u];
                kk00 = MFMA32(k0, k0, kk00); kk10 = MFMA32(k1, k0, kk10); kk11 = MFMA32(k1, k1, kk11);
                qk00 = MFMA32(q0, k0, qk00); qk10 = MFMA32(q1, k0, qk10); qk11 = MFMA32(q1, k1, qk11);
                bf16* kb = kt0 + (ks >> 1) * 2048 + (ks & 1) * 128;
#pragma unroll
                for (int e = 0; e < 8; ++e) { kb[(8 * (e >> 2) + (e & 3)) * 8] = (bf16)k0[e]; kb[1024 + (8 * (e >> 2) + (e & 3)) * 8] = (bf16)k1[e]; } }
        }
#pragma unroll 1
        for (int hh = 0; hh < 2; ++hh) { const int h = 2 * hq + hh; bf16* vt = VT + (((size_t)(b * 32 + h)) * NCH + c) * 128 * 64 + half * 512 + sm;
            bf16x8 vf0[8], vf1[8];
#pragma unroll
            for (int ks = 0; ks < 8; ++ks) { const int off = 4096 + h * 128 + 16 * ks + 8 * half; vf0[ks] = sel8(row0 >= 0, *(const bf16x8*)(r0 + off)); vf1[ks] = sel8(row1 >= 0, *(const bf16x8*)(r1 + off)); }
#pragma unroll
            for (int ks = 0; ks < 8; ++ks) {
#pragma unroll
                for (int e = 0; e < 8; ++e) { vt[ks * 1024 + e * 64] = (bf16)vf0[ks][e]; vt[ks * 1024 + e * 64 + 32] = (bf16)vf1[ks][e]; } } }
        WAVE_SYNC();
#pragma unroll 1
        for (int hh = 0; hh < 2; ++hh) { const int h = 2 * hq + hh; const size_t uh = ((size_t)(b * 32 + h)) * NCH + c;
            float* af = AF + uh * 4096 + half * 256 + m;
            bf16* pg = PG + uh * 4096 + half * 32 + ((sm >> 4) & 1) * 512 + ((sm >> 3) & 1) * 256 + (sm & 7);
            const float gcj0 = lg[hh * 64 + m], gcj1 = lg[hh * 64 + 32 + m];
#pragma unroll
            for (int r = 0; r < 16; ++r) { const int ir = crow32(r, half), rc = (r & 3) + 8 * (r >> 2);
                const float gi0 = lg[hh * 64 + ir], gi1 = lg[hh * 64 + 32 + ir], bi0 = lg[128 + hh * 64 + ir], bi1 = lg[128 + hh * 64 + 32 + ir];
                { const int i = ir, j = m; const float dec = __expf(fminf(gi0 - gcj0, 0.f)); af[rc * 64] = (j < i) ? bi0 * dec * kk00[r] : 0.f; pg[rc * 8] = f2bf((j <= i) ? dec * qk00[r] : 0.f); }
                { const int i = 32 + ir, j = m; const float dec = __expf(fminf(gi1 - gcj0, 0.f)); af[2048 + rc * 64] = bi1 * dec * kk10[r]; pg[2048 + rc * 8] = f2bf(dec * qk10[r]); }
                { const int i = 32 + ir, j = 32 + m; const float dec = __expf(fminf(gi1 - gcj1, 0.f)); af[2048 + 32 + rc * 64] = (j < i) ? bi1 * dec * kk11[r] : 0.f; pg[2048 + 1024 + rc * 8] = f2bf((j <= i) ? dec * qk11[r] : 0.f); }
            } }
        WAVE_SYNC();
    }
}
__device__ __forceinline__ void delta_d2_unit(unsigned char* ws, int uh, int lane) {
    asm volatile("" : "+v"(lane));
    const float* AF = (const float*)(ws + WS_DAF); const float* GC = (const float*)(ws + WS_DGC); const float* BT = (const float*)(ws + WS_DBT);
    bf16* TG = (bf16*)(ws + WS_DTG); bf16* TB = (bf16*)(ws + WS_DTB);
    {
        const float* af = AF + (size_t)uh * 4096;
        const float bc = BT[(size_t)uh * 64 + lane], gmc = __expf(GC[(size_t)uh * 64 + lane]);
        float T[64];
        const bool pad0 = (uh % NCH) == 0;
#pragma unroll
        for (int i0 = 0; i0 < 64; i0 += 32) {
            float ar[32];
#pragma unroll
            for (int u = 0; u < 32; ++u) ar[u] = af[(i0 + u) * 64 + lane];
            if (pad0 && i0 == 0) {
#pragma unroll
                for (int u = 0; u < 32; ++u) T[u] = (lane == u) ? 1.f : 0.f;
            } else {
#pragma unroll
                for (int u = 0; u < 32; ++u) { const int i = i0 + u; float pa[4] = {(lane == i) ? 1.f : 0.f, 0.f, 0.f, 0.f};
#pragma unroll
                    for (int j = 0; j < i; ++j) pa[j & 3] -= __int_as_float(__builtin_amdgcn_readlane(__float_as_int(ar[u]), j)) * T[j];
                    T[i] = (pa[0] + pa[1]) + (pa[2] + pa[3]); }
            }
        }
        bf16* tg = TG + (size_t)uh * 4096; bf16* tb = TB + (size_t)uh * 4096;
        const float sg = bc * gmc;
        const int cs = (lane & ~31) + sw23(lane & 31);
#pragma unroll
        for (int i = 0; i < 64; ++i) { tg[i * 64 + cs] = f2bf(T[i] * sg); tb[i * 64 + cs] = f2bf(T[i] * bc); }
    }
}
__device__ __forceinline__ void delta_d3_unit(unsigned char* ws, int uh, int lane) {
    asm volatile("" : "+v"(lane));
    const bf16* TG = (const bf16*)(ws + WS_DTG); const bf16* TB = (const bf16*)(ws + WS_DTB); const bf16* KT = (const bf16*)(ws + WS_DKT); const bf16* VT = (const bf16*)(ws + WS_DVT);
    bf16* WG = (bf16*)(ws + WS_DWG); bf16* UG = (bf16*)(ws + WS_DUG);
    const int m = lane & 31, half = lane >> 5;
    const int c = uh % NCH, bh = uh / NCH, h = bh & 31, b = bh >> 5;
    const size_t uq = ((size_t)(b * 16 + (h >> 1))) * NCH + c;
    {
        const bf16* Tm = TG + (size_t)uh * 4096; const bf16* Kf = KT + uq * 8192;
        f32x16 acc[4][2];
#pragma unroll
        for (int dn = 0; dn < 4; ++dn)
#pragma unroll
            for (int ti = 0; ti < 2; ++ti)
#pragma unroll
                for (int i = 0; i < 16; ++i) acc[dn][ti][i] = 0.f;
#pragma unroll
        for (int ks = 0; ks < 4; ++ks) {
            bf16x8 a[4], bb[2];
#pragma unroll
            for (int dn = 0; dn < 4; ++dn) a[dn] = *(const bf16x8*)(Kf + ((size_t)(((dn * 2 + (ks >> 1)) * 2 + (ks & 1)) * 64 + lane)) * 8);
#pragma unroll
            for (int ti = 0; ti < 2; ++ti) bb[ti] = *(const bf16x8*)(Tm + (32 * ti + m) * 64 + 16 * ks + 8 * half);
#pragma unroll
            for (int dn = 0; dn < 4; ++dn)
#pragma unroll
                for (int ti = 0; ti < 2; ++ti) acc[dn][ti] = MFMA32(a[dn], bb[ti], acc[dn][ti]);
        }
        bf16* wg = WG + (size_t)uh * 8192;
#pragma unroll
        for (int dn = 0; dn < 4; ++dn)
#pragma unroll
            for (int ti = 0; ti < 2; ++ti)
#pragma unroll
                for (int s2 = 0; s2 < 2; ++s2) *(v4u*)(wg + ((size_t)(((ti * 4 + dn) * 2 + s2) * 64 + lane)) * 8) = pack_frag(acc[dn][ti], s2);
    }
    {
        const bf16* Tm = TB + (size_t)uh * 4096; const bf16* Bt = VT + (size_t)uh * 8192;
        f32x16 acc[2][4];
#pragma unroll
        for (int ti = 0; ti < 2; ++ti)
#pragma unroll
            for (int dn = 0; dn < 4; ++dn)
#pragma unroll
                for (int i = 0; i < 16; ++i) acc[ti][dn][i] = 0.f;
#pragma unroll
        for (int ks = 0; ks < 4; ++ks) {
            bf16x8 a[2], bb[4];
#pragma unroll
            for (int ti = 0; ti < 2; ++ti) a[ti] = *(const bf16x8*)(Tm + (32 * ti + m) * 64 + 16 * ks + 8 * half);
#pragma unroll
            for (int dn = 0; dn < 4; ++dn) bb[dn] = *(const bf16x8*)(Bt + (32 * dn + m) * 64 + 16 * ks + 8 * half);
#pragma unroll
            for (int ti = 0; ti < 2; ++ti)
#pragma unroll
                for (int dn = 0; dn < 4; ++dn) acc[ti][dn] = MFMA32(a[ti], bb[dn], acc[ti][dn]);
        }
        bf16* ug = UG + (size_t)uh * 8192;
#pragma unroll
        for (int ti = 0; ti < 2; ++ti)
#pragma unroll
            for (int dn = 0; dn < 4; ++dn) { bf16* p = ug + ((size_t)((ti * 4 + dn) * 64 + lane)) * 16; *(v4u*)p = pack_frag(acc[ti][dn], 0); *(v4u*)(p + 8) = pack_frag(acc[ti][dn], 1); }
    }
}
__device__ __forceinline__ void delta_pre(unsigned char* ws, LAS unsigned char* lds, int gw, int NGW, int wave, int lane) {
    for (int uq = gw; uq < NUQ; uq += NGW) {
#ifndef NO_D1
        delta_d1_unit(ws, lds, uq, wave, lane);
#endif
        asm volatile("s_waitcnt vmcnt(0)" ::: "memory");
        const int c = uq % NCH, bh = uq / NCH, hq = bh & 15, b = bh >> 4;
#pragma unroll 1
        for (int hh = 0; hh < 2; ++hh) { const int uh = (b * 32 + 2 * hq + hh) * NCH + c;
#ifndef NO_D2
            delta_d2_unit(ws, uh, lane);
#endif
            asm volatile("s_waitcnt vmcnt(0)" ::: "memory");
#ifndef NO_D3
            delta_d3_unit(ws, uh, lane);
#endif
        }
    }
}
__device__ __forceinline__ bf16x8 afrag_perm(const bf16* rowp, int blk, int s, int half) {
    const v2u lo = *(const v2u*)(rowp + 32 * blk + 16 * s + 4 * half), hi2 = *(const v2u*)(rowp + 32 * blk + 16 * s + 8 + 4 * half);
    v4u w; w.x = lo.x; w.y = lo.y; w.z = hi2.x; w.w = hi2.y; return __builtin_bit_cast(bf16x8, w);
}
#define LBAR() asm volatile("s_waitcnt lgkmcnt(0)\n\ts_barrier" ::: "memory")
__device__ __forceinline__ void delta_d4(unsigned char* ws, float* out_state, LAS unsigned char* lds, int tid, int wave, int lane) {
    const bf16* QKVC = (const bf16*)(ws + WS_QKVC); const bf16* KT = (const bf16*)(ws + WS_DKT); const bf16* PG = (const bf16*)(ws + WS_DPG);
    const bf16* WG = (const bf16*)(ws + WS_DWG); const bf16* UG = (const bf16*)(ws + WS_DUG); const float* GC = (const float*)(ws + WS_DGC);
    float* OF = (float*)(ws + WS_SC);
    LAS v4u* Sfr = (LAS v4u*)lds;
    LAS v4u* Dfr = (LAS v4u*)(lds + 16384);
    LAS v4u* Dtf = (LAS v4u*)(lds + 16384 + 4096);
    LAS float* gam = (LAS float*)(lds + 16384 + 8192);
    const int m = lane & 31, half = lane >> 5;
    const bf16x8 zf = {0, 0, 0, 0, 0, 0, 0, 0};
    for (int item = blockIdx.x; item < NBP * 32 * 4; item += gridDim.x) {
        const int q = item & 3, bh = item >> 2, h = bh & 31, b = bh >> 5;
        const size_t uh0 = ((size_t)(b * 32 + h)) * NCH, uq0 = ((size_t)(b * 16 + (h >> 1))) * NCH;
        const int rt = wave & 1; const bool isq = wave >= 6;
        f32x16 S;
#pragma unroll
        for (int i = 0; i < 16; ++i) S[i] = 0.f;
        bf16x8 afr[8], afn[8], xfr[4], xfn[4]; float gcn = 0.f;
#pragma unroll
        for (int i = 0; i < 8; ++i) { afr[i] = zf; afn[i] = zf; }
#pragma unroll
        for (int i = 0; i < 4; ++i) { xfr[i] = zf; xfn[i] = zf; }
#define LOAD_NEXT(cc) do { if (wave < 4) { const bf16* kr_ = KT + (uq0 + (cc)) * 8192; \
                _Pragma("unroll") for (int blk = 0; blk < 2; ++blk) _Pragma("unroll") for (int s_ = 0; s_ < 2; ++s_) afn[blk * 2 + s_] = *(const bf16x8*)(kr_ + ((size_t)(((wave * 2 + blk) * 2 + s_) * 64 + lane)) * 8); } \
            else { const int row_ = chunk_row(b, (cc), 32 * rt + m); const bool ok_ = !isq || row_ >= 0; \
                  \
                const bf16* ab_ = isq ? QKVC + (size_t)(row_ < 0 ? 0 : row_) * CDIM + (h >> 1) * 128 + 8 * half : WG + (uh0 + (cc)) * 8192 + ((size_t)(rt * 512 + lane)) * 8; \
                const int sb_ = isq ? 32 : 1024, ss_ = isq ? 16 : 512; \
                _Pragma("unroll") for (int blk = 0; blk < 4; ++blk) _Pragma("unroll") for (int s_ = 0; s_ < 2; ++s_) afn[blk * 2 + s_] = sel8(ok_, *(const bf16x8*)(ab_ + blk * sb_ + s_ * ss_)); \
                const bf16* xb_ = isq ? PG + (uh0 + (cc)) * 4096 + ((size_t)(rt * 256 + lane)) * 8 : UG + (uh0 + (cc)) * 8192 + ((size_t)((rt * 4 + q) * 64 + lane)) * 16; \
                  \
                if (isq) { _Pragma("unroll") for (int blk = 0; blk < 2; ++blk) _Pragma("unroll") for (int s_ = 0; s_ < 2; ++s_) xfn[blk * 2 + s_] = sel8(blk <= rt, *(const bf16x8*)(xb_ + blk * 1024 + s_ * 512)); } \
                else { xfn[0] = *(const bf16x8*)xb_; xfn[1] = *(const bf16x8*)(xb_ + 8); if (wave == 4) gcn = GC[(uh0 + (cc)) * 64 + lane]; } } } while (0)
#define ROTATE() do { _Pragma("unroll") for (int i_ = 0; i_ < 8; ++i_) afr[i_] = afn[i_]; _Pragma("unroll") for (int i_ = 0; i_ < 4; ++i_) xfr[i_] = xfn[i_]; } while (0)
        LBAR();
        if (wave < 4) { const v4u z = {0u, 0u, 0u, 0u}; Sfr[(0 * 4 + wave) * 128 + lane] = z; Sfr[(0 * 4 + wave) * 128 + 64 + lane] = z; }
        if (wave == 4) { const float gc = GC[(uh0 + 0) * 64 + lane], gl = __shfl(gc, 63); gam[lane] = __expf(gc); gam[128 + lane] = __expf(gl - gc); }
        LOAD_NEXT(0); ROTATE();
        for (int c = 0; c < NCH; ++c) {
            const int bufc = c & 1;
            const size_t uh = uh0 + c, uq = uq0 + c;
            LBAR();
            f32x16 acc;
            if (c + 1 < NCH) LOAD_NEXT(c + 1);
            if (wave >= 4) {
                f32x16 acc2;
#pragma unroll
                for (int i = 0; i < 16; ++i) { acc[i] = 0.f; acc2[i] = 0.f; }
#pragma unroll
                for (int blk = 0; blk < 2; ++blk)
#pragma unroll
                    for (int s = 0; s < 2; ++s) { acc = MFMA32(afr[blk * 2 + s], __builtin_bit_cast(bf16x8, Sfr[(bufc * 4 + blk) * 128 + s * 64 + lane]), acc);
                        acc2 = MFMA32(afr[(blk + 2) * 2 + s], __builtin_bit_cast(bf16x8, Sfr[(bufc * 4 + blk + 2) * 128 + s * 64 + lane]), acc2); }
#pragma unroll
                for (int i = 0; i < 16; ++i) acc[i] += acc2[i];
                if (!isq) {
                    float uf[16]; { float t8[8]; unpack8(__builtin_bit_cast(v4u, xfr[0]), t8);
#pragma unroll
                        for (int i = 0; i < 8; ++i) uf[i] = t8[i]; unpack8(__builtin_bit_cast(v4u, xfr[1]), t8);
#pragma unroll
                        for (int i = 0; i < 8; ++i) uf[8 + i] = t8[i]; }
                    f32x16 dt;
#pragma unroll
                    for (int r = 0; r < 16; ++r) { acc[r] = uf[r] - acc[r]; dt[r] = acc[r] * gam[128 + bufc * 64 + 32 * rt + crow32(r, half)]; }
#pragma unroll
                    for (int s = 0; s < 2; ++s) { Dfr[(rt * 2 + s) * 64 + lane] = pack_frag(acc, s); Dtf[(rt * 2 + s) * 64 + lane] = pack_frag(dt, s); }
                }
            }
            LBAR();
            if (wave < 4) {
                const float gl = gam[bufc * 64 + 63];
                f32x16 s2;
#pragma unroll
                for (int i = 0; i < 16; ++i) { S[i] *= gl; s2[i] = 0.f; }
#pragma unroll
                for (int s = 0; s < 2; ++s) { S = MFMA32(afr[s], __builtin_bit_cast(bf16x8, Dtf[s * 64 + lane]), S); s2 = MFMA32(afr[2 + s], __builtin_bit_cast(bf16x8, Dtf[(2 + s) * 64 + lane]), s2); }
#pragma unroll
                for (int i = 0; i < 16; ++i) S[i] += s2[i];
#pragma unroll
                for (int s = 0; s < 2; ++s) Sfr[((bufc ^ 1) * 4 + wave) * 128 + s * 64 + lane] = pack_frag(S, s);
            } else if (isq) {
#pragma unroll
                for (int r = 0; r < 16; ++r) acc[r] *= gam[bufc * 64 + 32 * rt + crow32(r, half)];
#pragma unroll
                for (int blk = 0; blk < 2; ++blk)
#pragma unroll
                    for (int s = 0; s < 2; ++s) acc = MFMA32(xfr[blk * 2 + s], __builtin_bit_cast(bf16x8, Dfr[(blk * 2 + s) * 64 + lane]), acc);
#pragma unroll
                for (int r = 0; r < 16; ++r) { const int row = chunk_row(b, c, 32 * rt + crow32(r, half)); if (row >= 0) OF[(size_t)row * DVW + h * 128 + 32 * q + m] = acc[r]; }
            } else if (wave == 4 && c + 1 < NCH) {
                const float gl = __shfl(gcn, 63); gam[(bufc ^ 1) * 64 + lane] = __expf(gcn); gam[128 + (bufc ^ 1) * 64 + lane] = __expf(gl - gcn);
            }
            ROTATE();
        }
        if (wave < 4) { float* o = out_state + ((size_t)((b * 32 + h) * 128 + 32 * wave)) * 128 + 32 * q + m;
#pragma unroll
            for (int r = 0; r < 16; ++r) o[(size_t)sw23(crow32(r, half)) * 128] = S[r]; }
#undef LOAD_NEXT
#undef ROTATE
    }
    LBAR();
}
#undef LBAR
#undef MFMA32
template <int RT, int CT, class Epi>
__device__ __forceinline__ void small_gemm_unit(const bf16* A, int lda, const bf16* Bt, int ldb, int k0, int klen, LAS unsigned char* lds, const Epi& E, int tid, int wave, int lane) {
    const int r16 = lane & 15, q = lane >> 4;
    const int kw = klen >> 3;
    const bf16* ap = A + (size_t)r16 * lda + k0 + wave * kw + 8 * q;
    const bf16* bp = Bt + (size_t)r16 * ldb + k0 + wave * kw + 8 * q;
    pg8::f32x4 acc[RT][CT];
#pragma unroll
    for (int i = 0; i < RT; ++i)
#pragma unroll
        for (int j = 0; j < CT; ++j) acc[i][j] = (pg8::f32x4){0.f, 0.f, 0.f, 0.f};
#pragma unroll 4
    for (int ks = 0; ks < kw; ks += 32) {
        bf16x8 a[RT], b[CT];
#pragma unroll
        for (int i = 0; i < RT; ++i) a[i] = *(const bf16x8*)(ap + (size_t)(16 * i) * lda + ks);
#pragma unroll
        for (int j = 0; j < CT; ++j) b[j] = *(const bf16x8*)(bp + (size_t)(16 * j) * ldb + ks);
#pragma unroll
        for (int i = 0; i < RT; ++i)
#pragma unroll
            for (int j = 0; j < CT; ++j) acc[i][j] = __builtin_amdgcn_mfma_f32_16x16x32_bf16(a[i], b[j], acc[i][j], 0, 0, 0);
    }
    constexpr int NOUT = 256 * RT * CT;
    LAS float* part = (LAS float*)lds + wave * NOUT;
#pragma unroll
    for (int i = 0; i < RT; ++i)
#pragma unroll
        for (int j = 0; j < CT; ++j)
#pragma unroll
            for (int e = 0; e < 4; ++e) part[(16 * i + 4 * q + e) * (16 * CT) + 16 * j + r16] = acc[i][j][e];
    __syncthreads();
    for (int o = tid; o < NOUT; o += NTHREADS) { float sum = 0.f;
#pragma unroll
        for (int w = 0; w < 8; ++w) sum += ((LAS float*)lds)[w * NOUT + o];
        E(o / (16 * CT), o % (16 * CT), sum); }
    __syncthreads();
}
template <int ACT> struct SEpiRowsBf16 { bf16* O; int ldc; __device__ __forceinline__ void operator()(int row, int col, float v) const { if (ACT == 2) { v = v > 0.f ? v : 0.f; v = v * v; } O[(size_t)row * ldc + col] = f2bf(v); } };
struct SEpiF32 { float* O; int ldc; __device__ __forceinline__ void operator()(int row, int col, float v) const { O[(size_t)row * ldc + col] = v; } };
struct SEpiColsBf16 { bf16* O; int ldc; __device__ __forceinline__ void operator()(int row, int col, float v) const { O[(size_t)col * ldc + row] = f2bf(v); } };
template <int ACT> __device__ __forceinline__ void skinny_rows_bf16(const bf16* A, const bf16* Wt, int K, int nunits, bf16* O, int ldc, LAS unsigned char* lds, int tid, int wave, int lane) {
    for (int u = blockIdx.x; u < nunits; u += gridDim.x) { SEpiRowsBf16<ACT> E{O + (size_t)XROW0 * ldc + u * 64, ldc};
        small_gemm_unit<3, 4>(A + (size_t)XROW0 * K, K, Wt + (size_t)u * 64 * K, K, 0, K, lds, E, tid, wave, lane); }
}
__device__ __forceinline__ void skinny_rows_part(const bf16* A, const bf16* Wt, int K, float* ZP, LAS unsigned char* lds, int tid, int wave, int lane) {
    for (int u = blockIdx.x; u < 256; u += gridDim.x) { const int cgp = u & 31, ksl = u >> 5; SEpiF32 E{ZP + (size_t)ksl * XR * DM + cgp * 64, DM};
        small_gemm_unit<3, 4>(A + (size_t)XROW0 * K, K, Wt + (size_t)cgp * 64 * K, K, ksl * (K >> 3), K >> 3, lds, E, tid, wave, lane); }
}
template <int RT> __device__ __forceinline__ void tail_cols_bf16(const bf16* A, const bf16* Wt, int K, int c0, bf16* O, int ldc, LAS unsigned char* lds, int tid, int wave, int lane) {
    for (int u = blockIdx.x; u < MAINM / 32; u += gridDim.x) { SEpiColsBf16 E{O + (size_t)u * 32 * ldc + c0, ldc};
        small_gemm_unit<RT, 2>(Wt + (size_t)c0 * K, K, A + (size_t)u * 32 * K, K, 0, K, lds, E, tid, wave, lane); }
}

typedef __attribute__((address_space(4))) const unsigned long long* kargq_t;
#define KPF_(k) ((const float*)(const GAS float*)(q_[k]))
__device__ __forceinline__ void load_ptrs(Ptrs& P) {
    kargq_t q_ = (kargq_t)__builtin_amdgcn_kernarg_segment_ptr();
    asm volatile("" : "+s"(q_));
    P.x_prompt = KPF_(0); P.x_sample = KPF_(1); P.state_conv_a = KPF_(2); P.cache_k = KPF_(3);
    P.cache_v = KPF_(4); P.cache_ik = KPF_(5); P.state_conv_c = KPF_(6); P.state_delta = KPF_(7);
    P.page_table = ((const int*)(const GAS int*)(q_[8])); P.meta = KPF_(9); P.w_in_a = KPF_(10); P.conv_w_a = KPF_(11);
    P.w_out_a = KPF_(12); P.w_in_b = KPF_(13); P.w_out_b = KPF_(14); P.w_in_c = KPF_(15);
    P.conv_w_c = KPF_(16); P.a_log = KPF_(17); P.dt_bias = KPF_(18); P.norm_w = KPF_(19);
    P.w_out_c = KPF_(20); P.ln1_g = KPF_(21); P.ln1_b = KPF_(22); P.w1 = KPF_(23);
    P.w2 = KPF_(24); P.ln2_g = KPF_(25); P.ln2_b = KPF_(26);
    P.out = (float*)(GAS float*)(q_[27]); P.ws = (unsigned char*)(GAS unsigned char*)(q_[28]);
}
struct Args { const void* in[27]; float* out; unsigned char* ws; int ph_lo, ph_hi; };
constexpr int PH_PER_LAYER = 12, PH_END = 1 + 4 * PH_PER_LAYER;

__global__ void __launch_bounds__(NTHREADS, 2) mega_fwd(Args args) {
    extern __shared__ __attribute__((aligned(16))) unsigned char lds_raw[];
    LAS unsigned char* lds = (LAS unsigned char*)lds_raw;
    const int tid = threadIdx.x, lane = tid & 63, wave = __builtin_amdgcn_readfirstlane(tid >> 6);
    const int G_ = gridDim.x, NGW = G_ * NWAVES, NT = G_ * NTHREADS; (void)lane;
    unsigned char* ws = args.ws;
    const int lo = args.ph_lo, hi = args.ph_hi;
    const bool fused = (hi - lo) > 1;

    for (int u = tid; u < (LDS_BYTES - LDSCTL_OFF) / 4; u += NTHREADS) ((LAS unsigned*)(lds + LDSCTL_OFF))[u] = 0u;
    __syncthreads();
    volatile LAS unsigned* MISC = (volatile LAS unsigned*)(lds + MISC_OFF);
    XcdBarrier bar; bar.bar = (unsigned*)(ws + WS_CTL) + CW_BAR; bar.x = 0; bar.st = nullptr;
    if (fused) bar = xcd_barrier_post((unsigned*)(ws + WS_CTL) + CW_BAR, MISC + 8);
    bar.wv = wave;

#ifndef MK_SITES
#define MK_SITES 0xffffffffu
#endif
#define SITE(n) (((MK_SITES) >> (n)) & 1u)
#define IN(k) (lo <= (k) && (k) < hi)
#ifndef MK_DUP
#define MK_DUP 0u
#endif
#define NREP(n) ((((MK_DUP) >> (n)) & 1u) ? 2 : 1)
#define BEGIN_SITE(n, id) if (SITE(n) && IN(id)) { for (int rp_ = 0; rp_ < NREP(n); ++rp_) { Ptrs P; load_ptrs(P); unsigned char* ws = P.ws; (void)ws; \
    bf16* X = (bf16*)(P.ws + WS_X); float* Z = (float*)(P.ws + WS_Z); float* ZP = (float*)(P.ws + WS_ZP); bf16* Y = (bf16*)(P.ws + WS_Y); bf16* BIG = (bf16*)(P.ws + WS_BIG); (void)X; (void)Z; (void)ZP; (void)Y; (void)BIG;
#define END_SITE(id) SEAM(id); } }
#define LOCALS int tid_ = threadIdx.x; asm volatile("" : "+v"(tid_)); const int lane_ = tid_ & 63, wave_ = __builtin_amdgcn_readfirstlane(tid_ >> 6), gw_ = blockIdx.x * NWAVES + wave_, gtid_ = blockIdx.x * NTHREADS + tid_; (void)lane_; (void)wave_; (void)gw_; (void)gtid_
#define SEAM(k) do { if (fused && (k) + 1 < PH_END) xcd_barrier(bar); else __syncthreads(); } while (0)


    BEGIN_SITE(0, 0) LOCALS; p0_prologue(P, lds, gw_, NGW, wave_, lane_); END_SITE(0)
#ifdef MK_XBAR
    if (fused) { for (int xb_ = 0; xb_ < MK_XBAR; ++xb_) xcd_barrier(bar); }
#endif

    for (int layer = 0; layer < 4; ++layer) {
        const int kind = layer % 3, j = layer / 3, base = 1 + layer * PH_PER_LAYER;
        if (kind == 0) {
            BEGIN_SITE(1, base + 0)
                const bf16* Wt = (const bf16*)(ws + WS_WA_IN + (size_t)j * WSZ_A_IN); pg8::Gemm g{X, Wt, MAINM, NA_IN, DM}; pg8::StaticOrder S; S.init(MAINM, NA_IN, G_, (int)blockIdx.x);
                pg8::EpiBf16<0> E{BIG, NA_IN, nullptr, 0, 0, 1.f};
                pg8::gemm_phase<pg8::EpiBf16<0>, pg8::StaticOrder, true, true>(lds, g, S, E, wave);
                { LOCALS; skinny_rows_bf16<0>(X, Wt, DM, NA_IN / 64, BIG, NA_IN, lds, tid_, wave_, lane_); }
                END_SITE(base + 0)
            BEGIN_SITE(2, base + 1)
                LOCALS; convA_phase(BIG, Y, P.conv_w_a + (size_t)j * 3 * DM, P.state_conv_a + (size_t)j * SBN * 2 * DM, P.out + O_CAP + (size_t)j * NBP * 2 * DM, P.out + O_CAS + (size_t)j * SBN * 2 * DM, gtid_, NT);
                END_SITE(base + 1)
            BEGIN_SITE(3, base + 2)
                const bf16* Wt = (const bf16*)(ws + WS_WA_OUT + (size_t)j * WSZ_A_OUT); pg8::Gemm g{Y, Wt, MAINM, DM, DM}; pg8::StaticOrder S; S.init(MAINM, DM, G_, (int)blockIdx.x);
                pg8::EpiResBf16 E{X, DM, ALPHA};
                pg8::gemm_phase<pg8::EpiResBf16, pg8::StaticOrder, true, true>(lds, g, S, E, wave);
                { LOCALS; skinny_rows_part(Y, Wt, DM, ZP, lds, tid_, wave_, lane_); }
                END_SITE(base + 2)
        } else if (kind == 1) {
            BEGIN_SITE(4, base + 0)
                const bf16* Wt = (const bf16*)(ws + WS_WB_IN); pg8::Gemm g{X, Wt, MAINM, 4096, DM}; pg8::StaticOrder S; S.init(MAINM, 4096, G_, (int)blockIdx.x);
                pg8::EpiBf16<0> E{BIG, NB_PAD, nullptr, 0, 0, 1.f};
                pg8::gemm_phase<pg8::EpiBf16<0>, pg8::StaticOrder, true, true>(lds, g, S, E, wave);
                { LOCALS; tail_cols_bf16<5>(X, Wt, DM, 4096, BIG, NB_PAD, lds, tid_, wave_, lane_); skinny_rows_bf16<0>(X, Wt, DM, 4224 / 64, BIG, NB_PAD, lds, tid_, wave_, lane_); }
                END_SITE(base + 0)
            BEGIN_SITE(5, base + 1) LOCALS; rope_phase(BIG, P, gw_, NGW, lane_); END_SITE(base + 1)
            BEGIN_SITE(6, base + 2) LOCALS; indexer_sample(P, lds, tid_); indexer_prompt(P, lds, tid_, wave_, lane_); END_SITE(base + 2)
            BEGIN_SITE(7, base + 3) LOCALS; select_phase(P, lds, gw_, NGW, tid_, wave_, lane_); END_SITE(base + 3)
            BEGIN_SITE(8, base + 4) LOCALS; dense_attn_phase(P, Y, (char*)lds_raw, wave_); attn_phase(P, Y, lds, gw_, NGW, wave_, lane_); END_SITE(base + 4)
            BEGIN_SITE(9, base + 5)
                const bf16* Wt = (const bf16*)(ws + WS_WB_OUT); pg8::Gemm g{Y, Wt, MAINM, DM, DM}; pg8::StaticOrder S; S.init(MAINM, DM, G_, (int)blockIdx.x);
                pg8::EpiResBf16 E{X, DM, ALPHA};
                pg8::gemm_phase<pg8::EpiResBf16, pg8::StaticOrder, true, true>(lds, g, S, E, wave);
                { LOCALS; skinny_rows_part(Y, Wt, DM, ZP, lds, tid_, wave_, lane_); }
                END_SITE(base + 5)
        } else {
            BEGIN_SITE(10, base + 0)
                const bf16* Wt = (const bf16*)(ws + WS_WC_IN); pg8::Gemm g{X, Wt, MAINM, 12288, DM}; pg8::StaticOrder S; S.init(MAINM, 12288, G_, (int)blockIdx.x);
                pg8::EpiBf16<0> E{BIG, NC_PAD, nullptr, 0, 0, 1.f};
                pg8::gemm_phase<pg8::EpiBf16<0>, pg8::StaticOrder, true, true>(lds, g, S, E, wave);
                { LOCALS; tail_cols_bf16<4>(X, Wt, DM, 12288, BIG, NC_PAD, lds, tid_, wave_, lane_); skinny_rows_bf16<0>(X, Wt, DM, NC_IN / 64, BIG, NC_PAD, lds, tid_, wave_, lane_); }
                END_SITE(base + 0)
            BEGIN_SITE(11, base + 1) LOCALS; convC_phase(BIG, P, gw_, NGW, lane_); END_SITE(base + 1)
            BEGIN_SITE(19, base + 2) LOCALS; delta_pre(P.ws, lds, gw_, NGW, wave_, lane_); delta_phase(P, wave_, lane_); END_SITE(base + 2)
            BEGIN_SITE(22, base + 5) LOCALS; delta_d4(P.ws, P.out + O_DP, lds, tid_, wave_, lane_); END_SITE(base + 5)
            BEGIN_SITE(13, base + 6) LOCALS; normC_phase(BIG, Y, P, gw_, NGW, lane_); END_SITE(base + 6)
            BEGIN_SITE(14, base + 7)
                const bf16* Wt = (const bf16*)(ws + WS_WC_OUT); pg8::Gemm g{Y, Wt, MAINM, DM, DVW}; pg8::StaticOrder S; S.init(MAINM, DM, G_, (int)blockIdx.x);
                pg8::EpiResBf16 E{X, DM, ALPHA};
                pg8::gemm_phase<pg8::EpiResBf16, pg8::StaticOrder, true, true>(lds, g, S, E, wave);
                { LOCALS; skinny_rows_part(Y, Wt, DVW, ZP, lds, tid_, wave_, lane_); }
                END_SITE(base + 7)
        }
        BEGIN_SITE(15, base + 8) LOCALS; ln_phase(Z, ZP, X, rp_ == 0 ? X : (bf16*)(P.ws + WS_QR), P.ln1_g + (size_t)layer * DM, P.ln1_b + (size_t)layer * DM, nullptr, nullptr, gw_, NGW, lane_); END_SITE(base + 8)
        BEGIN_SITE(16, base + 9)
            const bf16* Wt = (const bf16*)(ws + WS_W1 + (size_t)layer * WSZ_W1); pg8::Gemm g{X, Wt, MAINM, FF, DM}; pg8::StaticOrder S; S.init(MAINM, FF, G_, (int)blockIdx.x);
            pg8::EpiBf16<2> E{BIG, FF, nullptr, 0, 0, 1.f};
            pg8::gemm_phase<pg8::EpiBf16<2>, pg8::StaticOrder, true, true>(lds, g, S, E, wave);
            { LOCALS; skinny_rows_bf16<2>(X, Wt, DM, FF / 64, BIG, FF, lds, tid_, wave_, lane_); }
            END_SITE(base + 9)
        BEGIN_SITE(17, base + 10)
            const bf16* Wt = (const bf16*)(ws + WS_W2 + (size_t)layer * WSZ_W2); pg8::Gemm g{BIG, Wt, MAINM, DM, FF}; pg8::StaticOrder S; S.init(MAINM, DM, G_, (int)blockIdx.x);
            pg8::EpiResBf16 E{X, DM, ALPHA};
            pg8::gemm_phase<pg8::EpiResBf16, pg8::StaticOrder, true, true>(lds, g, S, E, wave);
            { LOCALS; skinny_rows_part(BIG, Wt, FF, ZP, lds, tid_, wave_, lane_); }
            END_SITE(base + 10)
        BEGIN_SITE(18, base + 11)
            const bool last = layer == 3;
            LOCALS; ln_phase(Z, ZP, X, rp_ == 0 ? X : (bf16*)(P.ws + WS_QR), P.ln2_g + (size_t)layer * DM, P.ln2_b + (size_t)layer * DM, last ? P.out + O_YP : nullptr, last ? P.out + O_YS : nullptr, gw_, NGW, lane_);
            if (!last) SEAM(base + 11); } }
    }
#undef IN
#undef SEAM
}

#ifndef MK_SPLIT
#define MK_SPLIT 0
#endif
extern "C" void kernel_launch(void* const* d_in, const int* in_sizes, int n_in, void* d_out, int out_size, void* d_ws, size_t ws_size, hipStream_t stream) {
    static int grid = 0;
    if (grid == 0) {
        if (n_in != 27 || (size_t)out_size != O_END || ws_size < WS_END) { fprintf(stderr, "kernel_launch: unexpected shapes: n_in %d out %d (want %zu) ws %zu (want >= %zu)\n", n_in, out_size, (size_t)O_END, ws_size, (size_t)WS_END); grid = -1; return; }
        int dev = 0, cus = 0;
        if (hipGetDevice(&dev) != hipSuccess || hipDeviceGetAttribute(&cus, hipDeviceAttributeMultiprocessorCount, dev) != hipSuccess) { grid = -1; return; }
        if (hipFuncSetAttribute((const void*)mega_fwd, hipFuncAttributeMaxDynamicSharedMemorySize, LDS_BYTES) != hipSuccess) { fprintf(stderr, "kernel_launch: hipFuncSetAttribute failed\n"); grid = -1; return; }
        int per_cu = 0;
        if (hipOccupancyMaxActiveBlocksPerMultiprocessor(&per_cu, (const void*)mega_fwd, NTHREADS, LDS_BYTES) != hipSuccess || per_cu < 1) fprintf(stderr, "kernel_launch: occupancy query reports %d\n", per_cu);
        (void)hipGetLastError();
        grid = cus;
    }
    if (grid < 0) return;
    (void)hipMemsetAsync((char*)d_ws + WS_CTL, 0, CTL_ZERO_BYTES, stream);
    Args a{};
    for (int i = 0; i < 27; ++i) a.in[i] = d_in[i];
    a.out = (float*)d_out; a.ws = (unsigned char*)d_ws;
#if MK_SPLIT
    for (int ph = 0; ph < PH_END; ++ph) {
        bool exists = (ph == 0);
        if (ph > 0) { const int layer = (ph - 1) / PH_PER_LAYER, l = (ph - 1) % PH_PER_LAYER, kind = layer % 3; const int nmix = kind == 0 ? 3 : (kind == 1 ? 6 : 8); exists = (l < nmix) || (l >= 8 && l <= 11); }
        if (!exists) continue;
        a.ph_lo = ph; a.ph_hi = ph + 1;
        hipLaunchKernelGGL(mega_fwd, dim3(grid), dim3(NTHREADS), LDS_BYTES, stream, a);
    }
#else
    a.ph_lo = 0; a.ph_hi = PH_END;
    hipLaunchKernelGGL(mega_fwd, dim3(grid), dim3(NTHREADS), LDS_BYTES, stream, a);
#endif
    const hipError_t le = hipPeekAtLastError();
    if (le != hipSuccess) fprintf(stderr, "kernel_launch: launch failed: %s\n", hipGetErrorName(le));
}
```

```cpp
#include <hip/hip_runtime.h>
#include <cstdio>
#include <cstdint>
#include <cmath>
__device__ __forceinline__ int flane() { return (int)__builtin_amdgcn_mbcnt_hi(~0u, __builtin_amdgcn_mbcnt_lo(~0u, 0u)); }
namespace pg8 {
#define PG8_LAS __attribute__((address_space(3)))
typedef unsigned short bf16_t;
typedef short bf16x8 __attribute__((ext_vector_type(8)));
typedef float f32x4 __attribute__((ext_vector_type(4)));
typedef unsigned u32x4 __attribute__((ext_vector_type(4)));
constexpr int BM = 256, BK = 64, HALF = 128, HTB = HALF * BK * 2  , STAGE_BYTES = 8 * HTB, NXCD = 8, WGM = 8;

__host__ __device__ __forceinline__ int lds_byte(int r, int c) { const int st = (r >> 4) * 2 + (c >> 5), rr = r & 15, cc = c & 31, ob = rr * 64 + cc * 2; return st * 1024 + (ob ^ (((ob >> 9) & 1) << 5)); }
__host__ __device__ __forceinline__ void stage_rc(int b, int& R, int& C) { const int st = b / 1024, sb = b % 1024, swz = sb ^ (((sb >> 9) & 1) << 5); R = (st >> 1) * 16 + swz / 64; C = (st & 1) * 32 + (swz % 64) / 2; }
__host__ __device__ __forceinline__ int perm32(int rho) { const int n = rho >> 4, i = rho & 15; return 8 * (i >> 2) + 4 * n + (i & 3); }

struct Unit { int pm, pn; };
struct Gemm { const bf16_t* A; const bf16_t* Bt; int M, N, K; };

struct StaticOrder {
    int nM, nN, nwg, G, c;
    __host__ __device__ void init(int M, int N, int G_, int c_) { nM = M / BM; nN = N / BM; nwg = nM * nN; G = G_; c = c_; }
    __host__ __device__ bool next(int i, Unit& u) const {
        const long L = (long)i * G + c; if (L >= nwg) return false;
        int wgid = (int)L; { const int q = nwg / NXCD, r = nwg % NXCD, xcd = wgid % NXCD, off = wgid / NXCD; wgid = (xcd < r ? xcd * (q + 1) : r * (q + 1) + (xcd - r) * q) + off; }
        const int nig = WGM * nN, gid = wgid / nig, fm = gid * WGM, gsz = (nM - fm) < WGM ? (nM - fm) : WGM;
        u.pm = fm + ((wgid % nig) % gsz); u.pn = (wgid % nig) / gsz; return true;
    }
    __device__ __forceinline__ void a_ready(const Unit&) const {}
    __device__ __forceinline__ void done(const Unit&) const {}
};

__device__ __forceinline__ unsigned cvt_pk_bf16(float lo, float hi) { unsigned r; asm volatile("v_cvt_pk_bf16_f32 %0, %1, %2" : "=v"(r) : "v"(lo), "v"(hi)); return r; }
typedef float f32x2 __attribute__((ext_vector_type(2)));
__device__ __forceinline__ f32x2 gelu_pk(f32x2 v) {
    const f32x2 av = __builtin_elementwise_abs(v), d = av * 0.2316418882f + 1.0f;
    f32x2 t; t.x = __builtin_amdgcn_rcpf(d.x); t.y = __builtin_amdgcn_rcpf(d.y);
    f32x2 q = t * 0.5307027145f + (-0.7265760135f); q = q * t + 0.7107068705f; q = q * t + (-0.142248368f); q = q * t + 0.127414796f; q = q * t;
    const f32x2 s = (v * v) * (-0.72134752044f);
    f32x2 e; e.x = __builtin_amdgcn_exp2f(s.x); e.y = __builtin_amdgcn_exp2f(s.y);
    const f32x2 m = v * (q * e), r = v - m;
    f32x2 o; o.x = v.x < 0.f ? m.x : r.x; o.y = v.y < 0.f ? m.y : r.y; return o;
}

template <int ACT  > struct EpiBf16 {
    static constexpr bool PERM = true, AFTER_DRAIN = false; static_assert(ACT == 0 || ACT == 1 || ACT == 2, "EpiBf16: ACT is 0 (none), 1 (gelu_pk) or 2 (relu^2)");
    bf16_t* O; int ldc; const float* bias; int split_cols; size_t split_stride; float scale0;
    __device__ __forceinline__ void operator()(const f32x4 (&acc)[2][2][4][2], const Unit& u, int wr, int wc, int fr, int fq) const {
        const int row0 = u.pm * BM + wr * 64 + fr; int colt = u.pn * BM; bf16_t* base = O;
        float sc = 1.f; if (split_cols) { const int t = colt / split_cols; base += (size_t)t * split_stride; colt -= t * split_cols; if (t == 0) sc = scale0; }
        const int col0 = colt + wc * 32 + 8 * fq, bcol0 = u.pn * BM + wc * 32 + 8 * fq;
        f32x4 bv[2][2];
#pragma unroll
        for (int bj = 0; bj < 2; ++bj)
#pragma unroll
            for (int n = 0; n < 2; ++n) bv[bj][n] = bias ? *(const f32x4*)(bias + bcol0 + bj * HALF + 4 * n) : (f32x4){0.f, 0.f, 0.f, 0.f};
#pragma unroll
        for (int ai = 0; ai < 2; ++ai)
#pragma unroll
            for (int m = 0; m < 4; ++m) { bf16_t* rowp = base + (size_t)(row0 + ai * HALF + m * 16) * ldc + col0;
#pragma unroll
                for (int bj = 0; bj < 2; ++bj) { f32x4 v0 = acc[ai][bj][m][0] + bv[bj][0], v1 = acc[ai][bj][m][1] + bv[bj][1];
                    if (ACT == 1) { f32x2 a = gelu_pk((f32x2){v0[0], v0[1]}), b = gelu_pk((f32x2){v0[2], v0[3]}), c = gelu_pk((f32x2){v1[0], v1[1]}), d = gelu_pk((f32x2){v1[2], v1[3]});
                        v0 = (f32x4){a.x, a.y, b.x, b.y}; v1 = (f32x4){c.x, c.y, d.x, d.y}; }
                    if (ACT == 2) { _Pragma("unroll") for (int q_ = 0; q_ < 4; ++q_) { const float a_ = v0[q_] > 0.f ? v0[q_] : 0.f, b_ = v1[q_] > 0.f ? v1[q_] : 0.f; v0[q_] = a_ * a_; v1[q_] = b_ * b_; } }
                    v0 = v0 * sc; v1 = v1 * sc; u32x4 w; w.x = cvt_pk_bf16(v0[0], v0[1]); w.y = cvt_pk_bf16(v0[2], v0[3]); w.z = cvt_pk_bf16(v1[0], v1[1]); w.w = cvt_pk_bf16(v1[2], v1[3]);
                    *(u32x4*)(rowp + bj * HALF) = w; } }
    }
};


struct EpiResBf16 {
    static constexpr bool PERM = true, AFTER_DRAIN = false;
    bf16_t* X; int ldc; float alpha;
    __device__ __forceinline__ void operator()(const f32x4 (&acc)[2][2][4][2], const Unit& u, int wr, int wc, int fr, int fq) const {
        const int row0 = u.pm * BM + wr * 64 + fr, col0 = u.pn * BM + wc * 32 + 8 * fq;
#pragma unroll
        for (int ai = 0; ai < 2; ++ai) {
            u32x4 xin[4][2];
#pragma unroll
            for (int m = 0; m < 4; ++m)
#pragma unroll
                for (int bj = 0; bj < 2; ++bj) xin[m][bj] = *(const u32x4*)(X + (size_t)(row0 + ai * HALF + m * 16) * ldc + col0 + bj * HALF);
#pragma unroll
            for (int m = 0; m < 4; ++m) { bf16_t* rowp = X + (size_t)(row0 + ai * HALF + m * 16) * ldc + col0;
#pragma unroll
                for (int bj = 0; bj < 2; ++bj) { const u32x4 xi = xin[m][bj]; const f32x4 a0 = acc[ai][bj][m][0], a1 = acc[ai][bj][m][1];
                    float x[8] = {__uint_as_float(xi.x << 16), __uint_as_float(xi.x & 0xffff0000u), __uint_as_float(xi.y << 16), __uint_as_float(xi.y & 0xffff0000u),
                                  __uint_as_float(xi.z << 16), __uint_as_float(xi.z & 0xffff0000u), __uint_as_float(xi.w << 16), __uint_as_float(xi.w & 0xffff0000u)};
                    u32x4 w; w.x = cvt_pk_bf16(alpha * x[0] + a0[0], alpha * x[1] + a0[1]); w.y = cvt_pk_bf16(alpha * x[2] + a0[2], alpha * x[3] + a0[3]);
                    w.z = cvt_pk_bf16(alpha * x[4] + a1[0], alpha * x[5] + a1[1]); w.w = cvt_pk_bf16(alpha * x[6] + a1[2], alpha * x[7] + a1[3]);
                    *(u32x4*)(rowp + bj * HALF) = w; } }
        }
    }
};

struct EpiF32 {
    static constexpr bool PERM = false, AFTER_DRAIN = false;
    float* C; int ldc;
    __device__ __forceinline__ void operator()(const f32x4 (&acc)[2][2][4][2], const Unit& u, int wr, int wc, int fr, int fq) const {
        const int row0 = u.pm * BM + wr * 64 + fr, col0 = u.pn * BM + wc * 32 + 4 * fq;
#pragma unroll
        for (int ai = 0; ai < 2; ++ai)
#pragma unroll
            for (int m = 0; m < 4; ++m) { float* rowp = C + (size_t)(row0 + ai * HALF + m * 16) * ldc + col0;
#pragma unroll
                for (int bj = 0; bj < 2; ++bj)
#pragma unroll
                    for (int n = 0; n < 2; ++n) *(f32x4*)(rowp + bj * HALF + n * 16) = acc[ai][bj][m][n]; }
    }
};
struct PanelStats {
    unsigned* xbuf;
    unsigned* cnt;
    unsigned* tmo;
    int ntn; float eps;
    unsigned code;
    __device__ __forceinline__ bool run(const f32x4 (&v)[2][2][4][2], const Unit& u, int wr, int wc, int fr, int fq, PG8_LAS unsigned char* lds, int wid, int lane) const {
        typedef float f32x2v __attribute__((ext_vector_type(2)));
        PG8_LAS f32x2v* P = (PG8_LAS f32x2v*)lds;
        PG8_LAS f32x2v* S = (PG8_LAS f32x2v*)(lds + 8192);
        PG8_LAS unsigned* flag = (PG8_LAS unsigned*)(lds + 8192 + 2048);
#pragma unroll
        for (int ai = 0; ai < 2; ++ai)
#pragma unroll
            for (int m = 0; m < 4; ++m) {
                float s = 0.f;
#pragma unroll
                for (int bj = 0; bj < 2; ++bj)
#pragma unroll
                    for (int n = 0; n < 2; ++n) { const f32x4 x = v[ai][bj][m][n]; s += (x[0] + x[1]) + (x[2] + x[3]); }
                s += __shfl_xor(s, 16); s += __shfl_xor(s, 32);
                const float mw = s * (1.0f / 64.0f); float q = 0.f;
#pragma unroll
                for (int bj = 0; bj < 2; ++bj)
#pragma unroll
                    for (int n = 0; n < 2; ++n) { const f32x4 d = v[ai][bj][m][n] - mw; q += (d[0] * d[0] + d[1] * d[1]) + (d[2] * d[2] + d[3] * d[3]); }
                q += __shfl_xor(q, 16); q += __shfl_xor(q, 32);
                if (fq == 0) P[(ai * HALF + wr * 64 + m * 16 + fr) * 4 + wc] = (f32x2v){mw, q};
            }
        asm volatile("s_waitcnt lgkmcnt(0)" ::: "memory"); __builtin_amdgcn_s_barrier(); asm volatile("" ::: "memory");
#if defined(BROKEN_EXCHANGE_NO_WAIT)
#warning BROKEN CONTROL BUILD: the row-statistics exchange does not wait; results are wrong by design
        if (blockIdx.x >= 64) { const long long t0_ = clock64(); while (clock64() - t0_ < 60000) __builtin_amdgcn_s_sleep(8); }
#endif
        const int row = wid * 32 + (lane & 31);
        if (lane < 32) {
            const f32x2v a = P[row * 4 + 0], b = P[row * 4 + 1], c = P[row * 4 + 2], d = P[row * 4 + 3];
            const float mt = (a.x + b.x + c.x + d.x) * 0.25f;
            const float da = a.x - mt, db = b.x - mt, dc = c.x - mt, dd = d.x - mt;
            const float m2 = (a.y + b.y) + (c.y + d.y) + 64.0f * ((da * da + db * db) + (dc * dc + dd * dd));
            unsigned long long* slot = (unsigned long long*)xbuf + ((size_t)(u.pm * BM + row) * 4 + u.pn);
            __hip_atomic_store(slot, ((unsigned long long)__float_as_uint(m2) << 32) | __float_as_uint(mt), __ATOMIC_RELAXED, __HIP_MEMORY_SCOPE_AGENT);
        }
        asm volatile("s_waitcnt vmcnt(0)" ::: "memory");
        if (lane == 0) __hip_atomic_fetch_add(cnt + 64 * u.pm, 1u, __ATOMIC_RELAXED, __HIP_MEMORY_SCOPE_AGENT);
        if (wid == 0) {
            bool dead = false; const unsigned long long t0 = __builtin_amdgcn_s_memrealtime(); const unsigned want = 8u * (unsigned)ntn;
            for (;;) {
#if defined(BROKEN_EXCHANGE_NO_WAIT)
                break;
#endif
                if ((unsigned)__builtin_amdgcn_readfirstlane(__hip_atomic_load(cnt + 64 * u.pm, __ATOMIC_RELAXED, __HIP_MEMORY_SCOPE_AGENT)) >= want) break;
                if (__builtin_amdgcn_s_memrealtime() - t0 > 2000000ull) {
                    if (lane == 0) { unsigned expect = 0u; __hip_atomic_compare_exchange_strong(tmo + 1, &expect, code | (unsigned)(u.pm & 0xff), __ATOMIC_RELAXED, __ATOMIC_RELAXED, __HIP_MEMORY_SCOPE_AGENT);
                                     __hip_atomic_store(tmo, 1u, __ATOMIC_RELAXED, __HIP_MEMORY_SCOPE_AGENT); }
                    dead = true; break; }
                __builtin_amdgcn_s_sleep(2);
            }
            __builtin_amdgcn_fence(__ATOMIC_ACQUIRE, "agent");
            if (lane == 0) flag[0] = dead ? 1u : 0u;
        }
        asm volatile("s_waitcnt vmcnt(0) lgkmcnt(0)" ::: "memory"); __builtin_amdgcn_s_barrier(); asm volatile("" ::: "memory");
        const bool bad = flag[0] != 0u;
        if (lane < 32) {
            const unsigned long long* slot = (const unsigned long long*)xbuf + (size_t)(u.pm * BM + row) * 4; float mt[4], m2[4]; float ms = 0.f;
#pragma unroll
            for (int t = 0; t < 4; ++t) { if (t < ntn) { const unsigned long long w = __hip_atomic_load(slot + t, __ATOMIC_RELAXED, __HIP_MEMORY_SCOPE_AGENT); mt[t] = __uint_as_float((unsigned)w); m2[t] = __uint_as_float((unsigned)(w >> 32)); } else { mt[t] = 0.f; m2[t] = 0.f; } ms += mt[t]; }
            const float mean = ms / (float)ntn; float q = 0.f;
#pragma unroll
            for (int t = 0; t < 4; ++t) if (t < ntn) { const float dm = mt[t] - mean; q += m2[t] + 256.0f * dm * dm; }
            S[row] = (f32x2v){mean, 1.0f / sqrtf(q / (256.0f * (float)ntn) + eps)};
        }
        asm volatile("s_waitcnt lgkmcnt(0)" ::: "memory"); __builtin_amdgcn_s_barrier(); asm volatile("" ::: "memory");
        return bad;
    }
};
struct EpiLnRes {
    static constexpr bool PERM = false, AFTER_DRAIN = true;
    const float* base; float* out; int ldc; const float* bias; PanelStats st; unsigned poison;
    __device__ __forceinline__ void fused(f32x4 (&acc)[2][2][4][2], const Unit& u, int wr, int wc, int fr, int fq, PG8_LAS unsigned char* lds, int wid, int lane) const {
        typedef float f32x2v __attribute__((ext_vector_type(2)));
        const PG8_LAS f32x2v* S = (const PG8_LAS f32x2v*)(lds + 8192);
        const int col0 = u.pn * BM + wc * 32 + 4 * fq;
#pragma unroll
        for (int bj = 0; bj < 2; ++bj)
#pragma unroll
            for (int n = 0; n < 2; ++n) { const f32x4 bv = bias ? *(const f32x4*)(bias + col0 + bj * HALF + n * 16) : (f32x4){0.f, 0.f, 0.f, 0.f};
#pragma unroll
                for (int ai = 0; ai < 2; ++ai)
#pragma unroll
                    for (int m = 0; m < 4; ++m) acc[ai][bj][m][n] += bv; }
        f32x4 pre[4][2][2];
#pragma unroll
        for (int m = 0; m < 4; ++m) { const size_t off = (size_t)(u.pm * BM + wr * 64 + m * 16 + fr) * ldc + col0;
#pragma unroll
            for (int bj = 0; bj < 2; ++bj)
#pragma unroll
                for (int n = 0; n < 2; ++n) pre[m][bj][n] = *(const f32x4*)(base + off + bj * HALF + n * 16); }
        const bool bad = st.run(acc, u, wr, wc, fr, fq, lds, wid, lane) || poison != 0u;
        const float qnan = __builtin_nanf("");
#pragma unroll
        for (int ai = 0; ai < 2; ++ai)
#pragma unroll
            for (int m = 0; m < 4; ++m) { const int r = ai * HALF + wr * 64 + m * 16 + fr; const f32x2v sr = S[r]; const size_t off = (size_t)(u.pm * BM + r) * ldc + col0;
#pragma unroll
                for (int bj = 0; bj < 2; ++bj)
#pragma unroll
                    for (int n = 0; n < 2; ++n) { const f32x4 bs = ai == 0 ? pre[m][bj][n] : *(const f32x4*)(base + off + bj * HALF + n * 16); f32x4 o = bs + (acc[ai][bj][m][n] - sr.x) * sr.y;
                        if (bad) o = (f32x4){qnan, qnan, qnan, qnan}; *(f32x4*)(out + off + bj * HALF + n * 16) = o; }
                if (m & 1) asm volatile("" ::: "memory"); }
    }
};
struct EpiLnResLn {
    static constexpr bool PERM = false, AFTER_DRAIN = true;
    const float* base; float* out; bf16_t* xn; int ldc; const float* bias; PanelStats st1, st2; unsigned poison;
    __device__ __forceinline__ void fused(f32x4 (&acc)[2][2][4][2], const Unit& u, int wr, int wc, int fr, int fq, PG8_LAS unsigned char* lds, int wid, int lane) const {
        typedef float f32x2v __attribute__((ext_vector_type(2))); typedef unsigned u32x2v __attribute__((ext_vector_type(2)));
        const PG8_LAS f32x2v* S = (const PG8_LAS f32x2v*)(lds + 8192);
        const int col0 = u.pn * BM + wc * 32 + 4 * fq;
#pragma unroll
        for (int bj = 0; bj < 2; ++bj)
#pragma unroll
            for (int n = 0; n < 2; ++n) { const f32x4 bv = bias ? *(const f32x4*)(bias + col0 + bj * HALF + n * 16) : (f32x4){0.f, 0.f, 0.f, 0.f};
#pragma unroll
                for (int ai = 0; ai < 2; ++ai)
#pragma unroll
                    for (int m = 0; m < 4; ++m) acc[ai][bj][m][n] += bv; }
        bool bad = st1.run(acc, u, wr, wc, fr, fq, lds, wid, lane) || poison != 0u;
        const float qnan = __builtin_nanf("");
#pragma unroll
        for (int ai = 0; ai < 2; ++ai)
#pragma unroll
            for (int m = 0; m < 4; ++m) { const int r = ai * HALF + wr * 64 + m * 16 + fr; const f32x2v sr = S[r]; const size_t off = (size_t)(u.pm * BM + r) * ldc + col0;
#pragma unroll
                for (int bj = 0; bj < 2; ++bj)
#pragma unroll
                    for (int n = 0; n < 2; ++n) { const f32x4 bs = *(const f32x4*)(base + off + bj * HALF + n * 16); acc[ai][bj][m][n] = bs + (acc[ai][bj][m][n] - sr.x) * sr.y; }
                asm volatile("" : "+v"(acc[ai][0][m][0]), "+v"(acc[ai][0][m][1]), "+v"(acc[ai][1][m][0]), "+v"(acc[ai][1][m][1]));
                if (m & 1) asm volatile("" ::: "memory"); }
        const bool bad1 = bad;
        bad = st2.run(acc, u, wr, wc, fr, fq, lds, wid, lane) || bad;
#pragma unroll
        for (int ai = 0; ai < 2; ++ai)
#pragma unroll
            for (int m = 0; m < 4; ++m) { const int r = ai * HALF + wr * 64 + m * 16 + fr; const f32x2v sr = S[r]; const size_t off = (size_t)(u.pm * BM + r) * ldc + col0;
#pragma unroll
                for (int bj = 0; bj < 2; ++bj)
#pragma unroll
                    for (int n = 0; n < 2; ++n) { const f32x4 x1 = acc[ai][bj][m][n]; *(f32x4*)(out + off + bj * HALF + n * 16) = bad1 ? (f32x4){qnan, qnan, qnan, qnan} : x1;
                        const f32x4 o = (x1 - sr.x) * sr.y; u32x2v w; w.x = cvt_pk_bf16(o[0], o[1]); w.y = cvt_pk_bf16(o[2], o[3]);
                        if (bad) { w.x = 0x7fc07fc0u; w.y = 0x7fc07fc0u; } *(u32x2v*)(xn + off + bj * HALF + n * 16) = w; }
                asm volatile("" ::: "memory"); }
    }
};

template <class Epi, class Sched, bool ALIGN_EPI = false, bool SP2 = false>
__device__ __forceinline__ void gemm_phase(PG8_LAS unsigned char* lds, const Gemm g, const Sched& S, const Epi& E, int wv) {
    int tid0_ = threadIdx.x; asm volatile("" : "+v"(tid0_)); (void)wv;
    const int tid = tid0_, wid = __builtin_amdgcn_readfirstlane(tid >> 6), lane = tid & 63, wr = wid >> 2, wc = wid & 3, fr = lane & 15, fq = lane >> 4;
    const int K = g.K, nt = K / BK;
    unsigned voffA[2], voffB[2];
#pragma unroll
    for (int i = 0; i < 2; ++i) { int R, C; stage_rc(tid * 16 + i * 8192, R, C); const int Rb = Epi::PERM ? ((R & ~31) + perm32(R & 31)) : R;
        voffA[i] = (unsigned)(R * K + C) * 2u; voffB[i] = (unsigned)(Rb * K + C) * 2u; }
    const size_t kstep = (size_t)(BK * 2);
    const size_t hstep = (size_t)HALF * K * 2;
    const size_t tstep = 2 * hstep;
    const unsigned ldsw = (unsigned)wid * 1024u;
    const int aoff = lds_byte(wr * 64 + fr, fq * 8), boff = lds_byte(wc * 32 + fr, fq * 8);
#define PG8_SA(b, h) (((b) * 2 + (h)) * HTB)
#define PG8_SB(b, h) ((4 + (b) * 2 + (h)) * HTB)
#define PG8_STAGE(bufoff, gbase, voff) do { _Pragma("unroll") for (int _i = 0; _i < 2; ++_i) \
        __builtin_amdgcn_global_load_lds((const unsigned*)((const char*)(gbase) + (voff)[_i]), (PG8_LAS unsigned*)(lds + (bufoff) + ldsw + _i * 8192), 16, 0, 0); } while (0)
#define PG8_LDA(dst, b, h) do { _Pragma("unroll") for (int m = 0; m < 4; ++m) _Pragma("unroll") for (int k = 0; k < 2; ++k) dst[m][k] = *(const PG8_LAS bf16x8*)(lds + PG8_SA(b, h) + aoff + m * 2048 + k * 1024); } while (0)
#define PG8_LDB(dst, b, h) do { _Pragma("unroll") for (int n = 0; n < 2; ++n) _Pragma("unroll") for (int k = 0; k < 2; ++k) dst[n][k] = *(const PG8_LAS bf16x8*)(lds + PG8_SB(b, h) + boff + n * 2048 + k * 1024); } while (0)
#define PG8_MMA(ai, bj, At, Bt) do { __builtin_amdgcn_s_setprio(1); _Pragma("unroll") for (int m = 0; m < 4; ++m) _Pragma("unroll") for (int n = 0; n < 2; ++n) _Pragma("unroll") for (int k = 0; k < 2; ++k) \
        acc[ai][bj][m][n] = __builtin_amdgcn_mfma_f32_16x16x32_bf16(Bt[n][k], At[m][k], acc[ai][bj][m][n], 0, 0, 0); __builtin_amdgcn_s_setprio(0); } while (0)
#define PG8_WAIT_V(n) asm volatile("s_waitcnt vmcnt(" #n ")" ::: "memory")
#define PG8_WAIT_L(n) asm volatile("s_waitcnt lgkmcnt(" #n ")" ::: "memory")
#define PG8_BAR __builtin_amdgcn_s_barrier()
#define PG8_SCHED __builtin_amdgcn_sched_barrier(0)
    Unit cur, nxt; int ui = 0;
    if (!S.next(0, cur)) return;
    f32x4 acc[2][2][4][2];
#pragma unroll
    for (int a = 0; a < 2; ++a)
#pragma unroll
        for (int b = 0; b < 2; ++b)
#pragma unroll
            for (int m = 0; m < 4; ++m)
#pragma unroll
                for (int n = 0; n < 2; ++n) acc[a][b][m][n] = (f32x4){0.f, 0.f, 0.f, 0.f};
    bf16x8 At[4][2], B0[2][2], B1[2][2];
    const char* cA = (const char*)g.A + (size_t)cur.pm * tstep; const char* cB = (const char*)g.Bt + (size_t)cur.pn * tstep;
    S.a_ready(cur);
    if constexpr (SP2) {
        PG8_STAGE(PG8_SB(0, 0), cB, voffB); PG8_STAGE(PG8_SB(0, 1), cB + hstep, voffB); PG8_STAGE(PG8_SA(0, 0), cA, voffA); PG8_STAGE(PG8_SA(0, 1), cA + hstep, voffA);
        if (wr == 1) PG8_BAR;
        PG8_WAIT_V(2); PG8_BAR;
        PG8_STAGE(PG8_SB(1, 0), cB + kstep, voffB); PG8_STAGE(PG8_SA(1, 0), cA + kstep, voffA); PG8_STAGE(PG8_SB(1, 1), cB + hstep + kstep, voffB);
        PG8_WAIT_V(6); PG8_BAR;
    } else {
        PG8_STAGE(PG8_SB(0, 0), cB, voffB); PG8_STAGE(PG8_SA(0, 0), cA, voffA); PG8_STAGE(PG8_SB(0, 1), cB + hstep, voffB); PG8_STAGE(PG8_SA(0, 1), cA + hstep, voffA);
        if (wr == 1) PG8_BAR;
        PG8_WAIT_V(4); PG8_BAR;
        PG8_STAGE(PG8_SB(1, 0), cB + kstep, voffB); PG8_STAGE(PG8_SA(1, 0), cA + kstep, voffA); PG8_STAGE(PG8_SB(1, 1), cB + hstep + kstep, voffB);
        PG8_WAIT_V(6); PG8_BAR;
    }
    for (;;) {
        const bool has_next = S.next(ui + 1, nxt);
        const char* nA = has_next ? (const char*)g.A + (size_t)nxt.pm * tstep : cA; const char* nB = has_next ? (const char*)g.Bt + (size_t)nxt.pn * tstep : cB;
        for (int t = 0; t < nt; t += 2) {
            const bool last = (t == nt - 2);
            const char* a1 = cA + (size_t)(t + 1) * kstep;
            const char* a2 = last ? nA : cA + (size_t)(t + 2) * kstep; const char* b2 = last ? nB : cB + (size_t)(t + 2) * kstep;
            const char* a3 = a2 + kstep; const char* b3 = b2 + kstep;
            if (last && has_next) S.a_ready(nxt);
            if constexpr (SP2) {
            PG8_LDB(B0, 0, 0); PG8_LDB(B1, 0, 1); PG8_SCHED; PG8_LDA(At, 0, 0); PG8_STAGE(PG8_SA(1, 1), a1 + hstep, voffA);
            PG8_WAIT_V(8); PG8_WAIT_L(0); PG8_BAR; PG8_MMA(0, 0, At, B0); PG8_MMA(0, 1, At, B1); PG8_BAR; PG8_SCHED;
            PG8_LDA(At, 0, 1); PG8_STAGE(PG8_SB(0, 0), b2, voffB); PG8_STAGE(PG8_SB(0, 1), b2 + hstep, voffB); PG8_STAGE(PG8_SA(0, 0), a2, voffA);
            PG8_WAIT_V(8); PG8_WAIT_L(0); PG8_BAR; PG8_MMA(1, 0, At, B0); PG8_MMA(1, 1, At, B1); PG8_BAR; PG8_SCHED;
            PG8_LDB(B0, 1, 0); PG8_LDB(B1, 1, 1); PG8_SCHED; PG8_LDA(At, 1, 0); PG8_STAGE(PG8_SA(0, 1), a2 + hstep, voffA);
            PG8_WAIT_V(8); PG8_WAIT_L(0); PG8_BAR; PG8_MMA(0, 0, At, B0); PG8_MMA(0, 1, At, B1); PG8_BAR; PG8_SCHED;
            PG8_LDA(At, 1, 1); PG8_STAGE(PG8_SB(1, 0), b3, voffB); PG8_STAGE(PG8_SB(1, 1), b3 + hstep, voffB); PG8_STAGE(PG8_SA(1, 0), a3, voffA);
            PG8_WAIT_V(8); PG8_WAIT_L(0); PG8_BAR; PG8_MMA(1, 0, At, B0); PG8_MMA(1, 1, At, B1); PG8_BAR; PG8_SCHED;
            } else {
            PG8_LDB(B0, 0, 0); PG8_SCHED; PG8_LDA(At, 0, 0); PG8_STAGE(PG8_SA(1, 1), a1 + hstep, voffA);
            PG8_WAIT_L(8); PG8_BAR; PG8_WAIT_L(0); PG8_MMA(0, 0, At, B0); PG8_BAR; PG8_SCHED;
            PG8_LDB(B1, 0, 1); PG8_STAGE(PG8_SB(0, 0), b2, voffB);
            PG8_BAR; PG8_WAIT_L(0); PG8_MMA(0, 1, At, B1); PG8_BAR;
            PG8_LDA(At, 0, 1); PG8_STAGE(PG8_SA(0, 0), a2, voffA);
            PG8_BAR; PG8_WAIT_L(0); PG8_MMA(1, 0, At, B0); PG8_BAR; PG8_SCHED;
            PG8_STAGE(PG8_SB(0, 1), b2 + hstep, voffB);
            PG8_WAIT_V(6); PG8_BAR; PG8_MMA(1, 1, At, B1); PG8_BAR;
            PG8_LDB(B0, 1, 0); PG8_SCHED; PG8_LDA(At, 1, 0); PG8_STAGE(PG8_SA(0, 1), a2 + hstep, voffA);
            PG8_WAIT_L(8); PG8_BAR; PG8_WAIT_L(0); PG8_MMA(0, 0, At, B0); PG8_BAR; PG8_SCHED;
            PG8_LDB(B1, 1, 1); PG8_STAGE(PG8_SB(1, 0), b3, voffB);
            PG8_BAR; PG8_WAIT_L(0); PG8_MMA(0, 1, At, B1); PG8_BAR;
            PG8_LDA(At, 1, 1); PG8_STAGE(PG8_SA(1, 0), a3, voffA);
            PG8_BAR; PG8_WAIT_L(0); PG8_MMA(1, 0, At, B0); PG8_BAR; PG8_SCHED;
            PG8_STAGE(PG8_SB(1, 1), b3 + hstep, voffB);
            PG8_WAIT_V(6); PG8_BAR; PG8_MMA(1, 1, At, B1); PG8_BAR;
            }
        }
        if constexpr (ALIGN_EPI) { if (wr == 0) PG8_BAR; }
        if constexpr (!Epi::AFTER_DRAIN) { E(acc, cur, wr, wc, fr, fq); S.done(cur); }
        if (!has_next) break;
#pragma unroll
        for (int a = 0; a < 2; ++a)
#pragma unroll
            for (int b = 0; b < 2; ++b)
#pragma unroll
                for (int m = 0; m < 4; ++m)
#pragma unroll
                    for (int n = 0; n < 2; ++n) acc[a][b][m][n] = (f32x4){0.f, 0.f, 0.f, 0.f};
        cur = nxt; cA = nA; cB = nB; ++ui;
        if constexpr (ALIGN_EPI) { if (wr == 1) PG8_BAR; }
    }
    PG8_WAIT_V(0);
    if constexpr (!ALIGN_EPI) { if (wr == 0) PG8_BAR; }
    PG8_BAR;
    if constexpr (Epi::AFTER_DRAIN) { E.fused(acc, cur, wr, wc, fr, fq, lds, wid, lane); S.done(cur); }
#undef PG8_SA
#undef PG8_SB
#undef PG8_STAGE
#undef PG8_LDA
#undef PG8_LDB
#undef PG8_MMA
#undef PG8_WAIT_V
#undef PG8_WAIT_L
#undef PG8_BAR
#undef PG8_SCHED
}
}

#ifndef PG8_SP2
#define PG8_SP2 true
#endif
#ifndef PG8_ALIGN
#define PG8_ALIGN true
#endif
#define GAS __attribute__((address_space(1)))
#define LAS __attribute__((address_space(3)))
#define XB_TMO      128
#define XB_XCNT(j)  (256  + 64 * (j))
#define XB_XSUB(j)  (1280 + 64 * (j))
#define XB_XGEN(j)  (2304 + 64 * (j))
#define XB_TOP      3328
#define XB_TOPGEN   3392
#define XCD_BAR_WORDS 3456
#define XB_SPIN_CAP (1u << 18)

__device__ __forceinline__ unsigned xb_ld(unsigned* p)              { return __hip_atomic_load(p, __ATOMIC_RELAXED, __HIP_MEMORY_SCOPE_AGENT); }
__device__ __forceinline__ unsigned xb_add(unsigned* p, unsigned v) { return __hip_atomic_fetch_add(p, v, __ATOMIC_RELAXED, __HIP_MEMORY_SCOPE_AGENT); }
__device__ __forceinline__ unsigned xb_xcc_id() { return (unsigned)__builtin_amdgcn_s_getreg((3 << 11) | 20) & 0xFu; }
#define XB_SPIN(cond, bar) do { unsigned _sp = 0; while (cond) { __builtin_amdgcn_s_sleep(1); \
    if ((++_sp & 255u) == 0u) { if (xb_ld(&(bar)[XB_TMO])) break; if (_sp > XB_SPIN_CAP) { atomicAdd(&(bar)[XB_TMO], 1u); break; } } } } while (0)

struct XcdBarrier {
    unsigned* bar; unsigned x;
    volatile LAS unsigned* st;
    int wv;
};

__device__ __forceinline__ XcdBarrier xcd_barrier_post(unsigned* bar, volatile LAS unsigned* st) {
    XcdBarrier b; b.bar = bar; b.x = xb_xcc_id(); b.st = st;
    if (threadIdx.x == 0) (void)xb_add(&bar[XB_XCNT(b.x)], 1u);
    return b;
}
__device__ __forceinline__ void xcd_barrier_complete(unsigned* bar, unsigned x, unsigned& nloc, unsigned& nx) {
    asm volatile("" : "+s"(x));
    const unsigned G = gridDim.x * gridDim.y * gridDim.z;
    unsigned sum, cnt, mine, sp = 0u;
    for (;;) {
        sum = 0u; cnt = 0u; mine = 0u;
#pragma unroll
        for (unsigned j = 0; j < 16; ++j) { const unsigned c = xb_ld(&bar[XB_XCNT(j)]); sum += c; cnt += (c > 0u) ? 1u : 0u; mine = (j == x) ? c : mine; }
        if (sum == G) break;
        __builtin_amdgcn_s_sleep(1);
        if ((++sp & 255u) == 0u) { if (xb_ld(&bar[XB_TMO])) break; if (sp > XB_SPIN_CAP) { atomicAdd(&bar[XB_TMO], 1u); break; } }
    }
    nloc = mine > 0u ? mine : 1u; nx = cnt > 0u ? cnt : 1u;
}

__device__ __forceinline__ void xcd_barrier(const XcdBarrier& b) {
    asm volatile("s_waitcnt vmcnt(0)" ::: "memory");
    __syncthreads();
    if (threadIdx.x == 0) {
        unsigned* bar = b.bar; asm volatile("" : "+s"(bar));
        __builtin_amdgcn_s_waitcnt(0);
        unsigned nloc = b.st[0], nx = b.st[1];
        if (nloc == 0u) { xcd_barrier_complete(bar, b.x, nloc, nx); b.st[0] = nloc; b.st[1] = nx; }
        const unsigned old = xb_add(&bar[XB_XSUB(b.x)], 1u);
        const unsigned gen = old / nloc;
        if (old + 1u == (gen + 1u) * nloc) {
            __builtin_amdgcn_fence(__ATOMIC_RELEASE, "agent");
            asm volatile("s_waitcnt vmcnt(0)" ::: "memory");
            const unsigned og = xb_add(&bar[XB_TOP], 1u);
            const unsigned tg = og / nx;
            if (og + 1u == (tg + 1u) * nx) xb_add(&bar[XB_TOPGEN], 1u);
            else XB_SPIN(xb_ld(&bar[XB_TOPGEN]) == tg, bar);
            __builtin_amdgcn_fence(__ATOMIC_ACQUIRE, "agent");
            xb_add(&bar[XB_XGEN(b.x)], 1u);
            asm volatile("s_waitcnt vmcnt(0)" ::: "memory");
        } else {
            XB_SPIN(xb_ld(&bar[XB_XGEN(b.x)]) == gen, bar);
            __builtin_amdgcn_fence(__ATOMIC_ACQUIRE, "agent");
            asm volatile("s_waitcnt vmcnt(0)" ::: "memory");
        }
    }
    __syncthreads();
}
namespace dattn {
constexpr int D = 128, QST = 2048, KVS = 512, OST = 2048, MTW = 68, JLO = 3;
constexpr float THR = 8.f; constexpr bool WSKIP = false;
typedef unsigned short bf16;
constexpr float SCALE = 1.0f;
constexpr int NW = 8, QBLK = 32, KVBLK = 64, QB = NW * QBLK;
constexpr int SHM_V = KVBLK * D * 2, SHM_K = KVBLK * D * 2;
constexpr int LDS_BYTES = 2 * SHM_V + 2 * SHM_K + NW * 64 * 4;

typedef short bf16x8 __attribute__((ext_vector_type(8)));
typedef short s16x4 __attribute__((ext_vector_type(4)));
typedef float f32x16 __attribute__((ext_vector_type(16)));
typedef float f32x4 __attribute__((ext_vector_type(4)));
typedef unsigned u32x4 __attribute__((ext_vector_type(4)));
template <class A, class Bt> struct same_t { static constexpr bool v = false; };
template <class A> struct same_t<A, A> { static constexpr bool v = true; };

#define KSWZ(row, colB) ((row) * 256 + ((colB) ^ (((row) & 7) << 4)))
#define SBAR() __builtin_amdgcn_sched_barrier(0)
__device__ __forceinline__ int v_st(int k, int c) { const int kk = (k & ~0xC) | ((k & 4) << 1) | ((k & 8) >> 1); return ((kk >> 3) * 4 + (c >> 5)) * 512 + ((kk & 7) * 32 + (c & 31)) * 2; }
__device__ __forceinline__ int v_rd_base(int lane) { return ((lane & 3) << 3) | (((lane >> 2) & 3) << 6) | (((lane >> 4) & 1) << 5) | (((lane >> 5) & 1) << 8); }
constexpr int v_rd_off(int d0, int ks, int half) { return d0 * 512 + ks * 4096 + half * 2048; }
__device__ __forceinline__ int crow(int r, int hi) { return (r & 3) + 8 * (r >> 2) + 4 * hi; }
__device__ __forceinline__ unsigned cvtpk(float lo, float hi) {
    unsigned r; asm volatile("v_cvt_pk_bf16_f32 %0, %1, %2" : "=v"(r) : "v"(lo), "v"(hi)); return r;
}
__device__ __forceinline__ bf16x8 pack8(f32x4 a, f32x4 b) {
    u32x4 w = {cvtpk(a[0], a[1]), cvtpk(a[2], a[3]), cvtpk(b[0], b[1]), cvtpk(b[2], b[3])};
    return *reinterpret_cast<bf16x8*>(&w);
}
template <class T> __device__ __forceinline__ bf16x8 load8(const T* p) {
    if constexpr (same_t<T, float>::v) { return pack8(*(const f32x4*)p, *(const f32x4*)(p + 4)); }
    else { return *reinterpret_cast<const bf16x8*>(p); }
}
__device__ __forceinline__ void mask_tile(f32x16& p0, f32x16& p1, int dq, unsigned W) {
    const float NEG = -__builtin_inff();
#pragma unroll
    for (int r = 0; r < 16; ++r) {
        const int c = (r & 3) + 8 * (r >> 2);
        if ((unsigned)(dq - c) >= W) p0[r] = NEG;
        if ((unsigned)(dq - c - 32) >= W) p1[r] = NEG;
    }
}
__device__ __forceinline__ void mask_bits(f32x16& p0, f32x16& p1, unsigned long long mw, int hi) {
    const float NEG = -__builtin_inff();
    const unsigned lo = (unsigned)(mw >> (4 * hi)), up = (unsigned)(mw >> (32 + 4 * hi));
#pragma unroll
    for (int r = 0; r < 16; ++r) {
        const int c = (r & 3) + 8 * (r >> 2);
        if (!((lo >> c) & 1u)) p0[r] = NEG;
        if (!((up >> c) & 1u)) p1[r] = NEG;
    }
}
__device__ __forceinline__ void partialSM(f32x16& p0, f32x16& p1, float& m_reg, float& mn, float& alpha) {
    float pmax = p0[0]; for (int r = 1; r < 16; ++r) pmax = fmaxf(pmax, p0[r]); for (int r = 0; r < 16; ++r) pmax = fmaxf(pmax, p1[r]);
    { auto rr = __builtin_amdgcn_permlane32_swap(__float_as_uint(pmax), __float_as_uint(pmax), false, false);
      pmax = fmaxf(__uint_as_float(rr[0]), __uint_as_float(rr[1])); }
    constexpr float C2 = 1.4426950408889634f * SCALE;
    if (__builtin_expect(__all((pmax - m_reg) * SCALE <= THR), 1)) { mn = m_reg; alpha = 1.f; }
    else { mn = fmaxf(m_reg, pmax); alpha = __builtin_amdgcn_exp2f((m_reg - mn) * C2); m_reg = mn; }
    const float mnL = -mn * C2;
    for (int r = 0; r < 16; ++r) p0[r] = fmaf(p0[r], C2, mnL); for (int r = 0; r < 16; ++r) p1[r] = fmaf(p1[r], C2, mnL);
    for (int r = 0; r < 16; ++r) p0[r] = __builtin_amdgcn_exp2f(p0[r]);
}
__device__ __forceinline__ void finishSM(f32x16& p0, f32x16& p1, float alpha, float& l_reg, bf16x8& pa0, bf16x8& pa1, bf16x8& pa2, bf16x8& pa3) {
    for (int r = 0; r < 16; ++r) p1[r] = __builtin_amdgcn_exp2f(p1[r]);
    float ps = 0; for (int r = 0; r < 16; ++r) ps += p0[r]; for (int r = 0; r < 16; ++r) ps += p1[r];
    { auto rr = __builtin_amdgcn_permlane32_swap(__float_as_uint(ps), __float_as_uint(ps), false, false);
      ps = __uint_as_float(rr[0]) + __uint_as_float(rr[1]); }
    l_reg = l_reg * alpha + ps;
#define PK4(P, B_, OUT) do { unsigned a0 = cvtpk(P[B_+0], P[B_+1]), a1 = cvtpk(P[B_+2], P[B_+3]);                          \
        unsigned b0 = cvtpk(P[B_+4], P[B_+5]), b1 = cvtpk(P[B_+6], P[B_+7]);                                             \
        auto r0 = __builtin_amdgcn_permlane32_swap(a0, b0, false, false); auto r1 = __builtin_amdgcn_permlane32_swap(a1, b1, false, false); \
        u32x4 w = {r0[0], r1[0], r0[1], r1[1]}; OUT = *reinterpret_cast<bf16x8*>(&w); } while (0)
    PK4(p0, 0, pa0); PK4(p0, 8, pa1); PK4(p1, 0, pa2); PK4(p1, 8, pa3);
#undef PK4
}
template <int KB, bool SK>
__device__ __forceinline__ void qkt(f32x16& p0, f32x16& p1, const char* K_lds, int r32, int hi, const bf16x8* qr, bool act) {
    if (SK && !act) { const float NEG = -__builtin_inff();
#pragma unroll
        for (int r = 0; r < 16; ++r) { p0[r] = NEG; p1[r] = NEG; } return; }
    p0 = f32x16{}; p1 = f32x16{};
    const char* kb[4];
#pragma unroll
    for (int dd = 0; dd < 4; ++dd) kb[dd] = K_lds + KB * SHM_K + KSWZ(r32, (dd * 16 + hi * 8) * 2);
#pragma unroll
    for (int d0 = 0; d0 < 8; ++d0) { const char* a = kb[d0 & 3] + (d0 >> 2) * 128;
        bf16x8 b0 = *reinterpret_cast<const bf16x8*>(a);
        bf16x8 b1 = *reinterpret_cast<const bf16x8*>(a + 32 * 256);
        p0 = __builtin_amdgcn_mfma_f32_32x32x16_bf16(b0, qr[d0], p0, 0, 0, 0);
        p1 = __builtin_amdgcn_mfma_f32_32x32x16_bf16(b1, qr[d0], p1, 0, 0, 0); }
}
template <int VB, bool SK>
__device__ __forceinline__ void pv_tile(f32x16* o, int vb0, bf16x8 pa0, bf16x8 pa1, bf16x8 pa2, bf16x8 pa3, bool act) {
    if (SK && !act) return;
#define TRRD(dst, off) asm volatile("ds_read_b64_tr_b16 %0, %1 offset:%2" : "=&v"(dst) : "v"(vb0), "i"(off) : "memory")
#define PV_D0(d0) do { s16x4 l0, l1, l2, l3, h0, h1, h2, h3; constexpr int b_ = VB * SHM_V + v_rd_off(d0, 0, 0);     \
        TRRD(l0, b_); TRRD(h0, b_ + 2048); TRRD(l1, b_ + 4096); TRRD(h1, b_ + 6144); TRRD(l2, b_ + 8192); TRRD(h2, b_ + 10240); TRRD(l3, b_ + 12288); TRRD(h3, b_ + 14336); \
        asm volatile("s_waitcnt lgkmcnt(0)" ::: "memory"); SBAR();                 \
        o[d0] = __builtin_amdgcn_mfma_f32_32x32x16_bf16(pa0, (bf16x8){l0[0], l0[1], l0[2], l0[3], h0[0], h0[1], h0[2], h0[3]}, o[d0], 0, 0, 0);   \
        o[d0] = __builtin_amdgcn_mfma_f32_32x32x16_bf16(pa1, (bf16x8){l1[0], l1[1], l1[2], l1[3], h1[0], h1[1], h1[2], h1[3]}, o[d0], 0, 0, 0);   \
        o[d0] = __builtin_amdgcn_mfma_f32_32x32x16_bf16(pa2, (bf16x8){l2[0], l2[1], l2[2], l2[3], h2[0], h2[1], h2[2], h2[3]}, o[d0], 0, 0, 0);   \
        o[d0] = __builtin_amdgcn_mfma_f32_32x32x16_bf16(pa3, (bf16x8){l3[0], l3[1], l3[2], l3[3], h3[0], h3[1], h3[2], h3[3]}, o[d0], 0, 0, 0); } while (0)
    PV_D0(0); PV_D0(1); PV_D0(2); PV_D0(3);
#undef PV_D0
#undef TRRD
}

template <class TIn, class TOut> struct BlockRef { const TIn* Q; const TIn* K; const TIn* V; TOut* O; const unsigned long long* M; int P0; };
template <class TIn> struct Seam {
    bf16x8 qr[8];
    bf16x8 st_v0, st_v1, st_k0, st_k1; f32x4 sf0, sf1, sf2, sf3;
    f32x4 tq[16];
};
__device__ __forceinline__ int swa_jlo(int, int) { return JLO; }
#define ROW(p, k0, rr) ((p) + (size_t)((k0) + (rr)) * KVS + sc)
#define VMW() asm volatile("s_waitcnt vmcnt(0)" ::: "memory")
#define VMWN(n) asm volatile("s_waitcnt vmcnt(%0)" :: "i"(n) : "memory")
#define SLOAD_H(Kp, Vp, k0) do { S.st_v0 = load8<TIn>(ROW(Vp, k0, sr)); S.st_v1 = load8<TIn>(ROW(Vp, k0, 32 + sr));              \
                         S.st_k0 = load8<TIn>(ROW(Kp, k0, sr)); S.st_k1 = load8<TIn>(ROW(Kp, k0, 32 + sr)); } while (0)
#define SWRITE_HK(bf) do { *(bf16x8*)(K_lds + (bf) * SHM_K + kws) = S.st_k0; *(bf16x8*)(K_lds + (bf) * SHM_K + kws + 32 * 256) = S.st_k1; } while (0)
#define SWRITE_HV(bf) do { *(bf16x8*)(V_lds + (bf) * SHM_V + vst0) = S.st_v0; *(bf16x8*)(V_lds + (bf) * SHM_V + vst1) = S.st_v1; } while (0)
#define SWRITE_H(bf) do { SWRITE_HV(bf); SWRITE_HK(bf); } while (0)
#define SLOAD_F(p, k0) do { S.sf0 = *(const f32x4*)ROW(p, k0, sr); S.sf1 = *(const f32x4*)(ROW(p, k0, sr) + 4);                \
                            S.sf2 = *(const f32x4*)ROW(p, k0, 32 + sr); S.sf3 = *(const f32x4*)(ROW(p, k0, 32 + sr) + 4); } while (0)
#define SWRITE_KF(bf) do { *(bf16x8*)(K_lds + (bf) * SHM_K + kws) = pack8(S.sf0, S.sf1); *(bf16x8*)(K_lds + (bf) * SHM_K + kws + 32 * 256) = pack8(S.sf2, S.sf3); } while (0)
#define SWRITE_VF(bf) do { *(bf16x8*)(V_lds + (bf) * SHM_V + vst0) = pack8(S.sf0, S.sf1); *(bf16x8*)(V_lds + (bf) * SHM_V + vst1) = pack8(S.sf2, S.sf3); } while (0)
template <class TIn, class TOut>
__device__ __forceinline__ void causal_swa_prime(const BlockRef<TIn, TOut>& cur, int W, char* lds, Seam<TIn>& S, int wv) {
    constexpr bool F32 = same_t<TIn, float>::v;
    int tid0_ = threadIdx.x; asm volatile("" : "+v"(tid0_)); (void)wv;
    const int tid = tid0_, wid = __builtin_amdgcn_readfirstlane(tid >> 6), lane = tid & 63, r32 = lane & 31, hi = lane >> 5;
    const int sr = tid >> 4, sc = (tid & 15) * 8, kws = KSWZ(sr, sc * 2); char* K_lds = lds + 2 * SHM_V;
    const int kb0 = swa_jlo(cur.P0, W) * KVBLK;
    for (int d0 = 0; d0 < 8; ++d0) S.qr[d0] = load8<TIn>(cur.Q + (size_t)(wid * QBLK + r32) * QST + d0 * 16 + hi * 8);
    if constexpr (F32) { SLOAD_F((const float*)cur.K, kb0); VMW(); SWRITE_KF(0); SBAR(); SLOAD_F((const float*)cur.V, kb0); }
    else { SLOAD_H(cur.K, cur.V, kb0); VMW(); SWRITE_HK(0); }
    __syncthreads();
}
template <class TIn, class TOut>
__device__ __forceinline__ void causal_swa_block(const BlockRef<TIn, TOut>& cur, const BlockRef<TIn, TOut>& nxt, int skv, int W, char* lds, Seam<TIn>& S, int wv) {
    constexpr bool F32 = same_t<TIn, float>::v;
    int tid0_ = threadIdx.x; asm volatile("" : "+v"(tid0_)); (void)wv;
    const int tid = tid0_, wid = __builtin_amdgcn_readfirstlane(tid >> 6), lane = tid & 63, r32 = lane & 31, hi = lane >> 5;
    const int j_lo = swa_jlo(cur.P0, W);
    int j_hi = (cur.P0 + QB - 1) / KVBLK + 1; if (j_hi > skv / KVBLK) j_hi = skv / KVBLK;
    const int NT = j_hi - j_lo;
    const int kbn = swa_jlo(nxt.P0, W) * KVBLK;
    const int qlo = cur.P0 + wid * QBLK; (void)qlo;
    const unsigned long long* mrow = cur.M + (size_t)(wid * QBLK + r32) * MTW;
    const int qm_unused = 0; (void)qm_unused;
    char* V_lds = lds; char* K_lds = lds + 2 * SHM_V;
    float* ws = (float*)(lds + 2 * SHM_V + 2 * SHM_K) + wid * 64; float* li_l = ws, * al_l = ws + 32;
    float m_reg = -1e30f, l_reg = 0; f32x16 o[4] = {};
    const int sr = tid >> 4, sc = (tid & 15) * 8, vst0 = v_st(sr, sc), vst1 = v_st(32 + sr, sc), kws = KSWZ(sr, sc * 2);
    const int vb0 = (int)(uintptr_t)V_lds + v_rd_base(lane);
    const TIn* Kh = cur.K; const TIn* Vh = cur.V;
#define RESC(a) do { if (__any((a) < 1.f)) { if (hi == 0) al_l[r32] = (a); asm volatile("s_waitcnt lgkmcnt(0)" ::: "memory");              \
                     for (int d_ = 0; d_ < 4; ++d_) for (int r = 0; r < 16; ++r) o[d_][r] *= al_l[crow(r, hi)]; } } while (0)
#define KBASE(t) ((j_lo + (t)) * KVBLK)
#define ACT(t) (KBASE(t) <= qlo + QBLK - 1 && KBASE(t) + KVBLK - 1 >= qlo - W + 1)
#define MASKT(P0_, P1_, t) mask_bits(P0_, P1_, (((t) & 1) ? mwB : mwA), hi)
#define MWLOAD(t) do { const int tt_ = (t) < NT ? (t) : NT - 1; if ((t) & 1) mwB = mrow[j_lo + tt_]; else mwA = mrow[j_lo + tt_]; } while (0)
    constexpr int NQL = F32 ? 16 : 8;
    constexpr bool SK = WSKIP && !F32;
#define SEAM_K0() do { VMWN(NQL); if constexpr (F32) { SWRITE_KF(0); SBAR(); SLOAD_F((const float*)nxt.V, kbn); } else { SWRITE_HK(0); } SBAR(); } while (0)
    f32x16 pA0, pA1, pB0, pB1; float mnA, mnB, alA, alB; bf16x8 pa0, pa1, pa2, pa3;
    unsigned long long mwA = mrow[j_lo], mwB = mrow[j_lo + (NT > 1 ? 1 : 0)];
    if constexpr (F32) { VMW(); SWRITE_VF(0); SBAR(); } else { SWRITE_HV(0); SBAR(); }
    if (NT > 1) { if constexpr (F32) SLOAD_F((const float*)Kh, KBASE(1)); else SLOAD_H(Kh, Vh, KBASE(1)); }
    SBAR(); qkt<0, SK>(pA0, pA1, K_lds, r32, hi, S.qr, ACT(0));
    if constexpr (F32) { if (NT > 1) { VMW(); SWRITE_KF(1); SBAR(); SLOAD_F((const float*)Vh, KBASE(1)); } }
    MASKT(pA0, pA1, 0); MWLOAD(2); partialSM(pA0, pA1, m_reg, mnA, alA);
    if (NT > 1) { VMW(); if constexpr (F32) { SWRITE_VF(1); SBAR(); if (NT > 2) SLOAD_F((const float*)Kh, KBASE(2)); } else SWRITE_H(1); }
    __syncthreads();
#define HALF_STEP(PX0, PX1, mnX, alX, PY0, PY1, alY, t, KB, VB, SB) do {                                                      \
        SBAR(); qkt<KB, SK>(PX0, PX1, K_lds, r32, hi, S.qr, ACT(t));                                             \
        finishSM(PY0, PY1, alY, l_reg, pa0, pa1, pa2, pa3); SBAR();                                                           \
        if ((t) + 1 < NT) { if constexpr (F32) { VMW(); SWRITE_KF(SB); SBAR(); SLOAD_F((const float*)Vh, KBASE((t) + 1)); }  \
                            else { SLOAD_H(Kh, Vh, KBASE((t) + 1)); } SBAR(); }                                               \
        pv_tile<VB, SK>(o, vb0, pa0, pa1, pa2, pa3, ACT((t) - 1)); MASKT(PX0, PX1, (t)); MWLOAD((t) + 2); partialSM(PX0, PX1, m_reg, mnX, alX);                                        \
        __syncthreads();                                                                                                      \
        if ((t) + 1 < NT) { VMW(); if constexpr (F32) { SWRITE_VF(SB); SBAR(); if ((t) + 2 < NT) SLOAD_F((const float*)Kh, KBASE((t) + 2)); } \
                            else { SWRITE_H(SB); } }                                                                          \
        RESC(alX); __syncthreads(); } while (0)
    for (int t = 1; t + 1 < NT; t += 2) {
        HALF_STEP(pB0, pB1, mnB, alB, pA0, pA1, alA, t, 1, 0, 0);
        HALF_STEP(pA0, pA1, mnA, alA, pB0, pB1, alB, t + 1, 0, 1, 1);
    }
    const bool even = (NT & 1) == 0;
    if (even) { SBAR(); qkt<1, SK>(pB0, pB1, K_lds, r32, hi, S.qr, ACT(NT - 1)); SBAR(); }
#define QROW(e) (nxt.Q + (size_t)(wid * QBLK + r32) * QST + ((e) >> 1) * 16 + hi * 8 + ((e) & 1) * 4)
    if constexpr (F32) { SLOAD_F((const float*)nxt.K, kbn); SBAR();
#pragma unroll
        for (int e = 0; e < 8; ++e) S.tq[e] = *(const f32x4*)QROW(e); }
    else { SLOAD_H(nxt.K, nxt.V, kbn); SBAR();
#pragma unroll
        for (int d0 = 0; d0 < 8; ++d0) S.qr[d0] = load8<TIn>(nxt.Q + (size_t)(wid * QBLK + r32) * QST + d0 * 16 + hi * 8); }
    SBAR();
    finishSM(pA0, pA1, alA, l_reg, pa0, pa1, pa2, pa3); SBAR();
    if constexpr (F32) {
#pragma unroll
        for (int e = 8; e < 16; ++e) S.tq[e] = *(const f32x4*)QROW(e); SBAR(); }
#undef QROW
    pv_tile<0, SK>(o, vb0, pa0, pa1, pa2, pa3, ACT(even ? NT - 2 : NT - 1));
    if (even) { MASKT(pB0, pB1, NT - 1); partialSM(pB0, pB1, m_reg, mnB, alB); __syncthreads(); RESC(alB);
        finishSM(pB0, pB1, alB, l_reg, pa0, pa1, pa2, pa3); SBAR(); pv_tile<1, SK>(o, vb0, pa0, pa1, pa2, pa3, ACT(NT - 1)); }
    SBAR(); SEAM_K0();
    if (hi == 0) li_l[r32] = l_reg; asm volatile("s_waitcnt lgkmcnt(0)" ::: "memory");
    float rli[16];
#pragma unroll
    for (int r = 0; r < 16; ++r) rli[r] = __builtin_amdgcn_rcpf(li_l[crow(r, hi)]);
    TOut* Ow = cur.O + (size_t)(wid * QBLK) * OST;
#pragma unroll
    for (int r = 0; r < 16; ++r) { const int orow = crow(r, hi);
#pragma unroll
        for (int d0 = 0; d0 < 4; ++d0) { const float v = o[d0][r] * rli[r];
            if constexpr (same_t<TOut, float>::v) { Ow[(size_t)orow * OST + d0 * 32 + r32] = v; }
            else { const float vn = __shfl_xor(v, 1);
                   if ((r32 & 1) == 0) *(unsigned*)(Ow + (size_t)orow * OST + d0 * 32 + r32) = cvtpk(v, vn); } } }
    if constexpr (F32) {
#pragma unroll
        for (int d0 = 0; d0 < 8; ++d0) S.qr[d0] = pack8(S.tq[2 * d0], S.tq[2 * d0 + 1]); }
    __syncthreads();
#undef RESC
#undef KBASE
#undef ACT
#undef MASKT
#undef MWLOAD
#undef SEAM_K0
#undef HALF_STEP
}
#undef ROW
#undef VMW
#undef VMWN
#undef SLOAD_H
#undef SWRITE_HK
#undef SWRITE_HV
#undef SWRITE_H
#undef SLOAD_F
#undef SWRITE_KF
#undef SWRITE_VF

}

constexpr int NWAVES = 8, NTHREADS = 512;
constexpr int DM = 2048, SEQ = 4096, NMETA = 16, TP = 4112, NBP = 2, SBN = 8, PAST = 16384, NPG = 128;
constexpr int XROW0 = 8192, SROW0 = 8224, NROWS = 8232, MPAD = 8448, FF = 8192, MAINM = 8192, XR = 48;
constexpr int NA_IN = 6144, NB_IN = 4176, NB_PAD = 4352, NC_IN = 12352, NC_PAD = 12544, DVW = 4096, CDIM = 8192;
constexpr float ALPHA = 1.6817928305074292f;
constexpr float LN_EPS = 1e-5f, RMS_EPS = 1e-6f;
constexpr int SCW = 4160, SCSW = 16448, KIROWS = 4128, NSKEY = PAST + 1;
constexpr int POS_SAMPLE_IDX = TP;

constexpr size_t O_YP = 0, O_YS = O_YP + (size_t)NBP * SEQ * DM, O_CAP = O_YS + (size_t)SBN * DM, O_CAS = O_CAP + 2 * NBP * 2 * DM,
                 O_KP = O_CAS + 2 * SBN * 2 * DM, O_VP = O_KP + (size_t)NBP * TP * 512, O_IKP = O_VP + (size_t)NBP * TP * 512,
                 O_KS = O_IKP + (size_t)NBP * TP * 64, O_VS = O_KS + SBN * 512, O_IKS = O_VS + SBN * 512, O_CCP = O_IKS + SBN * 64,
                 O_CCS = O_CCP + (size_t)NBP * 3 * CDIM, O_DP = O_CCS + (size_t)SBN * 3 * CDIM, O_DS = O_DP + (size_t)NBP * 32 * 128 * 128,
                 O_END = O_DS + (size_t)SBN * 32 * 128 * 128;

constexpr size_t MiB = 1u << 20;
constexpr size_t WS_CTL = 0, CTL_ZERO_BYTES = 1 * MiB;
constexpr size_t WS_TAB128 = 1 * MiB, WS_TAB64 = 4 * MiB, WS_WI = 6 * MiB, WS_G = 7 * MiB, WS_BETA = 9 * MiB, WS_CNT = 11 * MiB, WS_KIB = 12 * MiB,
                 WS_SCS = 14 * MiB, WS_IDXL = 16 * MiB, WS_X = 26 * MiB, WS_QR = 60 * MiB, WS_QI = 94 * MiB, WS_Z = 112 * MiB, WS_Y = 180 * MiB,
                 WS_BIG = 248 * MiB, WS_QKVC = 452 * MiB, WS_SC = 584 * MiB, WS_W = 716 * MiB;
constexpr size_t WSZ_A_IN = (size_t)NA_IN * DM * 2, WSZ_A_OUT = (size_t)DM * DM * 2, WSZ_B_IN = (size_t)NB_PAD * DM * 2, WSZ_B_OUT = (size_t)DM * DM * 2,
                 WSZ_C_IN = (size_t)NC_PAD * DM * 2, WSZ_C_OUT = (size_t)DM * DVW * 2, WSZ_W1 = (size_t)FF * DM * 2, WSZ_W2 = (size_t)DM * FF * 2;
constexpr size_t WS_WA_IN = WS_W, WS_WA_OUT = WS_WA_IN + 2 * WSZ_A_IN, WS_WB_IN = WS_WA_OUT + 2 * WSZ_A_OUT, WS_WB_OUT = WS_WB_IN + WSZ_B_IN,
                 WS_WC_IN = WS_WB_OUT + WSZ_B_OUT, WS_WC_OUT = WS_WC_IN + WSZ_C_IN, WS_W1 = WS_WC_OUT + WSZ_C_OUT, WS_W2 = WS_W1 + 4 * WSZ_W1,
                 WS_ZP = WS_W2 + 4 * WSZ_W2, WS_QKF = WS_ZP + 4 * MiB, WS_DWG = WS_QKF + 130 * MiB, WS_DUG = WS_DWG + 66 * MiB, WS_END = WS_DUG + 66 * MiB;
constexpr size_t WS_MASK = WS_IDXL, WS_KS = WS_Z, WS_VS = WS_Z + 9 * MiB;
constexpr size_t WS_DAF = WS_Z, WS_DTG = WS_Y, WS_DTB = WS_Y + 33 * MiB, WS_DPG = WS_QR, WS_DKT = WS_QKF, WS_DVT = WS_QKF + 33 * MiB, WS_DGC = WS_QI, WS_DBT = WS_QI + 2 * MiB;
constexpr int SP = 4352, SPAD = 240, MTW = 68;
constexpr int CW_BAR = 4096;

constexpr int RING_BYTES = 131072, LDSCTL_OFF = RING_BYTES, MISC_OFF = LDSCTL_OFF + 320, LDS_BYTES = 147456;

typedef unsigned short bf16;
typedef unsigned v4u __attribute__((ext_vector_type(4)));
typedef unsigned v2u __attribute__((ext_vector_type(2)));
typedef float f32x4 __attribute__((ext_vector_type(4)));
typedef float f32x2 __attribute__((ext_vector_type(2)));
typedef short bf16x8 __attribute__((ext_vector_type(8)));
typedef float f32x16 __attribute__((ext_vector_type(16)));
typedef __bf16 bf16x2_t __attribute__((ext_vector_type(2)));

#define LDS_WAIT() asm volatile("s_waitcnt lgkmcnt(0)" ::: "memory")
#define WAVE_SYNC() do { asm volatile("s_waitcnt lgkmcnt(0)" ::: "memory"); __builtin_amdgcn_wave_barrier(); } while (0)

__device__ __forceinline__ float bflo(unsigned w) { return __uint_as_float(w << 16); }
__device__ __forceinline__ float bfhi(unsigned w) { return __uint_as_float(w & 0xffff0000u); }
__device__ __forceinline__ float bf2f(bf16 h) { return __uint_as_float((unsigned)h << 16); }
__device__ __forceinline__ unsigned pk2(float lo, float hi) { f32x2 v = {lo, hi}; bf16x2_t b = __builtin_convertvector(v, bf16x2_t); return __builtin_bit_cast(unsigned, b); }
__device__ __forceinline__ bf16 f2bf(float f) { return (bf16)(pk2(f, 0.f) & 0xffffu); }
__device__ __forceinline__ float wave_sum(float v) {
#pragma unroll
    for (int o = 1; o < 64; o <<= 1) v += __shfl_xor(v, o);
    return v;
}
__device__ __forceinline__ float wave_max(float v) {
#pragma unroll
    for (int o = 1; o < 64; o <<= 1) v = fmaxf(v, __shfl_xor(v, o));
    return v;
}
__device__ __forceinline__ int wave_sum_i(int v) {
#pragma unroll
    for (int o = 1; o < 64; o <<= 1) v += __shfl_xor(v, o);
    return v;
}
__device__ __forceinline__ float wave_sum_dpp(float v) {
    v += __int_as_float(__builtin_amdgcn_update_dpp(0, __float_as_int(v), 0x128, 0xf, 0xf, false));
    v += __int_as_float(__builtin_amdgcn_update_dpp(0, __float_as_int(v), 0x124, 0xf, 0xf, false));
    v += __int_as_float(__builtin_amdgcn_update_dpp(0, __float_as_int(v), 0x122, 0xf, 0xf, false));
    v += __int_as_float(__builtin_amdgcn_update_dpp(0, __float_as_int(v), 0x121, 0xf, 0xf, false));
    const int iv = __float_as_int(v);
    return (__int_as_float(__builtin_amdgcn_readlane(iv, 0)) + __int_as_float(__builtin_amdgcn_readlane(iv, 16))) + (__int_as_float(__builtin_amdgcn_readlane(iv, 32)) + __int_as_float(__builtin_amdgcn_readlane(iv, 48)));
}
__device__ __forceinline__ int wave_sum_dpp_i(int v) {
    v += __builtin_amdgcn_update_dpp(0, v, 0x128, 0xf, 0xf, false);
    v += __builtin_amdgcn_update_dpp(0, v, 0x124, 0xf, 0xf, false);
    v += __builtin_amdgcn_update_dpp(0, v, 0x122, 0xf, 0xf, false);
    v += __builtin_amdgcn_update_dpp(0, v, 0x121, 0xf, 0xf, false);
    return __builtin_amdgcn_readlane(v, 0) + __builtin_amdgcn_readlane(v, 16) + __builtin_amdgcn_readlane(v, 32) + __builtin_amdgcn_readlane(v, 48);
}
__device__ __forceinline__ float row16_sum(float v) {
    v += __int_as_float(__builtin_amdgcn_update_dpp(0, __float_as_int(v), 0x128, 0xf, 0xf, false));
    v += __int_as_float(__builtin_amdgcn_update_dpp(0, __float_as_int(v), 0x124, 0xf, 0xf, false));
    v += __int_as_float(__builtin_amdgcn_update_dpp(0, __float_as_int(v), 0x122, 0xf, 0xf, false));
    v += __int_as_float(__builtin_amdgcn_update_dpp(0, __float_as_int(v), 0x121, 0xf, 0xf, false));
    return v;
}
__device__ __forceinline__ float silu_f(float x) { return x / (1.f + __expf(-x)); }
__device__ __forceinline__ int prow(int b, int t) { return t >= NMETA ? b * SEQ + (t - NMETA) : XROW0 + b * NMETA + t; }
__device__ __forceinline__ void row_bt(int r, int& b, int& t) { if (r < XROW0) { b = r >> 12; t = (r & 4095) + NMETA; } else { b = (r - XROW0) >> 4; t = (r - XROW0) & 15; } }
__device__ __forceinline__ void unpack8(const v4u w, float (&f)[8]) {
    f[0] = bflo(w.x); f[1] = bfhi(w.x); f[2] = bflo(w.y); f[3] = bfhi(w.y); f[4] = bflo(w.z); f[5] = bfhi(w.z); f[6] = bflo(w.w); f[7] = bfhi(w.w);
}
__device__ __forceinline__ v4u pack8(const float (&f)[8]) { v4u w; w.x = pk2(f[0], f[1]); w.y = pk2(f[2], f[3]); w.z = pk2(f[4], f[5]); w.w = pk2(f[6], f[7]); return w; }

__device__ __forceinline__ void transpose_item(const float* W, int K, int N, int Npad, bf16* WT, LAS float* scr, int item, int lane) {
    const int nblk = Npad / 32, kb = item / nblk, nb = item % nblk, k0 = 64 * kb, n0 = 32 * nb;
    const int n = n0 + (lane & 31); const bool ok = n < N;
    float wv_[32];
#pragma unroll
    for (int i = 0; i < 32; ++i) { const int kk = 2 * i + (lane >> 5); wv_[i] = W[(size_t)(k0 + kk) * N + (ok ? n : N - 1)]; }
#pragma unroll
    for (int i = 0; i < 32; ++i) { const int kk = 2 * i + (lane >> 5); scr[kk * 33 + (lane & 31)] = ok ? wv_[i] : 0.f; }
    LDS_WAIT(); __builtin_amdgcn_wave_barrier();
    const int c = lane & 7;
#pragma unroll
    for (int j = 0; j < 4; ++j) { const int nn = (lane >> 3) + 8 * j; const LAS float* s = scr + (8 * c) * 33 + nn;
        v4u o; o.x = pk2(s[0 * 33], s[1 * 33]); o.y = pk2(s[2 * 33], s[3 * 33]); o.z = pk2(s[4 * 33], s[5 * 33]); o.w = pk2(s[6 * 33], s[7 * 33]);
        *(v4u*)(WT + (size_t)(n0 + nn) * K + k0 + 8 * c) = o; }
    LDS_WAIT(); __builtin_amdgcn_wave_barrier();
}

struct Ptrs {
    const float *x_prompt, *x_sample, *state_conv_a, *cache_k, *cache_v, *cache_ik, *state_conv_c, *state_delta;
    const int* page_table;
    const float *meta, *w_in_a, *conv_w_a, *w_out_a, *w_in_b, *w_out_b, *w_in_c, *conv_w_c, *a_log, *dt_bias, *norm_w, *w_out_c, *ln1_g, *ln1_b, *w1, *w2, *ln2_g, *ln2_b;
    float* out; unsigned char* ws;
};

__device__ __forceinline__ void p0_prologue(const Ptrs& P, LAS unsigned char* lds, int gw, int NGW, int wave, int lane) {
    LAS float* scr = (LAS float*)(lds + wave * 16384);
    unsigned char* ws = P.ws;
    constexpr int I_A_IN = (DM / 64) * (NA_IN / 32), I_A_OUT = (DM / 64) * (DM / 32), I_B_IN = (DM / 64) * (NB_PAD / 32), I_B_OUT = I_A_OUT,
                  I_C_IN = (DM / 64) * (NC_PAD / 32), I_C_OUT = (DVW / 64) * (DM / 32), I_W1 = (DM / 64) * (FF / 32), I_W2 = (FF / 64) * (DM / 32);
    constexpr int NITEMS = 2 * I_A_IN + 2 * I_A_OUT + I_B_IN + I_B_OUT + I_C_IN + I_C_OUT + 4 * I_W1 + 4 * I_W2;
#define TR_(cnt, Wp, Kk, Nn, Np, WTp) if (r < (cnt)) { transpose_item((Wp), (Kk), (Nn), (Np), (bf16*)(WTp), scr, r, lane); continue; } r -= (cnt);
    for (int it = gw; it < NITEMS; it += NGW) {
        int r = it;
        TR_(I_A_IN, P.w_in_a, DM, NA_IN, NA_IN, ws + WS_WA_IN)
        TR_(I_A_IN, P.w_in_a + (size_t)DM * NA_IN, DM, NA_IN, NA_IN, ws + WS_WA_IN + WSZ_A_IN)
        TR_(I_A_OUT, P.w_out_a, DM, DM, DM, ws + WS_WA_OUT)
        TR_(I_A_OUT, P.w_out_a + (size_t)DM * DM, DM, DM, DM, ws + WS_WA_OUT + WSZ_A_OUT)
        TR_(I_B_IN, P.w_in_b, DM, NB_IN, NB_PAD, ws + WS_WB_IN)
        TR_(I_B_OUT, P.w_out_b, DM, DM, DM, ws + WS_WB_OUT)
        TR_(I_C_IN, P.w_in_c, DM, NC_IN, NC_PAD, ws + WS_WC_IN)
        TR_(I_C_OUT, P.w_out_c, DVW, DM, DM, ws + WS_WC_OUT)
        TR_(I_W1, P.w1, DM, FF, FF, ws + WS_W1)
        TR_(I_W1, P.w1 + (size_t)DM * FF, DM, FF, FF, ws + WS_W1 + WSZ_W1)
        TR_(I_W1, P.w1 + 2 * (size_t)DM * FF, DM, FF, FF, ws + WS_W1 + 2 * WSZ_W1)
        TR_(I_W1, P.w1 + 3 * (size_t)DM * FF, DM, FF, FF, ws + WS_W1 + 3 * WSZ_W1)
        TR_(I_W2, P.w2, FF, DM, DM, ws + WS_W2)
        TR_(I_W2, P.w2 + (size_t)DM * FF, FF, DM, DM, ws + WS_W2 + WSZ_W2)
        TR_(I_W2, P.w2 + 2 * (size_t)DM * FF, FF, DM, DM, ws + WS_W2 + 2 * WSZ_W2)
        transpose_item(P.w2 + 3 * (size_t)DM * FF, FF, DM, DM, (bf16*)(ws + WS_W2 + 3 * WSZ_W2), scr, r, lane);
    }
#undef TR_
    bf16* X = (bf16*)(ws + WS_X);
    for (int r = gw; r < MPAD; r += NGW) {
        const float* src = nullptr;
        if (r < XROW0) src = P.x_prompt + (size_t)r * DM;
        else if (r < SROW0) src = P.meta + (size_t)((r - XROW0) & 15) * DM;
        else if (r < NROWS) src = P.x_sample + (size_t)(r - SROW0) * DM;
#pragma unroll
        for (int j = 0; j < 4; ++j) { const int c = 512 * j + 8 * lane; v4u o = {0u, 0u, 0u, 0u};
            if (src) { const f32x4 a = *(const f32x4*)(src + c), b = *(const f32x4*)(src + c + 4); o.x = pk2(a.x, a.y); o.y = pk2(a.z, a.w); o.z = pk2(b.x, b.y); o.w = pk2(b.z, b.w); }
            *(v4u*)(X + (size_t)r * DM + c) = o; }
    }
    f32x2* t128 = (f32x2*)(ws + WS_TAB128); f32x2* t64 = (f32x2*)(ws + WS_TAB64);
    const int gt = gw * 64 + lane, NGT = NGW * 64;
    for (int e = gt; e < (TP + 1) * 96; e += NGT) {
        const int pi = e / 96, i = e % 96; const float pos = (float)(pi == TP ? PAST : pi);
        const float ex = (i < 64) ? (float)(2 * i) * (1.f / 128.f) : (float)(2 * (i - 64)) * (1.f / 64.f);
        const float inv = __builtin_amdgcn_exp2f(-ex * 13.287712379549449f);
        const float angf = pos * inv;
        double rev = (double)angf * 0.15915494309189535; rev -= __builtin_rint(rev);
        const float rf = (float)rev; const float sn = __builtin_amdgcn_sinf(rf), cs = __builtin_amdgcn_cosf(rf);
        if (i < 64) t128[pi * 64 + i] = (f32x2){cs, sn}; else t64[pi * 32 + (i - 64)] = (f32x2){cs, sn};
    }
}

__device__ __forceinline__ void ln_phase(const float* Z, const float* ZP, bf16* X, bf16* Xo, const float* gam, const float* bet, float* yp, float* ys, int gw, int NGW, int lane) {
    for (int r = gw; r < NROWS; r += NGW) {
        const bool ext = r >= XROW0; bf16* xr = X + (size_t)r * DM;
        f32x4 gq[8], bq_[8];
#pragma unroll
        for (int j = 0; j < 4; ++j) { const int c = 512 * j + 8 * lane; gq[2 * j] = *(const f32x4*)(gam + c); gq[2 * j + 1] = *(const f32x4*)(gam + c + 4); bq_[2 * j] = *(const f32x4*)(bet + c); bq_[2 * j + 1] = *(const f32x4*)(bet + c + 4); }
        float v[32]; float s = 0.f;
#pragma unroll
        for (int j = 0; j < 4; ++j) { const int c = 512 * j + 8 * lane; const v4u xv = *(const v4u*)(xr + c);
            float xf[8]; unpack8(xv, xf);
            if (ext) {
                const float* zr = ZP + (size_t)(r - XROW0) * DM; f32x4 z0 = *(const f32x4*)(zr + c), z1 = *(const f32x4*)(zr + c + 4);
#pragma unroll
                for (int sl = 1; sl < 8; ++sl) { z0 += *(const f32x4*)(zr + (size_t)sl * XR * DM + c); z1 += *(const f32x4*)(zr + (size_t)sl * XR * DM + c + 4); }
                xf[0] = ALPHA * xf[0] + z0.x; xf[1] = ALPHA * xf[1] + z0.y; xf[2] = ALPHA * xf[2] + z0.z; xf[3] = ALPHA * xf[3] + z0.w;
                xf[4] = ALPHA * xf[4] + z1.x; xf[5] = ALPHA * xf[5] + z1.y; xf[6] = ALPHA * xf[6] + z1.z; xf[7] = ALPHA * xf[7] + z1.w;
            }
#pragma unroll
            for (int i = 0; i < 8; ++i) { v[8 * j + i] = xf[i]; s += xf[i]; } }
        const float mean = wave_sum_dpp(s) * (1.f / DM); float s2 = 0.f;
#pragma unroll
        for (int i = 0; i < 32; ++i) { v[i] -= mean; s2 += v[i] * v[i]; }
        const float rstd = 1.f / sqrtf(wave_sum_dpp(s2) * (1.f / DM) + LN_EPS);
        float* of = nullptr;
        if (yp) { if (r < XROW0) of = yp + (size_t)r * DM; else if (r >= SROW0) of = ys + (size_t)(r - SROW0) * DM; }
#pragma unroll
        for (int j = 0; j < 4; ++j) { const int c = 512 * j + 8 * lane; const f32x4 g0 = gq[2 * j], g1 = gq[2 * j + 1], b0 = bq_[2 * j], b1 = bq_[2 * j + 1];
            float o[8];
            o[0] = v[8 * j + 0] * rstd * g0.x + b0.x; o[1] = v[8 * j + 1] * rstd * g0.y + b0.y; o[2] = v[8 * j + 2] * rstd * g0.z + b0.z; o[3] = v[8 * j + 3] * rstd * g0.w + b0.w;
            o[4] = v[8 * j + 4] * rstd * g1.x + b1.x; o[5] = v[8 * j + 5] * rstd * g1.y + b1.y; o[6] = v[8 * j + 6] * rstd * g1.z + b1.z; o[7] = v[8 * j + 7] * rstd * g1.w + b1.w;
            *(v4u*)(Xo + (size_t)r * DM + c) = pack8(o);
            if (of) { *(f32x4*)(of + c) = (f32x4){o[0], o[1], o[2], o[3]}; *(f32x4*)(of + c + 4) = (f32x4){o[4], o[5], o[6], o[7]}; } }
    }
}

__device__ __forceinline__ void load_u(const bf16* BCH, int row, int c0, float (&u)[8]) {
    const v4u cg = *(const v4u*)(BCH + (size_t)row * NA_IN + DM + c0), hh = *(const v4u*)(BCH + (size_t)row * NA_IN + 2 * DM + c0);
    float a[8], b[8]; unpack8(cg, a); unpack8(hh, b);
#pragma unroll
    for (int i = 0; i < 8; ++i) u[i] = a[i] * b[i];
}
__device__ __forceinline__ void convA_phase(const bf16* BCH, bf16* Y, const float* cw, const float* hist, float* outp, float* outs, int gtid, int NT) {
    constexpr int RUN = 8, NRUN = TP / RUN;
    for (int it = gtid; it < (NBP * NRUN + SBN) * 256; it += NT) {
        const int c0 = (it & 255) * 8, ru = it >> 8;
        float w0[8], w1[8], w2[8];
        { const f32x4 a = *(const f32x4*)(cw + c0), b = *(const f32x4*)(cw + c0 + 4); w0[0] = a.x; w0[1] = a.y; w0[2] = a.z; w0[3] = a.w; w0[4] = b.x; w0[5] = b.y; w0[6] = b.z; w0[7] = b.w; }
        { const f32x4 a = *(const f32x4*)(cw + DM + c0), b = *(const f32x4*)(cw + DM + c0 + 4); w1[0] = a.x; w1[1] = a.y; w1[2] = a.z; w1[3] = a.w; w1[4] = b.x; w1[5] = b.y; w1[6] = b.z; w1[7] = b.w; }
        { const f32x4 a = *(const f32x4*)(cw + 2 * DM + c0), b = *(const f32x4*)(cw + 2 * DM + c0 + 4); w2[0] = a.x; w2[1] = a.y; w2[2] = a.z; w2[3] = a.w; w2[4] = b.x; w2[5] = b.y; w2[6] = b.z; w2[7] = b.w; }
        float u0[8], u1[8], u2[8];
        if (ru < NBP * NRUN) {
            const int b = ru / NRUN, t0 = (ru % NRUN) * RUN;
            if (t0 >= 1) load_u(BCH, prow(b, t0 - 1), c0, u1); else {
#pragma unroll
                for (int i = 0; i < 8; ++i) u1[i] = 0.f; }
            if (t0 >= 2) load_u(BCH, prow(b, t0 - 2), c0, u0); else {
#pragma unroll
                for (int i = 0; i < 8; ++i) u0[i] = 0.f; }
            const int r0 = prow(b, t0);
            v4u bq[RUN], cq[RUN], hq_[RUN];
#pragma unroll
            for (int k = 0; k < RUN; ++k) { const bf16* rp = BCH + (size_t)(r0 + k) * NA_IN + c0; bq[k] = *(const v4u*)rp; cq[k] = *(const v4u*)(rp + DM); hq_[k] = *(const v4u*)(rp + 2 * DM); }
#pragma unroll
            for (int k = 0; k < RUN; ++k) {
                const int r = r0 + k, t = t0 + k;
                { float ca[8], ha[8]; unpack8(cq[k], ca); unpack8(hq_[k], ha);
#pragma unroll
                  for (int i = 0; i < 8; ++i) u2[i] = ca[i] * ha[i]; }
                float bg[8]; unpack8(bq[k], bg);
                float y[8];
#pragma unroll
                for (int i = 0; i < 8; ++i) y[i] = bg[i] * (w0[i] * u0[i] + w1[i] * u1[i] + w2[i] * u2[i]);
                *(v4u*)(Y + (size_t)r * DM + c0) = pack8(y);
                if (t >= TP - 2) { float* o = outp + ((size_t)(b * 2 + (t - (TP - 2)))) * DM + c0; *(f32x4*)o = (f32x4){u2[0], u2[1], u2[2], u2[3]}; *(f32x4*)(o + 4) = (f32x4){u2[4], u2[5], u2[6], u2[7]}; }
#pragma unroll
                for (int i = 0; i < 8; ++i) { u0[i] = u1[i]; u1[i] = u2[i]; }
            }
        } else {
            const int sb = ru - NBP * NRUN, r = SROW0 + sb;
            load_u(BCH, r, c0, u2);
            const float* h0 = hist + ((size_t)(sb * 2 + 0)) * DM + c0; const float* h1 = hist + ((size_t)(sb * 2 + 1)) * DM + c0;
            const f32x4 a0 = *(const f32x4*)h0, a1 = *(const f32x4*)(h0 + 4), b0 = *(const f32x4*)h1, b1 = *(const f32x4*)(h1 + 4);
            u0[0] = a0.x; u0[1] = a0.y; u0[2] = a0.z; u0[3] = a0.w; u0[4] = a1.x; u0[5] = a1.y; u0[6] = a1.z; u0[7] = a1.w;
            u1[0] = b0.x; u1[1] = b0.y; u1[2] = b0.z; u1[3] = b0.w; u1[4] = b1.x; u1[5] = b1.y; u1[6] = b1.z; u1[7] = b1.w;
            float* o0 = outs + ((size_t)(sb * 2 + 0)) * DM + c0; float* o1 = outs + ((size_t)(sb * 2 + 1)) * DM + c0;
            *(f32x4*)o0 = b0; *(f32x4*)(o0 + 4) = b1;
            *(f32x4*)o1 = (f32x4){u2[0], u2[1], u2[2], u2[3]}; *(f32x4*)(o1 + 4) = (f32x4){u2[4], u2[5], u2[6], u2[7]};
            float bg[8]; unpack8(*(const v4u*)(BCH + (size_t)r * NA_IN + c0), bg);
            float y[8];
#pragma unroll
            for (int i = 0; i < 8; ++i) y[i] = bg[i] * (w0[i] * u0[i] + w1[i] * u1[i] + w2[i] * u2[i]);
            *(v4u*)(Y + (size_t)r * DM + c0) = pack8(y);
        }
    }
}

constexpr float QSCALE = 0.08838834764831845f;
__device__ __forceinline__ void rope_phase(const bf16* PROJ, const Ptrs& P, int gw, int NGW, int lane) {
    unsigned char* ws = P.ws;
    const f32x2* t128 = (const f32x2*)(ws + WS_TAB128); const f32x2* t64 = (const f32x2*)(ws + WS_TAB64);
    bf16* Qr = (bf16*)(ws + WS_QR); bf16* QI = (bf16*)(ws + WS_QI); bf16* KIb = (bf16*)(ws + WS_KIB); float* WI = (float*)(ws + WS_WI);
    bf16* Ks = (bf16*)(ws + WS_KS); bf16* Vs = (bf16*)(ws + WS_VS);
    for (int pr_ = gw; pr_ < NBP * SPAD; pr_ += NGW) {
        const size_t o = ((size_t)((pr_ / SPAD) * SP + (pr_ % SPAD))) * 512 + 8 * lane; *(v4u*)(Ks + o) = (v4u){0u, 0u, 0u, 0u}; *(v4u*)(Vs + o) = (v4u){0u, 0u, 0u, 0u}; }
    for (int r = gw; r < NROWS; r += NGW) {
        const bf16* pr = PROJ + (size_t)r * NB_PAD;
        int pi; float *ko, *vo, *iko; bf16* kib = nullptr; bf16 *ksq = nullptr, *vsq = nullptr;
        if (r < SROW0) { int b, t; row_bt(r, b, t); pi = t; ksq = Ks + ((size_t)(b * SP + t + SPAD)) * 512; vsq = Vs + ((size_t)(b * SP + t + SPAD)) * 512; ko = P.out + O_KP + ((size_t)(b * TP + t)) * 512; vo = P.out + O_VP + ((size_t)(b * TP + t)) * 512; iko = P.out + O_IKP + ((size_t)(b * TP + t)) * 64; kib = KIb + ((size_t)(b * KIROWS + t)) * 64; }
        else { const int sb = r - SROW0; pi = POS_SAMPLE_IDX; ko = P.out + O_KS + (size_t)sb * 512; vo = P.out + O_VS + (size_t)sb * 512; iko = P.out + O_IKS + (size_t)sb * 64; }
        const f32x2* c128 = t128 + (size_t)pi * 64; const f32x2* c64 = t64 + (size_t)pi * 32;
        const int hd = lane >> 2, sub = lane & 3;
        {
            float x1[16], x2[16], o1[16], o2[16];
            { float t8[8]; unpack8(*(const v4u*)(pr + hd * 128 + 16 * sub), t8);
#pragma unroll
              for (int i = 0; i < 8; ++i) x1[i] = t8[i]; unpack8(*(const v4u*)(pr + hd * 128 + 16 * sub + 8), t8);
#pragma unroll
              for (int i = 0; i < 8; ++i) x1[8 + i] = t8[i]; unpack8(*(const v4u*)(pr + hd * 128 + 64 + 16 * sub), t8);
#pragma unroll
              for (int i = 0; i < 8; ++i) x2[i] = t8[i]; unpack8(*(const v4u*)(pr + hd * 128 + 64 + 16 * sub + 8), t8);
#pragma unroll
              for (int i = 0; i < 8; ++i) x2[8 + i] = t8[i]; }
#pragma unroll
            for (int i = 0; i < 16; i += 2) { const f32x4 cs = *(const f32x4*)(c128 + 16 * sub + i);
                o1[i] = (x1[i] * cs.x - x2[i] * cs.y) * QSCALE; o2[i] = (x2[i] * cs.x + x1[i] * cs.y) * QSCALE;
                o1[i + 1] = (x1[i + 1] * cs.z - x2[i + 1] * cs.w) * QSCALE; o2[i + 1] = (x2[i + 1] * cs.z + x1[i + 1] * cs.w) * QSCALE; }
            bf16* qo = Qr + (size_t)r * DM + hd * 128 + 16 * sub;
            { float t8[8];
#pragma unroll
              for (int i = 0; i < 8; ++i) t8[i] = o1[i]; *(v4u*)qo = pack8(t8);
#pragma unroll
              for (int i = 0; i < 8; ++i) t8[i] = o1[8 + i]; *(v4u*)(qo + 8) = pack8(t8);
#pragma unroll
              for (int i = 0; i < 8; ++i) t8[i] = o2[i]; *(v4u*)(qo + 64) = pack8(t8);
#pragma unroll
              for (int i = 0; i < 8; ++i) t8[i] = o2[8 + i]; *(v4u*)(qo + 72) = pack8(t8); }
        }
        if (lane < 16) {
            const bf16* kp = pr + 2048 + hd * 128 + 16 * sub;
#pragma unroll
            for (int hf = 0; hf < 2; ++hf) { float x1[8], x2[8], o1[8], o2[8]; unpack8(*(const v4u*)(kp + 8 * hf), x1); unpack8(*(const v4u*)(kp + 64 + 8 * hf), x2);
#pragma unroll
                for (int i = 0; i < 8; i += 2) { const f32x4 cs = *(const f32x4*)(c128 + 16 * sub + 8 * hf + i);
                    o1[i] = x1[i] * cs.x - x2[i] * cs.y; o2[i] = x2[i] * cs.x + x1[i] * cs.y; o1[i + 1] = x1[i + 1] * cs.z - x2[i + 1] * cs.w; o2[i + 1] = x2[i + 1] * cs.z + x1[i + 1] * cs.w; }
                float* kq = ko + hd * 128 + 16 * sub + 8 * hf;
                *(f32x4*)kq = (f32x4){o1[0], o1[1], o1[2], o1[3]}; *(f32x4*)(kq + 4) = (f32x4){o1[4], o1[5], o1[6], o1[7]};
                *(f32x4*)(kq + 64) = (f32x4){o2[0], o2[1], o2[2], o2[3]}; *(f32x4*)(kq + 68) = (f32x4){o2[4], o2[5], o2[6], o2[7]};
                if (ksq) { *(v4u*)(ksq + hd * 128 + 16 * sub + 8 * hf) = pack8(o1); *(v4u*)(ksq + hd * 128 + 64 + 16 * sub + 8 * hf) = pack8(o2); } }
        }
        {
            const v4u vv = *(const v4u*)(pr + 2560 + 8 * lane); float vf[8]; unpack8(vv, vf);
            *(f32x4*)(vo + 8 * lane) = (f32x4){vf[0], vf[1], vf[2], vf[3]}; *(f32x4*)(vo + 8 * lane + 4) = (f32x4){vf[4], vf[5], vf[6], vf[7]};
            if (vsq) *(v4u*)(vsq + 8 * lane) = vv;
        }
        {
            float x1[8], x2[8], o1[8], o2[8]; unpack8(*(const v4u*)(pr + 3072 + hd * 64 + 8 * sub), x1); unpack8(*(const v4u*)(pr + 3072 + hd * 64 + 32 + 8 * sub), x2);
#pragma unroll
            for (int i = 0; i < 8; i += 2) { const f32x4 cs = *(const f32x4*)(c64 + 8 * sub + i);
                o1[i] = x1[i] * cs.x - x2[i] * cs.y; o2[i] = x2[i] * cs.x + x1[i] * cs.y; o1[i + 1] = x1[i + 1] * cs.z - x2[i + 1] * cs.w; o2[i + 1] = x2[i + 1] * cs.z + x1[i + 1] * cs.w; }
            *(v4u*)(QI + (size_t)r * 1024 + hd * 64 + 8 * sub) = pack8(o1); *(v4u*)(QI + (size_t)r * 1024 + hd * 64 + 32 + 8 * sub) = pack8(o2);
        }
        if (lane < 4) {
            float x1[8], x2[8], o1[8], o2[8]; unpack8(*(const v4u*)(pr + 4096 + 8 * sub), x1); unpack8(*(const v4u*)(pr + 4096 + 32 + 8 * sub), x2);
#pragma unroll
            for (int i = 0; i < 8; i += 2) { const f32x4 cs = *(const f32x4*)(c64 + 8 * sub + i);
                o1[i] = x1[i] * cs.x - x2[i] * cs.y; o2[i] = x2[i] * cs.x + x1[i] * cs.y; o1[i + 1] = x1[i + 1] * cs.z - x2[i + 1] * cs.w; o2[i + 1] = x2[i + 1] * cs.z + x1[i + 1] * cs.w; }
            float* io = iko + 8 * sub;
            *(f32x4*)io = (f32x4){o1[0], o1[1], o1[2], o1[3]}; *(f32x4*)(io + 4) = (f32x4){o1[4], o1[5], o1[6], o1[7]};
            *(f32x4*)(io + 32) = (f32x4){o2[0], o2[1], o2[2], o2[3]}; *(f32x4*)(io + 36) = (f32x4){o2[4], o2[5], o2[6], o2[7]};
            if (kib) { *(v4u*)(kib + 8 * sub) = pack8(o1); *(v4u*)(kib + 32 + 8 * sub) = pack8(o2); }
        } else if (lane < 6) {
            float wv[8]; unpack8(*(const v4u*)(pr + 4160 + 8 * (lane - 4)), wv); float* wo = WI + (size_t)r * 16 + 8 * (lane - 4);
            *(f32x4*)wo = (f32x4){wv[0], wv[1], wv[2], wv[3]}; *(f32x4*)(wo + 4) = (f32x4){wv[4], wv[5], wv[6], wv[7]};
        }
    }
}

__device__ __forceinline__ void indexer_prompt(const Ptrs& P, LAS unsigned char* lds, int tid, int wave, int lane) {
    unsigned char* ws = P.ws;
    const bf16* QI = (const bf16*)(ws + WS_QI); const bf16* KIb = (const bf16*)(ws + WS_KIB); const float* WI = (const float*)(ws + WS_WI); float* SC = (float*)(ws + WS_SC);
    const int n = lane & 31, h8 = lane >> 5;
    const int qsel = (n >> 2) & 1, head = (n & 3) + 4 * (n >> 3);
    constexpr int NG = TP / 16;
    constexpr int KROW = 144, TBUF = 128 * KROW;
    for (int it = blockIdx.x; it < 2 * NG; it += gridDim.x) {
        int b, qg;
        if (it < 256) { b = it & 1; qg = it >> 1; } else if (it < 512) { b = it & 1; qg = 256 - ((it - 256) >> 1); } else { b = it - 512; qg = 128; }
        const int t0 = 16 * qg + 2 * wave;
        const bf16* qa = QI + (size_t)prow(b, t0 + qsel) * 1024 + head * 64 + 8 * h8;
        bf16x8 a[4];
#pragma unroll
        for (int kk = 0; kk < 4; ++kk) a[kk] = *(const bf16x8*)(qa + 16 * kk);
        const int tq = t0 + h8;
        const float* wp = WI + (size_t)prow(b, tq) * 16;
        float w[16];
#pragma unroll
        for (int i = 0; i < 4; ++i) { const f32x4 x = *(const f32x4*)(wp + 4 * i); w[4 * i] = x.x; w[4 * i + 1] = x.y; w[4 * i + 2] = x.z; w[4 * i + 3] = x.w; }
        const int ntile = ((16 * qg + 15) >> 5) + 1, ntrip = (ntile + 3) >> 2;
        float* scrow = SC + ((size_t)(b * TP + tq)) * SCW;
        const bf16* kbase = KIb + (size_t)b * KIROWS * 64;
        const int p0 = tid, p1 = tid + 512;
        const int l0 = (p0 >> 3) * KROW + (p0 & 7) * 16, l1 = (p1 >> 3) * KROW + (p1 & 7) * 16;
        asm volatile("s_waitcnt lgkmcnt(0)\n\ts_barrier" ::: "memory");
        v4u g0 = *(const v4u*)(kbase + (size_t)p0 * 8), g1 = *(const v4u*)(kbase + (size_t)p1 * 8);
        *(LAS v4u*)(lds + l0) = g0; *(LAS v4u*)(lds + l1) = g1;
        for (int tr = 0; tr < ntrip; ++tr) {
            const int cur = tr & 1;
            if (tr + 1 < ntrip) { const size_t ko = (size_t)(tr + 1) * 128 * 64;
                const int kmax = KIROWS * 64 - 8;
                const size_t o0 = ko + (size_t)p0 * 8, o1 = ko + (size_t)p1 * 8;
                g0 = *(const v4u*)(kbase + (o0 <= (size_t)kmax ? o0 : (size_t)kmax)); g1 = *(const v4u*)(kbase + (o1 <= (size_t)kmax ? o1 : (size_t)kmax)); }
            asm volatile("s_waitcnt lgkmcnt(0)\n\ts_barrier" ::: "memory");
            const LAS unsigned char* kb = lds + cur * TBUF + n * KROW + h8 * 16;
#pragma unroll
            for (int u = 0; u < 4; ++u) {
                f32x16 acc;
#pragma unroll
                for (int i = 0; i < 16; ++i) acc[i] = 0.f;
#pragma unroll
                for (int kk = 0; kk < 4; ++kk) acc = __builtin_amdgcn_mfma_f32_32x32x16_bf16(a[kk], *(const LAS bf16x8*)(kb + u * 32 * KROW + kk * 32), acc, 0, 0, 0);
                float sc = 0.f;
#pragma unroll
                for (int i = 0; i < 16; ++i) sc += w[i] * fmaxf(acc[i], 0.f);
                const int s = 32 * (4 * tr + u) + n;
                if (s <= tq) scrow[s] = sc;
            }
            if (tr + 1 < ntrip) { *(LAS v4u*)(lds + (cur ^ 1) * TBUF + l0) = g0; *(LAS v4u*)(lds + (cur ^ 1) * TBUF + l1) = g1; }
        }
    }
    asm volatile("s_waitcnt lgkmcnt(0)\n\ts_barrier" ::: "memory");
}

__device__ __forceinline__ void indexer_sample(const Ptrs& P, LAS unsigned char* lds, int tid) {
    unsigned char* ws = P.ws;
    const bf16* QI = (const bf16*)(ws + WS_QI); const float* WI = (const float*)(ws + WS_WI); float* SCS = (float*)(ws + WS_SCS);
    LAS float* lq = (LAS float*)lds;
    LAS float* lw = lq + 1024;
    constexpr int NCH = (NSKEY + 511) / 512;
    for (int item = blockIdx.x; item < SBN * NCH; item += gridDim.x) {
        const int sb = item / NCH, ch = item % NCH, r = SROW0 + sb;
        __syncthreads();
        for (int e = tid; e < 1024; e += NTHREADS) lq[e] = bf2f(QI[(size_t)r * 1024 + e]);
        if (tid < 16) lw[tid] = WI[(size_t)r * 16 + tid];
        __syncthreads();
        const int s = ch * 512 + tid;
        if (s < NSKEY) {
            const float* kr = (s < PAST) ? P.cache_ik + ((size_t)P.page_table[sb * NPG + (s >> 7)] * 128 + (s & 127)) * 64 : P.out + O_IKS + (size_t)sb * 64;
            f32x4 kv[16];
#pragma unroll
            for (int i = 0; i < 16; ++i) kv[i] = *(const f32x4*)(kr + 4 * i);
            float sc = 0.f;
            for (int h = 0; h < 16; ++h) { float d = 0.f;
#pragma unroll
                for (int i = 0; i < 16; ++i) { const f32x4 q = *(const LAS f32x4*)(lq + h * 64 + 4 * i); d += q.x * kv[i].x + q.y * kv[i].y + q.z * kv[i].z + q.w * kv[i].w; }
                sc += lw[h] * fmaxf(d, 0.f); }
            SCS[(size_t)sb * SCSW + s] = sc;
        }
    }
    __syncthreads();
}

__device__ __forceinline__ unsigned ordkey(float f) { const unsigned u = __float_as_uint(f); return (u & 0x80000000u) ? ~u : (u | 0x80000000u); }
constexpr int TOPK = 256;
__device__ __forceinline__ void topk_wave_mask(const float* sc, int n, unsigned long long* mrow, int lane) {
    constexpr int NS = MTW, M0 = SPAD / 64;
    static_assert(M0 == dattn::JLO, "first real key tile");
    unsigned key[NS];
#pragma unroll
    for (int m = M0; m < NS; ++m) { const int sidx = lane + 64 * m - SPAD; const int ci = sidx < 0 ? 0 : (sidx < n ? sidx : n - 1); const float v = sc[ci]; key[m] = (sidx >= 0 && sidx < n) ? ordkey(v) : 0u; }
    if (n <= TOPK) {
#pragma unroll
        for (int m = M0; m < NS; ++m) { const unsigned long long w = __ballot(key[m] != 0u); if (lane == 0) mrow[m] = w; }
        return;
    }
    unsigned T = 0u;
    for (int bit = 31; bit >= 0; --bit) {
        const unsigned cand = T | (1u << bit); int c = 0, cv = 0;
#pragma unroll
        for (int m = M0; m < NS; ++m) { if ((m & 1) != 0) c += __popcll(__ballot(key[m] >= cand)); else cv += (key[m] >= cand) ? 1 : 0; }
        c += wave_sum_dpp_i(cv);
        if (c >= TOPK) T = cand;
    }
    int cg = 0;
#pragma unroll
    for (int m = M0; m < NS; ++m) cg += __popcll(__ballot(key[m] > T));
    const int need = TOPK - cg;
    int base_e = 0;
    const unsigned long long lt = (1ull << lane) - 1ull;
#pragma unroll
    for (int m = M0; m < NS; ++m) {
        const bool pg = key[m] > T, pe = key[m] == T;
        const unsigned long long me = __ballot(pe);
        const int pre_e = __popcll(me & lt);
        const unsigned long long w = __ballot(pg || (pe && (base_e + pre_e) < need));
        if (lane == 0) mrow[m] = w;
        base_e += __popcll(me);
    }
}
__device__ __forceinline__ void topk_block(const float* sc, int n, int* outIdx, int* outCnt, LAS unsigned* ls, int tid, int wave, int lane) {
    constexpr int NS = (NSKEY + NTHREADS - 1) / NTHREADS;
    unsigned key[NS];
#pragma unroll
    for (int m = 0; m < NS; ++m) { const int e = tid + NTHREADS * m; const float v = sc[e < n ? e : n - 1]; key[m] = (e < n) ? ordkey(v) : 0u; }
    unsigned T = 0u;
    for (int bit = 31; bit >= 0; --bit) {
        const unsigned cand = T | (1u << bit); int c = 0;
#pragma unroll
        for (int m = 0; m < NS; ++m) c += (key[m] >= cand) ? 1 : 0;
        c = wave_sum_i(c);
        LAS unsigned* buf = ls + (bit & 1) * 8;
        if (lane == 0) buf[wave] = (unsigned)c;
        __syncthreads();
        int tot = 0;
#pragma unroll
        for (int w = 0; w < 8; ++w) tot += (int)buf[w];
        if (tot >= TOPK) T = cand;
    }
    __syncthreads();
    if (tid == 0) { unsigned z_ = 0u; asm volatile("" : "+v"(z_)); ls[16] = z_; ls[17] = z_; }
    __syncthreads();
#pragma unroll
    for (int m = 0; m < NS; ++m) { const int e = tid + NTHREADS * m; if (key[m] > T) { const unsigned pos = atomicAdd((unsigned*)(ls + 16), 1u); if (pos < (unsigned)TOPK) outIdx[pos] = e; } }
    __syncthreads();
    const unsigned cg = ls[16];
    const unsigned need = (unsigned)TOPK - cg;
#pragma unroll
    for (int m = 0; m < NS; ++m) { const int e = tid + NTHREADS * m; if (key[m] == T) { const unsigned pos = atomicAdd((unsigned*)(ls + 17), 1u); if (pos < need) outIdx[cg + pos] = e; } }
    if (tid == 0) *outCnt = TOPK;
    __syncthreads();
}
__device__ __forceinline__ void select_phase(const Ptrs& P, LAS unsigned char* lds, int gw, int NGW, int tid, int wave, int lane) {
    unsigned char* ws = P.ws;
    const float* SC = (const float*)(ws + WS_SC); const float* SCS = (const float*)(ws + WS_SCS); int* IDXL = (int*)(ws + WS_IDXL); int* CNT = (int*)(ws + WS_CNT);
    for (int sb = blockIdx.x; sb < SBN; sb += gridDim.x) topk_block(SCS + (size_t)sb * SCSW, NSKEY, IDXL + (size_t)(SROW0 + sb) * TOPK, CNT + SROW0 + sb, (LAS unsigned*)lds, tid, wave, lane);
    unsigned long long* MASK = (unsigned long long*)(ws + WS_MASK);
    for (int r = gw; r < SROW0; r += NGW) { int b, t; row_bt(r, b, t);
        if (r < XROW0) topk_wave_mask(SC + ((size_t)(b * TP + t)) * SCW, t + 1, MASK + ((size_t)(b * SP + t + SPAD)) * MTW, lane);
        else { if (lane <= t) IDXL[(size_t)r * TOPK + lane] = lane; if (lane == 0) CNT[r] = t + 1; } }
}

__device__ __forceinline__ void attn_phase(const Ptrs& P, bf16* O, LAS unsigned char* lds, int gw, int NGW, int wave, int lane) {
    unsigned char* ws = P.ws;
    const bf16* Qr = (const bf16*)(ws + WS_QR); const int* IDXL = (const int*)(ws + WS_IDXL); const int* CNT = (const int*)(ws + WS_CNT);
    LAS float* lq = (LAS float*)(lds + wave * 12288);
    LAS f32x4* lp = (LAS f32x4*)(lds + wave * 12288 + 2048);
    LAS unsigned long long* lkp = (LAS unsigned long long*)(lds + wave * 12288 + 6144);
    LAS unsigned long long* lvp = (LAS unsigned long long*)(lds + wave * 12288 + 8192);
    for (int item = gw; item < (NROWS - XROW0) * 4; item += NGW) {
        const int r = XROW0 + (item >> 2), n = item & 3;
        const int cnt = CNT[r];
        WAVE_SYNC();
        { float qf[8]; unpack8(*(const v4u*)(Qr + (size_t)r * DM + n * 512 + 8 * lane), qf);
          *(LAS f32x4*)(lq + 8 * lane) = (f32x4){qf[0], qf[1], qf[2], qf[3]}; *(LAS f32x4*)(lq + 8 * lane + 4) = (f32x4){qf[4], qf[5], qf[6], qf[7]}; }
        const float* kp[4];
#pragma unroll
        for (int j = 0; j < 4; ++j) {
            const int e = lane + 64 * j; const int s = (e < cnt) ? IDXL[(size_t)r * TOPK + e] : 0;
            const float *kq, *vq;
            if (r < SROW0) { const int b = (r < XROW0) ? (r >> 12) : ((r - XROW0) >> 4); kq = P.out + O_KP + ((size_t)(b * TP + s)) * 512; vq = P.out + O_VP + ((size_t)(b * TP + s)) * 512; }
            else { const int sb = r - SROW0;
                if (s < PAST) { const size_t off = ((size_t)P.page_table[sb * NPG + (s >> 7)] * 128 + (s & 127)) * 512; kq = P.cache_k + off; vq = P.cache_v + off; }
                else { kq = P.out + O_KS + (size_t)sb * 512; vq = P.out + O_VS + (size_t)sb * 512; } }
            kp[j] = kq + n * 128; lkp[e] = (unsigned long long)(kq + n * 128); lvp[e] = (unsigned long long)(vq + n * 128);
        }
        WAVE_SYNC();
        float acc[4][4];
#pragma unroll
        for (int g = 0; g < 4; ++g)
#pragma unroll
            for (int j = 0; j < 4; ++j) acc[g][j] = 0.f;
#pragma unroll 4
        for (int d4 = 0; d4 < 32; ++d4) {
            f32x4 qv[4];
#pragma unroll
            for (int g = 0; g < 4; ++g) qv[g] = *(const LAS f32x4*)(lq + g * 128 + 4 * d4);
#pragma unroll
            for (int j = 0; j < 4; ++j) { const f32x4 kv = *(const f32x4*)(kp[j] + 4 * d4);
#pragma unroll
                for (int g = 0; g < 4; ++g) acc[g][j] += qv[g].x * kv.x + qv[g].y * kv.y + qv[g].z * kv.z + qv[g].w * kv.w; }
        }
        float linv[4];
#pragma unroll
        for (int g = 0; g < 4; ++g) {
            float m = -INFINITY;
#pragma unroll
            for (int j = 0; j < 4; ++j) { if (lane + 64 * j >= cnt) acc[g][j] = -INFINITY; m = fmaxf(m, acc[g][j]); }
            m = wave_max(m); float l = 0.f;
#pragma unroll
            for (int j = 0; j < 4; ++j) { acc[g][j] = __expf(acc[g][j] - m); l += acc[g][j]; }
            linv[g] = 1.f / wave_sum(l);
        }
#pragma unroll
        for (int j = 0; j < 4; ++j) lp[lane + 64 * j] = (f32x4){acc[0][j], acc[1][j], acc[2][j], acc[3][j]};
        WAVE_SYNC();
        float o[4][2];
#pragma unroll
        for (int g = 0; g < 4; ++g) { o[g][0] = 0.f; o[g][1] = 0.f; }
#pragma unroll 8
        for (int e = 0; e < cnt; ++e) {
            const float* vp = (const float*)lvp[e]; const f32x2 vv = *(const f32x2*)(vp + 2 * lane); const f32x4 p = lp[e];
            o[0][0] += p.x * vv.x; o[0][1] += p.x * vv.y; o[1][0] += p.y * vv.x; o[1][1] += p.y * vv.y; o[2][0] += p.z * vv.x; o[2][1] += p.z * vv.y; o[3][0] += p.w * vv.x; o[3][1] += p.w * vv.y;
        }
#pragma unroll
        for (int g = 0; g < 4; ++g) *(unsigned*)(O + (size_t)r * DM + (4 * n + g) * 128 + 2 * lane) = pk2(o[g][0] * linv[g], o[g][1] * linv[g]);
    }
}

__device__ __forceinline__ void convC_finish(float (&acc)[8], int it) {
    float ss = 0.f;
#pragma unroll
    for (int i = 0; i < 8; ++i) { acc[i] = silu_f(acc[i]); ss += acc[i] * acc[i]; }
    if (it < 8) { ss = row16_sum(ss); float rn = 1.f / sqrtf(ss + RMS_EPS); if (it < 4) rn *= QSCALE;
#pragma unroll
        for (int i = 0; i < 8; ++i) acc[i] *= rn; }
}
__device__ __forceinline__ void convC_phase(const bf16* PROJC, const Ptrs& P, int gw, int NGW, int lane) {
    unsigned char* ws = P.ws;
    bf16* QKVC = (bf16*)(ws + WS_QKVC); float* QKF = (float*)(ws + WS_QKF); float* G = (float*)(ws + WS_G); float* BETA = (float*)(ws + WS_BETA);
    const float* cw = P.conv_w_c;
    constexpr int RUN = 8, NRUN = TP / RUN;
    for (int item = gw; item < 16 * NBP * NRUN; item += NGW) {
        const int it = item & 15, ru = item >> 4, b = ru / NRUN, t0 = (ru % NRUN) * RUN, ch0 = it * 512 + 8 * lane;
        float w[4][8];
#pragma unroll
        for (int j = 0; j < 4; ++j) { const f32x4 w0 = *(const f32x4*)(cw + (size_t)j * CDIM + ch0), w1 = *(const f32x4*)(cw + (size_t)j * CDIM + ch0 + 4);
            w[j][0] = w0.x; w[j][1] = w0.y; w[j][2] = w0.z; w[j][3] = w0.w; w[j][4] = w1.x; w[j][5] = w1.y; w[j][6] = w1.z; w[j][7] = w1.w; }
        const int r0 = prow(b, t0);
        v4u xr[RUN + 3];
#pragma unroll
        for (int j = 0; j < 3; ++j) { const int tt = t0 - 3 + j; xr[j] = tt >= 0 ? *(const v4u*)(PROJC + (size_t)prow(b, tt) * NC_PAD + ch0) : (v4u){0u, 0u, 0u, 0u}; }
#pragma unroll
        for (int k = 0; k < RUN; ++k) xr[3 + k] = *(const v4u*)(PROJC + (size_t)(r0 + k) * NC_PAD + ch0);
        float x[RUN + 3][8];
#pragma unroll
        for (int j = 0; j < RUN + 3; ++j) unpack8(xr[j], x[j]);
#pragma unroll
        for (int k = 0; k < RUN; ++k) {
            float acc[8];
#pragma unroll
            for (int i = 0; i < 8; ++i) acc[i] = w[0][i] * x[k][i] + w[1][i] * x[k + 1][i] + w[2][i] * x[k + 2][i] + w[3][i] * x[k + 3][i];
            convC_finish(acc, it);
            *(v4u*)(QKVC + (size_t)(r0 + k) * CDIM + ch0) = pack8(acc);
            const int t = t0 + k;
            if (t >= TP - 3) { float* o = P.out + O_CCP + ((size_t)(b * 3 + (t - (TP - 3)))) * CDIM + ch0;
                *(f32x4*)o = (f32x4){x[k + 3][0], x[k + 3][1], x[k + 3][2], x[k + 3][3]}; *(f32x4*)(o + 4) = (f32x4){x[k + 3][4], x[k + 3][5], x[k + 3][6], x[k + 3][7]}; }
        }
    }
    for (int item = gw; item < 16 * SBN; item += NGW) {
        const int it = item & 15, sb = item >> 4, r = SROW0 + sb, ch0 = it * 512 + 8 * lane;
        float x[4][8];
#pragma unroll
        for (int j = 0; j < 3; ++j) { const float* hp = P.state_conv_c + ((size_t)(sb * 3 + j)) * CDIM + ch0; const f32x4 a = *(const f32x4*)hp, c = *(const f32x4*)(hp + 4);
            x[j][0] = a.x; x[j][1] = a.y; x[j][2] = a.z; x[j][3] = a.w; x[j][4] = c.x; x[j][5] = c.y; x[j][6] = c.z; x[j][7] = c.w; }
        unpack8(*(const v4u*)(PROJC + (size_t)r * NC_PAD + ch0), x[3]);
        float acc[8];
#pragma unroll
        for (int i = 0; i < 8; ++i) acc[i] = 0.f;
#pragma unroll
        for (int j = 0; j < 4; ++j) { const f32x4 w0 = *(const f32x4*)(cw + (size_t)j * CDIM + ch0), w1 = *(const f32x4*)(cw + (size_t)j * CDIM + ch0 + 4);
            acc[0] += w0.x * x[j][0]; acc[1] += w0.y * x[j][1]; acc[2] += w0.z * x[j][2]; acc[3] += w0.w * x[j][3];
            acc[4] += w1.x * x[j][4]; acc[5] += w1.y * x[j][5]; acc[6] += w1.z * x[j][6]; acc[7] += w1.w * x[j][7]; }
        convC_finish(acc, it);
        if (it < 8) { float* qk = QKF + (size_t)r * 4096 + ch0; *(f32x4*)qk = (f32x4){acc[0], acc[1], acc[2], acc[3]}; *(f32x4*)(qk + 4) = (f32x4){acc[4], acc[5], acc[6], acc[7]}; }
        *(v4u*)(QKVC + (size_t)r * CDIM + ch0) = pack8(acc);
        float* o = P.out + O_CCS + ((size_t)(sb * 3)) * CDIM + ch0;
#pragma unroll
        for (int j = 0; j < 3; ++j) { *(f32x4*)(o + (size_t)j * CDIM) = (f32x4){x[j + 1][0], x[j + 1][1], x[j + 1][2], x[j + 1][3]}; *(f32x4*)(o + (size_t)j * CDIM + 4) = (f32x4){x[j + 1][4], x[j + 1][5], x[j + 1][6], x[j + 1][7]}; }
    }
    for (int e = gw * 64 + lane; e < NROWS * 32; e += NGW * 64) {
        const int r = e >> 5, h = e & 31;
        const float braw = bf2f(PROJC[(size_t)r * NC_PAD + 12288 + h]), araw = bf2f(PROJC[(size_t)r * NC_PAD + 12320 + h]);
        const float xx = araw + P.dt_bias[h]; const float sp = xx > 20.f ? xx : __logf(1.f + __expf(xx));
        G[e] = -__expf(P.a_log[h]) * sp; BETA[e] = 1.f / (1.f + __expf(-braw));
    }
}

struct Tok { f32x4 k0, k1, q0, q1; unsigned v; float g, b; };
__device__ __forceinline__ void tok_load(Tok& T, const float* QKF, const bf16* QKVC, const float* G, const float* BETA, int row, int h, int rg, int col0) {
    const float* base = QKF + (size_t)row * 4096 + (h >> 1) * 128 + 8 * rg;
    T.q0 = *(const f32x4*)base; T.q1 = *(const f32x4*)(base + 4); T.k0 = *(const f32x4*)(base + 2048); T.k1 = *(const f32x4*)(base + 2052);
    T.v = *(const unsigned*)(QKVC + (size_t)row * CDIM + 4096 + h * 128 + col0);
    T.g = G[(size_t)row * 32 + h]; T.b = BETA[(size_t)row * 32 + h];
}
__device__ __forceinline__ f32x2 tok_step(f32x2 (&S)[8], const Tok& T) {
    const float kk[8] = {T.k0.x, T.k0.y, T.k0.z, T.k0.w, T.k1.x, T.k1.y, T.k1.z, T.k1.w};
    const float qq[8] = {T.q0.x, T.q0.y, T.q0.z, T.q0.w, T.q1.x, T.q1.y, T.q1.z, T.q1.w};
    const float a = __expf(T.g);
    f32x2 d0 = S[0] * kk[0], d1 = S[1] * kk[1];
#pragma unroll
    for (int i = 2; i < 8; i += 2) { d0 += S[i] * kk[i]; d1 += S[i + 1] * kk[i + 1]; }
    f32x2 d = d0 + d1;
    d.x = row16_sum(d.x); d.y = row16_sum(d.y);
    const f32x2 tv = {bflo(T.v), bfhi(T.v)};
    const f32x2 dl = (tv - d * a) * T.b;
    f32x2 o0 = {0.f, 0.f}, o1 = {0.f, 0.f};
#pragma unroll
    for (int i = 0; i < 8; i += 2) { S[i] = S[i] * a + dl * kk[i]; o0 += S[i] * qq[i]; S[i + 1] = S[i + 1] * a + dl * kk[i + 1]; o1 += S[i + 1] * qq[i + 1]; }
    f32x2 o = o0 + o1;
    o.x = row16_sum(o.x); o.y = row16_sum(o.y);
    return o;
}
__device__ __forceinline__ void delta_phase(const Ptrs& P, int wave, int lane) {
    unsigned char* ws = P.ws;
    const bf16* QKVC = (const bf16*)(ws + WS_QKVC); const float* QKF = (const float*)(ws + WS_QKF); const float* G = (const float*)(ws + WS_G); const float* BETA = (const float*)(ws + WS_BETA); bf16* OF = (bf16*)(ws + WS_SC);
    const int cg = lane >> 4, rg = lane & 15;
    {
        for (int item = blockIdx.x * 8 + wave; item < SBN * 32 * 16; item += gridDim.x * 8) {
            const int sb = item >> 9, h = (item >> 4) & 31, col0 = 8 * (item & 15) + 2 * cg;
            const size_t so = ((size_t)((sb * 32 + h) * 128 + 8 * rg)) * 128 + col0;
            f32x2 S[8];
#pragma unroll
            for (int i = 0; i < 8; ++i) S[i] = *(const f32x2*)(P.state_delta + so + (size_t)i * 128);
            Tok T; tok_load(T, QKF, QKVC, G, BETA, SROW0 + sb, h, rg, col0);
            const f32x2 o = tok_step(S, T);
            if (rg == 0) *(unsigned*)(OF + (size_t)(SROW0 + sb) * DVW + h * 128 + col0) = pk2(o.x, o.y);
            float* op = P.out + O_DS + so;
#pragma unroll
            for (int i = 0; i < 8; ++i) *(f32x2*)(op + (size_t)i * 128) = S[i];
        }
    }
}
__device__ __forceinline__ void normC_phase(const bf16* PROJC, bf16* Y, const Ptrs& P, int gw, int NGW, int lane) {
    const bf16* OF = (const bf16*)(P.ws + WS_SC);
    const int d0 = 8 * (lane & 15);
    float nw[8];
    { const f32x4 a = *(const f32x4*)(P.norm_w + d0), b = *(const f32x4*)(P.norm_w + d0 + 4); nw[0] = a.x; nw[1] = a.y; nw[2] = a.z; nw[3] = a.w; nw[4] = b.x; nw[5] = b.y; nw[6] = b.z; nw[7] = b.w; }
    for (int r = gw; r < NROWS; r += NGW) {
        v4u oq[8], zz[8];
#pragma unroll
        for (int it = 0; it < 8; ++it) { const int hd = it * 4 + (lane >> 4);
            oq[it] = *(const v4u*)(OF + (size_t)r * DVW + hd * 128 + d0); zz[it] = *(const v4u*)(PROJC + (size_t)r * NC_PAD + 8192 + hd * 128 + d0); }
#pragma unroll
        for (int it = 0; it < 8; ++it) {
            const int hd = it * 4 + (lane >> 4);
            float o[8]; unpack8(oq[it], o);
            float ss = 0.f;
#pragma unroll
            for (int i = 0; i < 8; ++i) ss += o[i] * o[i];
            ss = row16_sum(ss);
            const float rs = 1.f / sqrtf(ss * (1.f / 128.f) + RMS_EPS);
            float z[8]; unpack8(zz[it], z);
#pragma unroll
            for (int i = 0; i < 8; ++i) o[i] = o[i] * rs * nw[i] * silu_f(z[i]);
            *(v4u*)(Y + (size_t)r * DVW + hd * 128 + d0) = pack8(o);
        }
    }
}


__device__ __forceinline__ void dense_attn_phase(const Ptrs& P, bf16* O, char* lds, int wv) {
    unsigned char* ws = P.ws;
    const bf16* Qr = (const bf16*)(ws + WS_QR); const bf16* Ks = (const bf16*)(ws + WS_KS); const bf16* Vs = (const bf16*)(ws + WS_VS);
    const unsigned long long* MASK = (const unsigned long long*)(ws + WS_MASK);
    typedef dattn::BlockRef<bf16, bf16> BR;
    for (int it0 = blockIdx.x; it0 < 256; it0 += gridDim.x) {
        const int grp = it0 & 7, idx = it0 >> 3;
        const int b = grp >> 2, kvh = grp & 3, h = kvh * 4 + (idx >> 3), x = idx & 7;
        BR A, B;
        const int qa = 1 + x, qb = 16 - x;
        A.Q = Qr + ((size_t)(b * SEQ + 256 * (qa - 1))) * DM + h * 128; A.O = O + ((size_t)(b * SEQ + 256 * (qa - 1))) * DM + h * 128;
        B.Q = Qr + ((size_t)(b * SEQ + 256 * (qb - 1))) * DM + h * 128; B.O = O + ((size_t)(b * SEQ + 256 * (qb - 1))) * DM + h * 128;
        A.K = B.K = Ks + (size_t)b * SP * 512 + kvh * 128; A.V = B.V = Vs + (size_t)b * SP * 512 + kvh * 128;
        A.P0 = 256 * qa; B.P0 = 256 * qb;
        A.M = MASK + ((size_t)(b * SP + A.P0)) * MTW; B.M = MASK + ((size_t)(b * SP + B.P0)) * MTW;
        dattn::Seam<bf16> S;
        dattn::causal_swa_prime<bf16, bf16>(A, SP, lds, S, wv);
        dattn::causal_swa_block<bf16, bf16>(A, B, SP, SP, lds, S, wv);
        dattn::causal_swa_block<bf16, bf16>(B, B, SP, SP, lds, S, wv);
    }
}

constexpr int NCH = 65, CPAD = 48;
constexpr int NUQ = NBP * 16 * NCH, NUH = NBP * 32 * NCH;
__device__ __forceinline__ int crow32(int r, int hi) { return (r & 3) + 8 * (r >> 2) + 4 * hi; }
__device__ __forceinline__ int chunk_row(int b, int c, int i) { const int t = 64 * c + i - CPAD; return t >= 0 ? prow(b, t) : -1; }
__device__ __forceinline__ float incl_scan64(float v, int lane) {
#pragma unroll
    for (int o = 1; o < 64; o <<= 1) { const float u = __shfl_up(v, o); if (lane >= o) v += u; }
    return v;
}
#define MFMA32(a, b, c) __builtin_amdgcn_mfma_f32_32x32x16_bf16((a), (b), (c), 0, 0, 0)
__device__ __forceinline__ bf16x8 sel8(bool ok, bf16x8 v) { const bf16x8 z = {0, 0, 0, 0, 0, 0, 0, 0}; return ok ? v : z; }
__device__ __forceinline__ int sw23(int x) { return (x & ~12) | ((x & 4) << 1) | ((x & 8) >> 1); }
__device__ __forceinline__ int fidx64(int row, int xs) { return ((((row >> 5) * 2 + (xs >> 5)) * 2 + ((xs >> 4) & 1)) * 64 + (row & 31) + 32 * ((xs >> 3) & 1)) * 8 + (xs & 7); }

__device__ __forceinline__ v4u pack_frag(const f32x16& x, int s) { v4u w; w.x = pk2(x[8 * s], x[8 * s + 1]); w.y = pk2(x[8 * s + 2], x[8 * s + 3]); w.z = pk2(x[8 * s + 4], x[8 * s + 5]); w.w = pk2(x[8 * s + 6], x[8 * s + 7]); return w; }
__device__ __forceinline__ void delta_d1_unit(unsigned char* ws, LAS unsigned char* lds, int uq, int wave, int lane) {
    asm volatile("" : "+v"(lane));
    const bf16* QKVC = (const bf16*)(ws + WS_QKVC); const float* G = (const float*)(ws + WS_G); const float* BETA = (const float*)(ws + WS_BETA);
    float* AF = (float*)(ws + WS_DAF); bf16* PG = (bf16*)(ws + WS_DPG); bf16* KT = (bf16*)(ws + WS_DKT); bf16* VT = (bf16*)(ws + WS_DVT);
    float* GC = (float*)(ws + WS_DGC); float* BT = (float*)(ws + WS_DBT);
    LAS float* lg = (LAS float*)(lds + wave * 1024);
    const int m = lane & 31, half = lane >> 5;
    const bf16x8 zf = {0, 0, 0, 0, 0, 0, 0, 0};
    {
        const int c = uq % NCH, bh = uq / NCH, hq = bh & 15, b = bh >> 4;
        { const int row = chunk_row(b, c, lane);
#pragma unroll
          for (int hh = 0; hh < 2; ++hh) { const int h = 2 * hq + hh; const float g = row >= 0 ? G[(size_t)row * 32 + h] : 0.f, bt = row >= 0 ? BETA[(size_t)row * 32 + h] : 0.f;
              const float gc = incl_scan64(g, lane); lg[hh * 64 + lane] = gc; lg[128 + hh * 64 + lane] = bt;
              const size_t uh = ((size_t)(b * 32 + h)) * NCH + c; GC[uh * 64 + lane] = gc; BT[uh * 64 + lane] = bt; } }
        const int row0 = chunk_row(b, c, m), row1 = chunk_row(b, c, 32 + m);
        const bf16* r0 = QKVC + (size_t)(row0 < 0 ? 0 : row0) * CDIM; const bf16* r1 = QKVC + (size_t)(row1 < 0 ? 0 : row1) * CDIM;
        f32x16 kk00, kk10, kk11, qk00, qk10, qk11;
#pragma unroll
        for (int i = 0; i < 16; ++i) { kk00[i] = 0.f; kk10[i] = 0.f; kk11[i] = 0.f; qk00[i] = 0.f; qk10[i] = 0.f; qk11[i] = 0.f; }
        const int sm = sw23(m);
        bf16* kt0 = KT + (size_t)uq * 128 * 64 + half * 32 + ((sm >> 4) & 1) * 512 + ((sm >> 3) & 1) * 256 + (sm & 7);
#pragma unroll 1
        for (int kh = 0; kh < 2; ++kh) {
            bf16x8 kf0[4], kf1[4], qf0[4], qf1[4];
#pragma unroll
            for (int u = 0; u < 4; ++u) { const int off = hq * 128 + 16 * (4 * kh + u) + 8 * half;
                kf0[u] = sel8(row0 >= 0, *(const bf16x8*)(r0 + 2048 + off)); kf1[u] = sel8(row1 >= 0, *(const bf16x8*)(r1 + 2048 + off));
                qf0[u] = sel8(row0 >= 0, *(const bf16x8*)(r0 + off)); qf1[u] = sel8(row1 >= 0, *(const bf16x8*)(r1 + off)); }
#pragma unroll
            for (int u = 0; u < 4; ++u) { const int ks = 4 * kh + u; const bf16x8 k0 = kf0[u], k1 = kf1[u], q0 = qf0[u], q1 = qf1[u];
                kk00 = MFMA32(k0, k0, kk00); kk10 = MFMA32(k1, k0, kk10); kk11 = MFMA32(k1, k1, kk11);
                qk00 = MFMA32(q0, k0, qk00); qk10 = MFMA32(q1, k0, qk10); qk11 = MFMA32(q1, k1, qk11);
                bf16* kb = kt0 + (ks >> 1) * 2048 + (ks & 1) * 128;
#pragma unroll
                for (int e = 0; e < 8; ++e) { kb[(8 * (e >> 2) + (e & 3)) * 8] = (bf16)k0[e]; kb[1024 + (8 * (e >> 2) + (e & 3)) * 8] = (bf16)k1[e]; } }
        }
#pragma unroll 1
        for (int hh = 0; hh < 2; ++hh) { const int h = 2 * hq + hh; bf16* vt = VT + (((size_t)(b * 32 + h)) * NCH + c) * 128 * 64 + half * 512 + sm;
            bf16x8 vf0[8], vf1[8];
#pragma unroll
            for (int ks = 0; ks < 8; ++ks) { const int off = 4096 + h * 128 + 16 * ks + 8 * half; vf0[ks] = sel8(row0 >= 0, *(const bf16x8*)(r0 + off)); vf1[ks] = sel8(row1 >= 0, *(const bf16x8*)(r1 + off)); }
#pragma unroll
            for (int ks = 0; ks < 8; ++ks) {
#pragma unroll
                for (int e = 0; e < 8; ++e) { vt[ks * 1024 + e * 64] = (bf16)vf0[ks][e]; vt[ks * 1024 + e * 64 + 32] = (bf16)vf1[ks][e]; } } }
        WAVE_SYNC();
#pragma unroll 1
        for (int hh = 0; hh < 2; ++hh) { const int h = 2 * hq + hh; const size_t uh = ((size_t)(b * 32 + h)) * NCH + c;
            float* af = AF + uh * 4096 + half * 256 + m;
            bf16* pg = PG + uh * 4096 + half * 32 + ((sm >> 4) & 1) * 512 + ((sm >> 3) & 1) * 256 + (sm & 7);
            const float gcj0 = lg[hh * 64 + m], gcj1 = lg[hh * 64 + 32 + m];
#pragma unroll
            for (int r = 0; r < 16; ++r) { const int ir = crow32(r, half), rc = (r & 3) + 8 * (r >> 2);
                const float gi0 = lg[hh * 64 + ir], gi1 = lg[hh * 64 + 32 + ir], bi0 = lg[128 + hh * 64 + ir], bi1 = lg[128 + hh * 64 + 32 + ir];
                { const int i = ir, j = m; const float dec = __expf(fminf(gi0 - gcj0, 0.f)); af[rc * 64] = (j < i) ? bi0 * dec * kk00[r] : 0.f; pg[rc * 8] = f2bf((j <= i) ? dec * qk00[r] : 0.f); }
                { const int i = 32 + ir, j = m; const float dec = __expf(fminf(gi1 - gcj0, 0.f)); af[2048 + rc * 64] = bi1 * dec * kk10[r]; pg[2048 + rc * 8] = f2bf(dec * qk10[r]); }
                { const int i = 32 + ir, j = 32 + m; const float dec = __expf(fminf(gi1 - gcj1, 0.f)); af[2048 + 32 + rc * 64] = (j < i) ? bi1 * dec * kk11[r] : 0.f; pg[2048 + 1024 + rc * 8] = f2bf((j <= i) ? dec * qk11[r] : 0.f); }
            } }
        WAVE_SYNC();
    }
}
__device__ __forceinline__ void delta_d2_unit(unsigned char* ws, int uh, int lane) {
    asm volatile("" : "+v"(lane));
    const float* AF = (const float*)(ws + WS_DAF); const float* GC = (const float*)(ws + WS_DGC); const float* BT = (const float*)(ws + WS_DBT);
    bf16* TG = (bf16*)(ws + WS_DTG); bf16* TB = (bf16*)(ws + WS_DTB);
    {
        const float* af = AF + (size_t)uh * 4096;
        const float bc = BT[(size_t)uh * 64 + lane], gmc = __expf(GC[(size_t)uh * 64 + lane]);
        float T[64];
        const bool pad0 = (uh % NCH) == 0;
#pragma unroll
        for (int i0 = 0; i0 < 64; i0 += 16) {
            float ar[16];
#pragma unroll
            for (int u = 0; u < 16; ++u) ar[u] = af[(i0 + u) * 64 + lane];
            if (pad0 && i0 < 32) {
#pragma unroll
                for (int u = 0; u < 16; ++u) T[i0 + u] = (lane == i0 + u) ? 1.f : 0.f;
            } else {
#pragma unroll
                for (int u = 0; u < 16; ++u) { const int i = i0 + u; float pa[4] = {(lane == i) ? 1.f : 0.f, 0.f, 0.f, 0.f};
#pragma unroll
                    for (int j = 0; j < i; ++j) pa[j & 3] -= __int_as_float(__builtin_amdgcn_readlane(__float_as_int(ar[u]), j)) * T[j];
                    T[i] = (pa[0] + pa[1]) + (pa[2] + pa[3]); }
            }
        }
        bf16* tg = TG + (size_t)uh * 4096; bf16* tb = TB + (size_t)uh * 4096;
        const float sg = bc * gmc;
        const int cs = (lane & ~31) + sw23(lane & 31);
#pragma unroll
        for (int i = 0; i < 64; ++i) { tg[i * 64 + cs] = f2bf(T[i] * sg); tb[i * 64 + cs] = f2bf(T[i] * bc); }
    }
}
__device__ __forceinline__ void delta_d3_unit(unsigned char* ws, int uh, int lane) {
    asm volatile("" : "+v"(lane));
    const bf16* TG = (const bf16*)(ws + WS_DTG); const bf16* TB = (const bf16*)(ws + WS_DTB); const bf16* KT = (const bf16*)(ws + WS_DKT); const bf16* VT = (const bf16*)(ws + WS_DVT);
    bf16* WG = (bf16*)(ws + WS_DWG); bf16* UG = (bf16*)(ws + WS_DUG);
    const int m = lane & 31, half = lane >> 5;
    const int c = uh % NCH, bh = uh / NCH, h = bh & 31, b = bh >> 5;
    const size_t uq = ((size_t)(b * 16 + (h >> 1))) * NCH + c;
    {
        const bf16* Tm = TG + (size_t)uh * 4096; const bf16* Kf = KT + uq * 8192;
        f32x16 acc[4][2];
#pragma unroll
        for (int dn = 0; dn < 4; ++dn)
#pragma unroll
            for (int ti = 0; ti < 2; ++ti)
#pragma unroll
                for (int i = 0; i < 16; ++i) acc[dn][ti][i] = 0.f;
#pragma unroll
        for (int ks = 0; ks < 4; ++ks) {
            bf16x8 a[4], bb[2];
#pragma unroll
            for (int dn = 0; dn < 4; ++dn) a[dn] = *(const bf16x8*)(Kf + ((size_t)(((dn * 2 + (ks >> 1)) * 2 + (ks & 1)) * 64 + lane)) * 8);
#pragma unroll
            for (int ti = 0; ti < 2; ++ti) bb[ti] = *(const bf16x8*)(Tm + (32 * ti + m) * 64 + 16 * ks + 8 * half);
#pragma unroll
            for (int dn = 0; dn < 4; ++dn)
#pragma unroll
                for (int ti = 0; ti < 2; ++ti) acc[dn][ti] = MFMA32(a[dn], bb[ti], acc[dn][ti]);
        }
        bf16* wg = WG + (size_t)uh * 8192;
#pragma unroll
        for (int dn = 0; dn < 4; ++dn)
#pragma unroll
            for (int ti = 0; ti < 2; ++ti)
#pragma unroll
                for (int s2 = 0; s2 < 2; ++s2) *(v4u*)(wg + ((size_t)(((ti * 4 + dn) * 2 + s2) * 64 + lane)) * 8) = pack_frag(acc[dn][ti], s2);
    }
    {
        const bf16* Tm = TB + (size_t)uh * 4096; const bf16* Bt = VT + (size_t)uh * 8192;
        f32x16 acc[2][4];
#pragma unroll
        for (int ti = 0; ti < 2; ++ti)
#pragma unroll
            for (int dn = 0; dn < 4; ++dn)
#pragma unroll
                for (int i = 0; i < 16; ++i) acc[ti][dn][i] = 0.f;
#pragma unroll
        for (int ks = 0; ks < 4; ++ks) {
            bf16x8 a[2], bb[4];
#pragma unroll
            for (int ti = 0; ti < 2; ++ti) a[ti] = *(const bf16x8*)(Tm + (32 * ti + m) * 64 + 16 * ks + 8 * half);
#pragma unroll
            for (int dn = 0; dn < 4; ++dn) bb[dn] = *(const bf16x8*)(Bt + (32 * dn + m) * 64 + 16 * ks + 8 * half);
#pragma unroll
            for (int ti = 0; ti < 2; ++ti)
#pragma unroll
                for (int dn = 0; dn < 4; ++dn) acc[ti][dn] = MFMA32(a[ti], bb[dn], acc[ti][dn]);
        }
        bf16* ug = UG + (size_t)uh * 8192;
#pragma unroll
        for (int ti = 0; ti < 2; ++ti)
#pragma unroll
            for (int dn = 0; dn < 4; ++dn) { bf16* p = ug + ((size_t)((ti * 4 + dn) * 64 + lane)) * 16; *(v4u*)p = pack_frag(acc[ti][dn], 0); *(v4u*)(p + 8) = pack_frag(acc[ti][dn], 1); }
    }
}
__device__ __forceinline__ void delta_pre(unsigned char* ws, LAS unsigned char* lds, int gw, int NGW, int wave, int lane) {
    for (int uq = gw; uq < NUQ; uq += NGW) {
#ifndef NO_D1
        delta_d1_unit(ws, lds, uq, wave, lane);
#endif
        asm volatile("s_waitcnt vmcnt(0)" ::: "memory");
        const int c = uq % NCH, bh = uq / NCH, hq = bh & 15, b = bh >> 4;
#pragma unroll 1
        for (int hh = 0; hh < 2; ++hh) { const int uh = (b * 32 + 2 * hq + hh) * NCH + c;
#ifndef NO_D2
            delta_d2_unit(ws, uh, lane);
#endif
            asm volatile("s_waitcnt vmcnt(0)" ::: "memory");
#ifndef NO_D3
            delta_d3_unit(ws, uh, lane);
#endif
        }
    }
}
__device__ __forceinline__ bf16x8 afrag_perm(const bf16* rowp, int blk, int s, int half) {
    const v2u lo = *(const v2u*)(rowp + 32 * blk + 16 * s + 4 * half), hi2 = *(const v2u*)(rowp + 32 * blk + 16 * s + 8 + 4 * half);
    v4u w; w.x = lo.x; w.y = lo.y; w.z = hi2.x; w.w = hi2.y; return __builtin_bit_cast(bf16x8, w);
}
#define LBAR() asm volatile("s_waitcnt lgkmcnt(0)\n\ts_barrier" ::: "memory")
__device__ __forceinline__ void delta_d4(unsigned char* ws, float* out_state, LAS unsigned char* lds, int tid, int wave, int lane) {
    const bf16* QKVC = (const bf16*)(ws + WS_QKVC); const bf16* KT = (const bf16*)(ws + WS_DKT); const bf16* PG = (const bf16*)(ws + WS_DPG);
    const bf16* WG = (const bf16*)(ws + WS_DWG); const bf16* UG = (const bf16*)(ws + WS_DUG); const float* GC = (const float*)(ws + WS_DGC);
    bf16* OF = (bf16*)(ws + WS_SC);
    LAS v4u* Sfr = (LAS v4u*)lds;
    LAS v4u* Dfr = (LAS v4u*)(lds + 16384);
    LAS v4u* Dtf = (LAS v4u*)(lds + 16384 + 4096);
    LAS float* gam = (LAS float*)(lds + 16384 + 8192);
    const int m = lane & 31, half = lane >> 5;
    const bf16x8 zf = {0, 0, 0, 0, 0, 0, 0, 0};
    for (int item = blockIdx.x; item < NBP * 32 * 4; item += gridDim.x) {
        const int xg = item & 7, jj = item >> 3, pair = xg * 4 + (jj >> 3), q = jj & 3, h = 2 * (pair & 15) + ((jj >> 2) & 1), b = pair >> 4;
        const size_t uh0 = ((size_t)(b * 32 + h)) * NCH, uq0 = ((size_t)(b * 16 + (h >> 1))) * NCH;
        const int rt = wave & 1; const bool isq = wave >= 6;
#define ROT3(LOADM, STEPM) do { LOADM(0, 0); LOADM(1, 1); \
            for (int c = 0; c < NCH; c += 3) { \
                if (c + 2 < NCH) LOADM(c + 2, 2); \
                STEPM(c, 0); \
                if (c + 1 < NCH) { if (c + 3 < NCH) LOADM(c + 3, 0); STEPM(c + 1, 1); } \
                if (c + 2 < NCH) { if (c + 4 < NCH) LOADM(c + 4, 1); STEPM(c + 2, 2); } } } while (0)
#define ROT2(LOADM, STEPM) do { LOADM(0, 0); \
            for (int c = 0; c < NCH; c += 2) { \
                if (c + 1 < NCH) LOADM(c + 1, 1); \
                STEPM(c, 0); \
                if (c + 1 < NCH) { if (c + 2 < NCH) LOADM(c + 2, 0); STEPM(c + 1, 1); } } } while (0)
        LBAR();
        if (wave < 4) {
            int ll_ = lane; asm volatile("" : "+v"(ll_)); const int lane = ll_, m = lane & 31, half = lane >> 5; (void)m; (void)half;
            { const v4u z = {0u, 0u, 0u, 0u}; Sfr[(0 * 4 + wave) * 128 + lane] = z; Sfr[(0 * 4 + wave) * 128 + 64 + lane] = z; }
            bf16x8 kf[2][4];
            f32x16 S;
#pragma unroll
            for (int i = 0; i < 16; ++i) S[i] = 0.f;
#define LOAD_K(cc, B) do { const bf16* kr_ = KT + (uq0 + (cc)) * 8192; \
                _Pragma("unroll") for (int blk = 0; blk < 2; ++blk) _Pragma("unroll") for (int s_ = 0; s_ < 2; ++s_) kf[B][blk * 2 + s_] = *(const bf16x8*)(kr_ + ((size_t)(((wave * 2 + blk) * 2 + s_) * 64 + lane)) * 8); } while (0)
#define STEP_K(c, B) do { const int bufc = (c) & 1; LBAR(); LBAR(); \
                const float gl = gam[bufc * 64 + 63]; \
                _Pragma("unroll") for (int i = 0; i < 16; ++i) S[i] *= gl; \
                _Pragma("unroll") for (int blk = 0; blk < 2; ++blk) _Pragma("unroll") for (int s = 0; s < 2; ++s) S = MFMA32(kf[B][blk * 2 + s], __builtin_bit_cast(bf16x8, Dtf[(blk * 2 + s) * 64 + lane]), S); \
                _Pragma("unroll") for (int s = 0; s < 2; ++s) Sfr[((bufc ^ 1) * 4 + wave) * 128 + s * 64 + lane] = pack_frag(S, s); } while (0)
#ifndef NO_RK
            ROT2(LOAD_K, STEP_K);
#endif
            { float* o = out_state + ((size_t)((b * 32 + h) * 128 + 32 * wave)) * 128 + 32 * q + m;
#pragma unroll
              for (int r = 0; r < 16; ++r) o[(size_t)sw23(crow32(r, half)) * 128] = S[r]; }
#undef LOAD_K
#undef STEP_K
        } else if (!isq) {
            int ll_ = lane; asm volatile("" : "+v"(ll_)); const int lane = ll_, m = lane & 31, half = lane >> 5; (void)m; (void)half;
            bf16x8 wf[3][8], uf[3][2]; float gcv[3] = {0.f, 0.f, 0.f};
#define LOAD_W(cc, B) do { const bf16* wb_ = WG + (uh0 + (cc)) * 8192 + ((size_t)(rt * 512 + lane)) * 8; \
                _Pragma("unroll") for (int blk = 0; blk < 4; ++blk) _Pragma("unroll") for (int s_ = 0; s_ < 2; ++s_) wf[B][blk * 2 + s_] = *(const bf16x8*)(wb_ + blk * 1024 + s_ * 512); \
                const bf16* ub_ = UG + (uh0 + (cc)) * 8192 + ((size_t)((rt * 4 + q) * 64 + lane)) * 16; uf[B][0] = *(const bf16x8*)ub_; uf[B][1] = *(const bf16x8*)(ub_ + 8); \
                if (wave == 4) gcv[B] = GC[(uh0 + (cc)) * 64 + lane]; } while (0)
#define STEP_W(c, B) do { const int bufc = (c) & 1; LBAR(); \
                f32x16 acc; \
                _Pragma("unroll") for (int i = 0; i < 16; ++i) acc[i] = 0.f; \
                _Pragma("unroll") for (int blk = 0; blk < 4; ++blk) _Pragma("unroll") for (int s = 0; s < 2; ++s) \
                    acc = MFMA32(wf[B][blk * 2 + s], __builtin_bit_cast(bf16x8, Sfr[(bufc * 4 + blk) * 128 + s * 64 + lane]), acc); \
                { float t8[8]; unpack8(__builtin_bit_cast(v4u, uf[B][0]), t8); \
                    _Pragma("unroll") for (int i = 0; i < 8; ++i) acc[i] = t8[i] - acc[i]; unpack8(__builtin_bit_cast(v4u, uf[B][1]), t8); \
                    _Pragma("unroll") for (int i = 0; i < 8; ++i) acc[8 + i] = t8[i] - acc[8 + i]; } \
                _Pragma("unroll") for (int s = 0; s < 2; ++s) Dfr[(rt * 2 + s) * 64 + lane] = pack_frag(acc, s); \
                _Pragma("unroll") for (int r = 0; r < 16; ++r) acc[r] *= gam[128 + bufc * 64 + 32 * rt + crow32(r, half)]; \
                _Pragma("unroll") for (int s = 0; s < 2; ++s) Dtf[(rt * 2 + s) * 64 + lane] = pack_frag(acc, s); \
                LBAR(); \
                if (wave == 4 && (c) + 1 < NCH) { const float gn_ = gcv[((B) + 1) % 3], gl_ = __shfl(gn_, 63); gam[(bufc ^ 1) * 64 + lane] = __expf(gn_); gam[128 + (bufc ^ 1) * 64 + lane] = __expf(gl_ - gn_); } } while (0)
            if (wave == 4) { const float gc = GC[(uh0 + 0) * 64 + lane], gl = __shfl(gc, 63); gam[lane] = __expf(gc); gam[128 + lane] = __expf(gl - gc); }
#ifndef NO_RW
            ROT3(LOAD_W, STEP_W);
#endif
#undef LOAD_W
#undef STEP_W
        } else {
            int ll_ = lane; asm volatile("" : "+v"(ll_)); const int lane = ll_, m = lane & 31, half = lane >> 5; (void)m; (void)half;
            bf16x8 qf[1][8], pf[1][4];
#define LOAD_Q(cc, B) do { const int row_ = chunk_row(b, (cc), 32 * rt + m); const bool ok_ = row_ >= 0; \
                const bf16* qb_ = QKVC + (size_t)(row_ < 0 ? 0 : row_) * CDIM + (h >> 1) * 128 + 8 * half; \
                _Pragma("unroll") for (int blk = 0; blk < 4; ++blk) _Pragma("unroll") for (int s_ = 0; s_ < 2; ++s_) qf[B][blk * 2 + s_] = sel8(ok_, *(const bf16x8*)(qb_ + blk * 32 + s_ * 16)); \
                } while (0)
#define LOAD_P(cc, PB) do { const bf16* pb_ = PG + (uh0 + (cc)) * 4096 + ((size_t)(rt * 256 + lane)) * 8; \
                _Pragma("unroll") for (int blk = 0; blk < 2; ++blk) _Pragma("unroll") for (int s_ = 0; s_ < 2; ++s_) pf[PB][blk * 2 + s_] = sel8(blk <= rt, *(const bf16x8*)(pb_ + blk * 1024 + s_ * 512)); } while (0)
#define STEP_Q(c) do { const int bufc = (c) & 1; LBAR(); \
                LOAD_P((c), 0);                                                    \
                f32x16 acc; \
                _Pragma("unroll") for (int i = 0; i < 16; ++i) acc[i] = 0.f; \
                _Pragma("unroll") for (int blk = 0; blk < 4; ++blk) _Pragma("unroll") for (int s = 0; s < 2; ++s) \
                    acc = MFMA32(qf[0][blk * 2 + s], __builtin_bit_cast(bf16x8, Sfr[(bufc * 4 + blk) * 128 + s * 64 + lane]), acc); \
                if ((c) + 1 < NCH) LOAD_Q((c) + 1, 0);                             \
                LBAR(); \
                _Pragma("unroll") for (int r = 0; r < 16; ++r) acc[r] *= gam[bufc * 64 + 32 * rt + crow32(r, half)]; \
                _Pragma("unroll") for (int blk = 0; blk < 2; ++blk) _Pragma("unroll") for (int s = 0; s < 2; ++s) acc = MFMA32(pf[0][blk * 2 + s], __builtin_bit_cast(bf16x8, Dfr[(blk * 2 + s) * 64 + lane]), acc); \
                _Pragma("unroll") for (int r = 0; r < 16; ++r) { const int row = chunk_row(b, (c), 32 * rt + crow32(r, half)); if (row >= 0) OF[(size_t)row * DVW + h * 128 + 32 * q + m] = f2bf(acc[r]); } } while (0)
#ifndef NO_RQ
            LOAD_Q(0, 0);
            for (int c = 0; c < NCH; ++c) STEP_Q(c);
#endif
#undef LOAD_Q
#undef LOAD_P
#undef STEP_Q
        }
#undef ROT2
#undef ROT3
    }
    LBAR();
}
#undef LBAR
#undef MFMA32
template <int RT, int CT, class Epi>
__device__ __forceinline__ void small_gemm_unit(const bf16* A, int lda, const bf16* Bt, int ldb, int k0, int klen, LAS unsigned char* lds, const Epi& E, int tid, int wave, int lane) {
    const int r16 = lane & 15, q = lane >> 4;
    const int kw = klen >> 3;
    const bf16* ap = A + (size_t)r16 * lda + k0 + wave * kw + 8 * q;
    const bf16* bp = Bt + (size_t)r16 * ldb + k0 + wave * kw + 8 * q;
    pg8::f32x4 acc[RT][CT];
#pragma unroll
    for (int i = 0; i < RT; ++i)
#pragma unroll
        for (int j = 0; j < CT; ++j) acc[i][j] = (pg8::f32x4){0.f, 0.f, 0.f, 0.f};
#pragma unroll 4
    for (int ks = 0; ks < kw; ks += 32) {
        bf16x8 a[RT], b[CT];
#pragma unroll
        for (int i = 0; i < RT; ++i) a[i] = *(const bf16x8*)(ap + (size_t)(16 * i) * lda + ks);
#pragma unroll
        for (int j = 0; j < CT; ++j) b[j] = *(const bf16x8*)(bp + (size_t)(16 * j) * ldb + ks);
#pragma unroll
        for (int i = 0; i < RT; ++i)
#pragma unroll
            for (int j = 0; j < CT; ++j) acc[i][j] = __builtin_amdgcn_mfma_f32_16x16x32_bf16(a[i], b[j], acc[i][j], 0, 0, 0);
    }
    constexpr int NOUT = 256 * RT * CT;
    LAS float* part = (LAS float*)lds + wave * NOUT;
#pragma unroll
    for (int i = 0; i < RT; ++i)
#pragma unroll
        for (int j = 0; j < CT; ++j)
#pragma unroll
            for (int e = 0; e < 4; ++e) part[(16 * i + 4 * q + e) * (16 * CT) + 16 * j + r16] = acc[i][j][e];
    __syncthreads();
    for (int o = tid; o < NOUT; o += NTHREADS) { float sum = 0.f;
#pragma unroll
        for (int w = 0; w < 8; ++w) sum += ((LAS float*)lds)[w * NOUT + o];
        E(o / (16 * CT), o % (16 * CT), sum); }
    __syncthreads();
}
template <int ACT> struct SEpiRowsBf16 { bf16* O; int ldc; __device__ __forceinline__ void operator()(int row, int col, float v) const { if (ACT == 2) { v = v > 0.f ? v : 0.f; v = v * v; } O[(size_t)row * ldc + col] = f2bf(v); } };
struct SEpiF32 { float* O; int ldc; __device__ __forceinline__ void operator()(int row, int col, float v) const { O[(size_t)row * ldc + col] = v; } };
struct SEpiColsBf16 { bf16* O; int ldc; __device__ __forceinline__ void operator()(int row, int col, float v) const { O[(size_t)col * ldc + row] = f2bf(v); } };
template <int ACT> __device__ __forceinline__ void skinny_rows_bf16(const bf16* A, const bf16* Wt, int K, int nunits, bf16* O, int ldc, LAS unsigned char* lds, int tid, int wave, int lane) {
    for (int u = blockIdx.x; u < nunits; u += gridDim.x) { SEpiRowsBf16<ACT> E{O + (size_t)XROW0 * ldc + u * 64, ldc};
        small_gemm_unit<3, 4>(A + (size_t)XROW0 * K, K, Wt + (size_t)u * 64 * K, K, 0, K, lds, E, tid, wave, lane); }
}
__device__ __forceinline__ void skinny_rows_part(const bf16* A, const bf16* Wt, int K, float* ZP, LAS unsigned char* lds, int tid, int wave, int lane) {
    for (int u = blockIdx.x; u < 256; u += gridDim.x) { const int cgp = u & 31, ksl = u >> 5; SEpiF32 E{ZP + (size_t)ksl * XR * DM + cgp * 64, DM};
        small_gemm_unit<3, 4>(A + (size_t)XROW0 * K, K, Wt + (size_t)cgp * 64 * K, K, ksl * (K >> 3), K >> 3, lds, E, tid, wave, lane); }
}
template <int RT> __device__ __forceinline__ void tail_cols_bf16(const bf16* A, const bf16* Wt, int K, int c0, bf16* O, int ldc, LAS unsigned char* lds, int tid, int wave, int lane) {
    for (int u = blockIdx.x; u < MAINM / 32; u += gridDim.x) { SEpiColsBf16 E{O + (size_t)u * 32 * ldc + c0, ldc};
        small_gemm_unit<RT, 2>(Wt + (size_t)c0 * K, K, A + (size_t)u * 32 * K, K, 0, K, lds, E, tid, wave, lane); }
}

typedef __attribute__((address_space(4))) const unsigned long long* kargq_t;
#define KPF_(k) ((const float*)(const GAS float*)(q_[k]))
__device__ __forceinline__ void load_ptrs(Ptrs& P) {
    kargq_t q_ = (kargq_t)__builtin_amdgcn_kernarg_segment_ptr();
    asm volatile("" : "+s"(q_));
    P.x_prompt = KPF_(0); P.x_sample = KPF_(1); P.state_conv_a = KPF_(2); P.cache_k = KPF_(3);
    P.cache_v = KPF_(4); P.cache_ik = KPF_(5); P.state_conv_c = KPF_(6); P.state_delta = KPF_(7);
    P.page_table = ((const int*)(const GAS int*)(q_[8])); P.meta = KPF_(9); P.w_in_a = KPF_(10); P.conv_w_a = KPF_(11);
    P.w_out_a = KPF_(12); P.w_in_b = KPF_(13); P.w_out_b = KPF_(14); P.w_in_c = KPF_(15);
    P.conv_w_c = KPF_(16); P.a_log = KPF_(17); P.dt_bias = KPF_(18); P.norm_w = KPF_(19);
    P.w_out_c = KPF_(20); P.ln1_g = KPF_(21); P.ln1_b = KPF_(22); P.w1 = KPF_(23);
    P.w2 = KPF_(24); P.ln2_g = KPF_(25); P.ln2_b = KPF_(26);
    P.out = (float*)(GAS float*)(q_[27]); P.ws = (unsigned char*)(GAS unsigned char*)(q_[28]);
}
struct Args { const void* in[27]; float* out; unsigned char* ws; int ph_lo, ph_hi; };
constexpr int PH_PER_LAYER = 12, PH_END = 1 + 4 * PH_PER_LAYER;

__global__ void __launch_bounds__(NTHREADS, 2) mega_fwd(Args args) {
    extern __shared__ __attribute__((aligned(16))) unsigned char lds_raw[];
    LAS unsigned char* lds = (LAS unsigned char*)lds_raw;
    const int tid = threadIdx.x, lane = tid & 63, wave = __builtin_amdgcn_readfirstlane(tid >> 6);
    const int G_ = gridDim.x, NGW = G_ * NWAVES, NT = G_ * NTHREADS; (void)lane;
    unsigned char* ws = args.ws;
    const int lo = args.ph_lo, hi = args.ph_hi;
    const bool fused = (hi - lo) > 1;

    for (int u = tid; u < (LDS_BYTES - LDSCTL_OFF) / 4; u += NTHREADS) ((LAS unsigned*)(lds + LDSCTL_OFF))[u] = 0u;
    __syncthreads();
    volatile LAS unsigned* MISC = (volatile LAS unsigned*)(lds + MISC_OFF);
    XcdBarrier bar; bar.bar = (unsigned*)(ws + WS_CTL) + CW_BAR; bar.x = 0; bar.st = nullptr;
    if (fused) bar = xcd_barrier_post((unsigned*)(ws + WS_CTL) + CW_BAR, MISC + 8);
    bar.wv = wave;

#ifndef MK_SITES
#define MK_SITES 0xffffffffu
#endif
#define SITE(n) (((MK_SITES) >> (n)) & 1u)
#define IN(k) (lo <= (k) && (k) < hi)
#ifndef MK_DUP
#define MK_DUP 0u
#endif
#define NREP(n) ((((MK_DUP) >> (n)) & 1u) ? 2 : 1)
#ifdef MK_SKINNY2
#define SKREP 2
#else
#define SKREP 1
#endif
#define BEGIN_SITE(n, id) if (SITE(n) && IN(id)) { for (int rp_ = 0; rp_ < NREP(n); ++rp_) { Ptrs P; load_ptrs(P); unsigned char* ws = P.ws; (void)ws; \
    bf16* X = (bf16*)(P.ws + WS_X); float* Z = (float*)(P.ws + WS_Z); float* ZP = (float*)(P.ws + WS_ZP); bf16* Y = (bf16*)(P.ws + WS_Y); bf16* BIG = (bf16*)(P.ws + WS_BIG); (void)X; (void)Z; (void)ZP; (void)Y; (void)BIG;
#define END_SITE(id) SEAM(id); } }
#define LOCALS int tid_ = threadIdx.x; asm volatile("" : "+v"(tid_)); const int lane_ = tid_ & 63, wave_ = __builtin_amdgcn_readfirstlane(tid_ >> 6), gw_ = blockIdx.x * NWAVES + wave_, gtid_ = blockIdx.x * NTHREADS + tid_; (void)lane_; (void)wave_; (void)gw_; (void)gtid_
#define SEAM(k) do { if (fused && (k) + 1 < PH_END) xcd_barrier(bar); else __syncthreads(); } while (0)


    BEGIN_SITE(0, 0) LOCALS; p0_prologue(P, lds, gw_, NGW, wave_, lane_); END_SITE(0)
#ifdef MK_XBAR
    if (fused) { for (int xb_ = 0; xb_ < MK_XBAR; ++xb_) xcd_barrier(bar); }
#endif

    for (int layer = 0; layer < 4; ++layer) {
        const int kind = layer % 3, j = layer / 3, base = 1 + layer * PH_PER_LAYER;
        if (kind == 0) {
            BEGIN_SITE(1, base + 0)
                const bf16* Wt = (const bf16*)(ws + WS_WA_IN + (size_t)j * WSZ_A_IN); pg8::Gemm g{X, Wt, MAINM, NA_IN, DM}; pg8::StaticOrder S; S.init(MAINM, NA_IN, G_, (int)blockIdx.x);
                pg8::EpiBf16<0> E{BIG, NA_IN, nullptr, 0, 0, 1.f};
                pg8::gemm_phase<pg8::EpiBf16<0>, pg8::StaticOrder, true, true>(lds, g, S, E, wave);
                { LOCALS; for (int sk_ = 0; sk_ < SKREP; ++sk_) { skinny_rows_bf16<0>(X, Wt, DM, NA_IN / 64, BIG, NA_IN, lds, tid_, wave_, lane_); } }
                END_SITE(base + 0)
            BEGIN_SITE(2, base + 1)
                LOCALS; convA_phase(BIG, Y, P.conv_w_a + (size_t)j * 3 * DM, P.state_conv_a + (size_t)j * SBN * 2 * DM, P.out + O_CAP + (size_t)j * NBP * 2 * DM, P.out + O_CAS + (size_t)j * SBN * 2 * DM, gtid_, NT);
                END_SITE(base + 1)
            BEGIN_SITE(3, base + 2)
                const bf16* Wt = (const bf16*)(ws + WS_WA_OUT + (size_t)j * WSZ_A_OUT); pg8::Gemm g{Y, Wt, MAINM, DM, DM}; pg8::StaticOrder S; S.init(MAINM, DM, G_, (int)blockIdx.x);
                pg8::EpiResBf16 E{X, DM, ALPHA};
                pg8::gemm_phase<pg8::EpiResBf16, pg8::StaticOrder, true, true>(lds, g, S, E, wave);
                { LOCALS; for (int sk_ = 0; sk_ < SKREP; ++sk_) { skinny_rows_part(Y, Wt, DM, ZP, lds, tid_, wave_, lane_); } }
                END_SITE(base + 2)
        } else if (kind == 1) {
            BEGIN_SITE(4, base + 0)
                const bf16* Wt = (const bf16*)(ws + WS_WB_IN); pg8::Gemm g{X, Wt, MAINM, 4096, DM}; pg8::StaticOrder S; S.init(MAINM, 4096, G_, (int)blockIdx.x);
                pg8::EpiBf16<0> E{BIG, NB_PAD, nullptr, 0, 0, 1.f};
                pg8::gemm_phase<pg8::EpiBf16<0>, pg8::StaticOrder, true, true>(lds, g, S, E, wave);
                { LOCALS; for (int sk_ = 0; sk_ < SKREP; ++sk_) { tail_cols_bf16<5>(X, Wt, DM, 4096, BIG, NB_PAD, lds, tid_, wave_, lane_); skinny_rows_bf16<0>(X, Wt, DM, 4224 / 64, BIG, NB_PAD, lds, tid_, wave_, lane_); } }
                END_SITE(base + 0)
            BEGIN_SITE(5, base + 1) LOCALS; rope_phase(BIG, P, gw_, NGW, lane_); END_SITE(base + 1)
            BEGIN_SITE(6, base + 2) LOCALS; indexer_sample(P, lds, tid_); indexer_prompt(P, lds, tid_, wave_, lane_); END_SITE(base + 2)
            BEGIN_SITE(7, base + 3) LOCALS; select_phase(P, lds, gw_, NGW, tid_, wave_, lane_); END_SITE(base + 3)
            BEGIN_SITE(8, base + 4) LOCALS; dense_attn_phase(P, Y, (char*)lds_raw, wave_); attn_phase(P, Y, lds, gw_, NGW, wave_, lane_); END_SITE(base + 4)
            BEGIN_SITE(9, base + 5)
                const bf16* Wt = (const bf16*)(ws + WS_WB_OUT); pg8::Gemm g{Y, Wt, MAINM, DM, DM}; pg8::StaticOrder S; S.init(MAINM, DM, G_, (int)blockIdx.x);
                pg8::EpiResBf16 E{X, DM, ALPHA};
                pg8::gemm_phase<pg8::EpiResBf16, pg8::StaticOrder, true, true>(lds, g, S, E, wave);
                { LOCALS; for (int sk_ = 0; sk_ < SKREP; ++sk_) { skinny_rows_part(Y, Wt, DM, ZP, lds, tid_, wave_, lane_); } }
                END_SITE(base + 5)
        } else {
            BEGIN_SITE(10, base + 0)
                const bf16* Wt = (const bf16*)(ws + WS_WC_IN); pg8::Gemm g{X, Wt, MAINM, 12288, DM}; pg8::StaticOrder S; S.init(MAINM, 12288, G_, (int)blockIdx.x);
                pg8::EpiBf16<0> E{BIG, NC_PAD, nullptr, 0, 0, 1.f};
                pg8::gemm_phase<pg8::EpiBf16<0>, pg8::StaticOrder, true, true>(lds, g, S, E, wave);
                { LOCALS; for (int sk_ = 0; sk_ < SKREP; ++sk_) { tail_cols_bf16<4>(X, Wt, DM, 12288, BIG, NC_PAD, lds, tid_, wave_, lane_); skinny_rows_bf16<0>(X, Wt, DM, NC_IN / 64, BIG, NC_PAD, lds, tid_, wave_, lane_); } }
                END_SITE(base + 0)
            BEGIN_SITE(11, base + 1) LOCALS; convC_phase(BIG, P, gw_, NGW, lane_); END_SITE(base + 1)
            BEGIN_SITE(19, base + 2) LOCALS; delta_pre(P.ws, lds, gw_, NGW, wave_, lane_); delta_phase(P, wave_, lane_); END_SITE(base + 2)
            BEGIN_SITE(22, base + 5) LOCALS; delta_d4(P.ws, P.out + O_DP, lds, tid_, wave_, lane_); END_SITE(base + 5)
            BEGIN_SITE(13, base + 6) LOCALS; normC_phase(BIG, Y, P, gw_, NGW, lane_); END_SITE(base + 6)
            BEGIN_SITE(14, base + 7)
                const bf16* Wt = (const bf16*)(ws + WS_WC_OUT); pg8::Gemm g{Y, Wt, MAINM, DM, DVW}; pg8::StaticOrder S; S.init(MAINM, DM, G_, (int)blockIdx.x);
                pg8::EpiResBf16 E{X, DM, ALPHA};
                pg8::gemm_phase<pg8::EpiResBf16, pg8::StaticOrder, true, true>(lds, g, S, E, wave);
                { LOCALS; for (int sk_ = 0; sk_ < SKREP; ++sk_) { skinny_rows_part(Y, Wt, DVW, ZP, lds, tid_, wave_, lane_); } }
                END_SITE(base + 7)
        }
        BEGIN_SITE(15, base + 8) LOCALS; ln_phase(Z, ZP, X, rp_ == 0 ? X : (bf16*)(P.ws + WS_QR), P.ln1_g + (size_t)layer * DM, P.ln1_b + (size_t)layer * DM, nullptr, nullptr, gw_, NGW, lane_); END_SITE(base + 8)
        BEGIN_SITE(16, base + 9)
            const bf16* Wt = (const bf16*)(ws + WS_W1 + (size_t)layer * WSZ_W1); pg8::Gemm g{X, Wt, MAINM, FF, DM}; pg8::StaticOrder S; S.init(MAINM, FF, G_, (int)blockIdx.x);
            pg8::EpiBf16<2> E{BIG, FF, nullptr, 0, 0, 1.f};
            pg8::gemm_phase<pg8::EpiBf16<2>, pg8::StaticOrder, true, true>(lds, g, S, E, wave);
            { LOCALS; for (int sk_ = 0; sk_ < SKREP; ++sk_) { skinny_rows_bf16<2>(X, Wt, DM, FF / 64, BIG, FF, lds, tid_, wave_, lane_); } }
            END_SITE(base + 9)
        BEGIN_SITE(17, base + 10)
            const bf16* Wt = (const bf16*)(ws + WS_W2 + (size_t)layer * WSZ_W2); pg8::Gemm g{BIG, Wt, MAINM, DM, FF}; pg8::StaticOrder S; S.init(MAINM, DM, G_, (int)blockIdx.x);
            pg8::EpiResBf16 E{X, DM, ALPHA};
            pg8::gemm_phase<pg8::EpiResBf16, pg8::StaticOrder, true, true>(lds, g, S, E, wave);
            { LOCALS; for (int sk_ = 0; sk_ < SKREP; ++sk_) { skinny_rows_part(BIG, Wt, FF, ZP, lds, tid_, wave_, lane_); } }
            END_SITE(base + 10)
        BEGIN_SITE(18, base + 11)
            const bool last = layer == 3;
            LOCALS; ln_phase(Z, ZP, X, rp_ == 0 ? X : (bf16*)(P.ws + WS_QR), P.ln2_g + (size_t)layer * DM, P.ln2_b + (size_t)layer * DM, last ? P.out + O_YP : nullptr, last ? P.out + O_YS : nullptr, gw_, NGW, lane_);
            if (!last) SEAM(base + 11); } }
    }
#undef IN
#undef SEAM
}

#ifndef MK_SPLIT
#define MK_SPLIT 0
#endif
extern "C" void kernel_launch(void* const* d_in, const int* in_sizes, int n_in, void* d_out, int out_size, void* d_ws, size_t ws_size, hipStream_t stream) {
    static int grid = 0;
    if (grid == 0) {
        if (n_in != 27 || (size_t)out_size != O_END || ws_size < WS_END) { fprintf(stderr, "kernel_launch: unexpected shapes: n_in %d out %d (want %zu) ws %zu (want >= %zu)\n", n_in, out_size, (size_t)O_END, ws_size, (size_t)WS_END); grid = -1; return; }
        int dev = 0, cus = 0;
        if (hipGetDevice(&dev) != hipSuccess || hipDeviceGetAttribute(&cus, hipDeviceAttributeMultiprocessorCount, dev) != hipSuccess) { grid = -1; return; }
        if (hipFuncSetAttribute((const void*)mega_fwd, hipFuncAttributeMaxDynamicSharedMemorySize, LDS_BYTES) != hipSuccess) { fprintf(stderr, "kernel_launch: hipFuncSetAttribute failed\n"); grid = -1; return; }
        int per_cu = 0;
        if (hipOccupancyMaxActiveBlocksPerMultiprocessor(&per_cu, (const void*)mega_fwd, NTHREADS, LDS_BYTES) != hipSuccess || per_cu < 1) fprintf(stderr, "kernel_launch: occupancy query reports %d\n", per_cu);
        (void)hipGetLastError();
        grid = cus;
    }
    if (grid < 0) return;
    (void)hipMemsetAsync((char*)d_ws + WS_CTL, 0, CTL_ZERO_BYTES, stream);
    Args a{};
    for (int i = 0; i < 27; ++i) a.in[i] = d_in[i];
    a.out = (float*)d_out; a.ws = (unsigned char*)d_ws;
#if MK_SPLIT
    for (int ph = 0; ph < PH_END; ++ph) {
        bool exists = (ph == 0);
        if (ph > 0) { const int layer = (ph - 1) / PH_PER_LAYER, l = (ph - 1) % PH_PER_LAYER, kind = layer % 3; const int nmix = kind == 0 ? 3 : (kind == 1 ? 6 : 8); exists = (l < nmix) || (l >= 8 && l <= 11); }
        if (!exists) continue;
        a.ph_lo = ph; a.ph_hi = ph + 1;
        hipLaunchKernelGGL(mega_fwd, dim3(grid), dim3(NTHREADS), LDS_BYTES, stream, a);
    }
#else
    a.ph_lo = 0; a.ph_hi = PH_END;
    hipLaunchKernelGGL(mega_fwd, dim3(grid), dim3(NTHREADS), LDS_BYTES, stream, a);
#endif
    const hipError_t le = hipPeekAtLastError();
    if (le != hipSuccess) fprintf(stderr, "kernel_launch: launch failed: %s\n", hipGetErrorName(le));
}
```

```cpp
#include <hip/hip_runtime.h>
#include <cstdio>
#include <cstdint>
#include <cmath>
__device__ __forceinline__ int flane() { return (int)__builtin_amdgcn_mbcnt_hi(~0u, __builtin_amdgcn_mbcnt_lo(~0u, 0u)); }
namespace pg8 {
#define PG8_LAS __attribute__((address_space(3)))
typedef unsigned short bf16_t;
typedef short bf16x8 __attribute__((ext_vector_type(8)));
typedef float f32x4 __attribute__((ext_vector_type(4)));
typedef unsigned u32x4 __attribute__((ext_vector_type(4)));
constexpr int BM = 256, BK = 64, HALF = 128, HTB = HALF * BK * 2  , STAGE_BYTES = 8 * HTB, NXCD = 8, WGM = 8;

__host__ __device__ __forceinline__ int lds_byte(int r, int c) { const int st = (r >> 4) * 2 + (c >> 5), rr = r & 15, cc = c & 31, ob = rr * 64 + cc * 2; return st * 1024 + (ob ^ (((ob >> 9) & 1) << 5)); }
__host__ __device__ __forceinline__ void stage_rc(int b, int& R, int& C) { const int st = b / 1024, sb = b % 1024, swz = sb ^ (((sb >> 9) & 1) << 5); R = (st >> 1) * 16 + swz / 64; C = (st & 1) * 32 + (swz % 64) / 2; }
__host__ __device__ __forceinline__ int perm32(int rho) { const int n = rho >> 4, i = rho & 15; return 8 * (i >> 2) + 4 * n + (i & 3); }

struct Unit { int pm, pn; };
struct Gemm { const bf16_t* A; const bf16_t* Bt; int M, N, K; };

struct StaticOrder {
    int nM, nN, nwg, G, c;
    __host__ __device__ void init(int M, int N, int G_, int c_) { nM = M / BM; nN = N / BM; nwg = nM * nN; G = G_; c = c_; }
    __host__ __device__ bool next(int i, Unit& u) const {
        const long L = (long)i * G + c; if (L >= nwg) return false;
        int wgid = (int)L; { const int q = nwg / NXCD, r = nwg % NXCD, xcd = wgid % NXCD, off = wgid / NXCD; wgid = (xcd < r ? xcd * (q + 1) : r * (q + 1) + (xcd - r) * q) + off; }
        const int nig = WGM * nN, gid = wgid / nig, fm = gid * WGM, gsz = (nM - fm) < WGM ? (nM - fm) : WGM;
        u.pm = fm + ((wgid % nig) % gsz); u.pn = (wgid % nig) / gsz; return true;
    }
    __device__ __forceinline__ void a_ready(const Unit&) const {}
    __device__ __forceinline__ void done(const Unit&) const {}
};

__device__ __forceinline__ unsigned cvt_pk_bf16(float lo, float hi) { unsigned r; asm volatile("v_cvt_pk_bf16_f32 %0, %1, %2" : "=v"(r) : "v"(lo), "v"(hi)); return r; }
typedef float f32x2 __attribute__((ext_vector_type(2)));
__device__ __forceinline__ f32x2 gelu_pk(f32x2 v) {
    const f32x2 av = __builtin_elementwise_abs(v), d = av * 0.2316418882f + 1.0f;
    f32x2 t; t.x = __builtin_amdgcn_rcpf(d.x); t.y = __builtin_amdgcn_rcpf(d.y);
    f32x2 q = t * 0.5307027145f + (-0.7265760135f); q = q * t + 0.7107068705f; q = q * t + (-0.142248368f); q = q * t + 0.127414796f; q = q * t;
    const f32x2 s = (v * v) * (-0.72134752044f);
    f32x2 e; e.x = __builtin_amdgcn_exp2f(s.x); e.y = __builtin_amdgcn_exp2f(s.y);
    const f32x2 m = v * (q * e), r = v - m;
    f32x2 o; o.x = v.x < 0.f ? m.x : r.x; o.y = v.y < 0.f ? m.y : r.y; return o;
}

template <int ACT  > struct EpiBf16 {
    static constexpr bool PERM = true, AFTER_DRAIN = false; static_assert(ACT == 0 || ACT == 1 || ACT == 2, "EpiBf16: ACT is 0 (none), 1 (gelu_pk) or 2 (relu^2)");
    bf16_t* O; int ldc; const float* bias; int split_cols; size_t split_stride; float scale0;
    __device__ __forceinline__ void operator()(const f32x4 (&acc)[2][2][4][2], const Unit& u, int wr, int wc, int fr, int fq) const {
        const int row0 = u.pm * BM + wr * 64 + fr; int colt = u.pn * BM; bf16_t* base = O;
        float sc = 1.f; if (split_cols) { const int t = colt / split_cols; base += (size_t)t * split_stride; colt -= t * split_cols; if (t == 0) sc = scale0; }
        const int col0 = colt + wc * 32 + 8 * fq, bcol0 = u.pn * BM + wc * 32 + 8 * fq;
        f32x4 bv[2][2];
#pragma unroll
        for (int bj = 0; bj < 2; ++bj)
#pragma unroll
            for (int n = 0; n < 2; ++n) bv[bj][n] = bias ? *(const f32x4*)(bias + bcol0 + bj * HALF + 4 * n) : (f32x4){0.f, 0.f, 0.f, 0.f};
#pragma unroll
        for (int ai = 0; ai < 2; ++ai)
#pragma unroll
            for (int m = 0; m < 4; ++m) { bf16_t* rowp = base + (size_t)(row0 + ai * HALF + m * 16) * ldc + col0;
#pragma unroll
                for (int bj = 0; bj < 2; ++bj) { f32x4 v0 = acc[ai][bj][m][0] + bv[bj][0], v1 = acc[ai][bj][m][1] + bv[bj][1];
                    if (ACT == 1) { f32x2 a = gelu_pk((f32x2){v0[0], v0[1]}), b = gelu_pk((f32x2){v0[2], v0[3]}), c = gelu_pk((f32x2){v1[0], v1[1]}), d = gelu_pk((f32x2){v1[2], v1[3]});
                        v0 = (f32x4){a.x, a.y, b.x, b.y}; v1 = (f32x4){c.x, c.y, d.x, d.y}; }
                    if (ACT == 2) { _Pragma("unroll") for (int q_ = 0; q_ < 4; ++q_) { const float a_ = v0[q_] > 0.f ? v0[q_] : 0.f, b_ = v1[q_] > 0.f ? v1[q_] : 0.f; v0[q_] = a_ * a_; v1[q_] = b_ * b_; } }
                    v0 = v0 * sc; v1 = v1 * sc; u32x4 w; w.x = cvt_pk_bf16(v0[0], v0[1]); w.y = cvt_pk_bf16(v0[2], v0[3]); w.z = cvt_pk_bf16(v1[0], v1[1]); w.w = cvt_pk_bf16(v1[2], v1[3]);
                    *(u32x4*)(rowp + bj * HALF) = w; } }
    }
};


struct EpiResBf16 {
    static constexpr bool PERM = true, AFTER_DRAIN = false;
    bf16_t* X; int ldc; float alpha;
    __device__ __forceinline__ void operator()(const f32x4 (&acc)[2][2][4][2], const Unit& u, int wr, int wc, int fr, int fq) const {
        const int row0 = u.pm * BM + wr * 64 + fr, col0 = u.pn * BM + wc * 32 + 8 * fq;
#pragma unroll
        for (int ai = 0; ai < 2; ++ai) {
            u32x4 xin[4][2];
#pragma unroll
            for (int m = 0; m < 4; ++m)
#pragma unroll
                for (int bj = 0; bj < 2; ++bj) xin[m][bj] = *(const u32x4*)(X + (size_t)(row0 + ai * HALF + m * 16) * ldc + col0 + bj * HALF);
#pragma unroll
            for (int m = 0; m < 4; ++m) { bf16_t* rowp = X + (size_t)(row0 + ai * HALF + m * 16) * ldc + col0;
#pragma unroll
                for (int bj = 0; bj < 2; ++bj) { const u32x4 xi = xin[m][bj]; const f32x4 a0 = acc[ai][bj][m][0], a1 = acc[ai][bj][m][1];
                    float x[8] = {__uint_as_float(xi.x << 16), __uint_as_float(xi.x & 0xffff0000u), __uint_as_float(xi.y << 16), __uint_as_float(xi.y & 0xffff0000u),
                                  __uint_as_float(xi.z << 16), __uint_as_float(xi.z & 0xffff0000u), __uint_as_float(xi.w << 16), __uint_as_float(xi.w & 0xffff0000u)};
                    u32x4 w; w.x = cvt_pk_bf16(alpha * x[0] + a0[0], alpha * x[1] + a0[1]); w.y = cvt_pk_bf16(alpha * x[2] + a0[2], alpha * x[3] + a0[3]);
                    w.z = cvt_pk_bf16(alpha * x[4] + a1[0], alpha * x[5] + a1[1]); w.w = cvt_pk_bf16(alpha * x[6] + a1[2], alpha * x[7] + a1[3]);
                    *(u32x4*)(rowp + bj * HALF) = w; } }
        }
    }
};

struct EpiF32 {
    static constexpr bool PERM = false, AFTER_DRAIN = false;
    float* C; int ldc;
    __device__ __forceinline__ void operator()(const f32x4 (&acc)[2][2][4][2], const Unit& u, int wr, int wc, int fr, int fq) const {
        const int row0 = u.pm * BM + wr * 64 + fr, col0 = u.pn * BM + wc * 32 + 4 * fq;
#pragma unroll
        for (int ai = 0; ai < 2; ++ai)
#pragma unroll
            for (int m = 0; m < 4; ++m) { float* rowp = C + (size_t)(row0 + ai * HALF + m * 16) * ldc + col0;
#pragma unroll
                for (int bj = 0; bj < 2; ++bj)
#pragma unroll
                    for (int n = 0; n < 2; ++n) *(f32x4*)(rowp + bj * HALF + n * 16) = acc[ai][bj][m][n]; }
    }
};
struct PanelStats {
    unsigned* xbuf;
    unsigned* cnt;
    unsigned* tmo;
    int ntn; float eps;
    unsigned code;
    __device__ __forceinline__ bool run(const f32x4 (&v)[2][2][4][2], const Unit& u, int wr, int wc, int fr, int fq, PG8_LAS unsigned char* lds, int wid, int lane) const {
        typedef float f32x2v __attribute__((ext_vector_type(2)));
        PG8_LAS f32x2v* P = (PG8_LAS f32x2v*)lds;
        PG8_LAS f32x2v* S = (PG8_LAS f32x2v*)(lds + 8192);
        PG8_LAS unsigned* flag = (PG8_LAS unsigned*)(lds + 8192 + 2048);
#pragma unroll
        for (int ai = 0; ai < 2; ++ai)
#pragma unroll
            for (int m = 0; m < 4; ++m) {
                float s = 0.f;
#pragma unroll
                for (int bj = 0; bj < 2; ++bj)
#pragma unroll
                    for (int n = 0; n < 2; ++n) { const f32x4 x = v[ai][bj][m][n]; s += (x[0] + x[1]) + (x[2] + x[3]); }
                s += __shfl_xor(s, 16); s += __shfl_xor(s, 32);
                const float mw = s * (1.0f / 64.0f); float q = 0.f;
#pragma unroll
                for (int bj = 0; bj < 2; ++bj)
#pragma unroll
                    for (int n = 0; n < 2; ++n) { const f32x4 d = v[ai][bj][m][n] - mw; q += (d[0] * d[0] + d[1] * d[1]) + (d[2] * d[2] + d[3] * d[3]); }
                q += __shfl_xor(q, 16); q += __shfl_xor(q, 32);
                if (fq == 0) P[(ai * HALF + wr * 64 + m * 16 + fr) * 4 + wc] = (f32x2v){mw, q};
            }
        asm volatile("s_waitcnt lgkmcnt(0)" ::: "memory"); __builtin_amdgcn_s_barrier(); asm volatile("" ::: "memory");
#if defined(BROKEN_EXCHANGE_NO_WAIT)
#warning BROKEN CONTROL BUILD: the row-statistics exchange does not wait; results are wrong by design
        if (blockIdx.x >= 64) { const long long t0_ = clock64(); while (clock64() - t0_ < 60000) __builtin_amdgcn_s_sleep(8); }
#endif
        const int row = wid * 32 + (lane & 31);
        if (lane < 32) {
            const f32x2v a = P[row * 4 + 0], b = P[row * 4 + 1], c = P[row * 4 + 2], d = P[row * 4 + 3];
            const float mt = (a.x + b.x + c.x + d.x) * 0.25f;
            const float da = a.x - mt, db = b.x - mt, dc = c.x - mt, dd = d.x - mt;
            const float m2 = (a.y + b.y) + (c.y + d.y) + 64.0f * ((da * da + db * db) + (dc * dc + dd * dd));
            unsigned long long* slot = (unsigned long long*)xbuf + ((size_t)(u.pm * BM + row) * 4 + u.pn);
            __hip_atomic_store(slot, ((unsigned long long)__float_as_uint(m2) << 32) | __float_as_uint(mt), __ATOMIC_RELAXED, __HIP_MEMORY_SCOPE_AGENT);
        }
        asm volatile("s_waitcnt vmcnt(0)" ::: "memory");
        if (lane == 0) __hip_atomic_fetch_add(cnt + 64 * u.pm, 1u, __ATOMIC_RELAXED, __HIP_MEMORY_SCOPE_AGENT);
        if (wid == 0) {
            bool dead = false; const unsigned long long t0 = __builtin_amdgcn_s_memrealtime(); const unsigned want = 8u * (unsigned)ntn;
            for (;;) {
#if defined(BROKEN_EXCHANGE_NO_WAIT)
                break;
#endif
                if ((unsigned)__builtin_amdgcn_readfirstlane(__hip_atomic_load(cnt + 64 * u.pm, __ATOMIC_RELAXED, __HIP_MEMORY_SCOPE_AGENT)) >= want) break;
                if (__builtin_amdgcn_s_memrealtime() - t0 > 2000000ull) {
                    if (lane == 0) { unsigned expect = 0u; __hip_atomic_compare_exchange_strong(tmo + 1, &expect, code | (unsigned)(u.pm & 0xff), __ATOMIC_RELAXED, __ATOMIC_RELAXED, __HIP_MEMORY_SCOPE_AGENT);
                                     __hip_atomic_store(tmo, 1u, __ATOMIC_RELAXED, __HIP_MEMORY_SCOPE_AGENT); }
                    dead = true; break; }
                __builtin_amdgcn_s_sleep(2);
            }
            __builtin_amdgcn_fence(__ATOMIC_ACQUIRE, "agent");
            if (lane == 0) flag[0] = dead ? 1u : 0u;
        }
        asm volatile("s_waitcnt vmcnt(0) lgkmcnt(0)" ::: "memory"); __builtin_amdgcn_s_barrier(); asm volatile("" ::: "memory");
        const bool bad = flag[0] != 0u;
        if (lane < 32) {
            const unsigned long long* slot = (const unsigned long long*)xbuf + (size_t)(u.pm * BM + row) * 4; float mt[4], m2[4]; float ms = 0.f;
#pragma unroll
            for (int t = 0; t < 4; ++t) { if (t < ntn) { const unsigned long long w = __hip_atomic_load(slot + t, __ATOMIC_RELAXED, __HIP_MEMORY_SCOPE_AGENT); mt[t] = __uint_as_float((unsigned)w); m2[t] = __uint_as_float((unsigned)(w >> 32)); } else { mt[t] = 0.f; m2[t] = 0.f; } ms += mt[t]; }
            const float mean = ms / (float)ntn; float q = 0.f;
#pragma unroll
            for (int t = 0; t < 4; ++t) if (t < ntn) { const float dm = mt[t] - mean; q += m2[t] + 256.0f * dm * dm; }
            S[row] = (f32x2v){mean, 1.0f / sqrtf(q / (256.0f * (float)ntn) + eps)};
        }
        asm volatile("s_waitcnt lgkmcnt(0)" ::: "memory"); __builtin_amdgcn_s_barrier(); asm volatile("" ::: "memory");
        return bad;
    }
};
struct EpiLnRes {
    static constexpr bool PERM = false, AFTER_DRAIN = true;
    const float* base; float* out; int ldc; const float* bias; PanelStats st; unsigned poison;
    __device__ __forceinline__ void fused(f32x4 (&acc)[2][2][4][2], const Unit& u, int wr, int wc, int fr, int fq, PG8_LAS unsigned char* lds, int wid, int lane) const {
        typedef float f32x2v __attribute__((ext_vector_type(2)));
        const PG8_LAS f32x2v* S = (const PG8_LAS f32x2v*)(lds + 8192);
        const int col0 = u.pn * BM + wc * 32 + 4 * fq;
#pragma unroll
        for (int bj = 0; bj < 2; ++bj)
#pragma unroll
            for (int n = 0; n < 2; ++n) { const f32x4 bv = bias ? *(const f32x4*)(bias + col0 + bj * HALF + n * 16) : (f32x4){0.f, 0.f, 0.f, 0.f};
#pragma unroll
                for (int ai = 0; ai < 2; ++ai)
#pragma unroll
                    for (int m = 0; m < 4; ++m) acc[ai][bj][m][n] += bv; }
        f32x4 pre[4][2][2];
#pragma unroll
        for (int m = 0; m < 4; ++m) { const size_t off = (size_t)(u.pm * BM + wr * 64 + m * 16 + fr) * ldc + col0;
#pragma unroll
            for (int bj = 0; bj < 2; ++bj)
#pragma unroll
                for (int n = 0; n < 2; ++n) pre[m][bj][n] = *(const f32x4*)(base + off + bj * HALF + n * 16); }
        const bool bad = st.run(acc, u, wr, wc, fr, fq, lds, wid, lane) || poison != 0u;
        const float qnan = __builtin_nanf("");
#pragma unroll
        for (int ai = 0; ai < 2; ++ai)
#pragma unroll
            for (int m = 0; m < 4; ++m) { const int r = ai * HALF + wr * 64 + m * 16 + fr; const f32x2v sr = S[r]; const size_t off = (size_t)(u.pm * BM + r) * ldc + col0;
#pragma unroll
                for (int bj = 0; bj < 2; ++bj)
#pragma unroll
                    for (int n = 0; n < 2; ++n) { const f32x4 bs = ai == 0 ? pre[m][bj][n] : *(const f32x4*)(base + off + bj * HALF + n * 16); f32x4 o = bs + (acc[ai][bj][m][n] - sr.x) * sr.y;
                        if (bad) o = (f32x4){qnan, qnan, qnan, qnan}; *(f32x4*)(out + off + bj * HALF + n * 16) = o; }
                if (m & 1) asm volatile("" ::: "memory"); }
    }
};
struct EpiLnResLn {
    static constexpr bool PERM = false, AFTER_DRAIN = true;
    const float* base; float* out; bf16_t* xn; int ldc; const float* bias; PanelStats st1, st2; unsigned poison;
    __device__ __forceinline__ void fused(f32x4 (&acc)[2][2][4][2], const Unit& u, int wr, int wc, int fr, int fq, PG8_LAS unsigned char* lds, int wid, int lane) const {
        typedef float f32x2v __attribute__((ext_vector_type(2))); typedef unsigned u32x2v __attribute__((ext_vector_type(2)));
        const PG8_LAS f32x2v* S = (const PG8_LAS f32x2v*)(lds + 8192);
        const int col0 = u.pn * BM + wc * 32 + 4 * fq;
#pragma unroll
        for (int bj = 0; bj < 2; ++bj)
#pragma unroll
            for (int n = 0; n < 2; ++n) { const f32x4 bv = bias ? *(const f32x4*)(bias + col0 + bj * HALF + n * 16) : (f32x4){0.f, 0.f, 0.f, 0.f};
#pragma unroll
                for (int ai = 0; ai < 2; ++ai)
#pragma unroll
                    for (int m = 0; m < 4; ++m) acc[ai][bj][m][n] += bv; }
        bool bad = st1.run(acc, u, wr, wc, fr, fq, lds, wid, lane) || poison != 0u;
        const float qnan = __builtin_nanf("");
#pragma unroll
        for (int ai = 0; ai < 2; ++ai)
#pragma unroll
            for (int m = 0; m < 4; ++m) { const int r = ai * HALF + wr * 64 + m * 16 + fr; const f32x2v sr = S[r]; const size_t off = (size_t)(u.pm * BM + r) * ldc + col0;
#pragma unroll
                for (int bj = 0; bj < 2; ++bj)
#pragma unroll
                    for (int n = 0; n < 2; ++n) { const f32x4 bs = *(const f32x4*)(base + off + bj * HALF + n * 16); acc[ai][bj][m][n] = bs + (acc[ai][bj][m][n] - sr.x) * sr.y; }
                asm volatile("" : "+v"(acc[ai][0][m][0]), "+v"(acc[ai][0][m][1]), "+v"(acc[ai][1][m][0]), "+v"(acc[ai][1][m][1]));
                if (m & 1) asm volatile("" ::: "memory"); }
        const bool bad1 = bad;
        bad = st2.run(acc, u, wr, wc, fr, fq, lds, wid, lane) || bad;
#pragma unroll
        for (int ai = 0; ai < 2; ++ai)
#pragma unroll
            for (int m = 0; m < 4; ++m) { const int r = ai * HALF + wr * 64 + m * 16 + fr; const f32x2v sr = S[r]; const size_t off = (size_t)(u.pm * BM + r) * ldc + col0;
#pragma unroll
                for (int bj = 0; bj < 2; ++bj)
#pragma unroll
                    for (int n = 0; n < 2; ++n) { const f32x4 x1 = acc[ai][bj][m][n]; *(f32x4*)(out + off + bj * HALF + n * 16) = bad1 ? (f32x4){qnan, qnan, qnan, qnan} : x1;
                        const f32x4 o = (x1 - sr.x) * sr.y; u32x2v w; w.x = cvt_pk_bf16(o[0], o[1]); w.y = cvt_pk_bf16(o[2], o[3]);
                        if (bad) { w.x = 0x7fc07fc0u; w.y = 0x7fc07fc0u; } *(u32x2v*)(xn + off + bj * HALF + n * 16) = w; }
                asm volatile("" ::: "memory"); }
    }
};

template <class Epi, class Sched, bool ALIGN_EPI = false, bool SP2 = false>
__device__ __forceinline__ void gemm_phase(PG8_LAS unsigned char* lds, const Gemm g, const Sched& S, const Epi& E, int wv) {
    int tid0_ = threadIdx.x; asm volatile("" : "+v"(tid0_)); (void)wv;
    const int tid = tid0_, wid = __builtin_amdgcn_readfirstlane(tid >> 6), lane = tid & 63, wr = wid >> 2, wc = wid & 3, fr = lane & 15, fq = lane >> 4;
    const int K = g.K, nt = K / BK;
    unsigned voffA[2], voffB[2];
#pragma unroll
    for (int i = 0; i < 2; ++i) { int R, C; stage_rc(tid * 16 + i * 8192, R, C); const int Rb = Epi::PERM ? ((R & ~31) + perm32(R & 31)) : R;
        voffA[i] = (unsigned)(R * K + C) * 2u; voffB[i] = (unsigned)(Rb * K + C) * 2u; }
    const size_t kstep = (size_t)(BK * 2);
    const size_t hstep = (size_t)HALF * K * 2;
    const size_t tstep = 2 * hstep;
    const unsigned ldsw = (unsigned)wid * 1024u;
    const int aoff = lds_byte(wr * 64 + fr, fq * 8), boff = lds_byte(wc * 32 + fr, fq * 8);
#define PG8_SA(b, h) (((b) * 2 + (h)) * HTB)
#define PG8_SB(b, h) ((4 + (b) * 2 + (h)) * HTB)
#define PG8_STAGE(bufoff, gbase, voff) do { _Pragma("unroll") for (int _i = 0; _i < 2; ++_i) \
        __builtin_amdgcn_global_load_lds((const unsigned*)((const char*)(gbase) + (voff)[_i]), (PG8_LAS unsigned*)(lds + (bufoff) + ldsw + _i * 8192), 16, 0, 0); } while (0)
#define PG8_LDA(dst, b, h) do { _Pragma("unroll") for (int m = 0; m < 4; ++m) _Pragma("unroll") for (int k = 0; k < 2; ++k) dst[m][k] = *(const PG8_LAS bf16x8*)(lds + PG8_SA(b, h) + aoff + m * 2048 + k * 1024); } while (0)
#define PG8_LDB(dst, b, h) do { _Pragma("unroll") for (int n = 0; n < 2; ++n) _Pragma("unroll") for (int k = 0; k < 2; ++k) dst[n][k] = *(const PG8_LAS bf16x8*)(lds + PG8_SB(b, h) + boff + n * 2048 + k * 1024); } while (0)
#define PG8_MMA(ai, bj, At, Bt) do { __builtin_amdgcn_s_setprio(1); _Pragma("unroll") for (int m = 0; m < 4; ++m) _Pragma("unroll") for (int n = 0; n < 2; ++n) _Pragma("unroll") for (int k = 0; k < 2; ++k) \
        acc[ai][bj][m][n] = __builtin_amdgcn_mfma_f32_16x16x32_bf16(Bt[n][k], At[m][k], acc[ai][bj][m][n], 0, 0, 0); __builtin_amdgcn_s_setprio(0); } while (0)
#define PG8_WAIT_V(n) asm volatile("s_waitcnt vmcnt(" #n ")" ::: "memory")
#define PG8_WAIT_L(n) asm volatile("s_waitcnt lgkmcnt(" #n ")" ::: "memory")
#define PG8_BAR __builtin_amdgcn_s_barrier()
#define PG8_SCHED __builtin_amdgcn_sched_barrier(0)
    Unit cur, nxt; int ui = 0;
    if (!S.next(0, cur)) return;
    f32x4 acc[2][2][4][2];
#pragma unroll
    for (int a = 0; a < 2; ++a)
#pragma unroll
        for (int b = 0; b < 2; ++b)
#pragma unroll
            for (int m = 0; m < 4; ++m)
#pragma unroll
                for (int n = 0; n < 2; ++n) acc[a][b][m][n] = (f32x4){0.f, 0.f, 0.f, 0.f};
    bf16x8 At[4][2], B0[2][2], B1[2][2];
    const char* cA = (const char*)g.A + (size_t)cur.pm * tstep; const char* cB = (const char*)g.Bt + (size_t)cur.pn * tstep;
    S.a_ready(cur);
    if constexpr (SP2) {
        PG8_STAGE(PG8_SB(0, 0), cB, voffB); PG8_STAGE(PG8_SB(0, 1), cB + hstep, voffB); PG8_STAGE(PG8_SA(0, 0), cA, voffA); PG8_STAGE(PG8_SA(0, 1), cA + hstep, voffA);
        if (wr == 1) PG8_BAR;
        PG8_WAIT_V(2); PG8_BAR;
        PG8_STAGE(PG8_SB(1, 0), cB + kstep, voffB); PG8_STAGE(PG8_SA(1, 0), cA + kstep, voffA); PG8_STAGE(PG8_SB(1, 1), cB + hstep + kstep, voffB);
        PG8_WAIT_V(6); PG8_BAR;
    } else {
        PG8_STAGE(PG8_SB(0, 0), cB, voffB); PG8_STAGE(PG8_SA(0, 0), cA, voffA); PG8_STAGE(PG8_SB(0, 1), cB + hstep, voffB); PG8_STAGE(PG8_SA(0, 1), cA + hstep, voffA);
        if (wr == 1) PG8_BAR;
        PG8_WAIT_V(4); PG8_BAR;
        PG8_STAGE(PG8_SB(1, 0), cB + kstep, voffB); PG8_STAGE(PG8_SA(1, 0), cA + kstep, voffA); PG8_STAGE(PG8_SB(1, 1), cB + hstep + kstep, voffB);
        PG8_WAIT_V(6); PG8_BAR;
    }
    for (;;) {
        const bool has_next = S.next(ui + 1, nxt);
        const char* nA = has_next ? (const char*)g.A + (size_t)nxt.pm * tstep : cA; const char* nB = has_next ? (const char*)g.Bt + (size_t)nxt.pn * tstep : cB;
        for (int t = 0; t < nt; t += 2) {
            const bool last = (t == nt - 2);
            const char* a1 = cA + (size_t)(t + 1) * kstep;
            const char* a2 = last ? nA : cA + (size_t)(t + 2) * kstep; const char* b2 = last ? nB : cB + (size_t)(t + 2) * kstep;
            const char* a3 = a2 + kstep; const char* b3 = b2 + kstep;
            if (last && has_next) S.a_ready(nxt);
            if constexpr (SP2) {
            PG8_LDB(B0, 0, 0); PG8_LDB(B1, 0, 1); PG8_SCHED; PG8_LDA(At, 0, 0); PG8_STAGE(PG8_SA(1, 1), a1 + hstep, voffA);
            PG8_WAIT_V(8); PG8_WAIT_L(0); PG8_BAR; PG8_MMA(0, 0, At, B0); PG8_MMA(0, 1, At, B1); PG8_BAR; PG8_SCHED;
            PG8_LDA(At, 0, 1); PG8_STAGE(PG8_SB(0, 0), b2, voffB); PG8_STAGE(PG8_SB(0, 1), b2 + hstep, voffB); PG8_STAGE(PG8_SA(0, 0), a2, voffA);
            PG8_WAIT_V(8); PG8_WAIT_L(0); PG8_BAR; PG8_MMA(1, 0, At, B0); PG8_MMA(1, 1, At, B1); PG8_BAR; PG8_SCHED;
            PG8_LDB(B0, 1, 0); PG8_LDB(B1, 1, 1); PG8_SCHED; PG8_LDA(At, 1, 0); PG8_STAGE(PG8_SA(0, 1), a2 + hstep, voffA);
            PG8_WAIT_V(8); PG8_WAIT_L(0); PG8_BAR; PG8_MMA(0, 0, At, B0); PG8_MMA(0, 1, At, B1); PG8_BAR; PG8_SCHED;
            PG8_LDA(At, 1, 1); PG8_STAGE(PG8_SB(1, 0), b3, voffB); PG8_STAGE(PG8_SB(1, 1), b3 + hstep, voffB); PG8_STAGE(PG8_SA(1, 0), a3, voffA);
            PG8_WAIT_V(8); PG8_WAIT_L(0); PG8_BAR; PG8_MMA(1, 0, At, B0); PG8_MMA(1, 1, At, B1); PG8_BAR; PG8_SCHED;
            } else {
            PG8_LDB(B0, 0, 0); PG8_SCHED; PG8_LDA(At, 0, 0); PG8_STAGE(PG8_SA(1, 1), a1 + hstep, voffA);
            PG8_WAIT_L(8); PG8_BAR; PG8_WAIT_L(0); PG8_MMA(0, 0, At, B0); PG8_BAR; PG8_SCHED;
            PG8_LDB(B1, 0, 1); PG8_STAGE(PG8_SB(0, 0), b2, voffB);
            PG8_BAR; PG8_WAIT_L(0); PG8_MMA(0, 1, At, B1); PG8_BAR;
            PG8_LDA(At, 0, 1); PG8_STAGE(PG8_SA(0, 0), a2, voffA);
            PG8_BAR; PG8_WAIT_L(0); PG8_MMA(1, 0, At, B0); PG8_BAR; PG8_SCHED;
            PG8_STAGE(PG8_SB(0, 1), b2 + hstep, voffB);
            PG8_WAIT_V(6); PG8_BAR; PG8_MMA(1, 1, At, B1); PG8_BAR;
            PG8_LDB(B0, 1, 0); PG8_SCHED; PG8_LDA(At, 1, 0); PG8_STAGE(PG8_SA(0, 1), a2 + hstep, voffA);
            PG8_WAIT_L(8); PG8_BAR; PG8_WAIT_L(0); PG8_MMA(0, 0, At, B0); PG8_BAR; PG8_SCHED;
            PG8_LDB(B1, 1, 1); PG8_STAGE(PG8_SB(1, 0), b3, voffB);
            PG8_BAR; PG8_WAIT_L(0); PG8_MMA(0, 1, At, B1); PG8_BAR;
            PG8_LDA(At, 1, 1); PG8_STAGE(PG8_SA(1, 0), a3, voffA);
            PG8_BAR; PG8_WAIT_L(0); PG8_MMA(1, 0, At, B0); PG8_BAR; PG8_SCHED;
            PG8_STAGE(PG8_SB(1, 1), b3 + hstep, voffB);
            PG8_WAIT_V(6); PG8_BAR; PG8_MMA(1, 1, At, B1); PG8_BAR;
            }
        }
        if constexpr (ALIGN_EPI) { if (wr == 0) PG8_BAR; }
        if constexpr (!Epi::AFTER_DRAIN) { E(acc, cur, wr, wc, fr, fq); S.done(cur); }
        if (!has_next) break;
#pragma unroll
        for (int a = 0; a < 2; ++a)
#pragma unroll
            for (int b = 0; b < 2; ++b)
#pragma unroll
                for (int m = 0; m < 4; ++m)
#pragma unroll
                    for (int n = 0; n < 2; ++n) acc[a][b][m][n] = (f32x4){0.f, 0.f, 0.f, 0.f};
        cur = nxt; cA = nA; cB = nB; ++ui;
        if constexpr (ALIGN_EPI) { if (wr == 1) PG8_BAR; }
    }
    PG8_WAIT_V(0);
    if constexpr (!ALIGN_EPI) { if (wr == 0) PG8_BAR; }
    PG8_BAR;
    if constexpr (Epi::AFTER_DRAIN) { E.fused(acc, cur, wr, wc, fr, fq, lds, wid, lane); S.done(cur); }
#undef PG8_SA
#undef PG8_SB
#undef PG8_STAGE
#undef PG8_LDA
#undef PG8_LDB
#undef PG8_MMA
#undef PG8_WAIT_V
#undef PG8_WAIT_L
#undef PG8_BAR
#undef PG8_SCHED
}
}

#ifndef PG8_SP2
#define PG8_SP2 true
#endif
#ifndef PG8_ALIGN
#define PG8_ALIGN true
#endif
#define GAS __attribute__((address_space(1)))
#define LAS __attribute__((address_space(3)))
#define XB_TMO      128
#define XB_XCNT(j)  (256  + 64 * (j))
#define XB_XSUB(j)  (1280 + 64 * (j))
#define XB_XGEN(j)  (2304 + 64 * (j))
#define XB_TOP      3328
#define XB_TOPGEN   3392
#define XCD_BAR_WORDS 3456
#define XB_SPIN_CAP (1u << 18)

__device__ __forceinline__ unsigned xb_ld(unsigned* p)              { return __hip_atomic_load(p, __ATOMIC_RELAXED, __HIP_MEMORY_SCOPE_AGENT); }
__device__ __forceinline__ unsigned xb_add(unsigned* p, unsigned v) { return __hip_atomic_fetch_add(p, v, __ATOMIC_RELAXED, __HIP_MEMORY_SCOPE_AGENT); }
__device__ __forceinline__ unsigned xb_xcc_id() { return (unsigned)__builtin_amdgcn_s_getreg((3 << 11) | 20) & 0xFu; }
#define XB_SPIN(cond, bar) do { unsigned _sp = 0; while (cond) { __builtin_amdgcn_s_sleep(1); \
    if ((++_sp & 255u) == 0u) { if (xb_ld(&(bar)[XB_TMO])) break; if (_sp > XB_SPIN_CAP) { atomicAdd(&(bar)[XB_TMO], 1u); break; } } } } while (0)

struct XcdBarrier {
    unsigned* bar; unsigned x;
    volatile LAS unsigned* st;
    int wv;
};

__device__ __forceinline__ XcdBarrier xcd_barrier_post(unsigned* bar, volatile LAS unsigned* st) {
    XcdBarrier b; b.bar = bar; b.x = xb_xcc_id(); b.st = st;
    if (threadIdx.x == 0) (void)xb_add(&bar[XB_XCNT(b.x)], 1u);
    return b;
}
__device__ __forceinline__ void xcd_barrier_complete(unsigned* bar, unsigned x, unsigned& nloc, unsigned& nx) {
    asm volatile("" : "+s"(x));
    const unsigned G = gridDim.x * gridDim.y * gridDim.z;
    unsigned sum, cnt, mine, sp = 0u;
    for (;;) {
        sum = 0u; cnt = 0u; mine = 0u;
#pragma unroll
        for (unsigned j = 0; j < 16; ++j) { const unsigned c = xb_ld(&bar[XB_XCNT(j)]); sum += c; cnt += (c > 0u) ? 1u : 0u; mine = (j == x) ? c : mine; }
        if (sum == G) break;
        __builtin_amdgcn_s_sleep(1);
        if ((++sp & 255u) == 0u) { if (xb_ld(&bar[XB_TMO])) break; if (sp > XB_SPIN_CAP) { atomicAdd(&bar[XB_TMO], 1u); break; } }
    }
    nloc = mine > 0u ? mine : 1u; nx = cnt > 0u ? cnt : 1u;
}

__device__ __forceinline__ void xcd_barrier(const XcdBarrier& b) {
    asm volatile("s_waitcnt vmcnt(0)" ::: "memory");
    __syncthreads();
    if (threadIdx.x == 0) {
        unsigned* bar = b.bar; asm volatile("" : "+s"(bar));
        __builtin_amdgcn_s_waitcnt(0);
        unsigned nloc = b.st[0], nx = b.st[1];
        if (nloc == 0u) { xcd_barrier_complete(bar, b.x, nloc, nx); b.st[0] = nloc; b.st[1] = nx; }
        const unsigned old = xb_add(&bar[XB_XSUB(b.x)], 1u);
        const unsigned gen = old / nloc;
        if (old + 1u == (gen + 1u) * nloc) {
            __builtin_amdgcn_fence(__ATOMIC_RELEASE, "agent");
            asm volatile("s_waitcnt vmcnt(0)" ::: "memory");
            const unsigned og = xb_add(&bar[XB_TOP], 1u);
            const unsigned tg = og / nx;
            if (og + 1u == (tg + 1u) * nx) xb_add(&bar[XB_TOPGEN], 1u);
            else XB_SPIN(xb_ld(&bar[XB_TOPGEN]) == tg, bar);
            __builtin_amdgcn_fence(__ATOMIC_ACQUIRE, "agent");
            xb_add(&bar[XB_XGEN(b.x)], 1u);
            asm volatile("s_waitcnt vmcnt(0)" ::: "memory");
        } else {
            XB_SPIN(xb_ld(&bar[XB_XGEN(b.x)]) == gen, bar);
            __builtin_amdgcn_fence(__ATOMIC_ACQUIRE, "agent");
            asm volatile("s_waitcnt vmcnt(0)" ::: "memory");
        }
    }
    __syncthreads();
}
namespace dattn {
constexpr int D = 128, QST = 2048, KVS = 512, OST = 2048, MTW = 68, JLO = 3;
constexpr float THR = 8.f; constexpr bool WSKIP = false;
typedef unsigned short bf16;
constexpr float SCALE = 1.0f;
constexpr int NW = 8, QBLK = 32, KVBLK = 64, QB = NW * QBLK;
constexpr int SHM_V = KVBLK * D * 2, SHM_K = KVBLK * D * 2;
constexpr int LDS_BYTES = 2 * SHM_V + 2 * SHM_K + NW * 64 * 4;

typedef short bf16x8 __attribute__((ext_vector_type(8)));
typedef short s16x4 __attribute__((ext_vector_type(4)));
typedef float f32x16 __attribute__((ext_vector_type(16)));
typedef float f32x4 __attribute__((ext_vector_type(4)));
typedef unsigned u32x4 __attribute__((ext_vector_type(4)));
template <class A, class Bt> struct same_t { static constexpr bool v = false; };
template <class A> struct same_t<A, A> { static constexpr bool v = true; };

#define KSWZ(row, colB) ((row) * 256 + ((colB) ^ (((row) & 7) << 4)))
#define SBAR() __builtin_amdgcn_sched_barrier(0)
__device__ __forceinline__ int v_st(int k, int c) { const int kk = (k & ~0xC) | ((k & 4) << 1) | ((k & 8) >> 1); return ((kk >> 3) * 4 + (c >> 5)) * 512 + ((kk & 7) * 32 + (c & 31)) * 2; }
__device__ __forceinline__ int v_rd_base(int lane) { return ((lane & 3) << 3) | (((lane >> 2) & 3) << 6) | (((lane >> 4) & 1) << 5) | (((lane >> 5) & 1) << 8); }
constexpr int v_rd_off(int d0, int ks, int half) { return d0 * 512 + ks * 4096 + half * 2048; }
__device__ __forceinline__ int crow(int r, int hi) { return (r & 3) + 8 * (r >> 2) + 4 * hi; }
__device__ __forceinline__ unsigned cvtpk(float lo, float hi) {
    unsigned r; asm volatile("v_cvt_pk_bf16_f32 %0, %1, %2" : "=v"(r) : "v"(lo), "v"(hi)); return r;
}
__device__ __forceinline__ bf16x8 pack8(f32x4 a, f32x4 b) {
    u32x4 w = {cvtpk(a[0], a[1]), cvtpk(a[2], a[3]), cvtpk(b[0], b[1]), cvtpk(b[2], b[3])};
    return *reinterpret_cast<bf16x8*>(&w);
}
template <class T> __device__ __forceinline__ bf16x8 load8(const T* p) {
    if constexpr (same_t<T, float>::v) { return pack8(*(const f32x4*)p, *(const f32x4*)(p + 4)); }
    else { return *reinterpret_cast<const bf16x8*>(p); }
}
__device__ __forceinline__ void mask_tile(f32x16& p0, f32x16& p1, int dq, unsigned W) {
    const float NEG = -__builtin_inff();
#pragma unroll
    for (int r = 0; r < 16; ++r) {
        const int c = (r & 3) + 8 * (r >> 2);
        if ((unsigned)(dq - c) >= W) p0[r] = NEG;
        if ((unsigned)(dq - c - 32) >= W) p1[r] = NEG;
    }
}
__device__ __forceinline__ void mask_bits(f32x16& p0, f32x16& p1, unsigned long long mw, int hi) {
    const float NEG = -__builtin_inff();
    const unsigned lo = (unsigned)(mw >> (4 * hi)), up = (unsigned)(mw >> (32 + 4 * hi));
#pragma unroll
    for (int r = 0; r < 16; ++r) {
        const int c = (r & 3) + 8 * (r >> 2);
        if (!((lo >> c) & 1u)) p0[r] = NEG;
        if (!((up >> c) & 1u)) p1[r] = NEG;
    }
}
__device__ __forceinline__ void partialSM(f32x16& p0, f32x16& p1, float& m_reg, float& mn, float& alpha) {
    float pmax = p0[0]; for (int r = 1; r < 16; ++r) pmax = fmaxf(pmax, p0[r]); for (int r = 0; r < 16; ++r) pmax = fmaxf(pmax, p1[r]);
    { auto rr = __builtin_amdgcn_permlane32_swap(__float_as_uint(pmax), __float_as_uint(pmax), false, false);
      pmax = fmaxf(__uint_as_float(rr[0]), __uint_as_float(rr[1])); }
    constexpr float C2 = 1.4426950408889634f * SCALE;
    if (__builtin_expect(__all((pmax - m_reg) * SCALE <= THR), 1)) { mn = m_reg; alpha = 1.f; }
    else { mn = fmaxf(m_reg, pmax); alpha = __builtin_amdgcn_exp2f((m_reg - mn) * C2); m_reg = mn; }
    const float mnL = -mn * C2;
    for (int r = 0; r < 16; ++r) p0[r] = fmaf(p0[r], C2, mnL); for (int r = 0; r < 16; ++r) p1[r] = fmaf(p1[r], C2, mnL);
    for (int r = 0; r < 16; ++r) p0[r] = __builtin_amdgcn_exp2f(p0[r]);
}
__device__ __forceinline__ void finishSM(f32x16& p0, f32x16& p1, float alpha, float& l_reg, bf16x8& pa0, bf16x8& pa1, bf16x8& pa2, bf16x8& pa3) {
    for (int r = 0; r < 16; ++r) p1[r] = __builtin_amdgcn_exp2f(p1[r]);
    float ps = 0; for (int r = 0; r < 16; ++r) ps += p0[r]; for (int r = 0; r < 16; ++r) ps += p1[r];
    { auto rr = __builtin_amdgcn_permlane32_swap(__float_as_uint(ps), __float_as_uint(ps), false, false);
      ps = __uint_as_float(rr[0]) + __uint_as_float(rr[1]); }
    l_reg = l_reg * alpha + ps;
#define PK4(P, B_, OUT) do { unsigned a0 = cvtpk(P[B_+0], P[B_+1]), a1 = cvtpk(P[B_+2], P[B_+3]);                          \
        unsigned b0 = cvtpk(P[B_+4], P[B_+5]), b1 = cvtpk(P[B_+6], P[B_+7]);                                             \
        auto r0 = __builtin_amdgcn_permlane32_swap(a0, b0, false, false); auto r1 = __builtin_amdgcn_permlane32_swap(a1, b1, false, false); \
        u32x4 w = {r0[0], r1[0], r0[1], r1[1]}; OUT = *reinterpret_cast<bf16x8*>(&w); } while (0)
    PK4(p0, 0, pa0); PK4(p0, 8, pa1); PK4(p1, 0, pa2); PK4(p1, 8, pa3);
#undef PK4
}
template <int KB, bool SK>
__device__ __forceinline__ void qkt(f32x16& p0, f32x16& p1, const char* K_lds, int r32, int hi, const bf16x8* qr, bool act) {
    if (SK && !act) { const float NEG = -__builtin_inff();
#pragma unroll
        for (int r = 0; r < 16; ++r) { p0[r] = NEG; p1[r] = NEG; } return; }
    p0 = f32x16{}; p1 = f32x16{};
    const char* kb[4];
#pragma unroll
    for (int dd = 0; dd < 4; ++dd) kb[dd] = K_lds + KB * SHM_K + KSWZ(r32, (dd * 16 + hi * 8) * 2);
#pragma unroll
    for (int d0 = 0; d0 < 8; ++d0) { const char* a = kb[d0 & 3] + (d0 >> 2) * 128;
        bf16x8 b0 = *reinterpret_cast<const bf16x8*>(a);
        bf16x8 b1 = *reinterpret_cast<const bf16x8*>(a + 32 * 256);
        p0 = __builtin_amdgcn_mfma_f32_32x32x16_bf16(b0, qr[d0], p0, 0, 0, 0);
        p1 = __builtin_amdgcn_mfma_f32_32x32x16_bf16(b1, qr[d0], p1, 0, 0, 0); }
}
template <int VB, bool SK>
__device__ __forceinline__ void pv_tile(f32x16* o, int vb0, bf16x8 pa0, bf16x8 pa1, bf16x8 pa2, bf16x8 pa3, bool act) {
    if (SK && !act) return;
#define TRRD(dst, off) asm volatile("ds_read_b64_tr_b16 %0, %1 offset:%2" : "=&v"(dst) : "v"(vb0), "i"(off) : "memory")
#define PV_D0(d0) do { s16x4 l0, l1, l2, l3, h0, h1, h2, h3; constexpr int b_ = VB * SHM_V + v_rd_off(d0, 0, 0);     \
        TRRD(l0, b_); TRRD(h0, b_ + 2048); TRRD(l1, b_ + 4096); TRRD(h1, b_ + 6144); TRRD(l2, b_ + 8192); TRRD(h2, b_ + 10240); TRRD(l3, b_ + 12288); TRRD(h3, b_ + 14336); \
        asm volatile("s_waitcnt lgkmcnt(0)" ::: "memory"); SBAR();                 \
        o[d0] = __builtin_amdgcn_mfma_f32_32x32x16_bf16(pa0, (bf16x8){l0[0], l0[1], l0[2], l0[3], h0[0], h0[1], h0[2], h0[3]}, o[d0], 0, 0, 0);   \
        o[d0] = __builtin_amdgcn_mfma_f32_32x32x16_bf16(pa1, (bf16x8){l1[0], l1[1], l1[2], l1[3], h1[0], h1[1], h1[2], h1[3]}, o[d0], 0, 0, 0);   \
        o[d0] = __builtin_amdgcn_mfma_f32_32x32x16_bf16(pa2, (bf16x8){l2[0], l2[1], l2[2], l2[3], h2[0], h2[1], h2[2], h2[3]}, o[d0], 0, 0, 0);   \
        o[d0] = __builtin_amdgcn_mfma_f32_32x32x16_bf16(pa3, (bf16x8){l3[0], l3[1], l3[2], l3[3], h3[0], h3[1], h3[2], h3[3]}, o[d0], 0, 0, 0); } while (0)
    PV_D0(0); PV_D0(1); PV_D0(2); PV_D0(3);
#undef PV_D0
#undef TRRD
}

template <class TIn, class TOut> struct BlockRef { const TIn* Q; const TIn* K; const TIn* V; TOut* O; const unsigned long long* M; int P0; };
template <class TIn> struct Seam {
    bf16x8 qr[8];
    bf16x8 st_v0, st_v1, st_k0, st_k1; f32x4 sf0, sf1, sf2, sf3;
    f32x4 tq[16];
};
__device__ __forceinline__ int swa_jlo(int, int) { return JLO; }
#define ROW(p, k0, rr) ((p) + (size_t)((k0) + (rr)) * KVS + sc)
#define VMW() asm volatile("s_waitcnt vmcnt(0)" ::: "memory")
#define VMWN(n) asm volatile("s_waitcnt vmcnt(%0)" :: "i"(n) : "memory")
#define SLOAD_H(Kp, Vp, k0) do { S.st_v0 = load8<TIn>(ROW(Vp, k0, sr)); S.st_v1 = load8<TIn>(ROW(Vp, k0, 32 + sr));              \
                         S.st_k0 = load8<TIn>(ROW(Kp, k0, sr)); S.st_k1 = load8<TIn>(ROW(Kp, k0, 32 + sr)); } while (0)
#define SWRITE_HK(bf) do { *(bf16x8*)(K_lds + (bf) * SHM_K + kws) = S.st_k0; *(bf16x8*)(K_lds + (bf) * SHM_K + kws + 32 * 256) = S.st_k1; } while (0)
#define SWRITE_HV(bf) do { *(bf16x8*)(V_lds + (bf) * SHM_V + vst0) = S.st_v0; *(bf16x8*)(V_lds + (bf) * SHM_V + vst1) = S.st_v1; } while (0)
#define SWRITE_H(bf) do { SWRITE_HV(bf); SWRITE_HK(bf); } while (0)
#define SLOAD_F(p, k0) do { S.sf0 = *(const f32x4*)ROW(p, k0, sr); S.sf1 = *(const f32x4*)(ROW(p, k0, sr) + 4);                \
                            S.sf2 = *(const f32x4*)ROW(p, k0, 32 + sr); S.sf3 = *(const f32x4*)(ROW(p, k0, 32 + sr) + 4); } while (0)
#define SWRITE_KF(bf) do { *(bf16x8*)(K_lds + (bf) * SHM_K + kws) = pack8(S.sf0, S.sf1); *(bf16x8*)(K_lds + (bf) * SHM_K + kws + 32 * 256) = pack8(S.sf2, S.sf3); } while (0)
#define SWRITE_VF(bf) do { *(bf16x8*)(V_lds + (bf) * SHM_V + vst0) = pack8(S.sf0, S.sf1); *(bf16x8*)(V_lds + (bf) * SHM_V + vst1) = pack8(S.sf2, S.sf3); } while (0)
template <class TIn, class TOut>
__device__ __forceinline__ void causal_swa_prime(const BlockRef<TIn, TOut>& cur, int W, char* lds, Seam<TIn>& S, int wv) {
    constexpr bool F32 = same_t<TIn, float>::v;
    int tid0_ = threadIdx.x; asm volatile("" : "+v"(tid0_)); (void)wv;
    const int tid = tid0_, wid = __builtin_amdgcn_readfirstlane(tid >> 6), lane = tid & 63, r32 = lane & 31, hi = lane >> 5;
    const int sr = tid >> 4, sc = (tid & 15) * 8, kws = KSWZ(sr, sc * 2); char* K_lds = lds + 2 * SHM_V;
    const int kb0 = swa_jlo(cur.P0, W) * KVBLK;
    for (int d0 = 0; d0 < 8; ++d0) S.qr[d0] = load8<TIn>(cur.Q + (size_t)(wid * QBLK + r32) * QST + d0 * 16 + hi * 8);
    if constexpr (F32) { SLOAD_F((const float*)cur.K, kb0); VMW(); SWRITE_KF(0); SBAR(); SLOAD_F((const float*)cur.V, kb0); }
    else { SLOAD_H(cur.K, cur.V, kb0); VMW(); SWRITE_HK(0); }
    __syncthreads();
}
template <class TIn, class TOut>
__device__ __forceinline__ void causal_swa_block(const BlockRef<TIn, TOut>& cur, const BlockRef<TIn, TOut>& nxt, int skv, int W, char* lds, Seam<TIn>& S, int wv) {
    constexpr bool F32 = same_t<TIn, float>::v;
    int tid0_ = threadIdx.x; asm volatile("" : "+v"(tid0_)); (void)wv;
    const int tid = tid0_, wid = __builtin_amdgcn_readfirstlane(tid >> 6), lane = tid & 63, r32 = lane & 31, hi = lane >> 5;
    const int j_lo = swa_jlo(cur.P0, W);
    int j_hi = (cur.P0 + QB - 1) / KVBLK + 1; if (j_hi > skv / KVBLK) j_hi = skv / KVBLK;
    const int NT = j_hi - j_lo;
    const int kbn = swa_jlo(nxt.P0, W) * KVBLK;
    const int qlo = cur.P0 + wid * QBLK; (void)qlo;
    const unsigned long long* mrow = cur.M + (size_t)(wid * QBLK + r32) * MTW;
    const int qm_unused = 0; (void)qm_unused;
    char* V_lds = lds; char* K_lds = lds + 2 * SHM_V;
    float* ws = (float*)(lds + 2 * SHM_V + 2 * SHM_K) + wid * 64; float* li_l = ws, * al_l = ws + 32;
    float m_reg = -1e30f, l_reg = 0; f32x16 o[4] = {};
    const int sr = tid >> 4, sc = (tid & 15) * 8, vst0 = v_st(sr, sc), vst1 = v_st(32 + sr, sc), kws = KSWZ(sr, sc * 2);
    const int vb0 = (int)(uintptr_t)V_lds + v_rd_base(lane);
    const TIn* Kh = cur.K; const TIn* Vh = cur.V;
#define RESC(a) do { if (__any((a) < 1.f)) { if (hi == 0) al_l[r32] = (a); asm volatile("s_waitcnt lgkmcnt(0)" ::: "memory");              \
                     for (int d_ = 0; d_ < 4; ++d_) for (int r = 0; r < 16; ++r) o[d_][r] *= al_l[crow(r, hi)]; } } while (0)
#define KBASE(t) ((j_lo + (t)) * KVBLK)
#define ACT(t) (KBASE(t) <= qlo + QBLK - 1 && KBASE(t) + KVBLK - 1 >= qlo - W + 1)
#define MASKT(P0_, P1_, t) mask_bits(P0_, P1_, (((t) & 1) ? mwB : mwA), hi)
#define MWLOAD(t) do { const int tt_ = (t) < NT ? (t) : NT - 1; if ((t) & 1) mwB = mrow[j_lo + tt_]; else mwA = mrow[j_lo + tt_]; } while (0)
    constexpr int NQL = F32 ? 16 : 8;
    constexpr bool SK = WSKIP && !F32;
#define SEAM_K0() do { VMWN(NQL); if constexpr (F32) { SWRITE_KF(0); SBAR(); SLOAD_F((const float*)nxt.V, kbn); } else { SWRITE_HK(0); } SBAR(); } while (0)
    f32x16 pA0, pA1, pB0, pB1; float mnA, mnB, alA, alB; bf16x8 pa0, pa1, pa2, pa3;
    unsigned long long mwA = mrow[j_lo], mwB = mrow[j_lo + (NT > 1 ? 1 : 0)];
    if constexpr (F32) { VMW(); SWRITE_VF(0); SBAR(); } else { SWRITE_HV(0); SBAR(); }
    if (NT > 1) { if constexpr (F32) SLOAD_F((const float*)Kh, KBASE(1)); else SLOAD_H(Kh, Vh, KBASE(1)); }
    SBAR(); qkt<0, SK>(pA0, pA1, K_lds, r32, hi, S.qr, ACT(0));
    if constexpr (F32) { if (NT > 1) { VMW(); SWRITE_KF(1); SBAR(); SLOAD_F((const float*)Vh, KBASE(1)); } }
    MASKT(pA0, pA1, 0); MWLOAD(2); partialSM(pA0, pA1, m_reg, mnA, alA);
    if (NT > 1) { VMW(); if constexpr (F32) { SWRITE_VF(1); SBAR(); if (NT > 2) SLOAD_F((const float*)Kh, KBASE(2)); } else SWRITE_H(1); }
    __syncthreads();
#define HALF_STEP(PX0, PX1, mnX, alX, PY0, PY1, alY, t, KB, VB, SB) do {                                                      \
        SBAR(); qkt<KB, SK>(PX0, PX1, K_lds, r32, hi, S.qr, ACT(t));                                             \
        finishSM(PY0, PY1, alY, l_reg, pa0, pa1, pa2, pa3); SBAR();                                                           \
        if ((t) + 1 < NT) { if constexpr (F32) { VMW(); SWRITE_KF(SB); SBAR(); SLOAD_F((const float*)Vh, KBASE((t) + 1)); }  \
                            else { SLOAD_H(Kh, Vh, KBASE((t) + 1)); } SBAR(); }                                               \
        pv_tile<VB, SK>(o, vb0, pa0, pa1, pa2, pa3, ACT((t) - 1)); MASKT(PX0, PX1, (t)); MWLOAD((t) + 2); partialSM(PX0, PX1, m_reg, mnX, alX);                                        \
        __syncthreads();                                                                                                      \
        if ((t) + 1 < NT) { VMW(); if constexpr (F32) { SWRITE_VF(SB); SBAR(); if ((t) + 2 < NT) SLOAD_F((const float*)Kh, KBASE((t) + 2)); } \
                            else { SWRITE_H(SB); } }                                                                          \
        RESC(alX); __syncthreads(); } while (0)
    for (int t = 1; t + 1 < NT; t += 2) {
        HALF_STEP(pB0, pB1, mnB, alB, pA0, pA1, alA, t, 1, 0, 0);
        HALF_STEP(pA0, pA1, mnA, alA, pB0, pB1, alB, t + 1, 0, 1, 1);
    }
    const bool even = (NT & 1) == 0;
    if (even) { SBAR(); qkt<1, SK>(pB0, pB1, K_lds, r32, hi, S.qr, ACT(NT - 1)); SBAR(); }
#define QROW(e) (nxt.Q + (size_t)(wid * QBLK + r32) * QST + ((e) >> 1) * 16 + hi * 8 + ((e) & 1) * 4)
    if constexpr (F32) { SLOAD_F((const float*)nxt.K, kbn); SBAR();
#pragma unroll
        for (int e = 0; e < 8; ++e) S.tq[e] = *(const f32x4*)QROW(e); }
    else { SLOAD_H(nxt.K, nxt.V, kbn); SBAR();
#pragma unroll
        for (int d0 = 0; d0 < 8; ++d0) S.qr[d0] = load8<TIn>(nxt.Q + (size_t)(wid * QBLK + r32) * QST + d0 * 16 + hi * 8); }
    SBAR();
    finishSM(pA0, pA1, alA, l_reg, pa0, pa1, pa2, pa3); SBAR();
    if constexpr (F32) {
#pragma unroll
        for (int e = 8; e < 16; ++e) S.tq[e] = *(const f32x4*)QROW(e); SBAR(); }
#undef QROW
    pv_tile<0, SK>(o, vb0, pa0, pa1, pa2, pa3, ACT(even ? NT - 2 : NT - 1));
    if (even) { MASKT(pB0, pB1, NT - 1); partialSM(pB0, pB1, m_reg, mnB, alB); __syncthreads(); RESC(alB);
        finishSM(pB0, pB1, alB, l_reg, pa0, pa1, pa2, pa3); SBAR(); pv_tile<1, SK>(o, vb0, pa0, pa1, pa2, pa3, ACT(NT - 1)); }
    SBAR(); SEAM_K0();
    if (hi == 0) li_l[r32] = l_reg; asm volatile("s_waitcnt lgkmcnt(0)" ::: "memory");
    float rli[16];
#pragma unroll
    for (int r = 0; r < 16; ++r) rli[r] = __builtin_amdgcn_rcpf(li_l[crow(r, hi)]);
    TOut* Ow = cur.O + (size_t)(wid * QBLK) * OST;
#pragma unroll
    for (int r = 0; r < 16; ++r) { const int orow = crow(r, hi);
#pragma unroll
        for (int d0 = 0; d0 < 4; ++d0) { const float v = o[d0][r] * rli[r];
            if constexpr (same_t<TOut, float>::v) { Ow[(size_t)orow * OST + d0 * 32 + r32] = v; }
            else { const float vn = __shfl_xor(v, 1);
                   if ((r32 & 1) == 0) *(unsigned*)(Ow + (size_t)orow * OST + d0 * 32 + r32) = cvtpk(v, vn); } } }
    if constexpr (F32) {
#pragma unroll
        for (int d0 = 0; d0 < 8; ++d0) S.qr[d0] = pack8(S.tq[2 * d0], S.tq[2 * d0 + 1]); }
    __syncthreads();
#undef RESC
#undef KBASE
#undef ACT
#undef MASKT
#undef MWLOAD
#undef SEAM_K0
#undef HALF_STEP
}
#undef ROW
#undef VMW
#undef VMWN
#undef SLOAD_H
#undef SWRITE_HK
#undef SWRITE_HV
#undef SWRITE_H
#undef SLOAD_F
#undef SWRITE_KF
#undef SWRITE_VF

}

constexpr int NWAVES = 8, NTHREADS = 512;
constexpr int DM = 2048, SEQ = 4096, NMETA = 16, TP = 4112, NBP = 2, SBN = 8, PAST = 16384, NPG = 128;
constexpr int XROW0 = 8192, SROW0 = 8224, NROWS = 8232, MPAD = 8448, FF = 8192, MAINM = 8192, XR = 48;
constexpr int NA_IN = 6144, NB_IN = 4176, NB_PAD = 4352, NC_IN = 12352, NC_PAD = 12544, DVW = 4096, CDIM = 8192;
constexpr float ALPHA = 1.6817928305074292f;
constexpr float LN_EPS = 1e-5f, RMS_EPS = 1e-6f;
constexpr int SCW = 4160, SCSW = 16448, KIROWS = 4128, NSKEY = PAST + 1;
constexpr int POS_SAMPLE_IDX = TP;

constexpr size_t O_YP = 0, O_YS = O_YP + (size_t)NBP * SEQ * DM, O_CAP = O_YS + (size_t)SBN * DM, O_CAS = O_CAP + 2 * NBP * 2 * DM,
                 O_KP = O_CAS + 2 * SBN * 2 * DM, O_VP = O_KP + (size_t)NBP * TP * 512, O_IKP = O_VP + (size_t)NBP * TP * 512,
                 O_KS = O_IKP + (size_t)NBP * TP * 64, O_VS = O_KS + SBN * 512, O_IKS = O_VS + SBN * 512, O_CCP = O_IKS + SBN * 64,
                 O_CCS = O_CCP + (size_t)NBP * 3 * CDIM, O_DP = O_CCS + (size_t)SBN * 3 * CDIM, O_DS = O_DP + (size_t)NBP * 32 * 128 * 128,
                 O_END = O_DS + (size_t)SBN * 32 * 128 * 128;

constexpr size_t MiB = 1u << 20;
constexpr size_t WS_CTL = 0, CTL_ZERO_BYTES = 1 * MiB;
constexpr size_t WS_TAB128 = 1 * MiB, WS_TAB64 = 4 * MiB, WS_WI = 6 * MiB, WS_G = 7 * MiB, WS_BETA = 9 * MiB, WS_CNT = 11 * MiB, WS_KIB = 12 * MiB,
                 WS_SCS = 14 * MiB, WS_IDXL = 16 * MiB, WS_X = 26 * MiB, WS_QR = 60 * MiB, WS_QI = 94 * MiB, WS_Z = 112 * MiB, WS_Y = 180 * MiB,
                 WS_BIG = 248 * MiB, WS_QKVC = 452 * MiB, WS_SC = 584 * MiB, WS_W = 716 * MiB;
constexpr size_t WSZ_A_IN = (size_t)NA_IN * DM * 2, WSZ_A_OUT = (size_t)DM * DM * 2, WSZ_B_IN = (size_t)NB_PAD * DM * 2, WSZ_B_OUT = (size_t)DM * DM * 2,
                 WSZ_C_IN = (size_t)NC_PAD * DM * 2, WSZ_C_OUT = (size_t)DM * DVW * 2, WSZ_W1 = (size_t)FF * DM * 2, WSZ_W2 = (size_t)DM * FF * 2;
constexpr size_t WS_WA_IN = WS_W, WS_WA_OUT = WS_WA_IN + 2 * WSZ_A_IN, WS_WB_IN = WS_WA_OUT + 2 * WSZ_A_OUT, WS_WB_OUT = WS_WB_IN + WSZ_B_IN,
                 WS_WC_IN = WS_WB_OUT + WSZ_B_OUT, WS_WC_OUT = WS_WC_IN + WSZ_C_IN, WS_W1 = WS_WC_OUT + WSZ_C_OUT, WS_W2 = WS_W1 + 4 * WSZ_W1,
                 WS_ZP = WS_W2 + 4 * WSZ_W2, WS_QKF = WS_ZP + 4 * MiB, WS_DWG = WS_QKF + 130 * MiB, WS_DUG = WS_DWG + 66 * MiB, WS_END = WS_DUG + 66 * MiB;
constexpr size_t WS_MASK = WS_IDXL, WS_KS = WS_Z, WS_VS = WS_Z + 9 * MiB;
constexpr size_t WS_DAF = WS_Z, WS_DTG = WS_Y, WS_DTB = WS_Y + 33 * MiB, WS_DPG = WS_QR, WS_DKT = WS_QKF, WS_DVT = WS_QKF + 33 * MiB, WS_DGC = WS_QI, WS_DBT = WS_QI + 2 * MiB;
constexpr int SP = 4352, SPAD = 240, MTW = 68;
constexpr int CW_BAR = 4096;

constexpr int RING_BYTES = 131072, LDSCTL_OFF = RING_BYTES, MISC_OFF = LDSCTL_OFF + 320, LDS_BYTES = 147456;

typedef unsigned short bf16;
typedef unsigned v4u __attribute__((ext_vector_type(4)));
typedef unsigned v2u __attribute__((ext_vector_type(2)));
typedef float f32x4 __attribute__((ext_vector_type(4)));
typedef float f32x2 __attribute__((ext_vector_type(2)));
typedef short bf16x8 __attribute__((ext_vector_type(8)));
typedef float f32x16 __attribute__((ext_vector_type(16)));
typedef __bf16 bf16x2_t __attribute__((ext_vector_type(2)));

#define LDS_WAIT() asm volatile("s_waitcnt lgkmcnt(0)" ::: "memory")
#define WAVE_SYNC() do { asm volatile("s_waitcnt lgkmcnt(0)" ::: "memory"); __builtin_amdgcn_wave_barrier(); } while (0)

__device__ __forceinline__ float bflo(unsigned w) { return __uint_as_float(w << 16); }
__device__ __forceinline__ float bfhi(unsigned w) { return __uint_as_float(w & 0xffff0000u); }
__device__ __forceinline__ float bf2f(bf16 h) { return __uint_as_float((unsigned)h << 16); }
__device__ __forceinline__ unsigned pk2(float lo, float hi) { f32x2 v = {lo, hi}; bf16x2_t b = __builtin_convertvector(v, bf16x2_t); return __builtin_bit_cast(unsigned, b); }
__device__ __forceinline__ bf16 f2bf(float f) { return (bf16)(pk2(f, 0.f) & 0xffffu); }
__device__ __forceinline__ float wave_sum(float v) {
#pragma unroll
    for (int o = 1; o < 64; o <<= 1) v += __shfl_xor(v, o);
    return v;
}
__device__ __forceinline__ float wave_max(float v) {
#pragma unroll
    for (int o = 1; o < 64; o <<= 1) v = fmaxf(v, __shfl_xor(v, o));
    return v;
}
__device__ __forceinline__ int wave_sum_i(int v) {
#pragma unroll
    for (int o = 1; o < 64; o <<= 1) v += __shfl_xor(v, o);
    return v;
}
__device__ __forceinline__ float wave_sum_dpp(float v) {
    v += __int_as_float(__builtin_amdgcn_update_dpp(0, __float_as_int(v), 0x128, 0xf, 0xf, false));
    v += __int_as_float(__builtin_amdgcn_update_dpp(0, __float_as_int(v), 0x124, 0xf, 0xf, false));
    v += __int_as_float(__builtin_amdgcn_update_dpp(0, __float_as_int(v), 0x122, 0xf, 0xf, false));
    v += __int_as_float(__builtin_amdgcn_update_dpp(0, __float_as_int(v), 0x121, 0xf, 0xf, false));
    const int iv = __float_as_int(v);
    return (__int_as_float(__builtin_amdgcn_readlane(iv, 0)) + __int_as_float(__builtin_amdgcn_readlane(iv, 16))) + (__int_as_float(__builtin_amdgcn_readlane(iv, 32)) + __int_as_float(__builtin_amdgcn_readlane(iv, 48)));
}
__device__ __forceinline__ int wave_sum_dpp_i(int v) {
    v += __builtin_amdgcn_update_dpp(0, v, 0x128, 0xf, 0xf, false);
    v += __builtin_amdgcn_update_dpp(0, v, 0x124, 0xf, 0xf, false);
    v += __builtin_amdgcn_update_dpp(0, v, 0x122, 0xf, 0xf, false);
    v += __builtin_amdgcn_update_dpp(0, v, 0x121, 0xf, 0xf, false);
    return __builtin_amdgcn_readlane(v, 0) + __builtin_amdgcn_readlane(v, 16) + __builtin_amdgcn_readlane(v, 32) + __builtin_amdgcn_readlane(v, 48);
}
__device__ __forceinline__ float row16_sum(float v) {
    v += __int_as_float(__builtin_amdgcn_update_dpp(0, __float_as_int(v), 0x128, 0xf, 0xf, false));
    v += __int_as_float(__builtin_amdgcn_update_dpp(0, __float_as_int(v), 0x124, 0xf, 0xf, false));
    v += __int_as_float(__builtin_amdgcn_update_dpp(0, __float_as_int(v), 0x122, 0xf, 0xf, false));
    v += __int_as_float(__builtin_amdgcn_update_dpp(0, __float_as_int(v), 0x121, 0xf, 0xf, false));
    return v;
}
__device__ __forceinline__ float silu_f(float x) { return x / (1.f + __expf(-x)); }
__device__ __forceinline__ int prow(int b, int t) { return t >= NMETA ? b * SEQ + (t - NMETA) : XROW0 + b * NMETA + t; }
__device__ __forceinline__ void row_bt(int r, int& b, int& t) { if (r < XROW0) { b = r >> 12; t = (r & 4095) + NMETA; } else { b = (r - XROW0) >> 4; t = (r - XROW0) & 15; } }
__device__ __forceinline__ void unpack8(const v4u w, float (&f)[8]) {
    f[0] = bflo(w.x); f[1] = bfhi(w.x); f[2] = bflo(w.y); f[3] = bfhi(w.y); f[4] = bflo(w.z); f[5] = bfhi(w.z); f[6] = bflo(w.w); f[7] = bfhi(w.w);
}
__device__ __forceinline__ v4u pack8(const float (&f)[8]) { v4u w; w.x = pk2(f[0], f[1]); w.y = pk2(f[2], f[3]); w.z = pk2(f[4], f[5]); w.w = pk2(f[6], f[7]); return w; }

__device__ __forceinline__ void transpose_item(const float* W, int K, int N, int Npad, bf16* WT, LAS float* scr, int item, int lane) {
    const int nblk = Npad / 32, kb = item / nblk, nb = item % nblk, k0 = 64 * kb, n0 = 32 * nb;
    const int n = n0 + (lane & 31); const bool ok = n < N;
    float wv_[32];
#pragma unroll
    for (int i = 0; i < 32; ++i) { const int kk = 2 * i + (lane >> 5); wv_[i] = W[(size_t)(k0 + kk) * N + (ok ? n : N - 1)]; }
#pragma unroll
    for (int i = 0; i < 32; ++i) { const int kk = 2 * i + (lane >> 5); scr[kk * 33 + (lane & 31)] = ok ? wv_[i] : 0.f; }
    LDS_WAIT(); __builtin_amdgcn_wave_barrier();
    const int c = lane & 7;
#pragma unroll
    for (int j = 0; j < 4; ++j) { const int nn = (lane >> 3) + 8 * j; const LAS float* s = scr + (8 * c) * 33 + nn;
        v4u o; o.x = pk2(s[0 * 33], s[1 * 33]); o.y = pk2(s[2 * 33], s[3 * 33]); o.z = pk2(s[4 * 33], s[5 * 33]); o.w = pk2(s[6 * 33], s[7 * 33]);
        *(v4u*)(WT + (size_t)(n0 + nn) * K + k0 + 8 * c) = o; }
    LDS_WAIT(); __builtin_amdgcn_wave_barrier();
}

struct Ptrs {
    const float *x_prompt, *x_sample, *state_conv_a, *cache_k, *cache_v, *cache_ik, *state_conv_c, *state_delta;
    const int* page_table;
    const float *meta, *w_in_a, *conv_w_a, *w_out_a, *w_in_b, *w_out_b, *w_in_c, *conv_w_c, *a_log, *dt_bias, *norm_w, *w_out_c, *ln1_g, *ln1_b, *w1, *w2, *ln2_g, *ln2_b;
    float* out; unsigned char* ws;
};

__device__ __forceinline__ void p0_prologue(const Ptrs& P, LAS unsigned char* lds, int gw, int NGW, int wave, int lane) {
    LAS float* scr = (LAS float*)(lds + wave * 16384);
    unsigned char* ws = P.ws;
    constexpr int I_A_IN = (DM / 64) * (NA_IN / 32), I_A_OUT = (DM / 64) * (DM / 32), I_B_IN = (DM / 64) * (NB_PAD / 32), I_B_OUT = I_A_OUT,
                  I_C_IN = (DM / 64) * (NC_PAD / 32), I_C_OUT = (DVW / 64) * (DM / 32), I_W1 = (DM / 64) * (FF / 32), I_W2 = (FF / 64) * (DM / 32);
    constexpr int NITEMS = 2 * I_A_IN + 2 * I_A_OUT + I_B_IN + I_B_OUT + I_C_IN + I_C_OUT + 4 * I_W1 + 4 * I_W2;
#define TR_(cnt, Wp, Kk, Nn, Np, WTp) if (r < (cnt)) { transpose_item((Wp), (Kk), (Nn), (Np), (bf16*)(WTp), scr, r, lane); continue; } r -= (cnt);
    for (int it = gw; it < NITEMS; it += NGW) {
        int r = it;
        TR_(I_A_IN, P.w_in_a, DM, NA_IN, NA_IN, ws + WS_WA_IN)
        TR_(I_A_IN, P.w_in_a + (size_t)DM * NA_IN, DM, NA_IN, NA_IN, ws + WS_WA_IN + WSZ_A_IN)
        TR_(I_A_OUT, P.w_out_a, DM, DM, DM, ws + WS_WA_OUT)
        TR_(I_A_OUT, P.w_out_a + (size_t)DM * DM, DM, DM, DM, ws + WS_WA_OUT + WSZ_A_OUT)
        TR_(I_B_IN, P.w_in_b, DM, NB_IN, NB_PAD, ws + WS_WB_IN)
        TR_(I_B_OUT, P.w_out_b, DM, DM, DM, ws + WS_WB_OUT)
        TR_(I_C_IN, P.w_in_c, DM, NC_IN, NC_PAD, ws + WS_WC_IN)
        TR_(I_C_OUT, P.w_out_c, DVW, DM, DM, ws + WS_WC_OUT)
        TR_(I_W1, P.w1, DM, FF, FF, ws + WS_W1)
        TR_(I_W1, P.w1 + (size_t)DM * FF, DM, FF, FF, ws + WS_W1 + WSZ_W1)
        TR_(I_W1, P.w1 + 2 * (size_t)DM * FF, DM, FF, FF, ws + WS_W1 + 2 * WSZ_W1)
        TR_(I_W1, P.w1 + 3 * (size_t)DM * FF, DM, FF, FF, ws + WS_W1 + 3 * WSZ_W1)
        TR_(I_W2, P.w2, FF, DM, DM, ws + WS_W2)
        TR_(I_W2, P.w2 + (size_t)DM * FF, FF, DM, DM, ws + WS_W2 + WSZ_W2)
        TR_(I_W2, P.w2 + 2 * (size_t)DM * FF, FF, DM, DM, ws + WS_W2 + 2 * WSZ_W2)
        transpose_item(P.w2 + 3 * (size_t)DM * FF, FF, DM, DM, (bf16*)(ws + WS_W2 + 3 * WSZ_W2), scr, r, lane);
    }
#undef TR_
    bf16* X = (bf16*)(ws + WS_X);
    for (int r = gw; r < MPAD; r += NGW) {
        const float* src = nullptr;
        if (r < XROW0) src = P.x_prompt + (size_t)r * DM;
        else if (r < SROW0) src = P.meta + (size_t)((r - XROW0) & 15) * DM;
        else if (r < NROWS) src = P.x_sample + (size_t)(r - SROW0) * DM;
#pragma unroll
        for (int j = 0; j < 4; ++j) { const int c = 512 * j + 8 * lane; v4u o = {0u, 0u, 0u, 0u};
            if (src) { const f32x4 a = *(const f32x4*)(src + c), b = *(const f32x4*)(src + c + 4); o.x = pk2(a.x, a.y); o.y = pk2(a.z, a.w); o.z = pk2(b.x, b.y); o.w = pk2(b.z, b.w); }
            *(v4u*)(X + (size_t)r * DM + c) = o; }
    }
    f32x2* t128 = (f32x2*)(ws + WS_TAB128); f32x2* t64 = (f32x2*)(ws + WS_TAB64);
    const int gt = gw * 64 + lane, NGT = NGW * 64;
    for (int e = gt; e < (TP + 1) * 96; e += NGT) {
        const int pi = e / 96, i = e % 96; const float pos = (float)(pi == TP ? PAST : pi);
        const float ex = (i < 64) ? (float)(2 * i) * (1.f / 128.f) : (float)(2 * (i - 64)) * (1.f / 64.f);
        const float inv = __builtin_amdgcn_exp2f(-ex * 13.287712379549449f);
        const float angf = pos * inv;
        double rev = (double)angf * 0.15915494309189535; rev -= __builtin_rint(rev);
        const float rf = (float)rev; const float sn = __builtin_amdgcn_sinf(rf), cs = __builtin_amdgcn_cosf(rf);
        if (i < 64) t128[pi * 64 + i] = (f32x2){cs, sn}; else t64[pi * 32 + (i - 64)] = (f32x2){cs, sn};
    }
}

__device__ __forceinline__ void ln_phase(const float* Z, const float* ZP, bf16* X, bf16* Xo, const float* gam, const float* bet, float* yp, float* ys, int gw, int NGW, int lane) {
    for (int r = gw; r < NROWS; r += NGW) {
        const bool ext = r >= XROW0; bf16* xr = X + (size_t)r * DM;
        f32x4 gq[8], bq_[8];
#pragma unroll
        for (int j = 0; j < 4; ++j) { const int c = 512 * j + 8 * lane; gq[2 * j] = *(const f32x4*)(gam + c); gq[2 * j + 1] = *(const f32x4*)(gam + c + 4); bq_[2 * j] = *(const f32x4*)(bet + c); bq_[2 * j + 1] = *(const f32x4*)(bet + c + 4); }
        float v[32]; float s = 0.f;
#pragma unroll
        for (int j = 0; j < 4; ++j) { const int c = 512 * j + 8 * lane; const v4u xv = *(const v4u*)(xr + c);
            float xf[8]; unpack8(xv, xf);
            if (ext) {
                const float* zr = ZP + (size_t)(r - XROW0) * DM; f32x4 z0 = *(const f32x4*)(zr + c), z1 = *(const f32x4*)(zr + c + 4);
#pragma unroll
                for (int sl = 1; sl < 8; ++sl) { z0 += *(const f32x4*)(zr + (size_t)sl * XR * DM + c); z1 += *(const f32x4*)(zr + (size_t)sl * XR * DM + c + 4); }
                xf[0] = ALPHA * xf[0] + z0.x; xf[1] = ALPHA * xf[1] + z0.y; xf[2] = ALPHA * xf[2] + z0.z; xf[3] = ALPHA * xf[3] + z0.w;
                xf[4] = ALPHA * xf[4] + z1.x; xf[5] = ALPHA * xf[5] + z1.y; xf[6] = ALPHA * xf[6] + z1.z; xf[7] = ALPHA * xf[7] + z1.w;
            }
#pragma unroll
            for (int i = 0; i < 8; ++i) { v[8 * j + i] = xf[i]; s += xf[i]; } }
        const float mean = wave_sum_dpp(s) * (1.f / DM); float s2 = 0.f;
#pragma unroll
        for (int i = 0; i < 32; ++i) { v[i] -= mean; s2 += v[i] * v[i]; }
        const float rstd = 1.f / sqrtf(wave_sum_dpp(s2) * (1.f / DM) + LN_EPS);
        float* of = nullptr;
        if (yp) { if (r < XROW0) of = yp + (size_t)r * DM; else if (r >= SROW0) of = ys + (size_t)(r - SROW0) * DM; }
#pragma unroll
        for (int j = 0; j < 4; ++j) { const int c = 512 * j + 8 * lane; const f32x4 g0 = gq[2 * j], g1 = gq[2 * j + 1], b0 = bq_[2 * j], b1 = bq_[2 * j + 1];
            float o[8];
            o[0] = v[8 * j + 0] * rstd * g0.x + b0.x; o[1] = v[8 * j + 1] * rstd * g0.y + b0.y; o[2] = v[8 * j + 2] * rstd * g0.z + b0.z; o[3] = v[8 * j + 3] * rstd * g0.w + b0.w;
            o[4] = v[8 * j + 4] * rstd * g1.x + b1.x; o[5] = v[8 * j + 5] * rstd * g1.y + b1.y; o[6] = v[8 * j + 6] * rstd * g1.z + b1.z; o[7] = v[8 * j + 7] * rstd * g1.w + b1.w;
            *(v4u*)(Xo + (size_t)r * DM + c) = pack8(o);
            if (of) { *(f32x4*)(of + c) = (f32x4){o[0], o[1], o[2], o[3]}; *(f32x4*)(of + c + 4) = (f32x4){o[4], o[5], o[6], o[7]}; } }
    }
}

__device__ __forceinline__ void load_u(const bf16* BCH, int row, int c0, float (&u)[8]) {
    const v4u cg = *(const v4u*)(BCH + (size_t)row * NA_IN + DM + c0), hh = *(const v4u*)(BCH + (size_t)row * NA_IN + 2 * DM + c0);
    float a[8], b[8]; unpack8(cg, a); unpack8(hh, b);
#pragma unroll
    for (int i = 0; i < 8; ++i) u[i] = a[i] * b[i];
}
__device__ __forceinline__ void convA_phase(const bf16* BCH, bf16* Y, const float* cw, const float* hist, float* outp, float* outs, int gtid, int NT) {
    constexpr int RUN = 8, NRUN = TP / RUN;
    for (int it = gtid; it < (NBP * NRUN + SBN) * 256; it += NT) {
        const int c0 = (it & 255) * 8, ru = it >> 8;
        float w0[8], w1[8], w2[8];
        { const f32x4 a = *(const f32x4*)(cw + c0), b = *(const f32x4*)(cw + c0 + 4); w0[0] = a.x; w0[1] = a.y; w0[2] = a.z; w0[3] = a.w; w0[4] = b.x; w0[5] = b.y; w0[6] = b.z; w0[7] = b.w; }
        { const f32x4 a = *(const f32x4*)(cw + DM + c0), b = *(const f32x4*)(cw + DM + c0 + 4); w1[0] = a.x; w1[1] = a.y; w1[2] = a.z; w1[3] = a.w; w1[4] = b.x; w1[5] = b.y; w1[6] = b.z; w1[7] = b.w; }
        { const f32x4 a = *(const f32x4*)(cw + 2 * DM + c0), b = *(const f32x4*)(cw + 2 * DM + c0 + 4); w2[0] = a.x; w2[1] = a.y; w2[2] = a.z; w2[3] = a.w; w2[4] = b.x; w2[5] = b.y; w2[6] = b.z; w2[7] = b.w; }
        float u0[8], u1[8], u2[8];
        if (ru < NBP * NRUN) {
            const int b = ru / NRUN, t0 = (ru % NRUN) * RUN;
            if (t0 >= 1) load_u(BCH, prow(b, t0 - 1), c0, u1); else {
#pragma unroll
                for (int i = 0; i < 8; ++i) u1[i] = 0.f; }
            if (t0 >= 2) load_u(BCH, prow(b, t0 - 2), c0, u0); else {
#pragma unroll
                for (int i = 0; i < 8; ++i) u0[i] = 0.f; }
            const int r0 = prow(b, t0);
            v4u bq[RUN], cq[RUN], hq_[RUN];
#pragma unroll
            for (int k = 0; k < RUN; ++k) { const bf16* rp = BCH + (size_t)(r0 + k) * NA_IN + c0; bq[k] = *(const v4u*)rp; cq[k] = *(const v4u*)(rp + DM); hq_[k] = *(const v4u*)(rp + 2 * DM); }
#pragma unroll
            for (int k = 0; k < RUN; ++k) {
                const int r = r0 + k, t = t0 + k;
                { float ca[8], ha[8]; unpack8(cq[k], ca); unpack8(hq_[k], ha);
#pragma unroll
                  for (int i = 0; i < 8; ++i) u2[i] = ca[i] * ha[i]; }
                float bg[8]; unpack8(bq[k], bg);
                float y[8];
#pragma unroll
                for (int i = 0; i < 8; ++i) y[i] = bg[i] * (w0[i] * u0[i] + w1[i] * u1[i] + w2[i] * u2[i]);
                *(v4u*)(Y + (size_t)r * DM + c0) = pack8(y);
                if (t >= TP - 2) { float* o = outp + ((size_t)(b * 2 + (t - (TP - 2)))) * DM + c0; *(f32x4*)o = (f32x4){u2[0], u2[1], u2[2], u2[3]}; *(f32x4*)(o + 4) = (f32x4){u2[4], u2[5], u2[6], u2[7]}; }
#pragma unroll
                for (int i = 0; i < 8; ++i) { u0[i] = u1[i]; u1[i] = u2[i]; }
            }
        } else {
            const int sb = ru - NBP * NRUN, r = SROW0 + sb;
            load_u(BCH, r, c0, u2);
            const float* h0 = hist + ((size_t)(sb * 2 + 0)) * DM + c0; const float* h1 = hist + ((size_t)(sb * 2 + 1)) * DM + c0;
            const f32x4 a0 = *(const f32x4*)h0, a1 = *(const f32x4*)(h0 + 4), b0 = *(const f32x4*)h1, b1 = *(const f32x4*)(h1 + 4);
            u0[0] = a0.x; u0[1] = a0.y; u0[2] = a0.z; u0[3] = a0.w; u0[4] = a1.x; u0[5] = a1.y; u0[6] = a1.z; u0[7] = a1.w;
            u1[0] = b0.x; u1[1] = b0.y; u1[2] = b0.z; u1[3] = b0.w; u1[4] = b1.x; u1[5] = b1.y; u1[6] = b1.z; u1[7] = b1.w;
            float* o0 = outs + ((size_t)(sb * 2 + 0)) * DM + c0; float* o1 = outs + ((size_t)(sb * 2 + 1)) * DM + c0;
            *(f32x4*)o0 = b0; *(f32x4*)(o0 + 4) = b1;
            *(f32x4*)o1 = (f32x4){u2[0], u2[1], u2[2], u2[3]}; *(f32x4*)(o1 + 4) = (f32x4){u2[4], u2[5], u2[6], u2[7]};
            float bg[8]; unpack8(*(const v4u*)(BCH + (size_t)r * NA_IN + c0), bg);
            float y[8];
#pragma unroll
            for (int i = 0; i < 8; ++i) y[i] = bg[i] * (w0[i] * u0[i] + w1[i] * u1[i] + w2[i] * u2[i]);
            *(v4u*)(Y + (size_t)r * DM + c0) = pack8(y);
        }
    }
}

constexpr float QSCALE = 0.08838834764831845f;
__device__ __forceinline__ void rope_phase(const bf16* PROJ, const Ptrs& P, int gw, int NGW, int lane) {
    unsigned char* ws = P.ws;
    const f32x2* t128 = (const f32x2*)(ws + WS_TAB128); const f32x2* t64 = (const f32x2*)(ws + WS_TAB64);
    bf16* Qr = (bf16*)(ws + WS_QR); bf16* QI = (bf16*)(ws + WS_QI); bf16* KIb = (bf16*)(ws + WS_KIB); float* WI = (float*)(ws + WS_WI);
    bf16* Ks = (bf16*)(ws + WS_KS); bf16* Vs = (bf16*)(ws + WS_VS);
    for (int pr_ = gw; pr_ < NBP * SPAD; pr_ += NGW) {
        const size_t o = ((size_t)((pr_ / SPAD) * SP + (pr_ % SPAD))) * 512 + 8 * lane; *(v4u*)(Ks + o) = (v4u){0u, 0u, 0u, 0u}; *(v4u*)(Vs + o) = (v4u){0u, 0u, 0u, 0u}; }
    for (int r = gw; r < NROWS; r += NGW) {
        const bf16* pr = PROJ + (size_t)r * NB_PAD;
        int pi; float *ko, *vo, *iko; bf16* kib = nullptr; bf16 *ksq = nullptr, *vsq = nullptr;
        if (r < SROW0) { int b, t; row_bt(r, b, t); pi = t; ksq = Ks + ((size_t)(b * SP + t + SPAD)) * 512; vsq = Vs + ((size_t)(b * SP + t + SPAD)) * 512; ko = P.out + O_KP + ((size_t)(b * TP + t)) * 512; vo = P.out + O_VP + ((size_t)(b * TP + t)) * 512; iko = P.out + O_IKP + ((size_t)(b * TP + t)) * 64; kib = KIb + ((size_t)(b * KIROWS + t)) * 64; }
        else { const int sb = r - SROW0; pi = POS_SAMPLE_IDX; ko = P.out + O_KS + (size_t)sb * 512; vo = P.out + O_VS + (size_t)sb * 512; iko = P.out + O_IKS + (size_t)sb * 64; }
        const f32x2* c128 = t128 + (size_t)pi * 64; const f32x2* c64 = t64 + (size_t)pi * 32;
        const int hd = lane >> 2, sub = lane & 3;
        {
            float x1[16], x2[16], o1[16], o2[16];
            { float t8[8]; unpack8(*(const v4u*)(pr + hd * 128 + 16 * sub), t8);
#pragma unroll
              for (int i = 0; i < 8; ++i) x1[i] = t8[i]; unpack8(*(const v4u*)(pr + hd * 128 + 16 * sub + 8), t8);
#pragma unroll
              for (int i = 0; i < 8; ++i) x1[8 + i] = t8[i]; unpack8(*(const v4u*)(pr + hd * 128 + 64 + 16 * sub), t8);
#pragma unroll
              for (int i = 0; i < 8; ++i) x2[i] = t8[i]; unpack8(*(const v4u*)(pr + hd * 128 + 64 + 16 * sub + 8), t8);
#pragma unroll
              for (int i = 0; i < 8; ++i) x2[8 + i] = t8[i]; }
#pragma unroll
            for (int i = 0; i < 16; i += 2) { const f32x4 cs = *(const f32x4*)(c128 + 16 * sub + i);
                o1[i] = (x1[i] * cs.x - x2[i] * cs.y) * QSCALE; o2[i] = (x2[i] * cs.x + x1[i] * cs.y) * QSCALE;
                o1[i + 1] = (x1[i + 1] * cs.z - x2[i + 1] * cs.w) * QSCALE; o2[i + 1] = (x2[i + 1] * cs.z + x1[i + 1] * cs.w) * QSCALE; }
            bf16* qo = Qr + (size_t)r * DM + hd * 128 + 16 * sub;
            { float t8[8];
#pragma unroll
              for (int i = 0; i < 8; ++i) t8[i] = o1[i]; *(v4u*)qo = pack8(t8);
#pragma unroll
              for (int i = 0; i < 8; ++i) t8[i] = o1[8 + i]; *(v4u*)(qo + 8) = pack8(t8);
#pragma unroll
              for (int i = 0; i < 8; ++i) t8[i] = o2[i]; *(v4u*)(qo + 64) = pack8(t8);
#pragma unroll
              for (int i = 0; i < 8; ++i) t8[i] = o2[8 + i]; *(v4u*)(qo + 72) = pack8(t8); }
        }
        if (lane < 16) {
            const bf16* kp = pr + 2048 + hd * 128 + 16 * sub;
#pragma unroll
            for (int hf = 0; hf < 2; ++hf) { float x1[8], x2[8], o1[8], o2[8]; unpack8(*(const v4u*)(kp + 8 * hf), x1); unpack8(*(const v4u*)(kp + 64 + 8 * hf), x2);
#pragma unroll
                for (int i = 0; i < 8; i += 2) { const f32x4 cs = *(const f32x4*)(c128 + 16 * sub + 8 * hf + i);
                    o1[i] = x1[i] * cs.x - x2[i] * cs.y; o2[i] = x2[i] * cs.x + x1[i] * cs.y; o1[i + 1] = x1[i + 1] * cs.z - x2[i + 1] * cs.w; o2[i + 1] = x2[i + 1] * cs.z + x1[i + 1] * cs.w; }
                float* kq = ko + hd * 128 + 16 * sub + 8 * hf;
                *(f32x4*)kq = (f32x4){o1[0], o1[1], o1[2], o1[3]}; *(f32x4*)(kq + 4) = (f32x4){o1[4], o1[5], o1[6], o1[7]};
                *(f32x4*)(kq + 64) = (f32x4){o2[0], o2[1], o2[2], o2[3]}; *(f32x4*)(kq + 68) = (f32x4){o2[4], o2[5], o2[6], o2[7]};
                if (ksq) { *(v4u*)(ksq + hd * 128 + 16 * sub + 8 * hf) = pack8(o1); *(v4u*)(ksq + hd * 128 + 64 + 16 * sub + 8 * hf) = pack8(o2); } }
        }
        {
            const v4u vv = *(const v4u*)(pr + 2560 + 8 * lane); float vf[8]; unpack8(vv, vf);
            *(f32x4*)(vo + 8 * lane) = (f32x4){vf[0], vf[1], vf[2], vf[3]}; *(f32x4*)(vo + 8 * lane + 4) = (f32x4){vf[4], vf[5], vf[6], vf[7]};
            if (vsq) *(v4u*)(vsq + 8 * lane) = vv;
        }
        {
            float x1[8], x2[8], o1[8], o2[8]; unpack8(*(const v4u*)(pr + 3072 + hd * 64 + 8 * sub), x1); unpack8(*(const v4u*)(pr + 3072 + hd * 64 + 32 + 8 * sub), x2);
#pragma unroll
            for (int i = 0; i < 8; i += 2) { const f32x4 cs = *(const f32x4*)(c64 + 8 * sub + i);
                o1[i] = x1[i] * cs.x - x2[i] * cs.y; o2[i] = x2[i] * cs.x + x1[i] * cs.y; o1[i + 1] = x1[i + 1] * cs.z - x2[i + 1] * cs.w; o2[i + 1] = x2[i + 1] * cs.z + x1[i + 1] * cs.w; }
            *(v4u*)(QI + (size_t)r * 1024 + hd * 64 + 8 * sub) = pack8(o1); *(v4u*)(QI + (size_t)r * 1024 + hd * 64 + 32 + 8 * sub) = pack8(o2);
        }
        if (lane < 4) {
            float x1[8], x2[8], o1[8], o2[8]; unpack8(*(const v4u*)(pr + 4096 + 8 * sub), x1); unpack8(*(const v4u*)(pr + 4096 + 32 + 8 * sub), x2);
#pragma unroll
            for (int i = 0; i < 8; i += 2) { const f32x4 cs = *(const f32x4*)(c64 + 8 * sub + i);
                o1[i] = x1[i] * cs.x - x2[i] * cs.y; o2[i] = x2[i] * cs.x + x1[i] * cs.y; o1[i + 1] = x1[i + 1] * cs.z - x2[i + 1] * cs.w; o2[i + 1] = x2[i + 1] * cs.z + x1[i + 1] * cs.w; }
            float* io = iko + 8 * sub;
            *(f32x4*)io = (f32x4){o1[0], o1[1], o1[2], o1[3]}; *(f32x4*)(io + 4) = (f32x4){o1[4], o1[5], o1[6], o1[7]};
            *(f32x4*)(io + 32) = (f32x4){o2[0], o2[1], o2[2], o2[3]}; *(f32x4*)(io + 36) = (f32x4){o2[4], o2[5], o2[6], o2[7]};
            if (kib) { *(v4u*)(kib + 8 * sub) = pack8(o1); *(v4u*)(kib + 32 + 8 * sub) = pack8(o2); }
        } else if (lane < 6) {
            float wv[8]; unpack8(*(const v4u*)(pr + 4160 + 8 * (lane - 4)), wv); float* wo = WI + (size_t)r * 16 + 8 * (lane - 4);
            *(f32x4*)wo = (f32x4){wv[0], wv[1], wv[2], wv[3]}; *(f32x4*)(wo + 4) = (f32x4){wv[4], wv[5], wv[6], wv[7]};
        }
    }
}

__device__ __forceinline__ void indexer_prompt(const Ptrs& P, LAS unsigned char* lds, int tid, int wave, int lane) {
    unsigned char* ws = P.ws;
    const bf16* QI = (const bf16*)(ws + WS_QI); const bf16* KIb = (const bf16*)(ws + WS_KIB); const float* WI = (const float*)(ws + WS_WI); float* SC = (float*)(ws + WS_SC);
    const int n = lane & 31, h8 = lane >> 5;
    const int qsel = (n >> 2) & 1, head = (n & 3) + 4 * (n >> 3);
    constexpr int NG = TP / 16;
    constexpr int KROW = 144, TBUF = 128 * KROW;
    for (int it = blockIdx.x; it < 2 * NG; it += gridDim.x) {
        int b, qg;
        if (it < 256) { b = it & 1; qg = it >> 1; } else if (it < 512) { b = it & 1; qg = 256 - ((it - 256) >> 1); } else { b = it - 512; qg = 128; }
        const int t0 = 16 * qg + 2 * wave;
        const bf16* qa = QI + (size_t)prow(b, t0 + qsel) * 1024 + head * 64 + 8 * h8;
        bf16x8 a[4];
#pragma unroll
        for (int kk = 0; kk < 4; ++kk) a[kk] = *(const bf16x8*)(qa + 16 * kk);
        const int tq = t0 + h8;
        const float* wp = WI + (size_t)prow(b, tq) * 16;
        float w[16];
#pragma unroll
        for (int i = 0; i < 4; ++i) { const f32x4 x = *(const f32x4*)(wp + 4 * i); w[4 * i] = x.x; w[4 * i + 1] = x.y; w[4 * i + 2] = x.z; w[4 * i + 3] = x.w; }
        const int ntile = ((16 * qg + 15) >> 5) + 1, ntrip = (ntile + 3) >> 2;
        float* scrow = SC + ((size_t)(b * TP + tq)) * SCW;
        const bf16* kbase = KIb + (size_t)b * KIROWS * 64;
        const int p0 = tid, p1 = tid + 512;
        const int l0 = (p0 >> 3) * KROW + (p0 & 7) * 16, l1 = (p1 >> 3) * KROW + (p1 & 7) * 16;
        asm volatile("s_waitcnt lgkmcnt(0)\n\ts_barrier" ::: "memory");
        v4u g0 = *(const v4u*)(kbase + (size_t)p0 * 8), g1 = *(const v4u*)(kbase + (size_t)p1 * 8);
        *(LAS v4u*)(lds + l0) = g0; *(LAS v4u*)(lds + l1) = g1;
        for (int tr = 0; tr < ntrip; ++tr) {
            const int cur = tr & 1;
            if (tr + 1 < ntrip) { const size_t ko = (size_t)(tr + 1) * 128 * 64;
                const int kmax = KIROWS * 64 - 8;
                const size_t o0 = ko + (size_t)p0 * 8, o1 = ko + (size_t)p1 * 8;
                g0 = *(const v4u*)(kbase + (o0 <= (size_t)kmax ? o0 : (size_t)kmax)); g1 = *(const v4u*)(kbase + (o1 <= (size_t)kmax ? o1 : (size_t)kmax)); }
            asm volatile("s_waitcnt lgkmcnt(0)\n\ts_barrier" ::: "memory");
            const LAS unsigned char* kb = lds + cur * TBUF + n * KROW + h8 * 16;
#pragma unroll
            for (int u = 0; u < 4; ++u) {
                f32x16 acc;
#pragma unroll
                for (int i = 0; i < 16; ++i) acc[i] = 0.f;
#pragma unroll
                for (int kk = 0; kk < 4; ++kk) acc = __builtin_amdgcn_mfma_f32_32x32x16_bf16(a[kk], *(const LAS bf16x8*)(kb + u * 32 * KROW + kk * 32), acc, 0, 0, 0);
                float sc = 0.f;
#pragma unroll
                for (int i = 0; i < 16; ++i) sc += w[i] * fmaxf(acc[i], 0.f);
                const int s = 32 * (4 * tr + u) + n;
                if (s <= tq) scrow[s] = sc;
            }
            if (tr + 1 < ntrip) { *(LAS v4u*)(lds + (cur ^ 1) * TBUF + l0) = g0; *(LAS v4u*)(lds + (cur ^ 1) * TBUF + l1) = g1; }
        }
    }
    asm volatile("s_waitcnt lgkmcnt(0)\n\ts_barrier" ::: "memory");
}

__device__ __forceinline__ void indexer_sample(const Ptrs& P, LAS unsigned char* lds, int tid) {
    unsigned char* ws = P.ws;
    const bf16* QI = (const bf16*)(ws + WS_QI); const float* WI = (const float*)(ws + WS_WI); float* SCS = (float*)(ws + WS_SCS);
    LAS float* lq = (LAS float*)lds;
    LAS float* lw = lq + 1024;
    constexpr int NCH = (NSKEY + 511) / 512;
    for (int item = gridDim.x - 1 - blockIdx.x; item < SBN * NCH; item += gridDim.x) {
        const int sb = item / NCH, ch = item % NCH, r = SROW0 + sb;
        __syncthreads();
        for (int e = tid; e < 1024; e += NTHREADS) lq[e] = bf2f(QI[(size_t)r * 1024 + e]);
        if (tid < 16) lw[tid] = WI[(size_t)r * 16 + tid];
        __syncthreads();
        const int s = ch * 512 + tid;
        if (s < NSKEY) {
            const float* kr = (s < PAST) ? P.cache_ik + ((size_t)P.page_table[sb * NPG + (s >> 7)] * 128 + (s & 127)) * 64 : P.out + O_IKS + (size_t)sb * 64;
            f32x4 kv[16];
#pragma unroll
            for (int i = 0; i < 16; ++i) kv[i] = *(const f32x4*)(kr + 4 * i);
            float sc = 0.f;
            for (int h = 0; h < 16; ++h) { float d = 0.f;
#pragma unroll
                for (int i = 0; i < 16; ++i) { const f32x4 q = *(const LAS f32x4*)(lq + h * 64 + 4 * i); d += q.x * kv[i].x + q.y * kv[i].y + q.z * kv[i].z + q.w * kv[i].w; }
                sc += lw[h] * fmaxf(d, 0.f); }
            SCS[(size_t)sb * SCSW + s] = sc;
        }
    }
    __syncthreads();
}

__device__ __forceinline__ unsigned ordkey(float f) { const unsigned u = __float_as_uint(f); return (u & 0x80000000u) ? ~u : (u | 0x80000000u); }
constexpr int TOPK = 256;
__device__ __forceinline__ void topk_wave_mask(const float* sc, int n, unsigned long long* mrow, int lane) {
    constexpr int NS = MTW, M0 = SPAD / 64;
    static_assert(M0 == dattn::JLO, "first real key tile");
    unsigned key[NS];
#pragma unroll
    for (int m = M0; m < NS; ++m) { const int sidx = lane + 64 * m - SPAD; const int ci = sidx < 0 ? 0 : (sidx < n ? sidx : n - 1); const float v = sc[ci]; key[m] = (sidx >= 0 && sidx < n) ? ordkey(v) : 0u; }
    if (n <= TOPK) {
#pragma unroll
        for (int m = M0; m < NS; ++m) { const unsigned long long w = __ballot(key[m] != 0u); if (lane == 0) mrow[m] = w; }
        return;
    }
    unsigned T = 0u;
    for (int bit = 31; bit >= 0; --bit) {
        const unsigned cand = T | (1u << bit); int c = 0, cv = 0;
#pragma unroll
        for (int m = M0; m < NS; ++m) { if ((m & 1) != 0) c += __popcll(__ballot(key[m] >= cand)); else cv += (key[m] >= cand) ? 1 : 0; }
        c += wave_sum_dpp_i(cv);
        if (c >= TOPK) T = cand;
    }
    int cg = 0;
#pragma unroll
    for (int m = M0; m < NS; ++m) cg += __popcll(__ballot(key[m] > T));
    const int need = TOPK - cg;
    int base_e = 0;
    const unsigned long long lt = (1ull << lane) - 1ull;
#pragma unroll
    for (int m = M0; m < NS; ++m) {
        const bool pg = key[m] > T, pe = key[m] == T;
        const unsigned long long me = __ballot(pe);
        const int pre_e = __popcll(me & lt);
        const unsigned long long w = __ballot(pg || (pe && (base_e + pre_e) < need));
        if (lane == 0) mrow[m] = w;
        base_e += __popcll(me);
    }
}
__device__ __forceinline__ void topk_block(const float* sc, int n, int* outIdx, int* outCnt, LAS unsigned* ls, int tid, int wave, int lane) {
    constexpr int NS = (NSKEY + NTHREADS - 1) / NTHREADS;
    unsigned key[NS];
#pragma unroll
    for (int m = 0; m < NS; ++m) { const int e = tid + NTHREADS * m; const float v = sc[e < n ? e : n - 1]; key[m] = (e < n) ? ordkey(v) : 0u; }
    unsigned T = 0u;
    for (int bit = 31; bit >= 0; --bit) {
        const unsigned cand = T | (1u << bit); int c = 0;
#pragma unroll
        for (int m = 0; m < NS; ++m) c += (key[m] >= cand) ? 1 : 0;
        c = wave_sum_dpp_i(c);
        LAS unsigned* buf = ls + (bit & 1) * 8;
        if (lane == 0) buf[wave] = (unsigned)c;
        __syncthreads();
        int tot = 0;
#pragma unroll
        for (int w = 0; w < 8; ++w) tot += (int)buf[w];
        if (tot >= TOPK) T = cand;
    }
    __syncthreads();
    if (tid == 0) { unsigned z_ = 0u; asm volatile("" : "+v"(z_)); ls[16] = z_; ls[17] = z_; }
    __syncthreads();
#pragma unroll
    for (int m = 0; m < NS; ++m) { const int e = tid + NTHREADS * m; if (key[m] > T) { const unsigned pos = atomicAdd((unsigned*)(ls + 16), 1u); if (pos < (unsigned)TOPK) outIdx[pos] = e; } }
    __syncthreads();
    const unsigned cg = ls[16];
    const unsigned need = (unsigned)TOPK - cg;
#pragma unroll
    for (int m = 0; m < NS; ++m) { const int e = tid + NTHREADS * m; if (key[m] == T) { const unsigned pos = atomicAdd((unsigned*)(ls + 17), 1u); if (pos < need) outIdx[cg + pos] = e; } }
    if (tid == 0) *outCnt = TOPK;
    __syncthreads();
}
__device__ __forceinline__ void select_phase(const Ptrs& P, LAS unsigned char* lds, int gw, int NGW, int tid, int wave, int lane) {
    unsigned char* ws = P.ws;
    const float* SC = (const float*)(ws + WS_SC); const float* SCS = (const float*)(ws + WS_SCS); int* IDXL = (int*)(ws + WS_IDXL); int* CNT = (int*)(ws + WS_CNT);
    for (int sb = blockIdx.x; sb < SBN; sb += gridDim.x) topk_block(SCS + (size_t)sb * SCSW, NSKEY, IDXL + (size_t)(SROW0 + sb) * TOPK, CNT + SROW0 + sb, (LAS unsigned*)lds, tid, wave, lane);
    unsigned long long* MASK = (unsigned long long*)(ws + WS_MASK);
    for (int r = gw; r < SROW0; r += NGW) { int b, t; row_bt(r, b, t);
        if (r < XROW0) topk_wave_mask(SC + ((size_t)(b * TP + t)) * SCW, t + 1, MASK + ((size_t)(b * SP + t + SPAD)) * MTW, lane);
        else { if (lane <= t) IDXL[(size_t)r * TOPK + lane] = lane; if (lane == 0) CNT[r] = t + 1; } }
}

__device__ __forceinline__ void attn_phase(const Ptrs& P, bf16* O, LAS unsigned char* lds, int gw, int NGW, int wave, int lane) {
    unsigned char* ws = P.ws;
    const bf16* Qr = (const bf16*)(ws + WS_QR); const int* IDXL = (const int*)(ws + WS_IDXL); const int* CNT = (const int*)(ws + WS_CNT);
    LAS float* lq = (LAS float*)(lds + wave * 12288);
    LAS f32x4* lp = (LAS f32x4*)(lds + wave * 12288 + 2048);
    LAS unsigned long long* lkp = (LAS unsigned long long*)(lds + wave * 12288 + 6144);
    LAS unsigned long long* lvp = (LAS unsigned long long*)(lds + wave * 12288 + 8192);
    for (int item = gw; item < (NROWS - XROW0) * 4; item += NGW) {
        const int r = XROW0 + (item >> 2), n = item & 3;
        const int cnt = CNT[r];
        WAVE_SYNC();
        { float qf[8]; unpack8(*(const v4u*)(Qr + (size_t)r * DM + n * 512 + 8 * lane), qf);
          *(LAS f32x4*)(lq + 8 * lane) = (f32x4){qf[0], qf[1], qf[2], qf[3]}; *(LAS f32x4*)(lq + 8 * lane + 4) = (f32x4){qf[4], qf[5], qf[6], qf[7]}; }
        const float* kp[4];
#pragma unroll
        for (int j = 0; j < 4; ++j) {
            const int e = lane + 64 * j; const int s = (e < cnt) ? IDXL[(size_t)r * TOPK + e] : 0;
            const float *kq, *vq;
            if (r < SROW0) { const int b = (r < XROW0) ? (r >> 12) : ((r - XROW0) >> 4); kq = P.out + O_KP + ((size_t)(b * TP + s)) * 512; vq = P.out + O_VP + ((size_t)(b * TP + s)) * 512; }
            else { const int sb = r - SROW0;
                if (s < PAST) { const size_t off = ((size_t)P.page_table[sb * NPG + (s >> 7)] * 128 + (s & 127)) * 512; kq = P.cache_k + off; vq = P.cache_v + off; }
                else { kq = P.out + O_KS + (size_t)sb * 512; vq = P.out + O_VS + (size_t)sb * 512; } }
            kp[j] = kq + n * 128; lkp[e] = (unsigned long long)(kq + n * 128); lvp[e] = (unsigned long long)(vq + n * 128);
        }
        WAVE_SYNC();
        float acc[4][4];
#pragma unroll
        for (int g = 0; g < 4; ++g)
#pragma unroll
            for (int j = 0; j < 4; ++j) acc[g][j] = 0.f;
#pragma unroll 4
        for (int d4 = 0; d4 < 32; ++d4) {
            f32x4 qv[4];
#pragma unroll
            for (int g = 0; g < 4; ++g) qv[g] = *(const LAS f32x4*)(lq + g * 128 + 4 * d4);
#pragma unroll
            for (int j = 0; j < 4; ++j) { const f32x4 kv = *(const f32x4*)(kp[j] + 4 * d4);
#pragma unroll
                for (int g = 0; g < 4; ++g) acc[g][j] += qv[g].x * kv.x + qv[g].y * kv.y + qv[g].z * kv.z + qv[g].w * kv.w; }
        }
        float linv[4];
#pragma unroll
        for (int g = 0; g < 4; ++g) {
            float m = -INFINITY;
#pragma unroll
            for (int j = 0; j < 4; ++j) { if (lane + 64 * j >= cnt) acc[g][j] = -INFINITY; m = fmaxf(m, acc[g][j]); }
            m = wave_max(m); float l = 0.f;
#pragma unroll
            for (int j = 0; j < 4; ++j) { acc[g][j] = __expf(acc[g][j] - m); l += acc[g][j]; }
            linv[g] = 1.f / wave_sum(l);
        }
#pragma unroll
        for (int j = 0; j < 4; ++j) lp[lane + 64 * j] = (f32x4){acc[0][j], acc[1][j], acc[2][j], acc[3][j]};
        WAVE_SYNC();
        float o[4][2];
#pragma unroll
        for (int g = 0; g < 4; ++g) { o[g][0] = 0.f; o[g][1] = 0.f; }
#pragma unroll 8
        for (int e = 0; e < cnt; ++e) {
            const float* vp = (const float*)lvp[e]; const f32x2 vv = *(const f32x2*)(vp + 2 * lane); const f32x4 p = lp[e];
            o[0][0] += p.x * vv.x; o[0][1] += p.x * vv.y; o[1][0] += p.y * vv.x; o[1][1] += p.y * vv.y; o[2][0] += p.z * vv.x; o[2][1] += p.z * vv.y; o[3][0] += p.w * vv.x; o[3][1] += p.w * vv.y;
        }
#pragma unroll
        for (int g = 0; g < 4; ++g) *(unsigned*)(O + (size_t)r * DM + (4 * n + g) * 128 + 2 * lane) = pk2(o[g][0] * linv[g], o[g][1] * linv[g]);
    }
}

__device__ __forceinline__ void convC_finish(float (&acc)[8], int it) {
    float ss = 0.f;
#pragma unroll
    for (int i = 0; i < 8; ++i) { acc[i] = silu_f(acc[i]); ss += acc[i] * acc[i]; }
    if (it < 8) { ss = row16_sum(ss); float rn = 1.f / sqrtf(ss + RMS_EPS); if (it < 4) rn *= QSCALE;
#pragma unroll
        for (int i = 0; i < 8; ++i) acc[i] *= rn; }
}
__device__ __forceinline__ void convC_phase(const bf16* PROJC, const Ptrs& P, int gw, int NGW, int lane) {
    unsigned char* ws = P.ws;
    bf16* QKVC = (bf16*)(ws + WS_QKVC); float* QKF = (float*)(ws + WS_QKF); float* G = (float*)(ws + WS_G); float* BETA = (float*)(ws + WS_BETA);
    const float* cw = P.conv_w_c;
    constexpr int RUN = 8, NRUN = TP / RUN;
    for (int item = gw; item < 16 * NBP * NRUN; item += NGW) {
        const int it = item & 15, ru = item >> 4, b = ru / NRUN, t0 = (ru % NRUN) * RUN, ch0 = it * 512 + 8 * lane;
        float w[4][8];
#pragma unroll
        for (int j = 0; j < 4; ++j) { const f32x4 w0 = *(const f32x4*)(cw + (size_t)j * CDIM + ch0), w1 = *(const f32x4*)(cw + (size_t)j * CDIM + ch0 + 4);
            w[j][0] = w0.x; w[j][1] = w0.y; w[j][2] = w0.z; w[j][3] = w0.w; w[j][4] = w1.x; w[j][5] = w1.y; w[j][6] = w1.z; w[j][7] = w1.w; }
        const int r0 = prow(b, t0);
        v4u xr[RUN + 3];
#pragma unroll
        for (int j = 0; j < 3; ++j) { const int tt = t0 - 3 + j; xr[j] = tt >= 0 ? *(const v4u*)(PROJC + (size_t)prow(b, tt) * NC_PAD + ch0) : (v4u){0u, 0u, 0u, 0u}; }
#pragma unroll
        for (int k = 0; k < RUN; ++k) xr[3 + k] = *(const v4u*)(PROJC + (size_t)(r0 + k) * NC_PAD + ch0);
        float x[RUN + 3][8];
#pragma unroll
        for (int j = 0; j < RUN + 3; ++j) unpack8(xr[j], x[j]);
#pragma unroll
        for (int k = 0; k < RUN; ++k) {
            float acc[8];
#pragma unroll
            for (int i = 0; i < 8; ++i) acc[i] = w[0][i] * x[k][i] + w[1][i] * x[k + 1][i] + w[2][i] * x[k + 2][i] + w[3][i] * x[k + 3][i];
            convC_finish(acc, it);
            *(v4u*)(QKVC + (size_t)(r0 + k) * CDIM + ch0) = pack8(acc);
            const int t = t0 + k;
            if (t >= TP - 3) { float* o = P.out + O_CCP + ((size_t)(b * 3 + (t - (TP - 3)))) * CDIM + ch0;
                *(f32x4*)o = (f32x4){x[k + 3][0], x[k + 3][1], x[k + 3][2], x[k + 3][3]}; *(f32x4*)(o + 4) = (f32x4){x[k + 3][4], x[k + 3][5], x[k + 3][6], x[k + 3][7]}; }
        }
    }
    for (int item = gw; item < 16 * SBN; item += NGW) {
        const int it = item & 15, sb = item >> 4, r = SROW0 + sb, ch0 = it * 512 + 8 * lane;
        float x[4][8];
#pragma unroll
        for (int j = 0; j < 3; ++j) { const float* hp = P.state_conv_c + ((size_t)(sb * 3 + j)) * CDIM + ch0; const f32x4 a = *(const f32x4*)hp, c = *(const f32x4*)(hp + 4);
            x[j][0] = a.x; x[j][1] = a.y; x[j][2] = a.z; x[j][3] = a.w; x[j][4] = c.x; x[j][5] = c.y; x[j][6] = c.z; x[j][7] = c.w; }
        unpack8(*(const v4u*)(PROJC + (size_t)r * NC_PAD + ch0), x[3]);
        float acc[8];
#pragma unroll
        for (int i = 0; i < 8; ++i) acc[i] = 0.f;
#pragma unroll
        for (int j = 0; j < 4; ++j) { const f32x4 w0 = *(const f32x4*)(cw + (size_t)j * CDIM + ch0), w1 = *(const f32x4*)(cw + (size_t)j * CDIM + ch0 + 4);
            acc[0] += w0.x * x[j][0]; acc[1] += w0.y * x[j][1]; acc[2] += w0.z * x[j][2]; acc[3] += w0.w * x[j][3];
            acc[4] += w1.x * x[j][4]; acc[5] += w1.y * x[j][5]; acc[6] += w1.z * x[j][6]; acc[7] += w1.w * x[j][7]; }
        convC_finish(acc, it);
        if (it < 8) { float* qk = QKF + (size_t)r * 4096 + ch0; *(f32x4*)qk = (f32x4){acc[0], acc[1], acc[2], acc[3]}; *(f32x4*)(qk + 4) = (f32x4){acc[4], acc[5], acc[6], acc[7]}; }
        *(v4u*)(QKVC + (size_t)r * CDIM + ch0) = pack8(acc);
        float* o = P.out + O_CCS + ((size_t)(sb * 3)) * CDIM + ch0;
#pragma unroll
        for (int j = 0; j < 3; ++j) { *(f32x4*)(o + (size_t)j * CDIM) = (f32x4){x[j + 1][0], x[j + 1][1], x[j + 1][2], x[j + 1][3]}; *(f32x4*)(o + (size_t)j * CDIM + 4) = (f32x4){x[j + 1][4], x[j + 1][5], x[j + 1][6], x[j + 1][7]}; }
    }
    for (int e = gw * 64 + lane; e < NROWS * 32; e += NGW * 64) {
        const int r = e >> 5, h = e & 31;
        const float braw = bf2f(PROJC[(size_t)r * NC_PAD + 12288 + h]), araw = bf2f(PROJC[(size_t)r * NC_PAD + 12320 + h]);
        const float xx = araw + P.dt_bias[h]; const float sp = xx > 20.f ? xx : __logf(1.f + __expf(xx));
        G[e] = -__expf(P.a_log[h]) * sp; BETA[e] = 1.f / (1.f + __expf(-braw));
    }
}

struct Tok { f32x4 k0, k1, q0, q1; unsigned v; float g, b; };
__device__ __forceinline__ void tok_load(Tok& T, const float* QKF, const bf16* QKVC, const float* G, const float* BETA, int row, int h, int rg, int col0) {
    const float* base = QKF + (size_t)row * 4096 + (h >> 1) * 128 + 8 * rg;
    T.q0 = *(const f32x4*)base; T.q1 = *(const f32x4*)(base + 4); T.k0 = *(const f32x4*)(base + 2048); T.k1 = *(const f32x4*)(base + 2052);
    T.v = *(const unsigned*)(QKVC + (size_t)row * CDIM + 4096 + h * 128 + col0);
    T.g = G[(size_t)row * 32 + h]; T.b = BETA[(size_t)row * 32 + h];
}
__device__ __forceinline__ f32x2 tok_step(f32x2 (&S)[8], const Tok& T) {
    const float kk[8] = {T.k0.x, T.k0.y, T.k0.z, T.k0.w, T.k1.x, T.k1.y, T.k1.z, T.k1.w};
    const float qq[8] = {T.q0.x, T.q0.y, T.q0.z, T.q0.w, T.q1.x, T.q1.y, T.q1.z, T.q1.w};
    const float a = __expf(T.g);
    f32x2 d0 = S[0] * kk[0], d1 = S[1] * kk[1];
#pragma unroll
    for (int i = 2; i < 8; i += 2) { d0 += S[i] * kk[i]; d1 += S[i + 1] * kk[i + 1]; }
    f32x2 d = d0 + d1;
    d.x = row16_sum(d.x); d.y = row16_sum(d.y);
    const f32x2 tv = {bflo(T.v), bfhi(T.v)};
    const f32x2 dl = (tv - d * a) * T.b;
    f32x2 o0 = {0.f, 0.f}, o1 = {0.f, 0.f};
#pragma unroll
    for (int i = 0; i < 8; i += 2) { S[i] = S[i] * a + dl * kk[i]; o0 += S[i] * qq[i]; S[i + 1] = S[i + 1] * a + dl * kk[i + 1]; o1 += S[i + 1] * qq[i + 1]; }
    f32x2 o = o0 + o1;
    o.x = row16_sum(o.x); o.y = row16_sum(o.y);
    return o;
}
__device__ __forceinline__ void delta_phase(const Ptrs& P, int wave, int lane) {
    unsigned char* ws = P.ws;
    const bf16* QKVC = (const bf16*)(ws + WS_QKVC); const float* QKF = (const float*)(ws + WS_QKF); const float* G = (const float*)(ws + WS_G); const float* BETA = (const float*)(ws + WS_BETA); bf16* OF = (bf16*)(ws + WS_SC);
    const int cg = lane >> 4, rg = lane & 15;
    {
        for (int item = blockIdx.x * 8 + wave; item < SBN * 32 * 16; item += gridDim.x * 8) {
            const int sb = item >> 9, h = (item >> 4) & 31, col0 = 8 * (item & 15) + 2 * cg;
            const size_t so = ((size_t)((sb * 32 + h) * 128 + 8 * rg)) * 128 + col0;
            f32x2 S[8];
#pragma unroll
            for (int i = 0; i < 8; ++i) S[i] = *(const f32x2*)(P.state_delta + so + (size_t)i * 128);
            Tok T; tok_load(T, QKF, QKVC, G, BETA, SROW0 + sb, h, rg, col0);
            const f32x2 o = tok_step(S, T);
            if (rg == 0) *(unsigned*)(OF + (size_t)(SROW0 + sb) * DVW + h * 128 + col0) = pk2(o.x, o.y);
            float* op = P.out + O_DS + so;
#pragma unroll
            for (int i = 0; i < 8; ++i) *(f32x2*)(op + (size_t)i * 128) = S[i];
        }
    }
}
__device__ __forceinline__ void normC_phase(const bf16* PROJC, bf16* Y, const Ptrs& P, int gw, int NGW, int lane) {
    const bf16* OF = (const bf16*)(P.ws + WS_SC);
    const int d0 = 8 * (lane & 15);
    float nw[8];
    { const f32x4 a = *(const f32x4*)(P.norm_w + d0), b = *(const f32x4*)(P.norm_w + d0 + 4); nw[0] = a.x; nw[1] = a.y; nw[2] = a.z; nw[3] = a.w; nw[4] = b.x; nw[5] = b.y; nw[6] = b.z; nw[7] = b.w; }
    for (int r = gw; r < NROWS; r += NGW) {
        v4u oq[8], zz[8];
#pragma unroll
        for (int it = 0; it < 8; ++it) { const int hd = it * 4 + (lane >> 4);
            oq[it] = *(const v4u*)(OF + (size_t)r * DVW + hd * 128 + d0); zz[it] = *(const v4u*)(PROJC + (size_t)r * NC_PAD + 8192 + hd * 128 + d0); }
#pragma unroll
        for (int it = 0; it < 8; ++it) {
            const int hd = it * 4 + (lane >> 4);
            float o[8]; unpack8(oq[it], o);
            float ss = 0.f;
#pragma unroll
            for (int i = 0; i < 8; ++i) ss += o[i] * o[i];
            ss = row16_sum(ss);
            const float rs = 1.f / sqrtf(ss * (1.f / 128.f) + RMS_EPS);
            float z[8]; unpack8(zz[it], z);
#pragma unroll
            for (int i = 0; i < 8; ++i) o[i] = o[i] * rs * nw[i] * silu_f(z[i]);
            *(v4u*)(Y + (size_t)r * DVW + hd * 128 + d0) = pack8(o);
        }
    }
}


__device__ __forceinline__ void dense_attn_phase(const Ptrs& P, bf16* O, char* lds, int wv) {
    unsigned char* ws = P.ws;
    const bf16* Qr = (const bf16*)(ws + WS_QR); const bf16* Ks = (const bf16*)(ws + WS_KS); const bf16* Vs = (const bf16*)(ws + WS_VS);
    const unsigned long long* MASK = (const unsigned long long*)(ws + WS_MASK);
    typedef dattn::BlockRef<bf16, bf16> BR;
    for (int it0 = blockIdx.x; it0 < 256; it0 += gridDim.x) {
        const int grp = it0 & 7, idx = it0 >> 3;
        const int b = grp >> 2, kvh = grp & 3, h = kvh * 4 + (idx >> 3), x = idx & 7;
        BR A, B;
        const int qa = 1 + x, qb = 16 - x;
        A.Q = Qr + ((size_t)(b * SEQ + 256 * (qa - 1))) * DM + h * 128; A.O = O + ((size_t)(b * SEQ + 256 * (qa - 1))) * DM + h * 128;
        B.Q = Qr + ((size_t)(b * SEQ + 256 * (qb - 1))) * DM + h * 128; B.O = O + ((size_t)(b * SEQ + 256 * (qb - 1))) * DM + h * 128;
        A.K = B.K = Ks + (size_t)b * SP * 512 + kvh * 128; A.V = B.V = Vs + (size_t)b * SP * 512 + kvh * 128;
        A.P0 = 256 * qa; B.P0 = 256 * qb;
        A.M = MASK + ((size_t)(b * SP + A.P0)) * MTW; B.M = MASK + ((size_t)(b * SP + B.P0)) * MTW;
        dattn::Seam<bf16> S;
        dattn::causal_swa_prime<bf16, bf16>(A, SP, lds, S, wv);
        dattn::causal_swa_block<bf16, bf16>(A, B, SP, SP, lds, S, wv);
        dattn::causal_swa_block<bf16, bf16>(B, B, SP, SP, lds, S, wv);
    }
}

constexpr int NCH = 65, CPAD = 48;
constexpr int NUQ = NBP * 16 * NCH, NUH = NBP * 32 * NCH;
__device__ __forceinline__ int crow32(int r, int hi) { return (r & 3) + 8 * (r >> 2) + 4 * hi; }
__device__ __forceinline__ int chunk_row(int b, int c, int i) { const int t = 64 * c + i - CPAD; return t >= 0 ? prow(b, t) : -1; }
__device__ __forceinline__ float incl_scan64(float v, int lane) {
#pragma unroll
    for (int o = 1; o < 64; o <<= 1) { const float u = __shfl_up(v, o); if (lane >= o) v += u; }
    return v;
}
#define MFMA32(a, b, c) __builtin_amdgcn_mfma_f32_32x32x16_bf16((a), (b), (c), 0, 0, 0)
__device__ __forceinline__ bf16x8 sel8(bool ok, bf16x8 v) { const bf16x8 z = {0, 0, 0, 0, 0, 0, 0, 0}; return ok ? v : z; }
__device__ __forceinline__ int sw23(int x) { return (x & ~12) | ((x & 4) << 1) | ((x & 8) >> 1); }
__device__ __forceinline__ int fidx64(int row, int xs) { return ((((row >> 5) * 2 + (xs >> 5)) * 2 + ((xs >> 4) & 1)) * 64 + (row & 31) + 32 * ((xs >> 3) & 1)) * 8 + (xs & 7); }

__device__ __forceinline__ v4u pack_frag(const f32x16& x, int s) { v4u w; w.x = pk2(x[8 * s], x[8 * s + 1]); w.y = pk2(x[8 * s + 2], x[8 * s + 3]); w.z = pk2(x[8 * s + 4], x[8 * s + 5]); w.w = pk2(x[8 * s + 6], x[8 * s + 7]); return w; }
__device__ __forceinline__ void stage_out8k(LAS unsigned char* stg, bf16* gdst, int lane) {
    WAVE_SYNC();
#pragma unroll
    for (int k = 0; k < 8; ++k) *(v4u*)(gdst + k * 512 + lane * 8) = *(const LAS v4u*)(stg + k * 1024 + lane * 16);
    WAVE_SYNC();
}
__device__ __forceinline__ void delta_d1_unit(unsigned char* ws, LAS unsigned char* lds, int uq, int wave, int lane) {
    asm volatile("" : "+v"(lane));
    const bf16* QKVC = (const bf16*)(ws + WS_QKVC); const float* G = (const float*)(ws + WS_G); const float* BETA = (const float*)(ws + WS_BETA);
    float* AF = (float*)(ws + WS_DAF); bf16* PG = (bf16*)(ws + WS_DPG); bf16* KT = (bf16*)(ws + WS_DKT); bf16* VT = (bf16*)(ws + WS_DVT);
    float* GC = (float*)(ws + WS_DGC); float* BT = (float*)(ws + WS_DBT);
    LAS float* lg = (LAS float*)(lds + wave * 16384);
    LAS unsigned char* stg = lds + wave * 16384 + 2048; LAS bf16* st = (LAS bf16*)stg;
    const int m = lane & 31, half = lane >> 5;
    const bf16x8 zf = {0, 0, 0, 0, 0, 0, 0, 0};
    {
        const int c = uq % NCH, bh = uq / NCH, hq = bh & 15, b = bh >> 4;
        { const int row = chunk_row(b, c, lane);
#pragma unroll
          for (int hh = 0; hh < 2; ++hh) { const int h = 2 * hq + hh; const float g = row >= 0 ? G[(size_t)row * 32 + h] : 0.f, bt = row >= 0 ? BETA[(size_t)row * 32 + h] : 0.f;
              const float gc = incl_scan64(g, lane); lg[hh * 64 + lane] = gc; lg[128 + hh * 64 + lane] = bt;
              const size_t uh = ((size_t)(b * 32 + h)) * NCH + c; GC[uh * 64 + lane] = gc; BT[uh * 64 + lane] = bt; } }
        const int row0 = chunk_row(b, c, m), row1 = chunk_row(b, c, 32 + m);
        const bf16* r0 = QKVC + (size_t)(row0 < 0 ? 0 : row0) * CDIM; const bf16* r1 = QKVC + (size_t)(row1 < 0 ? 0 : row1) * CDIM;
        f32x16 kk00, kk10, kk11, qk00, qk10, qk11;
#pragma unroll
        for (int i = 0; i < 16; ++i) { kk00[i] = 0.f; kk10[i] = 0.f; kk11[i] = 0.f; qk00[i] = 0.f; qk10[i] = 0.f; qk11[i] = 0.f; }
        const int sm = sw23(m);
        const int ktl = half * 32 + ((sm >> 4) & 1) * 512 + ((sm >> 3) & 1) * 256 + (sm & 7);
#pragma unroll 1
        for (int kh = 0; kh < 2; ++kh) {
            bf16x8 kf0[4], kf1[4], qf0[4], qf1[4];
#pragma unroll
            for (int u = 0; u < 4; ++u) { const int off = hq * 128 + 16 * (4 * kh + u) + 8 * half;
                kf0[u] = sel8(row0 >= 0, *(const bf16x8*)(r0 + 2048 + off)); kf1[u] = sel8(row1 >= 0, *(const bf16x8*)(r1 + 2048 + off));
                qf0[u] = sel8(row0 >= 0, *(const bf16x8*)(r0 + off)); qf1[u] = sel8(row1 >= 0, *(const bf16x8*)(r1 + off)); }
#pragma unroll
            for (int u = 0; u < 4; ++u) { const int ks = 4 * kh + u; const bf16x8 k0 = kf0[u], k1 = kf1[u], q0 = qf0[u], q1 = qf1[u];
                kk00 = MFMA32(k0, k0, kk00); kk10 = MFMA32(k1, k0, kk10); kk11 = MFMA32(k1, k1, kk11);
                qk00 = MFMA32(q0, k0, qk00); qk10 = MFMA32(q1, k0, qk10); qk11 = MFMA32(q1, k1, qk11);
                LAS bf16* kb = st + ktl + ((ks >> 1) & 1) * 2048 + (ks & 1) * 128;
#pragma unroll
                for (int e = 0; e < 8; ++e) { kb[(8 * (e >> 2) + (e & 3)) * 8] = (bf16)k0[e]; kb[1024 + (8 * (e >> 2) + (e & 3)) * 8] = (bf16)k1[e]; } }
            stage_out8k(stg, KT + (size_t)uq * 8192 + kh * 4096, lane);
        }
#pragma unroll 1
        for (int hh = 0; hh < 2; ++hh) { const int h = 2 * hq + hh; bf16* vt = VT + (((size_t)(b * 32 + h)) * NCH + c) * 8192;
            const int vtl = half * 64 + ((sm >> 4) & 1) * 512 + ((sm >> 3) & 1) * 256 + (sm & 7);
            bf16x8 vf0[8], vf1[8];
#pragma unroll
            for (int ks = 0; ks < 8; ++ks) { const int off = 4096 + h * 128 + 16 * ks + 8 * half; vf0[ks] = sel8(row0 >= 0, *(const bf16x8*)(r0 + off)); vf1[ks] = sel8(row1 >= 0, *(const bf16x8*)(r1 + off)); }
#pragma unroll
            for (int kh = 0; kh < 2; ++kh) {
#pragma unroll
                for (int u = 0; u < 4; ++u) { const int ks = 4 * kh + u; LAS bf16* vb = st + vtl + ((ks >> 1) & 1) * 2048 + (ks & 1) * 128;
#pragma unroll
                    for (int e = 0; e < 8; ++e) { vb[e * 8] = (bf16)vf0[ks][e]; vb[1024 + e * 8] = (bf16)vf1[ks][e]; } }
                stage_out8k(stg, vt + kh * 4096, lane);
            } }
        WAVE_SYNC();
#pragma unroll 1
        for (int hh = 0; hh < 2; ++hh) { const int h = 2 * hq + hh; const size_t uh = ((size_t)(b * 32 + h)) * NCH + c;
            float* af = AF + uh * 4096 + half * 256 + m;
            LAS bf16* pg = st + ktl;
            const float gcj0 = lg[hh * 64 + m], gcj1 = lg[hh * 64 + 32 + m];
#pragma unroll
            for (int r = 0; r < 16; ++r) { const int ir = crow32(r, half), rc = (r & 3) + 8 * (r >> 2);
                const float gi0 = lg[hh * 64 + ir], gi1 = lg[hh * 64 + 32 + ir], bi0 = lg[128 + hh * 64 + ir], bi1 = lg[128 + hh * 64 + 32 + ir];
                { const int i = ir, j = m; const float dec = __expf(fminf(gi0 - gcj0, 0.f)); af[rc * 64] = (j < i) ? bi0 * dec * kk00[r] : 0.f; pg[rc * 8] = f2bf((j <= i) ? dec * qk00[r] : 0.f); }
                { const int i = 32 + ir, j = m; const float dec = __expf(fminf(gi1 - gcj0, 0.f)); af[2048 + rc * 64] = bi1 * dec * kk10[r]; pg[2048 + rc * 8] = f2bf(dec * qk10[r]); }
                { const int i = 32 + ir, j = 32 + m; const float dec = __expf(fminf(gi1 - gcj1, 0.f)); af[2048 + 32 + rc * 64] = (j < i) ? bi1 * dec * kk11[r] : 0.f; pg[2048 + 1024 + rc * 8] = f2bf((j <= i) ? dec * qk11[r] : 0.f); }
            }
            stage_out8k(stg, PG + uh * 4096, lane); }
        WAVE_SYNC();
    }
}
__device__ __forceinline__ void delta_d2_unit(unsigned char* ws, LAS unsigned char* lds, int uh, int wave, int lane) {
    asm volatile("" : "+v"(lane));
    const float* AF = (const float*)(ws + WS_DAF); const float* GC = (const float*)(ws + WS_DGC); const float* BT = (const float*)(ws + WS_DBT);
    bf16* TG = (bf16*)(ws + WS_DTG); bf16* TB = (bf16*)(ws + WS_DTB);
    {
        const float* af = AF + (size_t)uh * 4096;
        const float bc = BT[(size_t)uh * 64 + lane], gmc = __expf(GC[(size_t)uh * 64 + lane]);
        float T[64];
        const bool pad0 = (uh % NCH) == 0;
#pragma unroll
        for (int i0 = 0; i0 < 64; i0 += 16) {
            float ar[16];
#pragma unroll
            for (int u = 0; u < 16; ++u) ar[u] = af[(i0 + u) * 64 + lane];
            if (pad0 && i0 < 32) {
#pragma unroll
                for (int u = 0; u < 16; ++u) T[i0 + u] = (lane == i0 + u) ? 1.f : 0.f;
            } else {
#pragma unroll
                for (int u = 0; u < 16; ++u) { const int i = i0 + u; float pa[4] = {(lane == i) ? 1.f : 0.f, 0.f, 0.f, 0.f};
#pragma unroll
                    for (int j = 0; j < i; ++j) pa[j & 3] -= __int_as_float(__builtin_amdgcn_readlane(__float_as_int(ar[u]), j)) * T[j];
                    T[i] = (pa[0] + pa[1]) + (pa[2] + pa[3]); }
            }
        }
        bf16* tg = TG + (size_t)uh * 4096; bf16* tb = TB + (size_t)uh * 4096;
        const float sg = bc * gmc;
        const int cs = (lane & ~31) + sw23(lane & 31);
        const int lcol = (cs >> 4) * 512 + ((cs >> 3) & 1) * 256 + (cs & 7);
        LAS unsigned char* stg = lds + wave * 16384 + 2048; LAS bf16* st = (LAS bf16*)stg;
#pragma unroll
        for (int i = 0; i < 64; ++i) st[(i >> 5) * 2048 + (i & 31) * 8 + lcol] = f2bf(T[i] * sg);
        stage_out8k(stg, tg, lane);
#pragma unroll
        for (int i = 0; i < 64; ++i) st[(i >> 5) * 2048 + (i & 31) * 8 + lcol] = f2bf(T[i] * bc);
        stage_out8k(stg, tb, lane);
    }
}
__device__ __forceinline__ void delta_d3_unit(unsigned char* ws, int uh, int lane) {
    asm volatile("" : "+v"(lane));
    const bf16* TG = (const bf16*)(ws + WS_DTG); const bf16* TB = (const bf16*)(ws + WS_DTB); const bf16* KT = (const bf16*)(ws + WS_DKT); const bf16* VT = (const bf16*)(ws + WS_DVT);
    bf16* WG = (bf16*)(ws + WS_DWG); bf16* UG = (bf16*)(ws + WS_DUG);
    const int m = lane & 31, half = lane >> 5;
    const int c = uh % NCH, bh = uh / NCH, h = bh & 31, b = bh >> 5;
    const size_t uq = ((size_t)(b * 16 + (h >> 1))) * NCH + c;
    {
        const bf16* Tm = TG + (size_t)uh * 4096; const bf16* Kf = KT + uq * 8192;
        f32x16 acc[4][2];
#pragma unroll
        for (int dn = 0; dn < 4; ++dn)
#pragma unroll
            for (int ti = 0; ti < 2; ++ti)
#pragma unroll
                for (int i = 0; i < 16; ++i) acc[dn][ti][i] = 0.f;
#pragma unroll
        for (int ks = 0; ks < 4; ++ks) {
            bf16x8 a[4], bb[2];
#pragma unroll
            for (int dn = 0; dn < 4; ++dn) a[dn] = *(const bf16x8*)(Kf + ((size_t)(((dn * 2 + (ks >> 1)) * 2 + (ks & 1)) * 64 + lane)) * 8);
#pragma unroll
            for (int ti = 0; ti < 2; ++ti) bb[ti] = *(const bf16x8*)(Tm + ((size_t)((ti * 4 + ks) * 64 + lane)) * 8);
#pragma unroll
            for (int dn = 0; dn < 4; ++dn)
#pragma unroll
                for (int ti = 0; ti < 2; ++ti) acc[dn][ti] = MFMA32(a[dn], bb[ti], acc[dn][ti]);
        }
        bf16* wg = WG + (size_t)uh * 8192;
#pragma unroll
        for (int dn = 0; dn < 4; ++dn)
#pragma unroll
            for (int ti = 0; ti < 2; ++ti)
#pragma unroll
                for (int s2 = 0; s2 < 2; ++s2) *(v4u*)(wg + ((size_t)(((ti * 4 + dn) * 2 + s2) * 64 + lane)) * 8) = pack_frag(acc[dn][ti], s2);
    }
    {
        const bf16* Tm = TB + (size_t)uh * 4096; const bf16* Bt = VT + (size_t)uh * 8192;
        f32x16 acc[2][4];
#pragma unroll
        for (int ti = 0; ti < 2; ++ti)
#pragma unroll
            for (int dn = 0; dn < 4; ++dn)
#pragma unroll
                for (int i = 0; i < 16; ++i) acc[ti][dn][i] = 0.f;
#pragma unroll
        for (int ks = 0; ks < 4; ++ks) {
            bf16x8 a[2], bb[4];
#pragma unroll
            for (int ti = 0; ti < 2; ++ti) a[ti] = *(const bf16x8*)(Tm + ((size_t)((ti * 4 + ks) * 64 + lane)) * 8);
#pragma unroll
            for (int dn = 0; dn < 4; ++dn) bb[dn] = *(const bf16x8*)(Bt + ((size_t)((dn * 4 + ks) * 64 + lane)) * 8);
#pragma unroll
            for (int ti = 0; ti < 2; ++ti)
#pragma unroll
                for (int dn = 0; dn < 4; ++dn) acc[ti][dn] = MFMA32(a[ti], bb[dn], acc[ti][dn]);
        }
        bf16* ug = UG + (size_t)uh * 8192;
#pragma unroll
        for (int ti = 0; ti < 2; ++ti)
#pragma unroll
            for (int dn = 0; dn < 4; ++dn) { bf16* p = ug + ((size_t)((ti * 4 + dn) * 64 + lane)) * 16; *(v4u*)p = pack_frag(acc[ti][dn], 0); *(v4u*)(p + 8) = pack_frag(acc[ti][dn], 1); }
    }
}
__device__ __forceinline__ void delta_pre(unsigned char* ws, LAS unsigned char* lds, int gw, int NGW, int wave, int lane) {
    for (int uq = gw; uq < NUQ; uq += NGW) {
#ifndef NO_D1
        delta_d1_unit(ws, lds, uq, wave, lane);
#endif
#ifdef DUP_D1
        delta_d1_unit(ws, lds, uq, wave, lane);
#endif
        asm volatile("s_waitcnt vmcnt(0)" ::: "memory");
        const int c = uq % NCH, bh = uq / NCH, hq = bh & 15, b = bh >> 4;
#pragma unroll 1
        for (int hh = 0; hh < 2; ++hh) { const int uh = (b * 32 + 2 * hq + hh) * NCH + c;
#ifndef NO_D2
            delta_d2_unit(ws, lds, uh, wave, lane);
#endif
#ifdef DUP_D2
            delta_d2_unit(ws, lds, uh, wave, lane);
#endif
            asm volatile("s_waitcnt vmcnt(0)" ::: "memory");
#ifndef NO_D3
            delta_d3_unit(ws, uh, lane);
#endif
#ifdef DUP_D3
            delta_d3_unit(ws, uh, lane);
#endif
        }
    }
}
__device__ __forceinline__ bf16x8 afrag_perm(const bf16* rowp, int blk, int s, int half) {
    const v2u lo = *(const v2u*)(rowp + 32 * blk + 16 * s + 4 * half), hi2 = *(const v2u*)(rowp + 32 * blk + 16 * s + 8 + 4 * half);
    v4u w; w.x = lo.x; w.y = lo.y; w.z = hi2.x; w.w = hi2.y; return __builtin_bit_cast(bf16x8, w);
}
#define LBAR() asm volatile("s_waitcnt lgkmcnt(0)\n\ts_barrier" ::: "memory")
__device__ __forceinline__ void delta_d4(unsigned char* ws, float* out_state, LAS unsigned char* lds, int tid, int wave, int lane) {
    const bf16* QKVC = (const bf16*)(ws + WS_QKVC); const bf16* KT = (const bf16*)(ws + WS_DKT); const bf16* PG = (const bf16*)(ws + WS_DPG);
    const bf16* WG = (const bf16*)(ws + WS_DWG); const bf16* UG = (const bf16*)(ws + WS_DUG); const float* GC = (const float*)(ws + WS_DGC);
    bf16* OF = (bf16*)(ws + WS_SC);
    LAS v4u* Sfr = (LAS v4u*)lds;
    LAS v4u* Dfr = (LAS v4u*)(lds + 16384);
    LAS v4u* Dtf = (LAS v4u*)(lds + 16384 + 4096);
    LAS float* gam = (LAS float*)(lds + 16384 + 8192);
    const int m = lane & 31, half = lane >> 5;
    const bf16x8 zf = {0, 0, 0, 0, 0, 0, 0, 0};
    for (int item = blockIdx.x; item < NBP * 32 * 4; item += gridDim.x) {
        const int xg = item & 7, jj = item >> 3, pair = xg * 4 + (jj >> 3), q = jj & 3, h = 2 * (pair & 15) + ((jj >> 2) & 1), b = pair >> 4;
        const size_t uh0 = ((size_t)(b * 32 + h)) * NCH, uq0 = ((size_t)(b * 16 + (h >> 1))) * NCH;
        const int rt = wave & 1; const bool isq = wave >= 6;
#define ROT3(LOADM, STEPM) do { LOADM(0, 0); LOADM(1, 1); \
            for (int c = 0; c < NCH; c += 3) { \
                if (c + 2 < NCH) LOADM(c + 2, 2); \
                STEPM(c, 0); \
                if (c + 1 < NCH) { if (c + 3 < NCH) LOADM(c + 3, 0); STEPM(c + 1, 1); } \
                if (c + 2 < NCH) { if (c + 4 < NCH) LOADM(c + 4, 1); STEPM(c + 2, 2); } } } while (0)
#define ROT2(LOADM, STEPM) do { LOADM(0, 0); \
            for (int c = 0; c < NCH; c += 2) { \
                if (c + 1 < NCH) LOADM(c + 1, 1); \
                STEPM(c, 0); \
                if (c + 1 < NCH) { if (c + 2 < NCH) LOADM(c + 2, 0); STEPM(c + 1, 1); } } } while (0)
        LBAR();
        if (wave < 4) {
            int ll_ = lane; asm volatile("" : "+v"(ll_)); const int lane = ll_, m = lane & 31, half = lane >> 5; (void)m; (void)half;
            { const v4u z = {0u, 0u, 0u, 0u}; Sfr[(0 * 4 + wave) * 128 + lane] = z; Sfr[(0 * 4 + wave) * 128 + 64 + lane] = z; }
            bf16x8 kf[2][4];
            f32x16 S;
#pragma unroll
            for (int i = 0; i < 16; ++i) S[i] = 0.f;
#define LOAD_K(cc, B) do { const bf16* kr_ = KT + (uq0 + (cc)) * 8192; \
                _Pragma("unroll") for (int blk = 0; blk < 2; ++blk) _Pragma("unroll") for (int s_ = 0; s_ < 2; ++s_) kf[B][blk * 2 + s_] = *(const bf16x8*)(kr_ + ((size_t)(((wave * 2 + blk) * 2 + s_) * 64 + lane)) * 8); } while (0)
#define STEP_K(c, B) do { const int bufc = (c) & 1; LBAR(); LBAR(); \
                const float gl = gam[bufc * 64 + 63]; \
                _Pragma("unroll") for (int i = 0; i < 16; ++i) S[i] *= gl; \
                _Pragma("unroll") for (int blk = 0; blk < 2; ++blk) _Pragma("unroll") for (int s = 0; s < 2; ++s) S = MFMA32(kf[B][blk * 2 + s], __builtin_bit_cast(bf16x8, Dtf[(blk * 2 + s) * 64 + lane]), S); \
                _Pragma("unroll") for (int s = 0; s < 2; ++s) Sfr[((bufc ^ 1) * 4 + wave) * 128 + s * 64 + lane] = pack_frag(S, s); } while (0)
#ifndef NO_RK
            ROT2(LOAD_K, STEP_K);
#endif
            { float* o = out_state + ((size_t)((b * 32 + h) * 128 + 32 * wave)) * 128 + 32 * q + m;
#pragma unroll
              for (int r = 0; r < 16; ++r) o[(size_t)sw23(crow32(r, half)) * 128] = S[r]; }
#undef LOAD_K
#undef STEP_K
        } else if (!isq) {
            int ll_ = lane; asm volatile("" : "+v"(ll_)); const int lane = ll_, m = lane & 31, half = lane >> 5; (void)m; (void)half;
            bf16x8 wf[3][8], uf[3][2]; float gcv[3] = {0.f, 0.f, 0.f};
#define LOAD_W(cc, B) do { const bf16* wb_ = WG + (uh0 + (cc)) * 8192 + ((size_t)(rt * 512 + lane)) * 8; \
                _Pragma("unroll") for (int blk = 0; blk < 4; ++blk) _Pragma("unroll") for (int s_ = 0; s_ < 2; ++s_) wf[B][blk * 2 + s_] = *(const bf16x8*)(wb_ + blk * 1024 + s_ * 512); \
                const bf16* ub_ = UG + (uh0 + (cc)) * 8192 + ((size_t)((rt * 4 + q) * 64 + lane)) * 16; uf[B][0] = *(const bf16x8*)ub_; uf[B][1] = *(const bf16x8*)(ub_ + 8); \
                if (wave == 4) gcv[B] = GC[(uh0 + (cc)) * 64 + lane]; } while (0)
#define STEP_W(c, B) do { const int bufc = (c) & 1; LBAR(); \
                f32x16 acc; \
                _Pragma("unroll") for (int i = 0; i < 16; ++i) acc[i] = 0.f; \
                _Pragma("unroll") for (int blk = 0; blk < 4; ++blk) _Pragma("unroll") for (int s = 0; s < 2; ++s) \
                    acc = MFMA32(wf[B][blk * 2 + s], __builtin_bit_cast(bf16x8, Sfr[(bufc * 4 + blk) * 128 + s * 64 + lane]), acc); \
                { float t8[8]; unpack8(__builtin_bit_cast(v4u, uf[B][0]), t8); \
                    _Pragma("unroll") for (int i = 0; i < 8; ++i) acc[i] = t8[i] - acc[i]; unpack8(__builtin_bit_cast(v4u, uf[B][1]), t8); \
                    _Pragma("unroll") for (int i = 0; i < 8; ++i) acc[8 + i] = t8[i] - acc[8 + i]; } \
                _Pragma("unroll") for (int s = 0; s < 2; ++s) Dfr[(rt * 2 + s) * 64 + lane] = pack_frag(acc, s); \
                _Pragma("unroll") for (int r = 0; r < 16; ++r) acc[r] *= gam[128 + bufc * 64 + 32 * rt + crow32(r, half)]; \
                _Pragma("unroll") for (int s = 0; s < 2; ++s) Dtf[(rt * 2 + s) * 64 + lane] = pack_frag(acc, s); \
                LBAR(); \
                if (wave == 4 && (c) + 1 < NCH) { const float gn_ = gcv[((B) + 1) % 3], gl_ = __shfl(gn_, 63); gam[(bufc ^ 1) * 64 + lane] = __expf(gn_); gam[128 + (bufc ^ 1) * 64 + lane] = __expf(gl_ - gn_); } } while (0)
            if (wave == 4) { const float gc = GC[(uh0 + 0) * 64 + lane], gl = __shfl(gc, 63); gam[lane] = __expf(gc); gam[128 + lane] = __expf(gl - gc); }
#ifndef NO_RW
            ROT3(LOAD_W, STEP_W);
#endif
#undef LOAD_W
#undef STEP_W
        } else {
            int ll_ = lane; asm volatile("" : "+v"(ll_)); const int lane = ll_, m = lane & 31, half = lane >> 5; (void)m; (void)half;
            bf16x8 qf[1][8], pf[1][4];
#define LOAD_Q(cc, B) do { const int row_ = chunk_row(b, (cc), 32 * rt + m); const bool ok_ = row_ >= 0; \
                const bf16* qb_ = QKVC + (size_t)(row_ < 0 ? 0 : row_) * CDIM + (h >> 1) * 128 + 8 * half; \
                _Pragma("unroll") for (int blk = 0; blk < 4; ++blk) _Pragma("unroll") for (int s_ = 0; s_ < 2; ++s_) qf[B][blk * 2 + s_] = sel8(ok_, *(const bf16x8*)(qb_ + blk * 32 + s_ * 16)); \
                } while (0)
#define LOAD_P(cc, PB) do { const bf16* pb_ = PG + (uh0 + (cc)) * 4096 + ((size_t)(rt * 256 + lane)) * 8; \
                _Pragma("unroll") for (int blk = 0; blk < 2; ++blk) _Pragma("unroll") for (int s_ = 0; s_ < 2; ++s_) pf[PB][blk * 2 + s_] = sel8(blk <= rt, *(const bf16x8*)(pb_ + blk * 1024 + s_ * 512)); } while (0)
#define STEP_Q(c) do { const int bufc = (c) & 1; LBAR(); \
                LOAD_P((c), 0);                                                    \
                f32x16 acc; \
                _Pragma("unroll") for (int i = 0; i < 16; ++i) acc[i] = 0.f; \
                _Pragma("unroll") for (int blk = 0; blk < 4; ++blk) _Pragma("unroll") for (int s = 0; s < 2; ++s) \
                    acc = MFMA32(qf[0][blk * 2 + s], __builtin_bit_cast(bf16x8, Sfr[(bufc * 4 + blk) * 128 + s * 64 + lane]), acc); \
                if ((c) + 1 < NCH) LOAD_Q((c) + 1, 0);                             \
                LBAR(); \
                _Pragma("unroll") for (int r = 0; r < 16; ++r) acc[r] *= gam[bufc * 64 + 32 * rt + crow32(r, half)]; \
                _Pragma("unroll") for (int blk = 0; blk < 2; ++blk) _Pragma("unroll") for (int s = 0; s < 2; ++s) acc = MFMA32(pf[0][blk * 2 + s], __builtin_bit_cast(bf16x8, Dfr[(blk * 2 + s) * 64 + lane]), acc); \
                _Pragma("unroll") for (int r = 0; r < 16; ++r) { const int row = chunk_row(b, (c), 32 * rt + crow32(r, half)); if (row >= 0) OF[(size_t)row * DVW + h * 128 + 32 * q + m] = f2bf(acc[r]); } } while (0)
#ifndef NO_RQ
            LOAD_Q(0, 0);
            for (int c = 0; c < NCH; ++c) STEP_Q(c);
#endif
#undef LOAD_Q
#undef LOAD_P
#undef STEP_Q
        }
#undef ROT2
#undef ROT3
    }
    LBAR();
}
#undef LBAR
#undef MFMA32
template <int RT, int CT, class Epi>
__device__ __forceinline__ void small_gemm_unit(const bf16* A, int lda, const bf16* Bt, int ldb, int k0, int klen, LAS unsigned char* lds, const Epi& E, int tid, int wave, int lane) {
    const int r16 = lane & 15, q = lane >> 4;
    const int kw = klen >> 3;
    const bf16* ap = A + (size_t)r16 * lda + k0 + wave * kw + 8 * q;
    const bf16* bp = Bt + (size_t)r16 * ldb + k0 + wave * kw + 8 * q;
    pg8::f32x4 acc[RT][CT];
#pragma unroll
    for (int i = 0; i < RT; ++i)
#pragma unroll
        for (int j = 0; j < CT; ++j) acc[i][j] = (pg8::f32x4){0.f, 0.f, 0.f, 0.f};
#pragma unroll 4
    for (int ks = 0; ks < kw; ks += 32) {
        bf16x8 a[RT], b[CT];
#pragma unroll
        for (int i = 0; i < RT; ++i) a[i] = *(const bf16x8*)(ap + (size_t)(16 * i) * lda + ks);
#pragma unroll
        for (int j = 0; j < CT; ++j) b[j] = *(const bf16x8*)(bp + (size_t)(16 * j) * ldb + ks);
#pragma unroll
        for (int i = 0; i < RT; ++i)
#pragma unroll
            for (int j = 0; j < CT; ++j) acc[i][j] = __builtin_amdgcn_mfma_f32_16x16x32_bf16(a[i], b[j], acc[i][j], 0, 0, 0);
    }
    constexpr int NOUT = 256 * RT * CT;
    LAS float* part = (LAS float*)lds + wave * NOUT;
#pragma unroll
    for (int i = 0; i < RT; ++i)
#pragma unroll
        for (int j = 0; j < CT; ++j)
#pragma unroll
            for (int e = 0; e < 4; ++e) part[(16 * i + 4 * q + e) * (16 * CT) + 16 * j + r16] = acc[i][j][e];
    __syncthreads();
    for (int o = tid; o < NOUT; o += NTHREADS) { float sum = 0.f;
#pragma unroll
        for (int w = 0; w < 8; ++w) sum += ((LAS float*)lds)[w * NOUT + o];
        E(o / (16 * CT), o % (16 * CT), sum); }
    __syncthreads();
}
template <int ACT> struct SEpiRowsBf16 { bf16* O; int ldc; __device__ __forceinline__ void operator()(int row, int col, float v) const { if (ACT == 2) { v = v > 0.f ? v : 0.f; v = v * v; } O[(size_t)row * ldc + col] = f2bf(v); } };
struct SEpiF32 { float* O; int ldc; __device__ __forceinline__ void operator()(int row, int col, float v) const { O[(size_t)row * ldc + col] = v; } };
struct SEpiColsBf16 { bf16* O; int ldc; __device__ __forceinline__ void operator()(int row, int col, float v) const { O[(size_t)col * ldc + row] = f2bf(v); } };
template <int ACT> __device__ __forceinline__ void skinny_rows_bf16(const bf16* A, const bf16* Wt, int K, int nunits, bf16* O, int ldc, LAS unsigned char* lds, int tid, int wave, int lane) {
    for (int u = blockIdx.x; u < nunits; u += gridDim.x) { SEpiRowsBf16<ACT> E{O + (size_t)XROW0 * ldc + u * 64, ldc};
        small_gemm_unit<3, 4>(A + (size_t)XROW0 * K, K, Wt + (size_t)u * 64 * K, K, 0, K, lds, E, tid, wave, lane); }
}
__device__ __forceinline__ void skinny_rows_part(const bf16* A, const bf16* Wt, int K, float* ZP, LAS unsigned char* lds, int tid, int wave, int lane) {
    for (int u = blockIdx.x; u < 256; u += gridDim.x) { const int cgp = u & 31, ksl = u >> 5; SEpiF32 E{ZP + (size_t)ksl * XR * DM + cgp * 64, DM};
        small_gemm_unit<3, 4>(A + (size_t)XROW0 * K, K, Wt + (size_t)cgp * 64 * K, K, ksl * (K >> 3), K >> 3, lds, E, tid, wave, lane); }
}
template <int RT> __device__ __forceinline__ void tail_cols_bf16(const bf16* A, const bf16* Wt, int K, int c0, bf16* O, int ldc, LAS unsigned char* lds, int tid, int wave, int lane) {
    for (int u = blockIdx.x; u < MAINM / 32; u += gridDim.x) { SEpiColsBf16 E{O + (size_t)u * 32 * ldc + c0, ldc};
        small_gemm_unit<RT, 2>(Wt + (size_t)c0 * K, K, A + (size_t)u * 32 * K, K, 0, K, lds, E, tid, wave, lane); }
}

typedef __attribute__((address_space(4))) const unsigned long long* kargq_t;
#define KPF_(k) ((const float*)(const GAS float*)(q_[k]))
__device__ __forceinline__ void load_ptrs(Ptrs& P) {
    kargq_t q_ = (kargq_t)__builtin_amdgcn_kernarg_segment_ptr();
    asm volatile("" : "+s"(q_));
    P.x_prompt = KPF_(0); P.x_sample = KPF_(1); P.state_conv_a = KPF_(2); P.cache_k = KPF_(3);
    P.cache_v = KPF_(4); P.cache_ik = KPF_(5); P.state_conv_c = KPF_(6); P.state_delta = KPF_(7);
    P.page_table = ((const int*)(const GAS int*)(q_[8])); P.meta = KPF_(9); P.w_in_a = KPF_(10); P.conv_w_a = KPF_(11);
    P.w_out_a = KPF_(12); P.w_in_b = KPF_(13); P.w_out_b = KPF_(14); P.w_in_c = KPF_(15);
    P.conv_w_c = KPF_(16); P.a_log = KPF_(17); P.dt_bias = KPF_(18); P.norm_w = KPF_(19);
    P.w_out_c = KPF_(20); P.ln1_g = KPF_(21); P.ln1_b = KPF_(22); P.w1 = KPF_(23);
    P.w2 = KPF_(24); P.ln2_g = KPF_(25); P.ln2_b = KPF_(26);
    P.out = (float*)(GAS float*)(q_[27]); P.ws = (unsigned char*)(GAS unsigned char*)(q_[28]);
}
struct Args { const void* in[27]; float* out; unsigned char* ws; int ph_lo, ph_hi; };
constexpr int PH_PER_LAYER = 12, PH_END = 1 + 4 * PH_PER_LAYER;

__global__ void __launch_bounds__(NTHREADS, 2) mega_fwd(Args args) {
    extern __shared__ __attribute__((aligned(16))) unsigned char lds_raw[];
    LAS unsigned char* lds = (LAS unsigned char*)lds_raw;
    const int tid = threadIdx.x, lane = tid & 63, wave = __builtin_amdgcn_readfirstlane(tid >> 6);
    const int G_ = gridDim.x, NGW = G_ * NWAVES, NT = G_ * NTHREADS; (void)lane;
    unsigned char* ws = args.ws;
    const int lo = args.ph_lo, hi = args.ph_hi;
    const bool fused = (hi - lo) > 1;

    for (int u = tid; u < (LDS_BYTES - LDSCTL_OFF) / 4; u += NTHREADS) ((LAS unsigned*)(lds + LDSCTL_OFF))[u] = 0u;
    __syncthreads();
    volatile LAS unsigned* MISC = (volatile LAS unsigned*)(lds + MISC_OFF);
    XcdBarrier bar; bar.bar = (unsigned*)(ws + WS_CTL) + CW_BAR; bar.x = 0; bar.st = nullptr;
    if (fused) bar = xcd_barrier_post((unsigned*)(ws + WS_CTL) + CW_BAR, MISC + 8);
    bar.wv = wave;

#ifndef MK_SITES
#define MK_SITES 0xffffffffu
#endif
#define SITE(n) (((MK_SITES) >> (n)) & 1u)
#define IN(k) (lo <= (k) && (k) < hi)
#ifndef MK_DUP
#define MK_DUP 0u
#endif
#define NREP(n) ((((MK_DUP) >> (n)) & 1u) ? 2 : 1)
#ifdef MK_SKINNY2
#define SKREP 2
#else
#define SKREP 1
#endif
#define BEGIN_SITE(n, id) if (SITE(n) && IN(id)) { for (int rp_ = 0; rp_ < NREP(n); ++rp_) { Ptrs P; load_ptrs(P); unsigned char* ws = P.ws; (void)ws; \
    bf16* X = (bf16*)(P.ws + WS_X); float* Z = (float*)(P.ws + WS_Z); float* ZP = (float*)(P.ws + WS_ZP); bf16* Y = (bf16*)(P.ws + WS_Y); bf16* BIG = (bf16*)(P.ws + WS_BIG); (void)X; (void)Z; (void)ZP; (void)Y; (void)BIG;
#define END_SITE(id) SEAM(id); } }
#define LOCALS int tid_ = threadIdx.x; asm volatile("" : "+v"(tid_)); const int lane_ = tid_ & 63, wave_ = __builtin_amdgcn_readfirstlane(tid_ >> 6), gw_ = blockIdx.x * NWAVES + wave_, gtid_ = blockIdx.x * NTHREADS + tid_; (void)lane_; (void)wave_; (void)gw_; (void)gtid_
#define SEAM(k) do { if (fused && (k) + 1 < PH_END) xcd_barrier(bar); else __syncthreads(); } while (0)


    BEGIN_SITE(0, 0) LOCALS; p0_prologue(P, lds, gw_, NGW, wave_, lane_); END_SITE(0)
#ifdef MK_XBAR
    if (fused) { for (int xb_ = 0; xb_ < MK_XBAR; ++xb_) xcd_barrier(bar); }
#endif

    for (int layer = 0; layer < 4; ++layer) {
        const int kind = layer % 3, j = layer / 3, base = 1 + layer * PH_PER_LAYER;
        if (kind == 0) {
            BEGIN_SITE(1, base + 0)
                const bf16* Wt = (const bf16*)(ws + WS_WA_IN + (size_t)j * WSZ_A_IN); pg8::Gemm g{X, Wt, MAINM, NA_IN, DM}; pg8::StaticOrder S; S.init(MAINM, NA_IN, G_, (int)blockIdx.x);
                pg8::EpiBf16<0> E{BIG, NA_IN, nullptr, 0, 0, 1.f};
                pg8::gemm_phase<pg8::EpiBf16<0>, pg8::StaticOrder, true, true>(lds, g, S, E, wave);
                { LOCALS; for (int sk_ = 0; sk_ < SKREP; ++sk_) { skinny_rows_bf16<0>(X, Wt, DM, NA_IN / 64, BIG, NA_IN, lds, tid_, wave_, lane_); } }
                END_SITE(base + 0)
            BEGIN_SITE(2, base + 1)
                LOCALS; convA_phase(BIG, Y, P.conv_w_a + (size_t)j * 3 * DM, P.state_conv_a + (size_t)j * SBN * 2 * DM, P.out + O_CAP + (size_t)j * NBP * 2 * DM, P.out + O_CAS + (size_t)j * SBN * 2 * DM, gtid_, NT);
                END_SITE(base + 1)
            BEGIN_SITE(3, base + 2)
                const bf16* Wt = (const bf16*)(ws + WS_WA_OUT + (size_t)j * WSZ_A_OUT); pg8::Gemm g{Y, Wt, MAINM, DM, DM}; pg8::StaticOrder S; S.init(MAINM, DM, G_, (int)blockIdx.x);
                pg8::EpiResBf16 E{X, DM, ALPHA};
                pg8::gemm_phase<pg8::EpiResBf16, pg8::StaticOrder, true, true>(lds, g, S, E, wave);
                { LOCALS; for (int sk_ = 0; sk_ < SKREP; ++sk_) { skinny_rows_part(Y, Wt, DM, ZP, lds, tid_, wave_, lane_); } }
                END_SITE(base + 2)
        } else if (kind == 1) {
            BEGIN_SITE(4, base + 0)
                const bf16* Wt = (const bf16*)(ws + WS_WB_IN); pg8::Gemm g{X, Wt, MAINM, 4096, DM}; pg8::StaticOrder S; S.init(MAINM, 4096, G_, (int)blockIdx.x);
                pg8::EpiBf16<0> E{BIG, NB_PAD, nullptr, 0, 0, 1.f};
                pg8::gemm_phase<pg8::EpiBf16<0>, pg8::StaticOrder, true, true>(lds, g, S, E, wave);
                { LOCALS; for (int sk_ = 0; sk_ < SKREP; ++sk_) { tail_cols_bf16<5>(X, Wt, DM, 4096, BIG, NB_PAD, lds, tid_, wave_, lane_); skinny_rows_bf16<0>(X, Wt, DM, 4224 / 64, BIG, NB_PAD, lds, tid_, wave_, lane_); } }
                END_SITE(base + 0)
            BEGIN_SITE(5, base + 1) LOCALS; rope_phase(BIG, P, gw_, NGW, lane_); END_SITE(base + 1)
            BEGIN_SITE(6, base + 2) LOCALS; indexer_sample(P, lds, tid_); indexer_prompt(P, lds, tid_, wave_, lane_); END_SITE(base + 2)
            BEGIN_SITE(7, base + 3) LOCALS; select_phase(P, lds, gw_, NGW, tid_, wave_, lane_); END_SITE(base + 3)
            BEGIN_SITE(8, base + 4) LOCALS; dense_attn_phase(P, Y, (char*)lds_raw, wave_); attn_phase(P, Y, lds, gw_, NGW, wave_, lane_); END_SITE(base + 4)
            BEGIN_SITE(9, base + 5)
                const bf16* Wt = (const bf16*)(ws + WS_WB_OUT); pg8::Gemm g{Y, Wt, MAINM, DM, DM}; pg8::StaticOrder S; S.init(MAINM, DM, G_, (int)blockIdx.x);
                pg8::EpiResBf16 E{X, DM, ALPHA};
                pg8::gemm_phase<pg8::EpiResBf16, pg8::StaticOrder, true, true>(lds, g, S, E, wave);
                { LOCALS; for (int sk_ = 0; sk_ < SKREP; ++sk_) { skinny_rows_part(Y, Wt, DM, ZP, lds, tid_, wave_, lane_); } }
                END_SITE(base + 5)
        } else {
            BEGIN_SITE(10, base + 0)
                const bf16* Wt = (const bf16*)(ws + WS_WC_IN); pg8::Gemm g{X, Wt, MAINM, 12288, DM}; pg8::StaticOrder S; S.init(MAINM, 12288, G_, (int)blockIdx.x);
                pg8::EpiBf16<0> E{BIG, NC_PAD, nullptr, 0, 0, 1.f};
                pg8::gemm_phase<pg8::EpiBf16<0>, pg8::StaticOrder, true, true>(lds, g, S, E, wave);
                { LOCALS; for (int sk_ = 0; sk_ < SKREP; ++sk_) { tail_cols_bf16<4>(X, Wt, DM, 12288, BIG, NC_PAD, lds, tid_, wave_, lane_); skinny_rows_bf16<0>(X, Wt, DM, NC_IN / 64, BIG, NC_PAD, lds, tid_, wave_, lane_); } }
                END_SITE(base + 0)
            BEGIN_SITE(11, base + 1) LOCALS; convC_phase(BIG, P, gw_, NGW, lane_); END_SITE(base + 1)
            BEGIN_SITE(19, base + 2) LOCALS; delta_pre(P.ws, lds, gw_, NGW, wave_, lane_); delta_phase(P, wave_, lane_); END_SITE(base + 2)
            BEGIN_SITE(22, base + 5) LOCALS; delta_d4(P.ws, P.out + O_DP, lds, tid_, wave_, lane_); END_SITE(base + 5)
            BEGIN_SITE(13, base + 6) LOCALS; normC_phase(BIG, Y, P, gw_, NGW, lane_); END_SITE(base + 6)
            BEGIN_SITE(14, base + 7)
                const bf16* Wt = (const bf16*)(ws + WS_WC_OUT); pg8::Gemm g{Y, Wt, MAINM, DM, DVW}; pg8::StaticOrder S; S.init(MAINM, DM, G_, (int)blockIdx.x);
                pg8::EpiResBf16 E{X, DM, ALPHA};
                pg8::gemm_phase<pg8::EpiResBf16, pg8::StaticOrder, true, true>(lds, g, S, E, wave);
                { LOCALS; for (int sk_ = 0; sk_ < SKREP; ++sk_) { skinny_rows_part(Y, Wt, DVW, ZP, lds, tid_, wave_, lane_); } }
                END_SITE(base + 7)
        }
        BEGIN_SITE(15, base + 8) LOCALS; ln_phase(Z, ZP, X, rp_ == 0 ? X : (bf16*)(P.ws + WS_QR), P.ln1_g + (size_t)layer * DM, P.ln1_b + (size_t)layer * DM, nullptr, nullptr, gw_, NGW, lane_); END_SITE(base + 8)
        BEGIN_SITE(16, base + 9)
            const bf16* Wt = (const bf16*)(ws + WS_W1 + (size_t)layer * WSZ_W1); pg8::Gemm g{X, Wt, MAINM, FF, DM}; pg8::StaticOrder S; S.init(MAINM, FF, G_, (int)blockIdx.x);
            pg8::EpiBf16<2> E{BIG, FF, nullptr, 0, 0, 1.f};
            pg8::gemm_phase<pg8::EpiBf16<2>, pg8::StaticOrder, true, true>(lds, g, S, E, wave);
            { LOCALS; for (int sk_ = 0; sk_ < SKREP; ++sk_) { skinny_rows_bf16<2>(X, Wt, DM, FF / 64, BIG, FF, lds, tid_, wave_, lane_); } }
            END_SITE(base + 9)
        BEGIN_SITE(17, base + 10)
            const bf16* Wt = (const bf16*)(ws + WS_W2 + (size_t)layer * WSZ_W2); pg8::Gemm g{BIG, Wt, MAINM, DM, FF}; pg8::StaticOrder S; S.init(MAINM, DM, G_, (int)blockIdx.x);
            pg8::EpiResBf16 E{X, DM, ALPHA};
            pg8::gemm_phase<pg8::EpiResBf16, pg8::StaticOrder, true, true>(lds, g, S, E, wave);
            { LOCALS; for (int sk_ = 0; sk_ < SKREP; ++sk_) { skinny_rows_part(BIG, Wt, FF, ZP, lds, tid_, wave_, lane_); } }
            END_SITE(base + 10)
        BEGIN_SITE(18, base + 11)
            const bool last = layer == 3;
            LOCALS; ln_phase(Z, ZP, X, rp_ == 0 ? X : (bf16*)(P.ws + WS_QR), P.ln2_g + (size_t)layer * DM, P.ln2_b + (size_t)layer * DM, last ? P.out + O_YP : nullptr, last ? P.out + O_YS : nullptr, gw_, NGW, lane_);
            if (!last) SEAM(base + 11); } }
    }
#undef IN
#undef SEAM
}

#ifndef MK_SPLIT
#define MK_SPLIT 0
#endif
extern "C" void kernel_launch(void* const* d_in, const int* in_sizes, int n_in, void* d_out, int out_size, void* d_ws, size_t ws_size, hipStream_t stream) {
    static int grid = 0;
    if (grid == 0) {
        if (n_in != 27 || (size_t)out_size != O_END || ws_size < WS_END) { fprintf(stderr, "kernel_launch: unexpected shapes: n_in %d out %d (want %zu) ws %zu (want >= %zu)\n", n_in, out_size, (size_t)O_END, ws_size, (size_t)WS_END); grid = -1; return; }
        int dev = 0, cus = 0;
        if (hipGetDevice(&dev) != hipSuccess || hipDeviceGetAttribute(&cus, hipDeviceAttributeMultiprocessorCount, dev) != hipSuccess) { grid = -1; return; }
        if (hipFuncSetAttribute((const void*)mega_fwd, hipFuncAttributeMaxDynamicSharedMemorySize, LDS_BYTES) != hipSuccess) { fprintf(stderr, "kernel_launch: hipFuncSetAttribute failed\n"); grid = -1; return; }
        int per_cu = 0;
        if (hipOccupancyMaxActiveBlocksPerMultiprocessor(&per_cu, (const void*)mega_fwd, NTHREADS, LDS_BYTES) != hipSuccess || per_cu < 1) fprintf(stderr, "kernel_launch: occupancy query reports %d\n", per_cu);
        (void)hipGetLastError();
        grid = cus;
    }
    if (grid < 0) return;
    (void)hipMemsetAsync((char*)d_ws + WS_CTL, 0, CTL_ZERO_BYTES, stream);
    Args a{};
    for (int i = 0; i < 27; ++i) a.in[i] = d_in[i];
    a.out = (float*)d_out; a.ws = (unsigned char*)d_ws;
#if MK_SPLIT
    for (int ph = 0; ph < PH_END; ++ph) {
        bool exists = (ph == 0);
        if (ph > 0) { const int layer = (ph - 1) / PH_PER_LAYER, l = (ph - 1) % PH_PER_LAYER, kind = layer % 3; const int nmix = kind == 0 ? 3 : (kind == 1 ? 6 : 8); exists = (l < nmix) || (l >= 8 && l <= 11); }
        if (!exists) continue;
        a.ph_lo = ph; a.ph_hi = ph + 1;
        hipLaunchKernelGGL(mega_fwd, dim3(grid), dim3(NTHREADS), LDS_BYTES, stream, a);
    }
#else
    a.ph_lo = 0; a.ph_hi = PH_END;
    hipLaunchKernelGGL(mega_fwd, dim3(grid), dim3(NTHREADS), LDS_BYTES, stream, a);
#endif
    const hipError_t le = hipPeekAtLastError();
    if (le != hipSuccess) fprintf(stderr, "kernel_launch: launch failed: %s\n", hipGetErrorName(le));
}
```

```cpp
#include <hip/hip_runtime.h>
#include <cstdio>
#include <cstdint>
#include <cmath>
__device__ __forceinline__ int flane() { return (int)__builtin_amdgcn_mbcnt_hi(~0u, __builtin_amdgcn_mbcnt_lo(~0u, 0u)); }
namespace pg8 {
#define PG8_LAS __attribute__((address_space(3)))
typedef unsigned short bf16_t;
typedef short bf16x8 __attribute__((ext_vector_type(8)));
typedef float f32x4 __attribute__((ext_vector_type(4)));
typedef unsigned u32x4 __attribute__((ext_vector_type(4)));
constexpr int BM = 256, BK = 64, HALF = 128, HTB = HALF * BK * 2  , STAGE_BYTES = 8 * HTB, NXCD = 8, WGM = 8;

__host__ __device__ __forceinline__ int lds_byte(int r, int c) { const int st = (r >> 4) * 2 + (c >> 5), rr = r & 15, cc = c & 31, ob = rr * 64 + cc * 2; return st * 1024 + (ob ^ (((ob >> 9) & 1) << 5)); }
__host__ __device__ __forceinline__ void stage_rc(int b, int& R, int& C) { const int st = b / 1024, sb = b % 1024, swz = sb ^ (((sb >> 9) & 1) << 5); R = (st >> 1) * 16 + swz / 64; C = (st & 1) * 32 + (swz % 64) / 2; }
__host__ __device__ __forceinline__ int perm32(int rho) { const int n = rho >> 4, i = rho & 15; return 8 * (i >> 2) + 4 * n + (i & 3); }

struct Unit { int pm, pn; };
struct Gemm { const bf16_t* A; const bf16_t* Bt; int M, N, K; };

struct StaticOrder {
    int nM, nN, nwg, G, c;
    __host__ __device__ void init(int M, int N, int G_, int c_) { nM = M / BM; nN = N / BM; nwg = nM * nN; G = G_; c = c_; }
    __host__ __device__ bool next(int i, Unit& u) const {
        const long L = (long)i * G + c; if (L >= nwg) return false;
        int wgid = (int)L; { const int q = nwg / NXCD, r = nwg % NXCD, xcd = wgid % NXCD, off = wgid / NXCD; wgid = (xcd < r ? xcd * (q + 1) : r * (q + 1) + (xcd - r) * q) + off; }
        const int nig = WGM * nN, gid = wgid / nig, fm = gid * WGM, gsz = (nM - fm) < WGM ? (nM - fm) : WGM;
        u.pm = fm + ((wgid % nig) % gsz); u.pn = (wgid % nig) / gsz; return true;
    }
    __device__ __forceinline__ void a_ready(const Unit&) const {}
    __device__ __forceinline__ void done(const Unit&) const {}
};

__device__ __forceinline__ unsigned cvt_pk_bf16(float lo, float hi) { unsigned r; asm volatile("v_cvt_pk_bf16_f32 %0, %1, %2" : "=v"(r) : "v"(lo), "v"(hi)); return r; }
typedef float f32x2 __attribute__((ext_vector_type(2)));
__device__ __forceinline__ f32x2 gelu_pk(f32x2 v) {
    const f32x2 av = __builtin_elementwise_abs(v), d = av * 0.2316418882f + 1.0f;
    f32x2 t; t.x = __builtin_amdgcn_rcpf(d.x); t.y = __builtin_amdgcn_rcpf(d.y);
    f32x2 q = t * 0.5307027145f + (-0.7265760135f); q = q * t + 0.7107068705f; q = q * t + (-0.142248368f); q = q * t + 0.127414796f; q = q * t;
    const f32x2 s = (v * v) * (-0.72134752044f);
    f32x2 e; e.x = __builtin_amdgcn_exp2f(s.x); e.y = __builtin_amdgcn_exp2f(s.y);
    const f32x2 m = v * (q * e), r = v - m;
    f32x2 o; o.x = v.x < 0.f ? m.x : r.x; o.y = v.y < 0.f ? m.y : r.y; return o;
}

template <int ACT  > struct EpiBf16 {
    static constexpr bool PERM = true, AFTER_DRAIN = false; static_assert(ACT == 0 || ACT == 1 || ACT == 2, "EpiBf16: ACT is 0 (none), 1 (gelu_pk) or 2 (relu^2)");
    bf16_t* O; int ldc; const float* bias; int split_cols; size_t split_stride; float scale0;
    __device__ __forceinline__ void operator()(const f32x4 (&acc)[2][2][4][2], const Unit& u, int wr, int wc, int fr, int fq) const {
        const int row0 = u.pm * BM + wr * 64 + fr; int colt = u.pn * BM; bf16_t* base = O;
        float sc = 1.f; if (split_cols) { const int t = colt / split_cols; base += (size_t)t * split_stride; colt -= t * split_cols; if (t == 0) sc = scale0; }
        const int col0 = colt + wc * 32 + 8 * fq, bcol0 = u.pn * BM + wc * 32 + 8 * fq;
        f32x4 bv[2][2];
#pragma unroll
        for (int bj = 0; bj < 2; ++bj)
#pragma unroll
            for (int n = 0; n < 2; ++n) bv[bj][n] = bias ? *(const f32x4*)(bias + bcol0 + bj * HALF + 4 * n) : (f32x4){0.f, 0.f, 0.f, 0.f};
#pragma unroll
        for (int ai = 0; ai < 2; ++ai)
#pragma unroll
            for (int m = 0; m < 4; ++m) { bf16_t* rowp = base + (size_t)(row0 + ai * HALF + m * 16) * ldc + col0;
#pragma unroll
                for (int bj = 0; bj < 2; ++bj) { f32x4 v0 = acc[ai][bj][m][0] + bv[bj][0], v1 = acc[ai][bj][m][1] + bv[bj][1];
                    if (ACT == 1) { f32x2 a = gelu_pk((f32x2){v0[0], v0[1]}), b = gelu_pk((f32x2){v0[2], v0[3]}), c = gelu_pk((f32x2){v1[0], v1[1]}), d = gelu_pk((f32x2){v1[2], v1[3]});
                        v0 = (f32x4){a.x, a.y, b.x, b.y}; v1 = (f32x4){c.x, c.y, d.x, d.y}; }
                    if (ACT == 2) { _Pragma("unroll") for (int q_ = 0; q_ < 4; ++q_) { const float a_ = v0[q_] > 0.f ? v0[q_] : 0.f, b_ = v1[q_] > 0.f ? v1[q_] : 0.f; v0[q_] = a_ * a_; v1[q_] = b_ * b_; } }
                    v0 = v0 * sc; v1 = v1 * sc; u32x4 w; w.x = cvt_pk_bf16(v0[0], v0[1]); w.y = cvt_pk_bf16(v0[2], v0[3]); w.z = cvt_pk_bf16(v1[0], v1[1]); w.w = cvt_pk_bf16(v1[2], v1[3]);
                    *(u32x4*)(rowp + bj * HALF) = w; } }
    }
};


struct EpiResBf16 {
    static constexpr bool PERM = true, AFTER_DRAIN = false;
    bf16_t* X; int ldc; float alpha;
    __device__ __forceinline__ void operator()(const f32x4 (&acc)[2][2][4][2], const Unit& u, int wr, int wc, int fr, int fq) const {
        const int row0 = u.pm * BM + wr * 64 + fr, col0 = u.pn * BM + wc * 32 + 8 * fq;
#pragma unroll
        for (int ai = 0; ai < 2; ++ai) {
            u32x4 xin[4][2];
#pragma unroll
            for (int m = 0; m < 4; ++m)
#pragma unroll
                for (int bj = 0; bj < 2; ++bj) xin[m][bj] = *(const u32x4*)(X + (size_t)(row0 + ai * HALF + m * 16) * ldc + col0 + bj * HALF);
#pragma unroll
            for (int m = 0; m < 4; ++m) { bf16_t* rowp = X + (size_t)(row0 + ai * HALF + m * 16) * ldc + col0;
#pragma unroll
                for (int bj = 0; bj < 2; ++bj) { const u32x4 xi = xin[m][bj]; const f32x4 a0 = acc[ai][bj][m][0], a1 = acc[ai][bj][m][1];
                    float x[8] = {__uint_as_float(xi.x << 16), __uint_as_float(xi.x & 0xffff0000u), __uint_as_float(xi.y << 16), __uint_as_float(xi.y & 0xffff0000u),
                                  __uint_as_float(xi.z << 16), __uint_as_float(xi.z & 0xffff0000u), __uint_as_float(xi.w << 16), __uint_as_float(xi.w & 0xffff0000u)};
                    u32x4 w; w.x = cvt_pk_bf16(alpha * x[0] + a0[0], alpha * x[1] + a0[1]); w.y = cvt_pk_bf16(alpha * x[2] + a0[2], alpha * x[3] + a0[3]);
                    w.z = cvt_pk_bf16(alpha * x[4] + a1[0], alpha * x[5] + a1[1]); w.w = cvt_pk_bf16(alpha * x[6] + a1[2], alpha * x[7] + a1[3]);
                    *(u32x4*)(rowp + bj * HALF) = w; } }
        }
    }
};

struct EpiF32 {
    static constexpr bool PERM = false, AFTER_DRAIN = false;
    float* C; int ldc;
    __device__ __forceinline__ void operator()(const f32x4 (&acc)[2][2][4][2], const Unit& u, int wr, int wc, int fr, int fq) const {
        const int row0 = u.pm * BM + wr * 64 + fr, col0 = u.pn * BM + wc * 32 + 4 * fq;
#pragma unroll
        for (int ai = 0; ai < 2; ++ai)
#pragma unroll
            for (int m = 0; m < 4; ++m) { float* rowp = C + (size_t)(row0 + ai * HALF + m * 16) * ldc + col0;
#pragma unroll
                for (int bj = 0; bj < 2; ++bj)
#pragma unroll
                    for (int n = 0; n < 2; ++n) *(f32x4*)(rowp + bj * HALF + n * 16) = acc[ai][bj][m][n]; }
    }
};
struct PanelStats {
    unsigned* xbuf;
    unsigned* cnt;
    unsigned* tmo;
    int ntn; float eps;
    unsigned code;
    __device__ __forceinline__ bool run(const f32x4 (&v)[2][2][4][2], const Unit& u, int wr, int wc, int fr, int fq, PG8_LAS unsigned char* lds, int wid, int lane) const {
        typedef float f32x2v __attribute__((ext_vector_type(2)));
        PG8_LAS f32x2v* P = (PG8_LAS f32x2v*)lds;
        PG8_LAS f32x2v* S = (PG8_LAS f32x2v*)(lds + 8192);
        PG8_LAS unsigned* flag = (PG8_LAS unsigned*)(lds + 8192 + 2048);
#pragma unroll
        for (int ai = 0; ai < 2; ++ai)
#pragma unroll
            for (int m = 0; m < 4; ++m) {
                float s = 0.f;
#pragma unroll
                for (int bj = 0; bj < 2; ++bj)
#pragma unroll
                    for (int n = 0; n < 2; ++n) { const f32x4 x = v[ai][bj][m][n]; s += (x[0] + x[1]) + (x[2] + x[3]); }
                s += __shfl_xor(s, 16); s += __shfl_xor(s, 32);
                const float mw = s * (1.0f / 64.0f); float q = 0.f;
#pragma unroll
                for (int bj = 0; bj < 2; ++bj)
#pragma unroll
                    for (int n = 0; n < 2; ++n) { const f32x4 d = v[ai][bj][m][n] - mw; q += (d[0] * d[0] + d[1] * d[1]) + (d[2] * d[2] + d[3] * d[3]); }
                q += __shfl_xor(q, 16); q += __shfl_xor(q, 32);
                if (fq == 0) P[(ai * HALF + wr * 64 + m * 16 + fr) * 4 + wc] = (f32x2v){mw, q};
            }
        asm volatile("s_waitcnt lgkmcnt(0)" ::: "memory"); __builtin_amdgcn_s_barrier(); asm volatile("" ::: "memory");
#if defined(BROKEN_EXCHANGE_NO_WAIT)
#warning BROKEN CONTROL BUILD: the row-statistics exchange does not wait; results are wrong by design
        if (blockIdx.x >= 64) { const long long t0_ = clock64(); while (clock64() - t0_ < 60000) __builtin_amdgcn_s_sleep(8); }
#endif
        const int row = wid * 32 + (lane & 31);
        if (lane < 32) {
            const f32x2v a = P[row * 4 + 0], b = P[row * 4 + 1], c = P[row * 4 + 2], d = P[row * 4 + 3];
            const float mt = (a.x + b.x + c.x + d.x) * 0.25f;
            const float da = a.x - mt, db = b.x - mt, dc = c.x - mt, dd = d.x - mt;
            const float m2 = (a.y + b.y) + (c.y + d.y) + 64.0f * ((da * da + db * db) + (dc * dc + dd * dd));
            unsigned long long* slot = (unsigned long long*)xbuf + ((size_t)(u.pm * BM + row) * 4 + u.pn);
            __hip_atomic_store(slot, ((unsigned long long)__float_as_uint(m2) << 32) | __float_as_uint(mt), __ATOMIC_RELAXED, __HIP_MEMORY_SCOPE_AGENT);
        }
        asm volatile("s_waitcnt vmcnt(0)" ::: "memory");
        if (lane == 0) __hip_atomic_fetch_add(cnt + 64 * u.pm, 1u, __ATOMIC_RELAXED, __HIP_MEMORY_SCOPE_AGENT);
        if (wid == 0) {
            bool dead = false; const unsigned long long t0 = __builtin_amdgcn_s_memrealtime(); const unsigned want = 8u * (unsigned)ntn;
            for (;;) {
#if defined(BROKEN_EXCHANGE_NO_WAIT)
                break;
#endif
                if ((unsigned)__builtin_amdgcn_readfirstlane(__hip_atomic_load(cnt + 64 * u.pm, __ATOMIC_RELAXED, __HIP_MEMORY_SCOPE_AGENT)) >= want) break;
                if (__builtin_amdgcn_s_memrealtime() - t0 > 2000000ull) {
                    if (lane == 0) { unsigned expect = 0u; __hip_atomic_compare_exchange_strong(tmo + 1, &expect, code | (unsigned)(u.pm & 0xff), __ATOMIC_RELAXED, __ATOMIC_RELAXED, __HIP_MEMORY_SCOPE_AGENT);
                                     __hip_atomic_store(tmo, 1u, __ATOMIC_RELAXED, __HIP_MEMORY_SCOPE_AGENT); }
                    dead = true; break; }
                __builtin_amdgcn_s_sleep(2);
            }
            __builtin_amdgcn_fence(__ATOMIC_ACQUIRE, "agent");
            if (lane == 0) flag[0] = dead ? 1u : 0u;
        }
        asm volatile("s_waitcnt vmcnt(0) lgkmcnt(0)" ::: "memory"); __builtin_amdgcn_s_barrier(); asm volatile("" ::: "memory");
        const bool bad = flag[0] != 0u;
        if (lane < 32) {
            const unsigned long long* slot = (const unsigned long long*)xbuf + (size_t)(u.pm * BM + row) * 4; float mt[4], m2[4]; float ms = 0.f;
#pragma unroll
            for (int t = 0; t < 4; ++t) { if (t < ntn) { const unsigned long long w = __hip_atomic_load(slot + t, __ATOMIC_RELAXED, __HIP_MEMORY_SCOPE_AGENT); mt[t] = __uint_as_float((unsigned)w); m2[t] = __uint_as_float((unsigned)(w >> 32)); } else { mt[t] = 0.f; m2[t] = 0.f; } ms += mt[t]; }
            const float mean = ms / (float)ntn; float q = 0.f;
#pragma unroll
            for (int t = 0; t < 4; ++t) if (t < ntn) { const float dm = mt[t] - mean; q += m2[t] + 256.0f * dm * dm; }
            S[row] = (f32x2v){mean, 1.0f / sqrtf(q / (256.0f * (float)ntn) + eps)};
        }
        asm volatile("s_waitcnt lgkmcnt(0)" ::: "memory"); __builtin_amdgcn_s_barrier(); asm volatile("" ::: "memory");
        return bad;
    }
};
struct EpiLnRes {
    static constexpr bool PERM = false, AFTER_DRAIN = true;
    const float* base; float* out; int ldc; const float* bias; PanelStats st; unsigned poison;
    __device__ __forceinline__ void fused(f32x4 (&acc)[2][2][4][2], const Unit& u, int wr, int wc, int fr, int fq, PG8_LAS unsigned char* lds, int wid, int lane) const {
        typedef float f32x2v __attribute__((ext_vector_type(2)));
        const PG8_LAS f32x2v* S = (const PG8_LAS f32x2v*)(lds + 8192);
        const int col0 = u.pn * BM + wc * 32 + 4 * fq;
#pragma unroll
        for (int bj = 0; bj < 2; ++bj)
#pragma unroll
            for (int n = 0; n < 2; ++n) { const f32x4 bv = bias ? *(const f32x4*)(bias + col0 + bj * HALF + n * 16) : (f32x4){0.f, 0.f, 0.f, 0.f};
#pragma unroll
                for (int ai = 0; ai < 2; ++ai)
#pragma unroll
                    for (int m = 0; m < 4; ++m) acc[ai][bj][m][n] += bv; }
        f32x4 pre[4][2][2];
#pragma unroll
        for (int m = 0; m < 4; ++m) { const size_t off = (size_t)(u.pm * BM + wr * 64 + m * 16 + fr) * ldc + col0;
#pragma unroll
            for (int bj = 0; bj < 2; ++bj)
#pragma unroll
                for (int n = 0; n < 2; ++n) pre[m][bj][n] = *(const f32x4*)(base + off + bj * HALF + n * 16); }
        const bool bad = st.run(acc, u, wr, wc, fr, fq, lds, wid, lane) || poison != 0u;
        const float qnan = __builtin_nanf("");
#pragma unroll
        for (int ai = 0; ai < 2; ++ai)
#pragma unroll
            for (int m = 0; m < 4; ++m) { const int r = ai * HALF + wr * 64 + m * 16 + fr; const f32x2v sr = S[r]; const size_t off = (size_t)(u.pm * BM + r) * ldc + col0;
#pragma unroll
                for (int bj = 0; bj < 2; ++bj)
#pragma unroll
                    for (int n = 0; n < 2; ++n) { const f32x4 bs = ai == 0 ? pre[m][bj][n] : *(const f32x4*)(base + off + bj * HALF + n * 16); f32x4 o = bs + (acc[ai][bj][m][n] - sr.x) * sr.y;
                        if (bad) o = (f32x4){qnan, qnan, qnan, qnan}; *(f32x4*)(out + off + bj * HALF + n * 16) = o; }
                if (m & 1) asm volatile("" ::: "memory"); }
    }
};
struct EpiLnResLn {
    static constexpr bool PERM = false, AFTER_DRAIN = true;
    const float* base; float* out; bf16_t* xn; int ldc; const float* bias; PanelStats st1, st2; unsigned poison;
    __device__ __forceinline__ void fused(f32x4 (&acc)[2][2][4][2], const Unit& u, int wr, int wc, int fr, int fq, PG8_LAS unsigned char* lds, int wid, int lane) const {
        typedef float f32x2v __attribute__((ext_vector_type(2))); typedef unsigned u32x2v __attribute__((ext_vector_type(2)));
        const PG8_LAS f32x2v* S = (const PG8_LAS f32x2v*)(lds + 8192);
        const int col0 = u.pn * BM + wc * 32 + 4 * fq;
#pragma unroll
        for (int bj = 0; bj < 2; ++bj)
#pragma unroll
            for (int n = 0; n < 2; ++n) { const f32x4 bv = bias ? *(const f32x4*)(bias + col0 + bj * HALF + n * 16) : (f32x4){0.f, 0.f, 0.f, 0.f};
#pragma unroll
                for (int ai = 0; ai < 2; ++ai)
#pragma unroll
                    for (int m = 0; m < 4; ++m) acc[ai][bj][m][n] += bv; }
        bool bad = st1.run(acc, u, wr, wc, fr, fq, lds, wid, lane) || poison != 0u;
        const float qnan = __builtin_nanf("");
#pragma unroll
        for (int ai = 0; ai < 2; ++ai)
#pragma unroll
            for (int m = 0; m < 4; ++m) { const int r = ai * HALF + wr * 64 + m * 16 + fr; const f32x2v sr = S[r]; const size_t off = (size_t)(u.pm * BM + r) * ldc + col0;
#pragma unroll
                for (int bj = 0; bj < 2; ++bj)
#pragma unroll
                    for (int n = 0; n < 2; ++n) { const f32x4 bs = *(const f32x4*)(base + off + bj * HALF + n * 16); acc[ai][bj][m][n] = bs + (acc[ai][bj][m][n] - sr.x) * sr.y; }
                asm volatile("" : "+v"(acc[ai][0][m][0]), "+v"(acc[ai][0][m][1]), "+v"(acc[ai][1][m][0]), "+v"(acc[ai][1][m][1]));
                if (m & 1) asm volatile("" ::: "memory"); }
        const bool bad1 = bad;
        bad = st2.run(acc, u, wr, wc, fr, fq, lds, wid, lane) || bad;
#pragma unroll
        for (int ai = 0; ai < 2; ++ai)
#pragma unroll
            for (int m = 0; m < 4; ++m) { const int r = ai * HALF + wr * 64 + m * 16 + fr; const f32x2v sr = S[r]; const size_t off = (size_t)(u.pm * BM + r) * ldc + col0;
#pragma unroll
                for (int bj = 0; bj < 2; ++bj)
#pragma unroll
                    for (int n = 0; n < 2; ++n) { const f32x4 x1 = acc[ai][bj][m][n]; *(f32x4*)(out + off + bj * HALF + n * 16) = bad1 ? (f32x4){qnan, qnan, qnan, qnan} : x1;
                        const f32x4 o = (x1 - sr.x) * sr.y; u32x2v w; w.x = cvt_pk_bf16(o[0], o[1]); w.y = cvt_pk_bf16(o[2], o[3]);
                        if (bad) { w.x = 0x7fc07fc0u; w.y = 0x7fc07fc0u; } *(u32x2v*)(xn + off + bj * HALF + n * 16) = w; }
                asm volatile("" ::: "memory"); }
    }
};

template <class Epi, class Sched, bool ALIGN_EPI = false, bool SP2 = false>
__device__ __forceinline__ void gemm_phase(PG8_LAS unsigned char* lds, const Gemm g, const Sched& S, const Epi& E, int wv) {
    int tid0_ = threadIdx.x; asm volatile("" : "+v"(tid0_)); (void)wv;
    const int tid = tid0_, wid = __builtin_amdgcn_readfirstlane(tid >> 6), lane = tid & 63, wr = wid >> 2, wc = wid & 3, fr = lane & 15, fq = lane >> 4;
    const int K = g.K, nt = K / BK;
    unsigned voffA[2], voffB[2];
#pragma unroll
    for (int i = 0; i < 2; ++i) { int R, C; stage_rc(tid * 16 + i * 8192, R, C); const int Rb = Epi::PERM ? ((R & ~31) + perm32(R & 31)) : R;
        voffA[i] = (unsigned)(R * K + C) * 2u; voffB[i] = (unsigned)(Rb * K + C) * 2u; }
    const size_t kstep = (size_t)(BK * 2);
    const size_t hstep = (size_t)HALF * K * 2;
    const size_t tstep = 2 * hstep;
    const unsigned ldsw = (unsigned)wid * 1024u;
    const int aoff = lds_byte(wr * 64 + fr, fq * 8), boff = lds_byte(wc * 32 + fr, fq * 8);
#define PG8_SA(b, h) (((b) * 2 + (h)) * HTB)
#define PG8_SB(b, h) ((4 + (b) * 2 + (h)) * HTB)
#define PG8_STAGE(bufoff, gbase, voff) do { _Pragma("unroll") for (int _i = 0; _i < 2; ++_i) \
        __builtin_amdgcn_global_load_lds((const unsigned*)((const char*)(gbase) + (voff)[_i]), (PG8_LAS unsigned*)(lds + (bufoff) + ldsw + _i * 8192), 16, 0, 0); } while (0)
#define PG8_LDA(dst, b, h) do { _Pragma("unroll") for (int m = 0; m < 4; ++m) _Pragma("unroll") for (int k = 0; k < 2; ++k) dst[m][k] = *(const PG8_LAS bf16x8*)(lds + PG8_SA(b, h) + aoff + m * 2048 + k * 1024); } while (0)
#define PG8_LDB(dst, b, h) do { _Pragma("unroll") for (int n = 0; n < 2; ++n) _Pragma("unroll") for (int k = 0; k < 2; ++k) dst[n][k] = *(const PG8_LAS bf16x8*)(lds + PG8_SB(b, h) + boff + n * 2048 + k * 1024); } while (0)
#define PG8_MMA(ai, bj, At, Bt) do { __builtin_amdgcn_s_setprio(1); _Pragma("unroll") for (int m = 0; m < 4; ++m) _Pragma("unroll") for (int n = 0; n < 2; ++n) _Pragma("unroll") for (int k = 0; k < 2; ++k) \
        acc[ai][bj][m][n] = __builtin_amdgcn_mfma_f32_16x16x32_bf16(Bt[n][k], At[m][k], acc[ai][bj][m][n], 0, 0, 0); __builtin_amdgcn_s_setprio(0); } while (0)
#define PG8_WAIT_V(n) asm volatile("s_waitcnt vmcnt(" #n ")" ::: "memory")
#define PG8_WAIT_L(n) asm volatile("s_waitcnt lgkmcnt(" #n ")" ::: "memory")
#define PG8_BAR __builtin_amdgcn_s_barrier()
#define PG8_SCHED __builtin_amdgcn_sched_barrier(0)
    Unit cur, nxt; int ui = 0;
    if (!S.next(0, cur)) return;
    f32x4 acc[2][2][4][2];
#pragma unroll
    for (int a = 0; a < 2; ++a)
#pragma unroll
        for (int b = 0; b < 2; ++b)
#pragma unroll
            for (int m = 0; m < 4; ++m)
#pragma unroll
                for (int n = 0; n < 2; ++n) acc[a][b][m][n] = (f32x4){0.f, 0.f, 0.f, 0.f};
    bf16x8 At[4][2], B0[2][2], B1[2][2];
    const char* cA = (const char*)g.A + (size_t)cur.pm * tstep; const char* cB = (const char*)g.Bt + (size_t)cur.pn * tstep;
    S.a_ready(cur);
    if constexpr (SP2) {
        PG8_STAGE(PG8_SB(0, 0), cB, voffB); PG8_STAGE(PG8_SB(0, 1), cB + hstep, voffB); PG8_STAGE(PG8_SA(0, 0), cA, voffA); PG8_STAGE(PG8_SA(0, 1), cA + hstep, voffA);
        if (wr == 1) PG8_BAR;
        PG8_WAIT_V(2); PG8_BAR;
        PG8_STAGE(PG8_SB(1, 0), cB + kstep, voffB); PG8_STAGE(PG8_SA(1, 0), cA + kstep, voffA); PG8_STAGE(PG8_SB(1, 1), cB + hstep + kstep, voffB);
        PG8_WAIT_V(6); PG8_BAR;
    } else {
        PG8_STAGE(PG8_SB(0, 0), cB, voffB); PG8_STAGE(PG8_SA(0, 0), cA, voffA); PG8_STAGE(PG8_SB(0, 1), cB + hstep, voffB); PG8_STAGE(PG8_SA(0, 1), cA + hstep, voffA);
        if (wr == 1) PG8_BAR;
        PG8_WAIT_V(4); PG8_BAR;
        PG8_STAGE(PG8_SB(1, 0), cB + kstep, voffB); PG8_STAGE(PG8_SA(1, 0), cA + kstep, voffA); PG8_STAGE(PG8_SB(1, 1), cB + hstep + kstep, voffB);
        PG8_WAIT_V(6); PG8_BAR;
    }
    for (;;) {
        const bool has_next = S.next(ui + 1, nxt);
        const char* nA = has_next ? (const char*)g.A + (size_t)nxt.pm * tstep : cA; const char* nB = has_next ? (const char*)g.Bt + (size_t)nxt.pn * tstep : cB;
        for (int t = 0; t < nt; t += 2) {
            const bool last = (t == nt - 2);
            const char* a1 = cA + (size_t)(t + 1) * kstep;
            const char* a2 = last ? nA : cA + (size_t)(t + 2) * kstep; const char* b2 = last ? nB : cB + (size_t)(t + 2) * kstep;
            const char* a3 = a2 + kstep; const char* b3 = b2 + kstep;
            if (last && has_next) S.a_ready(nxt);
            if constexpr (SP2) {
            PG8_LDB(B0, 0, 0); PG8_LDB(B1, 0, 1); PG8_SCHED; PG8_LDA(At, 0, 0); PG8_STAGE(PG8_SA(1, 1), a1 + hstep, voffA);
            PG8_WAIT_V(8); PG8_WAIT_L(0); PG8_BAR; PG8_MMA(0, 0, At, B0); PG8_MMA(0, 1, At, B1); PG8_BAR; PG8_SCHED;
            PG8_LDA(At, 0, 1); PG8_STAGE(PG8_SB(0, 0), b2, voffB); PG8_STAGE(PG8_SB(0, 1), b2 + hstep, voffB); PG8_STAGE(PG8_SA(0, 0), a2, voffA);
            PG8_WAIT_V(8); PG8_WAIT_L(0); PG8_BAR; PG8_MMA(1, 0, At, B0); PG8_MMA(1, 1, At, B1); PG8_BAR; PG8_SCHED;
            PG8_LDB(B0, 1, 0); PG8_LDB(B1, 1, 1); PG8_SCHED; PG8_LDA(At, 1, 0); PG8_STAGE(PG8_SA(0, 1), a2 + hstep, voffA);
            PG8_WAIT_V(8); PG8_WAIT_L(0); PG8_BAR; PG8_MMA(0, 0, At, B0); PG8_MMA(0, 1, At, B1); PG8_BAR; PG8_SCHED;
            PG8_LDA(At, 1, 1); PG8_STAGE(PG8_SB(1, 0), b3, voffB); PG8_STAGE(PG8_SB(1, 1), b3 + hstep, voffB); PG8_STAGE(PG8_SA(1, 0), a3, voffA);
            PG8_WAIT_V(8); PG8_WAIT_L(0); PG8_BAR; PG8_MMA(1, 0, At, B0); PG8_MMA(1, 1, At, B1); PG8_BAR; PG8_SCHED;
            } else {
            PG8_LDB(B0, 0, 0); PG8_SCHED; PG8_LDA(At, 0, 0); PG8_STAGE(PG8_SA(1, 1), a1 + hstep, voffA);
            PG8_WAIT_L(8); PG8_BAR; PG8_WAIT_L(0); PG8_MMA(0, 0, At, B0); PG8_BAR; PG8_SCHED;
            PG8_LDB(B1, 0, 1); PG8_STAGE(PG8_SB(0, 0), b2, voffB);
            PG8_BAR; PG8_WAIT_L(0); PG8_MMA(0, 1, At, B1); PG8_BAR;
            PG8_LDA(At, 0, 1); PG8_STAGE(PG8_SA(0, 0), a2, voffA);
            PG8_BAR; PG8_WAIT_L(0); PG8_MMA(1, 0, At, B0); PG8_BAR; PG8_SCHED;
            PG8_STAGE(PG8_SB(0, 1), b2 + hstep, voffB);
            PG8_WAIT_V(6); PG8_BAR; PG8_MMA(1, 1, At, B1); PG8_BAR;
            PG8_LDB(B0, 1, 0); PG8_SCHED; PG8_LDA(At, 1, 0); PG8_STAGE(PG8_SA(0, 1), a2 + hstep, voffA);
            PG8_WAIT_L(8); PG8_BAR; PG8_WAIT_L(0); PG8_MMA(0, 0, At, B0); PG8_BAR; PG8_SCHED;
            PG8_LDB(B1, 1, 1); PG8_STAGE(PG8_SB(1, 0), b3, voffB);
            PG8_BAR; PG8_WAIT_L(0); PG8_MMA(0, 1, At, B1); PG8_BAR;
            PG8_LDA(At, 1, 1); PG8_STAGE(PG8_SA(1, 0), a3, voffA);
            PG8_BAR; PG8_WAIT_L(0); PG8_MMA(1, 0, At, B0); PG8_BAR; PG8_SCHED;
            PG8_STAGE(PG8_SB(1, 1), b3 + hstep, voffB);
            PG8_WAIT_V(6); PG8_BAR; PG8_MMA(1, 1, At, B1); PG8_BAR;
            }
        }
        if constexpr (ALIGN_EPI) { if (wr == 0) PG8_BAR; }
        if constexpr (!Epi::AFTER_DRAIN) { E(acc, cur, wr, wc, fr, fq); S.done(cur); }
        if (!has_next) break;
#pragma unroll
        for (int a = 0; a < 2; ++a)
#pragma unroll
            for (int b = 0; b < 2; ++b)
#pragma unroll
                for (int m = 0; m < 4; ++m)
#pragma unroll
                    for (int n = 0; n < 2; ++n) acc[a][b][m][n] = (f32x4){0.f, 0.f, 0.f, 0.f};
        cur = nxt; cA = nA; cB = nB; ++ui;
        if constexpr (ALIGN_EPI) { if (wr == 1) PG8_BAR; }
    }
    PG8_WAIT_V(0);
    if constexpr (!ALIGN_EPI) { if (wr == 0) PG8_BAR; }
    PG8_BAR;
    if constexpr (Epi::AFTER_DRAIN) { E.fused(acc, cur, wr, wc, fr, fq, lds, wid, lane); S.done(cur); }
#undef PG8_SA
#undef PG8_SB
#undef PG8_STAGE
#undef PG8_LDA
#undef PG8_LDB
#undef PG8_MMA
#undef PG8_WAIT_V
#undef PG8_WAIT_L
#undef PG8_BAR
#undef PG8_SCHED
}
}

#ifndef PG8_SP2
#define PG8_SP2 true
#endif
#ifndef PG8_ALIGN
#define PG8_ALIGN true
#endif
#define GAS __attribute__((address_space(1)))
#define LAS __attribute__((address_space(3)))
#define XB_TMO      128
#define XB_XCNT(j)  (256  + 64 * (j))
#define XB_XSUB(j)  (1280 + 64 * (j))
#define XB_XGEN(j)  (2304 + 64 * (j))
#define XB_TOP      3328
#define XB_TOPGEN   3392
#define XCD_BAR_WORDS 3456
#define XB_SPIN_CAP (1u << 18)

__device__ __forceinline__ unsigned xb_ld(unsigned* p)              { return __hip_atomic_load(p, __ATOMIC_RELAXED, __HIP_MEMORY_SCOPE_AGENT); }
__device__ __forceinline__ unsigned xb_add(unsigned* p, unsigned v) { return __hip_atomic_fetch_add(p, v, __ATOMIC_RELAXED, __HIP_MEMORY_SCOPE_AGENT); }
__device__ __forceinline__ unsigned xb_xcc_id() { return (unsigned)__builtin_amdgcn_s_getreg((3 << 11) | 20) & 0xFu; }
#define XB_SPIN(cond, bar) do { unsigned _sp = 0; while (cond) { __builtin_amdgcn_s_sleep(1); \
    if ((++_sp & 255u) == 0u) { if (xb_ld(&(bar)[XB_TMO])) break; if (_sp > XB_SPIN_CAP) { atomicAdd(&(bar)[XB_TMO], 1u); break; } } } } while (0)

struct XcdBarrier {
    unsigned* bar; unsigned x;
    volatile LAS unsigned* st;
    int wv;
};

__device__ __forceinline__ XcdBarrier xcd_barrier_post(unsigned* bar, volatile LAS unsigned* st) {
    XcdBarrier b; b.bar = bar; b.x = xb_xcc_id(); b.st = st;
    if (threadIdx.x == 0) (void)xb_add(&bar[XB_XCNT(b.x)], 1u);
    return b;
}
__device__ __forceinline__ void xcd_barrier_complete(unsigned* bar, unsigned x, unsigned& nloc, unsigned& nx) {
    asm volatile("" : "+s"(x));
    const unsigned G = gridDim.x * gridDim.y * gridDim.z;
    unsigned sum, cnt, mine, sp = 0u;
    for (;;) {
        sum = 0u; cnt = 0u; mine = 0u;
#pragma unroll
        for (unsigned j = 0; j < 16; ++j) { const unsigned c = xb_ld(&bar[XB_XCNT(j)]); sum += c; cnt += (c > 0u) ? 1u : 0u; mine = (j == x) ? c : mine; }
        if (sum == G) break;
        __builtin_amdgcn_s_sleep(1);
        if ((++sp & 255u) == 0u) { if (xb_ld(&bar[XB_TMO])) break; if (sp > XB_SPIN_CAP) { atomicAdd(&bar[XB_TMO], 1u); break; } }
    }
    nloc = mine > 0u ? mine : 1u; nx = cnt > 0u ? cnt : 1u;
}

__device__ __forceinline__ void xcd_barrier(const XcdBarrier& b) {
    asm volatile("s_waitcnt vmcnt(0)" ::: "memory");
    __syncthreads();
    if (threadIdx.x == 0) {
        unsigned* bar = b.bar; asm volatile("" : "+s"(bar));
        __builtin_amdgcn_s_waitcnt(0);
        unsigned nloc = b.st[0], nx = b.st[1];
        if (nloc == 0u) { xcd_barrier_complete(bar, b.x, nloc, nx); b.st[0] = nloc; b.st[1] = nx; }
        const unsigned old = xb_add(&bar[XB_XSUB(b.x)], 1u);
        const unsigned gen = old / nloc;
        if (old + 1u == (gen + 1u) * nloc) {
            __builtin_amdgcn_fence(__ATOMIC_RELEASE, "agent");
            asm volatile("s_waitcnt vmcnt(0)" ::: "memory");
            const unsigned og = xb_add(&bar[XB_TOP], 1u);
            const unsigned tg = og / nx;
            if (og + 1u == (tg + 1u) * nx) xb_add(&bar[XB_TOPGEN], 1u);
            else XB_SPIN(xb_ld(&bar[XB_TOPGEN]) == tg, bar);
            __builtin_amdgcn_fence(__ATOMIC_ACQUIRE, "agent");
            xb_add(&bar[XB_XGEN(b.x)], 1u);
            asm volatile("s_waitcnt vmcnt(0)" ::: "memory");
        } else {
            XB_SPIN(xb_ld(&bar[XB_XGEN(b.x)]) == gen, bar);
            __builtin_amdgcn_fence(__ATOMIC_ACQUIRE, "agent");
            asm volatile("s_waitcnt vmcnt(0)" ::: "memory");
        }
    }
    __syncthreads();
}
namespace dattn {
constexpr int D = 128, QST = 2048, KVS = 512, OST = 2048, MTW = 68, JLO = 3;
constexpr float THR = 8.f; constexpr bool WSKIP = false;
typedef unsigned short bf16;
constexpr float SCALE = 1.0f;
constexpr int NW = 8, QBLK = 32, KVBLK = 64, QB = NW * QBLK;
constexpr int SHM_V = KVBLK * D * 2, SHM_K = KVBLK * D * 2;
constexpr int LDS_BYTES = 2 * SHM_V + 2 * SHM_K + NW * 64 * 4;

typedef short bf16x8 __attribute__((ext_vector_type(8)));
typedef short s16x4 __attribute__((ext_vector_type(4)));
typedef float f32x16 __attribute__((ext_vector_type(16)));
typedef float f32x4 __attribute__((ext_vector_type(4)));
typedef unsigned u32x4 __attribute__((ext_vector_type(4)));
template <class A, class Bt> struct same_t { static constexpr bool v = false; };
template <class A> struct same_t<A, A> { static constexpr bool v = true; };

#define KSWZ(row, colB) ((row) * 256 + ((colB) ^ (((row) & 7) << 4)))
#define SBAR() __builtin_amdgcn_sched_barrier(0)
__device__ __forceinline__ int v_st(int k, int c) { const int kk = (k & ~0xC) | ((k & 4) << 1) | ((k & 8) >> 1); return ((kk >> 3) * 4 + (c >> 5)) * 512 + ((kk & 7) * 32 + (c & 31)) * 2; }
__device__ __forceinline__ int v_rd_base(int lane) { return ((lane & 3) << 3) | (((lane >> 2) & 3) << 6) | (((lane >> 4) & 1) << 5) | (((lane >> 5) & 1) << 8); }
constexpr int v_rd_off(int d0, int ks, int half) { return d0 * 512 + ks * 4096 + half * 2048; }
__device__ __forceinline__ int crow(int r, int hi) { return (r & 3) + 8 * (r >> 2) + 4 * hi; }
__device__ __forceinline__ unsigned cvtpk(float lo, float hi) {
    unsigned r; asm volatile("v_cvt_pk_bf16_f32 %0, %1, %2" : "=v"(r) : "v"(lo), "v"(hi)); return r;
}
__device__ __forceinline__ bf16x8 pack8(f32x4 a, f32x4 b) {
    u32x4 w = {cvtpk(a[0], a[1]), cvtpk(a[2], a[3]), cvtpk(b[0], b[1]), cvtpk(b[2], b[3])};
    return *reinterpret_cast<bf16x8*>(&w);
}
template <class T> __device__ __forceinline__ bf16x8 load8(const T* p) {
    if constexpr (same_t<T, float>::v) { return pack8(*(const f32x4*)p, *(const f32x4*)(p + 4)); }
    else { return *reinterpret_cast<const bf16x8*>(p); }
}
__device__ __forceinline__ void mask_tile(f32x16& p0, f32x16& p1, int dq, unsigned W) {
    const float NEG = -__builtin_inff();
#pragma unroll
    for (int r = 0; r < 16; ++r) {
        const int c = (r & 3) + 8 * (r >> 2);
        if ((unsigned)(dq - c) >= W) p0[r] = NEG;
        if ((unsigned)(dq - c - 32) >= W) p1[r] = NEG;
    }
}
__device__ __forceinline__ void mask_bits(f32x16& p0, f32x16& p1, unsigned long long mw, int hi) {
    const float NEG = -__builtin_inff();
    const unsigned lo = (unsigned)(mw >> (4 * hi)), up = (unsigned)(mw >> (32 + 4 * hi));
#pragma unroll
    for (int r = 0; r < 16; ++r) {
        const int c = (r & 3) + 8 * (r >> 2);
        if (!((lo >> c) & 1u)) p0[r] = NEG;
        if (!((up >> c) & 1u)) p1[r] = NEG;
    }
}
__device__ __forceinline__ void partialSM(f32x16& p0, f32x16& p1, float& m_reg, float& mn, float& alpha) {
    float pmax = p0[0]; for (int r = 1; r < 16; ++r) pmax = fmaxf(pmax, p0[r]); for (int r = 0; r < 16; ++r) pmax = fmaxf(pmax, p1[r]);
    { auto rr = __builtin_amdgcn_permlane32_swap(__float_as_uint(pmax), __float_as_uint(pmax), false, false);
      pmax = fmaxf(__uint_as_float(rr[0]), __uint_as_float(rr[1])); }
    constexpr float C2 = 1.4426950408889634f * SCALE;
    if (__builtin_expect(__all((pmax - m_reg) * SCALE <= THR), 1)) { mn = m_reg; alpha = 1.f; }
    else { mn = fmaxf(m_reg, pmax); alpha = __builtin_amdgcn_exp2f((m_reg - mn) * C2); m_reg = mn; }
    const float mnL = -mn * C2;
    for (int r = 0; r < 16; ++r) p0[r] = fmaf(p0[r], C2, mnL); for (int r = 0; r < 16; ++r) p1[r] = fmaf(p1[r], C2, mnL);
    for (int r = 0; r < 16; ++r) p0[r] = __builtin_amdgcn_exp2f(p0[r]);
}
__device__ __forceinline__ void finishSM(f32x16& p0, f32x16& p1, float alpha, float& l_reg, bf16x8& pa0, bf16x8& pa1, bf16x8& pa2, bf16x8& pa3) {
    for (int r = 0; r < 16; ++r) p1[r] = __builtin_amdgcn_exp2f(p1[r]);
    float ps = 0; for (int r = 0; r < 16; ++r) ps += p0[r]; for (int r = 0; r < 16; ++r) ps += p1[r];
    { auto rr = __builtin_amdgcn_permlane32_swap(__float_as_uint(ps), __float_as_uint(ps), false, false);
      ps = __uint_as_float(rr[0]) + __uint_as_float(rr[1]); }
    l_reg = l_reg * alpha + ps;
#define PK4(P, B_, OUT) do { unsigned a0 = cvtpk(P[B_+0], P[B_+1]), a1 = cvtpk(P[B_+2], P[B_+3]);                          \
        unsigned b0 = cvtpk(P[B_+4], P[B_+5]), b1 = cvtpk(P[B_+6], P[B_+7]);                                             \
        auto r0 = __builtin_amdgcn_permlane32_swap(a0, b0, false, false); auto r1 = __builtin_amdgcn_permlane32_swap(a1, b1, false, false); \
        u32x4 w = {r0[0], r1[0], r0[1], r1[1]}; OUT = *reinterpret_cast<bf16x8*>(&w); } while (0)
    PK4(p0, 0, pa0); PK4(p0, 8, pa1); PK4(p1, 0, pa2); PK4(p1, 8, pa3);
#undef PK4
}
template <int KB, bool SK>
__device__ __forceinline__ void qkt(f32x16& p0, f32x16& p1, const char* K_lds, int r32, int hi, const bf16x8* qr, bool act) {
    if (SK && !act) { const float NEG = -__builtin_inff();
#pragma unroll
        for (int r = 0; r < 16; ++r) { p0[r] = NEG; p1[r] = NEG; } return; }
    p0 = f32x16{}; p1 = f32x16{};
    const char* kb[4];
#pragma unroll
    for (int dd = 0; dd < 4; ++dd) kb[dd] = K_lds + KB * SHM_K + KSWZ(r32, (dd * 16 + hi * 8) * 2);
#pragma unroll
    for (int d0 = 0; d0 < 8; ++d0) { const char* a = kb[d0 & 3] + (d0 >> 2) * 128;
        bf16x8 b0 = *reinterpret_cast<const bf16x8*>(a);
        bf16x8 b1 = *reinterpret_cast<const bf16x8*>(a + 32 * 256);
        p0 = __builtin_amdgcn_mfma_f32_32x32x16_bf16(b0, qr[d0], p0, 0, 0, 0);
        p1 = __builtin_amdgcn_mfma_f32_32x32x16_bf16(b1, qr[d0], p1, 0, 0, 0); }
}
template <int VB, bool SK>
__device__ __forceinline__ void pv_tile(f32x16* o, int vb0, bf16x8 pa0, bf16x8 pa1, bf16x8 pa2, bf16x8 pa3, bool act) {
    if (SK && !act) return;
#define TRRD(dst, off) asm volatile("ds_read_b64_tr_b16 %0, %1 offset:%2" : "=&v"(dst) : "v"(vb0), "i"(off) : "memory")
#define PV_D0(d0) do { s16x4 l0, l1, l2, l3, h0, h1, h2, h3; constexpr int b_ = VB * SHM_V + v_rd_off(d0, 0, 0);     \
        TRRD(l0, b_); TRRD(h0, b_ + 2048); TRRD(l1, b_ + 4096); TRRD(h1, b_ + 6144); TRRD(l2, b_ + 8192); TRRD(h2, b_ + 10240); TRRD(l3, b_ + 12288); TRRD(h3, b_ + 14336); \
        asm volatile("s_waitcnt lgkmcnt(0)" ::: "memory"); SBAR();                 \
        o[d0] = __builtin_amdgcn_mfma_f32_32x32x16_bf16(pa0, (bf16x8){l0[0], l0[1], l0[2], l0[3], h0[0], h0[1], h0[2], h0[3]}, o[d0], 0, 0, 0);   \
        o[d0] = __builtin_amdgcn_mfma_f32_32x32x16_bf16(pa1, (bf16x8){l1[0], l1[1], l1[2], l1[3], h1[0], h1[1], h1[2], h1[3]}, o[d0], 0, 0, 0);   \
        o[d0] = __builtin_amdgcn_mfma_f32_32x32x16_bf16(pa2, (bf16x8){l2[0], l2[1], l2[2], l2[3], h2[0], h2[1], h2[2], h2[3]}, o[d0], 0, 0, 0);   \
        o[d0] = __builtin_amdgcn_mfma_f32_32x32x16_bf16(pa3, (bf16x8){l3[0], l3[1], l3[2], l3[3], h3[0], h3[1], h3[2], h3[3]}, o[d0], 0, 0, 0); } while (0)
    PV_D0(0); PV_D0(1); PV_D0(2); PV_D0(3);
#undef PV_D0
#undef TRRD
}

template <class TIn, class TOut> struct BlockRef { const TIn* Q; const TIn* K; const TIn* V; TOut* O; const unsigned long long* M; int P0; };
template <class TIn> struct Seam {
    bf16x8 qr[8];
    bf16x8 st_v0, st_v1, st_k0, st_k1; f32x4 sf0, sf1, sf2, sf3;
    f32x4 tq[16];
};
__device__ __forceinline__ int swa_jlo(int, int) { return JLO; }
#define ROW(p, k0, rr) ((p) + (size_t)((k0) + (rr)) * KVS + sc)
#define VMW() asm volatile("s_waitcnt vmcnt(0)" ::: "memory")
#define VMWN(n) asm volatile("s_waitcnt vmcnt(%0)" :: "i"(n) : "memory")
#define SLOAD_H(Kp, Vp, k0) do { S.st_v0 = load8<TIn>(ROW(Vp, k0, sr)); S.st_v1 = load8<TIn>(ROW(Vp, k0, 32 + sr));              \
                         S.st_k0 = load8<TIn>(ROW(Kp, k0, sr)); S.st_k1 = load8<TIn>(ROW(Kp, k0, 32 + sr)); } while (0)
#define SWRITE_HK(bf) do { *(bf16x8*)(K_lds + (bf) * SHM_K + kws) = S.st_k0; *(bf16x8*)(K_lds + (bf) * SHM_K + kws + 32 * 256) = S.st_k1; } while (0)
#define SWRITE_HV(bf) do { *(bf16x8*)(V_lds + (bf) * SHM_V + vst0) = S.st_v0; *(bf16x8*)(V_lds + (bf) * SHM_V + vst1) = S.st_v1; } while (0)
#define SWRITE_H(bf) do { SWRITE_HV(bf); SWRITE_HK(bf); } while (0)
#define SLOAD_F(p, k0) do { S.sf0 = *(const f32x4*)ROW(p, k0, sr); S.sf1 = *(const f32x4*)(ROW(p, k0, sr) + 4);                \
                            S.sf2 = *(const f32x4*)ROW(p, k0, 32 + sr); S.sf3 = *(const f32x4*)(ROW(p, k0, 32 + sr) + 4); } while (0)
#define SWRITE_KF(bf) do { *(bf16x8*)(K_lds + (bf) * SHM_K + kws) = pack8(S.sf0, S.sf1); *(bf16x8*)(K_lds + (bf) * SHM_K + kws + 32 * 256) = pack8(S.sf2, S.sf3); } while (0)
#define SWRITE_VF(bf) do { *(bf16x8*)(V_lds + (bf) * SHM_V + vst0) = pack8(S.sf0, S.sf1); *(bf16x8*)(V_lds + (bf) * SHM_V + vst1) = pack8(S.sf2, S.sf3); } while (0)
template <class TIn, class TOut>
__device__ __forceinline__ void causal_swa_prime(const BlockRef<TIn, TOut>& cur, int W, char* lds, Seam<TIn>& S, int wv) {
    constexpr bool F32 = same_t<TIn, float>::v;
    int tid0_ = threadIdx.x; asm volatile("" : "+v"(tid0_)); (void)wv;
    const int tid = tid0_, wid = __builtin_amdgcn_readfirstlane(tid >> 6), lane = tid & 63, r32 = lane & 31, hi = lane >> 5;
    const int sr = tid >> 4, sc = (tid & 15) * 8, kws = KSWZ(sr, sc * 2); char* K_lds = lds + 2 * SHM_V;
    const int kb0 = swa_jlo(cur.P0, W) * KVBLK;
    for (int d0 = 0; d0 < 8; ++d0) S.qr[d0] = load8<TIn>(cur.Q + (size_t)(wid * QBLK + r32) * QST + d0 * 16 + hi * 8);
    if constexpr (F32) { SLOAD_F((const float*)cur.K, kb0); VMW(); SWRITE_KF(0); SBAR(); SLOAD_F((const float*)cur.V, kb0); }
    else { SLOAD_H(cur.K, cur.V, kb0); VMW(); SWRITE_HK(0); }
    __syncthreads();
}
template <class TIn, class TOut>
__device__ __forceinline__ void causal_swa_block(const BlockRef<TIn, TOut>& cur, const BlockRef<TIn, TOut>& nxt, int skv, int W, char* lds, Seam<TIn>& S, int wv) {
    constexpr bool F32 = same_t<TIn, float>::v;
    int tid0_ = threadIdx.x; asm volatile("" : "+v"(tid0_)); (void)wv;
    const int tid = tid0_, wid = __builtin_amdgcn_readfirstlane(tid >> 6), lane = tid & 63, r32 = lane & 31, hi = lane >> 5;
    const int j_lo = swa_jlo(cur.P0, W);
    int j_hi = (cur.P0 + QB - 1) / KVBLK + 1; if (j_hi > skv / KVBLK) j_hi = skv / KVBLK;
    const int NT = j_hi - j_lo;
    const int kbn = swa_jlo(nxt.P0, W) * KVBLK;
    const int qlo = cur.P0 + wid * QBLK; (void)qlo;
    const unsigned long long* mrow = cur.M + (size_t)(wid * QBLK + r32) * MTW;
    const int qm_unused = 0; (void)qm_unused;
    char* V_lds = lds; char* K_lds = lds + 2 * SHM_V;
    float* ws = (float*)(lds + 2 * SHM_V + 2 * SHM_K) + wid * 64; float* li_l = ws, * al_l = ws + 32;
    float m_reg = -1e30f, l_reg = 0; f32x16 o[4] = {};
    const int sr = tid >> 4, sc = (tid & 15) * 8, vst0 = v_st(sr, sc), vst1 = v_st(32 + sr, sc), kws = KSWZ(sr, sc * 2);
    const int vb0 = (int)(uintptr_t)V_lds + v_rd_base(lane);
    const TIn* Kh = cur.K; const TIn* Vh = cur.V;
#define RESC(a) do { if (__any((a) < 1.f)) { if (hi == 0) al_l[r32] = (a); asm volatile("s_waitcnt lgkmcnt(0)" ::: "memory");              \
                     for (int d_ = 0; d_ < 4; ++d_) for (int r = 0; r < 16; ++r) o[d_][r] *= al_l[crow(r, hi)]; } } while (0)
#define KBASE(t) ((j_lo + (t)) * KVBLK)
#define ACT(t) (KBASE(t) <= qlo + QBLK - 1 && KBASE(t) + KVBLK - 1 >= qlo - W + 1)
#define MASKT(P0_, P1_, t) mask_bits(P0_, P1_, (((t) & 1) ? mwB : mwA), hi)
#define MWLOAD(t) do { const int tt_ = (t) < NT ? (t) : NT - 1; if ((t) & 1) mwB = mrow[j_lo + tt_]; else mwA = mrow[j_lo + tt_]; } while (0)
    constexpr int NQL = F32 ? 16 : 8;
    constexpr bool SK = WSKIP && !F32;
#define SEAM_K0() do { VMWN(NQL); if constexpr (F32) { SWRITE_KF(0); SBAR(); SLOAD_F((const float*)nxt.V, kbn); } else { SWRITE_HK(0); } SBAR(); } while (0)
    f32x16 pA0, pA1, pB0, pB1; float mnA, mnB, alA, alB; bf16x8 pa0, pa1, pa2, pa3;
    unsigned long long mwA = mrow[j_lo], mwB = mrow[j_lo + (NT > 1 ? 1 : 0)];
    if constexpr (F32) { VMW(); SWRITE_VF(0); SBAR(); } else { SWRITE_HV(0); SBAR(); }
    if (NT > 1) { if constexpr (F32) SLOAD_F((const float*)Kh, KBASE(1)); else SLOAD_H(Kh, Vh, KBASE(1)); }
    SBAR(); qkt<0, SK>(pA0, pA1, K_lds, r32, hi, S.qr, ACT(0));
    if constexpr (F32) { if (NT > 1) { VMW(); SWRITE_KF(1); SBAR(); SLOAD_F((const float*)Vh, KBASE(1)); } }
    MASKT(pA0, pA1, 0); MWLOAD(2); partialSM(pA0, pA1, m_reg, mnA, alA);
    if (NT > 1) { VMW(); if constexpr (F32) { SWRITE_VF(1); SBAR(); if (NT > 2) SLOAD_F((const float*)Kh, KBASE(2)); } else SWRITE_H(1); }
    __syncthreads();
#define HALF_STEP(PX0, PX1, mnX, alX, PY0, PY1, alY, t, KB, VB, SB) do {                                                      \
        SBAR(); qkt<KB, SK>(PX0, PX1, K_lds, r32, hi, S.qr, ACT(t));                                             \
        finishSM(PY0, PY1, alY, l_reg, pa0, pa1, pa2, pa3); SBAR();                                                           \
        if ((t) + 1 < NT) { if constexpr (F32) { VMW(); SWRITE_KF(SB); SBAR(); SLOAD_F((const float*)Vh, KBASE((t) + 1)); }  \
                            else { SLOAD_H(Kh, Vh, KBASE((t) + 1)); } SBAR(); }                                               \
        pv_tile<VB, SK>(o, vb0, pa0, pa1, pa2, pa3, ACT((t) - 1)); MASKT(PX0, PX1, (t)); MWLOAD((t) + 2); partialSM(PX0, PX1, m_reg, mnX, alX);                                        \
        __syncthreads();                                                                                                      \
        if ((t) + 1 < NT) { VMW(); if constexpr (F32) { SWRITE_VF(SB); SBAR(); if ((t) + 2 < NT) SLOAD_F((const float*)Kh, KBASE((t) + 2)); } \
                            else { SWRITE_H(SB); } }                                                                          \
        RESC(alX); __syncthreads(); } while (0)
    for (int t = 1; t + 1 < NT; t += 2) {
        HALF_STEP(pB0, pB1, mnB, alB, pA0, pA1, alA, t, 1, 0, 0);
        HALF_STEP(pA0, pA1, mnA, alA, pB0, pB1, alB, t + 1, 0, 1, 1);
    }
    const bool even = (NT & 1) == 0;
    if (even) { SBAR(); qkt<1, SK>(pB0, pB1, K_lds, r32, hi, S.qr, ACT(NT - 1)); SBAR(); }
#define QROW(e) (nxt.Q + (size_t)(wid * QBLK + r32) * QST + ((e) >> 1) * 16 + hi * 8 + ((e) & 1) * 4)
    if constexpr (F32) { SLOAD_F((const float*)nxt.K, kbn); SBAR();
#pragma unroll
        for (int e = 0; e < 8; ++e) S.tq[e] = *(const f32x4*)QROW(e); }
    else { SLOAD_H(nxt.K, nxt.V, kbn); SBAR();
#pragma unroll
        for (int d0 = 0; d0 < 8; ++d0) S.qr[d0] = load8<TIn>(nxt.Q + (size_t)(wid * QBLK + r32) * QST + d0 * 16 + hi * 8); }
    SBAR();
    finishSM(pA0, pA1, alA, l_reg, pa0, pa1, pa2, pa3); SBAR();
    if constexpr (F32) {
#pragma unroll
        for (int e = 8; e < 16; ++e) S.tq[e] = *(const f32x4*)QROW(e); SBAR(); }
#undef QROW
    pv_tile<0, SK>(o, vb0, pa0, pa1, pa2, pa3, ACT(even ? NT - 2 : NT - 1));
    if (even) { MASKT(pB0, pB1, NT - 1); partialSM(pB0, pB1, m_reg, mnB, alB); __syncthreads(); RESC(alB);
        finishSM(pB0, pB1, alB, l_reg, pa0, pa1, pa2, pa3); SBAR(); pv_tile<1, SK>(o, vb0, pa0, pa1, pa2, pa3, ACT(NT - 1)); }
    SBAR(); SEAM_K0();
    if (hi == 0) li_l[r32] = l_reg; asm volatile("s_waitcnt lgkmcnt(0)" ::: "memory");
    float rli[16];
#pragma unroll
    for (int r = 0; r < 16; ++r) rli[r] = __builtin_amdgcn_rcpf(li_l[crow(r, hi)]);
    TOut* Ow = cur.O + (size_t)(wid * QBLK) * OST;
#pragma unroll
    for (int r = 0; r < 16; ++r) { const int orow = crow(r, hi);
#pragma unroll
        for (int d0 = 0; d0 < 4; ++d0) { const float v = o[d0][r] * rli[r];
            if constexpr (same_t<TOut, float>::v) { Ow[(size_t)orow * OST + d0 * 32 + r32] = v; }
            else { const float vn = __shfl_xor(v, 1);
                   if ((r32 & 1) == 0) *(unsigned*)(Ow + (size_t)orow * OST + d0 * 32 + r32) = cvtpk(v, vn); } } }
    if constexpr (F32) {
#pragma unroll
        for (int d0 = 0; d0 < 8; ++d0) S.qr[d0] = pack8(S.tq[2 * d0], S.tq[2 * d0 + 1]); }
    __syncthreads();
#undef RESC
#undef KBASE
#undef ACT
#undef MASKT
#undef MWLOAD
#undef SEAM_K0
#undef HALF_STEP
}
#undef ROW
#undef VMW
#undef VMWN
#undef SLOAD_H
#undef SWRITE_HK
#undef SWRITE_HV
#undef SWRITE_H
#undef SLOAD_F
#undef SWRITE_KF
#undef SWRITE_VF

}

constexpr int NWAVES = 8, NTHREADS = 512;
constexpr int DM = 2048, SEQ = 4096, NMETA = 16, TP = 4112, NBP = 2, SBN = 8, PAST = 16384, NPG = 128;
constexpr int XROW0 = 8192, SROW0 = 8224, NROWS = 8232, MPAD = 8448, FF = 8192, MAINM = 8192, XR = 48;
constexpr int NA_IN = 6144, NB_IN = 4176, NB_PAD = 4352, NC_IN = 12352, NC_PAD = 12544, DVW = 4096, CDIM = 8192;
constexpr float ALPHA = 1.6817928305074292f;
constexpr float LN_EPS = 1e-5f, RMS_EPS = 1e-6f;
constexpr int SCW = 4160, SCSW = 16448, KIROWS = 4128, NSKEY = PAST + 1;
constexpr int POS_SAMPLE_IDX = TP;

constexpr size_t O_YP = 0, O_YS = O_YP + (size_t)NBP * SEQ * DM, O_CAP = O_YS + (size_t)SBN * DM, O_CAS = O_CAP + 2 * NBP * 2 * DM,
                 O_KP = O_CAS + 2 * SBN * 2 * DM, O_VP = O_KP + (size_t)NBP * TP * 512, O_IKP = O_VP + (size_t)NBP * TP * 512,
                 O_KS = O_IKP + (size_t)NBP * TP * 64, O_VS = O_KS + SBN * 512, O_IKS = O_VS + SBN * 512, O_CCP = O_IKS + SBN * 64,
                 O_CCS = O_CCP + (size_t)NBP * 3 * CDIM, O_DP = O_CCS + (size_t)SBN * 3 * CDIM, O_DS = O_DP + (size_t)NBP * 32 * 128 * 128,
                 O_END = O_DS + (size_t)SBN * 32 * 128 * 128;

constexpr size_t MiB = 1u << 20;
constexpr size_t WS_CTL = 0, CTL_ZERO_BYTES = 1 * MiB;
constexpr size_t WS_TAB128 = 1 * MiB, WS_TAB64 = 4 * MiB, WS_WI = 6 * MiB, WS_G = 7 * MiB, WS_BETA = 9 * MiB, WS_CNT = 11 * MiB, WS_KIB = 12 * MiB,
                 WS_SCS = 14 * MiB, WS_IDXL = 16 * MiB, WS_X = 26 * MiB, WS_QR = 60 * MiB, WS_QI = 94 * MiB, WS_Z = 112 * MiB, WS_Y = 180 * MiB,
                 WS_BIG = 248 * MiB, WS_QKVC = 452 * MiB, WS_SC = 584 * MiB, WS_W = 716 * MiB;
constexpr size_t WSZ_A_IN = (size_t)NA_IN * DM * 2, WSZ_A_OUT = (size_t)DM * DM * 2, WSZ_B_IN = (size_t)NB_PAD * DM * 2, WSZ_B_OUT = (size_t)DM * DM * 2,
                 WSZ_C_IN = (size_t)NC_PAD * DM * 2, WSZ_C_OUT = (size_t)DM * DVW * 2, WSZ_W1 = (size_t)FF * DM * 2, WSZ_W2 = (size_t)DM * FF * 2;
constexpr size_t WS_WA_IN = WS_W, WS_WA_OUT = WS_WA_IN + 2 * WSZ_A_IN, WS_WB_IN = WS_WA_OUT + 2 * WSZ_A_OUT, WS_WB_OUT = WS_WB_IN + WSZ_B_IN,
                 WS_WC_IN = WS_WB_OUT + WSZ_B_OUT, WS_WC_OUT = WS_WC_IN + WSZ_C_IN, WS_W1 = WS_WC_OUT + WSZ_C_OUT, WS_W2 = WS_W1 + 4 * WSZ_W1,
                 WS_ZP = WS_W2 + 4 * WSZ_W2, WS_QKF = WS_ZP + 4 * MiB, WS_DWG = WS_QKF + 130 * MiB, WS_DUG = WS_DWG + 66 * MiB, WS_END = WS_DUG + 66 * MiB;
constexpr size_t WS_MASK = WS_IDXL, WS_KS = WS_Z, WS_VS = WS_Z + 9 * MiB;
constexpr size_t WS_DAF = WS_Z, WS_DTG = WS_Y, WS_DTB = WS_Y + 33 * MiB, WS_DPG = WS_QR, WS_DKT = WS_QKF, WS_DVT = WS_QKF + 33 * MiB, WS_DGC = WS_QI, WS_DBT = WS_QI + 2 * MiB;
constexpr int SP = 4352, SPAD = 240, MTW = 68;
constexpr int CW_BAR = 4096;

constexpr int RING_BYTES = 131072, LDSCTL_OFF = RING_BYTES, MISC_OFF = LDSCTL_OFF + 320, LDS_BYTES = 147456;

typedef unsigned short bf16;
typedef unsigned v4u __attribute__((ext_vector_type(4)));
typedef unsigned v2u __attribute__((ext_vector_type(2)));
typedef float f32x4 __attribute__((ext_vector_type(4)));
typedef float f32x2 __attribute__((ext_vector_type(2)));
typedef short bf16x8 __attribute__((ext_vector_type(8)));
typedef float f32x16 __attribute__((ext_vector_type(16)));
typedef __bf16 bf16x2_t __attribute__((ext_vector_type(2)));

#define LDS_WAIT() asm volatile("s_waitcnt lgkmcnt(0)" ::: "memory")
#define WAVE_SYNC() do { asm volatile("s_waitcnt lgkmcnt(0)" ::: "memory"); __builtin_amdgcn_wave_barrier(); } while (0)

__device__ __forceinline__ float bflo(unsigned w) { return __uint_as_float(w << 16); }
__device__ __forceinline__ float bfhi(unsigned w) { return __uint_as_float(w & 0xffff0000u); }
__device__ __forceinline__ float bf2f(bf16 h) { return __uint_as_float((unsigned)h << 16); }
__device__ __forceinline__ unsigned pk2(float lo, float hi) { f32x2 v = {lo, hi}; bf16x2_t b = __builtin_convertvector(v, bf16x2_t); return __builtin_bit_cast(unsigned, b); }
__device__ __forceinline__ bf16 f2bf(float f) { return (bf16)(pk2(f, 0.f) & 0xffffu); }
__device__ __forceinline__ float wave_sum(float v) {
#pragma unroll
    for (int o = 1; o < 64; o <<= 1) v += __shfl_xor(v, o);
    return v;
}
__device__ __forceinline__ float wave_max(float v) {
#pragma unroll
    for (int o = 1; o < 64; o <<= 1) v = fmaxf(v, __shfl_xor(v, o));
    return v;
}
__device__ __forceinline__ int wave_sum_i(int v) {
#pragma unroll
    for (int o = 1; o < 64; o <<= 1) v += __shfl_xor(v, o);
    return v;
}
__device__ __forceinline__ float wave_sum_dpp(float v) {
    v += __int_as_float(__builtin_amdgcn_update_dpp(0, __float_as_int(v), 0x128, 0xf, 0xf, false));
    v += __int_as_float(__builtin_amdgcn_update_dpp(0, __float_as_int(v), 0x124, 0xf, 0xf, false));
    v += __int_as_float(__builtin_amdgcn_update_dpp(0, __float_as_int(v), 0x122, 0xf, 0xf, false));
    v += __int_as_float(__builtin_amdgcn_update_dpp(0, __float_as_int(v), 0x121, 0xf, 0xf, false));
    const int iv = __float_as_int(v);
    return (__int_as_float(__builtin_amdgcn_readlane(iv, 0)) + __int_as_float(__builtin_amdgcn_readlane(iv, 16))) + (__int_as_float(__builtin_amdgcn_readlane(iv, 32)) + __int_as_float(__builtin_amdgcn_readlane(iv, 48)));
}
__device__ __forceinline__ int wave_sum_dpp_i(int v) {
    v += __builtin_amdgcn_update_dpp(0, v, 0x128, 0xf, 0xf, false);
    v += __builtin_amdgcn_update_dpp(0, v, 0x124, 0xf, 0xf, false);
    v += __builtin_amdgcn_update_dpp(0, v, 0x122, 0xf, 0xf, false);
    v += __builtin_amdgcn_update_dpp(0, v, 0x121, 0xf, 0xf, false);
    return __builtin_amdgcn_readlane(v, 0) + __builtin_amdgcn_readlane(v, 16) + __builtin_amdgcn_readlane(v, 32) + __builtin_amdgcn_readlane(v, 48);
}
__device__ __forceinline__ float row16_sum(float v) {
    v += __int_as_float(__builtin_amdgcn_update_dpp(0, __float_as_int(v), 0x128, 0xf, 0xf, false));
    v += __int_as_float(__builtin_amdgcn_update_dpp(0, __float_as_int(v), 0x124, 0xf, 0xf, false));
    v += __int_as_float(__builtin_amdgcn_update_dpp(0, __float_as_int(v), 0x122, 0xf, 0xf, false));
    v += __int_as_float(__builtin_amdgcn_update_dpp(0, __float_as_int(v), 0x121, 0xf, 0xf, false));
    return v;
}
__device__ __forceinline__ float silu_f(float x) { return x / (1.f + __expf(-x)); }
__device__ __forceinline__ int prow(int b, int t) { return t >= NMETA ? b * SEQ + (t - NMETA) : XROW0 + b * NMETA + t; }
__device__ __forceinline__ void row_bt(int r, int& b, int& t) { if (r < XROW0) { b = r >> 12; t = (r & 4095) + NMETA; } else { b = (r - XROW0) >> 4; t = (r - XROW0) & 15; } }
__device__ __forceinline__ void unpack8(const v4u w, float (&f)[8]) {
    f[0] = bflo(w.x); f[1] = bfhi(w.x); f[2] = bflo(w.y); f[3] = bfhi(w.y); f[4] = bflo(w.z); f[5] = bfhi(w.z); f[6] = bflo(w.w); f[7] = bfhi(w.w);
}
__device__ __forceinline__ v4u pack8(const float (&f)[8]) { v4u w; w.x = pk2(f[0], f[1]); w.y = pk2(f[2], f[3]); w.z = pk2(f[4], f[5]); w.w = pk2(f[6], f[7]); return w; }

__device__ __forceinline__ void transpose_item(const float* W, int K, int N, int Npad, bf16* WT, LAS float* scr, int item, int lane) {
    const int nblk = Npad / 32, kb = item / nblk, nb = item % nblk, k0 = 64 * kb, n0 = 32 * nb;
    const int n = n0 + (lane & 31); const bool ok = n < N;
    float wv_[32];
#pragma unroll
    for (int i = 0; i < 32; ++i) { const int kk = 2 * i + (lane >> 5); wv_[i] = W[(size_t)(k0 + kk) * N + (ok ? n : N - 1)]; }
#pragma unroll
    for (int i = 0; i < 32; ++i) { const int kk = 2 * i + (lane >> 5); scr[kk * 33 + (lane & 31)] = ok ? wv_[i] : 0.f; }
    LDS_WAIT(); __builtin_amdgcn_wave_barrier();
    const int c = lane & 7;
#pragma unroll
    for (int j = 0; j < 4; ++j) { const int nn = (lane >> 3) + 8 * j; const LAS float* s = scr + (8 * c) * 33 + nn;
        v4u o; o.x = pk2(s[0 * 33], s[1 * 33]); o.y = pk2(s[2 * 33], s[3 * 33]); o.z = pk2(s[4 * 33], s[5 * 33]); o.w = pk2(s[6 * 33], s[7 * 33]);
        *(v4u*)(WT + (size_t)(n0 + nn) * K + k0 + 8 * c) = o; }
    LDS_WAIT(); __builtin_amdgcn_wave_barrier();
}

struct Ptrs {
    const float *x_prompt, *x_sample, *state_conv_a, *cache_k, *cache_v, *cache_ik, *state_conv_c, *state_delta;
    const int* page_table;
    const float *meta, *w_in_a, *conv_w_a, *w_out_a, *w_in_b, *w_out_b, *w_in_c, *conv_w_c, *a_log, *dt_bias, *norm_w, *w_out_c, *ln1_g, *ln1_b, *w1, *w2, *ln2_g, *ln2_b;
    float* out; unsigned char* ws;
};

__device__ __forceinline__ void p0_prologue(const Ptrs& P, LAS unsigned char* lds, int gw, int NGW, int wave, int lane) {
    LAS float* scr = (LAS float*)(lds + wave * 16384);
    unsigned char* ws = P.ws;
    constexpr int I_A_IN = (DM / 64) * (NA_IN / 32), I_A_OUT = (DM / 64) * (DM / 32), I_B_IN = (DM / 64) * (NB_PAD / 32), I_B_OUT = I_A_OUT,
                  I_C_IN = (DM / 64) * (NC_PAD / 32), I_C_OUT = (DVW / 64) * (DM / 32), I_W1 = (DM / 64) * (FF / 32), I_W2 = (FF / 64) * (DM / 32);
    constexpr int NITEMS = I_A_IN + I_A_OUT + I_B_IN + I_B_OUT + I_C_IN + 2 * I_W1 + 2 * I_W2;
#define TR_(cnt, Wp, Kk, Nn, Np, WTp) if (r < (cnt)) { transpose_item((Wp), (Kk), (Nn), (Np), (bf16*)(WTp), scr, r, lane); continue; } r -= (cnt);
    for (int it = gw; it < NITEMS; it += NGW) {
        int r = it;
        TR_(I_A_IN, P.w_in_a, DM, NA_IN, NA_IN, ws + WS_WA_IN)
        TR_(I_A_OUT, P.w_out_a, DM, DM, DM, ws + WS_WA_OUT)
        TR_(I_B_IN, P.w_in_b, DM, NB_IN, NB_PAD, ws + WS_WB_IN)
        TR_(I_B_OUT, P.w_out_b, DM, DM, DM, ws + WS_WB_OUT)
        TR_(I_C_IN, P.w_in_c, DM, NC_IN, NC_PAD, ws + WS_WC_IN)
        TR_(I_W1, P.w1, DM, FF, FF, ws + WS_W1)
        TR_(I_W1, P.w1 + (size_t)DM * FF, DM, FF, FF, ws + WS_W1 + WSZ_W1)
        TR_(I_W2, P.w2, FF, DM, DM, ws + WS_W2)
        transpose_item(P.w2 + (size_t)DM * FF, FF, DM, DM, (bf16*)(ws + WS_W2 + WSZ_W2), scr, r, lane);
    }
#undef TR_
    bf16* X = (bf16*)(ws + WS_X);
    for (int r = gw; r < MPAD; r += NGW) {
        const float* src = nullptr;
        if (r < XROW0) src = P.x_prompt + (size_t)r * DM;
        else if (r < SROW0) src = P.meta + (size_t)((r - XROW0) & 15) * DM;
        else if (r < NROWS) src = P.x_sample + (size_t)(r - SROW0) * DM;
#pragma unroll
        for (int j = 0; j < 4; ++j) { const int c = 512 * j + 8 * lane; v4u o = {0u, 0u, 0u, 0u};
            if (src) { const f32x4 a = *(const f32x4*)(src + c), b = *(const f32x4*)(src + c + 4); o.x = pk2(a.x, a.y); o.y = pk2(a.z, a.w); o.z = pk2(b.x, b.y); o.w = pk2(b.z, b.w); }
            *(v4u*)(X + (size_t)r * DM + c) = o; }
    }
    f32x2* t128 = (f32x2*)(ws + WS_TAB128); f32x2* t64 = (f32x2*)(ws + WS_TAB64);
    const int gt = gw * 64 + lane, NGT = NGW * 64;
    for (int e = gt; e < (TP + 1) * 96; e += NGT) {
        const int pi = e / 96, i = e % 96; const float pos = (float)(pi == TP ? PAST : pi);
        const float ex = (i < 64) ? (float)(2 * i) * (1.f / 128.f) : (float)(2 * (i - 64)) * (1.f / 64.f);
        const float inv = __builtin_amdgcn_exp2f(-ex * 13.287712379549449f);
        const float angf = pos * inv;
        double rev = (double)angf * 0.15915494309189535; rev -= __builtin_rint(rev);
        const float rf = (float)rev; const float sn = __builtin_amdgcn_sinf(rf), cs = __builtin_amdgcn_cosf(rf);
        if (i < 64) t128[pi * 64 + i] = (f32x2){cs, sn}; else t64[pi * 32 + (i - 64)] = (f32x2){cs, sn};
    }
}

__device__ __forceinline__ void deferred_transposes(const Ptrs& P, LAS unsigned char* lds, int idx, int stride, int wave, int lane) {
    LAS float* scr = (LAS float*)(lds + wave * 16384);
    unsigned char* ws = P.ws;
    constexpr int I_A_IN = (DM / 64) * (NA_IN / 32), I_A_OUT = (DM / 64) * (DM / 32), I_C_OUT = (DVW / 64) * (DM / 32), I_W1 = (DM / 64) * (FF / 32), I_W2 = (FF / 64) * (DM / 32);
    constexpr int NITEMS = I_A_IN + I_A_OUT + I_C_OUT + 2 * I_W1 + 2 * I_W2;
#define TR_(cnt, Wp, Kk, Nn, Np, WTp) if (r < (cnt)) { transpose_item((Wp), (Kk), (Nn), (Np), (bf16*)(WTp), scr, r, lane); continue; } r -= (cnt);
    for (int it = idx; it < NITEMS; it += stride) {
        int r = it;
        TR_(I_C_OUT, P.w_out_c, DVW, DM, DM, ws + WS_WC_OUT)
        TR_(I_W1, P.w1 + 2 * (size_t)DM * FF, DM, FF, FF, ws + WS_W1 + 2 * WSZ_W1)
        TR_(I_W2, P.w2 + 2 * (size_t)DM * FF, FF, DM, DM, ws + WS_W2 + 2 * WSZ_W2)
        TR_(I_A_IN, P.w_in_a + (size_t)DM * NA_IN, DM, NA_IN, NA_IN, ws + WS_WA_IN + WSZ_A_IN)
        TR_(I_A_OUT, P.w_out_a + (size_t)DM * DM, DM, DM, DM, ws + WS_WA_OUT + WSZ_A_OUT)
        TR_(I_W1, P.w1 + 3 * (size_t)DM * FF, DM, FF, FF, ws + WS_W1 + 3 * WSZ_W1)
        transpose_item(P.w2 + 3 * (size_t)DM * FF, FF, DM, DM, (bf16*)(ws + WS_W2 + 3 * WSZ_W2), scr, r, lane);
    }
#undef TR_
}

__device__ __forceinline__ void ln_row_finish(float (&v)[32], float s, const f32x4 (&gq)[8], const f32x4 (&bq_)[8], bf16* xo, float* of, int lane) {
    const float mean = wave_sum_dpp(s) * (1.f / DM); float s2 = 0.f;
#pragma unroll
    for (int i = 0; i < 32; ++i) { v[i] -= mean; s2 += v[i] * v[i]; }
    const float rstd = 1.f / sqrtf(wave_sum_dpp(s2) * (1.f / DM) + LN_EPS);
#pragma unroll
    for (int j = 0; j < 4; ++j) { const int c = 512 * j + 8 * lane; const f32x4 g0 = gq[2 * j], g1 = gq[2 * j + 1], b0 = bq_[2 * j], b1 = bq_[2 * j + 1];
        float o[8];
        o[0] = v[8 * j + 0] * rstd * g0.x + b0.x; o[1] = v[8 * j + 1] * rstd * g0.y + b0.y; o[2] = v[8 * j + 2] * rstd * g0.z + b0.z; o[3] = v[8 * j + 3] * rstd * g0.w + b0.w;
        o[4] = v[8 * j + 4] * rstd * g1.x + b1.x; o[5] = v[8 * j + 5] * rstd * g1.y + b1.y; o[6] = v[8 * j + 6] * rstd * g1.z + b1.z; o[7] = v[8 * j + 7] * rstd * g1.w + b1.w;
        *(v4u*)(xo + c) = pack8(o);
        if (of) { *(f32x4*)(of + c) = (f32x4){o[0], o[1], o[2], o[3]}; *(f32x4*)(of + c + 4) = (f32x4){o[4], o[5], o[6], o[7]}; } }
}
__device__ __forceinline__ void ln_phase(const float* Z, const float* ZP, bf16* X, bf16* Xo, const float* gam, const float* bet, float* yp, float* ys, LAS unsigned char* lds, int gw, int NGW, int tid, int wave, int lane) {
    (void)Z;
    LAS float* red = (LAS float*)lds;
    for (int xr = blockIdx.x; xr < NROWS - XROW0; xr += gridDim.x) {
        const int r = XROW0 + xr, c = 256 * wave + 4 * lane;
        const v2u xv = *(const v2u*)(X + (size_t)r * DM + c);
        const float* zr = ZP + (size_t)xr * DM + c; f32x4 z = *(const f32x4*)zr;
#pragma unroll
        for (int sl = 1; sl < 8; ++sl) z += *(const f32x4*)(zr + (size_t)sl * XR * DM);
        float v4[4] = {ALPHA * bflo(xv.x) + z.x, ALPHA * bfhi(xv.x) + z.y, ALPHA * bflo(xv.y) + z.z, ALPHA * bfhi(xv.y) + z.w};
        const float ps = wave_sum_dpp((v4[0] + v4[1]) + (v4[2] + v4[3]));
        __syncthreads();
        if (lane == 0) red[wave] = ps;
        __syncthreads();
        float tot = 0.f;
#pragma unroll
        for (int w = 0; w < 8; ++w) tot += red[w];
        const float mean = tot * (1.f / DM); float q2 = 0.f;
#pragma unroll
        for (int i = 0; i < 4; ++i) { v4[i] -= mean; q2 += v4[i] * v4[i]; }
        const float pq = wave_sum_dpp(q2);
        if (lane == 0) red[8 + wave] = pq;
        __syncthreads();
        float tq = 0.f;
#pragma unroll
        for (int w = 0; w < 8; ++w) tq += red[8 + w];
        const float rstd = 1.f / sqrtf(tq * (1.f / DM) + LN_EPS);
        const f32x4 g = *(const f32x4*)(gam + c), be = *(const f32x4*)(bet + c);
        const float o0 = v4[0] * rstd * g.x + be.x, o1 = v4[1] * rstd * g.y + be.y, o2 = v4[2] * rstd * g.z + be.z, o3 = v4[3] * rstd * g.w + be.w;
        v2u ov; ov.x = pk2(o0, o1); ov.y = pk2(o2, o3); *(v2u*)(Xo + (size_t)r * DM + c) = ov;
        if (ys && r >= SROW0) *(f32x4*)(ys + (size_t)(r - SROW0) * DM + c) = (f32x4){o0, o1, o2, o3};
    }
    f32x4 gq[8], bq_[8];
#pragma unroll
    for (int j = 0; j < 4; ++j) { const int c = 512 * j + 8 * lane; gq[2 * j] = *(const f32x4*)(gam + c); gq[2 * j + 1] = *(const f32x4*)(gam + c + 4); bq_[2 * j] = *(const f32x4*)(bet + c); bq_[2 * j + 1] = *(const f32x4*)(bet + c + 4); }
    for (int r = gw; r < XROW0; r += 2 * NGW) {
        const int r2 = r + NGW; const bool two = r2 < XROW0;
        v4u xa[4], xb[4];
#pragma unroll
        for (int j = 0; j < 4; ++j) { const int c = 512 * j + 8 * lane; xa[j] = *(const v4u*)(X + (size_t)r * DM + c); xb[j] = *(const v4u*)(X + (size_t)(two ? r2 : r) * DM + c); }
        float va[32], vb[32]; float sa = 0.f, sb = 0.f;
#pragma unroll
        for (int j = 0; j < 4; ++j) { float t8[8]; unpack8(xa[j], t8);
#pragma unroll
            for (int i = 0; i < 8; ++i) { va[8 * j + i] = t8[i]; sa += t8[i]; }
            unpack8(xb[j], t8);
#pragma unroll
            for (int i = 0; i < 8; ++i) { vb[8 * j + i] = t8[i]; sb += t8[i]; } }
        ln_row_finish(va, sa, gq, bq_, Xo + (size_t)r * DM, yp ? yp + (size_t)r * DM : nullptr, lane);
        if (two) ln_row_finish(vb, sb, gq, bq_, Xo + (size_t)r2 * DM, yp ? yp + (size_t)r2 * DM : nullptr, lane);
    }
}

__device__ __forceinline__ void load_u(const bf16* BCH, int row, int c0, float (&u)[8]) {
    const v4u cg = *(const v4u*)(BCH + (size_t)row * NA_IN + DM + c0), hh = *(const v4u*)(BCH + (size_t)row * NA_IN + 2 * DM + c0);
    float a[8], b[8]; unpack8(cg, a); unpack8(hh, b);
#pragma unroll
    for (int i = 0; i < 8; ++i) u[i] = a[i] * b[i];
}
__device__ __forceinline__ void convA_phase(const bf16* BCH, bf16* Y, const float* cw, const float* hist, float* outp, float* outs, int gtid, int NT) {
    constexpr int RUN = 8, NRUN = SEQ / RUN;
    for (int it = gtid; it < (NBP * NRUN + NBP * NMETA + SBN) * 256; it += NT) {
        const int c0 = (it & 255) * 8, ru = it >> 8;
        float w0[8], w1[8], w2[8];
        { const f32x4 a = *(const f32x4*)(cw + c0), b = *(const f32x4*)(cw + c0 + 4); w0[0] = a.x; w0[1] = a.y; w0[2] = a.z; w0[3] = a.w; w0[4] = b.x; w0[5] = b.y; w0[6] = b.z; w0[7] = b.w; }
        { const f32x4 a = *(const f32x4*)(cw + DM + c0), b = *(const f32x4*)(cw + DM + c0 + 4); w1[0] = a.x; w1[1] = a.y; w1[2] = a.z; w1[3] = a.w; w1[4] = b.x; w1[5] = b.y; w1[6] = b.z; w1[7] = b.w; }
        { const f32x4 a = *(const f32x4*)(cw + 2 * DM + c0), b = *(const f32x4*)(cw + 2 * DM + c0 + 4); w2[0] = a.x; w2[1] = a.y; w2[2] = a.z; w2[3] = a.w; w2[4] = b.x; w2[5] = b.y; w2[6] = b.z; w2[7] = b.w; }
        float u0[8], u1[8], u2[8];
        if (ru < NBP * NRUN) {
            const int b = ru / NRUN, t0 = NMETA + (ru % NRUN) * RUN;
            if (t0 >= 1) load_u(BCH, prow(b, t0 - 1), c0, u1); else {
#pragma unroll
                for (int i = 0; i < 8; ++i) u1[i] = 0.f; }
            if (t0 >= 2) load_u(BCH, prow(b, t0 - 2), c0, u0); else {
#pragma unroll
                for (int i = 0; i < 8; ++i) u0[i] = 0.f; }
            const int r0 = prow(b, t0);
            v4u bq[RUN], cq[RUN], hq_[RUN];
#pragma unroll
            for (int k = 0; k < RUN; ++k) { const bf16* rp = BCH + (size_t)(r0 + k) * NA_IN + c0; bq[k] = *(const v4u*)rp; cq[k] = *(const v4u*)(rp + DM); hq_[k] = *(const v4u*)(rp + 2 * DM); }
#pragma unroll
            for (int k = 0; k < RUN; ++k) {
                const int r = r0 + k, t = t0 + k;
                { float ca[8], ha[8]; unpack8(cq[k], ca); unpack8(hq_[k], ha);
#pragma unroll
                  for (int i = 0; i < 8; ++i) u2[i] = ca[i] * ha[i]; }
                float bg[8]; unpack8(bq[k], bg);
                float y[8];
#pragma unroll
                for (int i = 0; i < 8; ++i) y[i] = bg[i] * (w0[i] * u0[i] + w1[i] * u1[i] + w2[i] * u2[i]);
                *(v4u*)(Y + (size_t)r * DM + c0) = pack8(y);
                if (t >= TP - 2) { float* o = outp + ((size_t)(b * 2 + (t - (TP - 2)))) * DM + c0; *(f32x4*)o = (f32x4){u2[0], u2[1], u2[2], u2[3]}; *(f32x4*)(o + 4) = (f32x4){u2[4], u2[5], u2[6], u2[7]}; }
#pragma unroll
                for (int i = 0; i < 8; ++i) { u0[i] = u1[i]; u1[i] = u2[i]; }
            }
        } else if (ru < NBP * NRUN + NBP * NMETA) {
            const int mi = ru - NBP * NRUN, b = mi / NMETA, t = mi % NMETA, r = XROW0 + mi;
            load_u(BCH, r, c0, u2);
            if (t >= 1) load_u(BCH, r - 1, c0, u1); else {
#pragma unroll
                for (int i = 0; i < 8; ++i) u1[i] = 0.f; }
            if (t >= 2) load_u(BCH, r - 2, c0, u0); else {
#pragma unroll
                for (int i = 0; i < 8; ++i) u0[i] = 0.f; }
            (void)b;
            float bg[8]; unpack8(*(const v4u*)(BCH + (size_t)r * NA_IN + c0), bg);
            float y[8];
#pragma unroll
            for (int i = 0; i < 8; ++i) y[i] = bg[i] * (w0[i] * u0[i] + w1[i] * u1[i] + w2[i] * u2[i]);
            *(v4u*)(Y + (size_t)r * DM + c0) = pack8(y);
        } else {
            const int sb = ru - NBP * NRUN - NBP * NMETA, r = SROW0 + sb;
            load_u(BCH, r, c0, u2);
            const float* h0 = hist + ((size_t)(sb * 2 + 0)) * DM + c0; const float* h1 = hist + ((size_t)(sb * 2 + 1)) * DM + c0;
            const f32x4 a0 = *(const f32x4*)h0, a1 = *(const f32x4*)(h0 + 4), b0 = *(const f32x4*)h1, b1 = *(const f32x4*)(h1 + 4);
            u0[0] = a0.x; u0[1] = a0.y; u0[2] = a0.z; u0[3] = a0.w; u0[4] = a1.x; u0[5] = a1.y; u0[6] = a1.z; u0[7] = a1.w;
            u1[0] = b0.x; u1[1] = b0.y; u1[2] = b0.z; u1[3] = b0.w; u1[4] = b1.x; u1[5] = b1.y; u1[6] = b1.z; u1[7] = b1.w;
            float* o0 = outs + ((size_t)(sb * 2 + 0)) * DM + c0; float* o1 = outs + ((size_t)(sb * 2 + 1)) * DM + c0;
            *(f32x4*)o0 = b0; *(f32x4*)(o0 + 4) = b1;
            *(f32x4*)o1 = (f32x4){u2[0], u2[1], u2[2], u2[3]}; *(f32x4*)(o1 + 4) = (f32x4){u2[4], u2[5], u2[6], u2[7]};
            float bg[8]; unpack8(*(const v4u*)(BCH + (size_t)r * NA_IN + c0), bg);
            float y[8];
#pragma unroll
            for (int i = 0; i < 8; ++i) y[i] = bg[i] * (w0[i] * u0[i] + w1[i] * u1[i] + w2[i] * u2[i]);
            *(v4u*)(Y + (size_t)r * DM + c0) = pack8(y);
        }
    }
}

constexpr float QSCALE = 0.08838834764831845f;
__device__ __forceinline__ void rope_phase(const bf16* PROJ, const Ptrs& P, int gw, int NGW, int lane) {
    unsigned char* ws = P.ws;
    const f32x2* t128 = (const f32x2*)(ws + WS_TAB128); const f32x2* t64 = (const f32x2*)(ws + WS_TAB64);
    bf16* Qr = (bf16*)(ws + WS_QR); bf16* QI = (bf16*)(ws + WS_QI); bf16* KIb = (bf16*)(ws + WS_KIB); float* WI = (float*)(ws + WS_WI);
    bf16* Ks = (bf16*)(ws + WS_KS); bf16* Vs = (bf16*)(ws + WS_VS);
    for (int pr_ = gw; pr_ < NBP * SPAD; pr_ += NGW) {
        const size_t o = ((size_t)((pr_ / SPAD) * SP + (pr_ % SPAD))) * 512 + 8 * lane; *(v4u*)(Ks + o) = (v4u){0u, 0u, 0u, 0u}; *(v4u*)(Vs + o) = (v4u){0u, 0u, 0u, 0u}; }
    for (int r = gw; r < NROWS; r += NGW) {
        const bf16* pr = PROJ + (size_t)r * NB_PAD;
        int pi; float *ko, *vo, *iko; bf16* kib = nullptr; bf16 *ksq = nullptr, *vsq = nullptr;
        if (r < SROW0) { int b, t; row_bt(r, b, t); pi = t; ksq = Ks + ((size_t)(b * SP + t + SPAD)) * 512; vsq = Vs + ((size_t)(b * SP + t + SPAD)) * 512; ko = P.out + O_KP + ((size_t)(b * TP + t)) * 512; vo = P.out + O_VP + ((size_t)(b * TP + t)) * 512; iko = P.out + O_IKP + ((size_t)(b * TP + t)) * 64; kib = KIb + ((size_t)(b * KIROWS + t)) * 64; }
        else { const int sb = r - SROW0; pi = POS_SAMPLE_IDX; ko = P.out + O_KS + (size_t)sb * 512; vo = P.out + O_VS + (size_t)sb * 512; iko = P.out + O_IKS + (size_t)sb * 64; }
        const f32x2* c128 = t128 + (size_t)pi * 64; const f32x2* c64 = t64 + (size_t)pi * 32;
        const int hd = lane >> 2, sub = lane & 3, hk = hd & 3;
        const v4u q1a = *(const v4u*)(pr + hd * 128 + 16 * sub), q1b = *(const v4u*)(pr + hd * 128 + 16 * sub + 8), q2a = *(const v4u*)(pr + hd * 128 + 64 + 16 * sub), q2b = *(const v4u*)(pr + hd * 128 + 64 + 16 * sub + 8);
        const v4u k1a = *(const v4u*)(pr + 2048 + hk * 128 + 16 * sub), k1b = *(const v4u*)(pr + 2048 + hk * 128 + 16 * sub + 8), k2a = *(const v4u*)(pr + 2048 + hk * 128 + 64 + 16 * sub), k2b = *(const v4u*)(pr + 2048 + hk * 128 + 64 + 16 * sub + 8);
        const v4u vv = *(const v4u*)(pr + 2560 + 8 * lane);
        const v4u i1 = *(const v4u*)(pr + 3072 + hd * 64 + 8 * sub), i2 = *(const v4u*)(pr + 3072 + hd * 64 + 32 + 8 * sub);
        const v4u j1 = *(const v4u*)(pr + 4096 + 8 * sub), j2 = *(const v4u*)(pr + 4096 + 32 + 8 * sub);
        const v4u wq = *(const v4u*)(pr + 4160 + 8 * (lane & 1));
        f32x4 csq[8], csi[4];
#pragma unroll
        for (int i = 0; i < 8; ++i) csq[i] = *(const f32x4*)(c128 + 16 * sub + 2 * i);
#pragma unroll
        for (int i = 0; i < 4; ++i) csi[i] = *(const f32x4*)(c64 + 8 * sub + 2 * i);
        {
            float x1[16], x2[16], o1[16], o2[16];
            { float t8[8]; unpack8(q1a, t8);
#pragma unroll
              for (int i = 0; i < 8; ++i) x1[i] = t8[i]; unpack8(q1b, t8);
#pragma unroll
              for (int i = 0; i < 8; ++i) x1[8 + i] = t8[i]; unpack8(q2a, t8);
#pragma unroll
              for (int i = 0; i < 8; ++i) x2[i] = t8[i]; unpack8(q2b, t8);
#pragma unroll
              for (int i = 0; i < 8; ++i) x2[8 + i] = t8[i]; }
#pragma unroll
            for (int i = 0; i < 16; i += 2) { const f32x4 cs = csq[i >> 1];
                o1[i] = (x1[i] * cs.x - x2[i] * cs.y) * QSCALE; o2[i] = (x2[i] * cs.x + x1[i] * cs.y) * QSCALE;
                o1[i + 1] = (x1[i + 1] * cs.z - x2[i + 1] * cs.w) * QSCALE; o2[i + 1] = (x2[i + 1] * cs.z + x1[i + 1] * cs.w) * QSCALE; }
            bf16* qo = Qr + (size_t)r * DM + hd * 128 + 16 * sub;
            { float t8[8];
#pragma unroll
              for (int i = 0; i < 8; ++i) t8[i] = o1[i]; *(v4u*)qo = pack8(t8);
#pragma unroll
              for (int i = 0; i < 8; ++i) t8[i] = o1[8 + i]; *(v4u*)(qo + 8) = pack8(t8);
#pragma unroll
              for (int i = 0; i < 8; ++i) t8[i] = o2[i]; *(v4u*)(qo + 64) = pack8(t8);
#pragma unroll
              for (int i = 0; i < 8; ++i) t8[i] = o2[8 + i]; *(v4u*)(qo + 72) = pack8(t8); }
        }
        if (lane < 16) {
#pragma unroll
            for (int hf = 0; hf < 2; ++hf) { float x1[8], x2[8], o1[8], o2[8]; unpack8(hf ? k1b : k1a, x1); unpack8(hf ? k2b : k2a, x2);
#pragma unroll
                for (int i = 0; i < 8; i += 2) { const f32x4 cs = csq[4 * hf + (i >> 1)];
                    o1[i] = x1[i] * cs.x - x2[i] * cs.y; o2[i] = x2[i] * cs.x + x1[i] * cs.y; o1[i + 1] = x1[i + 1] * cs.z - x2[i + 1] * cs.w; o2[i + 1] = x2[i + 1] * cs.z + x1[i + 1] * cs.w; }
                float* kq = ko + hk * 128 + 16 * sub + 8 * hf;
                *(f32x4*)kq = (f32x4){o1[0], o1[1], o1[2], o1[3]}; *(f32x4*)(kq + 4) = (f32x4){o1[4], o1[5], o1[6], o1[7]};
                *(f32x4*)(kq + 64) = (f32x4){o2[0], o2[1], o2[2], o2[3]}; *(f32x4*)(kq + 68) = (f32x4){o2[4], o2[5], o2[6], o2[7]};
                if (ksq) { *(v4u*)(ksq + hk * 128 + 16 * sub + 8 * hf) = pack8(o1); *(v4u*)(ksq + hk * 128 + 64 + 16 * sub + 8 * hf) = pack8(o2); } }
        }
        {
            float vf[8]; unpack8(vv, vf);
            *(f32x4*)(vo + 8 * lane) = (f32x4){vf[0], vf[1], vf[2], vf[3]}; *(f32x4*)(vo + 8 * lane + 4) = (f32x4){vf[4], vf[5], vf[6], vf[7]};
            if (vsq) *(v4u*)(vsq + 8 * lane) = vv;
        }
        {
            float x1[8], x2[8], o1[8], o2[8]; unpack8(i1, x1); unpack8(i2, x2);
#pragma unroll
            for (int i = 0; i < 8; i += 2) { const f32x4 cs = csi[i >> 1];
                o1[i] = x1[i] * cs.x - x2[i] * cs.y; o2[i] = x2[i] * cs.x + x1[i] * cs.y; o1[i + 1] = x1[i + 1] * cs.z - x2[i + 1] * cs.w; o2[i + 1] = x2[i + 1] * cs.z + x1[i + 1] * cs.w; }
            *(v4u*)(QI + (size_t)r * 1024 + hd * 64 + 8 * sub) = pack8(o1); *(v4u*)(QI + (size_t)r * 1024 + hd * 64 + 32 + 8 * sub) = pack8(o2);
        }
        if (lane < 4) {
            float x1[8], x2[8], o1[8], o2[8]; unpack8(j1, x1); unpack8(j2, x2);
#pragma unroll
            for (int i = 0; i < 8; i += 2) { const f32x4 cs = csi[i >> 1];
                o1[i] = x1[i] * cs.x - x2[i] * cs.y; o2[i] = x2[i] * cs.x + x1[i] * cs.y; o1[i + 1] = x1[i + 1] * cs.z - x2[i + 1] * cs.w; o2[i + 1] = x2[i + 1] * cs.z + x1[i + 1] * cs.w; }
            float* io = iko + 8 * sub;
            *(f32x4*)io = (f32x4){o1[0], o1[1], o1[2], o1[3]}; *(f32x4*)(io + 4) = (f32x4){o1[4], o1[5], o1[6], o1[7]};
            *(f32x4*)(io + 32) = (f32x4){o2[0], o2[1], o2[2], o2[3]}; *(f32x4*)(io + 36) = (f32x4){o2[4], o2[5], o2[6], o2[7]};
            if (kib) { *(v4u*)(kib + 8 * sub) = pack8(o1); *(v4u*)(kib + 32 + 8 * sub) = pack8(o2); }
        } else if (lane < 6) {
            float wv[8]; unpack8(wq, wv); float* wo = WI + (size_t)r * 16 + 8 * (lane - 4);
            *(f32x4*)wo = (f32x4){wv[0], wv[1], wv[2], wv[3]}; *(f32x4*)(wo + 4) = (f32x4){wv[4], wv[5], wv[6], wv[7]};
        }
    }
}

__device__ __forceinline__ void indexer_prompt(const Ptrs& P, LAS unsigned char* lds, int tid, int wave, int lane) {
    unsigned char* ws = P.ws;
    const bf16* QI = (const bf16*)(ws + WS_QI); const bf16* KIb = (const bf16*)(ws + WS_KIB); const float* WI = (const float*)(ws + WS_WI); float* SC = (float*)(ws + WS_SC);
    const int n = lane & 31, h8 = lane >> 5;
    const int qsel = (n >> 2) & 1, head = (n & 3) + 4 * (n >> 3);
    constexpr int NG = TP / 16;
    constexpr int KROW = 144, TBUF = 128 * KROW;
    for (int it = blockIdx.x; it < 2 * NG; it += gridDim.x) {
        int b, qg;
        if (it < 256) { b = it & 1; qg = it >> 1; } else if (it < 512) { b = it & 1; qg = 256 - ((it - 256) >> 1); } else { b = it - 512; qg = 128; }
        const int t0 = 16 * qg + 2 * wave;
        const bf16* qa = QI + (size_t)prow(b, t0 + qsel) * 1024 + head * 64 + 8 * h8;
        bf16x8 a[4];
#pragma unroll
        for (int kk = 0; kk < 4; ++kk) a[kk] = *(const bf16x8*)(qa + 16 * kk);
        const int tq = t0 + h8;
        const float* wp = WI + (size_t)prow(b, tq) * 16;
        float w[16];
#pragma unroll
        for (int i = 0; i < 4; ++i) { const f32x4 x = *(const f32x4*)(wp + 4 * i); w[4 * i] = x.x; w[4 * i + 1] = x.y; w[4 * i + 2] = x.z; w[4 * i + 3] = x.w; }
        const int ntile = ((16 * qg + 15) >> 5) + 1, ntrip = (ntile + 3) >> 2;
        float* scrow = SC + ((size_t)(b * TP + tq)) * SCW;
        const bf16* kbase = KIb + (size_t)b * KIROWS * 64;
        const int p0 = tid, p1 = tid + 512;
        const int l0 = (p0 >> 3) * KROW + (p0 & 7) * 16, l1 = (p1 >> 3) * KROW + (p1 & 7) * 16;
        asm volatile("s_waitcnt lgkmcnt(0)\n\ts_barrier" ::: "memory");
        v4u g0 = *(const v4u*)(kbase + (size_t)p0 * 8), g1 = *(const v4u*)(kbase + (size_t)p1 * 8);
        *(LAS v4u*)(lds + l0) = g0; *(LAS v4u*)(lds + l1) = g1;
        for (int tr = 0; tr < ntrip; ++tr) {
            const int cur = tr & 1;
            if (tr + 1 < ntrip) { const size_t ko = (size_t)(tr + 1) * 128 * 64;
                const int kmax = KIROWS * 64 - 8;
                const size_t o0 = ko + (size_t)p0 * 8, o1 = ko + (size_t)p1 * 8;
                g0 = *(const v4u*)(kbase + (o0 <= (size_t)kmax ? o0 : (size_t)kmax)); g1 = *(const v4u*)(kbase + (o1 <= (size_t)kmax ? o1 : (size_t)kmax)); }
            asm volatile("s_waitcnt lgkmcnt(0)\n\ts_barrier" ::: "memory");
            const LAS unsigned char* kb = lds + cur * TBUF + n * KROW + h8 * 16;
#pragma unroll
            for (int u = 0; u < 4; ++u) {
                f32x16 acc;
#pragma unroll
                for (int i = 0; i < 16; ++i) acc[i] = 0.f;
#pragma unroll
                for (int kk = 0; kk < 4; ++kk) acc = __builtin_amdgcn_mfma_f32_32x32x16_bf16(a[kk], *(const LAS bf16x8*)(kb + u * 32 * KROW + kk * 32), acc, 0, 0, 0);
                float sc = 0.f;
#pragma unroll
                for (int i = 0; i < 16; ++i) sc += w[i] * fmaxf(acc[i], 0.f);
                const int s = 32 * (4 * tr + u) + n;
                if (s <= tq) scrow[s] = sc;
            }
            if (tr + 1 < ntrip) { *(LAS v4u*)(lds + (cur ^ 1) * TBUF + l0) = g0; *(LAS v4u*)(lds + (cur ^ 1) * TBUF + l1) = g1; }
        }
    }
    asm volatile("s_waitcnt lgkmcnt(0)\n\ts_barrier" ::: "memory");
}

__device__ __forceinline__ void indexer_sample(const Ptrs& P, LAS unsigned char* lds, int tid) {
    unsigned char* ws = P.ws;
    const bf16* QI = (const bf16*)(ws + WS_QI); const float* WI = (const float*)(ws + WS_WI); float* SCS = (float*)(ws + WS_SCS);
    LAS float* lq = (LAS float*)lds;
    LAS float* lw = lq + 1024;
    constexpr int NCH = (NSKEY + 511) / 512;
    for (int item = gridDim.x - 1 - blockIdx.x; item < SBN * NCH; item += gridDim.x) {
        const int sb = item / NCH, ch = item % NCH, r = SROW0 + sb;
        __syncthreads();
        for (int e = tid; e < 1024; e += NTHREADS) lq[e] = bf2f(QI[(size_t)r * 1024 + e]);
        if (tid < 16) lw[tid] = WI[(size_t)r * 16 + tid];
        __syncthreads();
        const int s = ch * 512 + tid;
        if (s < NSKEY) {
            const float* kr = (s < PAST) ? P.cache_ik + ((size_t)P.page_table[sb * NPG + (s >> 7)] * 128 + (s & 127)) * 64 : P.out + O_IKS + (size_t)sb * 64;
            f32x4 kv[16];
#pragma unroll
            for (int i = 0; i < 16; ++i) kv[i] = *(const f32x4*)(kr + 4 * i);
            float sc = 0.f;
            for (int h = 0; h < 16; ++h) { float d = 0.f;
#pragma unroll
                for (int i = 0; i < 16; ++i) { const f32x4 q = *(const LAS f32x4*)(lq + h * 64 + 4 * i); d += q.x * kv[i].x + q.y * kv[i].y + q.z * kv[i].z + q.w * kv[i].w; }
                sc += lw[h] * fmaxf(d, 0.f); }
            SCS[(size_t)sb * SCSW + s] = sc;
        }
    }
    __syncthreads();
}

__device__ __forceinline__ unsigned ordkey(float f) { const unsigned u = __float_as_uint(f); return (u & 0x80000000u) ? ~u : (u | 0x80000000u); }
constexpr int TOPK = 256;
__device__ __forceinline__ void topk_wave_mask(const float* sc, int n, unsigned long long* mrow, int lane) {
    constexpr int NS = MTW, M0 = SPAD / 64;
    static_assert(M0 == dattn::JLO, "first real key tile");
    unsigned key[NS];
#pragma unroll
    for (int m = M0; m < NS; ++m) { const int sidx = lane + 64 * m - SPAD; const int ci = sidx < 0 ? 0 : (sidx < n ? sidx : n - 1); const float v = sc[ci]; key[m] = (sidx >= 0 && sidx < n) ? ordkey(v) : 0u; }
    if (n <= TOPK) {
#pragma unroll
        for (int m = M0; m < NS; ++m) { const unsigned long long w = __ballot(key[m] != 0u); if (lane == 0) mrow[m] = w; }
        return;
    }
    unsigned T = 0u;
    for (int bit = 31; bit >= 0; --bit) {
        const unsigned cand = T | (1u << bit); int c = 0, cv = 0;
#pragma unroll
        for (int m = M0; m < NS; ++m) { if ((m & 1) != 0) c += __popcll(__ballot(key[m] >= cand)); else cv += (key[m] >= cand) ? 1 : 0; }
        c += wave_sum_dpp_i(cv);
        if (c >= TOPK) T = cand;
    }
    int cg = 0;
#pragma unroll
    for (int m = M0; m < NS; ++m) cg += __popcll(__ballot(key[m] > T));
    const int need = TOPK - cg;
    int base_e = 0;
    const unsigned long long lt = (1ull << lane) - 1ull;
#pragma unroll
    for (int m = M0; m < NS; ++m) {
        const bool pg = key[m] > T, pe = key[m] == T;
        const unsigned long long me = __ballot(pe);
        const int pre_e = __popcll(me & lt);
        const unsigned long long w = __ballot(pg || (pe && (base_e + pre_e) < need));
        if (lane == 0) mrow[m] = w;
        base_e += __popcll(me);
    }
}
__device__ __forceinline__ void topk_block(const float* sc, int n, int* outIdx, int* outCnt, LAS unsigned* ls, int tid, int wave, int lane) {
    constexpr int NS = (NSKEY + NTHREADS - 1) / NTHREADS;
    unsigned key[NS];
#pragma unroll
    for (int m = 0; m < NS; ++m) { const int e = tid + NTHREADS * m; const float v = sc[e < n ? e : n - 1]; key[m] = (e < n) ? ordkey(v) : 0u; }
    unsigned T = 0u;
    for (int bit = 31; bit >= 0; --bit) {
        const unsigned cand = T | (1u << bit); int c = 0;
#pragma unroll
        for (int m = 0; m < NS; ++m) c += (key[m] >= cand) ? 1 : 0;
        c = wave_sum_dpp_i(c);
        LAS unsigned* buf = ls + (bit & 1) * 8;
        if (lane == 0) buf[wave] = (unsigned)c;
        __syncthreads();
        int tot = 0;
#pragma unroll
        for (int w = 0; w < 8; ++w) tot += (int)buf[w];
        if (tot >= TOPK) T = cand;
    }
    __syncthreads();
    if (tid == 0) { unsigned z_ = 0u; asm volatile("" : "+v"(z_)); ls[16] = z_; ls[17] = z_; }
    __syncthreads();
#pragma unroll
    for (int m = 0; m < NS; ++m) { const int e = tid + NTHREADS * m; if (key[m] > T) { const unsigned pos = atomicAdd((unsigned*)(ls + 16), 1u); if (pos < (unsigned)TOPK) outIdx[pos] = e; } }
    __syncthreads();
    const unsigned cg = ls[16];
    const unsigned need = (unsigned)TOPK - cg;
#pragma unroll
    for (int m = 0; m < NS; ++m) { const int e = tid + NTHREADS * m; if (key[m] == T) { const unsigned pos = atomicAdd((unsigned*)(ls + 17), 1u); if (pos < need) outIdx[cg + pos] = e; } }
    if (tid == 0) *outCnt = TOPK;
    __syncthreads();
}
__device__ __forceinline__ void select_phase(const Ptrs& P, LAS unsigned char* lds, int gw, int NGW, int tid, int wave, int lane) {
    unsigned char* ws = P.ws;
    const float* SC = (const float*)(ws + WS_SC); const float* SCS = (const float*)(ws + WS_SCS); int* IDXL = (int*)(ws + WS_IDXL); int* CNT = (int*)(ws + WS_CNT);
    for (int sb = blockIdx.x; sb < SBN; sb += gridDim.x) topk_block(SCS + (size_t)sb * SCSW, NSKEY, IDXL + (size_t)(SROW0 + sb) * TOPK, CNT + SROW0 + sb, (LAS unsigned*)lds, tid, wave, lane);
    unsigned long long* MASK = (unsigned long long*)(ws + WS_MASK);
    for (int r = gw; r < SROW0; r += NGW) { int b, t; row_bt(r, b, t);
        if (r < XROW0) topk_wave_mask(SC + ((size_t)(b * TP + t)) * SCW, t + 1, MASK + ((size_t)(b * SP + t + SPAD)) * MTW, lane);
        else { if (lane <= t) IDXL[(size_t)r * TOPK + lane] = lane; if (lane == 0) CNT[r] = t + 1; } }
}

__device__ __forceinline__ void attn_phase(const Ptrs& P, bf16* O, LAS unsigned char* lds, int gw, int NGW, int wave, int lane) {
    unsigned char* ws = P.ws;
    const bf16* Qr = (const bf16*)(ws + WS_QR); const int* IDXL = (const int*)(ws + WS_IDXL); const int* CNT = (const int*)(ws + WS_CNT);
    LAS float* lq = (LAS float*)(lds + wave * 12288);
    LAS f32x4* lp = (LAS f32x4*)(lds + wave * 12288 + 2048);
    LAS unsigned long long* lkp = (LAS unsigned long long*)(lds + wave * 12288 + 6144);
    LAS unsigned long long* lvp = (LAS unsigned long long*)(lds + wave * 12288 + 8192);
    for (int item = gw; item < (NROWS - XROW0) * 4; item += NGW) {
        const int r = XROW0 + (item >> 2), n = item & 3;
        const int cnt = CNT[r];
        WAVE_SYNC();
        { float qf[8]; unpack8(*(const v4u*)(Qr + (size_t)r * DM + n * 512 + 8 * lane), qf);
          *(LAS f32x4*)(lq + 8 * lane) = (f32x4){qf[0], qf[1], qf[2], qf[3]}; *(LAS f32x4*)(lq + 8 * lane + 4) = (f32x4){qf[4], qf[5], qf[6], qf[7]}; }
        const float* kp[4];
#pragma unroll
        for (int j = 0; j < 4; ++j) {
            const int e = lane + 64 * j; const int s = (e < cnt) ? IDXL[(size_t)r * TOPK + e] : 0;
            const float *kq, *vq;
            if (r < SROW0) { const int b = (r < XROW0) ? (r >> 12) : ((r - XROW0) >> 4); kq = P.out + O_KP + ((size_t)(b * TP + s)) * 512; vq = P.out + O_VP + ((size_t)(b * TP + s)) * 512; }
            else { const int sb = r - SROW0;
                if (s < PAST) { const size_t off = ((size_t)P.page_table[sb * NPG + (s >> 7)] * 128 + (s & 127)) * 512; kq = P.cache_k + off; vq = P.cache_v + off; }
                else { kq = P.out + O_KS + (size_t)sb * 512; vq = P.out + O_VS + (size_t)sb * 512; } }
            kp[j] = kq + n * 128; lkp[e] = (unsigned long long)(kq + n * 128); lvp[e] = (unsigned long long)(vq + n * 128);
        }
        WAVE_SYNC();
        float acc[4][4];
#pragma unroll
        for (int g = 0; g < 4; ++g)
#pragma unroll
            for (int j = 0; j < 4; ++j) acc[g][j] = 0.f;
#pragma unroll 4
        for (int d4 = 0; d4 < 32; ++d4) {
            f32x4 qv[4];
#pragma unroll
            for (int g = 0; g < 4; ++g) qv[g] = *(const LAS f32x4*)(lq + g * 128 + 4 * d4);
#pragma unroll
            for (int j = 0; j < 4; ++j) { const f32x4 kv = *(const f32x4*)(kp[j] + 4 * d4);
#pragma unroll
                for (int g = 0; g < 4; ++g) acc[g][j] += qv[g].x * kv.x + qv[g].y * kv.y + qv[g].z * kv.z + qv[g].w * kv.w; }
        }
        float linv[4];
#pragma unroll
        for (int g = 0; g < 4; ++g) {
            float m = -INFINITY;
#pragma unroll
            for (int j = 0; j < 4; ++j) { if (lane + 64 * j >= cnt) acc[g][j] = -INFINITY; m = fmaxf(m, acc[g][j]); }
            m = wave_max(m); float l = 0.f;
#pragma unroll
            for (int j = 0; j < 4; ++j) { acc[g][j] = __expf(acc[g][j] - m); l += acc[g][j]; }
            linv[g] = 1.f / wave_sum(l);
        }
#pragma unroll
        for (int j = 0; j < 4; ++j) lp[lane + 64 * j] = (f32x4){acc[0][j], acc[1][j], acc[2][j], acc[3][j]};
        WAVE_SYNC();
        float o[4][2];
#pragma unroll
        for (int g = 0; g < 4; ++g) { o[g][0] = 0.f; o[g][1] = 0.f; }
#pragma unroll 8
        for (int e = 0; e < cnt; ++e) {
            const float* vp = (const float*)lvp[e]; const f32x2 vv = *(const f32x2*)(vp + 2 * lane); const f32x4 p = lp[e];
            o[0][0] += p.x * vv.x; o[0][1] += p.x * vv.y; o[1][0] += p.y * vv.x; o[1][1] += p.y * vv.y; o[2][0] += p.z * vv.x; o[2][1] += p.z * vv.y; o[3][0] += p.w * vv.x; o[3][1] += p.w * vv.y;
        }
#pragma unroll
        for (int g = 0; g < 4; ++g) *(unsigned*)(O + (size_t)r * DM + (4 * n + g) * 128 + 2 * lane) = pk2(o[g][0] * linv[g], o[g][1] * linv[g]);
    }
}

__device__ __forceinline__ void convC_finish(float (&acc)[8], int it) {
    float ss = 0.f;
#pragma unroll
    for (int i = 0; i < 8; ++i) { acc[i] = silu_f(acc[i]); ss += acc[i] * acc[i]; }
    if (it < 8) { ss = row16_sum(ss); float rn = 1.f / sqrtf(ss + RMS_EPS); if (it < 4) rn *= QSCALE;
#pragma unroll
        for (int i = 0; i < 8; ++i) acc[i] *= rn; }
}
__device__ __forceinline__ void convC_phase(const bf16* PROJC, const Ptrs& P, int gw, int NGW, int lane) {
    unsigned char* ws = P.ws;
    bf16* QKVC = (bf16*)(ws + WS_QKVC); float* QKF = (float*)(ws + WS_QKF); float* G = (float*)(ws + WS_G); float* BETA = (float*)(ws + WS_BETA);
    const float* cw = P.conv_w_c;
    constexpr int RUN = 8, NRUN = SEQ / RUN;
    for (int item = gw; item < 16 * NBP * NRUN; item += NGW) {
        const int it = item & 15, ru = item >> 4, b = ru / NRUN, t0 = NMETA + (ru % NRUN) * RUN, ch0 = it * 512 + 8 * lane;
        float w[4][8];
#pragma unroll
        for (int j = 0; j < 4; ++j) { const f32x4 w0 = *(const f32x4*)(cw + (size_t)j * CDIM + ch0), w1 = *(const f32x4*)(cw + (size_t)j * CDIM + ch0 + 4);
            w[j][0] = w0.x; w[j][1] = w0.y; w[j][2] = w0.z; w[j][3] = w0.w; w[j][4] = w1.x; w[j][5] = w1.y; w[j][6] = w1.z; w[j][7] = w1.w; }
        const int r0 = prow(b, t0);
        v4u xr[RUN + 3];
#pragma unroll
        for (int j = 0; j < 3; ++j) { const int tt = t0 - 3 + j; xr[j] = tt >= 0 ? *(const v4u*)(PROJC + (size_t)prow(b, tt) * NC_PAD + ch0) : (v4u){0u, 0u, 0u, 0u}; }
#pragma unroll
        for (int k = 0; k < RUN; ++k) xr[3 + k] = *(const v4u*)(PROJC + (size_t)(r0 + k) * NC_PAD + ch0);
        float x[RUN + 3][8];
#pragma unroll
        for (int j = 0; j < RUN + 3; ++j) unpack8(xr[j], x[j]);
#pragma unroll
        for (int k = 0; k < RUN; ++k) {
            float acc[8];
#pragma unroll
            for (int i = 0; i < 8; ++i) acc[i] = w[0][i] * x[k][i] + w[1][i] * x[k + 1][i] + w[2][i] * x[k + 2][i] + w[3][i] * x[k + 3][i];
            convC_finish(acc, it);
            *(v4u*)(QKVC + (size_t)(r0 + k) * CDIM + ch0) = pack8(acc);
            const int t = t0 + k;
            if (t >= TP - 3) { float* o = P.out + O_CCP + ((size_t)(b * 3 + (t - (TP - 3)))) * CDIM + ch0;
                *(f32x4*)o = (f32x4){x[k + 3][0], x[k + 3][1], x[k + 3][2], x[k + 3][3]}; *(f32x4*)(o + 4) = (f32x4){x[k + 3][4], x[k + 3][5], x[k + 3][6], x[k + 3][7]}; }
        }
    }
    for (int item = gw; item < 16 * NBP * NMETA; item += NGW) {
        const int it = item & 15, mi = item >> 4, t = mi % NMETA, r = XROW0 + mi, ch0 = it * 512 + 8 * lane;
        float x[4][8];
#pragma unroll
        for (int j = 0; j < 4; ++j) { const int tt = t - 3 + j; if (tt >= 0) unpack8(*(const v4u*)(PROJC + (size_t)(r - 3 + j) * NC_PAD + ch0), x[j]); else {
#pragma unroll
                for (int i = 0; i < 8; ++i) x[j][i] = 0.f; } }
        float acc[8];
#pragma unroll
        for (int i = 0; i < 8; ++i) acc[i] = 0.f;
#pragma unroll
        for (int j = 0; j < 4; ++j) { const f32x4 w0 = *(const f32x4*)(cw + (size_t)j * CDIM + ch0), w1 = *(const f32x4*)(cw + (size_t)j * CDIM + ch0 + 4);
            acc[0] += w0.x * x[j][0]; acc[1] += w0.y * x[j][1]; acc[2] += w0.z * x[j][2]; acc[3] += w0.w * x[j][3];
            acc[4] += w1.x * x[j][4]; acc[5] += w1.y * x[j][5]; acc[6] += w1.z * x[j][6]; acc[7] += w1.w * x[j][7]; }
        convC_finish(acc, it);
        *(v4u*)(QKVC + (size_t)r * CDIM + ch0) = pack8(acc);
    }
    for (int item = gw; item < 16 * SBN; item += NGW) {
        const int it = item & 15, sb = item >> 4, r = SROW0 + sb, ch0 = it * 512 + 8 * lane;
        float x[4][8];
#pragma unroll
        for (int j = 0; j < 3; ++j) { const float* hp = P.state_conv_c + ((size_t)(sb * 3 + j)) * CDIM + ch0; const f32x4 a = *(const f32x4*)hp, c = *(const f32x4*)(hp + 4);
            x[j][0] = a.x; x[j][1] = a.y; x[j][2] = a.z; x[j][3] = a.w; x[j][4] = c.x; x[j][5] = c.y; x[j][6] = c.z; x[j][7] = c.w; }
        unpack8(*(const v4u*)(PROJC + (size_t)r * NC_PAD + ch0), x[3]);
        float acc[8];
#pragma unroll
        for (int i = 0; i < 8; ++i) acc[i] = 0.f;
#pragma unroll
        for (int j = 0; j < 4; ++j) { const f32x4 w0 = *(const f32x4*)(cw + (size_t)j * CDIM + ch0), w1 = *(const f32x4*)(cw + (size_t)j * CDIM + ch0 + 4);
            acc[0] += w0.x * x[j][0]; acc[1] += w0.y * x[j][1]; acc[2] += w0.z * x[j][2]; acc[3] += w0.w * x[j][3];
            acc[4] += w1.x * x[j][4]; acc[5] += w1.y * x[j][5]; acc[6] += w1.z * x[j][6]; acc[7] += w1.w * x[j][7]; }
        convC_finish(acc, it);
        if (it < 8) { float* qk = QKF + (size_t)r * 4096 + ch0; *(f32x4*)qk = (f32x4){acc[0], acc[1], acc[2], acc[3]}; *(f32x4*)(qk + 4) = (f32x4){acc[4], acc[5], acc[6], acc[7]}; }
        *(v4u*)(QKVC + (size_t)r * CDIM + ch0) = pack8(acc);
        float* o = P.out + O_CCS + ((size_t)(sb * 3)) * CDIM + ch0;
#pragma unroll
        for (int j = 0; j < 3; ++j) { *(f32x4*)(o + (size_t)j * CDIM) = (f32x4){x[j + 1][0], x[j + 1][1], x[j + 1][2], x[j + 1][3]}; *(f32x4*)(o + (size_t)j * CDIM + 4) = (f32x4){x[j + 1][4], x[j + 1][5], x[j + 1][6], x[j + 1][7]}; }
    }
    for (int e = gw * 64 + lane; e < NROWS * 32; e += NGW * 64) {
        const int r = e >> 5, h = e & 31;
        const float braw = bf2f(PROJC[(size_t)r * NC_PAD + 12288 + h]), araw = bf2f(PROJC[(size_t)r * NC_PAD + 12320 + h]);
        const float xx = araw + P.dt_bias[h]; const float sp = xx > 20.f ? xx : __logf(1.f + __expf(xx));
        G[e] = -__expf(P.a_log[h]) * sp; BETA[e] = 1.f / (1.f + __expf(-braw));
    }
}

struct Tok { f32x4 k0, k1, q0, q1; unsigned v; float g, b; };
__device__ __forceinline__ void tok_load(Tok& T, const float* QKF, const bf16* QKVC, const float* G, const float* BETA, int row, int h, int rg, int col0) {
    const float* base = QKF + (size_t)row * 4096 + (h >> 1) * 128 + 8 * rg;
    T.q0 = *(const f32x4*)base; T.q1 = *(const f32x4*)(base + 4); T.k0 = *(const f32x4*)(base + 2048); T.k1 = *(const f32x4*)(base + 2052);
    T.v = *(const unsigned*)(QKVC + (size_t)row * CDIM + 4096 + h * 128 + col0);
    T.g = G[(size_t)row * 32 + h]; T.b = BETA[(size_t)row * 32 + h];
}
__device__ __forceinline__ f32x2 tok_step(f32x2 (&S)[8], const Tok& T) {
    const float kk[8] = {T.k0.x, T.k0.y, T.k0.z, T.k0.w, T.k1.x, T.k1.y, T.k1.z, T.k1.w};
    const float qq[8] = {T.q0.x, T.q0.y, T.q0.z, T.q0.w, T.q1.x, T.q1.y, T.q1.z, T.q1.w};
    const float a = __expf(T.g);
    f32x2 d0 = S[0] * kk[0], d1 = S[1] * kk[1];
#pragma unroll
    for (int i = 2; i < 8; i += 2) { d0 += S[i] * kk[i]; d1 += S[i + 1] * kk[i + 1]; }
    f32x2 d = d0 + d1;
    d.x = row16_sum(d.x); d.y = row16_sum(d.y);
    const f32x2 tv = {bflo(T.v), bfhi(T.v)};
    const f32x2 dl = (tv - d * a) * T.b;
    f32x2 o0 = {0.f, 0.f}, o1 = {0.f, 0.f};
#pragma unroll
    for (int i = 0; i < 8; i += 2) { S[i] = S[i] * a + dl * kk[i]; o0 += S[i] * qq[i]; S[i + 1] = S[i + 1] * a + dl * kk[i + 1]; o1 += S[i + 1] * qq[i + 1]; }
    f32x2 o = o0 + o1;
    o.x = row16_sum(o.x); o.y = row16_sum(o.y);
    return o;
}
__device__ __forceinline__ void delta_phase(const Ptrs& P, int wave, int lane) {
    unsigned char* ws = P.ws;
    const bf16* QKVC = (const bf16*)(ws + WS_QKVC); const float* QKF = (const float*)(ws + WS_QKF); const float* G = (const float*)(ws + WS_G); const float* BETA = (const float*)(ws + WS_BETA); bf16* OF = (bf16*)(ws + WS_SC);
    const int cg = lane >> 4, rg = lane & 15;
    {
        for (int item = blockIdx.x * 8 + wave; item < SBN * 32 * 16; item += gridDim.x * 8) {
            const int sb = item >> 9, h = (item >> 4) & 31, col0 = 8 * (item & 15) + 2 * cg;
            const size_t so = ((size_t)((sb * 32 + h) * 128 + 8 * rg)) * 128 + col0;
            f32x2 S[8];
#pragma unroll
            for (int i = 0; i < 8; ++i) S[i] = *(const f32x2*)(P.state_delta + so + (size_t)i * 128);
            Tok T; tok_load(T, QKF, QKVC, G, BETA, SROW0 + sb, h, rg, col0);
            const f32x2 o = tok_step(S, T);
            if (rg == 0) *(unsigned*)(OF + (size_t)(SROW0 + sb) * DVW + h * 128 + col0) = pk2(o.x, o.y);
            float* op = P.out + O_DS + so;
#pragma unroll
            for (int i = 0; i < 8; ++i) *(f32x2*)(op + (size_t)i * 128) = S[i];
        }
    }
}
__device__ __forceinline__ void normC_piece(const v4u oq, const v4u zz, const float (&nw)[8], bf16* yo) {
    float o[8]; unpack8(oq, o);
    float ss = 0.f;
#pragma unroll
    for (int i = 0; i < 8; ++i) ss += o[i] * o[i];
    ss = row16_sum(ss);
    const float rs = 1.f / sqrtf(ss * (1.f / 128.f) + RMS_EPS);
    float z[8]; unpack8(zz, z);
#pragma unroll
    for (int i = 0; i < 8; ++i) o[i] = o[i] * rs * nw[i] * silu_f(z[i]);
    *(v4u*)yo = pack8(o);
}
__device__ __forceinline__ void normC_phase(const bf16* PROJC, bf16* Y, const Ptrs& P, int gw, int NGW, int lane) {
    const bf16* OF = (const bf16*)(P.ws + WS_SC);
    const int d0 = 8 * (lane & 15), hl = lane >> 4;
    float nw[8];
    { const f32x4 a = *(const f32x4*)(P.norm_w + d0), b = *(const f32x4*)(P.norm_w + d0 + 4); nw[0] = a.x; nw[1] = a.y; nw[2] = a.z; nw[3] = a.w; nw[4] = b.x; nw[5] = b.y; nw[6] = b.z; nw[7] = b.w; }
    for (int it = gw; it < (NROWS - XROW0) * 8; it += NGW) { const int r = XROW0 + (it >> 3), hd = (it & 7) * 4 + hl;
        const v4u oq = *(const v4u*)(OF + (size_t)r * DVW + hd * 128 + d0), zz = *(const v4u*)(PROJC + (size_t)r * NC_PAD + 8192 + hd * 128 + d0);
        normC_piece(oq, zz, nw, Y + (size_t)r * DVW + hd * 128 + d0); }
    for (int r = gw; r < XROW0; r += 2 * NGW) {
        const int r2 = (r + NGW < XROW0) ? r + NGW : r; const bool two = r + NGW < XROW0;
        v4u oa[8], za[8], ob[8], zb[8];
#pragma unroll
        for (int it = 0; it < 8; ++it) { const int hd = it * 4 + hl;
            oa[it] = *(const v4u*)(OF + (size_t)r * DVW + hd * 128 + d0); za[it] = *(const v4u*)(PROJC + (size_t)r * NC_PAD + 8192 + hd * 128 + d0);
            ob[it] = *(const v4u*)(OF + (size_t)r2 * DVW + hd * 128 + d0); zb[it] = *(const v4u*)(PROJC + (size_t)r2 * NC_PAD + 8192 + hd * 128 + d0); }
#pragma unroll
        for (int it = 0; it < 8; ++it) { const int hd = it * 4 + hl;
            normC_piece(oa[it], za[it], nw, Y + (size_t)r * DVW + hd * 128 + d0);
            if (two) normC_piece(ob[it], zb[it], nw, Y + (size_t)r2 * DVW + hd * 128 + d0); }
    }
}


__device__ __forceinline__ void dense_attn_phase(const Ptrs& P, bf16* O, char* lds, int wv) {
    unsigned char* ws = P.ws;
    const bf16* Qr = (const bf16*)(ws + WS_QR); const bf16* Ks = (const bf16*)(ws + WS_KS); const bf16* Vs = (const bf16*)(ws + WS_VS);
    const unsigned long long* MASK = (const unsigned long long*)(ws + WS_MASK);
    typedef dattn::BlockRef<bf16, bf16> BR;
    for (int it0 = blockIdx.x; it0 < 256; it0 += gridDim.x) {
        const int grp = it0 & 7, idx = it0 >> 3;
        const int b = grp >> 2, kvh = grp & 3, h = kvh * 4 + (idx >> 3), x = idx & 7;
        BR A, B;
        const int qa = 1 + x, qb = 16 - x;
        A.Q = Qr + ((size_t)(b * SEQ + 256 * (qa - 1))) * DM + h * 128; A.O = O + ((size_t)(b * SEQ + 256 * (qa - 1))) * DM + h * 128;
        B.Q = Qr + ((size_t)(b * SEQ + 256 * (qb - 1))) * DM + h * 128; B.O = O + ((size_t)(b * SEQ + 256 * (qb - 1))) * DM + h * 128;
        A.K = B.K = Ks + (size_t)b * SP * 512 + kvh * 128; A.V = B.V = Vs + (size_t)b * SP * 512 + kvh * 128;
        A.P0 = 256 * qa; B.P0 = 256 * qb;
        A.M = MASK + ((size_t)(b * SP + A.P0)) * MTW; B.M = MASK + ((size_t)(b * SP + B.P0)) * MTW;
        dattn::Seam<bf16> S;
        dattn::causal_swa_prime<bf16, bf16>(A, SP, lds, S, wv);
        dattn::causal_swa_block<bf16, bf16>(A, B, SP, SP, lds, S, wv);
        dattn::causal_swa_block<bf16, bf16>(B, B, SP, SP, lds, S, wv);
    }
}

constexpr int NCH = 65, CPAD = 48;
constexpr int NUQ = NBP * 16 * NCH, NUH = NBP * 32 * NCH;
__device__ __forceinline__ int crow32(int r, int hi) { return (r & 3) + 8 * (r >> 2) + 4 * hi; }
__device__ __forceinline__ int chunk_row(int b, int c, int i) { const int t = 64 * c + i - CPAD; return t >= 0 ? prow(b, t) : -1; }
__device__ __forceinline__ float incl_scan64(float v, int lane) {
#pragma unroll
    for (int o = 1; o < 64; o <<= 1) { const float u = __shfl_up(v, o); if (lane >= o) v += u; }
    return v;
}
#define MFMA32(a, b, c) __builtin_amdgcn_mfma_f32_32x32x16_bf16((a), (b), (c), 0, 0, 0)
__device__ __forceinline__ bf16x8 sel8(bool ok, bf16x8 v) { const bf16x8 z = {0, 0, 0, 0, 0, 0, 0, 0}; return ok ? v : z; }
__device__ __forceinline__ int sw23(int x) { return (x & ~12) | ((x & 4) << 1) | ((x & 8) >> 1); }
__device__ __forceinline__ int fidx64(int row, int xs) { return ((((row >> 5) * 2 + (xs >> 5)) * 2 + ((xs >> 4) & 1)) * 64 + (row & 31) + 32 * ((xs >> 3) & 1)) * 8 + (xs & 7); }

__device__ __forceinline__ v4u pack_frag(const f32x16& x, int s) { v4u w; w.x = pk2(x[8 * s], x[8 * s + 1]); w.y = pk2(x[8 * s + 2], x[8 * s + 3]); w.z = pk2(x[8 * s + 4], x[8 * s + 5]); w.w = pk2(x[8 * s + 6], x[8 * s + 7]); return w; }
__device__ __forceinline__ void stage_out8k(LAS unsigned char* stg, bf16* gdst, int lane) {
    WAVE_SYNC();
#pragma unroll
    for (int k = 0; k < 8; ++k) *(v4u*)(gdst + k * 512 + lane * 8) = *(const LAS v4u*)(stg + k * 1024 + lane * 16);
    WAVE_SYNC();
}
__device__ __forceinline__ void delta_d1_unit(unsigned char* ws, LAS unsigned char* lds, int uq, int wave, int lane) {
    asm volatile("" : "+v"(lane));
    const bf16* QKVC = (const bf16*)(ws + WS_QKVC); const float* G = (const float*)(ws + WS_G); const float* BETA = (const float*)(ws + WS_BETA);
    float* AF = (float*)(ws + WS_DAF); bf16* PG = (bf16*)(ws + WS_DPG); bf16* KT = (bf16*)(ws + WS_DKT); bf16* VT = (bf16*)(ws + WS_DVT);
    float* GC = (float*)(ws + WS_DGC); float* BT = (float*)(ws + WS_DBT);
    LAS float* lg = (LAS float*)(lds + wave * 16384);
    LAS unsigned char* stg = lds + wave * 16384 + 2048; LAS bf16* st = (LAS bf16*)stg;
    const int m = lane & 31, half = lane >> 5;
    const bf16x8 zf = {0, 0, 0, 0, 0, 0, 0, 0};
    {
        const int c = uq % NCH, bh = uq / NCH, hq = bh & 15, b = bh >> 4;
        { const int row = chunk_row(b, c, lane);
#pragma unroll
          for (int hh = 0; hh < 2; ++hh) { const int h = 2 * hq + hh; const float g = row >= 0 ? G[(size_t)row * 32 + h] : 0.f, bt = row >= 0 ? BETA[(size_t)row * 32 + h] : 0.f;
              const float gc = incl_scan64(g, lane); lg[hh * 64 + lane] = gc; lg[128 + hh * 64 + lane] = bt;
              const size_t uh = ((size_t)(b * 32 + h)) * NCH + c; GC[uh * 64 + lane] = gc; BT[uh * 64 + lane] = bt; } }
        const int row0 = chunk_row(b, c, m), row1 = chunk_row(b, c, 32 + m);
        const bf16* r0 = QKVC + (size_t)(row0 < 0 ? 0 : row0) * CDIM; const bf16* r1 = QKVC + (size_t)(row1 < 0 ? 0 : row1) * CDIM;
        f32x16 kk00, kk10, kk11, qk00, qk10, qk11;
#pragma unroll
        for (int i = 0; i < 16; ++i) { kk00[i] = 0.f; kk10[i] = 0.f; kk11[i] = 0.f; qk00[i] = 0.f; qk10[i] = 0.f; qk11[i] = 0.f; }
        const int sm = sw23(m);
        const int ktl = half * 32 + ((sm >> 4) & 1) * 512 + ((sm >> 3) & 1) * 256 + (sm & 7);
#pragma unroll 1
        for (int kh = 0; kh < 2; ++kh) {
            bf16x8 kf0[4], kf1[4], qf0[4], qf1[4];
#pragma unroll
            for (int u = 0; u < 4; ++u) { const int off = hq * 128 + 16 * (4 * kh + u) + 8 * half;
                kf0[u] = sel8(row0 >= 0, *(const bf16x8*)(r0 + 2048 + off)); kf1[u] = sel8(row1 >= 0, *(const bf16x8*)(r1 + 2048 + off));
                qf0[u] = sel8(row0 >= 0, *(const bf16x8*)(r0 + off)); qf1[u] = sel8(row1 >= 0, *(const bf16x8*)(r1 + off)); }
#pragma unroll
            for (int u = 0; u < 4; ++u) { const int ks = 4 * kh + u; const bf16x8 k0 = kf0[u], k1 = kf1[u], q0 = qf0[u], q1 = qf1[u];
                kk00 = MFMA32(k0, k0, kk00); kk10 = MFMA32(k1, k0, kk10); kk11 = MFMA32(k1, k1, kk11);
                qk00 = MFMA32(q0, k0, qk00); qk10 = MFMA32(q1, k0, qk10); qk11 = MFMA32(q1, k1, qk11);
                LAS bf16* kb = st + ktl + ((ks >> 1) & 1) * 2048 + (ks & 1) * 128;
#pragma unroll
                for (int e = 0; e < 8; ++e) { kb[(8 * (e >> 2) + (e & 3)) * 8] = (bf16)k0[e]; kb[1024 + (8 * (e >> 2) + (e & 3)) * 8] = (bf16)k1[e]; } }
            stage_out8k(stg, KT + (size_t)uq * 8192 + kh * 4096, lane);
        }
#pragma unroll 1
        for (int hh = 0; hh < 2; ++hh) { const int h = 2 * hq + hh; bf16* vt = VT + (((size_t)(b * 32 + h)) * NCH + c) * 8192;
            const int vtl = half * 64 + ((sm >> 4) & 1) * 512 + ((sm >> 3) & 1) * 256 + (sm & 7);
            bf16x8 vf0[8], vf1[8];
#pragma unroll
            for (int ks = 0; ks < 8; ++ks) { const int off = 4096 + h * 128 + 16 * ks + 8 * half; vf0[ks] = sel8(row0 >= 0, *(const bf16x8*)(r0 + off)); vf1[ks] = sel8(row1 >= 0, *(const bf16x8*)(r1 + off)); }
#pragma unroll
            for (int kh = 0; kh < 2; ++kh) {
#pragma unroll
                for (int u = 0; u < 4; ++u) { const int ks = 4 * kh + u; LAS bf16* vb = st + vtl + ((ks >> 1) & 1) * 2048 + (ks & 1) * 128;
#pragma unroll
                    for (int e = 0; e < 8; ++e) { vb[e * 8] = (bf16)vf0[ks][e]; vb[1024 + e * 8] = (bf16)vf1[ks][e]; } }
                stage_out8k(stg, vt + kh * 4096, lane);
            } }
        WAVE_SYNC();
#pragma unroll 1
        for (int hh = 0; hh < 2; ++hh) { const int h = 2 * hq + hh; const size_t uh = ((size_t)(b * 32 + h)) * NCH + c;
            float* af = AF + uh * 4096 + half * 256 + m;
            LAS bf16* pg = st + ktl;
            const float gcj0 = lg[hh * 64 + m], gcj1 = lg[hh * 64 + 32 + m];
#pragma unroll
            for (int r = 0; r < 16; ++r) { const int ir = crow32(r, half), rc = (r & 3) + 8 * (r >> 2);
                const float gi0 = lg[hh * 64 + ir], gi1 = lg[hh * 64 + 32 + ir], bi0 = lg[128 + hh * 64 + ir], bi1 = lg[128 + hh * 64 + 32 + ir];
                { const int i = ir, j = m; const float dec = __expf(fminf(gi0 - gcj0, 0.f)); af[rc * 64] = (j < i) ? bi0 * dec * kk00[r] : 0.f; pg[rc * 8] = f2bf((j <= i) ? dec * qk00[r] : 0.f); }
                { const int i = 32 + ir, j = m; const float dec = __expf(fminf(gi1 - gcj0, 0.f)); af[2048 + rc * 64] = bi1 * dec * kk10[r]; pg[2048 + rc * 8] = f2bf(dec * qk10[r]); }
                { const int i = 32 + ir, j = 32 + m; const float dec = __expf(fminf(gi1 - gcj1, 0.f)); af[2048 + 32 + rc * 64] = (j < i) ? bi1 * dec * kk11[r] : 0.f; pg[2048 + 1024 + rc * 8] = f2bf((j <= i) ? dec * qk11[r] : 0.f); }
            }
            stage_out8k(stg, PG + uh * 4096, lane); }
        WAVE_SYNC();
    }
}
__device__ __forceinline__ void delta_d2_unit(unsigned char* ws, LAS unsigned char* lds, int uh, int wave, int lane) {
    asm volatile("" : "+v"(lane));
    const float* AF = (const float*)(ws + WS_DAF); const float* GC = (const float*)(ws + WS_DGC); const float* BT = (const float*)(ws + WS_DBT);
    bf16* TG = (bf16*)(ws + WS_DTG); bf16* TB = (bf16*)(ws + WS_DTB);
    {
        const float* af = AF + (size_t)uh * 4096;
        const float bc = BT[(size_t)uh * 64 + lane], gmc = __expf(GC[(size_t)uh * 64 + lane]);
        float T[64];
        const bool pad0 = (uh % NCH) == 0;
#pragma unroll
        for (int i0 = 0; i0 < 64; i0 += 16) {
            float ar[16];
#pragma unroll
            for (int u = 0; u < 16; ++u) ar[u] = af[(i0 + u) * 64 + lane];
            if (pad0 && i0 < 32) {
#pragma unroll
                for (int u = 0; u < 16; ++u) T[i0 + u] = (lane == i0 + u) ? 1.f : 0.f;
            } else {
#pragma unroll
                for (int u = 0; u < 16; ++u) { const int i = i0 + u; float pa[4] = {(lane == i) ? 1.f : 0.f, 0.f, 0.f, 0.f};
#pragma unroll
                    for (int j = 0; j < i; ++j) pa[j & 3] -= __int_as_float(__builtin_amdgcn_readlane(__float_as_int(ar[u]), j)) * T[j];
                    T[i] = (pa[0] + pa[1]) + (pa[2] + pa[3]); }
            }
        }
        bf16* tg = TG + (size_t)uh * 4096; bf16* tb = TB + (size_t)uh * 4096;
        const float sg = bc * gmc;
        const int cs = (lane & ~31) + sw23(lane & 31);
        const int lcol = (cs >> 4) * 512 + ((cs >> 3) & 1) * 256 + (cs & 7);
        LAS unsigned char* stg = lds + wave * 16384 + 2048; LAS bf16* st = (LAS bf16*)stg;
#pragma unroll
        for (int i = 0; i < 64; ++i) st[(i >> 5) * 2048 + (i & 31) * 8 + lcol] = f2bf(T[i] * sg);
        stage_out8k(stg, tg, lane);
#pragma unroll
        for (int i = 0; i < 64; ++i) st[(i >> 5) * 2048 + (i & 31) * 8 + lcol] = f2bf(T[i] * bc);
        stage_out8k(stg, tb, lane);
    }
}
__device__ __forceinline__ void delta_d3_unit(unsigned char* ws, int uh, int lane) {
    asm volatile("" : "+v"(lane));
    const bf16* TG = (const bf16*)(ws + WS_DTG); const bf16* TB = (const bf16*)(ws + WS_DTB); const bf16* KT = (const bf16*)(ws + WS_DKT); const bf16* VT = (const bf16*)(ws + WS_DVT);
    bf16* WG = (bf16*)(ws + WS_DWG); bf16* UG = (bf16*)(ws + WS_DUG);
    const int m = lane & 31, half = lane >> 5;
    const int c = uh % NCH, bh = uh / NCH, h = bh & 31, b = bh >> 5;
    const size_t uq = ((size_t)(b * 16 + (h >> 1))) * NCH + c;
    {
        const bf16* Tm = TG + (size_t)uh * 4096; const bf16* Kf = KT + uq * 8192;
        f32x16 acc[4][2];
#pragma unroll
        for (int dn = 0; dn < 4; ++dn)
#pragma unroll
            for (int ti = 0; ti < 2; ++ti)
#pragma unroll
                for (int i = 0; i < 16; ++i) acc[dn][ti][i] = 0.f;
#pragma unroll
        for (int ks = 0; ks < 4; ++ks) {
            bf16x8 a[4], bb[2];
#pragma unroll
            for (int dn = 0; dn < 4; ++dn) a[dn] = *(const bf16x8*)(Kf + ((size_t)(((dn * 2 + (ks >> 1)) * 2 + (ks & 1)) * 64 + lane)) * 8);
#pragma unroll
            for (int ti = 0; ti < 2; ++ti) bb[ti] = *(const bf16x8*)(Tm + ((size_t)((ti * 4 + ks) * 64 + lane)) * 8);
#pragma unroll
            for (int dn = 0; dn < 4; ++dn)
#pragma unroll
                for (int ti = 0; ti < 2; ++ti) acc[dn][ti] = MFMA32(a[dn], bb[ti], acc[dn][ti]);
        }
        bf16* wg = WG + (size_t)uh * 8192;
#pragma unroll
        for (int dn = 0; dn < 4; ++dn)
#pragma unroll
            for (int ti = 0; ti < 2; ++ti)
#pragma unroll
                for (int s2 = 0; s2 < 2; ++s2) *(v4u*)(wg + ((size_t)(((ti * 4 + dn) * 2 + s2) * 64 + lane)) * 8) = pack_frag(acc[dn][ti], s2);
    }
    {
        const bf16* Tm = TB + (size_t)uh * 4096; const bf16* Bt = VT + (size_t)uh * 8192;
        f32x16 acc[2][4];
#pragma unroll
        for (int ti = 0; ti < 2; ++ti)
#pragma unroll
            for (int dn = 0; dn < 4; ++dn)
#pragma unroll
                for (int i = 0; i < 16; ++i) acc[ti][dn][i] = 0.f;
#pragma unroll
        for (int ks = 0; ks < 4; ++ks) {
            bf16x8 a[2], bb[4];
#pragma unroll
            for (int ti = 0; ti < 2; ++ti) a[ti] = *(const bf16x8*)(Tm + ((size_t)((ti * 4 + ks) * 64 + lane)) * 8);
#pragma unroll
            for (int dn = 0; dn < 4; ++dn) bb[dn] = *(const bf16x8*)(Bt + ((size_t)((dn * 4 + ks) * 64 + lane)) * 8);
#pragma unroll
            for (int ti = 0; ti < 2; ++ti)
#pragma unroll
                for (int dn = 0; dn < 4; ++dn) acc[ti][dn] = MFMA32(a[ti], bb[dn], acc[ti][dn]);
        }
        bf16* ug = UG + (size_t)uh * 8192;
#pragma unroll
        for (int ti = 0; ti < 2; ++ti)
#pragma unroll
            for (int dn = 0; dn < 4; ++dn) { bf16* p = ug + ((size_t)((ti * 4 + dn) * 64 + lane)) * 16; *(v4u*)p = pack_frag(acc[ti][dn], 0); *(v4u*)(p + 8) = pack_frag(acc[ti][dn], 1); }
    }
}
__device__ __forceinline__ void delta_pre(unsigned char* ws, LAS unsigned char* lds, int gw, int NGW, int wave, int lane) {
    for (int uq = gw; uq < NUQ; uq += NGW) {
#ifndef NO_D1
        delta_d1_unit(ws, lds, uq, wave, lane);
#endif
#ifdef DUP_D1
        delta_d1_unit(ws, lds, uq, wave, lane);
#endif
        asm volatile("s_waitcnt vmcnt(0)" ::: "memory");
        const int c = uq % NCH, bh = uq / NCH, hq = bh & 15, b = bh >> 4;
#pragma unroll 1
        for (int hh = 0; hh < 2; ++hh) { const int uh = (b * 32 + 2 * hq + hh) * NCH + c;
#ifndef NO_D2
            delta_d2_unit(ws, lds, uh, wave, lane);
#endif
#ifdef DUP_D2
            delta_d2_unit(ws, lds, uh, wave, lane);
#endif
            asm volatile("s_waitcnt vmcnt(0)" ::: "memory");
#ifndef NO_D3
            delta_d3_unit(ws, uh, lane);
#endif
#ifdef DUP_D3
            delta_d3_unit(ws, uh, lane);
#endif
        }
    }
}
__device__ __forceinline__ bf16x8 afrag_perm(const bf16* rowp, int blk, int s, int half) {
    const v2u lo = *(const v2u*)(rowp + 32 * blk + 16 * s + 4 * half), hi2 = *(const v2u*)(rowp + 32 * blk + 16 * s + 8 + 4 * half);
    v4u w; w.x = lo.x; w.y = lo.y; w.z = hi2.x; w.w = hi2.y; return __builtin_bit_cast(bf16x8, w);
}
#define LBAR() asm volatile("s_waitcnt lgkmcnt(0)\n\ts_barrier" ::: "memory")
__device__ __forceinline__ void delta_d4(unsigned char* ws, float* out_state, LAS unsigned char* lds, int tid, int wave, int lane) {
    const bf16* QKVC = (const bf16*)(ws + WS_QKVC); const bf16* KT = (const bf16*)(ws + WS_DKT); const bf16* PG = (const bf16*)(ws + WS_DPG);
    const bf16* WG = (const bf16*)(ws + WS_DWG); const bf16* UG = (const bf16*)(ws + WS_DUG); const float* GC = (const float*)(ws + WS_DGC);
    bf16* OF = (bf16*)(ws + WS_SC);
    LAS v4u* Sfr = (LAS v4u*)lds;
    LAS v4u* Dfr = (LAS v4u*)(lds + 16384);
    LAS v4u* Dtf = (LAS v4u*)(lds + 16384 + 4096);
    LAS float* gam = (LAS float*)(lds + 16384 + 8192);
    const int m = lane & 31, half = lane >> 5;
    const bf16x8 zf = {0, 0, 0, 0, 0, 0, 0, 0};
    for (int item = blockIdx.x; item < NBP * 32 * 4; item += gridDim.x) {
        const int xg = item & 7, jj = item >> 3, pair = xg * 4 + (jj >> 3), q = jj & 3, h = 2 * (pair & 15) + ((jj >> 2) & 1), b = pair >> 4;
        const size_t uh0 = ((size_t)(b * 32 + h)) * NCH, uq0 = ((size_t)(b * 16 + (h >> 1))) * NCH;
        const int rt = wave & 1; const bool isq = wave >= 6;
#define ROT3(LOADM, STEPM) do { LOADM(0, 0); LOADM(1, 1); \
            for (int c = 0; c < NCH; c += 3) { \
                if (c + 2 < NCH) LOADM(c + 2, 2); \
                STEPM(c, 0); \
                if (c + 1 < NCH) { if (c + 3 < NCH) LOADM(c + 3, 0); STEPM(c + 1, 1); } \
                if (c + 2 < NCH) { if (c + 4 < NCH) LOADM(c + 4, 1); STEPM(c + 2, 2); } } } while (0)
#define ROT2(LOADM, STEPM) do { LOADM(0, 0); \
            for (int c = 0; c < NCH; c += 2) { \
                if (c + 1 < NCH) LOADM(c + 1, 1); \
                STEPM(c, 0); \
                if (c + 1 < NCH) { if (c + 2 < NCH) LOADM(c + 2, 0); STEPM(c + 1, 1); } } } while (0)
        LBAR();
        if (wave < 4) {
            int ll_ = lane; asm volatile("" : "+v"(ll_)); const int lane = ll_, m = lane & 31, half = lane >> 5; (void)m; (void)half;
            { const v4u z = {0u, 0u, 0u, 0u}; Sfr[(0 * 4 + wave) * 128 + lane] = z; Sfr[(0 * 4 + wave) * 128 + 64 + lane] = z; }
            bf16x8 kf[2][4];
            f32x16 S;
#pragma unroll
            for (int i = 0; i < 16; ++i) S[i] = 0.f;
#define LOAD_K(cc, B) do { const bf16* kr_ = KT + (uq0 + (cc)) * 8192; \
                _Pragma("unroll") for (int blk = 0; blk < 2; ++blk) _Pragma("unroll") for (int s_ = 0; s_ < 2; ++s_) kf[B][blk * 2 + s_] = *(const bf16x8*)(kr_ + ((size_t)(((wave * 2 + blk) * 2 + s_) * 64 + lane)) * 8); } while (0)
#define STEP_K(c, B) do { const int bufc = (c) & 1; LBAR(); LBAR(); \
                const float gl = gam[bufc * 64 + 63]; \
                _Pragma("unroll") for (int i = 0; i < 16; ++i) S[i] *= gl; \
                _Pragma("unroll") for (int blk = 0; blk < 2; ++blk) _Pragma("unroll") for (int s = 0; s < 2; ++s) S = MFMA32(kf[B][blk * 2 + s], __builtin_bit_cast(bf16x8, Dtf[(blk * 2 + s) * 64 + lane]), S); \
                _Pragma("unroll") for (int s = 0; s < 2; ++s) Sfr[((bufc ^ 1) * 4 + wave) * 128 + s * 64 + lane] = pack_frag(S, s); } while (0)
#ifndef NO_RK
            ROT2(LOAD_K, STEP_K);
#endif
            { float* o = out_state + ((size_t)((b * 32 + h) * 128 + 32 * wave)) * 128 + 32 * q + m;
#pragma unroll
              for (int r = 0; r < 16; ++r) o[(size_t)sw23(crow32(r, half)) * 128] = S[r]; }
#undef LOAD_K
#undef STEP_K
        } else if (!isq) {
            int ll_ = lane; asm volatile("" : "+v"(ll_)); const int lane = ll_, m = lane & 31, half = lane >> 5; (void)m; (void)half;
            bf16x8 wf[3][8], uf[3][2]; float gcv[3] = {0.f, 0.f, 0.f};
#define LOAD_W(cc, B) do { const bf16* wb_ = WG + (uh0 + (cc)) * 8192 + ((size_t)(rt * 512 + lane)) * 8; \
                _Pragma("unroll") for (int blk = 0; blk < 4; ++blk) _Pragma("unroll") for (int s_ = 0; s_ < 2; ++s_) wf[B][blk * 2 + s_] = *(const bf16x8*)(wb_ + blk * 1024 + s_ * 512); \
                const bf16* ub_ = UG + (uh0 + (cc)) * 8192 + ((size_t)((rt * 4 + q) * 64 + lane)) * 16; uf[B][0] = *(const bf16x8*)ub_; uf[B][1] = *(const bf16x8*)(ub_ + 8); \
                if (wave == 4) gcv[B] = GC[(uh0 + (cc)) * 64 + lane]; } while (0)
#define STEP_W(c, B) do { const int bufc = (c) & 1; LBAR(); \
                f32x16 acc; \
                _Pragma("unroll") for (int i = 0; i < 16; ++i) acc[i] = 0.f; \
                _Pragma("unroll") for (int blk = 0; blk < 4; ++blk) _Pragma("unroll") for (int s = 0; s < 2; ++s) \
                    acc = MFMA32(wf[B][blk * 2 + s], __builtin_bit_cast(bf16x8, Sfr[(bufc * 4 + blk) * 128 + s * 64 + lane]), acc); \
                { float t8[8]; unpack8(__builtin_bit_cast(v4u, uf[B][0]), t8); \
                    _Pragma("unroll") for (int i = 0; i < 8; ++i) acc[i] = t8[i] - acc[i]; unpack8(__builtin_bit_cast(v4u, uf[B][1]), t8); \
                    _Pragma("unroll") for (int i = 0; i < 8; ++i) acc[8 + i] = t8[i] - acc[8 + i]; } \
                _Pragma("unroll") for (int s = 0; s < 2; ++s) Dfr[(rt * 2 + s) * 64 + lane] = pack_frag(acc, s); \
                _Pragma("unroll") for (int r = 0; r < 16; ++r) acc[r] *= gam[128 + bufc * 64 + 32 * rt + crow32(r, half)]; \
                _Pragma("unroll") for (int s = 0; s < 2; ++s) Dtf[(rt * 2 + s) * 64 + lane] = pack_frag(acc, s); \
                LBAR(); \
                if (wave == 4 && (c) + 1 < NCH) { const float gn_ = gcv[((B) + 1) % 3], gl_ = __shfl(gn_, 63); gam[(bufc ^ 1) * 64 + lane] = __expf(gn_); gam[128 + (bufc ^ 1) * 64 + lane] = __expf(gl_ - gn_); } } while (0)
            if (wave == 4) { const float gc = GC[(uh0 + 0) * 64 + lane], gl = __shfl(gc, 63); gam[lane] = __expf(gc); gam[128 + lane] = __expf(gl - gc); }
#ifndef NO_RW
            ROT3(LOAD_W, STEP_W);
#endif
#undef LOAD_W
#undef STEP_W
        } else {
            int ll_ = lane; asm volatile("" : "+v"(ll_)); const int lane = ll_, m = lane & 31, half = lane >> 5; (void)m; (void)half;
            bf16x8 qf[1][8], pf[1][4];
#define LOAD_Q(cc, B) do { const int row_ = chunk_row(b, (cc), 32 * rt + m); const bool ok_ = row_ >= 0; \
                const bf16* qb_ = QKVC + (size_t)(row_ < 0 ? 0 : row_) * CDIM + (h >> 1) * 128 + 8 * half; \
                _Pragma("unroll") for (int blk = 0; blk < 4; ++blk) _Pragma("unroll") for (int s_ = 0; s_ < 2; ++s_) qf[B][blk * 2 + s_] = sel8(ok_, *(const bf16x8*)(qb_ + blk * 32 + s_ * 16)); \
                } while (0)
#define LOAD_P(cc, PB) do { const bf16* pb_ = PG + (uh0 + (cc)) * 4096 + ((size_t)(rt * 256 + lane)) * 8; \
                _Pragma("unroll") for (int blk = 0; blk < 2; ++blk) _Pragma("unroll") for (int s_ = 0; s_ < 2; ++s_) pf[PB][blk * 2 + s_] = sel8(blk <= rt, *(const bf16x8*)(pb_ + blk * 1024 + s_ * 512)); } while (0)
#define STEP_Q(c) do { const int bufc = (c) & 1; LBAR(); \
                LOAD_P((c), 0);                                                    \
                f32x16 acc; \
                _Pragma("unroll") for (int i = 0; i < 16; ++i) acc[i] = 0.f; \
                _Pragma("unroll") for (int blk = 0; blk < 4; ++blk) _Pragma("unroll") for (int s = 0; s < 2; ++s) \
                    acc = MFMA32(qf[0][blk * 2 + s], __builtin_bit_cast(bf16x8, Sfr[(bufc * 4 + blk) * 128 + s * 64 + lane]), acc); \
                if ((c) + 1 < NCH) LOAD_Q((c) + 1, 0);                             \
                LBAR(); \
                _Pragma("unroll") for (int r = 0; r < 16; ++r) acc[r] *= gam[bufc * 64 + 32 * rt + crow32(r, half)]; \
                _Pragma("unroll") for (int blk = 0; blk < 2; ++blk) _Pragma("unroll") for (int s = 0; s < 2; ++s) acc = MFMA32(pf[0][blk * 2 + s], __builtin_bit_cast(bf16x8, Dfr[(blk * 2 + s) * 64 + lane]), acc); \
                _Pragma("unroll") for (int r = 0; r < 16; ++r) { const int row = chunk_row(b, (c), 32 * rt + crow32(r, half)); if (row >= 0) OF[(size_t)row * DVW + h * 128 + 32 * q + m] = f2bf(acc[r]); } } while (0)
#ifndef NO_RQ
            LOAD_Q(0, 0);
            for (int c = 0; c < NCH; ++c) STEP_Q(c);
#endif
#undef LOAD_Q
#undef LOAD_P
#undef STEP_Q
        }
#undef ROT2
#undef ROT3
    }
    LBAR();
}
#undef LBAR
#undef MFMA32
template <int RT, int CT, class Epi>
__device__ __forceinline__ void small_gemm_unit(const bf16* A, int lda, const bf16* Bt, int ldb, int k0, int klen, LAS unsigned char* lds, const Epi& E, int tid, int wave, int lane) {
    const int r16 = lane & 15, q = lane >> 4;
    const int kw = klen >> 3;
    const bf16* ap = A + (size_t)r16 * lda + k0 + wave * kw + 8 * q;
    const bf16* bp = Bt + (size_t)r16 * ldb + k0 + wave * kw + 8 * q;
    pg8::f32x4 acc[RT][CT];
#pragma unroll
    for (int i = 0; i < RT; ++i)
#pragma unroll
        for (int j = 0; j < CT; ++j) acc[i][j] = (pg8::f32x4){0.f, 0.f, 0.f, 0.f};
#pragma unroll 4
    for (int ks = 0; ks < kw; ks += 32) {
        bf16x8 a[RT], b[CT];
#pragma unroll
        for (int i = 0; i < RT; ++i) a[i] = *(const bf16x8*)(ap + (size_t)(16 * i) * lda + ks);
#pragma unroll
        for (int j = 0; j < CT; ++j) b[j] = *(const bf16x8*)(bp + (size_t)(16 * j) * ldb + ks);
#pragma unroll
        for (int i = 0; i < RT; ++i)
#pragma unroll
            for (int j = 0; j < CT; ++j) acc[i][j] = __builtin_amdgcn_mfma_f32_16x16x32_bf16(a[i], b[j], acc[i][j], 0, 0, 0);
    }
    constexpr int NOUT = 256 * RT * CT;
    LAS float* part = (LAS float*)lds + wave * NOUT;
#pragma unroll
    for (int i = 0; i < RT; ++i)
#pragma unroll
        for (int j = 0; j < CT; ++j)
#pragma unroll
            for (int e = 0; e < 4; ++e) part[(16 * i + 4 * q + e) * (16 * CT) + 16 * j + r16] = acc[i][j][e];
    __syncthreads();
    for (int o = tid; o < NOUT; o += NTHREADS) { float sum = 0.f;
#pragma unroll
        for (int w = 0; w < 8; ++w) sum += ((LAS float*)lds)[w * NOUT + o];
        E(o / (16 * CT), o % (16 * CT), sum); }
    __syncthreads();
}
template <int ACT> struct SEpiRowsBf16 { bf16* O; int ldc; __device__ __forceinline__ void operator()(int row, int col, float v) const { if (ACT == 2) { v = v > 0.f ? v : 0.f; v = v * v; } O[(size_t)row * ldc + col] = f2bf(v); } };
struct SEpiF32 { float* O; int ldc; __device__ __forceinline__ void operator()(int row, int col, float v) const { O[(size_t)row * ldc + col] = v; } };
struct SEpiColsBf16 { bf16* O; int ldc; __device__ __forceinline__ void operator()(int row, int col, float v) const { O[(size_t)col * ldc + row] = f2bf(v); } };
template <int ACT> __device__ __forceinline__ void skinny_rows_bf16(const bf16* A, const bf16* Wt, int K, int nunits, bf16* O, int ldc, LAS unsigned char* lds, int tid, int wave, int lane) {
    for (int u = blockIdx.x; u < nunits; u += gridDim.x) { SEpiRowsBf16<ACT> E{O + (size_t)XROW0 * ldc + u * 64, ldc};
        small_gemm_unit<3, 4>(A + (size_t)XROW0 * K, K, Wt + (size_t)u * 64 * K, K, 0, K, lds, E, tid, wave, lane); }
}
__device__ __forceinline__ void skinny_rows_part(const bf16* A, const bf16* Wt, int K, float* ZP, LAS unsigned char* lds, int tid, int wave, int lane) {
    for (int u = blockIdx.x; u < 256; u += gridDim.x) { const int cgp = u & 31, ksl = u >> 5; SEpiF32 E{ZP + (size_t)ksl * XR * DM + cgp * 64, DM};
        small_gemm_unit<3, 4>(A + (size_t)XROW0 * K, K, Wt + (size_t)cgp * 64 * K, K, ksl * (K >> 3), K >> 3, lds, E, tid, wave, lane); }
}
template <int RT> __device__ __forceinline__ void tail_cols_bf16(const bf16* A, const bf16* Wt, int K, int c0, bf16* O, int ldc, LAS unsigned char* lds, int tid, int wave, int lane) {
    for (int u = blockIdx.x; u < MAINM / 32; u += gridDim.x) { SEpiColsBf16 E{O + (size_t)u * 32 * ldc + c0, ldc};
        small_gemm_unit<RT, 2>(Wt + (size_t)c0 * K, K, A + (size_t)u * 32 * K, K, 0, K, lds, E, tid, wave, lane); }
}

typedef __attribute__((address_space(4))) const unsigned long long* kargq_t;
#define KPF_(k) ((const float*)(const GAS float*)(q_[k]))
__device__ __forceinline__ void load_ptrs(Ptrs& P) {
    kargq_t q_ = (kargq_t)__builtin_amdgcn_kernarg_segment_ptr();
    asm volatile("" : "+s"(q_));
    P.x_prompt = KPF_(0); P.x_sample = KPF_(1); P.state_conv_a = KPF_(2); P.cache_k = KPF_(3);
    P.cache_v = KPF_(4); P.cache_ik = KPF_(5); P.state_conv_c = KPF_(6); P.state_delta = KPF_(7);
    P.page_table = ((const int*)(const GAS int*)(q_[8])); P.meta = KPF_(9); P.w_in_a = KPF_(10); P.conv_w_a = KPF_(11);
    P.w_out_a = KPF_(12); P.w_in_b = KPF_(13); P.w_out_b = KPF_(14); P.w_in_c = KPF_(15);
    P.conv_w_c = KPF_(16); P.a_log = KPF_(17); P.dt_bias = KPF_(18); P.norm_w = KPF_(19);
    P.w_out_c = KPF_(20); P.ln1_g = KPF_(21); P.ln1_b = KPF_(22); P.w1 = KPF_(23);
    P.w2 = KPF_(24); P.ln2_g = KPF_(25); P.ln2_b = KPF_(26);
    P.out = (float*)(GAS float*)(q_[27]); P.ws = (unsigned char*)(GAS unsigned char*)(q_[28]);
}
struct Args { const void* in[27]; float* out; unsigned char* ws; int ph_lo, ph_hi; };
constexpr int PH_PER_LAYER = 12, PH_END = 1 + 4 * PH_PER_LAYER;

__global__ void __launch_bounds__(NTHREADS, 2) mega_fwd(Args args) {
    extern __shared__ __attribute__((aligned(16))) unsigned char lds_raw[];
    LAS unsigned char* lds = (LAS unsigned char*)lds_raw;
    const int tid = threadIdx.x, lane = tid & 63, wave = __builtin_amdgcn_readfirstlane(tid >> 6);
    const int G_ = gridDim.x, NGW = G_ * NWAVES, NT = G_ * NTHREADS; (void)lane;
    unsigned char* ws = args.ws;
    const int lo = args.ph_lo, hi = args.ph_hi;
    const bool fused = (hi - lo) > 1;

    for (int u = tid; u < (LDS_BYTES - LDSCTL_OFF) / 4; u += NTHREADS) ((LAS unsigned*)(lds + LDSCTL_OFF))[u] = 0u;
    __syncthreads();
    volatile LAS unsigned* MISC = (volatile LAS unsigned*)(lds + MISC_OFF);
    XcdBarrier bar; bar.bar = (unsigned*)(ws + WS_CTL) + CW_BAR; bar.x = 0; bar.st = nullptr;
    if (fused) bar = xcd_barrier_post((unsigned*)(ws + WS_CTL) + CW_BAR, MISC + 8);
    bar.wv = wave;

#ifndef MK_SITES
#define MK_SITES 0xffffffffu
#endif
#define SITE(n) (((MK_SITES) >> (n)) & 1u)
#define IN(k) (lo <= (k) && (k) < hi)
#ifndef MK_DUP
#define MK_DUP 0u
#endif
#define NREP(n) ((((MK_DUP) >> (n)) & 1u) ? 2 : 1)
#ifdef MK_SKINNY2
#define SKREP 2
#else
#define SKREP 1
#endif
#define BEGIN_SITE(n, id) if (SITE(n) && IN(id)) { for (int rp_ = 0; rp_ < NREP(n); ++rp_) { Ptrs P; load_ptrs(P); unsigned char* ws = P.ws; (void)ws; \
    bf16* X = (bf16*)(P.ws + WS_X); float* Z = (float*)(P.ws + WS_Z); float* ZP = (float*)(P.ws + WS_ZP); bf16* Y = (bf16*)(P.ws + WS_Y); bf16* BIG = (bf16*)(P.ws + WS_BIG); (void)X; (void)Z; (void)ZP; (void)Y; (void)BIG;
#define END_SITE(id) SEAM(id); } }
#define LOCALS int tid_ = threadIdx.x; asm volatile("" : "+v"(tid_)); const int lane_ = tid_ & 63, wave_ = __builtin_amdgcn_readfirstlane(tid_ >> 6), gw_ = blockIdx.x * NWAVES + wave_, gtid_ = blockIdx.x * NTHREADS + tid_; (void)lane_; (void)wave_; (void)gw_; (void)gtid_
#define SEAM(k) do { if (fused && (k) + 1 < PH_END) xcd_barrier(bar); else __syncthreads(); } while (0)


    BEGIN_SITE(0, 0) LOCALS; p0_prologue(P, lds, gw_, NGW, wave_, lane_); END_SITE(0)
#ifdef MK_XBAR
    if (fused) { for (int xb_ = 0; xb_ < MK_XBAR; ++xb_) xcd_barrier(bar); }
#endif

    for (int layer = 0; layer < 4; ++layer) {
        const int kind = layer % 3, j = layer / 3, base = 1 + layer * PH_PER_LAYER;
        if (kind == 0) {
            BEGIN_SITE(1, base + 0)
                const bf16* Wt = (const bf16*)(ws + WS_WA_IN + (size_t)j * WSZ_A_IN); pg8::Gemm g{X, Wt, MAINM, NA_IN, DM}; pg8::StaticOrder S; S.init(MAINM, NA_IN, G_, (int)blockIdx.x);
                pg8::EpiBf16<0> E{BIG, NA_IN, nullptr, 0, 0, 1.f};
                pg8::gemm_phase<pg8::EpiBf16<0>, pg8::StaticOrder, true, true>(lds, g, S, E, wave);
                { LOCALS; for (int sk_ = 0; sk_ < SKREP; ++sk_) { skinny_rows_bf16<0>(X, Wt, DM, NA_IN / 64, BIG, NA_IN, lds, tid_, wave_, lane_); } }
                END_SITE(base + 0)
            BEGIN_SITE(2, base + 1)
                LOCALS; convA_phase(BIG, Y, P.conv_w_a + (size_t)j * 3 * DM, P.state_conv_a + (size_t)j * SBN * 2 * DM, P.out + O_CAP + (size_t)j * NBP * 2 * DM, P.out + O_CAS + (size_t)j * SBN * 2 * DM, gtid_, NT);
                END_SITE(base + 1)
            BEGIN_SITE(3, base + 2)
                const bf16* Wt = (const bf16*)(ws + WS_WA_OUT + (size_t)j * WSZ_A_OUT); pg8::Gemm g{Y, Wt, MAINM, DM, DM}; pg8::StaticOrder S; S.init(MAINM, DM, G_, (int)blockIdx.x);
                pg8::EpiResBf16 E{X, DM, ALPHA};
                pg8::gemm_phase<pg8::EpiResBf16, pg8::StaticOrder, true, true>(lds, g, S, E, wave);
                { LOCALS; for (int sk_ = 0; sk_ < SKREP; ++sk_) { skinny_rows_part(Y, Wt, DM, ZP, lds, tid_, wave_, lane_); } }
                END_SITE(base + 2)
        } else if (kind == 1) {
            BEGIN_SITE(4, base + 0)
                const bf16* Wt = (const bf16*)(ws + WS_WB_IN); pg8::Gemm g{X, Wt, MAINM, 4096, DM}; pg8::StaticOrder S; S.init(MAINM, 4096, G_, (int)blockIdx.x);
                pg8::EpiBf16<0> E{BIG, NB_PAD, nullptr, 0, 0, 1.f};
                pg8::gemm_phase<pg8::EpiBf16<0>, pg8::StaticOrder, true, true>(lds, g, S, E, wave);
                { LOCALS; for (int sk_ = 0; sk_ < SKREP; ++sk_) { tail_cols_bf16<5>(X, Wt, DM, 4096, BIG, NB_PAD, lds, tid_, wave_, lane_); skinny_rows_bf16<0>(X, Wt, DM, 4224 / 64, BIG, NB_PAD, lds, tid_, wave_, lane_); } }
                END_SITE(base + 0)
            BEGIN_SITE(5, base + 1) LOCALS; rope_phase(BIG, P, gw_, NGW, lane_); END_SITE(base + 1)
            BEGIN_SITE(6, base + 2) LOCALS; indexer_sample(P, lds, tid_); indexer_prompt(P, lds, tid_, wave_, lane_); END_SITE(base + 2)
            BEGIN_SITE(7, base + 3) LOCALS; select_phase(P, lds, gw_, NGW, tid_, wave_, lane_); END_SITE(base + 3)
            BEGIN_SITE(8, base + 4) LOCALS; dense_attn_phase(P, Y, (char*)lds_raw, wave_); attn_phase(P, Y, lds, gw_, NGW, wave_, lane_); END_SITE(base + 4)
            BEGIN_SITE(9, base + 5)
                const bf16* Wt = (const bf16*)(ws + WS_WB_OUT); pg8::Gemm g{Y, Wt, MAINM, DM, DM}; pg8::StaticOrder S; S.init(MAINM, DM, G_, (int)blockIdx.x);
                pg8::EpiResBf16 E{X, DM, ALPHA};
                pg8::gemm_phase<pg8::EpiResBf16, pg8::StaticOrder, true, true>(lds, g, S, E, wave);
                { LOCALS; for (int sk_ = 0; sk_ < SKREP; ++sk_) { skinny_rows_part(Y, Wt, DM, ZP, lds, tid_, wave_, lane_); } }
                END_SITE(base + 5)
        } else {
            BEGIN_SITE(10, base + 0)
                const bf16* Wt = (const bf16*)(ws + WS_WC_IN); pg8::Gemm g{X, Wt, MAINM, 12288, DM}; pg8::StaticOrder S; S.init(MAINM, 12288, G_, (int)blockIdx.x);
                pg8::EpiBf16<0> E{BIG, NC_PAD, nullptr, 0, 0, 1.f};
                pg8::gemm_phase<pg8::EpiBf16<0>, pg8::StaticOrder, true, true>(lds, g, S, E, wave);
                { LOCALS; for (int sk_ = 0; sk_ < SKREP; ++sk_) { tail_cols_bf16<4>(X, Wt, DM, 12288, BIG, NC_PAD, lds, tid_, wave_, lane_); skinny_rows_bf16<0>(X, Wt, DM, NC_IN / 64, BIG, NC_PAD, lds, tid_, wave_, lane_); } }
                END_SITE(base + 0)
            BEGIN_SITE(11, base + 1) LOCALS; convC_phase(BIG, P, gw_, NGW, lane_); END_SITE(base + 1)
            BEGIN_SITE(19, base + 2) LOCALS; delta_pre(P.ws, lds, gw_, NGW, wave_, lane_); delta_phase(P, wave_, lane_);
                { const int nbusy = (NUQ > NGW && NUQ < 2 * NGW) ? NUQ - NGW : 0;
                  if (gw_ >= nbusy) deferred_transposes(P, lds, gw_ - nbusy, NGW - nbusy, wave_, lane_); }
            END_SITE(base + 2)
            BEGIN_SITE(22, base + 5) LOCALS; delta_d4(P.ws, P.out + O_DP, lds, tid_, wave_, lane_); END_SITE(base + 5)
            BEGIN_SITE(13, base + 6) LOCALS; normC_phase(BIG, Y, P, gw_, NGW, lane_); END_SITE(base + 6)
            BEGIN_SITE(14, base + 7)
                const bf16* Wt = (const bf16*)(ws + WS_WC_OUT); pg8::Gemm g{Y, Wt, MAINM, DM, DVW}; pg8::StaticOrder S; S.init(MAINM, DM, G_, (int)blockIdx.x);
                pg8::EpiResBf16 E{X, DM, ALPHA};
                pg8::gemm_phase<pg8::EpiResBf16, pg8::StaticOrder, true, true>(lds, g, S, E, wave);
                { LOCALS; for (int sk_ = 0; sk_ < SKREP; ++sk_) { skinny_rows_part(Y, Wt, DVW, ZP, lds, tid_, wave_, lane_); } }
                END_SITE(base + 7)
        }
        BEGIN_SITE(15, base + 8) LOCALS; ln_phase(Z, ZP, X, rp_ == 0 ? X : (bf16*)(P.ws + WS_QR), P.ln1_g + (size_t)layer * DM, P.ln1_b + (size_t)layer * DM, nullptr, nullptr, lds, gw_, NGW, tid_, wave_, lane_); END_SITE(base + 8)
        BEGIN_SITE(16, base + 9)
            const bf16* Wt = (const bf16*)(ws + WS_W1 + (size_t)layer * WSZ_W1); pg8::Gemm g{X, Wt, MAINM, FF, DM}; pg8::StaticOrder S; S.init(MAINM, FF, G_, (int)blockIdx.x);
            pg8::EpiBf16<2> E{BIG, FF, nullptr, 0, 0, 1.f};
            pg8::gemm_phase<pg8::EpiBf16<2>, pg8::StaticOrder, true, true>(lds, g, S, E, wave);
            { LOCALS; for (int sk_ = 0; sk_ < SKREP; ++sk_) { skinny_rows_bf16<2>(X, Wt, DM, FF / 64, BIG, FF, lds, tid_, wave_, lane_); } }
            END_SITE(base + 9)
        BEGIN_SITE(17, base + 10)
            const bf16* Wt = (const bf16*)(ws + WS_W2 + (size_t)layer * WSZ_W2); pg8::Gemm g{BIG, Wt, MAINM, DM, FF}; pg8::StaticOrder S; S.init(MAINM, DM, G_, (int)blockIdx.x);
            pg8::EpiResBf16 E{X, DM, ALPHA};
            pg8::gemm_phase<pg8::EpiResBf16, pg8::StaticOrder, true, true>(lds, g, S, E, wave);
            { LOCALS; for (int sk_ = 0; sk_ < SKREP; ++sk_) { skinny_rows_part(BIG, Wt, FF, ZP, lds, tid_, wave_, lane_); } }
            END_SITE(base + 10)
        BEGIN_SITE(18, base + 11)
            const bool last = layer == 3;
            LOCALS; ln_phase(Z, ZP, X, rp_ == 0 ? X : (bf16*)(P.ws + WS_QR), P.ln2_g + (size_t)layer * DM, P.ln2_b + (size_t)layer * DM, last ? P.out + O_YP : nullptr, last ? P.out + O_YS : nullptr, lds, gw_, NGW, tid_, wave_, lane_);
            if (!last) SEAM(base + 11); } }
    }
#undef IN
#undef SEAM
}

#ifndef MK_SPLIT
#define MK_SPLIT 0
#endif
extern "C" void kernel_launch(void* const* d_in, const int* in_sizes, int n_in, void* d_out, int out_size, void* d_ws, size_t ws_size, hipStream_t stream) {
    static int grid = 0;
    if (grid == 0) {
        if (n_in != 27 || (size_t)out_size != O_END || ws_size < WS_END) { fprintf(stderr, "kernel_launch: unexpected shapes: n_in %d out %d (want %zu) ws %zu (want >= %zu)\n", n_in, out_size, (size_t)O_END, ws_size, (size_t)WS_END); grid = -1; return; }
        int dev = 0, cus = 0;
        if (hipGetDevice(&dev) != hipSuccess || hipDeviceGetAttribute(&cus, hipDeviceAttributeMultiprocessorCount, dev) != hipSuccess) { grid = -1; return; }
        if (hipFuncSetAttribute((const void*)mega_fwd, hipFuncAttributeMaxDynamicSharedMemorySize, LDS_BYTES) != hipSuccess) { fprintf(stderr, "kernel_launch: hipFuncSetAttribute failed\n"); grid = -1; return; }
        int per_cu = 0;
        if (hipOccupancyMaxActiveBlocksPerMultiprocessor(&per_cu, (const void*)mega_fwd, NTHREADS, LDS_BYTES) != hipSuccess || per_cu < 1) fprintf(stderr, "kernel_launch: occupancy query reports %d\n", per_cu);
        (void)hipGetLastError();
        grid = cus;
    }
    if (grid < 0) return;
    (void)hipMemsetAsync((char*)d_ws + WS_CTL, 0, CTL_ZERO_BYTES, stream);
    Args a{};
    for (int i = 0; i < 27; ++i) a.in[i] = d_in[i];
    a.out = (float*)d_out; a.ws = (unsigned char*)d_ws;
#if MK_SPLIT
    for (int ph = 0; ph < PH_END; ++ph) {
        bool exists = (ph == 0);
        if (ph > 0) { const int layer = (ph - 1) / PH_PER_LAYER, l = (ph - 1) % PH_PER_LAYER, kind = layer % 3; const int nmix = kind == 0 ? 3 : (kind == 1 ? 6 : 8); exists = (l < nmix) || (l >= 8 && l <= 11); }
        if (!exists) continue;
        a.ph_lo = ph; a.ph_hi = ph + 1;
        hipLaunchKernelGGL(mega_fwd, dim3(grid), dim3(NTHREADS), LDS_BYTES, stream, a);
    }
#else
    a.ph_lo = 0; a.ph_hi = PH_END;
    hipLaunchKernelGGL(mega_fwd, dim3(grid), dim3(NTHREADS), LDS_BYTES, stream, a);
#endif
    const hipError_t le = hipPeekAtLastError();
    if (le != hipSuccess) fprintf(stderr, "kernel_launch: launch failed: %s\n", hipGetErrorName(le));
}
```

```cpp
#include <hip/hip_runtime.h>
#include <cstdio>
#include <cstdint>
#include <cmath>
__device__ __forceinline__ int flane() { return (int)__builtin_amdgcn_mbcnt_hi(~0u, __builtin_amdgcn_mbcnt_lo(~0u, 0u)); }
namespace pg8 {
#define PG8_LAS __attribute__((address_space(3)))
typedef unsigned short bf16_t;
typedef short bf16x8 __attribute__((ext_vector_type(8)));
typedef float f32x4 __attribute__((ext_vector_type(4)));
typedef unsigned u32x4 __attribute__((ext_vector_type(4)));
constexpr int BM = 256, BK = 64, HALF = 128, HTB = HALF * BK * 2  , STAGE_BYTES = 8 * HTB, NXCD = 8, WGM = 8;

__host__ __device__ __forceinline__ int lds_byte(int r, int c) { const int st = (r >> 4) * 2 + (c >> 5), rr = r & 15, cc = c & 31, ob = rr * 64 + cc * 2; return st * 1024 + (ob ^ (((ob >> 9) & 1) << 5)); }
__host__ __device__ __forceinline__ void stage_rc(int b, int& R, int& C) { const int st = b / 1024, sb = b % 1024, swz = sb ^ (((sb >> 9) & 1) << 5); R = (st >> 1) * 16 + swz / 64; C = (st & 1) * 32 + (swz % 64) / 2; }
__host__ __device__ __forceinline__ int perm32(int rho) { const int n = rho >> 4, i = rho & 15; return 8 * (i >> 2) + 4 * n + (i & 3); }

struct Unit { int pm, pn; };
struct Gemm { const bf16_t* A; const bf16_t* Bt; int M, N, K; };

struct StaticOrder {
    int nM, nN, nwg, G, c;
    __host__ __device__ void init(int M, int N, int G_, int c_) { nM = M / BM; nN = N / BM; nwg = nM * nN; G = G_; c = c_; }
    __host__ __device__ bool next(int i, Unit& u) const {
        const long L = (long)i * G + c; if (L >= nwg) return false;
        int wgid = (int)L; { const int q = nwg / NXCD, r = nwg % NXCD, xcd = wgid % NXCD, off = wgid / NXCD; wgid = (xcd < r ? xcd * (q + 1) : r * (q + 1) + (xcd - r) * q) + off; }
        const int nig = WGM * nN, gid = wgid / nig, fm = gid * WGM, gsz = (nM - fm) < WGM ? (nM - fm) : WGM;
        u.pm = fm + ((wgid % nig) % gsz); u.pn = (wgid % nig) / gsz; return true;
    }
    __device__ __forceinline__ void a_ready(const Unit&) const {}
    __device__ __forceinline__ void done(const Unit&) const {}
};

__device__ __forceinline__ unsigned cvt_pk_bf16(float lo, float hi) { unsigned r; asm volatile("v_cvt_pk_bf16_f32 %0, %1, %2" : "=v"(r) : "v"(lo), "v"(hi)); return r; }
typedef float f32x2 __attribute__((ext_vector_type(2)));
__device__ __forceinline__ f32x2 gelu_pk(f32x2 v) {
    const f32x2 av = __builtin_elementwise_abs(v), d = av * 0.2316418882f + 1.0f;
    f32x2 t; t.x = __builtin_amdgcn_rcpf(d.x); t.y = __builtin_amdgcn_rcpf(d.y);
    f32x2 q = t * 0.5307027145f + (-0.7265760135f); q = q * t + 0.7107068705f; q = q * t + (-0.142248368f); q = q * t + 0.127414796f; q = q * t;
    const f32x2 s = (v * v) * (-0.72134752044f);
    f32x2 e; e.x = __builtin_amdgcn_exp2f(s.x); e.y = __builtin_amdgcn_exp2f(s.y);
    const f32x2 m = v * (q * e), r = v - m;
    f32x2 o; o.x = v.x < 0.f ? m.x : r.x; o.y = v.y < 0.f ? m.y : r.y; return o;
}

template <int ACT  > struct EpiBf16 {
    static constexpr bool PERM = true, AFTER_DRAIN = false; static_assert(ACT == 0 || ACT == 1 || ACT == 2, "EpiBf16: ACT is 0 (none), 1 (gelu_pk) or 2 (relu^2)");
    bf16_t* O; int ldc; const float* bias; int split_cols; size_t split_stride; float scale0;
    __device__ __forceinline__ void operator()(const f32x4 (&acc)[2][2][4][2], const Unit& u, int wr, int wc, int fr, int fq) const {
        const int row0 = u.pm * BM + wr * 64 + fr; int colt = u.pn * BM; bf16_t* base = O;
        float sc = 1.f; if (split_cols) { const int t = colt / split_cols; base += (size_t)t * split_stride; colt -= t * split_cols; if (t == 0) sc = scale0; }
        const int col0 = colt + wc * 32 + 8 * fq, bcol0 = u.pn * BM + wc * 32 + 8 * fq;
        f32x4 bv[2][2];
#pragma unroll
        for (int bj = 0; bj < 2; ++bj)
#pragma unroll
            for (int n = 0; n < 2; ++n) bv[bj][n] = bias ? *(const f32x4*)(bias + bcol0 + bj * HALF + 4 * n) : (f32x4){0.f, 0.f, 0.f, 0.f};
#pragma unroll
        for (int ai = 0; ai < 2; ++ai)
#pragma unroll
            for (int m = 0; m < 4; ++m) { bf16_t* rowp = base + (size_t)(row0 + ai * HALF + m * 16) * ldc + col0;
#pragma unroll
                for (int bj = 0; bj < 2; ++bj) { f32x4 v0 = acc[ai][bj][m][0] + bv[bj][0], v1 = acc[ai][bj][m][1] + bv[bj][1];
                    if (ACT == 1) { f32x2 a = gelu_pk((f32x2){v0[0], v0[1]}), b = gelu_pk((f32x2){v0[2], v0[3]}), c = gelu_pk((f32x2){v1[0], v1[1]}), d = gelu_pk((f32x2){v1[2], v1[3]});
                        v0 = (f32x4){a.x, a.y, b.x, b.y}; v1 = (f32x4){c.x, c.y, d.x, d.y}; }
                    if (ACT == 2) { _Pragma("unroll") for (int q_ = 0; q_ < 4; ++q_) { const float a_ = v0[q_] > 0.f ? v0[q_] : 0.f, b_ = v1[q_] > 0.f ? v1[q_] : 0.f; v0[q_] = a_ * a_; v1[q_] = b_ * b_; } }
                    v0 = v0 * sc; v1 = v1 * sc; u32x4 w; w.x = cvt_pk_bf16(v0[0], v0[1]); w.y = cvt_pk_bf16(v0[2], v0[3]); w.z = cvt_pk_bf16(v1[0], v1[1]); w.w = cvt_pk_bf16(v1[2], v1[3]);
                    *(u32x4*)(rowp + bj * HALF) = w; } }
    }
};


struct EpiResBf16 {
    static constexpr bool PERM = true, AFTER_DRAIN = false;
    bf16_t* X; int ldc; float alpha;
    __device__ __forceinline__ void operator()(const f32x4 (&acc)[2][2][4][2], const Unit& u, int wr, int wc, int fr, int fq) const {
        const int row0 = u.pm * BM + wr * 64 + fr, col0 = u.pn * BM + wc * 32 + 8 * fq;
#pragma unroll
        for (int ai = 0; ai < 2; ++ai) {
            u32x4 xin[4][2];
#pragma unroll
            for (int m = 0; m < 4; ++m)
#pragma unroll
                for (int bj = 0; bj < 2; ++bj) xin[m][bj] = *(const u32x4*)(X + (size_t)(row0 + ai * HALF + m * 16) * ldc + col0 + bj * HALF);
#pragma unroll
            for (int m = 0; m < 4; ++m) { bf16_t* rowp = X + (size_t)(row0 + ai * HALF + m * 16) * ldc + col0;
#pragma unroll
                for (int bj = 0; bj < 2; ++bj) { const u32x4 xi = xin[m][bj]; const f32x4 a0 = acc[ai][bj][m][0], a1 = acc[ai][bj][m][1];
                    float x[8] = {__uint_as_float(xi.x << 16), __uint_as_float(xi.x & 0xffff0000u), __uint_as_float(xi.y << 16), __uint_as_float(xi.y & 0xffff0000u),
                                  __uint_as_float(xi.z << 16), __uint_as_float(xi.z & 0xffff0000u), __uint_as_float(xi.w << 16), __uint_as_float(xi.w & 0xffff0000u)};
                    u32x4 w; w.x = cvt_pk_bf16(alpha * x[0] + a0[0], alpha * x[1] + a0[1]); w.y = cvt_pk_bf16(alpha * x[2] + a0[2], alpha * x[3] + a0[3]);
                    w.z = cvt_pk_bf16(alpha * x[4] + a1[0], alpha * x[5] + a1[1]); w.w = cvt_pk_bf16(alpha * x[6] + a1[2], alpha * x[7] + a1[3]);
                    *(u32x4*)(rowp + bj * HALF) = w; } }
        }
    }
};

struct EpiF32 {
    static constexpr bool PERM = false, AFTER_DRAIN = false;
    float* C; int ldc;
    __device__ __forceinline__ void operator()(const f32x4 (&acc)[2][2][4][2], const Unit& u, int wr, int wc, int fr, int fq) const {
        const int row0 = u.pm * BM + wr * 64 + fr, col0 = u.pn * BM + wc * 32 + 4 * fq;
#pragma unroll
        for (int ai = 0; ai < 2; ++ai)
#pragma unroll
            for (int m = 0; m < 4; ++m) { float* rowp = C + (size_t)(row0 + ai * HALF + m * 16) * ldc + col0;
#pragma unroll
                for (int bj = 0; bj < 2; ++bj)
#pragma unroll
                    for (int n = 0; n < 2; ++n) *(f32x4*)(rowp + bj * HALF + n * 16) = acc[ai][bj][m][n]; }
    }
};
struct PanelStats {
    unsigned* xbuf;
    unsigned* cnt;
    unsigned* tmo;
    int ntn; float eps;
    unsigned code;
    __device__ __forceinline__ bool run(const f32x4 (&v)[2][2][4][2], const Unit& u, int wr, int wc, int fr, int fq, PG8_LAS unsigned char* lds, int wid, int lane) const {
        typedef float f32x2v __attribute__((ext_vector_type(2)));
        PG8_LAS f32x2v* P = (PG8_LAS f32x2v*)lds;
        PG8_LAS f32x2v* S = (PG8_LAS f32x2v*)(lds + 8192);
        PG8_LAS unsigned* flag = (PG8_LAS unsigned*)(lds + 8192 + 2048);
#pragma unroll
        for (int ai = 0; ai < 2; ++ai)
#pragma unroll
            for (int m = 0; m < 4; ++m) {
                float s = 0.f;
#pragma unroll
                for (int bj = 0; bj < 2; ++bj)
#pragma unroll
                    for (int n = 0; n < 2; ++n) { const f32x4 x = v[ai][bj][m][n]; s += (x[0] + x[1]) + (x[2] + x[3]); }
                s += __shfl_xor(s, 16); s += __shfl_xor(s, 32);
                const float mw = s * (1.0f / 64.0f); float q = 0.f;
#pragma unroll
                for (int bj = 0; bj < 2; ++bj)
#pragma unroll
                    for (int n = 0; n < 2; ++n) { const f32x4 d = v[ai][bj][m][n] - mw; q += (d[0] * d[0] + d[1] * d[1]) + (d[2] * d[2] + d[3] * d[3]); }
                q += __shfl_xor(q, 16); q += __shfl_xor(q, 32);
                if (fq == 0) P[(ai * HALF + wr * 64 + m * 16 + fr) * 4 + wc] = (f32x2v){mw, q};
            }
        asm volatile("s_waitcnt lgkmcnt(0)" ::: "memory"); __builtin_amdgcn_s_barrier(); asm volatile("" ::: "memory");
#if defined(BROKEN_EXCHANGE_NO_WAIT)
#warning BROKEN CONTROL BUILD: the row-statistics exchange does not wait; results are wrong by design
        if (blockIdx.x >= 64) { const long long t0_ = clock64(); while (clock64() - t0_ < 60000) __builtin_amdgcn_s_sleep(8); }
#endif
        const int row = wid * 32 + (lane & 31);
        if (lane < 32) {
            const f32x2v a = P[row * 4 + 0], b = P[row * 4 + 1], c = P[row * 4 + 2], d = P[row * 4 + 3];
            const float mt = (a.x + b.x + c.x + d.x) * 0.25f;
            const float da = a.x - mt, db = b.x - mt, dc = c.x - mt, dd = d.x - mt;
            const float m2 = (a.y + b.y) + (c.y + d.y) + 64.0f * ((da * da + db * db) + (dc * dc + dd * dd));
            unsigned long long* slot = (unsigned long long*)xbuf + ((size_t)(u.pm * BM + row) * 4 + u.pn);
            __hip_atomic_store(slot, ((unsigned long long)__float_as_uint(m2) << 32) | __float_as_uint(mt), __ATOMIC_RELAXED, __HIP_MEMORY_SCOPE_AGENT);
        }
        asm volatile("s_waitcnt vmcnt(0)" ::: "memory");
        if (lane == 0) __hip_atomic_fetch_add(cnt + 64 * u.pm, 1u, __ATOMIC_RELAXED, __HIP_MEMORY_SCOPE_AGENT);
        if (wid == 0) {
            bool dead = false; const unsigned long long t0 = __builtin_amdgcn_s_memrealtime(); const unsigned want = 8u * (unsigned)ntn;
            for (;;) {
#if defined(BROKEN_EXCHANGE_NO_WAIT)
                break;
#endif
                if ((unsigned)__builtin_amdgcn_readfirstlane(__hip_atomic_load(cnt + 64 * u.pm, __ATOMIC_RELAXED, __HIP_MEMORY_SCOPE_AGENT)) >= want) break;
                if (__builtin_amdgcn_s_memrealtime() - t0 > 2000000ull) {
                    if (lane == 0) { unsigned expect = 0u; __hip_atomic_compare_exchange_strong(tmo + 1, &expect, code | (unsigned)(u.pm & 0xff), __ATOMIC_RELAXED, __ATOMIC_RELAXED, __HIP_MEMORY_SCOPE_AGENT);
                                     __hip_atomic_store(tmo, 1u, __ATOMIC_RELAXED, __HIP_MEMORY_SCOPE_AGENT); }
                    dead = true; break; }
                __builtin_amdgcn_s_sleep(2);
            }
            __builtin_amdgcn_fence(__ATOMIC_ACQUIRE, "agent");
            if (lane == 0) flag[0] = dead ? 1u : 0u;
        }
        asm volatile("s_waitcnt vmcnt(0) lgkmcnt(0)" ::: "memory"); __builtin_amdgcn_s_barrier(); asm volatile("" ::: "memory");
        const bool bad = flag[0] != 0u;
        if (lane < 32) {
            const unsigned long long* slot = (const unsigned long long*)xbuf + (size_t)(u.pm * BM + row) * 4; float mt[4], m2[4]; float ms = 0.f;
#pragma unroll
            for (int t = 0; t < 4; ++t) { if (t < ntn) { const unsigned long long w = __hip_atomic_load(slot + t, __ATOMIC_RELAXED, __HIP_MEMORY_SCOPE_AGENT); mt[t] = __uint_as_float((unsigned)w); m2[t] = __uint_as_float((unsigned)(w >> 32)); } else { mt[t] = 0.f; m2[t] = 0.f; } ms += mt[t]; }
            const float mean = ms / (float)ntn; float q = 0.f;
#pragma unroll
            for (int t = 0; t < 4; ++t) if (t < ntn) { const float dm = mt[t] - mean; q += m2[t] + 256.0f * dm * dm; }
            S[row] = (f32x2v){mean, 1.0f / sqrtf(q / (256.0f * (float)ntn) + eps)};
        }
        asm volatile("s_waitcnt lgkmcnt(0)" ::: "memory"); __builtin_amdgcn_s_barrier(); asm volatile("" ::: "memory");
        return bad;
    }
};
struct EpiLnRes {
    static constexpr bool PERM = false, AFTER_DRAIN = true;
    const float* base; float* out; int ldc; const float* bias; PanelStats st; unsigned poison;
    __device__ __forceinline__ void fused(f32x4 (&acc)[2][2][4][2], const Unit& u, int wr, int wc, int fr, int fq, PG8_LAS unsigned char* lds, int wid, int lane) const {
        typedef float f32x2v __attribute__((ext_vector_type(2)));
        const PG8_LAS f32x2v* S = (const PG8_LAS f32x2v*)(lds + 8192);
        const int col0 = u.pn * BM + wc * 32 + 4 * fq;
#pragma unroll
        for (int bj = 0; bj < 2; ++bj)
#pragma unroll
            for (int n = 0; n < 2; ++n) { const f32x4 bv = bias ? *(const f32x4*)(bias + col0 + bj * HALF + n * 16) : (f32x4){0.f, 0.f, 0.f, 0.f};
#pragma unroll
                for (int ai = 0; ai < 2; ++ai)
#pragma unroll
                    for (int m = 0; m < 4; ++m) acc[ai][bj][m][n] += bv; }
        f32x4 pre[4][2][2];
#pragma unroll
        for (int m = 0; m < 4; ++m) { const size_t off = (size_t)(u.pm * BM + wr * 64 + m * 16 + fr) * ldc + col0;
#pragma unroll
            for (int bj = 0; bj < 2; ++bj)
#pragma unroll
                for (int n = 0; n < 2; ++n) pre[m][bj][n] = *(const f32x4*)(base + off + bj * HALF + n * 16); }
        const bool bad = st.run(acc, u, wr, wc, fr, fq, lds, wid, lane) || poison != 0u;
        const float qnan = __builtin_nanf("");
#pragma unroll
        for (int ai = 0; ai < 2; ++ai)
#pragma unroll
            for (int m = 0; m < 4; ++m) { const int r = ai * HALF + wr * 64 + m * 16 + fr; const f32x2v sr = S[r]; const size_t off = (size_t)(u.pm * BM + r) * ldc + col0;
#pragma unroll
                for (int bj = 0; bj < 2; ++bj)
#pragma unroll
                    for (int n = 0; n < 2; ++n) { const f32x4 bs = ai == 0 ? pre[m][bj][n] : *(const f32x4*)(base + off + bj * HALF + n * 16); f32x4 o = bs + (acc[ai][bj][m][n] - sr.x) * sr.y;
                        if (bad) o = (f32x4){qnan, qnan, qnan, qnan}; *(f32x4*)(out + off + bj * HALF + n * 16) = o; }
                if (m & 1) asm volatile("" ::: "memory"); }
    }
};
struct EpiLnResLn {
    static constexpr bool PERM = false, AFTER_DRAIN = true;
    const float* base; float* out; bf16_t* xn; int ldc; const float* bias; PanelStats st1, st2; unsigned poison;
    __device__ __forceinline__ void fused(f32x4 (&acc)[2][2][4][2], const Unit& u, int wr, int wc, int fr, int fq, PG8_LAS unsigned char* lds, int wid, int lane) const {
        typedef float f32x2v __attribute__((ext_vector_type(2))); typedef unsigned u32x2v __attribute__((ext_vector_type(2)));
        const PG8_LAS f32x2v* S = (const PG8_LAS f32x2v*)(lds + 8192);
        const int col0 = u.pn * BM + wc * 32 + 4 * fq;
#pragma unroll
        for (int bj = 0; bj < 2; ++bj)
#pragma unroll
            for (int n = 0; n < 2; ++n) { const f32x4 bv = bias ? *(const f32x4*)(bias + col0 + bj * HALF + n * 16) : (f32x4){0.f, 0.f, 0.f, 0.f};
#pragma unroll
                for (int ai = 0; ai < 2; ++ai)
#pragma unroll
                    for (int m = 0; m < 4; ++m) acc[ai][bj][m][n] += bv; }
        bool bad = st1.run(acc, u, wr, wc, fr, fq, lds, wid, lane) || poison != 0u;
        const float qnan = __builtin_nanf("");
#pragma unroll
        for (int ai = 0; ai < 2; ++ai)
#pragma unroll
            for (int m = 0; m < 4; ++m) { const int r = ai * HALF + wr * 64 + m * 16 + fr; const f32x2v sr = S[r]; const size_t off = (size_t)(u.pm * BM + r) * ldc + col0;
#pragma unroll
                for (int bj = 0; bj < 2; ++bj)
#pragma unroll
                    for (int n = 0; n < 2; ++n) { const f32x4 bs = *(const f32x4*)(base + off + bj * HALF + n * 16); acc[ai][bj][m][n] = bs + (acc[ai][bj][m][n] - sr.x) * sr.y; }
                asm volatile("" : "+v"(acc[ai][0][m][0]), "+v"(acc[ai][0][m][1]), "+v"(acc[ai][1][m][0]), "+v"(acc[ai][1][m][1]));
                if (m & 1) asm volatile("" ::: "memory"); }
        const bool bad1 = bad;
        bad = st2.run(acc, u, wr, wc, fr, fq, lds, wid, lane) || bad;
#pragma unroll
        for (int ai = 0; ai < 2; ++ai)
#pragma unroll
            for (int m = 0; m < 4; ++m) { const int r = ai * HALF + wr * 64 + m * 16 + fr; const f32x2v sr = S[r]; const size_t off = (size_t)(u.pm * BM + r) * ldc + col0;
#pragma unroll
                for (int bj = 0; bj < 2; ++bj)
#pragma unroll
                    for (int n = 0; n < 2; ++n) { const f32x4 x1 = acc[ai][bj][m][n]; *(f32x4*)(out + off + bj * HALF + n * 16) = bad1 ? (f32x4){qnan, qnan, qnan, qnan} : x1;
                        const f32x4 o = (x1 - sr.x) * sr.y; u32x2v w; w.x = cvt_pk_bf16(o[0], o[1]); w.y = cvt_pk_bf16(o[2], o[3]);
                        if (bad) { w.x = 0x7fc07fc0u; w.y = 0x7fc07fc0u; } *(u32x2v*)(xn + off + bj * HALF + n * 16) = w; }
                asm volatile("" ::: "memory"); }
    }
};

template <class Epi, class Sched, bool ALIGN_EPI = false, bool SP2 = false>
__device__ __forceinline__ void gemm_phase(PG8_LAS unsigned char* lds, const Gemm g, const Sched& S, const Epi& E, int wv) {
    int tid0_ = threadIdx.x; asm volatile("" : "+v"(tid0_)); (void)wv;
    const int tid = tid0_, wid = __builtin_amdgcn_readfirstlane(tid >> 6), lane = tid & 63, wr = wid >> 2, wc = wid & 3, fr = lane & 15, fq = lane >> 4;
    const int K = g.K, nt = K / BK;
    unsigned voffA[2], voffB[2];
#pragma unroll
    for (int i = 0; i < 2; ++i) { int R, C; stage_rc(tid * 16 + i * 8192, R, C); const int Rb = Epi::PERM ? ((R & ~31) + perm32(R & 31)) : R;
        voffA[i] = (unsigned)(R * K + C) * 2u; voffB[i] = (unsigned)(Rb * K + C) * 2u; }
    const size_t kstep = (size_t)(BK * 2);
    const size_t hstep = (size_t)HALF * K * 2;
    const size_t tstep = 2 * hstep;
    const unsigned ldsw = (unsigned)wid * 1024u;
    const int aoff = lds_byte(wr * 64 + fr, fq * 8), boff = lds_byte(wc * 32 + fr, fq * 8);
#define PG8_SA(b, h) (((b) * 2 + (h)) * HTB)
#define PG8_SB(b, h) ((4 + (b) * 2 + (h)) * HTB)
#define PG8_STAGE(bufoff, gbase, voff) do { _Pragma("unroll") for (int _i = 0; _i < 2; ++_i) \
        __builtin_amdgcn_global_load_lds((const unsigned*)((const char*)(gbase) + (voff)[_i]), (PG8_LAS unsigned*)(lds + (bufoff) + ldsw + _i * 8192), 16, 0, 0); } while (0)
#define PG8_LDA(dst, b, h) do { _Pragma("unroll") for (int m = 0; m < 4; ++m) _Pragma("unroll") for (int k = 0; k < 2; ++k) dst[m][k] = *(const PG8_LAS bf16x8*)(lds + PG8_SA(b, h) + aoff + m * 2048 + k * 1024); } while (0)
#define PG8_LDB(dst, b, h) do { _Pragma("unroll") for (int n = 0; n < 2; ++n) _Pragma("unroll") for (int k = 0; k < 2; ++k) dst[n][k] = *(const PG8_LAS bf16x8*)(lds + PG8_SB(b, h) + boff + n * 2048 + k * 1024); } while (0)
#define PG8_MMA(ai, bj, At, Bt) do { __builtin_amdgcn_s_setprio(1); _Pragma("unroll") for (int m = 0; m < 4; ++m) _Pragma("unroll") for (int n = 0; n < 2; ++n) _Pragma("unroll") for (int k = 0; k < 2; ++k) \
        acc[ai][bj][m][n] = __builtin_amdgcn_mfma_f32_16x16x32_bf16(Bt[n][k], At[m][k], acc[ai][bj][m][n], 0, 0, 0); __builtin_amdgcn_s_setprio(0); } while (0)
#define PG8_WAIT_V(n) asm volatile("s_waitcnt vmcnt(" #n ")" ::: "memory")
#define PG8_WAIT_L(n) asm volatile("s_waitcnt lgkmcnt(" #n ")" ::: "memory")
#define PG8_BAR __builtin_amdgcn_s_barrier()
#define PG8_SCHED __builtin_amdgcn_sched_barrier(0)
    Unit cur, nxt; int ui = 0;
    if (!S.next(0, cur)) return;
    f32x4 acc[2][2][4][2];
#pragma unroll
    for (int a = 0; a < 2; ++a)
#pragma unroll
        for (int b = 0; b < 2; ++b)
#pragma unroll
            for (int m = 0; m < 4; ++m)
#pragma unroll
                for (int n = 0; n < 2; ++n) acc[a][b][m][n] = (f32x4){0.f, 0.f, 0.f, 0.f};
    bf16x8 At[4][2], B0[2][2], B1[2][2];
    const char* cA = (const char*)g.A + (size_t)cur.pm * tstep; const char* cB = (const char*)g.Bt + (size_t)cur.pn * tstep;
    S.a_ready(cur);
    if constexpr (SP2) {
        PG8_STAGE(PG8_SB(0, 0), cB, voffB); PG8_STAGE(PG8_SB(0, 1), cB + hstep, voffB); PG8_STAGE(PG8_SA(0, 0), cA, voffA); PG8_STAGE(PG8_SA(0, 1), cA + hstep, voffA);
        if (wr == 1) PG8_BAR;
        PG8_WAIT_V(2); PG8_BAR;
        PG8_STAGE(PG8_SB(1, 0), cB + kstep, voffB); PG8_STAGE(PG8_SA(1, 0), cA + kstep, voffA); PG8_STAGE(PG8_SB(1, 1), cB + hstep + kstep, voffB);
        PG8_WAIT_V(6); PG8_BAR;
    } else {
        PG8_STAGE(PG8_SB(0, 0), cB, voffB); PG8_STAGE(PG8_SA(0, 0), cA, voffA); PG8_STAGE(PG8_SB(0, 1), cB + hstep, voffB); PG8_STAGE(PG8_SA(0, 1), cA + hstep, voffA);
        if (wr == 1) PG8_BAR;
        PG8_WAIT_V(4); PG8_BAR;
        PG8_STAGE(PG8_SB(1, 0), cB + kstep, voffB); PG8_STAGE(PG8_SA(1, 0), cA + kstep, voffA); PG8_STAGE(PG8_SB(1, 1), cB + hstep + kstep, voffB);
        PG8_WAIT_V(6); PG8_BAR;
    }
    for (;;) {
        const bool has_next = S.next(ui + 1, nxt);
        const char* nA = has_next ? (const char*)g.A + (size_t)nxt.pm * tstep : cA; const char* nB = has_next ? (const char*)g.Bt + (size_t)nxt.pn * tstep : cB;
        for (int t = 0; t < nt; t += 2) {
            const bool last = (t == nt - 2);
            const char* a1 = cA + (size_t)(t + 1) * kstep;
            const char* a2 = last ? nA : cA + (size_t)(t + 2) * kstep; const char* b2 = last ? nB : cB + (size_t)(t + 2) * kstep;
            const char* a3 = a2 + kstep; const char* b3 = b2 + kstep;
            if (last && has_next) S.a_ready(nxt);
            if constexpr (SP2) {
            PG8_LDB(B0, 0, 0); PG8_LDB(B1, 0, 1); PG8_SCHED; PG8_LDA(At, 0, 0); PG8_STAGE(PG8_SA(1, 1), a1 + hstep, voffA);
            PG8_WAIT_V(8); PG8_WAIT_L(0); PG8_BAR; PG8_MMA(0, 0, At, B0); PG8_MMA(0, 1, At, B1); PG8_BAR; PG8_SCHED;
            PG8_LDA(At, 0, 1); PG8_STAGE(PG8_SB(0, 0), b2, voffB); PG8_STAGE(PG8_SB(0, 1), b2 + hstep, voffB); PG8_STAGE(PG8_SA(0, 0), a2, voffA);
            PG8_WAIT_V(8); PG8_WAIT_L(0); PG8_BAR; PG8_MMA(1, 0, At, B0); PG8_MMA(1, 1, At, B1); PG8_BAR; PG8_SCHED;
            PG8_LDB(B0, 1, 0); PG8_LDB(B1, 1, 1); PG8_SCHED; PG8_LDA(At, 1, 0); PG8_STAGE(PG8_SA(0, 1), a2 + hstep, voffA);
            PG8_WAIT_V(8); PG8_WAIT_L(0); PG8_BAR; PG8_MMA(0, 0, At, B0); PG8_MMA(0, 1, At, B1); PG8_BAR; PG8_SCHED;
            PG8_LDA(At, 1, 1); PG8_STAGE(PG8_SB(1, 0), b3, voffB); PG8_STAGE(PG8_SB(1, 1), b3 + hstep, voffB); PG8_STAGE(PG8_SA(1, 0), a3, voffA);
            PG8_WAIT_V(8); PG8_WAIT_L(0); PG8_BAR; PG8_MMA(1, 0, At, B0); PG8_MMA(1, 1, At, B1); PG8_BAR; PG8_SCHED;
            } else {
            PG8_LDB(B0, 0, 0); PG8_SCHED; PG8_LDA(At, 0, 0); PG8_STAGE(PG8_SA(1, 1), a1 + hstep, voffA);
            PG8_WAIT_L(8); PG8_BAR; PG8_WAIT_L(0); PG8_MMA(0, 0, At, B0); PG8_BAR; PG8_SCHED;
            PG8_LDB(B1, 0, 1); PG8_STAGE(PG8_SB(0, 0), b2, voffB);
            PG8_BAR; PG8_WAIT_L(0); PG8_MMA(0, 1, At, B1); PG8_BAR;
            PG8_LDA(At, 0, 1); PG8_STAGE(PG8_SA(0, 0), a2, voffA);
            PG8_BAR; PG8_WAIT_L(0); PG8_MMA(1, 0, At, B0); PG8_BAR; PG8_SCHED;
            PG8_STAGE(PG8_SB(0, 1), b2 + hstep, voffB);
            PG8_WAIT_V(6); PG8_BAR; PG8_MMA(1, 1, At, B1); PG8_BAR;
            PG8_LDB(B0, 1, 0); PG8_SCHED; PG8_LDA(At, 1, 0); PG8_STAGE(PG8_SA(0, 1), a2 + hstep, voffA);
            PG8_WAIT_L(8); PG8_BAR; PG8_WAIT_L(0); PG8_MMA(0, 0, At, B0); PG8_BAR; PG8_SCHED;
            PG8_LDB(B1, 1, 1); PG8_STAGE(PG8_SB(1, 0), b3, voffB);
            PG8_BAR; PG8_WAIT_L(0); PG8_MMA(0, 1, At, B1); PG8_BAR;
            PG8_LDA(At, 1, 1); PG8_STAGE(PG8_SA(1, 0), a3, voffA);
            PG8_BAR; PG8_WAIT_L(0); PG8_MMA(1, 0, At, B0); PG8_BAR; PG8_SCHED;
            PG8_STAGE(PG8_SB(1, 1), b3 + hstep, voffB);
            PG8_WAIT_V(6); PG8_BAR; PG8_MMA(1, 1, At, B1); PG8_BAR;
            }
        }
        if constexpr (ALIGN_EPI) { if (wr == 0) PG8_BAR; }
        if constexpr (!Epi::AFTER_DRAIN) { E(acc, cur, wr, wc, fr, fq); S.done(cur); }
        if (!has_next) break;
#pragma unroll
        for (int a = 0; a < 2; ++a)
#pragma unroll
            for (int b = 0; b < 2; ++b)
#pragma unroll
                for (int m = 0; m < 4; ++m)
#pragma unroll
                    for (int n = 0; n < 2; ++n) acc[a][b][m][n] = (f32x4){0.f, 0.f, 0.f, 0.f};
        cur = nxt; cA = nA; cB = nB; ++ui;
        if constexpr (ALIGN_EPI) { if (wr == 1) PG8_BAR; }
    }
    PG8_WAIT_V(0);
    if constexpr (!ALIGN_EPI) { if (wr == 0) PG8_BAR; }
    PG8_BAR;
    if constexpr (Epi::AFTER_DRAIN) { E.fused(acc, cur, wr, wc, fr, fq, lds, wid, lane); S.done(cur); }
#undef PG8_SA
#undef PG8_SB
#undef PG8_STAGE
#undef PG8_LDA
#undef PG8_LDB
#undef PG8_MMA
#undef PG8_WAIT_V
#undef PG8_WAIT_L
#undef PG8_BAR
#undef PG8_SCHED
}
}

#ifndef PG8_SP2
#define PG8_SP2 true
#endif
#ifndef PG8_ALIGN
#define PG8_ALIGN true
#endif
#define GAS __attribute__((address_space(1)))
#define LAS __attribute__((address_space(3)))
#define XB_TMO      128
#define XB_XCNT(j)  (256  + 64 * (j))
#define XB_XSUB(j)  (1280 + 64 * (j))
#define XB_XGEN(j)  (2304 + 64 * (j))
#define XB_TOP      3328
#define XB_TOPGEN   3392
#define XCD_BAR_WORDS 3456
#define XB_SPIN_CAP (1u << 18)

__device__ __forceinline__ unsigned xb_ld(unsigned* p)              { return __hip_atomic_load(p, __ATOMIC_RELAXED, __HIP_MEMORY_SCOPE_AGENT); }
__device__ __forceinline__ unsigned xb_add(unsigned* p, unsigned v) { return __hip_atomic_fetch_add(p, v, __ATOMIC_RELAXED, __HIP_MEMORY_SCOPE_AGENT); }
__device__ __forceinline__ unsigned xb_xcc_id() { return (unsigned)__builtin_amdgcn_s_getreg((3 << 11) | 20) & 0xFu; }
#define XB_SPIN(cond, bar) do { unsigned _sp = 0; while (cond) { __builtin_amdgcn_s_sleep(1); \
    if ((++_sp & 255u) == 0u) { if (xb_ld(&(bar)[XB_TMO])) break; if (_sp > XB_SPIN_CAP) { atomicAdd(&(bar)[XB_TMO], 1u); break; } } } } while (0)

struct XcdBarrier {
    unsigned* bar; unsigned x;
    volatile LAS unsigned* st;
    int wv;
};

__device__ __forceinline__ XcdBarrier xcd_barrier_post(unsigned* bar, volatile LAS unsigned* st) {
    XcdBarrier b; b.bar = bar; b.x = xb_xcc_id(); b.st = st;
    if (threadIdx.x == 0) (void)xb_add(&bar[XB_XCNT(b.x)], 1u);
    return b;
}
__device__ __forceinline__ void xcd_barrier_complete(unsigned* bar, unsigned x, unsigned& nloc, unsigned& nx) {
    asm volatile("" : "+s"(x));
    const unsigned G = gridDim.x * gridDim.y * gridDim.z;
    unsigned sum, cnt, mine, sp = 0u;
    for (;;) {
        sum = 0u; cnt = 0u; mine = 0u;
#pragma unroll
        for (unsigned j = 0; j < 16; ++j) { const unsigned c = xb_ld(&bar[XB_XCNT(j)]); sum += c; cnt += (c > 0u) ? 1u : 0u; mine = (j == x) ? c : mine; }
        if (sum == G) break;
        __builtin_amdgcn_s_sleep(1);
        if ((++sp & 255u) == 0u) { if (xb_ld(&bar[XB_TMO])) break; if (sp > XB_SPIN_CAP) { atomicAdd(&bar[XB_TMO], 1u); break; } }
    }
    nloc = mine > 0u ? mine : 1u; nx = cnt > 0u ? cnt : 1u;
}

__device__ __forceinline__ void xcd_barrier(const XcdBarrier& b) {
    asm volatile("s_waitcnt vmcnt(0)" ::: "memory");
    __syncthreads();
    if (threadIdx.x == 0) {
        unsigned* bar = b.bar; asm volatile("" : "+s"(bar));
        __builtin_amdgcn_s_waitcnt(0);
        unsigned nloc = b.st[0], nx = b.st[1];
        if (nloc == 0u) { xcd_barrier_complete(bar, b.x, nloc, nx); b.st[0] = nloc; b.st[1] = nx; }
        const unsigned old = xb_add(&bar[XB_XSUB(b.x)], 1u);
        const unsigned gen = old / nloc;
        if (old + 1u == (gen + 1u) * nloc) {
            __builtin_amdgcn_fence(__ATOMIC_RELEASE, "agent");
            asm volatile("s_waitcnt vmcnt(0)" ::: "memory");
            const unsigned og = xb_add(&bar[XB_TOP], 1u);
            const unsigned tg = og / nx;
            if (og + 1u == (tg + 1u) * nx) xb_add(&bar[XB_TOPGEN], 1u);
            else XB_SPIN(xb_ld(&bar[XB_TOPGEN]) == tg, bar);
            __builtin_amdgcn_fence(__ATOMIC_ACQUIRE, "agent");
            xb_add(&bar[XB_XGEN(b.x)], 1u);
            asm volatile("s_waitcnt vmcnt(0)" ::: "memory");
        } else {
            XB_SPIN(xb_ld(&bar[XB_XGEN(b.x)]) == gen, bar);
            __builtin_amdgcn_fence(__ATOMIC_ACQUIRE, "agent");
            asm volatile("s_waitcnt vmcnt(0)" ::: "memory");
        }
    }
    __syncthreads();
}
namespace dattn {
constexpr int D = 128, QST = 2048, KVS = 512, OST = 2048, MTW = 68, JLO = 3;
constexpr float THR = 8.f; constexpr bool WSKIP = false;
typedef unsigned short bf16;
constexpr float SCALE = 1.0f;
constexpr int NW = 8, QBLK = 32, KVBLK = 64, QB = NW * QBLK;
constexpr int SHM_V = KVBLK * D * 2, SHM_K = KVBLK * D * 2;
constexpr int LDS_BYTES = 2 * SHM_V + 2 * SHM_K + NW * 64 * 4;

typedef short bf16x8 __attribute__((ext_vector_type(8)));
typedef short s16x4 __attribute__((ext_vector_type(4)));
typedef float f32x16 __attribute__((ext_vector_type(16)));
typedef float f32x4 __attribute__((ext_vector_type(4)));
typedef unsigned u32x4 __attribute__((ext_vector_type(4)));
template <class A, class Bt> struct same_t { static constexpr bool v = false; };
template <class A> struct same_t<A, A> { static constexpr bool v = true; };

#define KSWZ(row, colB) ((row) * 256 + ((colB) ^ (((row) & 7) << 4)))
#define SBAR() __builtin_amdgcn_sched_barrier(0)
__device__ __forceinline__ int v_st(int k, int c) { const int kk = (k & ~0xC) | ((k & 4) << 1) | ((k & 8) >> 1); return ((kk >> 3) * 4 + (c >> 5)) * 512 + ((kk & 7) * 32 + (c & 31)) * 2; }
__device__ __forceinline__ int v_rd_base(int lane) { return ((lane & 3) << 3) | (((lane >> 2) & 3) << 6) | (((lane >> 4) & 1) << 5) | (((lane >> 5) & 1) << 8); }
constexpr int v_rd_off(int d0, int ks, int half) { return d0 * 512 + ks * 4096 + half * 2048; }
__device__ __forceinline__ int crow(int r, int hi) { return (r & 3) + 8 * (r >> 2) + 4 * hi; }
__device__ __forceinline__ unsigned cvtpk(float lo, float hi) {
    unsigned r; asm volatile("v_cvt_pk_bf16_f32 %0, %1, %2" : "=v"(r) : "v"(lo), "v"(hi)); return r;
}
__device__ __forceinline__ bf16x8 pack8(f32x4 a, f32x4 b) {
    u32x4 w = {cvtpk(a[0], a[1]), cvtpk(a[2], a[3]), cvtpk(b[0], b[1]), cvtpk(b[2], b[3])};
    return *reinterpret_cast<bf16x8*>(&w);
}
template <class T> __device__ __forceinline__ bf16x8 load8(const T* p) {
    if constexpr (same_t<T, float>::v) { return pack8(*(const f32x4*)p, *(const f32x4*)(p + 4)); }
    else { return *reinterpret_cast<const bf16x8*>(p); }
}
__device__ __forceinline__ void mask_tile(f32x16& p0, f32x16& p1, int dq, unsigned W) {
    const float NEG = -__builtin_inff();
#pragma unroll
    for (int r = 0; r < 16; ++r) {
        const int c = (r & 3) + 8 * (r >> 2);
        if ((unsigned)(dq - c) >= W) p0[r] = NEG;
        if ((unsigned)(dq - c - 32) >= W) p1[r] = NEG;
    }
}
__device__ __forceinline__ void mask_bits(f32x16& p0, f32x16& p1, unsigned long long mw, int hi) {
    const float NEG = -__builtin_inff();
    const unsigned lo = (unsigned)(mw >> (4 * hi)), up = (unsigned)(mw >> (32 + 4 * hi));
#pragma unroll
    for (int r = 0; r < 16; ++r) {
        const int c = (r & 3) + 8 * (r >> 2);
        if (!((lo >> c) & 1u)) p0[r] = NEG;
        if (!((up >> c) & 1u)) p1[r] = NEG;
    }
}
__device__ __forceinline__ void partialSM(f32x16& p0, f32x16& p1, float& m_reg, float& mn, float& alpha) {
    float pmax = p0[0]; for (int r = 1; r < 16; ++r) pmax = fmaxf(pmax, p0[r]); for (int r = 0; r < 16; ++r) pmax = fmaxf(pmax, p1[r]);
    { auto rr = __builtin_amdgcn_permlane32_swap(__float_as_uint(pmax), __float_as_uint(pmax), false, false);
      pmax = fmaxf(__uint_as_float(rr[0]), __uint_as_float(rr[1])); }
    constexpr float C2 = 1.4426950408889634f * SCALE;
    if (__builtin_expect(__all((pmax - m_reg) * SCALE <= THR), 1)) { mn = m_reg; alpha = 1.f; }
    else { mn = fmaxf(m_reg, pmax); alpha = __builtin_amdgcn_exp2f((m_reg - mn) * C2); m_reg = mn; }
    const float mnL = -mn * C2;
    for (int r = 0; r < 16; ++r) p0[r] = fmaf(p0[r], C2, mnL); for (int r = 0; r < 16; ++r) p1[r] = fmaf(p1[r], C2, mnL);
    for (int r = 0; r < 16; ++r) p0[r] = __builtin_amdgcn_exp2f(p0[r]);
}
__device__ __forceinline__ void finishSM(f32x16& p0, f32x16& p1, float alpha, float& l_reg, bf16x8& pa0, bf16x8& pa1, bf16x8& pa2, bf16x8& pa3) {
    for (int r = 0; r < 16; ++r) p1[r] = __builtin_amdgcn_exp2f(p1[r]);
    float ps = 0; for (int r = 0; r < 16; ++r) ps += p0[r]; for (int r = 0; r < 16; ++r) ps += p1[r];
    { auto rr = __builtin_amdgcn_permlane32_swap(__float_as_uint(ps), __float_as_uint(ps), false, false);
      ps = __uint_as_float(rr[0]) + __uint_as_float(rr[1]); }
    l_reg = l_reg * alpha + ps;
#define PK4(P, B_, OUT) do { unsigned a0 = cvtpk(P[B_+0], P[B_+1]), a1 = cvtpk(P[B_+2], P[B_+3]);                          \
        unsigned b0 = cvtpk(P[B_+4], P[B_+5]), b1 = cvtpk(P[B_+6], P[B_+7]);                                             \
        auto r0 = __builtin_amdgcn_permlane32_swap(a0, b0, false, false); auto r1 = __builtin_amdgcn_permlane32_swap(a1, b1, false, false); \
        u32x4 w = {r0[0], r1[0], r0[1], r1[1]}; OUT = *reinterpret_cast<bf16x8*>(&w); } while (0)
    PK4(p0, 0, pa0); PK4(p0, 8, pa1); PK4(p1, 0, pa2); PK4(p1, 8, pa3);
#undef PK4
}
template <int KB, bool SK>
__device__ __forceinline__ void qkt(f32x16& p0, f32x16& p1, const char* K_lds, int r32, int hi, const bf16x8* qr, bool act) {
    if (SK && !act) { const float NEG = -__builtin_inff();
#pragma unroll
        for (int r = 0; r < 16; ++r) { p0[r] = NEG; p1[r] = NEG; } return; }
    p0 = f32x16{}; p1 = f32x16{};
    const char* kb[4];
#pragma unroll
    for (int dd = 0; dd < 4; ++dd) kb[dd] = K_lds + KB * SHM_K + KSWZ(r32, (dd * 16 + hi * 8) * 2);
#pragma unroll
    for (int d0 = 0; d0 < 8; ++d0) { const char* a = kb[d0 & 3] + (d0 >> 2) * 128;
        bf16x8 b0 = *reinterpret_cast<const bf16x8*>(a);
        bf16x8 b1 = *reinterpret_cast<const bf16x8*>(a + 32 * 256);
        p0 = __builtin_amdgcn_mfma_f32_32x32x16_bf16(b0, qr[d0], p0, 0, 0, 0);
        p1 = __builtin_amdgcn_mfma_f32_32x32x16_bf16(b1, qr[d0], p1, 0, 0, 0); }
}
template <int VB, bool SK>
__device__ __forceinline__ void pv_tile(f32x16* o, int vb0, bf16x8 pa0, bf16x8 pa1, bf16x8 pa2, bf16x8 pa3, bool act) {
    if (SK && !act) return;
#define TRRD(dst, off) asm volatile("ds_read_b64_tr_b16 %0, %1 offset:%2" : "=&v"(dst) : "v"(vb0), "i"(off) : "memory")
#define PV_D0(d0) do { s16x4 l0, l1, l2, l3, h0, h1, h2, h3; constexpr int b_ = VB * SHM_V + v_rd_off(d0, 0, 0);     \
        TRRD(l0, b_); TRRD(h0, b_ + 2048); TRRD(l1, b_ + 4096); TRRD(h1, b_ + 6144); TRRD(l2, b_ + 8192); TRRD(h2, b_ + 10240); TRRD(l3, b_ + 12288); TRRD(h3, b_ + 14336); \
        asm volatile("s_waitcnt lgkmcnt(0)" ::: "memory"); SBAR();                 \
        o[d0] = __builtin_amdgcn_mfma_f32_32x32x16_bf16(pa0, (bf16x8){l0[0], l0[1], l0[2], l0[3], h0[0], h0[1], h0[2], h0[3]}, o[d0], 0, 0, 0);   \
        o[d0] = __builtin_amdgcn_mfma_f32_32x32x16_bf16(pa1, (bf16x8){l1[0], l1[1], l1[2], l1[3], h1[0], h1[1], h1[2], h1[3]}, o[d0], 0, 0, 0);   \
        o[d0] = __builtin_amdgcn_mfma_f32_32x32x16_bf16(pa2, (bf16x8){l2[0], l2[1], l2[2], l2[3], h2[0], h2[1], h2[2], h2[3]}, o[d0], 0, 0, 0);   \
        o[d0] = __builtin_amdgcn_mfma_f32_32x32x16_bf16(pa3, (bf16x8){l3[0], l3[1], l3[2], l3[3], h3[0], h3[1], h3[2], h3[3]}, o[d0], 0, 0, 0); } while (0)
    PV_D0(0); PV_D0(1); PV_D0(2); PV_D0(3);
#undef PV_D0
#undef TRRD
}

template <class TIn, class TOut> struct BlockRef { const TIn* Q; const TIn* K; const TIn* V; TOut* O; const unsigned long long* M; int P0; };
template <class TIn> struct Seam {
    bf16x8 qr[8];
    bf16x8 st_v0, st_v1, st_k0, st_k1; f32x4 sf0, sf1, sf2, sf3;
    f32x4 tq[16];
};
__device__ __forceinline__ int swa_jlo(int, int) { return JLO; }
#define ROW(p, k0, rr) ((p) + (size_t)((k0) + (rr)) * KVS + sc)
#define VMW() asm volatile("s_waitcnt vmcnt(0)" ::: "memory")
#define VMWN(n) asm volatile("s_waitcnt vmcnt(%0)" :: "i"(n) : "memory")
#define SLOAD_H(Kp, Vp, k0) do { S.st_v0 = load8<TIn>(ROW(Vp, k0, sr)); S.st_v1 = load8<TIn>(ROW(Vp, k0, 32 + sr));              \
                         S.st_k0 = load8<TIn>(ROW(Kp, k0, sr)); S.st_k1 = load8<TIn>(ROW(Kp, k0, 32 + sr)); } while (0)
#define SWRITE_HK(bf) do { *(bf16x8*)(K_lds + (bf) * SHM_K + kws) = S.st_k0; *(bf16x8*)(K_lds + (bf) * SHM_K + kws + 32 * 256) = S.st_k1; } while (0)
#define SWRITE_HV(bf) do { *(bf16x8*)(V_lds + (bf) * SHM_V + vst0) = S.st_v0; *(bf16x8*)(V_lds + (bf) * SHM_V + vst1) = S.st_v1; } while (0)
#define SWRITE_H(bf) do { SWRITE_HV(bf); SWRITE_HK(bf); } while (0)
#define SLOAD_F(p, k0) do { S.sf0 = *(const f32x4*)ROW(p, k0, sr); S.sf1 = *(const f32x4*)(ROW(p, k0, sr) + 4);                \
                            S.sf2 = *(const f32x4*)ROW(p, k0, 32 + sr); S.sf3 = *(const f32x4*)(ROW(p, k0, 32 + sr) + 4); } while (0)
#define SWRITE_KF(bf) do { *(bf16x8*)(K_lds + (bf) * SHM_K + kws) = pack8(S.sf0, S.sf1); *(bf16x8*)(K_lds + (bf) * SHM_K + kws + 32 * 256) = pack8(S.sf2, S.sf3); } while (0)
#define SWRITE_VF(bf) do { *(bf16x8*)(V_lds + (bf) * SHM_V + vst0) = pack8(S.sf0, S.sf1); *(bf16x8*)(V_lds + (bf) * SHM_V + vst1) = pack8(S.sf2, S.sf3); } while (0)
template <class TIn, class TOut>
__device__ __forceinline__ void causal_swa_prime(const BlockRef<TIn, TOut>& cur, int W, char* lds, Seam<TIn>& S, int wv) {
    constexpr bool F32 = same_t<TIn, float>::v;
    int tid0_ = threadIdx.x; asm volatile("" : "+v"(tid0_)); (void)wv;
    const int tid = tid0_, wid = __builtin_amdgcn_readfirstlane(tid >> 6), lane = tid & 63, r32 = lane & 31, hi = lane >> 5;
    const int sr = tid >> 4, sc = (tid & 15) * 8, kws = KSWZ(sr, sc * 2); char* K_lds = lds + 2 * SHM_V;
    const int kb0 = swa_jlo(cur.P0, W) * KVBLK;
    for (int d0 = 0; d0 < 8; ++d0) S.qr[d0] = load8<TIn>(cur.Q + (size_t)(wid * QBLK + r32) * QST + d0 * 16 + hi * 8);
    if constexpr (F32) { SLOAD_F((const float*)cur.K, kb0); VMW(); SWRITE_KF(0); SBAR(); SLOAD_F((const float*)cur.V, kb0); }
    else { SLOAD_H(cur.K, cur.V, kb0); VMW(); SWRITE_HK(0); }
    __syncthreads();
}
template <class TIn, class TOut>
__device__ __forceinline__ void causal_swa_block(const BlockRef<TIn, TOut>& cur, const BlockRef<TIn, TOut>& nxt, int skv, int W, char* lds, Seam<TIn>& S, int wv) {
    constexpr bool F32 = same_t<TIn, float>::v;
    int tid0_ = threadIdx.x; asm volatile("" : "+v"(tid0_)); (void)wv;
    const int tid = tid0_, wid = __builtin_amdgcn_readfirstlane(tid >> 6), lane = tid & 63, r32 = lane & 31, hi = lane >> 5;
    const int j_lo = swa_jlo(cur.P0, W);
    int j_hi = (cur.P0 + QB - 1) / KVBLK + 1; if (j_hi > skv / KVBLK) j_hi = skv / KVBLK;
    const int NT = j_hi - j_lo;
    const int kbn = swa_jlo(nxt.P0, W) * KVBLK;
    const int qlo = cur.P0 + wid * QBLK; (void)qlo;
    const unsigned long long* mrow = cur.M + (size_t)(wid * QBLK + r32) * MTW;
    const int qm_unused = 0; (void)qm_unused;
    char* V_lds = lds; char* K_lds = lds + 2 * SHM_V;
    float* ws = (float*)(lds + 2 * SHM_V + 2 * SHM_K) + wid * 64; float* li_l = ws, * al_l = ws + 32;
    float m_reg = -1e30f, l_reg = 0; f32x16 o[4] = {};
    const int sr = tid >> 4, sc = (tid & 15) * 8, vst0 = v_st(sr, sc), vst1 = v_st(32 + sr, sc), kws = KSWZ(sr, sc * 2);
    const int vb0 = (int)(uintptr_t)V_lds + v_rd_base(lane);
    const TIn* Kh = cur.K; const TIn* Vh = cur.V;
#define RESC(a) do { if (__any((a) < 1.f)) { if (hi == 0) al_l[r32] = (a); asm volatile("s_waitcnt lgkmcnt(0)" ::: "memory");              \
                     for (int d_ = 0; d_ < 4; ++d_) for (int r = 0; r < 16; ++r) o[d_][r] *= al_l[crow(r, hi)]; } } while (0)
#define KBASE(t) ((j_lo + (t)) * KVBLK)
#define ACT(t) (KBASE(t) <= qlo + QBLK - 1 && KBASE(t) + KVBLK - 1 >= qlo - W + 1)
#define MASKT(P0_, P1_, t) mask_bits(P0_, P1_, (((t) & 1) ? mwB : mwA), hi)
#define MWLOAD(t) do { const int tt_ = (t) < NT ? (t) : NT - 1; if ((t) & 1) mwB = mrow[j_lo + tt_]; else mwA = mrow[j_lo + tt_]; } while (0)
    constexpr int NQL = F32 ? 16 : 8;
    constexpr bool SK = WSKIP && !F32;
#define SEAM_K0() do { VMWN(NQL); if constexpr (F32) { SWRITE_KF(0); SBAR(); SLOAD_F((const float*)nxt.V, kbn); } else { SWRITE_HK(0); } SBAR(); } while (0)
    f32x16 pA0, pA1, pB0, pB1; float mnA, mnB, alA, alB; bf16x8 pa0, pa1, pa2, pa3;
    unsigned long long mwA = mrow[j_lo], mwB = mrow[j_lo + (NT > 1 ? 1 : 0)];
    if constexpr (F32) { VMW(); SWRITE_VF(0); SBAR(); } else { SWRITE_HV(0); SBAR(); }
    if (NT > 1) { if constexpr (F32) SLOAD_F((const float*)Kh, KBASE(1)); else SLOAD_H(Kh, Vh, KBASE(1)); }
    SBAR(); qkt<0, SK>(pA0, pA1, K_lds, r32, hi, S.qr, ACT(0));
    if constexpr (F32) { if (NT > 1) { VMW(); SWRITE_KF(1); SBAR(); SLOAD_F((const float*)Vh, KBASE(1)); } }
    MASKT(pA0, pA1, 0); MWLOAD(2); partialSM(pA0, pA1, m_reg, mnA, alA);
    if (NT > 1) { VMW(); if constexpr (F32) { SWRITE_VF(1); SBAR(); if (NT > 2) SLOAD_F((const float*)Kh, KBASE(2)); } else SWRITE_H(1); }
    __syncthreads();
#define HALF_STEP(PX0, PX1, mnX, alX, PY0, PY1, alY, t, KB, VB, SB) do {                                                      \
        SBAR(); qkt<KB, SK>(PX0, PX1, K_lds, r32, hi, S.qr, ACT(t));                                             \
        finishSM(PY0, PY1, alY, l_reg, pa0, pa1, pa2, pa3); SBAR();                                                           \
        if ((t) + 1 < NT) { if constexpr (F32) { VMW(); SWRITE_KF(SB); SBAR(); SLOAD_F((const float*)Vh, KBASE((t) + 1)); }  \
                            else { SLOAD_H(Kh, Vh, KBASE((t) + 1)); } SBAR(); }                                               \
        pv_tile<VB, SK>(o, vb0, pa0, pa1, pa2, pa3, ACT((t) - 1)); MASKT(PX0, PX1, (t)); MWLOAD((t) + 2); partialSM(PX0, PX1, m_reg, mnX, alX);                                        \
        __syncthreads();                                                                                                      \
        if ((t) + 1 < NT) { VMW(); if constexpr (F32) { SWRITE_VF(SB); SBAR(); if ((t) + 2 < NT) SLOAD_F((const float*)Kh, KBASE((t) + 2)); } \
                            else { SWRITE_H(SB); } }                                                                          \
        RESC(alX); __syncthreads(); } while (0)
    for (int t = 1; t + 1 < NT; t += 2) {
        HALF_STEP(pB0, pB1, mnB, alB, pA0, pA1, alA, t, 1, 0, 0);
        HALF_STEP(pA0, pA1, mnA, alA, pB0, pB1, alB, t + 1, 0, 1, 1);
    }
    const bool even = (NT & 1) == 0;
    if (even) { SBAR(); qkt<1, SK>(pB0, pB1, K_lds, r32, hi, S.qr, ACT(NT - 1)); SBAR(); }
#define QROW(e) (nxt.Q + (size_t)(wid * QBLK + r32) * QST + ((e) >> 1) * 16 + hi * 8 + ((e) & 1) * 4)
    if constexpr (F32) { SLOAD_F((const float*)nxt.K, kbn); SBAR();
#pragma unroll
        for (int e = 0; e < 8; ++e) S.tq[e] = *(const f32x4*)QROW(e); }
    else { SLOAD_H(nxt.K, nxt.V, kbn); SBAR();
#pragma unroll
        for (int d0 = 0; d0 < 8; ++d0) S.qr[d0] = load8<TIn>(nxt.Q + (size_t)(wid * QBLK + r32) * QST + d0 * 16 + hi * 8); }
    SBAR();
    finishSM(pA0, pA1, alA, l_reg, pa0, pa1, pa2, pa3); SBAR();
    if constexpr (F32) {
#pragma unroll
        for (int e = 8; e < 16; ++e) S.tq[e] = *(const f32x4*)QROW(e); SBAR(); }
#undef QROW
    pv_tile<0, SK>(o, vb0, pa0, pa1, pa2, pa3, ACT(even ? NT - 2 : NT - 1));
    if (even) { MASKT(pB0, pB1, NT - 1); partialSM(pB0, pB1, m_reg, mnB, alB); __syncthreads(); RESC(alB);
        finishSM(pB0, pB1, alB, l_reg, pa0, pa1, pa2, pa3); SBAR(); pv_tile<1, SK>(o, vb0, pa0, pa1, pa2, pa3, ACT(NT - 1)); }
    SBAR(); SEAM_K0();
    if (hi == 0) li_l[r32] = l_reg; asm volatile("s_waitcnt lgkmcnt(0)" ::: "memory");
    float rli[16];
#pragma unroll
    for (int r = 0; r < 16; ++r) rli[r] = __builtin_amdgcn_rcpf(li_l[crow(r, hi)]);
    TOut* Ow = cur.O + (size_t)(wid * QBLK) * OST;
#pragma unroll
    for (int r = 0; r < 16; ++r) { const int orow = crow(r, hi);
#pragma unroll
        for (int d0 = 0; d0 < 4; ++d0) { const float v = o[d0][r] * rli[r];
            if constexpr (same_t<TOut, float>::v) { Ow[(size_t)orow * OST + d0 * 32 + r32] = v; }
            else { const float vn = __shfl_xor(v, 1);
                   if ((r32 & 1) == 0) *(unsigned*)(Ow + (size_t)orow * OST + d0 * 32 + r32) = cvtpk(v, vn); } } }
    if constexpr (F32) {
#pragma unroll
        for (int d0 = 0; d0 < 8; ++d0) S.qr[d0] = pack8(S.tq[2 * d0], S.tq[2 * d0 + 1]); }
    __syncthreads();
#undef RESC
#undef KBASE
#undef ACT
#undef MASKT
#undef MWLOAD
#undef SEAM_K0
#undef HALF_STEP
}
#undef ROW
#undef VMW
#undef VMWN
#undef SLOAD_H
#undef SWRITE_HK
#undef SWRITE_HV
#undef SWRITE_H
#undef SLOAD_F
#undef SWRITE_KF
#undef SWRITE_VF

}

constexpr int NWAVES = 8, NTHREADS = 512;
constexpr int DM = 2048, SEQ = 4096, NMETA = 16, TP = 4112, NBP = 2, SBN = 8, PAST = 16384, NPG = 128;
constexpr int XROW0 = 8192, SROW0 = 8224, NROWS = 8232, MPAD = 8448, FF = 8192, MAINM = 8192, XR = 48;
constexpr int NA_IN = 6144, NB_IN = 4176, NB_PAD = 4352, NC_IN = 12352, NC_PAD = 12544, DVW = 4096, CDIM = 8192;
constexpr float ALPHA = 1.6817928305074292f;
constexpr float LN_EPS = 1e-5f, RMS_EPS = 1e-6f;
constexpr int SCW = 4160, SCSW = 16448, KIROWS = 4128, NSKEY = PAST + 1;
constexpr int POS_SAMPLE_IDX = TP;

constexpr size_t O_YP = 0, O_YS = O_YP + (size_t)NBP * SEQ * DM, O_CAP = O_YS + (size_t)SBN * DM, O_CAS = O_CAP + 2 * NBP * 2 * DM,
                 O_KP = O_CAS + 2 * SBN * 2 * DM, O_VP = O_KP + (size_t)NBP * TP * 512, O_IKP = O_VP + (size_t)NBP * TP * 512,
                 O_KS = O_IKP + (size_t)NBP * TP * 64, O_VS = O_KS + SBN * 512, O_IKS = O_VS + SBN * 512, O_CCP = O_IKS + SBN * 64,
                 O_CCS = O_CCP + (size_t)NBP * 3 * CDIM, O_DP = O_CCS + (size_t)SBN * 3 * CDIM, O_DS = O_DP + (size_t)NBP * 32 * 128 * 128,
                 O_END = O_DS + (size_t)SBN * 32 * 128 * 128;

constexpr size_t MiB = 1u << 20;
constexpr size_t WS_CTL = 0, CTL_ZERO_BYTES = 1 * MiB;
constexpr size_t WS_TAB128 = 1 * MiB, WS_TAB64 = 4 * MiB, WS_WI = 6 * MiB, WS_G = 7 * MiB, WS_BETA = 9 * MiB, WS_CNT = 11 * MiB, WS_KIB = 12 * MiB,
                 WS_SCS = 14 * MiB, WS_IDXL = 16 * MiB, WS_X = 26 * MiB, WS_QR = 60 * MiB, WS_QI = 94 * MiB, WS_Z = 112 * MiB, WS_Y = 180 * MiB,
                 WS_BIG = 248 * MiB, WS_QKVC = 452 * MiB, WS_SC = 584 * MiB, WS_W = 716 * MiB;
constexpr size_t WSZ_A_IN = (size_t)NA_IN * DM * 2, WSZ_A_OUT = (size_t)DM * DM * 2, WSZ_B_IN = (size_t)NB_PAD * DM * 2, WSZ_B_OUT = (size_t)DM * DM * 2,
                 WSZ_C_IN = (size_t)NC_PAD * DM * 2, WSZ_C_OUT = (size_t)DM * DVW * 2, WSZ_W1 = (size_t)FF * DM * 2, WSZ_W2 = (size_t)DM * FF * 2;
constexpr size_t WS_WA_IN = WS_W, WS_WA_OUT = WS_WA_IN + 2 * WSZ_A_IN, WS_WB_IN = WS_WA_OUT + 2 * WSZ_A_OUT, WS_WB_OUT = WS_WB_IN + WSZ_B_IN,
                 WS_WC_IN = WS_WB_OUT + WSZ_B_OUT, WS_WC_OUT = WS_WC_IN + WSZ_C_IN, WS_W1 = WS_WC_OUT + WSZ_C_OUT, WS_W2 = WS_W1 + 4 * WSZ_W1,
                 WS_ZP = WS_W2 + 4 * WSZ_W2, WS_QKF = WS_ZP + 4 * MiB, WS_DWG = WS_QKF + 130 * MiB, WS_DUG = WS_DWG + 66 * MiB, WS_END = WS_DUG + 66 * MiB;
constexpr size_t WS_MASK = WS_IDXL, WS_KS = WS_Z, WS_VS = WS_Z + 9 * MiB;
constexpr size_t WS_DAF = WS_Z, WS_DTG = WS_Y, WS_DTB = WS_Y + 33 * MiB, WS_DPG = WS_QR, WS_DKT = WS_QKF, WS_DVT = WS_QKF + 33 * MiB, WS_DGC = WS_QI, WS_DBT = WS_QI + 2 * MiB;
constexpr int SP = 4352, SPAD = 240, MTW = 68;
constexpr int CW_BAR = 4096;

constexpr int RING_BYTES = 131072, LDSCTL_OFF = RING_BYTES, MISC_OFF = LDSCTL_OFF + 320, LDS_BYTES = 147456;

typedef unsigned short bf16;
typedef unsigned v4u __attribute__((ext_vector_type(4)));
typedef unsigned v2u __attribute__((ext_vector_type(2)));
typedef float f32x4 __attribute__((ext_vector_type(4)));
typedef float f32x2 __attribute__((ext_vector_type(2)));
typedef short bf16x8 __attribute__((ext_vector_type(8)));
typedef float f32x16 __attribute__((ext_vector_type(16)));
typedef __bf16 bf16x2_t __attribute__((ext_vector_type(2)));

#define LDS_WAIT() asm volatile("s_waitcnt lgkmcnt(0)" ::: "memory")
#define WAVE_SYNC() do { asm volatile("s_waitcnt lgkmcnt(0)" ::: "memory"); __builtin_amdgcn_wave_barrier(); } while (0)

__device__ __forceinline__ float bflo(unsigned w) { return __uint_as_float(w << 16); }
__device__ __forceinline__ float bfhi(unsigned w) { return __uint_as_float(w & 0xffff0000u); }
__device__ __forceinline__ float bf2f(bf16 h) { return __uint_as_float((unsigned)h << 16); }
__device__ __forceinline__ unsigned pk2(float lo, float hi) { f32x2 v = {lo, hi}; bf16x2_t b = __builtin_convertvector(v, bf16x2_t); return __builtin_bit_cast(unsigned, b); }
__device__ __forceinline__ bf16 f2bf(float f) { return (bf16)(pk2(f, 0.f) & 0xffffu); }
__device__ __forceinline__ float wave_sum(float v) {
#pragma unroll
    for (int o = 1; o < 64; o <<= 1) v += __shfl_xor(v, o);
    return v;
}
__device__ __forceinline__ float wave_max(float v) {
#pragma unroll
    for (int o = 1; o < 64; o <<= 1) v = fmaxf(v, __shfl_xor(v, o));
    return v;
}
__device__ __forceinline__ int wave_sum_i(int v) {
#pragma unroll
    for (int o = 1; o < 64; o <<= 1) v += __shfl_xor(v, o);
    return v;
}
__device__ __forceinline__ float wave_sum_dpp(float v) {
    v += __int_as_float(__builtin_amdgcn_update_dpp(0, __float_as_int(v), 0x128, 0xf, 0xf, false));
    v += __int_as_float(__builtin_amdgcn_update_dpp(0, __float_as_int(v), 0x124, 0xf, 0xf, false));
    v += __int_as_float(__builtin_amdgcn_update_dpp(0, __float_as_int(v), 0x122, 0xf, 0xf, false));
    v += __int_as_float(__builtin_amdgcn_update_dpp(0, __float_as_int(v), 0x121, 0xf, 0xf, false));
    const int iv = __float_as_int(v);
    return (__int_as_float(__builtin_amdgcn_readlane(iv, 0)) + __int_as_float(__builtin_amdgcn_readlane(iv, 16))) + (__int_as_float(__builtin_amdgcn_readlane(iv, 32)) + __int_as_float(__builtin_amdgcn_readlane(iv, 48)));
}
__device__ __forceinline__ int wave_sum_dpp_i(int v) {
    v += __builtin_amdgcn_update_dpp(0, v, 0x128, 0xf, 0xf, false);
    v += __builtin_amdgcn_update_dpp(0, v, 0x124, 0xf, 0xf, false);
    v += __builtin_amdgcn_update_dpp(0, v, 0x122, 0xf, 0xf, false);
    v += __builtin_amdgcn_update_dpp(0, v, 0x121, 0xf, 0xf, false);
    return __builtin_amdgcn_readlane(v, 0) + __builtin_amdgcn_readlane(v, 16) + __builtin_amdgcn_readlane(v, 32) + __builtin_amdgcn_readlane(v, 48);
}
__device__ __forceinline__ float row16_sum(float v) {
    v += __int_as_float(__builtin_amdgcn_update_dpp(0, __float_as_int(v), 0x128, 0xf, 0xf, false));
    v += __int_as_float(__builtin_amdgcn_update_dpp(0, __float_as_int(v), 0x124, 0xf, 0xf, false));
    v += __int_as_float(__builtin_amdgcn_update_dpp(0, __float_as_int(v), 0x122, 0xf, 0xf, false));
    v += __int_as_float(__builtin_amdgcn_update_dpp(0, __float_as_int(v), 0x121, 0xf, 0xf, false));
    return v;
}
__device__ __forceinline__ float silu_f(float x) { return x / (1.f + __expf(-x)); }
__device__ __forceinline__ int prow(int b, int t) { return t >= NMETA ? b * SEQ + (t - NMETA) : XROW0 + b * NMETA + t; }
__device__ __forceinline__ void row_bt(int r, int& b, int& t) { if (r < XROW0) { b = r >> 12; t = (r & 4095) + NMETA; } else { b = (r - XROW0) >> 4; t = (r - XROW0) & 15; } }
__device__ __forceinline__ void unpack8(const v4u w, float (&f)[8]) {
    f[0] = bflo(w.x); f[1] = bfhi(w.x); f[2] = bflo(w.y); f[3] = bfhi(w.y); f[4] = bflo(w.z); f[5] = bfhi(w.z); f[6] = bflo(w.w); f[7] = bfhi(w.w);
}
__device__ __forceinline__ v4u pack8(const float (&f)[8]) { v4u w; w.x = pk2(f[0], f[1]); w.y = pk2(f[2], f[3]); w.z = pk2(f[4], f[5]); w.w = pk2(f[6], f[7]); return w; }

struct TrJob { bf16* WT; int K, k0, n0; bool ok, valid; };
__device__ __forceinline__ void tr_issue(const float* W, int K, int N, int Npad, bf16* WT, int item, int lane, float (&wv_)[32], TrJob& J) {
    const int nblk = Npad / 32, kb = item / nblk, nb = item % nblk, k0 = 64 * kb, n0 = 32 * nb;
    const int n = n0 + (lane & 31); const bool ok = n < N;
#pragma unroll
    for (int i = 0; i < 32; ++i) { const int kk = 2 * i + (lane >> 5); wv_[i] = W[(size_t)(k0 + kk) * N + (ok ? n : N - 1)]; }
    J.WT = WT; J.K = K; J.k0 = k0; J.n0 = n0; J.ok = ok; J.valid = true;
}
__device__ __forceinline__ void tr_finish(const float (&wv_)[32], const TrJob& J, LAS float* scr, int lane) {
#pragma unroll
    for (int i = 0; i < 32; ++i) { const int kk = 2 * i + (lane >> 5); scr[kk * 33 + (lane & 31)] = J.ok ? wv_[i] : 0.f; }
    LDS_WAIT(); __builtin_amdgcn_wave_barrier();
    const int c = lane & 7;
#pragma unroll
    for (int j = 0; j < 4; ++j) { const int nn = (lane >> 3) + 8 * j; const LAS float* sp = scr + (8 * c) * 33 + nn;
        v4u o; o.x = pk2(sp[0 * 33], sp[1 * 33]); o.y = pk2(sp[2 * 33], sp[3 * 33]); o.z = pk2(sp[4 * 33], sp[5 * 33]); o.w = pk2(sp[6 * 33], sp[7 * 33]);
        *(v4u*)(J.WT + (size_t)(J.n0 + nn) * J.K + J.k0 + 8 * c) = o; }
    LDS_WAIT(); __builtin_amdgcn_wave_barrier();
}
__device__ __forceinline__ void transpose_item(const float* W, int K, int N, int Npad, bf16* WT, LAS float* scr, int item, int lane) {
    float wv_[32]; TrJob J; tr_issue(W, K, N, Npad, WT, item, lane, wv_, J); tr_finish(wv_, J, scr, lane);
}

struct Ptrs {
    const float *x_prompt, *x_sample, *state_conv_a, *cache_k, *cache_v, *cache_ik, *state_conv_c, *state_delta;
    const int* page_table;
    const float *meta, *w_in_a, *conv_w_a, *w_out_a, *w_in_b, *w_out_b, *w_in_c, *conv_w_c, *a_log, *dt_bias, *norm_w, *w_out_c, *ln1_g, *ln1_b, *w1, *w2, *ln2_g, *ln2_b;
    float* out; unsigned char* ws;
};

__device__ __forceinline__ void p0_prologue(const Ptrs& P, LAS unsigned char* lds, int gw, int NGW, int wave, int lane) {
    LAS float* scr = (LAS float*)(lds + wave * 16384);
    unsigned char* ws = P.ws;
    constexpr int I_A_IN = (DM / 64) * (NA_IN / 32), I_A_OUT = (DM / 64) * (DM / 32), I_B_IN = (DM / 64) * (NB_PAD / 32), I_B_OUT = I_A_OUT,
                  I_C_IN = (DM / 64) * (NC_PAD / 32), I_C_OUT = (DVW / 64) * (DM / 32), I_W1 = (DM / 64) * (FF / 32), I_W2 = (FF / 64) * (DM / 32);
    constexpr int NITEMS = I_A_IN + I_A_OUT + I_B_IN + I_W1 + I_W2;
#define TR_(cnt, Wp, Kk, Nn, Np, WTp) if (r < (cnt)) { transpose_item((Wp), (Kk), (Nn), (Np), (bf16*)(WTp), scr, r, lane); continue; } r -= (cnt);
    for (int it = gw; it < NITEMS; it += NGW) {
        int r = it;
        TR_(I_A_IN, P.w_in_a, DM, NA_IN, NA_IN, ws + WS_WA_IN)
        TR_(I_A_OUT, P.w_out_a, DM, DM, DM, ws + WS_WA_OUT)
        TR_(I_B_IN, P.w_in_b, DM, NB_IN, NB_PAD, ws + WS_WB_IN)
        TR_(I_W1, P.w1, DM, FF, FF, ws + WS_W1)
        transpose_item(P.w2, FF, DM, DM, (bf16*)(ws + WS_W2), scr, r, lane);
    }
#undef TR_
    bf16* X = (bf16*)(ws + WS_X);
    for (int r = gw; r < MPAD; r += NGW) {
        const float* src = nullptr;
        if (r < XROW0) src = P.x_prompt + (size_t)r * DM;
        else if (r < SROW0) src = P.meta + (size_t)((r - XROW0) & 15) * DM;
        else if (r < NROWS) src = P.x_sample + (size_t)(r - SROW0) * DM;
#pragma unroll
        for (int j = 0; j < 4; ++j) { const int c = 512 * j + 8 * lane; v4u o = {0u, 0u, 0u, 0u};
            if (src) { const f32x4 a = *(const f32x4*)(src + c), b = *(const f32x4*)(src + c + 4); o.x = pk2(a.x, a.y); o.y = pk2(a.z, a.w); o.z = pk2(b.x, b.y); o.w = pk2(b.z, b.w); }
            *(v4u*)(X + (size_t)r * DM + c) = o; }
    }
    f32x2* t128 = (f32x2*)(ws + WS_TAB128); f32x2* t64 = (f32x2*)(ws + WS_TAB64);
    const int gt = gw * 64 + lane, NGT = NGW * 64;
    for (int e = gt; e < (TP + 1) * 96; e += NGT) {
        const int pi = e / 96, i = e % 96; const float pos = (float)(pi == TP ? PAST : pi);
        const float ex = (i < 64) ? (float)(2 * i) * (1.f / 128.f) : (float)(2 * (i - 64)) * (1.f / 64.f);
        const float inv = __builtin_amdgcn_exp2f(-ex * 13.287712379549449f);
        const float angf = pos * inv;
        double rev = (double)angf * 0.15915494309189535; rev -= __builtin_rint(rev);
        const float rf = (float)rev; const float sn = __builtin_amdgcn_sinf(rf), cs = __builtin_amdgcn_cosf(rf);
        if (i < 64) t128[pi * 64 + i] = (f32x2){cs, sn}; else t64[pi * 32 + (i - 64)] = (f32x2){cs, sn};
    }
}

constexpr int NHOSTED = (DM / 64) * (DM / 32) + (DM / 64) * (FF / 32) + (FF / 64) * (DM / 32) + (DM / 64) * (NC_PAD / 32);
__device__ __forceinline__ void hosted_issue(const Ptrs& P, int it, int lane, float (&wv_)[32], TrJob& J) {
    unsigned char* ws = P.ws;
    constexpr int I_B_OUT = (DM / 64) * (DM / 32), I_C_IN = (DM / 64) * (NC_PAD / 32), I_W1 = (DM / 64) * (FF / 32), I_W2 = (FF / 64) * (DM / 32);
    J.valid = false;
    if (it >= NHOSTED) return;
    int r = it;
    if (r < I_B_OUT) { tr_issue(P.w_out_b, DM, DM, DM, (bf16*)(ws + WS_WB_OUT), r, lane, wv_, J); return; } r -= I_B_OUT;
    if (r < I_W1) { tr_issue(P.w1 + (size_t)DM * FF, DM, FF, FF, (bf16*)(ws + WS_W1 + WSZ_W1), r, lane, wv_, J); return; } r -= I_W1;
    if (r < I_W2) { tr_issue(P.w2 + (size_t)DM * FF, FF, DM, DM, (bf16*)(ws + WS_W2 + WSZ_W2), r, lane, wv_, J); return; } r -= I_W2;
    (void)I_C_IN; tr_issue(P.w_in_c, DM, NC_IN, NC_PAD, (bf16*)(ws + WS_WC_IN), r, lane, wv_, J);
}
__device__ __forceinline__ void deferred_transposes(const Ptrs& P, LAS unsigned char* lds, int idx, int stride, int wave, int lane) {
    LAS float* scr = (LAS float*)(lds + wave * 16384);
    unsigned char* ws = P.ws;
    constexpr int I_A_IN = (DM / 64) * (NA_IN / 32), I_A_OUT = (DM / 64) * (DM / 32), I_C_OUT = (DVW / 64) * (DM / 32), I_W1 = (DM / 64) * (FF / 32), I_W2 = (FF / 64) * (DM / 32);
    constexpr int NITEMS = I_A_IN + I_A_OUT + I_C_OUT + 2 * I_W1 + 2 * I_W2;
#define TR_(cnt, Wp, Kk, Nn, Np, WTp) if (r < (cnt)) { transpose_item((Wp), (Kk), (Nn), (Np), (bf16*)(WTp), scr, r, lane); continue; } r -= (cnt);
    for (int it = idx; it < NITEMS; it += stride) {
        int r = it;
        TR_(I_C_OUT, P.w_out_c, DVW, DM, DM, ws + WS_WC_OUT)
        TR_(I_W1, P.w1 + 2 * (size_t)DM * FF, DM, FF, FF, ws + WS_W1 + 2 * WSZ_W1)
        TR_(I_W2, P.w2 + 2 * (size_t)DM * FF, FF, DM, DM, ws + WS_W2 + 2 * WSZ_W2)
        TR_(I_A_IN, P.w_in_a + (size_t)DM * NA_IN, DM, NA_IN, NA_IN, ws + WS_WA_IN + WSZ_A_IN)
        TR_(I_A_OUT, P.w_out_a + (size_t)DM * DM, DM, DM, DM, ws + WS_WA_OUT + WSZ_A_OUT)
        TR_(I_W1, P.w1 + 3 * (size_t)DM * FF, DM, FF, FF, ws + WS_W1 + 3 * WSZ_W1)
        transpose_item(P.w2 + 3 * (size_t)DM * FF, FF, DM, DM, (bf16*)(ws + WS_W2 + 3 * WSZ_W2), scr, r, lane);
    }
#undef TR_
}

__device__ __forceinline__ void ln_row_finish(float (&v)[32], float s, const f32x4 (&gq)[8], const f32x4 (&bq_)[8], bf16* xo, float* of, int lane) {
    const float mean = wave_sum_dpp(s) * (1.f / DM); float s2 = 0.f;
#pragma unroll
    for (int i = 0; i < 32; ++i) { v[i] -= mean; s2 += v[i] * v[i]; }
    const float rstd = 1.f / sqrtf(wave_sum_dpp(s2) * (1.f / DM) + LN_EPS);
#pragma unroll
    for (int j = 0; j < 4; ++j) { const int c = 512 * j + 8 * lane; const f32x4 g0 = gq[2 * j], g1 = gq[2 * j + 1], b0 = bq_[2 * j], b1 = bq_[2 * j + 1];
        float o[8];
        o[0] = v[8 * j + 0] * rstd * g0.x + b0.x; o[1] = v[8 * j + 1] * rstd * g0.y + b0.y; o[2] = v[8 * j + 2] * rstd * g0.z + b0.z; o[3] = v[8 * j + 3] * rstd * g0.w + b0.w;
        o[4] = v[8 * j + 4] * rstd * g1.x + b1.x; o[5] = v[8 * j + 5] * rstd * g1.y + b1.y; o[6] = v[8 * j + 6] * rstd * g1.z + b1.z; o[7] = v[8 * j + 7] * rstd * g1.w + b1.w;
        *(v4u*)(xo + c) = pack8(o);
        if (of) { *(f32x4*)(of + c) = (f32x4){o[0], o[1], o[2], o[3]}; *(f32x4*)(of + c + 4) = (f32x4){o[4], o[5], o[6], o[7]}; } }
}
__device__ __forceinline__ void ln_phase(const float* Z, const float* ZP, bf16* X, bf16* Xo, const float* gam, const float* bet, float* yp, float* ys, LAS unsigned char* lds, int gw, int NGW, int tid, int wave, int lane) {
    (void)Z;
    LAS float* red = (LAS float*)lds;
    for (int xr = blockIdx.x; xr < NROWS - XROW0; xr += gridDim.x) {
        const int r = XROW0 + xr, c = 256 * wave + 4 * lane;
        const v2u xv = *(const v2u*)(X + (size_t)r * DM + c);
        const float* zr = ZP + (size_t)xr * DM + c; f32x4 z = *(const f32x4*)zr;
#pragma unroll
        for (int sl = 1; sl < 8; ++sl) z += *(const f32x4*)(zr + (size_t)sl * XR * DM);
        float v4[4] = {ALPHA * bflo(xv.x) + z.x, ALPHA * bfhi(xv.x) + z.y, ALPHA * bflo(xv.y) + z.z, ALPHA * bfhi(xv.y) + z.w};
        const float ps = wave_sum_dpp((v4[0] + v4[1]) + (v4[2] + v4[3]));
        __syncthreads();
        if (lane == 0) red[wave] = ps;
        __syncthreads();
        float tot = 0.f;
#pragma unroll
        for (int w = 0; w < 8; ++w) tot += red[w];
        const float mean = tot * (1.f / DM); float q2 = 0.f;
#pragma unroll
        for (int i = 0; i < 4; ++i) { v4[i] -= mean; q2 += v4[i] * v4[i]; }
        const float pq = wave_sum_dpp(q2);
        if (lane == 0) red[8 + wave] = pq;
        __syncthreads();
        float tq = 0.f;
#pragma unroll
        for (int w = 0; w < 8; ++w) tq += red[8 + w];
        const float rstd = 1.f / sqrtf(tq * (1.f / DM) + LN_EPS);
        const f32x4 g = *(const f32x4*)(gam + c), be = *(const f32x4*)(bet + c);
        const float o0 = v4[0] * rstd * g.x + be.x, o1 = v4[1] * rstd * g.y + be.y, o2 = v4[2] * rstd * g.z + be.z, o3 = v4[3] * rstd * g.w + be.w;
        v2u ov; ov.x = pk2(o0, o1); ov.y = pk2(o2, o3); *(v2u*)(Xo + (size_t)r * DM + c) = ov;
        if (ys && r >= SROW0) *(f32x4*)(ys + (size_t)(r - SROW0) * DM + c) = (f32x4){o0, o1, o2, o3};
    }
    f32x4 gq[8], bq_[8];
#pragma unroll
    for (int j = 0; j < 4; ++j) { const int c = 512 * j + 8 * lane; gq[2 * j] = *(const f32x4*)(gam + c); gq[2 * j + 1] = *(const f32x4*)(gam + c + 4); bq_[2 * j] = *(const f32x4*)(bet + c); bq_[2 * j + 1] = *(const f32x4*)(bet + c + 4); }
    for (int r = gw; r < XROW0; r += 2 * NGW) {
        const int r2 = r + NGW; const bool two = r2 < XROW0;
        v4u xa[4], xb[4];
#pragma unroll
        for (int j = 0; j < 4; ++j) { const int c = 512 * j + 8 * lane; xa[j] = *(const v4u*)(X + (size_t)r * DM + c); xb[j] = *(const v4u*)(X + (size_t)(two ? r2 : r) * DM + c); }
        float va[32], vb[32]; float sa = 0.f, sb = 0.f;
#pragma unroll
        for (int j = 0; j < 4; ++j) { float t8[8]; unpack8(xa[j], t8);
#pragma unroll
            for (int i = 0; i < 8; ++i) { va[8 * j + i] = t8[i]; sa += t8[i]; }
            unpack8(xb[j], t8);
#pragma unroll
            for (int i = 0; i < 8; ++i) { vb[8 * j + i] = t8[i]; sb += t8[i]; } }
        ln_row_finish(va, sa, gq, bq_, Xo + (size_t)r * DM, yp ? yp + (size_t)r * DM : nullptr, lane);
        if (two) ln_row_finish(vb, sb, gq, bq_, Xo + (size_t)r2 * DM, yp ? yp + (size_t)r2 * DM : nullptr, lane);
    }
}

__device__ __forceinline__ void load_u(const bf16* BCH, int row, int c0, float (&u)[8]) {
    const v4u cg = *(const v4u*)(BCH + (size_t)row * NA_IN + DM + c0), hh = *(const v4u*)(BCH + (size_t)row * NA_IN + 2 * DM + c0);
    float a[8], b[8]; unpack8(cg, a); unpack8(hh, b);
#pragma unroll
    for (int i = 0; i < 8; ++i) u[i] = a[i] * b[i];
}
__device__ __forceinline__ void convA_phase(const bf16* BCH, bf16* Y, const float* cw, const float* hist, float* outp, float* outs, int gtid, int NT) {
    constexpr int RUN = 8, NRUN = SEQ / RUN;
    for (int it = gtid; it < (NBP * NRUN + NBP * NMETA + SBN) * 256; it += NT) {
        const int c0 = (it & 255) * 8, ru = it >> 8;
        float w0[8], w1[8], w2[8];
        { const f32x4 a = *(const f32x4*)(cw + c0), b = *(const f32x4*)(cw + c0 + 4); w0[0] = a.x; w0[1] = a.y; w0[2] = a.z; w0[3] = a.w; w0[4] = b.x; w0[5] = b.y; w0[6] = b.z; w0[7] = b.w; }
        { const f32x4 a = *(const f32x4*)(cw + DM + c0), b = *(const f32x4*)(cw + DM + c0 + 4); w1[0] = a.x; w1[1] = a.y; w1[2] = a.z; w1[3] = a.w; w1[4] = b.x; w1[5] = b.y; w1[6] = b.z; w1[7] = b.w; }
        { const f32x4 a = *(const f32x4*)(cw + 2 * DM + c0), b = *(const f32x4*)(cw + 2 * DM + c0 + 4); w2[0] = a.x; w2[1] = a.y; w2[2] = a.z; w2[3] = a.w; w2[4] = b.x; w2[5] = b.y; w2[6] = b.z; w2[7] = b.w; }
        float u0[8], u1[8], u2[8];
        if (ru < NBP * NRUN) {
            const int b = ru / NRUN, t0 = NMETA + (ru % NRUN) * RUN;
            if (t0 >= 1) load_u(BCH, prow(b, t0 - 1), c0, u1); else {
#pragma unroll
                for (int i = 0; i < 8; ++i) u1[i] = 0.f; }
            if (t0 >= 2) load_u(BCH, prow(b, t0 - 2), c0, u0); else {
#pragma unroll
                for (int i = 0; i < 8; ++i) u0[i] = 0.f; }
            const int r0 = prow(b, t0);
            v4u bq[RUN], cq[RUN], hq_[RUN];
#pragma unroll
            for (int k = 0; k < RUN; ++k) { const bf16* rp = BCH + (size_t)(r0 + k) * NA_IN + c0; bq[k] = *(const v4u*)rp; cq[k] = *(const v4u*)(rp + DM); hq_[k] = *(const v4u*)(rp + 2 * DM); }
#pragma unroll
            for (int k = 0; k < RUN; ++k) {
                const int r = r0 + k, t = t0 + k;
                { float ca[8], ha[8]; unpack8(cq[k], ca); unpack8(hq_[k], ha);
#pragma unroll
                  for (int i = 0; i < 8; ++i) u2[i] = ca[i] * ha[i]; }
                float bg[8]; unpack8(bq[k], bg);
                float y[8];
#pragma unroll
                for (int i = 0; i < 8; ++i) y[i] = bg[i] * (w0[i] * u0[i] + w1[i] * u1[i] + w2[i] * u2[i]);
                *(v4u*)(Y + (size_t)r * DM + c0) = pack8(y);
                if (t >= TP - 2) { float* o = outp + ((size_t)(b * 2 + (t - (TP - 2)))) * DM + c0; *(f32x4*)o = (f32x4){u2[0], u2[1], u2[2], u2[3]}; *(f32x4*)(o + 4) = (f32x4){u2[4], u2[5], u2[6], u2[7]}; }
#pragma unroll
                for (int i = 0; i < 8; ++i) { u0[i] = u1[i]; u1[i] = u2[i]; }
            }
        } else if (ru < NBP * NRUN + NBP * NMETA) {
            const int mi = ru - NBP * NRUN, b = mi / NMETA, t = mi % NMETA, r = XROW0 + mi;
            load_u(BCH, r, c0, u2);
            if (t >= 1) load_u(BCH, r - 1, c0, u1); else {
#pragma unroll
                for (int i = 0; i < 8; ++i) u1[i] = 0.f; }
            if (t >= 2) load_u(BCH, r - 2, c0, u0); else {
#pragma unroll
                for (int i = 0; i < 8; ++i) u0[i] = 0.f; }
            (void)b;
            float bg[8]; unpack8(*(const v4u*)(BCH + (size_t)r * NA_IN + c0), bg);
            float y[8];
#pragma unroll
            for (int i = 0; i < 8; ++i) y[i] = bg[i] * (w0[i] * u0[i] + w1[i] * u1[i] + w2[i] * u2[i]);
            *(v4u*)(Y + (size_t)r * DM + c0) = pack8(y);
        } else {
            const int sb = ru - NBP * NRUN - NBP * NMETA, r = SROW0 + sb;
            load_u(BCH, r, c0, u2);
            const float* h0 = hist + ((size_t)(sb * 2 + 0)) * DM + c0; const float* h1 = hist + ((size_t)(sb * 2 + 1)) * DM + c0;
            const f32x4 a0 = *(const f32x4*)h0, a1 = *(const f32x4*)(h0 + 4), b0 = *(const f32x4*)h1, b1 = *(const f32x4*)(h1 + 4);
            u0[0] = a0.x; u0[1] = a0.y; u0[2] = a0.z; u0[3] = a0.w; u0[4] = a1.x; u0[5] = a1.y; u0[6] = a1.z; u0[7] = a1.w;
            u1[0] = b0.x; u1[1] = b0.y; u1[2] = b0.z; u1[3] = b0.w; u1[4] = b1.x; u1[5] = b1.y; u1[6] = b1.z; u1[7] = b1.w;
            float* o0 = outs + ((size_t)(sb * 2 + 0)) * DM + c0; float* o1 = outs + ((size_t)(sb * 2 + 1)) * DM + c0;
            *(f32x4*)o0 = b0; *(f32x4*)(o0 + 4) = b1;
            *(f32x4*)o1 = (f32x4){u2[0], u2[1], u2[2], u2[3]}; *(f32x4*)(o1 + 4) = (f32x4){u2[4], u2[5], u2[6], u2[7]};
            float bg[8]; unpack8(*(const v4u*)(BCH + (size_t)r * NA_IN + c0), bg);
            float y[8];
#pragma unroll
            for (int i = 0; i < 8; ++i) y[i] = bg[i] * (w0[i] * u0[i] + w1[i] * u1[i] + w2[i] * u2[i]);
            *(v4u*)(Y + (size_t)r * DM + c0) = pack8(y);
        }
    }
}

constexpr float QSCALE = 0.08838834764831845f;
__device__ __forceinline__ void rope_phase(const bf16* PROJ, const Ptrs& P, int gw, int NGW, int lane) {
    unsigned char* ws = P.ws;
    const f32x2* t128 = (const f32x2*)(ws + WS_TAB128); const f32x2* t64 = (const f32x2*)(ws + WS_TAB64);
    bf16* Qr = (bf16*)(ws + WS_QR); bf16* QI = (bf16*)(ws + WS_QI); bf16* KIb = (bf16*)(ws + WS_KIB); float* WI = (float*)(ws + WS_WI);
    bf16* Ks = (bf16*)(ws + WS_KS); bf16* Vs = (bf16*)(ws + WS_VS);
    for (int pr_ = gw; pr_ < NBP * SPAD; pr_ += NGW) {
        const size_t o = ((size_t)((pr_ / SPAD) * SP + (pr_ % SPAD))) * 512 + 8 * lane; *(v4u*)(Ks + o) = (v4u){0u, 0u, 0u, 0u}; *(v4u*)(Vs + o) = (v4u){0u, 0u, 0u, 0u}; }
    for (int r = gw; r < NROWS; r += NGW) {
        const bf16* pr = PROJ + (size_t)r * NB_PAD;
        int pi; float *ko, *vo, *iko; bf16* kib = nullptr; bf16 *ksq = nullptr, *vsq = nullptr;
        if (r < SROW0) { int b, t; row_bt(r, b, t); pi = t; ksq = Ks + ((size_t)(b * SP + t + SPAD)) * 512; vsq = Vs + ((size_t)(b * SP + t + SPAD)) * 512; ko = P.out + O_KP + ((size_t)(b * TP + t)) * 512; vo = P.out + O_VP + ((size_t)(b * TP + t)) * 512; iko = P.out + O_IKP + ((size_t)(b * TP + t)) * 64; kib = KIb + ((size_t)(b * KIROWS + t)) * 64; }
        else { const int sb = r - SROW0; pi = POS_SAMPLE_IDX; ko = P.out + O_KS + (size_t)sb * 512; vo = P.out + O_VS + (size_t)sb * 512; iko = P.out + O_IKS + (size_t)sb * 64; }
        const f32x2* c128 = t128 + (size_t)pi * 64; const f32x2* c64 = t64 + (size_t)pi * 32;
        const int hd = lane >> 2, sub = lane & 3, hk = hd & 3;
        const v4u q1a = *(const v4u*)(pr + hd * 128 + 16 * sub), q1b = *(const v4u*)(pr + hd * 128 + 16 * sub + 8), q2a = *(const v4u*)(pr + hd * 128 + 64 + 16 * sub), q2b = *(const v4u*)(pr + hd * 128 + 64 + 16 * sub + 8);
        const v4u k1a = *(const v4u*)(pr + 2048 + hk * 128 + 16 * sub), k1b = *(const v4u*)(pr + 2048 + hk * 128 + 16 * sub + 8), k2a = *(const v4u*)(pr + 2048 + hk * 128 + 64 + 16 * sub), k2b = *(const v4u*)(pr + 2048 + hk * 128 + 64 + 16 * sub + 8);
        const v4u vv = *(const v4u*)(pr + 2560 + 8 * lane);
        const v4u i1 = *(const v4u*)(pr + 3072 + hd * 64 + 8 * sub), i2 = *(const v4u*)(pr + 3072 + hd * 64 + 32 + 8 * sub);
        const v4u j1 = *(const v4u*)(pr + 4096 + 8 * sub), j2 = *(const v4u*)(pr + 4096 + 32 + 8 * sub);
        const v4u wq = *(const v4u*)(pr + 4160 + 8 * (lane & 1));
        f32x4 csq[8], csi[4];
#pragma unroll
        for (int i = 0; i < 8; ++i) csq[i] = *(const f32x4*)(c128 + 16 * sub + 2 * i);
#pragma unroll
        for (int i = 0; i < 4; ++i) csi[i] = *(const f32x4*)(c64 + 8 * sub + 2 * i);
        {
            float x1[16], x2[16], o1[16], o2[16];
            { float t8[8]; unpack8(q1a, t8);
#pragma unroll
              for (int i = 0; i < 8; ++i) x1[i] = t8[i]; unpack8(q1b, t8);
#pragma unroll
              for (int i = 0; i < 8; ++i) x1[8 + i] = t8[i]; unpack8(q2a, t8);
#pragma unroll
              for (int i = 0; i < 8; ++i) x2[i] = t8[i]; unpack8(q2b, t8);
#pragma unroll
              for (int i = 0; i < 8; ++i) x2[8 + i] = t8[i]; }
#pragma unroll
            for (int i = 0; i < 16; i += 2) { const f32x4 cs = csq[i >> 1];
                o1[i] = (x1[i] * cs.x - x2[i] * cs.y) * QSCALE; o2[i] = (x2[i] * cs.x + x1[i] * cs.y) * QSCALE;
                o1[i + 1] = (x1[i + 1] * cs.z - x2[i + 1] * cs.w) * QSCALE; o2[i + 1] = (x2[i + 1] * cs.z + x1[i + 1] * cs.w) * QSCALE; }
            bf16* qo = Qr + (size_t)r * DM + hd * 128 + 16 * sub;
            { float t8[8];
#pragma unroll
              for (int i = 0; i < 8; ++i) t8[i] = o1[i]; *(v4u*)qo = pack8(t8);
#pragma unroll
              for (int i = 0; i < 8; ++i) t8[i] = o1[8 + i]; *(v4u*)(qo + 8) = pack8(t8);
#pragma unroll
              for (int i = 0; i < 8; ++i) t8[i] = o2[i]; *(v4u*)(qo + 64) = pack8(t8);
#pragma unroll
              for (int i = 0; i < 8; ++i) t8[i] = o2[8 + i]; *(v4u*)(qo + 72) = pack8(t8); }
        }
        if (lane < 16) {
#pragma unroll
            for (int hf = 0; hf < 2; ++hf) { float x1[8], x2[8], o1[8], o2[8]; unpack8(hf ? k1b : k1a, x1); unpack8(hf ? k2b : k2a, x2);
#pragma unroll
                for (int i = 0; i < 8; i += 2) { const f32x4 cs = csq[4 * hf + (i >> 1)];
                    o1[i] = x1[i] * cs.x - x2[i] * cs.y; o2[i] = x2[i] * cs.x + x1[i] * cs.y; o1[i + 1] = x1[i + 1] * cs.z - x2[i + 1] * cs.w; o2[i + 1] = x2[i + 1] * cs.z + x1[i + 1] * cs.w; }
                float* kq = ko + hk * 128 + 16 * sub + 8 * hf;
                *(f32x4*)kq = (f32x4){o1[0], o1[1], o1[2], o1[3]}; *(f32x4*)(kq + 4) = (f32x4){o1[4], o1[5], o1[6], o1[7]};
                *(f32x4*)(kq + 64) = (f32x4){o2[0], o2[1], o2[2], o2[3]}; *(f32x4*)(kq + 68) = (f32x4){o2[4], o2[5], o2[6], o2[7]};
                if (ksq) { *(v4u*)(ksq + hk * 128 + 16 * sub + 8 * hf) = pack8(o1); *(v4u*)(ksq + hk * 128 + 64 + 16 * sub + 8 * hf) = pack8(o2); } }
        }
        {
            float vf[8]; unpack8(vv, vf);
            *(f32x4*)(vo + 8 * lane) = (f32x4){vf[0], vf[1], vf[2], vf[3]}; *(f32x4*)(vo + 8 * lane + 4) = (f32x4){vf[4], vf[5], vf[6], vf[7]};
            if (vsq) *(v4u*)(vsq + 8 * lane) = vv;
        }
        {
            float x1[8], x2[8], o1[8], o2[8]; unpack8(i1, x1); unpack8(i2, x2);
#pragma unroll
            for (int i = 0; i < 8; i += 2) { const f32x4 cs = csi[i >> 1];
                o1[i] = x1[i] * cs.x - x2[i] * cs.y; o2[i] = x2[i] * cs.x + x1[i] * cs.y; o1[i + 1] = x1[i + 1] * cs.z - x2[i + 1] * cs.w; o2[i + 1] = x2[i + 1] * cs.z + x1[i + 1] * cs.w; }
            *(v4u*)(QI + (size_t)r * 1024 + hd * 64 + 8 * sub) = pack8(o1); *(v4u*)(QI + (size_t)r * 1024 + hd * 64 + 32 + 8 * sub) = pack8(o2);
        }
        if (lane < 4) {
            float x1[8], x2[8], o1[8], o2[8]; unpack8(j1, x1); unpack8(j2, x2);
#pragma unroll
            for (int i = 0; i < 8; i += 2) { const f32x4 cs = csi[i >> 1];
                o1[i] = x1[i] * cs.x - x2[i] * cs.y; o2[i] = x2[i] * cs.x + x1[i] * cs.y; o1[i + 1] = x1[i + 1] * cs.z - x2[i + 1] * cs.w; o2[i + 1] = x2[i + 1] * cs.z + x1[i + 1] * cs.w; }
            float* io = iko + 8 * sub;
            *(f32x4*)io = (f32x4){o1[0], o1[1], o1[2], o1[3]}; *(f32x4*)(io + 4) = (f32x4){o1[4], o1[5], o1[6], o1[7]};
            *(f32x4*)(io + 32) = (f32x4){o2[0], o2[1], o2[2], o2[3]}; *(f32x4*)(io + 36) = (f32x4){o2[4], o2[5], o2[6], o2[7]};
            if (kib) { *(v4u*)(kib + 8 * sub) = pack8(o1); *(v4u*)(kib + 32 + 8 * sub) = pack8(o2); }
        } else if (lane < 6) {
            float wv[8]; unpack8(wq, wv); float* wo = WI + (size_t)r * 16 + 8 * (lane - 4);
            *(f32x4*)wo = (f32x4){wv[0], wv[1], wv[2], wv[3]}; *(f32x4*)(wo + 4) = (f32x4){wv[4], wv[5], wv[6], wv[7]};
        }
    }
}

__device__ __forceinline__ void indexer_prompt(const Ptrs& P, LAS unsigned char* lds, int tid, int wave, int lane) {
    unsigned char* ws = P.ws;
    const bf16* QI = (const bf16*)(ws + WS_QI); const bf16* KIb = (const bf16*)(ws + WS_KIB); const float* WI = (const float*)(ws + WS_WI); float* SC = (float*)(ws + WS_SC);
    const int n = lane & 31, h8 = lane >> 5;
    const int qsel = (n >> 2) & 1, head = (n & 3) + 4 * (n >> 3);
    constexpr int NG = TP / 16;
    constexpr int KROW = 144, TBUF = 128 * KROW;
    LAS float* hscr = (LAS float*)(lds + 40960 + wave * 8448);
    int tit = blockIdx.x * 8 + wave;
    for (int it = blockIdx.x; it < 2 * NG; it += gridDim.x) {
        int b, qg;
        if (it < 256) { b = it & 1; qg = 1 + (it >> 1); } else if (it < 512) { b = it & 1; qg = 256 - ((it - 256) >> 1); } else { b = it - 512; qg = 0; }
        const int t0 = 16 * qg + 2 * wave;
        const bf16* qa = QI + (size_t)prow(b, t0 + qsel) * 1024 + head * 64 + 8 * h8;
        bf16x8 a[4];
#pragma unroll
        for (int kk = 0; kk < 4; ++kk) a[kk] = *(const bf16x8*)(qa + 16 * kk);
        const int tq = t0 + h8;
        const float* wp = WI + (size_t)prow(b, tq) * 16;
        float w[16];
#pragma unroll
        for (int i = 0; i < 4; ++i) { const f32x4 x = *(const f32x4*)(wp + 4 * i); w[4 * i] = x.x; w[4 * i + 1] = x.y; w[4 * i + 2] = x.z; w[4 * i + 3] = x.w; }
        const int ntile = ((16 * qg + 15) >> 5) + 1, ntrip = (ntile + 3) >> 2;
        float* scrow = SC + ((size_t)(b * TP + tq)) * SCW;
        const bf16* kbase = KIb + (size_t)b * KIROWS * 64;
        const int p0 = tid, p1 = tid + 512;
        const int l0 = (p0 >> 3) * KROW + (p0 & 7) * 16, l1 = (p1 >> 3) * KROW + (p1 & 7) * 16;
        asm volatile("s_waitcnt lgkmcnt(0)\n\ts_barrier" ::: "memory");
        v4u g0 = *(const v4u*)(kbase + (size_t)p0 * 8), g1 = *(const v4u*)(kbase + (size_t)p1 * 8);
        *(LAS v4u*)(lds + l0) = g0; *(LAS v4u*)(lds + l1) = g1;
        for (int tr = 0; tr < ntrip; ++tr) {
            const int cur = tr & 1;
            float hv[32]; TrJob HJ; hosted_issue(P, tit, lane, hv, HJ);
            if (tr + 1 < ntrip) { const size_t ko = (size_t)(tr + 1) * 128 * 64;
                const int kmax = KIROWS * 64 - 8;
                const size_t o0 = ko + (size_t)p0 * 8, o1 = ko + (size_t)p1 * 8;
                g0 = *(const v4u*)(kbase + (o0 <= (size_t)kmax ? o0 : (size_t)kmax)); g1 = *(const v4u*)(kbase + (o1 <= (size_t)kmax ? o1 : (size_t)kmax)); }
            asm volatile("s_waitcnt lgkmcnt(0)\n\ts_barrier" ::: "memory");
            const LAS unsigned char* kb = lds + cur * TBUF + n * KROW + h8 * 16;
#pragma unroll
            for (int u = 0; u < 4; ++u) {
                f32x16 acc;
#pragma unroll
                for (int i = 0; i < 16; ++i) acc[i] = 0.f;
#pragma unroll
                for (int kk = 0; kk < 4; ++kk) acc = __builtin_amdgcn_mfma_f32_32x32x16_bf16(a[kk], *(const LAS bf16x8*)(kb + u * 32 * KROW + kk * 32), acc, 0, 0, 0);
                float sc = 0.f;
#pragma unroll
                for (int i = 0; i < 16; ++i) sc += w[i] * fmaxf(acc[i], 0.f);
                const int s = 32 * (4 * tr + u) + n;
                if (s <= tq) scrow[s] = sc;
            }
            if (tr + 1 < ntrip) { *(LAS v4u*)(lds + (cur ^ 1) * TBUF + l0) = g0; *(LAS v4u*)(lds + (cur ^ 1) * TBUF + l1) = g1; }
            if (HJ.valid) { tr_finish(hv, HJ, hscr, lane); tit += gridDim.x * 8; }
        }
    }
    asm volatile("s_waitcnt lgkmcnt(0)\n\ts_barrier" ::: "memory");
    for (; tit < NHOSTED; tit += gridDim.x * 8) { float hv[32]; TrJob HJ; hosted_issue(P, tit, lane, hv, HJ); if (HJ.valid) tr_finish(hv, HJ, hscr, lane); }
}

__device__ __forceinline__ void indexer_sample(const Ptrs& P, LAS unsigned char* lds, int tid) {
    unsigned char* ws = P.ws;
    const bf16* QI = (const bf16*)(ws + WS_QI); const float* WI = (const float*)(ws + WS_WI); float* SCS = (float*)(ws + WS_SCS);
    LAS float* lq = (LAS float*)lds;
    LAS float* lw = lq + 1024;
    constexpr int NCH = (NSKEY + 511) / 512;
    for (int item = gridDim.x - 1 - blockIdx.x; item < SBN * NCH; item += gridDim.x) {
        const int sb = item / NCH, ch = item % NCH, r = SROW0 + sb;
        __syncthreads();
        for (int e = tid; e < 1024; e += NTHREADS) lq[e] = bf2f(QI[(size_t)r * 1024 + e]);
        if (tid < 16) lw[tid] = WI[(size_t)r * 16 + tid];
        __syncthreads();
        const int s = ch * 512 + tid;
        if (s < NSKEY) {
            const float* kr = (s < PAST) ? P.cache_ik + ((size_t)P.page_table[sb * NPG + (s >> 7)] * 128 + (s & 127)) * 64 : P.out + O_IKS + (size_t)sb * 64;
            f32x4 kv[16];
#pragma unroll
            for (int i = 0; i < 16; ++i) kv[i] = *(const f32x4*)(kr + 4 * i);
            float sc = 0.f;
            for (int h = 0; h < 16; ++h) { float d = 0.f;
#pragma unroll
                for (int i = 0; i < 16; ++i) { const f32x4 q = *(const LAS f32x4*)(lq + h * 64 + 4 * i); d += q.x * kv[i].x + q.y * kv[i].y + q.z * kv[i].z + q.w * kv[i].w; }
                sc += lw[h] * fmaxf(d, 0.f); }
            SCS[(size_t)sb * SCSW + s] = sc;
        }
    }
    __syncthreads();
}

__device__ __forceinline__ unsigned ordkey(float f) { const unsigned u = __float_as_uint(f); return (u & 0x80000000u) ? ~u : (u | 0x80000000u); }
constexpr int TOPK = 256;
__device__ __forceinline__ void topk_wave_mask(const float* sc, int n, unsigned long long* mrow, int lane) {
    constexpr int NS = MTW, M0 = SPAD / 64;
    static_assert(M0 == dattn::JLO, "first real key tile");
    unsigned key[NS];
#pragma unroll
    for (int m = M0; m < NS; ++m) { const int sidx = lane + 64 * m - SPAD; const int ci = sidx < 0 ? 0 : (sidx < n ? sidx : n - 1); const float v = sc[ci]; key[m] = (sidx >= 0 && sidx < n) ? ordkey(v) : 0u; }
    if (n <= TOPK) {
#pragma unroll
        for (int m = M0; m < NS; ++m) { const unsigned long long w = __ballot(key[m] != 0u); if (lane == 0) mrow[m] = w; }
        return;
    }
    unsigned T = 0u;
    for (int bit = 31; bit >= 0; --bit) {
        const unsigned cand = T | (1u << bit); int c = 0, cv = 0;
#pragma unroll
        for (int m = M0; m < NS; ++m) { if ((m & 1) != 0) c += __popcll(__ballot(key[m] >= cand)); else cv += (key[m] >= cand) ? 1 : 0; }
        c += wave_sum_dpp_i(cv);
        if (c >= TOPK) T = cand;
    }
    int cg = 0;
#pragma unroll
    for (int m = M0; m < NS; ++m) cg += __popcll(__ballot(key[m] > T));
    const int need = TOPK - cg;
    int base_e = 0;
    const unsigned long long lt = (1ull << lane) - 1ull;
#pragma unroll
    for (int m = M0; m < NS; ++m) {
        const bool pg = key[m] > T, pe = key[m] == T;
        const unsigned long long me = __ballot(pe);
        const int pre_e = __popcll(me & lt);
        const unsigned long long w = __ballot(pg || (pe && (base_e + pre_e) < need));
        if (lane == 0) mrow[m] = w;
        base_e += __popcll(me);
    }
}
__device__ __forceinline__ void topk_block(const float* sc, int n, int* outIdx, int* outCnt, LAS unsigned* ls, int tid, int wave, int lane) {
    constexpr int NS = (NSKEY + NTHREADS - 1) / NTHREADS;
    unsigned key[NS];
#pragma unroll
    for (int m = 0; m < NS; ++m) { const int e = tid + NTHREADS * m; const float v = sc[e < n ? e : n - 1]; key[m] = (e < n) ? ordkey(v) : 0u; }
    unsigned T = 0u;
    for (int bit = 31; bit >= 0; --bit) {
        const unsigned cand = T | (1u << bit); int c = 0;
#pragma unroll
        for (int m = 0; m < NS; ++m) c += (key[m] >= cand) ? 1 : 0;
        c = wave_sum_dpp_i(c);
        LAS unsigned* buf = ls + (bit & 1) * 8;
        if (lane == 0) buf[wave] = (unsigned)c;
        __syncthreads();
        int tot = 0;
#pragma unroll
        for (int w = 0; w < 8; ++w) tot += (int)buf[w];
        if (tot >= TOPK) T = cand;
    }
    __syncthreads();
    if (tid == 0) { unsigned z_ = 0u; asm volatile("" : "+v"(z_)); ls[16] = z_; ls[17] = z_; }
    __syncthreads();
#pragma unroll
    for (int m = 0; m < NS; ++m) { const int e = tid + NTHREADS * m; if (key[m] > T) { const unsigned pos = atomicAdd((unsigned*)(ls + 16), 1u); if (pos < (unsigned)TOPK) outIdx[pos] = e; } }
    __syncthreads();
    const unsigned cg = ls[16];
    const unsigned need = (unsigned)TOPK - cg;
#pragma unroll
    for (int m = 0; m < NS; ++m) { const int e = tid + NTHREADS * m; if (key[m] == T) { const unsigned pos = atomicAdd((unsigned*)(ls + 17), 1u); if (pos < need) outIdx[cg + pos] = e; } }
    if (tid == 0) *outCnt = TOPK;
    __syncthreads();
}
__device__ __forceinline__ void select_phase(const Ptrs& P, LAS unsigned char* lds, int gw, int NGW, int tid, int wave, int lane) {
    unsigned char* ws = P.ws;
    const float* SC = (const float*)(ws + WS_SC); const float* SCS = (const float*)(ws + WS_SCS); int* IDXL = (int*)(ws + WS_IDXL); int* CNT = (int*)(ws + WS_CNT);
    for (int sb = blockIdx.x; sb < SBN; sb += gridDim.x) topk_block(SCS + (size_t)sb * SCSW, NSKEY, IDXL + (size_t)(SROW0 + sb) * TOPK, CNT + SROW0 + sb, (LAS unsigned*)lds, tid, wave, lane);
    unsigned long long* MASK = (unsigned long long*)(ws + WS_MASK);
    for (int r = gw; r < SROW0; r += NGW) { int b, t; row_bt(r, b, t);
        if (r < XROW0) topk_wave_mask(SC + ((size_t)(b * TP + t)) * SCW, t + 1, MASK + ((size_t)(b * SP + t + SPAD)) * MTW, lane);
        else { if (lane <= t) IDXL[(size_t)r * TOPK + lane] = lane; if (lane == 0) CNT[r] = t + 1; } }
}

__device__ __forceinline__ void attn_phase(const Ptrs& P, bf16* O, LAS unsigned char* lds, int gw, int NGW, int wave, int lane) {
    unsigned char* ws = P.ws;
    const bf16* Qr = (const bf16*)(ws + WS_QR); const int* IDXL = (const int*)(ws + WS_IDXL); const int* CNT = (const int*)(ws + WS_CNT);
    LAS float* lq = (LAS float*)(lds + wave * 12288);
    LAS f32x4* lp = (LAS f32x4*)(lds + wave * 12288 + 2048);
    LAS unsigned long long* lkp = (LAS unsigned long long*)(lds + wave * 12288 + 6144);
    LAS unsigned long long* lvp = (LAS unsigned long long*)(lds + wave * 12288 + 8192);
    for (int item = gw; item < (NROWS - XROW0) * 4; item += NGW) {
        const int r = XROW0 + (item >> 2), n = item & 3;
        const int cnt = CNT[r];
        WAVE_SYNC();
        { float qf[8]; unpack8(*(const v4u*)(Qr + (size_t)r * DM + n * 512 + 8 * lane), qf);
          *(LAS f32x4*)(lq + 8 * lane) = (f32x4){qf[0], qf[1], qf[2], qf[3]}; *(LAS f32x4*)(lq + 8 * lane + 4) = (f32x4){qf[4], qf[5], qf[6], qf[7]}; }
        const float* kp[4];
#pragma unroll
        for (int j = 0; j < 4; ++j) {
            const int e = lane + 64 * j; const int s = (e < cnt) ? IDXL[(size_t)r * TOPK + e] : 0;
            const float *kq, *vq;
            if (r < SROW0) { const int b = (r < XROW0) ? (r >> 12) : ((r - XROW0) >> 4); kq = P.out + O_KP + ((size_t)(b * TP + s)) * 512; vq = P.out + O_VP + ((size_t)(b * TP + s)) * 512; }
            else { const int sb = r - SROW0;
                if (s < PAST) { const size_t off = ((size_t)P.page_table[sb * NPG + (s >> 7)] * 128 + (s & 127)) * 512; kq = P.cache_k + off; vq = P.cache_v + off; }
                else { kq = P.out + O_KS + (size_t)sb * 512; vq = P.out + O_VS + (size_t)sb * 512; } }
            kp[j] = kq + n * 128; lkp[e] = (unsigned long long)(kq + n * 128); lvp[e] = (unsigned long long)(vq + n * 128);
        }
        WAVE_SYNC();
        float acc[4][4];
#pragma unroll
        for (int g = 0; g < 4; ++g)
#pragma unroll
            for (int j = 0; j < 4; ++j) acc[g][j] = 0.f;
#pragma unroll 4
        for (int d4 = 0; d4 < 32; ++d4) {
            f32x4 qv[4];
#pragma unroll
            for (int g = 0; g < 4; ++g) qv[g] = *(const LAS f32x4*)(lq + g * 128 + 4 * d4);
#pragma unroll
            for (int j = 0; j < 4; ++j) { const f32x4 kv = *(const f32x4*)(kp[j] + 4 * d4);
#pragma unroll
                for (int g = 0; g < 4; ++g) acc[g][j] += qv[g].x * kv.x + qv[g].y * kv.y + qv[g].z * kv.z + qv[g].w * kv.w; }
        }
        float linv[4];
#pragma unroll
        for (int g = 0; g < 4; ++g) {
            float m = -INFINITY;
#pragma unroll
            for (int j = 0; j < 4; ++j) { if (lane + 64 * j >= cnt) acc[g][j] = -INFINITY; m = fmaxf(m, acc[g][j]); }
            m = wave_max(m); float l = 0.f;
#pragma unroll
            for (int j = 0; j < 4; ++j) { acc[g][j] = __expf(acc[g][j] - m); l += acc[g][j]; }
            linv[g] = 1.f / wave_sum(l);
        }
#pragma unroll
        for (int j = 0; j < 4; ++j) lp[lane + 64 * j] = (f32x4){acc[0][j], acc[1][j], acc[2][j], acc[3][j]};
        WAVE_SYNC();
        float o[4][2];
#pragma unroll
        for (int g = 0; g < 4; ++g) { o[g][0] = 0.f; o[g][1] = 0.f; }
#pragma unroll 8
        for (int e = 0; e < cnt; ++e) {
            const float* vp = (const float*)lvp[e]; const f32x2 vv = *(const f32x2*)(vp + 2 * lane); const f32x4 p = lp[e];
            o[0][0] += p.x * vv.x; o[0][1] += p.x * vv.y; o[1][0] += p.y * vv.x; o[1][1] += p.y * vv.y; o[2][0] += p.z * vv.x; o[2][1] += p.z * vv.y; o[3][0] += p.w * vv.x; o[3][1] += p.w * vv.y;
        }
#pragma unroll
        for (int g = 0; g < 4; ++g) *(unsigned*)(O + (size_t)r * DM + (4 * n + g) * 128 + 2 * lane) = pk2(o[g][0] * linv[g], o[g][1] * linv[g]);
    }
}

__device__ __forceinline__ void convC_finish(float (&acc)[8], int it) {
    float ss = 0.f;
#pragma unroll
    for (int i = 0; i < 8; ++i) { acc[i] = silu_f(acc[i]); ss += acc[i] * acc[i]; }
    if (it < 8) { ss = row16_sum(ss); float rn = 1.f / sqrtf(ss + RMS_EPS); if (it < 4) rn *= QSCALE;
#pragma unroll
        for (int i = 0; i < 8; ++i) acc[i] *= rn; }
}
__device__ __forceinline__ void convC_phase(const bf16* PROJC, const Ptrs& P, int gw, int NGW, int lane) {
    unsigned char* ws = P.ws;
    bf16* QKVC = (bf16*)(ws + WS_QKVC); float* QKF = (float*)(ws + WS_QKF); float* G = (float*)(ws + WS_G); float* BETA = (float*)(ws + WS_BETA);
    const float* cw = P.conv_w_c;
    constexpr int RUN = 8, NRUN = SEQ / RUN;
    for (int item = gw; item < 16 * NBP * NRUN; item += NGW) {
        const int it = item & 15, ru = item >> 4, b = ru / NRUN, t0 = NMETA + (ru % NRUN) * RUN, ch0 = it * 512 + 8 * lane;
        float w[4][8];
#pragma unroll
        for (int j = 0; j < 4; ++j) { const f32x4 w0 = *(const f32x4*)(cw + (size_t)j * CDIM + ch0), w1 = *(const f32x4*)(cw + (size_t)j * CDIM + ch0 + 4);
            w[j][0] = w0.x; w[j][1] = w0.y; w[j][2] = w0.z; w[j][3] = w0.w; w[j][4] = w1.x; w[j][5] = w1.y; w[j][6] = w1.z; w[j][7] = w1.w; }
        const int r0 = prow(b, t0);
        v4u xr[RUN + 3];
#pragma unroll
        for (int j = 0; j < 3; ++j) { const int tt = t0 - 3 + j; xr[j] = tt >= 0 ? *(const v4u*)(PROJC + (size_t)prow(b, tt) * NC_PAD + ch0) : (v4u){0u, 0u, 0u, 0u}; }
#pragma unroll
        for (int k = 0; k < RUN; ++k) xr[3 + k] = *(const v4u*)(PROJC + (size_t)(r0 + k) * NC_PAD + ch0);
        float x[RUN + 3][8];
#pragma unroll
        for (int j = 0; j < RUN + 3; ++j) unpack8(xr[j], x[j]);
#pragma unroll
        for (int k = 0; k < RUN; ++k) {
            float acc[8];
#pragma unroll
            for (int i = 0; i < 8; ++i) acc[i] = w[0][i] * x[k][i] + w[1][i] * x[k + 1][i] + w[2][i] * x[k + 2][i] + w[3][i] * x[k + 3][i];
            convC_finish(acc, it);
            *(v4u*)(QKVC + (size_t)(r0 + k) * CDIM + ch0) = pack8(acc);
            const int t = t0 + k;
            if (t >= TP - 3) { float* o = P.out + O_CCP + ((size_t)(b * 3 + (t - (TP - 3)))) * CDIM + ch0;
                *(f32x4*)o = (f32x4){x[k + 3][0], x[k + 3][1], x[k + 3][2], x[k + 3][3]}; *(f32x4*)(o + 4) = (f32x4){x[k + 3][4], x[k + 3][5], x[k + 3][6], x[k + 3][7]}; }
        }
    }
    for (int item = gw; item < 16 * NBP * NMETA; item += NGW) {
        const int it = item & 15, mi = item >> 4, t = mi % NMETA, r = XROW0 + mi, ch0 = it * 512 + 8 * lane;
        float x[4][8];
#pragma unroll
        for (int j = 0; j < 4; ++j) { const int tt = t - 3 + j; if (tt >= 0) unpack8(*(const v4u*)(PROJC + (size_t)(r - 3 + j) * NC_PAD + ch0), x[j]); else {
#pragma unroll
                for (int i = 0; i < 8; ++i) x[j][i] = 0.f; } }
        float acc[8];
#pragma unroll
        for (int i = 0; i < 8; ++i) acc[i] = 0.f;
#pragma unroll
        for (int j = 0; j < 4; ++j) { const f32x4 w0 = *(const f32x4*)(cw + (size_t)j * CDIM + ch0), w1 = *(const f32x4*)(cw + (size_t)j * CDIM + ch0 + 4);
            acc[0] += w0.x * x[j][0]; acc[1] += w0.y * x[j][1]; acc[2] += w0.z * x[j][2]; acc[3] += w0.w * x[j][3];
            acc[4] += w1.x * x[j][4]; acc[5] += w1.y * x[j][5]; acc[6] += w1.z * x[j][6]; acc[7] += w1.w * x[j][7]; }
        convC_finish(acc, it);
        *(v4u*)(QKVC + (size_t)r * CDIM + ch0) = pack8(acc);
    }
    for (int item = gw; item < 16 * SBN; item += NGW) {
        const int it = item & 15, sb = item >> 4, r = SROW0 + sb, ch0 = it * 512 + 8 * lane;
        float x[4][8];
#pragma unroll
        for (int j = 0; j < 3; ++j) { const float* hp = P.state_conv_c + ((size_t)(sb * 3 + j)) * CDIM + ch0; const f32x4 a = *(const f32x4*)hp, c = *(const f32x4*)(hp + 4);
            x[j][0] = a.x; x[j][1] = a.y; x[j][2] = a.z; x[j][3] = a.w; x[j][4] = c.x; x[j][5] = c.y; x[j][6] = c.z; x[j][7] = c.w; }
        unpack8(*(const v4u*)(PROJC + (size_t)r * NC_PAD + ch0), x[3]);
        float acc[8];
#pragma unroll
        for (int i = 0; i < 8; ++i) acc[i] = 0.f;
#pragma unroll
        for (int j = 0; j < 4; ++j) { const f32x4 w0 = *(const f32x4*)(cw + (size_t)j * CDIM + ch0), w1 = *(const f32x4*)(cw + (size_t)j * CDIM + ch0 + 4);
            acc[0] += w0.x * x[j][0]; acc[1] += w0.y * x[j][1]; acc[2] += w0.z * x[j][2]; acc[3] += w0.w * x[j][3];
            acc[4] += w1.x * x[j][4]; acc[5] += w1.y * x[j][5]; acc[6] += w1.z * x[j][6]; acc[7] += w1.w * x[j][7]; }
        convC_finish(acc, it);
        if (it < 8) { float* qk = QKF + (size_t)r * 4096 + ch0; *(f32x4*)qk = (f32x4){acc[0], acc[1], acc[2], acc[3]}; *(f32x4*)(qk + 4) = (f32x4){acc[4], acc[5], acc[6], acc[7]}; }
        *(v4u*)(QKVC + (size_t)r * CDIM + ch0) = pack8(acc);
        float* o = P.out + O_CCS + ((size_t)(sb * 3)) * CDIM + ch0;
#pragma unroll
        for (int j = 0; j < 3; ++j) { *(f32x4*)(o + (size_t)j * CDIM) = (f32x4){x[j + 1][0], x[j + 1][1], x[j + 1][2], x[j + 1][3]}; *(f32x4*)(o + (size_t)j * CDIM + 4) = (f32x4){x[j + 1][4], x[j + 1][5], x[j + 1][6], x[j + 1][7]}; }
    }
    for (int e = gw * 64 + lane; e < NROWS * 32; e += NGW * 64) {
        const int r = e >> 5, h = e & 31;
        const float braw = bf2f(PROJC[(size_t)r * NC_PAD + 12288 + h]), araw = bf2f(PROJC[(size_t)r * NC_PAD + 12320 + h]);
        const float xx = araw + P.dt_bias[h]; const float sp = xx > 20.f ? xx : __logf(1.f + __expf(xx));
        G[e] = -__expf(P.a_log[h]) * sp; BETA[e] = 1.f / (1.f + __expf(-braw));
    }
}

struct Tok { f32x4 k0, k1, q0, q1; unsigned v; float g, b; };
__device__ __forceinline__ void tok_load(Tok& T, const float* QKF, const bf16* QKVC, const float* G, const float* BETA, int row, int h, int rg, int col0) {
    const float* base = QKF + (size_t)row * 4096 + (h >> 1) * 128 + 8 * rg;
    T.q0 = *(const f32x4*)base; T.q1 = *(const f32x4*)(base + 4); T.k0 = *(const f32x4*)(base + 2048); T.k1 = *(const f32x4*)(base + 2052);
    T.v = *(const unsigned*)(QKVC + (size_t)row * CDIM + 4096 + h * 128 + col0);
    T.g = G[(size_t)row * 32 + h]; T.b = BETA[(size_t)row * 32 + h];
}
__device__ __forceinline__ f32x2 tok_step(f32x2 (&S)[8], const Tok& T) {
    const float kk[8] = {T.k0.x, T.k0.y, T.k0.z, T.k0.w, T.k1.x, T.k1.y, T.k1.z, T.k1.w};
    const float qq[8] = {T.q0.x, T.q0.y, T.q0.z, T.q0.w, T.q1.x, T.q1.y, T.q1.z, T.q1.w};
    const float a = __expf(T.g);
    f32x2 d0 = S[0] * kk[0], d1 = S[1] * kk[1];
#pragma unroll
    for (int i = 2; i < 8; i += 2) { d0 += S[i] * kk[i]; d1 += S[i + 1] * kk[i + 1]; }
    f32x2 d = d0 + d1;
    d.x = row16_sum(d.x); d.y = row16_sum(d.y);
    const f32x2 tv = {bflo(T.v), bfhi(T.v)};
    const f32x2 dl = (tv - d * a) * T.b;
    f32x2 o0 = {0.f, 0.f}, o1 = {0.f, 0.f};
#pragma unroll
    for (int i = 0; i < 8; i += 2) { S[i] = S[i] * a + dl * kk[i]; o0 += S[i] * qq[i]; S[i + 1] = S[i + 1] * a + dl * kk[i + 1]; o1 += S[i + 1] * qq[i + 1]; }
    f32x2 o = o0 + o1;
    o.x = row16_sum(o.x); o.y = row16_sum(o.y);
    return o;
}
__device__ __forceinline__ void delta_phase(const Ptrs& P, int idx, int stride, int lane) {
    unsigned char* ws = P.ws;
    const bf16* QKVC = (const bf16*)(ws + WS_QKVC); const float* QKF = (const float*)(ws + WS_QKF); const float* G = (const float*)(ws + WS_G); const float* BETA = (const float*)(ws + WS_BETA); bf16* OF = (bf16*)(ws + WS_SC);
    const int cg = lane >> 4, rg = lane & 15;
    {
        for (int item = idx; item < SBN * 32 * 16; item += stride) {
            const int sb = item >> 9, h = (item >> 4) & 31, col0 = 8 * (item & 15) + 2 * cg;
            const size_t so = ((size_t)((sb * 32 + h) * 128 + 8 * rg)) * 128 + col0;
            f32x2 S[8];
#pragma unroll
            for (int i = 0; i < 8; ++i) S[i] = *(const f32x2*)(P.state_delta + so + (size_t)i * 128);
            Tok T; tok_load(T, QKF, QKVC, G, BETA, SROW0 + sb, h, rg, col0);
            const f32x2 o = tok_step(S, T);
            if (rg == 0) *(unsigned*)(OF + (size_t)(SROW0 + sb) * DVW + h * 128 + col0) = pk2(o.x, o.y);
            float* op = P.out + O_DS + so;
#pragma unroll
            for (int i = 0; i < 8; ++i) *(f32x2*)(op + (size_t)i * 128) = S[i];
        }
    }
}
__device__ __forceinline__ void normC_piece(const v4u oq, const v4u zz, const float (&nw)[8], bf16* yo) {
    float o[8]; unpack8(oq, o);
    float ss = 0.f;
#pragma unroll
    for (int i = 0; i < 8; ++i) ss += o[i] * o[i];
    ss = row16_sum(ss);
    const float rs = 1.f / sqrtf(ss * (1.f / 128.f) + RMS_EPS);
    float z[8]; unpack8(zz, z);
#pragma unroll
    for (int i = 0; i < 8; ++i) o[i] = o[i] * rs * nw[i] * silu_f(z[i]);
    *(v4u*)yo = pack8(o);
}
__device__ __forceinline__ void normC_phase(const bf16* PROJC, bf16* Y, const Ptrs& P, int gw, int NGW, int lane) {
    const bf16* OF = (const bf16*)(P.ws + WS_SC);
    const int d0 = 8 * (lane & 15), hl = lane >> 4;
    float nw[8];
    { const f32x4 a = *(const f32x4*)(P.norm_w + d0), b = *(const f32x4*)(P.norm_w + d0 + 4); nw[0] = a.x; nw[1] = a.y; nw[2] = a.z; nw[3] = a.w; nw[4] = b.x; nw[5] = b.y; nw[6] = b.z; nw[7] = b.w; }
    for (int it = gw; it < (NROWS - XROW0) * 8; it += NGW) { const int r = XROW0 + (it >> 3), hd = (it & 7) * 4 + hl;
        const v4u oq = *(const v4u*)(OF + (size_t)r * DVW + hd * 128 + d0), zz = *(const v4u*)(PROJC + (size_t)r * NC_PAD + 8192 + hd * 128 + d0);
        normC_piece(oq, zz, nw, Y + (size_t)r * DVW + hd * 128 + d0); }
    for (int r = gw; r < XROW0; r += 2 * NGW) {
        const int r2 = (r + NGW < XROW0) ? r + NGW : r; const bool two = r + NGW < XROW0;
        v4u oa[8], za[8], ob[8], zb[8];
#pragma unroll
        for (int it = 0; it < 8; ++it) { const int hd = it * 4 + hl;
            oa[it] = *(const v4u*)(OF + (size_t)r * DVW + hd * 128 + d0); za[it] = *(const v4u*)(PROJC + (size_t)r * NC_PAD + 8192 + hd * 128 + d0);
            ob[it] = *(const v4u*)(OF + (size_t)r2 * DVW + hd * 128 + d0); zb[it] = *(const v4u*)(PROJC + (size_t)r2 * NC_PAD + 8192 + hd * 128 + d0); }
#pragma unroll
        for (int it = 0; it < 8; ++it) { const int hd = it * 4 + hl;
            normC_piece(oa[it], za[it], nw, Y + (size_t)r * DVW + hd * 128 + d0);
            if (two) normC_piece(ob[it], zb[it], nw, Y + (size_t)r2 * DVW + hd * 128 + d0); }
    }
}


__device__ __forceinline__ void dense_attn_phase(const Ptrs& P, bf16* O, char* lds, int wv) {
    unsigned char* ws = P.ws;
    const bf16* Qr = (const bf16*)(ws + WS_QR); const bf16* Ks = (const bf16*)(ws + WS_KS); const bf16* Vs = (const bf16*)(ws + WS_VS);
    const unsigned long long* MASK = (const unsigned long long*)(ws + WS_MASK);
    typedef dattn::BlockRef<bf16, bf16> BR;
    for (int it0 = blockIdx.x; it0 < 256; it0 += gridDim.x) {
        const int grp = it0 & 7, idx = it0 >> 3;
        const int b = grp >> 2, kvh = grp & 3, h = kvh * 4 + (idx >> 3), x = idx & 7;
        BR A, B;
        const int qa = 1 + x, qb = 16 - x;
        A.Q = Qr + ((size_t)(b * SEQ + 256 * (qa - 1))) * DM + h * 128; A.O = O + ((size_t)(b * SEQ + 256 * (qa - 1))) * DM + h * 128;
        B.Q = Qr + ((size_t)(b * SEQ + 256 * (qb - 1))) * DM + h * 128; B.O = O + ((size_t)(b * SEQ + 256 * (qb - 1))) * DM + h * 128;
        A.K = B.K = Ks + (size_t)b * SP * 512 + kvh * 128; A.V = B.V = Vs + (size_t)b * SP * 512 + kvh * 128;
        A.P0 = 256 * qa; B.P0 = 256 * qb;
        A.M = MASK + ((size_t)(b * SP + A.P0)) * MTW; B.M = MASK + ((size_t)(b * SP + B.P0)) * MTW;
        dattn::Seam<bf16> S;
        dattn::causal_swa_prime<bf16, bf16>(A, SP, lds, S, wv);
        dattn::causal_swa_block<bf16, bf16>(A, B, SP, SP, lds, S, wv);
        dattn::causal_swa_block<bf16, bf16>(B, B, SP, SP, lds, S, wv);
    }
}

constexpr int NCH = 65, CPAD = 48;
constexpr int NUQ = NBP * 16 * NCH, NUH = NBP * 32 * NCH;
__device__ __forceinline__ int crow32(int r, int hi) { return (r & 3) + 8 * (r >> 2) + 4 * hi; }
__device__ __forceinline__ int chunk_row(int b, int c, int i) { const int t = 64 * c + i - CPAD; return t >= 0 ? prow(b, t) : -1; }
__device__ __forceinline__ float incl_scan64(float v, int lane) {
#pragma unroll
    for (int o = 1; o < 64; o <<= 1) { const float u = __shfl_up(v, o); if (lane >= o) v += u; }
    return v;
}
#define MFMA32(a, b, c) __builtin_amdgcn_mfma_f32_32x32x16_bf16((a), (b), (c), 0, 0, 0)
__device__ __forceinline__ bf16x8 sel8(bool ok, bf16x8 v) { const bf16x8 z = {0, 0, 0, 0, 0, 0, 0, 0}; return ok ? v : z; }
__device__ __forceinline__ int sw23(int x) { return (x & ~12) | ((x & 4) << 1) | ((x & 8) >> 1); }
__device__ __forceinline__ int fidx64(int row, int xs) { return ((((row >> 5) * 2 + (xs >> 5)) * 2 + ((xs >> 4) & 1)) * 64 + (row & 31) + 32 * ((xs >> 3) & 1)) * 8 + (xs & 7); }

__device__ __forceinline__ v4u pack_frag(const f32x16& x, int s) { v4u w; w.x = pk2(x[8 * s], x[8 * s + 1]); w.y = pk2(x[8 * s + 2], x[8 * s + 3]); w.z = pk2(x[8 * s + 4], x[8 * s + 5]); w.w = pk2(x[8 * s + 6], x[8 * s + 7]); return w; }
__device__ __forceinline__ void stage_out8k(LAS unsigned char* stg, bf16* gdst, int lane) {
    WAVE_SYNC();
#pragma unroll
    for (int k = 0; k < 8; ++k) *(v4u*)(gdst + k * 512 + lane * 8) = *(const LAS v4u*)(stg + k * 1024 + lane * 16);
    WAVE_SYNC();
}
__device__ __forceinline__ void delta_d1_unit(unsigned char* ws, LAS unsigned char* lds, int uq, int wave, int lane) {
    asm volatile("" : "+v"(lane));
    const bf16* QKVC = (const bf16*)(ws + WS_QKVC); const float* G = (const float*)(ws + WS_G); const float* BETA = (const float*)(ws + WS_BETA);
    float* AF = (float*)(ws + WS_DAF); bf16* PG = (bf16*)(ws + WS_DPG); bf16* KT = (bf16*)(ws + WS_DKT); bf16* VT = (bf16*)(ws + WS_DVT);
    float* GC = (float*)(ws + WS_DGC); float* BT = (float*)(ws + WS_DBT);
    LAS float* lg = (LAS float*)(lds + wave * 16384);
    LAS unsigned char* stg = lds + wave * 16384 + 2048; LAS bf16* st = (LAS bf16*)stg;
    const int m = lane & 31, half = lane >> 5;
    const bf16x8 zf = {0, 0, 0, 0, 0, 0, 0, 0};
    {
        const int c = uq % NCH, bh = uq / NCH, hq = bh & 15, b = bh >> 4;
        { const int row = chunk_row(b, c, lane);
#pragma unroll
          for (int hh = 0; hh < 2; ++hh) { const int h = 2 * hq + hh; const float g = row >= 0 ? G[(size_t)row * 32 + h] : 0.f, bt = row >= 0 ? BETA[(size_t)row * 32 + h] : 0.f;
              const float gc = incl_scan64(g, lane); lg[hh * 64 + lane] = gc; lg[128 + hh * 64 + lane] = bt;
              const size_t uh = ((size_t)(b * 32 + h)) * NCH + c; GC[uh * 64 + lane] = gc; BT[uh * 64 + lane] = bt; } }
        const int row0 = chunk_row(b, c, m), row1 = chunk_row(b, c, 32 + m);
        const bf16* r0 = QKVC + (size_t)(row0 < 0 ? 0 : row0) * CDIM; const bf16* r1 = QKVC + (size_t)(row1 < 0 ? 0 : row1) * CDIM;
        f32x16 kk00, kk10, kk11, qk00, qk10, qk11;
#pragma unroll
        for (int i = 0; i < 16; ++i) { kk00[i] = 0.f; kk10[i] = 0.f; kk11[i] = 0.f; qk00[i] = 0.f; qk10[i] = 0.f; qk11[i] = 0.f; }
        const int sm = sw23(m);
        const int ktl = half * 32 + ((sm >> 4) & 1) * 512 + ((sm >> 3) & 1) * 256 + (sm & 7);
#pragma unroll 1
        for (int kh = 0; kh < 2; ++kh) {
            bf16x8 kf0[4], kf1[4], qf0[4], qf1[4];
#pragma unroll
            for (int u = 0; u < 4; ++u) { const int off = hq * 128 + 16 * (4 * kh + u) + 8 * half;
                kf0[u] = sel8(row0 >= 0, *(const bf16x8*)(r0 + 2048 + off)); kf1[u] = sel8(row1 >= 0, *(const bf16x8*)(r1 + 2048 + off));
                qf0[u] = sel8(row0 >= 0, *(const bf16x8*)(r0 + off)); qf1[u] = sel8(row1 >= 0, *(const bf16x8*)(r1 + off)); }
#pragma unroll
            for (int u = 0; u < 4; ++u) { const int ks = 4 * kh + u; const bf16x8 k0 = kf0[u], k1 = kf1[u], q0 = qf0[u], q1 = qf1[u];
                kk00 = MFMA32(k0, k0, kk00); kk10 = MFMA32(k1, k0, kk10); kk11 = MFMA32(k1, k1, kk11);
                qk00 = MFMA32(q0, k0, qk00); qk10 = MFMA32(q1, k0, qk10); qk11 = MFMA32(q1, k1, qk11);
                LAS bf16* kb = st + ktl + ((ks >> 1) & 1) * 2048 + (ks & 1) * 128;
#pragma unroll
                for (int e = 0; e < 8; ++e) { kb[(8 * (e >> 2) + (e & 3)) * 8] = (bf16)k0[e]; kb[1024 + (8 * (e >> 2) + (e & 3)) * 8] = (bf16)k1[e]; } }
            stage_out8k(stg, KT + (size_t)uq * 8192 + kh * 4096, lane);
        }
#pragma unroll 1
        for (int hh = 0; hh < 2; ++hh) { const int h = 2 * hq + hh; bf16* vt = VT + (((size_t)(b * 32 + h)) * NCH + c) * 8192;
            const int vtl = half * 64 + ((sm >> 4) & 1) * 512 + ((sm >> 3) & 1) * 256 + (sm & 7);
            bf16x8 vf0[8], vf1[8];
#pragma unroll
            for (int ks = 0; ks < 8; ++ks) { const int off = 4096 + h * 128 + 16 * ks + 8 * half; vf0[ks] = sel8(row0 >= 0, *(const bf16x8*)(r0 + off)); vf1[ks] = sel8(row1 >= 0, *(const bf16x8*)(r1 + off)); }
#pragma unroll
            for (int kh = 0; kh < 2; ++kh) {
#pragma unroll
                for (int u = 0; u < 4; ++u) { const int ks = 4 * kh + u; LAS bf16* vb = st + vtl + ((ks >> 1) & 1) * 2048 + (ks & 1) * 128;
#pragma unroll
                    for (int e = 0; e < 8; ++e) { vb[e * 8] = (bf16)vf0[ks][e]; vb[1024 + e * 8] = (bf16)vf1[ks][e]; } }
                stage_out8k(stg, vt + kh * 4096, lane);
            } }
        WAVE_SYNC();
#pragma unroll 1
        for (int hh = 0; hh < 2; ++hh) { const int h = 2 * hq + hh; const size_t uh = ((size_t)(b * 32 + h)) * NCH + c;
            float* af = AF + uh * 4096 + half * 256 + m;
            LAS bf16* pg = st + ktl;
            const float gcj0 = lg[hh * 64 + m], gcj1 = lg[hh * 64 + 32 + m];
#pragma unroll
            for (int r = 0; r < 16; ++r) { const int ir = crow32(r, half), rc = (r & 3) + 8 * (r >> 2);
                const float gi0 = lg[hh * 64 + ir], gi1 = lg[hh * 64 + 32 + ir], bi0 = lg[128 + hh * 64 + ir], bi1 = lg[128 + hh * 64 + 32 + ir];
                { const int i = ir, j = m; const float dec = __expf(fminf(gi0 - gcj0, 0.f)); af[rc * 64] = (j < i) ? bi0 * dec * kk00[r] : 0.f; pg[rc * 8] = f2bf((j <= i) ? dec * qk00[r] : 0.f); }
                { const int i = 32 + ir, j = m; const float dec = __expf(fminf(gi1 - gcj0, 0.f)); af[2048 + rc * 64] = bi1 * dec * kk10[r]; pg[2048 + rc * 8] = f2bf(dec * qk10[r]); }
                { const int i = 32 + ir, j = 32 + m; const float dec = __expf(fminf(gi1 - gcj1, 0.f)); af[2048 + 32 + rc * 64] = (j < i) ? bi1 * dec * kk11[r] : 0.f; pg[2048 + 1024 + rc * 8] = f2bf((j <= i) ? dec * qk11[r] : 0.f); }
            }
            stage_out8k(stg, PG + uh * 4096, lane); }
        WAVE_SYNC();
    }
}
__device__ __forceinline__ void delta_d2_unit(unsigned char* ws, LAS unsigned char* lds, int uh, int wave, int lane) {
    asm volatile("" : "+v"(lane));
    const float* AF = (const float*)(ws + WS_DAF); const float* GC = (const float*)(ws + WS_DGC); const float* BT = (const float*)(ws + WS_DBT);
    bf16* TG = (bf16*)(ws + WS_DTG); bf16* TB = (bf16*)(ws + WS_DTB);
    {
        const float* af = AF + (size_t)uh * 4096;
        const float bc = BT[(size_t)uh * 64 + lane], gmc = __expf(GC[(size_t)uh * 64 + lane]);
        float T[64];
        const bool pad0 = (uh % NCH) == 0;
#pragma unroll
        for (int i0 = 0; i0 < 64; i0 += 16) {
            float ar[16];
#pragma unroll
            for (int u = 0; u < 16; ++u) ar[u] = af[(i0 + u) * 64 + lane];
            if (pad0 && i0 < 32) {
#pragma unroll
                for (int u = 0; u < 16; ++u) T[i0 + u] = (lane == i0 + u) ? 1.f : 0.f;
            } else {
#pragma unroll
                for (int u = 0; u < 16; ++u) { const int i = i0 + u; float pa[4] = {(lane == i) ? 1.f : 0.f, 0.f, 0.f, 0.f};
#pragma unroll
                    for (int j = 0; j < i; ++j) pa[j & 3] -= __int_as_float(__builtin_amdgcn_readlane(__float_as_int(ar[u]), j)) * T[j];
                    T[i] = (pa[0] + pa[1]) + (pa[2] + pa[3]); }
            }
        }
        bf16* tg = TG + (size_t)uh * 4096; bf16* tb = TB + (size_t)uh * 4096;
        const float sg = bc * gmc;
        const int cs = (lane & ~31) + sw23(lane & 31);
        const int lcol = (cs >> 4) * 512 + ((cs >> 3) & 1) * 256 + (cs & 7);
        LAS unsigned char* stg = lds + wave * 16384 + 2048; LAS bf16* st = (LAS bf16*)stg;
#pragma unroll
        for (int i = 0; i < 64; ++i) st[(i >> 5) * 2048 + (i & 31) * 8 + lcol] = f2bf(T[i] * sg);
        stage_out8k(stg, tg, lane);
#pragma unroll
        for (int i = 0; i < 64; ++i) st[(i >> 5) * 2048 + (i & 31) * 8 + lcol] = f2bf(T[i] * bc);
        stage_out8k(stg, tb, lane);
    }
}
__device__ __forceinline__ void delta_d3_unit(unsigned char* ws, int uh, int lane) {
    asm volatile("" : "+v"(lane));
    const bf16* TG = (const bf16*)(ws + WS_DTG); const bf16* TB = (const bf16*)(ws + WS_DTB); const bf16* KT = (const bf16*)(ws + WS_DKT); const bf16* VT = (const bf16*)(ws + WS_DVT);
    bf16* WG = (bf16*)(ws + WS_DWG); bf16* UG = (bf16*)(ws + WS_DUG);
    const int m = lane & 31, half = lane >> 5;
    const int c = uh % NCH, bh = uh / NCH, h = bh & 31, b = bh >> 5;
    const size_t uq = ((size_t)(b * 16 + (h >> 1))) * NCH + c;
    {
        const bf16* Tm = TG + (size_t)uh * 4096; const bf16* Kf = KT + uq * 8192;
        f32x16 acc[4][2];
#pragma unroll
        for (int dn = 0; dn < 4; ++dn)
#pragma unroll
            for (int ti = 0; ti < 2; ++ti)
#pragma unroll
                for (int i = 0; i < 16; ++i) acc[dn][ti][i] = 0.f;
#pragma unroll
        for (int ks = 0; ks < 4; ++ks) {
            bf16x8 a[4], bb[2];
#pragma unroll
            for (int dn = 0; dn < 4; ++dn) a[dn] = *(const bf16x8*)(Kf + ((size_t)(((dn * 2 + (ks >> 1)) * 2 + (ks & 1)) * 64 + lane)) * 8);
#pragma unroll
            for (int ti = 0; ti < 2; ++ti) bb[ti] = *(const bf16x8*)(Tm + ((size_t)((ti * 4 + ks) * 64 + lane)) * 8);
#pragma unroll
            for (int dn = 0; dn < 4; ++dn)
#pragma unroll
                for (int ti = 0; ti < 2; ++ti) acc[dn][ti] = MFMA32(a[dn], bb[ti], acc[dn][ti]);
        }
        bf16* wg = WG + (size_t)uh * 8192;
#pragma unroll
        for (int dn = 0; dn < 4; ++dn)
#pragma unroll
            for (int ti = 0; ti < 2; ++ti)
#pragma unroll
                for (int s2 = 0; s2 < 2; ++s2) *(v4u*)(wg + ((size_t)(((ti * 4 + dn) * 2 + s2) * 64 + lane)) * 8) = pack_frag(acc[dn][ti], s2);
    }
    {
        const bf16* Tm = TB + (size_t)uh * 4096; const bf16* Bt = VT + (size_t)uh * 8192;
        f32x16 acc[2][4];
#pragma unroll
        for (int ti = 0; ti < 2; ++ti)
#pragma unroll
            for (int dn = 0; dn < 4; ++dn)
#pragma unroll
                for (int i = 0; i < 16; ++i) acc[ti][dn][i] = 0.f;
#pragma unroll
        for (int ks = 0; ks < 4; ++ks) {
            bf16x8 a[2], bb[4];
#pragma unroll
            for (int ti = 0; ti < 2; ++ti) a[ti] = *(const bf16x8*)(Tm + ((size_t)((ti * 4 + ks) * 64 + lane)) * 8);
#pragma unroll
            for (int dn = 0; dn < 4; ++dn) bb[dn] = *(const bf16x8*)(Bt + ((size_t)((dn * 4 + ks) * 64 + lane)) * 8);
#pragma unroll
            for (int ti = 0; ti < 2; ++ti)
#pragma unroll
                for (int dn = 0; dn < 4; ++dn) acc[ti][dn] = MFMA32(a[ti], bb[dn], acc[ti][dn]);
        }
        bf16* ug = UG + (size_t)uh * 8192;
#pragma unroll
        for (int ti = 0; ti < 2; ++ti)
#pragma unroll
            for (int dn = 0; dn < 4; ++dn) { bf16* p = ug + ((size_t)((ti * 4 + dn) * 64 + lane)) * 16; *(v4u*)p = pack_frag(acc[ti][dn], 0); *(v4u*)(p + 8) = pack_frag(acc[ti][dn], 1); }
    }
}
__device__ __forceinline__ void delta_pre(unsigned char* ws, LAS unsigned char* lds, int gw, int NGW, int wave, int lane) {
    const int nextra = (NUQ > NGW && NUQ < 2 * NGW) ? NUQ - NGW : 0;
    for (int rep = 0; rep < 2 || nextra == 0; ++rep) {
        int uq;
        if (nextra == 0) { uq = gw + rep * NGW; if (uq >= NUQ) break; }
        else if (rep == 0) uq = gw;
        else { if ((gw & 63) != 0 || (gw >> 6) >= nextra) break; uq = NGW + (gw >> 6); }
#ifndef NO_D1
        delta_d1_unit(ws, lds, uq, wave, lane);
#endif
#ifdef DUP_D1
        delta_d1_unit(ws, lds, uq, wave, lane);
#endif
        asm volatile("s_waitcnt vmcnt(0)" ::: "memory");
        const int c = uq % NCH, bh = uq / NCH, hq = bh & 15, b = bh >> 4;
#pragma unroll 1
        for (int hh = 0; hh < 2; ++hh) { const int uh = (b * 32 + 2 * hq + hh) * NCH + c;
#ifndef NO_D2
            delta_d2_unit(ws, lds, uh, wave, lane);
#endif
#ifdef DUP_D2
            delta_d2_unit(ws, lds, uh, wave, lane);
#endif
            asm volatile("s_waitcnt vmcnt(0)" ::: "memory");
#ifndef NO_D3
            delta_d3_unit(ws, uh, lane);
#endif
#ifdef DUP_D3
            delta_d3_unit(ws, uh, lane);
#endif
        }
    }
}
__device__ __forceinline__ bf16x8 afrag_perm(const bf16* rowp, int blk, int s, int half) {
    const v2u lo = *(const v2u*)(rowp + 32 * blk + 16 * s + 4 * half), hi2 = *(const v2u*)(rowp + 32 * blk + 16 * s + 8 + 4 * half);
    v4u w; w.x = lo.x; w.y = lo.y; w.z = hi2.x; w.w = hi2.y; return __builtin_bit_cast(bf16x8, w);
}
#define LBAR() asm volatile("s_waitcnt lgkmcnt(0)\n\ts_barrier" ::: "memory")
__device__ __forceinline__ void delta_d4(unsigned char* ws, float* out_state, LAS unsigned char* lds, int tid, int wave, int lane) {
    const bf16* QKVC = (const bf16*)(ws + WS_QKVC); const bf16* KT = (const bf16*)(ws + WS_DKT); const bf16* PG = (const bf16*)(ws + WS_DPG);
    const bf16* WG = (const bf16*)(ws + WS_DWG); const bf16* UG = (const bf16*)(ws + WS_DUG); const float* GC = (const float*)(ws + WS_DGC);
    bf16* OF = (bf16*)(ws + WS_SC);
    LAS v4u* Sfr = (LAS v4u*)lds;
    LAS v4u* Dfr = (LAS v4u*)(lds + 16384);
    LAS v4u* Dtf = (LAS v4u*)(lds + 16384 + 4096);
    LAS float* gam = (LAS float*)(lds + 16384 + 8192);
    const int m = lane & 31, half = lane >> 5;
    const bf16x8 zf = {0, 0, 0, 0, 0, 0, 0, 0};
    for (int item = blockIdx.x; item < NBP * 32 * 4; item += gridDim.x) {
        const int xg = item & 7, jj = item >> 3, pair = xg * 4 + (jj >> 3), q = jj & 3, h = 2 * (pair & 15) + ((jj >> 2) & 1), b = pair >> 4;
        const size_t uh0 = ((size_t)(b * 32 + h)) * NCH, uq0 = ((size_t)(b * 16 + (h >> 1))) * NCH;
        const int rt = wave & 1; const bool isq = wave >= 6;
#define ROT3(LOADM, STEPM) do { LOADM(0, 0); LOADM(1, 1); \
            for (int c = 0; c < NCH; c += 3) { \
                if (c + 2 < NCH) LOADM(c + 2, 2); \
                STEPM(c, 0); \
                if (c + 1 < NCH) { if (c + 3 < NCH) LOADM(c + 3, 0); STEPM(c + 1, 1); } \
                if (c + 2 < NCH) { if (c + 4 < NCH) LOADM(c + 4, 1); STEPM(c + 2, 2); } } } while (0)
#define ROT2(LOADM, STEPM) do { LOADM(0, 0); \
            for (int c = 0; c < NCH; c += 2) { \
                if (c + 1 < NCH) LOADM(c + 1, 1); \
                STEPM(c, 0); \
                if (c + 1 < NCH) { if (c + 2 < NCH) LOADM(c + 2, 0); STEPM(c + 1, 1); } } } while (0)
        LBAR();
        if (wave < 4) {
            int ll_ = lane; asm volatile("" : "+v"(ll_)); const int lane = ll_, m = lane & 31, half = lane >> 5; (void)m; (void)half;
            { const v4u z = {0u, 0u, 0u, 0u}; Sfr[(0 * 4 + wave) * 128 + lane] = z; Sfr[(0 * 4 + wave) * 128 + 64 + lane] = z; }
            bf16x8 kf[2][4];
            f32x16 S;
#pragma unroll
            for (int i = 0; i < 16; ++i) S[i] = 0.f;
#define LOAD_K(cc, B) do { const bf16* kr_ = KT + (uq0 + (cc)) * 8192; \
                _Pragma("unroll") for (int blk = 0; blk < 2; ++blk) _Pragma("unroll") for (int s_ = 0; s_ < 2; ++s_) kf[B][blk * 2 + s_] = *(const bf16x8*)(kr_ + ((size_t)(((wave * 2 + blk) * 2 + s_) * 64 + lane)) * 8); } while (0)
#define STEP_K(c, B) do { const int bufc = (c) & 1; LBAR(); LBAR(); \
                const float gl = gam[bufc * 64 + 63]; \
                _Pragma("unroll") for (int i = 0; i < 16; ++i) S[i] *= gl; \
                _Pragma("unroll") for (int blk = 0; blk < 2; ++blk) _Pragma("unroll") for (int s = 0; s < 2; ++s) S = MFMA32(kf[B][blk * 2 + s], __builtin_bit_cast(bf16x8, Dtf[(blk * 2 + s) * 64 + lane]), S); \
                _Pragma("unroll") for (int s = 0; s < 2; ++s) Sfr[((bufc ^ 1) * 4 + wave) * 128 + s * 64 + lane] = pack_frag(S, s); } while (0)
#ifndef NO_RK
            ROT2(LOAD_K, STEP_K);
#endif
            { float* o = out_state + ((size_t)((b * 32 + h) * 128 + 32 * wave)) * 128 + 32 * q + m;
#pragma unroll
              for (int r = 0; r < 16; ++r) o[(size_t)sw23(crow32(r, half)) * 128] = S[r]; }
#undef LOAD_K
#undef STEP_K
        } else if (!isq) {
            int ll_ = lane; asm volatile("" : "+v"(ll_)); const int lane = ll_, m = lane & 31, half = lane >> 5; (void)m; (void)half;
            bf16x8 wf[3][8], uf[3][2]; float gcv[3] = {0.f, 0.f, 0.f};
#define LOAD_W(cc, B) do { const bf16* wb_ = WG + (uh0 + (cc)) * 8192 + ((size_t)(rt * 512 + lane)) * 8; \
                _Pragma("unroll") for (int blk = 0; blk < 4; ++blk) _Pragma("unroll") for (int s_ = 0; s_ < 2; ++s_) wf[B][blk * 2 + s_] = *(const bf16x8*)(wb_ + blk * 1024 + s_ * 512); \
                const bf16* ub_ = UG + (uh0 + (cc)) * 8192 + ((size_t)((rt * 4 + q) * 64 + lane)) * 16; uf[B][0] = *(const bf16x8*)ub_; uf[B][1] = *(const bf16x8*)(ub_ + 8); \
                if (wave == 4) gcv[B] = GC[(uh0 + (cc)) * 64 + lane]; } while (0)
#define STEP_W(c, B) do { const int bufc = (c) & 1; LBAR(); \
                f32x16 acc; \
                _Pragma("unroll") for (int i = 0; i < 16; ++i) acc[i] = 0.f; \
                _Pragma("unroll") for (int blk = 0; blk < 4; ++blk) _Pragma("unroll") for (int s = 0; s < 2; ++s) \
                    acc = MFMA32(wf[B][blk * 2 + s], __builtin_bit_cast(bf16x8, Sfr[(bufc * 4 + blk) * 128 + s * 64 + lane]), acc); \
                { float t8[8]; unpack8(__builtin_bit_cast(v4u, uf[B][0]), t8); \
                    _Pragma("unroll") for (int i = 0; i < 8; ++i) acc[i] = t8[i] - acc[i]; unpack8(__builtin_bit_cast(v4u, uf[B][1]), t8); \
                    _Pragma("unroll") for (int i = 0; i < 8; ++i) acc[8 + i] = t8[i] - acc[8 + i]; } \
                _Pragma("unroll") for (int s = 0; s < 2; ++s) Dfr[(rt * 2 + s) * 64 + lane] = pack_frag(acc, s); \
                _Pragma("unroll") for (int r = 0; r < 16; ++r) acc[r] *= gam[128 + bufc * 64 + 32 * rt + crow32(r, half)]; \
                _Pragma("unroll") for (int s = 0; s < 2; ++s) Dtf[(rt * 2 + s) * 64 + lane] = pack_frag(acc, s); \
                LBAR(); \
                if (wave == 4 && (c) + 1 < NCH) { const float gn_ = gcv[((B) + 1) % 3], gl_ = __shfl(gn_, 63); gam[(bufc ^ 1) * 64 + lane] = __expf(gn_); gam[128 + (bufc ^ 1) * 64 + lane] = __expf(gl_ - gn_); } } while (0)
            if (wave == 4) { const float gc = GC[(uh0 + 0) * 64 + lane], gl = __shfl(gc, 63); gam[lane] = __expf(gc); gam[128 + lane] = __expf(gl - gc); }
#ifndef NO_RW
            ROT3(LOAD_W, STEP_W);
#endif
#undef LOAD_W
#undef STEP_W
        } else {
            int ll_ = lane; asm volatile("" : "+v"(ll_)); const int lane = ll_, m = lane & 31, half = lane >> 5; (void)m; (void)half;
            bf16x8 qf[1][8], pf[1][4];
#define LOAD_Q(cc, B) do { const int row_ = chunk_row(b, (cc), 32 * rt + m); const bool ok_ = row_ >= 0; \
                const bf16* qb_ = QKVC + (size_t)(row_ < 0 ? 0 : row_) * CDIM + (h >> 1) * 128 + 8 * half; \
                _Pragma("unroll") for (int blk = 0; blk < 4; ++blk) _Pragma("unroll") for (int s_ = 0; s_ < 2; ++s_) qf[B][blk * 2 + s_] = sel8(ok_, *(const bf16x8*)(qb_ + blk * 32 + s_ * 16)); \
                } while (0)
#define LOAD_P(cc, PB) do { const bf16* pb_ = PG + (uh0 + (cc)) * 4096 + ((size_t)(rt * 256 + lane)) * 8; \
                _Pragma("unroll") for (int blk = 0; blk < 2; ++blk) _Pragma("unroll") for (int s_ = 0; s_ < 2; ++s_) pf[PB][blk * 2 + s_] = sel8(blk <= rt, *(const bf16x8*)(pb_ + blk * 1024 + s_ * 512)); } while (0)
#define STEP_Q(c) do { const int bufc = (c) & 1; LBAR(); \
                LOAD_P((c), 0);                                                    \
                f32x16 acc; \
                _Pragma("unroll") for (int i = 0; i < 16; ++i) acc[i] = 0.f; \
                _Pragma("unroll") for (int blk = 0; blk < 4; ++blk) _Pragma("unroll") for (int s = 0; s < 2; ++s) \
                    acc = MFMA32(qf[0][blk * 2 + s], __builtin_bit_cast(bf16x8, Sfr[(bufc * 4 + blk) * 128 + s * 64 + lane]), acc); \
                if ((c) + 1 < NCH) LOAD_Q((c) + 1, 0);                             \
                LBAR(); \
                _Pragma("unroll") for (int r = 0; r < 16; ++r) acc[r] *= gam[bufc * 64 + 32 * rt + crow32(r, half)]; \
                _Pragma("unroll") for (int blk = 0; blk < 2; ++blk) _Pragma("unroll") for (int s = 0; s < 2; ++s) acc = MFMA32(pf[0][blk * 2 + s], __builtin_bit_cast(bf16x8, Dfr[(blk * 2 + s) * 64 + lane]), acc); \
                _Pragma("unroll") for (int r = 0; r < 16; ++r) { const int row = chunk_row(b, (c), 32 * rt + crow32(r, half)); if (row >= 0) OF[(size_t)row * DVW + h * 128 + 32 * q + m] = f2bf(acc[r]); } } while (0)
#ifndef NO_RQ
            LOAD_Q(0, 0);
            for (int c = 0; c < NCH; ++c) STEP_Q(c);
#endif
#undef LOAD_Q
#undef LOAD_P
#undef STEP_Q
        }
#undef ROT2
#undef ROT3
    }
    LBAR();
}
#undef LBAR
#undef MFMA32
template <int RT, int CT, class Epi>
__device__ __forceinline__ void small_gemm_unit(const bf16* A, int lda, const bf16* Bt, int ldb, int k0, int klen, LAS unsigned char* lds, const Epi& E, int tid, int wave, int lane) {
    const int r16 = lane & 15, q = lane >> 4;
    const int kw = klen >> 3;
    const bf16* ap = A + (size_t)r16 * lda + k0 + wave * kw + 8 * q;
    const bf16* bp = Bt + (size_t)r16 * ldb + k0 + wave * kw + 8 * q;
    pg8::f32x4 acc[RT][CT];
#pragma unroll
    for (int i = 0; i < RT; ++i)
#pragma unroll
        for (int j = 0; j < CT; ++j) acc[i][j] = (pg8::f32x4){0.f, 0.f, 0.f, 0.f};
#pragma unroll 4
    for (int ks = 0; ks < kw; ks += 32) {
        bf16x8 a[RT], b[CT];
#pragma unroll
        for (int i = 0; i < RT; ++i) a[i] = *(const bf16x8*)(ap + (size_t)(16 * i) * lda + ks);
#pragma unroll
        for (int j = 0; j < CT; ++j) b[j] = *(const bf16x8*)(bp + (size_t)(16 * j) * ldb + ks);
#pragma unroll
        for (int i = 0; i < RT; ++i)
#pragma unroll
            for (int j = 0; j < CT; ++j) acc[i][j] = __builtin_amdgcn_mfma_f32_16x16x32_bf16(a[i], b[j], acc[i][j], 0, 0, 0);
    }
    constexpr int NOUT = 256 * RT * CT;
    LAS float* part = (LAS float*)lds + wave * NOUT;
#pragma unroll
    for (int i = 0; i < RT; ++i)
#pragma unroll
        for (int j = 0; j < CT; ++j)
#pragma unroll
            for (int e = 0; e < 4; ++e) part[(16 * i + 4 * q + e) * (16 * CT) + 16 * j + r16] = acc[i][j][e];
    __syncthreads();
    for (int o = tid; o < NOUT; o += NTHREADS) { float sum = 0.f;
#pragma unroll
        for (int w = 0; w < 8; ++w) sum += ((LAS float*)lds)[w * NOUT + o];
        E(o / (16 * CT), o % (16 * CT), sum); }
    __syncthreads();
}
template <int ACT> struct SEpiRowsBf16 { bf16* O; int ldc; __device__ __forceinline__ void operator()(int row, int col, float v) const { if (ACT == 2) { v = v > 0.f ? v : 0.f; v = v * v; } O[(size_t)row * ldc + col] = f2bf(v); } };
struct SEpiF32 { float* O; int ldc; __device__ __forceinline__ void operator()(int row, int col, float v) const { O[(size_t)row * ldc + col] = v; } };
struct SEpiColsBf16 { bf16* O; int ldc; __device__ __forceinline__ void operator()(int row, int col, float v) const { O[(size_t)col * ldc + row] = f2bf(v); } };
template <int ACT> __device__ __forceinline__ void skinny_rows_bf16(const bf16* A, const bf16* Wt, int K, int nunits, bf16* O, int ldc, LAS unsigned char* lds, int tid, int wave, int lane) {
    for (int u = blockIdx.x; u < nunits; u += gridDim.x) { SEpiRowsBf16<ACT> E{O + (size_t)XROW0 * ldc + u * 64, ldc};
        small_gemm_unit<3, 4>(A + (size_t)XROW0 * K, K, Wt + (size_t)u * 64 * K, K, 0, K, lds, E, tid, wave, lane); }
}
__device__ __forceinline__ void skinny_rows_part(const bf16* A, const bf16* Wt, int K, float* ZP, LAS unsigned char* lds, int tid, int wave, int lane) {
    for (int u = blockIdx.x; u < 256; u += gridDim.x) { const int cgp = u & 31, ksl = u >> 5; SEpiF32 E{ZP + (size_t)ksl * XR * DM + cgp * 64, DM};
        small_gemm_unit<3, 4>(A + (size_t)XROW0 * K, K, Wt + (size_t)cgp * 64 * K, K, ksl * (K >> 3), K >> 3, lds, E, tid, wave, lane); }
}
template <int RT> __device__ __forceinline__ void tail_cols_bf16(const bf16* A, const bf16* Wt, int K, int c0, bf16* O, int ldc, LAS unsigned char* lds, int tid, int wave, int lane) {
    for (int u = blockIdx.x; u < MAINM / 32; u += gridDim.x) { SEpiColsBf16 E{O + (size_t)u * 32 * ldc + c0, ldc};
        small_gemm_unit<RT, 2>(Wt + (size_t)c0 * K, K, A + (size_t)u * 32 * K, K, 0, K, lds, E, tid, wave, lane); }
}

typedef __attribute__((address_space(4))) const unsigned long long* kargq_t;
#define KPF_(k) ((const float*)(const GAS float*)(q_[k]))
__device__ __forceinline__ void load_ptrs(Ptrs& P) {
    kargq_t q_ = (kargq_t)__builtin_amdgcn_kernarg_segment_ptr();
    asm volatile("" : "+s"(q_));
    P.x_prompt = KPF_(0); P.x_sample = KPF_(1); P.state_conv_a = KPF_(2); P.cache_k = KPF_(3);
    P.cache_v = KPF_(4); P.cache_ik = KPF_(5); P.state_conv_c = KPF_(6); P.state_delta = KPF_(7);
    P.page_table = ((const int*)(const GAS int*)(q_[8])); P.meta = KPF_(9); P.w_in_a = KPF_(10); P.conv_w_a = KPF_(11);
    P.w_out_a = KPF_(12); P.w_in_b = KPF_(13); P.w_out_b = KPF_(14); P.w_in_c = KPF_(15);
    P.conv_w_c = KPF_(16); P.a_log = KPF_(17); P.dt_bias = KPF_(18); P.norm_w = KPF_(19);
    P.w_out_c = KPF_(20); P.ln1_g = KPF_(21); P.ln1_b = KPF_(22); P.w1 = KPF_(23);
    P.w2 = KPF_(24); P.ln2_g = KPF_(25); P.ln2_b = KPF_(26);
    P.out = (float*)(GAS float*)(q_[27]); P.ws = (unsigned char*)(GAS unsigned char*)(q_[28]);
}
struct Args { const void* in[27]; float* out; unsigned char* ws; int ph_lo, ph_hi; };
constexpr int PH_PER_LAYER = 12, PH_END = 1 + 4 * PH_PER_LAYER;

__global__ void __launch_bounds__(NTHREADS, 2) mega_fwd(Args args) {
    extern __shared__ __attribute__((aligned(16))) unsigned char lds_raw[];
    LAS unsigned char* lds = (LAS unsigned char*)lds_raw;
    const int tid = threadIdx.x, lane = tid & 63, wave = __builtin_amdgcn_readfirstlane(tid >> 6);
    const int G_ = gridDim.x, NGW = G_ * NWAVES, NT = G_ * NTHREADS; (void)lane;
    unsigned char* ws = args.ws;
    const int lo = args.ph_lo, hi = args.ph_hi;
    const bool fused = (hi - lo) > 1;

    for (int u = tid; u < (LDS_BYTES - LDSCTL_OFF) / 4; u += NTHREADS) ((LAS unsigned*)(lds + LDSCTL_OFF))[u] = 0u;
    __syncthreads();
    volatile LAS unsigned* MISC = (volatile LAS unsigned*)(lds + MISC_OFF);
    XcdBarrier bar; bar.bar = (unsigned*)(ws + WS_CTL) + CW_BAR; bar.x = 0; bar.st = nullptr;
    if (fused) bar = xcd_barrier_post((unsigned*)(ws + WS_CTL) + CW_BAR, MISC + 8);
    bar.wv = wave;

#ifndef MK_SITES
#define MK_SITES 0xffffffffu
#endif
#define SITE(n) (((MK_SITES) >> (n)) & 1u)
#define IN(k) (lo <= (k) && (k) < hi)
#ifndef MK_DUP
#define MK_DUP 0u
#endif
#define NREP(n) ((((MK_DUP) >> (n)) & 1u) ? 2 : 1)
#ifdef MK_SKINNY2
#define SKREP 2
#else
#define SKREP 1
#endif
#define BEGIN_SITE(n, id) if (SITE(n) && IN(id)) { for (int rp_ = 0; rp_ < NREP(n); ++rp_) { Ptrs P; load_ptrs(P); unsigned char* ws = P.ws; (void)ws; \
    bf16* X = (bf16*)(P.ws + WS_X); float* Z = (float*)(P.ws + WS_Z); float* ZP = (float*)(P.ws + WS_ZP); bf16* Y = (bf16*)(P.ws + WS_Y); bf16* BIG = (bf16*)(P.ws + WS_BIG); (void)X; (void)Z; (void)ZP; (void)Y; (void)BIG;
#define END_SITE(id) SEAM(id); } }
#define LOCALS int tid_ = threadIdx.x; asm volatile("" : "+v"(tid_)); const int lane_ = tid_ & 63, wave_ = __builtin_amdgcn_readfirstlane(tid_ >> 6), gw_ = blockIdx.x * NWAVES + wave_, gtid_ = blockIdx.x * NTHREADS + tid_; (void)lane_; (void)wave_; (void)gw_; (void)gtid_
#define SEAM(k) do { if (fused && (k) + 1 < PH_END) xcd_barrier(bar); else __syncthreads(); } while (0)


    BEGIN_SITE(0, 0) LOCALS; p0_prologue(P, lds, gw_, NGW, wave_, lane_); END_SITE(0)
#ifdef MK_XBAR
    if (fused) { for (int xb_ = 0; xb_ < MK_XBAR; ++xb_) xcd_barrier(bar); }
#endif

    for (int layer = 0; layer < 4; ++layer) {
        const int kind = layer % 3, j = layer / 3, base = 1 + layer * PH_PER_LAYER;
        if (kind == 0) {
            BEGIN_SITE(1, base + 0)
                const bf16* Wt = (const bf16*)(ws + WS_WA_IN + (size_t)j * WSZ_A_IN); pg8::Gemm g{X, Wt, MAINM, NA_IN, DM}; pg8::StaticOrder S; S.init(MAINM, NA_IN, G_, (int)blockIdx.x);
                pg8::EpiBf16<0> E{BIG, NA_IN, nullptr, 0, 0, 1.f};
                pg8::gemm_phase<pg8::EpiBf16<0>, pg8::StaticOrder, true, true>(lds, g, S, E, wave);
                { LOCALS; for (int sk_ = 0; sk_ < SKREP; ++sk_) { skinny_rows_bf16<0>(X, Wt, DM, NA_IN / 64, BIG, NA_IN, lds, tid_, wave_, lane_); } }
                END_SITE(base + 0)
            BEGIN_SITE(2, base + 1)
                LOCALS; convA_phase(BIG, Y, P.conv_w_a + (size_t)j * 3 * DM, P.state_conv_a + (size_t)j * SBN * 2 * DM, P.out + O_CAP + (size_t)j * NBP * 2 * DM, P.out + O_CAS + (size_t)j * SBN * 2 * DM, gtid_, NT);
                END_SITE(base + 1)
            BEGIN_SITE(3, base + 2)
                const bf16* Wt = (const bf16*)(ws + WS_WA_OUT + (size_t)j * WSZ_A_OUT); pg8::Gemm g{Y, Wt, MAINM, DM, DM}; pg8::StaticOrder S; S.init(MAINM, DM, G_, (int)blockIdx.x);
                pg8::EpiResBf16 E{X, DM, ALPHA};
                pg8::gemm_phase<pg8::EpiResBf16, pg8::StaticOrder, true, true>(lds, g, S, E, wave);
                { LOCALS; for (int sk_ = 0; sk_ < SKREP; ++sk_) { skinny_rows_part(Y, Wt, DM, ZP, lds, tid_, wave_, lane_); } }
                END_SITE(base + 2)
        } else if (kind == 1) {
            BEGIN_SITE(4, base + 0)
                const bf16* Wt = (const bf16*)(ws + WS_WB_IN); pg8::Gemm g{X, Wt, MAINM, 4096, DM}; pg8::StaticOrder S; S.init(MAINM, 4096, G_, (int)blockIdx.x);
                pg8::EpiBf16<0> E{BIG, NB_PAD, nullptr, 0, 0, 1.f};
                pg8::gemm_phase<pg8::EpiBf16<0>, pg8::StaticOrder, true, true>(lds, g, S, E, wave);
                { LOCALS; for (int sk_ = 0; sk_ < SKREP; ++sk_) { tail_cols_bf16<5>(X, Wt, DM, 4096, BIG, NB_PAD, lds, tid_, wave_, lane_); skinny_rows_bf16<0>(X, Wt, DM, 4224 / 64, BIG, NB_PAD, lds, tid_, wave_, lane_); } }
                END_SITE(base + 0)
            BEGIN_SITE(5, base + 1) LOCALS; rope_phase(BIG, P, gw_, NGW, lane_); END_SITE(base + 1)
            BEGIN_SITE(6, base + 2) LOCALS; indexer_sample(P, lds, tid_); indexer_prompt(P, lds, tid_, wave_, lane_); END_SITE(base + 2)
            BEGIN_SITE(7, base + 3) LOCALS; select_phase(P, lds, gw_, NGW, tid_, wave_, lane_); END_SITE(base + 3)
            BEGIN_SITE(8, base + 4) LOCALS; dense_attn_phase(P, Y, (char*)lds_raw, wave_); attn_phase(P, Y, lds, gw_, NGW, wave_, lane_); END_SITE(base + 4)
            BEGIN_SITE(9, base + 5)
                const bf16* Wt = (const bf16*)(ws + WS_WB_OUT); pg8::Gemm g{Y, Wt, MAINM, DM, DM}; pg8::StaticOrder S; S.init(MAINM, DM, G_, (int)blockIdx.x);
                pg8::EpiResBf16 E{X, DM, ALPHA};
                pg8::gemm_phase<pg8::EpiResBf16, pg8::StaticOrder, true, true>(lds, g, S, E, wave);
                { LOCALS; for (int sk_ = 0; sk_ < SKREP; ++sk_) { skinny_rows_part(Y, Wt, DM, ZP, lds, tid_, wave_, lane_); } }
                END_SITE(base + 5)
        } else {
            BEGIN_SITE(10, base + 0)
                const bf16* Wt = (const bf16*)(ws + WS_WC_IN); pg8::Gemm g{X, Wt, MAINM, 12288, DM}; pg8::StaticOrder S; S.init(MAINM, 12288, G_, (int)blockIdx.x);
                pg8::EpiBf16<0> E{BIG, NC_PAD, nullptr, 0, 0, 1.f};
                pg8::gemm_phase<pg8::EpiBf16<0>, pg8::StaticOrder, true, true>(lds, g, S, E, wave);
                { LOCALS; for (int sk_ = 0; sk_ < SKREP; ++sk_) { tail_cols_bf16<4>(X, Wt, DM, 12288, BIG, NC_PAD, lds, tid_, wave_, lane_); skinny_rows_bf16<0>(X, Wt, DM, NC_IN / 64, BIG, NC_PAD, lds, tid_, wave_, lane_); } }
                END_SITE(base + 0)
            BEGIN_SITE(11, base + 1) LOCALS; convC_phase(BIG, P, gw_, NGW, lane_); END_SITE(base + 1)
            BEGIN_SITE(19, base + 2) LOCALS; delta_pre(P.ws, lds, gw_, NGW, wave_, lane_);
                { const int nbusy = (NUQ > NGW && NUQ < 2 * NGW) ? NUQ - NGW : 0;
                  const bool busy = nbusy > 0 && (gw_ & 63) == 0 && (gw_ >> 6) < nbusy; const int below = nbusy == 0 ? 0 : (((gw_ + 63) >> 6) < nbusy ? ((gw_ + 63) >> 6) : nbusy);
                  if (!busy) { delta_phase(P, gw_ - below, NGW - nbusy, lane_); deferred_transposes(P, lds, gw_ - below, NGW - nbusy, wave_, lane_); } }
            END_SITE(base + 2)
            BEGIN_SITE(22, base + 5) LOCALS; delta_d4(P.ws, P.out + O_DP, lds, tid_, wave_, lane_); END_SITE(base + 5)
            BEGIN_SITE(13, base + 6) LOCALS; normC_phase(BIG, Y, P, gw_, NGW, lane_); END_SITE(base + 6)
            BEGIN_SITE(14, base + 7)
                const bf16* Wt = (const bf16*)(ws + WS_WC_OUT); pg8::Gemm g{Y, Wt, MAINM, DM, DVW}; pg8::StaticOrder S; S.init(MAINM, DM, G_, (int)blockIdx.x);
                pg8::EpiResBf16 E{X, DM, ALPHA};
                pg8::gemm_phase<pg8::EpiResBf16, pg8::StaticOrder, true, true>(lds, g, S, E, wave);
                { LOCALS; for (int sk_ = 0; sk_ < SKREP; ++sk_) { skinny_rows_part(Y, Wt, DVW, ZP, lds, tid_, wave_, lane_); } }
                END_SITE(base + 7)
        }
        BEGIN_SITE(15, base + 8) LOCALS; ln_phase(Z, ZP, X, rp_ == 0 ? X : (bf16*)(P.ws + WS_QR), P.ln1_g + (size_t)layer * DM, P.ln1_b + (size_t)layer * DM, nullptr, nullptr, lds, gw_, NGW, tid_, wave_, lane_); END_SITE(base + 8)
        BEGIN_SITE(16, base + 9)
            const bf16* Wt = (const bf16*)(ws + WS_W1 + (size_t)layer * WSZ_W1); pg8::Gemm g{X, Wt, MAINM, FF, DM}; pg8::StaticOrder S; S.init(MAINM, FF, G_, (int)blockIdx.x);
            pg8::EpiBf16<2> E{BIG, FF, nullptr, 0, 0, 1.f};
            pg8::gemm_phase<pg8::EpiBf16<2>, pg8::StaticOrder, true, true>(lds, g, S, E, wave);
            { LOCALS; for (int sk_ = 0; sk_ < SKREP; ++sk_) { skinny_rows_bf16<2>(X, Wt, DM, FF / 64, BIG, FF, lds, tid_, wave_, lane_); } }
            END_SITE(base + 9)
        BEGIN_SITE(17, base + 10)
            const bf16* Wt = (const bf16*)(ws + WS_W2 + (size_t)layer * WSZ_W2); pg8::Gemm g{BIG, Wt, MAINM, DM, FF}; pg8::StaticOrder S; S.init(MAINM, DM, G_, (int)blockIdx.x);
            pg8::EpiResBf16 E{X, DM, ALPHA};
            pg8::gemm_phase<pg8::EpiResBf16, pg8::StaticOrder, true, true>(lds, g, S, E, wave);
            { LOCALS; for (int sk_ = 0; sk_ < SKREP; ++sk_) { skinny_rows_part(BIG, Wt, FF, ZP, lds, tid_, wave_, lane_); } }
            END_SITE(base + 10)
        BEGIN_SITE(18, base + 11)
            const bool last = layer == 3;
            LOCALS; ln_phase(Z, ZP, X, rp_ == 0 ? X : (bf16*)(P.ws + WS_QR), P.ln2_g + (size_t)layer * DM, P.ln2_b + (size_t)layer * DM, last ? P.out + O_YP : nullptr, last ? P.out + O_YS : nullptr, lds, gw_, NGW, tid_, wave_, lane_);
            if (!last) SEAM(base + 11); } }
    }
#undef IN
#undef SEAM
}

#ifndef MK_SPLIT
#define MK_SPLIT 0
#endif
extern "C" void kernel_launch(void* const* d_in, const int* in_sizes, int n_in, void* d_out, int out_size, void* d_ws, size_t ws_size, hipStream_t stream) {
    static int grid = 0;
    if (grid == 0) {
        if (n_in != 27 || (size_t)out_size != O_END || ws_size < WS_END) { fprintf(stderr, "kernel_launch: unexpected shapes: n_in %d out %d (want %zu) ws %zu (want >= %zu)\n", n_in, out_size, (size_t)O_END, ws_size, (size_t)WS_END); grid = -1; return; }
        int dev = 0, cus = 0;
        if (hipGetDevice(&dev) != hipSuccess || hipDeviceGetAttribute(&cus, hipDeviceAttributeMultiprocessorCount, dev) != hipSuccess) { grid = -1; return; }
        if (hipFuncSetAttribute((const void*)mega_fwd, hipFuncAttributeMaxDynamicSharedMemorySize, LDS_BYTES) != hipSuccess) { fprintf(stderr, "kernel_launch: hipFuncSetAttribute failed\n"); grid = -1; return; }
        int per_cu = 0;
        if (hipOccupancyMaxActiveBlocksPerMultiprocessor(&per_cu, (const void*)mega_fwd, NTHREADS, LDS_BYTES) != hipSuccess || per_cu < 1) fprintf(stderr, "kernel_launch: occupancy query reports %d\n", per_cu);
        (void)hipGetLastError();
        grid = cus;
    }
    if (grid < 0) return;
    (void)hipMemsetAsync((char*)d_ws + WS_CTL, 0, CTL_ZERO_BYTES, stream);
    Args a{};
    for (int i = 0; i < 27; ++i) a.in[i] = d_in[i];
    a.out = (float*)d_out; a.ws = (unsigned char*)d_ws;
#if MK_SPLIT
    for (int ph = 0; ph < PH_END; ++ph) {
        bool exists = (ph == 0);
        if (ph > 0) { const int layer = (ph - 1) / PH_PER_LAYER, l = (ph - 1) % PH_PER_LAYER, kind = layer % 3; const int nmix = kind == 0 ? 3 : (kind == 1 ? 6 : 8); exists = (l < nmix) || (l >= 8 && l <= 11); }
        if (!exists) continue;
        a.ph_lo = ph; a.ph_hi = ph + 1;
        hipLaunchKernelGGL(mega_fwd, dim3(grid), dim3(NTHREADS), LDS_BYTES, stream, a);
    }
#else
    a.ph_lo = 0; a.ph_hi = PH_END;
    hipLaunchKernelGGL(mega_fwd, dim3(grid), dim3(NTHREADS), LDS_BYTES, stream, a);
#endif
    const hipError_t le = hipPeekAtLastError();
    if (le != hipSuccess) fprintf(stderr, "kernel_launch: launch failed: %s\n", hipGetErrorName(le));
}
```

```cpp
#include <hip/hip_runtime.h>
#include <cstdio>
#include <cstdint>
#include <cmath>
__device__ __forceinline__ int flane() { return (int)__builtin_amdgcn_mbcnt_hi(~0u, __builtin_amdgcn_mbcnt_lo(~0u, 0u)); }
namespace pg8 {
#define PG8_LAS __attribute__((address_space(3)))
typedef unsigned short bf16_t;
typedef short bf16x8 __attribute__((ext_vector_type(8)));
typedef float f32x4 __attribute__((ext_vector_type(4)));
typedef unsigned u32x4 __attribute__((ext_vector_type(4)));
constexpr int BM = 256, BK = 64, HALF = 128, HTB = HALF * BK * 2  , STAGE_BYTES = 8 * HTB, NXCD = 8, WGM = 8;

__host__ __device__ __forceinline__ int lds_byte(int r, int c) { const int st = (r >> 4) * 2 + (c >> 5), rr = r & 15, cc = c & 31, ob = rr * 64 + cc * 2; return st * 1024 + (ob ^ (((ob >> 9) & 1) << 5)); }
__host__ __device__ __forceinline__ void stage_rc(int b, int& R, int& C) { const int st = b / 1024, sb = b % 1024, swz = sb ^ (((sb >> 9) & 1) << 5); R = (st >> 1) * 16 + swz / 64; C = (st & 1) * 32 + (swz % 64) / 2; }
__host__ __device__ __forceinline__ int perm32(int rho) { const int n = rho >> 4, i = rho & 15; return 8 * (i >> 2) + 4 * n + (i & 3); }

struct Unit { int pm, pn; };
struct Gemm { const bf16_t* A; const bf16_t* Bt; int M, N, K; };

struct StaticOrder {
    int nM, nN, nwg, G, c;
    __host__ __device__ void init(int M, int N, int G_, int c_) { nM = M / BM; nN = N / BM; nwg = nM * nN; G = G_; c = c_; }
    __host__ __device__ bool next(int i, Unit& u) const {
        const long L = (long)i * G + c; if (L >= nwg) return false;
        int wgid = (int)L; { const int q = nwg / NXCD, r = nwg % NXCD, xcd = wgid % NXCD, off = wgid / NXCD; wgid = (xcd < r ? xcd * (q + 1) : r * (q + 1) + (xcd - r) * q) + off; }
        const int nig = WGM * nN, gid = wgid / nig, fm = gid * WGM, gsz = (nM - fm) < WGM ? (nM - fm) : WGM;
        u.pm = fm + ((wgid % nig) % gsz); u.pn = (wgid % nig) / gsz; return true;
    }
    __device__ __forceinline__ void a_ready(const Unit&) const {}
    __device__ __forceinline__ void done(const Unit&) const {}
};

__device__ __forceinline__ unsigned cvt_pk_bf16(float lo, float hi) { unsigned r; asm volatile("v_cvt_pk_bf16_f32 %0, %1, %2" : "=v"(r) : "v"(lo), "v"(hi)); return r; }
typedef float f32x2 __attribute__((ext_vector_type(2)));
__device__ __forceinline__ f32x2 gelu_pk(f32x2 v) {
    const f32x2 av = __builtin_elementwise_abs(v), d = av * 0.2316418882f + 1.0f;
    f32x2 t; t.x = __builtin_amdgcn_rcpf(d.x); t.y = __builtin_amdgcn_rcpf(d.y);
    f32x2 q = t * 0.5307027145f + (-0.7265760135f); q = q * t + 0.7107068705f; q = q * t + (-0.142248368f); q = q * t + 0.127414796f; q = q * t;
    const f32x2 s = (v * v) * (-0.72134752044f);
    f32x2 e; e.x = __builtin_amdgcn_exp2f(s.x); e.y = __builtin_amdgcn_exp2f(s.y);
    const f32x2 m = v * (q * e), r = v - m;
    f32x2 o; o.x = v.x < 0.f ? m.x : r.x; o.y = v.y < 0.f ? m.y : r.y; return o;
}

template <int ACT  > struct EpiBf16 {
    static constexpr bool PERM = true, AFTER_DRAIN = false; static_assert(ACT == 0 || ACT == 1 || ACT == 2, "EpiBf16: ACT is 0 (none), 1 (gelu_pk) or 2 (relu^2)");
    bf16_t* O; int ldc; const float* bias; int split_cols; size_t split_stride; float scale0;
    __device__ __forceinline__ void operator()(const f32x4 (&acc)[2][2][4][2], const Unit& u, int wr, int wc, int fr, int fq) const {
        const int row0 = u.pm * BM + wr * 64 + fr; int colt = u.pn * BM; bf16_t* base = O;
        float sc = 1.f; if (split_cols) { const int t = colt / split_cols; base += (size_t)t * split_stride; colt -= t * split_cols; if (t == 0) sc = scale0; }
        const int col0 = colt + wc * 32 + 8 * fq, bcol0 = u.pn * BM + wc * 32 + 8 * fq;
        f32x4 bv[2][2];
#pragma unroll
        for (int bj = 0; bj < 2; ++bj)
#pragma unroll
            for (int n = 0; n < 2; ++n) bv[bj][n] = bias ? *(const f32x4*)(bias + bcol0 + bj * HALF + 4 * n) : (f32x4){0.f, 0.f, 0.f, 0.f};
#pragma unroll
        for (int ai = 0; ai < 2; ++ai)
#pragma unroll
            for (int m = 0; m < 4; ++m) { bf16_t* rowp = base + (size_t)(row0 + ai * HALF + m * 16) * ldc + col0;
#pragma unroll
                for (int bj = 0; bj < 2; ++bj) { f32x4 v0 = acc[ai][bj][m][0] + bv[bj][0], v1 = acc[ai][bj][m][1] + bv[bj][1];
                    if (ACT == 1) { f32x2 a = gelu_pk((f32x2){v0[0], v0[1]}), b = gelu_pk((f32x2){v0[2], v0[3]}), c = gelu_pk((f32x2){v1[0], v1[1]}), d = gelu_pk((f32x2){v1[2], v1[3]});
                        v0 = (f32x4){a.x, a.y, b.x, b.y}; v1 = (f32x4){c.x, c.y, d.x, d.y}; }
                    if (ACT == 2) { _Pragma("unroll") for (int q_ = 0; q_ < 4; ++q_) { const float a_ = v0[q_] > 0.f ? v0[q_] : 0.f, b_ = v1[q_] > 0.f ? v1[q_] : 0.f; v0[q_] = a_ * a_; v1[q_] = b_ * b_; } }
                    v0 = v0 * sc; v1 = v1 * sc; u32x4 w; w.x = cvt_pk_bf16(v0[0], v0[1]); w.y = cvt_pk_bf16(v0[2], v0[3]); w.z = cvt_pk_bf16(v1[0], v1[1]); w.w = cvt_pk_bf16(v1[2], v1[3]);
                    *(u32x4*)(rowp + bj * HALF) = w; } }
    }
};


struct EpiResBf16 {
    static constexpr bool PERM = true, AFTER_DRAIN = false;
    bf16_t* X; int ldc; float alpha;
    __device__ __forceinline__ void operator()(const f32x4 (&acc)[2][2][4][2], const Unit& u, int wr, int wc, int fr, int fq) const {
        const int row0 = u.pm * BM + wr * 64 + fr, col0 = u.pn * BM + wc * 32 + 8 * fq;
#pragma unroll
        for (int ai = 0; ai < 2; ++ai) {
            u32x4 xin[4][2];
#pragma unroll
            for (int m = 0; m < 4; ++m)
#pragma unroll
                for (int bj = 0; bj < 2; ++bj) xin[m][bj] = *(const u32x4*)(X + (size_t)(row0 + ai * HALF + m * 16) * ldc + col0 + bj * HALF);
#pragma unroll
            for (int m = 0; m < 4; ++m) { bf16_t* rowp = X + (size_t)(row0 + ai * HALF + m * 16) * ldc + col0;
#pragma unroll
                for (int bj = 0; bj < 2; ++bj) { const u32x4 xi = xin[m][bj]; const f32x4 a0 = acc[ai][bj][m][0], a1 = acc[ai][bj][m][1];
                    float x[8] = {__uint_as_float(xi.x << 16), __uint_as_float(xi.x & 0xffff0000u), __uint_as_float(xi.y << 16), __uint_as_float(xi.y & 0xffff0000u),
                                  __uint_as_float(xi.z << 16), __uint_as_float(xi.z & 0xffff0000u), __uint_as_float(xi.w << 16), __uint_as_float(xi.w & 0xffff0000u)};
                    u32x4 w; w.x = cvt_pk_bf16(alpha * x[0] + a0[0], alpha * x[1] + a0[1]); w.y = cvt_pk_bf16(alpha * x[2] + a0[2], alpha * x[3] + a0[3]);
                    w.z = cvt_pk_bf16(alpha * x[4] + a1[0], alpha * x[5] + a1[1]); w.w = cvt_pk_bf16(alpha * x[6] + a1[2], alpha * x[7] + a1[3]);
                    *(u32x4*)(rowp + bj * HALF) = w; } }
        }
    }
};

struct EpiF32 {
    static constexpr bool PERM = false, AFTER_DRAIN = false;
    float* C; int ldc;
    __device__ __forceinline__ void operator()(const f32x4 (&acc)[2][2][4][2], const Unit& u, int wr, int wc, int fr, int fq) const {
        const int row0 = u.pm * BM + wr * 64 + fr, col0 = u.pn * BM + wc * 32 + 4 * fq;
#pragma unroll
        for (int ai = 0; ai < 2; ++ai)
#pragma unroll
            for (int m = 0; m < 4; ++m) { float* rowp = C + (size_t)(row0 + ai * HALF + m * 16) * ldc + col0;
#pragma unroll
                for (int bj = 0; bj < 2; ++bj)
#pragma unroll
                    for (int n = 0; n < 2; ++n) *(f32x4*)(rowp + bj * HALF + n * 16) = acc[ai][bj][m][n]; }
    }
};
struct PanelStats {
    unsigned* xbuf;
    unsigned* cnt;
    unsigned* tmo;
    int ntn; float eps;
    unsigned code;
    __device__ __forceinline__ bool run(const f32x4 (&v)[2][2][4][2], const Unit& u, int wr, int wc, int fr, int fq, PG8_LAS unsigned char* lds, int wid, int lane) const {
        typedef float f32x2v __attribute__((ext_vector_type(2)));
        PG8_LAS f32x2v* P = (PG8_LAS f32x2v*)lds;
        PG8_LAS f32x2v* S = (PG8_LAS f32x2v*)(lds + 8192);
        PG8_LAS unsigned* flag = (PG8_LAS unsigned*)(lds + 8192 + 2048);
#pragma unroll
        for (int ai = 0; ai < 2; ++ai)
#pragma unroll
            for (int m = 0; m < 4; ++m) {
                float s = 0.f;
#pragma unroll
                for (int bj = 0; bj < 2; ++bj)
#pragma unroll
                    for (int n = 0; n < 2; ++n) { const f32x4 x = v[ai][bj][m][n]; s += (x[0] + x[1]) + (x[2] + x[3]); }
                s += __shfl_xor(s, 16); s += __shfl_xor(s, 32);
                const float mw = s * (1.0f / 64.0f); float q = 0.f;
#pragma unroll
                for (int bj = 0; bj < 2; ++bj)
#pragma unroll
                    for (int n = 0; n < 2; ++n) { const f32x4 d = v[ai][bj][m][n] - mw; q += (d[0] * d[0] + d[1] * d[1]) + (d[2] * d[2] + d[3] * d[3]); }
                q += __shfl_xor(q, 16); q += __shfl_xor(q, 32);
                if (fq == 0) P[(ai * HALF + wr * 64 + m * 16 + fr) * 4 + wc] = (f32x2v){mw, q};
            }
        asm volatile("s_waitcnt lgkmcnt(0)" ::: "memory"); __builtin_amdgcn_s_barrier(); asm volatile("" ::: "memory");
#if defined(BROKEN_EXCHANGE_NO_WAIT)
#warning BROKEN CONTROL BUILD: the row-statistics exchange does not wait; results are wrong by design
        if (blockIdx.x >= 64) { const long long t0_ = clock64(); while (clock64() - t0_ < 60000) __builtin_amdgcn_s_sleep(8); }
#endif
        const int row = wid * 32 + (lane & 31);
        if (lane < 32) {
            const f32x2v a = P[row * 4 + 0], b = P[row * 4 + 1], c = P[row * 4 + 2], d = P[row * 4 + 3];
            const float mt = (a.x + b.x + c.x + d.x) * 0.25f;
            const float da = a.x - mt, db = b.x - mt, dc = c.x - mt, dd = d.x - mt;
            const float m2 = (a.y + b.y) + (c.y + d.y) + 64.0f * ((da * da + db * db) + (dc * dc + dd * dd));
            unsigned long long* slot = (unsigned long long*)xbuf + ((size_t)(u.pm * BM + row) * 4 + u.pn);
            __hip_atomic_store(slot, ((unsigned long long)__float_as_uint(m2) << 32) | __float_as_uint(mt), __ATOMIC_RELAXED, __HIP_MEMORY_SCOPE_AGENT);
        }
        asm volatile("s_waitcnt vmcnt(0)" ::: "memory");
        if (lane == 0) __hip_atomic_fetch_add(cnt + 64 * u.pm, 1u, __ATOMIC_RELAXED, __HIP_MEMORY_SCOPE_AGENT);
        if (wid == 0) {
            bool dead = false; const unsigned long long t0 = __builtin_amdgcn_s_memrealtime(); const unsigned want = 8u * (unsigned)ntn;
            for (;;) {
#if defined(BROKEN_EXCHANGE_NO_WAIT)
                break;
#endif
                if ((unsigned)__builtin_amdgcn_readfirstlane(__hip_atomic_load(cnt + 64 * u.pm, __ATOMIC_RELAXED, __HIP_MEMORY_SCOPE_AGENT)) >= want) break;
                if (__builtin_amdgcn_s_memrealtime() - t0 > 2000000ull) {
                    if (lane == 0) { unsigned expect = 0u; __hip_atomic_compare_exchange_strong(tmo + 1, &expect, code | (unsigned)(u.pm & 0xff), __ATOMIC_RELAXED, __ATOMIC_RELAXED, __HIP_MEMORY_SCOPE_AGENT);
                                     __hip_atomic_store(tmo, 1u, __ATOMIC_RELAXED, __HIP_MEMORY_SCOPE_AGENT); }
                    dead = true; break; }
                __builtin_amdgcn_s_sleep(2);
            }
            __builtin_amdgcn_fence(__ATOMIC_ACQUIRE, "agent");
            if (lane == 0) flag[0] = dead ? 1u : 0u;
        }
        asm volatile("s_waitcnt vmcnt(0) lgkmcnt(0)" ::: "memory"); __builtin_amdgcn_s_barrier(); asm volatile("" ::: "memory");
        const bool bad = flag[0] != 0u;
        if (lane < 32) {
            const unsigned long long* slot = (const unsigned long long*)xbuf + (size_t)(u.pm * BM + row) * 4; float mt[4], m2[4]; float ms = 0.f;
#pragma unroll
            for (int t = 0; t < 4; ++t) { if (t < ntn) { const unsigned long long w = __hip_atomic_load(slot + t, __ATOMIC_RELAXED, __HIP_MEMORY_SCOPE_AGENT); mt[t] = __uint_as_float((unsigned)w); m2[t] = __uint_as_float((unsigned)(w >> 32)); } else { mt[t] = 0.f; m2[t] = 0.f; } ms += mt[t]; }
            const float mean = ms / (float)ntn; float q = 0.f;
#pragma unroll
            for (int t = 0; t < 4; ++t) if (t < ntn) { const float dm = mt[t] - mean; q += m2[t] + 256.0f * dm * dm; }
            S[row] = (f32x2v){mean, 1.0f / sqrtf(q / (256.0f * (float)ntn) + eps)};
        }
        asm volatile("s_waitcnt lgkmcnt(0)" ::: "memory"); __builtin_amdgcn_s_barrier(); asm volatile("" ::: "memory");
        return bad;
    }
};
struct EpiLnRes {
    static constexpr bool PERM = false, AFTER_DRAIN = true;
    const float* base; float* out; int ldc; const float* bias; PanelStats st; unsigned poison;
    __device__ __forceinline__ void fused(f32x4 (&acc)[2][2][4][2], const Unit& u, int wr, int wc, int fr, int fq, PG8_LAS unsigned char* lds, int wid, int lane) const {
        typedef float f32x2v __attribute__((ext_vector_type(2)));
        const PG8_LAS f32x2v* S = (const PG8_LAS f32x2v*)(lds + 8192);
        const int col0 = u.pn * BM + wc * 32 + 4 * fq;
#pragma unroll
        for (int bj = 0; bj < 2; ++bj)
#pragma unroll
            for (int n = 0; n < 2; ++n) { const f32x4 bv = bias ? *(const f32x4*)(bias + col0 + bj * HALF + n * 16) : (f32x4){0.f, 0.f, 0.f, 0.f};
#pragma unroll
                for (int ai = 0; ai < 2; ++ai)
#pragma unroll
                    for (int m = 0; m < 4; ++m) acc[ai][bj][m][n] += bv; }
        f32x4 pre[4][2][2];
#pragma unroll
        for (int m = 0; m < 4; ++m) { const size_t off = (size_t)(u.pm * BM + wr * 64 + m * 16 + fr) * ldc + col0;
#pragma unroll
            for (int bj = 0; bj < 2; ++bj)
#pragma unroll
                for (int n = 0; n < 2; ++n) pre[m][bj][n] = *(const f32x4*)(base + off + bj * HALF + n * 16); }
        const bool bad = st.run(acc, u, wr, wc, fr, fq, lds, wid, lane) || poison != 0u;
        const float qnan = __builtin_nanf("");
#pragma unroll
        for (int ai = 0; ai < 2; ++ai)
#pragma unroll
            for (int m = 0; m < 4; ++m) { const int r = ai * HALF + wr * 64 + m * 16 + fr; const f32x2v sr = S[r]; const size_t off = (size_t)(u.pm * BM + r) * ldc + col0;
#pragma unroll
                for (int bj = 0; bj < 2; ++bj)
#pragma unroll
                    for (int n = 0; n < 2; ++n) { const f32x4 bs = ai == 0 ? pre[m][bj][n] : *(const f32x4*)(base + off + bj * HALF + n * 16); f32x4 o = bs + (acc[ai][bj][m][n] - sr.x) * sr.y;
                        if (bad) o = (f32x4){qnan, qnan, qnan, qnan}; *(f32x4*)(out + off + bj * HALF + n * 16) = o; }
                if (m & 1) asm volatile("" ::: "memory"); }
    }
};
struct EpiLnResLn {
    static constexpr bool PERM = false, AFTER_DRAIN = true;
    const float* base; float* out; bf16_t* xn; int ldc; const float* bias; PanelStats st1, st2; unsigned poison;
    __device__ __forceinline__ void fused(f32x4 (&acc)[2][2][4][2], const Unit& u, int wr, int wc, int fr, int fq, PG8_LAS unsigned char* lds, int wid, int lane) const {
        typedef float f32x2v __attribute__((ext_vector_type(2))); typedef unsigned u32x2v __attribute__((ext_vector_type(2)));
        const PG8_LAS f32x2v* S = (const PG8_LAS f32x2v*)(lds + 8192);
        const int col0 = u.pn * BM + wc * 32 + 4 * fq;
#pragma unroll
        for (int bj = 0; bj < 2; ++bj)
#pragma unroll
            for (int n = 0; n < 2; ++n) { const f32x4 bv = bias ? *(const f32x4*)(bias + col0 + bj * HALF + n * 16) : (f32x4){0.f, 0.f, 0.f, 0.f};
#pragma unroll
                for (int ai = 0; ai < 2; ++ai)
#pragma unroll
                    for (int m = 0; m < 4; ++m) acc[ai][bj][m][n] += bv; }
        bool bad = st1.run(acc, u, wr, wc, fr, fq, lds, wid, lane) || poison != 0u;
        const float qnan = __builtin_nanf("");
#pragma unroll
        for (int ai = 0; ai < 2; ++ai)
#pragma unroll
            for (int m = 0; m < 4; ++m) { const int r = ai * HALF + wr * 64 + m * 16 + fr; const f32x2v sr = S[r]; const size_t off = (size_t)(u.pm * BM + r) * ldc + col0;
#pragma unroll
                for (int bj = 0; bj < 2; ++bj)
#pragma unroll
                    for (int n = 0; n < 2; ++n) { const f32x4 bs = *(const f32x4*)(base + off + bj * HALF + n * 16); acc[ai][bj][m][n] = bs + (acc[ai][bj][m][n] - sr.x) * sr.y; }
                asm volatile("" : "+v"(acc[ai][0][m][0]), "+v"(acc[ai][0][m][1]), "+v"(acc[ai][1][m][0]), "+v"(acc[ai][1][m][1]));
                if (m & 1) asm volatile("" ::: "memory"); }
        const bool bad1 = bad;
        bad = st2.run(acc, u, wr, wc, fr, fq, lds, wid, lane) || bad;
#pragma unroll
        for (int ai = 0; ai < 2; ++ai)
#pragma unroll
            for (int m = 0; m < 4; ++m) { const int r = ai * HALF + wr * 64 + m * 16 + fr; const f32x2v sr = S[r]; const size_t off = (size_t)(u.pm * BM + r) * ldc + col0;
#pragma unroll
                for (int bj = 0; bj < 2; ++bj)
#pragma unroll
                    for (int n = 0; n < 2; ++n) { const f32x4 x1 = acc[ai][bj][m][n]; *(f32x4*)(out + off + bj * HALF + n * 16) = bad1 ? (f32x4){qnan, qnan, qnan, qnan} : x1;
                        const f32x4 o = (x1 - sr.x) * sr.y; u32x2v w; w.x = cvt_pk_bf16(o[0], o[1]); w.y = cvt_pk_bf16(o[2], o[3]);
                        if (bad) { w.x = 0x7fc07fc0u; w.y = 0x7fc07fc0u; } *(u32x2v*)(xn + off + bj * HALF + n * 16) = w; }
                asm volatile("" ::: "memory"); }
    }
};

template <class Epi, class Sched, bool ALIGN_EPI = false, bool SP2 = false>
__device__ __forceinline__ void gemm_phase(PG8_LAS unsigned char* lds, const Gemm g, const Sched& S, const Epi& E, int wv) {
    int tid0_ = threadIdx.x; asm volatile("" : "+v"(tid0_)); (void)wv;
    const int tid = tid0_, wid = __builtin_amdgcn_readfirstlane(tid >> 6), lane = tid & 63, wr = wid >> 2, wc = wid & 3, fr = lane & 15, fq = lane >> 4;
    const int K = g.K, nt = K / BK;
    unsigned voffA[2], voffB[2];
#pragma unroll
    for (int i = 0; i < 2; ++i) { int R, C; stage_rc(tid * 16 + i * 8192, R, C); const int Rb = Epi::PERM ? ((R & ~31) + perm32(R & 31)) : R;
        voffA[i] = (unsigned)(R * K + C) * 2u; voffB[i] = (unsigned)(Rb * K + C) * 2u; }
    const size_t kstep = (size_t)(BK * 2);
    const size_t hstep = (size_t)HALF * K * 2;
    const size_t tstep = 2 * hstep;
    const unsigned ldsw = (unsigned)wid * 1024u;
    const int aoff = lds_byte(wr * 64 + fr, fq * 8), boff = lds_byte(wc * 32 + fr, fq * 8);
#define PG8_SA(b, h) (((b) * 2 + (h)) * HTB)
#define PG8_SB(b, h) ((4 + (b) * 2 + (h)) * HTB)
#define PG8_STAGE(bufoff, gbase, voff) do { _Pragma("unroll") for (int _i = 0; _i < 2; ++_i) \
        __builtin_amdgcn_global_load_lds((const unsigned*)((const char*)(gbase) + (voff)[_i]), (PG8_LAS unsigned*)(lds + (bufoff) + ldsw + _i * 8192), 16, 0, 0); } while (0)
#define PG8_LDA(dst, b, h) do { _Pragma("unroll") for (int m = 0; m < 4; ++m) _Pragma("unroll") for (int k = 0; k < 2; ++k) dst[m][k] = *(const PG8_LAS bf16x8*)(lds + PG8_SA(b, h) + aoff + m * 2048 + k * 1024); } while (0)
#define PG8_LDB(dst, b, h) do { _Pragma("unroll") for (int n = 0; n < 2; ++n) _Pragma("unroll") for (int k = 0; k < 2; ++k) dst[n][k] = *(const PG8_LAS bf16x8*)(lds + PG8_SB(b, h) + boff + n * 2048 + k * 1024); } while (0)
#define PG8_MMA(ai, bj, At, Bt) do { __builtin_amdgcn_s_setprio(1); _Pragma("unroll") for (int m = 0; m < 4; ++m) _Pragma("unroll") for (int n = 0; n < 2; ++n) _Pragma("unroll") for (int k = 0; k < 2; ++k) \
        acc[ai][bj][m][n] = __builtin_amdgcn_mfma_f32_16x16x32_bf16(Bt[n][k], At[m][k], acc[ai][bj][m][n], 0, 0, 0); __builtin_amdgcn_s_setprio(0); } while (0)
#define PG8_WAIT_V(n) asm volatile("s_waitcnt vmcnt(" #n ")" ::: "memory")
#define PG8_WAIT_L(n) asm volatile("s_waitcnt lgkmcnt(" #n ")" ::: "memory")
#define PG8_BAR __builtin_amdgcn_s_barrier()
#define PG8_SCHED __builtin_amdgcn_sched_barrier(0)
    Unit cur, nxt; int ui = 0;
    if (!S.next(0, cur)) return;
    f32x4 acc[2][2][4][2];
#pragma unroll
    for (int a = 0; a < 2; ++a)
#pragma unroll
        for (int b = 0; b < 2; ++b)
#pragma unroll
            for (int m = 0; m < 4; ++m)
#pragma unroll
                for (int n = 0; n < 2; ++n) acc[a][b][m][n] = (f32x4){0.f, 0.f, 0.f, 0.f};
    bf16x8 At[4][2], B0[2][2], B1[2][2];
    const char* cA = (const char*)g.A + (size_t)cur.pm * tstep; const char* cB = (const char*)g.Bt + (size_t)cur.pn * tstep;
    S.a_ready(cur);
    if constexpr (SP2) {
        PG8_STAGE(PG8_SB(0, 0), cB, voffB); PG8_STAGE(PG8_SB(0, 1), cB + hstep, voffB); PG8_STAGE(PG8_SA(0, 0), cA, voffA); PG8_STAGE(PG8_SA(0, 1), cA + hstep, voffA);
        if (wr == 1) PG8_BAR;
        PG8_WAIT_V(2); PG8_BAR;
        PG8_STAGE(PG8_SB(1, 0), cB + kstep, voffB); PG8_STAGE(PG8_SA(1, 0), cA + kstep, voffA); PG8_STAGE(PG8_SB(1, 1), cB + hstep + kstep, voffB);
        PG8_WAIT_V(6); PG8_BAR;
    } else {
        PG8_STAGE(PG8_SB(0, 0), cB, voffB); PG8_STAGE(PG8_SA(0, 0), cA, voffA); PG8_STAGE(PG8_SB(0, 1), cB + hstep, voffB); PG8_STAGE(PG8_SA(0, 1), cA + hstep, voffA);
        if (wr == 1) PG8_BAR;
        PG8_WAIT_V(4); PG8_BAR;
        PG8_STAGE(PG8_SB(1, 0), cB + kstep, voffB); PG8_STAGE(PG8_SA(1, 0), cA + kstep, voffA); PG8_STAGE(PG8_SB(1, 1), cB + hstep + kstep, voffB);
        PG8_WAIT_V(6); PG8_BAR;
    }
    for (;;) {
        const bool has_next = S.next(ui + 1, nxt);
        const char* nA = has_next ? (const char*)g.A + (size_t)nxt.pm * tstep : cA; const char* nB = has_next ? (const char*)g.Bt + (size_t)nxt.pn * tstep : cB;
        for (int t = 0; t < nt; t += 2) {
            const bool last = (t == nt - 2);
            const char* a1 = cA + (size_t)(t + 1) * kstep;
            const char* a2 = last ? nA : cA + (size_t)(t + 2) * kstep; const char* b2 = last ? nB : cB + (size_t)(t + 2) * kstep;
            const char* a3 = a2 + kstep; const char* b3 = b2 + kstep;
            if (last && has_next) S.a_ready(nxt);
            if constexpr (SP2) {
            PG8_LDB(B0, 0, 0); PG8_LDB(B1, 0, 1); PG8_SCHED; PG8_LDA(At, 0, 0); PG8_STAGE(PG8_SA(1, 1), a1 + hstep, voffA);
            PG8_WAIT_V(8); PG8_WAIT_L(0); PG8_BAR; PG8_MMA(0, 0, At, B0); PG8_MMA(0, 1, At, B1); PG8_BAR; PG8_SCHED;
            PG8_LDA(At, 0, 1); PG8_STAGE(PG8_SB(0, 0), b2, voffB); PG8_STAGE(PG8_SB(0, 1), b2 + hstep, voffB); PG8_STAGE(PG8_SA(0, 0), a2, voffA);
            PG8_WAIT_V(8); PG8_WAIT_L(0); PG8_BAR; PG8_MMA(1, 0, At, B0); PG8_MMA(1, 1, At, B1); PG8_BAR; PG8_SCHED;
            PG8_LDB(B0, 1, 0); PG8_LDB(B1, 1, 1); PG8_SCHED; PG8_LDA(At, 1, 0); PG8_STAGE(PG8_SA(0, 1), a2 + hstep, voffA);
            PG8_WAIT_V(8); PG8_WAIT_L(0); PG8_BAR; PG8_MMA(0, 0, At, B0); PG8_MMA(0, 1, At, B1); PG8_BAR; PG8_SCHED;
            PG8_LDA(At, 1, 1); PG8_STAGE(PG8_SB(1, 0), b3, voffB); PG8_STAGE(PG8_SB(1, 1), b3 + hstep, voffB); PG8_STAGE(PG8_SA(1, 0), a3, voffA);
            PG8_WAIT_V(8); PG8_WAIT_L(0); PG8_BAR; PG8_MMA(1, 0, At, B0); PG8_MMA(1, 1, At, B1); PG8_BAR; PG8_SCHED;
            } else {
            PG8_LDB(B0, 0, 0); PG8_SCHED; PG8_LDA(At, 0, 0); PG8_STAGE(PG8_SA(1, 1), a1 + hstep, voffA);
            PG8_WAIT_L(8); PG8_BAR; PG8_WAIT_L(0); PG8_MMA(0, 0, At, B0); PG8_BAR; PG8_SCHED;
            PG8_LDB(B1, 0, 1); PG8_STAGE(PG8_SB(0, 0), b2, voffB);
            PG8_BAR; PG8_WAIT_L(0); PG8_MMA(0, 1, At, B1); PG8_BAR;
            PG8_LDA(At, 0, 1); PG8_STAGE(PG8_SA(0, 0), a2, voffA);
            PG8_BAR; PG8_WAIT_L(0); PG8_MMA(1, 0, At, B0); PG8_BAR; PG8_SCHED;
            PG8_STAGE(PG8_SB(0, 1), b2 + hstep, voffB);
            PG8_WAIT_V(6); PG8_BAR; PG8_MMA(1, 1, At, B1); PG8_BAR;
            PG8_LDB(B0, 1, 0); PG8_SCHED; PG8_LDA(At, 1, 0); PG8_STAGE(PG8_SA(0, 1), a2 + hstep, voffA);
            PG8_WAIT_L(8); PG8_BAR; PG8_WAIT_L(0); PG8_MMA(0, 0, At, B0); PG8_BAR; PG8_SCHED;
            PG8_LDB(B1, 1, 1); PG8_STAGE(PG8_SB(1, 0), b3, voffB);
            PG8_BAR; PG8_WAIT_L(0); PG8_MMA(0, 1, At, B1); PG8_BAR;
            PG8_LDA(At, 1, 1); PG8_STAGE(PG8_SA(1, 0), a3, voffA);
            PG8_BAR; PG8_WAIT_L(0); PG8_MMA(1, 0, At, B0); PG8_BAR; PG8_SCHED;
            PG8_STAGE(PG8_SB(1, 1), b3 + hstep, voffB);
            PG8_WAIT_V(6); PG8_BAR; PG8_MMA(1, 1, At, B1); PG8_BAR;
            }
        }
        if constexpr (ALIGN_EPI) { if (wr == 0) PG8_BAR; }
        if constexpr (!Epi::AFTER_DRAIN) { E(acc, cur, wr, wc, fr, fq); S.done(cur); }
        if (!has_next) break;
#pragma unroll
        for (int a = 0; a < 2; ++a)
#pragma unroll
            for (int b = 0; b < 2; ++b)
#pragma unroll
                for (int m = 0; m < 4; ++m)
#pragma unroll
                    for (int n = 0; n < 2; ++n) acc[a][b][m][n] = (f32x4){0.f, 0.f, 0.f, 0.f};
        cur = nxt; cA = nA; cB = nB; ++ui;
        if constexpr (ALIGN_EPI) { if (wr == 1) PG8_BAR; }
    }
    PG8_WAIT_V(0);
    if constexpr (!ALIGN_EPI) { if (wr == 0) PG8_BAR; }
    PG8_BAR;
    if constexpr (Epi::AFTER_DRAIN) { E.fused(acc, cur, wr, wc, fr, fq, lds, wid, lane); S.done(cur); }
#undef PG8_SA
#undef PG8_SB
#undef PG8_STAGE
#undef PG8_LDA
#undef PG8_LDB
#undef PG8_MMA
#undef PG8_WAIT_V
#undef PG8_WAIT_L
#undef PG8_BAR
#undef PG8_SCHED
}
}

#ifndef PG8_SP2
#define PG8_SP2 true
#endif
#ifndef PG8_ALIGN
#define PG8_ALIGN true
#endif
#define GAS __attribute__((address_space(1)))
#define LAS __attribute__((address_space(3)))
#define XB_TMO      128
#define XB_XCNT(j)  (256  + 64 * (j))
#define XB_XSUB(j)  (1280 + 64 * (j))
#define XB_XGEN(j)  (2304 + 64 * (j))
#define XB_TOP      3328
#define XB_TOPGEN   3392
#define XCD_BAR_WORDS 3456
#define XB_SPIN_CAP (1u << 18)

__device__ __forceinline__ unsigned xb_ld(unsigned* p)              { return __hip_atomic_load(p, __ATOMIC_RELAXED, __HIP_MEMORY_SCOPE_AGENT); }
__device__ __forceinline__ unsigned xb_add(unsigned* p, unsigned v) { return __hip_atomic_fetch_add(p, v, __ATOMIC_RELAXED, __HIP_MEMORY_SCOPE_AGENT); }
__device__ __forceinline__ unsigned xb_xcc_id() { return (unsigned)__builtin_amdgcn_s_getreg((3 << 11) | 20) & 0xFu; }
#define XB_SPIN(cond, bar) do { unsigned _sp = 0; while (cond) { __builtin_amdgcn_s_sleep(1); \
    if ((++_sp & 255u) == 0u) { if (xb_ld(&(bar)[XB_TMO])) break; if (_sp > XB_SPIN_CAP) { atomicAdd(&(bar)[XB_TMO], 1u); break; } } } } while (0)

struct XcdBarrier {
    unsigned* bar; unsigned x;
    volatile LAS unsigned* st;
    int wv;
};

__device__ __forceinline__ XcdBarrier xcd_barrier_post(unsigned* bar, volatile LAS unsigned* st) {
    XcdBarrier b; b.bar = bar; b.x = xb_xcc_id(); b.st = st;
    if (threadIdx.x == 0) (void)xb_add(&bar[XB_XCNT(b.x)], 1u);
    return b;
}
__device__ __forceinline__ void xcd_barrier_complete(unsigned* bar, unsigned x, unsigned& nloc, unsigned& nx) {
    asm volatile("" : "+s"(x));
    const unsigned G = gridDim.x * gridDim.y * gridDim.z;
    unsigned sum, cnt, mine, sp = 0u;
    for (;;) {
        sum = 0u; cnt = 0u; mine = 0u;
#pragma unroll
        for (unsigned j = 0; j < 16; ++j) { const unsigned c = xb_ld(&bar[XB_XCNT(j)]); sum += c; cnt += (c > 0u) ? 1u : 0u; mine = (j == x) ? c : mine; }
        if (sum == G) break;
        __builtin_amdgcn_s_sleep(1);
        if ((++sp & 255u) == 0u) { if (xb_ld(&bar[XB_TMO])) break; if (sp > XB_SPIN_CAP) { atomicAdd(&bar[XB_TMO], 1u); break; } }
    }
    nloc = mine > 0u ? mine : 1u; nx = cnt > 0u ? cnt : 1u;
}

__device__ __forceinline__ void xcd_barrier(const XcdBarrier& b) {
    asm volatile("s_waitcnt vmcnt(0)" ::: "memory");
    __syncthreads();
    if (threadIdx.x == 0) {
        unsigned* bar = b.bar; asm volatile("" : "+s"(bar));
        __builtin_amdgcn_s_waitcnt(0);
        unsigned nloc = b.st[0], nx = b.st[1];
        if (nloc == 0u) { xcd_barrier_complete(bar, b.x, nloc, nx); b.st[0] = nloc; b.st[1] = nx; }
        const unsigned old = xb_add(&bar[XB_XSUB(b.x)], 1u);
        const unsigned gen = old / nloc;
        if (old + 1u == (gen + 1u) * nloc) {
            __builtin_amdgcn_fence(__ATOMIC_RELEASE, "agent");
            asm volatile("s_waitcnt vmcnt(0)" ::: "memory");
            const unsigned og = xb_add(&bar[XB_TOP], 1u);
            const unsigned tg = og / nx;
            if (og + 1u == (tg + 1u) * nx) xb_add(&bar[XB_TOPGEN], 1u);
            else XB_SPIN(xb_ld(&bar[XB_TOPGEN]) == tg, bar);
            __builtin_amdgcn_fence(__ATOMIC_ACQUIRE, "agent");
            xb_add(&bar[XB_XGEN(b.x)], 1u);
            asm volatile("s_waitcnt vmcnt(0)" ::: "memory");
        } else {
            XB_SPIN(xb_ld(&bar[XB_XGEN(b.x)]) == gen, bar);
            __builtin_amdgcn_fence(__ATOMIC_ACQUIRE, "agent");
            asm volatile("s_waitcnt vmcnt(0)" ::: "memory");
        }
    }
    __syncthreads();
}
namespace dattn {
constexpr int D = 128, QST = 2048, KVS = 512, OST = 2048, MTW = 68, JLO = 3;
constexpr float THR = 8.f; constexpr bool WSKIP = false;
typedef unsigned short bf16;
constexpr float SCALE = 1.0f;
constexpr int NW = 8, QBLK = 32, KVBLK = 64, QB = NW * QBLK;
constexpr int SHM_V = KVBLK * D * 2, SHM_K = KVBLK * D * 2;
constexpr int LDS_BYTES = 2 * SHM_V + 2 * SHM_K + NW * 64 * 4;

typedef short bf16x8 __attribute__((ext_vector_type(8)));
typedef short s16x4 __attribute__((ext_vector_type(4)));
typedef float f32x16 __attribute__((ext_vector_type(16)));
typedef float f32x4 __attribute__((ext_vector_type(4)));
typedef unsigned u32x4 __attribute__((ext_vector_type(4)));
template <class A, class Bt> struct same_t { static constexpr bool v = false; };
template <class A> struct same_t<A, A> { static constexpr bool v = true; };

#define KSWZ(row, colB) ((row) * 256 + ((colB) ^ (((row) & 7) << 4)))
#define SBAR() __builtin_amdgcn_sched_barrier(0)
__device__ __forceinline__ int v_st(int k, int c) { const int kk = (k & ~0xC) | ((k & 4) << 1) | ((k & 8) >> 1); return ((kk >> 3) * 4 + (c >> 5)) * 512 + ((kk & 7) * 32 + (c & 31)) * 2; }
__device__ __forceinline__ int v_rd_base(int lane) { return ((lane & 3) << 3) | (((lane >> 2) & 3) << 6) | (((lane >> 4) & 1) << 5) | (((lane >> 5) & 1) << 8); }
constexpr int v_rd_off(int d0, int ks, int half) { return d0 * 512 + ks * 4096 + half * 2048; }
__device__ __forceinline__ int crow(int r, int hi) { return (r & 3) + 8 * (r >> 2) + 4 * hi; }
__device__ __forceinline__ unsigned cvtpk(float lo, float hi) {
    unsigned r; asm volatile("v_cvt_pk_bf16_f32 %0, %1, %2" : "=v"(r) : "v"(lo), "v"(hi)); return r;
}
__device__ __forceinline__ bf16x8 pack8(f32x4 a, f32x4 b) {
    u32x4 w = {cvtpk(a[0], a[1]), cvtpk(a[2], a[3]), cvtpk(b[0], b[1]), cvtpk(b[2], b[3])};
    return *reinterpret_cast<bf16x8*>(&w);
}
template <class T> __device__ __forceinline__ bf16x8 load8(const T* p) {
    if constexpr (same_t<T, float>::v) { return pack8(*(const f32x4*)p, *(const f32x4*)(p + 4)); }
    else { return *reinterpret_cast<const bf16x8*>(p); }
}
__device__ __forceinline__ void mask_tile(f32x16& p0, f32x16& p1, int dq, unsigned W) {
    const float NEG = -__builtin_inff();
#pragma unroll
    for (int r = 0; r < 16; ++r) {
        const int c = (r & 3) + 8 * (r >> 2);
        if ((unsigned)(dq - c) >= W) p0[r] = NEG;
        if ((unsigned)(dq - c - 32) >= W) p1[r] = NEG;
    }
}
__device__ __forceinline__ void mask_bits(f32x16& p0, f32x16& p1, unsigned long long mw, int hi) {
    const float NEG = -__builtin_inff();
    const unsigned lo = (unsigned)(mw >> (4 * hi)), up = (unsigned)(mw >> (32 + 4 * hi));
#pragma unroll
    for (int r = 0; r < 16; ++r) {
        const int c = (r & 3) + 8 * (r >> 2);
        if (!((lo >> c) & 1u)) p0[r] = NEG;
        if (!((up >> c) & 1u)) p1[r] = NEG;
    }
}
__device__ __forceinline__ void partialSM(f32x16& p0, f32x16& p1, float& m_reg, float& mn, float& alpha) {
    float pmax = p0[0]; for (int r = 1; r < 16; ++r) pmax = fmaxf(pmax, p0[r]); for (int r = 0; r < 16; ++r) pmax = fmaxf(pmax, p1[r]);
    { auto rr = __builtin_amdgcn_permlane32_swap(__float_as_uint(pmax), __float_as_uint(pmax), false, false);
      pmax = fmaxf(__uint_as_float(rr[0]), __uint_as_float(rr[1])); }
    constexpr float C2 = 1.4426950408889634f * SCALE;
    if (__builtin_expect(__all((pmax - m_reg) * SCALE <= THR), 1)) { mn = m_reg; alpha = 1.f; }
    else { mn = fmaxf(m_reg, pmax); alpha = __builtin_amdgcn_exp2f((m_reg - mn) * C2); m_reg = mn; }
    const float mnL = -mn * C2;
    for (int r = 0; r < 16; ++r) p0[r] = fmaf(p0[r], C2, mnL); for (int r = 0; r < 16; ++r) p1[r] = fmaf(p1[r], C2, mnL);
    for (int r = 0; r < 16; ++r) p0[r] = __builtin_amdgcn_exp2f(p0[r]);
}
__device__ __forceinline__ void finishSM(f32x16& p0, f32x16& p1, float alpha, float& l_reg, bf16x8& pa0, bf16x8& pa1, bf16x8& pa2, bf16x8& pa3) {
    for (int r = 0; r < 16; ++r) p1[r] = __builtin_amdgcn_exp2f(p1[r]);
    float ps = 0; for (int r = 0; r < 16; ++r) ps += p0[r]; for (int r = 0; r < 16; ++r) ps += p1[r];
    { auto rr = __builtin_amdgcn_permlane32_swap(__float_as_uint(ps), __float_as_uint(ps), false, false);
      ps = __uint_as_float(rr[0]) + __uint_as_float(rr[1]); }
    l_reg = l_reg * alpha + ps;
#define PK4(P, B_, OUT) do { unsigned a0 = cvtpk(P[B_+0], P[B_+1]), a1 = cvtpk(P[B_+2], P[B_+3]);                          \
        unsigned b0 = cvtpk(P[B_+4], P[B_+5]), b1 = cvtpk(P[B_+6], P[B_+7]);                                             \
        auto r0 = __builtin_amdgcn_permlane32_swap(a0, b0, false, false); auto r1 = __builtin_amdgcn_permlane32_swap(a1, b1, false, false); \
        u32x4 w = {r0[0], r1[0], r0[1], r1[1]}; OUT = *reinterpret_cast<bf16x8*>(&w); } while (0)
    PK4(p0, 0, pa0); PK4(p0, 8, pa1); PK4(p1, 0, pa2); PK4(p1, 8, pa3);
#undef PK4
}
template <int KB, bool SK>
__device__ __forceinline__ void qkt(f32x16& p0, f32x16& p1, const char* K_lds, int r32, int hi, const bf16x8* qr, bool act) {
    if (SK && !act) { const float NEG = -__builtin_inff();
#pragma unroll
        for (int r = 0; r < 16; ++r) { p0[r] = NEG; p1[r] = NEG; } return; }
    p0 = f32x16{}; p1 = f32x16{};
    const char* kb[4];
#pragma unroll
    for (int dd = 0; dd < 4; ++dd) kb[dd] = K_lds + KB * SHM_K + KSWZ(r32, (dd * 16 + hi * 8) * 2);
#pragma unroll
    for (int d0 = 0; d0 < 8; ++d0) { const char* a = kb[d0 & 3] + (d0 >> 2) * 128;
        bf16x8 b0 = *reinterpret_cast<const bf16x8*>(a);
        bf16x8 b1 = *reinterpret_cast<const bf16x8*>(a + 32 * 256);
        p0 = __builtin_amdgcn_mfma_f32_32x32x16_bf16(b0, qr[d0], p0, 0, 0, 0);
        p1 = __builtin_amdgcn_mfma_f32_32x32x16_bf16(b1, qr[d0], p1, 0, 0, 0); }
}
template <int VB, bool SK>
__device__ __forceinline__ void pv_tile(f32x16* o, int vb0, bf16x8 pa0, bf16x8 pa1, bf16x8 pa2, bf16x8 pa3, bool act) {
    if (SK && !act) return;
#define TRRD(dst, off) asm volatile("ds_read_b64_tr_b16 %0, %1 offset:%2" : "=&v"(dst) : "v"(vb0), "i"(off) : "memory")
#define PV_D0(d0) do { s16x4 l0, l1, l2, l3, h0, h1, h2, h3; constexpr int b_ = VB * SHM_V + v_rd_off(d0, 0, 0);     \
        TRRD(l0, b_); TRRD(h0, b_ + 2048); TRRD(l1, b_ + 4096); TRRD(h1, b_ + 6144); TRRD(l2, b_ + 8192); TRRD(h2, b_ + 10240); TRRD(l3, b_ + 12288); TRRD(h3, b_ + 14336); \
        asm volatile("s_waitcnt lgkmcnt(0)" ::: "memory"); SBAR();                 \
        o[d0] = __builtin_amdgcn_mfma_f32_32x32x16_bf16(pa0, (bf16x8){l0[0], l0[1], l0[2], l0[3], h0[0], h0[1], h0[2], h0[3]}, o[d0], 0, 0, 0);   \
        o[d0] = __builtin_amdgcn_mfma_f32_32x32x16_bf16(pa1, (bf16x8){l1[0], l1[1], l1[2], l1[3], h1[0], h1[1], h1[2], h1[3]}, o[d0], 0, 0, 0);   \
        o[d0] = __builtin_amdgcn_mfma_f32_32x32x16_bf16(pa2, (bf16x8){l2[0], l2[1], l2[2], l2[3], h2[0], h2[1], h2[2], h2[3]}, o[d0], 0, 0, 0);   \
        o[d0] = __builtin_amdgcn_mfma_f32_32x32x16_bf16(pa3, (bf16x8){l3[0], l3[1], l3[2], l3[3], h3[0], h3[1], h3[2], h3[3]}, o[d0], 0, 0, 0); } while (0)
    PV_D0(0); PV_D0(1); PV_D0(2); PV_D0(3);
#undef PV_D0
#undef TRRD
}

template <class TIn, class TOut> struct BlockRef { const TIn* Q; const TIn* K; const TIn* V; TOut* O; const unsigned long long* M; int P0; };
template <class TIn> struct Seam {
    bf16x8 qr[8];
    bf16x8 st_v0, st_v1, st_k0, st_k1; f32x4 sf0, sf1, sf2, sf3;
    f32x4 tq[16];
};
__device__ __forceinline__ int swa_jlo(int, int) { return JLO; }
#define ROW(p, k0, rr) ((p) + (size_t)((k0) + (rr)) * KVS + sc)
#define VMW() asm volatile("s_waitcnt vmcnt(0)" ::: "memory")
#define VMWN(n) asm volatile("s_waitcnt vmcnt(%0)" :: "i"(n) : "memory")
#define SLOAD_H(Kp, Vp, k0) do { S.st_v0 = load8<TIn>(ROW(Vp, k0, sr)); S.st_v1 = load8<TIn>(ROW(Vp, k0, 32 + sr));              \
                         S.st_k0 = load8<TIn>(ROW(Kp, k0, sr)); S.st_k1 = load8<TIn>(ROW(Kp, k0, 32 + sr)); } while (0)
#define SWRITE_HK(bf) do { *(bf16x8*)(K_lds + (bf) * SHM_K + kws) = S.st_k0; *(bf16x8*)(K_lds + (bf) * SHM_K + kws + 32 * 256) = S.st_k1; } while (0)
#define SWRITE_HV(bf) do { *(bf16x8*)(V_lds + (bf) * SHM_V + vst0) = S.st_v0; *(bf16x8*)(V_lds + (bf) * SHM_V + vst1) = S.st_v1; } while (0)
#define SWRITE_H(bf) do { SWRITE_HV(bf); SWRITE_HK(bf); } while (0)
#define SLOAD_F(p, k0) do { S.sf0 = *(const f32x4*)ROW(p, k0, sr); S.sf1 = *(const f32x4*)(ROW(p, k0, sr) + 4);                \
                            S.sf2 = *(const f32x4*)ROW(p, k0, 32 + sr); S.sf3 = *(const f32x4*)(ROW(p, k0, 32 + sr) + 4); } while (0)
#define SWRITE_KF(bf) do { *(bf16x8*)(K_lds + (bf) * SHM_K + kws) = pack8(S.sf0, S.sf1); *(bf16x8*)(K_lds + (bf) * SHM_K + kws + 32 * 256) = pack8(S.sf2, S.sf3); } while (0)
#define SWRITE_VF(bf) do { *(bf16x8*)(V_lds + (bf) * SHM_V + vst0) = pack8(S.sf0, S.sf1); *(bf16x8*)(V_lds + (bf) * SHM_V + vst1) = pack8(S.sf2, S.sf3); } while (0)
template <class TIn, class TOut>
__device__ __forceinline__ void causal_swa_prime(const BlockRef<TIn, TOut>& cur, int W, char* lds, Seam<TIn>& S, int wv) {
    constexpr bool F32 = same_t<TIn, float>::v;
    int tid0_ = threadIdx.x; asm volatile("" : "+v"(tid0_)); (void)wv;
    const int tid = tid0_, wid = __builtin_amdgcn_readfirstlane(tid >> 6), lane = tid & 63, r32 = lane & 31, hi = lane >> 5;
    const int sr = tid >> 4, sc = (tid & 15) * 8, kws = KSWZ(sr, sc * 2); char* K_lds = lds + 2 * SHM_V;
    const int kb0 = swa_jlo(cur.P0, W) * KVBLK;
    for (int d0 = 0; d0 < 8; ++d0) S.qr[d0] = load8<TIn>(cur.Q + (size_t)(wid * QBLK + r32) * QST + d0 * 16 + hi * 8);
    if constexpr (F32) { SLOAD_F((const float*)cur.K, kb0); VMW(); SWRITE_KF(0); SBAR(); SLOAD_F((const float*)cur.V, kb0); }
    else { SLOAD_H(cur.K, cur.V, kb0); VMW(); SWRITE_HK(0); }
    __syncthreads();
}
template <class TIn, class TOut>
__device__ __forceinline__ void causal_swa_block(const BlockRef<TIn, TOut>& cur, const BlockRef<TIn, TOut>& nxt, int skv, int W, char* lds, Seam<TIn>& S, int wv) {
    constexpr bool F32 = same_t<TIn, float>::v;
    int tid0_ = threadIdx.x; asm volatile("" : "+v"(tid0_)); (void)wv;
    const int tid = tid0_, wid = __builtin_amdgcn_readfirstlane(tid >> 6), lane = tid & 63, r32 = lane & 31, hi = lane >> 5;
    const int j_lo = swa_jlo(cur.P0, W);
    int j_hi = (cur.P0 + QB - 1) / KVBLK + 1; if (j_hi > skv / KVBLK) j_hi = skv / KVBLK;
    const int NT = j_hi - j_lo;
    const int kbn = swa_jlo(nxt.P0, W) * KVBLK;
    const int qlo = cur.P0 + wid * QBLK; (void)qlo;
    const unsigned long long* mrow = cur.M + (size_t)(wid * QBLK + r32) * MTW;
    const int qm_unused = 0; (void)qm_unused;
    char* V_lds = lds; char* K_lds = lds + 2 * SHM_V;
    float* ws = (float*)(lds + 2 * SHM_V + 2 * SHM_K) + wid * 64; float* li_l = ws, * al_l = ws + 32;
    float m_reg = -1e30f, l_reg = 0; f32x16 o[4] = {};
    const int sr = tid >> 4, sc = (tid & 15) * 8, vst0 = v_st(sr, sc), vst1 = v_st(32 + sr, sc), kws = KSWZ(sr, sc * 2);
    const int vb0 = (int)(uintptr_t)V_lds + v_rd_base(lane);
    const TIn* Kh = cur.K; const TIn* Vh = cur.V;
#define RESC(a) do { if (__any((a) < 1.f)) { if (hi == 0) al_l[r32] = (a); asm volatile("s_waitcnt lgkmcnt(0)" ::: "memory");              \
                     for (int d_ = 0; d_ < 4; ++d_) for (int r = 0; r < 16; ++r) o[d_][r] *= al_l[crow(r, hi)]; } } while (0)
#define KBASE(t) ((j_lo + (t)) * KVBLK)
#define ACT(t) (KBASE(t) <= qlo + QBLK - 1 && KBASE(t) + KVBLK - 1 >= qlo - W + 1)
#define MASKT(P0_, P1_, t) mask_bits(P0_, P1_, (((t) & 1) ? mwB : mwA), hi)
#define MWLOAD(t) do { const int tt_ = (t) < NT ? (t) : NT - 1; if ((t) & 1) mwB = mrow[j_lo + tt_]; else mwA = mrow[j_lo + tt_]; } while (0)
    constexpr int NQL = F32 ? 16 : 8;
    constexpr bool SK = WSKIP && !F32;
#define SEAM_K0() do { VMWN(NQL); if constexpr (F32) { SWRITE_KF(0); SBAR(); SLOAD_F((const float*)nxt.V, kbn); } else { SWRITE_HK(0); } SBAR(); } while (0)
    f32x16 pA0, pA1, pB0, pB1; float mnA, mnB, alA, alB; bf16x8 pa0, pa1, pa2, pa3;
    unsigned long long mwA = mrow[j_lo], mwB = mrow[j_lo + (NT > 1 ? 1 : 0)];
    if constexpr (F32) { VMW(); SWRITE_VF(0); SBAR(); } else { SWRITE_HV(0); SBAR(); }
    if (NT > 1) { if constexpr (F32) SLOAD_F((const float*)Kh, KBASE(1)); else SLOAD_H(Kh, Vh, KBASE(1)); }
    SBAR(); qkt<0, SK>(pA0, pA1, K_lds, r32, hi, S.qr, ACT(0));
    if constexpr (F32) { if (NT > 1) { VMW(); SWRITE_KF(1); SBAR(); SLOAD_F((const float*)Vh, KBASE(1)); } }
    MASKT(pA0, pA1, 0); MWLOAD(2); partialSM(pA0, pA1, m_reg, mnA, alA);
    if (NT > 1) { VMW(); if constexpr (F32) { SWRITE_VF(1); SBAR(); if (NT > 2) SLOAD_F((const float*)Kh, KBASE(2)); } else SWRITE_H(1); }
    __syncthreads();
#define HALF_STEP(PX0, PX1, mnX, alX, PY0, PY1, alY, t, KB, VB, SB) do {                                                      \
        SBAR(); qkt<KB, SK>(PX0, PX1, K_lds, r32, hi, S.qr, ACT(t));                                             \
        finishSM(PY0, PY1, alY, l_reg, pa0, pa1, pa2, pa3); SBAR();                                                           \
        if ((t) + 1 < NT) { if constexpr (F32) { VMW(); SWRITE_KF(SB); SBAR(); SLOAD_F((const float*)Vh, KBASE((t) + 1)); }  \
                            else { SLOAD_H(Kh, Vh, KBASE((t) + 1)); } SBAR(); }                                               \
        pv_tile<VB, SK>(o, vb0, pa0, pa1, pa2, pa3, ACT((t) - 1)); MASKT(PX0, PX1, (t)); MWLOAD((t) + 2); partialSM(PX0, PX1, m_reg, mnX, alX);                                        \
        __syncthreads();                                                                                                      \
        if ((t) + 1 < NT) { VMW(); if constexpr (F32) { SWRITE_VF(SB); SBAR(); if ((t) + 2 < NT) SLOAD_F((const float*)Kh, KBASE((t) + 2)); } \
                            else { SWRITE_H(SB); } }                                                                          \
        RESC(alX); __syncthreads(); } while (0)
    for (int t = 1; t + 1 < NT; t += 2) {
        HALF_STEP(pB0, pB1, mnB, alB, pA0, pA1, alA, t, 1, 0, 0);
        HALF_STEP(pA0, pA1, mnA, alA, pB0, pB1, alB, t + 1, 0, 1, 1);
    }
    const bool even = (NT & 1) == 0;
    if (even) { SBAR(); qkt<1, SK>(pB0, pB1, K_lds, r32, hi, S.qr, ACT(NT - 1)); SBAR(); }
#define QROW(e) (nxt.Q + (size_t)(wid * QBLK + r32) * QST + ((e) >> 1) * 16 + hi * 8 + ((e) & 1) * 4)
    if constexpr (F32) { SLOAD_F((const float*)nxt.K, kbn); SBAR();
#pragma unroll
        for (int e = 0; e < 8; ++e) S.tq[e] = *(const f32x4*)QROW(e); }
    else { SLOAD_H(nxt.K, nxt.V, kbn); SBAR();
#pragma unroll
        for (int d0 = 0; d0 < 8; ++d0) S.qr[d0] = load8<TIn>(nxt.Q + (size_t)(wid * QBLK + r32) * QST + d0 * 16 + hi * 8); }
    SBAR();
    finishSM(pA0, pA1, alA, l_reg, pa0, pa1, pa2, pa3); SBAR();
    if constexpr (F32) {
#pragma unroll
        for (int e = 8; e < 16; ++e) S.tq[e] = *(const f32x4*)QROW(e); SBAR(); }
#undef QROW
    pv_tile<0, SK>(o, vb0, pa0, pa1, pa2, pa3, ACT(even ? NT - 2 : NT - 1));
    if (even) { MASKT(pB0, pB1, NT - 1); partialSM(pB0, pB1, m_reg, mnB, alB); __syncthreads(); RESC(alB);
        finishSM(pB0, pB1, alB, l_reg, pa0, pa1, pa2, pa3); SBAR(); pv_tile<1, SK>(o, vb0, pa0, pa1, pa2, pa3, ACT(NT - 1)); }
    SBAR(); SEAM_K0();
    if (hi == 0) li_l[r32] = l_reg; asm volatile("s_waitcnt lgkmcnt(0)" ::: "memory");
    float rli[16];
#pragma unroll
    for (int r = 0; r < 16; ++r) rli[r] = __builtin_amdgcn_rcpf(li_l[crow(r, hi)]);
    TOut* Ow = cur.O + (size_t)(wid * QBLK) * OST;
#pragma unroll
    for (int r = 0; r < 16; ++r) { const int orow = crow(r, hi);
#pragma unroll
        for (int d0 = 0; d0 < 4; ++d0) { const float v = o[d0][r] * rli[r];
            if constexpr (same_t<TOut, float>::v) { Ow[(size_t)orow * OST + d0 * 32 + r32] = v; }
            else { const float vn = __shfl_xor(v, 1);
                   if ((r32 & 1) == 0) *(unsigned*)(Ow + (size_t)orow * OST + d0 * 32 + r32) = cvtpk(v, vn); } } }
    if constexpr (F32) {
#pragma unroll
        for (int d0 = 0; d0 < 8; ++d0) S.qr[d0] = pack8(S.tq[2 * d0], S.tq[2 * d0 + 1]); }
    __syncthreads();
#undef RESC
#undef KBASE
#undef ACT
#undef MASKT
#undef MWLOAD
#undef SEAM_K0
#undef HALF_STEP
}
#undef ROW
#undef VMW
#undef VMWN
#undef SLOAD_H
#undef SWRITE_HK
#undef SWRITE_HV
#undef SWRITE_H
#undef SLOAD_F
#undef SWRITE_KF
#undef SWRITE_VF

}

constexpr int NWAVES = 8, NTHREADS = 512;
constexpr int DM = 2048, SEQ = 4096, NMETA = 16, TP = 4112, NBP = 2, SBN = 8, PAST = 16384, NPG = 128;
constexpr int XROW0 = 8192, SROW0 = 8224, NROWS = 8232, MPAD = 8448, FF = 8192, MAINM = 8192, XR = 48;
constexpr int NA_IN = 6144, NB_IN = 4176, NB_PAD = 4352, NC_IN = 12352, NC_PAD = 12544, DVW = 4096, CDIM = 8192;
constexpr float ALPHA = 1.6817928305074292f;
constexpr float LN_EPS = 1e-5f, RMS_EPS = 1e-6f;
constexpr int SCW = 4160, SCSW = 16448, KIROWS = 4128, NSKEY = PAST + 1;
constexpr int POS_SAMPLE_IDX = TP;

constexpr size_t O_YP = 0, O_YS = O_YP + (size_t)NBP * SEQ * DM, O_CAP = O_YS + (size_t)SBN * DM, O_CAS = O_CAP + 2 * NBP * 2 * DM,
                 O_KP = O_CAS + 2 * SBN * 2 * DM, O_VP = O_KP + (size_t)NBP * TP * 512, O_IKP = O_VP + (size_t)NBP * TP * 512,
                 O_KS = O_IKP + (size_t)NBP * TP * 64, O_VS = O_KS + SBN * 512, O_IKS = O_VS + SBN * 512, O_CCP = O_IKS + SBN * 64,
                 O_CCS = O_CCP + (size_t)NBP * 3 * CDIM, O_DP = O_CCS + (size_t)SBN * 3 * CDIM, O_DS = O_DP + (size_t)NBP * 32 * 128 * 128,
                 O_END = O_DS + (size_t)SBN * 32 * 128 * 128;

constexpr size_t MiB = 1u << 20;
constexpr size_t WS_CTL = 0, CTL_ZERO_BYTES = 1 * MiB;
constexpr size_t WS_TAB128 = 1 * MiB, WS_TAB64 = 4 * MiB, WS_WI = 6 * MiB, WS_G = 7 * MiB, WS_BETA = 9 * MiB, WS_CNT = 11 * MiB, WS_KIB = 12 * MiB,
                 WS_SCS = 14 * MiB, WS_IDXL = 16 * MiB, WS_X = 26 * MiB, WS_QR = 60 * MiB, WS_QI = 94 * MiB, WS_Z = 112 * MiB, WS_Y = 180 * MiB,
                 WS_BIG = 248 * MiB, WS_QKVC = 452 * MiB, WS_SC = 584 * MiB, WS_W = 716 * MiB;
constexpr size_t WSZ_A_IN = (size_t)NA_IN * DM * 2, WSZ_A_OUT = (size_t)DM * DM * 2, WSZ_B_IN = (size_t)NB_PAD * DM * 2, WSZ_B_OUT = (size_t)DM * DM * 2,
                 WSZ_C_IN = (size_t)NC_PAD * DM * 2, WSZ_C_OUT = (size_t)DM * DVW * 2, WSZ_W1 = (size_t)FF * DM * 2, WSZ_W2 = (size_t)DM * FF * 2;
constexpr size_t WS_WA_IN = WS_W, WS_WA_OUT = WS_WA_IN + 2 * WSZ_A_IN, WS_WB_IN = WS_WA_OUT + 2 * WSZ_A_OUT, WS_WB_OUT = WS_WB_IN + WSZ_B_IN,
                 WS_WC_IN = WS_WB_OUT + WSZ_B_OUT, WS_WC_OUT = WS_WC_IN + WSZ_C_IN, WS_W1 = WS_WC_OUT + WSZ_C_OUT, WS_W2 = WS_W1 + 4 * WSZ_W1,
                 WS_ZP = WS_W2 + 4 * WSZ_W2, WS_QKF = WS_ZP + 4 * MiB, WS_DWG = WS_QKF + 130 * MiB, WS_DUG = WS_DWG + 66 * MiB, WS_END = WS_DUG + 66 * MiB;
constexpr size_t WS_MASK = WS_IDXL, WS_KS = WS_Z, WS_VS = WS_Z + 9 * MiB;
constexpr size_t WS_DAF = WS_Z, WS_DTG = WS_Y, WS_DTB = WS_Y + 33 * MiB, WS_DPG = WS_QR, WS_DKT = WS_QKF, WS_DVT = WS_QKF + 33 * MiB, WS_DGC = WS_QI, WS_DBT = WS_QI + 2 * MiB;
constexpr int SP = 4352, SPAD = 240, MTW = 68;
constexpr int CW_BAR = 4096;

constexpr int RING_BYTES = 131072, LDSCTL_OFF = RING_BYTES, MISC_OFF = LDSCTL_OFF + 320, LDS_BYTES = 147456;

typedef unsigned short bf16;
typedef unsigned v4u __attribute__((ext_vector_type(4)));
typedef unsigned v2u __attribute__((ext_vector_type(2)));
typedef float f32x4 __attribute__((ext_vector_type(4)));
typedef float f32x2 __attribute__((ext_vector_type(2)));
typedef short bf16x8 __attribute__((ext_vector_type(8)));
typedef float f32x16 __attribute__((ext_vector_type(16)));
typedef __bf16 bf16x2_t __attribute__((ext_vector_type(2)));

#define LDS_WAIT() asm volatile("s_waitcnt lgkmcnt(0)" ::: "memory")
#define WAVE_SYNC() do { asm volatile("s_waitcnt lgkmcnt(0)" ::: "memory"); __builtin_amdgcn_wave_barrier(); } while (0)

__device__ __forceinline__ float bflo(unsigned w) { return __uint_as_float(w << 16); }
__device__ __forceinline__ float bfhi(unsigned w) { return __uint_as_float(w & 0xffff0000u); }
__device__ __forceinline__ float bf2f(bf16 h) { return __uint_as_float((unsigned)h << 16); }
__device__ __forceinline__ unsigned pk2(float lo, float hi) { f32x2 v = {lo, hi}; bf16x2_t b = __builtin_convertvector(v, bf16x2_t); return __builtin_bit_cast(unsigned, b); }
__device__ __forceinline__ bf16 f2bf(float f) { return (bf16)(pk2(f, 0.f) & 0xffffu); }
__device__ __forceinline__ float wave_sum(float v) {
#pragma unroll
    for (int o = 1; o < 64; o <<= 1) v += __shfl_xor(v, o);
    return v;
}
__device__ __forceinline__ float wave_max(float v) {
#pragma unroll
    for (int o = 1; o < 64; o <<= 1) v = fmaxf(v, __shfl_xor(v, o));
    return v;
}
__device__ __forceinline__ int wave_sum_i(int v) {
#pragma unroll
    for (int o = 1; o < 64; o <<= 1) v += __shfl_xor(v, o);
    return v;
}
__device__ __forceinline__ float wave_sum_dpp(float v) {
    v += __int_as_float(__builtin_amdgcn_update_dpp(0, __float_as_int(v), 0x128, 0xf, 0xf, false));
    v += __int_as_float(__builtin_amdgcn_update_dpp(0, __float_as_int(v), 0x124, 0xf, 0xf, false));
    v += __int_as_float(__builtin_amdgcn_update_dpp(0, __float_as_int(v), 0x122, 0xf, 0xf, false));
    v += __int_as_float(__builtin_amdgcn_update_dpp(0, __float_as_int(v), 0x121, 0xf, 0xf, false));
    const int iv = __float_as_int(v);
    return (__int_as_float(__builtin_amdgcn_readlane(iv, 0)) + __int_as_float(__builtin_amdgcn_readlane(iv, 16))) + (__int_as_float(__builtin_amdgcn_readlane(iv, 32)) + __int_as_float(__builtin_amdgcn_readlane(iv, 48)));
}
__device__ __forceinline__ int wave_sum_dpp_i(int v) {
    v += __builtin_amdgcn_update_dpp(0, v, 0x128, 0xf, 0xf, false);
    v += __builtin_amdgcn_update_dpp(0, v, 0x124, 0xf, 0xf, false);
    v += __builtin_amdgcn_update_dpp(0, v, 0x122, 0xf, 0xf, false);
    v += __builtin_amdgcn_update_dpp(0, v, 0x121, 0xf, 0xf, false);
    return __builtin_amdgcn_readlane(v, 0) + __builtin_amdgcn_readlane(v, 16) + __builtin_amdgcn_readlane(v, 32) + __builtin_amdgcn_readlane(v, 48);
}
__device__ __forceinline__ float row16_sum(float v) {
    v += __int_as_float(__builtin_amdgcn_update_dpp(0, __float_as_int(v), 0x128, 0xf, 0xf, false));
    v += __int_as_float(__builtin_amdgcn_update_dpp(0, __float_as_int(v), 0x124, 0xf, 0xf, false));
    v += __int_as_float(__builtin_amdgcn_update_dpp(0, __float_as_int(v), 0x122, 0xf, 0xf, false));
    v += __int_as_float(__builtin_amdgcn_update_dpp(0, __float_as_int(v), 0x121, 0xf, 0xf, false));
    return v;
}
__device__ __forceinline__ float silu_f(float x) { return x / (1.f + __expf(-x)); }
__device__ __forceinline__ int prow(int b, int t) { return t >= NMETA ? b * SEQ + (t - NMETA) : XROW0 + b * NMETA + t; }
__device__ __forceinline__ void row_bt(int r, int& b, int& t) { if (r < XROW0) { b = r >> 12; t = (r & 4095) + NMETA; } else { b = (r - XROW0) >> 4; t = (r - XROW0) & 15; } }
__device__ __forceinline__ void unpack8(const v4u w, float (&f)[8]) {
    f[0] = bflo(w.x); f[1] = bfhi(w.x); f[2] = bflo(w.y); f[3] = bfhi(w.y); f[4] = bflo(w.z); f[5] = bfhi(w.z); f[6] = bflo(w.w); f[7] = bfhi(w.w);
}
__device__ __forceinline__ v4u pack8(const float (&f)[8]) { v4u w; w.x = pk2(f[0], f[1]); w.y = pk2(f[2], f[3]); w.z = pk2(f[4], f[5]); w.w = pk2(f[6], f[7]); return w; }

struct TrJob { bf16* WT; int K, k0, n0; bool ok, valid; };
__device__ __forceinline__ void tr_issue(const float* W, int K, int N, int Npad, bf16* WT, int item, int lane, float (&wv_)[32], TrJob& J) {
    const int nblk = Npad / 32, kb = item / nblk, nb = item % nblk, k0 = 64 * kb, n0 = 32 * nb;
    const int n = n0 + (lane & 31); const bool ok = n < N;
#pragma unroll
    for (int i = 0; i < 32; ++i) { const int kk = 2 * i + (lane >> 5); wv_[i] = W[(size_t)(k0 + kk) * N + (ok ? n : N - 1)]; }
    J.WT = WT; J.K = K; J.k0 = k0; J.n0 = n0; J.ok = ok; J.valid = true;
}
__device__ __forceinline__ void tr_finish(const float (&wv_)[32], const TrJob& J, LAS float* scr, int lane) {
#pragma unroll
    for (int i = 0; i < 32; ++i) { const int kk = 2 * i + (lane >> 5); scr[kk * 33 + (lane & 31)] = J.ok ? wv_[i] : 0.f; }
    LDS_WAIT(); __builtin_amdgcn_wave_barrier();
    const int c = lane & 7;
#pragma unroll
    for (int j = 0; j < 4; ++j) { const int nn = (lane >> 3) + 8 * j; const LAS float* sp = scr + (8 * c) * 33 + nn;
        v4u o; o.x = pk2(sp[0 * 33], sp[1 * 33]); o.y = pk2(sp[2 * 33], sp[3 * 33]); o.z = pk2(sp[4 * 33], sp[5 * 33]); o.w = pk2(sp[6 * 33], sp[7 * 33]);
        *(v4u*)(J.WT + (size_t)(J.n0 + nn) * J.K + J.k0 + 8 * c) = o; }
    LDS_WAIT(); __builtin_amdgcn_wave_barrier();
}
__device__ __forceinline__ void transpose_item(const float* W, int K, int N, int Npad, bf16* WT, LAS float* scr, int item, int lane) {
    float wv_[32]; TrJob J; tr_issue(W, K, N, Npad, WT, item, lane, wv_, J); tr_finish(wv_, J, scr, lane);
}

struct Ptrs {
    const float *x_prompt, *x_sample, *state_conv_a, *cache_k, *cache_v, *cache_ik, *state_conv_c, *state_delta;
    const int* page_table;
    const float *meta, *w_in_a, *conv_w_a, *w_out_a, *w_in_b, *w_out_b, *w_in_c, *conv_w_c, *a_log, *dt_bias, *norm_w, *w_out_c, *ln1_g, *ln1_b, *w1, *w2, *ln2_g, *ln2_b;
    float* out; unsigned char* ws;
};

__device__ __forceinline__ void p0_prologue(const Ptrs& P, LAS unsigned char* lds, int gw, int NGW, int wave, int lane) {
    LAS float* scr = (LAS float*)(lds + wave * 16384);
    unsigned char* ws = P.ws;
    constexpr int I_A_IN = (DM / 64) * (NA_IN / 32), I_A_OUT = (DM / 64) * (DM / 32), I_B_IN = (DM / 64) * (NB_PAD / 32), I_B_OUT = I_A_OUT,
                  I_C_IN = (DM / 64) * (NC_PAD / 32), I_C_OUT = (DVW / 64) * (DM / 32), I_W1 = (DM / 64) * (FF / 32), I_W2 = (FF / 64) * (DM / 32);
    constexpr int NITEMS = I_A_IN + I_A_OUT + I_B_IN + I_W1 + I_W2;
#define TR_(cnt, Wp, Kk, Nn, Np, WTp) if (r < (cnt)) { transpose_item((Wp), (Kk), (Nn), (Np), (bf16*)(WTp), scr, r, lane); continue; } r -= (cnt);
    for (int it = gw; it < NITEMS; it += NGW) {
        int r = it;
        TR_(I_A_IN, P.w_in_a, DM, NA_IN, NA_IN, ws + WS_WA_IN)
        TR_(I_A_OUT, P.w_out_a, DM, DM, DM, ws + WS_WA_OUT)
        TR_(I_B_IN, P.w_in_b, DM, NB_IN, NB_PAD, ws + WS_WB_IN)
        TR_(I_W1, P.w1, DM, FF, FF, ws + WS_W1)
        transpose_item(P.w2, FF, DM, DM, (bf16*)(ws + WS_W2), scr, r, lane);
    }
#undef TR_
    bf16* X = (bf16*)(ws + WS_X);
    for (int r = gw; r < MPAD; r += NGW) {
        const float* src = nullptr;
        if (r < XROW0) src = P.x_prompt + (size_t)r * DM;
        else if (r < SROW0) src = P.meta + (size_t)((r - XROW0) & 15) * DM;
        else if (r < NROWS) src = P.x_sample + (size_t)(r - SROW0) * DM;
#pragma unroll
        for (int j = 0; j < 4; ++j) { const int c = 512 * j + 8 * lane; v4u o = {0u, 0u, 0u, 0u};
            if (src) { const f32x4 a = *(const f32x4*)(src + c), b = *(const f32x4*)(src + c + 4); o.x = pk2(a.x, a.y); o.y = pk2(a.z, a.w); o.z = pk2(b.x, b.y); o.w = pk2(b.z, b.w); }
            *(v4u*)(X + (size_t)r * DM + c) = o; }
    }
    f32x2* t128 = (f32x2*)(ws + WS_TAB128); f32x2* t64 = (f32x2*)(ws + WS_TAB64);
    const int gt = gw * 64 + lane, NGT = NGW * 64;
    for (int e = gt; e < (TP + 1) * 96; e += NGT) {
        const int pi = e / 96, i = e % 96; const float pos = (float)(pi == TP ? PAST : pi);
        const float ex = (i < 64) ? (float)(2 * i) * (1.f / 128.f) : (float)(2 * (i - 64)) * (1.f / 64.f);
        const float inv = __builtin_amdgcn_exp2f(-ex * 13.287712379549449f);
        const float angf = pos * inv;
        double rev = (double)angf * 0.15915494309189535; rev -= __builtin_rint(rev);
        const float rf = (float)rev; const float sn = __builtin_amdgcn_sinf(rf), cs = __builtin_amdgcn_cosf(rf);
        if (i < 64) t128[pi * 64 + i] = (f32x2){cs, sn}; else t64[pi * 32 + (i - 64)] = (f32x2){cs, sn};
    }
}

constexpr int NHOSTED = (DM / 64) * (DM / 32) + (DM / 64) * (FF / 32) + (FF / 64) * (DM / 32) + (DM / 64) * (NC_PAD / 32);
__device__ __forceinline__ void hosted_issue(const Ptrs& P, int it, int lane, float (&wv_)[32], TrJob& J) {
    unsigned char* ws = P.ws;
    constexpr int I_B_OUT = (DM / 64) * (DM / 32), I_C_IN = (DM / 64) * (NC_PAD / 32), I_W1 = (DM / 64) * (FF / 32), I_W2 = (FF / 64) * (DM / 32);
    J.valid = false;
    if (it >= NHOSTED) return;
    int r = it;
    if (r < I_B_OUT) { tr_issue(P.w_out_b, DM, DM, DM, (bf16*)(ws + WS_WB_OUT), r, lane, wv_, J); return; } r -= I_B_OUT;
    if (r < I_W1) { tr_issue(P.w1 + (size_t)DM * FF, DM, FF, FF, (bf16*)(ws + WS_W1 + WSZ_W1), r, lane, wv_, J); return; } r -= I_W1;
    if (r < I_W2) { tr_issue(P.w2 + (size_t)DM * FF, FF, DM, DM, (bf16*)(ws + WS_W2 + WSZ_W2), r, lane, wv_, J); return; } r -= I_W2;
    (void)I_C_IN; tr_issue(P.w_in_c, DM, NC_IN, NC_PAD, (bf16*)(ws + WS_WC_IN), r, lane, wv_, J);
}
__device__ __forceinline__ void deferred_transposes(const Ptrs& P, LAS unsigned char* lds, int idx, int stride, int wave, int lane) {
    LAS float* scr = (LAS float*)(lds + wave * 16384);
    unsigned char* ws = P.ws;
    constexpr int I_A_IN = (DM / 64) * (NA_IN / 32), I_A_OUT = (DM / 64) * (DM / 32), I_C_OUT = (DVW / 64) * (DM / 32), I_W1 = (DM / 64) * (FF / 32), I_W2 = (FF / 64) * (DM / 32);
    constexpr int NITEMS = I_A_IN + I_A_OUT + I_C_OUT + 2 * I_W1 + 2 * I_W2;
#define TR_(cnt, Wp, Kk, Nn, Np, WTp) if (r < (cnt)) { transpose_item((Wp), (Kk), (Nn), (Np), (bf16*)(WTp), scr, r, lane); continue; } r -= (cnt);
    for (int it = idx; it < NITEMS; it += stride) {
        int r = it;
        TR_(I_C_OUT, P.w_out_c, DVW, DM, DM, ws + WS_WC_OUT)
        TR_(I_W1, P.w1 + 2 * (size_t)DM * FF, DM, FF, FF, ws + WS_W1 + 2 * WSZ_W1)
        TR_(I_W2, P.w2 + 2 * (size_t)DM * FF, FF, DM, DM, ws + WS_W2 + 2 * WSZ_W2)
        TR_(I_A_IN, P.w_in_a + (size_t)DM * NA_IN, DM, NA_IN, NA_IN, ws + WS_WA_IN + WSZ_A_IN)
        TR_(I_A_OUT, P.w_out_a + (size_t)DM * DM, DM, DM, DM, ws + WS_WA_OUT + WSZ_A_OUT)
        TR_(I_W1, P.w1 + 3 * (size_t)DM * FF, DM, FF, FF, ws + WS_W1 + 3 * WSZ_W1)
        transpose_item(P.w2 + 3 * (size_t)DM * FF, FF, DM, DM, (bf16*)(ws + WS_W2 + 3 * WSZ_W2), scr, r, lane);
    }
#undef TR_
}

__device__ __forceinline__ void ln_row_finish(float (&v)[32], float s, const f32x4 (&gq)[8], const f32x4 (&bq_)[8], bf16* xo, float* of, int lane) {
    const float mean = wave_sum_dpp(s) * (1.f / DM); float s2 = 0.f;
#pragma unroll
    for (int i = 0; i < 32; ++i) { v[i] -= mean; s2 += v[i] * v[i]; }
    const float rstd = 1.f / sqrtf(wave_sum_dpp(s2) * (1.f / DM) + LN_EPS);
#pragma unroll
    for (int j = 0; j < 4; ++j) { const int c = 512 * j + 8 * lane; const f32x4 g0 = gq[2 * j], g1 = gq[2 * j + 1], b0 = bq_[2 * j], b1 = bq_[2 * j + 1];
        float o[8];
        o[0] = v[8 * j + 0] * rstd * g0.x + b0.x; o[1] = v[8 * j + 1] * rstd * g0.y + b0.y; o[2] = v[8 * j + 2] * rstd * g0.z + b0.z; o[3] = v[8 * j + 3] * rstd * g0.w + b0.w;
        o[4] = v[8 * j + 4] * rstd * g1.x + b1.x; o[5] = v[8 * j + 5] * rstd * g1.y + b1.y; o[6] = v[8 * j + 6] * rstd * g1.z + b1.z; o[7] = v[8 * j + 7] * rstd * g1.w + b1.w;
        *(v4u*)(xo + c) = pack8(o);
        if (of) { *(f32x4*)(of + c) = (f32x4){o[0], o[1], o[2], o[3]}; *(f32x4*)(of + c + 4) = (f32x4){o[4], o[5], o[6], o[7]}; } }
}
__device__ __forceinline__ void ln_phase(const float* Z, const float* ZP, bf16* X, bf16* Xo, const float* gam, const float* bet, float* yp, float* ys, LAS unsigned char* lds, int gw, int NGW, int tid, int wave, int lane) {
    (void)Z;
    LAS float* red = (LAS float*)lds;
    for (int xr = blockIdx.x; xr < NROWS - XROW0; xr += gridDim.x) {
        const int r = XROW0 + xr, c = 256 * wave + 4 * lane;
        const v2u xv = *(const v2u*)(X + (size_t)r * DM + c);
        const float* zr = ZP + (size_t)xr * DM + c; f32x4 z = *(const f32x4*)zr;
#pragma unroll
        for (int sl = 1; sl < 8; ++sl) z += *(const f32x4*)(zr + (size_t)sl * XR * DM);
        float v4[4] = {ALPHA * bflo(xv.x) + z.x, ALPHA * bfhi(xv.x) + z.y, ALPHA * bflo(xv.y) + z.z, ALPHA * bfhi(xv.y) + z.w};
        const float ps = wave_sum_dpp((v4[0] + v4[1]) + (v4[2] + v4[3]));
        __syncthreads();
        if (lane == 0) red[wave] = ps;
        __syncthreads();
        float tot = 0.f;
#pragma unroll
        for (int w = 0; w < 8; ++w) tot += red[w];
        const float mean = tot * (1.f / DM); float q2 = 0.f;
#pragma unroll
        for (int i = 0; i < 4; ++i) { v4[i] -= mean; q2 += v4[i] * v4[i]; }
        const float pq = wave_sum_dpp(q2);
        if (lane == 0) red[8 + wave] = pq;
        __syncthreads();
        float tq = 0.f;
#pragma unroll
        for (int w = 0; w < 8; ++w) tq += red[8 + w];
        const float rstd = 1.f / sqrtf(tq * (1.f / DM) + LN_EPS);
        const f32x4 g = *(const f32x4*)(gam + c), be = *(const f32x4*)(bet + c);
        const float o0 = v4[0] * rstd * g.x + be.x, o1 = v4[1] * rstd * g.y + be.y, o2 = v4[2] * rstd * g.z + be.z, o3 = v4[3] * rstd * g.w + be.w;
        v2u ov; ov.x = pk2(o0, o1); ov.y = pk2(o2, o3); *(v2u*)(Xo + (size_t)r * DM + c) = ov;
        if (ys && r >= SROW0) *(f32x4*)(ys + (size_t)(r - SROW0) * DM + c) = (f32x4){o0, o1, o2, o3};
    }
    f32x4 gq[8], bq_[8];
#pragma unroll
    for (int j = 0; j < 4; ++j) { const int c = 512 * j + 8 * lane; gq[2 * j] = *(const f32x4*)(gam + c); gq[2 * j + 1] = *(const f32x4*)(gam + c + 4); bq_[2 * j] = *(const f32x4*)(bet + c); bq_[2 * j + 1] = *(const f32x4*)(bet + c + 4); }
    for (int r = gw; r < XROW0; r += 2 * NGW) {
        const int r2 = r + NGW; const bool two = r2 < XROW0;
        v4u xa[4], xb[4];
#pragma unroll
        for (int j = 0; j < 4; ++j) { const int c = 512 * j + 8 * lane; xa[j] = *(const v4u*)(X + (size_t)r * DM + c); xb[j] = *(const v4u*)(X + (size_t)(two ? r2 : r) * DM + c); }
        float va[32], vb[32]; float sa = 0.f, sb = 0.f;
#pragma unroll
        for (int j = 0; j < 4; ++j) { float t8[8]; unpack8(xa[j], t8);
#pragma unroll
            for (int i = 0; i < 8; ++i) { va[8 * j + i] = t8[i]; sa += t8[i]; }
            unpack8(xb[j], t8);
#pragma unroll
            for (int i = 0; i < 8; ++i) { vb[8 * j + i] = t8[i]; sb += t8[i]; } }
        ln_row_finish(va, sa, gq, bq_, Xo + (size_t)r * DM, yp ? yp + (size_t)r * DM : nullptr, lane);
        if (two) ln_row_finish(vb, sb, gq, bq_, Xo + (size_t)r2 * DM, yp ? yp + (size_t)r2 * DM : nullptr, lane);
    }
}

__device__ __forceinline__ void load_u(const bf16* BCH, int row, int c0, float (&u)[8]) {
    const v4u cg = *(const v4u*)(BCH + (size_t)row * NA_IN + DM + c0), hh = *(const v4u*)(BCH + (size_t)row * NA_IN + 2 * DM + c0);
    float a[8], b[8]; unpack8(cg, a); unpack8(hh, b);
#pragma unroll
    for (int i = 0; i < 8; ++i) u[i] = a[i] * b[i];
}
__device__ __forceinline__ void convA_phase(const bf16* BCH, bf16* Y, const float* cw, const float* hist, float* outp, float* outs, int gtid, int NT) {
    constexpr int RUN = 8, NRUN = SEQ / RUN;
    for (int it = gtid; it < (NBP * NRUN + NBP * NMETA + SBN) * 256; it += NT) {
        const int c0 = (it & 255) * 8, ru = it >> 8;
        float w0[8], w1[8], w2[8];
        { const f32x4 a = *(const f32x4*)(cw + c0), b = *(const f32x4*)(cw + c0 + 4); w0[0] = a.x; w0[1] = a.y; w0[2] = a.z; w0[3] = a.w; w0[4] = b.x; w0[5] = b.y; w0[6] = b.z; w0[7] = b.w; }
        { const f32x4 a = *(const f32x4*)(cw + DM + c0), b = *(const f32x4*)(cw + DM + c0 + 4); w1[0] = a.x; w1[1] = a.y; w1[2] = a.z; w1[3] = a.w; w1[4] = b.x; w1[5] = b.y; w1[6] = b.z; w1[7] = b.w; }
        { const f32x4 a = *(const f32x4*)(cw + 2 * DM + c0), b = *(const f32x4*)(cw + 2 * DM + c0 + 4); w2[0] = a.x; w2[1] = a.y; w2[2] = a.z; w2[3] = a.w; w2[4] = b.x; w2[5] = b.y; w2[6] = b.z; w2[7] = b.w; }
        float u0[8], u1[8], u2[8];
        if (ru < NBP * NRUN) {
            const int b = ru / NRUN, t0 = NMETA + (ru % NRUN) * RUN;
            if (t0 >= 1) load_u(BCH, prow(b, t0 - 1), c0, u1); else {
#pragma unroll
                for (int i = 0; i < 8; ++i) u1[i] = 0.f; }
            if (t0 >= 2) load_u(BCH, prow(b, t0 - 2), c0, u0); else {
#pragma unroll
                for (int i = 0; i < 8; ++i) u0[i] = 0.f; }
            const int r0 = prow(b, t0);
            v4u bq[RUN], cq[RUN], hq_[RUN];
#pragma unroll
            for (int k = 0; k < RUN; ++k) { const bf16* rp = BCH + (size_t)(r0 + k) * NA_IN + c0; bq[k] = *(const v4u*)rp; cq[k] = *(const v4u*)(rp + DM); hq_[k] = *(const v4u*)(rp + 2 * DM); }
#pragma unroll
            for (int k = 0; k < RUN; ++k) {
                const int r = r0 + k, t = t0 + k;
                { float ca[8], ha[8]; unpack8(cq[k], ca); unpack8(hq_[k], ha);
#pragma unroll
                  for (int i = 0; i < 8; ++i) u2[i] = ca[i] * ha[i]; }
                float bg[8]; unpack8(bq[k], bg);
                float y[8];
#pragma unroll
                for (int i = 0; i < 8; ++i) y[i] = bg[i] * (w0[i] * u0[i] + w1[i] * u1[i] + w2[i] * u2[i]);
                *(v4u*)(Y + (size_t)r * DM + c0) = pack8(y);
                if (t >= TP - 2) { float* o = outp + ((size_t)(b * 2 + (t - (TP - 2)))) * DM + c0; *(f32x4*)o = (f32x4){u2[0], u2[1], u2[2], u2[3]}; *(f32x4*)(o + 4) = (f32x4){u2[4], u2[5], u2[6], u2[7]}; }
#pragma unroll
                for (int i = 0; i < 8; ++i) { u0[i] = u1[i]; u1[i] = u2[i]; }
            }
        } else if (ru < NBP * NRUN + NBP * NMETA) {
            const int mi = ru - NBP * NRUN, b = mi / NMETA, t = mi % NMETA, r = XROW0 + mi;
            load_u(BCH, r, c0, u2);
            if (t >= 1) load_u(BCH, r - 1, c0, u1); else {
#pragma unroll
                for (int i = 0; i < 8; ++i) u1[i] = 0.f; }
            if (t >= 2) load_u(BCH, r - 2, c0, u0); else {
#pragma unroll
                for (int i = 0; i < 8; ++i) u0[i] = 0.f; }
            (void)b;
            float bg[8]; unpack8(*(const v4u*)(BCH + (size_t)r * NA_IN + c0), bg);
            float y[8];
#pragma unroll
            for (int i = 0; i < 8; ++i) y[i] = bg[i] * (w0[i] * u0[i] + w1[i] * u1[i] + w2[i] * u2[i]);
            *(v4u*)(Y + (size_t)r * DM + c0) = pack8(y);
        } else {
            const int sb = ru - NBP * NRUN - NBP * NMETA, r = SROW0 + sb;
            load_u(BCH, r, c0, u2);
            const float* h0 = hist + ((size_t)(sb * 2 + 0)) * DM + c0; const float* h1 = hist + ((size_t)(sb * 2 + 1)) * DM + c0;
            const f32x4 a0 = *(const f32x4*)h0, a1 = *(const f32x4*)(h0 + 4), b0 = *(const f32x4*)h1, b1 = *(const f32x4*)(h1 + 4);
            u0[0] = a0.x; u0[1] = a0.y; u0[2] = a0.z; u0[3] = a0.w; u0[4] = a1.x; u0[5] = a1.y; u0[6] = a1.z; u0[7] = a1.w;
            u1[0] = b0.x; u1[1] = b0.y; u1[2] = b0.z; u1[3] = b0.w; u1[4] = b1.x; u1[5] = b1.y; u1[6] = b1.z; u1[7] = b1.w;
            float* o0 = outs + ((size_t)(sb * 2 + 0)) * DM + c0; float* o1 = outs + ((size_t)(sb * 2 + 1)) * DM + c0;
            *(f32x4*)o0 = b0; *(f32x4*)(o0 + 4) = b1;
            *(f32x4*)o1 = (f32x4){u2[0], u2[1], u2[2], u2[3]}; *(f32x4*)(o1 + 4) = (f32x4){u2[4], u2[5], u2[6], u2[7]};
            float bg[8]; unpack8(*(const v4u*)(BCH + (size_t)r * NA_IN + c0), bg);
            float y[8];
#pragma unroll
            for (int i = 0; i < 8; ++i) y[i] = bg[i] * (w0[i] * u0[i] + w1[i] * u1[i] + w2[i] * u2[i]);
            *(v4u*)(Y + (size_t)r * DM + c0) = pack8(y);
        }
    }
}

constexpr float QSCALE = 0.08838834764831845f;
__device__ __forceinline__ void rope_phase(const bf16* PROJ, const Ptrs& P, int gw, int NGW, int lane) {
    unsigned char* ws = P.ws;
    const f32x2* t128 = (const f32x2*)(ws + WS_TAB128); const f32x2* t64 = (const f32x2*)(ws + WS_TAB64);
    bf16* Qr = (bf16*)(ws + WS_QR); bf16* QI = (bf16*)(ws + WS_QI); bf16* KIb = (bf16*)(ws + WS_KIB); float* WI = (float*)(ws + WS_WI);
    bf16* Ks = (bf16*)(ws + WS_KS); bf16* Vs = (bf16*)(ws + WS_VS);
    for (int pr_ = gw; pr_ < NBP * SPAD; pr_ += NGW) {
        const size_t o = ((size_t)((pr_ / SPAD) * SP + (pr_ % SPAD))) * 512 + 8 * lane; *(v4u*)(Ks + o) = (v4u){0u, 0u, 0u, 0u}; *(v4u*)(Vs + o) = (v4u){0u, 0u, 0u, 0u}; }
    for (int r = gw; r < NROWS; r += NGW) {
        const bf16* pr = PROJ + (size_t)r * NB_PAD;
        int pi; float *ko, *vo, *iko; bf16* kib = nullptr; bf16 *ksq = nullptr, *vsq = nullptr;
        if (r < SROW0) { int b, t; row_bt(r, b, t); pi = t; ksq = Ks + ((size_t)(b * SP + t + SPAD)) * 512; vsq = Vs + ((size_t)(b * SP + t + SPAD)) * 512; ko = P.out + O_KP + ((size_t)(b * TP + t)) * 512; vo = P.out + O_VP + ((size_t)(b * TP + t)) * 512; iko = P.out + O_IKP + ((size_t)(b * TP + t)) * 64; kib = KIb + ((size_t)(b * KIROWS + t)) * 64; }
        else { const int sb = r - SROW0; pi = POS_SAMPLE_IDX; ko = P.out + O_KS + (size_t)sb * 512; vo = P.out + O_VS + (size_t)sb * 512; iko = P.out + O_IKS + (size_t)sb * 64; }
        const f32x2* c128 = t128 + (size_t)pi * 64; const f32x2* c64 = t64 + (size_t)pi * 32;
        const int hd = lane >> 2, sub = lane & 3, hk = hd & 3;
        const v4u q1a = *(const v4u*)(pr + hd * 128 + 16 * sub), q1b = *(const v4u*)(pr + hd * 128 + 16 * sub + 8), q2a = *(const v4u*)(pr + hd * 128 + 64 + 16 * sub), q2b = *(const v4u*)(pr + hd * 128 + 64 + 16 * sub + 8);
        const v4u k1a = *(const v4u*)(pr + 2048 + hk * 128 + 16 * sub), k1b = *(const v4u*)(pr + 2048 + hk * 128 + 16 * sub + 8), k2a = *(const v4u*)(pr + 2048 + hk * 128 + 64 + 16 * sub), k2b = *(const v4u*)(pr + 2048 + hk * 128 + 64 + 16 * sub + 8);
        const v4u vv = *(const v4u*)(pr + 2560 + 8 * lane);
        const v4u i1 = *(const v4u*)(pr + 3072 + hd * 64 + 8 * sub), i2 = *(const v4u*)(pr + 3072 + hd * 64 + 32 + 8 * sub);
        const v4u j1 = *(const v4u*)(pr + 4096 + 8 * sub), j2 = *(const v4u*)(pr + 4096 + 32 + 8 * sub);
        const v4u wq = *(const v4u*)(pr + 4160 + 8 * (lane & 1));
        f32x4 csq[8], csi[4];
#pragma unroll
        for (int i = 0; i < 8; ++i) csq[i] = *(const f32x4*)(c128 + 16 * sub + 2 * i);
#pragma unroll
        for (int i = 0; i < 4; ++i) csi[i] = *(const f32x4*)(c64 + 8 * sub + 2 * i);
        {
            float x1[16], x2[16], o1[16], o2[16];
            { float t8[8]; unpack8(q1a, t8);
#pragma unroll
              for (int i = 0; i < 8; ++i) x1[i] = t8[i]; unpack8(q1b, t8);
#pragma unroll
              for (int i = 0; i < 8; ++i) x1[8 + i] = t8[i]; unpack8(q2a, t8);
#pragma unroll
              for (int i = 0; i < 8; ++i) x2[i] = t8[i]; unpack8(q2b, t8);
#pragma unroll
              for (int i = 0; i < 8; ++i) x2[8 + i] = t8[i]; }
#pragma unroll
            for (int i = 0; i < 16; i += 2) { const f32x4 cs = csq[i >> 1];
                o1[i] = (x1[i] * cs.x - x2[i] * cs.y) * QSCALE; o2[i] = (x2[i] * cs.x + x1[i] * cs.y) * QSCALE;
                o1[i + 1] = (x1[i + 1] * cs.z - x2[i + 1] * cs.w) * QSCALE; o2[i + 1] = (x2[i + 1] * cs.z + x1[i + 1] * cs.w) * QSCALE; }
            bf16* qo = Qr + (size_t)r * DM + hd * 128 + 16 * sub;
            { float t8[8];
#pragma unroll
              for (int i = 0; i < 8; ++i) t8[i] = o1[i]; *(v4u*)qo = pack8(t8);
#pragma unroll
              for (int i = 0; i < 8; ++i) t8[i] = o1[8 + i]; *(v4u*)(qo + 8) = pack8(t8);
#pragma unroll
              for (int i = 0; i < 8; ++i) t8[i] = o2[i]; *(v4u*)(qo + 64) = pack8(t8);
#pragma unroll
              for (int i = 0; i < 8; ++i) t8[i] = o2[8 + i]; *(v4u*)(qo + 72) = pack8(t8); }
        }
        if (lane < 16) {
#pragma unroll
            for (int hf = 0; hf < 2; ++hf) { float x1[8], x2[8], o1[8], o2[8]; unpack8(hf ? k1b : k1a, x1); unpack8(hf ? k2b : k2a, x2);
#pragma unroll
                for (int i = 0; i < 8; i += 2) { const f32x4 cs = csq[4 * hf + (i >> 1)];
                    o1[i] = x1[i] * cs.x - x2[i] * cs.y; o2[i] = x2[i] * cs.x + x1[i] * cs.y; o1[i + 1] = x1[i + 1] * cs.z - x2[i + 1] * cs.w; o2[i + 1] = x2[i + 1] * cs.z + x1[i + 1] * cs.w; }
                float* kq = ko + hk * 128 + 16 * sub + 8 * hf;
                *(f32x4*)kq = (f32x4){o1[0], o1[1], o1[2], o1[3]}; *(f32x4*)(kq + 4) = (f32x4){o1[4], o1[5], o1[6], o1[7]};
                *(f32x4*)(kq + 64) = (f32x4){o2[0], o2[1], o2[2], o2[3]}; *(f32x4*)(kq + 68) = (f32x4){o2[4], o2[5], o2[6], o2[7]};
                if (ksq) { *(v4u*)(ksq + hk * 128 + 16 * sub + 8 * hf) = pack8(o1); *(v4u*)(ksq + hk * 128 + 64 + 16 * sub + 8 * hf) = pack8(o2); } }
        }
        {
            float vf[8]; unpack8(vv, vf);
            *(f32x4*)(vo + 8 * lane) = (f32x4){vf[0], vf[1], vf[2], vf[3]}; *(f32x4*)(vo + 8 * lane + 4) = (f32x4){vf[4], vf[5], vf[6], vf[7]};
            if (vsq) *(v4u*)(vsq + 8 * lane) = vv;
        }
        {
            float x1[8], x2[8], o1[8], o2[8]; unpack8(i1, x1); unpack8(i2, x2);
#pragma unroll
            for (int i = 0; i < 8; i += 2) { const f32x4 cs = csi[i >> 1];
                o1[i] = x1[i] * cs.x - x2[i] * cs.y; o2[i] = x2[i] * cs.x + x1[i] * cs.y; o1[i + 1] = x1[i + 1] * cs.z - x2[i + 1] * cs.w; o2[i + 1] = x2[i + 1] * cs.z + x1[i + 1] * cs.w; }
            *(v4u*)(QI + (size_t)r * 1024 + hd * 64 + 8 * sub) = pack8(o1); *(v4u*)(QI + (size_t)r * 1024 + hd * 64 + 32 + 8 * sub) = pack8(o2);
        }
        if (lane < 4) {
            float x1[8], x2[8], o1[8], o2[8]; unpack8(j1, x1); unpack8(j2, x2);
#pragma unroll
            for (int i = 0; i < 8; i += 2) { const f32x4 cs = csi[i >> 1];
                o1[i] = x1[i] * cs.x - x2[i] * cs.y; o2[i] = x2[i] * cs.x + x1[i] * cs.y; o1[i + 1] = x1[i + 1] * cs.z - x2[i + 1] * cs.w; o2[i + 1] = x2[i + 1] * cs.z + x1[i + 1] * cs.w; }
            float* io = iko + 8 * sub;
            *(f32x4*)io = (f32x4){o1[0], o1[1], o1[2], o1[3]}; *(f32x4*)(io + 4) = (f32x4){o1[4], o1[5], o1[6], o1[7]};
            *(f32x4*)(io + 32) = (f32x4){o2[0], o2[1], o2[2], o2[3]}; *(f32x4*)(io + 36) = (f32x4){o2[4], o2[5], o2[6], o2[7]};
            if (kib) { *(v4u*)(kib + 8 * sub) = pack8(o1); *(v4u*)(kib + 32 + 8 * sub) = pack8(o2); }
        } else if (lane < 6) {
            float wv[8]; unpack8(wq, wv); float* wo = WI + (size_t)r * 16 + 8 * (lane - 4);
            *(f32x4*)wo = (f32x4){wv[0], wv[1], wv[2], wv[3]}; *(f32x4*)(wo + 4) = (f32x4){wv[4], wv[5], wv[6], wv[7]};
        }
    }
}

__device__ __forceinline__ void indexer_prompt(const Ptrs& P, LAS unsigned char* lds, int tid, int wave, int lane) {
    unsigned char* ws = P.ws;
    const bf16* QI = (const bf16*)(ws + WS_QI); const bf16* KIb = (const bf16*)(ws + WS_KIB); const float* WI = (const float*)(ws + WS_WI); float* SC = (float*)(ws + WS_SC);
    const int n = lane & 31, h8 = lane >> 5;
    const int qsel = (n >> 2) & 1, head = (n & 3) + 4 * (n >> 3);
    constexpr int NG = TP / 16;
    constexpr int KROW = 144, TBUF = 128 * KROW;
    LAS float* hscr = (LAS float*)(lds + 40960 + wave * 8448);
    int tit = blockIdx.x * 8 + wave;
    for (int it = blockIdx.x; it < 2 * NG; it += gridDim.x) {
        int b, qg;
        if (it < 256) { b = it & 1; qg = 1 + (it >> 1); } else if (it < 512) { b = it & 1; qg = 256 - ((it - 256) >> 1); } else { b = it - 512; qg = 0; }
        const int t0 = 16 * qg + 2 * wave;
        const bf16* qa = QI + (size_t)prow(b, t0 + qsel) * 1024 + head * 64 + 8 * h8;
        bf16x8 a[4];
#pragma unroll
        for (int kk = 0; kk < 4; ++kk) a[kk] = *(const bf16x8*)(qa + 16 * kk);
        const int tq = t0 + h8;
        const float* wp = WI + (size_t)prow(b, tq) * 16;
        float w[16];
#pragma unroll
        for (int i = 0; i < 4; ++i) { const f32x4 x = *(const f32x4*)(wp + 4 * i); w[4 * i] = x.x; w[4 * i + 1] = x.y; w[4 * i + 2] = x.z; w[4 * i + 3] = x.w; }
        const int ntile = ((16 * qg + 15) >> 5) + 1, ntrip = (ntile + 3) >> 2;
        float* scrow = SC + ((size_t)(b * TP + tq)) * SCW;
        const bf16* kbase = KIb + (size_t)b * KIROWS * 64;
        const int p0 = tid, p1 = tid + 512;
        const int l0 = (p0 >> 3) * KROW + (p0 & 7) * 16, l1 = (p1 >> 3) * KROW + (p1 & 7) * 16;
        asm volatile("s_waitcnt lgkmcnt(0)\n\ts_barrier" ::: "memory");
        v4u g0 = *(const v4u*)(kbase + (size_t)p0 * 8), g1 = *(const v4u*)(kbase + (size_t)p1 * 8);
        *(LAS v4u*)(lds + l0) = g0; *(LAS v4u*)(lds + l1) = g1;
        for (int tr = 0; tr < ntrip; ++tr) {
            const int cur = tr & 1;
            float hv[32]; TrJob HJ; hosted_issue(P, tit, lane, hv, HJ);
            if (tr + 1 < ntrip) { const size_t ko = (size_t)(tr + 1) * 128 * 64;
                const int kmax = KIROWS * 64 - 8;
                const size_t o0 = ko + (size_t)p0 * 8, o1 = ko + (size_t)p1 * 8;
                g0 = *(const v4u*)(kbase + (o0 <= (size_t)kmax ? o0 : (size_t)kmax)); g1 = *(const v4u*)(kbase + (o1 <= (size_t)kmax ? o1 : (size_t)kmax)); }
            asm volatile("s_waitcnt lgkmcnt(0)\n\ts_barrier" ::: "memory");
            const LAS unsigned char* kb = lds + cur * TBUF + n * KROW + h8 * 16;
#pragma unroll
            for (int u = 0; u < 4; ++u) {
                f32x16 acc;
#pragma unroll
                for (int i = 0; i < 16; ++i) acc[i] = 0.f;
#pragma unroll
                for (int kk = 0; kk < 4; ++kk) acc = __builtin_amdgcn_mfma_f32_32x32x16_bf16(a[kk], *(const LAS bf16x8*)(kb + u * 32 * KROW + kk * 32), acc, 0, 0, 0);
                float sc = 0.f;
#pragma unroll
                for (int i = 0; i < 16; ++i) sc += w[i] * fmaxf(acc[i], 0.f);
                const int s = 32 * (4 * tr + u) + n;
                if (s <= tq) scrow[s] = sc;
            }
            if (tr + 1 < ntrip) { *(LAS v4u*)(lds + (cur ^ 1) * TBUF + l0) = g0; *(LAS v4u*)(lds + (cur ^ 1) * TBUF + l1) = g1; }
            if (HJ.valid) { tr_finish(hv, HJ, hscr, lane); tit += gridDim.x * 8; }
        }
    }
    asm volatile("s_waitcnt lgkmcnt(0)\n\ts_barrier" ::: "memory");
    for (; tit < NHOSTED; tit += gridDim.x * 8) { float hv[32]; TrJob HJ; hosted_issue(P, tit, lane, hv, HJ); if (HJ.valid) tr_finish(hv, HJ, hscr, lane); }
}

__device__ __forceinline__ void indexer_sample(const Ptrs& P, LAS unsigned char* lds, int tid) {
    unsigned char* ws = P.ws;
    const bf16* QI = (const bf16*)(ws + WS_QI); const float* WI = (const float*)(ws + WS_WI); float* SCS = (float*)(ws + WS_SCS);
    LAS float* lq = (LAS float*)lds;
    LAS float* lw = lq + 1024;
    constexpr int NCH = (NSKEY + 511) / 512;
    for (int item = gridDim.x - 1 - blockIdx.x; item < SBN * NCH; item += gridDim.x) {
        const int sb = item / NCH, ch = item % NCH, r = SROW0 + sb;
        __syncthreads();
        for (int e = tid; e < 1024; e += NTHREADS) lq[e] = bf2f(QI[(size_t)r * 1024 + e]);
        if (tid < 16) lw[tid] = WI[(size_t)r * 16 + tid];
        __syncthreads();
        const int s = ch * 512 + tid;
        if (s < NSKEY) {
            const float* kr = (s < PAST) ? P.cache_ik + ((size_t)P.page_table[sb * NPG + (s >> 7)] * 128 + (s & 127)) * 64 : P.out + O_IKS + (size_t)sb * 64;
            f32x4 kv[16];
#pragma unroll
            for (int i = 0; i < 16; ++i) kv[i] = *(const f32x4*)(kr + 4 * i);
            float sc = 0.f;
            for (int h = 0; h < 16; ++h) { float d = 0.f;
#pragma unroll
                for (int i = 0; i < 16; ++i) { const f32x4 q = *(const LAS f32x4*)(lq + h * 64 + 4 * i); d += q.x * kv[i].x + q.y * kv[i].y + q.z * kv[i].z + q.w * kv[i].w; }
                sc += lw[h] * fmaxf(d, 0.f); }
            SCS[(size_t)sb * SCSW + s] = sc;
        }
    }
    __syncthreads();
}

__device__ __forceinline__ unsigned ordkey(float f) { const unsigned u = __float_as_uint(f); return (u & 0x80000000u) ? ~u : (u | 0x80000000u); }
constexpr int TOPK = 256;
__device__ __forceinline__ void topk_wave_mask(const float* sc, int n, unsigned long long* mrow, int lane) {
    constexpr int NS = MTW, M0 = SPAD / 64;
    static_assert(M0 == dattn::JLO, "first real key tile");
    unsigned key[NS];
#pragma unroll
    for (int m = M0; m < NS; ++m) { const int sidx = lane + 64 * m - SPAD; const int ci = sidx < 0 ? 0 : (sidx < n ? sidx : n - 1); const float v = sc[ci]; key[m] = (sidx >= 0 && sidx < n) ? ordkey(v) : 0u; }
    if (n <= TOPK) {
#pragma unroll
        for (int m = M0; m < NS; ++m) { const unsigned long long w = __ballot(key[m] != 0u); if (lane == 0) mrow[m] = w; }
        return;
    }
    unsigned T = 0u;
    for (int bit = 31; bit >= 0; --bit) {
        const unsigned cand = T | (1u << bit); int c = 0, cv = 0;
#pragma unroll
        for (int m = M0; m < NS; ++m) { if ((m & 1) != 0) c += __popcll(__ballot(key[m] >= cand)); else cv += (key[m] >= cand) ? 1 : 0; }
        c = __builtin_amdgcn_readfirstlane(c + wave_sum_dpp_i(cv));
        if (c >= TOPK) { T = cand; if (c == TOPK) break; }
    }
    int cg = 0;
#pragma unroll
    for (int m = M0; m < NS; ++m) cg += __popcll(__ballot(key[m] > T));
    const int need = TOPK - cg;
    int base_e = 0;
    const unsigned long long lt = (1ull << lane) - 1ull;
#pragma unroll
    for (int m = M0; m < NS; ++m) {
        const bool pg = key[m] > T, pe = key[m] == T;
        const unsigned long long me = __ballot(pe);
        const int pre_e = __popcll(me & lt);
        const unsigned long long w = __ballot(pg || (pe && (base_e + pre_e) < need));
        if (lane == 0) mrow[m] = w;
        base_e += __popcll(me);
    }
}
__device__ __forceinline__ void topk_block(const float* sc, int n, int* outIdx, int* outCnt, LAS unsigned* ls, int tid, int wave, int lane) {
    constexpr int NS = (NSKEY + NTHREADS - 1) / NTHREADS;
    unsigned key[NS];
#pragma unroll
    for (int m = 0; m < NS; ++m) { const int e = tid + NTHREADS * m; const float v = sc[e < n ? e : n - 1]; key[m] = (e < n) ? ordkey(v) : 0u; }
    unsigned T = 0u;
    for (int bit = 31; bit >= 0; --bit) {
        const unsigned cand = T | (1u << bit); int c = 0;
#pragma unroll
        for (int m = 0; m < NS; ++m) c += (key[m] >= cand) ? 1 : 0;
        c = wave_sum_dpp_i(c);
        LAS unsigned* buf = ls + (bit & 1) * 8;
        if (lane == 0) buf[wave] = (unsigned)c;
        __syncthreads();
        int tot = 0;
#pragma unroll
        for (int w = 0; w < 8; ++w) tot += (int)buf[w];
        if (tot >= TOPK) T = cand;
    }
    __syncthreads();
    if (tid == 0) { unsigned z_ = 0u; asm volatile("" : "+v"(z_)); ls[16] = z_; ls[17] = z_; }
    __syncthreads();
#pragma unroll
    for (int m = 0; m < NS; ++m) { const int e = tid + NTHREADS * m; if (key[m] > T) { const unsigned pos = atomicAdd((unsigned*)(ls + 16), 1u); if (pos < (unsigned)TOPK) outIdx[pos] = e; } }
    __syncthreads();
    const unsigned cg = ls[16];
    const unsigned need = (unsigned)TOPK - cg;
#pragma unroll
    for (int m = 0; m < NS; ++m) { const int e = tid + NTHREADS * m; if (key[m] == T) { const unsigned pos = atomicAdd((unsigned*)(ls + 17), 1u); if (pos < need) outIdx[cg + pos] = e; } }
    if (tid == 0) *outCnt = TOPK;
    __syncthreads();
}
__device__ __forceinline__ void select_phase(const Ptrs& P, LAS unsigned char* lds, int gw, int NGW, int tid, int wave, int lane) {
    unsigned char* ws = P.ws;
    const float* SC = (const float*)(ws + WS_SC); const float* SCS = (const float*)(ws + WS_SCS); int* IDXL = (int*)(ws + WS_IDXL); int* CNT = (int*)(ws + WS_CNT);
    for (int sb = blockIdx.x; sb < SBN; sb += gridDim.x) topk_block(SCS + (size_t)sb * SCSW, NSKEY, IDXL + (size_t)(SROW0 + sb) * TOPK, CNT + SROW0 + sb, (LAS unsigned*)lds, tid, wave, lane);
    unsigned long long* MASK = (unsigned long long*)(ws + WS_MASK);
    for (int r = gw; r < SROW0; r += NGW) { int b, t; row_bt(r, b, t);
        if (r < XROW0) topk_wave_mask(SC + ((size_t)(b * TP + t)) * SCW, t + 1, MASK + ((size_t)(b * SP + t + SPAD)) * MTW, lane);
        else { if (lane <= t) IDXL[(size_t)r * TOPK + lane] = lane; if (lane == 0) CNT[r] = t + 1; } }
}

__device__ __forceinline__ void attn_phase(const Ptrs& P, bf16* O, LAS unsigned char* lds, int gw, int NGW, int wave, int lane) {
    unsigned char* ws = P.ws;
    const bf16* Qr = (const bf16*)(ws + WS_QR); const int* IDXL = (const int*)(ws + WS_IDXL); const int* CNT = (const int*)(ws + WS_CNT);
    LAS float* lq = (LAS float*)(lds + wave * 12288);
    LAS f32x4* lp = (LAS f32x4*)(lds + wave * 12288 + 2048);
    LAS unsigned long long* lkp = (LAS unsigned long long*)(lds + wave * 12288 + 6144);
    LAS unsigned long long* lvp = (LAS unsigned long long*)(lds + wave * 12288 + 8192);
    for (int item = gw; item < (NROWS - XROW0) * 4; item += NGW) {
        const int r = XROW0 + (item >> 2), n = item & 3;
        const int cnt = CNT[r];
        WAVE_SYNC();
        { float qf[8]; unpack8(*(const v4u*)(Qr + (size_t)r * DM + n * 512 + 8 * lane), qf);
          *(LAS f32x4*)(lq + 8 * lane) = (f32x4){qf[0], qf[1], qf[2], qf[3]}; *(LAS f32x4*)(lq + 8 * lane + 4) = (f32x4){qf[4], qf[5], qf[6], qf[7]}; }
        const float* kp[4];
#pragma unroll
        for (int j = 0; j < 4; ++j) {
            const int e = lane + 64 * j; const int s = (e < cnt) ? IDXL[(size_t)r * TOPK + e] : 0;
            const float *kq, *vq;
            if (r < SROW0) { const int b = (r < XROW0) ? (r >> 12) : ((r - XROW0) >> 4); kq = P.out + O_KP + ((size_t)(b * TP + s)) * 512; vq = P.out + O_VP + ((size_t)(b * TP + s)) * 512; }
            else { const int sb = r - SROW0;
                if (s < PAST) { const size_t off = ((size_t)P.page_table[sb * NPG + (s >> 7)] * 128 + (s & 127)) * 512; kq = P.cache_k + off; vq = P.cache_v + off; }
                else { kq = P.out + O_KS + (size_t)sb * 512; vq = P.out + O_VS + (size_t)sb * 512; } }
            kp[j] = kq + n * 128; lkp[e] = (unsigned long long)(kq + n * 128); lvp[e] = (unsigned long long)(vq + n * 128);
        }
        WAVE_SYNC();
        float acc[4][4];
#pragma unroll
        for (int g = 0; g < 4; ++g)
#pragma unroll
            for (int j = 0; j < 4; ++j) acc[g][j] = 0.f;
#pragma unroll 4
        for (int d4 = 0; d4 < 32; ++d4) {
            f32x4 qv[4];
#pragma unroll
            for (int g = 0; g < 4; ++g) qv[g] = *(const LAS f32x4*)(lq + g * 128 + 4 * d4);
#pragma unroll
            for (int j = 0; j < 4; ++j) { const f32x4 kv = *(const f32x4*)(kp[j] + 4 * d4);
#pragma unroll
                for (int g = 0; g < 4; ++g) acc[g][j] += qv[g].x * kv.x + qv[g].y * kv.y + qv[g].z * kv.z + qv[g].w * kv.w; }
        }
        float linv[4];
#pragma unroll
        for (int g = 0; g < 4; ++g) {
            float m = -INFINITY;
#pragma unroll
            for (int j = 0; j < 4; ++j) { if (lane + 64 * j >= cnt) acc[g][j] = -INFINITY; m = fmaxf(m, acc[g][j]); }
            m = wave_max(m); float l = 0.f;
#pragma unroll
            for (int j = 0; j < 4; ++j) { acc[g][j] = __expf(acc[g][j] - m); l += acc[g][j]; }
            linv[g] = 1.f / wave_sum(l);
        }
#pragma unroll
        for (int j = 0; j < 4; ++j) lp[lane + 64 * j] = (f32x4){acc[0][j], acc[1][j], acc[2][j], acc[3][j]};
        WAVE_SYNC();
        float o[4][2];
#pragma unroll
        for (int g = 0; g < 4; ++g) { o[g][0] = 0.f; o[g][1] = 0.f; }
#pragma unroll 8
        for (int e = 0; e < cnt; ++e) {
            const float* vp = (const float*)lvp[e]; const f32x2 vv = *(const f32x2*)(vp + 2 * lane); const f32x4 p = lp[e];
            o[0][0] += p.x * vv.x; o[0][1] += p.x * vv.y; o[1][0] += p.y * vv.x; o[1][1] += p.y * vv.y; o[2][0] += p.z * vv.x; o[2][1] += p.z * vv.y; o[3][0] += p.w * vv.x; o[3][1] += p.w * vv.y;
        }
#pragma unroll
        for (int g = 0; g < 4; ++g) *(unsigned*)(O + (size_t)r * DM + (4 * n + g) * 128 + 2 * lane) = pk2(o[g][0] * linv[g], o[g][1] * linv[g]);
    }
}

__device__ __forceinline__ void convC_finish(float (&acc)[8], int it) {
    float ss = 0.f;
#pragma unroll
    for (int i = 0; i < 8; ++i) { acc[i] = silu_f(acc[i]); ss += acc[i] * acc[i]; }
    if (it < 8) { ss = row16_sum(ss); float rn = 1.f / sqrtf(ss + RMS_EPS); if (it < 4) rn *= QSCALE;
#pragma unroll
        for (int i = 0; i < 8; ++i) acc[i] *= rn; }
}
__device__ __forceinline__ void convC_phase(const bf16* PROJC, const Ptrs& P, int gw, int NGW, int lane) {
    unsigned char* ws = P.ws;
    bf16* QKVC = (bf16*)(ws + WS_QKVC); float* QKF = (float*)(ws + WS_QKF); float* G = (float*)(ws + WS_G); float* BETA = (float*)(ws + WS_BETA);
    const float* cw = P.conv_w_c;
    constexpr int RUN = 8, NRUN = SEQ / RUN;
    for (int item = gw; item < 16 * NBP * NRUN; item += NGW) {
        const int it = item & 15, ru = item >> 4, b = ru / NRUN, t0 = NMETA + (ru % NRUN) * RUN, ch0 = it * 512 + 8 * lane;
        float w[4][8];
#pragma unroll
        for (int j = 0; j < 4; ++j) { const f32x4 w0 = *(const f32x4*)(cw + (size_t)j * CDIM + ch0), w1 = *(const f32x4*)(cw + (size_t)j * CDIM + ch0 + 4);
            w[j][0] = w0.x; w[j][1] = w0.y; w[j][2] = w0.z; w[j][3] = w0.w; w[j][4] = w1.x; w[j][5] = w1.y; w[j][6] = w1.z; w[j][7] = w1.w; }
        const int r0 = prow(b, t0);
        v4u xr[RUN + 3];
#pragma unroll
        for (int j = 0; j < 3; ++j) { const int tt = t0 - 3 + j; xr[j] = tt >= 0 ? *(const v4u*)(PROJC + (size_t)prow(b, tt) * NC_PAD + ch0) : (v4u){0u, 0u, 0u, 0u}; }
#pragma unroll
        for (int k = 0; k < RUN; ++k) xr[3 + k] = *(const v4u*)(PROJC + (size_t)(r0 + k) * NC_PAD + ch0);
        float x[RUN + 3][8];
#pragma unroll
        for (int j = 0; j < RUN + 3; ++j) unpack8(xr[j], x[j]);
#pragma unroll
        for (int k = 0; k < RUN; ++k) {
            float acc[8];
#pragma unroll
            for (int i = 0; i < 8; ++i) acc[i] = w[0][i] * x[k][i] + w[1][i] * x[k + 1][i] + w[2][i] * x[k + 2][i] + w[3][i] * x[k + 3][i];
            convC_finish(acc, it);
            *(v4u*)(QKVC + (size_t)(r0 + k) * CDIM + ch0) = pack8(acc);
            const int t = t0 + k;
            if (t >= TP - 3) { float* o = P.out + O_CCP + ((size_t)(b * 3 + (t - (TP - 3)))) * CDIM + ch0;
                *(f32x4*)o = (f32x4){x[k + 3][0], x[k + 3][1], x[k + 3][2], x[k + 3][3]}; *(f32x4*)(o + 4) = (f32x4){x[k + 3][4], x[k + 3][5], x[k + 3][6], x[k + 3][7]}; }
        }
    }
    for (int item = gw; item < 16 * NBP * NMETA; item += NGW) {
        const int it = item & 15, mi = item >> 4, t = mi % NMETA, r = XROW0 + mi, ch0 = it * 512 + 8 * lane;
        float x[4][8];
#pragma unroll
        for (int j = 0; j < 4; ++j) { const int tt = t - 3 + j; if (tt >= 0) unpack8(*(const v4u*)(PROJC + (size_t)(r - 3 + j) * NC_PAD + ch0), x[j]); else {
#pragma unroll
                for (int i = 0; i < 8; ++i) x[j][i] = 0.f; } }
        float acc[8];
#pragma unroll
        for (int i = 0; i < 8; ++i) acc[i] = 0.f;
#pragma unroll
        for (int j = 0; j < 4; ++j) { const f32x4 w0 = *(const f32x4*)(cw + (size_t)j * CDIM + ch0), w1 = *(const f32x4*)(cw + (size_t)j * CDIM + ch0 + 4);
            acc[0] += w0.x * x[j][0]; acc[1] += w0.y * x[j][1]; acc[2] += w0.z * x[j][2]; acc[3] += w0.w * x[j][3];
            acc[4] += w1.x * x[j][4]; acc[5] += w1.y * x[j][5]; acc[6] += w1.z * x[j][6]; acc[7] += w1.w * x[j][7]; }
        convC_finish(acc, it);
        *(v4u*)(QKVC + (size_t)r * CDIM + ch0) = pack8(acc);
    }
    for (int item = gw; item < 16 * SBN; item += NGW) {
        const int it = item & 15, sb = item >> 4, r = SROW0 + sb, ch0 = it * 512 + 8 * lane;
        float x[4][8];
#pragma unroll
        for (int j = 0; j < 3; ++j) { const float* hp = P.state_conv_c + ((size_t)(sb * 3 + j)) * CDIM + ch0; const f32x4 a = *(const f32x4*)hp, c = *(const f32x4*)(hp + 4);
            x[j][0] = a.x; x[j][1] = a.y; x[j][2] = a.z; x[j][3] = a.w; x[j][4] = c.x; x[j][5] = c.y; x[j][6] = c.z; x[j][7] = c.w; }
        unpack8(*(const v4u*)(PROJC + (size_t)r * NC_PAD + ch0), x[3]);
        float acc[8];
#pragma unroll
        for (int i = 0; i < 8; ++i) acc[i] = 0.f;
#pragma unroll
        for (int j = 0; j < 4; ++j) { const f32x4 w0 = *(const f32x4*)(cw + (size_t)j * CDIM + ch0), w1 = *(const f32x4*)(cw + (size_t)j * CDIM + ch0 + 4);
            acc[0] += w0.x * x[j][0]; acc[1] += w0.y * x[j][1]; acc[2] += w0.z * x[j][2]; acc[3] += w0.w * x[j][3];
            acc[4] += w1.x * x[j][4]; acc[5] += w1.y * x[j][5]; acc[6] += w1.z * x[j][6]; acc[7] += w1.w * x[j][7]; }
        convC_finish(acc, it);
        if (it < 8) { float* qk = QKF + (size_t)r * 4096 + ch0; *(f32x4*)qk = (f32x4){acc[0], acc[1], acc[2], acc[3]}; *(f32x4*)(qk + 4) = (f32x4){acc[4], acc[5], acc[6], acc[7]}; }
        *(v4u*)(QKVC + (size_t)r * CDIM + ch0) = pack8(acc);
        float* o = P.out + O_CCS + ((size_t)(sb * 3)) * CDIM + ch0;
#pragma unroll
        for (int j = 0; j < 3; ++j) { *(f32x4*)(o + (size_t)j * CDIM) = (f32x4){x[j + 1][0], x[j + 1][1], x[j + 1][2], x[j + 1][3]}; *(f32x4*)(o + (size_t)j * CDIM + 4) = (f32x4){x[j + 1][4], x[j + 1][5], x[j + 1][6], x[j + 1][7]}; }
    }
    for (int e = gw * 64 + lane; e < NROWS * 32; e += NGW * 64) {
        const int r = e >> 5, h = e & 31;
        const float braw = bf2f(PROJC[(size_t)r * NC_PAD + 12288 + h]), araw = bf2f(PROJC[(size_t)r * NC_PAD + 12320 + h]);
        const float xx = araw + P.dt_bias[h]; const float sp = xx > 20.f ? xx : __logf(1.f + __expf(xx));
        G[e] = -__expf(P.a_log[h]) * sp; BETA[e] = 1.f / (1.f + __expf(-braw));
    }
}

struct Tok { f32x4 k0, k1, q0, q1; unsigned v; float g, b; };
__device__ __forceinline__ void tok_load(Tok& T, const float* QKF, const bf16* QKVC, const float* G, const float* BETA, int row, int h, int rg, int col0) {
    const float* base = QKF + (size_t)row * 4096 + (h >> 1) * 128 + 8 * rg;
    T.q0 = *(const f32x4*)base; T.q1 = *(const f32x4*)(base + 4); T.k0 = *(const f32x4*)(base + 2048); T.k1 = *(const f32x4*)(base + 2052);
    T.v = *(const unsigned*)(QKVC + (size_t)row * CDIM + 4096 + h * 128 + col0);
    T.g = G[(size_t)row * 32 + h]; T.b = BETA[(size_t)row * 32 + h];
}
__device__ __forceinline__ f32x2 tok_step(f32x2 (&S)[8], const Tok& T) {
    const float kk[8] = {T.k0.x, T.k0.y, T.k0.z, T.k0.w, T.k1.x, T.k1.y, T.k1.z, T.k1.w};
    const float qq[8] = {T.q0.x, T.q0.y, T.q0.z, T.q0.w, T.q1.x, T.q1.y, T.q1.z, T.q1.w};
    const float a = __expf(T.g);
    f32x2 d0 = S[0] * kk[0], d1 = S[1] * kk[1];
#pragma unroll
    for (int i = 2; i < 8; i += 2) { d0 += S[i] * kk[i]; d1 += S[i + 1] * kk[i + 1]; }
    f32x2 d = d0 + d1;
    d.x = row16_sum(d.x); d.y = row16_sum(d.y);
    const f32x2 tv = {bflo(T.v), bfhi(T.v)};
    const f32x2 dl = (tv - d * a) * T.b;
    f32x2 o0 = {0.f, 0.f}, o1 = {0.f, 0.f};
#pragma unroll
    for (int i = 0; i < 8; i += 2) { S[i] = S[i] * a + dl * kk[i]; o0 += S[i] * qq[i]; S[i + 1] = S[i + 1] * a + dl * kk[i + 1]; o1 += S[i + 1] * qq[i + 1]; }
    f32x2 o = o0 + o1;
    o.x = row16_sum(o.x); o.y = row16_sum(o.y);
    return o;
}
__device__ __forceinline__ void delta_phase(const Ptrs& P, int idx, int stride, int lane) {
    unsigned char* ws = P.ws;
    const bf16* QKVC = (const bf16*)(ws + WS_QKVC); const float* QKF = (const float*)(ws + WS_QKF); const float* G = (const float*)(ws + WS_G); const float* BETA = (const float*)(ws + WS_BETA); bf16* OF = (bf16*)(ws + WS_SC);
    const int cg = lane >> 4, rg = lane & 15;
    {
        for (int item = idx; item < SBN * 32 * 16; item += stride) {
            const int sb = item >> 9, h = (item >> 4) & 31, col0 = 8 * (item & 15) + 2 * cg;
            const size_t so = ((size_t)((sb * 32 + h) * 128 + 8 * rg)) * 128 + col0;
            f32x2 S[8];
#pragma unroll
            for (int i = 0; i < 8; ++i) S[i] = *(const f32x2*)(P.state_delta + so + (size_t)i * 128);
            Tok T; tok_load(T, QKF, QKVC, G, BETA, SROW0 + sb, h, rg, col0);
            const f32x2 o = tok_step(S, T);
            if (rg == 0) *(unsigned*)(OF + (size_t)(SROW0 + sb) * DVW + h * 128 + col0) = pk2(o.x, o.y);
            float* op = P.out + O_DS + so;
#pragma unroll
            for (int i = 0; i < 8; ++i) *(f32x2*)(op + (size_t)i * 128) = S[i];
        }
    }
}
__device__ __forceinline__ void normC_piece(const v4u oq, const v4u zz, const float (&nw)[8], bf16* yo) {
    float o[8]; unpack8(oq, o);
    float ss = 0.f;
#pragma unroll
    for (int i = 0; i < 8; ++i) ss += o[i] * o[i];
    ss = row16_sum(ss);
    const float rs = 1.f / sqrtf(ss * (1.f / 128.f) + RMS_EPS);
    float z[8]; unpack8(zz, z);
#pragma unroll
    for (int i = 0; i < 8; ++i) o[i] = o[i] * rs * nw[i] * silu_f(z[i]);
    *(v4u*)yo = pack8(o);
}
__device__ __forceinline__ void normC_phase(const bf16* PROJC, bf16* Y, const Ptrs& P, int gw, int NGW, int lane) {
    const bf16* OF = (const bf16*)(P.ws + WS_SC);
    const int d0 = 8 * (lane & 15), hl = lane >> 4;
    float nw[8];
    { const f32x4 a = *(const f32x4*)(P.norm_w + d0), b = *(const f32x4*)(P.norm_w + d0 + 4); nw[0] = a.x; nw[1] = a.y; nw[2] = a.z; nw[3] = a.w; nw[4] = b.x; nw[5] = b.y; nw[6] = b.z; nw[7] = b.w; }
    for (int it = gw; it < (NROWS - XROW0) * 8; it += NGW) { const int r = XROW0 + (it >> 3), hd = (it & 7) * 4 + hl;
        const v4u oq = *(const v4u*)(OF + (size_t)r * DVW + hd * 128 + d0), zz = *(const v4u*)(PROJC + (size_t)r * NC_PAD + 8192 + hd * 128 + d0);
        normC_piece(oq, zz, nw, Y + (size_t)r * DVW + hd * 128 + d0); }
    for (int r = gw; r < XROW0; r += 2 * NGW) {
        const int r2 = (r + NGW < XROW0) ? r + NGW : r; const bool two = r + NGW < XROW0;
        v4u oa[8], za[8], ob[8], zb[8];
#pragma unroll
        for (int it = 0; it < 8; ++it) { const int hd = it * 4 + hl;
            oa[it] = *(const v4u*)(OF + (size_t)r * DVW + hd * 128 + d0); za[it] = *(const v4u*)(PROJC + (size_t)r * NC_PAD + 8192 + hd * 128 + d0);
            ob[it] = *(const v4u*)(OF + (size_t)r2 * DVW + hd * 128 + d0); zb[it] = *(const v4u*)(PROJC + (size_t)r2 * NC_PAD + 8192 + hd * 128 + d0); }
#pragma unroll
        for (int it = 0; it < 8; ++it) { const int hd = it * 4 + hl;
            normC_piece(oa[it], za[it], nw, Y + (size_t)r * DVW + hd * 128 + d0);
            if (two) normC_piece(ob[it], zb[it], nw, Y + (size_t)r2 * DVW + hd * 128 + d0); }
    }
}


__device__ __forceinline__ void dense_attn_phase(const Ptrs& P, bf16* O, char* lds, int wv) {
    unsigned char* ws = P.ws;
    const bf16* Qr = (const bf16*)(ws + WS_QR); const bf16* Ks = (const bf16*)(ws + WS_KS); const bf16* Vs = (const bf16*)(ws + WS_VS);
    const unsigned long long* MASK = (const unsigned long long*)(ws + WS_MASK);
    typedef dattn::BlockRef<bf16, bf16> BR;
    for (int it0 = blockIdx.x; it0 < 256; it0 += gridDim.x) {
        const int grp = it0 & 7, idx = it0 >> 3;
        const int b = grp >> 2, kvh = grp & 3, h = kvh * 4 + (idx >> 3), x = idx & 7;
        BR A, B;
        const int qa = 1 + x, qb = 16 - x;
        A.Q = Qr + ((size_t)(b * SEQ + 256 * (qa - 1))) * DM + h * 128; A.O = O + ((size_t)(b * SEQ + 256 * (qa - 1))) * DM + h * 128;
        B.Q = Qr + ((size_t)(b * SEQ + 256 * (qb - 1))) * DM + h * 128; B.O = O + ((size_t)(b * SEQ + 256 * (qb - 1))) * DM + h * 128;
        A.K = B.K = Ks + (size_t)b * SP * 512 + kvh * 128; A.V = B.V = Vs + (size_t)b * SP * 512 + kvh * 128;
        A.P0 = 256 * qa; B.P0 = 256 * qb;
        A.M = MASK + ((size_t)(b * SP + A.P0)) * MTW; B.M = MASK + ((size_t)(b * SP + B.P0)) * MTW;
        dattn::Seam<bf16> S;
        dattn::causal_swa_prime<bf16, bf16>(A, SP, lds, S, wv);
        dattn::causal_swa_block<bf16, bf16>(A, B, SP, SP, lds, S, wv);
        dattn::causal_swa_block<bf16, bf16>(B, B, SP, SP, lds, S, wv);
    }
}

constexpr int NCH = 65, CPAD = 48;
constexpr int NUQ = NBP * 16 * NCH, NUH = NBP * 32 * NCH;
__device__ __forceinline__ int crow32(int r, int hi) { return (r & 3) + 8 * (r >> 2) + 4 * hi; }
__device__ __forceinline__ int chunk_row(int b, int c, int i) { const int t = 64 * c + i - CPAD; return t >= 0 ? prow(b, t) : -1; }
__device__ __forceinline__ float incl_scan64(float v, int lane) {
#pragma unroll
    for (int o = 1; o < 64; o <<= 1) { const float u = __shfl_up(v, o); if (lane >= o) v += u; }
    return v;
}
#define MFMA32(a, b, c) __builtin_amdgcn_mfma_f32_32x32x16_bf16((a), (b), (c), 0, 0, 0)
__device__ __forceinline__ bf16x8 sel8(bool ok, bf16x8 v) { const bf16x8 z = {0, 0, 0, 0, 0, 0, 0, 0}; return ok ? v : z; }
__device__ __forceinline__ int sw23(int x) { return (x & ~12) | ((x & 4) << 1) | ((x & 8) >> 1); }
__device__ __forceinline__ int fidx64(int row, int xs) { return ((((row >> 5) * 2 + (xs >> 5)) * 2 + ((xs >> 4) & 1)) * 64 + (row & 31) + 32 * ((xs >> 3) & 1)) * 8 + (xs & 7); }

__device__ __forceinline__ v4u pack_frag(const f32x16& x, int s) { v4u w; w.x = pk2(x[8 * s], x[8 * s + 1]); w.y = pk2(x[8 * s + 2], x[8 * s + 3]); w.z = pk2(x[8 * s + 4], x[8 * s + 5]); w.w = pk2(x[8 * s + 6], x[8 * s + 7]); return w; }
__device__ __forceinline__ void stage_out8k(LAS unsigned char* stg, bf16* gdst, int lane) {
    WAVE_SYNC();
#pragma unroll
    for (int k = 0; k < 8; ++k) *(v4u*)(gdst + k * 512 + lane * 8) = *(const LAS v4u*)(stg + k * 1024 + lane * 16);
    WAVE_SYNC();
}
__device__ __forceinline__ void delta_d1_unit(unsigned char* ws, LAS unsigned char* lds, int uq, int wave, int lane) {
    asm volatile("" : "+v"(lane));
    const bf16* QKVC = (const bf16*)(ws + WS_QKVC); const float* G = (const float*)(ws + WS_G); const float* BETA = (const float*)(ws + WS_BETA);
    float* AF = (float*)(ws + WS_DAF); bf16* PG = (bf16*)(ws + WS_DPG); bf16* KT = (bf16*)(ws + WS_DKT); bf16* VT = (bf16*)(ws + WS_DVT);
    float* GC = (float*)(ws + WS_DGC); float* BT = (float*)(ws + WS_DBT);
    LAS float* lg = (LAS float*)(lds + wave * 16384);
    LAS unsigned char* stg = lds + wave * 16384 + 2048; LAS bf16* st = (LAS bf16*)stg;
    const int m = lane & 31, half = lane >> 5;
    const bf16x8 zf = {0, 0, 0, 0, 0, 0, 0, 0};
    {
        const int c = uq % NCH, bh = uq / NCH, hq = bh & 15, b = bh >> 4;
        { const int row = chunk_row(b, c, lane);
#pragma unroll
          for (int hh = 0; hh < 2; ++hh) { const int h = 2 * hq + hh; const float g = row >= 0 ? G[(size_t)row * 32 + h] : 0.f, bt = row >= 0 ? BETA[(size_t)row * 32 + h] : 0.f;
              const float gc = incl_scan64(g, lane); lg[hh * 64 + lane] = gc; lg[128 + hh * 64 + lane] = bt;
              const size_t uh = ((size_t)(b * 32 + h)) * NCH + c; GC[uh * 64 + lane] = gc; BT[uh * 64 + lane] = bt; } }
        const int row0 = chunk_row(b, c, m), row1 = chunk_row(b, c, 32 + m);
        const bf16* r0 = QKVC + (size_t)(row0 < 0 ? 0 : row0) * CDIM; const bf16* r1 = QKVC + (size_t)(row1 < 0 ? 0 : row1) * CDIM;
        f32x16 kk00, kk10, kk11, qk00, qk10, qk11;
#pragma unroll
        for (int i = 0; i < 16; ++i) { kk00[i] = 0.f; kk10[i] = 0.f; kk11[i] = 0.f; qk00[i] = 0.f; qk10[i] = 0.f; qk11[i] = 0.f; }
        const int sm = sw23(m);
        const int ktl = half * 32 + ((sm >> 4) & 1) * 512 + ((sm >> 3) & 1) * 256 + (sm & 7);
#pragma unroll 1
        for (int kh = 0; kh < 2; ++kh) {
            bf16x8 kf0[4], kf1[4], qf0[4], qf1[4];
#pragma unroll
            for (int u = 0; u < 4; ++u) { const int off = hq * 128 + 16 * (4 * kh + u) + 8 * half;
                kf0[u] = sel8(row0 >= 0, *(const bf16x8*)(r0 + 2048 + off)); kf1[u] = sel8(row1 >= 0, *(const bf16x8*)(r1 + 2048 + off));
                qf0[u] = sel8(row0 >= 0, *(const bf16x8*)(r0 + off)); qf1[u] = sel8(row1 >= 0, *(const bf16x8*)(r1 + off)); }
#pragma unroll
            for (int u = 0; u < 4; ++u) { const int ks = 4 * kh + u; const bf16x8 k0 = kf0[u], k1 = kf1[u], q0 = qf0[u], q1 = qf1[u];
                kk00 = MFMA32(k0, k0, kk00); kk10 = MFMA32(k1, k0, kk10); kk11 = MFMA32(k1, k1, kk11);
                qk00 = MFMA32(q0, k0, qk00); qk10 = MFMA32(q1, k0, qk10); qk11 = MFMA32(q1, k1, qk11);
                LAS bf16* kb = st + ktl + ((ks >> 1) & 1) * 2048 + (ks & 1) * 128;
#pragma unroll
                for (int e = 0; e < 8; ++e) { kb[(8 * (e >> 2) + (e & 3)) * 8] = (bf16)k0[e]; kb[1024 + (8 * (e >> 2) + (e & 3)) * 8] = (bf16)k1[e]; } }
            stage_out8k(stg, KT + (size_t)uq * 8192 + kh * 4096, lane);
        }
#pragma unroll 1
        for (int hh = 0; hh < 2; ++hh) { const int h = 2 * hq + hh; bf16* vt = VT + (((size_t)(b * 32 + h)) * NCH + c) * 8192;
            const int vtl = half * 64 + ((sm >> 4) & 1) * 512 + ((sm >> 3) & 1) * 256 + (sm & 7);
            bf16x8 vf0[8], vf1[8];
#pragma unroll
            for (int ks = 0; ks < 8; ++ks) { const int off = 4096 + h * 128 + 16 * ks + 8 * half; vf0[ks] = sel8(row0 >= 0, *(const bf16x8*)(r0 + off)); vf1[ks] = sel8(row1 >= 0, *(const bf16x8*)(r1 + off)); }
#pragma unroll
            for (int kh = 0; kh < 2; ++kh) {
#pragma unroll
                for (int u = 0; u < 4; ++u) { const int ks = 4 * kh + u; LAS bf16* vb = st + vtl + ((ks >> 1) & 1) * 2048 + (ks & 1) * 128;
#pragma unroll
                    for (int e = 0; e < 8; ++e) { vb[e * 8] = (bf16)vf0[ks][e]; vb[1024 + e * 8] = (bf16)vf1[ks][e]; } }
                stage_out8k(stg, vt + kh * 4096, lane);
            } }
        WAVE_SYNC();
#pragma unroll 1
        for (int hh = 0; hh < 2; ++hh) { const int h = 2 * hq + hh; const size_t uh = ((size_t)(b * 32 + h)) * NCH + c;
            float* af = AF + uh * 4096 + half * 256 + m;
            LAS bf16* pg = st + ktl;
            const float gcj0 = lg[hh * 64 + m], gcj1 = lg[hh * 64 + 32 + m];
#pragma unroll
            for (int r = 0; r < 16; ++r) { const int ir = crow32(r, half), rc = (r & 3) + 8 * (r >> 2);
                const float gi0 = lg[hh * 64 + ir], gi1 = lg[hh * 64 + 32 + ir], bi0 = lg[128 + hh * 64 + ir], bi1 = lg[128 + hh * 64 + 32 + ir];
                { const int i = ir, j = m; const float dec = __expf(fminf(gi0 - gcj0, 0.f)); af[rc * 64] = (j < i) ? bi0 * dec * kk00[r] : 0.f; pg[rc * 8] = f2bf((j <= i) ? dec * qk00[r] : 0.f); }
                { const int i = 32 + ir, j = m; const float dec = __expf(fminf(gi1 - gcj0, 0.f)); af[2048 + rc * 64] = bi1 * dec * kk10[r]; pg[2048 + rc * 8] = f2bf(dec * qk10[r]); }
                { const int i = 32 + ir, j = 32 + m; const float dec = __expf(fminf(gi1 - gcj1, 0.f)); af[2048 + 32 + rc * 64] = (j < i) ? bi1 * dec * kk11[r] : 0.f; pg[2048 + 1024 + rc * 8] = f2bf((j <= i) ? dec * qk11[r] : 0.f); }
            }
            stage_out8k(stg, PG + uh * 4096, lane); }
        WAVE_SYNC();
    }
}
__device__ __forceinline__ void delta_d2_unit(unsigned char* ws, LAS unsigned char* lds, int uh, int wave, int lane) {
    asm volatile("" : "+v"(lane));
    const float* AF = (const float*)(ws + WS_DAF); const float* GC = (const float*)(ws + WS_DGC); const float* BT = (const float*)(ws + WS_DBT);
    bf16* TG = (bf16*)(ws + WS_DTG); bf16* TB = (bf16*)(ws + WS_DTB);
    {
        const float* af = AF + (size_t)uh * 4096;
        const float bc = BT[(size_t)uh * 64 + lane], gmc = __expf(GC[(size_t)uh * 64 + lane]);
        float T[64];
        const bool pad0 = (uh % NCH) == 0;
#pragma unroll
        for (int i0 = 0; i0 < 64; i0 += 16) {
            float ar[16];
#pragma unroll
            for (int u = 0; u < 16; ++u) ar[u] = af[(i0 + u) * 64 + lane];
            if (pad0 && i0 < 32) {
#pragma unroll
                for (int u = 0; u < 16; ++u) T[i0 + u] = (lane == i0 + u) ? 1.f : 0.f;
            } else {
#pragma unroll
                for (int u = 0; u < 16; ++u) { const int i = i0 + u; float pa[4] = {(lane == i) ? 1.f : 0.f, 0.f, 0.f, 0.f};
#pragma unroll
                    for (int j = 0; j < i; ++j) pa[j & 3] -= __int_as_float(__builtin_amdgcn_readlane(__float_as_int(ar[u]), j)) * T[j];
                    T[i] = (pa[0] + pa[1]) + (pa[2] + pa[3]); }
            }
        }
        bf16* tg = TG + (size_t)uh * 4096; bf16* tb = TB + (size_t)uh * 4096;
        const float sg = bc * gmc;
        const int cs = (lane & ~31) + sw23(lane & 31);
        const int lcol = (cs >> 4) * 512 + ((cs >> 3) & 1) * 256 + (cs & 7);
        LAS unsigned char* stg = lds + wave * 16384 + 2048; LAS bf16* st = (LAS bf16*)stg;
#pragma unroll
        for (int i = 0; i < 64; ++i) st[(i >> 5) * 2048 + (i & 31) * 8 + lcol] = f2bf(T[i] * sg);
        stage_out8k(stg, tg, lane);
#pragma unroll
        for (int i = 0; i < 64; ++i) st[(i >> 5) * 2048 + (i & 31) * 8 + lcol] = f2bf(T[i] * bc);
        stage_out8k(stg, tb, lane);
    }
}
__device__ __forceinline__ void delta_d3_unit(unsigned char* ws, int uh, int lane) {
    asm volatile("" : "+v"(lane));
    const bf16* TG = (const bf16*)(ws + WS_DTG); const bf16* TB = (const bf16*)(ws + WS_DTB); const bf16* KT = (const bf16*)(ws + WS_DKT); const bf16* VT = (const bf16*)(ws + WS_DVT);
    bf16* WG = (bf16*)(ws + WS_DWG); bf16* UG = (bf16*)(ws + WS_DUG);
    const int m = lane & 31, half = lane >> 5;
    const int c = uh % NCH, bh = uh / NCH, h = bh & 31, b = bh >> 5;
    const size_t uq = ((size_t)(b * 16 + (h >> 1))) * NCH + c;
    {
        const bf16* Tm = TG + (size_t)uh * 4096; const bf16* Kf = KT + uq * 8192;
        f32x16 acc[4][2];
#pragma unroll
        for (int dn = 0; dn < 4; ++dn)
#pragma unroll
            for (int ti = 0; ti < 2; ++ti)
#pragma unroll
                for (int i = 0; i < 16; ++i) acc[dn][ti][i] = 0.f;
#pragma unroll
        for (int ks = 0; ks < 4; ++ks) {
            bf16x8 a[4], bb[2];
#pragma unroll
            for (int dn = 0; dn < 4; ++dn) a[dn] = *(const bf16x8*)(Kf + ((size_t)(((dn * 2 + (ks >> 1)) * 2 + (ks & 1)) * 64 + lane)) * 8);
#pragma unroll
            for (int ti = 0; ti < 2; ++ti) bb[ti] = *(const bf16x8*)(Tm + ((size_t)((ti * 4 + ks) * 64 + lane)) * 8);
#pragma unroll
            for (int dn = 0; dn < 4; ++dn)
#pragma unroll
                for (int ti = 0; ti < 2; ++ti) acc[dn][ti] = MFMA32(a[dn], bb[ti], acc[dn][ti]);
        }
        bf16* wg = WG + (size_t)uh * 8192;
#pragma unroll
        for (int dn = 0; dn < 4; ++dn)
#pragma unroll
            for (int ti = 0; ti < 2; ++ti)
#pragma unroll
                for (int s2 = 0; s2 < 2; ++s2) *(v4u*)(wg + ((size_t)(((ti * 4 + dn) * 2 + s2) * 64 + lane)) * 8) = pack_frag(acc[dn][ti], s2);
    }
    {
        const bf16* Tm = TB + (size_t)uh * 4096; const bf16* Bt = VT + (size_t)uh * 8192;
        f32x16 acc[2][4];
#pragma unroll
        for (int ti = 0; ti < 2; ++ti)
#pragma unroll
            for (int dn = 0; dn < 4; ++dn)
#pragma unroll
                for (int i = 0; i < 16; ++i) acc[ti][dn][i] = 0.f;
#pragma unroll
        for (int ks = 0; ks < 4; ++ks) {
            bf16x8 a[2], bb[4];
#pragma unroll
            for (int ti = 0; ti < 2; ++ti) a[ti] = *(const bf16x8*)(Tm + ((size_t)((ti * 4 + ks) * 64 + lane)) * 8);
#pragma unroll
            for (int dn = 0; dn < 4; ++dn) bb[dn] = *(const bf16x8*)(Bt + ((size_t)((dn * 4 + ks) * 64 + lane)) * 8);
#pragma unroll
            for (int ti = 0; ti < 2; ++ti)
#pragma unroll
                for (int dn = 0; dn < 4; ++dn) acc[ti][dn] = MFMA32(a[ti], bb[dn], acc[ti][dn]);
        }
        bf16* ug = UG + (size_t)uh * 8192;
#pragma unroll
        for (int ti = 0; ti < 2; ++ti)
#pragma unroll
            for (int dn = 0; dn < 4; ++dn) { bf16* p = ug + ((size_t)((ti * 4 + dn) * 64 + lane)) * 16; *(v4u*)p = pack_frag(acc[ti][dn], 0); *(v4u*)(p + 8) = pack_frag(acc[ti][dn], 1); }
    }
}
__device__ __forceinline__ void delta_pre(unsigned char* ws, LAS unsigned char* lds, int gw, int NGW, int wave, int lane) {
    const int nextra = (NUQ > NGW && NUQ < 2 * NGW) ? NUQ - NGW : 0;
    for (int rep = 0; rep < 2 || nextra == 0; ++rep) {
        int uq;
        if (nextra == 0) { uq = gw + rep * NGW; if (uq >= NUQ) break; }
        else if (rep == 0) uq = gw;
        else { if ((gw & 63) != 0 || (gw >> 6) >= nextra) break; uq = NGW + (gw >> 6); }
#ifndef NO_D1
        delta_d1_unit(ws, lds, uq, wave, lane);
#endif
#ifdef DUP_D1
        delta_d1_unit(ws, lds, uq, wave, lane);
#endif
        asm volatile("s_waitcnt vmcnt(0)" ::: "memory");
        const int c = uq % NCH, bh = uq / NCH, hq = bh & 15, b = bh >> 4;
#pragma unroll 1
        for (int hh = 0; hh < 2; ++hh) { const int uh = (b * 32 + 2 * hq + hh) * NCH + c;
#ifndef NO_D2
            delta_d2_unit(ws, lds, uh, wave, lane);
#endif
#ifdef DUP_D2
            delta_d2_unit(ws, lds, uh, wave, lane);
#endif
            asm volatile("s_waitcnt vmcnt(0)" ::: "memory");
#ifndef NO_D3
            delta_d3_unit(ws, uh, lane);
#endif
#ifdef DUP_D3
            delta_d3_unit(ws, uh, lane);
#endif
        }
    }
}
__device__ __forceinline__ bf16x8 afrag_perm(const bf16* rowp, int blk, int s, int half) {
    const v2u lo = *(const v2u*)(rowp + 32 * blk + 16 * s + 4 * half), hi2 = *(const v2u*)(rowp + 32 * blk + 16 * s + 8 + 4 * half);
    v4u w; w.x = lo.x; w.y = lo.y; w.z = hi2.x; w.w = hi2.y; return __builtin_bit_cast(bf16x8, w);
}
#define LBAR() asm volatile("s_waitcnt lgkmcnt(0)\n\ts_barrier" ::: "memory")
__device__ __forceinline__ void delta_d4(unsigned char* ws, float* out_state, LAS unsigned char* lds, int tid, int wave, int lane) {
    const bf16* QKVC = (const bf16*)(ws + WS_QKVC); const bf16* KT = (const bf16*)(ws + WS_DKT); const bf16* PG = (const bf16*)(ws + WS_DPG);
    const bf16* WG = (const bf16*)(ws + WS_DWG); const bf16* UG = (const bf16*)(ws + WS_DUG); const float* GC = (const float*)(ws + WS_DGC);
    bf16* OF = (bf16*)(ws + WS_SC);
    LAS v4u* Sfr = (LAS v4u*)lds;
    LAS v4u* Dfr = (LAS v4u*)(lds + 16384);
    LAS v4u* Dtf = (LAS v4u*)(lds + 16384 + 4096);
    LAS float* gam = (LAS float*)(lds + 16384 + 8192);
    const int m = lane & 31, half = lane >> 5;
    const bf16x8 zf = {0, 0, 0, 0, 0, 0, 0, 0};
    for (int item = blockIdx.x; item < NBP * 32 * 4; item += gridDim.x) {
        const int xg = item & 7, jj = item >> 3, pair = xg * 4 + (jj >> 3), q = jj & 3, h = 2 * (pair & 15) + ((jj >> 2) & 1), b = pair >> 4;
        const size_t uh0 = ((size_t)(b * 32 + h)) * NCH, uq0 = ((size_t)(b * 16 + (h >> 1))) * NCH;
        const int rt = wave & 1; const bool isq = wave >= 6;
#define ROT3(LOADM, STEPM) do { LOADM(0, 0); LOADM(1, 1); \
            for (int c = 0; c < NCH; c += 3) { \
                if (c + 2 < NCH) LOADM(c + 2, 2); \
                STEPM(c, 0); \
                if (c + 1 < NCH) { if (c + 3 < NCH) LOADM(c + 3, 0); STEPM(c + 1, 1); } \
                if (c + 2 < NCH) { if (c + 4 < NCH) LOADM(c + 4, 1); STEPM(c + 2, 2); } } } while (0)
#define ROT2(LOADM, STEPM) do { LOADM(0, 0); \
            for (int c = 0; c < NCH; c += 2) { \
                if (c + 1 < NCH) LOADM(c + 1, 1); \
                STEPM(c, 0); \
                if (c + 1 < NCH) { if (c + 2 < NCH) LOADM(c + 2, 0); STEPM(c + 1, 1); } } } while (0)
        LBAR();
        if (wave < 4) {
            int ll_ = lane; asm volatile("" : "+v"(ll_)); const int lane = ll_, m = lane & 31, half = lane >> 5; (void)m; (void)half;
            { const v4u z = {0u, 0u, 0u, 0u}; Sfr[(0 * 4 + wave) * 128 + lane] = z; Sfr[(0 * 4 + wave) * 128 + 64 + lane] = z; }
            bf16x8 kf[2][4];
            f32x16 S;
#pragma unroll
            for (int i = 0; i < 16; ++i) S[i] = 0.f;
#define LOAD_K(cc, B) do { const bf16* kr_ = KT + (uq0 + (cc)) * 8192; \
                _Pragma("unroll") for (int blk = 0; blk < 2; ++blk) _Pragma("unroll") for (int s_ = 0; s_ < 2; ++s_) kf[B][blk * 2 + s_] = *(const bf16x8*)(kr_ + ((size_t)(((wave * 2 + blk) * 2 + s_) * 64 + lane)) * 8); } while (0)
#define STEP_K(c, B) do { const int bufc = (c) & 1; LBAR(); LBAR(); \
                const float gl = gam[bufc * 64 + 63]; \
                _Pragma("unroll") for (int i = 0; i < 16; ++i) S[i] *= gl; \
                _Pragma("unroll") for (int blk = 0; blk < 2; ++blk) _Pragma("unroll") for (int s = 0; s < 2; ++s) S = MFMA32(kf[B][blk * 2 + s], __builtin_bit_cast(bf16x8, Dtf[(blk * 2 + s) * 64 + lane]), S); \
                _Pragma("unroll") for (int s = 0; s < 2; ++s) Sfr[((bufc ^ 1) * 4 + wave) * 128 + s * 64 + lane] = pack_frag(S, s); } while (0)
#ifndef NO_RK
            ROT2(LOAD_K, STEP_K);
#endif
            { float* o = out_state + ((size_t)((b * 32 + h) * 128 + 32 * wave)) * 128 + 32 * q + m;
#pragma unroll
              for (int r = 0; r < 16; ++r) o[(size_t)sw23(crow32(r, half)) * 128] = S[r]; }
#undef LOAD_K
#undef STEP_K
        } else if (!isq) {
            int ll_ = lane; asm volatile("" : "+v"(ll_)); const int lane = ll_, m = lane & 31, half = lane >> 5; (void)m; (void)half;
            bf16x8 wf[3][8], uf[3][2]; float gcv[3] = {0.f, 0.f, 0.f};
#define LOAD_W(cc, B) do { const bf16* wb_ = WG + (uh0 + (cc)) * 8192 + ((size_t)(rt * 512 + lane)) * 8; \
                _Pragma("unroll") for (int blk = 0; blk < 4; ++blk) _Pragma("unroll") for (int s_ = 0; s_ < 2; ++s_) wf[B][blk * 2 + s_] = *(const bf16x8*)(wb_ + blk * 1024 + s_ * 512); \
                const bf16* ub_ = UG + (uh0 + (cc)) * 8192 + ((size_t)((rt * 4 + q) * 64 + lane)) * 16; uf[B][0] = *(const bf16x8*)ub_; uf[B][1] = *(const bf16x8*)(ub_ + 8); \
                if (wave == 4) gcv[B] = GC[(uh0 + (cc)) * 64 + lane]; } while (0)
#define STEP_W(c, B) do { const int bufc = (c) & 1; LBAR(); \
                f32x16 acc; \
                _Pragma("unroll") for (int i = 0; i < 16; ++i) acc[i] = 0.f; \
                _Pragma("unroll") for (int blk = 0; blk < 4; ++blk) _Pragma("unroll") for (int s = 0; s < 2; ++s) \
                    acc = MFMA32(wf[B][blk * 2 + s], __builtin_bit_cast(bf16x8, Sfr[(bufc * 4 + blk) * 128 + s * 64 + lane]), acc); \
                { float t8[8]; unpack8(__builtin_bit_cast(v4u, uf[B][0]), t8); \
                    _Pragma("unroll") for (int i = 0; i < 8; ++i) acc[i] = t8[i] - acc[i]; unpack8(__builtin_bit_cast(v4u, uf[B][1]), t8); \
                    _Pragma("unroll") for (int i = 0; i < 8; ++i) acc[8 + i] = t8[i] - acc[8 + i]; } \
                _Pragma("unroll") for (int s = 0; s < 2; ++s) Dfr[(rt * 2 + s) * 64 + lane] = pack_frag(acc, s); \
                _Pragma("unroll") for (int r = 0; r < 16; ++r) acc[r] *= gam[128 + bufc * 64 + 32 * rt + crow32(r, half)]; \
                _Pragma("unroll") for (int s = 0; s < 2; ++s) Dtf[(rt * 2 + s) * 64 + lane] = pack_frag(acc, s); \
                LBAR(); \
                if (wave == 4 && (c) + 1 < NCH) { const float gn_ = gcv[((B) + 1) % 3], gl_ = __shfl(gn_, 63); gam[(bufc ^ 1) * 64 + lane] = __expf(gn_); gam[128 + (bufc ^ 1) * 64 + lane] = __expf(gl_ - gn_); } } while (0)
            if (wave == 4) { const float gc = GC[(uh0 + 0) * 64 + lane], gl = __shfl(gc, 63); gam[lane] = __expf(gc); gam[128 + lane] = __expf(gl - gc); }
#ifndef NO_RW
            ROT3(LOAD_W, STEP_W);
#endif
#undef LOAD_W
#undef STEP_W
        } else {
            int ll_ = lane; asm volatile("" : "+v"(ll_)); const int lane = ll_, m = lane & 31, half = lane >> 5; (void)m; (void)half;
            bf16x8 qf[1][8], pf[1][4];
#define LOAD_Q(cc, B) do { const int row_ = chunk_row(b, (cc), 32 * rt + m); const bool ok_ = row_ >= 0; \
                const bf16* qb_ = QKVC + (size_t)(row_ < 0 ? 0 : row_) * CDIM + (h >> 1) * 128 + 8 * half; \
                _Pragma("unroll") for (int blk = 0; blk < 4; ++blk) _Pragma("unroll") for (int s_ = 0; s_ < 2; ++s_) qf[B][blk * 2 + s_] = sel8(ok_, *(const bf16x8*)(qb_ + blk * 32 + s_ * 16)); \
                } while (0)
#define LOAD_P(cc, PB) do { const bf16* pb_ = PG + (uh0 + (cc)) * 4096 + ((size_t)(rt * 256 + lane)) * 8; \
                _Pragma("unroll") for (int blk = 0; blk < 2; ++blk) _Pragma("unroll") for (int s_ = 0; s_ < 2; ++s_) pf[PB][blk * 2 + s_] = sel8(blk <= rt, *(const bf16x8*)(pb_ + blk * 1024 + s_ * 512)); } while (0)
#define STEP_Q(c) do { const int bufc = (c) & 1; LBAR(); \
                LOAD_P((c), 0);                                                    \
                f32x16 acc; \
                _Pragma("unroll") for (int i = 0; i < 16; ++i) acc[i] = 0.f; \
                _Pragma("unroll") for (int blk = 0; blk < 4; ++blk) _Pragma("unroll") for (int s = 0; s < 2; ++s) \
                    acc = MFMA32(qf[0][blk * 2 + s], __builtin_bit_cast(bf16x8, Sfr[(bufc * 4 + blk) * 128 + s * 64 + lane]), acc); \
                if ((c) + 1 < NCH) LOAD_Q((c) + 1, 0);                             \
                LBAR(); \
                _Pragma("unroll") for (int r = 0; r < 16; ++r) acc[r] *= gam[bufc * 64 + 32 * rt + crow32(r, half)]; \
                _Pragma("unroll") for (int blk = 0; blk < 2; ++blk) _Pragma("unroll") for (int s = 0; s < 2; ++s) acc = MFMA32(pf[0][blk * 2 + s], __builtin_bit_cast(bf16x8, Dfr[(blk * 2 + s) * 64 + lane]), acc); \
                _Pragma("unroll") for (int r = 0; r < 16; ++r) { const int row = chunk_row(b, (c), 32 * rt + crow32(r, half)); if (row >= 0) OF[(size_t)row * DVW + h * 128 + 32 * q + m] = f2bf(acc[r]); } } while (0)
#ifndef NO_RQ
            LOAD_Q(0, 0);
            for (int c = 0; c < NCH; ++c) STEP_Q(c);
#endif
#undef LOAD_Q
#undef LOAD_P
#undef STEP_Q
        }
#undef ROT2
#undef ROT3
    }
    LBAR();
}
#undef LBAR
#undef MFMA32
template <int RT, int CT, class Epi>
__device__ __forceinline__ void small_gemm_unit(const bf16* A, int lda, const bf16* Bt, int ldb, int k0, int klen, LAS unsigned char* lds, const Epi& E, int tid, int wave, int lane) {
    const int r16 = lane & 15, q = lane >> 4;
    const int kw = klen >> 3;
    const bf16* ap = A + (size_t)r16 * lda + k0 + wave * kw + 8 * q;
    const bf16* bp = Bt + (size_t)r16 * ldb + k0 + wave * kw + 8 * q;
    pg8::f32x4 acc[RT][CT];
#pragma unroll
    for (int i = 0; i < RT; ++i)
#pragma unroll
        for (int j = 0; j < CT; ++j) acc[i][j] = (pg8::f32x4){0.f, 0.f, 0.f, 0.f};
#pragma unroll 4
    for (int ks = 0; ks < kw; ks += 32) {
        bf16x8 a[RT], b[CT];
#pragma unroll
        for (int i = 0; i < RT; ++i) a[i] = *(const bf16x8*)(ap + (size_t)(16 * i) * lda + ks);
#pragma unroll
        for (int j = 0; j < CT; ++j) b[j] = *(const bf16x8*)(bp + (size_t)(16 * j) * ldb + ks);
#pragma unroll
        for (int i = 0; i < RT; ++i)
#pragma unroll
            for (int j = 0; j < CT; ++j) acc[i][j] = __builtin_amdgcn_mfma_f32_16x16x32_bf16(a[i], b[j], acc[i][j], 0, 0, 0);
    }
    constexpr int NOUT = 256 * RT * CT;
    LAS float* part = (LAS float*)lds + wave * NOUT;
#pragma unroll
    for (int i = 0; i < RT; ++i)
#pragma unroll
        for (int j = 0; j < CT; ++j)
#pragma unroll
            for (int e = 0; e < 4; ++e) part[(16 * i + 4 * q + e) * (16 * CT) + 16 * j + r16] = acc[i][j][e];
    __syncthreads();
    for (int o = tid; o < NOUT; o += NTHREADS) { float sum = 0.f;
#pragma unroll
        for (int w = 0; w < 8; ++w) sum += ((LAS float*)lds)[w * NOUT + o];
        E(o / (16 * CT), o % (16 * CT), sum); }
    __syncthreads();
}
template <int ACT> struct SEpiRowsBf16 { bf16* O; int ldc; __device__ __forceinline__ void operator()(int row, int col, float v) const { if (ACT == 2) { v = v > 0.f ? v : 0.f; v = v * v; } O[(size_t)row * ldc + col] = f2bf(v); } };
struct SEpiF32 { float* O; int ldc; __device__ __forceinline__ void operator()(int row, int col, float v) const { O[(size_t)row * ldc + col] = v; } };
struct SEpiColsBf16 { bf16* O; int ldc; __device__ __forceinline__ void operator()(int row, int col, float v) const { O[(size_t)col * ldc + row] = f2bf(v); } };
template <int ACT> __device__ __forceinline__ void skinny_rows_bf16(const bf16* A, const bf16* Wt, int K, int nunits, bf16* O, int ldc, LAS unsigned char* lds, int tid, int wave, int lane) {
    for (int u = blockIdx.x; u < nunits; u += gridDim.x) { SEpiRowsBf16<ACT> E{O + (size_t)XROW0 * ldc + u * 64, ldc};
        small_gemm_unit<3, 4>(A + (size_t)XROW0 * K, K, Wt + (size_t)u * 64 * K, K, 0, K, lds, E, tid, wave, lane); }
}
__device__ __forceinline__ void skinny_rows_part(const bf16* A, const bf16* Wt, int K, float* ZP, LAS unsigned char* lds, int tid, int wave, int lane) {
    for (int u = blockIdx.x; u < 256; u += gridDim.x) { const int cgp = u & 31, ksl = u >> 5; SEpiF32 E{ZP + (size_t)ksl * XR * DM + cgp * 64, DM};
        small_gemm_unit<3, 4>(A + (size_t)XROW0 * K, K, Wt + (size_t)cgp * 64 * K, K, ksl * (K >> 3), K >> 3, lds, E, tid, wave, lane); }
}
template <int RT> __device__ __forceinline__ void tail_cols_bf16(const bf16* A, const bf16* Wt, int K, int c0, bf16* O, int ldc, LAS unsigned char* lds, int tid, int wave, int lane) {
    for (int u = blockIdx.x; u < MAINM / 32; u += gridDim.x) { SEpiColsBf16 E{O + (size_t)u * 32 * ldc + c0, ldc};
        small_gemm_unit<RT, 2>(Wt + (size_t)c0 * K, K, A + (size_t)u * 32 * K, K, 0, K, lds, E, tid, wave, lane); }
}

typedef __attribute__((address_space(4))) const unsigned long long* kargq_t;
#define KPF_(k) ((const float*)(const GAS float*)(q_[k]))
__device__ __forceinline__ void load_ptrs(Ptrs& P) {
    kargq_t q_ = (kargq_t)__builtin_amdgcn_kernarg_segment_ptr();
    asm volatile("" : "+s"(q_));
    P.x_prompt = KPF_(0); P.x_sample = KPF_(1); P.state_conv_a = KPF_(2); P.cache_k = KPF_(3);
    P.cache_v = KPF_(4); P.cache_ik = KPF_(5); P.state_conv_c = KPF_(6); P.state_delta = KPF_(7);
    P.page_table = ((const int*)(const GAS int*)(q_[8])); P.meta = KPF_(9); P.w_in_a = KPF_(10); P.conv_w_a = KPF_(11);
    P.w_out_a = KPF_(12); P.w_in_b = KPF_(13); P.w_out_b = KPF_(14); P.w_in_c = KPF_(15);
    P.conv_w_c = KPF_(16); P.a_log = KPF_(17); P.dt_bias = KPF_(18); P.norm_w = KPF_(19);
    P.w_out_c = KPF_(20); P.ln1_g = KPF_(21); P.ln1_b = KPF_(22); P.w1 = KPF_(23);
    P.w2 = KPF_(24); P.ln2_g = KPF_(25); P.ln2_b = KPF_(26);
    P.out = (float*)(GAS float*)(q_[27]); P.ws = (unsigned char*)(GAS unsigned char*)(q_[28]);
}
struct Args { const void* in[27]; float* out; unsigned char* ws; int ph_lo, ph_hi; };
constexpr int PH_PER_LAYER = 12, PH_END = 1 + 4 * PH_PER_LAYER;

__global__ void __launch_bounds__(NTHREADS, 2) mega_fwd(Args args) {
    extern __shared__ __attribute__((aligned(16))) unsigned char lds_raw[];
    LAS unsigned char* lds = (LAS unsigned char*)lds_raw;
    const int tid = threadIdx.x, lane = tid & 63, wave = __builtin_amdgcn_readfirstlane(tid >> 6);
    const int G_ = gridDim.x, NGW = G_ * NWAVES, NT = G_ * NTHREADS; (void)lane;
    unsigned char* ws = args.ws;
    const int lo = args.ph_lo, hi = args.ph_hi;
    const bool fused = (hi - lo) > 1;

    for (int u = tid; u < (LDS_BYTES - LDSCTL_OFF) / 4; u += NTHREADS) ((LAS unsigned*)(lds + LDSCTL_OFF))[u] = 0u;
    __syncthreads();
    volatile LAS unsigned* MISC = (volatile LAS unsigned*)(lds + MISC_OFF);
    XcdBarrier bar; bar.bar = (unsigned*)(ws + WS_CTL) + CW_BAR; bar.x = 0; bar.st = nullptr;
    if (fused) bar = xcd_barrier_post((unsigned*)(ws + WS_CTL) + CW_BAR, MISC + 8);
    bar.wv = wave;

#ifndef MK_SITES
#define MK_SITES 0xffffffffu
#endif
#define SITE(n) (((MK_SITES) >> (n)) & 1u)
#define IN(k) (lo <= (k) && (k) < hi)
#ifndef MK_DUP
#define MK_DUP 0u
#endif
#define NREP(n) ((((MK_DUP) >> (n)) & 1u) ? 2 : 1)
#ifdef MK_SKINNY2
#define SKREP 2
#else
#define SKREP 1
#endif
#define BEGIN_SITE(n, id) if (SITE(n) && IN(id)) { for (int rp_ = 0; rp_ < NREP(n); ++rp_) { Ptrs P; load_ptrs(P); unsigned char* ws = P.ws; (void)ws; \
    bf16* X = (bf16*)(P.ws + WS_X); float* Z = (float*)(P.ws + WS_Z); float* ZP = (float*)(P.ws + WS_ZP); bf16* Y = (bf16*)(P.ws + WS_Y); bf16* BIG = (bf16*)(P.ws + WS_BIG); (void)X; (void)Z; (void)ZP; (void)Y; (void)BIG;
#define END_SITE(id) SEAM(id); } }
#define LOCALS int tid_ = threadIdx.x; asm volatile("" : "+v"(tid_)); const int lane_ = tid_ & 63, wave_ = __builtin_amdgcn_readfirstlane(tid_ >> 6), gw_ = blockIdx.x * NWAVES + wave_, gtid_ = blockIdx.x * NTHREADS + tid_; (void)lane_; (void)wave_; (void)gw_; (void)gtid_
#define SEAM(k) do { if (fused && (k) + 1 < PH_END) xcd_barrier(bar); else __syncthreads(); } while (0)


    BEGIN_SITE(0, 0) LOCALS; p0_prologue(P, lds, gw_, NGW, wave_, lane_); END_SITE(0)
#ifdef MK_XBAR
    if (fused) { for (int xb_ = 0; xb_ < MK_XBAR; ++xb_) xcd_barrier(bar); }
#endif

    for (int layer = 0; layer < 4; ++layer) {
        const int kind = layer % 3, j = layer / 3, base = 1 + layer * PH_PER_LAYER;
        if (kind == 0) {
            BEGIN_SITE(1, base + 0)
                const bf16* Wt = (const bf16*)(ws + WS_WA_IN + (size_t)j * WSZ_A_IN); pg8::Gemm g{X, Wt, MAINM, NA_IN, DM}; pg8::StaticOrder S; S.init(MAINM, NA_IN, G_, (int)blockIdx.x);
                pg8::EpiBf16<0> E{BIG, NA_IN, nullptr, 0, 0, 1.f};
                pg8::gemm_phase<pg8::EpiBf16<0>, pg8::StaticOrder, true, true>(lds, g, S, E, wave);
                { LOCALS; for (int sk_ = 0; sk_ < SKREP; ++sk_) { skinny_rows_bf16<0>(X, Wt, DM, NA_IN / 64, BIG, NA_IN, lds, tid_, wave_, lane_); } }
                END_SITE(base + 0)
            BEGIN_SITE(2, base + 1)
                LOCALS; convA_phase(BIG, Y, P.conv_w_a + (size_t)j * 3 * DM, P.state_conv_a + (size_t)j * SBN * 2 * DM, P.out + O_CAP + (size_t)j * NBP * 2 * DM, P.out + O_CAS + (size_t)j * SBN * 2 * DM, gtid_, NT);
                END_SITE(base + 1)
            BEGIN_SITE(3, base + 2)
                const bf16* Wt = (const bf16*)(ws + WS_WA_OUT + (size_t)j * WSZ_A_OUT); pg8::Gemm g{Y, Wt, MAINM, DM, DM}; pg8::StaticOrder S; S.init(MAINM, DM, G_, (int)blockIdx.x);
                pg8::EpiResBf16 E{X, DM, ALPHA};
                pg8::gemm_phase<pg8::EpiResBf16, pg8::StaticOrder, true, true>(lds, g, S, E, wave);
                { LOCALS; for (int sk_ = 0; sk_ < SKREP; ++sk_) { skinny_rows_part(Y, Wt, DM, ZP, lds, tid_, wave_, lane_); } }
                END_SITE(base + 2)
        } else if (kind == 1) {
            BEGIN_SITE(4, base + 0)
                const bf16* Wt = (const bf16*)(ws + WS_WB_IN); pg8::Gemm g{X, Wt, MAINM, 4096, DM}; pg8::StaticOrder S; S.init(MAINM, 4096, G_, (int)blockIdx.x);
                pg8::EpiBf16<0> E{BIG, NB_PAD, nullptr, 0, 0, 1.f};
                pg8::gemm_phase<pg8::EpiBf16<0>, pg8::StaticOrder, true, true>(lds, g, S, E, wave);
                { LOCALS; for (int sk_ = 0; sk_ < SKREP; ++sk_) { tail_cols_bf16<5>(X, Wt, DM, 4096, BIG, NB_PAD, lds, tid_, wave_, lane_); skinny_rows_bf16<0>(X, Wt, DM, 4224 / 64, BIG, NB_PAD, lds, tid_, wave_, lane_); } }
                END_SITE(base + 0)
            BEGIN_SITE(5, base + 1) LOCALS; rope_phase(BIG, P, gw_, NGW, lane_); END_SITE(base + 1)
            BEGIN_SITE(6, base + 2) LOCALS; indexer_sample(P, lds, tid_); indexer_prompt(P, lds, tid_, wave_, lane_); END_SITE(base + 2)
            BEGIN_SITE(7, base + 3) LOCALS; select_phase(P, lds, gw_, NGW, tid_, wave_, lane_); END_SITE(base + 3)
            BEGIN_SITE(8, base + 4) LOCALS; dense_attn_phase(P, Y, (char*)lds_raw, wave_); attn_phase(P, Y, lds, gw_, NGW, wave_, lane_); END_SITE(base + 4)
            BEGIN_SITE(9, base + 5)
                const bf16* Wt = (const bf16*)(ws + WS_WB_OUT); pg8::Gemm g{Y, Wt, MAINM, DM, DM}; pg8::StaticOrder S; S.init(MAINM, DM, G_, (int)blockIdx.x);
                pg8::EpiResBf16 E{X, DM, ALPHA};
                pg8::gemm_phase<pg8::EpiResBf16, pg8::StaticOrder, true, true>(lds, g, S, E, wave);
                { LOCALS; for (int sk_ = 0; sk_ < SKREP; ++sk_) { skinny_rows_part(Y, Wt, DM, ZP, lds, tid_, wave_, lane_); } }
                END_SITE(base + 5)
        } else {
            BEGIN_SITE(10, base + 0)
                const bf16* Wt = (const bf16*)(ws + WS_WC_IN); pg8::Gemm g{X, Wt, MAINM, 12288, DM}; pg8::StaticOrder S; S.init(MAINM, 12288, G_, (int)blockIdx.x);
                pg8::EpiBf16<0> E{BIG, NC_PAD, nullptr, 0, 0, 1.f};
                pg8::gemm_phase<pg8::EpiBf16<0>, pg8::StaticOrder, true, true>(lds, g, S, E, wave);
                { LOCALS; for (int sk_ = 0; sk_ < SKREP; ++sk_) { tail_cols_bf16<4>(X, Wt, DM, 12288, BIG, NC_PAD, lds, tid_, wave_, lane_); skinny_rows_bf16<0>(X, Wt, DM, NC_IN / 64, BIG, NC_PAD, lds, tid_, wave_, lane_); } }
                END_SITE(base + 0)
            BEGIN_SITE(11, base + 1) LOCALS; convC_phase(BIG, P, gw_, NGW, lane_); END_SITE(base + 1)
            BEGIN_SITE(19, base + 2) LOCALS; delta_pre(P.ws, lds, gw_, NGW, wave_, lane_);
                { const int nbusy = (NUQ > NGW && NUQ < 2 * NGW) ? NUQ - NGW : 0;
                  const bool busy = nbusy > 0 && (gw_ & 63) == 0 && (gw_ >> 6) < nbusy; const int below = nbusy == 0 ? 0 : (((gw_ + 63) >> 6) < nbusy ? ((gw_ + 63) >> 6) : nbusy);
                  if (!busy) { delta_phase(P, gw_ - below, NGW - nbusy, lane_); deferred_transposes(P, lds, gw_ - below, NGW - nbusy, wave_, lane_); } }
            END_SITE(base + 2)
            BEGIN_SITE(22, base + 5) LOCALS; delta_d4(P.ws, P.out + O_DP, lds, tid_, wave_, lane_); END_SITE(base + 5)
            BEGIN_SITE(13, base + 6) LOCALS; normC_phase(BIG, Y, P, gw_, NGW, lane_); END_SITE(base + 6)
            BEGIN_SITE(14, base + 7)
                const bf16* Wt = (const bf16*)(ws + WS_WC_OUT); pg8::Gemm g{Y, Wt, MAINM, DM, DVW}; pg8::StaticOrder S; S.init(MAINM, DM, G_, (int)blockIdx.x);
                pg8::EpiResBf16 E{X, DM, ALPHA};
                pg8::gemm_phase<pg8::EpiResBf16, pg8::StaticOrder, true, true>(lds, g, S, E, wave);
                { LOCALS; for (int sk_ = 0; sk_ < SKREP; ++sk_) { skinny_rows_part(Y, Wt, DVW, ZP, lds, tid_, wave_, lane_); } }
                END_SITE(base + 7)
        }
        BEGIN_SITE(15, base + 8) LOCALS; ln_phase(Z, ZP, X, rp_ == 0 ? X : (bf16*)(P.ws + WS_QR), P.ln1_g + (size_t)layer * DM, P.ln1_b + (size_t)layer * DM, nullptr, nullptr, lds, gw_, NGW, tid_, wave_, lane_); END_SITE(base + 8)
        BEGIN_SITE(16, base + 9)
            const bf16* Wt = (const bf16*)(ws + WS_W1 + (size_t)layer * WSZ_W1); pg8::Gemm g{X, Wt, MAINM, FF, DM}; pg8::StaticOrder S; S.init(MAINM, FF, G_, (int)blockIdx.x);
            pg8::EpiBf16<2> E{BIG, FF, nullptr, 0, 0, 1.f};
            pg8::gemm_phase<pg8::EpiBf16<2>, pg8::StaticOrder, true, true>(lds, g, S, E, wave);
            { LOCALS; for (int sk_ = 0; sk_ < SKREP; ++sk_) { skinny_rows_bf16<2>(X, Wt, DM, FF / 64, BIG, FF, lds, tid_, wave_, lane_); } }
            END_SITE(base + 9)
        BEGIN_SITE(17, base + 10)
            const bf16* Wt = (const bf16*)(ws + WS_W2 + (size_t)layer * WSZ_W2); pg8::Gemm g{BIG, Wt, MAINM, DM, FF}; pg8::StaticOrder S; S.init(MAINM, DM, G_, (int)blockIdx.x);
            pg8::EpiResBf16 E{X, DM, ALPHA};
            pg8::gemm_phase<pg8::EpiResBf16, pg8::StaticOrder, true, true>(lds, g, S, E, wave);
            { LOCALS; for (int sk_ = 0; sk_ < SKREP; ++sk_) { skinny_rows_part(BIG, Wt, FF, ZP, lds, tid_, wave_, lane_); } }
            END_SITE(base + 10)
        BEGIN_SITE(18, base + 11)
            const bool last = layer == 3;
            LOCALS; ln_phase(Z, ZP, X, rp_ == 0 ? X : (bf16*)(P.ws + WS_QR), P.ln2_g + (size_t)layer * DM, P.ln2_b + (size_t)layer * DM, last ? P.out + O_YP : nullptr, last ? P.out + O_YS : nullptr, lds, gw_, NGW, tid_, wave_, lane_);
            if (!last) SEAM(base + 11); } }
    }
#undef IN
#undef SEAM
}

#ifndef MK_SPLIT
#define MK_SPLIT 0
#endif
extern "C" void kernel_launch(void* const* d_in, const int* in_sizes, int n_in, void* d_out, int out_size, void* d_ws, size_t ws_size, hipStream_t stream) {
    static int grid = 0;
    if (grid == 0) {
        if (n_in != 27 || (size_t)out_size != O_END || ws_size < WS_END) { fprintf(stderr, "kernel_launch: unexpected shapes: n_in %d out %d (want %zu) ws %zu (want >= %zu)\n", n_in, out_size, (size_t)O_END, ws_size, (size_t)WS_END); grid = -1; return; }
        int dev = 0, cus = 0;
        if (hipGetDevice(&dev) != hipSuccess || hipDeviceGetAttribute(&cus, hipDeviceAttributeMultiprocessorCount, dev) != hipSuccess) { grid = -1; return; }
        if (hipFuncSetAttribute((const void*)mega_fwd, hipFuncAttributeMaxDynamicSharedMemorySize, LDS_BYTES) != hipSuccess) { fprintf(stderr, "kernel_launch: hipFuncSetAttribute failed\n"); grid = -1; return; }
        int per_cu = 0;
        if (hipOccupancyMaxActiveBlocksPerMultiprocessor(&per_cu, (const void*)mega_fwd, NTHREADS, LDS_BYTES) != hipSuccess || per_cu < 1) fprintf(stderr, "kernel_launch: occupancy query reports %d\n", per_cu);
        (void)hipGetLastError();
        grid = cus;
    }
    if (grid < 0) return;
    (void)hipMemsetAsync((char*)d_ws + WS_CTL, 0, CTL_ZERO_BYTES, stream);
    Args a{};
    for (int i = 0; i < 27; ++i) a.in[i] = d_in[i];
    a.out = (float*)d_out; a.ws = (unsigned char*)d_ws;
#if MK_SPLIT
    for (int ph = 0; ph < PH_END; ++ph) {
        bool exists = (ph == 0);
        if (ph > 0) { const int layer = (ph - 1) / PH_PER_LAYER, l = (ph - 1) % PH_PER_LAYER, kind = layer % 3; const int nmix = kind == 0 ? 3 : (kind == 1 ? 6 : 8); exists = (l < nmix) || (l >= 8 && l <= 11); }
        if (!exists) continue;
        a.ph_lo = ph; a.ph_hi = ph + 1;
        hipLaunchKernelGGL(mega_fwd, dim3(grid), dim3(NTHREADS), LDS_BYTES, stream, a);
    }
#else
    a.ph_lo = 0; a.ph_hi = PH_END;
    hipLaunchKernelGGL(mega_fwd, dim3(grid), dim3(NTHREADS), LDS_BYTES, stream, a);
#endif
    const hipError_t le = hipPeekAtLastError();
    if (le != hipSuccess) fprintf(stderr, "kernel_launch: launch failed: %s\n", hipGetErrorName(le));
}
```

```cpp
#include <hip/hip_runtime.h>
#include <cstdio>
#include <cstdint>
#include <cmath>
__device__ __forceinline__ int flane() { return (int)__builtin_amdgcn_mbcnt_hi(~0u, __builtin_amdgcn_mbcnt_lo(~0u, 0u)); }
namespace pg8 {
#define PG8_LAS __attribute__((address_space(3)))
typedef unsigned short bf16_t;
typedef short bf16x8 __attribute__((ext_vector_type(8)));
typedef float f32x4 __attribute__((ext_vector_type(4)));
typedef unsigned u32x4 __attribute__((ext_vector_type(4)));
constexpr int BM = 256, BK = 64, HALF = 128, HTB = HALF * BK * 2  , STAGE_BYTES = 8 * HTB, NXCD = 8, WGM = 8;

__host__ __device__ __forceinline__ int lds_byte(int r, int c) { const int st = (r >> 4) * 2 + (c >> 5), rr = r & 15, cc = c & 31, ob = rr * 64 + cc * 2; return st * 1024 + (ob ^ (((ob >> 9) & 1) << 5)); }
__host__ __device__ __forceinline__ void stage_rc(int b, int& R, int& C) { const int st = b / 1024, sb = b % 1024, swz = sb ^ (((sb >> 9) & 1) << 5); R = (st >> 1) * 16 + swz / 64; C = (st & 1) * 32 + (swz % 64) / 2; }
__host__ __device__ __forceinline__ int perm32(int rho) { const int n = rho >> 4, i = rho & 15; return 8 * (i >> 2) + 4 * n + (i & 3); }

struct Unit { int pm, pn; };
struct Gemm { const bf16_t* A; const bf16_t* Bt; int M, N, K; };

struct StaticOrder {
    int nM, nN, nwg, G, c;
    __host__ __device__ void init(int M, int N, int G_, int c_) { nM = M / BM; nN = N / BM; nwg = nM * nN; G = G_; c = c_; }
    __host__ __device__ bool next(int i, Unit& u) const {
        const long L = (long)i * G + c; if (L >= nwg) return false;
        int wgid = (int)L; { const int q = nwg / NXCD, r = nwg % NXCD, xcd = wgid % NXCD, off = wgid / NXCD; wgid = (xcd < r ? xcd * (q + 1) : r * (q + 1) + (xcd - r) * q) + off; }
        const int nig = WGM * nN, gid = wgid / nig, fm = gid * WGM, gsz = (nM - fm) < WGM ? (nM - fm) : WGM;
        u.pm = fm + ((wgid % nig) % gsz); u.pn = (wgid % nig) / gsz; return true;
    }
    __device__ __forceinline__ void a_ready(const Unit&) const {}
    __device__ __forceinline__ void done(const Unit&) const {}
};

__device__ __forceinline__ unsigned cvt_pk_bf16(float lo, float hi) { unsigned r; asm volatile("v_cvt_pk_bf16_f32 %0, %1, %2" : "=v"(r) : "v"(lo), "v"(hi)); return r; }
typedef float f32x2 __attribute__((ext_vector_type(2)));
__device__ __forceinline__ f32x2 gelu_pk(f32x2 v) {
    const f32x2 av = __builtin_elementwise_abs(v), d = av * 0.2316418882f + 1.0f;
    f32x2 t; t.x = __builtin_amdgcn_rcpf(d.x); t.y = __builtin_amdgcn_rcpf(d.y);
    f32x2 q = t * 0.5307027145f + (-0.7265760135f); q = q * t + 0.7107068705f; q = q * t + (-0.142248368f); q = q * t + 0.127414796f; q = q * t;
    const f32x2 s = (v * v) * (-0.72134752044f);
    f32x2 e; e.x = __builtin_amdgcn_exp2f(s.x); e.y = __builtin_amdgcn_exp2f(s.y);
    const f32x2 m = v * (q * e), r = v - m;
    f32x2 o; o.x = v.x < 0.f ? m.x : r.x; o.y = v.y < 0.f ? m.y : r.y; return o;
}

template <int ACT  > struct EpiBf16 {
    static constexpr bool PERM = true, AFTER_DRAIN = false; static_assert(ACT == 0 || ACT == 1 || ACT == 2, "EpiBf16: ACT is 0 (none), 1 (gelu_pk) or 2 (relu^2)");
    bf16_t* O; int ldc; const float* bias; int split_cols; size_t split_stride; float scale0;
    __device__ __forceinline__ void operator()(const f32x4 (&acc)[2][2][4][2], const Unit& u, int wr, int wc, int fr, int fq) const {
        const int row0 = u.pm * BM + wr * 64 + fr; int colt = u.pn * BM; bf16_t* base = O;
        float sc = 1.f; if (split_cols) { const int t = colt / split_cols; base += (size_t)t * split_stride; colt -= t * split_cols; if (t == 0) sc = scale0; }
        const int col0 = colt + wc * 32 + 8 * fq, bcol0 = u.pn * BM + wc * 32 + 8 * fq;
        f32x4 bv[2][2];
#pragma unroll
        for (int bj = 0; bj < 2; ++bj)
#pragma unroll
            for (int n = 0; n < 2; ++n) bv[bj][n] = bias ? *(const f32x4*)(bias + bcol0 + bj * HALF + 4 * n) : (f32x4){0.f, 0.f, 0.f, 0.f};
#pragma unroll
        for (int ai = 0; ai < 2; ++ai)
#pragma unroll
            for (int m = 0; m < 4; ++m) { bf16_t* rowp = base + (size_t)(row0 + ai * HALF + m * 16) * ldc + col0;
#pragma unroll
                for (int bj = 0; bj < 2; ++bj) { f32x4 v0 = acc[ai][bj][m][0] + bv[bj][0], v1 = acc[ai][bj][m][1] + bv[bj][1];
                    if (ACT == 1) { f32x2 a = gelu_pk((f32x2){v0[0], v0[1]}), b = gelu_pk((f32x2){v0[2], v0[3]}), c = gelu_pk((f32x2){v1[0], v1[1]}), d = gelu_pk((f32x2){v1[2], v1[3]});
                        v0 = (f32x4){a.x, a.y, b.x, b.y}; v1 = (f32x4){c.x, c.y, d.x, d.y}; }
                    if (ACT == 2) { _Pragma("unroll") for (int q_ = 0; q_ < 4; ++q_) { const float a_ = v0[q_] > 0.f ? v0[q_] : 0.f, b_ = v1[q_] > 0.f ? v1[q_] : 0.f; v0[q_] = a_ * a_; v1[q_] = b_ * b_; } }
                    v0 = v0 * sc; v1 = v1 * sc; u32x4 w; w.x = cvt_pk_bf16(v0[0], v0[1]); w.y = cvt_pk_bf16(v0[2], v0[3]); w.z = cvt_pk_bf16(v1[0], v1[1]); w.w = cvt_pk_bf16(v1[2], v1[3]);
                    *(u32x4*)(rowp + bj * HALF) = w; } }
    }
};


struct EpiResBf16 {
    static constexpr bool PERM = true, AFTER_DRAIN = false;
    bf16_t* X; int ldc; float alpha;
    __device__ __forceinline__ void operator()(const f32x4 (&acc)[2][2][4][2], const Unit& u, int wr, int wc, int fr, int fq) const {
        const int row0 = u.pm * BM + wr * 64 + fr, col0 = u.pn * BM + wc * 32 + 8 * fq;
#pragma unroll
        for (int ai = 0; ai < 2; ++ai) {
            u32x4 xin[4][2];
#pragma unroll
            for (int m = 0; m < 4; ++m)
#pragma unroll
                for (int bj = 0; bj < 2; ++bj) xin[m][bj] = *(const u32x4*)(X + (size_t)(row0 + ai * HALF + m * 16) * ldc + col0 + bj * HALF);
#pragma unroll
            for (int m = 0; m < 4; ++m) { bf16_t* rowp = X + (size_t)(row0 + ai * HALF + m * 16) * ldc + col0;
#pragma unroll
                for (int bj = 0; bj < 2; ++bj) { const u32x4 xi = xin[m][bj]; const f32x4 a0 = acc[ai][bj][m][0], a1 = acc[ai][bj][m][1];
                    float x[8] = {__uint_as_float(xi.x << 16), __uint_as_float(xi.x & 0xffff0000u), __uint_as_float(xi.y << 16), __uint_as_float(xi.y & 0xffff0000u),
                                  __uint_as_float(xi.z << 16), __uint_as_float(xi.z & 0xffff0000u), __uint_as_float(xi.w << 16), __uint_as_float(xi.w & 0xffff0000u)};
                    u32x4 w; w.x = cvt_pk_bf16(alpha * x[0] + a0[0], alpha * x[1] + a0[1]); w.y = cvt_pk_bf16(alpha * x[2] + a0[2], alpha * x[3] + a0[3]);
                    w.z = cvt_pk_bf16(alpha * x[4] + a1[0], alpha * x[5] + a1[1]); w.w = cvt_pk_bf16(alpha * x[6] + a1[2], alpha * x[7] + a1[3]);
                    *(u32x4*)(rowp + bj * HALF) = w; } }
        }
    }
};

struct EpiF32 {
    static constexpr bool PERM = false, AFTER_DRAIN = false;
    float* C; int ldc;
    __device__ __forceinline__ void operator()(const f32x4 (&acc)[2][2][4][2], const Unit& u, int wr, int wc, int fr, int fq) const {
        const int row0 = u.pm * BM + wr * 64 + fr, col0 = u.pn * BM + wc * 32 + 4 * fq;
#pragma unroll
        for (int ai = 0; ai < 2; ++ai)
#pragma unroll
            for (int m = 0; m < 4; ++m) { float* rowp = C + (size_t)(row0 + ai * HALF + m * 16) * ldc + col0;
#pragma unroll
                for (int bj = 0; bj < 2; ++bj)
#pragma unroll
                    for (int n = 0; n < 2; ++n) *(f32x4*)(rowp + bj * HALF + n * 16) = acc[ai][bj][m][n]; }
    }
};
struct PanelStats {
    unsigned* xbuf;
    unsigned* cnt;
    unsigned* tmo;
    int ntn; float eps;
    unsigned code;
    __device__ __forceinline__ bool run(const f32x4 (&v)[2][2][4][2], const Unit& u, int wr, int wc, int fr, int fq, PG8_LAS unsigned char* lds, int wid, int lane) const {
        typedef float f32x2v __attribute__((ext_vector_type(2)));
        PG8_LAS f32x2v* P = (PG8_LAS f32x2v*)lds;
        PG8_LAS f32x2v* S = (PG8_LAS f32x2v*)(lds + 8192);
        PG8_LAS unsigned* flag = (PG8_LAS unsigned*)(lds + 8192 + 2048);
#pragma unroll
        for (int ai = 0; ai < 2; ++ai)
#pragma unroll
            for (int m = 0; m < 4; ++m) {
                float s = 0.f;
#pragma unroll
                for (int bj = 0; bj < 2; ++bj)
#pragma unroll
                    for (int n = 0; n < 2; ++n) { const f32x4 x = v[ai][bj][m][n]; s += (x[0] + x[1]) + (x[2] + x[3]); }
                s += __shfl_xor(s, 16); s += __shfl_xor(s, 32);
                const float mw = s * (1.0f / 64.0f); float q = 0.f;
#pragma unroll
                for (int bj = 0; bj < 2; ++bj)
#pragma unroll
                    for (int n = 0; n < 2; ++n) { const f32x4 d = v[ai][bj][m][n] - mw; q += (d[0] * d[0] + d[1] * d[1]) + (d[2] * d[2] + d[3] * d[3]); }
                q += __shfl_xor(q, 16); q += __shfl_xor(q, 32);
                if (fq == 0) P[(ai * HALF + wr * 64 + m * 16 + fr) * 4 + wc] = (f32x2v){mw, q};
            }
        asm volatile("s_waitcnt lgkmcnt(0)" ::: "memory"); __builtin_amdgcn_s_barrier(); asm volatile("" ::: "memory");
#if defined(BROKEN_EXCHANGE_NO_WAIT)
#warning BROKEN CONTROL BUILD: the row-statistics exchange does not wait; results are wrong by design
        if (blockIdx.x >= 64) { const long long t0_ = clock64(); while (clock64() - t0_ < 60000) __builtin_amdgcn_s_sleep(8); }
#endif
        const int row = wid * 32 + (lane & 31);
        if (lane < 32) {
            const f32x2v a = P[row * 4 + 0], b = P[row * 4 + 1], c = P[row * 4 + 2], d = P[row * 4 + 3];
            const float mt = (a.x + b.x + c.x + d.x) * 0.25f;
            const float da = a.x - mt, db = b.x - mt, dc = c.x - mt, dd = d.x - mt;
            const float m2 = (a.y + b.y) + (c.y + d.y) + 64.0f * ((da * da + db * db) + (dc * dc + dd * dd));
            unsigned long long* slot = (unsigned long long*)xbuf + ((size_t)(u.pm * BM + row) * 4 + u.pn);
            __hip_atomic_store(slot, ((unsigned long long)__float_as_uint(m2) << 32) | __float_as_uint(mt), __ATOMIC_RELAXED, __HIP_MEMORY_SCOPE_AGENT);
        }
        asm volatile("s_waitcnt vmcnt(0)" ::: "memory");
        if (lane == 0) __hip_atomic_fetch_add(cnt + 64 * u.pm, 1u, __ATOMIC_RELAXED, __HIP_MEMORY_SCOPE_AGENT);
        if (wid == 0) {
            bool dead = false; const unsigned long long t0 = __builtin_amdgcn_s_memrealtime(); const unsigned want = 8u * (unsigned)ntn;
            for (;;) {
#if defined(BROKEN_EXCHANGE_NO_WAIT)
                break;
#endif
                if ((unsigned)__builtin_amdgcn_readfirstlane(__hip_atomic_load(cnt + 64 * u.pm, __ATOMIC_RELAXED, __HIP_MEMORY_SCOPE_AGENT)) >= want) break;
                if (__builtin_amdgcn_s_memrealtime() - t0 > 2000000ull) {
                    if (lane == 0) { unsigned expect = 0u; __hip_atomic_compare_exchange_strong(tmo + 1, &expect, code | (unsigned)(u.pm & 0xff), __ATOMIC_RELAXED, __ATOMIC_RELAXED, __HIP_MEMORY_SCOPE_AGENT);
                                     __hip_atomic_store(tmo, 1u, __ATOMIC_RELAXED, __HIP_MEMORY_SCOPE_AGENT); }
                    dead = true; break; }
                __builtin_amdgcn_s_sleep(2);
            }
            __builtin_amdgcn_fence(__ATOMIC_ACQUIRE, "agent");
            if (lane == 0) flag[0] = dead ? 1u : 0u;
        }
        asm volatile("s_waitcnt vmcnt(0) lgkmcnt(0)" ::: "memory"); __builtin_amdgcn_s_barrier(); asm volatile("" ::: "memory");
        const bool bad = flag[0] != 0u;
        if (lane < 32) {
            const unsigned long long* slot = (const unsigned long long*)xbuf + (size_t)(u.pm * BM + row) * 4; float mt[4], m2[4]; float ms = 0.f;
#pragma unroll
            for (int t = 0; t < 4; ++t) { if (t < ntn) { const unsigned long long w = __hip_atomic_load(slot + t, __ATOMIC_RELAXED, __HIP_MEMORY_SCOPE_AGENT); mt[t] = __uint_as_float((unsigned)w); m2[t] = __uint_as_float((unsigned)(w >> 32)); } else { mt[t] = 0.f; m2[t] = 0.f; } ms += mt[t]; }
            const float mean = ms / (float)ntn; float q = 0.f;
#pragma unroll
            for (int t = 0; t < 4; ++t) if (t < ntn) { const float dm = mt[t] - mean; q += m2[t] + 256.0f * dm * dm; }
            S[row] = (f32x2v){mean, 1.0f / sqrtf(q / (256.0f * (float)ntn) + eps)};
        }
        asm volatile("s_waitcnt lgkmcnt(0)" ::: "memory"); __builtin_amdgcn_s_barrier(); asm volatile("" ::: "memory");
        return bad;
    }
};
struct EpiLnRes {
    static constexpr bool PERM = false, AFTER_DRAIN = true;
    const float* base; float* out; int ldc; const float* bias; PanelStats st; unsigned poison;
    __device__ __forceinline__ void fused(f32x4 (&acc)[2][2][4][2], const Unit& u, int wr, int wc, int fr, int fq, PG8_LAS unsigned char* lds, int wid, int lane) const {
        typedef float f32x2v __attribute__((ext_vector_type(2)));
        const PG8_LAS f32x2v* S = (const PG8_LAS f32x2v*)(lds + 8192);
        const int col0 = u.pn * BM + wc * 32 + 4 * fq;
#pragma unroll
        for (int bj = 0; bj < 2; ++bj)
#pragma unroll
            for (int n = 0; n < 2; ++n) { const f32x4 bv = bias ? *(const f32x4*)(bias + col0 + bj * HALF + n * 16) : (f32x4){0.f, 0.f, 0.f, 0.f};
#pragma unroll
                for (int ai = 0; ai < 2; ++ai)
#pragma unroll
                    for (int m = 0; m < 4; ++m) acc[ai][bj][m][n] += bv; }
        f32x4 pre[4][2][2];
#pragma unroll
        for (int m = 0; m < 4; ++m) { const size_t off = (size_t)(u.pm * BM + wr * 64 + m * 16 + fr) * ldc + col0;
#pragma unroll
            for (int bj = 0; bj < 2; ++bj)
#pragma unroll
                for (int n = 0; n < 2; ++n) pre[m][bj][n] = *(const f32x4*)(base + off + bj * HALF + n * 16); }
        const bool bad = st.run(acc, u, wr, wc, fr, fq, lds, wid, lane) || poison != 0u;
        const float qnan = __builtin_nanf("");
#pragma unroll
        for (int ai = 0; ai < 2; ++ai)
#pragma unroll
            for (int m = 0; m < 4; ++m) { const int r = ai * HALF + wr * 64 + m * 16 + fr; const f32x2v sr = S[r]; const size_t off = (size_t)(u.pm * BM + r) * ldc + col0;
#pragma unroll
                for (int bj = 0; bj < 2; ++bj)
#pragma unroll
                    for (int n = 0; n < 2; ++n) { const f32x4 bs = ai == 0 ? pre[m][bj][n] : *(const f32x4*)(base + off + bj * HALF + n * 16); f32x4 o = bs + (acc[ai][bj][m][n] - sr.x) * sr.y;
                        if (bad) o = (f32x4){qnan, qnan, qnan, qnan}; *(f32x4*)(out + off + bj * HALF + n * 16) = o; }
                if (m & 1) asm volatile("" ::: "memory"); }
    }
};
struct EpiLnResLn {
    static constexpr bool PERM = false, AFTER_DRAIN = true;
    const float* base; float* out; bf16_t* xn; int ldc; const float* bias; PanelStats st1, st2; unsigned poison;
    __device__ __forceinline__ void fused(f32x4 (&acc)[2][2][4][2], const Unit& u, int wr, int wc, int fr, int fq, PG8_LAS unsigned char* lds, int wid, int lane) const {
        typedef float f32x2v __attribute__((ext_vector_type(2))); typedef unsigned u32x2v __attribute__((ext_vector_type(2)));
        const PG8_LAS f32x2v* S = (const PG8_LAS f32x2v*)(lds + 8192);
        const int col0 = u.pn * BM + wc * 32 + 4 * fq;
#pragma unroll
        for (int bj = 0; bj < 2; ++bj)
#pragma unroll
            for (int n = 0; n < 2; ++n) { const f32x4 bv = bias ? *(const f32x4*)(bias + col0 + bj * HALF + n * 16) : (f32x4){0.f, 0.f, 0.f, 0.f};
#pragma unroll
                for (int ai = 0; ai < 2; ++ai)
#pragma unroll
                    for (int m = 0; m < 4; ++m) acc[ai][bj][m][n] += bv; }
        bool bad = st1.run(acc, u, wr, wc, fr, fq, lds, wid, lane) || poison != 0u;
        const float qnan = __builtin_nanf("");
#pragma unroll
        for (int ai = 0; ai < 2; ++ai)
#pragma unroll
            for (int m = 0; m < 4; ++m) { const int r = ai * HALF + wr * 64 + m * 16 + fr; const f32x2v sr = S[r]; const size_t off = (size_t)(u.pm * BM + r) * ldc + col0;
#pragma unroll
                for (int bj = 0; bj < 2; ++bj)
#pragma unroll
                    for (int n = 0; n < 2; ++n) { const f32x4 bs = *(const f32x4*)(base + off + bj * HALF + n * 16); acc[ai][bj][m][n] = bs + (acc[ai][bj][m][n] - sr.x) * sr.y; }
                asm volatile("" : "+v"(acc[ai][0][m][0]), "+v"(acc[ai][0][m][1]), "+v"(acc[ai][1][m][0]), "+v"(acc[ai][1][m][1]));
                if (m & 1) asm volatile("" ::: "memory"); }
        const bool bad1 = bad;
        bad = st2.run(acc, u, wr, wc, fr, fq, lds, wid, lane) || bad;
#pragma unroll
        for (int ai = 0; ai < 2; ++ai)
#pragma unroll
            for (int m = 0; m < 4; ++m) { const int r = ai * HALF + wr * 64 + m * 16 + fr; const f32x2v sr = S[r]; const size_t off = (size_t)(u.pm * BM + r) * ldc + col0;
#pragma unroll
                for (int bj = 0; bj < 2; ++bj)
#pragma unroll
                    for (int n = 0; n < 2; ++n) { const f32x4 x1 = acc[ai][bj][m][n]; *(f32x4*)(out + off + bj * HALF + n * 16) = bad1 ? (f32x4){qnan, qnan, qnan, qnan} : x1;
                        const f32x4 o = (x1 - sr.x) * sr.y; u32x2v w; w.x = cvt_pk_bf16(o[0], o[1]); w.y = cvt_pk_bf16(o[2], o[3]);
                        if (bad) { w.x = 0x7fc07fc0u; w.y = 0x7fc07fc0u; } *(u32x2v*)(xn + off + bj * HALF + n * 16) = w; }
                asm volatile("" ::: "memory"); }
    }
};

template <class Epi, class Sched, bool ALIGN_EPI = false, bool SP2 = false>
__device__ __forceinline__ void gemm_phase(PG8_LAS unsigned char* lds, const Gemm g, const Sched& S, const Epi& E, int wv) {
    int tid0_ = threadIdx.x; asm volatile("" : "+v"(tid0_)); (void)wv;
    const int tid = tid0_, wid = __builtin_amdgcn_readfirstlane(tid >> 6), lane = tid & 63, wr = wid >> 2, wc = wid & 3, fr = lane & 15, fq = lane >> 4;
    const int K = g.K, nt = K / BK;
    unsigned voffA[2], voffB[2];
#pragma unroll
    for (int i = 0; i < 2; ++i) { int R, C; stage_rc(tid * 16 + i * 8192, R, C); const int Rb = Epi::PERM ? ((R & ~31) + perm32(R & 31)) : R;
        voffA[i] = (unsigned)(R * K + C) * 2u; voffB[i] = (unsigned)(Rb * K + C) * 2u; }
    const size_t kstep = (size_t)(BK * 2);
    const size_t hstep = (size_t)HALF * K * 2;
    const size_t tstep = 2 * hstep;
    const unsigned ldsw = (unsigned)wid * 1024u;
    const int aoff = lds_byte(wr * 64 + fr, fq * 8), boff = lds_byte(wc * 32 + fr, fq * 8);
#define PG8_SA(b, h) (((b) * 2 + (h)) * HTB)
#define PG8_SB(b, h) ((4 + (b) * 2 + (h)) * HTB)
#define PG8_STAGE(bufoff, gbase, voff) do { _Pragma("unroll") for (int _i = 0; _i < 2; ++_i) \
        __builtin_amdgcn_global_load_lds((const unsigned*)((const char*)(gbase) + (voff)[_i]), (PG8_LAS unsigned*)(lds + (bufoff) + ldsw + _i * 8192), 16, 0, 0); } while (0)
#define PG8_LDA(dst, b, h) do { _Pragma("unroll") for (int m = 0; m < 4; ++m) _Pragma("unroll") for (int k = 0; k < 2; ++k) dst[m][k] = *(const PG8_LAS bf16x8*)(lds + PG8_SA(b, h) + aoff + m * 2048 + k * 1024); } while (0)
#define PG8_LDB(dst, b, h) do { _Pragma("unroll") for (int n = 0; n < 2; ++n) _Pragma("unroll") for (int k = 0; k < 2; ++k) dst[n][k] = *(const PG8_LAS bf16x8*)(lds + PG8_SB(b, h) + boff + n * 2048 + k * 1024); } while (0)
#define PG8_MMA(ai, bj, At, Bt) do { __builtin_amdgcn_s_setprio(1); _Pragma("unroll") for (int m = 0; m < 4; ++m) _Pragma("unroll") for (int n = 0; n < 2; ++n) _Pragma("unroll") for (int k = 0; k < 2; ++k) \
        acc[ai][bj][m][n] = __builtin_amdgcn_mfma_f32_16x16x32_bf16(Bt[n][k], At[m][k], acc[ai][bj][m][n], 0, 0, 0); __builtin_amdgcn_s_setprio(0); } while (0)
#define PG8_WAIT_V(n) asm volatile("s_waitcnt vmcnt(" #n ")" ::: "memory")
#define PG8_WAIT_L(n) asm volatile("s_waitcnt lgkmcnt(" #n ")" ::: "memory")
#define PG8_BAR __builtin_amdgcn_s_barrier()
#define PG8_SCHED __builtin_amdgcn_sched_barrier(0)
    Unit cur, nxt; int ui = 0;
    if (!S.next(0, cur)) return;
    f32x4 acc[2][2][4][2];
#pragma unroll
    for (int a = 0; a < 2; ++a)
#pragma unroll
        for (int b = 0; b < 2; ++b)
#pragma unroll
            for (int m = 0; m < 4; ++m)
#pragma unroll
                for (int n = 0; n < 2; ++n) acc[a][b][m][n] = (f32x4){0.f, 0.f, 0.f, 0.f};
    bf16x8 At[4][2], B0[2][2], B1[2][2];
    const char* cA = (const char*)g.A + (size_t)cur.pm * tstep; const char* cB = (const char*)g.Bt + (size_t)cur.pn * tstep;
    S.a_ready(cur);
    if constexpr (SP2) {
        PG8_STAGE(PG8_SB(0, 0), cB, voffB); PG8_STAGE(PG8_SB(0, 1), cB + hstep, voffB); PG8_STAGE(PG8_SA(0, 0), cA, voffA); PG8_STAGE(PG8_SA(0, 1), cA + hstep, voffA);
        if (wr == 1) PG8_BAR;
        PG8_WAIT_V(2); PG8_BAR;
        PG8_STAGE(PG8_SB(1, 0), cB + kstep, voffB); PG8_STAGE(PG8_SA(1, 0), cA + kstep, voffA); PG8_STAGE(PG8_SB(1, 1), cB + hstep + kstep, voffB);
        PG8_WAIT_V(6); PG8_BAR;
    } else {
        PG8_STAGE(PG8_SB(0, 0), cB, voffB); PG8_STAGE(PG8_SA(0, 0), cA, voffA); PG8_STAGE(PG8_SB(0, 1), cB + hstep, voffB); PG8_STAGE(PG8_SA(0, 1), cA + hstep, voffA);
        if (wr == 1) PG8_BAR;
        PG8_WAIT_V(4); PG8_BAR;
        PG8_STAGE(PG8_SB(1, 0), cB + kstep, voffB); PG8_STAGE(PG8_SA(1, 0), cA + kstep, voffA); PG8_STAGE(PG8_SB(1, 1), cB + hstep + kstep, voffB);
        PG8_WAIT_V(6); PG8_BAR;
    }
    for (;;) {
        const bool has_next = S.next(ui + 1, nxt);
        const char* nA = has_next ? (const char*)g.A + (size_t)nxt.pm * tstep : cA; const char* nB = has_next ? (const char*)g.Bt + (size_t)nxt.pn * tstep : cB;
        for (int t = 0; t < nt; t += 2) {
            const bool last = (t == nt - 2);
            const char* a1 = cA + (size_t)(t + 1) * kstep;
            const char* a2 = last ? nA : cA + (size_t)(t + 2) * kstep; const char* b2 = last ? nB : cB + (size_t)(t + 2) * kstep;
            const char* a3 = a2 + kstep; const char* b3 = b2 + kstep;
            if (last && has_next) S.a_ready(nxt);
            if constexpr (SP2) {
            PG8_LDB(B0, 0, 0); PG8_LDB(B1, 0, 1); PG8_SCHED; PG8_LDA(At, 0, 0); PG8_STAGE(PG8_SA(1, 1), a1 + hstep, voffA);
            PG8_WAIT_V(8); PG8_WAIT_L(0); PG8_BAR; PG8_MMA(0, 0, At, B0); PG8_MMA(0, 1, At, B1); PG8_BAR; PG8_SCHED;
            PG8_LDA(At, 0, 1); PG8_STAGE(PG8_SB(0, 0), b2, voffB); PG8_STAGE(PG8_SB(0, 1), b2 + hstep, voffB); PG8_STAGE(PG8_SA(0, 0), a2, voffA);
            PG8_WAIT_V(8); PG8_WAIT_L(0); PG8_BAR; PG8_MMA(1, 0, At, B0); PG8_MMA(1, 1, At, B1); PG8_BAR; PG8_SCHED;
            PG8_LDB(B0, 1, 0); PG8_LDB(B1, 1, 1); PG8_SCHED; PG8_LDA(At, 1, 0); PG8_STAGE(PG8_SA(0, 1), a2 + hstep, voffA);
            PG8_WAIT_V(8); PG8_WAIT_L(0); PG8_BAR; PG8_MMA(0, 0, At, B0); PG8_MMA(0, 1, At, B1); PG8_BAR; PG8_SCHED;
            PG8_LDA(At, 1, 1); PG8_STAGE(PG8_SB(1, 0), b3, voffB); PG8_STAGE(PG8_SB(1, 1), b3 + hstep, voffB); PG8_STAGE(PG8_SA(1, 0), a3, voffA);
            PG8_WAIT_V(8); PG8_WAIT_L(0); PG8_BAR; PG8_MMA(1, 0, At, B0); PG8_MMA(1, 1, At, B1); PG8_BAR; PG8_SCHED;
            } else {
            PG8_LDB(B0, 0, 0); PG8_SCHED; PG8_LDA(At, 0, 0); PG8_STAGE(PG8_SA(1, 1), a1 + hstep, voffA);
            PG8_WAIT_L(8); PG8_BAR; PG8_WAIT_L(0); PG8_MMA(0, 0, At, B0); PG8_BAR; PG8_SCHED;
            PG8_LDB(B1, 0, 1); PG8_STAGE(PG8_SB(0, 0), b2, voffB);
            PG8_BAR; PG8_WAIT_L(0); PG8_MMA(0, 1, At, B1); PG8_BAR;
            PG8_LDA(At, 0, 1); PG8_STAGE(PG8_SA(0, 0), a2, voffA);
            PG8_BAR; PG8_WAIT_L(0); PG8_MMA(1, 0, At, B0); PG8_BAR; PG8_SCHED;
            PG8_STAGE(PG8_SB(0, 1), b2 + hstep, voffB);
            PG8_WAIT_V(6); PG8_BAR; PG8_MMA(1, 1, At, B1); PG8_BAR;
            PG8_LDB(B0, 1, 0); PG8_SCHED; PG8_LDA(At, 1, 0); PG8_STAGE(PG8_SA(0, 1), a2 + hstep, voffA);
            PG8_WAIT_L(8); PG8_BAR; PG8_WAIT_L(0); PG8_MMA(0, 0, At, B0); PG8_BAR; PG8_SCHED;
            PG8_LDB(B1, 1, 1); PG8_STAGE(PG8_SB(1, 0), b3, voffB);
            PG8_BAR; PG8_WAIT_L(0); PG8_MMA(0, 1, At, B1); PG8_BAR;
            PG8_LDA(At, 1, 1); PG8_STAGE(PG8_SA(1, 0), a3, voffA);
            PG8_BAR; PG8_WAIT_L(0); PG8_MMA(1, 0, At, B0); PG8_BAR; PG8_SCHED;
            PG8_STAGE(PG8_SB(1, 1), b3 + hstep, voffB);
            PG8_WAIT_V(6); PG8_BAR; PG8_MMA(1, 1, At, B1); PG8_BAR;
            }
        }
        if constexpr (ALIGN_EPI) { if (wr == 0) PG8_BAR; }
        if constexpr (!Epi::AFTER_DRAIN) { E(acc, cur, wr, wc, fr, fq); S.done(cur); }
        if (!has_next) break;
#pragma unroll
        for (int a = 0; a < 2; ++a)
#pragma unroll
            for (int b = 0; b < 2; ++b)
#pragma unroll
                for (int m = 0; m < 4; ++m)
#pragma unroll
                    for (int n = 0; n < 2; ++n) acc[a][b][m][n] = (f32x4){0.f, 0.f, 0.f, 0.f};
        cur = nxt; cA = nA; cB = nB; ++ui;
        if constexpr (ALIGN_EPI) { if (wr == 1) PG8_BAR; }
    }
    PG8_WAIT_V(0);
    if constexpr (!ALIGN_EPI) { if (wr == 0) PG8_BAR; }
    PG8_BAR;
    if constexpr (Epi::AFTER_DRAIN) { E.fused(acc, cur, wr, wc, fr, fq, lds, wid, lane); S.done(cur); }
#undef PG8_SA
#undef PG8_SB
#undef PG8_STAGE
#undef PG8_LDA
#undef PG8_LDB
#undef PG8_MMA
#undef PG8_WAIT_V
#undef PG8_WAIT_L
#undef PG8_BAR
#undef PG8_SCHED
}
}

#ifndef PG8_SP2
#define PG8_SP2 true
#endif
#ifndef PG8_ALIGN
#define PG8_ALIGN true
#endif
#define GAS __attribute__((address_space(1)))
#define LAS __attribute__((address_space(3)))
#define XB_TMO      128
#define XB_XCNT(j)  (256  + 64 * (j))
#define XB_XSUB(j)  (1280 + 64 * (j))
#define XB_XGEN(j)  (2304 + 64 * (j))
#define XB_TOP      3328
#define XB_TOPGEN   3392
#define XCD_BAR_WORDS 3456
#define XB_SPIN_CAP (1u << 18)

__device__ __forceinline__ unsigned xb_ld(unsigned* p)              { return __hip_atomic_load(p, __ATOMIC_RELAXED, __HIP_MEMORY_SCOPE_AGENT); }
__device__ __forceinline__ unsigned xb_add(unsigned* p, unsigned v) { return __hip_atomic_fetch_add(p, v, __ATOMIC_RELAXED, __HIP_MEMORY_SCOPE_AGENT); }
__device__ __forceinline__ unsigned xb_xcc_id() { return (unsigned)__builtin_amdgcn_s_getreg((3 << 11) | 20) & 0xFu; }
#define XB_SPIN(cond, bar) do { unsigned _sp = 0; while (cond) { __builtin_amdgcn_s_sleep(1); \
    if ((++_sp & 255u) == 0u) { if (xb_ld(&(bar)[XB_TMO])) break; if (_sp > XB_SPIN_CAP) { atomicAdd(&(bar)[XB_TMO], 1u); break; } } } } while (0)

struct XcdBarrier {
    unsigned* bar; unsigned x;
    volatile LAS unsigned* st;
    int wv;
};

__device__ __forceinline__ XcdBarrier xcd_barrier_post(unsigned* bar, volatile LAS unsigned* st) {
    XcdBarrier b; b.bar = bar; b.x = xb_xcc_id(); b.st = st;
    if (threadIdx.x == 0) (void)xb_add(&bar[XB_XCNT(b.x)], 1u);
    return b;
}
__device__ __forceinline__ void xcd_barrier_complete(unsigned* bar, unsigned x, unsigned& nloc, unsigned& nx) {
    asm volatile("" : "+s"(x));
    const unsigned G = gridDim.x * gridDim.y * gridDim.z;
    unsigned sum, cnt, mine, sp = 0u;
    for (;;) {
        sum = 0u; cnt = 0u; mine = 0u;
#pragma unroll
        for (unsigned j = 0; j < 16; ++j) { const unsigned c = xb_ld(&bar[XB_XCNT(j)]); sum += c; cnt += (c > 0u) ? 1u : 0u; mine = (j == x) ? c : mine; }
        if (sum == G) break;
        __builtin_amdgcn_s_sleep(1);
        if ((++sp & 255u) == 0u) { if (xb_ld(&bar[XB_TMO])) break; if (sp > XB_SPIN_CAP) { atomicAdd(&bar[XB_TMO], 1u); break; } }
    }
    nloc = mine > 0u ? mine : 1u; nx = cnt > 0u ? cnt : 1u;
}

__device__ __forceinline__ void xcd_barrier(const XcdBarrier& b) {
    asm volatile("s_waitcnt vmcnt(0)" ::: "memory");
    __syncthreads();
    if (threadIdx.x == 0) {
        unsigned* bar = b.bar; asm volatile("" : "+s"(bar));
        __builtin_amdgcn_s_waitcnt(0);
        unsigned nloc = b.st[0], nx = b.st[1];
        if (nloc == 0u) { xcd_barrier_complete(bar, b.x, nloc, nx); b.st[0] = nloc; b.st[1] = nx; }
        const unsigned old = xb_add(&bar[XB_XSUB(b.x)], 1u);
        const unsigned gen = old / nloc;
        if (old + 1u == (gen + 1u) * nloc) {
            __builtin_amdgcn_fence(__ATOMIC_RELEASE, "agent");
            asm volatile("s_waitcnt vmcnt(0)" ::: "memory");
            const unsigned og = xb_add(&bar[XB_TOP], 1u);
            const unsigned tg = og / nx;
            if (og + 1u == (tg + 1u) * nx) xb_add(&bar[XB_TOPGEN], 1u);
            else XB_SPIN(xb_ld(&bar[XB_TOPGEN]) == tg, bar);
            __builtin_amdgcn_fence(__ATOMIC_ACQUIRE, "agent");
            xb_add(&bar[XB_XGEN(b.x)], 1u);
            asm volatile("s_waitcnt vmcnt(0)" ::: "memory");
        } else {
            XB_SPIN(xb_ld(&bar[XB_XGEN(b.x)]) == gen, bar);
            __builtin_amdgcn_fence(__ATOMIC_ACQUIRE, "agent");
            asm volatile("s_waitcnt vmcnt(0)" ::: "memory");
        }
    }
    __syncthreads();
}
namespace dattn {
constexpr int D = 128, QST = 2048, KVS = 512, OST = 2048, MTW = 68, JLO = 3;
constexpr float THR = 8.f; constexpr bool WSKIP = false;
typedef unsigned short bf16;
constexpr float SCALE = 1.0f;
constexpr int NW = 8, QBLK = 32, KVBLK = 64, QB = NW * QBLK;
constexpr int SHM_V = KVBLK * D * 2, SHM_K = KVBLK * D * 2;
constexpr int LDS_BYTES = 2 * SHM_V + 2 * SHM_K + NW * 64 * 4;

typedef short bf16x8 __attribute__((ext_vector_type(8)));
typedef short s16x4 __attribute__((ext_vector_type(4)));
typedef float f32x16 __attribute__((ext_vector_type(16)));
typedef float f32x4 __attribute__((ext_vector_type(4)));
typedef unsigned u32x4 __attribute__((ext_vector_type(4)));
template <class A, class Bt> struct same_t { static constexpr bool v = false; };
template <class A> struct same_t<A, A> { static constexpr bool v = true; };

#define KSWZ(row, colB) ((row) * 256 + ((colB) ^ (((row) & 7) << 4)))
#define SBAR() __builtin_amdgcn_sched_barrier(0)
__device__ __forceinline__ int v_st(int k, int c) { const int kk = (k & ~0xC) | ((k & 4) << 1) | ((k & 8) >> 1); return ((kk >> 3) * 4 + (c >> 5)) * 512 + ((kk & 7) * 32 + (c & 31)) * 2; }
__device__ __forceinline__ int v_rd_base(int lane) { return ((lane & 3) << 3) | (((lane >> 2) & 3) << 6) | (((lane >> 4) & 1) << 5) | (((lane >> 5) & 1) << 8); }
constexpr int v_rd_off(int d0, int ks, int half) { return d0 * 512 + ks * 4096 + half * 2048; }
__device__ __forceinline__ int crow(int r, int hi) { return (r & 3) + 8 * (r >> 2) + 4 * hi; }
__device__ __forceinline__ unsigned cvtpk(float lo, float hi) {
    unsigned r; asm volatile("v_cvt_pk_bf16_f32 %0, %1, %2" : "=v"(r) : "v"(lo), "v"(hi)); return r;
}
__device__ __forceinline__ bf16x8 pack8(f32x4 a, f32x4 b) {
    u32x4 w = {cvtpk(a[0], a[1]), cvtpk(a[2], a[3]), cvtpk(b[0], b[1]), cvtpk(b[2], b[3])};
    return *reinterpret_cast<bf16x8*>(&w);
}
template <class T> __device__ __forceinline__ bf16x8 load8(const T* p) {
    if constexpr (same_t<T, float>::v) { return pack8(*(const f32x4*)p, *(const f32x4*)(p + 4)); }
    else { return *reinterpret_cast<const bf16x8*>(p); }
}
__device__ __forceinline__ void mask_tile(f32x16& p0, f32x16& p1, int dq, unsigned W) {
    const float NEG = -__builtin_inff();
#pragma unroll
    for (int r = 0; r < 16; ++r) {
        const int c = (r & 3) + 8 * (r >> 2);
        if ((unsigned)(dq - c) >= W) p0[r] = NEG;
        if ((unsigned)(dq - c - 32) >= W) p1[r] = NEG;
    }
}
__device__ __forceinline__ void mask_bits(f32x16& p0, f32x16& p1, unsigned long long mw, int hi) {
    const float NEG = -__builtin_inff();
    const unsigned lo = (unsigned)(mw >> (4 * hi)), up = (unsigned)(mw >> (32 + 4 * hi));
#pragma unroll
    for (int r = 0; r < 16; ++r) {
        const int c = (r & 3) + 8 * (r >> 2);
        const unsigned t0 = (unsigned)__builtin_amdgcn_sbfe((int)lo, c, 1), t1 = (unsigned)__builtin_amdgcn_sbfe((int)up, c, 1);
        p0[r] = __uint_as_float((t0 & __float_as_uint(p0[r])) | (~t0 & __float_as_uint(NEG)));
        p1[r] = __uint_as_float((t1 & __float_as_uint(p1[r])) | (~t1 & __float_as_uint(NEG)));
    }
}
template <int Q> __device__ __forceinline__ void mask_bias_q(f32x16& p0, f32x16& p1, unsigned nlo, unsigned nup) {
#pragma unroll
    for (int r = 4 * Q; r < 4 * Q + 4; ++r) { const int c = (r & 3) + 8 * (r >> 2);
        p0[r] = __uint_as_float((unsigned)__builtin_amdgcn_sbfe((int)nlo, c, 1) & 0xFF800000u);
        p1[r] = __uint_as_float((unsigned)__builtin_amdgcn_sbfe((int)nup, c, 1) & 0xFF800000u); }
}
__device__ __forceinline__ void mask_bias(f32x16& p0, f32x16& p1, unsigned long long mw, int hi) {
    const unsigned nlo = ~(unsigned)(mw >> (4 * hi)), nup = ~(unsigned)(mw >> (32 + 4 * hi));
    mask_bias_q<0>(p0, p1, nlo, nup); mask_bias_q<1>(p0, p1, nlo, nup); mask_bias_q<2>(p0, p1, nlo, nup); mask_bias_q<3>(p0, p1, nlo, nup);
}
__device__ __forceinline__ void partialSM(f32x16& p0, f32x16& p1, float& m_reg, float& mn, float& alpha) {
    float pmax = p0[0]; for (int r = 1; r < 16; ++r) pmax = fmaxf(pmax, p0[r]); for (int r = 0; r < 16; ++r) pmax = fmaxf(pmax, p1[r]);
    { auto rr = __builtin_amdgcn_permlane32_swap(__float_as_uint(pmax), __float_as_uint(pmax), false, false);
      pmax = fmaxf(__uint_as_float(rr[0]), __uint_as_float(rr[1])); }
    constexpr float C2 = 1.4426950408889634f * SCALE;
    if (__builtin_expect(__all((pmax - m_reg) * SCALE <= THR), 1)) { mn = m_reg; alpha = 1.f; }
    else { mn = fmaxf(m_reg, pmax); alpha = __builtin_amdgcn_exp2f((m_reg - mn) * C2); m_reg = mn; }
    const float mnL = -mn * C2;
    for (int r = 0; r < 16; ++r) p0[r] = fmaf(p0[r], C2, mnL); for (int r = 0; r < 16; ++r) p1[r] = fmaf(p1[r], C2, mnL);
    for (int r = 0; r < 16; ++r) p0[r] = __builtin_amdgcn_exp2f(p0[r]);
}
__device__ __forceinline__ void finishSM(f32x16& p0, f32x16& p1, float alpha, float& l_reg, bf16x8& pa0, bf16x8& pa1, bf16x8& pa2, bf16x8& pa3) {
    for (int r = 0; r < 16; ++r) p1[r] = __builtin_amdgcn_exp2f(p1[r]);
    float ps = 0; for (int r = 0; r < 16; ++r) ps += p0[r]; for (int r = 0; r < 16; ++r) ps += p1[r];
    { auto rr = __builtin_amdgcn_permlane32_swap(__float_as_uint(ps), __float_as_uint(ps), false, false);
      ps = __uint_as_float(rr[0]) + __uint_as_float(rr[1]); }
    l_reg = l_reg * alpha + ps;
#define PK4(P, B_, OUT) do { unsigned a0 = cvtpk(P[B_+0], P[B_+1]), a1 = cvtpk(P[B_+2], P[B_+3]);                          \
        unsigned b0 = cvtpk(P[B_+4], P[B_+5]), b1 = cvtpk(P[B_+6], P[B_+7]);                                             \
        auto r0 = __builtin_amdgcn_permlane32_swap(a0, b0, false, false); auto r1 = __builtin_amdgcn_permlane32_swap(a1, b1, false, false); \
        u32x4 w = {r0[0], r1[0], r0[1], r1[1]}; OUT = *reinterpret_cast<bf16x8*>(&w); } while (0)
    PK4(p0, 0, pa0); PK4(p0, 8, pa1); PK4(p1, 0, pa2); PK4(p1, 8, pa3);
#undef PK4
}
template <int KB, bool SK, bool BI = false>
__device__ __forceinline__ void qkt(f32x16& p0, f32x16& p1, const char* K_lds, int r32, int hi, const bf16x8* qr, bool act) {
    if (SK && !act) { const float NEG = -__builtin_inff();
#pragma unroll
        for (int r = 0; r < 16; ++r) { p0[r] = NEG; p1[r] = NEG; } return; }
    if (!BI) { p0 = f32x16{}; p1 = f32x16{}; }
    const char* kb[4];
#pragma unroll
    for (int dd = 0; dd < 4; ++dd) kb[dd] = K_lds + KB * SHM_K + KSWZ(r32, (dd * 16 + hi * 8) * 2);
#pragma unroll
    for (int d0 = 0; d0 < 8; ++d0) { const char* a = kb[d0 & 3] + (d0 >> 2) * 128;
        bf16x8 b0 = *reinterpret_cast<const bf16x8*>(a);
        bf16x8 b1 = *reinterpret_cast<const bf16x8*>(a + 32 * 256);
        p0 = __builtin_amdgcn_mfma_f32_32x32x16_bf16(b0, qr[d0], p0, 0, 0, 0);
        p1 = __builtin_amdgcn_mfma_f32_32x32x16_bf16(b1, qr[d0], p1, 0, 0, 0); }
}
template <int VB, bool SK, bool BI = false>
__device__ __forceinline__ void pv_tile(f32x16* o, int vb0, bf16x8 pa0, bf16x8 pa1, bf16x8 pa2, bf16x8 pa3, bool act, f32x16* bq0 = nullptr, f32x16* bq1 = nullptr, unsigned nlo = 0u, unsigned nup = 0u) {
    if (SK && !act) return;
#define TRRD(dst, off) asm volatile("ds_read_b64_tr_b16 %0, %1 offset:%2" : "=&v"(dst) : "v"(vb0), "i"(off) : "memory")
#define PV_D0(d0) do { s16x4 l0, l1, l2, l3, h0, h1, h2, h3; constexpr int b_ = VB * SHM_V + v_rd_off(d0, 0, 0);     \
        TRRD(l0, b_); TRRD(h0, b_ + 2048); TRRD(l1, b_ + 4096); TRRD(h1, b_ + 6144); TRRD(l2, b_ + 8192); TRRD(h2, b_ + 10240); TRRD(l3, b_ + 12288); TRRD(h3, b_ + 14336); \
        asm volatile("s_waitcnt lgkmcnt(0)" ::: "memory"); SBAR();                 \
        o[d0] = __builtin_amdgcn_mfma_f32_32x32x16_bf16(pa0, (bf16x8){l0[0], l0[1], l0[2], l0[3], h0[0], h0[1], h0[2], h0[3]}, o[d0], 0, 0, 0);   \
        o[d0] = __builtin_amdgcn_mfma_f32_32x32x16_bf16(pa1, (bf16x8){l1[0], l1[1], l1[2], l1[3], h1[0], h1[1], h1[2], h1[3]}, o[d0], 0, 0, 0);   \
        o[d0] = __builtin_amdgcn_mfma_f32_32x32x16_bf16(pa2, (bf16x8){l2[0], l2[1], l2[2], l2[3], h2[0], h2[1], h2[2], h2[3]}, o[d0], 0, 0, 0);   \
        o[d0] = __builtin_amdgcn_mfma_f32_32x32x16_bf16(pa3, (bf16x8){l3[0], l3[1], l3[2], l3[3], h3[0], h3[1], h3[2], h3[3]}, o[d0], 0, 0, 0); } while (0)
    PV_D0(0); if (BI) mask_bias_q<0>(*bq0, *bq1, nlo, nup); PV_D0(1); if (BI) mask_bias_q<1>(*bq0, *bq1, nlo, nup);
    PV_D0(2); if (BI) mask_bias_q<2>(*bq0, *bq1, nlo, nup); PV_D0(3); if (BI) mask_bias_q<3>(*bq0, *bq1, nlo, nup);
#undef PV_D0
#undef TRRD
}

template <class TIn, class TOut> struct BlockRef { const TIn* Q; const TIn* K; const TIn* V; TOut* O; const unsigned long long* M; int P0; };
template <class TIn> struct Seam {
    bf16x8 qr[8];
    bf16x8 st_v0, st_v1, st_k0, st_k1; f32x4 sf0, sf1, sf2, sf3;
    f32x4 tq[16];
};
__device__ __forceinline__ int swa_jlo(int, int) { return JLO; }
#define ROW(p, k0, rr) ((p) + (size_t)((k0) + (rr)) * KVS + sc)
#define VMW() asm volatile("s_waitcnt vmcnt(0)" ::: "memory")
#define VMWN(n) asm volatile("s_waitcnt vmcnt(%0)" :: "i"(n) : "memory")
#define SLOAD_H(Kp, Vp, k0) do { S.st_v0 = load8<TIn>(ROW(Vp, k0, sr)); S.st_v1 = load8<TIn>(ROW(Vp, k0, 32 + sr));              \
                         S.st_k0 = load8<TIn>(ROW(Kp, k0, sr)); S.st_k1 = load8<TIn>(ROW(Kp, k0, 32 + sr)); } while (0)
#define SWRITE_HK(bf) do { *(bf16x8*)(K_lds + (bf) * SHM_K + kws) = S.st_k0; *(bf16x8*)(K_lds + (bf) * SHM_K + kws + 32 * 256) = S.st_k1; } while (0)
#define SWRITE_HV(bf) do { *(bf16x8*)(V_lds + (bf) * SHM_V + vst0) = S.st_v0; *(bf16x8*)(V_lds + (bf) * SHM_V + vst1) = S.st_v1; } while (0)
#define SWRITE_H(bf) do { SWRITE_HV(bf); SWRITE_HK(bf); } while (0)
#define SLOAD_F(p, k0) do { S.sf0 = *(const f32x4*)ROW(p, k0, sr); S.sf1 = *(const f32x4*)(ROW(p, k0, sr) + 4);                \
                            S.sf2 = *(const f32x4*)ROW(p, k0, 32 + sr); S.sf3 = *(const f32x4*)(ROW(p, k0, 32 + sr) + 4); } while (0)
#define SWRITE_KF(bf) do { *(bf16x8*)(K_lds + (bf) * SHM_K + kws) = pack8(S.sf0, S.sf1); *(bf16x8*)(K_lds + (bf) * SHM_K + kws + 32 * 256) = pack8(S.sf2, S.sf3); } while (0)
#define SWRITE_VF(bf) do { *(bf16x8*)(V_lds + (bf) * SHM_V + vst0) = pack8(S.sf0, S.sf1); *(bf16x8*)(V_lds + (bf) * SHM_V + vst1) = pack8(S.sf2, S.sf3); } while (0)
template <class TIn, class TOut>
__device__ __forceinline__ void causal_swa_prime(const BlockRef<TIn, TOut>& cur, int W, char* lds, Seam<TIn>& S, int wv) {
    constexpr bool F32 = same_t<TIn, float>::v;
    int tid0_ = threadIdx.x; asm volatile("" : "+v"(tid0_)); (void)wv;
    const int tid = tid0_, wid = __builtin_amdgcn_readfirstlane(tid >> 6), lane = tid & 63, r32 = lane & 31, hi = lane >> 5;
    const int sr = tid >> 4, sc = (tid & 15) * 8, kws = KSWZ(sr, sc * 2); char* K_lds = lds + 2 * SHM_V;
    const int kb0 = swa_jlo(cur.P0, W) * KVBLK;
    for (int d0 = 0; d0 < 8; ++d0) S.qr[d0] = load8<TIn>(cur.Q + (size_t)(wid * QBLK + r32) * QST + d0 * 16 + hi * 8);
    if constexpr (F32) { SLOAD_F((const float*)cur.K, kb0); VMW(); SWRITE_KF(0); SBAR(); SLOAD_F((const float*)cur.V, kb0); }
    else { SLOAD_H(cur.K, cur.V, kb0); VMW(); SWRITE_HK(0); }
    __syncthreads();
}
template <class TIn, class TOut, int VAR = 0>
__device__ __forceinline__ void causal_swa_block(const BlockRef<TIn, TOut>& cur, const BlockRef<TIn, TOut>& nxt, int skv, int W, char* lds, Seam<TIn>& S, int wv) {
    constexpr bool F32 = same_t<TIn, float>::v;
    int tid0_ = threadIdx.x; asm volatile("" : "+v"(tid0_)); (void)wv;
    const int tid = tid0_, wid = __builtin_amdgcn_readfirstlane(tid >> 6), lane = tid & 63, r32 = lane & 31, hi = lane >> 5;
    const int j_lo = swa_jlo(cur.P0, W);
    int j_hi = (cur.P0 + QB - 1) / KVBLK + 1; if (j_hi > skv / KVBLK) j_hi = skv / KVBLK;
    const int NT = j_hi - j_lo;
    const int kbn = swa_jlo(nxt.P0, W) * KVBLK;
    const int qlo = cur.P0 + wid * QBLK; (void)qlo;
    const unsigned long long* mrow = cur.M + (size_t)(wid * QBLK + r32) * MTW;
    const int qm_unused = 0; (void)qm_unused;
    char* V_lds = lds; char* K_lds = lds + 2 * SHM_V;
    float* ws = (float*)(lds + 2 * SHM_V + 2 * SHM_K) + wid * 64; float* li_l = ws, * al_l = ws + 32;
    float m_reg = -1e30f, l_reg = 0; f32x16 o[4] = {};
    const int sr = tid >> 4, sc = (tid & 15) * 8, vst0 = v_st(sr, sc), vst1 = v_st(32 + sr, sc), kws = KSWZ(sr, sc * 2);
    const int vb0 = (int)(uintptr_t)V_lds + v_rd_base(lane);
    const TIn* Kh = cur.K; const TIn* Vh = cur.V;
#define RESC(a) do { if (__any((a) < 1.f)) { if (hi == 0) al_l[r32] = (a); asm volatile("s_waitcnt lgkmcnt(0)" ::: "memory");              \
                     for (int d_ = 0; d_ < 4; ++d_) for (int r = 0; r < 16; ++r) o[d_][r] *= al_l[crow(r, hi)]; } } while (0)
#define KBASE(t) ((j_lo + (t)) * KVBLK)
#define ACT(t) (KBASE(t) <= qlo + QBLK - 1 && KBASE(t) + KVBLK - 1 >= qlo - W + 1)
#define MASKT(P0_, P1_, t) do { if constexpr (VAR == 3) mask_bits(P0_, P1_, (((t) & 1) ? mwB : mwA), hi); else if constexpr (VAR == 2) { unsigned long long m_ = (((t) & 1) ? mwB : mwA); asm volatile("" :: "v"(m_)); } } while (0)
#define MWLOAD(t) do { const int tt_ = (t) < NT ? (t) : NT - 1; if ((t) & 1) mwB = mrow[j_lo + tt_]; else mwA = mrow[j_lo + tt_]; } while (0)
    constexpr int NQL = F32 ? 16 : 8;
    constexpr bool BI = (VAR == 0);
    constexpr bool SK = WSKIP && !F32;
#define SEAM_K0() do { VMWN(NQL); if constexpr (F32) { SWRITE_KF(0); SBAR(); SLOAD_F((const float*)nxt.V, kbn); } else { SWRITE_HK(0); } SBAR(); } while (0)
    f32x16 pA0, pA1, pB0, pB1; float mnA, mnB, alA, alB; bf16x8 pa0, pa1, pa2, pa3;
    unsigned long long mwA = mrow[j_lo], mwB = mrow[j_lo + (NT > 1 ? 1 : 0)];
    if constexpr (F32) { VMW(); SWRITE_VF(0); SBAR(); } else { SWRITE_HV(0); SBAR(); }
    if (NT > 1) { if constexpr (F32) SLOAD_F((const float*)Kh, KBASE(1)); else SLOAD_H(Kh, Vh, KBASE(1)); }
    if constexpr (BI) { mask_bias(pA0, pA1, mwA, hi); MWLOAD(2); }
    SBAR(); qkt<0, SK, BI>(pA0, pA1, K_lds, r32, hi, S.qr, ACT(0));
    if constexpr (BI) mask_bias(pB0, pB1, mwB, hi);
    if constexpr (F32) { if (NT > 1) { VMW(); SWRITE_KF(1); SBAR(); SLOAD_F((const float*)Vh, KBASE(1)); } }
    MASKT(pA0, pA1, 0); partialSM(pA0, pA1, m_reg, mnA, alA);
    if (NT > 1) { VMW(); if constexpr (F32) { SWRITE_VF(1); SBAR(); if (NT > 2) SLOAD_F((const float*)Kh, KBASE(2)); } else SWRITE_H(1); }
    __syncthreads();
#define HALF_STEP(PX0, PX1, mnX, alX, PY0, PY1, alY, t, KB, VB, SB) do {                                                      \
        if constexpr (BI) MWLOAD((t) + 2); else MWLOAD((t) + 1);                                                          \
        SBAR(); qkt<KB, SK, BI>(PX0, PX1, K_lds, r32, hi, S.qr, ACT(t));                                                  \
        finishSM(PY0, PY1, alY, l_reg, pa0, pa1, pa2, pa3); SBAR();                                                           \
        if ((t) + 1 < NT) { if constexpr (F32) { VMW(); SWRITE_KF(SB); SBAR(); SLOAD_F((const float*)Vh, KBASE((t) + 1)); }  \
                            else { SLOAD_H(Kh, Vh, KBASE((t) + 1)); } SBAR(); }                                               \
        { const unsigned long long mwn_ = (((t) + 1) & 1) ? mwB : mwA; const unsigned nlo_ = ~(unsigned)(mwn_ >> (4 * hi)), nup_ = ~(unsigned)(mwn_ >> (32 + 4 * hi));   \
          pv_tile<VB, SK, BI>(o, vb0, pa0, pa1, pa2, pa3, ACT((t) - 1), &PY0, &PY1, nlo_, nup_); }                           \
        MASKT(PX0, PX1, (t)); partialSM(PX0, PX1, m_reg, mnX, alX);                                        \
        __syncthreads();                                                                                                      \
        if ((t) + 1 < NT) { VMW(); if constexpr (F32) { SWRITE_VF(SB); SBAR(); if ((t) + 2 < NT) SLOAD_F((const float*)Kh, KBASE((t) + 2)); } \
                            else { SWRITE_H(SB); } }                                                                          \
        RESC(alX); __syncthreads(); } while (0)
    for (int t = 1; t + 1 < NT; t += 2) {
        HALF_STEP(pB0, pB1, mnB, alB, pA0, pA1, alA, t, 1, 0, 0);
        HALF_STEP(pA0, pA1, mnA, alA, pB0, pB1, alB, t + 1, 0, 1, 1);
    }
    const bool even = (NT & 1) == 0;
    if (even) { SBAR(); qkt<1, SK, BI>(pB0, pB1, K_lds, r32, hi, S.qr, ACT(NT - 1)); SBAR(); }
#define QROW(e) (nxt.Q + (size_t)(wid * QBLK + r32) * QST + ((e) >> 1) * 16 + hi * 8 + ((e) & 1) * 4)
    if constexpr (F32) { SLOAD_F((const float*)nxt.K, kbn); SBAR();
#pragma unroll
        for (int e = 0; e < 8; ++e) S.tq[e] = *(const f32x4*)QROW(e); }
    else { SLOAD_H(nxt.K, nxt.V, kbn); SBAR();
#pragma unroll
        for (int d0 = 0; d0 < 8; ++d0) S.qr[d0] = load8<TIn>(nxt.Q + (size_t)(wid * QBLK + r32) * QST + d0 * 16 + hi * 8); }
    SBAR();
    finishSM(pA0, pA1, alA, l_reg, pa0, pa1, pa2, pa3); SBAR();
    if constexpr (F32) {
#pragma unroll
        for (int e = 8; e < 16; ++e) S.tq[e] = *(const f32x4*)QROW(e); SBAR(); }
#undef QROW
    pv_tile<0, SK>(o, vb0, pa0, pa1, pa2, pa3, ACT(even ? NT - 2 : NT - 1));
    if (even) { MASKT(pB0, pB1, NT - 1); partialSM(pB0, pB1, m_reg, mnB, alB); __syncthreads(); RESC(alB);
        finishSM(pB0, pB1, alB, l_reg, pa0, pa1, pa2, pa3); SBAR(); pv_tile<1, SK>(o, vb0, pa0, pa1, pa2, pa3, ACT(NT - 1)); }
    SBAR(); SEAM_K0();
    if (hi == 0) li_l[r32] = l_reg; asm volatile("s_waitcnt lgkmcnt(0)" ::: "memory");
    float rli[16];
#pragma unroll
    for (int r = 0; r < 16; ++r) rli[r] = __builtin_amdgcn_rcpf(li_l[crow(r, hi)]);
    TOut* Ow = cur.O + (size_t)(wid * QBLK) * OST;
#pragma unroll
    for (int r = 0; r < 16; ++r) { const int orow = crow(r, hi);
#pragma unroll
        for (int d0 = 0; d0 < 4; ++d0) { const float v = o[d0][r] * rli[r];
            if constexpr (same_t<TOut, float>::v) { Ow[(size_t)orow * OST + d0 * 32 + r32] = v; }
            else { const float vn = __shfl_xor(v, 1);
                   if ((r32 & 1) == 0) *(unsigned*)(Ow + (size_t)orow * OST + d0 * 32 + r32) = cvtpk(v, vn); } } }
    if constexpr (F32) {
#pragma unroll
        for (int d0 = 0; d0 < 8; ++d0) S.qr[d0] = pack8(S.tq[2 * d0], S.tq[2 * d0 + 1]); }
    __syncthreads();
#undef RESC
#undef KBASE
#undef ACT
#undef MASKT
#undef MWLOAD
#undef SEAM_K0
#undef HALF_STEP
}
#undef ROW
#undef VMW
#undef VMWN
#undef SLOAD_H
#undef SWRITE_HK
#undef SWRITE_HV
#undef SWRITE_H
#undef SLOAD_F
#undef SWRITE_KF
#undef SWRITE_VF

}

constexpr int NWAVES = 8, NTHREADS = 512;
constexpr int DM = 2048, SEQ = 4096, NMETA = 16, TP = 4112, NBP = 2, SBN = 8, PAST = 16384, NPG = 128;
constexpr int XROW0 = 8192, SROW0 = 8224, NROWS = 8232, MPAD = 8448, FF = 8192, MAINM = 8192, XR = 48;
constexpr int NA_IN = 6144, NB_IN = 4176, NB_PAD = 4352, NC_IN = 12352, NC_PAD = 12544, DVW = 4096, CDIM = 8192;
constexpr float ALPHA = 1.6817928305074292f;
constexpr float LN_EPS = 1e-5f, RMS_EPS = 1e-6f;
constexpr int SCW = 4160, SCSW = 16448, KIROWS = 4128, NSKEY = PAST + 1;
constexpr int POS_SAMPLE_IDX = TP;

constexpr size_t O_YP = 0, O_YS = O_YP + (size_t)NBP * SEQ * DM, O_CAP = O_YS + (size_t)SBN * DM, O_CAS = O_CAP + 2 * NBP * 2 * DM,
                 O_KP = O_CAS + 2 * SBN * 2 * DM, O_VP = O_KP + (size_t)NBP * TP * 512, O_IKP = O_VP + (size_t)NBP * TP * 512,
                 O_KS = O_IKP + (size_t)NBP * TP * 64, O_VS = O_KS + SBN * 512, O_IKS = O_VS + SBN * 512, O_CCP = O_IKS + SBN * 64,
                 O_CCS = O_CCP + (size_t)NBP * 3 * CDIM, O_DP = O_CCS + (size_t)SBN * 3 * CDIM, O_DS = O_DP + (size_t)NBP * 32 * 128 * 128,
                 O_END = O_DS + (size_t)SBN * 32 * 128 * 128;

constexpr size_t MiB = 1u << 20;
constexpr size_t WS_CTL = 0, CTL_ZERO_BYTES = 1 * MiB;
constexpr size_t WS_TAB128 = 1 * MiB, WS_TAB64 = 4 * MiB, WS_WI = 6 * MiB, WS_G = 7 * MiB, WS_BETA = 9 * MiB, WS_CNT = 11 * MiB, WS_KIB = 12 * MiB,
                 WS_SCS = 14 * MiB, WS_IDXL = 16 * MiB, WS_X = 26 * MiB, WS_QR = 60 * MiB, WS_QI = 94 * MiB, WS_Z = 112 * MiB, WS_Y = 180 * MiB,
                 WS_BIG = 248 * MiB, WS_QKVC = 452 * MiB, WS_SC = 584 * MiB, WS_W = 716 * MiB;
constexpr size_t WSZ_A_IN = (size_t)NA_IN * DM * 2, WSZ_A_OUT = (size_t)DM * DM * 2, WSZ_B_IN = (size_t)NB_PAD * DM * 2, WSZ_B_OUT = (size_t)DM * DM * 2,
                 WSZ_C_IN = (size_t)NC_PAD * DM * 2, WSZ_C_OUT = (size_t)DM * DVW * 2, WSZ_W1 = (size_t)FF * DM * 2, WSZ_W2 = (size_t)DM * FF * 2;
constexpr size_t WS_WA_IN = WS_W, WS_WA_OUT = WS_WA_IN + 2 * WSZ_A_IN, WS_WB_IN = WS_WA_OUT + 2 * WSZ_A_OUT, WS_WB_OUT = WS_WB_IN + WSZ_B_IN,
                 WS_WC_IN = WS_WB_OUT + WSZ_B_OUT, WS_WC_OUT = WS_WC_IN + WSZ_C_IN, WS_W1 = WS_WC_OUT + WSZ_C_OUT, WS_W2 = WS_W1 + 4 * WSZ_W1,
                 WS_ZP = WS_W2 + 4 * WSZ_W2, WS_QKF = WS_ZP + 4 * MiB, WS_DWG = WS_QKF + 130 * MiB, WS_DUG = WS_DWG + 66 * MiB, WS_END = WS_DUG + 66 * MiB;
constexpr size_t WS_MASK = WS_IDXL, WS_KS = WS_Z, WS_VS = WS_Z + 9 * MiB;
constexpr size_t WS_DAF = WS_Z, WS_DTG = WS_Y, WS_DTB = WS_Y + 33 * MiB, WS_DPG = WS_QR, WS_DKT = WS_QKF, WS_DVT = WS_QKF + 33 * MiB, WS_DGC = WS_QI, WS_DBT = WS_QI + 2 * MiB;
constexpr int SP = 4352, SPAD = 240, MTW = 68;
constexpr int CW_BAR = 4096;

constexpr int RING_BYTES = 131072, LDSCTL_OFF = RING_BYTES, MISC_OFF = LDSCTL_OFF + 320, LDS_BYTES = 147456;

typedef unsigned short bf16;
typedef unsigned v4u __attribute__((ext_vector_type(4)));
typedef unsigned v2u __attribute__((ext_vector_type(2)));
typedef float f32x4 __attribute__((ext_vector_type(4)));
typedef float f32x2 __attribute__((ext_vector_type(2)));
typedef short bf16x8 __attribute__((ext_vector_type(8)));
typedef float f32x16 __attribute__((ext_vector_type(16)));
typedef __bf16 bf16x2_t __attribute__((ext_vector_type(2)));

#define LDS_WAIT() asm volatile("s_waitcnt lgkmcnt(0)" ::: "memory")
#define WAVE_SYNC() do { asm volatile("s_waitcnt lgkmcnt(0)" ::: "memory"); __builtin_amdgcn_wave_barrier(); } while (0)

__device__ __forceinline__ float bflo(unsigned w) { return __uint_as_float(w << 16); }
__device__ __forceinline__ float bfhi(unsigned w) { return __uint_as_float(w & 0xffff0000u); }
__device__ __forceinline__ float bf2f(bf16 h) { return __uint_as_float((unsigned)h << 16); }
__device__ __forceinline__ unsigned pk2(float lo, float hi) { f32x2 v = {lo, hi}; bf16x2_t b = __builtin_convertvector(v, bf16x2_t); return __builtin_bit_cast(unsigned, b); }
__device__ __forceinline__ bf16 f2bf(float f) { return (bf16)(pk2(f, 0.f) & 0xffffu); }
__device__ __forceinline__ float wave_sum(float v) {
#pragma unroll
    for (int o = 1; o < 64; o <<= 1) v += __shfl_xor(v, o);
    return v;
}
__device__ __forceinline__ float wave_max(float v) {
#pragma unroll
    for (int o = 1; o < 64; o <<= 1) v = fmaxf(v, __shfl_xor(v, o));
    return v;
}
__device__ __forceinline__ int wave_sum_i(int v) {
#pragma unroll
    for (int o = 1; o < 64; o <<= 1) v += __shfl_xor(v, o);
    return v;
}
__device__ __forceinline__ float wave_sum_dpp(float v) {
    v += __int_as_float(__builtin_amdgcn_update_dpp(0, __float_as_int(v), 0x128, 0xf, 0xf, false));
    v += __int_as_float(__builtin_amdgcn_update_dpp(0, __float_as_int(v), 0x124, 0xf, 0xf, false));
    v += __int_as_float(__builtin_amdgcn_update_dpp(0, __float_as_int(v), 0x122, 0xf, 0xf, false));
    v += __int_as_float(__builtin_amdgcn_update_dpp(0, __float_as_int(v), 0x121, 0xf, 0xf, false));
    const int iv = __float_as_int(v);
    return (__int_as_float(__builtin_amdgcn_readlane(iv, 0)) + __int_as_float(__builtin_amdgcn_readlane(iv, 16))) + (__int_as_float(__builtin_amdgcn_readlane(iv, 32)) + __int_as_float(__builtin_amdgcn_readlane(iv, 48)));
}
__device__ __forceinline__ int wave_sum_dpp_i(int v) {
    v += __builtin_amdgcn_update_dpp(0, v, 0x128, 0xf, 0xf, false);
    v += __builtin_amdgcn_update_dpp(0, v, 0x124, 0xf, 0xf, false);
    v += __builtin_amdgcn_update_dpp(0, v, 0x122, 0xf, 0xf, false);
    v += __builtin_amdgcn_update_dpp(0, v, 0x121, 0xf, 0xf, false);
    return __builtin_amdgcn_readlane(v, 0) + __builtin_amdgcn_readlane(v, 16) + __builtin_amdgcn_readlane(v, 32) + __builtin_amdgcn_readlane(v, 48);
}
__device__ __forceinline__ float row16_sum(float v) {
    v += __int_as_float(__builtin_amdgcn_update_dpp(0, __float_as_int(v), 0x128, 0xf, 0xf, false));
    v += __int_as_float(__builtin_amdgcn_update_dpp(0, __float_as_int(v), 0x124, 0xf, 0xf, false));
    v += __int_as_float(__builtin_amdgcn_update_dpp(0, __float_as_int(v), 0x122, 0xf, 0xf, false));
    v += __int_as_float(__builtin_amdgcn_update_dpp(0, __float_as_int(v), 0x121, 0xf, 0xf, false));
    return v;
}
__device__ __forceinline__ float silu_f(float x) { return x / (1.f + __expf(-x)); }
__device__ __forceinline__ int prow(int b, int t) { return t >= NMETA ? b * SEQ + (t - NMETA) : XROW0 + b * NMETA + t; }
__device__ __forceinline__ void row_bt(int r, int& b, int& t) { if (r < XROW0) { b = r >> 12; t = (r & 4095) + NMETA; } else { b = (r - XROW0) >> 4; t = (r - XROW0) & 15; } }
__device__ __forceinline__ void unpack8(const v4u w, float (&f)[8]) {
    f[0] = bflo(w.x); f[1] = bfhi(w.x); f[2] = bflo(w.y); f[3] = bfhi(w.y); f[4] = bflo(w.z); f[5] = bfhi(w.z); f[6] = bflo(w.w); f[7] = bfhi(w.w);
}
__device__ __forceinline__ v4u pack8(const float (&f)[8]) { v4u w; w.x = pk2(f[0], f[1]); w.y = pk2(f[2], f[3]); w.z = pk2(f[4], f[5]); w.w = pk2(f[6], f[7]); return w; }

struct TrJob { bf16* WT; int K, k0, n0; bool ok, valid; };
__device__ __forceinline__ void tr_issue(const float* W, int K, int N, int Npad, bf16* WT, int item, int lane, float (&wv_)[32], TrJob& J) {
    const int nblk = Npad / 32, kb = item / nblk, nb = item % nblk, k0 = 64 * kb, n0 = 32 * nb;
    const int n = n0 + (lane & 31); const bool ok = n < N;
#pragma unroll
    for (int i = 0; i < 32; ++i) { const int kk = 2 * i + (lane >> 5); wv_[i] = W[(size_t)(k0 + kk) * N + (ok ? n : N - 1)]; }
    J.WT = WT; J.K = K; J.k0 = k0; J.n0 = n0; J.ok = ok; J.valid = true;
}
__device__ __forceinline__ void tr_finish(const float (&wv_)[32], const TrJob& J, LAS float* scr, int lane) {
#pragma unroll
    for (int i = 0; i < 32; ++i) { const int kk = 2 * i + (lane >> 5); scr[kk * 33 + (lane & 31)] = J.ok ? wv_[i] : 0.f; }
    LDS_WAIT(); __builtin_amdgcn_wave_barrier();
    const int c = lane & 7;
#pragma unroll
    for (int j = 0; j < 4; ++j) { const int nn = (lane >> 3) + 8 * j; const LAS float* sp = scr + (8 * c) * 33 + nn;
        v4u o; o.x = pk2(sp[0 * 33], sp[1 * 33]); o.y = pk2(sp[2 * 33], sp[3 * 33]); o.z = pk2(sp[4 * 33], sp[5 * 33]); o.w = pk2(sp[6 * 33], sp[7 * 33]);
        *(v4u*)(J.WT + (size_t)(J.n0 + nn) * J.K + J.k0 + 8 * c) = o; }
    LDS_WAIT(); __builtin_amdgcn_wave_barrier();
}
__device__ __forceinline__ void transpose_item(const float* W, int K, int N, int Npad, bf16* WT, LAS float* scr, int item, int lane) {
    float wv_[32]; TrJob J; tr_issue(W, K, N, Npad, WT, item, lane, wv_, J); tr_finish(wv_, J, scr, lane);
}

struct Ptrs {
    const float *x_prompt, *x_sample, *state_conv_a, *cache_k, *cache_v, *cache_ik, *state_conv_c, *state_delta;
    const int* page_table;
    const float *meta, *w_in_a, *conv_w_a, *w_out_a, *w_in_b, *w_out_b, *w_in_c, *conv_w_c, *a_log, *dt_bias, *norm_w, *w_out_c, *ln1_g, *ln1_b, *w1, *w2, *ln2_g, *ln2_b;
    float* out; unsigned char* ws;
};

__device__ __forceinline__ void p0_prologue(const Ptrs& P, LAS unsigned char* lds, int gw, int NGW, int wave, int lane) {
    LAS float* scr = (LAS float*)(lds + wave * 16384);
    unsigned char* ws = P.ws;
    constexpr int I_A_IN = (DM / 64) * (NA_IN / 32), I_A_OUT = (DM / 64) * (DM / 32), I_B_IN = (DM / 64) * (NB_PAD / 32), I_B_OUT = I_A_OUT,
                  I_C_IN = (DM / 64) * (NC_PAD / 32), I_C_OUT = (DVW / 64) * (DM / 32), I_W1 = (DM / 64) * (FF / 32), I_W2 = (FF / 64) * (DM / 32);
    constexpr int NITEMS = I_A_IN + I_A_OUT + I_B_IN + I_W1 + I_W2;
#define TR_(cnt, Wp, Kk, Nn, Np, WTp) if (r < (cnt)) { transpose_item((Wp), (Kk), (Nn), (Np), (bf16*)(WTp), scr, r, lane); continue; } r -= (cnt);
    for (int it = gw; it < NITEMS; it += NGW) {
        int r = it;
        TR_(I_A_IN, P.w_in_a, DM, NA_IN, NA_IN, ws + WS_WA_IN)
        TR_(I_A_OUT, P.w_out_a, DM, DM, DM, ws + WS_WA_OUT)
        TR_(I_B_IN, P.w_in_b, DM, NB_IN, NB_PAD, ws + WS_WB_IN)
        TR_(I_W1, P.w1, DM, FF, FF, ws + WS_W1)
        transpose_item(P.w2, FF, DM, DM, (bf16*)(ws + WS_W2), scr, r, lane);
    }
#undef TR_
    bf16* X = (bf16*)(ws + WS_X);
    for (int r = gw; r < MPAD; r += NGW) {
        const float* src = nullptr;
        if (r < XROW0) src = P.x_prompt + (size_t)r * DM;
        else if (r < SROW0) src = P.meta + (size_t)((r - XROW0) & 15) * DM;
        else if (r < NROWS) src = P.x_sample + (size_t)(r - SROW0) * DM;
#pragma unroll
        for (int j = 0; j < 4; ++j) { const int c = 512 * j + 8 * lane; v4u o = {0u, 0u, 0u, 0u};
            if (src) { const f32x4 a = *(const f32x4*)(src + c), b = *(const f32x4*)(src + c + 4); o.x = pk2(a.x, a.y); o.y = pk2(a.z, a.w); o.z = pk2(b.x, b.y); o.w = pk2(b.z, b.w); }
            *(v4u*)(X + (size_t)r * DM + c) = o; }
    }
    f32x2* t128 = (f32x2*)(ws + WS_TAB128); f32x2* t64 = (f32x2*)(ws + WS_TAB64);
    const int gt = gw * 64 + lane, NGT = NGW * 64;
    for (int e = gt; e < (TP + 1) * 96; e += NGT) {
        const int pi = e / 96, i = e % 96; const float pos = (float)(pi == TP ? PAST : pi);
        const float ex = (i < 64) ? (float)(2 * i) * (1.f / 128.f) : (float)(2 * (i - 64)) * (1.f / 64.f);
        const float inv = __builtin_amdgcn_exp2f(-ex * 13.287712379549449f);
        const float angf = pos * inv;
        double rev = (double)angf * 0.15915494309189535; rev -= __builtin_rint(rev);
        const float rf = (float)rev; const float sn = __builtin_amdgcn_sinf(rf), cs = __builtin_amdgcn_cosf(rf);
        if (i < 64) t128[pi * 64 + i] = (f32x2){cs, sn}; else t64[pi * 32 + (i - 64)] = (f32x2){cs, sn};
    }
}

constexpr int NHOSTED = (DM / 64) * (DM / 32) + (DM / 64) * (FF / 32) + (FF / 64) * (DM / 32) + (DM / 64) * (NC_PAD / 32);
__device__ __forceinline__ void hosted_issue(const Ptrs& P, int it, int lane, float (&wv_)[32], TrJob& J) {
    unsigned char* ws = P.ws;
    constexpr int I_B_OUT = (DM / 64) * (DM / 32), I_C_IN = (DM / 64) * (NC_PAD / 32), I_W1 = (DM / 64) * (FF / 32), I_W2 = (FF / 64) * (DM / 32);
    J.valid = false;
    if (it >= NHOSTED) return;
    int r = it;
    if (r < I_B_OUT) { tr_issue(P.w_out_b, DM, DM, DM, (bf16*)(ws + WS_WB_OUT), r, lane, wv_, J); return; } r -= I_B_OUT;
    if (r < I_W1) { tr_issue(P.w1 + (size_t)DM * FF, DM, FF, FF, (bf16*)(ws + WS_W1 + WSZ_W1), r, lane, wv_, J); return; } r -= I_W1;
    if (r < I_W2) { tr_issue(P.w2 + (size_t)DM * FF, FF, DM, DM, (bf16*)(ws + WS_W2 + WSZ_W2), r, lane, wv_, J); return; } r -= I_W2;
    (void)I_C_IN; tr_issue(P.w_in_c, DM, NC_IN, NC_PAD, (bf16*)(ws + WS_WC_IN), r, lane, wv_, J);
}
__device__ __forceinline__ void deferred_transposes(const Ptrs& P, LAS unsigned char* lds, int idx, int stride, int wave, int lane) {
    LAS float* scr = (LAS float*)(lds + wave * 16384);
    unsigned char* ws = P.ws;
    constexpr int I_A_IN = (DM / 64) * (NA_IN / 32), I_A_OUT = (DM / 64) * (DM / 32), I_C_OUT = (DVW / 64) * (DM / 32), I_W1 = (DM / 64) * (FF / 32), I_W2 = (FF / 64) * (DM / 32);
    constexpr int NITEMS = I_A_IN + I_A_OUT + I_C_OUT + 2 * I_W1 + 2 * I_W2;
#define TR_(cnt, Wp, Kk, Nn, Np, WTp) if (r < (cnt)) { transpose_item((Wp), (Kk), (Nn), (Np), (bf16*)(WTp), scr, r, lane); continue; } r -= (cnt);
    for (int it = idx; it < NITEMS; it += stride) {
        int r = it;
        TR_(I_C_OUT, P.w_out_c, DVW, DM, DM, ws + WS_WC_OUT)
        TR_(I_W1, P.w1 + 2 * (size_t)DM * FF, DM, FF, FF, ws + WS_W1 + 2 * WSZ_W1)
        TR_(I_W2, P.w2 + 2 * (size_t)DM * FF, FF, DM, DM, ws + WS_W2 + 2 * WSZ_W2)
        TR_(I_A_IN, P.w_in_a + (size_t)DM * NA_IN, DM, NA_IN, NA_IN, ws + WS_WA_IN + WSZ_A_IN)
        TR_(I_A_OUT, P.w_out_a + (size_t)DM * DM, DM, DM, DM, ws + WS_WA_OUT + WSZ_A_OUT)
        TR_(I_W1, P.w1 + 3 * (size_t)DM * FF, DM, FF, FF, ws + WS_W1 + 3 * WSZ_W1)
        transpose_item(P.w2 + 3 * (size_t)DM * FF, FF, DM, DM, (bf16*)(ws + WS_W2 + 3 * WSZ_W2), scr, r, lane);
    }
#undef TR_
}

__device__ __forceinline__ void ln_row_finish(float (&v)[32], float s, const f32x4 (&gq)[8], const f32x4 (&bq_)[8], bf16* xo, float* of, int lane) {
    const float mean = wave_sum_dpp(s) * (1.f / DM); float s2 = 0.f;
#pragma unroll
    for (int i = 0; i < 32; ++i) { v[i] -= mean; s2 += v[i] * v[i]; }
    const float rstd = 1.f / sqrtf(wave_sum_dpp(s2) * (1.f / DM) + LN_EPS);
#pragma unroll
    for (int j = 0; j < 4; ++j) { const int c = 512 * j + 8 * lane; const f32x4 g0 = gq[2 * j], g1 = gq[2 * j + 1], b0 = bq_[2 * j], b1 = bq_[2 * j + 1];
        float o[8];
        o[0] = v[8 * j + 0] * rstd * g0.x + b0.x; o[1] = v[8 * j + 1] * rstd * g0.y + b0.y; o[2] = v[8 * j + 2] * rstd * g0.z + b0.z; o[3] = v[8 * j + 3] * rstd * g0.w + b0.w;
        o[4] = v[8 * j + 4] * rstd * g1.x + b1.x; o[5] = v[8 * j + 5] * rstd * g1.y + b1.y; o[6] = v[8 * j + 6] * rstd * g1.z + b1.z; o[7] = v[8 * j + 7] * rstd * g1.w + b1.w;
        *(v4u*)(xo + c) = pack8(o);
        if (of) { *(f32x4*)(of + c) = (f32x4){o[0], o[1], o[2], o[3]}; *(f32x4*)(of + c + 4) = (f32x4){o[4], o[5], o[6], o[7]}; } }
}
__device__ __forceinline__ void ln_phase(const float* Z, const float* ZP, bf16* X, bf16* Xo, const float* gam, const float* bet, float* yp, float* ys, LAS unsigned char* lds, int gw, int NGW, int tid, int wave, int lane) {
    (void)Z;
    LAS float* red = (LAS float*)lds;
    for (int xr = blockIdx.x; xr < NROWS - XROW0; xr += gridDim.x) {
        const int r = XROW0 + xr, c = 256 * wave + 4 * lane;
        const v2u xv = *(const v2u*)(X + (size_t)r * DM + c);
        const float* zr = ZP + (size_t)xr * DM + c; f32x4 z = *(const f32x4*)zr;
#pragma unroll
        for (int sl = 1; sl < 8; ++sl) z += *(const f32x4*)(zr + (size_t)sl * XR * DM);
        float v4[4] = {ALPHA * bflo(xv.x) + z.x, ALPHA * bfhi(xv.x) + z.y, ALPHA * bflo(xv.y) + z.z, ALPHA * bfhi(xv.y) + z.w};
        const float ps = wave_sum_dpp((v4[0] + v4[1]) + (v4[2] + v4[3]));
        __syncthreads();
        if (lane == 0) red[wave] = ps;
        __syncthreads();
        float tot = 0.f;
#pragma unroll
        for (int w = 0; w < 8; ++w) tot += red[w];
        const float mean = tot * (1.f / DM); float q2 = 0.f;
#pragma unroll
        for (int i = 0; i < 4; ++i) { v4[i] -= mean; q2 += v4[i] * v4[i]; }
        const float pq = wave_sum_dpp(q2);
        if (lane == 0) red[8 + wave] = pq;
        __syncthreads();
        float tq = 0.f;
#pragma unroll
        for (int w = 0; w < 8; ++w) tq += red[8 + w];
        const float rstd = 1.f / sqrtf(tq * (1.f / DM) + LN_EPS);
        const f32x4 g = *(const f32x4*)(gam + c), be = *(const f32x4*)(bet + c);
        const float o0 = v4[0] * rstd * g.x + be.x, o1 = v4[1] * rstd * g.y + be.y, o2 = v4[2] * rstd * g.z + be.z, o3 = v4[3] * rstd * g.w + be.w;
        v2u ov; ov.x = pk2(o0, o1); ov.y = pk2(o2, o3); *(v2u*)(Xo + (size_t)r * DM + c) = ov;
        if (ys && r >= SROW0) *(f32x4*)(ys + (size_t)(r - SROW0) * DM + c) = (f32x4){o0, o1, o2, o3};
    }
    f32x4 gq[8], bq_[8];
#pragma unroll
    for (int j = 0; j < 4; ++j) { const int c = 512 * j + 8 * lane; gq[2 * j] = *(const f32x4*)(gam + c); gq[2 * j + 1] = *(const f32x4*)(gam + c + 4); bq_[2 * j] = *(const f32x4*)(bet + c); bq_[2 * j + 1] = *(const f32x4*)(bet + c + 4); }
    for (int r = gw; r < XROW0; r += 2 * NGW) {
        const int r2 = r + NGW; const bool two = r2 < XROW0;
        v4u xa[4], xb[4];
#pragma unroll
        for (int j = 0; j < 4; ++j) { const int c = 512 * j + 8 * lane; xa[j] = *(const v4u*)(X + (size_t)r * DM + c); xb[j] = *(const v4u*)(X + (size_t)(two ? r2 : r) * DM + c); }
        float va[32], vb[32]; float sa = 0.f, sb = 0.f;
#pragma unroll
        for (int j = 0; j < 4; ++j) { float t8[8]; unpack8(xa[j], t8);
#pragma unroll
            for (int i = 0; i < 8; ++i) { va[8 * j + i] = t8[i]; sa += t8[i]; }
            unpack8(xb[j], t8);
#pragma unroll
            for (int i = 0; i < 8; ++i) { vb[8 * j + i] = t8[i]; sb += t8[i]; } }
        ln_row_finish(va, sa, gq, bq_, Xo + (size_t)r * DM, yp ? yp + (size_t)r * DM : nullptr, lane);
        if (two) ln_row_finish(vb, sb, gq, bq_, Xo + (size_t)r2 * DM, yp ? yp + (size_t)r2 * DM : nullptr, lane);
    }
}

__device__ __forceinline__ void load_u(const bf16* BCH, int row, int c0, float (&u)[8]) {
    const v4u cg = *(const v4u*)(BCH + (size_t)row * NA_IN + DM + c0), hh = *(const v4u*)(BCH + (size_t)row * NA_IN + 2 * DM + c0);
    float a[8], b[8]; unpack8(cg, a); unpack8(hh, b);
#pragma unroll
    for (int i = 0; i < 8; ++i) u[i] = a[i] * b[i];
}
__device__ __forceinline__ void convA_phase(const bf16* BCH, bf16* Y, const float* cw, const float* hist, float* outp, float* outs, int gtid, int NT) {
    constexpr int RUN = 8, NRUN = SEQ / RUN;
    for (int it = gtid; it < (NBP * NRUN + NBP * NMETA + SBN) * 256; it += NT) {
        const int c0 = (it & 255) * 8, ru = it >> 8;
        float w0[8], w1[8], w2[8];
        { const f32x4 a = *(const f32x4*)(cw + c0), b = *(const f32x4*)(cw + c0 + 4); w0[0] = a.x; w0[1] = a.y; w0[2] = a.z; w0[3] = a.w; w0[4] = b.x; w0[5] = b.y; w0[6] = b.z; w0[7] = b.w; }
        { const f32x4 a = *(const f32x4*)(cw + DM + c0), b = *(const f32x4*)(cw + DM + c0 + 4); w1[0] = a.x; w1[1] = a.y; w1[2] = a.z; w1[3] = a.w; w1[4] = b.x; w1[5] = b.y; w1[6] = b.z; w1[7] = b.w; }
        { const f32x4 a = *(const f32x4*)(cw + 2 * DM + c0), b = *(const f32x4*)(cw + 2 * DM + c0 + 4); w2[0] = a.x; w2[1] = a.y; w2[2] = a.z; w2[3] = a.w; w2[4] = b.x; w2[5] = b.y; w2[6] = b.z; w2[7] = b.w; }
        float u0[8], u1[8], u2[8];
        if (ru < NBP * NRUN) {
            const int b = ru / NRUN, t0 = NMETA + (ru % NRUN) * RUN;
            if (t0 >= 1) load_u(BCH, prow(b, t0 - 1), c0, u1); else {
#pragma unroll
                for (int i = 0; i < 8; ++i) u1[i] = 0.f; }
            if (t0 >= 2) load_u(BCH, prow(b, t0 - 2), c0, u0); else {
#pragma unroll
                for (int i = 0; i < 8; ++i) u0[i] = 0.f; }
            const int r0 = prow(b, t0);
            v4u bq[RUN], cq[RUN], hq_[RUN];
#pragma unroll
            for (int k = 0; k < RUN; ++k) { const bf16* rp = BCH + (size_t)(r0 + k) * NA_IN + c0; bq[k] = *(const v4u*)rp; cq[k] = *(const v4u*)(rp + DM); hq_[k] = *(const v4u*)(rp + 2 * DM); }
#pragma unroll
            for (int k = 0; k < RUN; ++k) {
                const int r = r0 + k, t = t0 + k;
                { float ca[8], ha[8]; unpack8(cq[k], ca); unpack8(hq_[k], ha);
#pragma unroll
                  for (int i = 0; i < 8; ++i) u2[i] = ca[i] * ha[i]; }
                float bg[8]; unpack8(bq[k], bg);
                float y[8];
#pragma unroll
                for (int i = 0; i < 8; ++i) y[i] = bg[i] * (w0[i] * u0[i] + w1[i] * u1[i] + w2[i] * u2[i]);
                *(v4u*)(Y + (size_t)r * DM + c0) = pack8(y);
                if (t >= TP - 2) { float* o = outp + ((size_t)(b * 2 + (t - (TP - 2)))) * DM + c0; *(f32x4*)o = (f32x4){u2[0], u2[1], u2[2], u2[3]}; *(f32x4*)(o + 4) = (f32x4){u2[4], u2[5], u2[6], u2[7]}; }
#pragma unroll
                for (int i = 0; i < 8; ++i) { u0[i] = u1[i]; u1[i] = u2[i]; }
            }
        } else if (ru < NBP * NRUN + NBP * NMETA) {
            const int mi = ru - NBP * NRUN, b = mi / NMETA, t = mi % NMETA, r = XROW0 + mi;
            load_u(BCH, r, c0, u2);
            if (t >= 1) load_u(BCH, r - 1, c0, u1); else {
#pragma unroll
                for (int i = 0; i < 8; ++i) u1[i] = 0.f; }
            if (t >= 2) load_u(BCH, r - 2, c0, u0); else {
#pragma unroll
                for (int i = 0; i < 8; ++i) u0[i] = 0.f; }
            (void)b;
            float bg[8]; unpack8(*(const v4u*)(BCH + (size_t)r * NA_IN + c0), bg);
            float y[8];
#pragma unroll
            for (int i = 0; i < 8; ++i) y[i] = bg[i] * (w0[i] * u0[i] + w1[i] * u1[i] + w2[i] * u2[i]);
            *(v4u*)(Y + (size_t)r * DM + c0) = pack8(y);
        } else {
            const int sb = ru - NBP * NRUN - NBP * NMETA, r = SROW0 + sb;
            load_u(BCH, r, c0, u2);
            const float* h0 = hist + ((size_t)(sb * 2 + 0)) * DM + c0; const float* h1 = hist + ((size_t)(sb * 2 + 1)) * DM + c0;
            const f32x4 a0 = *(const f32x4*)h0, a1 = *(const f32x4*)(h0 + 4), b0 = *(const f32x4*)h1, b1 = *(const f32x4*)(h1 + 4);
            u0[0] = a0.x; u0[1] = a0.y; u0[2] = a0.z; u0[3] = a0.w; u0[4] = a1.x; u0[5] = a1.y; u0[6] = a1.z; u0[7] = a1.w;
            u1[0] = b0.x; u1[1] = b0.y; u1[2] = b0.z; u1[3] = b0.w; u1[4] = b1.x; u1[5] = b1.y; u1[6] = b1.z; u1[7] = b1.w;
            float* o0 = outs + ((size_t)(sb * 2 + 0)) * DM + c0; float* o1 = outs + ((size_t)(sb * 2 + 1)) * DM + c0;
            *(f32x4*)o0 = b0; *(f32x4*)(o0 + 4) = b1;
            *(f32x4*)o1 = (f32x4){u2[0], u2[1], u2[2], u2[3]}; *(f32x4*)(o1 + 4) = (f32x4){u2[4], u2[5], u2[6], u2[7]};
            float bg[8]; unpack8(*(const v4u*)(BCH + (size_t)r * NA_IN + c0), bg);
            float y[8];
#pragma unroll
            for (int i = 0; i < 8; ++i) y[i] = bg[i] * (w0[i] * u0[i] + w1[i] * u1[i] + w2[i] * u2[i]);
            *(v4u*)(Y + (size_t)r * DM + c0) = pack8(y);
        }
    }
}

constexpr float QSCALE = 0.08838834764831845f;
__device__ __forceinline__ void rope_phase(const bf16* PROJ, const Ptrs& P, int gw, int NGW, int lane) {
    unsigned char* ws = P.ws;
    const f32x2* t128 = (const f32x2*)(ws + WS_TAB128); const f32x2* t64 = (const f32x2*)(ws + WS_TAB64);
    bf16* Qr = (bf16*)(ws + WS_QR); bf16* QI = (bf16*)(ws + WS_QI); bf16* KIb = (bf16*)(ws + WS_KIB); float* WI = (float*)(ws + WS_WI);
    bf16* Ks = (bf16*)(ws + WS_KS); bf16* Vs = (bf16*)(ws + WS_VS);
    for (int pr_ = gw; pr_ < NBP * SPAD; pr_ += NGW) {
        const size_t o = ((size_t)((pr_ / SPAD) * SP + (pr_ % SPAD))) * 512 + 8 * lane; *(v4u*)(Ks + o) = (v4u){0u, 0u, 0u, 0u}; *(v4u*)(Vs + o) = (v4u){0u, 0u, 0u, 0u}; }
    for (int r = gw; r < NROWS; r += NGW) {
        const bf16* pr = PROJ + (size_t)r * NB_PAD;
        int pi; float *ko, *vo, *iko; bf16* kib = nullptr; bf16 *ksq = nullptr, *vsq = nullptr;
        if (r < SROW0) { int b, t; row_bt(r, b, t); pi = t; ksq = Ks + ((size_t)(b * SP + t + SPAD)) * 512; vsq = Vs + ((size_t)(b * SP + t + SPAD)) * 512; ko = P.out + O_KP + ((size_t)(b * TP + t)) * 512; vo = P.out + O_VP + ((size_t)(b * TP + t)) * 512; iko = P.out + O_IKP + ((size_t)(b * TP + t)) * 64; kib = KIb + ((size_t)(b * KIROWS + t)) * 64; }
        else { const int sb = r - SROW0; pi = POS_SAMPLE_IDX; ko = P.out + O_KS + (size_t)sb * 512; vo = P.out + O_VS + (size_t)sb * 512; iko = P.out + O_IKS + (size_t)sb * 64; }
        const f32x2* c128 = t128 + (size_t)pi * 64; const f32x2* c64 = t64 + (size_t)pi * 32;
        const int hd = lane >> 2, sub = lane & 3, hk = hd & 3;
        const v4u q1a = *(const v4u*)(pr + hd * 128 + 16 * sub), q1b = *(const v4u*)(pr + hd * 128 + 16 * sub + 8), q2a = *(const v4u*)(pr + hd * 128 + 64 + 16 * sub), q2b = *(const v4u*)(pr + hd * 128 + 64 + 16 * sub + 8);
        const v4u k1a = *(const v4u*)(pr + 2048 + hk * 128 + 16 * sub), k1b = *(const v4u*)(pr + 2048 + hk * 128 + 16 * sub + 8), k2a = *(const v4u*)(pr + 2048 + hk * 128 + 64 + 16 * sub), k2b = *(const v4u*)(pr + 2048 + hk * 128 + 64 + 16 * sub + 8);
        const v4u vv = *(const v4u*)(pr + 2560 + 8 * lane);
        const v4u i1 = *(const v4u*)(pr + 3072 + hd * 64 + 8 * sub), i2 = *(const v4u*)(pr + 3072 + hd * 64 + 32 + 8 * sub);
        const v4u j1 = *(const v4u*)(pr + 4096 + 8 * sub), j2 = *(const v4u*)(pr + 4096 + 32 + 8 * sub);
        const v4u wq = *(const v4u*)(pr + 4160 + 8 * (lane & 1));
        f32x4 csq[8], csi[4];
#pragma unroll
        for (int i = 0; i < 8; ++i) csq[i] = *(const f32x4*)(c128 + 16 * sub + 2 * i);
#pragma unroll
        for (int i = 0; i < 4; ++i) csi[i] = *(const f32x4*)(c64 + 8 * sub + 2 * i);
        {
            float x1[16], x2[16], o1[16], o2[16];
            { float t8[8]; unpack8(q1a, t8);
#pragma unroll
              for (int i = 0; i < 8; ++i) x1[i] = t8[i]; unpack8(q1b, t8);
#pragma unroll
              for (int i = 0; i < 8; ++i) x1[8 + i] = t8[i]; unpack8(q2a, t8);
#pragma unroll
              for (int i = 0; i < 8; ++i) x2[i] = t8[i]; unpack8(q2b, t8);
#pragma unroll
              for (int i = 0; i < 8; ++i) x2[8 + i] = t8[i]; }
#pragma unroll
            for (int i = 0; i < 16; i += 2) { const f32x4 cs = csq[i >> 1];
                o1[i] = (x1[i] * cs.x - x2[i] * cs.y) * QSCALE; o2[i] = (x2[i] * cs.x + x1[i] * cs.y) * QSCALE;
                o1[i + 1] = (x1[i + 1] * cs.z - x2[i + 1] * cs.w) * QSCALE; o2[i + 1] = (x2[i + 1] * cs.z + x1[i + 1] * cs.w) * QSCALE; }
            bf16* qo = Qr + (size_t)r * DM + hd * 128 + 16 * sub;
            { float t8[8];
#pragma unroll
              for (int i = 0; i < 8; ++i) t8[i] = o1[i]; *(v4u*)qo = pack8(t8);
#pragma unroll
              for (int i = 0; i < 8; ++i) t8[i] = o1[8 + i]; *(v4u*)(qo + 8) = pack8(t8);
#pragma unroll
              for (int i = 0; i < 8; ++i) t8[i] = o2[i]; *(v4u*)(qo + 64) = pack8(t8);
#pragma unroll
              for (int i = 0; i < 8; ++i) t8[i] = o2[8 + i]; *(v4u*)(qo + 72) = pack8(t8); }
        }
        if (lane < 16) {
#pragma unroll
            for (int hf = 0; hf < 2; ++hf) { float x1[8], x2[8], o1[8], o2[8]; unpack8(hf ? k1b : k1a, x1); unpack8(hf ? k2b : k2a, x2);
#pragma unroll
                for (int i = 0; i < 8; i += 2) { const f32x4 cs = csq[4 * hf + (i >> 1)];
                    o1[i] = x1[i] * cs.x - x2[i] * cs.y; o2[i] = x2[i] * cs.x + x1[i] * cs.y; o1[i + 1] = x1[i + 1] * cs.z - x2[i + 1] * cs.w; o2[i + 1] = x2[i + 1] * cs.z + x1[i + 1] * cs.w; }
                float* kq = ko + hk * 128 + 16 * sub + 8 * hf;
                *(f32x4*)kq = (f32x4){o1[0], o1[1], o1[2], o1[3]}; *(f32x4*)(kq + 4) = (f32x4){o1[4], o1[5], o1[6], o1[7]};
                *(f32x4*)(kq + 64) = (f32x4){o2[0], o2[1], o2[2], o2[3]}; *(f32x4*)(kq + 68) = (f32x4){o2[4], o2[5], o2[6], o2[7]};
                if (ksq) { *(v4u*)(ksq + hk * 128 + 16 * sub + 8 * hf) = pack8(o1); *(v4u*)(ksq + hk * 128 + 64 + 16 * sub + 8 * hf) = pack8(o2); } }
        }
        {
            float vf[8]; unpack8(vv, vf);
            *(f32x4*)(vo + 8 * lane) = (f32x4){vf[0], vf[1], vf[2], vf[3]}; *(f32x4*)(vo + 8 * lane + 4) = (f32x4){vf[4], vf[5], vf[6], vf[7]};
            if (vsq) *(v4u*)(vsq + 8 * lane) = vv;
        }
        {
            float x1[8], x2[8], o1[8], o2[8]; unpack8(i1, x1); unpack8(i2, x2);
#pragma unroll
            for (int i = 0; i < 8; i += 2) { const f32x4 cs = csi[i >> 1];
                o1[i] = x1[i] * cs.x - x2[i] * cs.y; o2[i] = x2[i] * cs.x + x1[i] * cs.y; o1[i + 1] = x1[i + 1] * cs.z - x2[i + 1] * cs.w; o2[i + 1] = x2[i + 1] * cs.z + x1[i + 1] * cs.w; }
            *(v4u*)(QI + (size_t)r * 1024 + hd * 64 + 8 * sub) = pack8(o1); *(v4u*)(QI + (size_t)r * 1024 + hd * 64 + 32 + 8 * sub) = pack8(o2);
        }
        if (lane < 4) {
            float x1[8], x2[8], o1[8], o2[8]; unpack8(j1, x1); unpack8(j2, x2);
#pragma unroll
            for (int i = 0; i < 8; i += 2) { const f32x4 cs = csi[i >> 1];
                o1[i] = x1[i] * cs.x - x2[i] * cs.y; o2[i] = x2[i] * cs.x + x1[i] * cs.y; o1[i + 1] = x1[i + 1] * cs.z - x2[i + 1] * cs.w; o2[i + 1] = x2[i + 1] * cs.z + x1[i + 1] * cs.w; }
            float* io = iko + 8 * sub;
            *(f32x4*)io = (f32x4){o1[0], o1[1], o1[2], o1[3]}; *(f32x4*)(io + 4) = (f32x4){o1[4], o1[5], o1[6], o1[7]};
            *(f32x4*)(io + 32) = (f32x4){o2[0], o2[1], o2[2], o2[3]}; *(f32x4*)(io + 36) = (f32x4){o2[4], o2[5], o2[6], o2[7]};
            if (kib) { *(v4u*)(kib + 8 * sub) = pack8(o1); *(v4u*)(kib + 32 + 8 * sub) = pack8(o2); }
        } else if (lane < 6) {
            float wv[8]; unpack8(wq, wv); float* wo = WI + (size_t)r * 16 + 8 * (lane - 4);
            *(f32x4*)wo = (f32x4){wv[0], wv[1], wv[2], wv[3]}; *(f32x4*)(wo + 4) = (f32x4){wv[4], wv[5], wv[6], wv[7]};
        }
    }
}

__device__ __forceinline__ void indexer_prompt(const Ptrs& P, LAS unsigned char* lds, int tid, int wave, int lane) {
    unsigned char* ws = P.ws;
    const bf16* QI = (const bf16*)(ws + WS_QI); const bf16* KIb = (const bf16*)(ws + WS_KIB); const float* WI = (const float*)(ws + WS_WI); float* SC = (float*)(ws + WS_SC);
    const int n = lane & 31, h8 = lane >> 5;
    const int qsel = (n >> 2) & 1, head = (n & 3) + 4 * (n >> 3);
    constexpr int NG = TP / 16;
    constexpr int KROW = 144, TBUF = 128 * KROW;
    LAS float* hscr = (LAS float*)(lds + 40960 + wave * 8448);
    int tit = blockIdx.x * 8 + wave;
    for (int it = blockIdx.x; it < 2 * NG; it += gridDim.x) {
        int b, qg;
        if (it < 256) { b = it & 1; qg = 1 + (it >> 1); } else if (it < 512) { b = it & 1; qg = 256 - ((it - 256) >> 1); } else { b = it - 512; qg = 0; }
        const int t0 = 16 * qg + 2 * wave;
        const bf16* qa = QI + (size_t)prow(b, t0 + qsel) * 1024 + head * 64 + 8 * h8;
        bf16x8 a[4];
#pragma unroll
        for (int kk = 0; kk < 4; ++kk) a[kk] = *(const bf16x8*)(qa + 16 * kk);
        const int tq = t0 + h8;
        const float* wp = WI + (size_t)prow(b, tq) * 16;
        float w[16];
#pragma unroll
        for (int i = 0; i < 4; ++i) { const f32x4 x = *(const f32x4*)(wp + 4 * i); w[4 * i] = x.x; w[4 * i + 1] = x.y; w[4 * i + 2] = x.z; w[4 * i + 3] = x.w; }
        const int ntile = ((16 * qg + 15) >> 5) + 1, ntrip = (ntile + 3) >> 2;
        float* scrow = SC + ((size_t)(b * TP + tq)) * SCW;
        const bf16* kbase = KIb + (size_t)b * KIROWS * 64;
        const int p0 = tid, p1 = tid + 512;
        const int l0 = (p0 >> 3) * KROW + (p0 & 7) * 16, l1 = (p1 >> 3) * KROW + (p1 & 7) * 16;
        asm volatile("s_waitcnt lgkmcnt(0)\n\ts_barrier" ::: "memory");
        v4u g0 = *(const v4u*)(kbase + (size_t)p0 * 8), g1 = *(const v4u*)(kbase + (size_t)p1 * 8);
        *(LAS v4u*)(lds + l0) = g0; *(LAS v4u*)(lds + l1) = g1;
        for (int tr = 0; tr < ntrip; ++tr) {
            const int cur = tr & 1;
            float hv[32]; TrJob HJ; hosted_issue(P, tit, lane, hv, HJ);
            if (tr + 1 < ntrip) { const size_t ko = (size_t)(tr + 1) * 128 * 64;
                const int kmax = KIROWS * 64 - 8;
                const size_t o0 = ko + (size_t)p0 * 8, o1 = ko + (size_t)p1 * 8;
                g0 = *(const v4u*)(kbase + (o0 <= (size_t)kmax ? o0 : (size_t)kmax)); g1 = *(const v4u*)(kbase + (o1 <= (size_t)kmax ? o1 : (size_t)kmax)); }
            asm volatile("s_waitcnt lgkmcnt(0)\n\ts_barrier" ::: "memory");
            const LAS unsigned char* kb = lds + cur * TBUF + n * KROW + h8 * 16;
#pragma unroll
            for (int u = 0; u < 4; ++u) {
                f32x16 acc;
#pragma unroll
                for (int i = 0; i < 16; ++i) acc[i] = 0.f;
#pragma unroll
                for (int kk = 0; kk < 4; ++kk) acc = __builtin_amdgcn_mfma_f32_32x32x16_bf16(a[kk], *(const LAS bf16x8*)(kb + u * 32 * KROW + kk * 32), acc, 0, 0, 0);
                float sc = 0.f;
#pragma unroll
                for (int i = 0; i < 16; ++i) sc += w[i] * fmaxf(acc[i], 0.f);
                const int s = 32 * (4 * tr + u) + n;
                if (s <= tq) scrow[s] = sc;
            }
            if (tr + 1 < ntrip) { *(LAS v4u*)(lds + (cur ^ 1) * TBUF + l0) = g0; *(LAS v4u*)(lds + (cur ^ 1) * TBUF + l1) = g1; }
            if (HJ.valid) { tr_finish(hv, HJ, hscr, lane); tit += gridDim.x * 8; }
        }
    }
    asm volatile("s_waitcnt lgkmcnt(0)\n\ts_barrier" ::: "memory");
    for (; tit < NHOSTED; tit += gridDim.x * 8) { float hv[32]; TrJob HJ; hosted_issue(P, tit, lane, hv, HJ); if (HJ.valid) tr_finish(hv, HJ, hscr, lane); }
}

__device__ __forceinline__ void indexer_sample(const Ptrs& P, LAS unsigned char* lds, int tid) {
    unsigned char* ws = P.ws;
    const bf16* QI = (const bf16*)(ws + WS_QI); const float* WI = (const float*)(ws + WS_WI); float* SCS = (float*)(ws + WS_SCS);
    LAS float* lq = (LAS float*)lds;
    LAS float* lw = lq + 1024;
    constexpr int NCH = (NSKEY + 511) / 512;
    for (int item = gridDim.x - 1 - blockIdx.x; item < SBN * NCH; item += gridDim.x) {
        const int sb = item / NCH, ch = item % NCH, r = SROW0 + sb;
        __syncthreads();
        for (int e = tid; e < 1024; e += NTHREADS) lq[e] = bf2f(QI[(size_t)r * 1024 + e]);
        if (tid < 16) lw[tid] = WI[(size_t)r * 16 + tid];
        __syncthreads();
        const int s = ch * 512 + tid;
        if (s < NSKEY) {
            const float* kr = (s < PAST) ? P.cache_ik + ((size_t)P.page_table[sb * NPG + (s >> 7)] * 128 + (s & 127)) * 64 : P.out + O_IKS + (size_t)sb * 64;
            f32x4 kv[16];
#pragma unroll
            for (int i = 0; i < 16; ++i) kv[i] = *(const f32x4*)(kr + 4 * i);
            float sc = 0.f;
            for (int h = 0; h < 16; ++h) { float d = 0.f;
#pragma unroll
                for (int i = 0; i < 16; ++i) { const f32x4 q = *(const LAS f32x4*)(lq + h * 64 + 4 * i); d += q.x * kv[i].x + q.y * kv[i].y + q.z * kv[i].z + q.w * kv[i].w; }
                sc += lw[h] * fmaxf(d, 0.f); }
            SCS[(size_t)sb * SCSW + s] = sc;
        }
    }
    __syncthreads();
}

__device__ __forceinline__ unsigned ordkey(float f) { const unsigned u = __float_as_uint(f); return (u & 0x80000000u) ? ~u : (u | 0x80000000u); }
constexpr int TOPK = 256;
__device__ __forceinline__ void topk_wave_mask(const float* sc, int n, unsigned long long* mrow, int lane) {
    constexpr int NS = MTW, M0 = SPAD / 64;
    static_assert(M0 == dattn::JLO, "first real key tile");
    unsigned key[NS];
#pragma unroll
    for (int m = M0; m < NS; ++m) { const int sidx = lane + 64 * m - SPAD; const int ci = sidx < 0 ? 0 : (sidx < n ? sidx : n - 1); const float v = sc[ci]; key[m] = (sidx >= 0 && sidx < n) ? ordkey(v) : 0u; }
    if (n <= TOPK) {
#pragma unroll
        for (int m = M0; m < NS; ++m) { const unsigned long long w = __ballot(key[m] != 0u); if (lane == 0) mrow[m] = w; }
        return;
    }
    unsigned T = 0u;
    for (int bit = 31; bit >= 0; --bit) {
        const unsigned cand = T | (1u << bit); int c = 0, cv = 0;
#pragma unroll
        for (int m = M0; m < NS; ++m) { if ((m & 1) != 0) c += __popcll(__ballot(key[m] >= cand)); else cv += (key[m] >= cand) ? 1 : 0; }
        c = __builtin_amdgcn_readfirstlane(c + wave_sum_dpp_i(cv));
        if (c >= TOPK) { T = cand; if (c == TOPK) break; }
    }
    int cg = 0;
#pragma unroll
    for (int m = M0; m < NS; ++m) cg += __popcll(__ballot(key[m] > T));
    const int need = TOPK - cg;
    int base_e = 0;
    const unsigned long long lt = (1ull << lane) - 1ull;
#pragma unroll
    for (int m = M0; m < NS; ++m) {
        const bool pg = key[m] > T, pe = key[m] == T;
        const unsigned long long me = __ballot(pe);
        const int pre_e = __popcll(me & lt);
        const unsigned long long w = __ballot(pg || (pe && (base_e + pre_e) < need));
        if (lane == 0) mrow[m] = w;
        base_e += __popcll(me);
    }
}
__device__ __forceinline__ void topk_block(const float* sc, int n, int* outIdx, int* outCnt, LAS unsigned* ls, int tid, int wave, int lane) {
    constexpr int NS = (NSKEY + NTHREADS - 1) / NTHREADS;
    unsigned key[NS];
#pragma unroll
    for (int m = 0; m < NS; ++m) { const int e = tid + NTHREADS * m; const float v = sc[e < n ? e : n - 1]; key[m] = (e < n) ? ordkey(v) : 0u; }
    unsigned T = 0u;
    for (int bit = 31; bit >= 0; --bit) {
        const unsigned cand = T | (1u << bit); int c = 0;
#pragma unroll
        for (int m = 0; m < NS; ++m) c += (key[m] >= cand) ? 1 : 0;
        c = wave_sum_dpp_i(c);
        LAS unsigned* buf = ls + (bit & 1) * 8;
        if (lane == 0) buf[wave] = (unsigned)c;
        __syncthreads();
        int tot = 0;
#pragma unroll
        for (int w = 0; w < 8; ++w) tot += (int)buf[w];
        if (tot >= TOPK) T = cand;
    }
    __syncthreads();
    if (tid == 0) { unsigned z_ = 0u; asm volatile("" : "+v"(z_)); ls[16] = z_; ls[17] = z_; }
    __syncthreads();
#pragma unroll
    for (int m = 0; m < NS; ++m) { const int e = tid + NTHREADS * m; if (key[m] > T) { const unsigned pos = atomicAdd((unsigned*)(ls + 16), 1u); if (pos < (unsigned)TOPK) outIdx[pos] = e; } }
    __syncthreads();
    const unsigned cg = ls[16];
    const unsigned need = (unsigned)TOPK - cg;
#pragma unroll
    for (int m = 0; m < NS; ++m) { const int e = tid + NTHREADS * m; if (key[m] == T) { const unsigned pos = atomicAdd((unsigned*)(ls + 17), 1u); if (pos < need) outIdx[cg + pos] = e; } }
    if (tid == 0) *outCnt = TOPK;
    __syncthreads();
}
__device__ __forceinline__ void select_phase(const Ptrs& P, LAS unsigned char* lds, int gw, int NGW, int tid, int wave, int lane) {
    unsigned char* ws = P.ws;
    const float* SC = (const float*)(ws + WS_SC); const float* SCS = (const float*)(ws + WS_SCS); int* IDXL = (int*)(ws + WS_IDXL); int* CNT = (int*)(ws + WS_CNT);
    for (int sb = blockIdx.x; sb < SBN; sb += gridDim.x) topk_block(SCS + (size_t)sb * SCSW, NSKEY, IDXL + (size_t)(SROW0 + sb) * TOPK, CNT + SROW0 + sb, (LAS unsigned*)lds, tid, wave, lane);
    unsigned long long* MASK = (unsigned long long*)(ws + WS_MASK);
    for (int r = gw; r < SROW0; r += NGW) { int b, t; row_bt(r, b, t);
        if (r < XROW0) topk_wave_mask(SC + ((size_t)(b * TP + t)) * SCW, t + 1, MASK + ((size_t)(b * SP + t + SPAD)) * MTW, lane);
        else { if (lane <= t) IDXL[(size_t)r * TOPK + lane] = lane; if (lane == 0) CNT[r] = t + 1; } }
}

__device__ __forceinline__ void attn_phase(const Ptrs& P, bf16* O, LAS unsigned char* lds, int tid, int wave, int lane) {
    unsigned char* ws = P.ws;
    const bf16* Qr = (const bf16*)(ws + WS_QR); const int* IDXL = (const int*)(ws + WS_IDXL); const int* CNT = (const int*)(ws + WS_CNT);
    LAS float* lq = (LAS float*)(lds + wave * 2048);
    LAS float* part = (LAS float*)(lds + 16384);
    LAS float* ml = (LAS float*)(lds + 32768);
    for (int item = blockIdx.x; item < (NROWS - XROW0) * 4; item += gridDim.x) {
        const int r = XROW0 + (item >> 2), n = item & 3;
        const int cnt = CNT[r];
        { float qf[8]; unpack8(*(const v4u*)(Qr + (size_t)r * DM + n * 512 + 8 * lane), qf);
          *(LAS f32x4*)(lq + 8 * lane) = (f32x4){qf[0], qf[1], qf[2], qf[3]}; *(LAS f32x4*)(lq + 8 * lane + 4) = (f32x4){qf[4], qf[5], qf[6], qf[7]}; }
        const int kl = lane & 31, hh = lane >> 5, e = wave * 32 + kl;
        const bool valid = e < cnt;
        const int s = valid ? IDXL[(size_t)r * TOPK + e] : 0;
        const float *kq, *vq;
        if (r < SROW0) { const int b = (r - XROW0) >> 4; kq = P.out + O_KP + ((size_t)(b * TP + s)) * 512; vq = P.out + O_VP + ((size_t)(b * TP + s)) * 512; }
        else { const int sb = r - SROW0;
            if (s < PAST) { const size_t off = ((size_t)P.page_table[sb * NPG + (s >> 7)] * 128 + (s & 127)) * 512; kq = P.cache_k + off; vq = P.cache_v + off; }
            else { kq = P.out + O_KS + (size_t)sb * 512; vq = P.out + O_VS + (size_t)sb * 512; } }
        kq += n * 128 + 64 * hh; vq += n * 128;
        f32x4 kv[16];
#pragma unroll
        for (int i = 0; i < 16; ++i) kv[i] = *(const f32x4*)(kq + 4 * i);
        WAVE_SYNC();
        float acc[4] = {0.f, 0.f, 0.f, 0.f};
#pragma unroll
        for (int i = 0; i < 16; ++i)
#pragma unroll
            for (int g = 0; g < 4; ++g) { const f32x4 qv = *(const LAS f32x4*)(lq + g * 128 + 64 * hh + 4 * i); acc[g] += qv.x * kv[i].x + qv.y * kv[i].y + qv.z * kv[i].z + qv.w * kv[i].w; }
        float pg[4], mw[4], lw[4];
#pragma unroll
        for (int g = 0; g < 4; ++g) { float a = acc[g] + __shfl_xor(acc[g], 32); a = valid ? a : -INFINITY;
            const float m = wave_max(a); const float pv = valid ? __expf(a - m) : 0.f;
            pg[g] = pv; mw[g] = m; lw[g] = wave_sum(hh == 0 ? pv : 0.f); }
        const unsigned long long va = (unsigned long long)vq; const int va_lo = (int)(unsigned)va, va_hi = (int)(unsigned)(va >> 32);
        f32x2 vv[32];
#pragma unroll
        for (int j = 0; j < 32; ++j) { const unsigned long long a = ((unsigned long long)(unsigned)__builtin_amdgcn_readlane(va_hi, j) << 32) | (unsigned)__builtin_amdgcn_readlane(va_lo, j);
            vv[j] = *(const f32x2*)((const float*)a + 2 * lane); }
        float o[4][2];
#pragma unroll
        for (int g = 0; g < 4; ++g) { o[g][0] = 0.f; o[g][1] = 0.f; }
#pragma unroll
        for (int j = 0; j < 32; ++j)
#pragma unroll
            for (int g = 0; g < 4; ++g) { const float pj = __int_as_float(__builtin_amdgcn_readlane(__float_as_int(pg[g]), j)); o[g][0] += pj * vv[j].x; o[g][1] += pj * vv[j].y; }
#pragma unroll
        for (int g = 0; g < 4; ++g) { *(LAS f32x2*)(part + (wave * 4 + g) * 128 + 2 * lane) = (f32x2){o[g][0], o[g][1]};
            if (lane == 0) { ml[(wave * 4 + g) * 2] = mw[g]; ml[(wave * 4 + g) * 2 + 1] = lw[g]; } }
        __syncthreads();
        { const int g = tid >> 7, d = tid & 127; float M = -INFINITY;
#pragma unroll
          for (int w = 0; w < 8; ++w) M = fmaxf(M, ml[(w * 4 + g) * 2]);
          float L = 0.f, a = 0.f;
#pragma unroll
          for (int w = 0; w < 8; ++w) { const float mv = ml[(w * 4 + g) * 2]; const float sc = (mv == -INFINITY) ? 0.f : __expf(mv - M); L += ml[(w * 4 + g) * 2 + 1] * sc; a += part[(w * 4 + g) * 128 + d] * sc; }
          O[(size_t)r * DM + (4 * n + g) * 128 + d] = f2bf(a / L); }
        __syncthreads();
    }
}

__device__ __forceinline__ void convC_finish(float (&acc)[8], int it) {
    float ss = 0.f;
#pragma unroll
    for (int i = 0; i < 8; ++i) { acc[i] = silu_f(acc[i]); ss += acc[i] * acc[i]; }
    if (it < 8) { ss = row16_sum(ss); float rn = 1.f / sqrtf(ss + RMS_EPS); if (it < 4) rn *= QSCALE;
#pragma unroll
        for (int i = 0; i < 8; ++i) acc[i] *= rn; }
}
__device__ __forceinline__ void convC_phase(const bf16* PROJC, const Ptrs& P, int gw, int NGW, int lane) {
    unsigned char* ws = P.ws;
    bf16* QKVC = (bf16*)(ws + WS_QKVC); float* QKF = (float*)(ws + WS_QKF); float* G = (float*)(ws + WS_G); float* BETA = (float*)(ws + WS_BETA);
    const float* cw = P.conv_w_c;
    constexpr int RUN = 8, NRUN = SEQ / RUN;
    for (int item = gw; item < 16 * NBP * NRUN; item += NGW) {
        const int it = item & 15, ru = item >> 4, b = ru / NRUN, t0 = NMETA + (ru % NRUN) * RUN, ch0 = it * 512 + 8 * lane;
        float w[4][8];
#pragma unroll
        for (int j = 0; j < 4; ++j) { const f32x4 w0 = *(const f32x4*)(cw + (size_t)j * CDIM + ch0), w1 = *(const f32x4*)(cw + (size_t)j * CDIM + ch0 + 4);
            w[j][0] = w0.x; w[j][1] = w0.y; w[j][2] = w0.z; w[j][3] = w0.w; w[j][4] = w1.x; w[j][5] = w1.y; w[j][6] = w1.z; w[j][7] = w1.w; }
        const int r0 = prow(b, t0);
        v4u xr[RUN + 3];
#pragma unroll
        for (int j = 0; j < 3; ++j) { const int tt = t0 - 3 + j; xr[j] = tt >= 0 ? *(const v4u*)(PROJC + (size_t)prow(b, tt) * NC_PAD + ch0) : (v4u){0u, 0u, 0u, 0u}; }
#pragma unroll
        for (int k = 0; k < RUN; ++k) xr[3 + k] = *(const v4u*)(PROJC + (size_t)(r0 + k) * NC_PAD + ch0);
        float x[RUN + 3][8];
#pragma unroll
        for (int j = 0; j < RUN + 3; ++j) unpack8(xr[j], x[j]);
#pragma unroll
        for (int k = 0; k < RUN; ++k) {
            float acc[8];
#pragma unroll
            for (int i = 0; i < 8; ++i) acc[i] = w[0][i] * x[k][i] + w[1][i] * x[k + 1][i] + w[2][i] * x[k + 2][i] + w[3][i] * x[k + 3][i];
            convC_finish(acc, it);
            *(v4u*)(QKVC + (size_t)(r0 + k) * CDIM + ch0) = pack8(acc);
            const int t = t0 + k;
            if (t >= TP - 3) { float* o = P.out + O_CCP + ((size_t)(b * 3 + (t - (TP - 3)))) * CDIM + ch0;
                *(f32x4*)o = (f32x4){x[k + 3][0], x[k + 3][1], x[k + 3][2], x[k + 3][3]}; *(f32x4*)(o + 4) = (f32x4){x[k + 3][4], x[k + 3][5], x[k + 3][6], x[k + 3][7]}; }
        }
    }
    for (int item = gw; item < 16 * NBP * NMETA; item += NGW) {
        const int it = item & 15, mi = item >> 4, t = mi % NMETA, r = XROW0 + mi, ch0 = it * 512 + 8 * lane;
        float x[4][8];
#pragma unroll
        for (int j = 0; j < 4; ++j) { const int tt = t - 3 + j; if (tt >= 0) unpack8(*(const v4u*)(PROJC + (size_t)(r - 3 + j) * NC_PAD + ch0), x[j]); else {
#pragma unroll
                for (int i = 0; i < 8; ++i) x[j][i] = 0.f; } }
        float acc[8];
#pragma unroll
        for (int i = 0; i < 8; ++i) acc[i] = 0.f;
#pragma unroll
        for (int j = 0; j < 4; ++j) { const f32x4 w0 = *(const f32x4*)(cw + (size_t)j * CDIM + ch0), w1 = *(const f32x4*)(cw + (size_t)j * CDIM + ch0 + 4);
            acc[0] += w0.x * x[j][0]; acc[1] += w0.y * x[j][1]; acc[2] += w0.z * x[j][2]; acc[3] += w0.w * x[j][3];
            acc[4] += w1.x * x[j][4]; acc[5] += w1.y * x[j][5]; acc[6] += w1.z * x[j][6]; acc[7] += w1.w * x[j][7]; }
        convC_finish(acc, it);
        *(v4u*)(QKVC + (size_t)r * CDIM + ch0) = pack8(acc);
    }
    for (int item = gw; item < 16 * SBN; item += NGW) {
        const int it = item & 15, sb = item >> 4, r = SROW0 + sb, ch0 = it * 512 + 8 * lane;
        float x[4][8];
#pragma unroll
        for (int j = 0; j < 3; ++j) { const float* hp = P.state_conv_c + ((size_t)(sb * 3 + j)) * CDIM + ch0; const f32x4 a = *(const f32x4*)hp, c = *(const f32x4*)(hp + 4);
            x[j][0] = a.x; x[j][1] = a.y; x[j][2] = a.z; x[j][3] = a.w; x[j][4] = c.x; x[j][5] = c.y; x[j][6] = c.z; x[j][7] = c.w; }
        unpack8(*(const v4u*)(PROJC + (size_t)r * NC_PAD + ch0), x[3]);
        float acc[8];
#pragma unroll
        for (int i = 0; i < 8; ++i) acc[i] = 0.f;
#pragma unroll
        for (int j = 0; j < 4; ++j) { const f32x4 w0 = *(const f32x4*)(cw + (size_t)j * CDIM + ch0), w1 = *(const f32x4*)(cw + (size_t)j * CDIM + ch0 + 4);
            acc[0] += w0.x * x[j][0]; acc[1] += w0.y * x[j][1]; acc[2] += w0.z * x[j][2]; acc[3] += w0.w * x[j][3];
            acc[4] += w1.x * x[j][4]; acc[5] += w1.y * x[j][5]; acc[6] += w1.z * x[j][6]; acc[7] += w1.w * x[j][7]; }
        convC_finish(acc, it);
        if (it < 8) { float* qk = QKF + (size_t)r * 4096 + ch0; *(f32x4*)qk = (f32x4){acc[0], acc[1], acc[2], acc[3]}; *(f32x4*)(qk + 4) = (f32x4){acc[4], acc[5], acc[6], acc[7]}; }
        *(v4u*)(QKVC + (size_t)r * CDIM + ch0) = pack8(acc);
        float* o = P.out + O_CCS + ((size_t)(sb * 3)) * CDIM + ch0;
#pragma unroll
        for (int j = 0; j < 3; ++j) { *(f32x4*)(o + (size_t)j * CDIM) = (f32x4){x[j + 1][0], x[j + 1][1], x[j + 1][2], x[j + 1][3]}; *(f32x4*)(o + (size_t)j * CDIM + 4) = (f32x4){x[j + 1][4], x[j + 1][5], x[j + 1][6], x[j + 1][7]}; }
    }
    for (int e = gw * 64 + lane; e < NROWS * 32; e += NGW * 64) {
        const int r = e >> 5, h = e & 31;
        const float braw = bf2f(PROJC[(size_t)r * NC_PAD + 12288 + h]), araw = bf2f(PROJC[(size_t)r * NC_PAD + 12320 + h]);
        const float xx = araw + P.dt_bias[h]; const float sp = xx > 20.f ? xx : __logf(1.f + __expf(xx));
        G[e] = -__expf(P.a_log[h]) * sp; BETA[e] = 1.f / (1.f + __expf(-braw));
    }
}

struct Tok { f32x4 k0, k1, q0, q1; unsigned v; float g, b; };
__device__ __forceinline__ void tok_load(Tok& T, const float* QKF, const bf16* QKVC, const float* G, const float* BETA, int row, int h, int rg, int col0) {
    const float* base = QKF + (size_t)row * 4096 + (h >> 1) * 128 + 8 * rg;
    T.q0 = *(const f32x4*)base; T.q1 = *(const f32x4*)(base + 4); T.k0 = *(const f32x4*)(base + 2048); T.k1 = *(const f32x4*)(base + 2052);
    T.v = *(const unsigned*)(QKVC + (size_t)row * CDIM + 4096 + h * 128 + col0);
    T.g = G[(size_t)row * 32 + h]; T.b = BETA[(size_t)row * 32 + h];
}
__device__ __forceinline__ f32x2 tok_step(f32x2 (&S)[8], const Tok& T) {
    const float kk[8] = {T.k0.x, T.k0.y, T.k0.z, T.k0.w, T.k1.x, T.k1.y, T.k1.z, T.k1.w};
    const float qq[8] = {T.q0.x, T.q0.y, T.q0.z, T.q0.w, T.q1.x, T.q1.y, T.q1.z, T.q1.w};
    const float a = __expf(T.g);
    f32x2 d0 = S[0] * kk[0], d1 = S[1] * kk[1];
#pragma unroll
    for (int i = 2; i < 8; i += 2) { d0 += S[i] * kk[i]; d1 += S[i + 1] * kk[i + 1]; }
    f32x2 d = d0 + d1;
    d.x = row16_sum(d.x); d.y = row16_sum(d.y);
    const f32x2 tv = {bflo(T.v), bfhi(T.v)};
    const f32x2 dl = (tv - d * a) * T.b;
    f32x2 o0 = {0.f, 0.f}, o1 = {0.f, 0.f};
#pragma unroll
    for (int i = 0; i < 8; i += 2) { S[i] = S[i] * a + dl * kk[i]; o0 += S[i] * qq[i]; S[i + 1] = S[i + 1] * a + dl * kk[i + 1]; o1 += S[i + 1] * qq[i + 1]; }
    f32x2 o = o0 + o1;
    o.x = row16_sum(o.x); o.y = row16_sum(o.y);
    return o;
}
__device__ __forceinline__ void delta_phase(const Ptrs& P, int idx, int stride, int lane) {
    unsigned char* ws = P.ws;
    const bf16* QKVC = (const bf16*)(ws + WS_QKVC); const float* QKF = (const float*)(ws + WS_QKF); const float* G = (const float*)(ws + WS_G); const float* BETA = (const float*)(ws + WS_BETA); bf16* OF = (bf16*)(ws + WS_SC);
    const int cg = lane >> 4, rg = lane & 15;
    {
        for (int item = idx; item < SBN * 32 * 16; item += stride) {
            const int sb = item >> 9, h = (item >> 4) & 31, col0 = 8 * (item & 15) + 2 * cg;
            const size_t so = ((size_t)((sb * 32 + h) * 128 + 8 * rg)) * 128 + col0;
            f32x2 S[8];
#pragma unroll
            for (int i = 0; i < 8; ++i) S[i] = *(const f32x2*)(P.state_delta + so + (size_t)i * 128);
            Tok T; tok_load(T, QKF, QKVC, G, BETA, SROW0 + sb, h, rg, col0);
            const f32x2 o = tok_step(S, T);
            if (rg == 0) *(unsigned*)(OF + (size_t)(SROW0 + sb) * DVW + h * 128 + col0) = pk2(o.x, o.y);
            float* op = P.out + O_DS + so;
#pragma unroll
            for (int i = 0; i < 8; ++i) *(f32x2*)(op + (size_t)i * 128) = S[i];
        }
    }
}
__device__ __forceinline__ void normC_piece(const v4u oq, const v4u zz, const float (&nw)[8], bf16* yo) {
    float o[8]; unpack8(oq, o);
    float ss = 0.f;
#pragma unroll
    for (int i = 0; i < 8; ++i) ss += o[i] * o[i];
    ss = row16_sum(ss);
    const float rs = 1.f / sqrtf(ss * (1.f / 128.f) + RMS_EPS);
    float z[8]; unpack8(zz, z);
#pragma unroll
    for (int i = 0; i < 8; ++i) o[i] = o[i] * rs * nw[i] * silu_f(z[i]);
    *(v4u*)yo = pack8(o);
}
__device__ __forceinline__ void normC_phase(const bf16* PROJC, bf16* Y, const Ptrs& P, int gw, int NGW, int lane) {
    const bf16* OF = (const bf16*)(P.ws + WS_SC);
    const int d0 = 8 * (lane & 15), hl = lane >> 4;
    float nw[8];
    { const f32x4 a = *(const f32x4*)(P.norm_w + d0), b = *(const f32x4*)(P.norm_w + d0 + 4); nw[0] = a.x; nw[1] = a.y; nw[2] = a.z; nw[3] = a.w; nw[4] = b.x; nw[5] = b.y; nw[6] = b.z; nw[7] = b.w; }
    for (int it = gw; it < (NROWS - XROW0) * 8; it += NGW) { const int r = XROW0 + (it >> 3), hd = (it & 7) * 4 + hl;
        const v4u oq = *(const v4u*)(OF + (size_t)r * DVW + hd * 128 + d0), zz = *(const v4u*)(PROJC + (size_t)r * NC_PAD + 8192 + hd * 128 + d0);
        normC_piece(oq, zz, nw, Y + (size_t)r * DVW + hd * 128 + d0); }
    for (int r = gw; r < XROW0; r += 2 * NGW) {
        const int r2 = (r + NGW < XROW0) ? r + NGW : r; const bool two = r + NGW < XROW0;
        v4u oa[8], za[8], ob[8], zb[8];
#pragma unroll
        for (int it = 0; it < 8; ++it) { const int hd = it * 4 + hl;
            oa[it] = *(const v4u*)(OF + (size_t)r * DVW + hd * 128 + d0); za[it] = *(const v4u*)(PROJC + (size_t)r * NC_PAD + 8192 + hd * 128 + d0);
            ob[it] = *(const v4u*)(OF + (size_t)r2 * DVW + hd * 128 + d0); zb[it] = *(const v4u*)(PROJC + (size_t)r2 * NC_PAD + 8192 + hd * 128 + d0); }
#pragma unroll
        for (int it = 0; it < 8; ++it) { const int hd = it * 4 + hl;
            normC_piece(oa[it], za[it], nw, Y + (size_t)r * DVW + hd * 128 + d0);
            if (two) normC_piece(ob[it], zb[it], nw, Y + (size_t)r2 * DVW + hd * 128 + d0); }
    }
}


template <int VAR = 0> __device__ __forceinline__ void dense_attn_phase(const Ptrs& P, bf16* O, char* lds, int wv) {
    unsigned char* ws = P.ws;
    const bf16* Qr = (const bf16*)(ws + WS_QR); const bf16* Ks = (const bf16*)(ws + WS_KS); const bf16* Vs = (const bf16*)(ws + WS_VS);
    const unsigned long long* MASK = (const unsigned long long*)(ws + WS_MASK);
    typedef dattn::BlockRef<bf16, bf16> BR;
    for (int it0 = blockIdx.x; it0 < 256; it0 += gridDim.x) {
        const int grp = it0 & 7, idx = it0 >> 3;
        const int b = grp >> 2, kvh = grp & 3, h = kvh * 4 + (idx >> 3), x = idx & 7;
        BR A, B;
        const int qa = 1 + x, qb = 16 - x;
        A.Q = Qr + ((size_t)(b * SEQ + 256 * (qa - 1))) * DM + h * 128; A.O = O + ((size_t)(b * SEQ + 256 * (qa - 1))) * DM + h * 128;
        B.Q = Qr + ((size_t)(b * SEQ + 256 * (qb - 1))) * DM + h * 128; B.O = O + ((size_t)(b * SEQ + 256 * (qb - 1))) * DM + h * 128;
        A.K = B.K = Ks + (size_t)b * SP * 512 + kvh * 128; A.V = B.V = Vs + (size_t)b * SP * 512 + kvh * 128;
        A.P0 = 256 * qa; B.P0 = 256 * qb;
        A.M = MASK + ((size_t)(b * SP + A.P0)) * MTW; B.M = MASK + ((size_t)(b * SP + B.P0)) * MTW;
        dattn::Seam<bf16> S;
        dattn::causal_swa_prime<bf16, bf16>(A, SP, lds, S, wv);
        dattn::causal_swa_block<bf16, bf16, VAR>(A, B, SP, SP, lds, S, wv);
        dattn::causal_swa_block<bf16, bf16, VAR>(B, B, SP, SP, lds, S, wv);
    }
}

constexpr int NCH = 65, CPAD = 48;
constexpr int NUQ = NBP * 16 * NCH, NUH = NBP * 32 * NCH;
__device__ __forceinline__ int crow32(int r, int hi) { return (r & 3) + 8 * (r >> 2) + 4 * hi; }
__device__ __forceinline__ int chunk_row(int b, int c, int i) { const int t = 64 * c + i - CPAD; return t >= 0 ? prow(b, t) : -1; }
__device__ __forceinline__ float incl_scan64(float v, int lane) {
#pragma unroll
    for (int o = 1; o < 64; o <<= 1) { const float u = __shfl_up(v, o); if (lane >= o) v += u; }
    return v;
}
#define MFMA32(a, b, c) __builtin_amdgcn_mfma_f32_32x32x16_bf16((a), (b), (c), 0, 0, 0)
__device__ __forceinline__ bf16x8 sel8(bool ok, bf16x8 v) { const bf16x8 z = {0, 0, 0, 0, 0, 0, 0, 0}; return ok ? v : z; }
__device__ __forceinline__ int sw23(int x) { return (x & ~12) | ((x & 4) << 1) | ((x & 8) >> 1); }
__device__ __forceinline__ int fidx64(int row, int xs) { return ((((row >> 5) * 2 + (xs >> 5)) * 2 + ((xs >> 4) & 1)) * 64 + (row & 31) + 32 * ((xs >> 3) & 1)) * 8 + (xs & 7); }

__device__ __forceinline__ v4u pack_frag(const f32x16& x, int s) { v4u w; w.x = pk2(x[8 * s], x[8 * s + 1]); w.y = pk2(x[8 * s + 2], x[8 * s + 3]); w.z = pk2(x[8 * s + 4], x[8 * s + 5]); w.w = pk2(x[8 * s + 6], x[8 * s + 7]); return w; }
__device__ __forceinline__ void stage_out8k(LAS unsigned char* stg, bf16* gdst, int lane) {
    WAVE_SYNC();
#pragma unroll
    for (int k = 0; k < 8; ++k) *(v4u*)(gdst + k * 512 + lane * 8) = *(const LAS v4u*)(stg + k * 1024 + lane * 16);
    WAVE_SYNC();
}
__device__ __forceinline__ void delta_d1_unit(unsigned char* ws, LAS unsigned char* lds, int uq, int wave, int lane) {
    asm volatile("" : "+v"(lane));
    const bf16* QKVC = (const bf16*)(ws + WS_QKVC); const float* G = (const float*)(ws + WS_G); const float* BETA = (const float*)(ws + WS_BETA);
    float* AF = (float*)(ws + WS_DAF); bf16* PG = (bf16*)(ws + WS_DPG); bf16* KT = (bf16*)(ws + WS_DKT); bf16* VT = (bf16*)(ws + WS_DVT);
    float* GC = (float*)(ws + WS_DGC); float* BT = (float*)(ws + WS_DBT);
    LAS float* lg = (LAS float*)(lds + wave * 16384);
    LAS unsigned char* stg = lds + wave * 16384 + 2048; LAS bf16* st = (LAS bf16*)stg;
    const int m = lane & 31, half = lane >> 5;
    const bf16x8 zf = {0, 0, 0, 0, 0, 0, 0, 0};
    {
        const int c = uq % NCH, bh = uq / NCH, hq = bh & 15, b = bh >> 4;
        { const int row = chunk_row(b, c, lane);
#pragma unroll
          for (int hh = 0; hh < 2; ++hh) { const int h = 2 * hq + hh; const float g = row >= 0 ? G[(size_t)row * 32 + h] : 0.f, bt = row >= 0 ? BETA[(size_t)row * 32 + h] : 0.f;
              const float gc = incl_scan64(g, lane); lg[hh * 64 + lane] = gc; lg[128 + hh * 64 + lane] = bt;
              const size_t uh = ((size_t)(b * 32 + h)) * NCH + c; GC[uh * 64 + lane] = gc; BT[uh * 64 + lane] = bt; } }
        const int row0 = chunk_row(b, c, m), row1 = chunk_row(b, c, 32 + m);
        const bf16* r0 = QKVC + (size_t)(row0 < 0 ? 0 : row0) * CDIM; const bf16* r1 = QKVC + (size_t)(row1 < 0 ? 0 : row1) * CDIM;
        f32x16 kk00, kk10, kk11, qk00, qk10, qk11;
#pragma unroll
        for (int i = 0; i < 16; ++i) { kk00[i] = 0.f; kk10[i] = 0.f; kk11[i] = 0.f; qk00[i] = 0.f; qk10[i] = 0.f; qk11[i] = 0.f; }
        const int sm = sw23(m);
        const int ktl = half * 32 + ((sm >> 4) & 1) * 512 + ((sm >> 3) & 1) * 256 + (sm & 7);
#pragma unroll 1
        for (int kh = 0; kh < 2; ++kh) {
            bf16x8 kf0[4], kf1[4], qf0[4], qf1[4];
#pragma unroll
            for (int u = 0; u < 4; ++u) { const int off = hq * 128 + 16 * (4 * kh + u) + 8 * half;
                kf0[u] = sel8(row0 >= 0, *(const bf16x8*)(r0 + 2048 + off)); kf1[u] = sel8(row1 >= 0, *(const bf16x8*)(r1 + 2048 + off));
                qf0[u] = sel8(row0 >= 0, *(const bf16x8*)(r0 + off)); qf1[u] = sel8(row1 >= 0, *(const bf16x8*)(r1 + off)); }
#pragma unroll
            for (int u = 0; u < 4; ++u) { const int ks = 4 * kh + u; const bf16x8 k0 = kf0[u], k1 = kf1[u], q0 = qf0[u], q1 = qf1[u];
                kk00 = MFMA32(k0, k0, kk00); kk10 = MFMA32(k1, k0, kk10); kk11 = MFMA32(k1, k1, kk11);
                qk00 = MFMA32(q0, k0, qk00); qk10 = MFMA32(q1, k0, qk10); qk11 = MFMA32(q1, k1, qk11);
                LAS bf16* kb = st + ktl + ((ks >> 1) & 1) * 2048 + (ks & 1) * 128;
#pragma unroll
                for (int e = 0; e < 8; ++e) { kb[(8 * (e >> 2) + (e & 3)) * 8] = (bf16)k0[e]; kb[1024 + (8 * (e >> 2) + (e & 3)) * 8] = (bf16)k1[e]; } }
            stage_out8k(stg, KT + (size_t)uq * 8192 + kh * 4096, lane);
        }
#pragma unroll 1
        for (int hh = 0; hh < 2; ++hh) { const int h = 2 * hq + hh; bf16* vt = VT + (((size_t)(b * 32 + h)) * NCH + c) * 8192;
            const int vtl = half * 64 + ((sm >> 4) & 1) * 512 + ((sm >> 3) & 1) * 256 + (sm & 7);
            bf16x8 vf0[8], vf1[8];
#pragma unroll
            for (int ks = 0; ks < 8; ++ks) { const int off = 4096 + h * 128 + 16 * ks + 8 * half; vf0[ks] = sel8(row0 >= 0, *(const bf16x8*)(r0 + off)); vf1[ks] = sel8(row1 >= 0, *(const bf16x8*)(r1 + off)); }
#pragma unroll
            for (int kh = 0; kh < 2; ++kh) {
#pragma unroll
                for (int u = 0; u < 4; ++u) { const int ks = 4 * kh + u; LAS bf16* vb = st + vtl + ((ks >> 1) & 1) * 2048 + (ks & 1) * 128;
#pragma unroll
                    for (int e = 0; e < 8; ++e) { vb[e * 8] = (bf16)vf0[ks][e]; vb[1024 + e * 8] = (bf16)vf1[ks][e]; } }
                stage_out8k(stg, vt + kh * 4096, lane);
            } }
        WAVE_SYNC();
#pragma unroll 1
        for (int hh = 0; hh < 2; ++hh) { const int h = 2 * hq + hh; const size_t uh = ((size_t)(b * 32 + h)) * NCH + c;
            float* af = AF + uh * 4096 + half * 256 + m;
            LAS bf16* pg = st + ktl;
            const float gcj0 = lg[hh * 64 + m], gcj1 = lg[hh * 64 + 32 + m];
#pragma unroll
            for (int r = 0; r < 16; ++r) { const int ir = crow32(r, half), rc = (r & 3) + 8 * (r >> 2);
                const float gi0 = lg[hh * 64 + ir], gi1 = lg[hh * 64 + 32 + ir], bi0 = lg[128 + hh * 64 + ir], bi1 = lg[128 + hh * 64 + 32 + ir];
                { const int i = ir, j = m; const float dec = __expf(fminf(gi0 - gcj0, 0.f)); af[rc * 64] = (j < i) ? bi0 * dec * kk00[r] : 0.f; pg[rc * 8] = f2bf((j <= i) ? dec * qk00[r] : 0.f); }
                { const int i = 32 + ir, j = m; const float dec = __expf(fminf(gi1 - gcj0, 0.f)); af[2048 + rc * 64] = bi1 * dec * kk10[r]; pg[2048 + rc * 8] = f2bf(dec * qk10[r]); }
                { const int i = 32 + ir, j = 32 + m; const float dec = __expf(fminf(gi1 - gcj1, 0.f)); af[2048 + 32 + rc * 64] = (j < i) ? bi1 * dec * kk11[r] : 0.f; pg[2048 + 1024 + rc * 8] = f2bf((j <= i) ? dec * qk11[r] : 0.f); }
            }
            stage_out8k(stg, PG + uh * 4096, lane); }
        WAVE_SYNC();
    }
}
__device__ __forceinline__ void delta_d2_unit(unsigned char* ws, LAS unsigned char* lds, int uh, int wave, int lane) {
    asm volatile("" : "+v"(lane));
    const float* AF = (const float*)(ws + WS_DAF); const float* GC = (const float*)(ws + WS_DGC); const float* BT = (const float*)(ws + WS_DBT);
    bf16* TG = (bf16*)(ws + WS_DTG); bf16* TB = (bf16*)(ws + WS_DTB);
    {
        const float* af = AF + (size_t)uh * 4096;
        const float bc = BT[(size_t)uh * 64 + lane], gmc = __expf(GC[(size_t)uh * 64 + lane]);
        float T[64];
        const bool pad0 = (uh % NCH) == 0;
#pragma unroll
        for (int i0 = 0; i0 < 64; i0 += 16) {
            float ar[16];
#pragma unroll
            for (int u = 0; u < 16; ++u) ar[u] = af[(i0 + u) * 64 + lane];
            if (pad0 && i0 < 32) {
#pragma unroll
                for (int u = 0; u < 16; ++u) T[i0 + u] = (lane == i0 + u) ? 1.f : 0.f;
            } else {
#pragma unroll
                for (int u = 0; u < 16; ++u) { const int i = i0 + u; float pa[4] = {(lane == i) ? 1.f : 0.f, 0.f, 0.f, 0.f};
#pragma unroll
                    for (int j = 0; j < i; ++j) pa[j & 3] -= __int_as_float(__builtin_amdgcn_readlane(__float_as_int(ar[u]), j)) * T[j];
                    T[i] = (pa[0] + pa[1]) + (pa[2] + pa[3]); }
            }
        }
        bf16* tg = TG + (size_t)uh * 4096; bf16* tb = TB + (size_t)uh * 4096;
        const float sg = bc * gmc;
        const int cs = (lane & ~31) + sw23(lane & 31);
        const int lcol = (cs >> 4) * 512 + ((cs >> 3) & 1) * 256 + (cs & 7);
        LAS unsigned char* stg = lds + wave * 16384 + 2048; LAS bf16* st = (LAS bf16*)stg;
#pragma unroll
        for (int i = 0; i < 64; ++i) st[(i >> 5) * 2048 + (i & 31) * 8 + lcol] = f2bf(T[i] * sg);
        stage_out8k(stg, tg, lane);
#pragma unroll
        for (int i = 0; i < 64; ++i) st[(i >> 5) * 2048 + (i & 31) * 8 + lcol] = f2bf(T[i] * bc);
        stage_out8k(stg, tb, lane);
    }
}
__device__ __forceinline__ void delta_d3_unit(unsigned char* ws, int uh, int lane) {
    asm volatile("" : "+v"(lane));
    const bf16* TG = (const bf16*)(ws + WS_DTG); const bf16* TB = (const bf16*)(ws + WS_DTB); const bf16* KT = (const bf16*)(ws + WS_DKT); const bf16* VT = (const bf16*)(ws + WS_DVT);
    bf16* WG = (bf16*)(ws + WS_DWG); bf16* UG = (bf16*)(ws + WS_DUG);
    const int m = lane & 31, half = lane >> 5;
    const int c = uh % NCH, bh = uh / NCH, h = bh & 31, b = bh >> 5;
    const size_t uq = ((size_t)(b * 16 + (h >> 1))) * NCH + c;
    {
        const bf16* Tm = TG + (size_t)uh * 4096; const bf16* Kf = KT + uq * 8192;
        f32x16 acc[4][2];
#pragma unroll
        for (int dn = 0; dn < 4; ++dn)
#pragma unroll
            for (int ti = 0; ti < 2; ++ti)
#pragma unroll
                for (int i = 0; i < 16; ++i) acc[dn][ti][i] = 0.f;
#pragma unroll
        for (int ks = 0; ks < 4; ++ks) {
            bf16x8 a[4], bb[2];
#pragma unroll
            for (int dn = 0; dn < 4; ++dn) a[dn] = *(const bf16x8*)(Kf + ((size_t)(((dn * 2 + (ks >> 1)) * 2 + (ks & 1)) * 64 + lane)) * 8);
#pragma unroll
            for (int ti = 0; ti < 2; ++ti) bb[ti] = *(const bf16x8*)(Tm + ((size_t)((ti * 4 + ks) * 64 + lane)) * 8);
#pragma unroll
            for (int dn = 0; dn < 4; ++dn)
#pragma unroll
                for (int ti = 0; ti < 2; ++ti) acc[dn][ti] = MFMA32(a[dn], bb[ti], acc[dn][ti]);
        }
        bf16* wg = WG + (size_t)uh * 8192;
#pragma unroll
        for (int dn = 0; dn < 4; ++dn)
#pragma unroll
            for (int ti = 0; ti < 2; ++ti)
#pragma unroll
                for (int s2 = 0; s2 < 2; ++s2) *(v4u*)(wg + ((size_t)(((ti * 4 + dn) * 2 + s2) * 64 + lane)) * 8) = pack_frag(acc[dn][ti], s2);
    }
    {
        const bf16* Tm = TB + (size_t)uh * 4096; const bf16* Bt = VT + (size_t)uh * 8192;
        f32x16 acc[2][4];
#pragma unroll
        for (int ti = 0; ti < 2; ++ti)
#pragma unroll
            for (int dn = 0; dn < 4; ++dn)
#pragma unroll
                for (int i = 0; i < 16; ++i) acc[ti][dn][i] = 0.f;
#pragma unroll
        for (int ks = 0; ks < 4; ++ks) {
            bf16x8 a[2], bb[4];
#pragma unroll
            for (int ti = 0; ti < 2; ++ti) a[ti] = *(const bf16x8*)(Tm + ((size_t)((ti * 4 + ks) * 64 + lane)) * 8);
#pragma unroll
            for (int dn = 0; dn < 4; ++dn) bb[dn] = *(const bf16x8*)(Bt + ((size_t)((dn * 4 + ks) * 64 + lane)) * 8);
#pragma unroll
            for (int ti = 0; ti < 2; ++ti)
#pragma unroll
                for (int dn = 0; dn < 4; ++dn) acc[ti][dn] = MFMA32(a[ti], bb[dn], acc[ti][dn]);
        }
        bf16* ug = UG + (size_t)uh * 8192;
#pragma unroll
        for (int ti = 0; ti < 2; ++ti)
#pragma unroll
            for (int dn = 0; dn < 4; ++dn) { bf16* p = ug + ((size_t)((ti * 4 + dn) * 64 + lane)) * 16; *(v4u*)p = pack_frag(acc[ti][dn], 0); *(v4u*)(p + 8) = pack_frag(acc[ti][dn], 1); }
    }
}
__device__ __forceinline__ void delta_pre(unsigned char* ws, LAS unsigned char* lds, int gw, int NGW, int wave, int lane) {
    const int nextra = (NUQ > NGW && NUQ < 2 * NGW) ? NUQ - NGW : 0;
    for (int rep = 0; rep < 2 || nextra == 0; ++rep) {
        int uq;
        if (nextra == 0) { uq = gw + rep * NGW; if (uq >= NUQ) break; }
        else if (rep == 0) uq = gw;
        else { if ((gw & 63) != 0 || (gw >> 6) >= nextra) break; uq = NGW + (gw >> 6); }
#ifndef NO_D1
        delta_d1_unit(ws, lds, uq, wave, lane);
#endif
#ifdef DUP_D1
        delta_d1_unit(ws, lds, uq, wave, lane);
#endif
        asm volatile("s_waitcnt vmcnt(0)" ::: "memory");
        const int c = uq % NCH, bh = uq / NCH, hq = bh & 15, b = bh >> 4;
#pragma unroll 1
        for (int hh = 0; hh < 2; ++hh) { const int uh = (b * 32 + 2 * hq + hh) * NCH + c;
#ifndef NO_D2
            delta_d2_unit(ws, lds, uh, wave, lane);
#endif
#ifdef DUP_D2
            delta_d2_unit(ws, lds, uh, wave, lane);
#endif
            asm volatile("s_waitcnt vmcnt(0)" ::: "memory");
#ifndef NO_D3
            delta_d3_unit(ws, uh, lane);
#endif
#ifdef DUP_D3
            delta_d3_unit(ws, uh, lane);
#endif
        }
    }
}
__device__ __forceinline__ bf16x8 afrag_perm(const bf16* rowp, int blk, int s, int half) {
    const v2u lo = *(const v2u*)(rowp + 32 * blk + 16 * s + 4 * half), hi2 = *(const v2u*)(rowp + 32 * blk + 16 * s + 8 + 4 * half);
    v4u w; w.x = lo.x; w.y = lo.y; w.z = hi2.x; w.w = hi2.y; return __builtin_bit_cast(bf16x8, w);
}
#define LBAR() asm volatile("s_waitcnt lgkmcnt(0)\n\ts_barrier" ::: "memory")
__device__ __forceinline__ void delta_d4(unsigned char* ws, float* out_state, LAS unsigned char* lds, int tid, int wave, int lane) {
    const bf16* QKVC = (const bf16*)(ws + WS_QKVC); const bf16* KT = (const bf16*)(ws + WS_DKT); const bf16* PG = (const bf16*)(ws + WS_DPG);
    const bf16* WG = (const bf16*)(ws + WS_DWG); const bf16* UG = (const bf16*)(ws + WS_DUG); const float* GC = (const float*)(ws + WS_DGC);
    bf16* OF = (bf16*)(ws + WS_SC);
    LAS v4u* Sfr = (LAS v4u*)lds;
    LAS v4u* Dfr = (LAS v4u*)(lds + 16384);
    LAS v4u* Dtf = (LAS v4u*)(lds + 16384 + 4096);
    LAS float* gam = (LAS float*)(lds + 16384 + 8192);
    const int m = lane & 31, half = lane >> 5;
    const bf16x8 zf = {0, 0, 0, 0, 0, 0, 0, 0};
    for (int item = blockIdx.x; item < NBP * 32 * 4; item += gridDim.x) {
        const int xg = item & 7, jj = item >> 3, pair = xg * 4 + (jj >> 3), q = jj & 3, h = 2 * (pair & 15) + ((jj >> 2) & 1), b = pair >> 4;
        const size_t uh0 = ((size_t)(b * 32 + h)) * NCH, uq0 = ((size_t)(b * 16 + (h >> 1))) * NCH;
        const int rt = wave & 1; const bool isq = wave >= 6;
#define ROT3(LOADM, STEPM) do { LOADM(0, 0); LOADM(1, 1); \
            for (int c = 0; c < NCH; c += 3) { \
                if (c + 2 < NCH) LOADM(c + 2, 2); \
                STEPM(c, 0); \
                if (c + 1 < NCH) { if (c + 3 < NCH) LOADM(c + 3, 0); STEPM(c + 1, 1); } \
                if (c + 2 < NCH) { if (c + 4 < NCH) LOADM(c + 4, 1); STEPM(c + 2, 2); } } } while (0)
#define ROT2(LOADM, STEPM) do { LOADM(0, 0); \
            for (int c = 0; c < NCH; c += 2) { \
                if (c + 1 < NCH) LOADM(c + 1, 1); \
                STEPM(c, 0); \
                if (c + 1 < NCH) { if (c + 2 < NCH) LOADM(c + 2, 0); STEPM(c + 1, 1); } } } while (0)
        LBAR();
        if (wave < 4) {
            int ll_ = lane; asm volatile("" : "+v"(ll_)); const int lane = ll_, m = lane & 31, half = lane >> 5; (void)m; (void)half;
            { const v4u z = {0u, 0u, 0u, 0u}; Sfr[(0 * 4 + wave) * 128 + lane] = z; Sfr[(0 * 4 + wave) * 128 + 64 + lane] = z; }
            bf16x8 kf[2][4];
            f32x16 S;
#pragma unroll
            for (int i = 0; i < 16; ++i) S[i] = 0.f;
#define LOAD_K(cc, B) do { const bf16* kr_ = KT + (uq0 + (cc)) * 8192; \
                _Pragma("unroll") for (int blk = 0; blk < 2; ++blk) _Pragma("unroll") for (int s_ = 0; s_ < 2; ++s_) kf[B][blk * 2 + s_] = *(const bf16x8*)(kr_ + ((size_t)(((wave * 2 + blk) * 2 + s_) * 64 + lane)) * 8); } while (0)
#define STEP_K(c, B) do { const int bufc = (c) & 1; LBAR(); LBAR(); \
                const float gl = gam[bufc * 64 + 63]; \
                _Pragma("unroll") for (int i = 0; i < 16; ++i) S[i] *= gl; \
                _Pragma("unroll") for (int blk = 0; blk < 2; ++blk) _Pragma("unroll") for (int s = 0; s < 2; ++s) S = MFMA32(kf[B][blk * 2 + s], __builtin_bit_cast(bf16x8, Dtf[(blk * 2 + s) * 64 + lane]), S); \
                _Pragma("unroll") for (int s = 0; s < 2; ++s) Sfr[((bufc ^ 1) * 4 + wave) * 128 + s * 64 + lane] = pack_frag(S, s); } while (0)
#ifndef NO_RK
            ROT2(LOAD_K, STEP_K);
#endif
            { float* o = out_state + ((size_t)((b * 32 + h) * 128 + 32 * wave)) * 128 + 32 * q + m;
#pragma unroll
              for (int r = 0; r < 16; ++r) o[(size_t)sw23(crow32(r, half)) * 128] = S[r]; }
#undef LOAD_K
#undef STEP_K
        } else if (!isq) {
            int ll_ = lane; asm volatile("" : "+v"(ll_)); const int lane = ll_, m = lane & 31, half = lane >> 5; (void)m; (void)half;
            bf16x8 wf[3][8], uf[3][2]; float gcv[3] = {0.f, 0.f, 0.f};
#define LOAD_W(cc, B) do { const bf16* wb_ = WG + (uh0 + (cc)) * 8192 + ((size_t)(rt * 512 + lane)) * 8; \
                _Pragma("unroll") for (int blk = 0; blk < 4; ++blk) _Pragma("unroll") for (int s_ = 0; s_ < 2; ++s_) wf[B][blk * 2 + s_] = *(const bf16x8*)(wb_ + blk * 1024 + s_ * 512); \
                const bf16* ub_ = UG + (uh0 + (cc)) * 8192 + ((size_t)((rt * 4 + q) * 64 + lane)) * 16; uf[B][0] = *(const bf16x8*)ub_; uf[B][1] = *(const bf16x8*)(ub_ + 8); \
                if (wave == 4) gcv[B] = GC[(uh0 + (cc)) * 64 + lane]; } while (0)
#define STEP_W(c, B) do { const int bufc = (c) & 1; LBAR(); \
                f32x16 acc; \
                _Pragma("unroll") for (int i = 0; i < 16; ++i) acc[i] = 0.f; \
                _Pragma("unroll") for (int blk = 0; blk < 4; ++blk) _Pragma("unroll") for (int s = 0; s < 2; ++s) \
                    acc = MFMA32(wf[B][blk * 2 + s], __builtin_bit_cast(bf16x8, Sfr[(bufc * 4 + blk) * 128 + s * 64 + lane]), acc); \
                { float t8[8]; unpack8(__builtin_bit_cast(v4u, uf[B][0]), t8); \
                    _Pragma("unroll") for (int i = 0; i < 8; ++i) acc[i] = t8[i] - acc[i]; unpack8(__builtin_bit_cast(v4u, uf[B][1]), t8); \
                    _Pragma("unroll") for (int i = 0; i < 8; ++i) acc[8 + i] = t8[i] - acc[8 + i]; } \
                _Pragma("unroll") for (int s = 0; s < 2; ++s) Dfr[(rt * 2 + s) * 64 + lane] = pack_frag(acc, s); \
                _Pragma("unroll") for (int r = 0; r < 16; ++r) acc[r] *= gam[128 + bufc * 64 + 32 * rt + crow32(r, half)]; \
                _Pragma("unroll") for (int s = 0; s < 2; ++s) Dtf[(rt * 2 + s) * 64 + lane] = pack_frag(acc, s); \
                LBAR(); \
                if (wave == 4 && (c) + 1 < NCH) { const float gn_ = gcv[((B) + 1) % 3], gl_ = __shfl(gn_, 63); gam[(bufc ^ 1) * 64 + lane] = __expf(gn_); gam[128 + (bufc ^ 1) * 64 + lane] = __expf(gl_ - gn_); } } while (0)
            if (wave == 4) { const float gc = GC[(uh0 + 0) * 64 + lane], gl = __shfl(gc, 63); gam[lane] = __expf(gc); gam[128 + lane] = __expf(gl - gc); }
#ifndef NO_RW
            ROT3(LOAD_W, STEP_W);
#endif
#undef LOAD_W
#undef STEP_W
        } else {
            int ll_ = lane; asm volatile("" : "+v"(ll_)); const int lane = ll_, m = lane & 31, half = lane >> 5; (void)m; (void)half;
            bf16x8 qf[1][8], pf[1][4];
#define LOAD_Q(cc, B) do { const int row_ = chunk_row(b, (cc), 32 * rt + m); const bool ok_ = row_ >= 0; \
                const bf16* qb_ = QKVC + (size_t)(row_ < 0 ? 0 : row_) * CDIM + (h >> 1) * 128 + 8 * half; \
                _Pragma("unroll") for (int blk = 0; blk < 4; ++blk) _Pragma("unroll") for (int s_ = 0; s_ < 2; ++s_) qf[B][blk * 2 + s_] = sel8(ok_, *(const bf16x8*)(qb_ + blk * 32 + s_ * 16)); \
                } while (0)
#define LOAD_P(cc, PB) do { const bf16* pb_ = PG + (uh0 + (cc)) * 4096 + ((size_t)(rt * 256 + lane)) * 8; \
                _Pragma("unroll") for (int blk = 0; blk < 2; ++blk) _Pragma("unroll") for (int s_ = 0; s_ < 2; ++s_) pf[PB][blk * 2 + s_] = sel8(blk <= rt, *(const bf16x8*)(pb_ + blk * 1024 + s_ * 512)); } while (0)
#define STEP_Q(c) do { const int bufc = (c) & 1; LBAR(); \
                LOAD_P((c), 0);                                                    \
                f32x16 acc; \
                _Pragma("unroll") for (int i = 0; i < 16; ++i) acc[i] = 0.f; \
                _Pragma("unroll") for (int blk = 0; blk < 4; ++blk) _Pragma("unroll") for (int s = 0; s < 2; ++s) \
                    acc = MFMA32(qf[0][blk * 2 + s], __builtin_bit_cast(bf16x8, Sfr[(bufc * 4 + blk) * 128 + s * 64 + lane]), acc); \
                if ((c) + 1 < NCH) LOAD_Q((c) + 1, 0);                             \
                LBAR(); \
                _Pragma("unroll") for (int r = 0; r < 16; ++r) acc[r] *= gam[bufc * 64 + 32 * rt + crow32(r, half)]; \
                _Pragma("unroll") for (int blk = 0; blk < 2; ++blk) _Pragma("unroll") for (int s = 0; s < 2; ++s) acc = MFMA32(pf[0][blk * 2 + s], __builtin_bit_cast(bf16x8, Dfr[(blk * 2 + s) * 64 + lane]), acc); \
                _Pragma("unroll") for (int r = 0; r < 16; ++r) { const int row = chunk_row(b, (c), 32 * rt + crow32(r, half)); if (row >= 0) OF[(size_t)row * DVW + h * 128 + 32 * q + m] = f2bf(acc[r]); } } while (0)
#ifndef NO_RQ
            LOAD_Q(0, 0);
            for (int c = 0; c < NCH; ++c) STEP_Q(c);
#endif
#undef LOAD_Q
#undef LOAD_P
#undef STEP_Q
        }
#undef ROT2
#undef ROT3
    }
    LBAR();
}
#undef LBAR
#undef MFMA32
template <int RT, int CT, int UNR = 4, class Epi>
__device__ __forceinline__ void small_gemm_unit(const bf16* A, int lda, const bf16* Bt, int ldb, int k0, int klen, LAS unsigned char* lds, const Epi& E, int tid, int wave, int lane) {
    const int r16 = lane & 15, q = lane >> 4;
    const int kw = klen >> 3;
    const bf16* ap = A + (size_t)r16 * lda + k0 + wave * kw + 8 * q;
    const bf16* bp = Bt + (size_t)r16 * ldb + k0 + wave * kw + 8 * q;
    pg8::f32x4 acc[RT][CT];
#pragma unroll
    for (int i = 0; i < RT; ++i)
#pragma unroll
        for (int j = 0; j < CT; ++j) acc[i][j] = (pg8::f32x4){0.f, 0.f, 0.f, 0.f};
#pragma unroll UNR
    for (int ks = 0; ks < kw; ks += 32) {
        bf16x8 a[RT], b[CT];
#pragma unroll
        for (int i = 0; i < RT; ++i) a[i] = *(const bf16x8*)(ap + (size_t)(16 * i) * lda + ks);
#pragma unroll
        for (int j = 0; j < CT; ++j) b[j] = *(const bf16x8*)(bp + (size_t)(16 * j) * ldb + ks);
#pragma unroll
        for (int i = 0; i < RT; ++i)
#pragma unroll
            for (int j = 0; j < CT; ++j) acc[i][j] = __builtin_amdgcn_mfma_f32_16x16x32_bf16(a[i], b[j], acc[i][j], 0, 0, 0);
    }
    constexpr int NOUT = 256 * RT * CT;
    LAS float* part = (LAS float*)lds + wave * NOUT;
#pragma unroll
    for (int i = 0; i < RT; ++i)
#pragma unroll
        for (int j = 0; j < CT; ++j)
#pragma unroll
            for (int e = 0; e < 4; ++e) part[(16 * i + 4 * q + e) * (16 * CT) + 16 * j + r16] = acc[i][j][e];
    __syncthreads();
    for (int o = tid; o < NOUT; o += NTHREADS) { float sum = 0.f;
#pragma unroll
        for (int w = 0; w < 8; ++w) sum += ((LAS float*)lds)[w * NOUT + o];
        E(o / (16 * CT), o % (16 * CT), sum); }
    __syncthreads();
}
template <int ACT> struct SEpiRowsBf16 { bf16* O; int ldc; __device__ __forceinline__ void operator()(int row, int col, float v) const { if (ACT == 2) { v = v > 0.f ? v : 0.f; v = v * v; } O[(size_t)row * ldc + col] = f2bf(v); } };
struct SEpiF32 { float* O; int ldc; __device__ __forceinline__ void operator()(int row, int col, float v) const { O[(size_t)row * ldc + col] = v; } };
struct SEpiColsBf16 { bf16* O; int ldc; __device__ __forceinline__ void operator()(int row, int col, float v) const { O[(size_t)col * ldc + row] = f2bf(v); } };
template <int ACT> __device__ __forceinline__ void skinny_rows_bf16(const bf16* A, const bf16* Wt, int K, int nunits, bf16* O, int ldc, LAS unsigned char* lds, int tid, int wave, int lane) {
    for (int u = blockIdx.x; u < 2 * nunits; u += gridDim.x) { SEpiRowsBf16<ACT> E{O + (size_t)XROW0 * ldc + u * 32, ldc};
        small_gemm_unit<3, 2, 8>(A + (size_t)XROW0 * K, K, Wt + (size_t)u * 32 * K, K, 0, K, lds, E, tid, wave, lane); }
}
__device__ __forceinline__ void skinny_rows_part(const bf16* A, const bf16* Wt, int K, float* ZP, LAS unsigned char* lds, int tid, int wave, int lane) {
    for (int u = blockIdx.x; u < 256; u += gridDim.x) { const int cgp = u & 31, ksl = u >> 5; SEpiF32 E{ZP + (size_t)ksl * XR * DM + cgp * 64, DM};
        small_gemm_unit<3, 4>(A + (size_t)XROW0 * K, K, Wt + (size_t)cgp * 64 * K, K, ksl * (K >> 3), K >> 3, lds, E, tid, wave, lane); }
}
template <int RT> __device__ __forceinline__ void tail_cols_bf16(const bf16* A, const bf16* Wt, int K, int c0, bf16* O, int ldc, LAS unsigned char* lds, int tid, int wave, int lane) {
    for (int u = blockIdx.x; u < MAINM / 32; u += gridDim.x) { SEpiColsBf16 E{O + (size_t)u * 32 * ldc + c0, ldc};
        small_gemm_unit<RT, 2>(Wt + (size_t)c0 * K, K, A + (size_t)u * 32 * K, K, 0, K, lds, E, tid, wave, lane); }
}

typedef __attribute__((address_space(4))) const unsigned long long* kargq_t;
#define KPF_(k) ((const float*)(const GAS float*)(q_[k]))
__device__ __forceinline__ void load_ptrs(Ptrs& P) {
    kargq_t q_ = (kargq_t)__builtin_amdgcn_kernarg_segment_ptr();
    asm volatile("" : "+s"(q_));
    P.x_prompt = KPF_(0); P.x_sample = KPF_(1); P.state_conv_a = KPF_(2); P.cache_k = KPF_(3);
    P.cache_v = KPF_(4); P.cache_ik = KPF_(5); P.state_conv_c = KPF_(6); P.state_delta = KPF_(7);
    P.page_table = ((const int*)(const GAS int*)(q_[8])); P.meta = KPF_(9); P.w_in_a = KPF_(10); P.conv_w_a = KPF_(11);
    P.w_out_a = KPF_(12); P.w_in_b = KPF_(13); P.w_out_b = KPF_(14); P.w_in_c = KPF_(15);
    P.conv_w_c = KPF_(16); P.a_log = KPF_(17); P.dt_bias = KPF_(18); P.norm_w = KPF_(19);
    P.w_out_c = KPF_(20); P.ln1_g = KPF_(21); P.ln1_b = KPF_(22); P.w1 = KPF_(23);
    P.w2 = KPF_(24); P.ln2_g = KPF_(25); P.ln2_b = KPF_(26);
    P.out = (float*)(GAS float*)(q_[27]); P.ws = (unsigned char*)(GAS unsigned char*)(q_[28]);
}
struct Args { const void* in[27]; float* out; unsigned char* ws; int ph_lo, ph_hi; };
constexpr int PH_PER_LAYER = 12, PH_END = 1 + 4 * PH_PER_LAYER;

__global__ void __launch_bounds__(NTHREADS, 2) mega_fwd(Args args) {
    extern __shared__ __attribute__((aligned(16))) unsigned char lds_raw[];
    LAS unsigned char* lds = (LAS unsigned char*)lds_raw;
    const int tid = threadIdx.x, lane = tid & 63, wave = __builtin_amdgcn_readfirstlane(tid >> 6);
    const int G_ = gridDim.x, NGW = G_ * NWAVES, NT = G_ * NTHREADS; (void)lane;
    unsigned char* ws = args.ws;
    const int lo = args.ph_lo, hi = args.ph_hi;
    const bool fused = (hi - lo) > 1;

    for (int u = tid; u < (LDS_BYTES - LDSCTL_OFF) / 4; u += NTHREADS) ((LAS unsigned*)(lds + LDSCTL_OFF))[u] = 0u;
    __syncthreads();
    volatile LAS unsigned* MISC = (volatile LAS unsigned*)(lds + MISC_OFF);
    XcdBarrier bar; bar.bar = (unsigned*)(ws + WS_CTL) + CW_BAR; bar.x = 0; bar.st = nullptr;
    if (fused) bar = xcd_barrier_post((unsigned*)(ws + WS_CTL) + CW_BAR, MISC + 8);
    bar.wv = wave;

#ifndef MK_SITES
#define MK_SITES 0xffffffffu
#endif
#define SITE(n) (((MK_SITES) >> (n)) & 1u)
#define IN(k) (lo <= (k) && (k) < hi)
#ifndef MK_DUP
#define MK_DUP 0u
#endif
#define NREP(n) ((((MK_DUP) >> (n)) & 1u) ? 2 : 1)
#ifdef MK_SKINNY2
#define SKREP 2
#else
#define SKREP 1
#endif
#define BEGIN_SITE(n, id) if (SITE(n) && IN(id)) { for (int rp_ = 0; rp_ < NREP(n); ++rp_) { Ptrs P; load_ptrs(P); unsigned char* ws = P.ws; (void)ws; \
    bf16* X = (bf16*)(P.ws + WS_X); float* Z = (float*)(P.ws + WS_Z); float* ZP = (float*)(P.ws + WS_ZP); bf16* Y = (bf16*)(P.ws + WS_Y); bf16* BIG = (bf16*)(P.ws + WS_BIG); (void)X; (void)Z; (void)ZP; (void)Y; (void)BIG;
#define END_SITE(id) SEAM(id); } }
#define LOCALS int tid_ = threadIdx.x; asm volatile("" : "+v"(tid_)); const int lane_ = tid_ & 63, wave_ = __builtin_amdgcn_readfirstlane(tid_ >> 6), gw_ = blockIdx.x * NWAVES + wave_, gtid_ = blockIdx.x * NTHREADS + tid_; (void)lane_; (void)wave_; (void)gw_; (void)gtid_
#define SEAM(k) do { if (fused && (k) + 1 < PH_END) xcd_barrier(bar); else __syncthreads(); } while (0)


    BEGIN_SITE(0, 0) LOCALS; p0_prologue(P, lds, gw_, NGW, wave_, lane_); END_SITE(0)
#ifdef MK_XBAR
    if (fused) { for (int xb_ = 0; xb_ < MK_XBAR; ++xb_) xcd_barrier(bar); }
#endif

    for (int layer = 0; layer < 4; ++layer) {
        const int kind = layer % 3, j = layer / 3, base = 1 + layer * PH_PER_LAYER;
        if (kind == 0) {
            BEGIN_SITE(1, base + 0)
                const bf16* Wt = (const bf16*)(ws + WS_WA_IN + (size_t)j * WSZ_A_IN); pg8::Gemm g{X, Wt, MAINM, NA_IN, DM}; pg8::StaticOrder S; S.init(MAINM, NA_IN, G_, (int)blockIdx.x);
                pg8::EpiBf16<0> E{BIG, NA_IN, nullptr, 0, 0, 1.f};
                pg8::gemm_phase<pg8::EpiBf16<0>, pg8::StaticOrder, true, true>(lds, g, S, E, wave);
                { LOCALS; for (int sk_ = 0; sk_ < SKREP; ++sk_) { skinny_rows_bf16<0>(X, Wt, DM, NA_IN / 64, BIG, NA_IN, lds, tid_, wave_, lane_); } }
                END_SITE(base + 0)
            BEGIN_SITE(2, base + 1)
                LOCALS; convA_phase(BIG, Y, P.conv_w_a + (size_t)j * 3 * DM, P.state_conv_a + (size_t)j * SBN * 2 * DM, P.out + O_CAP + (size_t)j * NBP * 2 * DM, P.out + O_CAS + (size_t)j * SBN * 2 * DM, gtid_, NT);
                END_SITE(base + 1)
            BEGIN_SITE(3, base + 2)
                const bf16* Wt = (const bf16*)(ws + WS_WA_OUT + (size_t)j * WSZ_A_OUT); pg8::Gemm g{Y, Wt, MAINM, DM, DM}; pg8::StaticOrder S; S.init(MAINM, DM, G_, (int)blockIdx.x);
                pg8::EpiResBf16 E{X, DM, ALPHA};
                pg8::gemm_phase<pg8::EpiResBf16, pg8::StaticOrder, true, true>(lds, g, S, E, wave);
                { LOCALS; for (int sk_ = 0; sk_ < SKREP; ++sk_) { skinny_rows_part(Y, Wt, DM, ZP, lds, tid_, wave_, lane_); } }
                END_SITE(base + 2)
        } else if (kind == 1) {
            BEGIN_SITE(4, base + 0)
                const bf16* Wt = (const bf16*)(ws + WS_WB_IN); pg8::Gemm g{X, Wt, MAINM, 4096, DM}; pg8::StaticOrder S; S.init(MAINM, 4096, G_, (int)blockIdx.x);
                pg8::EpiBf16<0> E{BIG, NB_PAD, nullptr, 0, 0, 1.f};
                pg8::gemm_phase<pg8::EpiBf16<0>, pg8::StaticOrder, true, true>(lds, g, S, E, wave);
                { LOCALS; for (int sk_ = 0; sk_ < SKREP; ++sk_) { tail_cols_bf16<5>(X, Wt, DM, 4096, BIG, NB_PAD, lds, tid_, wave_, lane_); skinny_rows_bf16<0>(X, Wt, DM, 4224 / 64, BIG, NB_PAD, lds, tid_, wave_, lane_); } }
                END_SITE(base + 0)
            BEGIN_SITE(5, base + 1) LOCALS; rope_phase(BIG, P, gw_, NGW, lane_); END_SITE(base + 1)
            BEGIN_SITE(6, base + 2) LOCALS; indexer_sample(P, lds, tid_); indexer_prompt(P, lds, tid_, wave_, lane_); END_SITE(base + 2)
            BEGIN_SITE(7, base + 3) LOCALS; select_phase(P, lds, gw_, NGW, tid_, wave_, lane_); END_SITE(base + 3)
#ifdef ATTN_PROBE
            if (IN(base + 4)) { Ptrs P; load_ptrs(P); bf16* Y = (bf16*)(P.ws + WS_Y); LOCALS; dense_attn_phase<ATTN_PROBE>(P, Y, (char*)lds_raw, wave_); __syncthreads(); }
#endif
            BEGIN_SITE(8, base + 4) LOCALS; dense_attn_phase(P, Y, (char*)lds_raw, wave_); attn_phase(P, Y, lds, tid_, wave_, lane_); END_SITE(base + 4)
            BEGIN_SITE(9, base + 5)
                const bf16* Wt = (const bf16*)(ws + WS_WB_OUT); pg8::Gemm g{Y, Wt, MAINM, DM, DM}; pg8::StaticOrder S; S.init(MAINM, DM, G_, (int)blockIdx.x);
                pg8::EpiResBf16 E{X, DM, ALPHA};
                pg8::gemm_phase<pg8::EpiResBf16, pg8::StaticOrder, true, true>(lds, g, S, E, wave);
                { LOCALS; for (int sk_ = 0; sk_ < SKREP; ++sk_) { skinny_rows_part(Y, Wt, DM, ZP, lds, tid_, wave_, lane_); } }
                END_SITE(base + 5)
        } else {
            BEGIN_SITE(10, base + 0)
                const bf16* Wt = (const bf16*)(ws + WS_WC_IN); pg8::Gemm g{X, Wt, MAINM, 12288, DM}; pg8::StaticOrder S; S.init(MAINM, 12288, G_, (int)blockIdx.x);
                pg8::EpiBf16<0> E{BIG, NC_PAD, nullptr, 0, 0, 1.f};
                pg8::gemm_phase<pg8::EpiBf16<0>, pg8::StaticOrder, true, true>(lds, g, S, E, wave);
                { LOCALS; for (int sk_ = 0; sk_ < SKREP; ++sk_) { tail_cols_bf16<4>(X, Wt, DM, 12288, BIG, NC_PAD, lds, tid_, wave_, lane_); skinny_rows_bf16<0>(X, Wt, DM, NC_IN / 64, BIG, NC_PAD, lds, tid_, wave_, lane_); } }
                END_SITE(base + 0)
            BEGIN_SITE(11, base + 1) LOCALS; convC_phase(BIG, P, gw_, NGW, lane_); END_SITE(base + 1)
            BEGIN_SITE(19, base + 2) LOCALS; delta_pre(P.ws, lds, gw_, NGW, wave_, lane_);
                { const int nbusy = (NUQ > NGW && NUQ < 2 * NGW) ? NUQ - NGW : 0;
                  const bool busy = nbusy > 0 && (gw_ & 63) == 0 && (gw_ >> 6) < nbusy; const int below = nbusy == 0 ? 0 : (((gw_ + 63) >> 6) < nbusy ? ((gw_ + 63) >> 6) : nbusy);
                  if (!busy) { delta_phase(P, gw_ - below, NGW - nbusy, lane_); deferred_transposes(P, lds, gw_ - below, NGW - nbusy, wave_, lane_); } }
            END_SITE(base + 2)
            BEGIN_SITE(22, base + 5) LOCALS; delta_d4(P.ws, P.out + O_DP, lds, tid_, wave_, lane_); END_SITE(base + 5)
            BEGIN_SITE(13, base + 6) LOCALS; normC_phase(BIG, Y, P, gw_, NGW, lane_); END_SITE(base + 6)
            BEGIN_SITE(14, base + 7)
                const bf16* Wt = (const bf16*)(ws + WS_WC_OUT); pg8::Gemm g{Y, Wt, MAINM, DM, DVW}; pg8::StaticOrder S; S.init(MAINM, DM, G_, (int)blockIdx.x);
                pg8::EpiResBf16 E{X, DM, ALPHA};
                pg8::gemm_phase<pg8::EpiResBf16, pg8::StaticOrder, true, true>(lds, g, S, E, wave);
                { LOCALS; for (int sk_ = 0; sk_ < SKREP; ++sk_) { skinny_rows_part(Y, Wt, DVW, ZP, lds, tid_, wave_, lane_); } }
                END_SITE(base + 7)
        }
        BEGIN_SITE(15, base + 8) LOCALS; ln_phase(Z, ZP, X, rp_ == 0 ? X : (bf16*)(P.ws + WS_QR), P.ln1_g + (size_t)layer * DM, P.ln1_b + (size_t)layer * DM, nullptr, nullptr, lds, gw_, NGW, tid_, wave_, lane_); END_SITE(base + 8)
        BEGIN_SITE(16, base + 9)
            const bf16* Wt = (const bf16*)(ws + WS_W1 + (size_t)layer * WSZ_W1); pg8::Gemm g{X, Wt, MAINM, FF, DM}; pg8::StaticOrder S; S.init(MAINM, FF, G_, (int)blockIdx.x);
            pg8::EpiBf16<2> E{BIG, FF, nullptr, 0, 0, 1.f};
            pg8::gemm_phase<pg8::EpiBf16<2>, pg8::StaticOrder, true, true>(lds, g, S, E, wave);
            { LOCALS; for (int sk_ = 0; sk_ < SKREP; ++sk_) { skinny_rows_bf16<2>(X, Wt, DM, FF / 64, BIG, FF, lds, tid_, wave_, lane_); } }
            END_SITE(base + 9)
        BEGIN_SITE(17, base + 10)
            const bf16* Wt = (const bf16*)(ws + WS_W2 + (size_t)layer * WSZ_W2); pg8::Gemm g{BIG, Wt, MAINM, DM, FF}; pg8::StaticOrder S; S.init(MAINM, DM, G_, (int)blockIdx.x);
            pg8::EpiResBf16 E{X, DM, ALPHA};
            pg8::gemm_phase<pg8::EpiResBf16, pg8::StaticOrder, true, true>(lds, g, S, E, wave);
            { LOCALS; for (int sk_ = 0; sk_ < SKREP; ++sk_) { skinny_rows_part(BIG, Wt, FF, ZP, lds, tid_, wave_, lane_); } }
            END_SITE(base + 10)
        BEGIN_SITE(18, base + 11)
            const bool last = layer == 3;
            LOCALS; ln_phase(Z, ZP, X, rp_ == 0 ? X : (bf16*)(P.ws + WS_QR), P.ln2_g + (size_t)layer * DM, P.ln2_b + (size_t)layer * DM, last ? P.out + O_YP : nullptr, last ? P.out + O_YS : nullptr, lds, gw_, NGW, tid_, wave_, lane_);
            if (!last) SEAM(base + 11); } }
    }
#undef IN
#undef SEAM
}

#ifndef MK_SPLIT
#define MK_SPLIT 0
#endif
extern "C" void kernel_launch(void* const* d_in, const int* in_sizes, int n_in, void* d_out, int out_size, void* d_ws, size_t ws_size, hipStream_t stream) {
    static int grid = 0;
    if (grid == 0) {
        if (n_in != 27 || (size_t)out_size != O_END || ws_size < WS_END) { fprintf(stderr, "kernel_launch: unexpected shapes: n_in %d out %d (want %zu) ws %zu (want >= %zu)\n", n_in, out_size, (size_t)O_END, ws_size, (size_t)WS_END); grid = -1; return; }
        int dev = 0, cus = 0;
        if (hipGetDevice(&dev) != hipSuccess || hipDeviceGetAttribute(&cus, hipDeviceAttributeMultiprocessorCount, dev) != hipSuccess) { grid = -1; return; }
        if (hipFuncSetAttribute((const void*)mega_fwd, hipFuncAttributeMaxDynamicSharedMemorySize, LDS_BYTES) != hipSuccess) { fprintf(stderr, "kernel_launch: hipFuncSetAttribute failed\n"); grid = -1; return; }
        int per_cu = 0;
        if (hipOccupancyMaxActiveBlocksPerMultiprocessor(&per_cu, (const void*)mega_fwd, NTHREADS, LDS_BYTES) != hipSuccess || per_cu < 1) fprintf(stderr, "kernel_launch: occupancy query reports %d\n", per_cu);
        (void)hipGetLastError();
        grid = cus;
    }
    if (grid < 0) return;
    (void)hipMemsetAsync((char*)d_ws + WS_CTL, 0, CTL_ZERO_BYTES, stream);
    Args a{};
    for (int i = 0; i < 27; ++i) a.in[i] = d_in[i];
    a.out = (float*)d_out; a.ws = (unsigned char*)d_ws;
#if MK_SPLIT
    for (int ph = 0; ph < PH_END; ++ph) {
        bool exists = (ph == 0);
        if (ph > 0) { const int layer = (ph - 1) / PH_PER_LAYER, l = (ph - 1) % PH_PER_LAYER, kind = layer % 3; const int nmix = kind == 0 ? 3 : (kind == 1 ? 6 : 8); exists = (l < nmix) || (l >= 8 && l <= 11); }
        if (!exists) continue;
        a.ph_lo = ph; a.ph_hi = ph + 1;
        hipLaunchKernelGGL(mega_fwd, dim3(grid), dim3(NTHREADS), LDS_BYTES, stream, a);
    }
#else
    a.ph_lo = 0; a.ph_hi = PH_END;
    hipLaunchKernelGGL(mega_fwd, dim3(grid), dim3(NTHREADS), LDS_BYTES, stream, a);
#endif
    const hipError_t le = hipPeekAtLastError();
    if (le != hipSuccess) fprintf(stderr, "kernel_launch: launch failed: %s\n", hipGetErrorName(le));
}
```

```cpp
#include <hip/hip_runtime.h>
#include <cstdio>
#include <cstdint>
#include <cmath>
__device__ __forceinline__ int flane() { return (int)__builtin_amdgcn_mbcnt_hi(~0u, __builtin_amdgcn_mbcnt_lo(~0u, 0u)); }
namespace pg8 {
#define PG8_LAS __attribute__((address_space(3)))
typedef unsigned short bf16_t;
typedef short bf16x8 __attribute__((ext_vector_type(8)));
typedef float f32x4 __attribute__((ext_vector_type(4)));
typedef unsigned u32x4 __attribute__((ext_vector_type(4)));
constexpr int BM = 256, BK = 64, HALF = 128, HTB = HALF * BK * 2  , STAGE_BYTES = 8 * HTB, NXCD = 8, WGM = 8;

__host__ __device__ __forceinline__ int lds_byte(int r, int c) { const int st = (r >> 4) * 2 + (c >> 5), rr = r & 15, cc = c & 31, ob = rr * 64 + cc * 2; return st * 1024 + (ob ^ (((ob >> 9) & 1) << 5)); }
__host__ __device__ __forceinline__ void stage_rc(int b, int& R, int& C) { const int st = b / 1024, sb = b % 1024, swz = sb ^ (((sb >> 9) & 1) << 5); R = (st >> 1) * 16 + swz / 64; C = (st & 1) * 32 + (swz % 64) / 2; }
__host__ __device__ __forceinline__ int perm32(int rho) { const int n = rho >> 4, i = rho & 15; return 8 * (i >> 2) + 4 * n + (i & 3); }

struct Unit { int pm, pn; };
struct Gemm { const bf16_t* A; const bf16_t* Bt; int M, N, K; };

struct StaticOrder {
    int nM, nN, nwg, G, c;
    __host__ __device__ void init(int M, int N, int G_, int c_) { nM = M / BM; nN = N / BM; nwg = nM * nN; G = G_; c = c_; }
    __host__ __device__ bool next(int i, Unit& u) const {
        const long L = (long)i * G + c; if (L >= nwg) return false;
        int wgid = (int)L; { const int q = nwg / NXCD, r = nwg % NXCD, xcd = wgid % NXCD, off = wgid / NXCD; wgid = (xcd < r ? xcd * (q + 1) : r * (q + 1) + (xcd - r) * q) + off; }
        const int nig = WGM * nN, gid = wgid / nig, fm = gid * WGM, gsz = (nM - fm) < WGM ? (nM - fm) : WGM;
        u.pm = fm + ((wgid % nig) % gsz); u.pn = (wgid % nig) / gsz; return true;
    }
    __device__ __forceinline__ void a_ready(const Unit&) const {}
    __device__ __forceinline__ void done(const Unit&) const {}
};

__device__ __forceinline__ unsigned cvt_pk_bf16(float lo, float hi) { unsigned r; asm volatile("v_cvt_pk_bf16_f32 %0, %1, %2" : "=v"(r) : "v"(lo), "v"(hi)); return r; }
typedef float f32x2 __attribute__((ext_vector_type(2)));
__device__ __forceinline__ f32x2 gelu_pk(f32x2 v) {
    const f32x2 av = __builtin_elementwise_abs(v), d = av * 0.2316418882f + 1.0f;
    f32x2 t; t.x = __builtin_amdgcn_rcpf(d.x); t.y = __builtin_amdgcn_rcpf(d.y);
    f32x2 q = t * 0.5307027145f + (-0.7265760135f); q = q * t + 0.7107068705f; q = q * t + (-0.142248368f); q = q * t + 0.127414796f; q = q * t;
    const f32x2 s = (v * v) * (-0.72134752044f);
    f32x2 e; e.x = __builtin_amdgcn_exp2f(s.x); e.y = __builtin_amdgcn_exp2f(s.y);
    const f32x2 m = v * (q * e), r = v - m;
    f32x2 o; o.x = v.x < 0.f ? m.x : r.x; o.y = v.y < 0.f ? m.y : r.y; return o;
}

template <int ACT  > struct EpiBf16 {
    static constexpr bool PERM = true, AFTER_DRAIN = false; static_assert(ACT == 0 || ACT == 1 || ACT == 2, "EpiBf16: ACT is 0 (none), 1 (gelu_pk) or 2 (relu^2)");
    bf16_t* O; int ldc; const float* bias; int split_cols; size_t split_stride; float scale0;
    __device__ __forceinline__ void operator()(const f32x4 (&acc)[2][2][4][2], const Unit& u, int wr, int wc, int fr, int fq) const {
        const int row0 = u.pm * BM + wr * 64 + fr; int colt = u.pn * BM; bf16_t* base = O;
        float sc = 1.f; if (split_cols) { const int t = colt / split_cols; base += (size_t)t * split_stride; colt -= t * split_cols; if (t == 0) sc = scale0; }
        const int col0 = colt + wc * 32 + 8 * fq, bcol0 = u.pn * BM + wc * 32 + 8 * fq;
        f32x4 bv[2][2];
#pragma unroll
        for (int bj = 0; bj < 2; ++bj)
#pragma unroll
            for (int n = 0; n < 2; ++n) bv[bj][n] = bias ? *(const f32x4*)(bias + bcol0 + bj * HALF + 4 * n) : (f32x4){0.f, 0.f, 0.f, 0.f};
#pragma unroll
        for (int ai = 0; ai < 2; ++ai)
#pragma unroll
            for (int m = 0; m < 4; ++m) { bf16_t* rowp = base + (size_t)(row0 + ai * HALF + m * 16) * ldc + col0;
#pragma unroll
                for (int bj = 0; bj < 2; ++bj) { f32x4 v0 = acc[ai][bj][m][0] + bv[bj][0], v1 = acc[ai][bj][m][1] + bv[bj][1];
                    if (ACT == 1) { f32x2 a = gelu_pk((f32x2){v0[0], v0[1]}), b = gelu_pk((f32x2){v0[2], v0[3]}), c = gelu_pk((f32x2){v1[0], v1[1]}), d = gelu_pk((f32x2){v1[2], v1[3]});
                        v0 = (f32x4){a.x, a.y, b.x, b.y}; v1 = (f32x4){c.x, c.y, d.x, d.y}; }
                    if (ACT == 2) { _Pragma("unroll") for (int q_ = 0; q_ < 4; ++q_) { const float a_ = v0[q_] > 0.f ? v0[q_] : 0.f, b_ = v1[q_] > 0.f ? v1[q_] : 0.f; v0[q_] = a_ * a_; v1[q_] = b_ * b_; } }
                    v0 = v0 * sc; v1 = v1 * sc; u32x4 w; w.x = cvt_pk_bf16(v0[0], v0[1]); w.y = cvt_pk_bf16(v0[2], v0[3]); w.z = cvt_pk_bf16(v1[0], v1[1]); w.w = cvt_pk_bf16(v1[2], v1[3]);
                    *(u32x4*)(rowp + bj * HALF) = w; } }
    }
};


struct EpiResBf16 {
    static constexpr bool PERM = true, AFTER_DRAIN = false;
    bf16_t* X; int ldc; float alpha;
    __device__ __forceinline__ void operator()(const f32x4 (&acc)[2][2][4][2], const Unit& u, int wr, int wc, int fr, int fq) const {
        const int row0 = u.pm * BM + wr * 64 + fr, col0 = u.pn * BM + wc * 32 + 8 * fq;
#pragma unroll
        for (int ai = 0; ai < 2; ++ai) {
            u32x4 xin[4][2];
#pragma unroll
            for (int m = 0; m < 4; ++m)
#pragma unroll
                for (int bj = 0; bj < 2; ++bj) xin[m][bj] = *(const u32x4*)(X + (size_t)(row0 + ai * HALF + m * 16) * ldc + col0 + bj * HALF);
#pragma unroll
            for (int m = 0; m < 4; ++m) { bf16_t* rowp = X + (size_t)(row0 + ai * HALF + m * 16) * ldc + col0;
#pragma unroll
                for (int bj = 0; bj < 2; ++bj) { const u32x4 xi = xin[m][bj]; const f32x4 a0 = acc[ai][bj][m][0], a1 = acc[ai][bj][m][1];
                    float x[8] = {__uint_as_float(xi.x << 16), __uint_as_float(xi.x & 0xffff0000u), __uint_as_float(xi.y << 16), __uint_as_float(xi.y & 0xffff0000u),
                                  __uint_as_float(xi.z << 16), __uint_as_float(xi.z & 0xffff0000u), __uint_as_float(xi.w << 16), __uint_as_float(xi.w & 0xffff0000u)};
                    u32x4 w; w.x = cvt_pk_bf16(alpha * x[0] + a0[0], alpha * x[1] + a0[1]); w.y = cvt_pk_bf16(alpha * x[2] + a0[2], alpha * x[3] + a0[3]);
                    w.z = cvt_pk_bf16(alpha * x[4] + a1[0], alpha * x[5] + a1[1]); w.w = cvt_pk_bf16(alpha * x[6] + a1[2], alpha * x[7] + a1[3]);
                    *(u32x4*)(rowp + bj * HALF) = w; } }
        }
    }
};

struct EpiF32 {
    static constexpr bool PERM = false, AFTER_DRAIN = false;
    float* C; int ldc;
    __device__ __forceinline__ void operator()(const f32x4 (&acc)[2][2][4][2], const Unit& u, int wr, int wc, int fr, int fq) const {
        const int row0 = u.pm * BM + wr * 64 + fr, col0 = u.pn * BM + wc * 32 + 4 * fq;
#pragma unroll
        for (int ai = 0; ai < 2; ++ai)
#pragma unroll
            for (int m = 0; m < 4; ++m) { float* rowp = C + (size_t)(row0 + ai * HALF + m * 16) * ldc + col0;
#pragma unroll
                for (int bj = 0; bj < 2; ++bj)
#pragma unroll
                    for (int n = 0; n < 2; ++n) *(f32x4*)(rowp + bj * HALF + n * 16) = acc[ai][bj][m][n]; }
    }
};
struct PanelStats {
    unsigned* xbuf;
    unsigned* cnt;
    unsigned* tmo;
    int ntn; float eps;
    unsigned code;
    __device__ __forceinline__ bool run(const f32x4 (&v)[2][2][4][2], const Unit& u, int wr, int wc, int fr, int fq, PG8_LAS unsigned char* lds, int wid, int lane) const {
        typedef float f32x2v __attribute__((ext_vector_type(2)));
        PG8_LAS f32x2v* P = (PG8_LAS f32x2v*)lds;
        PG8_LAS f32x2v* S = (PG8_LAS f32x2v*)(lds + 8192);
        PG8_LAS unsigned* flag = (PG8_LAS unsigned*)(lds + 8192 + 2048);
#pragma unroll
        for (int ai = 0; ai < 2; ++ai)
#pragma unroll
            for (int m = 0; m < 4; ++m) {
                float s = 0.f;
#pragma unroll
                for (int bj = 0; bj < 2; ++bj)
#pragma unroll
                    for (int n = 0; n < 2; ++n) { const f32x4 x = v[ai][bj][m][n]; s += (x[0] + x[1]) + (x[2] + x[3]); }
                s += __shfl_xor(s, 16); s += __shfl_xor(s, 32);
                const float mw = s * (1.0f / 64.0f); float q = 0.f;
#pragma unroll
                for (int bj = 0; bj < 2; ++bj)
#pragma unroll
                    for (int n = 0; n < 2; ++n) { const f32x4 d = v[ai][bj][m][n] - mw; q += (d[0] * d[0] + d[1] * d[1]) + (d[2] * d[2] + d[3] * d[3]); }
                q += __shfl_xor(q, 16); q += __shfl_xor(q, 32);
                if (fq == 0) P[(ai * HALF + wr * 64 + m * 16 + fr) * 4 + wc] = (f32x2v){mw, q};
            }
        asm volatile("s_waitcnt lgkmcnt(0)" ::: "memory"); __builtin_amdgcn_s_barrier(); asm volatile("" ::: "memory");
#if defined(BROKEN_EXCHANGE_NO_WAIT)
#warning BROKEN CONTROL BUILD: the row-statistics exchange does not wait; results are wrong by design
        if (blockIdx.x >= 64) { const long long t0_ = clock64(); while (clock64() - t0_ < 60000) __builtin_amdgcn_s_sleep(8); }
#endif
        const int row = wid * 32 + (lane & 31);
        if (lane < 32) {
            const f32x2v a = P[row * 4 + 0], b = P[row * 4 + 1], c = P[row * 4 + 2], d = P[row * 4 + 3];
            const float mt = (a.x + b.x + c.x + d.x) * 0.25f;
            const float da = a.x - mt, db = b.x - mt, dc = c.x - mt, dd = d.x - mt;
            const float m2 = (a.y + b.y) + (c.y + d.y) + 64.0f * ((da * da + db * db) + (dc * dc + dd * dd));
            unsigned long long* slot = (unsigned long long*)xbuf + ((size_t)(u.pm * BM + row) * 4 + u.pn);
            __hip_atomic_store(slot, ((unsigned long long)__float_as_uint(m2) << 32) | __float_as_uint(mt), __ATOMIC_RELAXED, __HIP_MEMORY_SCOPE_AGENT);
        }
        asm volatile("s_waitcnt vmcnt(0)" ::: "memory");
        if (lane == 0) __hip_atomic_fetch_add(cnt + 64 * u.pm, 1u, __ATOMIC_RELAXED, __HIP_MEMORY_SCOPE_AGENT);
        if (wid == 0) {
            bool dead = false; const unsigned long long t0 = __builtin_amdgcn_s_memrealtime(); const unsigned want = 8u * (unsigned)ntn;
            for (;;) {
#if defined(BROKEN_EXCHANGE_NO_WAIT)
                break;
#endif
                if ((unsigned)__builtin_amdgcn_readfirstlane(__hip_atomic_load(cnt + 64 * u.pm, __ATOMIC_RELAXED, __HIP_MEMORY_SCOPE_AGENT)) >= want) break;
                if (__builtin_amdgcn_s_memrealtime() - t0 > 2000000ull) {
                    if (lane == 0) { unsigned expect = 0u; __hip_atomic_compare_exchange_strong(tmo + 1, &expect, code | (unsigned)(u.pm & 0xff), __ATOMIC_RELAXED, __ATOMIC_RELAXED, __HIP_MEMORY_SCOPE_AGENT);
                                     __hip_atomic_store(tmo, 1u, __ATOMIC_RELAXED, __HIP_MEMORY_SCOPE_AGENT); }
                    dead = true; break; }
                __builtin_amdgcn_s_sleep(2);
            }
            __builtin_amdgcn_fence(__ATOMIC_ACQUIRE, "agent");
            if (lane == 0) flag[0] = dead ? 1u : 0u;
        }
        asm volatile("s_waitcnt vmcnt(0) lgkmcnt(0)" ::: "memory"); __builtin_amdgcn_s_barrier(); asm volatile("" ::: "memory");
        const bool bad = flag[0] != 0u;
        if (lane < 32) {
            const unsigned long long* slot = (const unsigned long long*)xbuf + (size_t)(u.pm * BM + row) * 4; float mt[4], m2[4]; float ms = 0.f;
#pragma unroll
            for (int t = 0; t < 4; ++t) { if (t < ntn) { const unsigned long long w = __hip_atomic_load(slot + t, __ATOMIC_RELAXED, __HIP_MEMORY_SCOPE_AGENT); mt[t] = __uint_as_float((unsigned)w); m2[t] = __uint_as_float((unsigned)(w >> 32)); } else { mt[t] = 0.f; m2[t] = 0.f; } ms += mt[t]; }
            const float mean = ms / (float)ntn; float q = 0.f;
#pragma unroll
            for (int t = 0; t < 4; ++t) if (t < ntn) { const float dm = mt[t] - mean; q += m2[t] + 256.0f * dm * dm; }
            S[row] = (f32x2v){mean, 1.0f / sqrtf(q / (256.0f * (float)ntn) + eps)};
        }
        asm volatile("s_waitcnt lgkmcnt(0)" ::: "memory"); __builtin_amdgcn_s_barrier(); asm volatile("" ::: "memory");
        return bad;
    }
};
struct EpiLnRes {
    static constexpr bool PERM = false, AFTER_DRAIN = true;
    const float* base; float* out; int ldc; const float* bias; PanelStats st; unsigned poison;
    __device__ __forceinline__ void fused(f32x4 (&acc)[2][2][4][2], const Unit& u, int wr, int wc, int fr, int fq, PG8_LAS unsigned char* lds, int wid, int lane) const {
        typedef float f32x2v __attribute__((ext_vector_type(2)));
        const PG8_LAS f32x2v* S = (const PG8_LAS f32x2v*)(lds + 8192);
        const int col0 = u.pn * BM + wc * 32 + 4 * fq;
#pragma unroll
        for (int bj = 0; bj < 2; ++bj)
#pragma unroll
            for (int n = 0; n < 2; ++n) { const f32x4 bv = bias ? *(const f32x4*)(bias + col0 + bj * HALF + n * 16) : (f32x4){0.f, 0.f, 0.f, 0.f};
#pragma unroll
                for (int ai = 0; ai < 2; ++ai)
#pragma unroll
                    for (int m = 0; m < 4; ++m) acc[ai][bj][m][n] += bv; }
        f32x4 pre[4][2][2];
#pragma unroll
        for (int m = 0; m < 4; ++m) { const size_t off = (size_t)(u.pm * BM + wr * 64 + m * 16 + fr) * ldc + col0;
#pragma unroll
            for (int bj = 0; bj < 2; ++bj)
#pragma unroll
                for (int n = 0; n < 2; ++n) pre[m][bj][n] = *(const f32x4*)(base + off + bj * HALF + n * 16); }
        const bool bad = st.run(acc, u, wr, wc, fr, fq, lds, wid, lane) || poison != 0u;
        const float qnan = __builtin_nanf("");
#pragma unroll
        for (int ai = 0; ai < 2; ++ai)
#pragma unroll
            for (int m = 0; m < 4; ++m) { const int r = ai * HALF + wr * 64 + m * 16 + fr; const f32x2v sr = S[r]; const size_t off = (size_t)(u.pm * BM + r) * ldc + col0;
#pragma unroll
                for (int bj = 0; bj < 2; ++bj)
#pragma unroll
                    for (int n = 0; n < 2; ++n) { const f32x4 bs = ai == 0 ? pre[m][bj][n] : *(const f32x4*)(base + off + bj * HALF + n * 16); f32x4 o = bs + (acc[ai][bj][m][n] - sr.x) * sr.y;
                        if (bad) o = (f32x4){qnan, qnan, qnan, qnan}; *(f32x4*)(out + off + bj * HALF + n * 16) = o; }
                if (m & 1) asm volatile("" ::: "memory"); }
    }
};
struct EpiLnResLn {
    static constexpr bool PERM = false, AFTER_DRAIN = true;
    const float* base; float* out; bf16_t* xn; int ldc; const float* bias; PanelStats st1, st2; unsigned poison;
    __device__ __forceinline__ void fused(f32x4 (&acc)[2][2][4][2], const Unit& u, int wr, int wc, int fr, int fq, PG8_LAS unsigned char* lds, int wid, int lane) const {
        typedef float f32x2v __attribute__((ext_vector_type(2))); typedef unsigned u32x2v __attribute__((ext_vector_type(2)));
        const PG8_LAS f32x2v* S = (const PG8_LAS f32x2v*)(lds + 8192);
        const int col0 = u.pn * BM + wc * 32 + 4 * fq;
#pragma unroll
        for (int bj = 0; bj < 2; ++bj)
#pragma unroll
            for (int n = 0; n < 2; ++n) { const f32x4 bv = bias ? *(const f32x4*)(bias + col0 + bj * HALF + n * 16) : (f32x4){0.f, 0.f, 0.f, 0.f};
#pragma unroll
                for (int ai = 0; ai < 2; ++ai)
#pragma unroll
                    for (int m = 0; m < 4; ++m) acc[ai][bj][m][n] += bv; }
        bool bad = st1.run(acc, u, wr, wc, fr, fq, lds, wid, lane) || poison != 0u;
        const float qnan = __builtin_nanf("");
#pragma unroll
        for (int ai = 0; ai < 2; ++ai)
#pragma unroll
            for (int m = 0; m < 4; ++m) { const int r = ai * HALF + wr * 64 + m * 16 + fr; const f32x2v sr = S[r]; const size_t off = (size_t)(u.pm * BM + r) * ldc + col0;
#pragma unroll
                for (int bj = 0; bj < 2; ++bj)
#pragma unroll
                    for (int n = 0; n < 2; ++n) { const f32x4 bs = *(const f32x4*)(base + off + bj * HALF + n * 16); acc[ai][bj][m][n] = bs + (acc[ai][bj][m][n] - sr.x) * sr.y; }
                asm volatile("" : "+v"(acc[ai][0][m][0]), "+v"(acc[ai][0][m][1]), "+v"(acc[ai][1][m][0]), "+v"(acc[ai][1][m][1]));
                if (m & 1) asm volatile("" ::: "memory"); }
        const bool bad1 = bad;
        bad = st2.run(acc, u, wr, wc, fr, fq, lds, wid, lane) || bad;
#pragma unroll
        for (int ai = 0; ai < 2; ++ai)
#pragma unroll
            for (int m = 0; m < 4; ++m) { const int r = ai * HALF + wr * 64 + m * 16 + fr; const f32x2v sr = S[r]; const size_t off = (size_t)(u.pm * BM + r) * ldc + col0;
#pragma unroll
                for (int bj = 0; bj < 2; ++bj)
#pragma unroll
                    for (int n = 0; n < 2; ++n) { const f32x4 x1 = acc[ai][bj][m][n]; *(f32x4*)(out + off + bj * HALF + n * 16) = bad1 ? (f32x4){qnan, qnan, qnan, qnan} : x1;
                        const f32x4 o = (x1 - sr.x) * sr.y; u32x2v w; w.x = cvt_pk_bf16(o[0], o[1]); w.y = cvt_pk_bf16(o[2], o[3]);
                        if (bad) { w.x = 0x7fc07fc0u; w.y = 0x7fc07fc0u; } *(u32x2v*)(xn + off + bj * HALF + n * 16) = w; }
                asm volatile("" ::: "memory"); }
    }
};

template <class Epi, class Sched, bool ALIGN_EPI = false, bool SP2 = false>
__device__ __forceinline__ void gemm_phase(PG8_LAS unsigned char* lds, const Gemm g, const Sched& S, const Epi& E, int wv) {
    int tid0_ = threadIdx.x; asm volatile("" : "+v"(tid0_)); (void)wv;
    const int tid = tid0_, wid = __builtin_amdgcn_readfirstlane(tid >> 6), lane = tid & 63, wr = wid >> 2, wc = wid & 3, fr = lane & 15, fq = lane >> 4;
    const int K = g.K, nt = K / BK;
    unsigned voffA[2], voffB[2];
#pragma unroll
    for (int i = 0; i < 2; ++i) { int R, C; stage_rc(tid * 16 + i * 8192, R, C); const int Rb = Epi::PERM ? ((R & ~31) + perm32(R & 31)) : R;
        voffA[i] = (unsigned)(R * K + C) * 2u; voffB[i] = (unsigned)(Rb * K + C) * 2u; }
    const size_t kstep = (size_t)(BK * 2);
    const size_t hstep = (size_t)HALF * K * 2;
    const size_t tstep = 2 * hstep;
    const unsigned ldsw = (unsigned)wid * 1024u;
    const int aoff = lds_byte(wr * 64 + fr, fq * 8), boff = lds_byte(wc * 32 + fr, fq * 8);
#define PG8_SA(b, h) (((b) * 2 + (h)) * HTB)
#define PG8_SB(b, h) ((4 + (b) * 2 + (h)) * HTB)
#define PG8_STAGE(bufoff, gbase, voff) do { _Pragma("unroll") for (int _i = 0; _i < 2; ++_i) \
        __builtin_amdgcn_global_load_lds((const unsigned*)((const char*)(gbase) + (voff)[_i]), (PG8_LAS unsigned*)(lds + (bufoff) + ldsw + _i * 8192), 16, 0, 0); } while (0)
#define PG8_LDA(dst, b, h) do { _Pragma("unroll") for (int m = 0; m < 4; ++m) _Pragma("unroll") for (int k = 0; k < 2; ++k) dst[m][k] = *(const PG8_LAS bf16x8*)(lds + PG8_SA(b, h) + aoff + m * 2048 + k * 1024); } while (0)
#define PG8_LDB(dst, b, h) do { _Pragma("unroll") for (int n = 0; n < 2; ++n) _Pragma("unroll") for (int k = 0; k < 2; ++k) dst[n][k] = *(const PG8_LAS bf16x8*)(lds + PG8_SB(b, h) + boff + n * 2048 + k * 1024); } while (0)
#define PG8_MMA(ai, bj, At, Bt) do { __builtin_amdgcn_s_setprio(1); _Pragma("unroll") for (int m = 0; m < 4; ++m) _Pragma("unroll") for (int n = 0; n < 2; ++n) _Pragma("unroll") for (int k = 0; k < 2; ++k) \
        acc[ai][bj][m][n] = __builtin_amdgcn_mfma_f32_16x16x32_bf16(Bt[n][k], At[m][k], acc[ai][bj][m][n], 0, 0, 0); __builtin_amdgcn_s_setprio(0); } while (0)
#define PG8_WAIT_V(n) asm volatile("s_waitcnt vmcnt(" #n ")" ::: "memory")
#define PG8_WAIT_L(n) asm volatile("s_waitcnt lgkmcnt(" #n ")" ::: "memory")
#define PG8_BAR __builtin_amdgcn_s_barrier()
#define PG8_SCHED __builtin_amdgcn_sched_barrier(0)
    Unit cur, nxt; int ui = 0;
    if (!S.next(0, cur)) return;
    f32x4 acc[2][2][4][2];
#pragma unroll
    for (int a = 0; a < 2; ++a)
#pragma unroll
        for (int b = 0; b < 2; ++b)
#pragma unroll
            for (int m = 0; m < 4; ++m)
#pragma unroll
                for (int n = 0; n < 2; ++n) acc[a][b][m][n] = (f32x4){0.f, 0.f, 0.f, 0.f};
    bf16x8 At[4][2], B0[2][2], B1[2][2];
    const char* cA = (const char*)g.A + (size_t)cur.pm * tstep; const char* cB = (const char*)g.Bt + (size_t)cur.pn * tstep;
    S.a_ready(cur);
    if constexpr (SP2) {
        PG8_STAGE(PG8_SB(0, 0), cB, voffB); PG8_STAGE(PG8_SB(0, 1), cB + hstep, voffB); PG8_STAGE(PG8_SA(0, 0), cA, voffA); PG8_STAGE(PG8_SA(0, 1), cA + hstep, voffA);
        if (wr == 1) PG8_BAR;
        PG8_WAIT_V(2); PG8_BAR;
        PG8_STAGE(PG8_SB(1, 0), cB + kstep, voffB); PG8_STAGE(PG8_SA(1, 0), cA + kstep, voffA); PG8_STAGE(PG8_SB(1, 1), cB + hstep + kstep, voffB);
        PG8_WAIT_V(6); PG8_BAR;
    } else {
        PG8_STAGE(PG8_SB(0, 0), cB, voffB); PG8_STAGE(PG8_SA(0, 0), cA, voffA); PG8_STAGE(PG8_SB(0, 1), cB + hstep, voffB); PG8_STAGE(PG8_SA(0, 1), cA + hstep, voffA);
        if (wr == 1) PG8_BAR;
        PG8_WAIT_V(4); PG8_BAR;
        PG8_STAGE(PG8_SB(1, 0), cB + kstep, voffB); PG8_STAGE(PG8_SA(1, 0), cA + kstep, voffA); PG8_STAGE(PG8_SB(1, 1), cB + hstep + kstep, voffB);
        PG8_WAIT_V(6); PG8_BAR;
    }
    for (;;) {
        const bool has_next = S.next(ui + 1, nxt);
        const char* nA = has_next ? (const char*)g.A + (size_t)nxt.pm * tstep : cA; const char* nB = has_next ? (const char*)g.Bt + (size_t)nxt.pn * tstep : cB;
        for (int t = 0; t < nt; t += 2) {
            const bool last = (t == nt - 2);
            const char* a1 = cA + (size_t)(t + 1) * kstep;
            const char* a2 = last ? nA : cA + (size_t)(t + 2) * kstep; const char* b2 = last ? nB : cB + (size_t)(t + 2) * kstep;
            const char* a3 = a2 + kstep; const char* b3 = b2 + kstep;
            if (last && has_next) S.a_ready(nxt);
            if constexpr (SP2) {
            PG8_LDB(B0, 0, 0); PG8_LDB(B1, 0, 1); PG8_SCHED; PG8_LDA(At, 0, 0); PG8_STAGE(PG8_SA(1, 1), a1 + hstep, voffA);
            PG8_WAIT_V(8); PG8_WAIT_L(0); PG8_BAR; PG8_MMA(0, 0, At, B0); PG8_MMA(0, 1, At, B1); PG8_BAR; PG8_SCHED;
            PG8_LDA(At, 0, 1); PG8_STAGE(PG8_SB(0, 0), b2, voffB); PG8_STAGE(PG8_SB(0, 1), b2 + hstep, voffB); PG8_STAGE(PG8_SA(0, 0), a2, voffA);
            PG8_WAIT_V(8); PG8_WAIT_L(0); PG8_BAR; PG8_MMA(1, 0, At, B0); PG8_MMA(1, 1, At, B1); PG8_BAR; PG8_SCHED;
            PG8_LDB(B0, 1, 0); PG8_LDB(B1, 1, 1); PG8_SCHED; PG8_LDA(At, 1, 0); PG8_STAGE(PG8_SA(0, 1), a2 + hstep, voffA);
            PG8_WAIT_V(8); PG8_WAIT_L(0); PG8_BAR; PG8_MMA(0, 0, At, B0); PG8_MMA(0, 1, At, B1); PG8_BAR; PG8_SCHED;
            PG8_LDA(At, 1, 1); PG8_STAGE(PG8_SB(1, 0), b3, voffB); PG8_STAGE(PG8_SB(1, 1), b3 + hstep, voffB); PG8_STAGE(PG8_SA(1, 0), a3, voffA);
            PG8_WAIT_V(8); PG8_WAIT_L(0); PG8_BAR; PG8_MMA(1, 0, At, B0); PG8_MMA(1, 1, At, B1); PG8_BAR; PG8_SCHED;
            } else {
            PG8_LDB(B0, 0, 0); PG8_SCHED; PG8_LDA(At, 0, 0); PG8_STAGE(PG8_SA(1, 1), a1 + hstep, voffA);
            PG8_WAIT_L(8); PG8_BAR; PG8_WAIT_L(0); PG8_MMA(0, 0, At, B0); PG8_BAR; PG8_SCHED;
            PG8_LDB(B1, 0, 1); PG8_STAGE(PG8_SB(0, 0), b2, voffB);
            PG8_BAR; PG8_WAIT_L(0); PG8_MMA(0, 1, At, B1); PG8_BAR;
            PG8_LDA(At, 0, 1); PG8_STAGE(PG8_SA(0, 0), a2, voffA);
            PG8_BAR; PG8_WAIT_L(0); PG8_MMA(1, 0, At, B0); PG8_BAR; PG8_SCHED;
            PG8_STAGE(PG8_SB(0, 1), b2 + hstep, voffB);
            PG8_WAIT_V(6); PG8_BAR; PG8_MMA(1, 1, At, B1); PG8_BAR;
            PG8_LDB(B0, 1, 0); PG8_SCHED; PG8_LDA(At, 1, 0); PG8_STAGE(PG8_SA(0, 1), a2 + hstep, voffA);
            PG8_WAIT_L(8); PG8_BAR; PG8_WAIT_L(0); PG8_MMA(0, 0, At, B0); PG8_BAR; PG8_SCHED;
            PG8_LDB(B1, 1, 1); PG8_STAGE(PG8_SB(1, 0), b3, voffB);
            PG8_BAR; PG8_WAIT_L(0); PG8_MMA(0, 1, At, B1); PG8_BAR;
            PG8_LDA(At, 1, 1); PG8_STAGE(PG8_SA(1, 0), a3, voffA);
            PG8_BAR; PG8_WAIT_L(0); PG8_MMA(1, 0, At, B0); PG8_BAR; PG8_SCHED;
            PG8_STAGE(PG8_SB(1, 1), b3 + hstep, voffB);
            PG8_WAIT_V(6); PG8_BAR; PG8_MMA(1, 1, At, B1); PG8_BAR;
            }
        }
        if constexpr (ALIGN_EPI) { if (wr == 0) PG8_BAR; }
        if constexpr (!Epi::AFTER_DRAIN) { E(acc, cur, wr, wc, fr, fq); S.done(cur); }
        if (!has_next) break;
#pragma unroll
        for (int a = 0; a < 2; ++a)
#pragma unroll
            for (int b = 0; b < 2; ++b)
#pragma unroll
                for (int m = 0; m < 4; ++m)
#pragma unroll
                    for (int n = 0; n < 2; ++n) acc[a][b][m][n] = (f32x4){0.f, 0.f, 0.f, 0.f};
        cur = nxt; cA = nA; cB = nB; ++ui;
        if constexpr (ALIGN_EPI) { if (wr == 1) PG8_BAR; }
    }
    PG8_WAIT_V(0);
    if constexpr (!ALIGN_EPI) { if (wr == 0) PG8_BAR; }
    PG8_BAR;
    if constexpr (Epi::AFTER_DRAIN) { E.fused(acc, cur, wr, wc, fr, fq, lds, wid, lane); S.done(cur); }
#undef PG8_SA
#undef PG8_SB
#undef PG8_STAGE
#undef PG8_LDA
#undef PG8_LDB
#undef PG8_MMA
#undef PG8_WAIT_V
#undef PG8_WAIT_L
#undef PG8_BAR
#undef PG8_SCHED
}
}

#ifndef PG8_SP2
#define PG8_SP2 true
#endif
#ifndef PG8_ALIGN
#define PG8_ALIGN true
#endif
#define GAS __attribute__((address_space(1)))
#define LAS __attribute__((address_space(3)))
#define XB_TMO      128
#define XB_XCNT(j)  (256  + 64 * (j))
#define XB_XSUB(j)  (1280 + 64 * (j))
#define XB_XGEN(j)  (2304 + 64 * (j))
#define XB_TOP      3328
#define XB_TOPGEN   3392
#define XCD_BAR_WORDS 3456
#define XB_SPIN_CAP (1u << 18)

__device__ __forceinline__ unsigned xb_ld(unsigned* p)              { return __hip_atomic_load(p, __ATOMIC_RELAXED, __HIP_MEMORY_SCOPE_AGENT); }
__device__ __forceinline__ unsigned xb_add(unsigned* p, unsigned v) { return __hip_atomic_fetch_add(p, v, __ATOMIC_RELAXED, __HIP_MEMORY_SCOPE_AGENT); }
__device__ __forceinline__ unsigned xb_xcc_id() { return (unsigned)__builtin_amdgcn_s_getreg((3 << 11) | 20) & 0xFu; }
#define XB_SPIN(cond, bar) do { unsigned _sp = 0; while (cond) { __builtin_amdgcn_s_sleep(1); \
    if ((++_sp & 255u) == 0u) { if (xb_ld(&(bar)[XB_TMO])) break; if (_sp > XB_SPIN_CAP) { atomicAdd(&(bar)[XB_TMO], 1u); break; } } } } while (0)

struct XcdBarrier {
    unsigned* bar; unsigned x;
    volatile LAS unsigned* st;
    int wv;
};

__device__ __forceinline__ XcdBarrier xcd_barrier_post(unsigned* bar, volatile LAS unsigned* st) {
    XcdBarrier b; b.bar = bar; b.x = xb_xcc_id(); b.st = st;
    if (threadIdx.x == 0) (void)xb_add(&bar[XB_XCNT(b.x)], 1u);
    return b;
}
__device__ __forceinline__ void xcd_barrier_complete(unsigned* bar, unsigned x, unsigned& nloc, unsigned& nx) {
    asm volatile("" : "+s"(x));
    const unsigned G = gridDim.x * gridDim.y * gridDim.z;
    unsigned sum, cnt, mine, sp = 0u;
    for (;;) {
        sum = 0u; cnt = 0u; mine = 0u;
#pragma unroll
        for (unsigned j = 0; j < 16; ++j) { const unsigned c = xb_ld(&bar[XB_XCNT(j)]); sum += c; cnt += (c > 0u) ? 1u : 0u; mine = (j == x) ? c : mine; }
        if (sum == G) break;
        __builtin_amdgcn_s_sleep(1);
        if ((++sp & 255u) == 0u) { if (xb_ld(&bar[XB_TMO])) break; if (sp > XB_SPIN_CAP) { atomicAdd(&bar[XB_TMO], 1u); break; } }
    }
    nloc = mine > 0u ? mine : 1u; nx = cnt > 0u ? cnt : 1u;
}

__device__ __forceinline__ void xcd_barrier(const XcdBarrier& b) {
    asm volatile("s_waitcnt vmcnt(0)" ::: "memory");
    __syncthreads();
    if (threadIdx.x == 0) {
        unsigned* bar = b.bar; asm volatile("" : "+s"(bar));
        __builtin_amdgcn_s_waitcnt(0);
        unsigned nloc = b.st[0], nx = b.st[1];
        if (nloc == 0u) { xcd_barrier_complete(bar, b.x, nloc, nx); b.st[0] = nloc; b.st[1] = nx; }
        const unsigned old = xb_add(&bar[XB_XSUB(b.x)], 1u);
        const unsigned gen = old / nloc;
        if (old + 1u == (gen + 1u) * nloc) {
            __builtin_amdgcn_fence(__ATOMIC_RELEASE, "agent");
            asm volatile("s_waitcnt vmcnt(0)" ::: "memory");
            const unsigned og = xb_add(&bar[XB_TOP], 1u);
            const unsigned tg = og / nx;
            if (og + 1u == (tg + 1u) * nx) xb_add(&bar[XB_TOPGEN], 1u);
            else XB_SPIN(xb_ld(&bar[XB_TOPGEN]) == tg, bar);
            __builtin_amdgcn_fence(__ATOMIC_ACQUIRE, "agent");
            xb_add(&bar[XB_XGEN(b.x)], 1u);
            asm volatile("s_waitcnt vmcnt(0)" ::: "memory");
        } else {
            XB_SPIN(xb_ld(&bar[XB_XGEN(b.x)]) == gen, bar);
            __builtin_amdgcn_fence(__ATOMIC_ACQUIRE, "agent");
            asm volatile("s_waitcnt vmcnt(0)" ::: "memory");
        }
    }
    __syncthreads();
}
namespace dattn {
constexpr int D = 128, QST = 2048, KVS = 512, OST = 2048, MTW = 68, JLO = 3;
constexpr float THR = 8.f; constexpr bool WSKIP = false;
typedef unsigned short bf16;
constexpr float SCALE = 1.0f;
constexpr int NW = 8, QBLK = 32, KVBLK = 64, QB = NW * QBLK;
constexpr int SHM_V = KVBLK * D * 2, SHM_K = KVBLK * D * 2;
constexpr int LDS_BYTES = 2 * SHM_V + 2 * SHM_K + NW * 64 * 4;

typedef short bf16x8 __attribute__((ext_vector_type(8)));
typedef short s16x4 __attribute__((ext_vector_type(4)));
typedef float f32x16 __attribute__((ext_vector_type(16)));
typedef float f32x4 __attribute__((ext_vector_type(4)));
typedef unsigned u32x4 __attribute__((ext_vector_type(4)));
template <class A, class Bt> struct same_t { static constexpr bool v = false; };
template <class A> struct same_t<A, A> { static constexpr bool v = true; };

#define KSWZ(row, colB) ((row) * 256 + ((colB) ^ (((row) & 7) << 4)))
#define SBAR() __builtin_amdgcn_sched_barrier(0)
__device__ __forceinline__ int v_st(int k, int c) { const int kk = (k & ~0xC) | ((k & 4) << 1) | ((k & 8) >> 1); return ((kk >> 3) * 4 + (c >> 5)) * 512 + ((kk & 7) * 32 + (c & 31)) * 2; }
__device__ __forceinline__ int v_rd_base(int lane) { return ((lane & 3) << 3) | (((lane >> 2) & 3) << 6) | (((lane >> 4) & 1) << 5) | (((lane >> 5) & 1) << 8); }
constexpr int v_rd_off(int d0, int ks, int half) { return d0 * 512 + ks * 4096 + half * 2048; }
__device__ __forceinline__ int crow(int r, int hi) { return (r & 3) + 8 * (r >> 2) + 4 * hi; }
__device__ __forceinline__ unsigned cvtpk(float lo, float hi) {
    unsigned r; asm volatile("v_cvt_pk_bf16_f32 %0, %1, %2" : "=v"(r) : "v"(lo), "v"(hi)); return r;
}
__device__ __forceinline__ bf16x8 pack8(f32x4 a, f32x4 b) {
    u32x4 w = {cvtpk(a[0], a[1]), cvtpk(a[2], a[3]), cvtpk(b[0], b[1]), cvtpk(b[2], b[3])};
    return *reinterpret_cast<bf16x8*>(&w);
}
template <class T> __device__ __forceinline__ bf16x8 load8(const T* p) {
    if constexpr (same_t<T, float>::v) { return pack8(*(const f32x4*)p, *(const f32x4*)(p + 4)); }
    else { return *reinterpret_cast<const bf16x8*>(p); }
}
__device__ __forceinline__ void mask_tile(f32x16& p0, f32x16& p1, int dq, unsigned W) {
    const float NEG = -__builtin_inff();
#pragma unroll
    for (int r = 0; r < 16; ++r) {
        const int c = (r & 3) + 8 * (r >> 2);
        if ((unsigned)(dq - c) >= W) p0[r] = NEG;
        if ((unsigned)(dq - c - 32) >= W) p1[r] = NEG;
    }
}
__device__ __forceinline__ void mask_bits(f32x16& p0, f32x16& p1, unsigned long long mw, int hi) {
    const float NEG = -__builtin_inff();
    const unsigned lo = (unsigned)(mw >> (4 * hi)), up = (unsigned)(mw >> (32 + 4 * hi));
#pragma unroll
    for (int r = 0; r < 16; ++r) {
        const int c = (r & 3) + 8 * (r >> 2);
        const unsigned t0 = (unsigned)__builtin_amdgcn_sbfe((int)lo, c, 1), t1 = (unsigned)__builtin_amdgcn_sbfe((int)up, c, 1);
        p0[r] = __uint_as_float((t0 & __float_as_uint(p0[r])) | (~t0 & __float_as_uint(NEG)));
        p1[r] = __uint_as_float((t1 & __float_as_uint(p1[r])) | (~t1 & __float_as_uint(NEG)));
    }
}
template <int Q> __device__ __forceinline__ void mask_bias_q(f32x16& p0, f32x16& p1, unsigned nlo, unsigned nup) {
#pragma unroll
    for (int r = 4 * Q; r < 4 * Q + 4; ++r) { const int c = (r & 3) + 8 * (r >> 2);
        p0[r] = __uint_as_float((unsigned)__builtin_amdgcn_sbfe((int)nlo, c, 1) & 0xFF800000u);
        p1[r] = __uint_as_float((unsigned)__builtin_amdgcn_sbfe((int)nup, c, 1) & 0xFF800000u); }
}
__device__ __forceinline__ void mask_bias(f32x16& p0, f32x16& p1, unsigned long long mw, int hi) {
    const unsigned nlo = ~(unsigned)(mw >> (4 * hi)), nup = ~(unsigned)(mw >> (32 + 4 * hi));
    mask_bias_q<0>(p0, p1, nlo, nup); mask_bias_q<1>(p0, p1, nlo, nup); mask_bias_q<2>(p0, p1, nlo, nup); mask_bias_q<3>(p0, p1, nlo, nup);
}
__device__ __forceinline__ void partialSM(f32x16& p0, f32x16& p1, float& m_reg, float& mn, float& alpha) {
    float pmax = p0[0]; for (int r = 1; r < 16; ++r) pmax = fmaxf(pmax, p0[r]); for (int r = 0; r < 16; ++r) pmax = fmaxf(pmax, p1[r]);
    { auto rr = __builtin_amdgcn_permlane32_swap(__float_as_uint(pmax), __float_as_uint(pmax), false, false);
      pmax = fmaxf(__uint_as_float(rr[0]), __uint_as_float(rr[1])); }
    constexpr float C2 = 1.4426950408889634f * SCALE;
    if (__builtin_expect(__all((pmax - m_reg) * SCALE <= THR), 1)) { mn = m_reg; alpha = 1.f; }
    else { mn = fmaxf(m_reg, pmax); alpha = __builtin_amdgcn_exp2f((m_reg - mn) * C2); m_reg = mn; }
    const float mnL = -mn * C2;
    for (int r = 0; r < 16; ++r) p0[r] = fmaf(p0[r], C2, mnL); for (int r = 0; r < 16; ++r) p1[r] = fmaf(p1[r], C2, mnL);
    for (int r = 0; r < 16; ++r) p0[r] = __builtin_amdgcn_exp2f(p0[r]);
}
__device__ __forceinline__ void finishSM(f32x16& p0, f32x16& p1, float alpha, float& l_reg, bf16x8& pa0, bf16x8& pa1, bf16x8& pa2, bf16x8& pa3) {
    for (int r = 0; r < 16; ++r) p1[r] = __builtin_amdgcn_exp2f(p1[r]);
    float ps = 0; for (int r = 0; r < 16; ++r) ps += p0[r]; for (int r = 0; r < 16; ++r) ps += p1[r];
    { auto rr = __builtin_amdgcn_permlane32_swap(__float_as_uint(ps), __float_as_uint(ps), false, false);
      ps = __uint_as_float(rr[0]) + __uint_as_float(rr[1]); }
    l_reg = l_reg * alpha + ps;
#define PK4(P, B_, OUT) do { unsigned a0 = cvtpk(P[B_+0], P[B_+1]), a1 = cvtpk(P[B_+2], P[B_+3]);                          \
        unsigned b0 = cvtpk(P[B_+4], P[B_+5]), b1 = cvtpk(P[B_+6], P[B_+7]);                                             \
        auto r0 = __builtin_amdgcn_permlane32_swap(a0, b0, false, false); auto r1 = __builtin_amdgcn_permlane32_swap(a1, b1, false, false); \
        u32x4 w = {r0[0], r1[0], r0[1], r1[1]}; OUT = *reinterpret_cast<bf16x8*>(&w); } while (0)
    PK4(p0, 0, pa0); PK4(p0, 8, pa1); PK4(p1, 0, pa2); PK4(p1, 8, pa3);
#undef PK4
}
template <int KB, bool SK, bool BI = false>
__device__ __forceinline__ void qkt(f32x16& p0, f32x16& p1, const char* K_lds, int r32, int hi, const bf16x8* qr, bool act) {
    if (SK && !act) { const float NEG = -__builtin_inff();
#pragma unroll
        for (int r = 0; r < 16; ++r) { p0[r] = NEG; p1[r] = NEG; } return; }
    if (!BI) { p0 = f32x16{}; p1 = f32x16{}; }
    const char* kb[4];
#pragma unroll
    for (int dd = 0; dd < 4; ++dd) kb[dd] = K_lds + KB * SHM_K + KSWZ(r32, (dd * 16 + hi * 8) * 2);
#pragma unroll
    for (int d0 = 0; d0 < 8; ++d0) { const char* a = kb[d0 & 3] + (d0 >> 2) * 128;
        bf16x8 b0 = *reinterpret_cast<const bf16x8*>(a);
        bf16x8 b1 = *reinterpret_cast<const bf16x8*>(a + 32 * 256);
        p0 = __builtin_amdgcn_mfma_f32_32x32x16_bf16(b0, qr[d0], p0, 0, 0, 0);
        p1 = __builtin_amdgcn_mfma_f32_32x32x16_bf16(b1, qr[d0], p1, 0, 0, 0); }
}
template <int VB, bool SK, bool BI = false>
__device__ __forceinline__ void pv_tile(f32x16* o, int vb0, bf16x8 pa0, bf16x8 pa1, bf16x8 pa2, bf16x8 pa3, bool act, f32x16* bq0 = nullptr, f32x16* bq1 = nullptr, unsigned nlo = 0u, unsigned nup = 0u) {
    if (SK && !act) return;
#define TRRD(dst, off) asm volatile("ds_read_b64_tr_b16 %0, %1 offset:%2" : "=&v"(dst) : "v"(vb0), "i"(off) : "memory")
#define PV_D0(d0) do { s16x4 l0, l1, l2, l3, h0, h1, h2, h3; constexpr int b_ = VB * SHM_V + v_rd_off(d0, 0, 0);     \
        TRRD(l0, b_); TRRD(h0, b_ + 2048); TRRD(l1, b_ + 4096); TRRD(h1, b_ + 6144); TRRD(l2, b_ + 8192); TRRD(h2, b_ + 10240); TRRD(l3, b_ + 12288); TRRD(h3, b_ + 14336); \
        asm volatile("s_waitcnt lgkmcnt(0)" ::: "memory"); SBAR();                 \
        o[d0] = __builtin_amdgcn_mfma_f32_32x32x16_bf16(pa0, (bf16x8){l0[0], l0[1], l0[2], l0[3], h0[0], h0[1], h0[2], h0[3]}, o[d0], 0, 0, 0);   \
        o[d0] = __builtin_amdgcn_mfma_f32_32x32x16_bf16(pa1, (bf16x8){l1[0], l1[1], l1[2], l1[3], h1[0], h1[1], h1[2], h1[3]}, o[d0], 0, 0, 0);   \
        o[d0] = __builtin_amdgcn_mfma_f32_32x32x16_bf16(pa2, (bf16x8){l2[0], l2[1], l2[2], l2[3], h2[0], h2[1], h2[2], h2[3]}, o[d0], 0, 0, 0);   \
        o[d0] = __builtin_amdgcn_mfma_f32_32x32x16_bf16(pa3, (bf16x8){l3[0], l3[1], l3[2], l3[3], h3[0], h3[1], h3[2], h3[3]}, o[d0], 0, 0, 0); } while (0)
    PV_D0(0); if (BI) mask_bias_q<0>(*bq0, *bq1, nlo, nup); PV_D0(1); if (BI) mask_bias_q<1>(*bq0, *bq1, nlo, nup);
    PV_D0(2); if (BI) mask_bias_q<2>(*bq0, *bq1, nlo, nup); PV_D0(3); if (BI) mask_bias_q<3>(*bq0, *bq1, nlo, nup);
#undef PV_D0
#undef TRRD
}

template <class TIn, class TOut> struct BlockRef { const TIn* Q; const TIn* K; const TIn* V; TOut* O; const unsigned long long* M; int P0; };
template <class TIn> struct Seam {
    bf16x8 qr[8];
    bf16x8 st_v0, st_v1, st_k0, st_k1; f32x4 sf0, sf1, sf2, sf3;
    f32x4 tq[16];
};
__device__ __forceinline__ int swa_jlo(int, int) { return JLO; }
#define ROW(p, k0, rr) ((p) + (size_t)((k0) + (rr)) * KVS + sc)
#define VMW() asm volatile("s_waitcnt vmcnt(0)" ::: "memory")
#define VMWN(n) asm volatile("s_waitcnt vmcnt(%0)" :: "i"(n) : "memory")
#define SLOAD_H(Kp, Vp, k0) do { S.st_v0 = load8<TIn>(ROW(Vp, k0, sr)); S.st_v1 = load8<TIn>(ROW(Vp, k0, 32 + sr));              \
                         S.st_k0 = load8<TIn>(ROW(Kp, k0, sr)); S.st_k1 = load8<TIn>(ROW(Kp, k0, 32 + sr)); } while (0)
#define SWRITE_HK(bf) do { *(bf16x8*)(K_lds + (bf) * SHM_K + kws) = S.st_k0; *(bf16x8*)(K_lds + (bf) * SHM_K + kws + 32 * 256) = S.st_k1; } while (0)
#define SWRITE_HV(bf) do { *(bf16x8*)(V_lds + (bf) * SHM_V + vst0) = S.st_v0; *(bf16x8*)(V_lds + (bf) * SHM_V + vst1) = S.st_v1; } while (0)
#define SWRITE_H(bf) do { SWRITE_HV(bf); SWRITE_HK(bf); } while (0)
#define SLOAD_F(p, k0) do { S.sf0 = *(const f32x4*)ROW(p, k0, sr); S.sf1 = *(const f32x4*)(ROW(p, k0, sr) + 4);                \
                            S.sf2 = *(const f32x4*)ROW(p, k0, 32 + sr); S.sf3 = *(const f32x4*)(ROW(p, k0, 32 + sr) + 4); } while (0)
#define SWRITE_KF(bf) do { *(bf16x8*)(K_lds + (bf) * SHM_K + kws) = pack8(S.sf0, S.sf1); *(bf16x8*)(K_lds + (bf) * SHM_K + kws + 32 * 256) = pack8(S.sf2, S.sf3); } while (0)
#define SWRITE_VF(bf) do { *(bf16x8*)(V_lds + (bf) * SHM_V + vst0) = pack8(S.sf0, S.sf1); *(bf16x8*)(V_lds + (bf) * SHM_V + vst1) = pack8(S.sf2, S.sf3); } while (0)
template <class TIn, class TOut>
__device__ __forceinline__ void causal_swa_prime(const BlockRef<TIn, TOut>& cur, int W, char* lds, Seam<TIn>& S, int wv) {
    constexpr bool F32 = same_t<TIn, float>::v;
    int tid0_ = threadIdx.x; asm volatile("" : "+v"(tid0_)); (void)wv;
    const int tid = tid0_, wid = __builtin_amdgcn_readfirstlane(tid >> 6), lane = tid & 63, r32 = lane & 31, hi = lane >> 5;
    const int sr = tid >> 4, sc = (tid & 15) * 8, kws = KSWZ(sr, sc * 2); char* K_lds = lds + 2 * SHM_V;
    const int kb0 = swa_jlo(cur.P0, W) * KVBLK;
    for (int d0 = 0; d0 < 8; ++d0) S.qr[d0] = load8<TIn>(cur.Q + (size_t)(wid * QBLK + r32) * QST + d0 * 16 + hi * 8);
    if constexpr (F32) { SLOAD_F((const float*)cur.K, kb0); VMW(); SWRITE_KF(0); SBAR(); SLOAD_F((const float*)cur.V, kb0); }
    else { SLOAD_H(cur.K, cur.V, kb0); VMW(); SWRITE_HK(0); }
    __syncthreads();
}
template <class TIn, class TOut, int VAR = 0>
__device__ __forceinline__ void causal_swa_block(const BlockRef<TIn, TOut>& cur, const BlockRef<TIn, TOut>& nxt, int skv, int W, char* lds, Seam<TIn>& S, int wv) {
    constexpr bool F32 = same_t<TIn, float>::v;
    int tid0_ = threadIdx.x; asm volatile("" : "+v"(tid0_)); (void)wv;
    const int tid = tid0_, wid = __builtin_amdgcn_readfirstlane(tid >> 6), lane = tid & 63, r32 = lane & 31, hi = lane >> 5;
    const int j_lo = swa_jlo(cur.P0, W);
    int j_hi = (cur.P0 + QB - 1) / KVBLK + 1; if (j_hi > skv / KVBLK) j_hi = skv / KVBLK;
    const int NT = j_hi - j_lo;
    const int kbn = swa_jlo(nxt.P0, W) * KVBLK;
    const int qlo = cur.P0 + wid * QBLK; (void)qlo;
    const unsigned long long* mrow = cur.M + (size_t)(wid * QBLK + r32) * MTW;
    const int qm_unused = 0; (void)qm_unused;
    char* V_lds = lds; char* K_lds = lds + 2 * SHM_V;
    float* ws = (float*)(lds + 2 * SHM_V + 2 * SHM_K) + wid * 64; float* li_l = ws, * al_l = ws + 32;
    float m_reg = -1e30f, l_reg = 0; f32x16 o[4] = {};
    const int sr = tid >> 4, sc = (tid & 15) * 8, vst0 = v_st(sr, sc), vst1 = v_st(32 + sr, sc), kws = KSWZ(sr, sc * 2);
    const int vb0 = (int)(uintptr_t)V_lds + v_rd_base(lane);
    const TIn* Kh = cur.K; const TIn* Vh = cur.V;
#define RESC(a) do { if (__any((a) < 1.f)) { if (hi == 0) al_l[r32] = (a); asm volatile("s_waitcnt lgkmcnt(0)" ::: "memory");              \
                     for (int d_ = 0; d_ < 4; ++d_) for (int r = 0; r < 16; ++r) o[d_][r] *= al_l[crow(r, hi)]; } } while (0)
#define KBASE(t) ((j_lo + (t)) * KVBLK)
#define ACT(t) (KBASE(t) <= qlo + QBLK - 1 && KBASE(t) + KVBLK - 1 >= qlo - W + 1)
#define MASKT(P0_, P1_, t) do { if constexpr (VAR == 3) mask_bits(P0_, P1_, (((t) & 1) ? mwB : mwA), hi); else if constexpr (VAR == 2) { unsigned long long m_ = (((t) & 1) ? mwB : mwA); asm volatile("" :: "v"(m_)); } } while (0)
#define MWLOAD(t) do { const int tt_ = (t) < NT ? (t) : NT - 1; if ((t) & 1) mwB = mrow[j_lo + tt_]; else mwA = mrow[j_lo + tt_]; } while (0)
    constexpr int NQL = F32 ? 16 : 8;
    constexpr bool BI = (VAR == 0);
    constexpr bool SK = WSKIP && !F32;
#define SEAM_K0() do { VMWN(NQL); if constexpr (F32) { SWRITE_KF(0); SBAR(); SLOAD_F((const float*)nxt.V, kbn); } else { SWRITE_HK(0); } SBAR(); } while (0)
    f32x16 pA0, pA1, pB0, pB1; float mnA, mnB, alA, alB; bf16x8 pa0, pa1, pa2, pa3;
    unsigned long long mwA = mrow[j_lo], mwB = mrow[j_lo + (NT > 1 ? 1 : 0)];
    if constexpr (F32) { VMW(); SWRITE_VF(0); SBAR(); } else { SWRITE_HV(0); SBAR(); }
    if (NT > 1) { if constexpr (F32) SLOAD_F((const float*)Kh, KBASE(1)); else SLOAD_H(Kh, Vh, KBASE(1)); }
    if constexpr (BI) { mask_bias(pA0, pA1, mwA, hi); MWLOAD(2); }
    SBAR(); qkt<0, SK, BI>(pA0, pA1, K_lds, r32, hi, S.qr, ACT(0));
    if constexpr (BI) mask_bias(pB0, pB1, mwB, hi);
    if constexpr (F32) { if (NT > 1) { VMW(); SWRITE_KF(1); SBAR(); SLOAD_F((const float*)Vh, KBASE(1)); } }
    MASKT(pA0, pA1, 0); partialSM(pA0, pA1, m_reg, mnA, alA);
    if (NT > 1) { VMW(); if constexpr (F32) { SWRITE_VF(1); SBAR(); if (NT > 2) SLOAD_F((const float*)Kh, KBASE(2)); } else SWRITE_H(1); }
    __syncthreads();
#define HALF_STEP(PX0, PX1, mnX, alX, PY0, PY1, alY, t, KB, VB, SB) do {                                                      \
        if constexpr (BI) MWLOAD((t) + 2); else MWLOAD((t) + 1);                                                          \
        SBAR(); qkt<KB, SK, BI>(PX0, PX1, K_lds, r32, hi, S.qr, ACT(t));                                                  \
        finishSM(PY0, PY1, alY, l_reg, pa0, pa1, pa2, pa3); SBAR();                                                           \
        if ((t) + 1 < NT) { if constexpr (F32) { VMW(); SWRITE_KF(SB); SBAR(); SLOAD_F((const float*)Vh, KBASE((t) + 1)); }  \
                            else { SLOAD_H(Kh, Vh, KBASE((t) + 1)); } SBAR(); }                                               \
        { const unsigned long long mwn_ = (((t) + 1) & 1) ? mwB : mwA; const unsigned nlo_ = ~(unsigned)(mwn_ >> (4 * hi)), nup_ = ~(unsigned)(mwn_ >> (32 + 4 * hi));   \
          pv_tile<VB, SK, BI>(o, vb0, pa0, pa1, pa2, pa3, ACT((t) - 1), &PY0, &PY1, nlo_, nup_); }                           \
        MASKT(PX0, PX1, (t)); partialSM(PX0, PX1, m_reg, mnX, alX);                                        \
        __syncthreads();                                                                                                      \
        if ((t) + 1 < NT) { VMW(); if constexpr (F32) { SWRITE_VF(SB); SBAR(); if ((t) + 2 < NT) SLOAD_F((const float*)Kh, KBASE((t) + 2)); } \
                            else { SWRITE_H(SB); } }                                                                          \
        RESC(alX); __syncthreads(); } while (0)
    for (int t = 1; t + 1 < NT; t += 2) {
        HALF_STEP(pB0, pB1, mnB, alB, pA0, pA1, alA, t, 1, 0, 0);
        HALF_STEP(pA0, pA1, mnA, alA, pB0, pB1, alB, t + 1, 0, 1, 1);
    }
    const bool even = (NT & 1) == 0;
    if (even) { SBAR(); qkt<1, SK, BI>(pB0, pB1, K_lds, r32, hi, S.qr, ACT(NT - 1)); SBAR(); }
#define QROW(e) (nxt.Q + (size_t)(wid * QBLK + r32) * QST + ((e) >> 1) * 16 + hi * 8 + ((e) & 1) * 4)
    if constexpr (F32) { SLOAD_F((const float*)nxt.K, kbn); SBAR();
#pragma unroll
        for (int e = 0; e < 8; ++e) S.tq[e] = *(const f32x4*)QROW(e); }
    else { SLOAD_H(nxt.K, nxt.V, kbn); SBAR();
#pragma unroll
        for (int d0 = 0; d0 < 8; ++d0) S.qr[d0] = load8<TIn>(nxt.Q + (size_t)(wid * QBLK + r32) * QST + d0 * 16 + hi * 8); }
    SBAR();
    finishSM(pA0, pA1, alA, l_reg, pa0, pa1, pa2, pa3); SBAR();
    if constexpr (F32) {
#pragma unroll
        for (int e = 8; e < 16; ++e) S.tq[e] = *(const f32x4*)QROW(e); SBAR(); }
#undef QROW
    pv_tile<0, SK>(o, vb0, pa0, pa1, pa2, pa3, ACT(even ? NT - 2 : NT - 1));
    if (even) { MASKT(pB0, pB1, NT - 1); partialSM(pB0, pB1, m_reg, mnB, alB); __syncthreads(); RESC(alB);
        finishSM(pB0, pB1, alB, l_reg, pa0, pa1, pa2, pa3); SBAR(); pv_tile<1, SK>(o, vb0, pa0, pa1, pa2, pa3, ACT(NT - 1)); }
    SBAR(); SEAM_K0();
    if (hi == 0) li_l[r32] = l_reg; asm volatile("s_waitcnt lgkmcnt(0)" ::: "memory");
    float rli[16];
#pragma unroll
    for (int r = 0; r < 16; ++r) rli[r] = __builtin_amdgcn_rcpf(li_l[crow(r, hi)]);
    TOut* Ow = cur.O + (size_t)(wid * QBLK) * OST;
#pragma unroll
    for (int r = 0; r < 16; ++r) { const int orow = crow(r, hi);
#pragma unroll
        for (int d0 = 0; d0 < 4; ++d0) { const float v = o[d0][r] * rli[r];
            if constexpr (same_t<TOut, float>::v) { Ow[(size_t)orow * OST + d0 * 32 + r32] = v; }
            else { const float vn = __shfl_xor(v, 1);
                   if ((r32 & 1) == 0) *(unsigned*)(Ow + (size_t)orow * OST + d0 * 32 + r32) = cvtpk(v, vn); } } }
    if constexpr (F32) {
#pragma unroll
        for (int d0 = 0; d0 < 8; ++d0) S.qr[d0] = pack8(S.tq[2 * d0], S.tq[2 * d0 + 1]); }
    __syncthreads();
#undef RESC
#undef KBASE
#undef ACT
#undef MASKT
#undef MWLOAD
#undef SEAM_K0
#undef HALF_STEP
}
#undef ROW
#undef VMW
#undef VMWN
#undef SLOAD_H
#undef SWRITE_HK
#undef SWRITE_HV
#undef SWRITE_H
#undef SLOAD_F
#undef SWRITE_KF
#undef SWRITE_VF

}

constexpr int NWAVES = 8, NTHREADS = 512;
constexpr int DM = 2048, SEQ = 4096, NMETA = 16, TP = 4112, NBP = 2, SBN = 8, PAST = 16384, NPG = 128;
constexpr int XROW0 = 8192, SROW0 = 8224, NROWS = 8232, MPAD = 8448, FF = 8192, MAINM = 8192, XR = 48;
constexpr int NA_IN = 6144, NB_IN = 4176, NB_PAD = 4352, NC_IN = 12352, NC_PAD = 12544, DVW = 4096, CDIM = 8192;
constexpr float ALPHA = 1.6817928305074292f;
constexpr float LN_EPS = 1e-5f, RMS_EPS = 1e-6f;
constexpr int SCW = 4160, SCSW = 16448, KIROWS = 4128, NSKEY = PAST + 1;
constexpr int POS_SAMPLE_IDX = TP;

constexpr size_t O_YP = 0, O_YS = O_YP + (size_t)NBP * SEQ * DM, O_CAP = O_YS + (size_t)SBN * DM, O_CAS = O_CAP + 2 * NBP * 2 * DM,
                 O_KP = O_CAS + 2 * SBN * 2 * DM, O_VP = O_KP + (size_t)NBP * TP * 512, O_IKP = O_VP + (size_t)NBP * TP * 512,
                 O_KS = O_IKP + (size_t)NBP * TP * 64, O_VS = O_KS + SBN * 512, O_IKS = O_VS + SBN * 512, O_CCP = O_IKS + SBN * 64,
                 O_CCS = O_CCP + (size_t)NBP * 3 * CDIM, O_DP = O_CCS + (size_t)SBN * 3 * CDIM, O_DS = O_DP + (size_t)NBP * 32 * 128 * 128,
                 O_END = O_DS + (size_t)SBN * 32 * 128 * 128;

constexpr size_t MiB = 1u << 20;
constexpr size_t WS_CTL = 0, CTL_ZERO_BYTES = 1 * MiB;
constexpr size_t WS_TAB128 = 1 * MiB, WS_TAB64 = 4 * MiB, WS_WI = 6 * MiB, WS_G = 7 * MiB, WS_BETA = 9 * MiB, WS_CNT = 11 * MiB, WS_KIB = 12 * MiB,
                 WS_SCS = 14 * MiB, WS_IDXL = 16 * MiB, WS_X = 26 * MiB, WS_QR = 60 * MiB, WS_QI = 94 * MiB, WS_Z = 112 * MiB, WS_Y = 180 * MiB,
                 WS_BIG = 248 * MiB, WS_QKVC = 452 * MiB, WS_SC = 584 * MiB, WS_W = 716 * MiB;
constexpr size_t WSZ_A_IN = (size_t)NA_IN * DM * 2, WSZ_A_OUT = (size_t)DM * DM * 2, WSZ_B_IN = (size_t)NB_PAD * DM * 2, WSZ_B_OUT = (size_t)DM * DM * 2,
                 WSZ_C_IN = (size_t)NC_PAD * DM * 2, WSZ_C_OUT = (size_t)DM * DVW * 2, WSZ_W1 = (size_t)FF * DM * 2, WSZ_W2 = (size_t)DM * FF * 2;
constexpr size_t WS_WA_IN = WS_W, WS_WA_OUT = WS_WA_IN + 2 * WSZ_A_IN, WS_WB_IN = WS_WA_OUT + 2 * WSZ_A_OUT, WS_WB_OUT = WS_WB_IN + WSZ_B_IN,
                 WS_WC_IN = WS_WB_OUT + WSZ_B_OUT, WS_WC_OUT = WS_WC_IN + WSZ_C_IN, WS_W1 = WS_WC_OUT + WSZ_C_OUT, WS_W2 = WS_W1 + 4 * WSZ_W1,
                 WS_ZP = WS_W2 + 4 * WSZ_W2, WS_QKF = WS_ZP + 4 * MiB, WS_DWG = WS_QKF + 130 * MiB, WS_DUG = WS_DWG + 66 * MiB, WS_END = WS_DUG + 66 * MiB;
constexpr size_t WS_MASK = WS_IDXL, WS_KS = WS_Z, WS_VS = WS_Z + 9 * MiB;
constexpr size_t WS_DAF = WS_Z, WS_DTG = WS_Y, WS_DTB = WS_Y + 33 * MiB, WS_DPG = WS_QR, WS_DKT = WS_QKF, WS_DVT = WS_QKF + 33 * MiB, WS_DGC = WS_QI, WS_DBT = WS_QI + 2 * MiB;
constexpr int SP = 4352, SPAD = 240, MTW = 68;
constexpr int CW_BAR = 4096;

constexpr int RING_BYTES = 131072, LDSCTL_OFF = RING_BYTES, MISC_OFF = LDSCTL_OFF + 320, LDS_BYTES = 147456;

typedef unsigned short bf16;
typedef unsigned v4u __attribute__((ext_vector_type(4)));
typedef unsigned v2u __attribute__((ext_vector_type(2)));
typedef float f32x4 __attribute__((ext_vector_type(4)));
typedef float f32x2 __attribute__((ext_vector_type(2)));
typedef short bf16x8 __attribute__((ext_vector_type(8)));
typedef float f32x16 __attribute__((ext_vector_type(16)));
typedef __bf16 bf16x2_t __attribute__((ext_vector_type(2)));

#define LDS_WAIT() asm volatile("s_waitcnt lgkmcnt(0)" ::: "memory")
#define WAVE_SYNC() do { asm volatile("s_waitcnt lgkmcnt(0)" ::: "memory"); __builtin_amdgcn_wave_barrier(); } while (0)

__device__ __forceinline__ float bflo(unsigned w) { return __uint_as_float(w << 16); }
__device__ __forceinline__ float bfhi(unsigned w) { return __uint_as_float(w & 0xffff0000u); }
__device__ __forceinline__ float bf2f(bf16 h) { return __uint_as_float((unsigned)h << 16); }
__device__ __forceinline__ unsigned pk2(float lo, float hi) { f32x2 v = {lo, hi}; bf16x2_t b = __builtin_convertvector(v, bf16x2_t); return __builtin_bit_cast(unsigned, b); }
__device__ __forceinline__ bf16 f2bf(float f) { return (bf16)(pk2(f, 0.f) & 0xffffu); }
__device__ __forceinline__ float wave_sum(float v) {
#pragma unroll
    for (int o = 1; o < 64; o <<= 1) v += __shfl_xor(v, o);
    return v;
}
__device__ __forceinline__ float wave_max(float v) {
#pragma unroll
    for (int o = 1; o < 64; o <<= 1) v = fmaxf(v, __shfl_xor(v, o));
    return v;
}
__device__ __forceinline__ int wave_sum_i(int v) {
#pragma unroll
    for (int o = 1; o < 64; o <<= 1) v += __shfl_xor(v, o);
    return v;
}
__device__ __forceinline__ float wave_sum_dpp(float v) {
    v += __int_as_float(__builtin_amdgcn_update_dpp(0, __float_as_int(v), 0x128, 0xf, 0xf, false));
    v += __int_as_float(__builtin_amdgcn_update_dpp(0, __float_as_int(v), 0x124, 0xf, 0xf, false));
    v += __int_as_float(__builtin_amdgcn_update_dpp(0, __float_as_int(v), 0x122, 0xf, 0xf, false));
    v += __int_as_float(__builtin_amdgcn_update_dpp(0, __float_as_int(v), 0x121, 0xf, 0xf, false));
    const int iv = __float_as_int(v);
    return (__int_as_float(__builtin_amdgcn_readlane(iv, 0)) + __int_as_float(__builtin_amdgcn_readlane(iv, 16))) + (__int_as_float(__builtin_amdgcn_readlane(iv, 32)) + __int_as_float(__builtin_amdgcn_readlane(iv, 48)));
}
__device__ __forceinline__ int wave_sum_dpp_i(int v) {
    v += __builtin_amdgcn_update_dpp(0, v, 0x128, 0xf, 0xf, false);
    v += __builtin_amdgcn_update_dpp(0, v, 0x124, 0xf, 0xf, false);
    v += __builtin_amdgcn_update_dpp(0, v, 0x122, 0xf, 0xf, false);
    v += __builtin_amdgcn_update_dpp(0, v, 0x121, 0xf, 0xf, false);
    return __builtin_amdgcn_readlane(v, 0) + __builtin_amdgcn_readlane(v, 16) + __builtin_amdgcn_readlane(v, 32) + __builtin_amdgcn_readlane(v, 48);
}
__device__ __forceinline__ float row16_sum(float v) {
    v += __int_as_float(__builtin_amdgcn_update_dpp(0, __float_as_int(v), 0x128, 0xf, 0xf, false));
    v += __int_as_float(__builtin_amdgcn_update_dpp(0, __float_as_int(v), 0x124, 0xf, 0xf, false));
    v += __int_as_float(__builtin_amdgcn_update_dpp(0, __float_as_int(v), 0x122, 0xf, 0xf, false));
    v += __int_as_float(__builtin_amdgcn_update_dpp(0, __float_as_int(v), 0x121, 0xf, 0xf, false));
    return v;
}
__device__ __forceinline__ float silu_f(float x) { return x / (1.f + __expf(-x)); }
__device__ __forceinline__ int prow(int b, int t) { return t >= NMETA ? b * SEQ + (t - NMETA) : XROW0 + b * NMETA + t; }
__device__ __forceinline__ void row_bt(int r, int& b, int& t) { if (r < XROW0) { b = r >> 12; t = (r & 4095) + NMETA; } else { b = (r - XROW0) >> 4; t = (r - XROW0) & 15; } }
__device__ __forceinline__ void unpack8(const v4u w, float (&f)[8]) {
    f[0] = bflo(w.x); f[1] = bfhi(w.x); f[2] = bflo(w.y); f[3] = bfhi(w.y); f[4] = bflo(w.z); f[5] = bfhi(w.z); f[6] = bflo(w.w); f[7] = bfhi(w.w);
}
__device__ __forceinline__ v4u pack8(const float (&f)[8]) { v4u w; w.x = pk2(f[0], f[1]); w.y = pk2(f[2], f[3]); w.z = pk2(f[4], f[5]); w.w = pk2(f[6], f[7]); return w; }

struct TrJob { bf16* WT; int K, k0, n0; bool ok, valid; };
__device__ __forceinline__ void tr_issue(const float* W, int K, int N, int Npad, bf16* WT, int item, int lane, float (&wv_)[32], TrJob& J) {
    const int nblk = Npad / 32, kb = item / nblk, nb = item % nblk, k0 = 64 * kb, n0 = 32 * nb;
    const int n = n0 + (lane & 31); const bool ok = n < N;
#pragma unroll
    for (int i = 0; i < 32; ++i) { const int kk = 2 * i + (lane >> 5); wv_[i] = W[(size_t)(k0 + kk) * N + (ok ? n : N - 1)]; }
    J.WT = WT; J.K = K; J.k0 = k0; J.n0 = n0; J.ok = ok; J.valid = true;
}
__device__ __forceinline__ void tr_finish(const float (&wv_)[32], const TrJob& J, LAS float* scr, int lane) {
#pragma unroll
    for (int i = 0; i < 32; ++i) { const int kk = 2 * i + (lane >> 5); scr[kk * 33 + (lane & 31)] = J.ok ? wv_[i] : 0.f; }
    LDS_WAIT(); __builtin_amdgcn_wave_barrier();
    const int c = lane & 7;
#pragma unroll
    for (int j = 0; j < 4; ++j) { const int nn = (lane >> 3) + 8 * j; const LAS float* sp = scr + (8 * c) * 33 + nn;
        v4u o; o.x = pk2(sp[0 * 33], sp[1 * 33]); o.y = pk2(sp[2 * 33], sp[3 * 33]); o.z = pk2(sp[4 * 33], sp[5 * 33]); o.w = pk2(sp[6 * 33], sp[7 * 33]);
        *(v4u*)(J.WT + (size_t)(J.n0 + nn) * J.K + J.k0 + 8 * c) = o; }
    LDS_WAIT(); __builtin_amdgcn_wave_barrier();
}
__device__ __forceinline__ void transpose_item(const float* W, int K, int N, int Npad, bf16* WT, LAS float* scr, int item, int lane) {
    float wv_[32]; TrJob J; tr_issue(W, K, N, Npad, WT, item, lane, wv_, J); tr_finish(wv_, J, scr, lane);
}

struct Ptrs {
    const float *x_prompt, *x_sample, *state_conv_a, *cache_k, *cache_v, *cache_ik, *state_conv_c, *state_delta;
    const int* page_table;
    const float *meta, *w_in_a, *conv_w_a, *w_out_a, *w_in_b, *w_out_b, *w_in_c, *conv_w_c, *a_log, *dt_bias, *norm_w, *w_out_c, *ln1_g, *ln1_b, *w1, *w2, *ln2_g, *ln2_b;
    float* out; unsigned char* ws;
};

__device__ __forceinline__ void p0_prologue(const Ptrs& P, LAS unsigned char* lds, int gw, int NGW, int wave, int lane) {
    LAS float* scr = (LAS float*)(lds + wave * 16384);
    unsigned char* ws = P.ws;
    constexpr int I_A_IN = (DM / 64) * (NA_IN / 32), I_A_OUT = (DM / 64) * (DM / 32), I_B_IN = (DM / 64) * (NB_PAD / 32), I_B_OUT = I_A_OUT,
                  I_C_IN = (DM / 64) * (NC_PAD / 32), I_C_OUT = (DVW / 64) * (DM / 32), I_W1 = (DM / 64) * (FF / 32), I_W2 = (FF / 64) * (DM / 32);
    constexpr int NITEMS = I_A_IN + I_A_OUT + I_B_IN + I_W1 + I_W2;
#define TR_(cnt, Wp, Kk, Nn, Np, WTp) if (r < (cnt)) { transpose_item((Wp), (Kk), (Nn), (Np), (bf16*)(WTp), scr, r, lane); continue; } r -= (cnt);
    for (int it = gw; it < NITEMS; it += NGW) {
        int r = it;
        TR_(I_A_IN, P.w_in_a, DM, NA_IN, NA_IN, ws + WS_WA_IN)
        TR_(I_A_OUT, P.w_out_a, DM, DM, DM, ws + WS_WA_OUT)
        TR_(I_B_IN, P.w_in_b, DM, NB_IN, NB_PAD, ws + WS_WB_IN)
        TR_(I_W1, P.w1, DM, FF, FF, ws + WS_W1)
        transpose_item(P.w2, FF, DM, DM, (bf16*)(ws + WS_W2), scr, r, lane);
    }
#undef TR_
    bf16* X = (bf16*)(ws + WS_X);
    for (int r = gw; r < MPAD; r += NGW) {
        const float* src = nullptr;
        if (r < XROW0) src = P.x_prompt + (size_t)r * DM;
        else if (r < SROW0) src = P.meta + (size_t)((r - XROW0) & 15) * DM;
        else if (r < NROWS) src = P.x_sample + (size_t)(r - SROW0) * DM;
#pragma unroll
        for (int j = 0; j < 4; ++j) { const int c = 512 * j + 8 * lane; v4u o = {0u, 0u, 0u, 0u};
            if (src) { const f32x4 a = *(const f32x4*)(src + c), b = *(const f32x4*)(src + c + 4); o.x = pk2(a.x, a.y); o.y = pk2(a.z, a.w); o.z = pk2(b.x, b.y); o.w = pk2(b.z, b.w); }
            *(v4u*)(X + (size_t)r * DM + c) = o; }
    }
    f32x2* t128 = (f32x2*)(ws + WS_TAB128); f32x2* t64 = (f32x2*)(ws + WS_TAB64);
    const int gt = gw * 64 + lane, NGT = NGW * 64;
    for (int e = gt; e < (TP + 1) * 96; e += NGT) {
        const int pi = e / 96, i = e % 96; const float pos = (float)(pi == TP ? PAST : pi);
        const float ex = (i < 64) ? (float)(2 * i) * (1.f / 128.f) : (float)(2 * (i - 64)) * (1.f / 64.f);
        const float inv = __builtin_amdgcn_exp2f(-ex * 13.287712379549449f);
        const float angf = pos * inv;
        double rev = (double)angf * 0.15915494309189535; rev -= __builtin_rint(rev);
        const float rf = (float)rev; const float sn = __builtin_amdgcn_sinf(rf), cs = __builtin_amdgcn_cosf(rf);
        if (i < 64) t128[pi * 64 + i] = (f32x2){cs, sn}; else t64[pi * 32 + (i - 64)] = (f32x2){cs, sn};
    }
}

constexpr int NHOSTED = (DM / 64) * (DM / 32) + (DM / 64) * (FF / 32) + (FF / 64) * (DM / 32) + (DM / 64) * (NC_PAD / 32);
__device__ __forceinline__ void hosted_issue(const Ptrs& P, int it, int lane, float (&wv_)[32], TrJob& J) {
    unsigned char* ws = P.ws;
    constexpr int I_B_OUT = (DM / 64) * (DM / 32), I_C_IN = (DM / 64) * (NC_PAD / 32), I_W1 = (DM / 64) * (FF / 32), I_W2 = (FF / 64) * (DM / 32);
    J.valid = false;
    if (it >= NHOSTED) return;
    int r = it;
    if (r < I_B_OUT) { tr_issue(P.w_out_b, DM, DM, DM, (bf16*)(ws + WS_WB_OUT), r, lane, wv_, J); return; } r -= I_B_OUT;
    if (r < I_W1) { tr_issue(P.w1 + (size_t)DM * FF, DM, FF, FF, (bf16*)(ws + WS_W1 + WSZ_W1), r, lane, wv_, J); return; } r -= I_W1;
    if (r < I_W2) { tr_issue(P.w2 + (size_t)DM * FF, FF, DM, DM, (bf16*)(ws + WS_W2 + WSZ_W2), r, lane, wv_, J); return; } r -= I_W2;
    (void)I_C_IN; tr_issue(P.w_in_c, DM, NC_IN, NC_PAD, (bf16*)(ws + WS_WC_IN), r, lane, wv_, J);
}
__device__ __forceinline__ void deferred_transposes(const Ptrs& P, LAS unsigned char* lds, int idx, int stride, int wave, int lane) {
    LAS float* scr = (LAS float*)(lds + wave * 16384);
    unsigned char* ws = P.ws;
    constexpr int I_A_IN = (DM / 64) * (NA_IN / 32), I_A_OUT = (DM / 64) * (DM / 32), I_C_OUT = (DVW / 64) * (DM / 32), I_W1 = (DM / 64) * (FF / 32), I_W2 = (FF / 64) * (DM / 32);
    constexpr int NITEMS = I_A_IN + I_A_OUT + I_C_OUT + 2 * I_W1 + 2 * I_W2;
#define TR_(cnt, Wp, Kk, Nn, Np, WTp) if (r < (cnt)) { transpose_item((Wp), (Kk), (Nn), (Np), (bf16*)(WTp), scr, r, lane); continue; } r -= (cnt);
    for (int it = idx; it < NITEMS; it += stride) {
        int r = it;
        TR_(I_C_OUT, P.w_out_c, DVW, DM, DM, ws + WS_WC_OUT)
        TR_(I_W1, P.w1 + 2 * (size_t)DM * FF, DM, FF, FF, ws + WS_W1 + 2 * WSZ_W1)
        TR_(I_W2, P.w2 + 2 * (size_t)DM * FF, FF, DM, DM, ws + WS_W2 + 2 * WSZ_W2)
        TR_(I_A_IN, P.w_in_a + (size_t)DM * NA_IN, DM, NA_IN, NA_IN, ws + WS_WA_IN + WSZ_A_IN)
        TR_(I_A_OUT, P.w_out_a + (size_t)DM * DM, DM, DM, DM, ws + WS_WA_OUT + WSZ_A_OUT)
        TR_(I_W1, P.w1 + 3 * (size_t)DM * FF, DM, FF, FF, ws + WS_W1 + 3 * WSZ_W1)
        transpose_item(P.w2 + 3 * (size_t)DM * FF, FF, DM, DM, (bf16*)(ws + WS_W2 + 3 * WSZ_W2), scr, r, lane);
    }
#undef TR_
}

__device__ __forceinline__ void ln_row_finish(float (&v)[32], float s, const f32x4 (&gq)[8], const f32x4 (&bq_)[8], bf16* xo, float* of, int lane) {
    const float mean = wave_sum_dpp(s) * (1.f / DM); float s2 = 0.f;
#pragma unroll
    for (int i = 0; i < 32; ++i) { v[i] -= mean; s2 += v[i] * v[i]; }
    const float rstd = 1.f / sqrtf(wave_sum_dpp(s2) * (1.f / DM) + LN_EPS);
#pragma unroll
    for (int j = 0; j < 4; ++j) { const int c = 512 * j + 8 * lane; const f32x4 g0 = gq[2 * j], g1 = gq[2 * j + 1], b0 = bq_[2 * j], b1 = bq_[2 * j + 1];
        float o[8];
        o[0] = v[8 * j + 0] * rstd * g0.x + b0.x; o[1] = v[8 * j + 1] * rstd * g0.y + b0.y; o[2] = v[8 * j + 2] * rstd * g0.z + b0.z; o[3] = v[8 * j + 3] * rstd * g0.w + b0.w;
        o[4] = v[8 * j + 4] * rstd * g1.x + b1.x; o[5] = v[8 * j + 5] * rstd * g1.y + b1.y; o[6] = v[8 * j + 6] * rstd * g1.z + b1.z; o[7] = v[8 * j + 7] * rstd * g1.w + b1.w;
        *(v4u*)(xo + c) = pack8(o);
        if (of) { *(f32x4*)(of + c) = (f32x4){o[0], o[1], o[2], o[3]}; *(f32x4*)(of + c + 4) = (f32x4){o[4], o[5], o[6], o[7]}; } }
}
__device__ __forceinline__ void ln_phase(const float* Z, const float* ZP, bf16* X, bf16* Xo, const float* gam, const float* bet, float* yp, float* ys, LAS unsigned char* lds, int gw, int NGW, int tid, int wave, int lane) {
    (void)Z;
    LAS float* red = (LAS float*)lds;
    for (int xr = blockIdx.x; xr < NROWS - XROW0; xr += gridDim.x) {
        const int r = XROW0 + xr, c = 256 * wave + 4 * lane;
        const v2u xv = *(const v2u*)(X + (size_t)r * DM + c);
        const float* zr = ZP + (size_t)xr * DM + c; f32x4 z = *(const f32x4*)zr;
#pragma unroll
        for (int sl = 1; sl < 8; ++sl) z += *(const f32x4*)(zr + (size_t)sl * XR * DM);
        float v4[4] = {ALPHA * bflo(xv.x) + z.x, ALPHA * bfhi(xv.x) + z.y, ALPHA * bflo(xv.y) + z.z, ALPHA * bfhi(xv.y) + z.w};
        const float ps = wave_sum_dpp((v4[0] + v4[1]) + (v4[2] + v4[3]));
        __syncthreads();
        if (lane == 0) red[wave] = ps;
        __syncthreads();
        float tot = 0.f;
#pragma unroll
        for (int w = 0; w < 8; ++w) tot += red[w];
        const float mean = tot * (1.f / DM); float q2 = 0.f;
#pragma unroll
        for (int i = 0; i < 4; ++i) { v4[i] -= mean; q2 += v4[i] * v4[i]; }
        const float pq = wave_sum_dpp(q2);
        if (lane == 0) red[8 + wave] = pq;
        __syncthreads();
        float tq = 0.f;
#pragma unroll
        for (int w = 0; w < 8; ++w) tq += red[8 + w];
        const float rstd = 1.f / sqrtf(tq * (1.f / DM) + LN_EPS);
        const f32x4 g = *(const f32x4*)(gam + c), be = *(const f32x4*)(bet + c);
        const float o0 = v4[0] * rstd * g.x + be.x, o1 = v4[1] * rstd * g.y + be.y, o2 = v4[2] * rstd * g.z + be.z, o3 = v4[3] * rstd * g.w + be.w;
        v2u ov; ov.x = pk2(o0, o1); ov.y = pk2(o2, o3); *(v2u*)(Xo + (size_t)r * DM + c) = ov;
        if (ys && r >= SROW0) *(f32x4*)(ys + (size_t)(r - SROW0) * DM + c) = (f32x4){o0, o1, o2, o3};
    }
    f32x4 gq[8], bq_[8];
#pragma unroll
    for (int j = 0; j < 4; ++j) { const int c = 512 * j + 8 * lane; gq[2 * j] = *(const f32x4*)(gam + c); gq[2 * j + 1] = *(const f32x4*)(gam + c + 4); bq_[2 * j] = *(const f32x4*)(bet + c); bq_[2 * j + 1] = *(const f32x4*)(bet + c + 4); }
    for (int r = gw; r < XROW0; r += 2 * NGW) {
        const int r2 = r + NGW; const bool two = r2 < XROW0;
        v4u xa[4], xb[4];
#pragma unroll
        for (int j = 0; j < 4; ++j) { const int c = 512 * j + 8 * lane; xa[j] = *(const v4u*)(X + (size_t)r * DM + c); xb[j] = *(const v4u*)(X + (size_t)(two ? r2 : r) * DM + c); }
        float va[32], vb[32]; float sa = 0.f, sb = 0.f;
#pragma unroll
        for (int j = 0; j < 4; ++j) { float t8[8]; unpack8(xa[j], t8);
#pragma unroll
            for (int i = 0; i < 8; ++i) { va[8 * j + i] = t8[i]; sa += t8[i]; }
            unpack8(xb[j], t8);
#pragma unroll
            for (int i = 0; i < 8; ++i) { vb[8 * j + i] = t8[i]; sb += t8[i]; } }
        ln_row_finish(va, sa, gq, bq_, Xo + (size_t)r * DM, yp ? yp + (size_t)r * DM : nullptr, lane);
        if (two) ln_row_finish(vb, sb, gq, bq_, Xo + (size_t)r2 * DM, yp ? yp + (size_t)r2 * DM : nullptr, lane);
    }
}

__device__ __forceinline__ void load_u(const bf16* BCH, int row, int c0, float (&u)[8]) {
    const v4u cg = *(const v4u*)(BCH + (size_t)row * NA_IN + DM + c0), hh = *(const v4u*)(BCH + (size_t)row * NA_IN + 2 * DM + c0);
    float a[8], b[8]; unpack8(cg, a); unpack8(hh, b);
#pragma unroll
    for (int i = 0; i < 8; ++i) u[i] = a[i] * b[i];
}
__device__ __forceinline__ void convA_phase(const bf16* BCH, bf16* Y, const float* cw, const float* hist, float* outp, float* outs, int gtid, int NT) {
    constexpr int RUN = 8, NRUN = SEQ / RUN;
    for (int it = gtid; it < (NBP * NRUN + NBP * NMETA + SBN) * 256; it += NT) {
        const int c0 = (it & 255) * 8, ru = it >> 8;
        float w0[8], w1[8], w2[8];
        { const f32x4 a = *(const f32x4*)(cw + c0), b = *(const f32x4*)(cw + c0 + 4); w0[0] = a.x; w0[1] = a.y; w0[2] = a.z; w0[3] = a.w; w0[4] = b.x; w0[5] = b.y; w0[6] = b.z; w0[7] = b.w; }
        { const f32x4 a = *(const f32x4*)(cw + DM + c0), b = *(const f32x4*)(cw + DM + c0 + 4); w1[0] = a.x; w1[1] = a.y; w1[2] = a.z; w1[3] = a.w; w1[4] = b.x; w1[5] = b.y; w1[6] = b.z; w1[7] = b.w; }
        { const f32x4 a = *(const f32x4*)(cw + 2 * DM + c0), b = *(const f32x4*)(cw + 2 * DM + c0 + 4); w2[0] = a.x; w2[1] = a.y; w2[2] = a.z; w2[3] = a.w; w2[4] = b.x; w2[5] = b.y; w2[6] = b.z; w2[7] = b.w; }
        float u0[8], u1[8], u2[8];
        if (ru < NBP * NRUN) {
            const int b = ru / NRUN, t0 = NMETA + (ru % NRUN) * RUN;
            if (t0 >= 1) load_u(BCH, prow(b, t0 - 1), c0, u1); else {
#pragma unroll
                for (int i = 0; i < 8; ++i) u1[i] = 0.f; }
            if (t0 >= 2) load_u(BCH, prow(b, t0 - 2), c0, u0); else {
#pragma unroll
                for (int i = 0; i < 8; ++i) u0[i] = 0.f; }
            const int r0 = prow(b, t0);
            v4u bq[RUN], cq[RUN], hq_[RUN];
#pragma unroll
            for (int k = 0; k < RUN; ++k) { const bf16* rp = BCH + (size_t)(r0 + k) * NA_IN + c0; bq[k] = *(const v4u*)rp; cq[k] = *(const v4u*)(rp + DM); hq_[k] = *(const v4u*)(rp + 2 * DM); }
#pragma unroll
            for (int k = 0; k < RUN; ++k) {
                const int r = r0 + k, t = t0 + k;
                { float ca[8], ha[8]; unpack8(cq[k], ca); unpack8(hq_[k], ha);
#pragma unroll
                  for (int i = 0; i < 8; ++i) u2[i] = ca[i] * ha[i]; }
                float bg[8]; unpack8(bq[k], bg);
                float y[8];
#pragma unroll
                for (int i = 0; i < 8; ++i) y[i] = bg[i] * (w0[i] * u0[i] + w1[i] * u1[i] + w2[i] * u2[i]);
                *(v4u*)(Y + (size_t)r * DM + c0) = pack8(y);
                if (t >= TP - 2) { float* o = outp + ((size_t)(b * 2 + (t - (TP - 2)))) * DM + c0; *(f32x4*)o = (f32x4){u2[0], u2[1], u2[2], u2[3]}; *(f32x4*)(o + 4) = (f32x4){u2[4], u2[5], u2[6], u2[7]}; }
#pragma unroll
                for (int i = 0; i < 8; ++i) { u0[i] = u1[i]; u1[i] = u2[i]; }
            }
        } else if (ru < NBP * NRUN + NBP * NMETA) {
            const int mi = ru - NBP * NRUN, b = mi / NMETA, t = mi % NMETA, r = XROW0 + mi;
            load_u(BCH, r, c0, u2);
            if (t >= 1) load_u(BCH, r - 1, c0, u1); else {
#pragma unroll
                for (int i = 0; i < 8; ++i) u1[i] = 0.f; }
            if (t >= 2) load_u(BCH, r - 2, c0, u0); else {
#pragma unroll
                for (int i = 0; i < 8; ++i) u0[i] = 0.f; }
            (void)b;
            float bg[8]; unpack8(*(const v4u*)(BCH + (size_t)r * NA_IN + c0), bg);
            float y[8];
#pragma unroll
            for (int i = 0; i < 8; ++i) y[i] = bg[i] * (w0[i] * u0[i] + w1[i] * u1[i] + w2[i] * u2[i]);
            *(v4u*)(Y + (size_t)r * DM + c0) = pack8(y);
        } else {
            const int sb = ru - NBP * NRUN - NBP * NMETA, r = SROW0 + sb;
            load_u(BCH, r, c0, u2);
            const float* h0 = hist + ((size_t)(sb * 2 + 0)) * DM + c0; const float* h1 = hist + ((size_t)(sb * 2 + 1)) * DM + c0;
            const f32x4 a0 = *(const f32x4*)h0, a1 = *(const f32x4*)(h0 + 4), b0 = *(const f32x4*)h1, b1 = *(const f32x4*)(h1 + 4);
            u0[0] = a0.x; u0[1] = a0.y; u0[2] = a0.z; u0[3] = a0.w; u0[4] = a1.x; u0[5] = a1.y; u0[6] = a1.z; u0[7] = a1.w;
            u1[0] = b0.x; u1[1] = b0.y; u1[2] = b0.z; u1[3] = b0.w; u1[4] = b1.x; u1[5] = b1.y; u1[6] = b1.z; u1[7] = b1.w;
            float* o0 = outs + ((size_t)(sb * 2 + 0)) * DM + c0; float* o1 = outs + ((size_t)(sb * 2 + 1)) * DM + c0;
            *(f32x4*)o0 = b0; *(f32x4*)(o0 + 4) = b1;
            *(f32x4*)o1 = (f32x4){u2[0], u2[1], u2[2], u2[3]}; *(f32x4*)(o1 + 4) = (f32x4){u2[4], u2[5], u2[6], u2[7]};
            float bg[8]; unpack8(*(const v4u*)(BCH + (size_t)r * NA_IN + c0), bg);
            float y[8];
#pragma unroll
            for (int i = 0; i < 8; ++i) y[i] = bg[i] * (w0[i] * u0[i] + w1[i] * u1[i] + w2[i] * u2[i]);
            *(v4u*)(Y + (size_t)r * DM + c0) = pack8(y);
        }
    }
}

constexpr float QSCALE = 0.08838834764831845f;
__device__ __forceinline__ void rope_phase(const bf16* PROJ, const Ptrs& P, int gw, int NGW, int lane) {
    unsigned char* ws = P.ws;
    const f32x2* t128 = (const f32x2*)(ws + WS_TAB128); const f32x2* t64 = (const f32x2*)(ws + WS_TAB64);
    bf16* Qr = (bf16*)(ws + WS_QR); bf16* QI = (bf16*)(ws + WS_QI); bf16* KIb = (bf16*)(ws + WS_KIB); float* WI = (float*)(ws + WS_WI);
    bf16* Ks = (bf16*)(ws + WS_KS); bf16* Vs = (bf16*)(ws + WS_VS);
    for (int pr_ = gw; pr_ < NBP * SPAD; pr_ += NGW) {
        const size_t o = ((size_t)((pr_ / SPAD) * SP + (pr_ % SPAD))) * 512 + 8 * lane; *(v4u*)(Ks + o) = (v4u){0u, 0u, 0u, 0u}; *(v4u*)(Vs + o) = (v4u){0u, 0u, 0u, 0u}; }
    for (int r = gw; r < NROWS; r += NGW) {
        const bf16* pr = PROJ + (size_t)r * NB_PAD;
        int pi; float *ko, *vo, *iko; bf16* kib = nullptr; bf16 *ksq = nullptr, *vsq = nullptr;
        if (r < SROW0) { int b, t; row_bt(r, b, t); pi = t; ksq = Ks + ((size_t)(b * SP + t + SPAD)) * 512; vsq = Vs + ((size_t)(b * SP + t + SPAD)) * 512; ko = P.out + O_KP + ((size_t)(b * TP + t)) * 512; vo = P.out + O_VP + ((size_t)(b * TP + t)) * 512; iko = P.out + O_IKP + ((size_t)(b * TP + t)) * 64; kib = KIb + ((size_t)(b * KIROWS + t)) * 64; }
        else { const int sb = r - SROW0; pi = POS_SAMPLE_IDX; ko = P.out + O_KS + (size_t)sb * 512; vo = P.out + O_VS + (size_t)sb * 512; iko = P.out + O_IKS + (size_t)sb * 64; }
        const f32x2* c128 = t128 + (size_t)pi * 64; const f32x2* c64 = t64 + (size_t)pi * 32;
        const int hd = lane >> 2, sub = lane & 3, hk = hd & 3;
        const v4u q1a = *(const v4u*)(pr + hd * 128 + 16 * sub), q1b = *(const v4u*)(pr + hd * 128 + 16 * sub + 8), q2a = *(const v4u*)(pr + hd * 128 + 64 + 16 * sub), q2b = *(const v4u*)(pr + hd * 128 + 64 + 16 * sub + 8);
        const v4u k1a = *(const v4u*)(pr + 2048 + hk * 128 + 16 * sub), k1b = *(const v4u*)(pr + 2048 + hk * 128 + 16 * sub + 8), k2a = *(const v4u*)(pr + 2048 + hk * 128 + 64 + 16 * sub), k2b = *(const v4u*)(pr + 2048 + hk * 128 + 64 + 16 * sub + 8);
        const v4u vv = *(const v4u*)(pr + 2560 + 8 * lane);
        const v4u i1 = *(const v4u*)(pr + 3072 + hd * 64 + 8 * sub), i2 = *(const v4u*)(pr + 3072 + hd * 64 + 32 + 8 * sub);
        const v4u j1 = *(const v4u*)(pr + 4096 + 8 * sub), j2 = *(const v4u*)(pr + 4096 + 32 + 8 * sub);
        const v4u wq = *(const v4u*)(pr + 4160 + 8 * (lane & 1));
        f32x4 csq[8], csi[4];
#pragma unroll
        for (int i = 0; i < 8; ++i) csq[i] = *(const f32x4*)(c128 + 16 * sub + 2 * i);
#pragma unroll
        for (int i = 0; i < 4; ++i) csi[i] = *(const f32x4*)(c64 + 8 * sub + 2 * i);
        {
            float x1[16], x2[16], o1[16], o2[16];
            { float t8[8]; unpack8(q1a, t8);
#pragma unroll
              for (int i = 0; i < 8; ++i) x1[i] = t8[i]; unpack8(q1b, t8);
#pragma unroll
              for (int i = 0; i < 8; ++i) x1[8 + i] = t8[i]; unpack8(q2a, t8);
#pragma unroll
              for (int i = 0; i < 8; ++i) x2[i] = t8[i]; unpack8(q2b, t8);
#pragma unroll
              for (int i = 0; i < 8; ++i) x2[8 + i] = t8[i]; }
#pragma unroll
            for (int i = 0; i < 16; i += 2) { const f32x4 cs = csq[i >> 1];
                o1[i] = (x1[i] * cs.x - x2[i] * cs.y) * QSCALE; o2[i] = (x2[i] * cs.x + x1[i] * cs.y) * QSCALE;
                o1[i + 1] = (x1[i + 1] * cs.z - x2[i + 1] * cs.w) * QSCALE; o2[i + 1] = (x2[i + 1] * cs.z + x1[i + 1] * cs.w) * QSCALE; }
            bf16* qo = Qr + (size_t)r * DM + hd * 128 + 16 * sub;
            { float t8[8];
#pragma unroll
              for (int i = 0; i < 8; ++i) t8[i] = o1[i]; *(v4u*)qo = pack8(t8);
#pragma unroll
              for (int i = 0; i < 8; ++i) t8[i] = o1[8 + i]; *(v4u*)(qo + 8) = pack8(t8);
#pragma unroll
              for (int i = 0; i < 8; ++i) t8[i] = o2[i]; *(v4u*)(qo + 64) = pack8(t8);
#pragma unroll
              for (int i = 0; i < 8; ++i) t8[i] = o2[8 + i]; *(v4u*)(qo + 72) = pack8(t8); }
        }
        if (lane < 16) {
#pragma unroll
            for (int hf = 0; hf < 2; ++hf) { float x1[8], x2[8], o1[8], o2[8]; unpack8(hf ? k1b : k1a, x1); unpack8(hf ? k2b : k2a, x2);
#pragma unroll
                for (int i = 0; i < 8; i += 2) { const f32x4 cs = csq[4 * hf + (i >> 1)];
                    o1[i] = x1[i] * cs.x - x2[i] * cs.y; o2[i] = x2[i] * cs.x + x1[i] * cs.y; o1[i + 1] = x1[i + 1] * cs.z - x2[i + 1] * cs.w; o2[i + 1] = x2[i + 1] * cs.z + x1[i + 1] * cs.w; }
                float* kq = ko + hk * 128 + 16 * sub + 8 * hf;
                *(f32x4*)kq = (f32x4){o1[0], o1[1], o1[2], o1[3]}; *(f32x4*)(kq + 4) = (f32x4){o1[4], o1[5], o1[6], o1[7]};
                *(f32x4*)(kq + 64) = (f32x4){o2[0], o2[1], o2[2], o2[3]}; *(f32x4*)(kq + 68) = (f32x4){o2[4], o2[5], o2[6], o2[7]};
                if (ksq) { *(v4u*)(ksq + hk * 128 + 16 * sub + 8 * hf) = pack8(o1); *(v4u*)(ksq + hk * 128 + 64 + 16 * sub + 8 * hf) = pack8(o2); } }
        }
        {
            float vf[8]; unpack8(vv, vf);
            *(f32x4*)(vo + 8 * lane) = (f32x4){vf[0], vf[1], vf[2], vf[3]}; *(f32x4*)(vo + 8 * lane + 4) = (f32x4){vf[4], vf[5], vf[6], vf[7]};
            if (vsq) *(v4u*)(vsq + 8 * lane) = vv;
        }
        {
            float x1[8], x2[8], o1[8], o2[8]; unpack8(i1, x1); unpack8(i2, x2);
#pragma unroll
            for (int i = 0; i < 8; i += 2) { const f32x4 cs = csi[i >> 1];
                o1[i] = x1[i] * cs.x - x2[i] * cs.y; o2[i] = x2[i] * cs.x + x1[i] * cs.y; o1[i + 1] = x1[i + 1] * cs.z - x2[i + 1] * cs.w; o2[i + 1] = x2[i + 1] * cs.z + x1[i + 1] * cs.w; }
            *(v4u*)(QI + (size_t)r * 1024 + hd * 64 + 8 * sub) = pack8(o1); *(v4u*)(QI + (size_t)r * 1024 + hd * 64 + 32 + 8 * sub) = pack8(o2);
        }
        if (lane < 4) {
            float x1[8], x2[8], o1[8], o2[8]; unpack8(j1, x1); unpack8(j2, x2);
#pragma unroll
            for (int i = 0; i < 8; i += 2) { const f32x4 cs = csi[i >> 1];
                o1[i] = x1[i] * cs.x - x2[i] * cs.y; o2[i] = x2[i] * cs.x + x1[i] * cs.y; o1[i + 1] = x1[i + 1] * cs.z - x2[i + 1] * cs.w; o2[i + 1] = x2[i + 1] * cs.z + x1[i + 1] * cs.w; }
            float* io = iko + 8 * sub;
            *(f32x4*)io = (f32x4){o1[0], o1[1], o1[2], o1[3]}; *(f32x4*)(io + 4) = (f32x4){o1[4], o1[5], o1[6], o1[7]};
            *(f32x4*)(io + 32) = (f32x4){o2[0], o2[1], o2[2], o2[3]}; *(f32x4*)(io + 36) = (f32x4){o2[4], o2[5], o2[6], o2[7]};
            if (kib) { *(v4u*)(kib + 8 * sub) = pack8(o1); *(v4u*)(kib + 32 + 8 * sub) = pack8(o2); }
        } else if (lane < 6) {
            float wv[8]; unpack8(wq, wv); float* wo = WI + (size_t)r * 16 + 8 * (lane - 4);
            *(f32x4*)wo = (f32x4){wv[0], wv[1], wv[2], wv[3]}; *(f32x4*)(wo + 4) = (f32x4){wv[4], wv[5], wv[6], wv[7]};
        }
    }
}

__device__ __forceinline__ void indexer_prompt(const Ptrs& P, LAS unsigned char* lds, int tid, int wave, int lane) {
    unsigned char* ws = P.ws;
    const bf16* QI = (const bf16*)(ws + WS_QI); const bf16* KIb = (const bf16*)(ws + WS_KIB); const float* WI = (const float*)(ws + WS_WI); float* SC = (float*)(ws + WS_SC);
    const int n = lane & 31, h8 = lane >> 5;
    const int qsel = (n >> 2) & 1, head = (n & 3) + 4 * (n >> 3);
    constexpr int NG = TP / 16;
    constexpr int KROW = 144, TBUF = 128 * KROW;
    LAS float* hscr = (LAS float*)(lds + 40960 + wave * 8448);
    int tit = blockIdx.x * 8 + wave;
    for (int it = blockIdx.x; it < 2 * NG; it += gridDim.x) {
        int b, qg;
        if (it < 256) { b = it & 1; qg = 1 + (it >> 1); } else if (it < 512) { b = it & 1; qg = 256 - ((it - 256) >> 1); } else { b = it - 512; qg = 0; }
        const int t0 = 16 * qg + 2 * wave;
        const bf16* qa = QI + (size_t)prow(b, t0 + qsel) * 1024 + head * 64 + 8 * h8;
        bf16x8 a[4];
#pragma unroll
        for (int kk = 0; kk < 4; ++kk) a[kk] = *(const bf16x8*)(qa + 16 * kk);
        const int tq = t0 + h8;
        const float* wp = WI + (size_t)prow(b, tq) * 16;
        float w[16];
#pragma unroll
        for (int i = 0; i < 4; ++i) { const f32x4 x = *(const f32x4*)(wp + 4 * i); w[4 * i] = x.x; w[4 * i + 1] = x.y; w[4 * i + 2] = x.z; w[4 * i + 3] = x.w; }
        const int ntile = ((16 * qg + 15) >> 5) + 1, ntrip = (ntile + 3) >> 2;
        float* scrow = SC + ((size_t)(b * TP + tq)) * SCW;
        const bf16* kbase = KIb + (size_t)b * KIROWS * 64;
        const int p0 = tid, p1 = tid + 512;
        const int l0 = (p0 >> 3) * KROW + (p0 & 7) * 16, l1 = (p1 >> 3) * KROW + (p1 & 7) * 16;
        asm volatile("s_waitcnt lgkmcnt(0)\n\ts_barrier" ::: "memory");
        v4u g0 = *(const v4u*)(kbase + (size_t)p0 * 8), g1 = *(const v4u*)(kbase + (size_t)p1 * 8);
        *(LAS v4u*)(lds + l0) = g0; *(LAS v4u*)(lds + l1) = g1;
        for (int tr = 0; tr < ntrip; ++tr) {
            const int cur = tr & 1;
            float hv[32]; TrJob HJ; hosted_issue(P, tit, lane, hv, HJ);
            if (tr + 1 < ntrip) { const size_t ko = (size_t)(tr + 1) * 128 * 64;
                const int kmax = KIROWS * 64 - 8;
                const size_t o0 = ko + (size_t)p0 * 8, o1 = ko + (size_t)p1 * 8;
                g0 = *(const v4u*)(kbase + (o0 <= (size_t)kmax ? o0 : (size_t)kmax)); g1 = *(const v4u*)(kbase + (o1 <= (size_t)kmax ? o1 : (size_t)kmax)); }
            asm volatile("s_waitcnt lgkmcnt(0)\n\ts_barrier" ::: "memory");
            const LAS unsigned char* kb = lds + cur * TBUF + n * KROW + h8 * 16;
#pragma unroll
            for (int u = 0; u < 4; ++u) {
                f32x16 acc;
#pragma unroll
                for (int i = 0; i < 16; ++i) acc[i] = 0.f;
#pragma unroll
                for (int kk = 0; kk < 4; ++kk) acc = __builtin_amdgcn_mfma_f32_32x32x16_bf16(a[kk], *(const LAS bf16x8*)(kb + u * 32 * KROW + kk * 32), acc, 0, 0, 0);
                float sc = 0.f;
#pragma unroll
                for (int i = 0; i < 16; ++i) sc += w[i] * fmaxf(acc[i], 0.f);
                const int s = 32 * (4 * tr + u) + n;
                if (s <= tq) scrow[s] = sc;
            }
            if (tr + 1 < ntrip) { *(LAS v4u*)(lds + (cur ^ 1) * TBUF + l0) = g0; *(LAS v4u*)(lds + (cur ^ 1) * TBUF + l1) = g1; }
            if (HJ.valid) { tr_finish(hv, HJ, hscr, lane); tit += gridDim.x * 8; }
        }
    }
    asm volatile("s_waitcnt lgkmcnt(0)\n\ts_barrier" ::: "memory");
    for (; tit < NHOSTED; tit += gridDim.x * 8) { float hv[32]; TrJob HJ; hosted_issue(P, tit, lane, hv, HJ); if (HJ.valid) tr_finish(hv, HJ, hscr, lane); }
}

__device__ __forceinline__ void indexer_sample(const Ptrs& P, LAS unsigned char* lds, int tid) {
    unsigned char* ws = P.ws;
    const bf16* QI = (const bf16*)(ws + WS_QI); const float* WI = (const float*)(ws + WS_WI); float* SCS = (float*)(ws + WS_SCS);
    LAS float* lq = (LAS float*)lds;
    LAS float* lw = lq + 1024;
    constexpr int NCH = (NSKEY + 511) / 512;
    for (int item = gridDim.x - 1 - blockIdx.x; item < SBN * NCH; item += gridDim.x) {
        const int sb = item / NCH, ch = item % NCH, r = SROW0 + sb;
        __syncthreads();
        for (int e = tid; e < 1024; e += NTHREADS) lq[e] = bf2f(QI[(size_t)r * 1024 + e]);
        if (tid < 16) lw[tid] = WI[(size_t)r * 16 + tid];
        __syncthreads();
        const int s = ch * 512 + tid;
        if (s < NSKEY) {
            const float* kr = (s < PAST) ? P.cache_ik + ((size_t)P.page_table[sb * NPG + (s >> 7)] * 128 + (s & 127)) * 64 : P.out + O_IKS + (size_t)sb * 64;
            f32x4 kv[16];
#pragma unroll
            for (int i = 0; i < 16; ++i) kv[i] = *(const f32x4*)(kr + 4 * i);
            float sc = 0.f;
            for (int h = 0; h < 16; ++h) { float d = 0.f;
#pragma unroll
                for (int i = 0; i < 16; ++i) { const f32x4 q = *(const LAS f32x4*)(lq + h * 64 + 4 * i); d += q.x * kv[i].x + q.y * kv[i].y + q.z * kv[i].z + q.w * kv[i].w; }
                sc += lw[h] * fmaxf(d, 0.f); }
            SCS[(size_t)sb * SCSW + s] = sc;
        }
    }
    __syncthreads();
}

__device__ __forceinline__ unsigned ordkey(float f) { const unsigned u = __float_as_uint(f); return (u & 0x80000000u) ? ~u : (u | 0x80000000u); }
constexpr int TOPK = 256;
__device__ __forceinline__ void topk_wave_mask(const float* sc, int n, unsigned long long* mrow, int lane) {
    constexpr int NS = MTW, M0 = SPAD / 64;
    static_assert(M0 == dattn::JLO, "first real key tile");
    unsigned key[NS];
#pragma unroll
    for (int m = M0; m < NS; ++m) { const int sidx = lane + 64 * m - SPAD; const int ci = sidx < 0 ? 0 : (sidx < n ? sidx : n - 1); const float v = sc[ci]; key[m] = (sidx >= 0 && sidx < n) ? ordkey(v) : 0u; }
    if (n <= TOPK) {
#pragma unroll
        for (int m = M0; m < NS; ++m) { const unsigned long long w = __ballot(key[m] != 0u); if (lane == 0) mrow[m] = w; }
        return;
    }
    unsigned T = 0u;
    for (int bit = 31; bit >= 0; --bit) {
        const unsigned cand = T | (1u << bit); int c = 0, cv = 0;
#pragma unroll
        for (int m = M0; m < NS; ++m) { if ((m & 1) != 0) c += __popcll(__ballot(key[m] >= cand)); else cv += (key[m] >= cand) ? 1 : 0; }
        c = __builtin_amdgcn_readfirstlane(c + wave_sum_dpp_i(cv));
        if (c >= TOPK) { T = cand; if (c == TOPK) break; }
    }
    int cg = 0;
#pragma unroll
    for (int m = M0; m < NS; ++m) cg += __popcll(__ballot(key[m] > T));
    const int need = TOPK - cg;
    int base_e = 0;
    const unsigned long long lt = (1ull << lane) - 1ull;
#pragma unroll
    for (int m = M0; m < NS; ++m) {
        const bool pg = key[m] > T, pe = key[m] == T;
        const unsigned long long me = __ballot(pe);
        const int pre_e = __popcll(me & lt);
        const unsigned long long w = __ballot(pg || (pe && (base_e + pre_e) < need));
        if (lane == 0) mrow[m] = w;
        base_e += __popcll(me);
    }
}
__device__ __forceinline__ void topk_block(const float* sc, int n, int* outIdx, int* outCnt, LAS unsigned* ls, int tid, int wave, int lane) {
    constexpr int NS = (NSKEY + NTHREADS - 1) / NTHREADS;
    unsigned key[NS];
#pragma unroll
    for (int m = 0; m < NS; ++m) { const int e = tid + NTHREADS * m; const float v = sc[e < n ? e : n - 1]; key[m] = (e < n) ? ordkey(v) : 0u; }
    unsigned T = 0u;
    for (int bit = 31; bit >= 0; --bit) {
        const unsigned cand = T | (1u << bit); int c = 0;
#pragma unroll
        for (int m = 0; m < NS; ++m) c += (key[m] >= cand) ? 1 : 0;
        c = wave_sum_dpp_i(c);
        LAS unsigned* buf = ls + (bit & 1) * 8;
        if (lane == 0) buf[wave] = (unsigned)c;
        __syncthreads();
        int tot = 0;
#pragma unroll
        for (int w = 0; w < 8; ++w) tot += (int)buf[w];
        if (tot >= TOPK) T = cand;
    }
    __syncthreads();
    if (tid == 0) { unsigned z_ = 0u; asm volatile("" : "+v"(z_)); ls[16] = z_; ls[17] = z_; }
    __syncthreads();
#pragma unroll
    for (int m = 0; m < NS; ++m) { const int e = tid + NTHREADS * m; if (key[m] > T) { const unsigned pos = atomicAdd((unsigned*)(ls + 16), 1u); if (pos < (unsigned)TOPK) outIdx[pos] = e; } }
    __syncthreads();
    const unsigned cg = ls[16];
    const unsigned need = (unsigned)TOPK - cg;
#pragma unroll
    for (int m = 0; m < NS; ++m) { const int e = tid + NTHREADS * m; if (key[m] == T) { const unsigned pos = atomicAdd((unsigned*)(ls + 17), 1u); if (pos < need) outIdx[cg + pos] = e; } }
    if (tid == 0) *outCnt = TOPK;
    __syncthreads();
}
__device__ __forceinline__ void select_phase(const Ptrs& P, LAS unsigned char* lds, int gw, int NGW, int tid, int wave, int lane) {
    unsigned char* ws = P.ws;
    const float* SC = (const float*)(ws + WS_SC); const float* SCS = (const float*)(ws + WS_SCS); int* IDXL = (int*)(ws + WS_IDXL); int* CNT = (int*)(ws + WS_CNT);
    for (int sb = blockIdx.x; sb < SBN; sb += gridDim.x) topk_block(SCS + (size_t)sb * SCSW, NSKEY, IDXL + (size_t)(SROW0 + sb) * TOPK, CNT + SROW0 + sb, (LAS unsigned*)lds, tid, wave, lane);
    unsigned long long* MASK = (unsigned long long*)(ws + WS_MASK);
    for (int r = gw; r < SROW0; r += NGW) { int b, t; row_bt(r, b, t);
        if (r < XROW0) topk_wave_mask(SC + ((size_t)(b * TP + t)) * SCW, t + 1, MASK + ((size_t)(b * SP + t + SPAD)) * MTW, lane);
        else { if (lane <= t) IDXL[(size_t)r * TOPK + lane] = lane; if (lane == 0) CNT[r] = t + 1; } }
}

__device__ __forceinline__ void attn_phase(const Ptrs& P, bf16* O, LAS unsigned char* lds, int tid, int wave, int lane) {
    unsigned char* ws = P.ws;
    const bf16* Qr = (const bf16*)(ws + WS_QR); const int* IDXL = (const int*)(ws + WS_IDXL); const int* CNT = (const int*)(ws + WS_CNT);
    LAS float* lq = (LAS float*)(lds + wave * 2048);
    LAS float* part = (LAS float*)(lds + 16384);
    LAS float* ml = (LAS float*)(lds + 32768);
    for (int item = blockIdx.x; item < (NROWS - XROW0) * 4; item += gridDim.x) {
        const int r = XROW0 + (item >> 2), n = item & 3;
        const int cnt = CNT[r];
        { float qf[8]; unpack8(*(const v4u*)(Qr + (size_t)r * DM + n * 512 + 8 * lane), qf);
          *(LAS f32x4*)(lq + 8 * lane) = (f32x4){qf[0], qf[1], qf[2], qf[3]}; *(LAS f32x4*)(lq + 8 * lane + 4) = (f32x4){qf[4], qf[5], qf[6], qf[7]}; }
        const int kl = lane & 31, hh = lane >> 5, e = wave * 32 + kl;
        const bool valid = e < cnt;
        const int s = valid ? IDXL[(size_t)r * TOPK + e] : 0;
        const float *kq, *vq;
        if (r < SROW0) { const int b = (r - XROW0) >> 4; kq = P.out + O_KP + ((size_t)(b * TP + s)) * 512; vq = P.out + O_VP + ((size_t)(b * TP + s)) * 512; }
        else { const int sb = r - SROW0;
            if (s < PAST) { const size_t off = ((size_t)P.page_table[sb * NPG + (s >> 7)] * 128 + (s & 127)) * 512; kq = P.cache_k + off; vq = P.cache_v + off; }
            else { kq = P.out + O_KS + (size_t)sb * 512; vq = P.out + O_VS + (size_t)sb * 512; } }
        kq += n * 128 + 64 * hh; vq += n * 128;
        f32x4 kv[16];
#pragma unroll
        for (int i = 0; i < 16; ++i) kv[i] = *(const f32x4*)(kq + 4 * i);
        WAVE_SYNC();
        float acc[4] = {0.f, 0.f, 0.f, 0.f};
#pragma unroll
        for (int i = 0; i < 16; ++i)
#pragma unroll
            for (int g = 0; g < 4; ++g) { const f32x4 qv = *(const LAS f32x4*)(lq + g * 128 + 64 * hh + 4 * i); acc[g] += qv.x * kv[i].x + qv.y * kv[i].y + qv.z * kv[i].z + qv.w * kv[i].w; }
        float pg[4], mw[4], lw[4];
#pragma unroll
        for (int g = 0; g < 4; ++g) { float a = acc[g] + __shfl_xor(acc[g], 32); a = valid ? a : -INFINITY;
            const float m = wave_max(a); const float pv = valid ? __expf(a - m) : 0.f;
            pg[g] = pv; mw[g] = m; lw[g] = wave_sum(hh == 0 ? pv : 0.f); }
        const unsigned long long va = (unsigned long long)vq; const int va_lo = (int)(unsigned)va, va_hi = (int)(unsigned)(va >> 32);
        f32x2 vv[32];
#pragma unroll
        for (int j = 0; j < 32; ++j) { const unsigned long long a = ((unsigned long long)(unsigned)__builtin_amdgcn_readlane(va_hi, j) << 32) | (unsigned)__builtin_amdgcn_readlane(va_lo, j);
            vv[j] = *(const f32x2*)((const float*)a + 2 * lane); }
        float o[4][2];
#pragma unroll
        for (int g = 0; g < 4; ++g) { o[g][0] = 0.f; o[g][1] = 0.f; }
#pragma unroll
        for (int j = 0; j < 32; ++j)
#pragma unroll
            for (int g = 0; g < 4; ++g) { const float pj = __int_as_float(__builtin_amdgcn_readlane(__float_as_int(pg[g]), j)); o[g][0] += pj * vv[j].x; o[g][1] += pj * vv[j].y; }
#pragma unroll
        for (int g = 0; g < 4; ++g) { *(LAS f32x2*)(part + (wave * 4 + g) * 128 + 2 * lane) = (f32x2){o[g][0], o[g][1]};
            if (lane == 0) { ml[(wave * 4 + g) * 2] = mw[g]; ml[(wave * 4 + g) * 2 + 1] = lw[g]; } }
        __syncthreads();
        { const int g = tid >> 7, d = tid & 127; float M = -INFINITY;
#pragma unroll
          for (int w = 0; w < 8; ++w) M = fmaxf(M, ml[(w * 4 + g) * 2]);
          float L = 0.f, a = 0.f;
#pragma unroll
          for (int w = 0; w < 8; ++w) { const float mv = ml[(w * 4 + g) * 2]; const float sc = (mv == -INFINITY) ? 0.f : __expf(mv - M); L += ml[(w * 4 + g) * 2 + 1] * sc; a += part[(w * 4 + g) * 128 + d] * sc; }
          O[(size_t)r * DM + (4 * n + g) * 128 + d] = f2bf(a / L); }
        __syncthreads();
    }
}

__device__ __forceinline__ void convC_finish(float (&acc)[8], int it) {
    float ss = 0.f;
#pragma unroll
    for (int i = 0; i < 8; ++i) { acc[i] = silu_f(acc[i]); ss += acc[i] * acc[i]; }
    if (it < 8) { ss = row16_sum(ss); float rn = 1.f / sqrtf(ss + RMS_EPS); if (it < 4) rn *= QSCALE;
#pragma unroll
        for (int i = 0; i < 8; ++i) acc[i] *= rn; }
}
__device__ __forceinline__ void convC_phase(const bf16* PROJC, const Ptrs& P, int gw, int NGW, int lane) {
    unsigned char* ws = P.ws;
    bf16* QKVC = (bf16*)(ws + WS_QKVC); float* QKF = (float*)(ws + WS_QKF); float* G = (float*)(ws + WS_G); float* BETA = (float*)(ws + WS_BETA);
    const float* cw = P.conv_w_c;
    constexpr int RUN = 8, NRUN = SEQ / RUN;
    for (int item = gw; item < 16 * NBP * NRUN; item += NGW) {
        const int it = item & 15, ru = item >> 4, b = ru / NRUN, t0 = NMETA + (ru % NRUN) * RUN, ch0 = it * 512 + 8 * lane;
        float w[4][8];
#pragma unroll
        for (int j = 0; j < 4; ++j) { const f32x4 w0 = *(const f32x4*)(cw + (size_t)j * CDIM + ch0), w1 = *(const f32x4*)(cw + (size_t)j * CDIM + ch0 + 4);
            w[j][0] = w0.x; w[j][1] = w0.y; w[j][2] = w0.z; w[j][3] = w0.w; w[j][4] = w1.x; w[j][5] = w1.y; w[j][6] = w1.z; w[j][7] = w1.w; }
        const int r0 = prow(b, t0);
        v4u xr[RUN + 3];
#pragma unroll
        for (int j = 0; j < 3; ++j) { const int tt = t0 - 3 + j; xr[j] = tt >= 0 ? *(const v4u*)(PROJC + (size_t)prow(b, tt) * NC_PAD + ch0) : (v4u){0u, 0u, 0u, 0u}; }
#pragma unroll
        for (int k = 0; k < RUN; ++k) xr[3 + k] = *(const v4u*)(PROJC + (size_t)(r0 + k) * NC_PAD + ch0);
        float x[RUN + 3][8];
#pragma unroll
        for (int j = 0; j < RUN + 3; ++j) unpack8(xr[j], x[j]);
#pragma unroll
        for (int k = 0; k < RUN; ++k) {
            float acc[8];
#pragma unroll
            for (int i = 0; i < 8; ++i) acc[i] = w[0][i] * x[k][i] + w[1][i] * x[k + 1][i] + w[2][i] * x[k + 2][i] + w[3][i] * x[k + 3][i];
            convC_finish(acc, it);
            *(v4u*)(QKVC + (size_t)(r0 + k) * CDIM + ch0) = pack8(acc);
            const int t = t0 + k;
            if (t >= TP - 3) { float* o = P.out + O_CCP + ((size_t)(b * 3 + (t - (TP - 3)))) * CDIM + ch0;
                *(f32x4*)o = (f32x4){x[k + 3][0], x[k + 3][1], x[k + 3][2], x[k + 3][3]}; *(f32x4*)(o + 4) = (f32x4){x[k + 3][4], x[k + 3][5], x[k + 3][6], x[k + 3][7]}; }
        }
    }
    for (int item = gw; item < 16 * NBP * NMETA; item += NGW) {
        const int it = item & 15, mi = item >> 4, t = mi % NMETA, r = XROW0 + mi, ch0 = it * 512 + 8 * lane;
        float x[4][8];
#pragma unroll
        for (int j = 0; j < 4; ++j) { const int tt = t - 3 + j; if (tt >= 0) unpack8(*(const v4u*)(PROJC + (size_t)(r - 3 + j) * NC_PAD + ch0), x[j]); else {
#pragma unroll
                for (int i = 0; i < 8; ++i) x[j][i] = 0.f; } }
        float acc[8];
#pragma unroll
        for (int i = 0; i < 8; ++i) acc[i] = 0.f;
#pragma unroll
        for (int j = 0; j < 4; ++j) { const f32x4 w0 = *(const f32x4*)(cw + (size_t)j * CDIM + ch0), w1 = *(const f32x4*)(cw + (size_t)j * CDIM + ch0 + 4);
            acc[0] += w0.x * x[j][0]; acc[1] += w0.y * x[j][1]; acc[2] += w0.z * x[j][2]; acc[3] += w0.w * x[j][3];
            acc[4] += w1.x * x[j][4]; acc[5] += w1.y * x[j][5]; acc[6] += w1.z * x[j][6]; acc[7] += w1.w * x[j][7]; }
        convC_finish(acc, it);
        *(v4u*)(QKVC + (size_t)r * CDIM + ch0) = pack8(acc);
    }
    for (int item = gw; item < 16 * SBN; item += NGW) {
        const int it = item & 15, sb = item >> 4, r = SROW0 + sb, ch0 = it * 512 + 8 * lane;
        float x[4][8];
#pragma unroll
        for (int j = 0; j < 3; ++j) { const float* hp = P.state_conv_c + ((size_t)(sb * 3 + j)) * CDIM + ch0; const f32x4 a = *(const f32x4*)hp, c = *(const f32x4*)(hp + 4);
            x[j][0] = a.x; x[j][1] = a.y; x[j][2] = a.z; x[j][3] = a.w; x[j][4] = c.x; x[j][5] = c.y; x[j][6] = c.z; x[j][7] = c.w; }
        unpack8(*(const v4u*)(PROJC + (size_t)r * NC_PAD + ch0), x[3]);
        float acc[8];
#pragma unroll
        for (int i = 0; i < 8; ++i) acc[i] = 0.f;
#pragma unroll
        for (int j = 0; j < 4; ++j) { const f32x4 w0 = *(const f32x4*)(cw + (size_t)j * CDIM + ch0), w1 = *(const f32x4*)(cw + (size_t)j * CDIM + ch0 + 4);
            acc[0] += w0.x * x[j][0]; acc[1] += w0.y * x[j][1]; acc[2] += w0.z * x[j][2]; acc[3] += w0.w * x[j][3];
            acc[4] += w1.x * x[j][4]; acc[5] += w1.y * x[j][5]; acc[6] += w1.z * x[j][6]; acc[7] += w1.w * x[j][7]; }
        convC_finish(acc, it);
        if (it < 8) { float* qk = QKF + (size_t)r * 4096 + ch0; *(f32x4*)qk = (f32x4){acc[0], acc[1], acc[2], acc[3]}; *(f32x4*)(qk + 4) = (f32x4){acc[4], acc[5], acc[6], acc[7]}; }
        *(v4u*)(QKVC + (size_t)r * CDIM + ch0) = pack8(acc);
        float* o = P.out + O_CCS + ((size_t)(sb * 3)) * CDIM + ch0;
#pragma unroll
        for (int j = 0; j < 3; ++j) { *(f32x4*)(o + (size_t)j * CDIM) = (f32x4){x[j + 1][0], x[j + 1][1], x[j + 1][2], x[j + 1][3]}; *(f32x4*)(o + (size_t)j * CDIM + 4) = (f32x4){x[j + 1][4], x[j + 1][5], x[j + 1][6], x[j + 1][7]}; }
    }
    for (int e = gw * 64 + lane; e < NROWS * 32; e += NGW * 64) {
        const int r = e >> 5, h = e & 31;
        const float braw = bf2f(PROJC[(size_t)r * NC_PAD + 12288 + h]), araw = bf2f(PROJC[(size_t)r * NC_PAD + 12320 + h]);
        const float xx = araw + P.dt_bias[h]; const float sp = xx > 20.f ? xx : __logf(1.f + __expf(xx));
        G[e] = -__expf(P.a_log[h]) * sp; BETA[e] = 1.f / (1.f + __expf(-braw));
    }
}

struct Tok { f32x4 k0, k1, q0, q1; unsigned v; float g, b; };
__device__ __forceinline__ void tok_load(Tok& T, const float* QKF, const bf16* QKVC, const float* G, const float* BETA, int row, int h, int rg, int col0) {
    const float* base = QKF + (size_t)row * 4096 + (h >> 1) * 128 + 8 * rg;
    T.q0 = *(const f32x4*)base; T.q1 = *(const f32x4*)(base + 4); T.k0 = *(const f32x4*)(base + 2048); T.k1 = *(const f32x4*)(base + 2052);
    T.v = *(const unsigned*)(QKVC + (size_t)row * CDIM + 4096 + h * 128 + col0);
    T.g = G[(size_t)row * 32 + h]; T.b = BETA[(size_t)row * 32 + h];
}
__device__ __forceinline__ f32x2 tok_step(f32x2 (&S)[8], const Tok& T) {
    const float kk[8] = {T.k0.x, T.k0.y, T.k0.z, T.k0.w, T.k1.x, T.k1.y, T.k1.z, T.k1.w};
    const float qq[8] = {T.q0.x, T.q0.y, T.q0.z, T.q0.w, T.q1.x, T.q1.y, T.q1.z, T.q1.w};
    const float a = __expf(T.g);
    f32x2 d0 = S[0] * kk[0], d1 = S[1] * kk[1];
#pragma unroll
    for (int i = 2; i < 8; i += 2) { d0 += S[i] * kk[i]; d1 += S[i + 1] * kk[i + 1]; }
    f32x2 d = d0 + d1;
    d.x = row16_sum(d.x); d.y = row16_sum(d.y);
    const f32x2 tv = {bflo(T.v), bfhi(T.v)};
    const f32x2 dl = (tv - d * a) * T.b;
    f32x2 o0 = {0.f, 0.f}, o1 = {0.f, 0.f};
#pragma unroll
    for (int i = 0; i < 8; i += 2) { S[i] = S[i] * a + dl * kk[i]; o0 += S[i] * qq[i]; S[i + 1] = S[i + 1] * a + dl * kk[i + 1]; o1 += S[i + 1] * qq[i + 1]; }
    f32x2 o = o0 + o1;
    o.x = row16_sum(o.x); o.y = row16_sum(o.y);
    return o;
}
__device__ __forceinline__ void delta_phase(const Ptrs& P, int idx, int stride, int lane) {
    unsigned char* ws = P.ws;
    const bf16* QKVC = (const bf16*)(ws + WS_QKVC); const float* QKF = (const float*)(ws + WS_QKF); const float* G = (const float*)(ws + WS_G); const float* BETA = (const float*)(ws + WS_BETA); bf16* OF = (bf16*)(ws + WS_SC);
    const int cg = lane >> 4, rg = lane & 15;
    {
        for (int item = idx; item < SBN * 32 * 16; item += stride) {
            const int sb = item >> 9, h = (item >> 4) & 31, col0 = 8 * (item & 15) + 2 * cg;
            const size_t so = ((size_t)((sb * 32 + h) * 128 + 8 * rg)) * 128 + col0;
            f32x2 S[8];
#pragma unroll
            for (int i = 0; i < 8; ++i) S[i] = *(const f32x2*)(P.state_delta + so + (size_t)i * 128);
            Tok T; tok_load(T, QKF, QKVC, G, BETA, SROW0 + sb, h, rg, col0);
            const f32x2 o = tok_step(S, T);
            if (rg == 0) *(unsigned*)(OF + (size_t)(SROW0 + sb) * DVW + h * 128 + col0) = pk2(o.x, o.y);
            float* op = P.out + O_DS + so;
#pragma unroll
            for (int i = 0; i < 8; ++i) *(f32x2*)(op + (size_t)i * 128) = S[i];
        }
    }
}
__device__ __forceinline__ void normC_piece(const v4u oq, const v4u zz, const float (&nw)[8], bf16* yo) {
    float o[8]; unpack8(oq, o);
    float ss = 0.f;
#pragma unroll
    for (int i = 0; i < 8; ++i) ss += o[i] * o[i];
    ss = row16_sum(ss);
    const float rs = 1.f / sqrtf(ss * (1.f / 128.f) + RMS_EPS);
    float z[8]; unpack8(zz, z);
#pragma unroll
    for (int i = 0; i < 8; ++i) o[i] = o[i] * rs * nw[i] * silu_f(z[i]);
    *(v4u*)yo = pack8(o);
}
__device__ __forceinline__ void normC_phase(const bf16* PROJC, bf16* Y, const Ptrs& P, int gw, int NGW, int lane) {
    const bf16* OF = (const bf16*)(P.ws + WS_SC);
    const int d0 = 8 * (lane & 15), hl = lane >> 4;
    float nw[8];
    { const f32x4 a = *(const f32x4*)(P.norm_w + d0), b = *(const f32x4*)(P.norm_w + d0 + 4); nw[0] = a.x; nw[1] = a.y; nw[2] = a.z; nw[3] = a.w; nw[4] = b.x; nw[5] = b.y; nw[6] = b.z; nw[7] = b.w; }
    for (int it = gw; it < (NROWS - XROW0) * 8; it += NGW) { const int r = XROW0 + (it >> 3), hd = (it & 7) * 4 + hl;
        const v4u oq = *(const v4u*)(OF + (size_t)r * DVW + hd * 128 + d0), zz = *(const v4u*)(PROJC + (size_t)r * NC_PAD + 8192 + hd * 128 + d0);
        normC_piece(oq, zz, nw, Y + (size_t)r * DVW + hd * 128 + d0); }
    for (int r = gw; r < XROW0; r += 2 * NGW) {
        const int r2 = (r + NGW < XROW0) ? r + NGW : r; const bool two = r + NGW < XROW0;
        v4u oa[8], za[8], ob[8], zb[8];
#pragma unroll
        for (int it = 0; it < 8; ++it) { const int hd = it * 4 + hl;
            oa[it] = *(const v4u*)(OF + (size_t)r * DVW + hd * 128 + d0); za[it] = *(const v4u*)(PROJC + (size_t)r * NC_PAD + 8192 + hd * 128 + d0);
            ob[it] = *(const v4u*)(OF + (size_t)r2 * DVW + hd * 128 + d0); zb[it] = *(const v4u*)(PROJC + (size_t)r2 * NC_PAD + 8192 + hd * 128 + d0); }
#pragma unroll
        for (int it = 0; it < 8; ++it) { const int hd = it * 4 + hl;
            normC_piece(oa[it], za[it], nw, Y + (size_t)r * DVW + hd * 128 + d0);
            if (two) normC_piece(ob[it], zb[it], nw, Y + (size_t)r2 * DVW + hd * 128 + d0); }
    }
}


template <int VAR = 0> __device__ __forceinline__ void dense_attn_phase(const Ptrs& P, bf16* O, char* lds, int wv) {
    unsigned char* ws = P.ws;
    const bf16* Qr = (const bf16*)(ws + WS_QR); const bf16* Ks = (const bf16*)(ws + WS_KS); const bf16* Vs = (const bf16*)(ws + WS_VS);
    const unsigned long long* MASK = (const unsigned long long*)(ws + WS_MASK);
    typedef dattn::BlockRef<bf16, bf16> BR;
    for (int it0 = blockIdx.x; it0 < 256; it0 += gridDim.x) {
        const int grp = it0 & 7, idx = it0 >> 3;
        const int b = grp >> 2, kvh = grp & 3, h = kvh * 4 + (idx >> 3), x = idx & 7;
        BR A, B;
        const int qa = 1 + x, qb = 16 - x;
        A.Q = Qr + ((size_t)(b * SEQ + 256 * (qa - 1))) * DM + h * 128; A.O = O + ((size_t)(b * SEQ + 256 * (qa - 1))) * DM + h * 128;
        B.Q = Qr + ((size_t)(b * SEQ + 256 * (qb - 1))) * DM + h * 128; B.O = O + ((size_t)(b * SEQ + 256 * (qb - 1))) * DM + h * 128;
        A.K = B.K = Ks + (size_t)b * SP * 512 + kvh * 128; A.V = B.V = Vs + (size_t)b * SP * 512 + kvh * 128;
        A.P0 = 256 * qa; B.P0 = 256 * qb;
        A.M = MASK + ((size_t)(b * SP + A.P0)) * MTW; B.M = MASK + ((size_t)(b * SP + B.P0)) * MTW;
        dattn::Seam<bf16> S;
        dattn::causal_swa_prime<bf16, bf16>(A, SP, lds, S, wv);
        dattn::causal_swa_block<bf16, bf16, VAR>(A, B, SP, SP, lds, S, wv);
        dattn::causal_swa_block<bf16, bf16, VAR>(B, B, SP, SP, lds, S, wv);
    }
}

constexpr int NCH = 65, CPAD = 48;
constexpr int NUQ = NBP * 16 * NCH, NUH = NBP * 32 * NCH;
__device__ __forceinline__ int crow32(int r, int hi) { return (r & 3) + 8 * (r >> 2) + 4 * hi; }
__device__ __forceinline__ int chunk_row(int b, int c, int i) { const int t = 64 * c + i - CPAD; return t >= 0 ? prow(b, t) : -1; }
__device__ __forceinline__ float incl_scan64(float v, int lane) {
#pragma unroll
    for (int o = 1; o < 64; o <<= 1) { const float u = __shfl_up(v, o); if (lane >= o) v += u; }
    return v;
}
#define MFMA32(a, b, c) __builtin_amdgcn_mfma_f32_32x32x16_bf16((a), (b), (c), 0, 0, 0)
__device__ __forceinline__ bf16x8 sel8(bool ok, bf16x8 v) { const bf16x8 z = {0, 0, 0, 0, 0, 0, 0, 0}; return ok ? v : z; }
__device__ __forceinline__ int sw23(int x) { return (x & ~12) | ((x & 4) << 1) | ((x & 8) >> 1); }
__device__ __forceinline__ int fidx64(int row, int xs) { return ((((row >> 5) * 2 + (xs >> 5)) * 2 + ((xs >> 4) & 1)) * 64 + (row & 31) + 32 * ((xs >> 3) & 1)) * 8 + (xs & 7); }

__device__ __forceinline__ v4u pack_frag(const f32x16& x, int s) { v4u w; w.x = pk2(x[8 * s], x[8 * s + 1]); w.y = pk2(x[8 * s + 2], x[8 * s + 3]); w.z = pk2(x[8 * s + 4], x[8 * s + 5]); w.w = pk2(x[8 * s + 6], x[8 * s + 7]); return w; }
__device__ __forceinline__ void stage_out8k(LAS unsigned char* stg, bf16* gdst, int lane) {
    WAVE_SYNC();
#pragma unroll
    for (int k = 0; k < 8; ++k) *(v4u*)(gdst + k * 512 + lane * 8) = *(const LAS v4u*)(stg + k * 1024 + lane * 16);
    WAVE_SYNC();
}
__device__ __forceinline__ void delta_d1_unit(unsigned char* ws, LAS unsigned char* lds, int uq, int wave, int lane) {
    asm volatile("" : "+v"(lane));
    const bf16* QKVC = (const bf16*)(ws + WS_QKVC); const float* G = (const float*)(ws + WS_G); const float* BETA = (const float*)(ws + WS_BETA);
    float* AF = (float*)(ws + WS_DAF); bf16* PG = (bf16*)(ws + WS_DPG); bf16* KT = (bf16*)(ws + WS_DKT); bf16* VT = (bf16*)(ws + WS_DVT);
    float* GC = (float*)(ws + WS_DGC); float* BT = (float*)(ws + WS_DBT);
    LAS float* lg = (LAS float*)(lds + wave * 16384);
    LAS unsigned char* stg = lds + wave * 16384 + 2048; LAS bf16* st = (LAS bf16*)stg;
    const int m = lane & 31, half = lane >> 5;
    const bf16x8 zf = {0, 0, 0, 0, 0, 0, 0, 0};
    {
        const int c = uq % NCH, bh = uq / NCH, hq = bh & 15, b = bh >> 4;
        { const int row = chunk_row(b, c, lane);
#pragma unroll
          for (int hh = 0; hh < 2; ++hh) { const int h = 2 * hq + hh; const float g = row >= 0 ? G[(size_t)row * 32 + h] : 0.f, bt = row >= 0 ? BETA[(size_t)row * 32 + h] : 0.f;
              const float gc = incl_scan64(g, lane); lg[hh * 64 + lane] = gc; lg[128 + hh * 64 + lane] = bt;
              const size_t uh = ((size_t)(b * 32 + h)) * NCH + c; GC[uh * 64 + lane] = gc; BT[uh * 64 + lane] = bt; } }
        const int row0 = chunk_row(b, c, m), row1 = chunk_row(b, c, 32 + m);
        const bf16* r0 = QKVC + (size_t)(row0 < 0 ? 0 : row0) * CDIM; const bf16* r1 = QKVC + (size_t)(row1 < 0 ? 0 : row1) * CDIM;
        f32x16 kk00, kk10, kk11, qk00, qk10, qk11;
#pragma unroll
        for (int i = 0; i < 16; ++i) { kk00[i] = 0.f; kk10[i] = 0.f; kk11[i] = 0.f; qk00[i] = 0.f; qk10[i] = 0.f; qk11[i] = 0.f; }
        const int sm = sw23(m);
        const int ktl = half * 32 + ((sm >> 4) & 1) * 512 + ((sm >> 3) & 1) * 256 + (sm & 7);
#pragma unroll 1
        for (int kh = 0; kh < 2; ++kh) {
            bf16x8 kf0[4], kf1[4], qf0[4], qf1[4];
#pragma unroll
            for (int u = 0; u < 4; ++u) { const int off = hq * 128 + 16 * (4 * kh + u) + 8 * half;
                kf0[u] = sel8(row0 >= 0, *(const bf16x8*)(r0 + 2048 + off)); kf1[u] = sel8(row1 >= 0, *(const bf16x8*)(r1 + 2048 + off));
                qf0[u] = sel8(row0 >= 0, *(const bf16x8*)(r0 + off)); qf1[u] = sel8(row1 >= 0, *(const bf16x8*)(r1 + off)); }
#pragma unroll
            for (int u = 0; u < 4; ++u) { const int ks = 4 * kh + u; const bf16x8 k0 = kf0[u], k1 = kf1[u], q0 = qf0[u], q1 = qf1[u];
                kk00 = MFMA32(k0, k0, kk00); kk10 = MFMA32(k1, k0, kk10); kk11 = MFMA32(k1, k1, kk11);
                qk00 = MFMA32(q0, k0, qk00); qk10 = MFMA32(q1, k0, qk10); qk11 = MFMA32(q1, k1, qk11);
                LAS bf16* kb = st + ktl + ((ks >> 1) & 1) * 2048 + (ks & 1) * 128;
#pragma unroll
                for (int e = 0; e < 8; ++e) { kb[(8 * (e >> 2) + (e & 3)) * 8] = (bf16)k0[e]; kb[1024 + (8 * (e >> 2) + (e & 3)) * 8] = (bf16)k1[e]; } }
            stage_out8k(stg, KT + (size_t)uq * 8192 + kh * 4096, lane);
        }
#pragma unroll 1
        for (int hh = 0; hh < 2; ++hh) { const int h = 2 * hq + hh; bf16* vt = VT + (((size_t)(b * 32 + h)) * NCH + c) * 8192;
            const int vtl = half * 64 + ((sm >> 4) & 1) * 512 + ((sm >> 3) & 1) * 256 + (sm & 7);
            bf16x8 vf0[8], vf1[8];
#pragma unroll
            for (int ks = 0; ks < 8; ++ks) { const int off = 4096 + h * 128 + 16 * ks + 8 * half; vf0[ks] = sel8(row0 >= 0, *(const bf16x8*)(r0 + off)); vf1[ks] = sel8(row1 >= 0, *(const bf16x8*)(r1 + off)); }
#pragma unroll
            for (int kh = 0; kh < 2; ++kh) {
#pragma unroll
                for (int u = 0; u < 4; ++u) { const int ks = 4 * kh + u; LAS bf16* vb = st + vtl + ((ks >> 1) & 1) * 2048 + (ks & 1) * 128;
#pragma unroll
                    for (int e = 0; e < 8; ++e) { vb[e * 8] = (bf16)vf0[ks][e]; vb[1024 + e * 8] = (bf16)vf1[ks][e]; } }
                stage_out8k(stg, vt + kh * 4096, lane);
            } }
        WAVE_SYNC();
#pragma unroll 1
        for (int hh = 0; hh < 2; ++hh) { const int h = 2 * hq + hh; const size_t uh = ((size_t)(b * 32 + h)) * NCH + c;
            float* af = AF + uh * 4096 + half * 256 + m;
            LAS bf16* pg = st + ktl;
            const float gcj0 = lg[hh * 64 + m], gcj1 = lg[hh * 64 + 32 + m];
#pragma unroll
            for (int r = 0; r < 16; ++r) { const int ir = crow32(r, half), rc = (r & 3) + 8 * (r >> 2);
                const float gi0 = lg[hh * 64 + ir], gi1 = lg[hh * 64 + 32 + ir], bi0 = lg[128 + hh * 64 + ir], bi1 = lg[128 + hh * 64 + 32 + ir];
                { const int i = ir, j = m; const float dec = __expf(fminf(gi0 - gcj0, 0.f)); af[rc * 64] = (j < i) ? bi0 * dec * kk00[r] : 0.f; pg[rc * 8] = f2bf((j <= i) ? dec * qk00[r] : 0.f); }
                { const int i = 32 + ir, j = m; const float dec = __expf(fminf(gi1 - gcj0, 0.f)); af[2048 + rc * 64] = bi1 * dec * kk10[r]; pg[2048 + rc * 8] = f2bf(dec * qk10[r]); }
                { const int i = 32 + ir, j = 32 + m; const float dec = __expf(fminf(gi1 - gcj1, 0.f)); af[2048 + 32 + rc * 64] = (j < i) ? bi1 * dec * kk11[r] : 0.f; pg[2048 + 1024 + rc * 8] = f2bf((j <= i) ? dec * qk11[r] : 0.f); }
            }
            stage_out8k(stg, PG + uh * 4096, lane); }
        WAVE_SYNC();
    }
}
__device__ __forceinline__ void delta_d2_unit(unsigned char* ws, LAS unsigned char* lds, int uh, int wave, int lane) {
    asm volatile("" : "+v"(lane));
    const float* AF = (const float*)(ws + WS_DAF); const float* GC = (const float*)(ws + WS_DGC); const float* BT = (const float*)(ws + WS_DBT);
    bf16* TG = (bf16*)(ws + WS_DTG); bf16* TB = (bf16*)(ws + WS_DTB);
    {
        const float* af = AF + (size_t)uh * 4096;
        const float bc = BT[(size_t)uh * 64 + lane], gmc = __expf(GC[(size_t)uh * 64 + lane]);
        float T[64];
        const bool pad0 = (uh % NCH) == 0;
#pragma unroll
        for (int i0 = 0; i0 < 64; i0 += 16) {
            float ar[16];
#pragma unroll
            for (int u = 0; u < 16; ++u) ar[u] = af[(i0 + u) * 64 + lane];
            if (pad0 && i0 < 32) {
#pragma unroll
                for (int u = 0; u < 16; ++u) T[i0 + u] = (lane == i0 + u) ? 1.f : 0.f;
            } else {
#pragma unroll
                for (int u = 0; u < 16; ++u) { const int i = i0 + u; float pa[4] = {(lane == i) ? 1.f : 0.f, 0.f, 0.f, 0.f};
#pragma unroll
                    for (int j = 0; j < i; ++j) pa[j & 3] -= __int_as_float(__builtin_amdgcn_readlane(__float_as_int(ar[u]), j)) * T[j];
                    T[i] = (pa[0] + pa[1]) + (pa[2] + pa[3]); }
            }
        }
        bf16* tg = TG + (size_t)uh * 4096; bf16* tb = TB + (size_t)uh * 4096;
        const float sg = bc * gmc;
        const int cs = (lane & ~31) + sw23(lane & 31);
        const int lcol = (cs >> 4) * 512 + ((cs >> 3) & 1) * 256 + (cs & 7);
        LAS unsigned char* stg = lds + wave * 16384 + 2048; LAS bf16* st = (LAS bf16*)stg;
#pragma unroll
        for (int i = 0; i < 64; ++i) st[(i >> 5) * 2048 + (i & 31) * 8 + lcol] = f2bf(T[i] * sg);
        stage_out8k(stg, tg, lane);
#pragma unroll
        for (int i = 0; i < 64; ++i) st[(i >> 5) * 2048 + (i & 31) * 8 + lcol] = f2bf(T[i] * bc);
        stage_out8k(stg, tb, lane);
    }
}
__device__ __forceinline__ void delta_d3_unit(unsigned char* ws, int uh, int lane) {
    asm volatile("" : "+v"(lane));
    const bf16* TG = (const bf16*)(ws + WS_DTG); const bf16* TB = (const bf16*)(ws + WS_DTB); const bf16* KT = (const bf16*)(ws + WS_DKT); const bf16* VT = (const bf16*)(ws + WS_DVT);
    bf16* WG = (bf16*)(ws + WS_DWG); bf16* UG = (bf16*)(ws + WS_DUG);
    const int m = lane & 31, half = lane >> 5;
    const int c = uh % NCH, bh = uh / NCH, h = bh & 31, b = bh >> 5;
    const size_t uq = ((size_t)(b * 16 + (h >> 1))) * NCH + c;
    {
        const bf16* Tm = TG + (size_t)uh * 4096; const bf16* Kf = KT + uq * 8192;
        f32x16 acc[4][2];
#pragma unroll
        for (int dn = 0; dn < 4; ++dn)
#pragma unroll
            for (int ti = 0; ti < 2; ++ti)
#pragma unroll
                for (int i = 0; i < 16; ++i) acc[dn][ti][i] = 0.f;
#pragma unroll
        for (int ks = 0; ks < 4; ++ks) {
            bf16x8 a[4], bb[2];
#pragma unroll
            for (int dn = 0; dn < 4; ++dn) a[dn] = *(const bf16x8*)(Kf + ((size_t)(((dn * 2 + (ks >> 1)) * 2 + (ks & 1)) * 64 + lane)) * 8);
#pragma unroll
            for (int ti = 0; ti < 2; ++ti) bb[ti] = *(const bf16x8*)(Tm + ((size_t)((ti * 4 + ks) * 64 + lane)) * 8);
#pragma unroll
            for (int dn = 0; dn < 4; ++dn)
#pragma unroll
                for (int ti = 0; ti < 2; ++ti) acc[dn][ti] = MFMA32(a[dn], bb[ti], acc[dn][ti]);
        }
        bf16* wg = WG + (size_t)uh * 8192;
#pragma unroll
        for (int dn = 0; dn < 4; ++dn)
#pragma unroll
            for (int ti = 0; ti < 2; ++ti)
#pragma unroll
                for (int s2 = 0; s2 < 2; ++s2) *(v4u*)(wg + ((size_t)(((ti * 4 + dn) * 2 + s2) * 64 + lane)) * 8) = pack_frag(acc[dn][ti], s2);
    }
    {
        const bf16* Tm = TB + (size_t)uh * 4096; const bf16* Bt = VT + (size_t)uh * 8192;
        f32x16 acc[2][4];
#pragma unroll
        for (int ti = 0; ti < 2; ++ti)
#pragma unroll
            for (int dn = 0; dn < 4; ++dn)
#pragma unroll
                for (int i = 0; i < 16; ++i) acc[ti][dn][i] = 0.f;
#pragma unroll
        for (int ks = 0; ks < 4; ++ks) {
            bf16x8 a[2], bb[4];
#pragma unroll
            for (int ti = 0; ti < 2; ++ti) a[ti] = *(const bf16x8*)(Tm + ((size_t)((ti * 4 + ks) * 64 + lane)) * 8);
#pragma unroll
            for (int dn = 0; dn < 4; ++dn) bb[dn] = *(const bf16x8*)(Bt + ((size_t)((dn * 4 + ks) * 64 + lane)) * 8);
#pragma unroll
            for (int ti = 0; ti < 2; ++ti)
#pragma unroll
                for (int dn = 0; dn < 4; ++dn) acc[ti][dn] = MFMA32(a[ti], bb[dn], acc[ti][dn]);
        }
        bf16* ug = UG + (size_t)uh * 8192;
#pragma unroll
        for (int ti = 0; ti < 2; ++ti)
#pragma unroll
            for (int dn = 0; dn < 4; ++dn) { bf16* p = ug + ((size_t)((ti * 4 + dn) * 64 + lane)) * 16; *(v4u*)p = pack_frag(acc[ti][dn], 0); *(v4u*)(p + 8) = pack_frag(acc[ti][dn], 1); }
    }
}
__device__ __forceinline__ void delta_pre(unsigned char* ws, LAS unsigned char* lds, int gw, int NGW, int wave, int lane) {
    const int nextra = (NUQ > NGW && NUQ < 2 * NGW) ? NUQ - NGW : 0;
    for (int rep = 0; rep < 2 || nextra == 0; ++rep) {
        int uq;
        if (nextra == 0) { uq = gw + rep * NGW; if (uq >= NUQ) break; }
        else if (rep == 0) uq = gw;
        else { if ((gw & 63) != 0 || (gw >> 6) >= nextra) break; uq = NGW + (gw >> 6); }
#ifndef NO_D1
        delta_d1_unit(ws, lds, uq, wave, lane);
#endif
#ifdef DUP_D1
        delta_d1_unit(ws, lds, uq, wave, lane);
#endif
        asm volatile("s_waitcnt vmcnt(0)" ::: "memory");
        const int c = uq % NCH, bh = uq / NCH, hq = bh & 15, b = bh >> 4;
#pragma unroll 1
        for (int hh = 0; hh < 2; ++hh) { const int uh = (b * 32 + 2 * hq + hh) * NCH + c;
#ifndef NO_D2
            delta_d2_unit(ws, lds, uh, wave, lane);
#endif
#ifdef DUP_D2
            delta_d2_unit(ws, lds, uh, wave, lane);
#endif
            asm volatile("s_waitcnt vmcnt(0)" ::: "memory");
#ifndef NO_D3
            delta_d3_unit(ws, uh, lane);
#endif
#ifdef DUP_D3
            delta_d3_unit(ws, uh, lane);
#endif
        }
    }
}
__device__ __forceinline__ bf16x8 afrag_perm(const bf16* rowp, int blk, int s, int half) {
    const v2u lo = *(const v2u*)(rowp + 32 * blk + 16 * s + 4 * half), hi2 = *(const v2u*)(rowp + 32 * blk + 16 * s + 8 + 4 * half);
    v4u w; w.x = lo.x; w.y = lo.y; w.z = hi2.x; w.w = hi2.y; return __builtin_bit_cast(bf16x8, w);
}
#define LBAR() asm volatile("s_waitcnt lgkmcnt(0)\n\ts_barrier" ::: "memory")
__device__ __forceinline__ void delta_d4(unsigned char* ws, float* out_state, LAS unsigned char* lds, int tid, int wave, int lane) {
    const bf16* QKVC = (const bf16*)(ws + WS_QKVC); const bf16* KT = (const bf16*)(ws + WS_DKT); const bf16* PG = (const bf16*)(ws + WS_DPG);
    const bf16* WG = (const bf16*)(ws + WS_DWG); const bf16* UG = (const bf16*)(ws + WS_DUG); const float* GC = (const float*)(ws + WS_DGC);
    bf16* OF = (bf16*)(ws + WS_SC);
    LAS v4u* Sfr = (LAS v4u*)lds;
    LAS v4u* Dfr = (LAS v4u*)(lds + 16384);
    LAS v4u* Dtf = (LAS v4u*)(lds + 16384 + 4096);
    LAS float* gam = (LAS float*)(lds + 16384 + 8192);
    const int m = lane & 31, half = lane >> 5;
    const bf16x8 zf = {0, 0, 0, 0, 0, 0, 0, 0};
    for (int item = blockIdx.x; item < NBP * 32 * 4; item += gridDim.x) {
        const int xg = item & 7, jj = item >> 3, pair = xg * 4 + (jj >> 3), q = jj & 3, h = 2 * (pair & 15) + ((jj >> 2) & 1), b = pair >> 4;
        const size_t uh0 = ((size_t)(b * 32 + h)) * NCH, uq0 = ((size_t)(b * 16 + (h >> 1))) * NCH;
        const int rt = wave & 1; const bool isq = wave >= 6;
#define ROT3(LOADM, STEPM) do { LOADM(0, 0); LOADM(1, 1); \
            for (int c = 0; c < NCH; c += 3) { \
                if (c + 2 < NCH) LOADM(c + 2, 2); \
                STEPM(c, 0); \
                if (c + 1 < NCH) { if (c + 3 < NCH) LOADM(c + 3, 0); STEPM(c + 1, 1); } \
                if (c + 2 < NCH) { if (c + 4 < NCH) LOADM(c + 4, 1); STEPM(c + 2, 2); } } } while (0)
#define ROT2(LOADM, STEPM) do { LOADM(0, 0); \
            for (int c = 0; c < NCH; c += 2) { \
                if (c + 1 < NCH) LOADM(c + 1, 1); \
                STEPM(c, 0); \
                if (c + 1 < NCH) { if (c + 2 < NCH) LOADM(c + 2, 0); STEPM(c + 1, 1); } } } while (0)
        LBAR();
        if (wave < 4) {
            int ll_ = lane; asm volatile("" : "+v"(ll_)); const int lane = ll_, m = lane & 31, half = lane >> 5; (void)m; (void)half;
            { const v4u z = {0u, 0u, 0u, 0u}; Sfr[(0 * 4 + wave) * 128 + lane] = z; Sfr[(0 * 4 + wave) * 128 + 64 + lane] = z; }
            bf16x8 kf[2][4];
            f32x16 S;
#pragma unroll
            for (int i = 0; i < 16; ++i) S[i] = 0.f;
#define LOAD_K(cc, B) do { const bf16* kr_ = KT + (uq0 + (cc)) * 8192; \
                _Pragma("unroll") for (int blk = 0; blk < 2; ++blk) _Pragma("unroll") for (int s_ = 0; s_ < 2; ++s_) kf[B][blk * 2 + s_] = *(const bf16x8*)(kr_ + ((size_t)(((wave * 2 + blk) * 2 + s_) * 64 + lane)) * 8); } while (0)
#define STEP_K(c, B) do { const int bufc = (c) & 1; LBAR(); LBAR(); \
                const float gl = gam[bufc * 64 + 63]; \
                _Pragma("unroll") for (int i = 0; i < 16; ++i) S[i] *= gl; \
                _Pragma("unroll") for (int blk = 0; blk < 2; ++blk) _Pragma("unroll") for (int s = 0; s < 2; ++s) S = MFMA32(kf[B][blk * 2 + s], __builtin_bit_cast(bf16x8, Dtf[(blk * 2 + s) * 64 + lane]), S); \
                _Pragma("unroll") for (int s = 0; s < 2; ++s) Sfr[((bufc ^ 1) * 4 + wave) * 128 + s * 64 + lane] = pack_frag(S, s); } while (0)
#ifndef NO_RK
            ROT2(LOAD_K, STEP_K);
#endif
            { float* o = out_state + ((size_t)((b * 32 + h) * 128 + 32 * wave)) * 128 + 32 * q + m;
#pragma unroll
              for (int r = 0; r < 16; ++r) o[(size_t)sw23(crow32(r, half)) * 128] = S[r]; }
#undef LOAD_K
#undef STEP_K
        } else if (!isq) {
            int ll_ = lane; asm volatile("" : "+v"(ll_)); const int lane = ll_, m = lane & 31, half = lane >> 5; (void)m; (void)half;
            bf16x8 wf[3][8], uf[3][2]; float gcv[3] = {0.f, 0.f, 0.f};
#define LOAD_W(cc, B) do { const bf16* wb_ = WG + (uh0 + (cc)) * 8192 + ((size_t)(rt * 512 + lane)) * 8; \
                _Pragma("unroll") for (int blk = 0; blk < 4; ++blk) _Pragma("unroll") for (int s_ = 0; s_ < 2; ++s_) wf[B][blk * 2 + s_] = *(const bf16x8*)(wb_ + blk * 1024 + s_ * 512); \
                const bf16* ub_ = UG + (uh0 + (cc)) * 8192 + ((size_t)((rt * 4 + q) * 64 + lane)) * 16; uf[B][0] = *(const bf16x8*)ub_; uf[B][1] = *(const bf16x8*)(ub_ + 8); \
                if (wave == 4) gcv[B] = GC[(uh0 + (cc)) * 64 + lane]; } while (0)
#define STEP_W(c, B) do { const int bufc = (c) & 1; LBAR(); \
                f32x16 acc; \
                _Pragma("unroll") for (int i = 0; i < 16; ++i) acc[i] = 0.f; \
                _Pragma("unroll") for (int blk = 0; blk < 4; ++blk) _Pragma("unroll") for (int s = 0; s < 2; ++s) \
                    acc = MFMA32(wf[B][blk * 2 + s], __builtin_bit_cast(bf16x8, Sfr[(bufc * 4 + blk) * 128 + s * 64 + lane]), acc); \
                { float t8[8]; unpack8(__builtin_bit_cast(v4u, uf[B][0]), t8); \
                    _Pragma("unroll") for (int i = 0; i < 8; ++i) acc[i] = t8[i] - acc[i]; unpack8(__builtin_bit_cast(v4u, uf[B][1]), t8); \
                    _Pragma("unroll") for (int i = 0; i < 8; ++i) acc[8 + i] = t8[i] - acc[8 + i]; } \
                _Pragma("unroll") for (int s = 0; s < 2; ++s) Dfr[(rt * 2 + s) * 64 + lane] = pack_frag(acc, s); \
                _Pragma("unroll") for (int r = 0; r < 16; ++r) acc[r] *= gam[128 + bufc * 64 + 32 * rt + crow32(r, half)]; \
                _Pragma("unroll") for (int s = 0; s < 2; ++s) Dtf[(rt * 2 + s) * 64 + lane] = pack_frag(acc, s); \
                LBAR(); \
                if (wave == 4 && (c) + 1 < NCH) { const float gn_ = gcv[((B) + 1) % 3], gl_ = __shfl(gn_, 63); gam[(bufc ^ 1) * 64 + lane] = __expf(gn_); gam[128 + (bufc ^ 1) * 64 + lane] = __expf(gl_ - gn_); } } while (0)
            if (wave == 4) { const float gc = GC[(uh0 + 0) * 64 + lane], gl = __shfl(gc, 63); gam[lane] = __expf(gc); gam[128 + lane] = __expf(gl - gc); }
#ifndef NO_RW
            ROT3(LOAD_W, STEP_W);
#endif
#undef LOAD_W
#undef STEP_W
        } else {
            int ll_ = lane; asm volatile("" : "+v"(ll_)); const int lane = ll_, m = lane & 31, half = lane >> 5; (void)m; (void)half;
            bf16x8 qf[1][8], pf[1][4];
#define LOAD_Q(cc, B) do { const int row_ = chunk_row(b, (cc), 32 * rt + m); const bool ok_ = row_ >= 0; \
                const bf16* qb_ = QKVC + (size_t)(row_ < 0 ? 0 : row_) * CDIM + (h >> 1) * 128 + 8 * half; \
                _Pragma("unroll") for (int blk = 0; blk < 4; ++blk) _Pragma("unroll") for (int s_ = 0; s_ < 2; ++s_) qf[B][blk * 2 + s_] = sel8(ok_, *(const bf16x8*)(qb_ + blk * 32 + s_ * 16)); \
                } while (0)
#define LOAD_P(cc, PB) do { const bf16* pb_ = PG + (uh0 + (cc)) * 4096 + ((size_t)(rt * 256 + lane)) * 8; \
                _Pragma("unroll") for (int blk = 0; blk < 2; ++blk) _Pragma("unroll") for (int s_ = 0; s_ < 2; ++s_) pf[PB][blk * 2 + s_] = sel8(blk <= rt, *(const bf16x8*)(pb_ + blk * 1024 + s_ * 512)); } while (0)
#define STEP_Q(c) do { const int bufc = (c) & 1; LBAR(); \
                LOAD_P((c), 0);                                                    \
                f32x16 acc; \
                _Pragma("unroll") for (int i = 0; i < 16; ++i) acc[i] = 0.f; \
                _Pragma("unroll") for (int blk = 0; blk < 4; ++blk) _Pragma("unroll") for (int s = 0; s < 2; ++s) \
                    acc = MFMA32(qf[0][blk * 2 + s], __builtin_bit_cast(bf16x8, Sfr[(bufc * 4 + blk) * 128 + s * 64 + lane]), acc); \
                if ((c) + 1 < NCH) LOAD_Q((c) + 1, 0);                             \
                LBAR(); \
                _Pragma("unroll") for (int r = 0; r < 16; ++r) acc[r] *= gam[bufc * 64 + 32 * rt + crow32(r, half)]; \
                _Pragma("unroll") for (int blk = 0; blk < 2; ++blk) _Pragma("unroll") for (int s = 0; s < 2; ++s) acc = MFMA32(pf[0][blk * 2 + s], __builtin_bit_cast(bf16x8, Dfr[(blk * 2 + s) * 64 + lane]), acc); \
                _Pragma("unroll") for (int r = 0; r < 16; ++r) { const int row = chunk_row(b, (c), 32 * rt + crow32(r, half)); if (row >= 0) OF[(size_t)row * DVW + h * 128 + 32 * q + m] = f2bf(acc[r]); } } while (0)
#ifndef NO_RQ
            LOAD_Q(0, 0);
            for (int c = 0; c < NCH; ++c) STEP_Q(c);
#endif
#undef LOAD_Q
#undef LOAD_P
#undef STEP_Q
        }
#undef ROT2
#undef ROT3
    }
    LBAR();
}
#undef LBAR
#undef MFMA32
template <int RT, int CT, int UNR = 4, class Epi>
__device__ __forceinline__ void small_gemm_unit(const bf16* A, int lda, const bf16* Bt, int ldb, int k0, int klen, LAS unsigned char* lds, const Epi& E, int tid, int wave, int lane) {
    const int r16 = lane & 15, q = lane >> 4;
    const int kw = klen >> 3;
    const bf16* ap = A + (size_t)r16 * lda + k0 + wave * kw + 8 * q;
    const bf16* bp = Bt + (size_t)r16 * ldb + k0 + wave * kw + 8 * q;
    pg8::f32x4 acc[RT][CT];
#pragma unroll
    for (int i = 0; i < RT; ++i)
#pragma unroll
        for (int j = 0; j < CT; ++j) acc[i][j] = (pg8::f32x4){0.f, 0.f, 0.f, 0.f};
#pragma unroll UNR
    for (int ks = 0; ks < kw; ks += 32) {
        bf16x8 a[RT], b[CT];
#pragma unroll
        for (int i = 0; i < RT; ++i) a[i] = *(const bf16x8*)(ap + (size_t)(16 * i) * lda + ks);
#pragma unroll
        for (int j = 0; j < CT; ++j) b[j] = *(const bf16x8*)(bp + (size_t)(16 * j) * ldb + ks);
#pragma unroll
        for (int i = 0; i < RT; ++i)
#pragma unroll
            for (int j = 0; j < CT; ++j) acc[i][j] = __builtin_amdgcn_mfma_f32_16x16x32_bf16(a[i], b[j], acc[i][j], 0, 0, 0);
    }
    constexpr int NOUT = 256 * RT * CT;
    LAS float* part = (LAS float*)lds + wave * NOUT;
#pragma unroll
    for (int i = 0; i < RT; ++i)
#pragma unroll
        for (int j = 0; j < CT; ++j)
#pragma unroll
            for (int e = 0; e < 4; ++e) part[(16 * i + 4 * q + e) * (16 * CT) + 16 * j + r16] = acc[i][j][e];
    __syncthreads();
    for (int o = tid; o < NOUT; o += NTHREADS) { float sum = 0.f;
#pragma unroll
        for (int w = 0; w < 8; ++w) sum += ((LAS float*)lds)[w * NOUT + o];
        E(o / (16 * CT), o % (16 * CT), sum); }
    __syncthreads();
}
template <int ACT> struct SEpiRowsBf16 { bf16* O; int ldc; __device__ __forceinline__ void operator()(int row, int col, float v) const { if (ACT == 2) { v = v > 0.f ? v : 0.f; v = v * v; } O[(size_t)row * ldc + col] = f2bf(v); } };
struct SEpiF32 { float* O; int ldc; __device__ __forceinline__ void operator()(int row, int col, float v) const { O[(size_t)row * ldc + col] = v; } };
struct SEpiColsBf16 { bf16* O; int ldc; __device__ __forceinline__ void operator()(int row, int col, float v) const { O[(size_t)col * ldc + row] = f2bf(v); } };
template <int ACT> __device__ __forceinline__ void skinny_rows_bf16(const bf16* A, const bf16* Wt, int K, int nunits, bf16* O, int ldc, LAS unsigned char* lds, int tid, int wave, int lane) {
    for (int u = blockIdx.x; u < 2 * nunits; u += gridDim.x) { SEpiRowsBf16<ACT> E{O + (size_t)XROW0 * ldc + u * 32, ldc};
        small_gemm_unit<3, 2, 8>(A + (size_t)XROW0 * K, K, Wt + (size_t)u * 32 * K, K, 0, K, lds, E, tid, wave, lane); }
}
__device__ __forceinline__ void skinny_rows_part(const bf16* A, const bf16* Wt, int K, float* ZP, LAS unsigned char* lds, int tid, int wave, int lane) {
    for (int u = blockIdx.x; u < 256; u += gridDim.x) { const int cgp = u & 31, ksl = u >> 5; SEpiF32 E{ZP + (size_t)ksl * XR * DM + cgp * 64, DM};
        small_gemm_unit<3, 4>(A + (size_t)XROW0 * K, K, Wt + (size_t)cgp * 64 * K, K, ksl * (K >> 3), K >> 3, lds, E, tid, wave, lane); }
}
template <int RT> __device__ __forceinline__ void tail_cols_bf16(const bf16* A, const bf16* Wt, int K, int c0, bf16* O, int ldc, LAS unsigned char* lds, int tid, int wave, int lane) {
    for (int u = blockIdx.x; u < MAINM / 32; u += gridDim.x) { SEpiColsBf16 E{O + (size_t)u * 32 * ldc + c0, ldc};
        small_gemm_unit<RT, 2>(Wt + (size_t)c0 * K, K, A + (size_t)u * 32 * K, K, 0, K, lds, E, tid, wave, lane); }
}

typedef __attribute__((address_space(4))) const unsigned long long* kargq_t;
#define KPF_(k) ((const float*)(const GAS float*)(q_[k]))
__device__ __forceinline__ void load_ptrs(Ptrs& P) {
    kargq_t q_ = (kargq_t)__builtin_amdgcn_kernarg_segment_ptr();
    asm volatile("" : "+s"(q_));
    P.x_prompt = KPF_(0); P.x_sample = KPF_(1); P.state_conv_a = KPF_(2); P.cache_k = KPF_(3);
    P.cache_v = KPF_(4); P.cache_ik = KPF_(5); P.state_conv_c = KPF_(6); P.state_delta = KPF_(7);
    P.page_table = ((const int*)(const GAS int*)(q_[8])); P.meta = KPF_(9); P.w_in_a = KPF_(10); P.conv_w_a = KPF_(11);
    P.w_out_a = KPF_(12); P.w_in_b = KPF_(13); P.w_out_b = KPF_(14); P.w_in_c = KPF_(15);
    P.conv_w_c = KPF_(16); P.a_log = KPF_(17); P.dt_bias = KPF_(18); P.norm_w = KPF_(19);
    P.w_out_c = KPF_(20); P.ln1_g = KPF_(21); P.ln1_b = KPF_(22); P.w1 = KPF_(23);
    P.w2 = KPF_(24); P.ln2_g = KPF_(25); P.ln2_b = KPF_(26);
    P.out = (float*)(GAS float*)(q_[27]); P.ws = (unsigned char*)(GAS unsigned char*)(q_[28]);
}
struct Args { const void* in[27]; float* out; unsigned char* ws; int ph_lo, ph_hi; };
constexpr int PH_PER_LAYER = 12, PH_END = 1 + 4 * PH_PER_LAYER;

__global__ void __launch_bounds__(NTHREADS, 2) mega_fwd(Args args) {
    extern __shared__ __attribute__((aligned(16))) unsigned char lds_raw[];
    LAS unsigned char* lds = (LAS unsigned char*)lds_raw;
    const int tid = threadIdx.x, lane = tid & 63, wave = __builtin_amdgcn_readfirstlane(tid >> 6);
    const int G_ = gridDim.x, NGW = G_ * NWAVES, NT = G_ * NTHREADS; (void)lane;
    unsigned char* ws = args.ws;
    const int lo = args.ph_lo, hi = args.ph_hi;
    const bool fused = (hi - lo) > 1;

    for (int u = tid; u < (LDS_BYTES - LDSCTL_OFF) / 4; u += NTHREADS) ((LAS unsigned*)(lds + LDSCTL_OFF))[u] = 0u;
    __syncthreads();
    volatile LAS unsigned* MISC = (volatile LAS unsigned*)(lds + MISC_OFF);
    XcdBarrier bar; bar.bar = (unsigned*)(ws + WS_CTL) + CW_BAR; bar.x = 0; bar.st = nullptr;
    if (fused) bar = xcd_barrier_post((unsigned*)(ws + WS_CTL) + CW_BAR, MISC + 8);
    bar.wv = wave;

#ifndef MK_SITES
#define MK_SITES 0xffffffffu
#endif
#define SITE(n) (((MK_SITES) >> (n)) & 1u)
#define IN(k) (lo <= (k) && (k) < hi)
#ifndef MK_DUP
#define MK_DUP 0u
#endif
#define NREP(n) ((((MK_DUP) >> (n)) & 1u) ? 2 : 1)
#ifdef MK_SKINNY2
#define SKREP 2
#else
#define SKREP 1
#endif
#define BEGIN_SITE(n, id) if (SITE(n) && IN(id)) { for (int rp_ = 0; rp_ < NREP(n); ++rp_) { Ptrs P; load_ptrs(P); unsigned char* ws = P.ws; (void)ws; \
    bf16* X = (bf16*)(P.ws + WS_X); float* Z = (float*)(P.ws + WS_Z); float* ZP = (float*)(P.ws + WS_ZP); bf16* Y = (bf16*)(P.ws + WS_Y); bf16* BIG = (bf16*)(P.ws + WS_BIG); (void)X; (void)Z; (void)ZP; (void)Y; (void)BIG;
#define END_SITE(id) SEAM(id); } }
#define LOCALS int tid_ = threadIdx.x; asm volatile("" : "+v"(tid_)); const int lane_ = tid_ & 63, wave_ = __builtin_amdgcn_readfirstlane(tid_ >> 6), gw_ = blockIdx.x * NWAVES + wave_, gtid_ = blockIdx.x * NTHREADS + tid_; (void)lane_; (void)wave_; (void)gw_; (void)gtid_
#define SEAM(k) do { if (fused && (k) + 1 < PH_END) xcd_barrier(bar); else __syncthreads(); } while (0)


    BEGIN_SITE(0, 0) LOCALS; p0_prologue(P, lds, gw_, NGW, wave_, lane_); END_SITE(0)
#ifdef MK_XBAR
    if (fused) { for (int xb_ = 0; xb_ < MK_XBAR; ++xb_) xcd_barrier(bar); }
#endif

    for (int layer = 0; layer < 4; ++layer) {
        const int kind = layer % 3, j = layer / 3, base = 1 + layer * PH_PER_LAYER;
        if (kind == 0) {
            BEGIN_SITE(1, base + 0)
                const bf16* Wt = (const bf16*)(ws + WS_WA_IN + (size_t)j * WSZ_A_IN); pg8::Gemm g{X, Wt, MAINM, NA_IN, DM}; pg8::StaticOrder S; S.init(MAINM, NA_IN, G_, (int)blockIdx.x);
                pg8::EpiBf16<0> E{BIG, NA_IN, nullptr, 0, 0, 1.f};
                pg8::gemm_phase<pg8::EpiBf16<0>, pg8::StaticOrder, true, true>(lds, g, S, E, wave);
                { LOCALS; for (int sk_ = 0; sk_ < SKREP; ++sk_) { skinny_rows_bf16<0>(X, Wt, DM, NA_IN / 64, BIG, NA_IN, lds, tid_, wave_, lane_); } }
                END_SITE(base + 0)
            BEGIN_SITE(2, base + 1)
                LOCALS; convA_phase(BIG, Y, P.conv_w_a + (size_t)j * 3 * DM, P.state_conv_a + (size_t)j * SBN * 2 * DM, P.out + O_CAP + (size_t)j * NBP * 2 * DM, P.out + O_CAS + (size_t)j * SBN * 2 * DM, gtid_, NT);
                END_SITE(base + 1)
            BEGIN_SITE(3, base + 2)
                const bf16* Wt = (const bf16*)(ws + WS_WA_OUT + (size_t)j * WSZ_A_OUT); pg8::Gemm g{Y, Wt, MAINM, DM, DM}; pg8::StaticOrder S; S.init(MAINM, DM, G_, (int)blockIdx.x);
                pg8::EpiResBf16 E{X, DM, ALPHA};
                pg8::gemm_phase<pg8::EpiResBf16, pg8::StaticOrder, true, true>(lds, g, S, E, wave);
                { LOCALS; for (int sk_ = 0; sk_ < SKREP; ++sk_) { skinny_rows_part(Y, Wt, DM, ZP, lds, tid_, wave_, lane_); } }
                END_SITE(base + 2)
        } else if (kind == 1) {
            BEGIN_SITE(4, base + 0)
                const bf16* Wt = (const bf16*)(ws + WS_WB_IN); pg8::Gemm g{X, Wt, MAINM, 4096, DM}; pg8::StaticOrder S; S.init(MAINM, 4096, G_, (int)blockIdx.x);
                pg8::EpiBf16<0> E{BIG, NB_PAD, nullptr, 0, 0, 1.f};
                pg8::gemm_phase<pg8::EpiBf16<0>, pg8::StaticOrder, true, true>(lds, g, S, E, wave);
                { LOCALS; for (int sk_ = 0; sk_ < SKREP; ++sk_) { tail_cols_bf16<5>(X, Wt, DM, 4096, BIG, NB_PAD, lds, tid_, wave_, lane_); skinny_rows_bf16<0>(X, Wt, DM, 4224 / 64, BIG, NB_PAD, lds, tid_, wave_, lane_); } }
                END_SITE(base + 0)
            BEGIN_SITE(5, base + 1) LOCALS; rope_phase(BIG, P, gw_, NGW, lane_); END_SITE(base + 1)
            BEGIN_SITE(6, base + 2) LOCALS; indexer_sample(P, lds, tid_); indexer_prompt(P, lds, tid_, wave_, lane_); END_SITE(base + 2)
            BEGIN_SITE(7, base + 3) LOCALS; select_phase(P, lds, gw_, NGW, tid_, wave_, lane_); END_SITE(base + 3)
#ifdef ATTN_PROBE
            if (IN(base + 4)) { Ptrs P; load_ptrs(P); bf16* Y = (bf16*)(P.ws + WS_Y); LOCALS; dense_attn_phase<ATTN_PROBE>(P, Y, (char*)lds_raw, wave_); __syncthreads(); }
#endif
            BEGIN_SITE(8, base + 4) LOCALS; dense_attn_phase(P, Y, (char*)lds_raw, wave_); attn_phase(P, Y, lds, tid_, wave_, lane_); END_SITE(base + 4)
            BEGIN_SITE(9, base + 5)
                const bf16* Wt = (const bf16*)(ws + WS_WB_OUT); pg8::Gemm g{Y, Wt, MAINM, DM, DM}; pg8::StaticOrder S; S.init(MAINM, DM, G_, (int)blockIdx.x);
                pg8::EpiResBf16 E{X, DM, ALPHA};
                pg8::gemm_phase<pg8::EpiResBf16, pg8::StaticOrder, true, true>(lds, g, S, E, wave);
                { LOCALS; for (int sk_ = 0; sk_ < SKREP; ++sk_) { skinny_rows_part(Y, Wt, DM, ZP, lds, tid_, wave_, lane_); } }
                END_SITE(base + 5)
        } else {
            BEGIN_SITE(10, base + 0)
                const bf16* Wt = (const bf16*)(ws + WS_WC_IN); pg8::Gemm g{X, Wt, MAINM, 12288, DM}; pg8::StaticOrder S; S.init(MAINM, 12288, G_, (int)blockIdx.x);
                pg8::EpiBf16<0> E{BIG, NC_PAD, nullptr, 0, 0, 1.f};
                pg8::gemm_phase<pg8::EpiBf16<0>, pg8::StaticOrder, true, true>(lds, g, S, E, wave);
                { LOCALS; for (int sk_ = 0; sk_ < SKREP; ++sk_) { tail_cols_bf16<4>(X, Wt, DM, 12288, BIG, NC_PAD, lds, tid_, wave_, lane_); skinny_rows_bf16<0>(X, Wt, DM, NC_IN / 64, BIG, NC_PAD, lds, tid_, wave_, lane_); } }
                END_SITE(base + 0)
            BEGIN_SITE(11, base + 1) LOCALS; convC_phase(BIG, P, gw_, NGW, lane_); END_SITE(base + 1)
            BEGIN_SITE(19, base + 2) LOCALS;
#pragma unroll 1
                for (int half_ = 0; half_ < 2; ++half_) {
                    if ((half_ == 0) == ((wave_ & 1) == 0)) delta_pre(P.ws, lds, gw_, NGW, wave_, lane_);
                    else { const int nbusy = (NUQ > NGW && NUQ < 2 * NGW) ? NUQ - NGW : 0;
                      const bool busy = nbusy > 0 && (gw_ & 63) == 0 && (gw_ >> 6) < nbusy; const int below = nbusy == 0 ? 0 : (((gw_ + 63) >> 6) < nbusy ? ((gw_ + 63) >> 6) : nbusy);
                      if (!busy) { delta_phase(P, gw_ - below, NGW - nbusy, lane_); deferred_transposes(P, lds, gw_ - below, NGW - nbusy, wave_, lane_); } }
                }
            END_SITE(base + 2)
            BEGIN_SITE(22, base + 5) LOCALS; delta_d4(P.ws, P.out + O_DP, lds, tid_, wave_, lane_); END_SITE(base + 5)
            BEGIN_SITE(13, base + 6) LOCALS; normC_phase(BIG, Y, P, gw_, NGW, lane_); END_SITE(base + 6)
            BEGIN_SITE(14, base + 7)
                const bf16* Wt = (const bf16*)(ws + WS_WC_OUT); pg8::Gemm g{Y, Wt, MAINM, DM, DVW}; pg8::StaticOrder S; S.init(MAINM, DM, G_, (int)blockIdx.x);
                pg8::EpiResBf16 E{X, DM, ALPHA};
                pg8::gemm_phase<pg8::EpiResBf16, pg8::StaticOrder, true, true>(lds, g, S, E, wave);
                { LOCALS; for (int sk_ = 0; sk_ < SKREP; ++sk_) { skinny_rows_part(Y, Wt, DVW, ZP, lds, tid_, wave_, lane_); } }
                END_SITE(base + 7)
        }
        BEGIN_SITE(15, base + 8) LOCALS; ln_phase(Z, ZP, X, rp_ == 0 ? X : (bf16*)(P.ws + WS_QR), P.ln1_g + (size_t)layer * DM, P.ln1_b + (size_t)layer * DM, nullptr, nullptr, lds, gw_, NGW, tid_, wave_, lane_); END_SITE(base + 8)
        BEGIN_SITE(16, base + 9)
            const bf16* Wt = (const bf16*)(ws + WS_W1 + (size_t)layer * WSZ_W1); pg8::Gemm g{X, Wt, MAINM, FF, DM}; pg8::StaticOrder S; S.init(MAINM, FF, G_, (int)blockIdx.x);
            pg8::EpiBf16<2> E{BIG, FF, nullptr, 0, 0, 1.f};
            pg8::gemm_phase<pg8::EpiBf16<2>, pg8::StaticOrder, true, true>(lds, g, S, E, wave);
            { LOCALS; for (int sk_ = 0; sk_ < SKREP; ++sk_) { skinny_rows_bf16<2>(X, Wt, DM, FF / 64, BIG, FF, lds, tid_, wave_, lane_); } }
            END_SITE(base + 9)
        BEGIN_SITE(17, base + 10)
            const bf16* Wt = (const bf16*)(ws + WS_W2 + (size_t)layer * WSZ_W2); pg8::Gemm g{BIG, Wt, MAINM, DM, FF}; pg8::StaticOrder S; S.init(MAINM, DM, G_, (int)blockIdx.x);
            pg8::EpiResBf16 E{X, DM, ALPHA};
            pg8::gemm_phase<pg8::EpiResBf16, pg8::StaticOrder, true, true>(lds, g, S, E, wave);
            { LOCALS; for (int sk_ = 0; sk_ < SKREP; ++sk_) { skinny_rows_part(BIG, Wt, FF, ZP, lds, tid_, wave_, lane_); } }
            END_SITE(base + 10)
        BEGIN_SITE(18, base + 11)
            const bool last = layer == 3;
            LOCALS; ln_phase(Z, ZP, X, rp_ == 0 ? X : (bf16*)(P.ws + WS_QR), P.ln2_g + (size_t)layer * DM, P.ln2_b + (size_t)layer * DM, last ? P.out + O_YP : nullptr, last ? P.out + O_YS : nullptr, lds, gw_, NGW, tid_, wave_, lane_);
            if (!last) SEAM(base + 11); } }
    }
#undef IN
#undef SEAM
}

#ifndef MK_SPLIT
#define MK_SPLIT 0
#endif
extern "C" void kernel_launch(void* const* d_in, const int* in_sizes, int n_in, void* d_out, int out_size, void* d_ws, size_t ws_size, hipStream_t stream) {
    static int grid = 0;
    if (grid == 0) {
        if (n_in != 27 || (size_t)out_size != O_END || ws_size < WS_END) { fprintf(stderr, "kernel_launch: unexpected shapes: n_in %d out %d (want %zu) ws %zu (want >= %zu)\n", n_in, out_size, (size_t)O_END, ws_size, (size_t)WS_END); grid = -1; return; }
        int dev = 0, cus = 0;
        if (hipGetDevice(&dev) != hipSuccess || hipDeviceGetAttribute(&cus, hipDeviceAttributeMultiprocessorCount, dev) != hipSuccess) { grid = -1; return; }
        if (hipFuncSetAttribute((const void*)mega_fwd, hipFuncAttributeMaxDynamicSharedMemorySize, LDS_BYTES) != hipSuccess) { fprintf(stderr, "kernel_launch: hipFuncSetAttribute failed\n"); grid = -1; return; }
        int per_cu = 0;
        if (hipOccupancyMaxActiveBlocksPerMultiprocessor(&per_cu, (const void*)mega_fwd, NTHREADS, LDS_BYTES) != hipSuccess || per_cu < 1) fprintf(stderr, "kernel_launch: occupancy query reports %d\n", per_cu);
        (void)hipGetLastError();
        grid = cus;
    }
    if (grid < 0) return;
    (void)hipMemsetAsync((char*)d_ws + WS_CTL, 0, CTL_ZERO_BYTES, stream);
    Args a{};
    for (int i = 0; i < 27; ++i) a.in[i] = d_in[i];
    a.out = (float*)d_out; a.ws = (unsigned char*)d_ws;
#if MK_SPLIT
    for (int ph = 0; ph < PH_END; ++ph) {
        bool exists = (ph == 0);
        if (ph > 0) { const int layer = (ph - 1) / PH_PER_LAYER, l = (ph - 1) % PH_PER_LAYER, kind = layer % 3; const int nmix = kind == 0 ? 3 : (kind == 1 ? 6 : 8); exists = (l < nmix) || (l >= 8 && l <= 11); }
        if (!exists) continue;
        a.ph_lo = ph; a.ph_hi = ph + 1;
        hipLaunchKernelGGL(mega_fwd, dim3(grid), dim3(NTHREADS), LDS_BYTES, stream, a);
    }
#else
    a.ph_lo = 0; a.ph_hi = PH_END;
    hipLaunchKernelGGL(mega_fwd, dim3(grid), dim3(NTHREADS), LDS_BYTES, stream, a);
#endif
    const hipError_t le = hipPeekAtLastError();
    if (le != hipSuccess) fprintf(stderr, "kernel_launch: launch failed: %s\n", hipGetErrorName(le));
}
```

```cpp
#include <hip/hip_runtime.h>
#include <cstdio>
#include <cstdint>
#include <cmath>
__device__ __forceinline__ int flane() { return (int)__builtin_amdgcn_mbcnt_hi(~0u, __builtin_amdgcn_mbcnt_lo(~0u, 0u)); }
namespace pg8 {
#define PG8_LAS __attribute__((address_space(3)))
typedef unsigned short bf16_t;
typedef short bf16x8 __attribute__((ext_vector_type(8)));
typedef float f32x4 __attribute__((ext_vector_type(4)));
typedef unsigned u32x4 __attribute__((ext_vector_type(4)));
constexpr int BM = 256, BK = 64, HALF = 128, HTB = HALF * BK * 2  , STAGE_BYTES = 8 * HTB, NXCD = 8, WGM = 8;

__host__ __device__ __forceinline__ int lds_byte(int r, int c) { const int st = (r >> 4) * 2 + (c >> 5), rr = r & 15, cc = c & 31, ob = rr * 64 + cc * 2; return st * 1024 + (ob ^ (((ob >> 9) & 1) << 5)); }
__host__ __device__ __forceinline__ void stage_rc(int b, int& R, int& C) { const int st = b / 1024, sb = b % 1024, swz = sb ^ (((sb >> 9) & 1) << 5); R = (st >> 1) * 16 + swz / 64; C = (st & 1) * 32 + (swz % 64) / 2; }
__host__ __device__ __forceinline__ int perm32(int rho) { const int n = rho >> 4, i = rho & 15; return 8 * (i >> 2) + 4 * n + (i & 3); }

struct Unit { int pm, pn; };
struct Gemm { const bf16_t* A; const bf16_t* Bt; int M, N, K; };

struct StaticOrder {
    int nM, nN, nwg, G, c;
    __host__ __device__ void init(int M, int N, int G_, int c_) { nM = M / BM; nN = N / BM; nwg = nM * nN; G = G_; c = c_; }
    __host__ __device__ bool next(int i, Unit& u) const {
        const long L = (long)i * G + c; if (L >= nwg) return false;
        int wgid = (int)L; { const int q = nwg / NXCD, r = nwg % NXCD, xcd = wgid % NXCD, off = wgid / NXCD; wgid = (xcd < r ? xcd * (q + 1) : r * (q + 1) + (xcd - r) * q) + off; }
        const int nig = WGM * nN, gid = wgid / nig, fm = gid * WGM, gsz = (nM - fm) < WGM ? (nM - fm) : WGM;
        u.pm = fm + ((wgid % nig) % gsz); u.pn = (wgid % nig) / gsz; return true;
    }
    __device__ __forceinline__ void a_ready(const Unit&) const {}
    __device__ __forceinline__ void done(const Unit&) const {}
};

__device__ __forceinline__ unsigned cvt_pk_bf16(float lo, float hi) { unsigned r; asm volatile("v_cvt_pk_bf16_f32 %0, %1, %2" : "=v"(r) : "v"(lo), "v"(hi)); return r; }
typedef float f32x2 __attribute__((ext_vector_type(2)));
__device__ __forceinline__ f32x2 gelu_pk(f32x2 v) {
    const f32x2 av = __builtin_elementwise_abs(v), d = av * 0.2316418882f + 1.0f;
    f32x2 t; t.x = __builtin_amdgcn_rcpf(d.x); t.y = __builtin_amdgcn_rcpf(d.y);
    f32x2 q = t * 0.5307027145f + (-0.7265760135f); q = q * t + 0.7107068705f; q = q * t + (-0.142248368f); q = q * t + 0.127414796f; q = q * t;
    const f32x2 s = (v * v) * (-0.72134752044f);
    f32x2 e; e.x = __builtin_amdgcn_exp2f(s.x); e.y = __builtin_amdgcn_exp2f(s.y);
    const f32x2 m = v * (q * e), r = v - m;
    f32x2 o; o.x = v.x < 0.f ? m.x : r.x; o.y = v.y < 0.f ? m.y : r.y; return o;
}

template <int ACT  > struct EpiBf16 {
    static constexpr bool PERM = true, AFTER_DRAIN = false; static_assert(ACT == 0 || ACT == 1 || ACT == 2, "EpiBf16: ACT is 0 (none), 1 (gelu_pk) or 2 (relu^2)");
    bf16_t* O; int ldc; const float* bias; int split_cols; size_t split_stride; float scale0;
    __device__ __forceinline__ void operator()(const f32x4 (&acc)[2][2][4][2], const Unit& u, int wr, int wc, int fr, int fq) const {
        const int row0 = u.pm * BM + wr * 64 + fr; int colt = u.pn * BM; bf16_t* base = O;
        float sc = 1.f; if (split_cols) { const int t = colt / split_cols; base += (size_t)t * split_stride; colt -= t * split_cols; if (t == 0) sc = scale0; }
        const int col0 = colt + wc * 32 + 8 * fq, bcol0 = u.pn * BM + wc * 32 + 8 * fq;
        f32x4 bv[2][2];
#pragma unroll
        for (int bj = 0; bj < 2; ++bj)
#pragma unroll
            for (int n = 0; n < 2; ++n) bv[bj][n] = bias ? *(const f32x4*)(bias + bcol0 + bj * HALF + 4 * n) : (f32x4){0.f, 0.f, 0.f, 0.f};
#pragma unroll
        for (int ai = 0; ai < 2; ++ai)
#pragma unroll
            for (int m = 0; m < 4; ++m) { bf16_t* rowp = base + (size_t)(row0 + ai * HALF + m * 16) * ldc + col0;
#pragma unroll
                for (int bj = 0; bj < 2; ++bj) { f32x4 v0 = acc[ai][bj][m][0] + bv[bj][0], v1 = acc[ai][bj][m][1] + bv[bj][1];
                    if (ACT == 1) { f32x2 a = gelu_pk((f32x2){v0[0], v0[1]}), b = gelu_pk((f32x2){v0[2], v0[3]}), c = gelu_pk((f32x2){v1[0], v1[1]}), d = gelu_pk((f32x2){v1[2], v1[3]});
                        v0 = (f32x4){a.x, a.y, b.x, b.y}; v1 = (f32x4){c.x, c.y, d.x, d.y}; }
                    if (ACT == 2) { _Pragma("unroll") for (int q_ = 0; q_ < 4; ++q_) { const float a_ = v0[q_] > 0.f ? v0[q_] : 0.f, b_ = v1[q_] > 0.f ? v1[q_] : 0.f; v0[q_] = a_ * a_; v1[q_] = b_ * b_; } }
                    v0 = v0 * sc; v1 = v1 * sc; u32x4 w; w.x = cvt_pk_bf16(v0[0], v0[1]); w.y = cvt_pk_bf16(v0[2], v0[3]); w.z = cvt_pk_bf16(v1[0], v1[1]); w.w = cvt_pk_bf16(v1[2], v1[3]);
                    *(u32x4*)(rowp + bj * HALF) = w; } }
    }
};


struct EpiResBf16 {
    static constexpr bool PERM = true, AFTER_DRAIN = false;
    bf16_t* X; int ldc; float alpha;
    __device__ __forceinline__ void operator()(const f32x4 (&acc)[2][2][4][2], const Unit& u, int wr, int wc, int fr, int fq) const {
        const int row0 = u.pm * BM + wr * 64 + fr, col0 = u.pn * BM + wc * 32 + 8 * fq;
#pragma unroll
        for (int ai = 0; ai < 2; ++ai) {
            u32x4 xin[4][2];
#pragma unroll
            for (int m = 0; m < 4; ++m)
#pragma unroll
                for (int bj = 0; bj < 2; ++bj) xin[m][bj] = *(const u32x4*)(X + (size_t)(row0 + ai * HALF + m * 16) * ldc + col0 + bj * HALF);
#pragma unroll
            for (int m = 0; m < 4; ++m) { bf16_t* rowp = X + (size_t)(row0 + ai * HALF + m * 16) * ldc + col0;
#pragma unroll
                for (int bj = 0; bj < 2; ++bj) { const u32x4 xi = xin[m][bj]; const f32x4 a0 = acc[ai][bj][m][0], a1 = acc[ai][bj][m][1];
                    float x[8] = {__uint_as_float(xi.x << 16), __uint_as_float(xi.x & 0xffff0000u), __uint_as_float(xi.y << 16), __uint_as_float(xi.y & 0xffff0000u),
                                  __uint_as_float(xi.z << 16), __uint_as_float(xi.z & 0xffff0000u), __uint_as_float(xi.w << 16), __uint_as_float(xi.w & 0xffff0000u)};
                    u32x4 w; w.x = cvt_pk_bf16(alpha * x[0] + a0[0], alpha * x[1] + a0[1]); w.y = cvt_pk_bf16(alpha * x[2] + a0[2], alpha * x[3] + a0[3]);
                    w.z = cvt_pk_bf16(alpha * x[4] + a1[0], alpha * x[5] + a1[1]); w.w = cvt_pk_bf16(alpha * x[6] + a1[2], alpha * x[7] + a1[3]);
                    *(u32x4*)(rowp + bj * HALF) = w; } }
        }
    }
};

struct EpiF32 {
    static constexpr bool PERM = false, AFTER_DRAIN = false;
    float* C; int ldc;
    __device__ __forceinline__ void operator()(const f32x4 (&acc)[2][2][4][2], const Unit& u, int wr, int wc, int fr, int fq) const {
        const int row0 = u.pm * BM + wr * 64 + fr, col0 = u.pn * BM + wc * 32 + 4 * fq;
#pragma unroll
        for (int ai = 0; ai < 2; ++ai)
#pragma unroll
            for (int m = 0; m < 4; ++m) { float* rowp = C + (size_t)(row0 + ai * HALF + m * 16) * ldc + col0;
#pragma unroll
                for (int bj = 0; bj < 2; ++bj)
#pragma unroll
                    for (int n = 0; n < 2; ++n) *(f32x4*)(rowp + bj * HALF + n * 16) = acc[ai][bj][m][n]; }
    }
};
struct PanelStats {
    unsigned* xbuf;
    unsigned* cnt;
    unsigned* tmo;
    int ntn; float eps;
    unsigned code;
    __device__ __forceinline__ bool run(const f32x4 (&v)[2][2][4][2], const Unit& u, int wr, int wc, int fr, int fq, PG8_LAS unsigned char* lds, int wid, int lane) const {
        typedef float f32x2v __attribute__((ext_vector_type(2)));
        PG8_LAS f32x2v* P = (PG8_LAS f32x2v*)lds;
        PG8_LAS f32x2v* S = (PG8_LAS f32x2v*)(lds + 8192);
        PG8_LAS unsigned* flag = (PG8_LAS unsigned*)(lds + 8192 + 2048);
#pragma unroll
        for (int ai = 0; ai < 2; ++ai)
#pragma unroll
            for (int m = 0; m < 4; ++m) {
                float s = 0.f;
#pragma unroll
                for (int bj = 0; bj < 2; ++bj)
#pragma unroll
                    for (int n = 0; n < 2; ++n) { const f32x4 x = v[ai][bj][m][n]; s += (x[0] + x[1]) + (x[2] + x[3]); }
                s += __shfl_xor(s, 16); s += __shfl_xor(s, 32);
                const float mw = s * (1.0f / 64.0f); float q = 0.f;
#pragma unroll
                for (int bj = 0; bj < 2; ++bj)
#pragma unroll
                    for (int n = 0; n < 2; ++n) { const f32x4 d = v[ai][bj][m][n] - mw; q += (d[0] * d[0] + d[1] * d[1]) + (d[2] * d[2] + d[3] * d[3]); }
                q += __shfl_xor(q, 16); q += __shfl_xor(q, 32);
                if (fq == 0) P[(ai * HALF + wr * 64 + m * 16 + fr) * 4 + wc] = (f32x2v){mw, q};
            }
        asm volatile("s_waitcnt lgkmcnt(0)" ::: "memory"); __builtin_amdgcn_s_barrier(); asm volatile("" ::: "memory");
#if defined(BROKEN_EXCHANGE_NO_WAIT)
#warning BROKEN CONTROL BUILD: the row-statistics exchange does not wait; results are wrong by design
        if (blockIdx.x >= 64) { const long long t0_ = clock64(); while (clock64() - t0_ < 60000) __builtin_amdgcn_s_sleep(8); }
#endif
        const int row = wid * 32 + (lane & 31);
        if (lane < 32) {
            const f32x2v a = P[row * 4 + 0], b = P[row * 4 + 1], c = P[row * 4 + 2], d = P[row * 4 + 3];
            const float mt = (a.x + b.x + c.x + d.x) * 0.25f;
            const float da = a.x - mt, db = b.x - mt, dc = c.x - mt, dd = d.x - mt;
            const float m2 = (a.y + b.y) + (c.y + d.y) + 64.0f * ((da * da + db * db) + (dc * dc + dd * dd));
            unsigned long long* slot = (unsigned long long*)xbuf + ((size_t)(u.pm * BM + row) * 4 + u.pn);
            __hip_atomic_store(slot, ((unsigned long long)__float_as_uint(m2) << 32) | __float_as_uint(mt), __ATOMIC_RELAXED, __HIP_MEMORY_SCOPE_AGENT);
        }
        asm volatile("s_waitcnt vmcnt(0)" ::: "memory");
        if (lane == 0) __hip_atomic_fetch_add(cnt + 64 * u.pm, 1u, __ATOMIC_RELAXED, __HIP_MEMORY_SCOPE_AGENT);
        if (wid == 0) {
            bool dead = false; const unsigned long long t0 = __builtin_amdgcn_s_memrealtime(); const unsigned want = 8u * (unsigned)ntn;
            for (;;) {
#if defined(BROKEN_EXCHANGE_NO_WAIT)
                break;
#endif
                if ((unsigned)__builtin_amdgcn_readfirstlane(__hip_atomic_load(cnt + 64 * u.pm, __ATOMIC_RELAXED, __HIP_MEMORY_SCOPE_AGENT)) >= want) break;
                if (__builtin_amdgcn_s_memrealtime() - t0 > 2000000ull) {
                    if (lane == 0) { unsigned expect = 0u; __hip_atomic_compare_exchange_strong(tmo + 1, &expect, code | (unsigned)(u.pm & 0xff), __ATOMIC_RELAXED, __ATOMIC_RELAXED, __HIP_MEMORY_SCOPE_AGENT);
                                     __hip_atomic_store(tmo, 1u, __ATOMIC_RELAXED, __HIP_MEMORY_SCOPE_AGENT); }
                    dead = true; break; }
                __builtin_amdgcn_s_sleep(2);
            }
            __builtin_amdgcn_fence(__ATOMIC_ACQUIRE, "agent");
            if (lane == 0) flag[0] = dead ? 1u : 0u;
        }
        asm volatile("s_waitcnt vmcnt(0) lgkmcnt(0)" ::: "memory"); __builtin_amdgcn_s_barrier(); asm volatile("" ::: "memory");
        const bool bad = flag[0] != 0u;
        if (lane < 32) {
            const unsigned long long* slot = (const unsigned long long*)xbuf + (size_t)(u.pm * BM + row) * 4; float mt[4], m2[4]; float ms = 0.f;
#pragma unroll
            for (int t = 0; t < 4; ++t) { if (t < ntn) { const unsigned long long w = __hip_atomic_load(slot + t, __ATOMIC_RELAXED, __HIP_MEMORY_SCOPE_AGENT); mt[t] = __uint_as_float((unsigned)w); m2[t] = __uint_as_float((unsigned)(w >> 32)); } else { mt[t] = 0.f; m2[t] = 0.f; } ms += mt[t]; }
            const float mean = ms / (float)ntn; float q = 0.f;
#pragma unroll
            for (int t = 0; t < 4; ++t) if (t < ntn) { const float dm = mt[t] - mean; q += m2[t] + 256.0f * dm * dm; }
            S[row] = (f32x2v){mean, 1.0f / sqrtf(q / (256.0f * (float)ntn) + eps)};
        }
        asm volatile("s_waitcnt lgkmcnt(0)" ::: "memory"); __builtin_amdgcn_s_barrier(); asm volatile("" ::: "memory");
        return bad;
    }
};
struct EpiLnRes {
    static constexpr bool PERM = false, AFTER_DRAIN = true;
    const float* base; float* out; int ldc; const float* bias; PanelStats st; unsigned poison;
    __device__ __forceinline__ void fused(f32x4 (&acc)[2][2][4][2], const Unit& u, int wr, int wc, int fr, int fq, PG8_LAS unsigned char* lds, int wid, int lane) const {
        typedef float f32x2v __attribute__((ext_vector_type(2)));
        const PG8_LAS f32x2v* S = (const PG8_LAS f32x2v*)(lds + 8192);
        const int col0 = u.pn * BM + wc * 32 + 4 * fq;
#pragma unroll
        for (int bj = 0; bj < 2; ++bj)
#pragma unroll
            for (int n = 0; n < 2; ++n) { const f32x4 bv = bias ? *(const f32x4*)(bias + col0 + bj * HALF + n * 16) : (f32x4){0.f, 0.f, 0.f, 0.f};
#pragma unroll
                for (int ai = 0; ai < 2; ++ai)
#pragma unroll
                    for (int m = 0; m < 4; ++m) acc[ai][bj][m][n] += bv; }
        f32x4 pre[4][2][2];
#pragma unroll
        for (int m = 0; m < 4; ++m) { const size_t off = (size_t)(u.pm * BM + wr * 64 + m * 16 + fr) * ldc + col0;
#pragma unroll
            for (int bj = 0; bj < 2; ++bj)
#pragma unroll
                for (int n = 0; n < 2; ++n) pre[m][bj][n] = *(const f32x4*)(base + off + bj * HALF + n * 16); }
        const bool bad = st.run(acc, u, wr, wc, fr, fq, lds, wid, lane) || poison != 0u;
        const float qnan = __builtin_nanf("");
#pragma unroll
        for (int ai = 0; ai < 2; ++ai)
#pragma unroll
            for (int m = 0; m < 4; ++m) { const int r = ai * HALF + wr * 64 + m * 16 + fr; const f32x2v sr = S[r]; const size_t off = (size_t)(u.pm * BM + r) * ldc + col0;
#pragma unroll
                for (int bj = 0; bj < 2; ++bj)
#pragma unroll
                    for (int n = 0; n < 2; ++n) { const f32x4 bs = ai == 0 ? pre[m][bj][n] : *(const f32x4*)(base + off + bj * HALF + n * 16); f32x4 o = bs + (acc[ai][bj][m][n] - sr.x) * sr.y;
                        if (bad) o = (f32x4){qnan, qnan, qnan, qnan}; *(f32x4*)(out + off + bj * HALF + n * 16) = o; }
                if (m & 1) asm volatile("" ::: "memory"); }
    }
};
struct EpiLnResLn {
    static constexpr bool PERM = false, AFTER_DRAIN = true;
    const float* base; float* out; bf16_t* xn; int ldc; const float* bias; PanelStats st1, st2; unsigned poison;
    __device__ __forceinline__ void fused(f32x4 (&acc)[2][2][4][2], const Unit& u, int wr, int wc, int fr, int fq, PG8_LAS unsigned char* lds, int wid, int lane) const {
        typedef float f32x2v __attribute__((ext_vector_type(2))); typedef unsigned u32x2v __attribute__((ext_vector_type(2)));
        const PG8_LAS f32x2v* S = (const PG8_LAS f32x2v*)(lds + 8192);
        const int col0 = u.pn * BM + wc * 32 + 4 * fq;
#pragma unroll
        for (int bj = 0; bj < 2; ++bj)
#pragma unroll
            for (int n = 0; n < 2; ++n) { const f32x4 bv = bias ? *(const f32x4*)(bias + col0 + bj * HALF + n * 16) : (f32x4){0.f, 0.f, 0.f, 0.f};
#pragma unroll
                for (int ai = 0; ai < 2; ++ai)
#pragma unroll
                    for (int m = 0; m < 4; ++m) acc[ai][bj][m][n] += bv; }
        bool bad = st1.run(acc, u, wr, wc, fr, fq, lds, wid, lane) || poison != 0u;
        const float qnan = __builtin_nanf("");
#pragma unroll
        for (int ai = 0; ai < 2; ++ai)
#pragma unroll
            for (int m = 0; m < 4; ++m) { const int r = ai * HALF + wr * 64 + m * 16 + fr; const f32x2v sr = S[r]; const size_t off = (size_t)(u.pm * BM + r) * ldc + col0;
#pragma unroll
                for (int bj = 0; bj < 2; ++bj)
#pragma unroll
                    for (int n = 0; n < 2; ++n) { const f32x4 bs = *(const f32x4*)(base + off + bj * HALF + n * 16); acc[ai][bj][m][n] = bs + (acc[ai][bj][m][n] - sr.x) * sr.y; }
                asm volatile("" : "+v"(acc[ai][0][m][0]), "+v"(acc[ai][0][m][1]), "+v"(acc[ai][1][m][0]), "+v"(acc[ai][1][m][1]));
                if (m & 1) asm volatile("" ::: "memory"); }
        const bool bad1 = bad;
        bad = st2.run(acc, u, wr, wc, fr, fq, lds, wid, lane) || bad;
#pragma unroll
        for (int ai = 0; ai < 2; ++ai)
#pragma unroll
            for (int m = 0; m < 4; ++m) { const int r = ai * HALF + wr * 64 + m * 16 + fr; const f32x2v sr = S[r]; const size_t off = (size_t)(u.pm * BM + r) * ldc + col0;
#pragma unroll
                for (int bj = 0; bj < 2; ++bj)
#pragma unroll
                    for (int n = 0; n < 2; ++n) { const f32x4 x1 = acc[ai][bj][m][n]; *(f32x4*)(out + off + bj * HALF + n * 16) = bad1 ? (f32x4){qnan, qnan, qnan, qnan} : x1;
                        const f32x4 o = (x1 - sr.x) * sr.y; u32x2v w; w.x = cvt_pk_bf16(o[0], o[1]); w.y = cvt_pk_bf16(o[2], o[3]);
                        if (bad) { w.x = 0x7fc07fc0u; w.y = 0x7fc07fc0u; } *(u32x2v*)(xn + off + bj * HALF + n * 16) = w; }
                asm volatile("" ::: "memory"); }
    }
};

template <class Epi, class Sched, bool ALIGN_EPI = false, bool SP2 = false>
__device__ __forceinline__ void gemm_phase(PG8_LAS unsigned char* lds, const Gemm g, const Sched& S, const Epi& E, int wv) {
    int tid0_ = threadIdx.x; asm volatile("" : "+v"(tid0_)); (void)wv;
    const int tid = tid0_, wid = __builtin_amdgcn_readfirstlane(tid >> 6), lane = tid & 63, wr = wid >> 2, wc = wid & 3, fr = lane & 15, fq = lane >> 4;
    const int K = g.K, nt = K / BK;
    unsigned voffA[2], voffB[2];
#pragma unroll
    for (int i = 0; i < 2; ++i) { int R, C; stage_rc(tid * 16 + i * 8192, R, C); const int Rb = Epi::PERM ? ((R & ~31) + perm32(R & 31)) : R;
        voffA[i] = (unsigned)(R * K + C) * 2u; voffB[i] = (unsigned)(Rb * K + C) * 2u; }
    const size_t kstep = (size_t)(BK * 2);
    const size_t hstep = (size_t)HALF * K * 2;
    const size_t tstep = 2 * hstep;
    const unsigned ldsw = (unsigned)wid * 1024u;
    const int aoff = lds_byte(wr * 64 + fr, fq * 8), boff = lds_byte(wc * 32 + fr, fq * 8);
#define PG8_SA(b, h) (((b) * 2 + (h)) * HTB)
#define PG8_SB(b, h) ((4 + (b) * 2 + (h)) * HTB)
#define PG8_STAGE(bufoff, gbase, voff) do { _Pragma("unroll") for (int _i = 0; _i < 2; ++_i) \
        __builtin_amdgcn_global_load_lds((const unsigned*)((const char*)(gbase) + (voff)[_i]), (PG8_LAS unsigned*)(lds + (bufoff) + ldsw + _i * 8192), 16, 0, 0); } while (0)
#define PG8_LDA(dst, b, h) do { _Pragma("unroll") for (int m = 0; m < 4; ++m) _Pragma("unroll") for (int k = 0; k < 2; ++k) dst[m][k] = *(const PG8_LAS bf16x8*)(lds + PG8_SA(b, h) + aoff + m * 2048 + k * 1024); } while (0)
#define PG8_LDB(dst, b, h) do { _Pragma("unroll") for (int n = 0; n < 2; ++n) _Pragma("unroll") for (int k = 0; k < 2; ++k) dst[n][k] = *(const PG8_LAS bf16x8*)(lds + PG8_SB(b, h) + boff + n * 2048 + k * 1024); } while (0)
#define PG8_MMA(ai, bj, At, Bt) do { __builtin_amdgcn_s_setprio(1); _Pragma("unroll") for (int m = 0; m < 4; ++m) _Pragma("unroll") for (int n = 0; n < 2; ++n) _Pragma("unroll") for (int k = 0; k < 2; ++k) \
        acc[ai][bj][m][n] = __builtin_amdgcn_mfma_f32_16x16x32_bf16(Bt[n][k], At[m][k], acc[ai][bj][m][n], 0, 0, 0); __builtin_amdgcn_s_setprio(0); } while (0)
#define PG8_WAIT_V(n) asm volatile("s_waitcnt vmcnt(" #n ")" ::: "memory")
#define PG8_WAIT_L(n) asm volatile("s_waitcnt lgkmcnt(" #n ")" ::: "memory")
#define PG8_BAR __builtin_amdgcn_s_barrier()
#define PG8_SCHED __builtin_amdgcn_sched_barrier(0)
    Unit cur, nxt; int ui = 0;
    if (!S.next(0, cur)) return;
    f32x4 acc[2][2][4][2];
#pragma unroll
    for (int a = 0; a < 2; ++a)
#pragma unroll
        for (int b = 0; b < 2; ++b)
#pragma unroll
            for (int m = 0; m < 4; ++m)
#pragma unroll
                for (int n = 0; n < 2; ++n) acc[a][b][m][n] = (f32x4){0.f, 0.f, 0.f, 0.f};
    bf16x8 At[4][2], B0[2][2], B1[2][2];
    const char* cA = (const char*)g.A + (size_t)cur.pm * tstep; const char* cB = (const char*)g.Bt + (size_t)cur.pn * tstep;
    S.a_ready(cur);
    if constexpr (SP2) {
        PG8_STAGE(PG8_SB(0, 0), cB, voffB); PG8_STAGE(PG8_SB(0, 1), cB + hstep, voffB); PG8_STAGE(PG8_SA(0, 0), cA, voffA); PG8_STAGE(PG8_SA(0, 1), cA + hstep, voffA);
        if (wr == 1) PG8_BAR;
        PG8_WAIT_V(2); PG8_BAR;
        PG8_STAGE(PG8_SB(1, 0), cB + kstep, voffB); PG8_STAGE(PG8_SA(1, 0), cA + kstep, voffA); PG8_STAGE(PG8_SB(1, 1), cB + hstep + kstep, voffB);
        PG8_WAIT_V(6); PG8_BAR;
    } else {
        PG8_STAGE(PG8_SB(0, 0), cB, voffB); PG8_STAGE(PG8_SA(0, 0), cA, voffA); PG8_STAGE(PG8_SB(0, 1), cB + hstep, voffB); PG8_STAGE(PG8_SA(0, 1), cA + hstep, voffA);
        if (wr == 1) PG8_BAR;
        PG8_WAIT_V(4); PG8_BAR;
        PG8_STAGE(PG8_SB(1, 0), cB + kstep, voffB); PG8_STAGE(PG8_SA(1, 0), cA + kstep, voffA); PG8_STAGE(PG8_SB(1, 1), cB + hstep + kstep, voffB);
        PG8_WAIT_V(6); PG8_BAR;
    }
    for (;;) {
        const bool has_next = S.next(ui + 1, nxt);
        const char* nA = has_next ? (const char*)g.A + (size_t)nxt.pm * tstep : cA; const char* nB = has_next ? (const char*)g.Bt + (size_t)nxt.pn * tstep : cB;
        for (int t = 0; t < nt; t += 2) {
            const bool last = (t == nt - 2);
            const char* a1 = cA + (size_t)(t + 1) * kstep;
            const char* a2 = last ? nA : cA + (size_t)(t + 2) * kstep; const char* b2 = last ? nB : cB + (size_t)(t + 2) * kstep;
            const char* a3 = a2 + kstep; const char* b3 = b2 + kstep;
            if (last && has_next) S.a_ready(nxt);
            if constexpr (SP2) {
            PG8_LDB(B0, 0, 0); PG8_LDB(B1, 0, 1); PG8_SCHED; PG8_LDA(At, 0, 0); PG8_STAGE(PG8_SA(1, 1), a1 + hstep, voffA);
            PG8_WAIT_V(8); PG8_WAIT_L(0); PG8_BAR; PG8_MMA(0, 0, At, B0); PG8_MMA(0, 1, At, B1); PG8_BAR; PG8_SCHED;
            PG8_LDA(At, 0, 1); PG8_STAGE(PG8_SB(0, 0), b2, voffB); PG8_STAGE(PG8_SB(0, 1), b2 + hstep, voffB); PG8_STAGE(PG8_SA(0, 0), a2, voffA);
            PG8_WAIT_V(8); PG8_WAIT_L(0); PG8_BAR; PG8_MMA(1, 0, At, B0); PG8_MMA(1, 1, At, B1); PG8_BAR; PG8_SCHED;
            PG8_LDB(B0, 1, 0); PG8_LDB(B1, 1, 1); PG8_SCHED; PG8_LDA(At, 1, 0); PG8_STAGE(PG8_SA(0, 1), a2 + hstep, voffA);
            PG8_WAIT_V(8); PG8_WAIT_L(0); PG8_BAR; PG8_MMA(0, 0, At, B0); PG8_MMA(0, 1, At, B1); PG8_BAR; PG8_SCHED;
            PG8_LDA(At, 1, 1); PG8_STAGE(PG8_SB(1, 0), b3, voffB); PG8_STAGE(PG8_SB(1, 1), b3 + hstep, voffB); PG8_STAGE(PG8_SA(1, 0), a3, voffA);
            PG8_WAIT_V(8); PG8_WAIT_L(0); PG8_BAR; PG8_MMA(1, 0, At, B0); PG8_MMA(1, 1, At, B1); PG8_BAR; PG8_SCHED;
            } else {
            PG8_LDB(B0, 0, 0); PG8_SCHED; PG8_LDA(At, 0, 0); PG8_STAGE(PG8_SA(1, 1), a1 + hstep, voffA);
            PG8_WAIT_L(8); PG8_BAR; PG8_WAIT_L(0); PG8_MMA(0, 0, At, B0); PG8_BAR; PG8_SCHED;
            PG8_LDB(B1, 0, 1); PG8_STAGE(PG8_SB(0, 0), b2, voffB);
            PG8_BAR; PG8_WAIT_L(0); PG8_MMA(0, 1, At, B1); PG8_BAR;
            PG8_LDA(At, 0, 1); PG8_STAGE(PG8_SA(0, 0), a2, voffA);
            PG8_BAR; PG8_WAIT_L(0); PG8_MMA(1, 0, At, B0); PG8_BAR; PG8_SCHED;
            PG8_STAGE(PG8_SB(0, 1), b2 + hstep, voffB);
            PG8_WAIT_V(6); PG8_BAR; PG8_MMA(1, 1, At, B1); PG8_BAR;
            PG8_LDB(B0, 1, 0); PG8_SCHED; PG8_LDA(At, 1, 0); PG8_STAGE(PG8_SA(0, 1), a2 + hstep, voffA);
            PG8_WAIT_L(8); PG8_BAR; PG8_WAIT_L(0); PG8_MMA(0, 0, At, B0); PG8_BAR; PG8_SCHED;
            PG8_LDB(B1, 1, 1); PG8_STAGE(PG8_SB(1, 0), b3, voffB);
            PG8_BAR; PG8_WAIT_L(0); PG8_MMA(0, 1, At, B1); PG8_BAR;
            PG8_LDA(At, 1, 1); PG8_STAGE(PG8_SA(1, 0), a3, voffA);
            PG8_BAR; PG8_WAIT_L(0); PG8_MMA(1, 0, At, B0); PG8_BAR; PG8_SCHED;
            PG8_STAGE(PG8_SB(1, 1), b3 + hstep, voffB);
            PG8_WAIT_V(6); PG8_BAR; PG8_MMA(1, 1, At, B1); PG8_BAR;
            }
        }
        if constexpr (ALIGN_EPI) { if (wr == 0) PG8_BAR; }
        if constexpr (!Epi::AFTER_DRAIN) { E(acc, cur, wr, wc, fr, fq); S.done(cur); }
        if (!has_next) break;
#pragma unroll
        for (int a = 0; a < 2; ++a)
#pragma unroll
            for (int b = 0; b < 2; ++b)
#pragma unroll
                for (int m = 0; m < 4; ++m)
#pragma unroll
                    for (int n = 0; n < 2; ++n) acc[a][b][m][n] = (f32x4){0.f, 0.f, 0.f, 0.f};
        cur = nxt; cA = nA; cB = nB; ++ui;
        if constexpr (ALIGN_EPI) { if (wr == 1) PG8_BAR; }
    }
    PG8_WAIT_V(0);
    if constexpr (!ALIGN_EPI) { if (wr == 0) PG8_BAR; }
    PG8_BAR;
    if constexpr (Epi::AFTER_DRAIN) { E.fused(acc, cur, wr, wc, fr, fq, lds, wid, lane); S.done(cur); }
#undef PG8_SA
#undef PG8_SB
#undef PG8_STAGE
#undef PG8_LDA
#undef PG8_LDB
#undef PG8_MMA
#undef PG8_WAIT_V
#undef PG8_WAIT_L
#undef PG8_BAR
#undef PG8_SCHED
}
}

#ifndef PG8_SP2
#define PG8_SP2 true
#endif
#ifndef PG8_ALIGN
#define PG8_ALIGN true
#endif
#define GAS __attribute__((address_space(1)))
#define LAS __attribute__((address_space(3)))
#define XB_TMO      128
#define XB_XCNT(j)  (256  + 64 * (j))
#define XB_XSUB(j)  (1280 + 64 * (j))
#define XB_XGEN(j)  (2304 + 64 * (j))
#define XB_TOP      3328
#define XB_TOPGEN   3392
#define XCD_BAR_WORDS 3456
#define XB_SPIN_CAP (1u << 18)

__device__ __forceinline__ unsigned xb_ld(unsigned* p)              { return __hip_atomic_load(p, __ATOMIC_RELAXED, __HIP_MEMORY_SCOPE_AGENT); }
__device__ __forceinline__ unsigned xb_add(unsigned* p, unsigned v) { return __hip_atomic_fetch_add(p, v, __ATOMIC_RELAXED, __HIP_MEMORY_SCOPE_AGENT); }
__device__ __forceinline__ unsigned xb_xcc_id() { return (unsigned)__builtin_amdgcn_s_getreg((3 << 11) | 20) & 0xFu; }
#define XB_SPIN(cond, bar) do { unsigned _sp = 0; while (cond) { __builtin_amdgcn_s_sleep(1); \
    if ((++_sp & 255u) == 0u) { if (xb_ld(&(bar)[XB_TMO])) break; if (_sp > XB_SPIN_CAP) { atomicAdd(&(bar)[XB_TMO], 1u); break; } } } } while (0)

struct XcdBarrier {
    unsigned* bar; unsigned x;
    volatile LAS unsigned* st;
    int wv;
};

__device__ __forceinline__ XcdBarrier xcd_barrier_post(unsigned* bar, volatile LAS unsigned* st) {
    XcdBarrier b; b.bar = bar; b.x = xb_xcc_id(); b.st = st;
    if (threadIdx.x == 0) (void)xb_add(&bar[XB_XCNT(b.x)], 1u);
    return b;
}
__device__ __forceinline__ void xcd_barrier_complete(unsigned* bar, unsigned x, unsigned& nloc, unsigned& nx) {
    asm volatile("" : "+s"(x));
    const unsigned G = gridDim.x * gridDim.y * gridDim.z;
    unsigned sum, cnt, mine, sp = 0u;
    for (;;) {
        sum = 0u; cnt = 0u; mine = 0u;
#pragma unroll
        for (unsigned j = 0; j < 16; ++j) { const unsigned c = xb_ld(&bar[XB_XCNT(j)]); sum += c; cnt += (c > 0u) ? 1u : 0u; mine = (j == x) ? c : mine; }
        if (sum == G) break;
        __builtin_amdgcn_s_sleep(1);
        if ((++sp & 255u) == 0u) { if (xb_ld(&bar[XB_TMO])) break; if (sp > XB_SPIN_CAP) { atomicAdd(&bar[XB_TMO], 1u); break; } }
    }
    nloc = mine > 0u ? mine : 1u; nx = cnt > 0u ? cnt : 1u;
}

__device__ __forceinline__ void xcd_barrier(const XcdBarrier& b) {
    asm volatile("s_waitcnt vmcnt(0)" ::: "memory");
    __syncthreads();
    if (threadIdx.x == 0) {
        unsigned* bar = b.bar; asm volatile("" : "+s"(bar));
        __builtin_amdgcn_s_waitcnt(0);
        unsigned nloc = b.st[0], nx = b.st[1];
        if (nloc == 0u) { xcd_barrier_complete(bar, b.x, nloc, nx); b.st[0] = nloc; b.st[1] = nx; }
        const unsigned old = xb_add(&bar[XB_XSUB(b.x)], 1u);
        const unsigned gen = old / nloc;
        if (old + 1u == (gen + 1u) * nloc) {
            __builtin_amdgcn_fence(__ATOMIC_RELEASE, "agent");
            asm volatile("s_waitcnt vmcnt(0)" ::: "memory");
            const unsigned og = xb_add(&bar[XB_TOP], 1u);
            const unsigned tg = og / nx;
            if (og + 1u == (tg + 1u) * nx) xb_add(&bar[XB_TOPGEN], 1u);
            else XB_SPIN(xb_ld(&bar[XB_TOPGEN]) == tg, bar);
            __builtin_amdgcn_fence(__ATOMIC_ACQUIRE, "agent");
            xb_add(&bar[XB_XGEN(b.x)], 1u);
            asm volatile("s_waitcnt vmcnt(0)" ::: "memory");
        } else {
            XB_SPIN(xb_ld(&bar[XB_XGEN(b.x)]) == gen, bar);
            __builtin_amdgcn_fence(__ATOMIC_ACQUIRE, "agent");
            asm volatile("s_waitcnt vmcnt(0)" ::: "memory");
        }
    }
    __syncthreads();
}
namespace dattn {
constexpr int D = 128, QST = 2048, KVS = 512, OST = 2048, MTW = 68, JLO = 3;
constexpr float THR = 8.f; constexpr bool WSKIP = false;
typedef unsigned short bf16;
constexpr float SCALE = 1.0f;
constexpr int NW = 8, QBLK = 32, KVBLK = 64, QB = NW * QBLK;
constexpr int SHM_V = KVBLK * D * 2, SHM_K = KVBLK * D * 2;
constexpr int LDS_BYTES = 2 * SHM_V + 2 * SHM_K + NW * 64 * 4;

typedef short bf16x8 __attribute__((ext_vector_type(8)));
typedef short s16x4 __attribute__((ext_vector_type(4)));
typedef float f32x16 __attribute__((ext_vector_type(16)));
typedef float f32x4 __attribute__((ext_vector_type(4)));
typedef unsigned u32x4 __attribute__((ext_vector_type(4)));
template <class A, class Bt> struct same_t { static constexpr bool v = false; };
template <class A> struct same_t<A, A> { static constexpr bool v = true; };

#define KSWZ(row, colB) ((row) * 256 + ((colB) ^ (((row) & 7) << 4)))
#define SBAR() __builtin_amdgcn_sched_barrier(0)
__device__ __forceinline__ int v_st(int k, int c) { const int kk = (k & ~0xC) | ((k & 4) << 1) | ((k & 8) >> 1); return ((kk >> 3) * 4 + (c >> 5)) * 512 + ((kk & 7) * 32 + (c & 31)) * 2; }
__device__ __forceinline__ int v_rd_base(int lane) { return ((lane & 3) << 3) | (((lane >> 2) & 3) << 6) | (((lane >> 4) & 1) << 5) | (((lane >> 5) & 1) << 8); }
constexpr int v_rd_off(int d0, int ks, int half) { return d0 * 512 + ks * 4096 + half * 2048; }
__device__ __forceinline__ int crow(int r, int hi) { return (r & 3) + 8 * (r >> 2) + 4 * hi; }
__device__ __forceinline__ unsigned cvtpk(float lo, float hi) {
    unsigned r; asm volatile("v_cvt_pk_bf16_f32 %0, %1, %2" : "=v"(r) : "v"(lo), "v"(hi)); return r;
}
__device__ __forceinline__ bf16x8 pack8(f32x4 a, f32x4 b) {
    u32x4 w = {cvtpk(a[0], a[1]), cvtpk(a[2], a[3]), cvtpk(b[0], b[1]), cvtpk(b[2], b[3])};
    return *reinterpret_cast<bf16x8*>(&w);
}
template <class T> __device__ __forceinline__ bf16x8 load8(const T* p) {
    if constexpr (same_t<T, float>::v) { return pack8(*(const f32x4*)p, *(const f32x4*)(p + 4)); }
    else { return *reinterpret_cast<const bf16x8*>(p); }
}
__device__ __forceinline__ void mask_tile(f32x16& p0, f32x16& p1, int dq, unsigned W) {
    const float NEG = -__builtin_inff();
#pragma unroll
    for (int r = 0; r < 16; ++r) {
        const int c = (r & 3) + 8 * (r >> 2);
        if ((unsigned)(dq - c) >= W) p0[r] = NEG;
        if ((unsigned)(dq - c - 32) >= W) p1[r] = NEG;
    }
}
__device__ __forceinline__ void mask_bits(f32x16& p0, f32x16& p1, unsigned long long mw, int hi) {
    const float NEG = -__builtin_inff();
    const unsigned lo = (unsigned)(mw >> (4 * hi)), up = (unsigned)(mw >> (32 + 4 * hi));
#pragma unroll
    for (int r = 0; r < 16; ++r) {
        const int c = (r & 3) + 8 * (r >> 2);
        const unsigned t0 = (unsigned)__builtin_amdgcn_sbfe((int)lo, c, 1), t1 = (unsigned)__builtin_amdgcn_sbfe((int)up, c, 1);
        p0[r] = __uint_as_float((t0 & __float_as_uint(p0[r])) | (~t0 & __float_as_uint(NEG)));
        p1[r] = __uint_as_float((t1 & __float_as_uint(p1[r])) | (~t1 & __float_as_uint(NEG)));
    }
}
template <int Q> __device__ __forceinline__ void mask_bias_q(f32x16& p0, f32x16& p1, unsigned nlo, unsigned nup) {
#pragma unroll
    for (int r = 4 * Q; r < 4 * Q + 4; ++r) { const int c = (r & 3) + 8 * (r >> 2);
        p0[r] = __uint_as_float((unsigned)__builtin_amdgcn_sbfe((int)nlo, c, 1) & 0xFF800000u);
        p1[r] = __uint_as_float((unsigned)__builtin_amdgcn_sbfe((int)nup, c, 1) & 0xFF800000u); }
}
__device__ __forceinline__ void mask_bias(f32x16& p0, f32x16& p1, unsigned long long mw, int hi) {
    const unsigned nlo = ~(unsigned)(mw >> (4 * hi)), nup = ~(unsigned)(mw >> (32 + 4 * hi));
    mask_bias_q<0>(p0, p1, nlo, nup); mask_bias_q<1>(p0, p1, nlo, nup); mask_bias_q<2>(p0, p1, nlo, nup); mask_bias_q<3>(p0, p1, nlo, nup);
}
__device__ __forceinline__ void partialSM(f32x16& p0, f32x16& p1, float& m_reg, float& mn, float& alpha) {
    float pmax = p0[0]; for (int r = 1; r < 16; ++r) pmax = fmaxf(pmax, p0[r]); for (int r = 0; r < 16; ++r) pmax = fmaxf(pmax, p1[r]);
    { auto rr = __builtin_amdgcn_permlane32_swap(__float_as_uint(pmax), __float_as_uint(pmax), false, false);
      pmax = fmaxf(__uint_as_float(rr[0]), __uint_as_float(rr[1])); }
    constexpr float C2 = 1.4426950408889634f * SCALE;
    if (__builtin_expect(__all((pmax - m_reg) * SCALE <= THR), 1)) { mn = m_reg; alpha = 1.f; }
    else { mn = fmaxf(m_reg, pmax); alpha = __builtin_amdgcn_exp2f((m_reg - mn) * C2); m_reg = mn; }
    const float mnL = -mn * C2;
    for (int r = 0; r < 16; ++r) p0[r] = fmaf(p0[r], C2, mnL); for (int r = 0; r < 16; ++r) p1[r] = fmaf(p1[r], C2, mnL);
    for (int r = 0; r < 16; ++r) p0[r] = __builtin_amdgcn_exp2f(p0[r]);
}
__device__ __forceinline__ void finishSM(f32x16& p0, f32x16& p1, float alpha, float& l_reg, bf16x8& pa0, bf16x8& pa1, bf16x8& pa2, bf16x8& pa3) {
    for (int r = 0; r < 16; ++r) p1[r] = __builtin_amdgcn_exp2f(p1[r]);
    float ps = 0; for (int r = 0; r < 16; ++r) ps += p0[r]; for (int r = 0; r < 16; ++r) ps += p1[r];
    { auto rr = __builtin_amdgcn_permlane32_swap(__float_as_uint(ps), __float_as_uint(ps), false, false);
      ps = __uint_as_float(rr[0]) + __uint_as_float(rr[1]); }
    l_reg = l_reg * alpha + ps;
#define PK4(P, B_, OUT) do { unsigned a0 = cvtpk(P[B_+0], P[B_+1]), a1 = cvtpk(P[B_+2], P[B_+3]);                          \
        unsigned b0 = cvtpk(P[B_+4], P[B_+5]), b1 = cvtpk(P[B_+6], P[B_+7]);                                             \
        auto r0 = __builtin_amdgcn_permlane32_swap(a0, b0, false, false); auto r1 = __builtin_amdgcn_permlane32_swap(a1, b1, false, false); \
        u32x4 w = {r0[0], r1[0], r0[1], r1[1]}; OUT = *reinterpret_cast<bf16x8*>(&w); } while (0)
    PK4(p0, 0, pa0); PK4(p0, 8, pa1); PK4(p1, 0, pa2); PK4(p1, 8, pa3);
#undef PK4
}
template <int KB, bool SK, bool BI = false>
__device__ __forceinline__ void qkt(f32x16& p0, f32x16& p1, const char* K_lds, int r32, int hi, const bf16x8* qr, bool act) {
    if (SK && !act) { const float NEG = -__builtin_inff();
#pragma unroll
        for (int r = 0; r < 16; ++r) { p0[r] = NEG; p1[r] = NEG; } return; }
    if (!BI) { p0 = f32x16{}; p1 = f32x16{}; }
    const char* kb[4];
#pragma unroll
    for (int dd = 0; dd < 4; ++dd) kb[dd] = K_lds + KB * SHM_K + KSWZ(r32, (dd * 16 + hi * 8) * 2);
#pragma unroll
    for (int d0 = 0; d0 < 8; ++d0) { const char* a = kb[d0 & 3] + (d0 >> 2) * 128;
        bf16x8 b0 = *reinterpret_cast<const bf16x8*>(a);
        bf16x8 b1 = *reinterpret_cast<const bf16x8*>(a + 32 * 256);
        p0 = __builtin_amdgcn_mfma_f32_32x32x16_bf16(b0, qr[d0], p0, 0, 0, 0);
        p1 = __builtin_amdgcn_mfma_f32_32x32x16_bf16(b1, qr[d0], p1, 0, 0, 0); }
}
template <int VB, bool SK, bool BI = false>
__device__ __forceinline__ void pv_tile(f32x16* o, int vb0, bf16x8 pa0, bf16x8 pa1, bf16x8 pa2, bf16x8 pa3, bool act, f32x16* bq0 = nullptr, f32x16* bq1 = nullptr, unsigned nlo = 0u, unsigned nup = 0u) {
    if (SK && !act) return;
#define TRRD(dst, off) asm volatile("ds_read_b64_tr_b16 %0, %1 offset:%2" : "=&v"(dst) : "v"(vb0), "i"(off) : "memory")
#define PV_D0(d0) do { s16x4 l0, l1, l2, l3, h0, h1, h2, h3; constexpr int b_ = VB * SHM_V + v_rd_off(d0, 0, 0);     \
        TRRD(l0, b_); TRRD(h0, b_ + 2048); TRRD(l1, b_ + 4096); TRRD(h1, b_ + 6144); TRRD(l2, b_ + 8192); TRRD(h2, b_ + 10240); TRRD(l3, b_ + 12288); TRRD(h3, b_ + 14336); \
        asm volatile("s_waitcnt lgkmcnt(0)" ::: "memory"); SBAR();                 \
        o[d0] = __builtin_amdgcn_mfma_f32_32x32x16_bf16(pa0, (bf16x8){l0[0], l0[1], l0[2], l0[3], h0[0], h0[1], h0[2], h0[3]}, o[d0], 0, 0, 0);   \
        o[d0] = __builtin_amdgcn_mfma_f32_32x32x16_bf16(pa1, (bf16x8){l1[0], l1[1], l1[2], l1[3], h1[0], h1[1], h1[2], h1[3]}, o[d0], 0, 0, 0);   \
        o[d0] = __builtin_amdgcn_mfma_f32_32x32x16_bf16(pa2, (bf16x8){l2[0], l2[1], l2[2], l2[3], h2[0], h2[1], h2[2], h2[3]}, o[d0], 0, 0, 0);   \
        o[d0] = __builtin_amdgcn_mfma_f32_32x32x16_bf16(pa3, (bf16x8){l3[0], l3[1], l3[2], l3[3], h3[0], h3[1], h3[2], h3[3]}, o[d0], 0, 0, 0); } while (0)
    PV_D0(0); if (BI) mask_bias_q<0>(*bq0, *bq1, nlo, nup); PV_D0(1); if (BI) mask_bias_q<1>(*bq0, *bq1, nlo, nup);
    PV_D0(2); if (BI) mask_bias_q<2>(*bq0, *bq1, nlo, nup); PV_D0(3); if (BI) mask_bias_q<3>(*bq0, *bq1, nlo, nup);
#undef PV_D0
#undef TRRD
}

template <class TIn, class TOut> struct BlockRef { const TIn* Q; const TIn* K; const TIn* V; TOut* O; const unsigned long long* M; int P0; };
template <class TIn> struct Seam {
    bf16x8 qr[8];
    bf16x8 st_v0, st_v1, st_k0, st_k1; f32x4 sf0, sf1, sf2, sf3;
    f32x4 tq[16];
};
__device__ __forceinline__ int swa_jlo(int, int) { return JLO; }
#define ROW(p, k0, rr) ((p) + (size_t)((k0) + (rr)) * KVS + sc)
#define VMW() asm volatile("s_waitcnt vmcnt(0)" ::: "memory")
#define VMWN(n) asm volatile("s_waitcnt vmcnt(%0)" :: "i"(n) : "memory")
#define SLOAD_H(Kp, Vp, k0) do { S.st_v0 = load8<TIn>(ROW(Vp, k0, sr)); S.st_v1 = load8<TIn>(ROW(Vp, k0, 32 + sr));              \
                         S.st_k0 = load8<TIn>(ROW(Kp, k0, sr)); S.st_k1 = load8<TIn>(ROW(Kp, k0, 32 + sr)); } while (0)
#define SWRITE_HK(bf) do { *(bf16x8*)(K_lds + (bf) * SHM_K + kws) = S.st_k0; *(bf16x8*)(K_lds + (bf) * SHM_K + kws + 32 * 256) = S.st_k1; } while (0)
#define SWRITE_HV(bf) do { *(bf16x8*)(V_lds + (bf) * SHM_V + vst0) = S.st_v0; *(bf16x8*)(V_lds + (bf) * SHM_V + vst1) = S.st_v1; } while (0)
#define SWRITE_H(bf) do { SWRITE_HV(bf); SWRITE_HK(bf); } while (0)
#define SLOAD_F(p, k0) do { S.sf0 = *(const f32x4*)ROW(p, k0, sr); S.sf1 = *(const f32x4*)(ROW(p, k0, sr) + 4);                \
                            S.sf2 = *(const f32x4*)ROW(p, k0, 32 + sr); S.sf3 = *(const f32x4*)(ROW(p, k0, 32 + sr) + 4); } while (0)
#define SWRITE_KF(bf) do { *(bf16x8*)(K_lds + (bf) * SHM_K + kws) = pack8(S.sf0, S.sf1); *(bf16x8*)(K_lds + (bf) * SHM_K + kws + 32 * 256) = pack8(S.sf2, S.sf3); } while (0)
#define SWRITE_VF(bf) do { *(bf16x8*)(V_lds + (bf) * SHM_V + vst0) = pack8(S.sf0, S.sf1); *(bf16x8*)(V_lds + (bf) * SHM_V + vst1) = pack8(S.sf2, S.sf3); } while (0)
template <class TIn, class TOut>
__device__ __forceinline__ void causal_swa_prime(const BlockRef<TIn, TOut>& cur, int W, char* lds, Seam<TIn>& S, int wv) {
    constexpr bool F32 = same_t<TIn, float>::v;
    int tid0_ = threadIdx.x; asm volatile("" : "+v"(tid0_)); (void)wv;
    const int tid = tid0_, wid = __builtin_amdgcn_readfirstlane(tid >> 6), lane = tid & 63, r32 = lane & 31, hi = lane >> 5;
    const int sr = tid >> 4, sc = (tid & 15) * 8, kws = KSWZ(sr, sc * 2); char* K_lds = lds + 2 * SHM_V;
    const int kb0 = swa_jlo(cur.P0, W) * KVBLK;
    for (int d0 = 0; d0 < 8; ++d0) S.qr[d0] = load8<TIn>(cur.Q + (size_t)(wid * QBLK + r32) * QST + d0 * 16 + hi * 8);
    if constexpr (F32) { SLOAD_F((const float*)cur.K, kb0); VMW(); SWRITE_KF(0); SBAR(); SLOAD_F((const float*)cur.V, kb0); }
    else { SLOAD_H(cur.K, cur.V, kb0); VMW(); SWRITE_HK(0); }
    __syncthreads();
}
template <class TIn, class TOut, int VAR = 0>
__device__ __forceinline__ void causal_swa_block(const BlockRef<TIn, TOut>& cur, const BlockRef<TIn, TOut>& nxt, int skv, int W, char* lds, Seam<TIn>& S, int wv) {
    constexpr bool F32 = same_t<TIn, float>::v;
    int tid0_ = threadIdx.x; asm volatile("" : "+v"(tid0_)); (void)wv;
    const int tid = tid0_, wid = __builtin_amdgcn_readfirstlane(tid >> 6), lane = tid & 63, r32 = lane & 31, hi = lane >> 5;
    const int j_lo = swa_jlo(cur.P0, W);
    int j_hi = (cur.P0 + QB - 1) / KVBLK + 1; if (j_hi > skv / KVBLK) j_hi = skv / KVBLK;
    const int NT = j_hi - j_lo;
    const int kbn = swa_jlo(nxt.P0, W) * KVBLK;
    const int qlo = cur.P0 + wid * QBLK; (void)qlo;
    const unsigned long long* mrow = cur.M + (size_t)(wid * QBLK + r32) * MTW;
    const int qm_unused = 0; (void)qm_unused;
    char* V_lds = lds; char* K_lds = lds + 2 * SHM_V;
    float* ws = (float*)(lds + 2 * SHM_V + 2 * SHM_K) + wid * 64; float* li_l = ws, * al_l = ws + 32;
    float m_reg = -1e30f, l_reg = 0; f32x16 o[4] = {};
    const int sr = tid >> 4, sc = (tid & 15) * 8, vst0 = v_st(sr, sc), vst1 = v_st(32 + sr, sc), kws = KSWZ(sr, sc * 2);
    const int vb0 = (int)(uintptr_t)V_lds + v_rd_base(lane);
    const TIn* Kh = cur.K; const TIn* Vh = cur.V;
#define RESC(a) do { if (__any((a) < 1.f)) { if (hi == 0) al_l[r32] = (a); asm volatile("s_waitcnt lgkmcnt(0)" ::: "memory");              \
                     for (int d_ = 0; d_ < 4; ++d_) for (int r = 0; r < 16; ++r) o[d_][r] *= al_l[crow(r, hi)]; } } while (0)
#define KBASE(t) ((j_lo + (t)) * KVBLK)
#define ACT(t) (KBASE(t) <= qlo + QBLK - 1 && KBASE(t) + KVBLK - 1 >= qlo - W + 1)
#define MASKT(P0_, P1_, t) do { if constexpr (VAR == 3) mask_bits(P0_, P1_, (((t) & 1) ? mwB : mwA), hi); else if constexpr (VAR == 2) { unsigned long long m_ = (((t) & 1) ? mwB : mwA); asm volatile("" :: "v"(m_)); } } while (0)
#define MWLOAD(t) do { const int tt_ = (t) < NT ? (t) : NT - 1; if ((t) & 1) mwB = mrow[j_lo + tt_]; else mwA = mrow[j_lo + tt_]; } while (0)
    constexpr int NQL = F32 ? 16 : 8;
    constexpr bool BI = (VAR == 0);
    constexpr bool SK = WSKIP && !F32;
#define SEAM_K0() do { VMWN(NQL); if constexpr (F32) { SWRITE_KF(0); SBAR(); SLOAD_F((const float*)nxt.V, kbn); } else { SWRITE_HK(0); } SBAR(); } while (0)
    f32x16 pA0, pA1, pB0, pB1; float mnA, mnB, alA, alB; bf16x8 pa0, pa1, pa2, pa3;
    unsigned long long mwA = mrow[j_lo], mwB = mrow[j_lo + (NT > 1 ? 1 : 0)];
    if constexpr (F32) { VMW(); SWRITE_VF(0); SBAR(); } else { SWRITE_HV(0); SBAR(); }
    if (NT > 1) { if constexpr (F32) SLOAD_F((const float*)Kh, KBASE(1)); else SLOAD_H(Kh, Vh, KBASE(1)); }
    if constexpr (BI) { mask_bias(pA0, pA1, mwA, hi); MWLOAD(2); }
    SBAR(); qkt<0, SK, BI>(pA0, pA1, K_lds, r32, hi, S.qr, ACT(0));
    if constexpr (BI) mask_bias(pB0, pB1, mwB, hi);
    if constexpr (F32) { if (NT > 1) { VMW(); SWRITE_KF(1); SBAR(); SLOAD_F((const float*)Vh, KBASE(1)); } }
    MASKT(pA0, pA1, 0); partialSM(pA0, pA1, m_reg, mnA, alA);
    if (NT > 1) { VMW(); if constexpr (F32) { SWRITE_VF(1); SBAR(); if (NT > 2) SLOAD_F((const float*)Kh, KBASE(2)); } else SWRITE_H(1); }
    __syncthreads();
#define HALF_STEP(PX0, PX1, mnX, alX, PY0, PY1, alY, t, KB, VB, SB) do {                                                      \
        if constexpr (BI) MWLOAD((t) + 2); else MWLOAD((t) + 1);                                                          \
        SBAR(); qkt<KB, SK, BI>(PX0, PX1, K_lds, r32, hi, S.qr, ACT(t));                                                  \
        finishSM(PY0, PY1, alY, l_reg, pa0, pa1, pa2, pa3); SBAR();                                                           \
        if ((t) + 1 < NT) { if constexpr (F32) { VMW(); SWRITE_KF(SB); SBAR(); SLOAD_F((const float*)Vh, KBASE((t) + 1)); }  \
                            else { SLOAD_H(Kh, Vh, KBASE((t) + 1)); } SBAR(); }                                               \
        { const unsigned long long mwn_ = (((t) + 1) & 1) ? mwB : mwA; const unsigned nlo_ = ~(unsigned)(mwn_ >> (4 * hi)), nup_ = ~(unsigned)(mwn_ >> (32 + 4 * hi));   \
          pv_tile<VB, SK, BI>(o, vb0, pa0, pa1, pa2, pa3, ACT((t) - 1), &PY0, &PY1, nlo_, nup_); }                           \
        MASKT(PX0, PX1, (t)); partialSM(PX0, PX1, m_reg, mnX, alX);                                        \
        __syncthreads();                                                                                                      \
        if ((t) + 1 < NT) { VMW(); if constexpr (F32) { SWRITE_VF(SB); SBAR(); if ((t) + 2 < NT) SLOAD_F((const float*)Kh, KBASE((t) + 2)); } \
                            else { SWRITE_H(SB); } }                                                                          \
        RESC(alX); __syncthreads(); } while (0)
    for (int t = 1; t + 1 < NT; t += 2) {
        HALF_STEP(pB0, pB1, mnB, alB, pA0, pA1, alA, t, 1, 0, 0);
        HALF_STEP(pA0, pA1, mnA, alA, pB0, pB1, alB, t + 1, 0, 1, 1);
    }
    const bool even = (NT & 1) == 0;
    if (even) { SBAR(); qkt<1, SK, BI>(pB0, pB1, K_lds, r32, hi, S.qr, ACT(NT - 1)); SBAR(); }
#define QROW(e) (nxt.Q + (size_t)(wid * QBLK + r32) * QST + ((e) >> 1) * 16 + hi * 8 + ((e) & 1) * 4)
    if constexpr (F32) { SLOAD_F((const float*)nxt.K, kbn); SBAR();
#pragma unroll
        for (int e = 0; e < 8; ++e) S.tq[e] = *(const f32x4*)QROW(e); }
    else { SLOAD_H(nxt.K, nxt.V, kbn); SBAR();
#pragma unroll
        for (int d0 = 0; d0 < 8; ++d0) S.qr[d0] = load8<TIn>(nxt.Q + (size_t)(wid * QBLK + r32) * QST + d0 * 16 + hi * 8); }
    SBAR();
    finishSM(pA0, pA1, alA, l_reg, pa0, pa1, pa2, pa3); SBAR();
    if constexpr (F32) {
#pragma unroll
        for (int e = 8; e < 16; ++e) S.tq[e] = *(const f32x4*)QROW(e); SBAR(); }
#undef QROW
    pv_tile<0, SK>(o, vb0, pa0, pa1, pa2, pa3, ACT(even ? NT - 2 : NT - 1));
    if (even) { MASKT(pB0, pB1, NT - 1); partialSM(pB0, pB1, m_reg, mnB, alB); __syncthreads(); RESC(alB);
        finishSM(pB0, pB1, alB, l_reg, pa0, pa1, pa2, pa3); SBAR(); pv_tile<1, SK>(o, vb0, pa0, pa1, pa2, pa3, ACT(NT - 1)); }
    SBAR(); SEAM_K0();
    if (hi == 0) li_l[r32] = l_reg; asm volatile("s_waitcnt lgkmcnt(0)" ::: "memory");
    float rli[16];
#pragma unroll
    for (int r = 0; r < 16; ++r) rli[r] = __builtin_amdgcn_rcpf(li_l[crow(r, hi)]);
    TOut* Ow = cur.O + (size_t)(wid * QBLK) * OST;
#pragma unroll
    for (int r = 0; r < 16; ++r) { const int orow = crow(r, hi);
#pragma unroll
        for (int d0 = 0; d0 < 4; ++d0) { const float v = o[d0][r] * rli[r];
            if constexpr (same_t<TOut, float>::v) { Ow[(size_t)orow * OST + d0 * 32 + r32] = v; }
            else { const float vn = __shfl_xor(v, 1);
                   if ((r32 & 1) == 0) *(unsigned*)(Ow + (size_t)orow * OST + d0 * 32 + r32) = cvtpk(v, vn); } } }
    if constexpr (F32) {
#pragma unroll
        for (int d0 = 0; d0 < 8; ++d0) S.qr[d0] = pack8(S.tq[2 * d0], S.tq[2 * d0 + 1]); }
    __syncthreads();
#undef RESC
#undef KBASE
#undef ACT
#undef MASKT
#undef MWLOAD
#undef SEAM_K0
#undef HALF_STEP
}
#undef ROW
#undef VMW
#undef VMWN
#undef SLOAD_H
#undef SWRITE_HK
#undef SWRITE_HV
#undef SWRITE_H
#undef SLOAD_F
#undef SWRITE_KF
#undef SWRITE_VF

}

constexpr int NWAVES = 8, NTHREADS = 512;
constexpr int DM = 2048, SEQ = 4096, NMETA = 16, TP = 4112, NBP = 2, SBN = 8, PAST = 16384, NPG = 128;
constexpr int XROW0 = 8192, SROW0 = 8224, NROWS = 8232, MPAD = 8448, FF = 8192, MAINM = 8192, XR = 48;
constexpr int NA_IN = 6144, NB_IN = 4176, NB_PAD = 4352, NC_IN = 12352, NC_PAD = 12544, DVW = 4096, CDIM = 8192;
constexpr float ALPHA = 1.6817928305074292f;
constexpr float LN_EPS = 1e-5f, RMS_EPS = 1e-6f;
constexpr int SCW = 4160, SCSW = 16448, KIROWS = 4128, NSKEY = PAST + 1;
constexpr int POS_SAMPLE_IDX = TP;

constexpr size_t O_YP = 0, O_YS = O_YP + (size_t)NBP * SEQ * DM, O_CAP = O_YS + (size_t)SBN * DM, O_CAS = O_CAP + 2 * NBP * 2 * DM,
                 O_KP = O_CAS + 2 * SBN * 2 * DM, O_VP = O_KP + (size_t)NBP * TP * 512, O_IKP = O_VP + (size_t)NBP * TP * 512,
                 O_KS = O_IKP + (size_t)NBP * TP * 64, O_VS = O_KS + SBN * 512, O_IKS = O_VS + SBN * 512, O_CCP = O_IKS + SBN * 64,
                 O_CCS = O_CCP + (size_t)NBP * 3 * CDIM, O_DP = O_CCS + (size_t)SBN * 3 * CDIM, O_DS = O_DP + (size_t)NBP * 32 * 128 * 128,
                 O_END = O_DS + (size_t)SBN * 32 * 128 * 128;

constexpr size_t MiB = 1u << 20;
constexpr size_t WS_CTL = 0, CTL_ZERO_BYTES = 1 * MiB;
constexpr size_t WS_TAB128 = 1 * MiB, WS_TAB64 = 4 * MiB, WS_WI = 6 * MiB, WS_G = 7 * MiB, WS_BETA = 9 * MiB, WS_CNT = 11 * MiB, WS_KIB = 12 * MiB,
                 WS_SCS = 14 * MiB, WS_IDXL = 16 * MiB, WS_X = 26 * MiB, WS_QR = 60 * MiB, WS_QI = 94 * MiB, WS_Z = 112 * MiB, WS_Y = 180 * MiB,
                 WS_BIG = 248 * MiB, WS_QKVC = 452 * MiB, WS_SC = 584 * MiB, WS_W = 716 * MiB;
constexpr size_t WSZ_A_IN = (size_t)NA_IN * DM * 2, WSZ_A_OUT = (size_t)DM * DM * 2, WSZ_B_IN = (size_t)NB_PAD * DM * 2, WSZ_B_OUT = (size_t)DM * DM * 2,
                 WSZ_C_IN = (size_t)NC_PAD * DM * 2, WSZ_C_OUT = (size_t)DM * DVW * 2, WSZ_W1 = (size_t)FF * DM * 2, WSZ_W2 = (size_t)DM * FF * 2;
constexpr size_t WS_WA_IN = WS_W, WS_WA_OUT = WS_WA_IN + 2 * WSZ_A_IN, WS_WB_IN = WS_WA_OUT + 2 * WSZ_A_OUT, WS_WB_OUT = WS_WB_IN + WSZ_B_IN,
                 WS_WC_IN = WS_WB_OUT + WSZ_B_OUT, WS_WC_OUT = WS_WC_IN + WSZ_C_IN, WS_W1 = WS_WC_OUT + WSZ_C_OUT, WS_W2 = WS_W1 + 4 * WSZ_W1,
                 WS_ZP = WS_W2 + 4 * WSZ_W2, WS_QKF = WS_ZP + 4 * MiB, WS_DWG = WS_QKF + 130 * MiB, WS_DUG = WS_DWG + 66 * MiB, WS_END = WS_DUG + 66 * MiB;
constexpr size_t WS_MASK = WS_IDXL, WS_KS = WS_Z, WS_VS = WS_Z + 9 * MiB;
constexpr size_t WS_DAF = WS_Z, WS_DTG = WS_Y, WS_DTB = WS_Y + 33 * MiB, WS_DPG = WS_QR, WS_DKT = WS_QKF, WS_DVT = WS_QKF + 33 * MiB, WS_DGC = WS_QI, WS_DBT = WS_QI + 2 * MiB;
constexpr int SP = 4352, SPAD = 240, MTW = 68;
constexpr int CW_BAR = 4096;

constexpr int RING_BYTES = 131072, LDSCTL_OFF = RING_BYTES, MISC_OFF = LDSCTL_OFF + 320, LDS_BYTES = 147456;

typedef unsigned short bf16;
typedef unsigned v4u __attribute__((ext_vector_type(4)));
typedef unsigned v2u __attribute__((ext_vector_type(2)));
typedef float f32x4 __attribute__((ext_vector_type(4)));
typedef float f32x2 __attribute__((ext_vector_type(2)));
typedef short bf16x8 __attribute__((ext_vector_type(8)));
typedef float f32x16 __attribute__((ext_vector_type(16)));
typedef __bf16 bf16x2_t __attribute__((ext_vector_type(2)));

#define LDS_WAIT() asm volatile("s_waitcnt lgkmcnt(0)" ::: "memory")
#define WAVE_SYNC() do { asm volatile("s_waitcnt lgkmcnt(0)" ::: "memory"); __builtin_amdgcn_wave_barrier(); } while (0)

__device__ __forceinline__ float bflo(unsigned w) { return __uint_as_float(w << 16); }
__device__ __forceinline__ float bfhi(unsigned w) { return __uint_as_float(w & 0xffff0000u); }
__device__ __forceinline__ float bf2f(bf16 h) { return __uint_as_float((unsigned)h << 16); }
__device__ __forceinline__ unsigned pk2(float lo, float hi) { f32x2 v = {lo, hi}; bf16x2_t b = __builtin_convertvector(v, bf16x2_t); return __builtin_bit_cast(unsigned, b); }
__device__ __forceinline__ bf16 f2bf(float f) { return (bf16)(pk2(f, 0.f) & 0xffffu); }
__device__ __forceinline__ float wave_sum(float v) {
#pragma unroll
    for (int o = 1; o < 64; o <<= 1) v += __shfl_xor(v, o);
    return v;
}
__device__ __forceinline__ float wave_max(float v) {
#pragma unroll
    for (int o = 1; o < 64; o <<= 1) v = fmaxf(v, __shfl_xor(v, o));
    return v;
}
__device__ __forceinline__ int wave_sum_i(int v) {
#pragma unroll
    for (int o = 1; o < 64; o <<= 1) v += __shfl_xor(v, o);
    return v;
}
__device__ __forceinline__ float wave_sum_dpp(float v) {
    v += __int_as_float(__builtin_amdgcn_update_dpp(0, __float_as_int(v), 0x128, 0xf, 0xf, false));
    v += __int_as_float(__builtin_amdgcn_update_dpp(0, __float_as_int(v), 0x124, 0xf, 0xf, false));
    v += __int_as_float(__builtin_amdgcn_update_dpp(0, __float_as_int(v), 0x122, 0xf, 0xf, false));
    v += __int_as_float(__builtin_amdgcn_update_dpp(0, __float_as_int(v), 0x121, 0xf, 0xf, false));
    const int iv = __float_as_int(v);
    return (__int_as_float(__builtin_amdgcn_readlane(iv, 0)) + __int_as_float(__builtin_amdgcn_readlane(iv, 16))) + (__int_as_float(__builtin_amdgcn_readlane(iv, 32)) + __int_as_float(__builtin_amdgcn_readlane(iv, 48)));
}
__device__ __forceinline__ int wave_sum_dpp_i(int v) {
    v += __builtin_amdgcn_update_dpp(0, v, 0x128, 0xf, 0xf, false);
    v += __builtin_amdgcn_update_dpp(0, v, 0x124, 0xf, 0xf, false);
    v += __builtin_amdgcn_update_dpp(0, v, 0x122, 0xf, 0xf, false);
    v += __builtin_amdgcn_update_dpp(0, v, 0x121, 0xf, 0xf, false);
    return __builtin_amdgcn_readlane(v, 0) + __builtin_amdgcn_readlane(v, 16) + __builtin_amdgcn_readlane(v, 32) + __builtin_amdgcn_readlane(v, 48);
}
__device__ __forceinline__ float row16_sum(float v) {
    v += __int_as_float(__builtin_amdgcn_update_dpp(0, __float_as_int(v), 0x128, 0xf, 0xf, false));
    v += __int_as_float(__builtin_amdgcn_update_dpp(0, __float_as_int(v), 0x124, 0xf, 0xf, false));
    v += __int_as_float(__builtin_amdgcn_update_dpp(0, __float_as_int(v), 0x122, 0xf, 0xf, false));
    v += __int_as_float(__builtin_amdgcn_update_dpp(0, __float_as_int(v), 0x121, 0xf, 0xf, false));
    return v;
}
__device__ __forceinline__ float silu_f(float x) { return x / (1.f + __expf(-x)); }
__device__ __forceinline__ int prow(int b, int t) { return t >= NMETA ? b * SEQ + (t - NMETA) : XROW0 + b * NMETA + t; }
__device__ __forceinline__ void row_bt(int r, int& b, int& t) { if (r < XROW0) { b = r >> 12; t = (r & 4095) + NMETA; } else { b = (r - XROW0) >> 4; t = (r - XROW0) & 15; } }
__device__ __forceinline__ void unpack8(const v4u w, float (&f)[8]) {
    f[0] = bflo(w.x); f[1] = bfhi(w.x); f[2] = bflo(w.y); f[3] = bfhi(w.y); f[4] = bflo(w.z); f[5] = bfhi(w.z); f[6] = bflo(w.w); f[7] = bfhi(w.w);
}
__device__ __forceinline__ v4u pack8(const float (&f)[8]) { v4u w; w.x = pk2(f[0], f[1]); w.y = pk2(f[2], f[3]); w.z = pk2(f[4], f[5]); w.w = pk2(f[6], f[7]); return w; }

struct TrJob { bf16* WT; int K, k0, n0; bool ok, valid; };
__device__ __forceinline__ void tr_issue(const float* W, int K, int N, int Npad, bf16* WT, int item, int lane, float (&wv_)[32], TrJob& J) {
    const int nblk = Npad / 32, kb = item / nblk, nb = item % nblk, k0 = 64 * kb, n0 = 32 * nb;
    const int n = n0 + (lane & 31); const bool ok = n < N;
#pragma unroll
    for (int i = 0; i < 32; ++i) { const int kk = 2 * i + (lane >> 5); wv_[i] = W[(size_t)(k0 + kk) * N + (ok ? n : N - 1)]; }
    J.WT = WT; J.K = K; J.k0 = k0; J.n0 = n0; J.ok = ok; J.valid = true;
}
__device__ __forceinline__ void tr_finish(const float (&wv_)[32], const TrJob& J, LAS float* scr, int lane) {
#pragma unroll
    for (int i = 0; i < 32; ++i) { const int kk = 2 * i + (lane >> 5); scr[kk * 33 + (lane & 31)] = J.ok ? wv_[i] : 0.f; }
    LDS_WAIT(); __builtin_amdgcn_wave_barrier();
    const int c = lane & 7;
#pragma unroll
    for (int j = 0; j < 4; ++j) { const int nn = (lane >> 3) + 8 * j; const LAS float* sp = scr + (8 * c) * 33 + nn;
        v4u o; o.x = pk2(sp[0 * 33], sp[1 * 33]); o.y = pk2(sp[2 * 33], sp[3 * 33]); o.z = pk2(sp[4 * 33], sp[5 * 33]); o.w = pk2(sp[6 * 33], sp[7 * 33]);
        *(v4u*)(J.WT + (size_t)(J.n0 + nn) * J.K + J.k0 + 8 * c) = o; }
    LDS_WAIT(); __builtin_amdgcn_wave_barrier();
}
__device__ __forceinline__ void transpose_item(const float* W, int K, int N, int Npad, bf16* WT, LAS float* scr, int item, int lane) {
    float wv_[32]; TrJob J; tr_issue(W, K, N, Npad, WT, item, lane, wv_, J); tr_finish(wv_, J, scr, lane);
}

struct Ptrs {
    const float *x_prompt, *x_sample, *state_conv_a, *cache_k, *cache_v, *cache_ik, *state_conv_c, *state_delta;
    const int* page_table;
    const float *meta, *w_in_a, *conv_w_a, *w_out_a, *w_in_b, *w_out_b, *w_in_c, *conv_w_c, *a_log, *dt_bias, *norm_w, *w_out_c, *ln1_g, *ln1_b, *w1, *w2, *ln2_g, *ln2_b;
    float* out; unsigned char* ws;
};

__device__ __forceinline__ void p0_prologue(const Ptrs& P, LAS unsigned char* lds, int gw, int NGW, int wave, int lane) {
    LAS float* scr = (LAS float*)(lds + wave * 16384);
    unsigned char* ws = P.ws;
    constexpr int I_A_IN = (DM / 64) * (NA_IN / 32), I_A_OUT = (DM / 64) * (DM / 32), I_B_IN = (DM / 64) * (NB_PAD / 32), I_B_OUT = I_A_OUT,
                  I_C_IN = (DM / 64) * (NC_PAD / 32), I_C_OUT = (DVW / 64) * (DM / 32), I_W1 = (DM / 64) * (FF / 32), I_W2 = (FF / 64) * (DM / 32);
    constexpr int NITEMS = I_A_IN + I_A_OUT + I_B_IN + I_W1 + I_W2;
#define TR_(cnt, Wp, Kk, Nn, Np, WTp) if (r < (cnt)) { transpose_item((Wp), (Kk), (Nn), (Np), (bf16*)(WTp), scr, r, lane); continue; } r -= (cnt);
    for (int it = gw; it < NITEMS; it += NGW) {
        int r = it;
        TR_(I_A_IN, P.w_in_a, DM, NA_IN, NA_IN, ws + WS_WA_IN)
        TR_(I_A_OUT, P.w_out_a, DM, DM, DM, ws + WS_WA_OUT)
        TR_(I_B_IN, P.w_in_b, DM, NB_IN, NB_PAD, ws + WS_WB_IN)
        TR_(I_W1, P.w1, DM, FF, FF, ws + WS_W1)
        transpose_item(P.w2, FF, DM, DM, (bf16*)(ws + WS_W2), scr, r, lane);
    }
#undef TR_
    bf16* X = (bf16*)(ws + WS_X);
    for (int r = gw; r < MPAD; r += NGW) {
        const float* src = nullptr;
        if (r < XROW0) src = P.x_prompt + (size_t)r * DM;
        else if (r < SROW0) src = P.meta + (size_t)((r - XROW0) & 15) * DM;
        else if (r < NROWS) src = P.x_sample + (size_t)(r - SROW0) * DM;
#pragma unroll
        for (int j = 0; j < 4; ++j) { const int c = 512 * j + 8 * lane; v4u o = {0u, 0u, 0u, 0u};
            if (src) { const f32x4 a = *(const f32x4*)(src + c), b = *(const f32x4*)(src + c + 4); o.x = pk2(a.x, a.y); o.y = pk2(a.z, a.w); o.z = pk2(b.x, b.y); o.w = pk2(b.z, b.w); }
            *(v4u*)(X + (size_t)r * DM + c) = o; }
    }
    f32x2* t128 = (f32x2*)(ws + WS_TAB128); f32x2* t64 = (f32x2*)(ws + WS_TAB64);
    const int gt = gw * 64 + lane, NGT = NGW * 64;
    for (int e = gt; e < (TP + 1) * 96; e += NGT) {
        const int pi = e / 96, i = e % 96; const float pos = (float)(pi == TP ? PAST : pi);
        const float ex = (i < 64) ? (float)(2 * i) * (1.f / 128.f) : (float)(2 * (i - 64)) * (1.f / 64.f);
        const float inv = __builtin_amdgcn_exp2f(-ex * 13.287712379549449f);
        const float angf = pos * inv;
        double rev = (double)angf * 0.15915494309189535; rev -= __builtin_rint(rev);
        const float rf = (float)rev; const float sn = __builtin_amdgcn_sinf(rf), cs = __builtin_amdgcn_cosf(rf);
        if (i < 64) t128[pi * 64 + i] = (f32x2){cs, sn}; else t64[pi * 32 + (i - 64)] = (f32x2){cs, sn};
    }
}

constexpr int NHOSTED = (DM / 64) * (DM / 32) + (DM / 64) * (FF / 32) + (FF / 64) * (DM / 32) + (DM / 64) * (NC_PAD / 32);
__device__ __forceinline__ void hosted_issue(const Ptrs& P, int it, int lane, float (&wv_)[32], TrJob& J) {
    unsigned char* ws = P.ws;
    constexpr int I_B_OUT = (DM / 64) * (DM / 32), I_C_IN = (DM / 64) * (NC_PAD / 32), I_W1 = (DM / 64) * (FF / 32), I_W2 = (FF / 64) * (DM / 32);
    J.valid = false;
    if (it >= NHOSTED) return;
    int r = it;
    if (r < I_B_OUT) { tr_issue(P.w_out_b, DM, DM, DM, (bf16*)(ws + WS_WB_OUT), r, lane, wv_, J); return; } r -= I_B_OUT;
    if (r < I_W1) { tr_issue(P.w1 + (size_t)DM * FF, DM, FF, FF, (bf16*)(ws + WS_W1 + WSZ_W1), r, lane, wv_, J); return; } r -= I_W1;
    if (r < I_W2) { tr_issue(P.w2 + (size_t)DM * FF, FF, DM, DM, (bf16*)(ws + WS_W2 + WSZ_W2), r, lane, wv_, J); return; } r -= I_W2;
    (void)I_C_IN; tr_issue(P.w_in_c, DM, NC_IN, NC_PAD, (bf16*)(ws + WS_WC_IN), r, lane, wv_, J);
}
__device__ __forceinline__ void deferred_transposes(const Ptrs& P, LAS unsigned char* lds, int idx, int stride, int wave, int lane) {
    LAS float* scr = (LAS float*)(lds + wave * 16384);
    unsigned char* ws = P.ws;
    constexpr int I_A_IN = (DM / 64) * (NA_IN / 32), I_A_OUT = (DM / 64) * (DM / 32), I_C_OUT = (DVW / 64) * (DM / 32), I_W1 = (DM / 64) * (FF / 32), I_W2 = (FF / 64) * (DM / 32);
    constexpr int NITEMS = I_A_IN + I_A_OUT + I_C_OUT + 2 * I_W1 + 2 * I_W2;
#define TR_(cnt, Wp, Kk, Nn, Np, WTp) if (r < (cnt)) { transpose_item((Wp), (Kk), (Nn), (Np), (bf16*)(WTp), scr, r, lane); continue; } r -= (cnt);
    for (int it = idx; it < NITEMS; it += stride) {
        int r = it;
        TR_(I_C_OUT, P.w_out_c, DVW, DM, DM, ws + WS_WC_OUT)
        TR_(I_W1, P.w1 + 2 * (size_t)DM * FF, DM, FF, FF, ws + WS_W1 + 2 * WSZ_W1)
        TR_(I_W2, P.w2 + 2 * (size_t)DM * FF, FF, DM, DM, ws + WS_W2 + 2 * WSZ_W2)
        TR_(I_A_IN, P.w_in_a + (size_t)DM * NA_IN, DM, NA_IN, NA_IN, ws + WS_WA_IN + WSZ_A_IN)
        TR_(I_A_OUT, P.w_out_a + (size_t)DM * DM, DM, DM, DM, ws + WS_WA_OUT + WSZ_A_OUT)
        TR_(I_W1, P.w1 + 3 * (size_t)DM * FF, DM, FF, FF, ws + WS_W1 + 3 * WSZ_W1)
        transpose_item(P.w2 + 3 * (size_t)DM * FF, FF, DM, DM, (bf16*)(ws + WS_W2 + 3 * WSZ_W2), scr, r, lane);
    }
#undef TR_
}

__device__ __forceinline__ void ln_row_finish(float (&v)[32], float s, const f32x4 (&gq)[8], const f32x4 (&bq_)[8], bf16* xo, float* of, int lane) {
    const float mean = wave_sum_dpp(s) * (1.f / DM); float s2 = 0.f;
#pragma unroll
    for (int i = 0; i < 32; ++i) { v[i] -= mean; s2 += v[i] * v[i]; }
    const float rstd = 1.f / sqrtf(wave_sum_dpp(s2) * (1.f / DM) + LN_EPS);
#pragma unroll
    for (int j = 0; j < 4; ++j) { const int c = 512 * j + 8 * lane; const f32x4 g0 = gq[2 * j], g1 = gq[2 * j + 1], b0 = bq_[2 * j], b1 = bq_[2 * j + 1];
        float o[8];
        o[0] = v[8 * j + 0] * rstd * g0.x + b0.x; o[1] = v[8 * j + 1] * rstd * g0.y + b0.y; o[2] = v[8 * j + 2] * rstd * g0.z + b0.z; o[3] = v[8 * j + 3] * rstd * g0.w + b0.w;
        o[4] = v[8 * j + 4] * rstd * g1.x + b1.x; o[5] = v[8 * j + 5] * rstd * g1.y + b1.y; o[6] = v[8 * j + 6] * rstd * g1.z + b1.z; o[7] = v[8 * j + 7] * rstd * g1.w + b1.w;
        *(v4u*)(xo + c) = pack8(o);
        if (of) { *(f32x4*)(of + c) = (f32x4){o[0], o[1], o[2], o[3]}; *(f32x4*)(of + c + 4) = (f32x4){o[4], o[5], o[6], o[7]}; } }
}
__device__ __forceinline__ void ln_phase(const float* Z, const float* ZP, bf16* X, bf16* Xo, const float* gam, const float* bet, float* yp, float* ys, LAS unsigned char* lds, int gw, int NGW, int tid, int wave, int lane) {
    (void)Z;
    LAS float* red = (LAS float*)lds;
    for (int xr = blockIdx.x; xr < NROWS - XROW0; xr += gridDim.x) {
        const int r = XROW0 + xr, c = 256 * wave + 4 * lane;
        const v2u xv = *(const v2u*)(X + (size_t)r * DM + c);
        const float* zr = ZP + (size_t)xr * DM + c; f32x4 z = *(const f32x4*)zr;
#pragma unroll
        for (int sl = 1; sl < 8; ++sl) z += *(const f32x4*)(zr + (size_t)sl * XR * DM);
        float v4[4] = {ALPHA * bflo(xv.x) + z.x, ALPHA * bfhi(xv.x) + z.y, ALPHA * bflo(xv.y) + z.z, ALPHA * bfhi(xv.y) + z.w};
        const float ps = wave_sum_dpp((v4[0] + v4[1]) + (v4[2] + v4[3]));
        __syncthreads();
        if (lane == 0) red[wave] = ps;
        __syncthreads();
        float tot = 0.f;
#pragma unroll
        for (int w = 0; w < 8; ++w) tot += red[w];
        const float mean = tot * (1.f / DM); float q2 = 0.f;
#pragma unroll
        for (int i = 0; i < 4; ++i) { v4[i] -= mean; q2 += v4[i] * v4[i]; }
        const float pq = wave_sum_dpp(q2);
        if (lane == 0) red[8 + wave] = pq;
        __syncthreads();
        float tq = 0.f;
#pragma unroll
        for (int w = 0; w < 8; ++w) tq += red[8 + w];
        const float rstd = 1.f / sqrtf(tq * (1.f / DM) + LN_EPS);
        const f32x4 g = *(const f32x4*)(gam + c), be = *(const f32x4*)(bet + c);
        const float o0 = v4[0] * rstd * g.x + be.x, o1 = v4[1] * rstd * g.y + be.y, o2 = v4[2] * rstd * g.z + be.z, o3 = v4[3] * rstd * g.w + be.w;
        v2u ov; ov.x = pk2(o0, o1); ov.y = pk2(o2, o3); *(v2u*)(Xo + (size_t)r * DM + c) = ov;
        if (ys && r >= SROW0) *(f32x4*)(ys + (size_t)(r - SROW0) * DM + c) = (f32x4){o0, o1, o2, o3};
    }
    f32x4 gq[8], bq_[8];
#pragma unroll
    for (int j = 0; j < 4; ++j) { const int c = 512 * j + 8 * lane; gq[2 * j] = *(const f32x4*)(gam + c); gq[2 * j + 1] = *(const f32x4*)(gam + c + 4); bq_[2 * j] = *(const f32x4*)(bet + c); bq_[2 * j + 1] = *(const f32x4*)(bet + c + 4); }
    for (int r = gw; r < XROW0; r += 2 * NGW) {
        const int r2 = r + NGW; const bool two = r2 < XROW0;
        v4u xa[4], xb[4];
#pragma unroll
        for (int j = 0; j < 4; ++j) { const int c = 512 * j + 8 * lane; xa[j] = *(const v4u*)(X + (size_t)r * DM + c); xb[j] = *(const v4u*)(X + (size_t)(two ? r2 : r) * DM + c); }
        float va[32], vb[32]; float sa = 0.f, sb = 0.f;
#pragma unroll
        for (int j = 0; j < 4; ++j) { float t8[8]; unpack8(xa[j], t8);
#pragma unroll
            for (int i = 0; i < 8; ++i) { va[8 * j + i] = t8[i]; sa += t8[i]; }
            unpack8(xb[j], t8);
#pragma unroll
            for (int i = 0; i < 8; ++i) { vb[8 * j + i] = t8[i]; sb += t8[i]; } }
        ln_row_finish(va, sa, gq, bq_, Xo + (size_t)r * DM, yp ? yp + (size_t)r * DM : nullptr, lane);
        if (two) ln_row_finish(vb, sb, gq, bq_, Xo + (size_t)r2 * DM, yp ? yp + (size_t)r2 * DM : nullptr, lane);
    }
}

__device__ __forceinline__ void load_u(const bf16* BCH, int row, int c0, float (&u)[8]) {
    const v4u cg = *(const v4u*)(BCH + (size_t)row * NA_IN + DM + c0), hh = *(const v4u*)(BCH + (size_t)row * NA_IN + 2 * DM + c0);
    float a[8], b[8]; unpack8(cg, a); unpack8(hh, b);
#pragma unroll
    for (int i = 0; i < 8; ++i) u[i] = a[i] * b[i];
}
__device__ __forceinline__ void convA_phase(const bf16* BCH, bf16* Y, const float* cw, const float* hist, float* outp, float* outs, int gtid, int NT) {
    constexpr int RUN = 8, NRUN = SEQ / RUN;
    for (int it = gtid; it < (NBP * NRUN + NBP * NMETA + SBN) * 256; it += NT) {
        const int c0 = (it & 255) * 8, ru = it >> 8;
        float w0[8], w1[8], w2[8];
        { const f32x4 a = *(const f32x4*)(cw + c0), b = *(const f32x4*)(cw + c0 + 4); w0[0] = a.x; w0[1] = a.y; w0[2] = a.z; w0[3] = a.w; w0[4] = b.x; w0[5] = b.y; w0[6] = b.z; w0[7] = b.w; }
        { const f32x4 a = *(const f32x4*)(cw + DM + c0), b = *(const f32x4*)(cw + DM + c0 + 4); w1[0] = a.x; w1[1] = a.y; w1[2] = a.z; w1[3] = a.w; w1[4] = b.x; w1[5] = b.y; w1[6] = b.z; w1[7] = b.w; }
        { const f32x4 a = *(const f32x4*)(cw + 2 * DM + c0), b = *(const f32x4*)(cw + 2 * DM + c0 + 4); w2[0] = a.x; w2[1] = a.y; w2[2] = a.z; w2[3] = a.w; w2[4] = b.x; w2[5] = b.y; w2[6] = b.z; w2[7] = b.w; }
        float u0[8], u1[8], u2[8];
        if (ru < NBP * NRUN) {
            const int b = ru / NRUN, t0 = NMETA + (ru % NRUN) * RUN;
            if (t0 >= 1) load_u(BCH, prow(b, t0 - 1), c0, u1); else {
#pragma unroll
                for (int i = 0; i < 8; ++i) u1[i] = 0.f; }
            if (t0 >= 2) load_u(BCH, prow(b, t0 - 2), c0, u0); else {
#pragma unroll
                for (int i = 0; i < 8; ++i) u0[i] = 0.f; }
            const int r0 = prow(b, t0);
            v4u bq[RUN], cq[RUN], hq_[RUN];
#pragma unroll
            for (int k = 0; k < RUN; ++k) { const bf16* rp = BCH + (size_t)(r0 + k) * NA_IN + c0; bq[k] = *(const v4u*)rp; cq[k] = *(const v4u*)(rp + DM); hq_[k] = *(const v4u*)(rp + 2 * DM); }
#pragma unroll
            for (int k = 0; k < RUN; ++k) {
                const int r = r0 + k, t = t0 + k;
                { float ca[8], ha[8]; unpack8(cq[k], ca); unpack8(hq_[k], ha);
#pragma unroll
                  for (int i = 0; i < 8; ++i) u2[i] = ca[i] * ha[i]; }
                float bg[8]; unpack8(bq[k], bg);
                float y[8];
#pragma unroll
                for (int i = 0; i < 8; ++i) y[i] = bg[i] * (w0[i] * u0[i] + w1[i] * u1[i] + w2[i] * u2[i]);
                *(v4u*)(Y + (size_t)r * DM + c0) = pack8(y);
                if (t >= TP - 2) { float* o = outp + ((size_t)(b * 2 + (t - (TP - 2)))) * DM + c0; *(f32x4*)o = (f32x4){u2[0], u2[1], u2[2], u2[3]}; *(f32x4*)(o + 4) = (f32x4){u2[4], u2[5], u2[6], u2[7]}; }
#pragma unroll
                for (int i = 0; i < 8; ++i) { u0[i] = u1[i]; u1[i] = u2[i]; }
            }
        } else if (ru < NBP * NRUN + NBP * NMETA) {
            const int mi = ru - NBP * NRUN, b = mi / NMETA, t = mi % NMETA, r = XROW0 + mi;
            load_u(BCH, r, c0, u2);
            if (t >= 1) load_u(BCH, r - 1, c0, u1); else {
#pragma unroll
                for (int i = 0; i < 8; ++i) u1[i] = 0.f; }
            if (t >= 2) load_u(BCH, r - 2, c0, u0); else {
#pragma unroll
                for (int i = 0; i < 8; ++i) u0[i] = 0.f; }
            (void)b;
            float bg[8]; unpack8(*(const v4u*)(BCH + (size_t)r * NA_IN + c0), bg);
            float y[8];
#pragma unroll
            for (int i = 0; i < 8; ++i) y[i] = bg[i] * (w0[i] * u0[i] + w1[i] * u1[i] + w2[i] * u2[i]);
            *(v4u*)(Y + (size_t)r * DM + c0) = pack8(y);
        } else {
            const int sb = ru - NBP * NRUN - NBP * NMETA, r = SROW0 + sb;
            load_u(BCH, r, c0, u2);
            const float* h0 = hist + ((size_t)(sb * 2 + 0)) * DM + c0; const float* h1 = hist + ((size_t)(sb * 2 + 1)) * DM + c0;
            const f32x4 a0 = *(const f32x4*)h0, a1 = *(const f32x4*)(h0 + 4), b0 = *(const f32x4*)h1, b1 = *(const f32x4*)(h1 + 4);
            u0[0] = a0.x; u0[1] = a0.y; u0[2] = a0.z; u0[3] = a0.w; u0[4] = a1.x; u0[5] = a1.y; u0[6] = a1.z; u0[7] = a1.w;
            u1[0] = b0.x; u1[1] = b0.y; u1[2] = b0.z; u1[3] = b0.w; u1[4] = b1.x; u1[5] = b1.y; u1[6] = b1.z; u1[7] = b1.w;
            float* o0 = outs + ((size_t)(sb * 2 + 0)) * DM + c0; float* o1 = outs + ((size_t)(sb * 2 + 1)) * DM + c0;
            *(f32x4*)o0 = b0; *(f32x4*)(o0 + 4) = b1;
            *(f32x4*)o1 = (f32x4){u2[0], u2[1], u2[2], u2[3]}; *(f32x4*)(o1 + 4) = (f32x4){u2[4], u2[5], u2[6], u2[7]};
            float bg[8]; unpack8(*(const v4u*)(BCH + (size_t)r * NA_IN + c0), bg);
            float y[8];
#pragma unroll
            for (int i = 0; i < 8; ++i) y[i] = bg[i] * (w0[i] * u0[i] + w1[i] * u1[i] + w2[i] * u2[i]);
            *(v4u*)(Y + (size_t)r * DM + c0) = pack8(y);
        }
    }
}

constexpr float QSCALE = 0.08838834764831845f;
__device__ __forceinline__ void rope_phase(const bf16* PROJ, const Ptrs& P, int gw, int NGW, int lane) {
    unsigned char* ws = P.ws;
    const f32x2* t128 = (const f32x2*)(ws + WS_TAB128); const f32x2* t64 = (const f32x2*)(ws + WS_TAB64);
    bf16* Qr = (bf16*)(ws + WS_QR); bf16* QI = (bf16*)(ws + WS_QI); bf16* KIb = (bf16*)(ws + WS_KIB); float* WI = (float*)(ws + WS_WI);
    bf16* Ks = (bf16*)(ws + WS_KS); bf16* Vs = (bf16*)(ws + WS_VS);
    for (int pr_ = gw; pr_ < NBP * SPAD; pr_ += NGW) {
        const size_t o = ((size_t)((pr_ / SPAD) * SP + (pr_ % SPAD))) * 512 + 8 * lane; *(v4u*)(Ks + o) = (v4u){0u, 0u, 0u, 0u}; *(v4u*)(Vs + o) = (v4u){0u, 0u, 0u, 0u}; }
    for (int r = gw; r < NROWS; r += NGW) {
        const bf16* pr = PROJ + (size_t)r * NB_PAD;
        int pi; float *ko, *vo, *iko; bf16* kib = nullptr; bf16 *ksq = nullptr, *vsq = nullptr;
        if (r < SROW0) { int b, t; row_bt(r, b, t); pi = t; ksq = Ks + ((size_t)(b * SP + t + SPAD)) * 512; vsq = Vs + ((size_t)(b * SP + t + SPAD)) * 512; ko = P.out + O_KP + ((size_t)(b * TP + t)) * 512; vo = P.out + O_VP + ((size_t)(b * TP + t)) * 512; iko = P.out + O_IKP + ((size_t)(b * TP + t)) * 64; kib = KIb + ((size_t)(b * KIROWS + t)) * 64; }
        else { const int sb = r - SROW0; pi = POS_SAMPLE_IDX; ko = P.out + O_KS + (size_t)sb * 512; vo = P.out + O_VS + (size_t)sb * 512; iko = P.out + O_IKS + (size_t)sb * 64; }
        const f32x2* c128 = t128 + (size_t)pi * 64; const f32x2* c64 = t64 + (size_t)pi * 32;
        const int hd = lane >> 2, sub = lane & 3, hk = hd & 3;
        const v4u q1a = *(const v4u*)(pr + hd * 128 + 16 * sub), q1b = *(const v4u*)(pr + hd * 128 + 16 * sub + 8), q2a = *(const v4u*)(pr + hd * 128 + 64 + 16 * sub), q2b = *(const v4u*)(pr + hd * 128 + 64 + 16 * sub + 8);
        const v4u k1a = *(const v4u*)(pr + 2048 + hk * 128 + 16 * sub), k1b = *(const v4u*)(pr + 2048 + hk * 128 + 16 * sub + 8), k2a = *(const v4u*)(pr + 2048 + hk * 128 + 64 + 16 * sub), k2b = *(const v4u*)(pr + 2048 + hk * 128 + 64 + 16 * sub + 8);
        const v4u vv = *(const v4u*)(pr + 2560 + 8 * lane);
        const v4u i1 = *(const v4u*)(pr + 3072 + hd * 64 + 8 * sub), i2 = *(const v4u*)(pr + 3072 + hd * 64 + 32 + 8 * sub);
        const v4u j1 = *(const v4u*)(pr + 4096 + 8 * sub), j2 = *(const v4u*)(pr + 4096 + 32 + 8 * sub);
        const v4u wq = *(const v4u*)(pr + 4160 + 8 * (lane & 1));
        f32x4 csq[8], csi[4];
#pragma unroll
        for (int i = 0; i < 8; ++i) csq[i] = *(const f32x4*)(c128 + 16 * sub + 2 * i);
#pragma unroll
        for (int i = 0; i < 4; ++i) csi[i] = *(const f32x4*)(c64 + 8 * sub + 2 * i);
        {
            float x1[16], x2[16], o1[16], o2[16];
            { float t8[8]; unpack8(q1a, t8);
#pragma unroll
              for (int i = 0; i < 8; ++i) x1[i] = t8[i]; unpack8(q1b, t8);
#pragma unroll
              for (int i = 0; i < 8; ++i) x1[8 + i] = t8[i]; unpack8(q2a, t8);
#pragma unroll
              for (int i = 0; i < 8; ++i) x2[i] = t8[i]; unpack8(q2b, t8);
#pragma unroll
              for (int i = 0; i < 8; ++i) x2[8 + i] = t8[i]; }
#pragma unroll
            for (int i = 0; i < 16; i += 2) { const f32x4 cs = csq[i >> 1];
                o1[i] = (x1[i] * cs.x - x2[i] * cs.y) * QSCALE; o2[i] = (x2[i] * cs.x + x1[i] * cs.y) * QSCALE;
                o1[i + 1] = (x1[i + 1] * cs.z - x2[i + 1] * cs.w) * QSCALE; o2[i + 1] = (x2[i + 1] * cs.z + x1[i + 1] * cs.w) * QSCALE; }
            bf16* qo = Qr + (size_t)r * DM + hd * 128 + 16 * sub;
            { float t8[8];
#pragma unroll
              for (int i = 0; i < 8; ++i) t8[i] = o1[i]; *(v4u*)qo = pack8(t8);
#pragma unroll
              for (int i = 0; i < 8; ++i) t8[i] = o1[8 + i]; *(v4u*)(qo + 8) = pack8(t8);
#pragma unroll
              for (int i = 0; i < 8; ++i) t8[i] = o2[i]; *(v4u*)(qo + 64) = pack8(t8);
#pragma unroll
              for (int i = 0; i < 8; ++i) t8[i] = o2[8 + i]; *(v4u*)(qo + 72) = pack8(t8); }
        }
        if (lane < 16) {
#pragma unroll
            for (int hf = 0; hf < 2; ++hf) { float x1[8], x2[8], o1[8], o2[8]; unpack8(hf ? k1b : k1a, x1); unpack8(hf ? k2b : k2a, x2);
#pragma unroll
                for (int i = 0; i < 8; i += 2) { const f32x4 cs = csq[4 * hf + (i >> 1)];
                    o1[i] = x1[i] * cs.x - x2[i] * cs.y; o2[i] = x2[i] * cs.x + x1[i] * cs.y; o1[i + 1] = x1[i + 1] * cs.z - x2[i + 1] * cs.w; o2[i + 1] = x2[i + 1] * cs.z + x1[i + 1] * cs.w; }
                float* kq = ko + hk * 128 + 16 * sub + 8 * hf;
                *(f32x4*)kq = (f32x4){o1[0], o1[1], o1[2], o1[3]}; *(f32x4*)(kq + 4) = (f32x4){o1[4], o1[5], o1[6], o1[7]};
                *(f32x4*)(kq + 64) = (f32x4){o2[0], o2[1], o2[2], o2[3]}; *(f32x4*)(kq + 68) = (f32x4){o2[4], o2[5], o2[6], o2[7]};
                if (ksq) { *(v4u*)(ksq + hk * 128 + 16 * sub + 8 * hf) = pack8(o1); *(v4u*)(ksq + hk * 128 + 64 + 16 * sub + 8 * hf) = pack8(o2); } }
        }
        {
            float vf[8]; unpack8(vv, vf);
            *(f32x4*)(vo + 8 * lane) = (f32x4){vf[0], vf[1], vf[2], vf[3]}; *(f32x4*)(vo + 8 * lane + 4) = (f32x4){vf[4], vf[5], vf[6], vf[7]};
            if (vsq) *(v4u*)(vsq + 8 * lane) = vv;
        }
        {
            float x1[8], x2[8], o1[8], o2[8]; unpack8(i1, x1); unpack8(i2, x2);
#pragma unroll
            for (int i = 0; i < 8; i += 2) { const f32x4 cs = csi[i >> 1];
                o1[i] = x1[i] * cs.x - x2[i] * cs.y; o2[i] = x2[i] * cs.x + x1[i] * cs.y; o1[i + 1] = x1[i + 1] * cs.z - x2[i + 1] * cs.w; o2[i + 1] = x2[i + 1] * cs.z + x1[i + 1] * cs.w; }
            *(v4u*)(QI + (size_t)r * 1024 + hd * 64 + 8 * sub) = pack8(o1); *(v4u*)(QI + (size_t)r * 1024 + hd * 64 + 32 + 8 * sub) = pack8(o2);
        }
        if (lane < 4) {
            float x1[8], x2[8], o1[8], o2[8]; unpack8(j1, x1); unpack8(j2, x2);
#pragma unroll
            for (int i = 0; i < 8; i += 2) { const f32x4 cs = csi[i >> 1];
                o1[i] = x1[i] * cs.x - x2[i] * cs.y; o2[i] = x2[i] * cs.x + x1[i] * cs.y; o1[i + 1] = x1[i + 1] * cs.z - x2[i + 1] * cs.w; o2[i + 1] = x2[i + 1] * cs.z + x1[i + 1] * cs.w; }
            float* io = iko + 8 * sub;
            *(f32x4*)io = (f32x4){o1[0], o1[1], o1[2], o1[3]}; *(f32x4*)(io + 4) = (f32x4){o1[4], o1[5], o1[6], o1[7]};
            *(f32x4*)(io + 32) = (f32x4){o2[0], o2[1], o2[2], o2[3]}; *(f32x4*)(io + 36) = (f32x4){o2[4], o2[5], o2[6], o2[7]};
            if (kib) { *(v4u*)(kib + 8 * sub) = pack8(o1); *(v4u*)(kib + 32 + 8 * sub) = pack8(o2); }
        } else if (lane < 6) {
            float wv[8]; unpack8(wq, wv); float* wo = WI + (size_t)r * 16 + 8 * (lane - 4);
            *(f32x4*)wo = (f32x4){wv[0], wv[1], wv[2], wv[3]}; *(f32x4*)(wo + 4) = (f32x4){wv[4], wv[5], wv[6], wv[7]};
        }
    }
}

__device__ __forceinline__ void indexer_prompt(const Ptrs& P, LAS unsigned char* lds, int tid, int wave, int lane) {
    unsigned char* ws = P.ws;
    const bf16* QI = (const bf16*)(ws + WS_QI); const bf16* KIb = (const bf16*)(ws + WS_KIB); const float* WI = (const float*)(ws + WS_WI); float* SC = (float*)(ws + WS_SC);
    const int n = lane & 31, h8 = lane >> 5;
    const int qsel = (n >> 2) & 1, head = (n & 3) + 4 * (n >> 3);
    constexpr int NG = TP / 16;
    constexpr int KROW = 144, TBUF = 128 * KROW;
    LAS float* hscr = (LAS float*)(lds + 40960 + wave * 8448);
    int tit = blockIdx.x * 8 + wave;
    for (int it = blockIdx.x; it < 2 * NG; it += gridDim.x) {
        int b, qg;
        if (it < 256) { b = it & 1; qg = 1 + (it >> 1); } else if (it < 512) { b = it & 1; qg = 256 - ((it - 256) >> 1); } else { b = it - 512; qg = 0; }
        const int t0 = 16 * qg + 2 * wave;
        const bf16* qa = QI + (size_t)prow(b, t0 + qsel) * 1024 + head * 64 + 8 * h8;
        bf16x8 a[4];
#pragma unroll
        for (int kk = 0; kk < 4; ++kk) a[kk] = *(const bf16x8*)(qa + 16 * kk);
        const int tq = t0 + h8;
        const float* wp = WI + (size_t)prow(b, tq) * 16;
        float w[16];
#pragma unroll
        for (int i = 0; i < 4; ++i) { const f32x4 x = *(const f32x4*)(wp + 4 * i); w[4 * i] = x.x; w[4 * i + 1] = x.y; w[4 * i + 2] = x.z; w[4 * i + 3] = x.w; }
        const int ntile = ((16 * qg + 15) >> 5) + 1, ntrip = (ntile + 3) >> 2;
        float* scrow = SC + ((size_t)(b * TP + tq)) * SCW;
        const bf16* kbase = KIb + (size_t)b * KIROWS * 64;
        const int p0 = tid, p1 = tid + 512;
        const int l0 = (p0 >> 3) * KROW + (p0 & 7) * 16, l1 = (p1 >> 3) * KROW + (p1 & 7) * 16;
        asm volatile("s_waitcnt lgkmcnt(0)\n\ts_barrier" ::: "memory");
        v4u g0 = *(const v4u*)(kbase + (size_t)p0 * 8), g1 = *(const v4u*)(kbase + (size_t)p1 * 8);
        *(LAS v4u*)(lds + l0) = g0; *(LAS v4u*)(lds + l1) = g1;
        for (int tr = 0; tr < ntrip; ++tr) {
            const int cur = tr & 1;
            float hv[32]; TrJob HJ; hosted_issue(P, tit, lane, hv, HJ);
            if (tr + 1 < ntrip) { const size_t ko = (size_t)(tr + 1) * 128 * 64;
                const int kmax = KIROWS * 64 - 8;
                const size_t o0 = ko + (size_t)p0 * 8, o1 = ko + (size_t)p1 * 8;
                g0 = *(const v4u*)(kbase + (o0 <= (size_t)kmax ? o0 : (size_t)kmax)); g1 = *(const v4u*)(kbase + (o1 <= (size_t)kmax ? o1 : (size_t)kmax)); }
            asm volatile("s_waitcnt lgkmcnt(0)\n\ts_barrier" ::: "memory");
            const LAS unsigned char* kb = lds + cur * TBUF + n * KROW + h8 * 16;
#pragma unroll
            for (int u = 0; u < 4; ++u) {
                f32x16 acc;
#pragma unroll
                for (int i = 0; i < 16; ++i) acc[i] = 0.f;
#pragma unroll
                for (int kk = 0; kk < 4; ++kk) acc = __builtin_amdgcn_mfma_f32_32x32x16_bf16(a[kk], *(const LAS bf16x8*)(kb + u * 32 * KROW + kk * 32), acc, 0, 0, 0);
                float sc = 0.f;
#pragma unroll
                for (int i = 0; i < 16; ++i) sc += w[i] * fmaxf(acc[i], 0.f);
                const int s = 32 * (4 * tr + u) + n;
                if (s <= tq) scrow[s] = sc;
            }
            if (tr + 1 < ntrip) { *(LAS v4u*)(lds + (cur ^ 1) * TBUF + l0) = g0; *(LAS v4u*)(lds + (cur ^ 1) * TBUF + l1) = g1; }
            if (HJ.valid) { tr_finish(hv, HJ, hscr, lane); tit += gridDim.x * 8; }
        }
    }
    asm volatile("s_waitcnt lgkmcnt(0)\n\ts_barrier" ::: "memory");
    for (; tit < NHOSTED; tit += gridDim.x * 8) { float hv[32]; TrJob HJ; hosted_issue(P, tit, lane, hv, HJ); if (HJ.valid) tr_finish(hv, HJ, hscr, lane); }
}

__device__ __forceinline__ void indexer_sample(const Ptrs& P, LAS unsigned char* lds, int tid) {
    unsigned char* ws = P.ws;
    const bf16* QI = (const bf16*)(ws + WS_QI); const float* WI = (const float*)(ws + WS_WI); float* SCS = (float*)(ws + WS_SCS);
    LAS float* lq = (LAS float*)lds;
    LAS float* lw = lq + 1024;
    constexpr int NCH = (NSKEY + 511) / 512;
    for (int item = gridDim.x - 1 - blockIdx.x; item < SBN * NCH; item += gridDim.x) {
        const int sb = item / NCH, ch = item % NCH, r = SROW0 + sb;
        __syncthreads();
        for (int e = tid; e < 1024; e += NTHREADS) lq[e] = bf2f(QI[(size_t)r * 1024 + e]);
        if (tid < 16) lw[tid] = WI[(size_t)r * 16 + tid];
        __syncthreads();
        const int s = ch * 512 + tid;
        if (s < NSKEY) {
            const float* kr = (s < PAST) ? P.cache_ik + ((size_t)P.page_table[sb * NPG + (s >> 7)] * 128 + (s & 127)) * 64 : P.out + O_IKS + (size_t)sb * 64;
            f32x4 kv[16];
#pragma unroll
            for (int i = 0; i < 16; ++i) kv[i] = *(const f32x4*)(kr + 4 * i);
            float sc = 0.f;
            for (int h = 0; h < 16; ++h) { float d = 0.f;
#pragma unroll
                for (int i = 0; i < 16; ++i) { const f32x4 q = *(const LAS f32x4*)(lq + h * 64 + 4 * i); d += q.x * kv[i].x + q.y * kv[i].y + q.z * kv[i].z + q.w * kv[i].w; }
                sc += lw[h] * fmaxf(d, 0.f); }
            SCS[(size_t)sb * SCSW + s] = sc;
        }
    }
    __syncthreads();
}

__device__ __forceinline__ unsigned ordkey(float f) { const unsigned u = __float_as_uint(f); return (u & 0x80000000u) ? ~u : (u | 0x80000000u); }
constexpr int TOPK = 256;
__device__ __forceinline__ void topk_wave_mask(const float* sc, int n, unsigned long long* mrow, int lane) {
    constexpr int NS = MTW, M0 = SPAD / 64;
    static_assert(M0 == dattn::JLO, "first real key tile");
    unsigned key[NS];
#pragma unroll
    for (int m = M0; m < NS; ++m) { const int sidx = lane + 64 * m - SPAD; const int ci = sidx < 0 ? 0 : (sidx < n ? sidx : n - 1); const float v = sc[ci]; key[m] = (sidx >= 0 && sidx < n) ? ordkey(v) : 0u; }
    if (n <= TOPK) {
#pragma unroll
        for (int m = M0; m < NS; ++m) { const unsigned long long w = __ballot(key[m] != 0u); if (lane == 0) mrow[m] = w; }
        return;
    }
    unsigned T = 0u;
    for (int bit = 31; bit >= 0; --bit) {
        const unsigned cand = T | (1u << bit); int c = 0, cv = 0;
#pragma unroll
        for (int m = M0; m < NS; ++m) { if ((m & 1) != 0) c += __popcll(__ballot(key[m] >= cand)); else cv += (key[m] >= cand) ? 1 : 0; }
        c = __builtin_amdgcn_readfirstlane(c + wave_sum_dpp_i(cv));
        if (c >= TOPK) { T = cand; if (c == TOPK) break; }
    }
    int cg = 0;
#pragma unroll
    for (int m = M0; m < NS; ++m) cg += __popcll(__ballot(key[m] > T));
    const int need = TOPK - cg;
    int base_e = 0;
    const unsigned long long lt = (1ull << lane) - 1ull;
#pragma unroll
    for (int m = M0; m < NS; ++m) {
        const bool pg = key[m] > T, pe = key[m] == T;
        const unsigned long long me = __ballot(pe);
        const int pre_e = __popcll(me & lt);
        const unsigned long long w = __ballot(pg || (pe && (base_e + pre_e) < need));
        if (lane == 0) mrow[m] = w;
        base_e += __popcll(me);
    }
}
__device__ __forceinline__ void topk_block(const float* sc, int n, int* outIdx, int* outCnt, LAS unsigned* ls, int tid, int wave, int lane) {
    constexpr int NS = (NSKEY + NTHREADS - 1) / NTHREADS;
    unsigned key[NS];
#pragma unroll
    for (int m = 0; m < NS; ++m) { const int e = tid + NTHREADS * m; const float v = sc[e < n ? e : n - 1]; key[m] = (e < n) ? ordkey(v) : 0u; }
    unsigned T = 0u;
    for (int bit = 31; bit >= 0; --bit) {
        const unsigned cand = T | (1u << bit); int c = 0;
#pragma unroll
        for (int m = 0; m < NS; ++m) c += (key[m] >= cand) ? 1 : 0;
        c = wave_sum_dpp_i(c);
        LAS unsigned* buf = ls + (bit & 1) * 8;
        if (lane == 0) buf[wave] = (unsigned)c;
        __syncthreads();
        int tot = 0;
#pragma unroll
        for (int w = 0; w < 8; ++w) tot += (int)buf[w];
        if (tot >= TOPK) T = cand;
    }
    __syncthreads();
    if (tid == 0) { unsigned z_ = 0u; asm volatile("" : "+v"(z_)); ls[16] = z_; ls[17] = z_; }
    __syncthreads();
#pragma unroll
    for (int m = 0; m < NS; ++m) { const int e = tid + NTHREADS * m; if (key[m] > T) { const unsigned pos = atomicAdd((unsigned*)(ls + 16), 1u); if (pos < (unsigned)TOPK) outIdx[pos] = e; } }
    __syncthreads();
    const unsigned cg = ls[16];
    const unsigned need = (unsigned)TOPK - cg;
#pragma unroll
    for (int m = 0; m < NS; ++m) { const int e = tid + NTHREADS * m; if (key[m] == T) { const unsigned pos = atomicAdd((unsigned*)(ls + 17), 1u); if (pos < need) outIdx[cg + pos] = e; } }
    if (tid == 0) *outCnt = TOPK;
    __syncthreads();
}
__device__ __forceinline__ void select_phase(const Ptrs& P, LAS unsigned char* lds, int gw, int NGW, int tid, int wave, int lane) {
    unsigned char* ws = P.ws;
    const float* SC = (const float*)(ws + WS_SC); const float* SCS = (const float*)(ws + WS_SCS); int* IDXL = (int*)(ws + WS_IDXL); int* CNT = (int*)(ws + WS_CNT);
    for (int sb = blockIdx.x; sb < SBN; sb += gridDim.x) topk_block(SCS + (size_t)sb * SCSW, NSKEY, IDXL + (size_t)(SROW0 + sb) * TOPK, CNT + SROW0 + sb, (LAS unsigned*)lds, tid, wave, lane);
    unsigned long long* MASK = (unsigned long long*)(ws + WS_MASK);
    for (int r = gw; r < SROW0; r += NGW) { int b, t; row_bt(r, b, t);
        if (r < XROW0) topk_wave_mask(SC + ((size_t)(b * TP + t)) * SCW, t + 1, MASK + ((size_t)(b * SP + t + SPAD)) * MTW, lane);
        else { if (lane <= t) IDXL[(size_t)r * TOPK + lane] = lane; if (lane == 0) CNT[r] = t + 1; } }
}

__device__ __forceinline__ void attn_phase(const Ptrs& P, bf16* O, LAS unsigned char* lds, int tid, int wave, int lane) {
    unsigned char* ws = P.ws;
    const bf16* Qr = (const bf16*)(ws + WS_QR); const int* IDXL = (const int*)(ws + WS_IDXL); const int* CNT = (const int*)(ws + WS_CNT);
    LAS float* lq = (LAS float*)(lds + wave * 2048);
    LAS float* part = (LAS float*)(lds + 16384);
    LAS float* ml = (LAS float*)(lds + 32768);
    for (int item = blockIdx.x; item < (NROWS - XROW0) * 4; item += gridDim.x) {
        const int r = XROW0 + (item >> 2), n = item & 3;
        const int cnt = CNT[r];
        { float qf[8]; unpack8(*(const v4u*)(Qr + (size_t)r * DM + n * 512 + 8 * lane), qf);
          *(LAS f32x4*)(lq + 8 * lane) = (f32x4){qf[0], qf[1], qf[2], qf[3]}; *(LAS f32x4*)(lq + 8 * lane + 4) = (f32x4){qf[4], qf[5], qf[6], qf[7]}; }
        const int kl = lane & 31, hh = lane >> 5, e = wave * 32 + kl;
        const bool valid = e < cnt;
        const int s = valid ? IDXL[(size_t)r * TOPK + e] : 0;
        const float *kq, *vq;
        if (r < SROW0) { const int b = (r - XROW0) >> 4; kq = P.out + O_KP + ((size_t)(b * TP + s)) * 512; vq = P.out + O_VP + ((size_t)(b * TP + s)) * 512; }
        else { const int sb = r - SROW0;
            if (s < PAST) { const size_t off = ((size_t)P.page_table[sb * NPG + (s >> 7)] * 128 + (s & 127)) * 512; kq = P.cache_k + off; vq = P.cache_v + off; }
            else { kq = P.out + O_KS + (size_t)sb * 512; vq = P.out + O_VS + (size_t)sb * 512; } }
        kq += n * 128 + 64 * hh; vq += n * 128;
        f32x4 kv[16];
#pragma unroll
        for (int i = 0; i < 16; ++i) kv[i] = *(const f32x4*)(kq + 4 * i);
        WAVE_SYNC();
        float acc[4] = {0.f, 0.f, 0.f, 0.f};
#pragma unroll
        for (int i = 0; i < 16; ++i)
#pragma unroll
            for (int g = 0; g < 4; ++g) { const f32x4 qv = *(const LAS f32x4*)(lq + g * 128 + 64 * hh + 4 * i); acc[g] += qv.x * kv[i].x + qv.y * kv[i].y + qv.z * kv[i].z + qv.w * kv[i].w; }
        float pg[4], mw[4], lw[4];
#pragma unroll
        for (int g = 0; g < 4; ++g) { float a = acc[g] + __shfl_xor(acc[g], 32); a = valid ? a : -INFINITY;
            const float m = wave_max(a); const float pv = valid ? __expf(a - m) : 0.f;
            pg[g] = pv; mw[g] = m; lw[g] = wave_sum(hh == 0 ? pv : 0.f); }
        const unsigned long long va = (unsigned long long)vq; const int va_lo = (int)(unsigned)va, va_hi = (int)(unsigned)(va >> 32);
        f32x2 vv[32];
#pragma unroll
        for (int j = 0; j < 32; ++j) { const unsigned long long a = ((unsigned long long)(unsigned)__builtin_amdgcn_readlane(va_hi, j) << 32) | (unsigned)__builtin_amdgcn_readlane(va_lo, j);
            vv[j] = *(const f32x2*)((const float*)a + 2 * lane); }
        float o[4][2];
#pragma unroll
        for (int g = 0; g < 4; ++g) { o[g][0] = 0.f; o[g][1] = 0.f; }
#pragma unroll
        for (int j = 0; j < 32; ++j)
#pragma unroll
            for (int g = 0; g < 4; ++g) { const float pj = __int_as_float(__builtin_amdgcn_readlane(__float_as_int(pg[g]), j)); o[g][0] += pj * vv[j].x; o[g][1] += pj * vv[j].y; }
#pragma unroll
        for (int g = 0; g < 4; ++g) { *(LAS f32x2*)(part + (wave * 4 + g) * 128 + 2 * lane) = (f32x2){o[g][0], o[g][1]};
            if (lane == 0) { ml[(wave * 4 + g) * 2] = mw[g]; ml[(wave * 4 + g) * 2 + 1] = lw[g]; } }
        __syncthreads();
        { const int g = tid >> 7, d = tid & 127; float M = -INFINITY;
#pragma unroll
          for (int w = 0; w < 8; ++w) M = fmaxf(M, ml[(w * 4 + g) * 2]);
          float L = 0.f, a = 0.f;
#pragma unroll
          for (int w = 0; w < 8; ++w) { const float mv = ml[(w * 4 + g) * 2]; const float sc = (mv == -INFINITY) ? 0.f : __expf(mv - M); L += ml[(w * 4 + g) * 2 + 1] * sc; a += part[(w * 4 + g) * 128 + d] * sc; }
          O[(size_t)r * DM + (4 * n + g) * 128 + d] = f2bf(a / L); }
        __syncthreads();
    }
}

__device__ __forceinline__ void convC_finish(float (&acc)[8], int it) {
    float ss = 0.f;
#pragma unroll
    for (int i = 0; i < 8; ++i) { acc[i] = silu_f(acc[i]); ss += acc[i] * acc[i]; }
    if (it < 8) { ss = row16_sum(ss); float rn = 1.f / sqrtf(ss + RMS_EPS); if (it < 4) rn *= QSCALE;
#pragma unroll
        for (int i = 0; i < 8; ++i) acc[i] *= rn; }
}
__device__ __forceinline__ void convC_phase(const bf16* PROJC, const Ptrs& P, int gw, int NGW, int lane) {
    unsigned char* ws = P.ws;
    bf16* QKVC = (bf16*)(ws + WS_QKVC); float* QKF = (float*)(ws + WS_QKF); float* G = (float*)(ws + WS_G); float* BETA = (float*)(ws + WS_BETA);
    const float* cw = P.conv_w_c;
    constexpr int RUN = 8, NRUN = SEQ / RUN;
    for (int item = gw; item < 16 * NBP * NRUN; item += NGW) {
        const int it = item & 15, ru = item >> 4, b = ru / NRUN, t0 = NMETA + (ru % NRUN) * RUN, ch0 = it * 512 + 8 * lane;
        float w[4][8];
#pragma unroll
        for (int j = 0; j < 4; ++j) { const f32x4 w0 = *(const f32x4*)(cw + (size_t)j * CDIM + ch0), w1 = *(const f32x4*)(cw + (size_t)j * CDIM + ch0 + 4);
            w[j][0] = w0.x; w[j][1] = w0.y; w[j][2] = w0.z; w[j][3] = w0.w; w[j][4] = w1.x; w[j][5] = w1.y; w[j][6] = w1.z; w[j][7] = w1.w; }
        const int r0 = prow(b, t0);
        v4u xr[RUN + 3];
#pragma unroll
        for (int j = 0; j < 3; ++j) { const int tt = t0 - 3 + j; xr[j] = tt >= 0 ? *(const v4u*)(PROJC + (size_t)prow(b, tt) * NC_PAD + ch0) : (v4u){0u, 0u, 0u, 0u}; }
#pragma unroll
        for (int k = 0; k < RUN; ++k) xr[3 + k] = *(const v4u*)(PROJC + (size_t)(r0 + k) * NC_PAD + ch0);
        float x[RUN + 3][8];
#pragma unroll
        for (int j = 0; j < RUN + 3; ++j) unpack8(xr[j], x[j]);
#pragma unroll
        for (int k = 0; k < RUN; ++k) {
            float acc[8];
#pragma unroll
            for (int i = 0; i < 8; ++i) acc[i] = w[0][i] * x[k][i] + w[1][i] * x[k + 1][i] + w[2][i] * x[k + 2][i] + w[3][i] * x[k + 3][i];
            convC_finish(acc, it);
            *(v4u*)(QKVC + (size_t)(r0 + k) * CDIM + ch0) = pack8(acc);
            const int t = t0 + k;
            if (t >= TP - 3) { float* o = P.out + O_CCP + ((size_t)(b * 3 + (t - (TP - 3)))) * CDIM + ch0;
                *(f32x4*)o = (f32x4){x[k + 3][0], x[k + 3][1], x[k + 3][2], x[k + 3][3]}; *(f32x4*)(o + 4) = (f32x4){x[k + 3][4], x[k + 3][5], x[k + 3][6], x[k + 3][7]}; }
        }
    }
    for (int item = gw; item < 16 * NBP * NMETA; item += NGW) {
        const int it = item & 15, mi = item >> 4, t = mi % NMETA, r = XROW0 + mi, ch0 = it * 512 + 8 * lane;
        float x[4][8];
#pragma unroll
        for (int j = 0; j < 4; ++j) { const int tt = t - 3 + j; if (tt >= 0) unpack8(*(const v4u*)(PROJC + (size_t)(r - 3 + j) * NC_PAD + ch0), x[j]); else {
#pragma unroll
                for (int i = 0; i < 8; ++i) x[j][i] = 0.f; } }
        float acc[8];
#pragma unroll
        for (int i = 0; i < 8; ++i) acc[i] = 0.f;
#pragma unroll
        for (int j = 0; j < 4; ++j) { const f32x4 w0 = *(const f32x4*)(cw + (size_t)j * CDIM + ch0), w1 = *(const f32x4*)(cw + (size_t)j * CDIM + ch0 + 4);
            acc[0] += w0.x * x[j][0]; acc[1] += w0.y * x[j][1]; acc[2] += w0.z * x[j][2]; acc[3] += w0.w * x[j][3];
            acc[4] += w1.x * x[j][4]; acc[5] += w1.y * x[j][5]; acc[6] += w1.z * x[j][6]; acc[7] += w1.w * x[j][7]; }
        convC_finish(acc, it);
        *(v4u*)(QKVC + (size_t)r * CDIM + ch0) = pack8(acc);
    }
    for (int item = gw; item < 16 * SBN; item += NGW) {
        const int it = item & 15, sb = item >> 4, r = SROW0 + sb, ch0 = it * 512 + 8 * lane;
        float x[4][8];
#pragma unroll
        for (int j = 0; j < 3; ++j) { const float* hp = P.state_conv_c + ((size_t)(sb * 3 + j)) * CDIM + ch0; const f32x4 a = *(const f32x4*)hp, c = *(const f32x4*)(hp + 4);
            x[j][0] = a.x; x[j][1] = a.y; x[j][2] = a.z; x[j][3] = a.w; x[j][4] = c.x; x[j][5] = c.y; x[j][6] = c.z; x[j][7] = c.w; }
        unpack8(*(const v4u*)(PROJC + (size_t)r * NC_PAD + ch0), x[3]);
        float acc[8];
#pragma unroll
        for (int i = 0; i < 8; ++i) acc[i] = 0.f;
#pragma unroll
        for (int j = 0; j < 4; ++j) { const f32x4 w0 = *(const f32x4*)(cw + (size_t)j * CDIM + ch0), w1 = *(const f32x4*)(cw + (size_t)j * CDIM + ch0 + 4);
            acc[0] += w0.x * x[j][0]; acc[1] += w0.y * x[j][1]; acc[2] += w0.z * x[j][2]; acc[3] += w0.w * x[j][3];
            acc[4] += w1.x * x[j][4]; acc[5] += w1.y * x[j][5]; acc[6] += w1.z * x[j][6]; acc[7] += w1.w * x[j][7]; }
        convC_finish(acc, it);
        if (it < 8) { float* qk = QKF + (size_t)r * 4096 + ch0; *(f32x4*)qk = (f32x4){acc[0], acc[1], acc[2], acc[3]}; *(f32x4*)(qk + 4) = (f32x4){acc[4], acc[5], acc[6], acc[7]}; }
        *(v4u*)(QKVC + (size_t)r * CDIM + ch0) = pack8(acc);
        float* o = P.out + O_CCS + ((size_t)(sb * 3)) * CDIM + ch0;
#pragma unroll
        for (int j = 0; j < 3; ++j) { *(f32x4*)(o + (size_t)j * CDIM) = (f32x4){x[j + 1][0], x[j + 1][1], x[j + 1][2], x[j + 1][3]}; *(f32x4*)(o + (size_t)j * CDIM + 4) = (f32x4){x[j + 1][4], x[j + 1][5], x[j + 1][6], x[j + 1][7]}; }
    }
    for (int e = gw * 64 + lane; e < NROWS * 32; e += NGW * 64) {
        const int r = e >> 5, h = e & 31;
        const float braw = bf2f(PROJC[(size_t)r * NC_PAD + 12288 + h]), araw = bf2f(PROJC[(size_t)r * NC_PAD + 12320 + h]);
        const float xx = araw + P.dt_bias[h]; const float sp = xx > 20.f ? xx : __logf(1.f + __expf(xx));
        G[e] = -__expf(P.a_log[h]) * sp; BETA[e] = 1.f / (1.f + __expf(-braw));
    }
}

struct Tok { f32x4 k0, k1, q0, q1; unsigned v; float g, b; };
__device__ __forceinline__ void tok_load(Tok& T, const float* QKF, const bf16* QKVC, const float* G, const float* BETA, int row, int h, int rg, int col0) {
    const float* base = QKF + (size_t)row * 4096 + (h >> 1) * 128 + 8 * rg;
    T.q0 = *(const f32x4*)base; T.q1 = *(const f32x4*)(base + 4); T.k0 = *(const f32x4*)(base + 2048); T.k1 = *(const f32x4*)(base + 2052);
    T.v = *(const unsigned*)(QKVC + (size_t)row * CDIM + 4096 + h * 128 + col0);
    T.g = G[(size_t)row * 32 + h]; T.b = BETA[(size_t)row * 32 + h];
}
__device__ __forceinline__ f32x2 tok_step(f32x2 (&S)[8], const Tok& T) {
    const float kk[8] = {T.k0.x, T.k0.y, T.k0.z, T.k0.w, T.k1.x, T.k1.y, T.k1.z, T.k1.w};
    const float qq[8] = {T.q0.x, T.q0.y, T.q0.z, T.q0.w, T.q1.x, T.q1.y, T.q1.z, T.q1.w};
    const float a = __expf(T.g);
    f32x2 d0 = S[0] * kk[0], d1 = S[1] * kk[1];
#pragma unroll
    for (int i = 2; i < 8; i += 2) { d0 += S[i] * kk[i]; d1 += S[i + 1] * kk[i + 1]; }
    f32x2 d = d0 + d1;
    d.x = row16_sum(d.x); d.y = row16_sum(d.y);
    const f32x2 tv = {bflo(T.v), bfhi(T.v)};
    const f32x2 dl = (tv - d * a) * T.b;
    f32x2 o0 = {0.f, 0.f}, o1 = {0.f, 0.f};
#pragma unroll
    for (int i = 0; i < 8; i += 2) { S[i] = S[i] * a + dl * kk[i]; o0 += S[i] * qq[i]; S[i + 1] = S[i + 1] * a + dl * kk[i + 1]; o1 += S[i + 1] * qq[i + 1]; }
    f32x2 o = o0 + o1;
    o.x = row16_sum(o.x); o.y = row16_sum(o.y);
    return o;
}
__device__ __forceinline__ void delta_phase(const Ptrs& P, int idx, int stride, int lane) {
    unsigned char* ws = P.ws;
    const bf16* QKVC = (const bf16*)(ws + WS_QKVC); const float* QKF = (const float*)(ws + WS_QKF); const float* G = (const float*)(ws + WS_G); const float* BETA = (const float*)(ws + WS_BETA); bf16* OF = (bf16*)(ws + WS_SC);
    const int cg = lane >> 4, rg = lane & 15;
    {
        for (int item = idx; item < SBN * 32 * 16; item += stride) {
            const int sb = item >> 9, h = (item >> 4) & 31, col0 = 8 * (item & 15) + 2 * cg;
            const size_t so = ((size_t)((sb * 32 + h) * 128 + 8 * rg)) * 128 + col0;
            f32x2 S[8];
#pragma unroll
            for (int i = 0; i < 8; ++i) S[i] = *(const f32x2*)(P.state_delta + so + (size_t)i * 128);
            Tok T; tok_load(T, QKF, QKVC, G, BETA, SROW0 + sb, h, rg, col0);
            const f32x2 o = tok_step(S, T);
            if (rg == 0) *(unsigned*)(OF + (size_t)(SROW0 + sb) * DVW + h * 128 + col0) = pk2(o.x, o.y);
            float* op = P.out + O_DS + so;
#pragma unroll
            for (int i = 0; i < 8; ++i) *(f32x2*)(op + (size_t)i * 128) = S[i];
        }
    }
}
__device__ __forceinline__ void normC_piece(const v4u oq, const v4u zz, const float (&nw)[8], bf16* yo) {
    float o[8]; unpack8(oq, o);
    float ss = 0.f;
#pragma unroll
    for (int i = 0; i < 8; ++i) ss += o[i] * o[i];
    ss = row16_sum(ss);
    const float rs = 1.f / sqrtf(ss * (1.f / 128.f) + RMS_EPS);
    float z[8]; unpack8(zz, z);
#pragma unroll
    for (int i = 0; i < 8; ++i) o[i] = o[i] * rs * nw[i] * silu_f(z[i]);
    *(v4u*)yo = pack8(o);
}
__device__ __forceinline__ void normC_phase(const bf16* PROJC, bf16* Y, const Ptrs& P, int gw, int NGW, int lane) {
    const bf16* OF = (const bf16*)(P.ws + WS_SC);
    const int d0 = 8 * (lane & 15), hl = lane >> 4;
    float nw[8];
    { const f32x4 a = *(const f32x4*)(P.norm_w + d0), b = *(const f32x4*)(P.norm_w + d0 + 4); nw[0] = a.x; nw[1] = a.y; nw[2] = a.z; nw[3] = a.w; nw[4] = b.x; nw[5] = b.y; nw[6] = b.z; nw[7] = b.w; }
    for (int it = gw; it < (NROWS - XROW0) * 8; it += NGW) { const int r = XROW0 + (it >> 3), hd = (it & 7) * 4 + hl;
        const v4u oq = *(const v4u*)(OF + (size_t)r * DVW + hd * 128 + d0), zz = *(const v4u*)(PROJC + (size_t)r * NC_PAD + 8192 + hd * 128 + d0);
        normC_piece(oq, zz, nw, Y + (size_t)r * DVW + hd * 128 + d0); }
    for (int r = gw; r < XROW0; r += 2 * NGW) {
        const int r2 = (r + NGW < XROW0) ? r + NGW : r; const bool two = r + NGW < XROW0;
        v4u oa[8], za[8], ob[8], zb[8];
#pragma unroll
        for (int it = 0; it < 8; ++it) { const int hd = it * 4 + hl;
            oa[it] = *(const v4u*)(OF + (size_t)r * DVW + hd * 128 + d0); za[it] = *(const v4u*)(PROJC + (size_t)r * NC_PAD + 8192 + hd * 128 + d0);
            ob[it] = *(const v4u*)(OF + (size_t)r2 * DVW + hd * 128 + d0); zb[it] = *(const v4u*)(PROJC + (size_t)r2 * NC_PAD + 8192 + hd * 128 + d0); }
#pragma unroll
        for (int it = 0; it < 8; ++it) { const int hd = it * 4 + hl;
            normC_piece(oa[it], za[it], nw, Y + (size_t)r * DVW + hd * 128 + d0);
            if (two) normC_piece(ob[it], zb[it], nw, Y + (size_t)r2 * DVW + hd * 128 + d0); }
    }
}


template <int VAR = 0> __device__ __forceinline__ void dense_attn_phase(const Ptrs& P, bf16* O, char* lds, int wv) {
    unsigned char* ws = P.ws;
    const bf16* Qr = (const bf16*)(ws + WS_QR); const bf16* Ks = (const bf16*)(ws + WS_KS); const bf16* Vs = (const bf16*)(ws + WS_VS);
    const unsigned long long* MASK = (const unsigned long long*)(ws + WS_MASK);
    typedef dattn::BlockRef<bf16, bf16> BR;
    for (int it0 = blockIdx.x; it0 < 256; it0 += gridDim.x) {
        const int grp = it0 & 7, idx = it0 >> 3;
        const int b = grp >> 2, kvh = grp & 3, h = kvh * 4 + (idx >> 3), x = idx & 7;
        BR A, B;
        const int qa = 1 + x, qb = 16 - x;
        A.Q = Qr + ((size_t)(b * SEQ + 256 * (qa - 1))) * DM + h * 128; A.O = O + ((size_t)(b * SEQ + 256 * (qa - 1))) * DM + h * 128;
        B.Q = Qr + ((size_t)(b * SEQ + 256 * (qb - 1))) * DM + h * 128; B.O = O + ((size_t)(b * SEQ + 256 * (qb - 1))) * DM + h * 128;
        A.K = B.K = Ks + (size_t)b * SP * 512 + kvh * 128; A.V = B.V = Vs + (size_t)b * SP * 512 + kvh * 128;
        A.P0 = 256 * qa; B.P0 = 256 * qb;
        A.M = MASK + ((size_t)(b * SP + A.P0)) * MTW; B.M = MASK + ((size_t)(b * SP + B.P0)) * MTW;
        dattn::Seam<bf16> S;
        dattn::causal_swa_prime<bf16, bf16>(A, SP, lds, S, wv);
        dattn::causal_swa_block<bf16, bf16, VAR>(A, B, SP, SP, lds, S, wv);
        dattn::causal_swa_block<bf16, bf16, VAR>(B, B, SP, SP, lds, S, wv);
    }
}

constexpr int NCH = 65, CPAD = 48;
constexpr int NUQ = NBP * 16 * NCH, NUH = NBP * 32 * NCH;
__device__ __forceinline__ int crow32(int r, int hi) { return (r & 3) + 8 * (r >> 2) + 4 * hi; }
__device__ __forceinline__ int chunk_row(int b, int c, int i) { const int t = 64 * c + i - CPAD; return t >= 0 ? prow(b, t) : -1; }
__device__ __forceinline__ float incl_scan64(float v, int lane) {
#pragma unroll
    for (int o = 1; o < 64; o <<= 1) { const float u = __shfl_up(v, o); if (lane >= o) v += u; }
    return v;
}
#define MFMA32(a, b, c) __builtin_amdgcn_mfma_f32_32x32x16_bf16((a), (b), (c), 0, 0, 0)
__device__ __forceinline__ bf16x8 sel8(bool ok, bf16x8 v) { const bf16x8 z = {0, 0, 0, 0, 0, 0, 0, 0}; return ok ? v : z; }
__device__ __forceinline__ int sw23(int x) { return (x & ~12) | ((x & 4) << 1) | ((x & 8) >> 1); }
__device__ __forceinline__ int fidx64(int row, int xs) { return ((((row >> 5) * 2 + (xs >> 5)) * 2 + ((xs >> 4) & 1)) * 64 + (row & 31) + 32 * ((xs >> 3) & 1)) * 8 + (xs & 7); }

__device__ __forceinline__ v4u pack_frag(const f32x16& x, int s) { v4u w; w.x = pk2(x[8 * s], x[8 * s + 1]); w.y = pk2(x[8 * s + 2], x[8 * s + 3]); w.z = pk2(x[8 * s + 4], x[8 * s + 5]); w.w = pk2(x[8 * s + 6], x[8 * s + 7]); return w; }
__device__ __forceinline__ void stage_out8k(LAS unsigned char* stg, bf16* gdst, int lane) {
    WAVE_SYNC();
#pragma unroll
    for (int k = 0; k < 8; ++k) *(v4u*)(gdst + k * 512 + lane * 8) = *(const LAS v4u*)(stg + k * 1024 + lane * 16);
    WAVE_SYNC();
}
__device__ __forceinline__ void delta_d1_unit(unsigned char* ws, LAS unsigned char* lds, int uq, int wave, int lane) {
    asm volatile("" : "+v"(lane));
    const bf16* QKVC = (const bf16*)(ws + WS_QKVC); const float* G = (const float*)(ws + WS_G); const float* BETA = (const float*)(ws + WS_BETA);
    float* AF = (float*)(ws + WS_DAF); bf16* PG = (bf16*)(ws + WS_DPG); bf16* KT = (bf16*)(ws + WS_DKT); bf16* VT = (bf16*)(ws + WS_DVT);
    float* GC = (float*)(ws + WS_DGC); float* BT = (float*)(ws + WS_DBT);
    LAS float* lg = (LAS float*)(lds + wave * 16384);
    LAS unsigned char* stg = lds + wave * 16384 + 2048; LAS bf16* st = (LAS bf16*)stg;
    const int m = lane & 31, half = lane >> 5;
    const bf16x8 zf = {0, 0, 0, 0, 0, 0, 0, 0};
    {
        const int c = uq % NCH, bh = uq / NCH, hq = bh & 15, b = bh >> 4;
        { const int row = chunk_row(b, c, lane);
#pragma unroll
          for (int hh = 0; hh < 2; ++hh) { const int h = 2 * hq + hh; const float g = row >= 0 ? G[(size_t)row * 32 + h] : 0.f, bt = row >= 0 ? BETA[(size_t)row * 32 + h] : 0.f;
              const float gc = incl_scan64(g, lane); lg[hh * 64 + lane] = gc; lg[128 + hh * 64 + lane] = bt;
              const size_t uh = ((size_t)(b * 32 + h)) * NCH + c; GC[uh * 64 + lane] = gc; BT[uh * 64 + lane] = bt; } }
        const int row0 = chunk_row(b, c, m), row1 = chunk_row(b, c, 32 + m);
        const bf16* r0 = QKVC + (size_t)(row0 < 0 ? 0 : row0) * CDIM; const bf16* r1 = QKVC + (size_t)(row1 < 0 ? 0 : row1) * CDIM;
        f32x16 kk00, kk10, kk11, qk00, qk10, qk11;
#pragma unroll
        for (int i = 0; i < 16; ++i) { kk00[i] = 0.f; kk10[i] = 0.f; kk11[i] = 0.f; qk00[i] = 0.f; qk10[i] = 0.f; qk11[i] = 0.f; }
        const int sm = sw23(m);
        const int ktl = half * 32 + ((sm >> 4) & 1) * 512 + ((sm >> 3) & 1) * 256 + (sm & 7);
#pragma unroll 1
        for (int kh = 0; kh < 2; ++kh) {
            bf16x8 kf0[4], kf1[4], qf0[4], qf1[4];
#pragma unroll
            for (int u = 0; u < 4; ++u) { const int off = hq * 128 + 16 * (4 * kh + u) + 8 * half;
                kf0[u] = sel8(row0 >= 0, *(const bf16x8*)(r0 + 2048 + off)); kf1[u] = sel8(row1 >= 0, *(const bf16x8*)(r1 + 2048 + off));
                qf0[u] = sel8(row0 >= 0, *(const bf16x8*)(r0 + off)); qf1[u] = sel8(row1 >= 0, *(const bf16x8*)(r1 + off)); }
#pragma unroll
            for (int u = 0; u < 4; ++u) { const int ks = 4 * kh + u; const bf16x8 k0 = kf0[u], k1 = kf1[u], q0 = qf0[u], q1 = qf1[u];
                kk00 = MFMA32(k0, k0, kk00); kk10 = MFMA32(k1, k0, kk10); kk11 = MFMA32(k1, k1, kk11);
                qk00 = MFMA32(q0, k0, qk00); qk10 = MFMA32(q1, k0, qk10); qk11 = MFMA32(q1, k1, qk11);
                LAS bf16* kb = st + ktl + ((ks >> 1) & 1) * 2048 + (ks & 1) * 128;
#pragma unroll
                for (int e = 0; e < 8; ++e) { kb[(8 * (e >> 2) + (e & 3)) * 8] = (bf16)k0[e]; kb[1024 + (8 * (e >> 2) + (e & 3)) * 8] = (bf16)k1[e]; } }
            stage_out8k(stg, KT + (size_t)uq * 8192 + kh * 4096, lane);
        }
#pragma unroll 1
        for (int hh = 0; hh < 2; ++hh) { const int h = 2 * hq + hh; bf16* vt = VT + (((size_t)(b * 32 + h)) * NCH + c) * 8192;
            const int vtl = half * 64 + ((sm >> 4) & 1) * 512 + ((sm >> 3) & 1) * 256 + (sm & 7);
            bf16x8 vf0[8], vf1[8];
#pragma unroll
            for (int ks = 0; ks < 8; ++ks) { const int off = 4096 + h * 128 + 16 * ks + 8 * half; vf0[ks] = sel8(row0 >= 0, *(const bf16x8*)(r0 + off)); vf1[ks] = sel8(row1 >= 0, *(const bf16x8*)(r1 + off)); }
#pragma unroll
            for (int kh = 0; kh < 2; ++kh) {
#pragma unroll
                for (int u = 0; u < 4; ++u) { const int ks = 4 * kh + u; LAS bf16* vb = st + vtl + ((ks >> 1) & 1) * 2048 + (ks & 1) * 128;
#pragma unroll
                    for (int e = 0; e < 8; ++e) { vb[e * 8] = (bf16)vf0[ks][e]; vb[1024 + e * 8] = (bf16)vf1[ks][e]; } }
                stage_out8k(stg, vt + kh * 4096, lane);
            } }
        WAVE_SYNC();
#pragma unroll 1
        for (int hh = 0; hh < 2; ++hh) { const int h = 2 * hq + hh; const size_t uh = ((size_t)(b * 32 + h)) * NCH + c;
            float* af = AF + uh * 4096 + half * 256 + m;
            LAS bf16* pg = st + ktl;
            const float gcj0 = lg[hh * 64 + m], gcj1 = lg[hh * 64 + 32 + m];
#pragma unroll
            for (int r = 0; r < 16; ++r) { const int ir = crow32(r, half), rc = (r & 3) + 8 * (r >> 2);
                const float gi0 = lg[hh * 64 + ir], gi1 = lg[hh * 64 + 32 + ir], bi0 = lg[128 + hh * 64 + ir], bi1 = lg[128 + hh * 64 + 32 + ir];
                { const int i = ir, j = m; const float dec = __expf(fminf(gi0 - gcj0, 0.f)); af[rc * 64] = (j < i) ? bi0 * dec * kk00[r] : 0.f; pg[rc * 8] = f2bf((j <= i) ? dec * qk00[r] : 0.f); }
                { const int i = 32 + ir, j = m; const float dec = __expf(fminf(gi1 - gcj0, 0.f)); af[2048 + rc * 64] = bi1 * dec * kk10[r]; pg[2048 + rc * 8] = f2bf(dec * qk10[r]); }
                { const int i = 32 + ir, j = 32 + m; const float dec = __expf(fminf(gi1 - gcj1, 0.f)); af[2048 + 32 + rc * 64] = (j < i) ? bi1 * dec * kk11[r] : 0.f; pg[2048 + 1024 + rc * 8] = f2bf((j <= i) ? dec * qk11[r] : 0.f); }
            }
            stage_out8k(stg, PG + uh * 4096, lane); }
        WAVE_SYNC();
    }
}
__device__ __forceinline__ void delta_d2_unit(unsigned char* ws, LAS unsigned char* lds, int uh, int wave, int lane) {
    asm volatile("" : "+v"(lane));
    const float* AF = (const float*)(ws + WS_DAF); const float* GC = (const float*)(ws + WS_DGC); const float* BT = (const float*)(ws + WS_DBT);
    bf16* TG = (bf16*)(ws + WS_DTG); bf16* TB = (bf16*)(ws + WS_DTB);
    {
        const float* af = AF + (size_t)uh * 4096;
        const float bc = BT[(size_t)uh * 64 + lane], gmc = __expf(GC[(size_t)uh * 64 + lane]);
        float T[64];
        const bool pad0 = (uh % NCH) == 0;
#pragma unroll
        for (int i0 = 0; i0 < 64; i0 += 16) {
            float ar[16];
#pragma unroll
            for (int u = 0; u < 16; ++u) ar[u] = af[(i0 + u) * 64 + lane];
            if (pad0 && i0 < 32) {
#pragma unroll
                for (int u = 0; u < 16; ++u) T[i0 + u] = (lane == i0 + u) ? 1.f : 0.f;
            } else {
#pragma unroll
                for (int u = 0; u < 16; ++u) { const int i = i0 + u; float pa[4] = {(lane == i) ? 1.f : 0.f, 0.f, 0.f, 0.f};
#pragma unroll
                    for (int j = 0; j < i; ++j) pa[j & 3] -= __int_as_float(__builtin_amdgcn_readlane(__float_as_int(ar[u]), j)) * T[j];
                    T[i] = (pa[0] + pa[1]) + (pa[2] + pa[3]); }
            }
        }
        bf16* tg = TG + (size_t)uh * 4096; bf16* tb = TB + (size_t)uh * 4096;
        const float sg = bc * gmc;
        const int cs = (lane & ~31) + sw23(lane & 31);
        const int lcol = (cs >> 4) * 512 + ((cs >> 3) & 1) * 256 + (cs & 7);
        LAS unsigned char* stg = lds + wave * 16384 + 2048; LAS bf16* st = (LAS bf16*)stg;
#pragma unroll
        for (int i = 0; i < 64; ++i) st[(i >> 5) * 2048 + (i & 31) * 8 + lcol] = f2bf(T[i] * sg);
        stage_out8k(stg, tg, lane);
#pragma unroll
        for (int i = 0; i < 64; ++i) st[(i >> 5) * 2048 + (i & 31) * 8 + lcol] = f2bf(T[i] * bc);
        stage_out8k(stg, tb, lane);
    }
}
__device__ __forceinline__ void delta_d3_unit(unsigned char* ws, int uh, int lane) {
    asm volatile("" : "+v"(lane));
    const bf16* TG = (const bf16*)(ws + WS_DTG); const bf16* TB = (const bf16*)(ws + WS_DTB); const bf16* KT = (const bf16*)(ws + WS_DKT); const bf16* VT = (const bf16*)(ws + WS_DVT);
    bf16* WG = (bf16*)(ws + WS_DWG); bf16* UG = (bf16*)(ws + WS_DUG);
    const int m = lane & 31, half = lane >> 5;
    const int c = uh % NCH, bh = uh / NCH, h = bh & 31, b = bh >> 5;
    const size_t uq = ((size_t)(b * 16 + (h >> 1))) * NCH + c;
    {
        const bf16* Tm = TG + (size_t)uh * 4096; const bf16* Kf = KT + uq * 8192;
        f32x16 acc[4][2];
#pragma unroll
        for (int dn = 0; dn < 4; ++dn)
#pragma unroll
            for (int ti = 0; ti < 2; ++ti)
#pragma unroll
                for (int i = 0; i < 16; ++i) acc[dn][ti][i] = 0.f;
#pragma unroll
        for (int ks = 0; ks < 4; ++ks) {
            bf16x8 a[4], bb[2];
#pragma unroll
            for (int dn = 0; dn < 4; ++dn) a[dn] = *(const bf16x8*)(Kf + ((size_t)(((dn * 2 + (ks >> 1)) * 2 + (ks & 1)) * 64 + lane)) * 8);
#pragma unroll
            for (int ti = 0; ti < 2; ++ti) bb[ti] = *(const bf16x8*)(Tm + ((size_t)((ti * 4 + ks) * 64 + lane)) * 8);
#pragma unroll
            for (int dn = 0; dn < 4; ++dn)
#pragma unroll
                for (int ti = 0; ti < 2; ++ti) acc[dn][ti] = MFMA32(a[dn], bb[ti], acc[dn][ti]);
        }
        bf16* wg = WG + (size_t)uh * 8192;
#pragma unroll
        for (int dn = 0; dn < 4; ++dn)
#pragma unroll
            for (int ti = 0; ti < 2; ++ti)
#pragma unroll
                for (int s2 = 0; s2 < 2; ++s2) *(v4u*)(wg + ((size_t)(((ti * 4 + dn) * 2 + s2) * 64 + lane)) * 8) = pack_frag(acc[dn][ti], s2);
    }
    {
        const bf16* Tm = TB + (size_t)uh * 4096; const bf16* Bt = VT + (size_t)uh * 8192;
        f32x16 acc[2][4];
#pragma unroll
        for (int ti = 0; ti < 2; ++ti)
#pragma unroll
            for (int dn = 0; dn < 4; ++dn)
#pragma unroll
                for (int i = 0; i < 16; ++i) acc[ti][dn][i] = 0.f;
#pragma unroll
        for (int ks = 0; ks < 4; ++ks) {
            bf16x8 a[2], bb[4];
#pragma unroll
            for (int ti = 0; ti < 2; ++ti) a[ti] = *(const bf16x8*)(Tm + ((size_t)((ti * 4 + ks) * 64 + lane)) * 8);
#pragma unroll
            for (int dn = 0; dn < 4; ++dn) bb[dn] = *(const bf16x8*)(Bt + ((size_t)((dn * 4 + ks) * 64 + lane)) * 8);
#pragma unroll
            for (int ti = 0; ti < 2; ++ti)
#pragma unroll
                for (int dn = 0; dn < 4; ++dn) acc[ti][dn] = MFMA32(a[ti], bb[dn], acc[ti][dn]);
        }
        bf16* ug = UG + (size_t)uh * 8192;
#pragma unroll
        for (int ti = 0; ti < 2; ++ti)
#pragma unroll
            for (int dn = 0; dn < 4; ++dn) { bf16* p = ug + ((size_t)((ti * 4 + dn) * 64 + lane)) * 16; *(v4u*)p = pack_frag(acc[ti][dn], 0); *(v4u*)(p + 8) = pack_frag(acc[ti][dn], 1); }
    }
}
__device__ __forceinline__ void delta_d23_unit(unsigned char* ws, LAS unsigned char* lds, int uh, int wave, int lane) {
    asm volatile("" : "+v"(lane));
    const float* AF = (const float*)(ws + WS_DAF); const float* GC = (const float*)(ws + WS_DGC); const float* BT = (const float*)(ws + WS_DBT);
    const bf16* KT = (const bf16*)(ws + WS_DKT); const bf16* VT = (const bf16*)(ws + WS_DVT);
    bf16* WG = (bf16*)(ws + WS_DWG); bf16* UG = (bf16*)(ws + WS_DUG);
    const float* af = AF + (size_t)uh * 4096;
    const float bc = BT[(size_t)uh * 64 + lane], gmc = __expf(GC[(size_t)uh * 64 + lane]);
    const int c = uh % NCH, bh = uh / NCH, h = bh & 31, b = bh >> 5;
    const size_t uq = ((size_t)(b * 16 + (h >> 1))) * NCH + c;
    float T[64];
    const bool pad0 = c == 0;
    float ar[16], an[16];
#pragma unroll
    for (int u = 0; u < 16; ++u) ar[u] = af[u * 64 + lane];
#pragma unroll
    for (int i0 = 0; i0 < 64; i0 += 16) {
        if (i0 + 16 < 64) {
#pragma unroll
            for (int u = 0; u < 16; ++u) an[u] = af[(i0 + 16 + u) * 64 + lane];
        }
        if (pad0 && i0 < 32) {
#pragma unroll
            for (int u = 0; u < 16; ++u) T[i0 + u] = (lane == i0 + u) ? 1.f : 0.f;
        } else {
#pragma unroll
            for (int u = 0; u < 16; ++u) { const int i = i0 + u; float pa[4] = {(lane == i) ? 1.f : 0.f, 0.f, 0.f, 0.f};
#pragma unroll
                for (int j = 0; j < i; ++j) pa[j & 3] -= __int_as_float(__builtin_amdgcn_readlane(__float_as_int(ar[u]), j)) * T[j];
                T[i] = (pa[0] + pa[1]) + (pa[2] + pa[3]); }
        }
#pragma unroll
        for (int u = 0; u < 16; ++u) ar[u] = an[u];
    }
    const bf16* Kf = KT + uq * 8192;
    bf16x8 ka[4][4];
    asm volatile("" ::: "memory");
#pragma unroll
    for (int ks = 0; ks < 4; ++ks)
#pragma unroll
        for (int dn = 0; dn < 2; ++dn) ka[ks][dn] = *(const bf16x8*)(Kf + ((size_t)(((dn * 2 + (ks >> 1)) * 2 + (ks & 1)) * 64 + lane)) * 8);
    const float sg = bc * gmc;
    const int cs = (lane & ~31) + sw23(lane & 31);
    const int lcol = (cs >> 4) * 512 + ((cs >> 3) & 1) * 256 + (cs & 7);
    LAS unsigned char* stg = lds + wave * 16384 + 2048; LAS bf16* st = (LAS bf16*)stg;
    bf16x8 tf[2][4];
    WAVE_SYNC();
#pragma unroll
    for (int i = 0; i < 64; ++i) st[(i >> 5) * 2048 + (i & 31) * 8 + lcol] = f2bf(T[i] * sg);
    WAVE_SYNC();
#pragma unroll
    for (int ti = 0; ti < 2; ++ti)
#pragma unroll
        for (int ks = 0; ks < 4; ++ks) tf[ti][ks] = *(const LAS bf16x8*)(st + ((ti * 4 + ks) * 64 + lane) * 8);
    WAVE_SYNC();
#pragma unroll
    for (int i = 0; i < 64; ++i) st[(i >> 5) * 2048 + (i & 31) * 8 + lcol] = f2bf(T[i] * bc);
    WAVE_SYNC();
    const bf16* Bt = VT + (size_t)uh * 8192;
    bf16x8 vb[4][4];
#pragma unroll
    for (int ks = 0; ks < 4; ++ks)
#pragma unroll
        for (int dn = 2; dn < 4; ++dn) ka[ks][dn] = *(const bf16x8*)(Kf + ((size_t)(((dn * 2 + (ks >> 1)) * 2 + (ks & 1)) * 64 + lane)) * 8);
    asm volatile("" ::: "memory");
    {
        bf16* wg = WG + (size_t)uh * 8192;
#pragma unroll
        for (int dp = 0; dp < 2; ++dp) {
            f32x16 acc[2][2];
#pragma unroll
            for (int d2 = 0; d2 < 2; ++d2)
#pragma unroll
                for (int ti = 0; ti < 2; ++ti)
#pragma unroll
                    for (int i = 0; i < 16; ++i) acc[d2][ti][i] = 0.f;
#pragma unroll
            for (int ks = 0; ks < 4; ++ks)
#pragma unroll
                for (int d2 = 0; d2 < 2; ++d2)
#pragma unroll
                    for (int ti = 0; ti < 2; ++ti) acc[d2][ti] = MFMA32(ka[ks][2 * dp + d2], tf[ti][ks], acc[d2][ti]);
#pragma unroll
            for (int d2 = 0; d2 < 2; ++d2)
#pragma unroll
                for (int ti = 0; ti < 2; ++ti)
#pragma unroll
                    for (int s2 = 0; s2 < 2; ++s2) *(v4u*)(wg + ((size_t)(((ti * 4 + 2 * dp + d2) * 2 + s2) * 64 + lane)) * 8) = pack_frag(acc[d2][ti], s2);
            if (dp == 0) {
                asm volatile("" ::: "memory");
#pragma unroll
                for (int ks = 0; ks < 2; ++ks)
#pragma unroll
                    for (int dn = 0; dn < 4; ++dn) vb[ks][dn] = *(const bf16x8*)(Bt + ((size_t)((dn * 4 + ks) * 64 + lane)) * 8);
                asm volatile("" ::: "memory");
            }
        }
    }
    asm volatile("" ::: "memory");
#pragma unroll
    for (int ks = 2; ks < 4; ++ks)
#pragma unroll
        for (int dn = 0; dn < 4; ++dn) vb[ks][dn] = *(const bf16x8*)(Bt + ((size_t)((dn * 4 + ks) * 64 + lane)) * 8);
#pragma unroll
    for (int ti = 0; ti < 2; ++ti)
#pragma unroll
        for (int ks = 0; ks < 4; ++ks) tf[ti][ks] = *(const LAS bf16x8*)(st + ((ti * 4 + ks) * 64 + lane) * 8);
    {
        bf16* ug = UG + (size_t)uh * 8192;
#pragma unroll
        for (int ti = 0; ti < 2; ++ti) {
            f32x16 acc[4];
#pragma unroll
            for (int dn = 0; dn < 4; ++dn)
#pragma unroll
                for (int i = 0; i < 16; ++i) acc[dn][i] = 0.f;
#pragma unroll
            for (int ks = 0; ks < 4; ++ks)
#pragma unroll
                for (int dn = 0; dn < 4; ++dn) acc[dn] = MFMA32(tf[ti][ks], vb[ks][dn], acc[dn]);
#pragma unroll
            for (int dn = 0; dn < 4; ++dn) { bf16* p = ug + ((size_t)((ti * 4 + dn) * 64 + lane)) * 16; *(v4u*)p = pack_frag(acc[dn], 0); *(v4u*)(p + 8) = pack_frag(acc[dn], 1); }
        }
    }
    WAVE_SYNC();
}
__device__ __forceinline__ void delta_pre(unsigned char* ws, LAS unsigned char* lds, int gw, int NGW, int wave, int lane) {
    const int nextra = (NUQ > NGW && NUQ < 2 * NGW) ? NUQ - NGW : 0;
    for (int rep = 0; rep < 2 || nextra == 0; ++rep) {
        int uq;
        if (nextra == 0) { uq = gw + rep * NGW; if (uq >= NUQ) break; }
        else if (rep == 0) uq = gw;
        else { if ((gw & 63) != 0 || (gw >> 6) >= nextra) break; uq = NGW + (gw >> 6); }
#ifndef NO_D1
        delta_d1_unit(ws, lds, uq, wave, lane);
#endif
#ifdef DUP_D1
        delta_d1_unit(ws, lds, uq, wave, lane);
#endif
        asm volatile("s_waitcnt vmcnt(0)" ::: "memory");
        const int c = uq % NCH, bh = uq / NCH, hq = bh & 15, b = bh >> 4;
#pragma unroll 1
        for (int hh = 0; hh < 2; ++hh) { const int uh = (b * 32 + 2 * hq + hh) * NCH + c;
#ifndef NO_D23FUSE
            delta_d23_unit(ws, lds, uh, wave, lane);
#ifdef DUP_D23
            delta_d23_unit(ws, lds, uh, wave, lane);
#endif
            continue;
#endif
#ifndef NO_D2
            delta_d2_unit(ws, lds, uh, wave, lane);
#endif
#ifdef DUP_D2
            delta_d2_unit(ws, lds, uh, wave, lane);
#endif
            asm volatile("s_waitcnt vmcnt(0)" ::: "memory");
#ifndef NO_D3
            delta_d3_unit(ws, uh, lane);
#endif
#ifdef DUP_D3
            delta_d3_unit(ws, uh, lane);
#endif
        }
    }
}
__device__ __forceinline__ bf16x8 afrag_perm(const bf16* rowp, int blk, int s, int half) {
    const v2u lo = *(const v2u*)(rowp + 32 * blk + 16 * s + 4 * half), hi2 = *(const v2u*)(rowp + 32 * blk + 16 * s + 8 + 4 * half);
    v4u w; w.x = lo.x; w.y = lo.y; w.z = hi2.x; w.w = hi2.y; return __builtin_bit_cast(bf16x8, w);
}
#define LBAR() asm volatile("s_waitcnt lgkmcnt(0)\n\ts_barrier" ::: "memory")
__device__ __forceinline__ void delta_d4(unsigned char* ws, float* out_state, LAS unsigned char* lds, int tid, int wave, int lane) {
    const bf16* QKVC = (const bf16*)(ws + WS_QKVC); const bf16* KT = (const bf16*)(ws + WS_DKT); const bf16* PG = (const bf16*)(ws + WS_DPG);
    const bf16* WG = (const bf16*)(ws + WS_DWG); const bf16* UG = (const bf16*)(ws + WS_DUG); const float* GC = (const float*)(ws + WS_DGC);
    bf16* OF = (bf16*)(ws + WS_SC);
    LAS v4u* Sfr = (LAS v4u*)lds;
    LAS v4u* Dfr = (LAS v4u*)(lds + 16384);
    LAS v4u* Dtf = (LAS v4u*)(lds + 16384 + 4096);
    LAS float* gam = (LAS float*)(lds + 16384 + 8192);
    const int m = lane & 31, half = lane >> 5;
    const bf16x8 zf = {0, 0, 0, 0, 0, 0, 0, 0};
    for (int item = blockIdx.x; item < NBP * 32 * 4; item += gridDim.x) {
        const int xg = item & 7, jj = item >> 3, pair = xg * 4 + (jj >> 3), q = jj & 3, h = 2 * (pair & 15) + ((jj >> 2) & 1), b = pair >> 4;
        const size_t uh0 = ((size_t)(b * 32 + h)) * NCH, uq0 = ((size_t)(b * 16 + (h >> 1))) * NCH;
        const int rt = wave & 1; const bool isq = wave >= 6;
#define ROT3(LOADM, STEPM) do { LOADM(0, 0); LOADM(1, 1); \
            for (int c = 0; c < NCH; c += 3) { \
                if (c + 2 < NCH) LOADM(c + 2, 2); \
                STEPM(c, 0); \
                if (c + 1 < NCH) { if (c + 3 < NCH) LOADM(c + 3, 0); STEPM(c + 1, 1); } \
                if (c + 2 < NCH) { if (c + 4 < NCH) LOADM(c + 4, 1); STEPM(c + 2, 2); } } } while (0)
#define ROT2(LOADM, STEPM) do { LOADM(0, 0); \
            for (int c = 0; c < NCH; c += 2) { \
                if (c + 1 < NCH) LOADM(c + 1, 1); \
                STEPM(c, 0); \
                if (c + 1 < NCH) { if (c + 2 < NCH) LOADM(c + 2, 0); STEPM(c + 1, 1); } } } while (0)
        LBAR();
        if (wave < 4) {
            int ll_ = lane; asm volatile("" : "+v"(ll_)); const int lane = ll_, m = lane & 31, half = lane >> 5; (void)m; (void)half;
            { const v4u z = {0u, 0u, 0u, 0u}; Sfr[(0 * 4 + wave) * 128 + lane] = z; Sfr[(0 * 4 + wave) * 128 + 64 + lane] = z; }
            bf16x8 kf[2][4];
            f32x16 S;
#pragma unroll
            for (int i = 0; i < 16; ++i) S[i] = 0.f;
#define LOAD_K(cc, B) do { const bf16* kr_ = KT + (uq0 + (cc)) * 8192; \
                _Pragma("unroll") for (int blk = 0; blk < 2; ++blk) _Pragma("unroll") for (int s_ = 0; s_ < 2; ++s_) kf[B][blk * 2 + s_] = *(const bf16x8*)(kr_ + ((size_t)(((wave * 2 + blk) * 2 + s_) * 64 + lane)) * 8); } while (0)
#define STEP_K(c, B) do { const int bufc = (c) & 1; LBAR(); LBAR(); \
                const float gl = gam[bufc * 64 + 63]; \
                _Pragma("unroll") for (int i = 0; i < 16; ++i) S[i] *= gl; \
                _Pragma("unroll") for (int blk = 0; blk < 2; ++blk) _Pragma("unroll") for (int s = 0; s < 2; ++s) S = MFMA32(kf[B][blk * 2 + s], __builtin_bit_cast(bf16x8, Dtf[(blk * 2 + s) * 64 + lane]), S); \
                _Pragma("unroll") for (int s = 0; s < 2; ++s) Sfr[((bufc ^ 1) * 4 + wave) * 128 + s * 64 + lane] = pack_frag(S, s); } while (0)
#ifndef NO_RK
            ROT2(LOAD_K, STEP_K);
#endif
            { float* o = out_state + ((size_t)((b * 32 + h) * 128 + 32 * wave)) * 128 + 32 * q + m;
#pragma unroll
              for (int r = 0; r < 16; ++r) o[(size_t)sw23(crow32(r, half)) * 128] = S[r]; }
#undef LOAD_K
#undef STEP_K
        } else if (!isq) {
            int ll_ = lane; asm volatile("" : "+v"(ll_)); const int lane = ll_, m = lane & 31, half = lane >> 5; (void)m; (void)half;
            bf16x8 wf[3][8], uf[3][2]; float gcv[3] = {0.f, 0.f, 0.f};
#define LOAD_W(cc, B) do { const bf16* wb_ = WG + (uh0 + (cc)) * 8192 + ((size_t)(rt * 512 + lane)) * 8; \
                _Pragma("unroll") for (int blk = 0; blk < 4; ++blk) _Pragma("unroll") for (int s_ = 0; s_ < 2; ++s_) wf[B][blk * 2 + s_] = *(const bf16x8*)(wb_ + blk * 1024 + s_ * 512); \
                const bf16* ub_ = UG + (uh0 + (cc)) * 8192 + ((size_t)((rt * 4 + q) * 64 + lane)) * 16; uf[B][0] = *(const bf16x8*)ub_; uf[B][1] = *(const bf16x8*)(ub_ + 8); \
                if (wave == 4) gcv[B] = GC[(uh0 + (cc)) * 64 + lane]; } while (0)
#define STEP_W(c, B) do { const int bufc = (c) & 1; LBAR(); \
                f32x16 acc; \
                _Pragma("unroll") for (int i = 0; i < 16; ++i) acc[i] = 0.f; \
                _Pragma("unroll") for (int blk = 0; blk < 4; ++blk) _Pragma("unroll") for (int s = 0; s < 2; ++s) \
                    acc = MFMA32(wf[B][blk * 2 + s], __builtin_bit_cast(bf16x8, Sfr[(bufc * 4 + blk) * 128 + s * 64 + lane]), acc); \
                { float t8[8]; unpack8(__builtin_bit_cast(v4u, uf[B][0]), t8); \
                    _Pragma("unroll") for (int i = 0; i < 8; ++i) acc[i] = t8[i] - acc[i]; unpack8(__builtin_bit_cast(v4u, uf[B][1]), t8); \
                    _Pragma("unroll") for (int i = 0; i < 8; ++i) acc[8 + i] = t8[i] - acc[8 + i]; } \
                _Pragma("unroll") for (int s = 0; s < 2; ++s) Dfr[(rt * 2 + s) * 64 + lane] = pack_frag(acc, s); \
                _Pragma("unroll") for (int r = 0; r < 16; ++r) acc[r] *= gam[128 + bufc * 64 + 32 * rt + crow32(r, half)]; \
                _Pragma("unroll") for (int s = 0; s < 2; ++s) Dtf[(rt * 2 + s) * 64 + lane] = pack_frag(acc, s); \
                LBAR(); \
                if (wave == 4 && (c) + 1 < NCH) { const float gn_ = gcv[((B) + 1) % 3], gl_ = __shfl(gn_, 63); gam[(bufc ^ 1) * 64 + lane] = __expf(gn_); gam[128 + (bufc ^ 1) * 64 + lane] = __expf(gl_ - gn_); } } while (0)
            if (wave == 4) { const float gc = GC[(uh0 + 0) * 64 + lane], gl = __shfl(gc, 63); gam[lane] = __expf(gc); gam[128 + lane] = __expf(gl - gc); }
#ifndef NO_RW
            ROT3(LOAD_W, STEP_W);
#endif
#undef LOAD_W
#undef STEP_W
        } else {
            int ll_ = lane; asm volatile("" : "+v"(ll_)); const int lane = ll_, m = lane & 31, half = lane >> 5; (void)m; (void)half;
            bf16x8 qf[1][8], pf[1][4];
#define LOAD_Q(cc, B) do { const int row_ = chunk_row(b, (cc), 32 * rt + m); const bool ok_ = row_ >= 0; \
                const bf16* qb_ = QKVC + (size_t)(row_ < 0 ? 0 : row_) * CDIM + (h >> 1) * 128 + 8 * half; \
                _Pragma("unroll") for (int blk = 0; blk < 4; ++blk) _Pragma("unroll") for (int s_ = 0; s_ < 2; ++s_) qf[B][blk * 2 + s_] = sel8(ok_, *(const bf16x8*)(qb_ + blk * 32 + s_ * 16)); \
                } while (0)
#define LOAD_P(cc, PB) do { const bf16* pb_ = PG + (uh0 + (cc)) * 4096 + ((size_t)(rt * 256 + lane)) * 8; \
                _Pragma("unroll") for (int blk = 0; blk < 2; ++blk) _Pragma("unroll") for (int s_ = 0; s_ < 2; ++s_) pf[PB][blk * 2 + s_] = sel8(blk <= rt, *(const bf16x8*)(pb_ + blk * 1024 + s_ * 512)); } while (0)
#define STEP_Q(c) do { const int bufc = (c) & 1; LBAR(); \
                LOAD_P((c), 0);                                                    \
                f32x16 acc; \
                _Pragma("unroll") for (int i = 0; i < 16; ++i) acc[i] = 0.f; \
                _Pragma("unroll") for (int blk = 0; blk < 4; ++blk) _Pragma("unroll") for (int s = 0; s < 2; ++s) \
                    acc = MFMA32(qf[0][blk * 2 + s], __builtin_bit_cast(bf16x8, Sfr[(bufc * 4 + blk) * 128 + s * 64 + lane]), acc); \
                if ((c) + 1 < NCH) LOAD_Q((c) + 1, 0);                             \
                LBAR(); \
                _Pragma("unroll") for (int r = 0; r < 16; ++r) acc[r] *= gam[bufc * 64 + 32 * rt + crow32(r, half)]; \
                _Pragma("unroll") for (int blk = 0; blk < 2; ++blk) _Pragma("unroll") for (int s = 0; s < 2; ++s) acc = MFMA32(pf[0][blk * 2 + s], __builtin_bit_cast(bf16x8, Dfr[(blk * 2 + s) * 64 + lane]), acc); \
                _Pragma("unroll") for (int r = 0; r < 16; ++r) { const int row = chunk_row(b, (c), 32 * rt + crow32(r, half)); if (row >= 0) OF[(size_t)row * DVW + h * 128 + 32 * q + m] = f2bf(acc[r]); } } while (0)
#ifndef NO_RQ
            LOAD_Q(0, 0);
            for (int c = 0; c < NCH; ++c) STEP_Q(c);
#endif
#undef LOAD_Q
#undef LOAD_P
#undef STEP_Q
        }
#undef ROT2
#undef ROT3
    }
    LBAR();
}
#undef LBAR
#undef MFMA32
template <int RT, int CT, int UNR = 4, class Epi>
__device__ __forceinline__ void small_gemm_unit(const bf16* A, int lda, const bf16* Bt, int ldb, int k0, int klen, LAS unsigned char* lds, const Epi& E, int tid, int wave, int lane) {
    const int r16 = lane & 15, q = lane >> 4;
    const int kw = klen >> 3;
    const bf16* ap = A + (size_t)r16 * lda + k0 + wave * kw + 8 * q;
    const bf16* bp = Bt + (size_t)r16 * ldb + k0 + wave * kw + 8 * q;
    pg8::f32x4 acc[RT][CT];
#pragma unroll
    for (int i = 0; i < RT; ++i)
#pragma unroll
        for (int j = 0; j < CT; ++j) acc[i][j] = (pg8::f32x4){0.f, 0.f, 0.f, 0.f};
#pragma unroll UNR
    for (int ks = 0; ks < kw; ks += 32) {
        bf16x8 a[RT], b[CT];
#pragma unroll
        for (int i = 0; i < RT; ++i) a[i] = *(const bf16x8*)(ap + (size_t)(16 * i) * lda + ks);
#pragma unroll
        for (int j = 0; j < CT; ++j) b[j] = *(const bf16x8*)(bp + (size_t)(16 * j) * ldb + ks);
#pragma unroll
        for (int i = 0; i < RT; ++i)
#pragma unroll
            for (int j = 0; j < CT; ++j) acc[i][j] = __builtin_amdgcn_mfma_f32_16x16x32_bf16(a[i], b[j], acc[i][j], 0, 0, 0);
    }
    constexpr int NOUT = 256 * RT * CT;
    LAS float* part = (LAS float*)lds + wave * NOUT;
#pragma unroll
    for (int i = 0; i < RT; ++i)
#pragma unroll
        for (int j = 0; j < CT; ++j)
#pragma unroll
            for (int e = 0; e < 4; ++e) part[(16 * i + 4 * q + e) * (16 * CT) + 16 * j + r16] = acc[i][j][e];
    __syncthreads();
    for (int o = tid; o < NOUT; o += NTHREADS) { float sum = 0.f;
#pragma unroll
        for (int w = 0; w < 8; ++w) sum += ((LAS float*)lds)[w * NOUT + o];
        E(o / (16 * CT), o % (16 * CT), sum); }
    __syncthreads();
}
template <int ACT> struct SEpiRowsBf16 { bf16* O; int ldc; __device__ __forceinline__ void operator()(int row, int col, float v) const { if (ACT == 2) { v = v > 0.f ? v : 0.f; v = v * v; } O[(size_t)row * ldc + col] = f2bf(v); } };
struct SEpiF32 { float* O; int ldc; __device__ __forceinline__ void operator()(int row, int col, float v) const { O[(size_t)row * ldc + col] = v; } };
struct SEpiColsBf16 { bf16* O; int ldc; __device__ __forceinline__ void operator()(int row, int col, float v) const { O[(size_t)col * ldc + row] = f2bf(v); } };
template <int ACT> __device__ __forceinline__ void skinny_rows_bf16(const bf16* A, const bf16* Wt, int K, int nunits, bf16* O, int ldc, LAS unsigned char* lds, int tid, int wave, int lane) {
    for (int u = blockIdx.x; u < 2 * nunits; u += gridDim.x) { SEpiRowsBf16<ACT> E{O + (size_t)XROW0 * ldc + u * 32, ldc};
        small_gemm_unit<3, 2, 8>(A + (size_t)XROW0 * K, K, Wt + (size_t)u * 32 * K, K, 0, K, lds, E, tid, wave, lane); }
}
__device__ __forceinline__ void skinny_rows_part(const bf16* A, const bf16* Wt, int K, float* ZP, LAS unsigned char* lds, int tid, int wave, int lane) {
    for (int u = blockIdx.x; u < 256; u += gridDim.x) { const int cgp = u & 31, ksl = u >> 5; SEpiF32 E{ZP + (size_t)ksl * XR * DM + cgp * 64, DM};
        small_gemm_unit<3, 4>(A + (size_t)XROW0 * K, K, Wt + (size_t)cgp * 64 * K, K, ksl * (K >> 3), K >> 3, lds, E, tid, wave, lane); }
}
template <int RT> __device__ __forceinline__ void tail_cols_bf16(const bf16* A, const bf16* Wt, int K, int c0, bf16* O, int ldc, LAS unsigned char* lds, int tid, int wave, int lane) {
    for (int u = blockIdx.x; u < MAINM / 32; u += gridDim.x) { SEpiColsBf16 E{O + (size_t)u * 32 * ldc + c0, ldc};
        small_gemm_unit<RT, 2>(Wt + (size_t)c0 * K, K, A + (size_t)u * 32 * K, K, 0, K, lds, E, tid, wave, lane); }
}

typedef __attribute__((address_space(4))) const unsigned long long* kargq_t;
#define KPF_(k) ((const float*)(const GAS float*)(q_[k]))
__device__ __forceinline__ void load_ptrs(Ptrs& P) {
    kargq_t q_ = (kargq_t)__builtin_amdgcn_kernarg_segment_ptr();
    asm volatile("" : "+s"(q_));
    P.x_prompt = KPF_(0); P.x_sample = KPF_(1); P.state_conv_a = KPF_(2); P.cache_k = KPF_(3);
    P.cache_v = KPF_(4); P.cache_ik = KPF_(5); P.state_conv_c = KPF_(6); P.state_delta = KPF_(7);
    P.page_table = ((const int*)(const GAS int*)(q_[8])); P.meta = KPF_(9); P.w_in_a = KPF_(10); P.conv_w_a = KPF_(11);
    P.w_out_a = KPF_(12); P.w_in_b = KPF_(13); P.w_out_b = KPF_(14); P.w_in_c = KPF_(15);
    P.conv_w_c = KPF_(16); P.a_log = KPF_(17); P.dt_bias = KPF_(18); P.norm_w = KPF_(19);
    P.w_out_c = KPF_(20); P.ln1_g = KPF_(21); P.ln1_b = KPF_(22); P.w1 = KPF_(23);
    P.w2 = KPF_(24); P.ln2_g = KPF_(25); P.ln2_b = KPF_(26);
    P.out = (float*)(GAS float*)(q_[27]); P.ws = (unsigned char*)(GAS unsigned char*)(q_[28]);
}
struct Args { const void* in[27]; float* out; unsigned char* ws; int ph_lo, ph_hi; };
constexpr int PH_PER_LAYER = 12, PH_END = 1 + 4 * PH_PER_LAYER;

__global__ void __launch_bounds__(NTHREADS, 2) mega_fwd(Args args) {
    extern __shared__ __attribute__((aligned(16))) unsigned char lds_raw[];
    LAS unsigned char* lds = (LAS unsigned char*)lds_raw;
    const int tid = threadIdx.x, lane = tid & 63, wave = __builtin_amdgcn_readfirstlane(tid >> 6);
    const int G_ = gridDim.x, NGW = G_ * NWAVES, NT = G_ * NTHREADS; (void)lane;
    unsigned char* ws = args.ws;
    const int lo = args.ph_lo, hi = args.ph_hi;
    const bool fused = (hi - lo) > 1;

    for (int u = tid; u < (LDS_BYTES - LDSCTL_OFF) / 4; u += NTHREADS) ((LAS unsigned*)(lds + LDSCTL_OFF))[u] = 0u;
    __syncthreads();
    volatile LAS unsigned* MISC = (volatile LAS unsigned*)(lds + MISC_OFF);
    XcdBarrier bar; bar.bar = (unsigned*)(ws + WS_CTL) + CW_BAR; bar.x = 0; bar.st = nullptr;
    if (fused) bar = xcd_barrier_post((unsigned*)(ws + WS_CTL) + CW_BAR, MISC + 8);
    bar.wv = wave;

#ifndef MK_SITES
#define MK_SITES 0xffffffffu
#endif
#define SITE(n) (((MK_SITES) >> (n)) & 1u)
#define IN(k) (lo <= (k) && (k) < hi)
#ifndef MK_DUP
#define MK_DUP 0u
#endif
#define NREP(n) ((((MK_DUP) >> (n)) & 1u) ? 2 : 1)
#ifdef MK_SKINNY2
#define SKREP 2
#else
#define SKREP 1
#endif
#define BEGIN_SITE(n, id) if (SITE(n) && IN(id)) { for (int rp_ = 0; rp_ < NREP(n); ++rp_) { Ptrs P; load_ptrs(P); unsigned char* ws = P.ws; (void)ws; \
    bf16* X = (bf16*)(P.ws + WS_X); float* Z = (float*)(P.ws + WS_Z); float* ZP = (float*)(P.ws + WS_ZP); bf16* Y = (bf16*)(P.ws + WS_Y); bf16* BIG = (bf16*)(P.ws + WS_BIG); (void)X; (void)Z; (void)ZP; (void)Y; (void)BIG;
#define END_SITE(id) SEAM(id); } }
#define LOCALS int tid_ = threadIdx.x; asm volatile("" : "+v"(tid_)); const int lane_ = tid_ & 63, wave_ = __builtin_amdgcn_readfirstlane(tid_ >> 6), gw_ = blockIdx.x * NWAVES + wave_, gtid_ = blockIdx.x * NTHREADS + tid_; (void)lane_; (void)wave_; (void)gw_; (void)gtid_
#define SEAM(k) do { if (fused && (k) + 1 < PH_END) xcd_barrier(bar); else __syncthreads(); } while (0)


    BEGIN_SITE(0, 0) LOCALS; p0_prologue(P, lds, gw_, NGW, wave_, lane_); END_SITE(0)
#ifdef MK_XBAR
    if (fused) { for (int xb_ = 0; xb_ < MK_XBAR; ++xb_) xcd_barrier(bar); }
#endif

    for (int layer = 0; layer < 4; ++layer) {
        const int kind = layer % 3, j = layer / 3, base = 1 + layer * PH_PER_LAYER;
        if (kind == 0) {
            BEGIN_SITE(1, base + 0)
                const bf16* Wt = (const bf16*)(ws + WS_WA_IN + (size_t)j * WSZ_A_IN); pg8::Gemm g{X, Wt, MAINM, NA_IN, DM}; pg8::StaticOrder S; S.init(MAINM, NA_IN, G_, (int)blockIdx.x);
                pg8::EpiBf16<0> E{BIG, NA_IN, nullptr, 0, 0, 1.f};
                pg8::gemm_phase<pg8::EpiBf16<0>, pg8::StaticOrder, true, true>(lds, g, S, E, wave);
                { LOCALS; for (int sk_ = 0; sk_ < SKREP; ++sk_) { skinny_rows_bf16<0>(X, Wt, DM, NA_IN / 64, BIG, NA_IN, lds, tid_, wave_, lane_); } }
                END_SITE(base + 0)
            BEGIN_SITE(2, base + 1)
                LOCALS; convA_phase(BIG, Y, P.conv_w_a + (size_t)j * 3 * DM, P.state_conv_a + (size_t)j * SBN * 2 * DM, P.out + O_CAP + (size_t)j * NBP * 2 * DM, P.out + O_CAS + (size_t)j * SBN * 2 * DM, gtid_, NT);
                END_SITE(base + 1)
            BEGIN_SITE(3, base + 2)
                const bf16* Wt = (const bf16*)(ws + WS_WA_OUT + (size_t)j * WSZ_A_OUT); pg8::Gemm g{Y, Wt, MAINM, DM, DM}; pg8::StaticOrder S; S.init(MAINM, DM, G_, (int)blockIdx.x);
                pg8::EpiResBf16 E{X, DM, ALPHA};
                pg8::gemm_phase<pg8::EpiResBf16, pg8::StaticOrder, true, true>(lds, g, S, E, wave);
                { LOCALS; for (int sk_ = 0; sk_ < SKREP; ++sk_) { skinny_rows_part(Y, Wt, DM, ZP, lds, tid_, wave_, lane_); } }
                END_SITE(base + 2)
        } else if (kind == 1) {
            BEGIN_SITE(4, base + 0)
                const bf16* Wt = (const bf16*)(ws + WS_WB_IN); pg8::Gemm g{X, Wt, MAINM, 4096, DM}; pg8::StaticOrder S; S.init(MAINM, 4096, G_, (int)blockIdx.x);
                pg8::EpiBf16<0> E{BIG, NB_PAD, nullptr, 0, 0, 1.f};
                pg8::gemm_phase<pg8::EpiBf16<0>, pg8::StaticOrder, true, true>(lds, g, S, E, wave);
                { LOCALS; for (int sk_ = 0; sk_ < SKREP; ++sk_) { tail_cols_bf16<5>(X, Wt, DM, 4096, BIG, NB_PAD, lds, tid_, wave_, lane_); skinny_rows_bf16<0>(X, Wt, DM, 4224 / 64, BIG, NB_PAD, lds, tid_, wave_, lane_); } }
                END_SITE(base + 0)
            BEGIN_SITE(5, base + 1) LOCALS; rope_phase(BIG, P, gw_, NGW, lane_); END_SITE(base + 1)
            BEGIN_SITE(6, base + 2) LOCALS; indexer_sample(P, lds, tid_); indexer_prompt(P, lds, tid_, wave_, lane_); END_SITE(base + 2)
            BEGIN_SITE(7, base + 3) LOCALS; select_phase(P, lds, gw_, NGW, tid_, wave_, lane_); END_SITE(base + 3)
#ifdef ATTN_PROBE
            if (IN(base + 4)) { Ptrs P; load_ptrs(P); bf16* Y = (bf16*)(P.ws + WS_Y); LOCALS; dense_attn_phase<ATTN_PROBE>(P, Y, (char*)lds_raw, wave_); __syncthreads(); }
#endif
            BEGIN_SITE(8, base + 4) LOCALS; dense_attn_phase(P, Y, (char*)lds_raw, wave_); attn_phase(P, Y, lds, tid_, wave_, lane_); END_SITE(base + 4)
            BEGIN_SITE(9, base + 5)
                const bf16* Wt = (const bf16*)(ws + WS_WB_OUT); pg8::Gemm g{Y, Wt, MAINM, DM, DM}; pg8::StaticOrder S; S.init(MAINM, DM, G_, (int)blockIdx.x);
                pg8::EpiResBf16 E{X, DM, ALPHA};
                pg8::gemm_phase<pg8::EpiResBf16, pg8::StaticOrder, true, true>(lds, g, S, E, wave);
                { LOCALS; for (int sk_ = 0; sk_ < SKREP; ++sk_) { skinny_rows_part(Y, Wt, DM, ZP, lds, tid_, wave_, lane_); } }
                END_SITE(base + 5)
        } else {
            BEGIN_SITE(10, base + 0)
                const bf16* Wt = (const bf16*)(ws + WS_WC_IN); pg8::Gemm g{X, Wt, MAINM, 12288, DM}; pg8::StaticOrder S; S.init(MAINM, 12288, G_, (int)blockIdx.x);
                pg8::EpiBf16<0> E{BIG, NC_PAD, nullptr, 0, 0, 1.f};
                pg8::gemm_phase<pg8::EpiBf16<0>, pg8::StaticOrder, true, true>(lds, g, S, E, wave);
                { LOCALS; for (int sk_ = 0; sk_ < SKREP; ++sk_) { tail_cols_bf16<4>(X, Wt, DM, 12288, BIG, NC_PAD, lds, tid_, wave_, lane_); skinny_rows_bf16<0>(X, Wt, DM, NC_IN / 64, BIG, NC_PAD, lds, tid_, wave_, lane_); } }
                END_SITE(base + 0)
            BEGIN_SITE(11, base + 1) LOCALS; convC_phase(BIG, P, gw_, NGW, lane_); END_SITE(base + 1)
            BEGIN_SITE(19, base + 2) LOCALS;
#pragma unroll 1
                for (int half_ = 0; half_ < 2; ++half_) {
                    if ((half_ == 0) == ((wave_ & 1) == 0)) delta_pre(P.ws, lds, gw_, NGW, wave_, lane_);
                    else { const int nbusy = (NUQ > NGW && NUQ < 2 * NGW) ? NUQ - NGW : 0;
                      const bool busy = nbusy > 0 && (gw_ & 63) == 0 && (gw_ >> 6) < nbusy; const int below = nbusy == 0 ? 0 : (((gw_ + 63) >> 6) < nbusy ? ((gw_ + 63) >> 6) : nbusy);
                      if (!busy) { delta_phase(P, gw_ - below, NGW - nbusy, lane_); deferred_transposes(P, lds, gw_ - below, NGW - nbusy, wave_, lane_); } }
                }
            END_SITE(base + 2)
            BEGIN_SITE(22, base + 5) LOCALS; delta_d4(P.ws, P.out + O_DP, lds, tid_, wave_, lane_); END_SITE(base + 5)
            BEGIN_SITE(13, base + 6) LOCALS; normC_phase(BIG, Y, P, gw_, NGW, lane_); END_SITE(base + 6)
            BEGIN_SITE(14, base + 7)
                const bf16* Wt = (const bf16*)(ws + WS_WC_OUT); pg8::Gemm g{Y, Wt, MAINM, DM, DVW}; pg8::StaticOrder S; S.init(MAINM, DM, G_, (int)blockIdx.x);
                pg8::EpiResBf16 E{X, DM, ALPHA};
                pg8::gemm_phase<pg8::EpiResBf16, pg8::StaticOrder, true, true>(lds, g, S, E, wave);
                { LOCALS; for (int sk_ = 0; sk_ < SKREP; ++sk_) { skinny_rows_part(Y, Wt, DVW, ZP, lds, tid_, wave_, lane_); } }
                END_SITE(base + 7)
        }
        BEGIN_SITE(15, base + 8) LOCALS; ln_phase(Z, ZP, X, rp_ == 0 ? X : (bf16*)(P.ws + WS_QR), P.ln1_g + (size_t)layer * DM, P.ln1_b + (size_t)layer * DM, nullptr, nullptr, lds, gw_, NGW, tid_, wave_, lane_); END_SITE(base + 8)
        BEGIN_SITE(16, base + 9)
            const bf16* Wt = (const bf16*)(ws + WS_W1 + (size_t)layer * WSZ_W1); pg8::Gemm g{X, Wt, MAINM, FF, DM}; pg8::StaticOrder S; S.init(MAINM, FF, G_, (int)blockIdx.x);
            pg8::EpiBf16<2> E{BIG, FF, nullptr, 0, 0, 1.f};
            pg8::gemm_phase<pg8::EpiBf16<2>, pg8::StaticOrder, true, true>(lds, g, S, E, wave);
            { LOCALS; for (int sk_ = 0; sk_ < SKREP; ++sk_) { skinny_rows_bf16<2>(X, Wt, DM, FF / 64, BIG, FF, lds, tid_, wave_, lane_); } }
            END_SITE(base + 9)
        BEGIN_SITE(17, base + 10)
            const bf16* Wt = (const bf16*)(ws + WS_W2 + (size_t)layer * WSZ_W2); pg8::Gemm g{BIG, Wt, MAINM, DM, FF}; pg8::StaticOrder S; S.init(MAINM, DM, G_, (int)blockIdx.x);
            pg8::EpiResBf16 E{X, DM, ALPHA};
            pg8::gemm_phase<pg8::EpiResBf16, pg8::StaticOrder, true, true>(lds, g, S, E, wave);
            { LOCALS; for (int sk_ = 0; sk_ < SKREP; ++sk_) { skinny_rows_part(BIG, Wt, FF, ZP, lds, tid_, wave_, lane_); } }
            END_SITE(base + 10)
        BEGIN_SITE(18, base + 11)
            const bool last = layer == 3;
            LOCALS; ln_phase(Z, ZP, X, rp_ == 0 ? X : (bf16*)(P.ws + WS_QR), P.ln2_g + (size_t)layer * DM, P.ln2_b + (size_t)layer * DM, last ? P.out + O_YP : nullptr, last ? P.out + O_YS : nullptr, lds, gw_, NGW, tid_, wave_, lane_);
            if (!last) SEAM(base + 11); } }
    }
#undef IN
#undef SEAM
}

#ifndef MK_SPLIT
#define MK_SPLIT 0
#endif
extern "C" void kernel_launch(void* const* d_in, const int* in_sizes, int n_in, void* d_out, int out_size, void* d_ws, size_t ws_size, hipStream_t stream) {
    static int grid = 0;
    if (grid == 0) {
        if (n_in != 27 || (size_t)out_size != O_END || ws_size < WS_END) { fprintf(stderr, "kernel_launch: unexpected shapes: n_in %d out %d (want %zu) ws %zu (want >= %zu)\n", n_in, out_size, (size_t)O_END, ws_size, (size_t)WS_END); grid = -1; return; }
        int dev = 0, cus = 0;
        if (hipGetDevice(&dev) != hipSuccess || hipDeviceGetAttribute(&cus, hipDeviceAttributeMultiprocessorCount, dev) != hipSuccess) { grid = -1; return; }
        if (hipFuncSetAttribute((const void*)mega_fwd, hipFuncAttributeMaxDynamicSharedMemorySize, LDS_BYTES) != hipSuccess) { fprintf(stderr, "kernel_launch: hipFuncSetAttribute failed\n"); grid = -1; return; }
        int per_cu = 0;
        if (hipOccupancyMaxActiveBlocksPerMultiprocessor(&per_cu, (const void*)mega_fwd, NTHREADS, LDS_BYTES) != hipSuccess || per_cu < 1) fprintf(stderr, "kernel_launch: occupancy query reports %d\n", per_cu);
        (void)hipGetLastError();
        grid = cus;
    }
    if (grid < 0) return;
    (void)hipMemsetAsync((char*)d_ws + WS_CTL, 0, CTL_ZERO_BYTES, stream);
    Args a{};
    for (int i = 0; i < 27; ++i) a.in[i] = d_in[i];
    a.out = (float*)d_out; a.ws = (unsigned char*)d_ws;
#if MK_SPLIT
    for (int ph = 0; ph < PH_END; ++ph) {
        bool exists = (ph == 0);
        if (ph > 0) { const int layer = (ph - 1) / PH_PER_LAYER, l = (ph - 1) % PH_PER_LAYER, kind = layer % 3; const int nmix = kind == 0 ? 3 : (kind == 1 ? 6 : 8); exists = (l < nmix) || (l >= 8 && l <= 11); }
        if (!exists) continue;
        a.ph_lo = ph; a.ph_hi = ph + 1;
        hipLaunchKernelGGL(mega_fwd, dim3(grid), dim3(NTHREADS), LDS_BYTES, stream, a);
    }
#else
    a.ph_lo = 0; a.ph_hi = PH_END;
    hipLaunchKernelGGL(mega_fwd, dim3(grid), dim3(NTHREADS), LDS_BYTES, stream, a);
#endif
    const hipError_t le = hipPeekAtLastError();
    if (le != hipSuccess) fprintf(stderr, "kernel_launch: launch failed: %s\n", hipGetErrorName(le));
}
```

```cpp
#include <hip/hip_runtime.h>
#include <cstdio>
#include <cstdint>
#include <cmath>
__device__ __forceinline__ int flane() { return (int)__builtin_amdgcn_mbcnt_hi(~0u, __builtin_amdgcn_mbcnt_lo(~0u, 0u)); }
namespace pg8 {
#define PG8_LAS __attribute__((address_space(3)))
typedef unsigned short bf16_t;
typedef short bf16x8 __attribute__((ext_vector_type(8)));
typedef float f32x4 __attribute__((ext_vector_type(4)));
typedef unsigned u32x4 __attribute__((ext_vector_type(4)));
constexpr int BM = 256, BK = 64, HALF = 128, HTB = HALF * BK * 2  , STAGE_BYTES = 8 * HTB, NXCD = 8, WGM = 8;

__host__ __device__ __forceinline__ int lds_byte(int r, int c) { const int st = (r >> 4) * 2 + (c >> 5), rr = r & 15, cc = c & 31, ob = rr * 64 + cc * 2; return st * 1024 + (ob ^ (((ob >> 9) & 1) << 5)); }
__host__ __device__ __forceinline__ void stage_rc(int b, int& R, int& C) { const int st = b / 1024, sb = b % 1024, swz = sb ^ (((sb >> 9) & 1) << 5); R = (st >> 1) * 16 + swz / 64; C = (st & 1) * 32 + (swz % 64) / 2; }
__host__ __device__ __forceinline__ int perm32(int rho) { const int n = rho >> 4, i = rho & 15; return 8 * (i >> 2) + 4 * n + (i & 3); }

struct Unit { int pm, pn; };
struct Gemm { const bf16_t* A; const bf16_t* Bt; int M, N, K; };

struct StaticOrder {
    int nM, nN, nwg, G, c;
    __host__ __device__ void init(int M, int N, int G_, int c_) { nM = M / BM; nN = N / BM; nwg = nM * nN; G = G_; c = c_; }
    __host__ __device__ bool next(int i, Unit& u) const {
        const long L = (long)i * G + c; if (L >= nwg) return false;
        int wgid = (int)L; { const int q = nwg / NXCD, r = nwg % NXCD, xcd = wgid % NXCD, off = wgid / NXCD; wgid = (xcd < r ? xcd * (q + 1) : r * (q + 1) + (xcd - r) * q) + off; }
        const int nig = WGM * nN, gid = wgid / nig, fm = gid * WGM, gsz = (nM - fm) < WGM ? (nM - fm) : WGM;
        u.pm = fm + ((wgid % nig) % gsz); u.pn = (wgid % nig) / gsz; return true;
    }
    __device__ __forceinline__ void a_ready(const Unit&) const {}
    __device__ __forceinline__ void done(const Unit&) const {}
};

__device__ __forceinline__ unsigned cvt_pk_bf16(float lo, float hi) { unsigned r; asm volatile("v_cvt_pk_bf16_f32 %0, %1, %2" : "=v"(r) : "v"(lo), "v"(hi)); return r; }
typedef float f32x2 __attribute__((ext_vector_type(2)));
__device__ __forceinline__ f32x2 gelu_pk(f32x2 v) {
    const f32x2 av = __builtin_elementwise_abs(v), d = av * 0.2316418882f + 1.0f;
    f32x2 t; t.x = __builtin_amdgcn_rcpf(d.x); t.y = __builtin_amdgcn_rcpf(d.y);
    f32x2 q = t * 0.5307027145f + (-0.7265760135f); q = q * t + 0.7107068705f; q = q * t + (-0.142248368f); q = q * t + 0.127414796f; q = q * t;
    const f32x2 s = (v * v) * (-0.72134752044f);
    f32x2 e; e.x = __builtin_amdgcn_exp2f(s.x); e.y = __builtin_amdgcn_exp2f(s.y);
    const f32x2 m = v * (q * e), r = v - m;
    f32x2 o; o.x = v.x < 0.f ? m.x : r.x; o.y = v.y < 0.f ? m.y : r.y; return o;
}

template <int ACT  > struct EpiBf16 {
    static constexpr bool PERM = true, AFTER_DRAIN = false; static_assert(ACT == 0 || ACT == 1 || ACT == 2, "EpiBf16: ACT is 0 (none), 1 (gelu_pk) or 2 (relu^2)");
    bf16_t* O; int ldc; const float* bias; int split_cols; size_t split_stride; float scale0;
    __device__ __forceinline__ void operator()(const f32x4 (&acc)[2][2][4][2], const Unit& u, int wr, int wc, int fr, int fq) const {
        const int row0 = u.pm * BM + wr * 64 + fr; int colt = u.pn * BM; bf16_t* base = O;
        float sc = 1.f; if (split_cols) { const int t = colt / split_cols; base += (size_t)t * split_stride; colt -= t * split_cols; if (t == 0) sc = scale0; }
        const int col0 = colt + wc * 32 + 8 * fq, bcol0 = u.pn * BM + wc * 32 + 8 * fq;
        f32x4 bv[2][2];
#pragma unroll
        for (int bj = 0; bj < 2; ++bj)
#pragma unroll
            for (int n = 0; n < 2; ++n) bv[bj][n] = bias ? *(const f32x4*)(bias + bcol0 + bj * HALF + 4 * n) : (f32x4){0.f, 0.f, 0.f, 0.f};
#pragma unroll
        for (int ai = 0; ai < 2; ++ai)
#pragma unroll
            for (int m = 0; m < 4; ++m) { bf16_t* rowp = base + (size_t)(row0 + ai * HALF + m * 16) * ldc + col0;
#pragma unroll
                for (int bj = 0; bj < 2; ++bj) { f32x4 v0 = acc[ai][bj][m][0] + bv[bj][0], v1 = acc[ai][bj][m][1] + bv[bj][1];
                    if (ACT == 1) { f32x2 a = gelu_pk((f32x2){v0[0], v0[1]}), b = gelu_pk((f32x2){v0[2], v0[3]}), c = gelu_pk((f32x2){v1[0], v1[1]}), d = gelu_pk((f32x2){v1[2], v1[3]});
                        v0 = (f32x4){a.x, a.y, b.x, b.y}; v1 = (f32x4){c.x, c.y, d.x, d.y}; }
                    if (ACT == 2) { _Pragma("unroll") for (int q_ = 0; q_ < 4; ++q_) { const float a_ = v0[q_] > 0.f ? v0[q_] : 0.f, b_ = v1[q_] > 0.f ? v1[q_] : 0.f; v0[q_] = a_ * a_; v1[q_] = b_ * b_; } }
                    v0 = v0 * sc; v1 = v1 * sc; u32x4 w; w.x = cvt_pk_bf16(v0[0], v0[1]); w.y = cvt_pk_bf16(v0[2], v0[3]); w.z = cvt_pk_bf16(v1[0], v1[1]); w.w = cvt_pk_bf16(v1[2], v1[3]);
                    *(u32x4*)(rowp + bj * HALF) = w; } }
    }
};


struct EpiResBf16 {
    static constexpr bool PERM = true, AFTER_DRAIN = false;
    bf16_t* X; int ldc; float alpha;
    __device__ __forceinline__ void operator()(const f32x4 (&acc)[2][2][4][2], const Unit& u, int wr, int wc, int fr, int fq) const {
        const int row0 = u.pm * BM + wr * 64 + fr, col0 = u.pn * BM + wc * 32 + 8 * fq;
#pragma unroll
        for (int ai = 0; ai < 2; ++ai) {
            u32x4 xin[4][2];
#pragma unroll
            for (int m = 0; m < 4; ++m)
#pragma unroll
                for (int bj = 0; bj < 2; ++bj) xin[m][bj] = *(const u32x4*)(X + (size_t)(row0 + ai * HALF + m * 16) * ldc + col0 + bj * HALF);
#pragma unroll
            for (int m = 0; m < 4; ++m) { bf16_t* rowp = X + (size_t)(row0 + ai * HALF + m * 16) * ldc + col0;
#pragma unroll
                for (int bj = 0; bj < 2; ++bj) { const u32x4 xi = xin[m][bj]; const f32x4 a0 = acc[ai][bj][m][0], a1 = acc[ai][bj][m][1];
                    float x[8] = {__uint_as_float(xi.x << 16), __uint_as_float(xi.x & 0xffff0000u), __uint_as_float(xi.y << 16), __uint_as_float(xi.y & 0xffff0000u),
                                  __uint_as_float(xi.z << 16), __uint_as_float(xi.z & 0xffff0000u), __uint_as_float(xi.w << 16), __uint_as_float(xi.w & 0xffff0000u)};
                    u32x4 w; w.x = cvt_pk_bf16(alpha * x[0] + a0[0], alpha * x[1] + a0[1]); w.y = cvt_pk_bf16(alpha * x[2] + a0[2], alpha * x[3] + a0[3]);
                    w.z = cvt_pk_bf16(alpha * x[4] + a1[0], alpha * x[5] + a1[1]); w.w = cvt_pk_bf16(alpha * x[6] + a1[2], alpha * x[7] + a1[3]);
                    *(u32x4*)(rowp + bj * HALF) = w; } }
        }
    }
};

struct EpiF32 {
    static constexpr bool PERM = false, AFTER_DRAIN = false;
    float* C; int ldc;
    __device__ __forceinline__ void operator()(const f32x4 (&acc)[2][2][4][2], const Unit& u, int wr, int wc, int fr, int fq) const {
        const int row0 = u.pm * BM + wr * 64 + fr, col0 = u.pn * BM + wc * 32 + 4 * fq;
#pragma unroll
        for (int ai = 0; ai < 2; ++ai)
#pragma unroll
            for (int m = 0; m < 4; ++m) { float* rowp = C + (size_t)(row0 + ai * HALF + m * 16) * ldc + col0;
#pragma unroll
                for (int bj = 0; bj < 2; ++bj)
#pragma unroll
                    for (int n = 0; n < 2; ++n) *(f32x4*)(rowp + bj * HALF + n * 16) = acc[ai][bj][m][n]; }
    }
};
struct PanelStats {
    unsigned* xbuf;
    unsigned* cnt;
    unsigned* tmo;
    int ntn; float eps;
    unsigned code;
    __device__ __forceinline__ bool run(const f32x4 (&v)[2][2][4][2], const Unit& u, int wr, int wc, int fr, int fq, PG8_LAS unsigned char* lds, int wid, int lane) const {
        typedef float f32x2v __attribute__((ext_vector_type(2)));
        PG8_LAS f32x2v* P = (PG8_LAS f32x2v*)lds;
        PG8_LAS f32x2v* S = (PG8_LAS f32x2v*)(lds + 8192);
        PG8_LAS unsigned* flag = (PG8_LAS unsigned*)(lds + 8192 + 2048);
#pragma unroll
        for (int ai = 0; ai < 2; ++ai)
#pragma unroll
            for (int m = 0; m < 4; ++m) {
                float s = 0.f;
#pragma unroll
                for (int bj = 0; bj < 2; ++bj)
#pragma unroll
                    for (int n = 0; n < 2; ++n) { const f32x4 x = v[ai][bj][m][n]; s += (x[0] + x[1]) + (x[2] + x[3]); }
                s += __shfl_xor(s, 16); s += __shfl_xor(s, 32);
                const float mw = s * (1.0f / 64.0f); float q = 0.f;
#pragma unroll
                for (int bj = 0; bj < 2; ++bj)
#pragma unroll
                    for (int n = 0; n < 2; ++n) { const f32x4 d = v[ai][bj][m][n] - mw; q += (d[0] * d[0] + d[1] * d[1]) + (d[2] * d[2] + d[3] * d[3]); }
                q += __shfl_xor(q, 16); q += __shfl_xor(q, 32);
                if (fq == 0) P[(ai * HALF + wr * 64 + m * 16 + fr) * 4 + wc] = (f32x2v){mw, q};
            }
        asm volatile("s_waitcnt lgkmcnt(0)" ::: "memory"); __builtin_amdgcn_s_barrier(); asm volatile("" ::: "memory");
#if defined(BROKEN_EXCHANGE_NO_WAIT)
#warning BROKEN CONTROL BUILD: the row-statistics exchange does not wait; results are wrong by design
        if (blockIdx.x >= 64) { const long long t0_ = clock64(); while (clock64() - t0_ < 60000) __builtin_amdgcn_s_sleep(8); }
#endif
        const int row = wid * 32 + (lane & 31);
        if (lane < 32) {
            const f32x2v a = P[row * 4 + 0], b = P[row * 4 + 1], c = P[row * 4 + 2], d = P[row * 4 + 3];
            const float mt = (a.x + b.x + c.x + d.x) * 0.25f;
            const float da = a.x - mt, db = b.x - mt, dc = c.x - mt, dd = d.x - mt;
            const float m2 = (a.y + b.y) + (c.y + d.y) + 64.0f * ((da * da + db * db) + (dc * dc + dd * dd));
            unsigned long long* slot = (unsigned long long*)xbuf + ((size_t)(u.pm * BM + row) * 4 + u.pn);
            __hip_atomic_store(slot, ((unsigned long long)__float_as_uint(m2) << 32) | __float_as_uint(mt), __ATOMIC_RELAXED, __HIP_MEMORY_SCOPE_AGENT);
        }
        asm volatile("s_waitcnt vmcnt(0)" ::: "memory");
        if (lane == 0) __hip_atomic_fetch_add(cnt + 64 * u.pm, 1u, __ATOMIC_RELAXED, __HIP_MEMORY_SCOPE_AGENT);
        if (wid == 0) {
            bool dead = false; const unsigned long long t0 = __builtin_amdgcn_s_memrealtime(); const unsigned want = 8u * (unsigned)ntn;
            for (;;) {
#if defined(BROKEN_EXCHANGE_NO_WAIT)
                break;
#endif
                if ((unsigned)__builtin_amdgcn_readfirstlane(__hip_atomic_load(cnt + 64 * u.pm, __ATOMIC_RELAXED, __HIP_MEMORY_SCOPE_AGENT)) >= want) break;
                if (__builtin_amdgcn_s_memrealtime() - t0 > 2000000ull) {
                    if (lane == 0) { unsigned expect = 0u; __hip_atomic_compare_exchange_strong(tmo + 1, &expect, code | (unsigned)(u.pm & 0xff), __ATOMIC_RELAXED, __ATOMIC_RELAXED, __HIP_MEMORY_SCOPE_AGENT);
                                     __hip_atomic_store(tmo, 1u, __ATOMIC_RELAXED, __HIP_MEMORY_SCOPE_AGENT); }
                    dead = true; break; }
                __builtin_amdgcn_s_sleep(2);
            }
            __builtin_amdgcn_fence(__ATOMIC_ACQUIRE, "agent");
            if (lane == 0) flag[0] = dead ? 1u : 0u;
        }
        asm volatile("s_waitcnt vmcnt(0) lgkmcnt(0)" ::: "memory"); __builtin_amdgcn_s_barrier(); asm volatile("" ::: "memory");
        const bool bad = flag[0] != 0u;
        if (lane < 32) {
            const unsigned long long* slot = (const unsigned long long*)xbuf + (size_t)(u.pm * BM + row) * 4; float mt[4], m2[4]; float ms = 0.f;
#pragma unroll
            for (int t = 0; t < 4; ++t) { if (t < ntn) { const unsigned long long w = __hip_atomic_load(slot + t, __ATOMIC_RELAXED, __HIP_MEMORY_SCOPE_AGENT); mt[t] = __uint_as_float((unsigned)w); m2[t] = __uint_as_float((unsigned)(w >> 32)); } else { mt[t] = 0.f; m2[t] = 0.f; } ms += mt[t]; }
            const float mean = ms / (float)ntn; float q = 0.f;
#pragma unroll
            for (int t = 0; t < 4; ++t) if (t < ntn) { const float dm = mt[t] - mean; q += m2[t] + 256.0f * dm * dm; }
            S[row] = (f32x2v){mean, 1.0f / sqrtf(q / (256.0f * (float)ntn) + eps)};
        }
        asm volatile("s_waitcnt lgkmcnt(0)" ::: "memory"); __builtin_amdgcn_s_barrier(); asm volatile("" ::: "memory");
        return bad;
    }
};
struct EpiLnRes {
    static constexpr bool PERM = false, AFTER_DRAIN = true;
    const float* base; float* out; int ldc; const float* bias; PanelStats st; unsigned poison;
    __device__ __forceinline__ void fused(f32x4 (&acc)[2][2][4][2], const Unit& u, int wr, int wc, int fr, int fq, PG8_LAS unsigned char* lds, int wid, int lane) const {
        typedef float f32x2v __attribute__((ext_vector_type(2)));
        const PG8_LAS f32x2v* S = (const PG8_LAS f32x2v*)(lds + 8192);
        const int col0 = u.pn * BM + wc * 32 + 4 * fq;
#pragma unroll
        for (int bj = 0; bj < 2; ++bj)
#pragma unroll
            for (int n = 0; n < 2; ++n) { const f32x4 bv = bias ? *(const f32x4*)(bias + col0 + bj * HALF + n * 16) : (f32x4){0.f, 0.f, 0.f, 0.f};
#pragma unroll
                for (int ai = 0; ai < 2; ++ai)
#pragma unroll
                    for (int m = 0; m < 4; ++m) acc[ai][bj][m][n] += bv; }
        f32x4 pre[4][2][2];
#pragma unroll
        for (int m = 0; m < 4; ++m) { const size_t off = (size_t)(u.pm * BM + wr * 64 + m * 16 + fr) * ldc + col0;
#pragma unroll
            for (int bj = 0; bj < 2; ++bj)
#pragma unroll
                for (int n = 0; n < 2; ++n) pre[m][bj][n] = *(const f32x4*)(base + off + bj * HALF + n * 16); }
        const bool bad = st.run(acc, u, wr, wc, fr, fq, lds, wid, lane) || poison != 0u;
        const float qnan = __builtin_nanf("");
#pragma unroll
        for (int ai = 0; ai < 2; ++ai)
#pragma unroll
            for (int m = 0; m < 4; ++m) { const int r = ai * HALF + wr * 64 + m * 16 + fr; const f32x2v sr = S[r]; const size_t off = (size_t)(u.pm * BM + r) * ldc + col0;
#pragma unroll
                for (int bj = 0; bj < 2; ++bj)
#pragma unroll
                    for (int n = 0; n < 2; ++n) { const f32x4 bs = ai == 0 ? pre[m][bj][n] : *(const f32x4*)(base + off + bj * HALF + n * 16); f32x4 o = bs + (acc[ai][bj][m][n] - sr.x) * sr.y;
                        if (bad) o = (f32x4){qnan, qnan, qnan, qnan}; *(f32x4*)(out + off + bj * HALF + n * 16) = o; }
                if (m & 1) asm volatile("" ::: "memory"); }
    }
};
struct EpiLnResLn {
    static constexpr bool PERM = false, AFTER_DRAIN = true;
    const float* base; float* out; bf16_t* xn; int ldc; const float* bias; PanelStats st1, st2; unsigned poison;
    __device__ __forceinline__ void fused(f32x4 (&acc)[2][2][4][2], const Unit& u, int wr, int wc, int fr, int fq, PG8_LAS unsigned char* lds, int wid, int lane) const {
        typedef float f32x2v __attribute__((ext_vector_type(2))); typedef unsigned u32x2v __attribute__((ext_vector_type(2)));
        const PG8_LAS f32x2v* S = (const PG8_LAS f32x2v*)(lds + 8192);
        const int col0 = u.pn * BM + wc * 32 + 4 * fq;
#pragma unroll
        for (int bj = 0; bj < 2; ++bj)
#pragma unroll
            for (int n = 0; n < 2; ++n) { const f32x4 bv = bias ? *(const f32x4*)(bias + col0 + bj * HALF + n * 16) : (f32x4){0.f, 0.f, 0.f, 0.f};
#pragma unroll
                for (int ai = 0; ai < 2; ++ai)
#pragma unroll
                    for (int m = 0; m < 4; ++m) acc[ai][bj][m][n] += bv; }
        bool bad = st1.run(acc, u, wr, wc, fr, fq, lds, wid, lane) || poison != 0u;
        const float qnan = __builtin_nanf("");
#pragma unroll
        for (int ai = 0; ai < 2; ++ai)
#pragma unroll
            for (int m = 0; m < 4; ++m) { const int r = ai * HALF + wr * 64 + m * 16 + fr; const f32x2v sr = S[r]; const size_t off = (size_t)(u.pm * BM + r) * ldc + col0;
#pragma unroll
                for (int bj = 0; bj < 2; ++bj)
#pragma unroll
                    for (int n = 0; n < 2; ++n) { const f32x4 bs = *(const f32x4*)(base + off + bj * HALF + n * 16); acc[ai][bj][m][n] = bs + (acc[ai][bj][m][n] - sr.x) * sr.y; }
                asm volatile("" : "+v"(acc[ai][0][m][0]), "+v"(acc[ai][0][m][1]), "+v"(acc[ai][1][m][0]), "+v"(acc[ai][1][m][1]));
                if (m & 1) asm volatile("" ::: "memory"); }
        const bool bad1 = bad;
        bad = st2.run(acc, u, wr, wc, fr, fq, lds, wid, lane) || bad;
#pragma unroll
        for (int ai = 0; ai < 2; ++ai)
#pragma unroll
            for (int m = 0; m < 4; ++m) { const int r = ai * HALF + wr * 64 + m * 16 + fr; const f32x2v sr = S[r]; const size_t off = (size_t)(u.pm * BM + r) * ldc + col0;
#pragma unroll
                for (int bj = 0; bj < 2; ++bj)
#pragma unroll
                    for (int n = 0; n < 2; ++n) { const f32x4 x1 = acc[ai][bj][m][n]; *(f32x4*)(out + off + bj * HALF + n * 16) = bad1 ? (f32x4){qnan, qnan, qnan, qnan} : x1;
                        const f32x4 o = (x1 - sr.x) * sr.y; u32x2v w; w.x = cvt_pk_bf16(o[0], o[1]); w.y = cvt_pk_bf16(o[2], o[3]);
                        if (bad) { w.x = 0x7fc07fc0u; w.y = 0x7fc07fc0u; } *(u32x2v*)(xn + off + bj * HALF + n * 16) = w; }
                asm volatile("" ::: "memory"); }
    }
};

template <class Epi, class Sched, bool ALIGN_EPI = false, bool SP2 = false>
__device__ __forceinline__ void gemm_phase(PG8_LAS unsigned char* lds, const Gemm g, const Sched& S, const Epi& E, int wv) {
    int tid0_ = threadIdx.x; asm volatile("" : "+v"(tid0_)); (void)wv;
    const int tid = tid0_, wid = __builtin_amdgcn_readfirstlane(tid >> 6), lane = tid & 63, wr = wid >> 2, wc = wid & 3, fr = lane & 15, fq = lane >> 4;
    const int K = g.K, nt = K / BK;
    unsigned voffA[2], voffB[2];
#pragma unroll
    for (int i = 0; i < 2; ++i) { int R, C; stage_rc(tid * 16 + i * 8192, R, C); const int Rb = Epi::PERM ? ((R & ~31) + perm32(R & 31)) : R;
        voffA[i] = (unsigned)(R * K + C) * 2u; voffB[i] = (unsigned)(Rb * K + C) * 2u; }
    const size_t kstep = (size_t)(BK * 2);
    const size_t hstep = (size_t)HALF * K * 2;
    const size_t tstep = 2 * hstep;
    const unsigned ldsw = (unsigned)wid * 1024u;
    const int aoff = lds_byte(wr * 64 + fr, fq * 8), boff = lds_byte(wc * 32 + fr, fq * 8);
#define PG8_SA(b, h) (((b) * 2 + (h)) * HTB)
#define PG8_SB(b, h) ((4 + (b) * 2 + (h)) * HTB)
#define PG8_STAGE(bufoff, gbase, voff) do { _Pragma("unroll") for (int _i = 0; _i < 2; ++_i) \
        __builtin_amdgcn_global_load_lds((const unsigned*)((const char*)(gbase) + (voff)[_i]), (PG8_LAS unsigned*)(lds + (bufoff) + ldsw + _i * 8192), 16, 0, 0); } while (0)
#define PG8_LDA(dst, b, h) do { _Pragma("unroll") for (int m = 0; m < 4; ++m) _Pragma("unroll") for (int k = 0; k < 2; ++k) dst[m][k] = *(const PG8_LAS bf16x8*)(lds + PG8_SA(b, h) + aoff + m * 2048 + k * 1024); } while (0)
#define PG8_LDB(dst, b, h) do { _Pragma("unroll") for (int n = 0; n < 2; ++n) _Pragma("unroll") for (int k = 0; k < 2; ++k) dst[n][k] = *(const PG8_LAS bf16x8*)(lds + PG8_SB(b, h) + boff + n * 2048 + k * 1024); } while (0)
#define PG8_MMA(ai, bj, At, Bt) do { __builtin_amdgcn_s_setprio(1); _Pragma("unroll") for (int m = 0; m < 4; ++m) _Pragma("unroll") for (int n = 0; n < 2; ++n) _Pragma("unroll") for (int k = 0; k < 2; ++k) \
        acc[ai][bj][m][n] = __builtin_amdgcn_mfma_f32_16x16x32_bf16(Bt[n][k], At[m][k], acc[ai][bj][m][n], 0, 0, 0); __builtin_amdgcn_s_setprio(0); } while (0)
#define PG8_WAIT_V(n) asm volatile("s_waitcnt vmcnt(" #n ")" ::: "memory")
#define PG8_WAIT_L(n) asm volatile("s_waitcnt lgkmcnt(" #n ")" ::: "memory")
#define PG8_BAR __builtin_amdgcn_s_barrier()
#define PG8_SCHED __builtin_amdgcn_sched_barrier(0)
    Unit cur, nxt; int ui = 0;
    if (!S.next(0, cur)) return;
    f32x4 acc[2][2][4][2];
#pragma unroll
    for (int a = 0; a < 2; ++a)
#pragma unroll
        for (int b = 0; b < 2; ++b)
#pragma unroll
            for (int m = 0; m < 4; ++m)
#pragma unroll
                for (int n = 0; n < 2; ++n) acc[a][b][m][n] = (f32x4){0.f, 0.f, 0.f, 0.f};
    bf16x8 At[4][2], B0[2][2], B1[2][2];
    const char* cA = (const char*)g.A + (size_t)cur.pm * tstep; const char* cB = (const char*)g.Bt + (size_t)cur.pn * tstep;
    S.a_ready(cur);
    if constexpr (SP2) {
        PG8_STAGE(PG8_SB(0, 0), cB, voffB); PG8_STAGE(PG8_SB(0, 1), cB + hstep, voffB); PG8_STAGE(PG8_SA(0, 0), cA, voffA); PG8_STAGE(PG8_SA(0, 1), cA + hstep, voffA);
        if (wr == 1) PG8_BAR;
        PG8_WAIT_V(2); PG8_BAR;
        PG8_STAGE(PG8_SB(1, 0), cB + kstep, voffB); PG8_STAGE(PG8_SA(1, 0), cA + kstep, voffA); PG8_STAGE(PG8_SB(1, 1), cB + hstep + kstep, voffB);
        PG8_WAIT_V(6); PG8_BAR;
    } else {
        PG8_STAGE(PG8_SB(0, 0), cB, voffB); PG8_STAGE(PG8_SA(0, 0), cA, voffA); PG8_STAGE(PG8_SB(0, 1), cB + hstep, voffB); PG8_STAGE(PG8_SA(0, 1), cA + hstep, voffA);
        if (wr == 1) PG8_BAR;
        PG8_WAIT_V(4); PG8_BAR;
        PG8_STAGE(PG8_SB(1, 0), cB + kstep, voffB); PG8_STAGE(PG8_SA(1, 0), cA + kstep, voffA); PG8_STAGE(PG8_SB(1, 1), cB + hstep + kstep, voffB);
        PG8_WAIT_V(6); PG8_BAR;
    }
    for (;;) {
        const bool has_next = S.next(ui + 1, nxt);
        const char* nA = has_next ? (const char*)g.A + (size_t)nxt.pm * tstep : cA; const char* nB = has_next ? (const char*)g.Bt + (size_t)nxt.pn * tstep : cB;
        for (int t = 0; t < nt; t += 2) {
            const bool last = (t == nt - 2);
            const char* a1 = cA + (size_t)(t + 1) * kstep;
            const char* a2 = last ? nA : cA + (size_t)(t + 2) * kstep; const char* b2 = last ? nB : cB + (size_t)(t + 2) * kstep;
            const char* a3 = a2 + kstep; const char* b3 = b2 + kstep;
            if (last && has_next) S.a_ready(nxt);
            if constexpr (SP2) {
            PG8_LDB(B0, 0, 0); PG8_LDB(B1, 0, 1); PG8_SCHED; PG8_LDA(At, 0, 0); PG8_STAGE(PG8_SA(1, 1), a1 + hstep, voffA);
            PG8_WAIT_V(8); PG8_WAIT_L(0); PG8_BAR; PG8_MMA(0, 0, At, B0); PG8_MMA(0, 1, At, B1); PG8_BAR; PG8_SCHED;
            PG8_LDA(At, 0, 1); PG8_STAGE(PG8_SB(0, 0), b2, voffB); PG8_STAGE(PG8_SB(0, 1), b2 + hstep, voffB); PG8_STAGE(PG8_SA(0, 0), a2, voffA);
            PG8_WAIT_V(8); PG8_WAIT_L(0); PG8_BAR; PG8_MMA(1, 0, At, B0); PG8_MMA(1, 1, At, B1); PG8_BAR; PG8_SCHED;
            PG8_LDB(B0, 1, 0); PG8_LDB(B1, 1, 1); PG8_SCHED; PG8_LDA(At, 1, 0); PG8_STAGE(PG8_SA(0, 1), a2 + hstep, voffA);
            PG8_WAIT_V(8); PG8_WAIT_L(0); PG8_BAR; PG8_MMA(0, 0, At, B0); PG8_MMA(0, 1, At, B1); PG8_BAR; PG8_SCHED;
            PG8_LDA(At, 1, 1); PG8_STAGE(PG8_SB(1, 0), b3, voffB); PG8_STAGE(PG8_SB(1, 1), b3 + hstep, voffB); PG8_STAGE(PG8_SA(1, 0), a3, voffA);
            PG8_WAIT_V(8); PG8_WAIT_L(0); PG8_BAR; PG8_MMA(1, 0, At, B0); PG8_MMA(1, 1, At, B1); PG8_BAR; PG8_SCHED;
            } else {
            PG8_LDB(B0, 0, 0); PG8_SCHED; PG8_LDA(At, 0, 0); PG8_STAGE(PG8_SA(1, 1), a1 + hstep, voffA);
            PG8_WAIT_L(8); PG8_BAR; PG8_WAIT_L(0); PG8_MMA(0, 0, At, B0); PG8_BAR; PG8_SCHED;
            PG8_LDB(B1, 0, 1); PG8_STAGE(PG8_SB(0, 0), b2, voffB);
            PG8_BAR; PG8_WAIT_L(0); PG8_MMA(0, 1, At, B1); PG8_BAR;
            PG8_LDA(At, 0, 1); PG8_STAGE(PG8_SA(0, 0), a2, voffA);
            PG8_BAR; PG8_WAIT_L(0); PG8_MMA(1, 0, At, B0); PG8_BAR; PG8_SCHED;
            PG8_STAGE(PG8_SB(0, 1), b2 + hstep, voffB);
            PG8_WAIT_V(6); PG8_BAR; PG8_MMA(1, 1, At, B1); PG8_BAR;
            PG8_LDB(B0, 1, 0); PG8_SCHED; PG8_LDA(At, 1, 0); PG8_STAGE(PG8_SA(0, 1), a2 + hstep, voffA);
            PG8_WAIT_L(8); PG8_BAR; PG8_WAIT_L(0); PG8_MMA(0, 0, At, B0); PG8_BAR; PG8_SCHED;
            PG8_LDB(B1, 1, 1); PG8_STAGE(PG8_SB(1, 0), b3, voffB);
            PG8_BAR; PG8_WAIT_L(0); PG8_MMA(0, 1, At, B1); PG8_BAR;
            PG8_LDA(At, 1, 1); PG8_STAGE(PG8_SA(1, 0), a3, voffA);
            PG8_BAR; PG8_WAIT_L(0); PG8_MMA(1, 0, At, B0); PG8_BAR; PG8_SCHED;
            PG8_STAGE(PG8_SB(1, 1), b3 + hstep, voffB);
            PG8_WAIT_V(6); PG8_BAR; PG8_MMA(1, 1, At, B1); PG8_BAR;
            }
        }
        if constexpr (ALIGN_EPI) { if (wr == 0) PG8_BAR; }
        if constexpr (!Epi::AFTER_DRAIN) { E(acc, cur, wr, wc, fr, fq); S.done(cur); }
        if (!has_next) break;
#pragma unroll
        for (int a = 0; a < 2; ++a)
#pragma unroll
            for (int b = 0; b < 2; ++b)
#pragma unroll
                for (int m = 0; m < 4; ++m)
#pragma unroll
                    for (int n = 0; n < 2; ++n) acc[a][b][m][n] = (f32x4){0.f, 0.f, 0.f, 0.f};
        cur = nxt; cA = nA; cB = nB; ++ui;
        if constexpr (ALIGN_EPI) { if (wr == 1) PG8_BAR; }
    }
    PG8_WAIT_V(0);
    if constexpr (!ALIGN_EPI) { if (wr == 0) PG8_BAR; }
    PG8_BAR;
    if constexpr (Epi::AFTER_DRAIN) { E.fused(acc, cur, wr, wc, fr, fq, lds, wid, lane); S.done(cur); }
#undef PG8_SA
#undef PG8_SB
#undef PG8_STAGE
#undef PG8_LDA
#undef PG8_LDB
#undef PG8_MMA
#undef PG8_WAIT_V
#undef PG8_WAIT_L
#undef PG8_BAR
#undef PG8_SCHED
}
}

#ifndef PG8_SP2
#define PG8_SP2 true
#endif
#ifndef PG8_ALIGN
#define PG8_ALIGN true
#endif
#define GAS __attribute__((address_space(1)))
#define LAS __attribute__((address_space(3)))
#define XB_TMO      128
#define XB_XCNT(j)  (256  + 64 * (j))
#define XB_XSUB(j)  (1280 + 64 * (j))
#define XB_XGEN(j)  (2304 + 64 * (j))
#define XB_TOP      3328
#define XB_TOPGEN   3392
#define XCD_BAR_WORDS 3456
#define XB_SPIN_CAP (1u << 18)

__device__ __forceinline__ unsigned xb_ld(unsigned* p)              { return __hip_atomic_load(p, __ATOMIC_RELAXED, __HIP_MEMORY_SCOPE_AGENT); }
__device__ __forceinline__ unsigned xb_add(unsigned* p, unsigned v) { return __hip_atomic_fetch_add(p, v, __ATOMIC_RELAXED, __HIP_MEMORY_SCOPE_AGENT); }
__device__ __forceinline__ unsigned xb_xcc_id() { return (unsigned)__builtin_amdgcn_s_getreg((3 << 11) | 20) & 0xFu; }
#define XB_SPIN(cond, bar) do { unsigned _sp = 0; while (cond) { __builtin_amdgcn_s_sleep(1); \
    if ((++_sp & 255u) == 0u) { if (xb_ld(&(bar)[XB_TMO])) break; if (_sp > XB_SPIN_CAP) { atomicAdd(&(bar)[XB_TMO], 1u); break; } } } } while (0)

struct XcdBarrier {
    unsigned* bar; unsigned x;
    volatile LAS unsigned* st;
    int wv;
};

__device__ __forceinline__ XcdBarrier xcd_barrier_post(unsigned* bar, volatile LAS unsigned* st) {
    XcdBarrier b; b.bar = bar; b.x = xb_xcc_id(); b.st = st;
    if (threadIdx.x == 0) (void)xb_add(&bar[XB_XCNT(b.x)], 1u);
    return b;
}
__device__ __forceinline__ void xcd_barrier_complete(unsigned* bar, unsigned x, unsigned& nloc, unsigned& nx) {
    asm volatile("" : "+s"(x));
    const unsigned G = gridDim.x * gridDim.y * gridDim.z;
    unsigned sum, cnt, mine, sp = 0u;
    for (;;) {
        sum = 0u; cnt = 0u; mine = 0u;
#pragma unroll
        for (unsigned j = 0; j < 16; ++j) { const unsigned c = xb_ld(&bar[XB_XCNT(j)]); sum += c; cnt += (c > 0u) ? 1u : 0u; mine = (j == x) ? c : mine; }
        if (sum == G) break;
        __builtin_amdgcn_s_sleep(1);
        if ((++sp & 255u) == 0u) { if (xb_ld(&bar[XB_TMO])) break; if (sp > XB_SPIN_CAP) { atomicAdd(&bar[XB_TMO], 1u); break; } }
    }
    nloc = mine > 0u ? mine : 1u; nx = cnt > 0u ? cnt : 1u;
}

__device__ __forceinline__ void xcd_barrier(const XcdBarrier& b) {
    asm volatile("s_waitcnt vmcnt(0)" ::: "memory");
    __syncthreads();
    if (threadIdx.x == 0) {
        unsigned* bar = b.bar; asm volatile("" : "+s"(bar));
        __builtin_amdgcn_s_waitcnt(0);
        unsigned nloc = b.st[0], nx = b.st[1];
        if (nloc == 0u) { xcd_barrier_complete(bar, b.x, nloc, nx); b.st[0] = nloc; b.st[1] = nx; }
        const unsigned old = xb_add(&bar[XB_XSUB(b.x)], 1u);
        const unsigned gen = old / nloc;
        if (old + 1u == (gen + 1u) * nloc) {
            __builtin_amdgcn_fence(__ATOMIC_RELEASE, "agent");
            asm volatile("s_waitcnt vmcnt(0)" ::: "memory");
            const unsigned og = xb_add(&bar[XB_TOP], 1u);
            const unsigned tg = og / nx;
            if (og + 1u == (tg + 1u) * nx) xb_add(&bar[XB_TOPGEN], 1u);
            else XB_SPIN(xb_ld(&bar[XB_TOPGEN]) == tg, bar);
            __builtin_amdgcn_fence(__ATOMIC_ACQUIRE, "agent");
            xb_add(&bar[XB_XGEN(b.x)], 1u);
            asm volatile("s_waitcnt vmcnt(0)" ::: "memory");
        } else {
            XB_SPIN(xb_ld(&bar[XB_XGEN(b.x)]) == gen, bar);
            __builtin_amdgcn_fence(__ATOMIC_ACQUIRE, "agent");
            asm volatile("s_waitcnt vmcnt(0)" ::: "memory");
        }
    }
    __syncthreads();
}
namespace dattn {
constexpr int D = 128, QST = 2048, KVS = 512, OST = 2048, MTW = 68, JLO = 3;
constexpr float THR = 8.f; constexpr bool WSKIP = false;
typedef unsigned short bf16;
constexpr float SCALE = 1.0f;
constexpr int NW = 8, QBLK = 32, KVBLK = 64, QB = NW * QBLK;
constexpr int SHM_V = KVBLK * D * 2, SHM_K = KVBLK * D * 2;
constexpr int LDS_BYTES = 2 * SHM_V + 2 * SHM_K + NW * 64 * 4;

typedef short bf16x8 __attribute__((ext_vector_type(8)));
typedef short s16x4 __attribute__((ext_vector_type(4)));
typedef float f32x16 __attribute__((ext_vector_type(16)));
typedef float f32x4 __attribute__((ext_vector_type(4)));
typedef unsigned u32x4 __attribute__((ext_vector_type(4)));
template <class A, class Bt> struct same_t { static constexpr bool v = false; };
template <class A> struct same_t<A, A> { static constexpr bool v = true; };

#define KSWZ(row, colB) ((row) * 256 + ((colB) ^ (((row) & 7) << 4)))
#define SBAR() __builtin_amdgcn_sched_barrier(0)
__device__ __forceinline__ int v_st(int k, int c) { const int kk = (k & ~0xC) | ((k & 4) << 1) | ((k & 8) >> 1); return ((kk >> 3) * 4 + (c >> 5)) * 512 + ((kk & 7) * 32 + (c & 31)) * 2; }
__device__ __forceinline__ int v_rd_base(int lane) { return ((lane & 3) << 3) | (((lane >> 2) & 3) << 6) | (((lane >> 4) & 1) << 5) | (((lane >> 5) & 1) << 8); }
constexpr int v_rd_off(int d0, int ks, int half) { return d0 * 512 + ks * 4096 + half * 2048; }
__device__ __forceinline__ int crow(int r, int hi) { return (r & 3) + 8 * (r >> 2) + 4 * hi; }
__device__ __forceinline__ unsigned cvtpk(float lo, float hi) {
    unsigned r; asm volatile("v_cvt_pk_bf16_f32 %0, %1, %2" : "=v"(r) : "v"(lo), "v"(hi)); return r;
}
__device__ __forceinline__ bf16x8 pack8(f32x4 a, f32x4 b) {
    u32x4 w = {cvtpk(a[0], a[1]), cvtpk(a[2], a[3]), cvtpk(b[0], b[1]), cvtpk(b[2], b[3])};
    return *reinterpret_cast<bf16x8*>(&w);
}
template <class T> __device__ __forceinline__ bf16x8 load8(const T* p) {
    if constexpr (same_t<T, float>::v) { return pack8(*(const f32x4*)p, *(const f32x4*)(p + 4)); }
    else { return *reinterpret_cast<const bf16x8*>(p); }
}
__device__ __forceinline__ void mask_tile(f32x16& p0, f32x16& p1, int dq, unsigned W) {
    const float NEG = -__builtin_inff();
#pragma unroll
    for (int r = 0; r < 16; ++r) {
        const int c = (r & 3) + 8 * (r >> 2);
        if ((unsigned)(dq - c) >= W) p0[r] = NEG;
        if ((unsigned)(dq - c - 32) >= W) p1[r] = NEG;
    }
}
__device__ __forceinline__ void mask_bits(f32x16& p0, f32x16& p1, unsigned long long mw, int hi) {
    const float NEG = -__builtin_inff();
    const unsigned lo = (unsigned)(mw >> (4 * hi)), up = (unsigned)(mw >> (32 + 4 * hi));
#pragma unroll
    for (int r = 0; r < 16; ++r) {
        const int c = (r & 3) + 8 * (r >> 2);
        const unsigned t0 = (unsigned)__builtin_amdgcn_sbfe((int)lo, c, 1), t1 = (unsigned)__builtin_amdgcn_sbfe((int)up, c, 1);
        p0[r] = __uint_as_float((t0 & __float_as_uint(p0[r])) | (~t0 & __float_as_uint(NEG)));
        p1[r] = __uint_as_float((t1 & __float_as_uint(p1[r])) | (~t1 & __float_as_uint(NEG)));
    }
}
template <int Q> __device__ __forceinline__ void mask_bias_q(f32x16& p0, f32x16& p1, unsigned nlo, unsigned nup) {
#pragma unroll
    for (int r = 4 * Q; r < 4 * Q + 4; ++r) { const int c = (r & 3) + 8 * (r >> 2);
        p0[r] = __uint_as_float((unsigned)__builtin_amdgcn_sbfe((int)nlo, c, 1) & 0xFF800000u);
        p1[r] = __uint_as_float((unsigned)__builtin_amdgcn_sbfe((int)nup, c, 1) & 0xFF800000u); }
}
__device__ __forceinline__ void mask_bias(f32x16& p0, f32x16& p1, unsigned long long mw, int hi) {
    const unsigned nlo = ~(unsigned)(mw >> (4 * hi)), nup = ~(unsigned)(mw >> (32 + 4 * hi));
    mask_bias_q<0>(p0, p1, nlo, nup); mask_bias_q<1>(p0, p1, nlo, nup); mask_bias_q<2>(p0, p1, nlo, nup); mask_bias_q<3>(p0, p1, nlo, nup);
}
__device__ __forceinline__ void partialSM(f32x16& p0, f32x16& p1, float& m_reg, float& mn, float& alpha) {
    float pmax = p0[0]; for (int r = 1; r < 16; ++r) pmax = fmaxf(pmax, p0[r]); for (int r = 0; r < 16; ++r) pmax = fmaxf(pmax, p1[r]);
    { auto rr = __builtin_amdgcn_permlane32_swap(__float_as_uint(pmax), __float_as_uint(pmax), false, false);
      pmax = fmaxf(__uint_as_float(rr[0]), __uint_as_float(rr[1])); }
    constexpr float C2 = 1.4426950408889634f * SCALE;
    if (__builtin_expect(__all((pmax - m_reg) * SCALE <= THR), 1)) { mn = m_reg; alpha = 1.f; }
    else { mn = fmaxf(m_reg, pmax); alpha = __builtin_amdgcn_exp2f((m_reg - mn) * C2); m_reg = mn; }
    const float mnL = -mn * C2;
    for (int r = 0; r < 16; ++r) p0[r] = fmaf(p0[r], C2, mnL); for (int r = 0; r < 16; ++r) p1[r] = fmaf(p1[r], C2, mnL);
    for (int r = 0; r < 16; ++r) p0[r] = __builtin_amdgcn_exp2f(p0[r]);
}
__device__ __forceinline__ void finishSM(f32x16& p0, f32x16& p1, float alpha, float& l_reg, bf16x8& pa0, bf16x8& pa1, bf16x8& pa2, bf16x8& pa3) {
    for (int r = 0; r < 16; ++r) p1[r] = __builtin_amdgcn_exp2f(p1[r]);
    float ps = 0; for (int r = 0; r < 16; ++r) ps += p0[r]; for (int r = 0; r < 16; ++r) ps += p1[r];
    { auto rr = __builtin_amdgcn_permlane32_swap(__float_as_uint(ps), __float_as_uint(ps), false, false);
      ps = __uint_as_float(rr[0]) + __uint_as_float(rr[1]); }
    l_reg = l_reg * alpha + ps;
#define PK4(P, B_, OUT) do { unsigned a0 = cvtpk(P[B_+0], P[B_+1]), a1 = cvtpk(P[B_+2], P[B_+3]);                          \
        unsigned b0 = cvtpk(P[B_+4], P[B_+5]), b1 = cvtpk(P[B_+6], P[B_+7]);                                             \
        auto r0 = __builtin_amdgcn_permlane32_swap(a0, b0, false, false); auto r1 = __builtin_amdgcn_permlane32_swap(a1, b1, false, false); \
        u32x4 w = {r0[0], r1[0], r0[1], r1[1]}; OUT = *reinterpret_cast<bf16x8*>(&w); } while (0)
    PK4(p0, 0, pa0); PK4(p0, 8, pa1); PK4(p1, 0, pa2); PK4(p1, 8, pa3);
#undef PK4
}
template <int KB, bool SK, bool BI = false>
__device__ __forceinline__ void qkt(f32x16& p0, f32x16& p1, const char* K_lds, int r32, int hi, const bf16x8* qr, bool act) {
    if (SK && !act) { const float NEG = -__builtin_inff();
#pragma unroll
        for (int r = 0; r < 16; ++r) { p0[r] = NEG; p1[r] = NEG; } return; }
    if (!BI) { p0 = f32x16{}; p1 = f32x16{}; }
    const char* kb[4];
#pragma unroll
    for (int dd = 0; dd < 4; ++dd) kb[dd] = K_lds + KB * SHM_K + KSWZ(r32, (dd * 16 + hi * 8) * 2);
#pragma unroll
    for (int d0 = 0; d0 < 8; ++d0) { const char* a = kb[d0 & 3] + (d0 >> 2) * 128;
        bf16x8 b0 = *reinterpret_cast<const bf16x8*>(a);
        bf16x8 b1 = *reinterpret_cast<const bf16x8*>(a + 32 * 256);
        p0 = __builtin_amdgcn_mfma_f32_32x32x16_bf16(b0, qr[d0], p0, 0, 0, 0);
        p1 = __builtin_amdgcn_mfma_f32_32x32x16_bf16(b1, qr[d0], p1, 0, 0, 0); }
}
template <int VB, bool SK, bool BI = false>
__device__ __forceinline__ void pv_tile(f32x16* o, int vb0, bf16x8 pa0, bf16x8 pa1, bf16x8 pa2, bf16x8 pa3, bool act, f32x16* bq0 = nullptr, f32x16* bq1 = nullptr, unsigned nlo = 0u, unsigned nup = 0u) {
    if (SK && !act) return;
#define TRRD(dst, off) asm volatile("ds_read_b64_tr_b16 %0, %1 offset:%2" : "=&v"(dst) : "v"(vb0), "i"(off) : "memory")
#define PV_D0(d0) do { s16x4 l0, l1, l2, l3, h0, h1, h2, h3; constexpr int b_ = VB * SHM_V + v_rd_off(d0, 0, 0);     \
        TRRD(l0, b_); TRRD(h0, b_ + 2048); TRRD(l1, b_ + 4096); TRRD(h1, b_ + 6144); TRRD(l2, b_ + 8192); TRRD(h2, b_ + 10240); TRRD(l3, b_ + 12288); TRRD(h3, b_ + 14336); \
        asm volatile("s_waitcnt lgkmcnt(0)" ::: "memory"); SBAR();                 \
        o[d0] = __builtin_amdgcn_mfma_f32_32x32x16_bf16(pa0, (bf16x8){l0[0], l0[1], l0[2], l0[3], h0[0], h0[1], h0[2], h0[3]}, o[d0], 0, 0, 0);   \
        o[d0] = __builtin_amdgcn_mfma_f32_32x32x16_bf16(pa1, (bf16x8){l1[0], l1[1], l1[2], l1[3], h1[0], h1[1], h1[2], h1[3]}, o[d0], 0, 0, 0);   \
        o[d0] = __builtin_amdgcn_mfma_f32_32x32x16_bf16(pa2, (bf16x8){l2[0], l2[1], l2[2], l2[3], h2[0], h2[1], h2[2], h2[3]}, o[d0], 0, 0, 0);   \
        o[d0] = __builtin_amdgcn_mfma_f32_32x32x16_bf16(pa3, (bf16x8){l3[0], l3[1], l3[2], l3[3], h3[0], h3[1], h3[2], h3[3]}, o[d0], 0, 0, 0); } while (0)
    PV_D0(0); if (BI) mask_bias_q<0>(*bq0, *bq1, nlo, nup); PV_D0(1); if (BI) mask_bias_q<1>(*bq0, *bq1, nlo, nup);
    PV_D0(2); if (BI) mask_bias_q<2>(*bq0, *bq1, nlo, nup); PV_D0(3); if (BI) mask_bias_q<3>(*bq0, *bq1, nlo, nup);
#undef PV_D0
#undef TRRD
}

template <class TIn, class TOut> struct BlockRef { const TIn* Q; const TIn* K; const TIn* V; TOut* O; const unsigned long long* M; int P0; };
template <class TIn> struct Seam {
    bf16x8 qr[8];
    bf16x8 st_v0, st_v1, st_k0, st_k1; f32x4 sf0, sf1, sf2, sf3;
    f32x4 tq[16];
};
__device__ __forceinline__ int swa_jlo(int, int) { return JLO; }
#define ROW(p, k0, rr) ((p) + (size_t)((k0) + (rr)) * KVS + sc)
#define VMW() asm volatile("s_waitcnt vmcnt(0)" ::: "memory")
#define VMWN(n) asm volatile("s_waitcnt vmcnt(%0)" :: "i"(n) : "memory")
#define SLOAD_H(Kp, Vp, k0) do { S.st_v0 = load8<TIn>(ROW(Vp, k0, sr)); S.st_v1 = load8<TIn>(ROW(Vp, k0, 32 + sr));              \
                         S.st_k0 = load8<TIn>(ROW(Kp, k0, sr)); S.st_k1 = load8<TIn>(ROW(Kp, k0, 32 + sr)); } while (0)
#define SWRITE_HK(bf) do { *(bf16x8*)(K_lds + (bf) * SHM_K + kws) = S.st_k0; *(bf16x8*)(K_lds + (bf) * SHM_K + kws + 32 * 256) = S.st_k1; } while (0)
#define SWRITE_HV(bf) do { *(bf16x8*)(V_lds + (bf) * SHM_V + vst0) = S.st_v0; *(bf16x8*)(V_lds + (bf) * SHM_V + vst1) = S.st_v1; } while (0)
#define SWRITE_H(bf) do { SWRITE_HV(bf); SWRITE_HK(bf); } while (0)
#define SLOAD_F(p, k0) do { S.sf0 = *(const f32x4*)ROW(p, k0, sr); S.sf1 = *(const f32x4*)(ROW(p, k0, sr) + 4);                \
                            S.sf2 = *(const f32x4*)ROW(p, k0, 32 + sr); S.sf3 = *(const f32x4*)(ROW(p, k0, 32 + sr) + 4); } while (0)
#define SWRITE_KF(bf) do { *(bf16x8*)(K_lds + (bf) * SHM_K + kws) = pack8(S.sf0, S.sf1); *(bf16x8*)(K_lds + (bf) * SHM_K + kws + 32 * 256) = pack8(S.sf2, S.sf3); } while (0)
#define SWRITE_VF(bf) do { *(bf16x8*)(V_lds + (bf) * SHM_V + vst0) = pack8(S.sf0, S.sf1); *(bf16x8*)(V_lds + (bf) * SHM_V + vst1) = pack8(S.sf2, S.sf3); } while (0)
template <class TIn, class TOut>
__device__ __forceinline__ void causal_swa_prime(const BlockRef<TIn, TOut>& cur, int W, char* lds, Seam<TIn>& S, int wv) {
    constexpr bool F32 = same_t<TIn, float>::v;
    int tid0_ = threadIdx.x; asm volatile("" : "+v"(tid0_)); (void)wv;
    const int tid = tid0_, wid = __builtin_amdgcn_readfirstlane(tid >> 6), lane = tid & 63, r32 = lane & 31, hi = lane >> 5;
    const int sr = tid >> 4, sc = (tid & 15) * 8, kws = KSWZ(sr, sc * 2); char* K_lds = lds + 2 * SHM_V;
    const int kb0 = swa_jlo(cur.P0, W) * KVBLK;
    for (int d0 = 0; d0 < 8; ++d0) S.qr[d0] = load8<TIn>(cur.Q + (size_t)(wid * QBLK + r32) * QST + d0 * 16 + hi * 8);
    if constexpr (F32) { SLOAD_F((const float*)cur.K, kb0); VMW(); SWRITE_KF(0); SBAR(); SLOAD_F((const float*)cur.V, kb0); }
    else { SLOAD_H(cur.K, cur.V, kb0); VMW(); SWRITE_HK(0); }
    __syncthreads();
}
struct NoHost { __device__ __forceinline__ void issue() {} __device__ __forceinline__ void finish() {} };
template <class TIn, class TOut, int VAR = 0, class HT = NoHost>
__device__ __forceinline__ void causal_swa_block(const BlockRef<TIn, TOut>& cur, const BlockRef<TIn, TOut>& nxt, int skv, int W, char* lds, Seam<TIn>& S, int wv, HT& H) {
    constexpr bool F32 = same_t<TIn, float>::v;
    int tid0_ = threadIdx.x; asm volatile("" : "+v"(tid0_)); (void)wv;
    const int tid = tid0_, wid = __builtin_amdgcn_readfirstlane(tid >> 6), lane = tid & 63, r32 = lane & 31, hi = lane >> 5;
    const int j_lo = swa_jlo(cur.P0, W);
    int j_hi = (cur.P0 + QB - 1) / KVBLK + 1; if (j_hi > skv / KVBLK) j_hi = skv / KVBLK;
    const int NT = j_hi - j_lo;
    const int kbn = swa_jlo(nxt.P0, W) * KVBLK;
    const int qlo = cur.P0 + wid * QBLK; (void)qlo;
    const unsigned long long* mrow = cur.M + (size_t)(wid * QBLK + r32) * MTW;
    const int qm_unused = 0; (void)qm_unused;
    char* V_lds = lds; char* K_lds = lds + 2 * SHM_V;
    float* ws = (float*)(lds + 2 * SHM_V + 2 * SHM_K) + wid * 64; float* li_l = ws, * al_l = ws + 32;
    float m_reg = -1e30f, l_reg = 0; f32x16 o[4] = {};
    const int sr = tid >> 4, sc = (tid & 15) * 8, vst0 = v_st(sr, sc), vst1 = v_st(32 + sr, sc), kws = KSWZ(sr, sc * 2);
    const int vb0 = (int)(uintptr_t)V_lds + v_rd_base(lane);
    const TIn* Kh = cur.K; const TIn* Vh = cur.V;
#define RESC(a) do { if (__any((a) < 1.f)) { if (hi == 0) al_l[r32] = (a); asm volatile("s_waitcnt lgkmcnt(0)" ::: "memory");              \
                     for (int d_ = 0; d_ < 4; ++d_) for (int r = 0; r < 16; ++r) o[d_][r] *= al_l[crow(r, hi)]; } } while (0)
#define KBASE(t) ((j_lo + (t)) * KVBLK)
#define ACT(t) (KBASE(t) <= qlo + QBLK - 1 && KBASE(t) + KVBLK - 1 >= qlo - W + 1)
#define MASKT(P0_, P1_, t) do { if constexpr (VAR == 3) mask_bits(P0_, P1_, (((t) & 1) ? mwB : mwA), hi); else if constexpr (VAR == 2) { unsigned long long m_ = (((t) & 1) ? mwB : mwA); asm volatile("" :: "v"(m_)); } } while (0)
#define MWLOAD(t) do { const int tt_ = (t) < NT ? (t) : NT - 1; if ((t) & 1) mwB = mrow[j_lo + tt_]; else mwA = mrow[j_lo + tt_]; } while (0)
    constexpr int NQL = F32 ? 16 : 8;
    constexpr bool BI = (VAR == 0);
    constexpr bool SK = WSKIP && !F32;
#define SEAM_K0() do { VMWN(NQL); if constexpr (F32) { SWRITE_KF(0); SBAR(); SLOAD_F((const float*)nxt.V, kbn); } else { SWRITE_HK(0); } SBAR(); } while (0)
    f32x16 pA0, pA1, pB0, pB1; float mnA, mnB, alA, alB; bf16x8 pa0, pa1, pa2, pa3;
    unsigned long long mwA = mrow[j_lo], mwB = mrow[j_lo + (NT > 1 ? 1 : 0)];
    if constexpr (F32) { VMW(); SWRITE_VF(0); SBAR(); } else { SWRITE_HV(0); SBAR(); }
    if (NT > 1) { if constexpr (F32) SLOAD_F((const float*)Kh, KBASE(1)); else SLOAD_H(Kh, Vh, KBASE(1)); }
    if constexpr (BI) { mask_bias(pA0, pA1, mwA, hi); MWLOAD(2); }
    SBAR(); qkt<0, SK, BI>(pA0, pA1, K_lds, r32, hi, S.qr, ACT(0));
    if constexpr (BI) mask_bias(pB0, pB1, mwB, hi);
    if constexpr (F32) { if (NT > 1) { VMW(); SWRITE_KF(1); SBAR(); SLOAD_F((const float*)Vh, KBASE(1)); } }
    MASKT(pA0, pA1, 0); partialSM(pA0, pA1, m_reg, mnA, alA);
    if (NT > 1) { VMW(); if constexpr (F32) { SWRITE_VF(1); SBAR(); if (NT > 2) SLOAD_F((const float*)Kh, KBASE(2)); } else SWRITE_H(1); }
    __syncthreads();
#define HALF_STEP(PX0, PX1, mnX, alX, PY0, PY1, alY, t, KB, VB, SB) do {                                                      \
        H.issue(); if constexpr (BI) MWLOAD((t) + 2); else MWLOAD((t) + 1);                                               \
        SBAR(); qkt<KB, SK, BI>(PX0, PX1, K_lds, r32, hi, S.qr, ACT(t));                                                  \
        finishSM(PY0, PY1, alY, l_reg, pa0, pa1, pa2, pa3); SBAR();                                                           \
        if ((t) + 1 < NT) { if constexpr (F32) { VMW(); SWRITE_KF(SB); SBAR(); SLOAD_F((const float*)Vh, KBASE((t) + 1)); }  \
                            else { SLOAD_H(Kh, Vh, KBASE((t) + 1)); } SBAR(); }                                               \
        { const unsigned long long mwn_ = (((t) + 1) & 1) ? mwB : mwA; const unsigned nlo_ = ~(unsigned)(mwn_ >> (4 * hi)), nup_ = ~(unsigned)(mwn_ >> (32 + 4 * hi));   \
          pv_tile<VB, SK, BI>(o, vb0, pa0, pa1, pa2, pa3, ACT((t) - 1), &PY0, &PY1, nlo_, nup_); }                           \
        MASKT(PX0, PX1, (t)); partialSM(PX0, PX1, m_reg, mnX, alX);                                        \
        __syncthreads();                                                                                                      \
        if ((t) + 1 < NT) { VMW(); if constexpr (F32) { SWRITE_VF(SB); SBAR(); if ((t) + 2 < NT) SLOAD_F((const float*)Kh, KBASE((t) + 2)); } \
                            else { SWRITE_H(SB); } }                                                                          \
        H.finish(); RESC(alX); __syncthreads(); } while (0)
    for (int t = 1; t + 1 < NT; t += 2) {
        HALF_STEP(pB0, pB1, mnB, alB, pA0, pA1, alA, t, 1, 0, 0);
        HALF_STEP(pA0, pA1, mnA, alA, pB0, pB1, alB, t + 1, 0, 1, 1);
    }
    const bool even = (NT & 1) == 0;
    if (even) { SBAR(); qkt<1, SK, BI>(pB0, pB1, K_lds, r32, hi, S.qr, ACT(NT - 1)); SBAR(); }
#define QROW(e) (nxt.Q + (size_t)(wid * QBLK + r32) * QST + ((e) >> 1) * 16 + hi * 8 + ((e) & 1) * 4)
    if constexpr (F32) { SLOAD_F((const float*)nxt.K, kbn); SBAR();
#pragma unroll
        for (int e = 0; e < 8; ++e) S.tq[e] = *(const f32x4*)QROW(e); }
    else { SLOAD_H(nxt.K, nxt.V, kbn); SBAR();
#pragma unroll
        for (int d0 = 0; d0 < 8; ++d0) S.qr[d0] = load8<TIn>(nxt.Q + (size_t)(wid * QBLK + r32) * QST + d0 * 16 + hi * 8); }
    SBAR();
    finishSM(pA0, pA1, alA, l_reg, pa0, pa1, pa2, pa3); SBAR();
    if constexpr (F32) {
#pragma unroll
        for (int e = 8; e < 16; ++e) S.tq[e] = *(const f32x4*)QROW(e); SBAR(); }
#undef QROW
    pv_tile<0, SK>(o, vb0, pa0, pa1, pa2, pa3, ACT(even ? NT - 2 : NT - 1));
    if (even) { MASKT(pB0, pB1, NT - 1); partialSM(pB0, pB1, m_reg, mnB, alB); __syncthreads(); RESC(alB);
        finishSM(pB0, pB1, alB, l_reg, pa0, pa1, pa2, pa3); SBAR(); pv_tile<1, SK>(o, vb0, pa0, pa1, pa2, pa3, ACT(NT - 1)); }
    SBAR(); SEAM_K0();
    if (hi == 0) li_l[r32] = l_reg; asm volatile("s_waitcnt lgkmcnt(0)" ::: "memory");
    float rli[16];
#pragma unroll
    for (int r = 0; r < 16; ++r) rli[r] = __builtin_amdgcn_rcpf(li_l[crow(r, hi)]);
    TOut* Ow = cur.O + (size_t)(wid * QBLK) * OST;
#pragma unroll
    for (int r = 0; r < 16; ++r) { const int orow = crow(r, hi);
#pragma unroll
        for (int d0 = 0; d0 < 4; ++d0) { const float v = o[d0][r] * rli[r];
            if constexpr (same_t<TOut, float>::v) { Ow[(size_t)orow * OST + d0 * 32 + r32] = v; }
            else { const float vn = __shfl_xor(v, 1);
                   if ((r32 & 1) == 0) *(unsigned*)(Ow + (size_t)orow * OST + d0 * 32 + r32) = cvtpk(v, vn); } } }
    if constexpr (F32) {
#pragma unroll
        for (int d0 = 0; d0 < 8; ++d0) S.qr[d0] = pack8(S.tq[2 * d0], S.tq[2 * d0 + 1]); }
    __syncthreads();
#undef RESC
#undef KBASE
#undef ACT
#undef MASKT
#undef MWLOAD
#undef SEAM_K0
#undef HALF_STEP
}
#undef ROW
#undef VMW
#undef VMWN
#undef SLOAD_H
#undef SWRITE_HK
#undef SWRITE_HV
#undef SWRITE_H
#undef SLOAD_F
#undef SWRITE_KF
#undef SWRITE_VF

}

constexpr int NWAVES = 8, NTHREADS = 512;
constexpr int DM = 2048, SEQ = 4096, NMETA = 16, TP = 4112, NBP = 2, SBN = 8, PAST = 16384, NPG = 128;
constexpr int XROW0 = 8192, SROW0 = 8224, NROWS = 8232, MPAD = 8448, FF = 8192, MAINM = 8192, XR = 48;
constexpr int NA_IN = 6144, NB_IN = 4176, NB_PAD = 4352, NC_IN = 12352, NC_PAD = 12544, DVW = 4096, CDIM = 8192;
constexpr float ALPHA = 1.6817928305074292f;
constexpr float LN_EPS = 1e-5f, RMS_EPS = 1e-6f;
constexpr int SCW = 4160, SCSW = 16448, KIROWS = 4128, NSKEY = PAST + 1;
constexpr int POS_SAMPLE_IDX = TP;

constexpr size_t O_YP = 0, O_YS = O_YP + (size_t)NBP * SEQ * DM, O_CAP = O_YS + (size_t)SBN * DM, O_CAS = O_CAP + 2 * NBP * 2 * DM,
                 O_KP = O_CAS + 2 * SBN * 2 * DM, O_VP = O_KP + (size_t)NBP * TP * 512, O_IKP = O_VP + (size_t)NBP * TP * 512,
                 O_KS = O_IKP + (size_t)NBP * TP * 64, O_VS = O_KS + SBN * 512, O_IKS = O_VS + SBN * 512, O_CCP = O_IKS + SBN * 64,
                 O_CCS = O_CCP + (size_t)NBP * 3 * CDIM, O_DP = O_CCS + (size_t)SBN * 3 * CDIM, O_DS = O_DP + (size_t)NBP * 32 * 128 * 128,
                 O_END = O_DS + (size_t)SBN * 32 * 128 * 128;

constexpr size_t MiB = 1u << 20;
constexpr size_t WS_CTL = 0, CTL_ZERO_BYTES = 1 * MiB;
constexpr size_t WS_TAB128 = 1 * MiB, WS_TAB64 = 4 * MiB, WS_WI = 6 * MiB, WS_G = 7 * MiB, WS_BETA = 9 * MiB, WS_CNT = 11 * MiB, WS_KIB = 12 * MiB,
                 WS_SCS = 14 * MiB, WS_IDXL = 16 * MiB, WS_X = 26 * MiB, WS_QR = 60 * MiB, WS_QI = 94 * MiB, WS_Z = 112 * MiB, WS_Y = 180 * MiB,
                 WS_BIG = 248 * MiB, WS_QKVC = 452 * MiB, WS_SC = 584 * MiB, WS_W = 716 * MiB;
constexpr size_t WSZ_A_IN = (size_t)NA_IN * DM * 2, WSZ_A_OUT = (size_t)DM * DM * 2, WSZ_B_IN = (size_t)NB_PAD * DM * 2, WSZ_B_OUT = (size_t)DM * DM * 2,
                 WSZ_C_IN = (size_t)NC_PAD * DM * 2, WSZ_C_OUT = (size_t)DM * DVW * 2, WSZ_W1 = (size_t)FF * DM * 2, WSZ_W2 = (size_t)DM * FF * 2;
constexpr size_t WS_WA_IN = WS_W, WS_WA_OUT = WS_WA_IN + 2 * WSZ_A_IN, WS_WB_IN = WS_WA_OUT + 2 * WSZ_A_OUT, WS_WB_OUT = WS_WB_IN + WSZ_B_IN,
                 WS_WC_IN = WS_WB_OUT + WSZ_B_OUT, WS_WC_OUT = WS_WC_IN + WSZ_C_IN, WS_W1 = WS_WC_OUT + WSZ_C_OUT, WS_W2 = WS_W1 + 4 * WSZ_W1,
                 WS_ZP = WS_W2 + 4 * WSZ_W2, WS_QKF = WS_ZP + 4 * MiB, WS_DWG = WS_QKF + 130 * MiB, WS_DUG = WS_DWG + 66 * MiB, WS_END = WS_DUG + 66 * MiB;
constexpr size_t WS_MASK = WS_IDXL, WS_KS = WS_Z, WS_VS = WS_Z + 9 * MiB;
constexpr size_t WS_DAF = WS_Z, WS_DTG = WS_Y, WS_DTB = WS_Y + 33 * MiB, WS_DPG = WS_QR, WS_DKT = WS_QKF, WS_DVT = WS_QKF + 33 * MiB, WS_DGC = WS_QI, WS_DBT = WS_QI + 2 * MiB;
constexpr int SP = 4352, SPAD = 240, MTW = 68;
constexpr int CW_BAR = 4096;

constexpr int RING_BYTES = 131072, LDSCTL_OFF = RING_BYTES, MISC_OFF = LDSCTL_OFF + 320, LDS_BYTES = 147456;

typedef unsigned short bf16;
typedef unsigned v4u __attribute__((ext_vector_type(4)));
typedef unsigned v2u __attribute__((ext_vector_type(2)));
typedef float f32x4 __attribute__((ext_vector_type(4)));
typedef float f32x2 __attribute__((ext_vector_type(2)));
typedef short bf16x8 __attribute__((ext_vector_type(8)));
typedef float f32x16 __attribute__((ext_vector_type(16)));
typedef __bf16 bf16x2_t __attribute__((ext_vector_type(2)));

#define LDS_WAIT() asm volatile("s_waitcnt lgkmcnt(0)" ::: "memory")
#define WAVE_SYNC() do { asm volatile("s_waitcnt lgkmcnt(0)" ::: "memory"); __builtin_amdgcn_wave_barrier(); } while (0)

__device__ __forceinline__ float bflo(unsigned w) { return __uint_as_float(w << 16); }
__device__ __forceinline__ float bfhi(unsigned w) { return __uint_as_float(w & 0xffff0000u); }
__device__ __forceinline__ float bf2f(bf16 h) { return __uint_as_float((unsigned)h << 16); }
__device__ __forceinline__ unsigned pk2(float lo, float hi) { f32x2 v = {lo, hi}; bf16x2_t b = __builtin_convertvector(v, bf16x2_t); return __builtin_bit_cast(unsigned, b); }
__device__ __forceinline__ bf16 f2bf(float f) { return (bf16)(pk2(f, 0.f) & 0xffffu); }
__device__ __forceinline__ float wave_sum(float v) {
#pragma unroll
    for (int o = 1; o < 64; o <<= 1) v += __shfl_xor(v, o);
    return v;
}
__device__ __forceinline__ float wave_max(float v) {
#pragma unroll
    for (int o = 1; o < 64; o <<= 1) v = fmaxf(v, __shfl_xor(v, o));
    return v;
}
__device__ __forceinline__ int wave_sum_i(int v) {
#pragma unroll
    for (int o = 1; o < 64; o <<= 1) v += __shfl_xor(v, o);
    return v;
}
__device__ __forceinline__ float wave_sum_dpp(float v) {
    v += __int_as_float(__builtin_amdgcn_update_dpp(0, __float_as_int(v), 0x128, 0xf, 0xf, false));
    v += __int_as_float(__builtin_amdgcn_update_dpp(0, __float_as_int(v), 0x124, 0xf, 0xf, false));
    v += __int_as_float(__builtin_amdgcn_update_dpp(0, __float_as_int(v), 0x122, 0xf, 0xf, false));
    v += __int_as_float(__builtin_amdgcn_update_dpp(0, __float_as_int(v), 0x121, 0xf, 0xf, false));
    const int iv = __float_as_int(v);
    return (__int_as_float(__builtin_amdgcn_readlane(iv, 0)) + __int_as_float(__builtin_amdgcn_readlane(iv, 16))) + (__int_as_float(__builtin_amdgcn_readlane(iv, 32)) + __int_as_float(__builtin_amdgcn_readlane(iv, 48)));
}
__device__ __forceinline__ int wave_sum_dpp_i(int v) {
    v += __builtin_amdgcn_update_dpp(0, v, 0x128, 0xf, 0xf, false);
    v += __builtin_amdgcn_update_dpp(0, v, 0x124, 0xf, 0xf, false);
    v += __builtin_amdgcn_update_dpp(0, v, 0x122, 0xf, 0xf, false);
    v += __builtin_amdgcn_update_dpp(0, v, 0x121, 0xf, 0xf, false);
    return __builtin_amdgcn_readlane(v, 0) + __builtin_amdgcn_readlane(v, 16) + __builtin_amdgcn_readlane(v, 32) + __builtin_amdgcn_readlane(v, 48);
}
__device__ __forceinline__ float row16_sum(float v) {
    v += __int_as_float(__builtin_amdgcn_update_dpp(0, __float_as_int(v), 0x128, 0xf, 0xf, false));
    v += __int_as_float(__builtin_amdgcn_update_dpp(0, __float_as_int(v), 0x124, 0xf, 0xf, false));
    v += __int_as_float(__builtin_amdgcn_update_dpp(0, __float_as_int(v), 0x122, 0xf, 0xf, false));
    v += __int_as_float(__builtin_amdgcn_update_dpp(0, __float_as_int(v), 0x121, 0xf, 0xf, false));
    return v;
}
__device__ __forceinline__ float silu_f(float x) { return x / (1.f + __expf(-x)); }
__device__ __forceinline__ int prow(int b, int t) { return t >= NMETA ? b * SEQ + (t - NMETA) : XROW0 + b * NMETA + t; }
__device__ __forceinline__ void row_bt(int r, int& b, int& t) { if (r < XROW0) { b = r >> 12; t = (r & 4095) + NMETA; } else { b = (r - XROW0) >> 4; t = (r - XROW0) & 15; } }
__device__ __forceinline__ void unpack8(const v4u w, float (&f)[8]) {
    f[0] = bflo(w.x); f[1] = bfhi(w.x); f[2] = bflo(w.y); f[3] = bfhi(w.y); f[4] = bflo(w.z); f[5] = bfhi(w.z); f[6] = bflo(w.w); f[7] = bfhi(w.w);
}
__device__ __forceinline__ v4u pack8(const float (&f)[8]) { v4u w; w.x = pk2(f[0], f[1]); w.y = pk2(f[2], f[3]); w.z = pk2(f[4], f[5]); w.w = pk2(f[6], f[7]); return w; }

struct TrJob { bf16* WT; int K, k0, n0; bool ok, valid; };
__device__ __forceinline__ void tr_issue(const float* W, int K, int N, int Npad, bf16* WT, int item, int lane, float (&wv_)[32], TrJob& J) {
    const int nblk = Npad / 32, kb = item / nblk, nb = item % nblk, k0 = 64 * kb, n0 = 32 * nb;
    const int n = n0 + (lane & 31); const bool ok = n < N;
#pragma unroll
    for (int i = 0; i < 32; ++i) { const int kk = 2 * i + (lane >> 5); wv_[i] = W[(size_t)(k0 + kk) * N + (ok ? n : N - 1)]; }
    J.WT = WT; J.K = K; J.k0 = k0; J.n0 = n0; J.ok = ok; J.valid = true;
}
__device__ __forceinline__ void tr_finish(const float (&wv_)[32], const TrJob& J, LAS float* scr, int lane) {
#pragma unroll
    for (int i = 0; i < 32; ++i) { const int kk = 2 * i + (lane >> 5); scr[kk * 33 + (lane & 31)] = J.ok ? wv_[i] : 0.f; }
    LDS_WAIT(); __builtin_amdgcn_wave_barrier();
    const int c = lane & 7;
#pragma unroll
    for (int j = 0; j < 4; ++j) { const int nn = (lane >> 3) + 8 * j; const LAS float* sp = scr + (8 * c) * 33 + nn;
        v4u o; o.x = pk2(sp[0 * 33], sp[1 * 33]); o.y = pk2(sp[2 * 33], sp[3 * 33]); o.z = pk2(sp[4 * 33], sp[5 * 33]); o.w = pk2(sp[6 * 33], sp[7 * 33]);
        *(v4u*)(J.WT + (size_t)(J.n0 + nn) * J.K + J.k0 + 8 * c) = o; }
    LDS_WAIT(); __builtin_amdgcn_wave_barrier();
}
__device__ __forceinline__ void transpose_item(const float* W, int K, int N, int Npad, bf16* WT, LAS float* scr, int item, int lane) {
    float wv_[32]; TrJob J; tr_issue(W, K, N, Npad, WT, item, lane, wv_, J); tr_finish(wv_, J, scr, lane);
}

struct Ptrs {
    const float *x_prompt, *x_sample, *state_conv_a, *cache_k, *cache_v, *cache_ik, *state_conv_c, *state_delta;
    const int* page_table;
    const float *meta, *w_in_a, *conv_w_a, *w_out_a, *w_in_b, *w_out_b, *w_in_c, *conv_w_c, *a_log, *dt_bias, *norm_w, *w_out_c, *ln1_g, *ln1_b, *w1, *w2, *ln2_g, *ln2_b;
    float* out; unsigned char* ws;
};

__device__ __forceinline__ void p0_prologue(const Ptrs& P, LAS unsigned char* lds, int gw, int NGW, int wave, int lane) {
    LAS float* scr = (LAS float*)(lds + wave * 16384);
    unsigned char* ws = P.ws;
    constexpr int I_A_IN = (DM / 64) * (NA_IN / 32), I_A_OUT = (DM / 64) * (DM / 32), I_B_IN = (DM / 64) * (NB_PAD / 32), I_B_OUT = I_A_OUT,
                  I_C_IN = (DM / 64) * (NC_PAD / 32), I_C_OUT = (DVW / 64) * (DM / 32), I_W1 = (DM / 64) * (FF / 32), I_W2 = (FF / 64) * (DM / 32);
    constexpr int NITEMS = I_A_IN + I_A_OUT + I_B_IN + I_W1 + I_W2;
#define TR_(cnt, Wp, Kk, Nn, Np, WTp) if (r < (cnt)) { transpose_item((Wp), (Kk), (Nn), (Np), (bf16*)(WTp), scr, r, lane); continue; } r -= (cnt);
    for (int it = gw; it < NITEMS; it += NGW) {
        int r = it;
        TR_(I_A_IN, P.w_in_a, DM, NA_IN, NA_IN, ws + WS_WA_IN)
        TR_(I_A_OUT, P.w_out_a, DM, DM, DM, ws + WS_WA_OUT)
        TR_(I_B_IN, P.w_in_b, DM, NB_IN, NB_PAD, ws + WS_WB_IN)
        TR_(I_W1, P.w1, DM, FF, FF, ws + WS_W1)
        transpose_item(P.w2, FF, DM, DM, (bf16*)(ws + WS_W2), scr, r, lane);
    }
#undef TR_
    bf16* X = (bf16*)(ws + WS_X);
    for (int r = gw; r < MPAD; r += NGW) {
        const float* src = nullptr;
        if (r < XROW0) src = P.x_prompt + (size_t)r * DM;
        else if (r < SROW0) src = P.meta + (size_t)((r - XROW0) & 15) * DM;
        else if (r < NROWS) src = P.x_sample + (size_t)(r - SROW0) * DM;
#pragma unroll
        for (int j = 0; j < 4; ++j) { const int c = 512 * j + 8 * lane; v4u o = {0u, 0u, 0u, 0u};
            if (src) { const f32x4 a = *(const f32x4*)(src + c), b = *(const f32x4*)(src + c + 4); o.x = pk2(a.x, a.y); o.y = pk2(a.z, a.w); o.z = pk2(b.x, b.y); o.w = pk2(b.z, b.w); }
            *(v4u*)(X + (size_t)r * DM + c) = o; }
    }
    f32x2* t128 = (f32x2*)(ws + WS_TAB128); f32x2* t64 = (f32x2*)(ws + WS_TAB64);
    const int gt = gw * 64 + lane, NGT = NGW * 64;
    for (int e = gt; e < (TP + 1) * 96; e += NGT) {
        const int pi = e / 96, i = e % 96; const float pos = (float)(pi == TP ? PAST : pi);
        const float ex = (i < 64) ? (float)(2 * i) * (1.f / 128.f) : (float)(2 * (i - 64)) * (1.f / 64.f);
        const float inv = __builtin_amdgcn_exp2f(-ex * 13.287712379549449f);
        const float angf = pos * inv;
        double rev = (double)angf * 0.15915494309189535; rev -= __builtin_rint(rev);
        const float rf = (float)rev; const float sn = __builtin_amdgcn_sinf(rf), cs = __builtin_amdgcn_cosf(rf);
        if (i < 64) t128[pi * 64 + i] = (f32x2){cs, sn}; else t64[pi * 32 + (i - 64)] = (f32x2){cs, sn};
    }
}

constexpr int NHOSTED = (DM / 64) * (DM / 32) + (DM / 64) * (FF / 32) + (FF / 64) * (DM / 32) + (DM / 64) * (NC_PAD / 32);
__device__ __forceinline__ void hosted_issue(const Ptrs& P, int it, int lane, float (&wv_)[32], TrJob& J) {
    unsigned char* ws = P.ws;
    constexpr int I_B_OUT = (DM / 64) * (DM / 32), I_C_IN = (DM / 64) * (NC_PAD / 32), I_W1 = (DM / 64) * (FF / 32), I_W2 = (FF / 64) * (DM / 32);
    J.valid = false;
    if (it >= NHOSTED) return;
    int r = it;
    if (r < I_B_OUT) { tr_issue(P.w_out_b, DM, DM, DM, (bf16*)(ws + WS_WB_OUT), r, lane, wv_, J); return; } r -= I_B_OUT;
    if (r < I_W1) { tr_issue(P.w1 + (size_t)DM * FF, DM, FF, FF, (bf16*)(ws + WS_W1 + WSZ_W1), r, lane, wv_, J); return; } r -= I_W1;
    if (r < I_W2) { tr_issue(P.w2 + (size_t)DM * FF, FF, DM, DM, (bf16*)(ws + WS_W2 + WSZ_W2), r, lane, wv_, J); return; } r -= I_W2;
    (void)I_C_IN; tr_issue(P.w_in_c, DM, NC_IN, NC_PAD, (bf16*)(ws + WS_WC_IN), r, lane, wv_, J);
}
__device__ __forceinline__ void deferred_transposes(const Ptrs& P, LAS unsigned char* lds, int idx, int stride, int wave, int lane) {
    LAS float* scr = (LAS float*)(lds + wave * 16384);
    unsigned char* ws = P.ws;
    constexpr int I_A_IN = (DM / 64) * (NA_IN / 32), I_A_OUT = (DM / 64) * (DM / 32), I_C_OUT = (DVW / 64) * (DM / 32), I_W1 = (DM / 64) * (FF / 32), I_W2 = (FF / 64) * (DM / 32);
    constexpr int NITEMS = I_C_OUT + I_W1 + I_W2; (void)I_A_IN; (void)I_A_OUT;
#define TR_(cnt, Wp, Kk, Nn, Np, WTp) if (r < (cnt)) { transpose_item((Wp), (Kk), (Nn), (Np), (bf16*)(WTp), scr, r, lane); continue; } r -= (cnt);
    for (int it = idx; it < NITEMS; it += stride) {
        int r = it;
        TR_(I_C_OUT, P.w_out_c, DVW, DM, DM, ws + WS_WC_OUT)
        TR_(I_W1, P.w1 + 2 * (size_t)DM * FF, DM, FF, FF, ws + WS_W1 + 2 * WSZ_W1)
        transpose_item(P.w2 + 2 * (size_t)DM * FF, FF, DM, DM, (bf16*)(ws + WS_W2 + 2 * WSZ_W2), scr, r, lane);
    }
#undef TR_
}

__device__ __forceinline__ void ln_row_finish(float (&v)[32], float s, const f32x4 (&gq)[8], const f32x4 (&bq_)[8], bf16* xo, float* of, int lane) {
    const float mean = wave_sum_dpp(s) * (1.f / DM); float s2 = 0.f;
#pragma unroll
    for (int i = 0; i < 32; ++i) { v[i] -= mean; s2 += v[i] * v[i]; }
    const float rstd = 1.f / sqrtf(wave_sum_dpp(s2) * (1.f / DM) + LN_EPS);
#pragma unroll
    for (int j = 0; j < 4; ++j) { const int c = 512 * j + 8 * lane; const f32x4 g0 = gq[2 * j], g1 = gq[2 * j + 1], b0 = bq_[2 * j], b1 = bq_[2 * j + 1];
        float o[8];
        o[0] = v[8 * j + 0] * rstd * g0.x + b0.x; o[1] = v[8 * j + 1] * rstd * g0.y + b0.y; o[2] = v[8 * j + 2] * rstd * g0.z + b0.z; o[3] = v[8 * j + 3] * rstd * g0.w + b0.w;
        o[4] = v[8 * j + 4] * rstd * g1.x + b1.x; o[5] = v[8 * j + 5] * rstd * g1.y + b1.y; o[6] = v[8 * j + 6] * rstd * g1.z + b1.z; o[7] = v[8 * j + 7] * rstd * g1.w + b1.w;
        *(v4u*)(xo + c) = pack8(o);
        if (of) { *(f32x4*)(of + c) = (f32x4){o[0], o[1], o[2], o[3]}; *(f32x4*)(of + c + 4) = (f32x4){o[4], o[5], o[6], o[7]}; } }
}
__device__ __forceinline__ void ln_phase(const float* Z, const float* ZP, bf16* X, bf16* Xo, const float* gam, const float* bet, float* yp, float* ys, LAS unsigned char* lds, int gw, int NGW, int tid, int wave, int lane) {
    (void)Z;
    LAS float* red = (LAS float*)lds;
    for (int xr = blockIdx.x; xr < NROWS - XROW0; xr += gridDim.x) {
        const int r = XROW0 + xr, c = 256 * wave + 4 * lane;
        const v2u xv = *(const v2u*)(X + (size_t)r * DM + c);
        const float* zr = ZP + (size_t)xr * DM + c; f32x4 z = *(const f32x4*)zr;
#pragma unroll
        for (int sl = 1; sl < 8; ++sl) z += *(const f32x4*)(zr + (size_t)sl * XR * DM);
        float v4[4] = {ALPHA * bflo(xv.x) + z.x, ALPHA * bfhi(xv.x) + z.y, ALPHA * bflo(xv.y) + z.z, ALPHA * bfhi(xv.y) + z.w};
        const float ps = wave_sum_dpp((v4[0] + v4[1]) + (v4[2] + v4[3]));
        __syncthreads();
        if (lane == 0) red[wave] = ps;
        __syncthreads();
        float tot = 0.f;
#pragma unroll
        for (int w = 0; w < 8; ++w) tot += red[w];
        const float mean = tot * (1.f / DM); float q2 = 0.f;
#pragma unroll
        for (int i = 0; i < 4; ++i) { v4[i] -= mean; q2 += v4[i] * v4[i]; }
        const float pq = wave_sum_dpp(q2);
        if (lane == 0) red[8 + wave] = pq;
        __syncthreads();
        float tq = 0.f;
#pragma unroll
        for (int w = 0; w < 8; ++w) tq += red[8 + w];
        const float rstd = 1.f / sqrtf(tq * (1.f / DM) + LN_EPS);
        const f32x4 g = *(const f32x4*)(gam + c), be = *(const f32x4*)(bet + c);
        const float o0 = v4[0] * rstd * g.x + be.x, o1 = v4[1] * rstd * g.y + be.y, o2 = v4[2] * rstd * g.z + be.z, o3 = v4[3] * rstd * g.w + be.w;
        v2u ov; ov.x = pk2(o0, o1); ov.y = pk2(o2, o3); *(v2u*)(Xo + (size_t)r * DM + c) = ov;
        if (ys && r >= SROW0) *(f32x4*)(ys + (size_t)(r - SROW0) * DM + c) = (f32x4){o0, o1, o2, o3};
    }
    f32x4 gq[8], bq_[8];
#pragma unroll
    for (int j = 0; j < 4; ++j) { const int c = 512 * j + 8 * lane; gq[2 * j] = *(const f32x4*)(gam + c); gq[2 * j + 1] = *(const f32x4*)(gam + c + 4); bq_[2 * j] = *(const f32x4*)(bet + c); bq_[2 * j + 1] = *(const f32x4*)(bet + c + 4); }
    for (int r = gw; r < XROW0; r += 2 * NGW) {
        const int r2 = r + NGW; const bool two = r2 < XROW0;
        v4u xa[4], xb[4];
#pragma unroll
        for (int j = 0; j < 4; ++j) { const int c = 512 * j + 8 * lane; xa[j] = *(const v4u*)(X + (size_t)r * DM + c); xb[j] = *(const v4u*)(X + (size_t)(two ? r2 : r) * DM + c); }
        float va[32], vb[32]; float sa = 0.f, sb = 0.f;
#pragma unroll
        for (int j = 0; j < 4; ++j) { float t8[8]; unpack8(xa[j], t8);
#pragma unroll
            for (int i = 0; i < 8; ++i) { va[8 * j + i] = t8[i]; sa += t8[i]; }
            unpack8(xb[j], t8);
#pragma unroll
            for (int i = 0; i < 8; ++i) { vb[8 * j + i] = t8[i]; sb += t8[i]; } }
        ln_row_finish(va, sa, gq, bq_, Xo + (size_t)r * DM, yp ? yp + (size_t)r * DM : nullptr, lane);
        if (two) ln_row_finish(vb, sb, gq, bq_, Xo + (size_t)r2 * DM, yp ? yp + (size_t)r2 * DM : nullptr, lane);
    }
}

__device__ __forceinline__ void load_u(const bf16* BCH, int row, int c0, float (&u)[8]) {
    const v4u cg = *(const v4u*)(BCH + (size_t)row * NA_IN + DM + c0), hh = *(const v4u*)(BCH + (size_t)row * NA_IN + 2 * DM + c0);
    float a[8], b[8]; unpack8(cg, a); unpack8(hh, b);
#pragma unroll
    for (int i = 0; i < 8; ++i) u[i] = a[i] * b[i];
}
__device__ __forceinline__ void convA_phase(const bf16* BCH, bf16* Y, const float* cw, const float* hist, float* outp, float* outs, int gtid, int NT) {
    constexpr int RUN = 8, NRUN = SEQ / RUN;
    for (int it = gtid; it < (NBP * NRUN + NBP * NMETA + SBN) * 256; it += NT) {
        const int c0 = (it & 255) * 8, ru = it >> 8;
        float w0[8], w1[8], w2[8];
        { const f32x4 a = *(const f32x4*)(cw + c0), b = *(const f32x4*)(cw + c0 + 4); w0[0] = a.x; w0[1] = a.y; w0[2] = a.z; w0[3] = a.w; w0[4] = b.x; w0[5] = b.y; w0[6] = b.z; w0[7] = b.w; }
        { const f32x4 a = *(const f32x4*)(cw + DM + c0), b = *(const f32x4*)(cw + DM + c0 + 4); w1[0] = a.x; w1[1] = a.y; w1[2] = a.z; w1[3] = a.w; w1[4] = b.x; w1[5] = b.y; w1[6] = b.z; w1[7] = b.w; }
        { const f32x4 a = *(const f32x4*)(cw + 2 * DM + c0), b = *(const f32x4*)(cw + 2 * DM + c0 + 4); w2[0] = a.x; w2[1] = a.y; w2[2] = a.z; w2[3] = a.w; w2[4] = b.x; w2[5] = b.y; w2[6] = b.z; w2[7] = b.w; }
        float u0[8], u1[8], u2[8];
        if (ru < NBP * NRUN) {
            const int b = ru / NRUN, t0 = NMETA + (ru % NRUN) * RUN;
            if (t0 >= 1) load_u(BCH, prow(b, t0 - 1), c0, u1); else {
#pragma unroll
                for (int i = 0; i < 8; ++i) u1[i] = 0.f; }
            if (t0 >= 2) load_u(BCH, prow(b, t0 - 2), c0, u0); else {
#pragma unroll
                for (int i = 0; i < 8; ++i) u0[i] = 0.f; }
            const int r0 = prow(b, t0);
            v4u bq[RUN], cq[RUN], hq_[RUN];
#pragma unroll
            for (int k = 0; k < RUN; ++k) { const bf16* rp = BCH + (size_t)(r0 + k) * NA_IN + c0; bq[k] = *(const v4u*)rp; cq[k] = *(const v4u*)(rp + DM); hq_[k] = *(const v4u*)(rp + 2 * DM); }
#pragma unroll
            for (int k = 0; k < RUN; ++k) {
                const int r = r0 + k, t = t0 + k;
                { float ca[8], ha[8]; unpack8(cq[k], ca); unpack8(hq_[k], ha);
#pragma unroll
                  for (int i = 0; i < 8; ++i) u2[i] = ca[i] * ha[i]; }
                float bg[8]; unpack8(bq[k], bg);
                float y[8];
#pragma unroll
                for (int i = 0; i < 8; ++i) y[i] = bg[i] * (w0[i] * u0[i] + w1[i] * u1[i] + w2[i] * u2[i]);
                *(v4u*)(Y + (size_t)r * DM + c0) = pack8(y);
                if (t >= TP - 2) { float* o = outp + ((size_t)(b * 2 + (t - (TP - 2)))) * DM + c0; *(f32x4*)o = (f32x4){u2[0], u2[1], u2[2], u2[3]}; *(f32x4*)(o + 4) = (f32x4){u2[4], u2[5], u2[6], u2[7]}; }
#pragma unroll
                for (int i = 0; i < 8; ++i) { u0[i] = u1[i]; u1[i] = u2[i]; }
            }
        } else if (ru < NBP * NRUN + NBP * NMETA) {
            const int mi = ru - NBP * NRUN, b = mi / NMETA, t = mi % NMETA, r = XROW0 + mi;
            load_u(BCH, r, c0, u2);
            if (t >= 1) load_u(BCH, r - 1, c0, u1); else {
#pragma unroll
                for (int i = 0; i < 8; ++i) u1[i] = 0.f; }
            if (t >= 2) load_u(BCH, r - 2, c0, u0); else {
#pragma unroll
                for (int i = 0; i < 8; ++i) u0[i] = 0.f; }
            (void)b;
            float bg[8]; unpack8(*(const v4u*)(BCH + (size_t)r * NA_IN + c0), bg);
            float y[8];
#pragma unroll
            for (int i = 0; i < 8; ++i) y[i] = bg[i] * (w0[i] * u0[i] + w1[i] * u1[i] + w2[i] * u2[i]);
            *(v4u*)(Y + (size_t)r * DM + c0) = pack8(y);
        } else {
            const int sb = ru - NBP * NRUN - NBP * NMETA, r = SROW0 + sb;
            load_u(BCH, r, c0, u2);
            const float* h0 = hist + ((size_t)(sb * 2 + 0)) * DM + c0; const float* h1 = hist + ((size_t)(sb * 2 + 1)) * DM + c0;
            const f32x4 a0 = *(const f32x4*)h0, a1 = *(const f32x4*)(h0 + 4), b0 = *(const f32x4*)h1, b1 = *(const f32x4*)(h1 + 4);
            u0[0] = a0.x; u0[1] = a0.y; u0[2] = a0.z; u0[3] = a0.w; u0[4] = a1.x; u0[5] = a1.y; u0[6] = a1.z; u0[7] = a1.w;
            u1[0] = b0.x; u1[1] = b0.y; u1[2] = b0.z; u1[3] = b0.w; u1[4] = b1.x; u1[5] = b1.y; u1[6] = b1.z; u1[7] = b1.w;
            float* o0 = outs + ((size_t)(sb * 2 + 0)) * DM + c0; float* o1 = outs + ((size_t)(sb * 2 + 1)) * DM + c0;
            *(f32x4*)o0 = b0; *(f32x4*)(o0 + 4) = b1;
            *(f32x4*)o1 = (f32x4){u2[0], u2[1], u2[2], u2[3]}; *(f32x4*)(o1 + 4) = (f32x4){u2[4], u2[5], u2[6], u2[7]};
            float bg[8]; unpack8(*(const v4u*)(BCH + (size_t)r * NA_IN + c0), bg);
            float y[8];
#pragma unroll
            for (int i = 0; i < 8; ++i) y[i] = bg[i] * (w0[i] * u0[i] + w1[i] * u1[i] + w2[i] * u2[i]);
            *(v4u*)(Y + (size_t)r * DM + c0) = pack8(y);
        }
    }
}

constexpr float QSCALE = 0.08838834764831845f;
__device__ __forceinline__ void rope_phase(const bf16* PROJ, const Ptrs& P, int gw, int NGW, int lane) {
    unsigned char* ws = P.ws;
    const f32x2* t128 = (const f32x2*)(ws + WS_TAB128); const f32x2* t64 = (const f32x2*)(ws + WS_TAB64);
    bf16* Qr = (bf16*)(ws + WS_QR); bf16* QI = (bf16*)(ws + WS_QI); bf16* KIb = (bf16*)(ws + WS_KIB); float* WI = (float*)(ws + WS_WI);
    bf16* Ks = (bf16*)(ws + WS_KS); bf16* Vs = (bf16*)(ws + WS_VS);
    for (int pr_ = gw; pr_ < NBP * SPAD; pr_ += NGW) {
        const size_t o = ((size_t)((pr_ / SPAD) * SP + (pr_ % SPAD))) * 512 + 8 * lane; *(v4u*)(Ks + o) = (v4u){0u, 0u, 0u, 0u}; *(v4u*)(Vs + o) = (v4u){0u, 0u, 0u, 0u}; }
    for (int r = gw; r < NROWS; r += NGW) {
        const bf16* pr = PROJ + (size_t)r * NB_PAD;
        int pi; float *ko, *vo, *iko; bf16* kib = nullptr; bf16 *ksq = nullptr, *vsq = nullptr;
        if (r < SROW0) { int b, t; row_bt(r, b, t); pi = t; ksq = Ks + ((size_t)(b * SP + t + SPAD)) * 512; vsq = Vs + ((size_t)(b * SP + t + SPAD)) * 512; ko = P.out + O_KP + ((size_t)(b * TP + t)) * 512; vo = P.out + O_VP + ((size_t)(b * TP + t)) * 512; iko = P.out + O_IKP + ((size_t)(b * TP + t)) * 64; kib = KIb + ((size_t)(b * KIROWS + t)) * 64; }
        else { const int sb = r - SROW0; pi = POS_SAMPLE_IDX; ko = P.out + O_KS + (size_t)sb * 512; vo = P.out + O_VS + (size_t)sb * 512; iko = P.out + O_IKS + (size_t)sb * 64; }
        const f32x2* c128 = t128 + (size_t)pi * 64; const f32x2* c64 = t64 + (size_t)pi * 32;
        const int hd = lane >> 2, sub = lane & 3, hk = hd & 3;
        const v4u q1a = *(const v4u*)(pr + hd * 128 + 16 * sub), q1b = *(const v4u*)(pr + hd * 128 + 16 * sub + 8), q2a = *(const v4u*)(pr + hd * 128 + 64 + 16 * sub), q2b = *(const v4u*)(pr + hd * 128 + 64 + 16 * sub + 8);
        const v4u k1a = *(const v4u*)(pr + 2048 + hk * 128 + 16 * sub), k1b = *(const v4u*)(pr + 2048 + hk * 128 + 16 * sub + 8), k2a = *(const v4u*)(pr + 2048 + hk * 128 + 64 + 16 * sub), k2b = *(const v4u*)(pr + 2048 + hk * 128 + 64 + 16 * sub + 8);
        const v4u vv = *(const v4u*)(pr + 2560 + 8 * lane);
        const v4u i1 = *(const v4u*)(pr + 3072 + hd * 64 + 8 * sub), i2 = *(const v4u*)(pr + 3072 + hd * 64 + 32 + 8 * sub);
        const v4u j1 = *(const v4u*)(pr + 4096 + 8 * sub), j2 = *(const v4u*)(pr + 4096 + 32 + 8 * sub);
        const v4u wq = *(const v4u*)(pr + 4160 + 8 * (lane & 1));
        f32x4 csq[8], csi[4];
#pragma unroll
        for (int i = 0; i < 8; ++i) csq[i] = *(const f32x4*)(c128 + 16 * sub + 2 * i);
#pragma unroll
        for (int i = 0; i < 4; ++i) csi[i] = *(const f32x4*)(c64 + 8 * sub + 2 * i);
        {
            float x1[16], x2[16], o1[16], o2[16];
            { float t8[8]; unpack8(q1a, t8);
#pragma unroll
              for (int i = 0; i < 8; ++i) x1[i] = t8[i]; unpack8(q1b, t8);
#pragma unroll
              for (int i = 0; i < 8; ++i) x1[8 + i] = t8[i]; unpack8(q2a, t8);
#pragma unroll
              for (int i = 0; i < 8; ++i) x2[i] = t8[i]; unpack8(q2b, t8);
#pragma unroll
              for (int i = 0; i < 8; ++i) x2[8 + i] = t8[i]; }
#pragma unroll
            for (int i = 0; i < 16; i += 2) { const f32x4 cs = csq[i >> 1];
                o1[i] = (x1[i] * cs.x - x2[i] * cs.y) * QSCALE; o2[i] = (x2[i] * cs.x + x1[i] * cs.y) * QSCALE;
                o1[i + 1] = (x1[i + 1] * cs.z - x2[i + 1] * cs.w) * QSCALE; o2[i + 1] = (x2[i + 1] * cs.z + x1[i + 1] * cs.w) * QSCALE; }
            bf16* qo = Qr + (size_t)r * DM + hd * 128 + 16 * sub;
            { float t8[8];
#pragma unroll
              for (int i = 0; i < 8; ++i) t8[i] = o1[i]; *(v4u*)qo = pack8(t8);
#pragma unroll
              for (int i = 0; i < 8; ++i) t8[i] = o1[8 + i]; *(v4u*)(qo + 8) = pack8(t8);
#pragma unroll
              for (int i = 0; i < 8; ++i) t8[i] = o2[i]; *(v4u*)(qo + 64) = pack8(t8);
#pragma unroll
              for (int i = 0; i < 8; ++i) t8[i] = o2[8 + i]; *(v4u*)(qo + 72) = pack8(t8); }
        }
        if (lane < 16) {
#pragma unroll
            for (int hf = 0; hf < 2; ++hf) { float x1[8], x2[8], o1[8], o2[8]; unpack8(hf ? k1b : k1a, x1); unpack8(hf ? k2b : k2a, x2);
#pragma unroll
                for (int i = 0; i < 8; i += 2) { const f32x4 cs = csq[4 * hf + (i >> 1)];
                    o1[i] = x1[i] * cs.x - x2[i] * cs.y; o2[i] = x2[i] * cs.x + x1[i] * cs.y; o1[i + 1] = x1[i + 1] * cs.z - x2[i + 1] * cs.w; o2[i + 1] = x2[i + 1] * cs.z + x1[i + 1] * cs.w; }
                float* kq = ko + hk * 128 + 16 * sub + 8 * hf;
                *(f32x4*)kq = (f32x4){o1[0], o1[1], o1[2], o1[3]}; *(f32x4*)(kq + 4) = (f32x4){o1[4], o1[5], o1[6], o1[7]};
                *(f32x4*)(kq + 64) = (f32x4){o2[0], o2[1], o2[2], o2[3]}; *(f32x4*)(kq + 68) = (f32x4){o2[4], o2[5], o2[6], o2[7]};
                if (ksq) { *(v4u*)(ksq + hk * 128 + 16 * sub + 8 * hf) = pack8(o1); *(v4u*)(ksq + hk * 128 + 64 + 16 * sub + 8 * hf) = pack8(o2); } }
        }
        {
            float vf[8]; unpack8(vv, vf);
            *(f32x4*)(vo + 8 * lane) = (f32x4){vf[0], vf[1], vf[2], vf[3]}; *(f32x4*)(vo + 8 * lane + 4) = (f32x4){vf[4], vf[5], vf[6], vf[7]};
            if (vsq) *(v4u*)(vsq + 8 * lane) = vv;
        }
        {
            float x1[8], x2[8], o1[8], o2[8]; unpack8(i1, x1); unpack8(i2, x2);
#pragma unroll
            for (int i = 0; i < 8; i += 2) { const f32x4 cs = csi[i >> 1];
                o1[i] = x1[i] * cs.x - x2[i] * cs.y; o2[i] = x2[i] * cs.x + x1[i] * cs.y; o1[i + 1] = x1[i + 1] * cs.z - x2[i + 1] * cs.w; o2[i + 1] = x2[i + 1] * cs.z + x1[i + 1] * cs.w; }
            *(v4u*)(QI + (size_t)r * 1024 + hd * 64 + 8 * sub) = pack8(o1); *(v4u*)(QI + (size_t)r * 1024 + hd * 64 + 32 + 8 * sub) = pack8(o2);
        }
        if (lane < 4) {
            float x1[8], x2[8], o1[8], o2[8]; unpack8(j1, x1); unpack8(j2, x2);
#pragma unroll
            for (int i = 0; i < 8; i += 2) { const f32x4 cs = csi[i >> 1];
                o1[i] = x1[i] * cs.x - x2[i] * cs.y; o2[i] = x2[i] * cs.x + x1[i] * cs.y; o1[i + 1] = x1[i + 1] * cs.z - x2[i + 1] * cs.w; o2[i + 1] = x2[i + 1] * cs.z + x1[i + 1] * cs.w; }
            float* io = iko + 8 * sub;
            *(f32x4*)io = (f32x4){o1[0], o1[1], o1[2], o1[3]}; *(f32x4*)(io + 4) = (f32x4){o1[4], o1[5], o1[6], o1[7]};
            *(f32x4*)(io + 32) = (f32x4){o2[0], o2[1], o2[2], o2[3]}; *(f32x4*)(io + 36) = (f32x4){o2[4], o2[5], o2[6], o2[7]};
            if (kib) { *(v4u*)(kib + 8 * sub) = pack8(o1); *(v4u*)(kib + 32 + 8 * sub) = pack8(o2); }
        } else if (lane < 6) {
            float wv[8]; unpack8(wq, wv); float* wo = WI + (size_t)r * 16 + 8 * (lane - 4);
            *(f32x4*)wo = (f32x4){wv[0], wv[1], wv[2], wv[3]}; *(f32x4*)(wo + 4) = (f32x4){wv[4], wv[5], wv[6], wv[7]};
        }
    }
}

__device__ __forceinline__ void indexer_prompt(const Ptrs& P, LAS unsigned char* lds, int tid, int wave, int lane) {
    unsigned char* ws = P.ws;
    const bf16* QI = (const bf16*)(ws + WS_QI); const bf16* KIb = (const bf16*)(ws + WS_KIB); const float* WI = (const float*)(ws + WS_WI); float* SC = (float*)(ws + WS_SC);
    const int n = lane & 31, h8 = lane >> 5;
    const int qsel = (n >> 2) & 1, head = (n & 3) + 4 * (n >> 3);
    constexpr int NG = TP / 16;
    constexpr int KROW = 144, TBUF = 128 * KROW;
    LAS float* hscr = (LAS float*)(lds + 40960 + wave * 8448);
    int tit = blockIdx.x * 8 + wave;
    for (int it = blockIdx.x; it < 2 * NG; it += gridDim.x) {
        int b, qg;
        if (it < 256) { b = it & 1; qg = 1 + (it >> 1); } else if (it < 512) { b = it & 1; qg = 256 - ((it - 256) >> 1); } else { b = it - 512; qg = 0; }
        const int t0 = 16 * qg + 2 * wave;
        const bf16* qa = QI + (size_t)prow(b, t0 + qsel) * 1024 + head * 64 + 8 * h8;
        bf16x8 a[4];
#pragma unroll
        for (int kk = 0; kk < 4; ++kk) a[kk] = *(const bf16x8*)(qa + 16 * kk);
        const int tq = t0 + h8;
        const float* wp = WI + (size_t)prow(b, tq) * 16;
        float w[16];
#pragma unroll
        for (int i = 0; i < 4; ++i) { const f32x4 x = *(const f32x4*)(wp + 4 * i); w[4 * i] = x.x; w[4 * i + 1] = x.y; w[4 * i + 2] = x.z; w[4 * i + 3] = x.w; }
        const int ntile = ((16 * qg + 15) >> 5) + 1, ntrip = (ntile + 3) >> 2;
        float* scrow = SC + ((size_t)(b * TP + tq)) * SCW;
        const bf16* kbase = KIb + (size_t)b * KIROWS * 64;
        const int p0 = tid, p1 = tid + 512;
        const int l0 = (p0 >> 3) * KROW + (p0 & 7) * 16, l1 = (p1 >> 3) * KROW + (p1 & 7) * 16;
        asm volatile("s_waitcnt lgkmcnt(0)\n\ts_barrier" ::: "memory");
        v4u g0 = *(const v4u*)(kbase + (size_t)p0 * 8), g1 = *(const v4u*)(kbase + (size_t)p1 * 8);
        *(LAS v4u*)(lds + l0) = g0; *(LAS v4u*)(lds + l1) = g1;
        for (int tr = 0; tr < ntrip; ++tr) {
            const int cur = tr & 1;
            float hv[32]; TrJob HJ; hosted_issue(P, tit, lane, hv, HJ);
            if (tr + 1 < ntrip) { const size_t ko = (size_t)(tr + 1) * 128 * 64;
                const int kmax = KIROWS * 64 - 8;
                const size_t o0 = ko + (size_t)p0 * 8, o1 = ko + (size_t)p1 * 8;
                g0 = *(const v4u*)(kbase + (o0 <= (size_t)kmax ? o0 : (size_t)kmax)); g1 = *(const v4u*)(kbase + (o1 <= (size_t)kmax ? o1 : (size_t)kmax)); }
            asm volatile("s_waitcnt lgkmcnt(0)\n\ts_barrier" ::: "memory");
            const LAS unsigned char* kb = lds + cur * TBUF + n * KROW + h8 * 16;
#pragma unroll
            for (int u = 0; u < 4; ++u) {
                f32x16 acc;
#pragma unroll
                for (int i = 0; i < 16; ++i) acc[i] = 0.f;
#pragma unroll
                for (int kk = 0; kk < 4; ++kk) acc = __builtin_amdgcn_mfma_f32_32x32x16_bf16(a[kk], *(const LAS bf16x8*)(kb + u * 32 * KROW + kk * 32), acc, 0, 0, 0);
                float sc = 0.f;
#pragma unroll
                for (int i = 0; i < 16; ++i) sc += w[i] * fmaxf(acc[i], 0.f);
                const int s = 32 * (4 * tr + u) + n;
                if (s <= tq) scrow[s] = sc;
            }
            if (tr + 1 < ntrip) { *(LAS v4u*)(lds + (cur ^ 1) * TBUF + l0) = g0; *(LAS v4u*)(lds + (cur ^ 1) * TBUF + l1) = g1; }
            if (HJ.valid) { tr_finish(hv, HJ, hscr, lane); tit += gridDim.x * 8; }
        }
    }
    asm volatile("s_waitcnt lgkmcnt(0)\n\ts_barrier" ::: "memory");
    for (; tit < NHOSTED; tit += gridDim.x * 8) { float hv[32]; TrJob HJ; hosted_issue(P, tit, lane, hv, HJ); if (HJ.valid) tr_finish(hv, HJ, hscr, lane); }
}

__device__ __forceinline__ void indexer_sample(const Ptrs& P, LAS unsigned char* lds, int tid) {
    unsigned char* ws = P.ws;
    const bf16* QI = (const bf16*)(ws + WS_QI); const float* WI = (const float*)(ws + WS_WI); float* SCS = (float*)(ws + WS_SCS);
    LAS float* lq = (LAS float*)lds;
    LAS float* lw = lq + 1024;
    constexpr int NCH = (NSKEY + 511) / 512;
    for (int item = gridDim.x - 1 - blockIdx.x; item < SBN * NCH; item += gridDim.x) {
        const int sb = item / NCH, ch = item % NCH, r = SROW0 + sb;
        __syncthreads();
        for (int e = tid; e < 1024; e += NTHREADS) lq[e] = bf2f(QI[(size_t)r * 1024 + e]);
        if (tid < 16) lw[tid] = WI[(size_t)r * 16 + tid];
        __syncthreads();
        const int s = ch * 512 + tid;
        if (s < NSKEY) {
            const float* kr = (s < PAST) ? P.cache_ik + ((size_t)P.page_table[sb * NPG + (s >> 7)] * 128 + (s & 127)) * 64 : P.out + O_IKS + (size_t)sb * 64;
            f32x4 kv[16];
#pragma unroll
            for (int i = 0; i < 16; ++i) kv[i] = *(const f32x4*)(kr + 4 * i);
            float sc = 0.f;
            for (int h = 0; h < 16; ++h) { float d = 0.f;
#pragma unroll
                for (int i = 0; i < 16; ++i) { const f32x4 q = *(const LAS f32x4*)(lq + h * 64 + 4 * i); d += q.x * kv[i].x + q.y * kv[i].y + q.z * kv[i].z + q.w * kv[i].w; }
                sc += lw[h] * fmaxf(d, 0.f); }
            SCS[(size_t)sb * SCSW + s] = sc;
        }
    }
    __syncthreads();
}

__device__ __forceinline__ unsigned ordkey(float f) { const unsigned u = __float_as_uint(f); return (u & 0x80000000u) ? ~u : (u | 0x80000000u); }
constexpr int TOPK = 256;
__device__ __forceinline__ void topk_wave_mask(const float* sc, int n, unsigned long long* mrow, int lane) {
    constexpr int NS = MTW, M0 = SPAD / 64;
    static_assert(M0 == dattn::JLO, "first real key tile");
    unsigned key[NS];
#pragma unroll
    for (int m = M0; m < NS; ++m) { const int sidx = lane + 64 * m - SPAD; const int ci = sidx < 0 ? 0 : (sidx < n ? sidx : n - 1); const float v = sc[ci]; key[m] = (sidx >= 0 && sidx < n) ? ordkey(v) : 0u; }
    if (n <= TOPK) {
#pragma unroll
        for (int m = M0; m < NS; ++m) { const unsigned long long w = __ballot(key[m] != 0u); if (lane == 0) mrow[m] = w; }
        return;
    }
    unsigned T = 0u;
    for (int bit = 31; bit >= 0; --bit) {
        const unsigned cand = T | (1u << bit); int c = 0, cv = 0;
#pragma unroll
        for (int m = M0; m < NS; ++m) { if ((m & 1) != 0) c += __popcll(__ballot(key[m] >= cand)); else cv += (key[m] >= cand) ? 1 : 0; }
        c = __builtin_amdgcn_readfirstlane(c + wave_sum_dpp_i(cv));
        if (c >= TOPK) { T = cand; if (c == TOPK) break; }
    }
    int cg = 0;
#pragma unroll
    for (int m = M0; m < NS; ++m) cg += __popcll(__ballot(key[m] > T));
    const int need = TOPK - cg;
    int base_e = 0;
    const unsigned long long lt = (1ull << lane) - 1ull;
#pragma unroll
    for (int m = M0; m < NS; ++m) {
        const bool pg = key[m] > T, pe = key[m] == T;
        const unsigned long long me = __ballot(pe);
        const int pre_e = __popcll(me & lt);
        const unsigned long long w = __ballot(pg || (pe && (base_e + pre_e) < need));
        if (lane == 0) mrow[m] = w;
        base_e += __popcll(me);
    }
}
__device__ __forceinline__ void topk_block(const float* sc, int n, int* outIdx, int* outCnt, LAS unsigned* ls, int tid, int wave, int lane) {
    constexpr int NS = (NSKEY + NTHREADS - 1) / NTHREADS;
    unsigned key[NS];
#pragma unroll
    for (int m = 0; m < NS; ++m) { const int e = tid + NTHREADS * m; const float v = sc[e < n ? e : n - 1]; key[m] = (e < n) ? ordkey(v) : 0u; }
    unsigned T = 0u;
    for (int bit = 31; bit >= 0; --bit) {
        const unsigned cand = T | (1u << bit); int c = 0;
#pragma unroll
        for (int m = 0; m < NS; ++m) c += (key[m] >= cand) ? 1 : 0;
        c = wave_sum_dpp_i(c);
        LAS unsigned* buf = ls + (bit & 1) * 8;
        if (lane == 0) buf[wave] = (unsigned)c;
        __syncthreads();
        int tot = 0;
#pragma unroll
        for (int w = 0; w < 8; ++w) tot += (int)buf[w];
        if (tot >= TOPK) T = cand;
    }
    __syncthreads();
    if (tid == 0) { unsigned z_ = 0u; asm volatile("" : "+v"(z_)); ls[16] = z_; ls[17] = z_; }
    __syncthreads();
#pragma unroll
    for (int m = 0; m < NS; ++m) { const int e = tid + NTHREADS * m; if (key[m] > T) { const unsigned pos = atomicAdd((unsigned*)(ls + 16), 1u); if (pos < (unsigned)TOPK) outIdx[pos] = e; } }
    __syncthreads();
    const unsigned cg = ls[16];
    const unsigned need = (unsigned)TOPK - cg;
#pragma unroll
    for (int m = 0; m < NS; ++m) { const int e = tid + NTHREADS * m; if (key[m] == T) { const unsigned pos = atomicAdd((unsigned*)(ls + 17), 1u); if (pos < need) outIdx[cg + pos] = e; } }
    if (tid == 0) *outCnt = TOPK;
    __syncthreads();
}
__device__ __forceinline__ void select_phase(const Ptrs& P, LAS unsigned char* lds, int gw, int NGW, int tid, int wave, int lane) {
    unsigned char* ws = P.ws;
    const float* SC = (const float*)(ws + WS_SC); const float* SCS = (const float*)(ws + WS_SCS); int* IDXL = (int*)(ws + WS_IDXL); int* CNT = (int*)(ws + WS_CNT);
    for (int sb = blockIdx.x; sb < SBN; sb += gridDim.x) topk_block(SCS + (size_t)sb * SCSW, NSKEY, IDXL + (size_t)(SROW0 + sb) * TOPK, CNT + SROW0 + sb, (LAS unsigned*)lds, tid, wave, lane);
    unsigned long long* MASK = (unsigned long long*)(ws + WS_MASK);
    for (int r = gw; r < SROW0; r += NGW) { int b, t; row_bt(r, b, t);
        if (r < XROW0) topk_wave_mask(SC + ((size_t)(b * TP + t)) * SCW, t + 1, MASK + ((size_t)(b * SP + t + SPAD)) * MTW, lane);
        else { if (lane <= t) IDXL[(size_t)r * TOPK + lane] = lane; if (lane == 0) CNT[r] = t + 1; } }
}

__device__ __forceinline__ void attn_phase(const Ptrs& P, bf16* O, LAS unsigned char* lds, int tid, int wave, int lane) {
    unsigned char* ws = P.ws;
    const bf16* Qr = (const bf16*)(ws + WS_QR); const int* IDXL = (const int*)(ws + WS_IDXL); const int* CNT = (const int*)(ws + WS_CNT);
    LAS float* lq = (LAS float*)(lds + wave * 2048);
    LAS float* part = (LAS float*)(lds + 16384);
    LAS float* ml = (LAS float*)(lds + 32768);
    for (int item = blockIdx.x; item < (NROWS - XROW0) * 4; item += gridDim.x) {
        const int r = XROW0 + (item >> 2), n = item & 3;
        const int cnt = CNT[r];
        { float qf[8]; unpack8(*(const v4u*)(Qr + (size_t)r * DM + n * 512 + 8 * lane), qf);
          *(LAS f32x4*)(lq + 8 * lane) = (f32x4){qf[0], qf[1], qf[2], qf[3]}; *(LAS f32x4*)(lq + 8 * lane + 4) = (f32x4){qf[4], qf[5], qf[6], qf[7]}; }
        const int kl = lane & 31, hh = lane >> 5, e = wave * 32 + kl;
        const bool valid = e < cnt;
        const int s = valid ? IDXL[(size_t)r * TOPK + e] : 0;
        const float *kq, *vq;
        if (r < SROW0) { const int b = (r - XROW0) >> 4; kq = P.out + O_KP + ((size_t)(b * TP + s)) * 512; vq = P.out + O_VP + ((size_t)(b * TP + s)) * 512; }
        else { const int sb = r - SROW0;
            if (s < PAST) { const size_t off = ((size_t)P.page_table[sb * NPG + (s >> 7)] * 128 + (s & 127)) * 512; kq = P.cache_k + off; vq = P.cache_v + off; }
            else { kq = P.out + O_KS + (size_t)sb * 512; vq = P.out + O_VS + (size_t)sb * 512; } }
        kq += n * 128 + 64 * hh; vq += n * 128;
        f32x4 kv[16];
#pragma unroll
        for (int i = 0; i < 16; ++i) kv[i] = *(const f32x4*)(kq + 4 * i);
        WAVE_SYNC();
        float acc[4] = {0.f, 0.f, 0.f, 0.f};
#pragma unroll
        for (int i = 0; i < 16; ++i)
#pragma unroll
            for (int g = 0; g < 4; ++g) { const f32x4 qv = *(const LAS f32x4*)(lq + g * 128 + 64 * hh + 4 * i); acc[g] += qv.x * kv[i].x + qv.y * kv[i].y + qv.z * kv[i].z + qv.w * kv[i].w; }
        float pg[4], mw[4], lw[4];
#pragma unroll
        for (int g = 0; g < 4; ++g) { float a = acc[g] + __shfl_xor(acc[g], 32); a = valid ? a : -INFINITY;
            const float m = wave_max(a); const float pv = valid ? __expf(a - m) : 0.f;
            pg[g] = pv; mw[g] = m; lw[g] = wave_sum(hh == 0 ? pv : 0.f); }
        const unsigned long long va = (unsigned long long)vq; const int va_lo = (int)(unsigned)va, va_hi = (int)(unsigned)(va >> 32);
        f32x2 vv[32];
#pragma unroll
        for (int j = 0; j < 32; ++j) { const unsigned long long a = ((unsigned long long)(unsigned)__builtin_amdgcn_readlane(va_hi, j) << 32) | (unsigned)__builtin_amdgcn_readlane(va_lo, j);
            vv[j] = *(const f32x2*)((const float*)a + 2 * lane); }
        float o[4][2];
#pragma unroll
        for (int g = 0; g < 4; ++g) { o[g][0] = 0.f; o[g][1] = 0.f; }
#pragma unroll
        for (int j = 0; j < 32; ++j)
#pragma unroll
            for (int g = 0; g < 4; ++g) { const float pj = __int_as_float(__builtin_amdgcn_readlane(__float_as_int(pg[g]), j)); o[g][0] += pj * vv[j].x; o[g][1] += pj * vv[j].y; }
#pragma unroll
        for (int g = 0; g < 4; ++g) { *(LAS f32x2*)(part + (wave * 4 + g) * 128 + 2 * lane) = (f32x2){o[g][0], o[g][1]};
            if (lane == 0) { ml[(wave * 4 + g) * 2] = mw[g]; ml[(wave * 4 + g) * 2 + 1] = lw[g]; } }
        __syncthreads();
        { const int g = tid >> 7, d = tid & 127; float M = -INFINITY;
#pragma unroll
          for (int w = 0; w < 8; ++w) M = fmaxf(M, ml[(w * 4 + g) * 2]);
          float L = 0.f, a = 0.f;
#pragma unroll
          for (int w = 0; w < 8; ++w) { const float mv = ml[(w * 4 + g) * 2]; const float sc = (mv == -INFINITY) ? 0.f : __expf(mv - M); L += ml[(w * 4 + g) * 2 + 1] * sc; a += part[(w * 4 + g) * 128 + d] * sc; }
          O[(size_t)r * DM + (4 * n + g) * 128 + d] = f2bf(a / L); }
        __syncthreads();
    }
}

__device__ __forceinline__ void convC_finish(float (&acc)[8], int it) {
    float ss = 0.f;
#pragma unroll
    for (int i = 0; i < 8; ++i) { acc[i] = silu_f(acc[i]); ss += acc[i] * acc[i]; }
    if (it < 8) { ss = row16_sum(ss); float rn = 1.f / sqrtf(ss + RMS_EPS); if (it < 4) rn *= QSCALE;
#pragma unroll
        for (int i = 0; i < 8; ++i) acc[i] *= rn; }
}
__device__ __forceinline__ void convC_phase(const bf16* PROJC, const Ptrs& P, int gw, int NGW, int lane) {
    unsigned char* ws = P.ws;
    bf16* QKVC = (bf16*)(ws + WS_QKVC); float* QKF = (float*)(ws + WS_QKF); float* G = (float*)(ws + WS_G); float* BETA = (float*)(ws + WS_BETA);
    const float* cw = P.conv_w_c;
    constexpr int RUN = 8, NRUN = SEQ / RUN;
    for (int item = gw; item < 16 * NBP * NRUN; item += NGW) {
        const int it = item & 15, ru = item >> 4, b = ru / NRUN, t0 = NMETA + (ru % NRUN) * RUN, ch0 = it * 512 + 8 * lane;
        float w[4][8];
#pragma unroll
        for (int j = 0; j < 4; ++j) { const f32x4 w0 = *(const f32x4*)(cw + (size_t)j * CDIM + ch0), w1 = *(const f32x4*)(cw + (size_t)j * CDIM + ch0 + 4);
            w[j][0] = w0.x; w[j][1] = w0.y; w[j][2] = w0.z; w[j][3] = w0.w; w[j][4] = w1.x; w[j][5] = w1.y; w[j][6] = w1.z; w[j][7] = w1.w; }
        const int r0 = prow(b, t0);
        v4u xr[RUN + 3];
#pragma unroll
        for (int j = 0; j < 3; ++j) { const int tt = t0 - 3 + j; xr[j] = tt >= 0 ? *(const v4u*)(PROJC + (size_t)prow(b, tt) * NC_PAD + ch0) : (v4u){0u, 0u, 0u, 0u}; }
#pragma unroll
        for (int k = 0; k < RUN; ++k) xr[3 + k] = *(const v4u*)(PROJC + (size_t)(r0 + k) * NC_PAD + ch0);
        float x[RUN + 3][8];
#pragma unroll
        for (int j = 0; j < RUN + 3; ++j) unpack8(xr[j], x[j]);
#pragma unroll
        for (int k = 0; k < RUN; ++k) {
            float acc[8];
#pragma unroll
            for (int i = 0; i < 8; ++i) acc[i] = w[0][i] * x[k][i] + w[1][i] * x[k + 1][i] + w[2][i] * x[k + 2][i] + w[3][i] * x[k + 3][i];
            convC_finish(acc, it);
            *(v4u*)(QKVC + (size_t)(r0 + k) * CDIM + ch0) = pack8(acc);
            const int t = t0 + k;
            if (t >= TP - 3) { float* o = P.out + O_CCP + ((size_t)(b * 3 + (t - (TP - 3)))) * CDIM + ch0;
                *(f32x4*)o = (f32x4){x[k + 3][0], x[k + 3][1], x[k + 3][2], x[k + 3][3]}; *(f32x4*)(o + 4) = (f32x4){x[k + 3][4], x[k + 3][5], x[k + 3][6], x[k + 3][7]}; }
        }
    }
    for (int item = gw; item < 16 * NBP * NMETA; item += NGW) {
        const int it = item & 15, mi = item >> 4, t = mi % NMETA, r = XROW0 + mi, ch0 = it * 512 + 8 * lane;
        float x[4][8];
#pragma unroll
        for (int j = 0; j < 4; ++j) { const int tt = t - 3 + j; if (tt >= 0) unpack8(*(const v4u*)(PROJC + (size_t)(r - 3 + j) * NC_PAD + ch0), x[j]); else {
#pragma unroll
                for (int i = 0; i < 8; ++i) x[j][i] = 0.f; } }
        float acc[8];
#pragma unroll
        for (int i = 0; i < 8; ++i) acc[i] = 0.f;
#pragma unroll
        for (int j = 0; j < 4; ++j) { const f32x4 w0 = *(const f32x4*)(cw + (size_t)j * CDIM + ch0), w1 = *(const f32x4*)(cw + (size_t)j * CDIM + ch0 + 4);
            acc[0] += w0.x * x[j][0]; acc[1] += w0.y * x[j][1]; acc[2] += w0.z * x[j][2]; acc[3] += w0.w * x[j][3];
            acc[4] += w1.x * x[j][4]; acc[5] += w1.y * x[j][5]; acc[6] += w1.z * x[j][6]; acc[7] += w1.w * x[j][7]; }
        convC_finish(acc, it);
        *(v4u*)(QKVC + (size_t)r * CDIM + ch0) = pack8(acc);
    }
    for (int item = gw; item < 16 * SBN; item += NGW) {
        const int it = item & 15, sb = item >> 4, r = SROW0 + sb, ch0 = it * 512 + 8 * lane;
        float x[4][8];
#pragma unroll
        for (int j = 0; j < 3; ++j) { const float* hp = P.state_conv_c + ((size_t)(sb * 3 + j)) * CDIM + ch0; const f32x4 a = *(const f32x4*)hp, c = *(const f32x4*)(hp + 4);
            x[j][0] = a.x; x[j][1] = a.y; x[j][2] = a.z; x[j][3] = a.w; x[j][4] = c.x; x[j][5] = c.y; x[j][6] = c.z; x[j][7] = c.w; }
        unpack8(*(const v4u*)(PROJC + (size_t)r * NC_PAD + ch0), x[3]);
        float acc[8];
#pragma unroll
        for (int i = 0; i < 8; ++i) acc[i] = 0.f;
#pragma unroll
        for (int j = 0; j < 4; ++j) { const f32x4 w0 = *(const f32x4*)(cw + (size_t)j * CDIM + ch0), w1 = *(const f32x4*)(cw + (size_t)j * CDIM + ch0 + 4);
            acc[0] += w0.x * x[j][0]; acc[1] += w0.y * x[j][1]; acc[2] += w0.z * x[j][2]; acc[3] += w0.w * x[j][3];
            acc[4] += w1.x * x[j][4]; acc[5] += w1.y * x[j][5]; acc[6] += w1.z * x[j][6]; acc[7] += w1.w * x[j][7]; }
        convC_finish(acc, it);
        if (it < 8) { float* qk = QKF + (size_t)r * 4096 + ch0; *(f32x4*)qk = (f32x4){acc[0], acc[1], acc[2], acc[3]}; *(f32x4*)(qk + 4) = (f32x4){acc[4], acc[5], acc[6], acc[7]}; }
        *(v4u*)(QKVC + (size_t)r * CDIM + ch0) = pack8(acc);
        float* o = P.out + O_CCS + ((size_t)(sb * 3)) * CDIM + ch0;
#pragma unroll
        for (int j = 0; j < 3; ++j) { *(f32x4*)(o + (size_t)j * CDIM) = (f32x4){x[j + 1][0], x[j + 1][1], x[j + 1][2], x[j + 1][3]}; *(f32x4*)(o + (size_t)j * CDIM + 4) = (f32x4){x[j + 1][4], x[j + 1][5], x[j + 1][6], x[j + 1][7]}; }
    }
    for (int e = gw * 64 + lane; e < NROWS * 32; e += NGW * 64) {
        const int r = e >> 5, h = e & 31;
        const float braw = bf2f(PROJC[(size_t)r * NC_PAD + 12288 + h]), araw = bf2f(PROJC[(size_t)r * NC_PAD + 12320 + h]);
        const float xx = araw + P.dt_bias[h]; const float sp = xx > 20.f ? xx : __logf(1.f + __expf(xx));
        G[e] = -__expf(P.a_log[h]) * sp; BETA[e] = 1.f / (1.f + __expf(-braw));
    }
}

struct Tok { f32x4 k0, k1, q0, q1; unsigned v; float g, b; };
__device__ __forceinline__ void tok_load(Tok& T, const float* QKF, const bf16* QKVC, const float* G, const float* BETA, int row, int h, int rg, int col0) {
    const float* base = QKF + (size_t)row * 4096 + (h >> 1) * 128 + 8 * rg;
    T.q0 = *(const f32x4*)base; T.q1 = *(const f32x4*)(base + 4); T.k0 = *(const f32x4*)(base + 2048); T.k1 = *(const f32x4*)(base + 2052);
    T.v = *(const unsigned*)(QKVC + (size_t)row * CDIM + 4096 + h * 128 + col0);
    T.g = G[(size_t)row * 32 + h]; T.b = BETA[(size_t)row * 32 + h];
}
__device__ __forceinline__ f32x2 tok_step(f32x2 (&S)[8], const Tok& T) {
    const float kk[8] = {T.k0.x, T.k0.y, T.k0.z, T.k0.w, T.k1.x, T.k1.y, T.k1.z, T.k1.w};
    const float qq[8] = {T.q0.x, T.q0.y, T.q0.z, T.q0.w, T.q1.x, T.q1.y, T.q1.z, T.q1.w};
    const float a = __expf(T.g);
    f32x2 d0 = S[0] * kk[0], d1 = S[1] * kk[1];
#pragma unroll
    for (int i = 2; i < 8; i += 2) { d0 += S[i] * kk[i]; d1 += S[i + 1] * kk[i + 1]; }
    f32x2 d = d0 + d1;
    d.x = row16_sum(d.x); d.y = row16_sum(d.y);
    const f32x2 tv = {bflo(T.v), bfhi(T.v)};
    const f32x2 dl = (tv - d * a) * T.b;
    f32x2 o0 = {0.f, 0.f}, o1 = {0.f, 0.f};
#pragma unroll
    for (int i = 0; i < 8; i += 2) { S[i] = S[i] * a + dl * kk[i]; o0 += S[i] * qq[i]; S[i + 1] = S[i + 1] * a + dl * kk[i + 1]; o1 += S[i + 1] * qq[i + 1]; }
    f32x2 o = o0 + o1;
    o.x = row16_sum(o.x); o.y = row16_sum(o.y);
    return o;
}
__device__ __forceinline__ void delta_phase(const Ptrs& P, int idx, int stride, int lane) {
    unsigned char* ws = P.ws;
    const bf16* QKVC = (const bf16*)(ws + WS_QKVC); const float* QKF = (const float*)(ws + WS_QKF); const float* G = (const float*)(ws + WS_G); const float* BETA = (const float*)(ws + WS_BETA); bf16* OF = (bf16*)(ws + WS_SC);
    const int cg = lane >> 4, rg = lane & 15;
    {
        for (int item = idx; item < SBN * 32 * 16; item += stride) {
            const int sb = item >> 9, h = (item >> 4) & 31, col0 = 8 * (item & 15) + 2 * cg;
            const size_t so = ((size_t)((sb * 32 + h) * 128 + 8 * rg)) * 128 + col0;
            f32x2 S[8];
#pragma unroll
            for (int i = 0; i < 8; ++i) S[i] = *(const f32x2*)(P.state_delta + so + (size_t)i * 128);
            Tok T; tok_load(T, QKF, QKVC, G, BETA, SROW0 + sb, h, rg, col0);
            const f32x2 o = tok_step(S, T);
            if (rg == 0) *(unsigned*)(OF + (size_t)(SROW0 + sb) * DVW + h * 128 + col0) = pk2(o.x, o.y);
            float* op = P.out + O_DS + so;
#pragma unroll
            for (int i = 0; i < 8; ++i) *(f32x2*)(op + (size_t)i * 128) = S[i];
        }
    }
}
__device__ __forceinline__ void normC_piece(const v4u oq, const v4u zz, const float (&nw)[8], bf16* yo) {
    float o[8]; unpack8(oq, o);
    float ss = 0.f;
#pragma unroll
    for (int i = 0; i < 8; ++i) ss += o[i] * o[i];
    ss = row16_sum(ss);
    const float rs = 1.f / sqrtf(ss * (1.f / 128.f) + RMS_EPS);
    float z[8]; unpack8(zz, z);
#pragma unroll
    for (int i = 0; i < 8; ++i) o[i] = o[i] * rs * nw[i] * silu_f(z[i]);
    *(v4u*)yo = pack8(o);
}
__device__ __forceinline__ void normC_phase(const bf16* PROJC, bf16* Y, const Ptrs& P, int gw, int NGW, int lane) {
    const bf16* OF = (const bf16*)(P.ws + WS_SC);
    const int d0 = 8 * (lane & 15), hl = lane >> 4;
    float nw[8];
    { const f32x4 a = *(const f32x4*)(P.norm_w + d0), b = *(const f32x4*)(P.norm_w + d0 + 4); nw[0] = a.x; nw[1] = a.y; nw[2] = a.z; nw[3] = a.w; nw[4] = b.x; nw[5] = b.y; nw[6] = b.z; nw[7] = b.w; }
    for (int it = gw; it < (NROWS - XROW0) * 8; it += NGW) { const int r = XROW0 + (it >> 3), hd = (it & 7) * 4 + hl;
        const v4u oq = *(const v4u*)(OF + (size_t)r * DVW + hd * 128 + d0), zz = *(const v4u*)(PROJC + (size_t)r * NC_PAD + 8192 + hd * 128 + d0);
        normC_piece(oq, zz, nw, Y + (size_t)r * DVW + hd * 128 + d0); }
    for (int r = gw; r < XROW0; r += 2 * NGW) {
        const int r2 = (r + NGW < XROW0) ? r + NGW : r; const bool two = r + NGW < XROW0;
        v4u oa[8], za[8], ob[8], zb[8];
#pragma unroll
        for (int it = 0; it < 8; ++it) { const int hd = it * 4 + hl;
            oa[it] = *(const v4u*)(OF + (size_t)r * DVW + hd * 128 + d0); za[it] = *(const v4u*)(PROJC + (size_t)r * NC_PAD + 8192 + hd * 128 + d0);
            ob[it] = *(const v4u*)(OF + (size_t)r2 * DVW + hd * 128 + d0); zb[it] = *(const v4u*)(PROJC + (size_t)r2 * NC_PAD + 8192 + hd * 128 + d0); }
#pragma unroll
        for (int it = 0; it < 8; ++it) { const int hd = it * 4 + hl;
            normC_piece(oa[it], za[it], nw, Y + (size_t)r * DVW + hd * 128 + d0);
            if (two) normC_piece(ob[it], zb[it], nw, Y + (size_t)r2 * DVW + hd * 128 + d0); }
    }
}


constexpr int AH_I0 = (DM / 16) * (NA_IN / 32), AH_I1 = (DM / 16) * (DM / 32), AH_I2 = (DM / 16) * (FF / 32), AH_I3 = (FF / 16) * (DM / 32), AH_N = AH_I0 + AH_I1 + AH_I2 + AH_I3;
struct AttnHost {
    const float* w_in_a; const float* w_out_a; const float* w1; const float* w2; unsigned char* ws;
    LAS float* scr; int item, stride, lane; float hv[8]; bool live;
    __device__ __forceinline__ void decode(int it, const float*& W, bf16*& WT, int& K, int& N, int& kb, int& nb) const {
        int r = it;
        if (r < AH_I0) { W = w_in_a + (size_t)DM * NA_IN; WT = (bf16*)(ws + WS_WA_IN + WSZ_A_IN); K = DM; N = NA_IN; }
        else if ((r -= AH_I0) < AH_I1) { W = w_out_a + (size_t)DM * DM; WT = (bf16*)(ws + WS_WA_OUT + WSZ_A_OUT); K = DM; N = DM; }
        else if ((r -= AH_I1) < AH_I2) { W = w1 + 3 * (size_t)DM * FF; WT = (bf16*)(ws + WS_W1 + 3 * WSZ_W1); K = DM; N = FF; }
        else { r -= AH_I2; W = w2 + 3 * (size_t)DM * FF; WT = (bf16*)(ws + WS_W2 + 3 * WSZ_W2); K = FF; N = DM; }
        const int nblk = N >> 5; kb = r / nblk; nb = r - kb * nblk;
    }
    __device__ __forceinline__ void issue() {
        live = item < AH_N; if (!live) return;
        const float* W; bf16* WT; int K, N, kb, nb; decode(item, W, WT, K, N, kb, nb);
        const float* src = W + (size_t)(16 * kb + (lane >> 5)) * N + 32 * nb + (lane & 31);
#pragma unroll
        for (int i = 0; i < 8; ++i) hv[i] = src[(size_t)(2 * i) * N];
    }
    __device__ __forceinline__ void finish() {
        if (!live) return;
        asm volatile("s_waitcnt vmcnt(0)" ::: "memory");
        const float* W; bf16* WT; int K, N, kb, nb; decode(item, W, WT, K, N, kb, nb);
#pragma unroll
        for (int i = 0; i < 8; ++i) scr[(2 * i + (lane >> 5)) * 33 + (lane & 31)] = hv[i];
        LDS_WAIT(); __builtin_amdgcn_wave_barrier();
        const int n = lane >> 1, kh = lane & 1; const LAS float* sp = scr + (8 * kh) * 33 + n;
        v4u o; o.x = pk2(sp[0 * 33], sp[1 * 33]); o.y = pk2(sp[2 * 33], sp[3 * 33]); o.z = pk2(sp[4 * 33], sp[5 * 33]); o.w = pk2(sp[6 * 33], sp[7 * 33]);
        *(v4u*)(WT + (size_t)(32 * nb + n) * K + 16 * kb + 8 * kh) = o;
        LDS_WAIT(); __builtin_amdgcn_wave_barrier();
        item += stride;
    }
};
template <int VAR = 0> __device__ __forceinline__ void dense_attn_phase(const Ptrs& P, bf16* O, char* lds, int wv) {
    unsigned char* ws = P.ws;
    const bf16* Qr = (const bf16*)(ws + WS_QR); const bf16* Ks = (const bf16*)(ws + WS_KS); const bf16* Vs = (const bf16*)(ws + WS_VS);
    const unsigned long long* MASK = (const unsigned long long*)(ws + WS_MASK);
    typedef dattn::BlockRef<bf16, bf16> BR;
    AttnHost H; { int tl = threadIdx.x; asm volatile("" : "+v"(tl)); const int wvh = __builtin_amdgcn_readfirstlane(tl >> 6);
        H.w_in_a = P.w_in_a; H.w_out_a = P.w_out_a; H.w1 = P.w1; H.w2 = P.w2; H.ws = ws; H.lane = tl & 63; H.live = false;
        H.scr = (LAS float*)((LAS unsigned char*)(unsigned)(size_t)lds + 69632 + wvh * 2304);
        H.item = (VAR == 0) ? (int)blockIdx.x * 8 + wvh : AH_N; H.stride = (int)gridDim.x * 8; }
    for (int it0 = blockIdx.x; it0 < 256; it0 += gridDim.x) {
        const int grp = it0 & 7, idx = it0 >> 3;
        const int b = grp >> 2, kvh = grp & 3, h = kvh * 4 + (idx >> 3), x = idx & 7;
        BR A, B;
        const int qa = 1 + x, qb = 16 - x;
        A.Q = Qr + ((size_t)(b * SEQ + 256 * (qa - 1))) * DM + h * 128; A.O = O + ((size_t)(b * SEQ + 256 * (qa - 1))) * DM + h * 128;
        B.Q = Qr + ((size_t)(b * SEQ + 256 * (qb - 1))) * DM + h * 128; B.O = O + ((size_t)(b * SEQ + 256 * (qb - 1))) * DM + h * 128;
        A.K = B.K = Ks + (size_t)b * SP * 512 + kvh * 128; A.V = B.V = Vs + (size_t)b * SP * 512 + kvh * 128;
        A.P0 = 256 * qa; B.P0 = 256 * qb;
        A.M = MASK + ((size_t)(b * SP + A.P0)) * MTW; B.M = MASK + ((size_t)(b * SP + B.P0)) * MTW;
        dattn::Seam<bf16> S;
        dattn::causal_swa_prime<bf16, bf16>(A, SP, lds, S, wv);
        dattn::causal_swa_block<bf16, bf16, VAR>(A, B, SP, SP, lds, S, wv, H);
        dattn::causal_swa_block<bf16, bf16, VAR>(B, B, SP, SP, lds, S, wv, H);
    }
    while (H.item < AH_N) { H.issue(); H.finish(); }
}

constexpr int NCH = 65, CPAD = 48;
constexpr int NUQ = NBP * 16 * NCH, NUH = NBP * 32 * NCH;
__device__ __forceinline__ int crow32(int r, int hi) { return (r & 3) + 8 * (r >> 2) + 4 * hi; }
__device__ __forceinline__ int chunk_row(int b, int c, int i) { const int t = 64 * c + i - CPAD; return t >= 0 ? prow(b, t) : -1; }
__device__ __forceinline__ float incl_scan64(float v, int lane) {
#pragma unroll
    for (int o = 1; o < 64; o <<= 1) { const float u = __shfl_up(v, o); if (lane >= o) v += u; }
    return v;
}
#define MFMA32(a, b, c) __builtin_amdgcn_mfma_f32_32x32x16_bf16((a), (b), (c), 0, 0, 0)
__device__ __forceinline__ bf16x8 sel8(bool ok, bf16x8 v) { const bf16x8 z = {0, 0, 0, 0, 0, 0, 0, 0}; return ok ? v : z; }
__device__ __forceinline__ int sw23(int x) { return (x & ~12) | ((x & 4) << 1) | ((x & 8) >> 1); }
__device__ __forceinline__ int fidx64(int row, int xs) { return ((((row >> 5) * 2 + (xs >> 5)) * 2 + ((xs >> 4) & 1)) * 64 + (row & 31) + 32 * ((xs >> 3) & 1)) * 8 + (xs & 7); }

__device__ __forceinline__ v4u pack_frag(const f32x16& x, int s) { v4u w; w.x = pk2(x[8 * s], x[8 * s + 1]); w.y = pk2(x[8 * s + 2], x[8 * s + 3]); w.z = pk2(x[8 * s + 4], x[8 * s + 5]); w.w = pk2(x[8 * s + 6], x[8 * s + 7]); return w; }
__device__ __forceinline__ void stage_out8k(LAS unsigned char* stg, bf16* gdst, int lane) {
    WAVE_SYNC();
#pragma unroll
    for (int k = 0; k < 8; ++k) *(v4u*)(gdst + k * 512 + lane * 8) = *(const LAS v4u*)(stg + k * 1024 + lane * 16);
    WAVE_SYNC();
}
__device__ __forceinline__ void delta_d1_unit(unsigned char* ws, LAS unsigned char* lds, int uq, int wave, int lane) {
    asm volatile("" : "+v"(lane));
    const bf16* QKVC = (const bf16*)(ws + WS_QKVC); const float* G = (const float*)(ws + WS_G); const float* BETA = (const float*)(ws + WS_BETA);
    float* AF = (float*)(ws + WS_DAF); bf16* PG = (bf16*)(ws + WS_DPG); bf16* KT = (bf16*)(ws + WS_DKT); bf16* VT = (bf16*)(ws + WS_DVT);
    float* GC = (float*)(ws + WS_DGC); float* BT = (float*)(ws + WS_DBT);
    LAS float* lg = (LAS float*)(lds + wave * 16384);
    LAS unsigned char* stg = lds + wave * 16384 + 2048; LAS bf16* st = (LAS bf16*)stg;
    const int m = lane & 31, half = lane >> 5;
    const bf16x8 zf = {0, 0, 0, 0, 0, 0, 0, 0};
    {
        const int c = uq % NCH, bh = uq / NCH, hq = bh & 15, b = bh >> 4;
        { const int row = chunk_row(b, c, lane);
#pragma unroll
          for (int hh = 0; hh < 2; ++hh) { const int h = 2 * hq + hh; const float g = row >= 0 ? G[(size_t)row * 32 + h] : 0.f, bt = row >= 0 ? BETA[(size_t)row * 32 + h] : 0.f;
              const float gc = incl_scan64(g, lane); lg[hh * 64 + lane] = gc; lg[128 + hh * 64 + lane] = bt;
              const size_t uh = ((size_t)(b * 32 + h)) * NCH + c; GC[uh * 64 + lane] = gc; BT[uh * 64 + lane] = bt; } }
        const int row0 = chunk_row(b, c, m), row1 = chunk_row(b, c, 32 + m);
        const bf16* r0 = QKVC + (size_t)(row0 < 0 ? 0 : row0) * CDIM; const bf16* r1 = QKVC + (size_t)(row1 < 0 ? 0 : row1) * CDIM;
        f32x16 kk00, kk10, kk11, qk00, qk10, qk11;
#pragma unroll
        for (int i = 0; i < 16; ++i) { kk00[i] = 0.f; kk10[i] = 0.f; kk11[i] = 0.f; qk00[i] = 0.f; qk10[i] = 0.f; qk11[i] = 0.f; }
        const int sm = sw23(m);
        const int ktl = half * 32 + ((sm >> 4) & 1) * 512 + ((sm >> 3) & 1) * 256 + (sm & 7);
#pragma unroll 1
        for (int kh = 0; kh < 2; ++kh) {
            bf16x8 kf0[4], kf1[4], qf0[4], qf1[4];
#pragma unroll
            for (int u = 0; u < 4; ++u) { const int off = hq * 128 + 16 * (4 * kh + u) + 8 * half;
                kf0[u] = sel8(row0 >= 0, *(const bf16x8*)(r0 + 2048 + off)); kf1[u] = sel8(row1 >= 0, *(const bf16x8*)(r1 + 2048 + off));
                qf0[u] = sel8(row0 >= 0, *(const bf16x8*)(r0 + off)); qf1[u] = sel8(row1 >= 0, *(const bf16x8*)(r1 + off)); }
#pragma unroll
            for (int u = 0; u < 4; ++u) { const int ks = 4 * kh + u; const bf16x8 k0 = kf0[u], k1 = kf1[u], q0 = qf0[u], q1 = qf1[u];
                kk00 = MFMA32(k0, k0, kk00); kk10 = MFMA32(k1, k0, kk10); kk11 = MFMA32(k1, k1, kk11);
                qk00 = MFMA32(q0, k0, qk00); qk10 = MFMA32(q1, k0, qk10); qk11 = MFMA32(q1, k1, qk11);
                LAS bf16* kb = st + ktl + ((ks >> 1) & 1) * 2048 + (ks & 1) * 128;
#pragma unroll
                for (int e = 0; e < 8; ++e) { kb[(8 * (e >> 2) + (e & 3)) * 8] = (bf16)k0[e]; kb[1024 + (8 * (e >> 2) + (e & 3)) * 8] = (bf16)k1[e]; } }
            stage_out8k(stg, KT + (size_t)uq * 8192 + kh * 4096, lane);
        }
#pragma unroll 1
        for (int hh = 0; hh < 2; ++hh) { const int h = 2 * hq + hh; bf16* vt = VT + (((size_t)(b * 32 + h)) * NCH + c) * 8192;
            const int vtl = half * 64 + ((sm >> 4) & 1) * 512 + ((sm >> 3) & 1) * 256 + (sm & 7);
            bf16x8 vf0[8], vf1[8];
#pragma unroll
            for (int ks = 0; ks < 8; ++ks) { const int off = 4096 + h * 128 + 16 * ks + 8 * half; vf0[ks] = sel8(row0 >= 0, *(const bf16x8*)(r0 + off)); vf1[ks] = sel8(row1 >= 0, *(const bf16x8*)(r1 + off)); }
#pragma unroll
            for (int kh = 0; kh < 2; ++kh) {
#pragma unroll
                for (int u = 0; u < 4; ++u) { const int ks = 4 * kh + u; LAS bf16* vb = st + vtl + ((ks >> 1) & 1) * 2048 + (ks & 1) * 128;
#pragma unroll
                    for (int e = 0; e < 8; ++e) { vb[e * 8] = (bf16)vf0[ks][e]; vb[1024 + e * 8] = (bf16)vf1[ks][e]; } }
                stage_out8k(stg, vt + kh * 4096, lane);
            } }
        WAVE_SYNC();
#pragma unroll 1
        for (int hh = 0; hh < 2; ++hh) { const int h = 2 * hq + hh; const size_t uh = ((size_t)(b * 32 + h)) * NCH + c;
            float* af = AF + uh * 4096 + half * 256 + m;
            LAS bf16* pg = st + ktl;
            const float gcj0 = lg[hh * 64 + m], gcj1 = lg[hh * 64 + 32 + m];
#pragma unroll
            for (int r = 0; r < 16; ++r) { const int ir = crow32(r, half), rc = (r & 3) + 8 * (r >> 2);
                const float gi0 = lg[hh * 64 + ir], gi1 = lg[hh * 64 + 32 + ir], bi0 = lg[128 + hh * 64 + ir], bi1 = lg[128 + hh * 64 + 32 + ir];
                { const int i = ir, j = m; const float dec = __expf(fminf(gi0 - gcj0, 0.f)); af[rc * 64] = (j < i) ? bi0 * dec * kk00[r] : 0.f; pg[rc * 8] = f2bf((j <= i) ? dec * qk00[r] : 0.f); }
                { const int i = 32 + ir, j = m; const float dec = __expf(fminf(gi1 - gcj0, 0.f)); af[2048 + rc * 64] = bi1 * dec * kk10[r]; pg[2048 + rc * 8] = f2bf(dec * qk10[r]); }
                { const int i = 32 + ir, j = 32 + m; const float dec = __expf(fminf(gi1 - gcj1, 0.f)); af[2048 + 32 + rc * 64] = (j < i) ? bi1 * dec * kk11[r] : 0.f; pg[2048 + 1024 + rc * 8] = f2bf((j <= i) ? dec * qk11[r] : 0.f); }
            }
            stage_out8k(stg, PG + uh * 4096, lane); }
        WAVE_SYNC();
    }
}
__device__ __forceinline__ void delta_d2_unit(unsigned char* ws, LAS unsigned char* lds, int uh, int wave, int lane) {
    asm volatile("" : "+v"(lane));
    const float* AF = (const float*)(ws + WS_DAF); const float* GC = (const float*)(ws + WS_DGC); const float* BT = (const float*)(ws + WS_DBT);
    bf16* TG = (bf16*)(ws + WS_DTG); bf16* TB = (bf16*)(ws + WS_DTB);
    {
        const float* af = AF + (size_t)uh * 4096;
        const float bc = BT[(size_t)uh * 64 + lane], gmc = __expf(GC[(size_t)uh * 64 + lane]);
        float T[64];
        const bool pad0 = (uh % NCH) == 0;
#pragma unroll
        for (int i0 = 0; i0 < 64; i0 += 16) {
            float ar[16];
#pragma unroll
            for (int u = 0; u < 16; ++u) ar[u] = af[(i0 + u) * 64 + lane];
            if (pad0 && i0 < 32) {
#pragma unroll
                for (int u = 0; u < 16; ++u) T[i0 + u] = (lane == i0 + u) ? 1.f : 0.f;
            } else {
#pragma unroll
                for (int u = 0; u < 16; ++u) { const int i = i0 + u; float pa[4] = {(lane == i) ? 1.f : 0.f, 0.f, 0.f, 0.f};
#pragma unroll
                    for (int j = 0; j < i; ++j) pa[j & 3] -= __int_as_float(__builtin_amdgcn_readlane(__float_as_int(ar[u]), j)) * T[j];
                    T[i] = (pa[0] + pa[1]) + (pa[2] + pa[3]); }
            }
        }
        bf16* tg = TG + (size_t)uh * 4096; bf16* tb = TB + (size_t)uh * 4096;
        const float sg = bc * gmc;
        const int cs = (lane & ~31) + sw23(lane & 31);
        const int lcol = (cs >> 4) * 512 + ((cs >> 3) & 1) * 256 + (cs & 7);
        LAS unsigned char* stg = lds + wave * 16384 + 2048; LAS bf16* st = (LAS bf16*)stg;
#pragma unroll
        for (int i = 0; i < 64; ++i) st[(i >> 5) * 2048 + (i & 31) * 8 + lcol] = f2bf(T[i] * sg);
        stage_out8k(stg, tg, lane);
#pragma unroll
        for (int i = 0; i < 64; ++i) st[(i >> 5) * 2048 + (i & 31) * 8 + lcol] = f2bf(T[i] * bc);
        stage_out8k(stg, tb, lane);
    }
}
__device__ __forceinline__ void delta_d3_unit(unsigned char* ws, int uh, int lane) {
    asm volatile("" : "+v"(lane));
    const bf16* TG = (const bf16*)(ws + WS_DTG); const bf16* TB = (const bf16*)(ws + WS_DTB); const bf16* KT = (const bf16*)(ws + WS_DKT); const bf16* VT = (const bf16*)(ws + WS_DVT);
    bf16* WG = (bf16*)(ws + WS_DWG); bf16* UG = (bf16*)(ws + WS_DUG);
    const int m = lane & 31, half = lane >> 5;
    const int c = uh % NCH, bh = uh / NCH, h = bh & 31, b = bh >> 5;
    const size_t uq = ((size_t)(b * 16 + (h >> 1))) * NCH + c;
    {
        const bf16* Tm = TG + (size_t)uh * 4096; const bf16* Kf = KT + uq * 8192;
        f32x16 acc[4][2];
#pragma unroll
        for (int dn = 0; dn < 4; ++dn)
#pragma unroll
            for (int ti = 0; ti < 2; ++ti)
#pragma unroll
                for (int i = 0; i < 16; ++i) acc[dn][ti][i] = 0.f;
#pragma unroll
        for (int ks = 0; ks < 4; ++ks) {
            bf16x8 a[4], bb[2];
#pragma unroll
            for (int dn = 0; dn < 4; ++dn) a[dn] = *(const bf16x8*)(Kf + ((size_t)(((dn * 2 + (ks >> 1)) * 2 + (ks & 1)) * 64 + lane)) * 8);
#pragma unroll
            for (int ti = 0; ti < 2; ++ti) bb[ti] = *(const bf16x8*)(Tm + ((size_t)((ti * 4 + ks) * 64 + lane)) * 8);
#pragma unroll
            for (int dn = 0; dn < 4; ++dn)
#pragma unroll
                for (int ti = 0; ti < 2; ++ti) acc[dn][ti] = MFMA32(a[dn], bb[ti], acc[dn][ti]);
        }
        bf16* wg = WG + (size_t)uh * 8192;
#pragma unroll
        for (int dn = 0; dn < 4; ++dn)
#pragma unroll
            for (int ti = 0; ti < 2; ++ti)
#pragma unroll
                for (int s2 = 0; s2 < 2; ++s2) *(v4u*)(wg + ((size_t)(((ti * 4 + dn) * 2 + s2) * 64 + lane)) * 8) = pack_frag(acc[dn][ti], s2);
    }
    {
        const bf16* Tm = TB + (size_t)uh * 4096; const bf16* Bt = VT + (size_t)uh * 8192;
        f32x16 acc[2][4];
#pragma unroll
        for (int ti = 0; ti < 2; ++ti)
#pragma unroll
            for (int dn = 0; dn < 4; ++dn)
#pragma unroll
                for (int i = 0; i < 16; ++i) acc[ti][dn][i] = 0.f;
#pragma unroll
        for (int ks = 0; ks < 4; ++ks) {
            bf16x8 a[2], bb[4];
#pragma unroll
            for (int ti = 0; ti < 2; ++ti) a[ti] = *(const bf16x8*)(Tm + ((size_t)((ti * 4 + ks) * 64 + lane)) * 8);
#pragma unroll
            for (int dn = 0; dn < 4; ++dn) bb[dn] = *(const bf16x8*)(Bt + ((size_t)((dn * 4 + ks) * 64 + lane)) * 8);
#pragma unroll
            for (int ti = 0; ti < 2; ++ti)
#pragma unroll
                for (int dn = 0; dn < 4; ++dn) acc[ti][dn] = MFMA32(a[ti], bb[dn], acc[ti][dn]);
        }
        bf16* ug = UG + (size_t)uh * 8192;
#pragma unroll
        for (int ti = 0; ti < 2; ++ti)
#pragma unroll
            for (int dn = 0; dn < 4; ++dn) { bf16* p = ug + ((size_t)((ti * 4 + dn) * 64 + lane)) * 16; *(v4u*)p = pack_frag(acc[ti][dn], 0); *(v4u*)(p + 8) = pack_frag(acc[ti][dn], 1); }
    }
}
__device__ __forceinline__ void delta_d23_unit(unsigned char* ws, LAS unsigned char* lds, int uh, int wave, int lane) {
    asm volatile("" : "+v"(lane));
    const float* AF = (const float*)(ws + WS_DAF); const float* GC = (const float*)(ws + WS_DGC); const float* BT = (const float*)(ws + WS_DBT);
    const bf16* KT = (const bf16*)(ws + WS_DKT); const bf16* VT = (const bf16*)(ws + WS_DVT);
    bf16* WG = (bf16*)(ws + WS_DWG); bf16* UG = (bf16*)(ws + WS_DUG);
    const float* af = AF + (size_t)uh * 4096;
    const float bc = BT[(size_t)uh * 64 + lane], gmc = __expf(GC[(size_t)uh * 64 + lane]);
    const int c = uh % NCH, bh = uh / NCH, h = bh & 31, b = bh >> 5;
    const size_t uq = ((size_t)(b * 16 + (h >> 1))) * NCH + c;
    float T[64];
    const bool pad0 = c == 0;
    float ar[16], an[16];
#pragma unroll
    for (int u = 0; u < 16; ++u) ar[u] = af[u * 64 + lane];
#pragma unroll
    for (int i0 = 0; i0 < 64; i0 += 16) {
        if (i0 + 16 < 64) {
#pragma unroll
            for (int u = 0; u < 16; ++u) an[u] = af[(i0 + 16 + u) * 64 + lane];
        }
        if (pad0 && i0 < 32) {
#pragma unroll
            for (int u = 0; u < 16; ++u) T[i0 + u] = (lane == i0 + u) ? 1.f : 0.f;
        } else {
#pragma unroll
            for (int u = 0; u < 16; ++u) { const int i = i0 + u; float pa[4] = {(lane == i) ? 1.f : 0.f, 0.f, 0.f, 0.f};
#pragma unroll
                for (int j = 0; j < i; ++j) pa[j & 3] -= __int_as_float(__builtin_amdgcn_readlane(__float_as_int(ar[u]), j)) * T[j];
                T[i] = (pa[0] + pa[1]) + (pa[2] + pa[3]); }
        }
#pragma unroll
        for (int u = 0; u < 16; ++u) ar[u] = an[u];
    }
    const bf16* Kf = KT + uq * 8192;
    bf16x8 ka[4][4];
    asm volatile("" ::: "memory");
#pragma unroll
    for (int ks = 0; ks < 4; ++ks)
#pragma unroll
        for (int dn = 0; dn < 2; ++dn) ka[ks][dn] = *(const bf16x8*)(Kf + ((size_t)(((dn * 2 + (ks >> 1)) * 2 + (ks & 1)) * 64 + lane)) * 8);
    const float sg = bc * gmc;
    const int cs = (lane & ~31) + sw23(lane & 31);
    const int lcol = (cs >> 4) * 512 + ((cs >> 3) & 1) * 256 + (cs & 7);
    LAS unsigned char* stg = lds + wave * 16384 + 2048; LAS bf16* st = (LAS bf16*)stg;
    bf16x8 tf[2][4];
    WAVE_SYNC();
#pragma unroll
    for (int i = 0; i < 64; ++i) st[(i >> 5) * 2048 + (i & 31) * 8 + lcol] = f2bf(T[i] * sg);
    WAVE_SYNC();
#pragma unroll
    for (int ti = 0; ti < 2; ++ti)
#pragma unroll
        for (int ks = 0; ks < 4; ++ks) tf[ti][ks] = *(const LAS bf16x8*)(st + ((ti * 4 + ks) * 64 + lane) * 8);
    WAVE_SYNC();
#pragma unroll
    for (int i = 0; i < 64; ++i) st[(i >> 5) * 2048 + (i & 31) * 8 + lcol] = f2bf(T[i] * bc);
    WAVE_SYNC();
    const bf16* Bt = VT + (size_t)uh * 8192;
    bf16x8 vb[4][4];
#pragma unroll
    for (int ks = 0; ks < 4; ++ks)
#pragma unroll
        for (int dn = 2; dn < 4; ++dn) ka[ks][dn] = *(const bf16x8*)(Kf + ((size_t)(((dn * 2 + (ks >> 1)) * 2 + (ks & 1)) * 64 + lane)) * 8);
    asm volatile("" ::: "memory");
    {
        bf16* wg = WG + (size_t)uh * 8192;
#pragma unroll
        for (int dp = 0; dp < 2; ++dp) {
            f32x16 acc[2][2];
#pragma unroll
            for (int d2 = 0; d2 < 2; ++d2)
#pragma unroll
                for (int ti = 0; ti < 2; ++ti)
#pragma unroll
                    for (int i = 0; i < 16; ++i) acc[d2][ti][i] = 0.f;
#pragma unroll
            for (int ks = 0; ks < 4; ++ks)
#pragma unroll
                for (int d2 = 0; d2 < 2; ++d2)
#pragma unroll
                    for (int ti = 0; ti < 2; ++ti) acc[d2][ti] = MFMA32(ka[ks][2 * dp + d2], tf[ti][ks], acc[d2][ti]);
#pragma unroll
            for (int d2 = 0; d2 < 2; ++d2)
#pragma unroll
                for (int ti = 0; ti < 2; ++ti)
#pragma unroll
                    for (int s2 = 0; s2 < 2; ++s2) *(v4u*)(wg + ((size_t)(((ti * 4 + 2 * dp + d2) * 2 + s2) * 64 + lane)) * 8) = pack_frag(acc[d2][ti], s2);
            if (dp == 0) {
                asm volatile("" ::: "memory");
#pragma unroll
                for (int ks = 0; ks < 2; ++ks)
#pragma unroll
                    for (int dn = 0; dn < 4; ++dn) vb[ks][dn] = *(const bf16x8*)(Bt + ((size_t)((dn * 4 + ks) * 64 + lane)) * 8);
                asm volatile("" ::: "memory");
            }
        }
    }
    asm volatile("" ::: "memory");
#pragma unroll
    for (int ks = 2; ks < 4; ++ks)
#pragma unroll
        for (int dn = 0; dn < 4; ++dn) vb[ks][dn] = *(const bf16x8*)(Bt + ((size_t)((dn * 4 + ks) * 64 + lane)) * 8);
#pragma unroll
    for (int ti = 0; ti < 2; ++ti)
#pragma unroll
        for (int ks = 0; ks < 4; ++ks) tf[ti][ks] = *(const LAS bf16x8*)(st + ((ti * 4 + ks) * 64 + lane) * 8);
    {
        bf16* ug = UG + (size_t)uh * 8192;
#pragma unroll
        for (int ti = 0; ti < 2; ++ti) {
            f32x16 acc[4];
#pragma unroll
            for (int dn = 0; dn < 4; ++dn)
#pragma unroll
                for (int i = 0; i < 16; ++i) acc[dn][i] = 0.f;
#pragma unroll
            for (int ks = 0; ks < 4; ++ks)
#pragma unroll
                for (int dn = 0; dn < 4; ++dn) acc[dn] = MFMA32(tf[ti][ks], vb[ks][dn], acc[dn]);
#pragma unroll
            for (int dn = 0; dn < 4; ++dn) { bf16* p = ug + ((size_t)((ti * 4 + dn) * 64 + lane)) * 16; *(v4u*)p = pack_frag(acc[dn], 0); *(v4u*)(p + 8) = pack_frag(acc[dn], 1); }
        }
    }
    WAVE_SYNC();
}
__device__ __forceinline__ void delta_pre(unsigned char* ws, LAS unsigned char* lds, int gw, int NGW, int wave, int lane) {
    const int nextra = (NUQ > NGW && NUQ < 2 * NGW) ? NUQ - NGW : 0;
    for (int rep = 0; rep < 2 || nextra == 0; ++rep) {
        int uq;
        if (nextra == 0) { uq = gw + rep * NGW; if (uq >= NUQ) break; }
        else if (rep == 0) uq = gw;
        else { if ((gw & 63) != 0 || (gw >> 6) >= nextra) break; uq = NGW + (gw >> 6); }
#ifndef NO_D1
        delta_d1_unit(ws, lds, uq, wave, lane);
#endif
#ifdef DUP_D1
        delta_d1_unit(ws, lds, uq, wave, lane);
#endif
        asm volatile("s_waitcnt vmcnt(0)" ::: "memory");
        const int c = uq % NCH, bh = uq / NCH, hq = bh & 15, b = bh >> 4;
#pragma unroll 1
        for (int hh = 0; hh < 2; ++hh) { const int uh = (b * 32 + 2 * hq + hh) * NCH + c;
#ifndef NO_D23FUSE
            delta_d23_unit(ws, lds, uh, wave, lane);
#ifdef DUP_D23
            delta_d23_unit(ws, lds, uh, wave, lane);
#endif
            continue;
#endif
#ifndef NO_D2
            delta_d2_unit(ws, lds, uh, wave, lane);
#endif
#ifdef DUP_D2
            delta_d2_unit(ws, lds, uh, wave, lane);
#endif
            asm volatile("s_waitcnt vmcnt(0)" ::: "memory");
#ifndef NO_D3
            delta_d3_unit(ws, uh, lane);
#endif
#ifdef DUP_D3
            delta_d3_unit(ws, uh, lane);
#endif
        }
    }
}
__device__ __forceinline__ bf16x8 afrag_perm(const bf16* rowp, int blk, int s, int half) {
    const v2u lo = *(const v2u*)(rowp + 32 * blk + 16 * s + 4 * half), hi2 = *(const v2u*)(rowp + 32 * blk + 16 * s + 8 + 4 * half);
    v4u w; w.x = lo.x; w.y = lo.y; w.z = hi2.x; w.w = hi2.y; return __builtin_bit_cast(bf16x8, w);
}
#define LBAR() asm volatile("s_waitcnt lgkmcnt(0)\n\ts_barrier" ::: "memory")
__device__ __forceinline__ void delta_d4(unsigned char* ws, float* out_state, LAS unsigned char* lds, int tid, int wave, int lane) {
    const bf16* QKVC = (const bf16*)(ws + WS_QKVC); const bf16* KT = (const bf16*)(ws + WS_DKT); const bf16* PG = (const bf16*)(ws + WS_DPG);
    const bf16* WG = (const bf16*)(ws + WS_DWG); const bf16* UG = (const bf16*)(ws + WS_DUG); const float* GC = (const float*)(ws + WS_DGC);
    bf16* OF = (bf16*)(ws + WS_SC);
    LAS v4u* Sfr = (LAS v4u*)lds;
    LAS v4u* Dfr = (LAS v4u*)(lds + 16384);
    LAS v4u* Dtf = (LAS v4u*)(lds + 16384 + 4096);
    LAS float* gam = (LAS float*)(lds + 16384 + 8192);
    const int m = lane & 31, half = lane >> 5;
    const bf16x8 zf = {0, 0, 0, 0, 0, 0, 0, 0};
    for (int item = blockIdx.x; item < NBP * 32 * 4; item += gridDim.x) {
        const int xg = item & 7, jj = item >> 3, pair = xg * 4 + (jj >> 3), q = jj & 3, h = 2 * (pair & 15) + ((jj >> 2) & 1), b = pair >> 4;
        const size_t uh0 = ((size_t)(b * 32 + h)) * NCH, uq0 = ((size_t)(b * 16 + (h >> 1))) * NCH;
        const int rt = wave & 1; const bool isq = wave >= 6;
#define ROT3(LOADM, STEPM) do { LOADM(0, 0); LOADM(1, 1); \
            for (int c = 0; c < NCH; c += 3) { \
                if (c + 2 < NCH) LOADM(c + 2, 2); \
                STEPM(c, 0); \
                if (c + 1 < NCH) { if (c + 3 < NCH) LOADM(c + 3, 0); STEPM(c + 1, 1); } \
                if (c + 2 < NCH) { if (c + 4 < NCH) LOADM(c + 4, 1); STEPM(c + 2, 2); } } } while (0)
#define ROT2(LOADM, STEPM) do { LOADM(0, 0); \
            for (int c = 0; c < NCH; c += 2) { \
                if (c + 1 < NCH) LOADM(c + 1, 1); \
                STEPM(c, 0); \
                if (c + 1 < NCH) { if (c + 2 < NCH) LOADM(c + 2, 0); STEPM(c + 1, 1); } } } while (0)
        LBAR();
        if (wave < 4) {
            int ll_ = lane; asm volatile("" : "+v"(ll_)); const int lane = ll_, m = lane & 31, half = lane >> 5; (void)m; (void)half;
            { const v4u z = {0u, 0u, 0u, 0u}; Sfr[(0 * 4 + wave) * 128 + lane] = z; Sfr[(0 * 4 + wave) * 128 + 64 + lane] = z; }
            bf16x8 kf[2][4];
            f32x16 S;
#pragma unroll
            for (int i = 0; i < 16; ++i) S[i] = 0.f;
#define LOAD_K(cc, B) do { const bf16* kr_ = KT + (uq0 + (cc)) * 8192; \
                _Pragma("unroll") for (int blk = 0; blk < 2; ++blk) _Pragma("unroll") for (int s_ = 0; s_ < 2; ++s_) kf[B][blk * 2 + s_] = *(const bf16x8*)(kr_ + ((size_t)(((wave * 2 + blk) * 2 + s_) * 64 + lane)) * 8); } while (0)
#define STEP_K(c, B) do { const int bufc = (c) & 1; LBAR(); LBAR(); \
                const float gl = gam[bufc * 64 + 63]; \
                _Pragma("unroll") for (int i = 0; i < 16; ++i) S[i] *= gl; \
                _Pragma("unroll") for (int blk = 0; blk < 2; ++blk) _Pragma("unroll") for (int s = 0; s < 2; ++s) S = MFMA32(kf[B][blk * 2 + s], __builtin_bit_cast(bf16x8, Dtf[(blk * 2 + s) * 64 + lane]), S); \
                _Pragma("unroll") for (int s = 0; s < 2; ++s) Sfr[((bufc ^ 1) * 4 + wave) * 128 + s * 64 + lane] = pack_frag(S, s); } while (0)
#ifndef NO_RK
            ROT2(LOAD_K, STEP_K);
#endif
            { float* o = out_state + ((size_t)((b * 32 + h) * 128 + 32 * wave)) * 128 + 32 * q + m;
#pragma unroll
              for (int r = 0; r < 16; ++r) o[(size_t)sw23(crow32(r, half)) * 128] = S[r]; }
#undef LOAD_K
#undef STEP_K
        } else if (!isq) {
            int ll_ = lane; asm volatile("" : "+v"(ll_)); const int lane = ll_, m = lane & 31, half = lane >> 5; (void)m; (void)half;
            bf16x8 wf[3][8], uf[3][2]; float gcv[3] = {0.f, 0.f, 0.f};
#define LOAD_W(cc, B) do { const bf16* wb_ = WG + (uh0 + (cc)) * 8192 + ((size_t)(rt * 512 + lane)) * 8; \
                _Pragma("unroll") for (int blk = 0; blk < 4; ++blk) _Pragma("unroll") for (int s_ = 0; s_ < 2; ++s_) wf[B][blk * 2 + s_] = *(const bf16x8*)(wb_ + blk * 1024 + s_ * 512); \
                const bf16* ub_ = UG + (uh0 + (cc)) * 8192 + ((size_t)((rt * 4 + q) * 64 + lane)) * 16; uf[B][0] = *(const bf16x8*)ub_; uf[B][1] = *(const bf16x8*)(ub_ + 8); \
                if (wave == 4) gcv[B] = GC[(uh0 + (cc)) * 64 + lane]; } while (0)
#define STEP_W(c, B) do { const int bufc = (c) & 1; LBAR(); \
                f32x16 acc; \
                _Pragma("unroll") for (int i = 0; i < 16; ++i) acc[i] = 0.f; \
                _Pragma("unroll") for (int blk = 0; blk < 4; ++blk) _Pragma("unroll") for (int s = 0; s < 2; ++s) \
                    acc = MFMA32(wf[B][blk * 2 + s], __builtin_bit_cast(bf16x8, Sfr[(bufc * 4 + blk) * 128 + s * 64 + lane]), acc); \
                { float t8[8]; unpack8(__builtin_bit_cast(v4u, uf[B][0]), t8); \
                    _Pragma("unroll") for (int i = 0; i < 8; ++i) acc[i] = t8[i] - acc[i]; unpack8(__builtin_bit_cast(v4u, uf[B][1]), t8); \
                    _Pragma("unroll") for (int i = 0; i < 8; ++i) acc[8 + i] = t8[i] - acc[8 + i]; } \
                _Pragma("unroll") for (int s = 0; s < 2; ++s) Dfr[(rt * 2 + s) * 64 + lane] = pack_frag(acc, s); \
                _Pragma("unroll") for (int r = 0; r < 16; ++r) acc[r] *= gam[128 + bufc * 64 + 32 * rt + crow32(r, half)]; \
                _Pragma("unroll") for (int s = 0; s < 2; ++s) Dtf[(rt * 2 + s) * 64 + lane] = pack_frag(acc, s); \
                LBAR(); \
                if (wave == 4 && (c) + 1 < NCH) { const float gn_ = gcv[((B) + 1) % 3], gl_ = __shfl(gn_, 63); gam[(bufc ^ 1) * 64 + lane] = __expf(gn_); gam[128 + (bufc ^ 1) * 64 + lane] = __expf(gl_ - gn_); } } while (0)
            if (wave == 4) { const float gc = GC[(uh0 + 0) * 64 + lane], gl = __shfl(gc, 63); gam[lane] = __expf(gc); gam[128 + lane] = __expf(gl - gc); }
#ifndef NO_RW
            ROT3(LOAD_W, STEP_W);
#endif
#undef LOAD_W
#undef STEP_W
        } else {
            int ll_ = lane; asm volatile("" : "+v"(ll_)); const int lane = ll_, m = lane & 31, half = lane >> 5; (void)m; (void)half;
            bf16x8 qf[1][8], pf[1][4];
#define LOAD_Q(cc, B) do { const int row_ = chunk_row(b, (cc), 32 * rt + m); const bool ok_ = row_ >= 0; \
                const bf16* qb_ = QKVC + (size_t)(row_ < 0 ? 0 : row_) * CDIM + (h >> 1) * 128 + 8 * half; \
                _Pragma("unroll") for (int blk = 0; blk < 4; ++blk) _Pragma("unroll") for (int s_ = 0; s_ < 2; ++s_) qf[B][blk * 2 + s_] = sel8(ok_, *(const bf16x8*)(qb_ + blk * 32 + s_ * 16)); \
                } while (0)
#define LOAD_P(cc, PB) do { const bf16* pb_ = PG + (uh0 + (cc)) * 4096 + ((size_t)(rt * 256 + lane)) * 8; \
                _Pragma("unroll") for (int blk = 0; blk < 2; ++blk) _Pragma("unroll") for (int s_ = 0; s_ < 2; ++s_) pf[PB][blk * 2 + s_] = sel8(blk <= rt, *(const bf16x8*)(pb_ + blk * 1024 + s_ * 512)); } while (0)
#define STEP_Q(c) do { const int bufc = (c) & 1; LBAR(); \
                LOAD_P((c), 0);                                                    \
                f32x16 acc; \
                _Pragma("unroll") for (int i = 0; i < 16; ++i) acc[i] = 0.f; \
                _Pragma("unroll") for (int blk = 0; blk < 4; ++blk) _Pragma("unroll") for (int s = 0; s < 2; ++s) \
                    acc = MFMA32(qf[0][blk * 2 + s], __builtin_bit_cast(bf16x8, Sfr[(bufc * 4 + blk) * 128 + s * 64 + lane]), acc); \
                if ((c) + 1 < NCH) LOAD_Q((c) + 1, 0);                             \
                LBAR(); \
                _Pragma("unroll") for (int r = 0; r < 16; ++r) acc[r] *= gam[bufc * 64 + 32 * rt + crow32(r, half)]; \
                _Pragma("unroll") for (int blk = 0; blk < 2; ++blk) _Pragma("unroll") for (int s = 0; s < 2; ++s) acc = MFMA32(pf[0][blk * 2 + s], __builtin_bit_cast(bf16x8, Dfr[(blk * 2 + s) * 64 + lane]), acc); \
                _Pragma("unroll") for (int r = 0; r < 16; ++r) { const int row = chunk_row(b, (c), 32 * rt + crow32(r, half)); if (row >= 0) OF[(size_t)row * DVW + h * 128 + 32 * q + m] = f2bf(acc[r]); } } while (0)
#ifndef NO_RQ
            LOAD_Q(0, 0);
            for (int c = 0; c < NCH; ++c) STEP_Q(c);
#endif
#undef LOAD_Q
#undef LOAD_P
#undef STEP_Q
        }
#undef ROT2
#undef ROT3
    }
    LBAR();
}
#undef LBAR
#undef MFMA32
template <int RT, int CT, int UNR = 4, class Epi>
__device__ __forceinline__ void small_gemm_unit(const bf16* A, int lda, const bf16* Bt, int ldb, int k0, int klen, LAS unsigned char* lds, const Epi& E, int tid, int wave, int lane) {
    const int r16 = lane & 15, q = lane >> 4;
    const int kw = klen >> 3;
    const bf16* ap = A + (size_t)r16 * lda + k0 + wave * kw + 8 * q;
    const bf16* bp = Bt + (size_t)r16 * ldb + k0 + wave * kw + 8 * q;
    pg8::f32x4 acc[RT][CT];
#pragma unroll
    for (int i = 0; i < RT; ++i)
#pragma unroll
        for (int j = 0; j < CT; ++j) acc[i][j] = (pg8::f32x4){0.f, 0.f, 0.f, 0.f};
#pragma unroll UNR
    for (int ks = 0; ks < kw; ks += 32) {
        bf16x8 a[RT], b[CT];
#pragma unroll
        for (int i = 0; i < RT; ++i) a[i] = *(const bf16x8*)(ap + (size_t)(16 * i) * lda + ks);
#pragma unroll
        for (int j = 0; j < CT; ++j) b[j] = *(const bf16x8*)(bp + (size_t)(16 * j) * ldb + ks);
#pragma unroll
        for (int i = 0; i < RT; ++i)
#pragma unroll
            for (int j = 0; j < CT; ++j) acc[i][j] = __builtin_amdgcn_mfma_f32_16x16x32_bf16(a[i], b[j], acc[i][j], 0, 0, 0);
    }
    constexpr int NOUT = 256 * RT * CT;
    LAS float* part = (LAS float*)lds + wave * NOUT;
#pragma unroll
    for (int i = 0; i < RT; ++i)
#pragma unroll
        for (int j = 0; j < CT; ++j)
#pragma unroll
            for (int e = 0; e < 4; ++e) part[(16 * i + 4 * q + e) * (16 * CT) + 16 * j + r16] = acc[i][j][e];
    __syncthreads();
    for (int o = tid; o < NOUT; o += NTHREADS) { float sum = 0.f;
#pragma unroll
        for (int w = 0; w < 8; ++w) sum += ((LAS float*)lds)[w * NOUT + o];
        E(o / (16 * CT), o % (16 * CT), sum); }
    __syncthreads();
}
template <int ACT> struct SEpiRowsBf16 { bf16* O; int ldc; __device__ __forceinline__ void operator()(int row, int col, float v) const { if (ACT == 2) { v = v > 0.f ? v : 0.f; v = v * v; } O[(size_t)row * ldc + col] = f2bf(v); } };
struct SEpiF32 { float* O; int ldc; __device__ __forceinline__ void operator()(int row, int col, float v) const { O[(size_t)row * ldc + col] = v; } };
struct SEpiColsBf16 { bf16* O; int ldc; __device__ __forceinline__ void operator()(int row, int col, float v) const { O[(size_t)col * ldc + row] = f2bf(v); } };
template <int ACT> __device__ __forceinline__ void skinny_rows_bf16(const bf16* A, const bf16* Wt, int K, int nunits, bf16* O, int ldc, LAS unsigned char* lds, int tid, int wave, int lane) {
    for (int u = blockIdx.x; u < 2 * nunits; u += gridDim.x) { SEpiRowsBf16<ACT> E{O + (size_t)XROW0 * ldc + u * 32, ldc};
        small_gemm_unit<3, 2, 8>(A + (size_t)XROW0 * K, K, Wt + (size_t)u * 32 * K, K, 0, K, lds, E, tid, wave, lane); }
}
__device__ __forceinline__ void skinny_rows_part(const bf16* A, const bf16* Wt, int K, float* ZP, LAS unsigned char* lds, int tid, int wave, int lane) {
    for (int u = blockIdx.x; u < 256; u += gridDim.x) { const int cgp = u & 31, ksl = u >> 5; SEpiF32 E{ZP + (size_t)ksl * XR * DM + cgp * 64, DM};
        small_gemm_unit<3, 4>(A + (size_t)XROW0 * K, K, Wt + (size_t)cgp * 64 * K, K, ksl * (K >> 3), K >> 3, lds, E, tid, wave, lane); }
}
template <int RT> __device__ __forceinline__ void tail_cols_bf16(const bf16* A, const bf16* Wt, int K, int c0, bf16* O, int ldc, LAS unsigned char* lds, int tid, int wave, int lane) {
    for (int u = blockIdx.x; u < MAINM / 32; u += gridDim.x) { SEpiColsBf16 E{O + (size_t)u * 32 * ldc + c0, ldc};
        small_gemm_unit<RT, 2>(Wt + (size_t)c0 * K, K, A + (size_t)u * 32 * K, K, 0, K, lds, E, tid, wave, lane); }
}

typedef __attribute__((address_space(4))) const unsigned long long* kargq_t;
#define KPF_(k) ((const float*)(const GAS float*)(q_[k]))
__device__ __forceinline__ void load_ptrs(Ptrs& P) {
    kargq_t q_ = (kargq_t)__builtin_amdgcn_kernarg_segment_ptr();
    asm volatile("" : "+s"(q_));
    P.x_prompt = KPF_(0); P.x_sample = KPF_(1); P.state_conv_a = KPF_(2); P.cache_k = KPF_(3);
    P.cache_v = KPF_(4); P.cache_ik = KPF_(5); P.state_conv_c = KPF_(6); P.state_delta = KPF_(7);
    P.page_table = ((const int*)(const GAS int*)(q_[8])); P.meta = KPF_(9); P.w_in_a = KPF_(10); P.conv_w_a = KPF_(11);
    P.w_out_a = KPF_(12); P.w_in_b = KPF_(13); P.w_out_b = KPF_(14); P.w_in_c = KPF_(15);
    P.conv_w_c = KPF_(16); P.a_log = KPF_(17); P.dt_bias = KPF_(18); P.norm_w = KPF_(19);
    P.w_out_c = KPF_(20); P.ln1_g = KPF_(21); P.ln1_b = KPF_(22); P.w1 = KPF_(23);
    P.w2 = KPF_(24); P.ln2_g = KPF_(25); P.ln2_b = KPF_(26);
    P.out = (float*)(GAS float*)(q_[27]); P.ws = (unsigned char*)(GAS unsigned char*)(q_[28]);
}
struct Args { const void* in[27]; float* out; unsigned char* ws; int ph_lo, ph_hi; };
constexpr int PH_PER_LAYER = 12, PH_END = 1 + 4 * PH_PER_LAYER;

__global__ void __launch_bounds__(NTHREADS, 2) mega_fwd(Args args) {
    extern __shared__ __attribute__((aligned(16))) unsigned char lds_raw[];
    LAS unsigned char* lds = (LAS unsigned char*)lds_raw;
    const int tid = threadIdx.x, lane = tid & 63, wave = __builtin_amdgcn_readfirstlane(tid >> 6);
    const int G_ = gridDim.x, NGW = G_ * NWAVES, NT = G_ * NTHREADS; (void)lane;
    unsigned char* ws = args.ws;
    const int lo = args.ph_lo, hi = args.ph_hi;
    const bool fused = (hi - lo) > 1;

    for (int u = tid; u < (LDS_BYTES - LDSCTL_OFF) / 4; u += NTHREADS) ((LAS unsigned*)(lds + LDSCTL_OFF))[u] = 0u;
    __syncthreads();
    volatile LAS unsigned* MISC = (volatile LAS unsigned*)(lds + MISC_OFF);
    XcdBarrier bar; bar.bar = (unsigned*)(ws + WS_CTL) + CW_BAR; bar.x = 0; bar.st = nullptr;
    if (fused) bar = xcd_barrier_post((unsigned*)(ws + WS_CTL) + CW_BAR, MISC + 8);
    bar.wv = wave;

#ifndef MK_SITES
#define MK_SITES 0xffffffffu
#endif
#define SITE(n) (((MK_SITES) >> (n)) & 1u)
#define IN(k) (lo <= (k) && (k) < hi)
#ifndef MK_DUP
#define MK_DUP 0u
#endif
#define NREP(n) ((((MK_DUP) >> (n)) & 1u) ? 2 : 1)
#ifdef MK_SKINNY2
#define SKREP 2
#else
#define SKREP 1
#endif
#define BEGIN_SITE(n, id) if (SITE(n) && IN(id)) { for (int rp_ = 0; rp_ < NREP(n); ++rp_) { Ptrs P; load_ptrs(P); unsigned char* ws = P.ws; (void)ws; \
    bf16* X = (bf16*)(P.ws + WS_X); float* Z = (float*)(P.ws + WS_Z); float* ZP = (float*)(P.ws + WS_ZP); bf16* Y = (bf16*)(P.ws + WS_Y); bf16* BIG = (bf16*)(P.ws + WS_BIG); (void)X; (void)Z; (void)ZP; (void)Y; (void)BIG;
#define END_SITE(id) SEAM(id); } }
#define LOCALS int tid_ = threadIdx.x; asm volatile("" : "+v"(tid_)); const int lane_ = tid_ & 63, wave_ = __builtin_amdgcn_readfirstlane(tid_ >> 6), gw_ = blockIdx.x * NWAVES + wave_, gtid_ = blockIdx.x * NTHREADS + tid_; (void)lane_; (void)wave_; (void)gw_; (void)gtid_
#define SEAM(k) do { if (fused && (k) + 1 < PH_END) xcd_barrier(bar); else __syncthreads(); } while (0)


    BEGIN_SITE(0, 0) LOCALS; p0_prologue(P, lds, gw_, NGW, wave_, lane_); END_SITE(0)
#ifdef MK_XBAR
    if (fused) { for (int xb_ = 0; xb_ < MK_XBAR; ++xb_) xcd_barrier(bar); }
#endif

    for (int layer = 0; layer < 4; ++layer) {
        const int kind = layer % 3, j = layer / 3, base = 1 + layer * PH_PER_LAYER;
        if (kind == 0) {
            BEGIN_SITE(1, base + 0)
                const bf16* Wt = (const bf16*)(ws + WS_WA_IN + (size_t)j * WSZ_A_IN); pg8::Gemm g{X, Wt, MAINM, NA_IN, DM}; pg8::StaticOrder S; S.init(MAINM, NA_IN, G_, (int)blockIdx.x);
                pg8::EpiBf16<0> E{BIG, NA_IN, nullptr, 0, 0, 1.f};
                pg8::gemm_phase<pg8::EpiBf16<0>, pg8::StaticOrder, true, true>(lds, g, S, E, wave);
                { LOCALS; for (int sk_ = 0; sk_ < SKREP; ++sk_) { skinny_rows_bf16<0>(X, Wt, DM, NA_IN / 64, BIG, NA_IN, lds, tid_, wave_, lane_); } }
                END_SITE(base + 0)
            BEGIN_SITE(2, base + 1)
                LOCALS; convA_phase(BIG, Y, P.conv_w_a + (size_t)j * 3 * DM, P.state_conv_a + (size_t)j * SBN * 2 * DM, P.out + O_CAP + (size_t)j * NBP * 2 * DM, P.out + O_CAS + (size_t)j * SBN * 2 * DM, gtid_, NT);
                END_SITE(base + 1)
            BEGIN_SITE(3, base + 2)
                const bf16* Wt = (const bf16*)(ws + WS_WA_OUT + (size_t)j * WSZ_A_OUT); pg8::Gemm g{Y, Wt, MAINM, DM, DM}; pg8::StaticOrder S; S.init(MAINM, DM, G_, (int)blockIdx.x);
                pg8::EpiResBf16 E{X, DM, ALPHA};
                pg8::gemm_phase<pg8::EpiResBf16, pg8::StaticOrder, true, true>(lds, g, S, E, wave);
                { LOCALS; for (int sk_ = 0; sk_ < SKREP; ++sk_) { skinny_rows_part(Y, Wt, DM, ZP, lds, tid_, wave_, lane_); } }
                END_SITE(base + 2)
        } else if (kind == 1) {
            BEGIN_SITE(4, base + 0)
                const bf16* Wt = (const bf16*)(ws + WS_WB_IN); pg8::Gemm g{X, Wt, MAINM, 4096, DM}; pg8::StaticOrder S; S.init(MAINM, 4096, G_, (int)blockIdx.x);
                pg8::EpiBf16<0> E{BIG, NB_PAD, nullptr, 0, 0, 1.f};
                pg8::gemm_phase<pg8::EpiBf16<0>, pg8::StaticOrder, true, true>(lds, g, S, E, wave);
                { LOCALS; for (int sk_ = 0; sk_ < SKREP; ++sk_) { tail_cols_bf16<5>(X, Wt, DM, 4096, BIG, NB_PAD, lds, tid_, wave_, lane_); skinny_rows_bf16<0>(X, Wt, DM, 4224 / 64, BIG, NB_PAD, lds, tid_, wave_, lane_); } }
                END_SITE(base + 0)
            BEGIN_SITE(5, base + 1) LOCALS; rope_phase(BIG, P, gw_, NGW, lane_); END_SITE(base + 1)
            BEGIN_SITE(6, base + 2) LOCALS; indexer_sample(P, lds, tid_); indexer_prompt(P, lds, tid_, wave_, lane_); END_SITE(base + 2)
            BEGIN_SITE(7, base + 3) LOCALS; select_phase(P, lds, gw_, NGW, tid_, wave_, lane_); END_SITE(base + 3)
#ifdef ATTN_PROBE
            if (IN(base + 4)) { Ptrs P; load_ptrs(P); bf16* Y = (bf16*)(P.ws + WS_Y); LOCALS; dense_attn_phase<ATTN_PROBE>(P, Y, (char*)lds_raw, wave_); __syncthreads(); }
#endif
            BEGIN_SITE(8, base + 4) LOCALS; dense_attn_phase(P, Y, (char*)lds_raw, wave_); attn_phase(P, Y, lds, tid_, wave_, lane_); END_SITE(base + 4)
            BEGIN_SITE(9, base + 5)
                const bf16* Wt = (const bf16*)(ws + WS_WB_OUT); pg8::Gemm g{Y, Wt, MAINM, DM, DM}; pg8::StaticOrder S; S.init(MAINM, DM, G_, (int)blockIdx.x);
                pg8::EpiResBf16 E{X, DM, ALPHA};
                pg8::gemm_phase<pg8::EpiResBf16, pg8::StaticOrder, true, true>(lds, g, S, E, wave);
                { LOCALS; for (int sk_ = 0; sk_ < SKREP; ++sk_) { skinny_rows_part(Y, Wt, DM, ZP, lds, tid_, wave_, lane_); } }
                END_SITE(base + 5)
        } else {
            BEGIN_SITE(10, base + 0)
                const bf16* Wt = (const bf16*)(ws + WS_WC_IN); pg8::Gemm g{X, Wt, MAINM, 12288, DM}; pg8::StaticOrder S; S.init(MAINM, 12288, G_, (int)blockIdx.x);
                pg8::EpiBf16<0> E{BIG, NC_PAD, nullptr, 0, 0, 1.f};
                pg8::gemm_phase<pg8::EpiBf16<0>, pg8::StaticOrder, true, true>(lds, g, S, E, wave);
                { LOCALS; for (int sk_ = 0; sk_ < SKREP; ++sk_) { tail_cols_bf16<4>(X, Wt, DM, 12288, BIG, NC_PAD, lds, tid_, wave_, lane_); skinny_rows_bf16<0>(X, Wt, DM, NC_IN / 64, BIG, NC_PAD, lds, tid_, wave_, lane_); } }
                END_SITE(base + 0)
            BEGIN_SITE(11, base + 1) LOCALS; convC_phase(BIG, P, gw_, NGW, lane_); END_SITE(base + 1)
            BEGIN_SITE(19, base + 2) LOCALS;
#pragma unroll 1
                for (int half_ = 0; half_ < 2; ++half_) {
                    if ((half_ == 0) == ((wave_ & 1) == 0)) delta_pre(P.ws, lds, gw_, NGW, wave_, lane_);
                    else { const int nbusy = (NUQ > NGW && NUQ < 2 * NGW) ? NUQ - NGW : 0;
                      const bool busy = nbusy > 0 && (gw_ & 63) == 0 && (gw_ >> 6) < nbusy; const int below = nbusy == 0 ? 0 : (((gw_ + 63) >> 6) < nbusy ? ((gw_ + 63) >> 6) : nbusy);
                      if (!busy) { delta_phase(P, gw_ - below, NGW - nbusy, lane_); deferred_transposes(P, lds, gw_ - below, NGW - nbusy, wave_, lane_); } }
                }
            END_SITE(base + 2)
            BEGIN_SITE(22, base + 5) LOCALS; delta_d4(P.ws, P.out + O_DP, lds, tid_, wave_, lane_); END_SITE(base + 5)
            BEGIN_SITE(13, base + 6) LOCALS; normC_phase(BIG, Y, P, gw_, NGW, lane_); END_SITE(base + 6)
            BEGIN_SITE(14, base + 7)
                const bf16* Wt = (const bf16*)(ws + WS_WC_OUT); pg8::Gemm g{Y, Wt, MAINM, DM, DVW}; pg8::StaticOrder S; S.init(MAINM, DM, G_, (int)blockIdx.x);
                pg8::EpiResBf16 E{X, DM, ALPHA};
                pg8::gemm_phase<pg8::EpiResBf16, pg8::StaticOrder, true, true>(lds, g, S, E, wave);
                { LOCALS; for (int sk_ = 0; sk_ < SKREP; ++sk_) { skinny_rows_part(Y, Wt, DVW, ZP, lds, tid_, wave_, lane_); } }
                END_SITE(base + 7)
        }
        BEGIN_SITE(15, base + 8) LOCALS; ln_phase(Z, ZP, X, rp_ == 0 ? X : (bf16*)(P.ws + WS_QR), P.ln1_g + (size_t)layer * DM, P.ln1_b + (size_t)layer * DM, nullptr, nullptr, lds, gw_, NGW, tid_, wave_, lane_); END_SITE(base + 8)
        BEGIN_SITE(16, base + 9)
            const bf16* Wt = (const bf16*)(ws + WS_W1 + (size_t)layer * WSZ_W1); pg8::Gemm g{X, Wt, MAINM, FF, DM}; pg8::StaticOrder S; S.init(MAINM, FF, G_, (int)blockIdx.x);
            pg8::EpiBf16<2> E{BIG, FF, nullptr, 0, 0, 1.f};
            pg8::gemm_phase<pg8::EpiBf16<2>, pg8::StaticOrder, true, true>(lds, g, S, E, wave);
            { LOCALS; for (int sk_ = 0; sk_ < SKREP; ++sk_) { skinny_rows_bf16<2>(X, Wt, DM, FF / 64, BIG, FF, lds, tid_, wave_, lane_); } }
            END_SITE(base + 9)
        BEGIN_SITE(17, base + 10)
            const bf16* Wt = (const bf16*)(ws + WS_W2 + (size_t)layer * WSZ_W2); pg8::Gemm g{BIG, Wt, MAINM, DM, FF}; pg8::StaticOrder S; S.init(MAINM, DM, G_, (int)blockIdx.x);
            pg8::EpiResBf16 E{X, DM, ALPHA};
            pg8::gemm_phase<pg8::EpiResBf16, pg8::StaticOrder, true, true>(lds, g, S, E, wave);
            { LOCALS; for (int sk_ = 0; sk_ < SKREP; ++sk_) { skinny_rows_part(BIG, Wt, FF, ZP, lds, tid_, wave_, lane_); } }
            END_SITE(base + 10)
        BEGIN_SITE(18, base + 11)
            const bool last = layer == 3;
            LOCALS; ln_phase(Z, ZP, X, rp_ == 0 ? X : (bf16*)(P.ws + WS_QR), P.ln2_g + (size_t)layer * DM, P.ln2_b + (size_t)layer * DM, last ? P.out + O_YP : nullptr, last ? P.out + O_YS : nullptr, lds, gw_, NGW, tid_, wave_, lane_);
            if (!last) SEAM(base + 11); } }
    }
#undef IN
#undef SEAM
}

#ifndef MK_SPLIT
#define MK_SPLIT 0
#endif
extern "C" void kernel_launch(void* const* d_in, const int* in_sizes, int n_in, void* d_out, int out_size, void* d_ws, size_t ws_size, hipStream_t stream) {
    static int grid = 0;
    if (grid == 0) {
        if (n_in != 27 || (size_t)out_size != O_END || ws_size < WS_END) { fprintf(stderr, "kernel_launch: unexpected shapes: n_in %d out %d (want %zu) ws %zu (want >= %zu)\n", n_in, out_size, (size_t)O_END, ws_size, (size_t)WS_END); grid = -1; return; }
        int dev = 0, cus = 0;
        if (hipGetDevice(&dev) != hipSuccess || hipDeviceGetAttribute(&cus, hipDeviceAttributeMultiprocessorCount, dev) != hipSuccess) { grid = -1; return; }
        if (hipFuncSetAttribute((const void*)mega_fwd, hipFuncAttributeMaxDynamicSharedMemorySize, LDS_BYTES) != hipSuccess) { fprintf(stderr, "kernel_launch: hipFuncSetAttribute failed\n"); grid = -1; return; }
        int per_cu = 0;
        if (hipOccupancyMaxActiveBlocksPerMultiprocessor(&per_cu, (const void*)mega_fwd, NTHREADS, LDS_BYTES) != hipSuccess || per_cu < 1) fprintf(stderr, "kernel_launch: occupancy query reports %d\n", per_cu);
        (void)hipGetLastError();
        grid = cus;
    }
    if (grid < 0) return;
    (void)hipMemsetAsync((char*)d_ws + WS_CTL, 0, CTL_ZERO_BYTES, stream);
    Args a{};
    for (int i = 0; i < 27; ++i) a.in[i] = d_in[i];
    a.out = (float*)d_out; a.ws = (unsigned char*)d_ws;
#if MK_SPLIT
    for (int ph = 0; ph < PH_END; ++ph) {
        bool exists = (ph == 0);
        if (ph > 0) { const int layer = (ph - 1) / PH_PER_LAYER, l = (ph - 1) % PH_PER_LAYER, kind = layer % 3; const int nmix = kind == 0 ? 3 : (kind == 1 ? 6 : 8); exists = (l < nmix) || (l >= 8 && l <= 11); }
        if (!exists) continue;
        a.ph_lo = ph; a.ph_hi = ph + 1;
        hipLaunchKernelGGL(mega_fwd, dim3(grid), dim3(NTHREADS), LDS_BYTES, stream, a);
    }
#else
    a.ph_lo = 0; a.ph_hi = PH_END;
    hipLaunchKernelGGL(mega_fwd, dim3(grid), dim3(NTHREADS), LDS_BYTES, stream, a);
#endif
    const hipError_t le = hipPeekAtLastError();
    if (le != hipSuccess) fprintf(stderr, "kernel_launch: launch failed: %s\n", hipGetErrorName(le));
}
```

```cpp
#include <hip/hip_runtime.h>
#include <cstdio>
#include <cstdint>
#include <cmath>
__device__ __forceinline__ int flane() { return (int)__builtin_amdgcn_mbcnt_hi(~0u, __builtin_amdgcn_mbcnt_lo(~0u, 0u)); }
namespace pg8 {
#define PG8_LAS __attribute__((address_space(3)))
typedef unsigned short bf16_t;
typedef short bf16x8 __attribute__((ext_vector_type(8)));
typedef float f32x4 __attribute__((ext_vector_type(4)));
typedef unsigned u32x4 __attribute__((ext_vector_type(4)));
constexpr int BM = 256, BK = 64, HALF = 128, HTB = HALF * BK * 2  , STAGE_BYTES = 8 * HTB, NXCD = 8, WGM = 8;

__host__ __device__ __forceinline__ int lds_byte(int r, int c) { const int st = (r >> 4) * 2 + (c >> 5), rr = r & 15, cc = c & 31, ob = rr * 64 + cc * 2; return st * 1024 + (ob ^ (((ob >> 9) & 1) << 5)); }
__host__ __device__ __forceinline__ void stage_rc(int b, int& R, int& C) { const int st = b / 1024, sb = b % 1024, swz = sb ^ (((sb >> 9) & 1) << 5); R = (st >> 1) * 16 + swz / 64; C = (st & 1) * 32 + (swz % 64) / 2; }
__host__ __device__ __forceinline__ int perm32(int rho) { const int n = rho >> 4, i = rho & 15; return 8 * (i >> 2) + 4 * n + (i & 3); }

struct Unit { int pm, pn; };
struct Gemm { const bf16_t* A; const bf16_t* Bt; int M, N, K; };

struct StaticOrder {
    int nM, nN, nwg, G, c;
    __host__ __device__ void init(int M, int N, int G_, int c_) { nM = M / BM; nN = N / BM; nwg = nM * nN; G = G_; c = c_; }
    __host__ __device__ bool next(int i, Unit& u) const {
        const long L = (long)i * G + c; if (L >= nwg) return false;
        int wgid = (int)L; { const int q = nwg / NXCD, r = nwg % NXCD, xcd = wgid % NXCD, off = wgid / NXCD; wgid = (xcd < r ? xcd * (q + 1) : r * (q + 1) + (xcd - r) * q) + off; }
        const int nig = WGM * nN, gid = wgid / nig, fm = gid * WGM, gsz = (nM - fm) < WGM ? (nM - fm) : WGM;
        u.pm = fm + ((wgid % nig) % gsz); u.pn = (wgid % nig) / gsz; return true;
    }
    __device__ __forceinline__ void a_ready(const Unit&) const {}
    __device__ __forceinline__ void done(const Unit&) const {}
};

__device__ __forceinline__ unsigned cvt_pk_bf16(float lo, float hi) { unsigned r; asm volatile("v_cvt_pk_bf16_f32 %0, %1, %2" : "=v"(r) : "v"(lo), "v"(hi)); return r; }
typedef float f32x2 __attribute__((ext_vector_type(2)));
__device__ __forceinline__ f32x2 gelu_pk(f32x2 v) {
    const f32x2 av = __builtin_elementwise_abs(v), d = av * 0.2316418882f + 1.0f;
    f32x2 t; t.x = __builtin_amdgcn_rcpf(d.x); t.y = __builtin_amdgcn_rcpf(d.y);
    f32x2 q = t * 0.5307027145f + (-0.7265760135f); q = q * t + 0.7107068705f; q = q * t + (-0.142248368f); q = q * t + 0.127414796f; q = q * t;
    const f32x2 s = (v * v) * (-0.72134752044f);
    f32x2 e; e.x = __builtin_amdgcn_exp2f(s.x); e.y = __builtin_amdgcn_exp2f(s.y);
    const f32x2 m = v * (q * e), r = v - m;
    f32x2 o; o.x = v.x < 0.f ? m.x : r.x; o.y = v.y < 0.f ? m.y : r.y; return o;
}

template <int ACT  > struct EpiBf16 {
    static constexpr bool PERM = true, AFTER_DRAIN = false; static_assert(ACT == 0 || ACT == 1 || ACT == 2, "EpiBf16: ACT is 0 (none), 1 (gelu_pk) or 2 (relu^2)");
    bf16_t* O; int ldc; const float* bias; int split_cols; size_t split_stride; float scale0;
    __device__ __forceinline__ void operator()(const f32x4 (&acc)[2][2][4][2], const Unit& u, int wr, int wc, int fr, int fq) const {
        const int row0 = u.pm * BM + wr * 64 + fr; int colt = u.pn * BM; bf16_t* base = O;
        float sc = 1.f; if (split_cols) { const int t = colt / split_cols; base += (size_t)t * split_stride; colt -= t * split_cols; if (t == 0) sc = scale0; }
        const int col0 = colt + wc * 32 + 8 * fq, bcol0 = u.pn * BM + wc * 32 + 8 * fq;
        f32x4 bv[2][2];
#pragma unroll
        for (int bj = 0; bj < 2; ++bj)
#pragma unroll
            for (int n = 0; n < 2; ++n) bv[bj][n] = bias ? *(const f32x4*)(bias + bcol0 + bj * HALF + 4 * n) : (f32x4){0.f, 0.f, 0.f, 0.f};
#pragma unroll
        for (int ai = 0; ai < 2; ++ai)
#pragma unroll
            for (int m = 0; m < 4; ++m) { bf16_t* rowp = base + (size_t)(row0 + ai * HALF + m * 16) * ldc + col0;
#pragma unroll
                for (int bj = 0; bj < 2; ++bj) { f32x4 v0 = acc[ai][bj][m][0] + bv[bj][0], v1 = acc[ai][bj][m][1] + bv[bj][1];
                    if (ACT == 1) { f32x2 a = gelu_pk((f32x2){v0[0], v0[1]}), b = gelu_pk((f32x2){v0[2], v0[3]}), c = gelu_pk((f32x2){v1[0], v1[1]}), d = gelu_pk((f32x2){v1[2], v1[3]});
                        v0 = (f32x4){a.x, a.y, b.x, b.y}; v1 = (f32x4){c.x, c.y, d.x, d.y}; }
                    if (ACT == 2) { _Pragma("unroll") for (int q_ = 0; q_ < 4; ++q_) { const float a_ = v0[q_] > 0.f ? v0[q_] : 0.f, b_ = v1[q_] > 0.f ? v1[q_] : 0.f; v0[q_] = a_ * a_; v1[q_] = b_ * b_; } }
                    v0 = v0 * sc; v1 = v1 * sc; u32x4 w; w.x = cvt_pk_bf16(v0[0], v0[1]); w.y = cvt_pk_bf16(v0[2], v0[3]); w.z = cvt_pk_bf16(v1[0], v1[1]); w.w = cvt_pk_bf16(v1[2], v1[3]);
                    *(u32x4*)(rowp + bj * HALF) = w; } }
    }
};


struct EpiResBf16 {
    static constexpr bool PERM = true, AFTER_DRAIN = false;
    bf16_t* X; int ldc; float alpha;
    __device__ __forceinline__ void operator()(const f32x4 (&acc)[2][2][4][2], const Unit& u, int wr, int wc, int fr, int fq) const {
        const int row0 = u.pm * BM + wr * 64 + fr, col0 = u.pn * BM + wc * 32 + 8 * fq;
#pragma unroll
        for (int ai = 0; ai < 2; ++ai) {
            u32x4 xin[4][2];
#pragma unroll
            for (int m = 0; m < 4; ++m)
#pragma unroll
                for (int bj = 0; bj < 2; ++bj) xin[m][bj] = *(const u32x4*)(X + (size_t)(row0 + ai * HALF + m * 16) * ldc + col0 + bj * HALF);
#pragma unroll
            for (int m = 0; m < 4; ++m) { bf16_t* rowp = X + (size_t)(row0 + ai * HALF + m * 16) * ldc + col0;
#pragma unroll
                for (int bj = 0; bj < 2; ++bj) { const u32x4 xi = xin[m][bj]; const f32x4 a0 = acc[ai][bj][m][0], a1 = acc[ai][bj][m][1];
                    float x[8] = {__uint_as_float(xi.x << 16), __uint_as_float(xi.x & 0xffff0000u), __uint_as_float(xi.y << 16), __uint_as_float(xi.y & 0xffff0000u),
                                  __uint_as_float(xi.z << 16), __uint_as_float(xi.z & 0xffff0000u), __uint_as_float(xi.w << 16), __uint_as_float(xi.w & 0xffff0000u)};
                    u32x4 w; w.x = cvt_pk_bf16(alpha * x[0] + a0[0], alpha * x[1] + a0[1]); w.y = cvt_pk_bf16(alpha * x[2] + a0[2], alpha * x[3] + a0[3]);
                    w.z = cvt_pk_bf16(alpha * x[4] + a1[0], alpha * x[5] + a1[1]); w.w = cvt_pk_bf16(alpha * x[6] + a1[2], alpha * x[7] + a1[3]);
                    *(u32x4*)(rowp + bj * HALF) = w; } }
        }
    }
};

struct EpiF32 {
    static constexpr bool PERM = false, AFTER_DRAIN = false;
    float* C; int ldc;
    __device__ __forceinline__ void operator()(const f32x4 (&acc)[2][2][4][2], const Unit& u, int wr, int wc, int fr, int fq) const {
        const int row0 = u.pm * BM + wr * 64 + fr, col0 = u.pn * BM + wc * 32 + 4 * fq;
#pragma unroll
        for (int ai = 0; ai < 2; ++ai)
#pragma unroll
            for (int m = 0; m < 4; ++m) { float* rowp = C + (size_t)(row0 + ai * HALF + m * 16) * ldc + col0;
#pragma unroll
                for (int bj = 0; bj < 2; ++bj)
#pragma unroll
                    for (int n = 0; n < 2; ++n) *(f32x4*)(rowp + bj * HALF + n * 16) = acc[ai][bj][m][n]; }
    }
};
struct PanelStats {
    unsigned* xbuf;
    unsigned* cnt;
    unsigned* tmo;
    int ntn; float eps;
    unsigned code;
    __device__ __forceinline__ bool run(const f32x4 (&v)[2][2][4][2], const Unit& u, int wr, int wc, int fr, int fq, PG8_LAS unsigned char* lds, int wid, int lane) const {
        typedef float f32x2v __attribute__((ext_vector_type(2)));
        PG8_LAS f32x2v* P = (PG8_LAS f32x2v*)lds;
        PG8_LAS f32x2v* S = (PG8_LAS f32x2v*)(lds + 8192);
        PG8_LAS unsigned* flag = (PG8_LAS unsigned*)(lds + 8192 + 2048);
#pragma unroll
        for (int ai = 0; ai < 2; ++ai)
#pragma unroll
            for (int m = 0; m < 4; ++m) {
                float s = 0.f;
#pragma unroll
                for (int bj = 0; bj < 2; ++bj)
#pragma unroll
                    for (int n = 0; n < 2; ++n) { const f32x4 x = v[ai][bj][m][n]; s += (x[0] + x[1]) + (x[2] + x[3]); }
                s += __shfl_xor(s, 16); s += __shfl_xor(s, 32);
                const float mw = s * (1.0f / 64.0f); float q = 0.f;
#pragma unroll
                for (int bj = 0; bj < 2; ++bj)
#pragma unroll
                    for (int n = 0; n < 2; ++n) { const f32x4 d = v[ai][bj][m][n] - mw; q += (d[0] * d[0] + d[1] * d[1]) + (d[2] * d[2] + d[3] * d[3]); }
                q += __shfl_xor(q, 16); q += __shfl_xor(q, 32);
                if (fq == 0) P[(ai * HALF + wr * 64 + m * 16 + fr) * 4 + wc] = (f32x2v){mw, q};
            }
        asm volatile("s_waitcnt lgkmcnt(0)" ::: "memory"); __builtin_amdgcn_s_barrier(); asm volatile("" ::: "memory");
#if defined(BROKEN_EXCHANGE_NO_WAIT)
#warning BROKEN CONTROL BUILD: the row-statistics exchange does not wait; results are wrong by design
        if (blockIdx.x >= 64) { const long long t0_ = clock64(); while (clock64() - t0_ < 60000) __builtin_amdgcn_s_sleep(8); }
#endif
        const int row = wid * 32 + (lane & 31);
        if (lane < 32) {
            const f32x2v a = P[row * 4 + 0], b = P[row * 4 + 1], c = P[row * 4 + 2], d = P[row * 4 + 3];
            const float mt = (a.x + b.x + c.x + d.x) * 0.25f;
            const float da = a.x - mt, db = b.x - mt, dc = c.x - mt, dd = d.x - mt;
            const float m2 = (a.y + b.y) + (c.y + d.y) + 64.0f * ((da * da + db * db) + (dc * dc + dd * dd));
            unsigned long long* slot = (unsigned long long*)xbuf + ((size_t)(u.pm * BM + row) * 4 + u.pn);
            __hip_atomic_store(slot, ((unsigned long long)__float_as_uint(m2) << 32) | __float_as_uint(mt), __ATOMIC_RELAXED, __HIP_MEMORY_SCOPE_AGENT);
        }
        asm volatile("s_waitcnt vmcnt(0)" ::: "memory");
        if (lane == 0) __hip_atomic_fetch_add(cnt + 64 * u.pm, 1u, __ATOMIC_RELAXED, __HIP_MEMORY_SCOPE_AGENT);
        if (wid == 0) {
            bool dead = false; const unsigned long long t0 = __builtin_amdgcn_s_memrealtime(); const unsigned want = 8u * (unsigned)ntn;
            for (;;) {
#if defined(BROKEN_EXCHANGE_NO_WAIT)
                break;
#endif
                if ((unsigned)__builtin_amdgcn_readfirstlane(__hip_atomic_load(cnt + 64 * u.pm, __ATOMIC_RELAXED, __HIP_MEMORY_SCOPE_AGENT)) >= want) break;
                if (__builtin_amdgcn_s_memrealtime() - t0 > 2000000ull) {
                    if (lane == 0) { unsigned expect = 0u; __hip_atomic_compare_exchange_strong(tmo + 1, &expect, code | (unsigned)(u.pm & 0xff), __ATOMIC_RELAXED, __ATOMIC_RELAXED, __HIP_MEMORY_SCOPE_AGENT);
                                     __hip_atomic_store(tmo, 1u, __ATOMIC_RELAXED, __HIP_MEMORY_SCOPE_AGENT); }
                    dead = true; break; }
                __builtin_amdgcn_s_sleep(2);
            }
            __builtin_amdgcn_fence(__ATOMIC_ACQUIRE, "agent");
            if (lane == 0) flag[0] = dead ? 1u : 0u;
        }
        asm volatile("s_waitcnt vmcnt(0) lgkmcnt(0)" ::: "memory"); __builtin_amdgcn_s_barrier(); asm volatile("" ::: "memory");
        const bool bad = flag[0] != 0u;
        if (lane < 32) {
            const unsigned long long* slot = (const unsigned long long*)xbuf + (size_t)(u.pm * BM + row) * 4; float mt[4], m2[4]; float ms = 0.f;
#pragma unroll
            for (int t = 0; t < 4; ++t) { if (t < ntn) { const unsigned long long w = __hip_atomic_load(slot + t, __ATOMIC_RELAXED, __HIP_MEMORY_SCOPE_AGENT); mt[t] = __uint_as_float((unsigned)w); m2[t] = __uint_as_float((unsigned)(w >> 32)); } else { mt[t] = 0.f; m2[t] = 0.f; } ms += mt[t]; }
            const float mean = ms / (float)ntn; float q = 0.f;
#pragma unroll
            for (int t = 0; t < 4; ++t) if (t < ntn) { const float dm = mt[t] - mean; q += m2[t] + 256.0f * dm * dm; }
            S[row] = (f32x2v){mean, 1.0f / sqrtf(q / (256.0f * (float)ntn) + eps)};
        }
        asm volatile("s_waitcnt lgkmcnt(0)" ::: "memory"); __builtin_amdgcn_s_barrier(); asm volatile("" ::: "memory");
        return bad;
    }
};
struct EpiLnRes {
    static constexpr bool PERM = false, AFTER_DRAIN = true;
    const float* base; float* out; int ldc; const float* bias; PanelStats st; unsigned poison;
    __device__ __forceinline__ void fused(f32x4 (&acc)[2][2][4][2], const Unit& u, int wr, int wc, int fr, int fq, PG8_LAS unsigned char* lds, int wid, int lane) const {
        typedef float f32x2v __attribute__((ext_vector_type(2)));
        const PG8_LAS f32x2v* S = (const PG8_LAS f32x2v*)(lds + 8192);
        const int col0 = u.pn * BM + wc * 32 + 4 * fq;
#pragma unroll
        for (int bj = 0; bj < 2; ++bj)
#pragma unroll
            for (int n = 0; n < 2; ++n) { const f32x4 bv = bias ? *(const f32x4*)(bias + col0 + bj * HALF + n * 16) : (f32x4){0.f, 0.f, 0.f, 0.f};
#pragma unroll
                for (int ai = 0; ai < 2; ++ai)
#pragma unroll
                    for (int m = 0; m < 4; ++m) acc[ai][bj][m][n] += bv; }
        f32x4 pre[4][2][2];
#pragma unroll
        for (int m = 0; m < 4; ++m) { const size_t off = (size_t)(u.pm * BM + wr * 64 + m * 16 + fr) * ldc + col0;
#pragma unroll
            for (int bj = 0; bj < 2; ++bj)
#pragma unroll
                for (int n = 0; n < 2; ++n) pre[m][bj][n] = *(const f32x4*)(base + off + bj * HALF + n * 16); }
        const bool bad = st.run(acc, u, wr, wc, fr, fq, lds, wid, lane) || poison != 0u;
        const float qnan = __builtin_nanf("");
#pragma unroll
        for (int ai = 0; ai < 2; ++ai)
#pragma unroll
            for (int m = 0; m < 4; ++m) { const int r = ai * HALF + wr * 64 + m * 16 + fr; const f32x2v sr = S[r]; const size_t off = (size_t)(u.pm * BM + r) * ldc + col0;
#pragma unroll
                for (int bj = 0; bj < 2; ++bj)
#pragma unroll
                    for (int n = 0; n < 2; ++n) { const f32x4 bs = ai == 0 ? pre[m][bj][n] : *(const f32x4*)(base + off + bj * HALF + n * 16); f32x4 o = bs + (acc[ai][bj][m][n] - sr.x) * sr.y;
                        if (bad) o = (f32x4){qnan, qnan, qnan, qnan}; *(f32x4*)(out + off + bj * HALF + n * 16) = o; }
                if (m & 1) asm volatile("" ::: "memory"); }
    }
};
struct EpiLnResLn {
    static constexpr bool PERM = false, AFTER_DRAIN = true;
    const float* base; float* out; bf16_t* xn; int ldc; const float* bias; PanelStats st1, st2; unsigned poison;
    __device__ __forceinline__ void fused(f32x4 (&acc)[2][2][4][2], const Unit& u, int wr, int wc, int fr, int fq, PG8_LAS unsigned char* lds, int wid, int lane) const {
        typedef float f32x2v __attribute__((ext_vector_type(2))); typedef unsigned u32x2v __attribute__((ext_vector_type(2)));
        const PG8_LAS f32x2v* S = (const PG8_LAS f32x2v*)(lds + 8192);
        const int col0 = u.pn * BM + wc * 32 + 4 * fq;
#pragma unroll
        for (int bj = 0; bj < 2; ++bj)
#pragma unroll
            for (int n = 0; n < 2; ++n) { const f32x4 bv = bias ? *(const f32x4*)(bias + col0 + bj * HALF + n * 16) : (f32x4){0.f, 0.f, 0.f, 0.f};
#pragma unroll
                for (int ai = 0; ai < 2; ++ai)
#pragma unroll
                    for (int m = 0; m < 4; ++m) acc[ai][bj][m][n] += bv; }
        bool bad = st1.run(acc, u, wr, wc, fr, fq, lds, wid, lane) || poison != 0u;
        const float qnan = __builtin_nanf("");
#pragma unroll
        for (int ai = 0; ai < 2; ++ai)
#pragma unroll
            for (int m = 0; m < 4; ++m) { const int r = ai * HALF + wr * 64 + m * 16 + fr; const f32x2v sr = S[r]; const size_t off = (size_t)(u.pm * BM + r) * ldc + col0;
#pragma unroll
                for (int bj = 0; bj < 2; ++bj)
#pragma unroll
                    for (int n = 0; n < 2; ++n) { const f32x4 bs = *(const f32x4*)(base + off + bj * HALF + n * 16); acc[ai][bj][m][n] = bs + (acc[ai][bj][m][n] - sr.x) * sr.y; }
                asm volatile("" : "+v"(acc[ai][0][m][0]), "+v"(acc[ai][0][m][1]), "+v"(acc[ai][1][m][0]), "+v"(acc[ai][1][m][1]));
                if (m & 1) asm volatile("" ::: "memory"); }
        const bool bad1 = bad;
        bad = st2.run(acc, u, wr, wc, fr, fq, lds, wid, lane) || bad;
#pragma unroll
        for (int ai = 0; ai < 2; ++ai)
#pragma unroll
            for (int m = 0; m < 4; ++m) { const int r = ai * HALF + wr * 64 + m * 16 + fr; const f32x2v sr = S[r]; const size_t off = (size_t)(u.pm * BM + r) * ldc + col0;
#pragma unroll
                for (int bj = 0; bj < 2; ++bj)
#pragma unroll
                    for (int n = 0; n < 2; ++n) { const f32x4 x1 = acc[ai][bj][m][n]; *(f32x4*)(out + off + bj * HALF + n * 16) = bad1 ? (f32x4){qnan, qnan, qnan, qnan} : x1;
                        const f32x4 o = (x1 - sr.x) * sr.y; u32x2v w; w.x = cvt_pk_bf16(o[0], o[1]); w.y = cvt_pk_bf16(o[2], o[3]);
                        if (bad) { w.x = 0x7fc07fc0u; w.y = 0x7fc07fc0u; } *(u32x2v*)(xn + off + bj * HALF + n * 16) = w; }
                asm volatile("" ::: "memory"); }
    }
};

template <class Epi, class Sched, bool ALIGN_EPI = false, bool SP2 = false>
__device__ __forceinline__ void gemm_phase(PG8_LAS unsigned char* lds, const Gemm g, const Sched& S, const Epi& E, int wv) {
    int tid0_ = threadIdx.x; asm volatile("" : "+v"(tid0_)); (void)wv;
    const int tid = tid0_, wid = __builtin_amdgcn_readfirstlane(tid >> 6), lane = tid & 63, wr = wid >> 2, wc = wid & 3, fr = lane & 15, fq = lane >> 4;
    const int K = g.K, nt = K / BK;
    unsigned voffA[2], voffB[2];
#pragma unroll
    for (int i = 0; i < 2; ++i) { int R, C; stage_rc(tid * 16 + i * 8192, R, C); const int Rb = Epi::PERM ? ((R & ~31) + perm32(R & 31)) : R;
        voffA[i] = (unsigned)(R * K + C) * 2u; voffB[i] = (unsigned)(Rb * K + C) * 2u; }
    const size_t kstep = (size_t)(BK * 2);
    const size_t hstep = (size_t)HALF * K * 2;
    const size_t tstep = 2 * hstep;
    const unsigned ldsw = (unsigned)wid * 1024u;
    const int aoff = lds_byte(wr * 64 + fr, fq * 8), boff = lds_byte(wc * 32 + fr, fq * 8);
#define PG8_SA(b, h) (((b) * 2 + (h)) * HTB)
#define PG8_SB(b, h) ((4 + (b) * 2 + (h)) * HTB)
#define PG8_STAGE(bufoff, gbase, voff) do { _Pragma("unroll") for (int _i = 0; _i < 2; ++_i) \
        __builtin_amdgcn_global_load_lds((const unsigned*)((const char*)(gbase) + (voff)[_i]), (PG8_LAS unsigned*)(lds + (bufoff) + ldsw + _i * 8192), 16, 0, 0); } while (0)
#define PG8_LDA(dst, b, h) do { _Pragma("unroll") for (int m = 0; m < 4; ++m) _Pragma("unroll") for (int k = 0; k < 2; ++k) dst[m][k] = *(const PG8_LAS bf16x8*)(lds + PG8_SA(b, h) + aoff + m * 2048 + k * 1024); } while (0)
#define PG8_LDB(dst, b, h) do { _Pragma("unroll") for (int n = 0; n < 2; ++n) _Pragma("unroll") for (int k = 0; k < 2; ++k) dst[n][k] = *(const PG8_LAS bf16x8*)(lds + PG8_SB(b, h) + boff + n * 2048 + k * 1024); } while (0)
#define PG8_MMA(ai, bj, At, Bt) do { __builtin_amdgcn_s_setprio(1); _Pragma("unroll") for (int m = 0; m < 4; ++m) _Pragma("unroll") for (int n = 0; n < 2; ++n) _Pragma("unroll") for (int k = 0; k < 2; ++k) \
        acc[ai][bj][m][n] = __builtin_amdgcn_mfma_f32_16x16x32_bf16(Bt[n][k], At[m][k], acc[ai][bj][m][n], 0, 0, 0); __builtin_amdgcn_s_setprio(0); } while (0)
#define PG8_WAIT_V(n) asm volatile("s_waitcnt vmcnt(" #n ")" ::: "memory")
#define PG8_WAIT_L(n) asm volatile("s_waitcnt lgkmcnt(" #n ")" ::: "memory")
#define PG8_BAR __builtin_amdgcn_s_barrier()
#define PG8_SCHED __builtin_amdgcn_sched_barrier(0)
    Unit cur, nxt; int ui = 0;
    if (!S.next(0, cur)) return;
    f32x4 acc[2][2][4][2];
#pragma unroll
    for (int a = 0; a < 2; ++a)
#pragma unroll
        for (int b = 0; b < 2; ++b)
#pragma unroll
            for (int m = 0; m < 4; ++m)
#pragma unroll
                for (int n = 0; n < 2; ++n) acc[a][b][m][n] = (f32x4){0.f, 0.f, 0.f, 0.f};
    bf16x8 At[4][2], B0[2][2], B1[2][2];
    const char* cA = (const char*)g.A + (size_t)cur.pm * tstep; const char* cB = (const char*)g.Bt + (size_t)cur.pn * tstep;
    S.a_ready(cur);
    if constexpr (SP2) {
        PG8_STAGE(PG8_SB(0, 0), cB, voffB); PG8_STAGE(PG8_SB(0, 1), cB + hstep, voffB); PG8_STAGE(PG8_SA(0, 0), cA, voffA); PG8_STAGE(PG8_SA(0, 1), cA + hstep, voffA);
        if (wr == 1) PG8_BAR;
        PG8_WAIT_V(2); PG8_BAR;
        PG8_STAGE(PG8_SB(1, 0), cB + kstep, voffB); PG8_STAGE(PG8_SA(1, 0), cA + kstep, voffA); PG8_STAGE(PG8_SB(1, 1), cB + hstep + kstep, voffB);
        PG8_WAIT_V(6); PG8_BAR;
    } else {
        PG8_STAGE(PG8_SB(0, 0), cB, voffB); PG8_STAGE(PG8_SA(0, 0), cA, voffA); PG8_STAGE(PG8_SB(0, 1), cB + hstep, voffB); PG8_STAGE(PG8_SA(0, 1), cA + hstep, voffA);
        if (wr == 1) PG8_BAR;
        PG8_WAIT_V(4); PG8_BAR;
        PG8_STAGE(PG8_SB(1, 0), cB + kstep, voffB); PG8_STAGE(PG8_SA(1, 0), cA + kstep, voffA); PG8_STAGE(PG8_SB(1, 1), cB + hstep + kstep, voffB);
        PG8_WAIT_V(6); PG8_BAR;
    }
    for (;;) {
        const bool has_next = S.next(ui + 1, nxt);
        const char* nA = has_next ? (const char*)g.A + (size_t)nxt.pm * tstep : cA; const char* nB = has_next ? (const char*)g.Bt + (size_t)nxt.pn * tstep : cB;
        for (int t = 0; t < nt; t += 2) {
            const bool last = (t == nt - 2);
            const char* a1 = cA + (size_t)(t + 1) * kstep;
            const char* a2 = last ? nA : cA + (size_t)(t + 2) * kstep; const char* b2 = last ? nB : cB + (size_t)(t + 2) * kstep;
            const char* a3 = a2 + kstep; const char* b3 = b2 + kstep;
            if (last && has_next) S.a_ready(nxt);
            if constexpr (SP2) {
            PG8_LDB(B0, 0, 0); PG8_LDB(B1, 0, 1); PG8_SCHED; PG8_LDA(At, 0, 0); PG8_STAGE(PG8_SA(1, 1), a1 + hstep, voffA);
            PG8_WAIT_V(8); PG8_WAIT_L(0); PG8_BAR; PG8_MMA(0, 0, At, B0); PG8_MMA(0, 1, At, B1); PG8_BAR; PG8_SCHED;
            PG8_LDA(At, 0, 1); PG8_STAGE(PG8_SB(0, 0), b2, voffB); PG8_STAGE(PG8_SB(0, 1), b2 + hstep, voffB); PG8_STAGE(PG8_SA(0, 0), a2, voffA);
            PG8_WAIT_V(8); PG8_WAIT_L(0); PG8_BAR; PG8_MMA(1, 0, At, B0); PG8_MMA(1, 1, At, B1); PG8_BAR; PG8_SCHED;
            PG8_LDB(B0, 1, 0); PG8_LDB(B1, 1, 1); PG8_SCHED; PG8_LDA(At, 1, 0); PG8_STAGE(PG8_SA(0, 1), a2 + hstep, voffA);
            PG8_WAIT_V(8); PG8_WAIT_L(0); PG8_BAR; PG8_MMA(0, 0, At, B0); PG8_MMA(0, 1, At, B1); PG8_BAR; PG8_SCHED;
            PG8_LDA(At, 1, 1); PG8_STAGE(PG8_SB(1, 0), b3, voffB); PG8_STAGE(PG8_SB(1, 1), b3 + hstep, voffB); PG8_STAGE(PG8_SA(1, 0), a3, voffA);
            PG8_WAIT_V(8); PG8_WAIT_L(0); PG8_BAR; PG8_MMA(1, 0, At, B0); PG8_MMA(1, 1, At, B1); PG8_BAR; PG8_SCHED;
            } else {
            PG8_LDB(B0, 0, 0); PG8_SCHED; PG8_LDA(At, 0, 0); PG8_STAGE(PG8_SA(1, 1), a1 + hstep, voffA);
            PG8_WAIT_L(8); PG8_BAR; PG8_WAIT_L(0); PG8_MMA(0, 0, At, B0); PG8_BAR; PG8_SCHED;
            PG8_LDB(B1, 0, 1); PG8_STAGE(PG8_SB(0, 0), b2, voffB);
            PG8_BAR; PG8_WAIT_L(0); PG8_MMA(0, 1, At, B1); PG8_BAR;
            PG8_LDA(At, 0, 1); PG8_STAGE(PG8_SA(0, 0), a2, voffA);
            PG8_BAR; PG8_WAIT_L(0); PG8_MMA(1, 0, At, B0); PG8_BAR; PG8_SCHED;
            PG8_STAGE(PG8_SB(0, 1), b2 + hstep, voffB);
            PG8_WAIT_V(6); PG8_BAR; PG8_MMA(1, 1, At, B1); PG8_BAR;
            PG8_LDB(B0, 1, 0); PG8_SCHED; PG8_LDA(At, 1, 0); PG8_STAGE(PG8_SA(0, 1), a2 + hstep, voffA);
            PG8_WAIT_L(8); PG8_BAR; PG8_WAIT_L(0); PG8_MMA(0, 0, At, B0); PG8_BAR; PG8_SCHED;
            PG8_LDB(B1, 1, 1); PG8_STAGE(PG8_SB(1, 0), b3, voffB);
            PG8_BAR; PG8_WAIT_L(0); PG8_MMA(0, 1, At, B1); PG8_BAR;
            PG8_LDA(At, 1, 1); PG8_STAGE(PG8_SA(1, 0), a3, voffA);
            PG8_BAR; PG8_WAIT_L(0); PG8_MMA(1, 0, At, B0); PG8_BAR; PG8_SCHED;
            PG8_STAGE(PG8_SB(1, 1), b3 + hstep, voffB);
            PG8_WAIT_V(6); PG8_BAR; PG8_MMA(1, 1, At, B1); PG8_BAR;
            }
        }
        if constexpr (ALIGN_EPI) { if (wr == 0) PG8_BAR; }
        if constexpr (!Epi::AFTER_DRAIN) { E(acc, cur, wr, wc, fr, fq); S.done(cur); }
        if (!has_next) break;
#pragma unroll
        for (int a = 0; a < 2; ++a)
#pragma unroll
            for (int b = 0; b < 2; ++b)
#pragma unroll
                for (int m = 0; m < 4; ++m)
#pragma unroll
                    for (int n = 0; n < 2; ++n) acc[a][b][m][n] = (f32x4){0.f, 0.f, 0.f, 0.f};
        cur = nxt; cA = nA; cB = nB; ++ui;
        if constexpr (ALIGN_EPI) { if (wr == 1) PG8_BAR; }
    }
    PG8_WAIT_V(0);
    if constexpr (!ALIGN_EPI) { if (wr == 0) PG8_BAR; }
    PG8_BAR;
    if constexpr (Epi::AFTER_DRAIN) { E.fused(acc, cur, wr, wc, fr, fq, lds, wid, lane); S.done(cur); }
#undef PG8_SA
#undef PG8_SB
#undef PG8_STAGE
#undef PG8_LDA
#undef PG8_LDB
#undef PG8_MMA
#undef PG8_WAIT_V
#undef PG8_WAIT_L
#undef PG8_BAR
#undef PG8_SCHED
}
}

#ifndef PG8_SP2
#define PG8_SP2 true
#endif
#ifndef PG8_ALIGN
#define PG8_ALIGN true
#endif
#define GAS __attribute__((address_space(1)))
#define LAS __attribute__((address_space(3)))
#define XB_TMO      128
#define XB_XCNT(j)  (256  + 64 * (j))
#define XB_XSUB(j)  (1280 + 64 * (j))
#define XB_XGEN(j)  (2304 + 64 * (j))
#define XB_TOP      3328
#define XB_TOPGEN   3392
#define XCD_BAR_WORDS 3456
#define XB_SPIN_CAP (1u << 18)

__device__ __forceinline__ unsigned xb_ld(unsigned* p)              { return __hip_atomic_load(p, __ATOMIC_RELAXED, __HIP_MEMORY_SCOPE_AGENT); }
__device__ __forceinline__ unsigned xb_add(unsigned* p, unsigned v) { return __hip_atomic_fetch_add(p, v, __ATOMIC_RELAXED, __HIP_MEMORY_SCOPE_AGENT); }
__device__ __forceinline__ unsigned xb_xcc_id() { return (unsigned)__builtin_amdgcn_s_getreg((3 << 11) | 20) & 0xFu; }
#define XB_SPIN(cond, bar) do { unsigned _sp = 0; while (cond) { __builtin_amdgcn_s_sleep(1); \
    if ((++_sp & 255u) == 0u) { if (xb_ld(&(bar)[XB_TMO])) break; if (_sp > XB_SPIN_CAP) { atomicAdd(&(bar)[XB_TMO], 1u); break; } } } } while (0)

struct XcdBarrier {
    unsigned* bar; unsigned x;
    volatile LAS unsigned* st;
    int wv;
};

__device__ __forceinline__ XcdBarrier xcd_barrier_post(unsigned* bar, volatile LAS unsigned* st) {
    XcdBarrier b; b.bar = bar; b.x = xb_xcc_id(); b.st = st;
    if (threadIdx.x == 0) (void)xb_add(&bar[XB_XCNT(b.x)], 1u);
    return b;
}
__device__ __forceinline__ void xcd_barrier_complete(unsigned* bar, unsigned x, unsigned& nloc, unsigned& nx) {
    asm volatile("" : "+s"(x));
    const unsigned G = gridDim.x * gridDim.y * gridDim.z;
    unsigned sum, cnt, mine, sp = 0u;
    for (;;) {
        sum = 0u; cnt = 0u; mine = 0u;
#pragma unroll
        for (unsigned j = 0; j < 16; ++j) { const unsigned c = xb_ld(&bar[XB_XCNT(j)]); sum += c; cnt += (c > 0u) ? 1u : 0u; mine = (j == x) ? c : mine; }
        if (sum == G) break;
        __builtin_amdgcn_s_sleep(1);
        if ((++sp & 255u) == 0u) { if (xb_ld(&bar[XB_TMO])) break; if (sp > XB_SPIN_CAP) { atomicAdd(&bar[XB_TMO], 1u); break; } }
    }
    nloc = mine > 0u ? mine : 1u; nx = cnt > 0u ? cnt : 1u;
}

__device__ __forceinline__ void xcd_barrier(const XcdBarrier& b) {
    asm volatile("s_waitcnt vmcnt(0)" ::: "memory");
    __syncthreads();
    if (threadIdx.x == 0) {
        unsigned* bar = b.bar; asm volatile("" : "+s"(bar));
        __builtin_amdgcn_s_waitcnt(0);
        unsigned nloc = b.st[0], nx = b.st[1];
        if (nloc == 0u) { xcd_barrier_complete(bar, b.x, nloc, nx); b.st[0] = nloc; b.st[1] = nx; }
        const unsigned old = xb_add(&bar[XB_XSUB(b.x)], 1u);
        const unsigned gen = old / nloc;
        if (old + 1u == (gen + 1u) * nloc) {
            __builtin_amdgcn_fence(__ATOMIC_RELEASE, "agent");
            asm volatile("s_waitcnt vmcnt(0)" ::: "memory");
            const unsigned og = xb_add(&bar[XB_TOP], 1u);
            const unsigned tg = og / nx;
            if (og + 1u == (tg + 1u) * nx) xb_add(&bar[XB_TOPGEN], 1u);
            else XB_SPIN(xb_ld(&bar[XB_TOPGEN]) == tg, bar);
            __builtin_amdgcn_fence(__ATOMIC_ACQUIRE, "agent");
            xb_add(&bar[XB_XGEN(b.x)], 1u);
            asm volatile("s_waitcnt vmcnt(0)" ::: "memory");
        } else {
            XB_SPIN(xb_ld(&bar[XB_XGEN(b.x)]) == gen, bar);
            __builtin_amdgcn_fence(__ATOMIC_ACQUIRE, "agent");
            asm volatile("s_waitcnt vmcnt(0)" ::: "memory");
        }
    }
    __syncthreads();
}
namespace dattn {
constexpr int D = 128, QST = 2048, KVS = 512, OST = 2048, MTW = 68, JLO = 3;
constexpr float THR = 8.f; constexpr bool WSKIP = false;
typedef unsigned short bf16;
constexpr float SCALE = 1.0f;
constexpr int NW = 8, QBLK = 32, KVBLK = 64, QB = NW * QBLK;
constexpr int SHM_V = KVBLK * D * 2, SHM_K = KVBLK * D * 2;
constexpr int LDS_BYTES = 2 * SHM_V + 2 * SHM_K + NW * 64 * 4;

typedef short bf16x8 __attribute__((ext_vector_type(8)));
typedef short s16x4 __attribute__((ext_vector_type(4)));
typedef float f32x16 __attribute__((ext_vector_type(16)));
typedef float f32x4 __attribute__((ext_vector_type(4)));
typedef unsigned u32x4 __attribute__((ext_vector_type(4)));
template <class A, class Bt> struct same_t { static constexpr bool v = false; };
template <class A> struct same_t<A, A> { static constexpr bool v = true; };

#define KSWZ(row, colB) ((row) * 256 + ((colB) ^ (((row) & 7) << 4)))
#define SBAR() __builtin_amdgcn_sched_barrier(0)
__device__ __forceinline__ int v_st(int k, int c) { const int kk = (k & ~0xC) | ((k & 4) << 1) | ((k & 8) >> 1); return ((kk >> 3) * 4 + (c >> 5)) * 512 + ((kk & 7) * 32 + (c & 31)) * 2; }
__device__ __forceinline__ int v_rd_base(int lane) { return ((lane & 3) << 3) | (((lane >> 2) & 3) << 6) | (((lane >> 4) & 1) << 5) | (((lane >> 5) & 1) << 8); }
constexpr int v_rd_off(int d0, int ks, int half) { return d0 * 512 + ks * 4096 + half * 2048; }
__device__ __forceinline__ int crow(int r, int hi) { return (r & 3) + 8 * (r >> 2) + 4 * hi; }
__device__ __forceinline__ unsigned cvtpk(float lo, float hi) {
    unsigned r; asm volatile("v_cvt_pk_bf16_f32 %0, %1, %2" : "=v"(r) : "v"(lo), "v"(hi)); return r;
}
__device__ __forceinline__ bf16x8 pack8(f32x4 a, f32x4 b) {
    u32x4 w = {cvtpk(a[0], a[1]), cvtpk(a[2], a[3]), cvtpk(b[0], b[1]), cvtpk(b[2], b[3])};
    return *reinterpret_cast<bf16x8*>(&w);
}
template <class T> __device__ __forceinline__ bf16x8 load8(const T* p) {
    if constexpr (same_t<T, float>::v) { return pack8(*(const f32x4*)p, *(const f32x4*)(p + 4)); }
    else { return *reinterpret_cast<const bf16x8*>(p); }
}
__device__ __forceinline__ void mask_tile(f32x16& p0, f32x16& p1, int dq, unsigned W) {
    const float NEG = -__builtin_inff();
#pragma unroll
    for (int r = 0; r < 16; ++r) {
        const int c = (r & 3) + 8 * (r >> 2);
        if ((unsigned)(dq - c) >= W) p0[r] = NEG;
        if ((unsigned)(dq - c - 32) >= W) p1[r] = NEG;
    }
}
__device__ __forceinline__ void mask_bits(f32x16& p0, f32x16& p1, unsigned long long mw, int hi) {
    const float NEG = -__builtin_inff();
    const unsigned lo = (unsigned)(mw >> (4 * hi)), up = (unsigned)(mw >> (32 + 4 * hi));
#pragma unroll
    for (int r = 0; r < 16; ++r) {
        const int c = (r & 3) + 8 * (r >> 2);
        const unsigned t0 = (unsigned)__builtin_amdgcn_sbfe((int)lo, c, 1), t1 = (unsigned)__builtin_amdgcn_sbfe((int)up, c, 1);
        p0[r] = __uint_as_float((t0 & __float_as_uint(p0[r])) | (~t0 & __float_as_uint(NEG)));
        p1[r] = __uint_as_float((t1 & __float_as_uint(p1[r])) | (~t1 & __float_as_uint(NEG)));
    }
}
template <int Q> __device__ __forceinline__ void mask_bias_q(f32x16& p0, f32x16& p1, unsigned nlo, unsigned nup) {
#pragma unroll
    for (int r = 4 * Q; r < 4 * Q + 4; ++r) { const int c = (r & 3) + 8 * (r >> 2);
        p0[r] = __uint_as_float((unsigned)__builtin_amdgcn_sbfe((int)nlo, c, 1) & 0xFF800000u);
        p1[r] = __uint_as_float((unsigned)__builtin_amdgcn_sbfe((int)nup, c, 1) & 0xFF800000u); }
}
__device__ __forceinline__ void mask_bias(f32x16& p0, f32x16& p1, unsigned long long mw, int hi) {
    const unsigned nlo = ~(unsigned)(mw >> (4 * hi)), nup = ~(unsigned)(mw >> (32 + 4 * hi));
    mask_bias_q<0>(p0, p1, nlo, nup); mask_bias_q<1>(p0, p1, nlo, nup); mask_bias_q<2>(p0, p1, nlo, nup); mask_bias_q<3>(p0, p1, nlo, nup);
}
__device__ __forceinline__ void partialSM(f32x16& p0, f32x16& p1, float& m_reg, float& mn, float& alpha) {
    float pmax = p0[0]; for (int r = 1; r < 16; ++r) pmax = fmaxf(pmax, p0[r]); for (int r = 0; r < 16; ++r) pmax = fmaxf(pmax, p1[r]);
    { auto rr = __builtin_amdgcn_permlane32_swap(__float_as_uint(pmax), __float_as_uint(pmax), false, false);
      pmax = fmaxf(__uint_as_float(rr[0]), __uint_as_float(rr[1])); }
    constexpr float C2 = 1.4426950408889634f * SCALE;
    if (__builtin_expect(__all((pmax - m_reg) * SCALE <= THR), 1)) { mn = m_reg; alpha = 1.f; }
    else { mn = fmaxf(m_reg, pmax); alpha = __builtin_amdgcn_exp2f((m_reg - mn) * C2); m_reg = mn; }
    const float mnL = -mn * C2;
    for (int r = 0; r < 16; ++r) p0[r] = fmaf(p0[r], C2, mnL); for (int r = 0; r < 16; ++r) p1[r] = fmaf(p1[r], C2, mnL);
    for (int r = 0; r < 16; ++r) p0[r] = __builtin_amdgcn_exp2f(p0[r]);
}
__device__ __forceinline__ void finishSM(f32x16& p0, f32x16& p1, float alpha, float& l_reg, bf16x8& pa0, bf16x8& pa1, bf16x8& pa2, bf16x8& pa3) {
    for (int r = 0; r < 16; ++r) p1[r] = __builtin_amdgcn_exp2f(p1[r]);
    float ps = 0; for (int r = 0; r < 16; ++r) ps += p0[r]; for (int r = 0; r < 16; ++r) ps += p1[r];
    { auto rr = __builtin_amdgcn_permlane32_swap(__float_as_uint(ps), __float_as_uint(ps), false, false);
      ps = __uint_as_float(rr[0]) + __uint_as_float(rr[1]); }
    l_reg = l_reg * alpha + ps;
#define PK4(P, B_, OUT) do { unsigned a0 = cvtpk(P[B_+0], P[B_+1]), a1 = cvtpk(P[B_+2], P[B_+3]);                          \
        unsigned b0 = cvtpk(P[B_+4], P[B_+5]), b1 = cvtpk(P[B_+6], P[B_+7]);                                             \
        auto r0 = __builtin_amdgcn_permlane32_swap(a0, b0, false, false); auto r1 = __builtin_amdgcn_permlane32_swap(a1, b1, false, false); \
        u32x4 w = {r0[0], r1[0], r0[1], r1[1]}; OUT = *reinterpret_cast<bf16x8*>(&w); } while (0)
    PK4(p0, 0, pa0); PK4(p0, 8, pa1); PK4(p1, 0, pa2); PK4(p1, 8, pa3);
#undef PK4
}
template <int KB, bool SK, bool BI = false>
__device__ __forceinline__ void qkt(f32x16& p0, f32x16& p1, const char* K_lds, int r32, int hi, const bf16x8* qr, bool act) {
    if (SK && !act) { const float NEG = -__builtin_inff();
#pragma unroll
        for (int r = 0; r < 16; ++r) { p0[r] = NEG; p1[r] = NEG; } return; }
    if (!BI) { p0 = f32x16{}; p1 = f32x16{}; }
    const char* kb[4];
#pragma unroll
    for (int dd = 0; dd < 4; ++dd) kb[dd] = K_lds + KB * SHM_K + KSWZ(r32, (dd * 16 + hi * 8) * 2);
#pragma unroll
    for (int d0 = 0; d0 < 8; ++d0) { const char* a = kb[d0 & 3] + (d0 >> 2) * 128;
        bf16x8 b0 = *reinterpret_cast<const bf16x8*>(a);
        bf16x8 b1 = *reinterpret_cast<const bf16x8*>(a + 32 * 256);
        p0 = __builtin_amdgcn_mfma_f32_32x32x16_bf16(b0, qr[d0], p0, 0, 0, 0);
        p1 = __builtin_amdgcn_mfma_f32_32x32x16_bf16(b1, qr[d0], p1, 0, 0, 0); }
}
template <int VB, bool SK, bool BI = false>
__device__ __forceinline__ void pv_tile(f32x16* o, int vb0, bf16x8 pa0, bf16x8 pa1, bf16x8 pa2, bf16x8 pa3, bool act, f32x16* bq0 = nullptr, f32x16* bq1 = nullptr, unsigned nlo = 0u, unsigned nup = 0u) {
    if (SK && !act) return;
#define TRRD(dst, off) asm volatile("ds_read_b64_tr_b16 %0, %1 offset:%2" : "=&v"(dst) : "v"(vb0), "i"(off) : "memory")
#define PV_D0(d0) do { s16x4 l0, l1, l2, l3, h0, h1, h2, h3; constexpr int b_ = VB * SHM_V + v_rd_off(d0, 0, 0);     \
        TRRD(l0, b_); TRRD(h0, b_ + 2048); TRRD(l1, b_ + 4096); TRRD(h1, b_ + 6144); TRRD(l2, b_ + 8192); TRRD(h2, b_ + 10240); TRRD(l3, b_ + 12288); TRRD(h3, b_ + 14336); \
        asm volatile("s_waitcnt lgkmcnt(0)" ::: "memory"); SBAR();                 \
        o[d0] = __builtin_amdgcn_mfma_f32_32x32x16_bf16(pa0, (bf16x8){l0[0], l0[1], l0[2], l0[3], h0[0], h0[1], h0[2], h0[3]}, o[d0], 0, 0, 0);   \
        o[d0] = __builtin_amdgcn_mfma_f32_32x32x16_bf16(pa1, (bf16x8){l1[0], l1[1], l1[2], l1[3], h1[0], h1[1], h1[2], h1[3]}, o[d0], 0, 0, 0);   \
        o[d0] = __builtin_amdgcn_mfma_f32_32x32x16_bf16(pa2, (bf16x8){l2[0], l2[1], l2[2], l2[3], h2[0], h2[1], h2[2], h2[3]}, o[d0], 0, 0, 0);   \
        o[d0] = __builtin_amdgcn_mfma_f32_32x32x16_bf16(pa3, (bf16x8){l3[0], l3[1], l3[2], l3[3], h3[0], h3[1], h3[2], h3[3]}, o[d0], 0, 0, 0); } while (0)
    PV_D0(0); if (BI) mask_bias_q<0>(*bq0, *bq1, nlo, nup); PV_D0(1); if (BI) mask_bias_q<1>(*bq0, *bq1, nlo, nup);
    PV_D0(2); if (BI) mask_bias_q<2>(*bq0, *bq1, nlo, nup); PV_D0(3); if (BI) mask_bias_q<3>(*bq0, *bq1, nlo, nup);
#undef PV_D0
#undef TRRD
}

template <class TIn, class TOut> struct BlockRef { const TIn* Q; const TIn* K; const TIn* V; TOut* O; const unsigned long long* M; int P0; };
template <class TIn> struct Seam {
    bf16x8 qr[8];
    bf16x8 st_v0, st_v1, st_k0, st_k1; f32x4 sf0, sf1, sf2, sf3;
    f32x4 tq[16];
};
__device__ __forceinline__ int swa_jlo(int, int) { return JLO; }
#define ROW(p, k0, rr) ((p) + (size_t)((k0) + (rr)) * KVS + sc)
#define VMW() asm volatile("s_waitcnt vmcnt(0)" ::: "memory")
#define VMWN(n) asm volatile("s_waitcnt vmcnt(%0)" :: "i"(n) : "memory")
#define SLOAD_H(Kp, Vp, k0) do { S.st_v0 = load8<TIn>(ROW(Vp, k0, sr)); S.st_v1 = load8<TIn>(ROW(Vp, k0, 32 + sr));              \
                         S.st_k0 = load8<TIn>(ROW(Kp, k0, sr)); S.st_k1 = load8<TIn>(ROW(Kp, k0, 32 + sr)); } while (0)
#define SWRITE_HK(bf) do { *(bf16x8*)(K_lds + (bf) * SHM_K + kws) = S.st_k0; *(bf16x8*)(K_lds + (bf) * SHM_K + kws + 32 * 256) = S.st_k1; } while (0)
#define SWRITE_HV(bf) do { *(bf16x8*)(V_lds + (bf) * SHM_V + vst0) = S.st_v0; *(bf16x8*)(V_lds + (bf) * SHM_V + vst1) = S.st_v1; } while (0)
#define SWRITE_H(bf) do { SWRITE_HV(bf); SWRITE_HK(bf); } while (0)
#define SLOAD_F(p, k0) do { S.sf0 = *(const f32x4*)ROW(p, k0, sr); S.sf1 = *(const f32x4*)(ROW(p, k0, sr) + 4);                \
                            S.sf2 = *(const f32x4*)ROW(p, k0, 32 + sr); S.sf3 = *(const f32x4*)(ROW(p, k0, 32 + sr) + 4); } while (0)
#define SWRITE_KF(bf) do { *(bf16x8*)(K_lds + (bf) * SHM_K + kws) = pack8(S.sf0, S.sf1); *(bf16x8*)(K_lds + (bf) * SHM_K + kws + 32 * 256) = pack8(S.sf2, S.sf3); } while (0)
#define SWRITE_VF(bf) do { *(bf16x8*)(V_lds + (bf) * SHM_V + vst0) = pack8(S.sf0, S.sf1); *(bf16x8*)(V_lds + (bf) * SHM_V + vst1) = pack8(S.sf2, S.sf3); } while (0)
template <class TIn, class TOut>
__device__ __forceinline__ void causal_swa_prime(const BlockRef<TIn, TOut>& cur, int W, char* lds, Seam<TIn>& S, int wv) {
    constexpr bool F32 = same_t<TIn, float>::v;
    int tid0_ = threadIdx.x; asm volatile("" : "+v"(tid0_)); (void)wv;
    const int tid = tid0_, wid = __builtin_amdgcn_readfirstlane(tid >> 6), lane = tid & 63, r32 = lane & 31, hi = lane >> 5;
    const int sr = tid >> 4, sc = (tid & 15) * 8, kws = KSWZ(sr, sc * 2); char* K_lds = lds + 2 * SHM_V;
    const int kb0 = swa_jlo(cur.P0, W) * KVBLK;
    for (int d0 = 0; d0 < 8; ++d0) S.qr[d0] = load8<TIn>(cur.Q + (size_t)(wid * QBLK + r32) * QST + d0 * 16 + hi * 8);
    if constexpr (F32) { SLOAD_F((const float*)cur.K, kb0); VMW(); SWRITE_KF(0); SBAR(); SLOAD_F((const float*)cur.V, kb0); }
    else { SLOAD_H(cur.K, cur.V, kb0); VMW(); SWRITE_HK(0); }
    __syncthreads();
}
struct NoHost { __device__ __forceinline__ void issue() {} __device__ __forceinline__ void finish() {} };
template <class TIn, class TOut, int VAR = 0, class HT = NoHost>
__device__ __forceinline__ void causal_swa_block(const BlockRef<TIn, TOut>& cur, const BlockRef<TIn, TOut>& nxt, int skv, int W, char* lds, Seam<TIn>& S, int wv, HT& H) {
    constexpr bool F32 = same_t<TIn, float>::v;
    int tid0_ = threadIdx.x; asm volatile("" : "+v"(tid0_)); (void)wv;
    const int tid = tid0_, wid = __builtin_amdgcn_readfirstlane(tid >> 6), lane = tid & 63, r32 = lane & 31, hi = lane >> 5;
    const int j_lo = swa_jlo(cur.P0, W);
    int j_hi = (cur.P0 + QB - 1) / KVBLK + 1; if (j_hi > skv / KVBLK) j_hi = skv / KVBLK;
    const int NT = j_hi - j_lo;
    const int kbn = swa_jlo(nxt.P0, W) * KVBLK;
    const int qlo = cur.P0 + wid * QBLK; (void)qlo;
    const unsigned long long* mrow = cur.M + (size_t)(wid * QBLK + r32) * MTW;
    const int qm_unused = 0; (void)qm_unused;
    char* V_lds = lds; char* K_lds = lds + 2 * SHM_V;
    float* ws = (float*)(lds + 2 * SHM_V + 2 * SHM_K) + wid * 64; float* li_l = ws, * al_l = ws + 32;
    float m_reg = -1e30f, l_reg = 0; f32x16 o[4] = {};
    const int sr = tid >> 4, sc = (tid & 15) * 8, vst0 = v_st(sr, sc), vst1 = v_st(32 + sr, sc), kws = KSWZ(sr, sc * 2);
    const int vb0 = (int)(uintptr_t)V_lds + v_rd_base(lane);
    const TIn* Kh = cur.K; const TIn* Vh = cur.V;
#define RESC(a) do { if (__any((a) < 1.f)) { if (hi == 0) al_l[r32] = (a); asm volatile("s_waitcnt lgkmcnt(0)" ::: "memory");              \
                     for (int d_ = 0; d_ < 4; ++d_) for (int r = 0; r < 16; ++r) o[d_][r] *= al_l[crow(r, hi)]; } } while (0)
#define KBASE(t) ((j_lo + (t)) * KVBLK)
#define ACT(t) (KBASE(t) <= qlo + QBLK - 1 && KBASE(t) + KVBLK - 1 >= qlo - W + 1)
#define MASKT(P0_, P1_, t) do { if constexpr (VAR == 3) mask_bits(P0_, P1_, (((t) & 1) ? mwB : mwA), hi); else if constexpr (VAR == 2) { unsigned long long m_ = (((t) & 1) ? mwB : mwA); asm volatile("" :: "v"(m_)); } } while (0)
#define MWLOAD(t) do { const int tt_ = (t) < NT ? (t) : NT - 1; if ((t) & 1) mwB = mrow[j_lo + tt_]; else mwA = mrow[j_lo + tt_]; } while (0)
    constexpr int NQL = F32 ? 16 : 8;
    constexpr bool BI = (VAR == 0);
    constexpr bool SK = WSKIP && !F32;
#define SEAM_K0() do { VMWN(NQL); if constexpr (F32) { SWRITE_KF(0); SBAR(); SLOAD_F((const float*)nxt.V, kbn); } else { SWRITE_HK(0); } SBAR(); } while (0)
    f32x16 pA0, pA1, pB0, pB1; float mnA, mnB, alA, alB; bf16x8 pa0, pa1, pa2, pa3;
    unsigned long long mwA = mrow[j_lo], mwB = mrow[j_lo + (NT > 1 ? 1 : 0)];
    if constexpr (F32) { VMW(); SWRITE_VF(0); SBAR(); } else { SWRITE_HV(0); SBAR(); }
    if (NT > 1) { if constexpr (F32) SLOAD_F((const float*)Kh, KBASE(1)); else SLOAD_H(Kh, Vh, KBASE(1)); }
    if constexpr (BI) { mask_bias(pA0, pA1, mwA, hi); MWLOAD(2); }
    SBAR(); qkt<0, SK, BI>(pA0, pA1, K_lds, r32, hi, S.qr, ACT(0));
    if constexpr (BI) mask_bias(pB0, pB1, mwB, hi);
    if constexpr (F32) { if (NT > 1) { VMW(); SWRITE_KF(1); SBAR(); SLOAD_F((const float*)Vh, KBASE(1)); } }
    MASKT(pA0, pA1, 0); partialSM(pA0, pA1, m_reg, mnA, alA);
    if (NT > 1) { VMW(); if constexpr (F32) { SWRITE_VF(1); SBAR(); if (NT > 2) SLOAD_F((const float*)Kh, KBASE(2)); } else SWRITE_H(1); }
    __syncthreads();
#define HALF_STEP(PX0, PX1, mnX, alX, PY0, PY1, alY, t, KB, VB, SB) do {                                                      \
        H.issue(); if constexpr (BI) MWLOAD((t) + 2); else MWLOAD((t) + 1);                                               \
        SBAR(); qkt<KB, SK, BI>(PX0, PX1, K_lds, r32, hi, S.qr, ACT(t));                                                  \
        finishSM(PY0, PY1, alY, l_reg, pa0, pa1, pa2, pa3); SBAR();                                                           \
        if ((t) + 1 < NT) { if constexpr (F32) { VMW(); SWRITE_KF(SB); SBAR(); SLOAD_F((const float*)Vh, KBASE((t) + 1)); }  \
                            else { SLOAD_H(Kh, Vh, KBASE((t) + 1)); } SBAR(); }                                               \
        { const unsigned long long mwn_ = (((t) + 1) & 1) ? mwB : mwA; const unsigned nlo_ = ~(unsigned)(mwn_ >> (4 * hi)), nup_ = ~(unsigned)(mwn_ >> (32 + 4 * hi));   \
          pv_tile<VB, SK, BI>(o, vb0, pa0, pa1, pa2, pa3, ACT((t) - 1), &PY0, &PY1, nlo_, nup_); }                           \
        MASKT(PX0, PX1, (t)); partialSM(PX0, PX1, m_reg, mnX, alX);                                        \
        __syncthreads();                                                                                                      \
        if ((t) + 1 < NT) { VMW(); if constexpr (F32) { SWRITE_VF(SB); SBAR(); if ((t) + 2 < NT) SLOAD_F((const float*)Kh, KBASE((t) + 2)); } \
                            else { SWRITE_H(SB); } }                                                                          \
        H.finish(); RESC(alX); __syncthreads(); } while (0)
    for (int t = 1; t + 1 < NT; t += 2) {
        HALF_STEP(pB0, pB1, mnB, alB, pA0, pA1, alA, t, 1, 0, 0);
        HALF_STEP(pA0, pA1, mnA, alA, pB0, pB1, alB, t + 1, 0, 1, 1);
    }
    const bool even = (NT & 1) == 0;
    if (even) { SBAR(); qkt<1, SK, BI>(pB0, pB1, K_lds, r32, hi, S.qr, ACT(NT - 1)); SBAR(); }
#define QROW(e) (nxt.Q + (size_t)(wid * QBLK + r32) * QST + ((e) >> 1) * 16 + hi * 8 + ((e) & 1) * 4)
    if constexpr (F32) { SLOAD_F((const float*)nxt.K, kbn); SBAR();
#pragma unroll
        for (int e = 0; e < 8; ++e) S.tq[e] = *(const f32x4*)QROW(e); }
    else { SLOAD_H(nxt.K, nxt.V, kbn); SBAR();
#pragma unroll
        for (int d0 = 0; d0 < 8; ++d0) S.qr[d0] = load8<TIn>(nxt.Q + (size_t)(wid * QBLK + r32) * QST + d0 * 16 + hi * 8); }
    SBAR();
    finishSM(pA0, pA1, alA, l_reg, pa0, pa1, pa2, pa3); SBAR();
    if constexpr (F32) {
#pragma unroll
        for (int e = 8; e < 16; ++e) S.tq[e] = *(const f32x4*)QROW(e); SBAR(); }
#undef QROW
    pv_tile<0, SK>(o, vb0, pa0, pa1, pa2, pa3, ACT(even ? NT - 2 : NT - 1));
    if (even) { MASKT(pB0, pB1, NT - 1); partialSM(pB0, pB1, m_reg, mnB, alB); __syncthreads(); RESC(alB);
        finishSM(pB0, pB1, alB, l_reg, pa0, pa1, pa2, pa3); SBAR(); pv_tile<1, SK>(o, vb0, pa0, pa1, pa2, pa3, ACT(NT - 1)); }
    SBAR(); SEAM_K0();
    if (hi == 0) li_l[r32] = l_reg; asm volatile("s_waitcnt lgkmcnt(0)" ::: "memory");
    float rli[16];
#pragma unroll
    for (int r = 0; r < 16; ++r) rli[r] = __builtin_amdgcn_rcpf(li_l[crow(r, hi)]);
    TOut* Ow = cur.O + (size_t)(wid * QBLK) * OST;
#pragma unroll
    for (int r = 0; r < 16; ++r) { const int orow = crow(r, hi);
#pragma unroll
        for (int d0 = 0; d0 < 4; ++d0) { const float v = o[d0][r] * rli[r];
            if constexpr (same_t<TOut, float>::v) { Ow[(size_t)orow * OST + d0 * 32 + r32] = v; }
            else { const float vn = __shfl_xor(v, 1);
                   if ((r32 & 1) == 0) *(unsigned*)(Ow + (size_t)orow * OST + d0 * 32 + r32) = cvtpk(v, vn); } } }
    if constexpr (F32) {
#pragma unroll
        for (int d0 = 0; d0 < 8; ++d0) S.qr[d0] = pack8(S.tq[2 * d0], S.tq[2 * d0 + 1]); }
    __syncthreads();
#undef RESC
#undef KBASE
#undef ACT
#undef MASKT
#undef MWLOAD
#undef SEAM_K0
#undef HALF_STEP
}
#undef ROW
#undef VMW
#undef VMWN
#undef SLOAD_H
#undef SWRITE_HK
#undef SWRITE_HV
#undef SWRITE_H
#undef SLOAD_F
#undef SWRITE_KF
#undef SWRITE_VF

}

constexpr int NWAVES = 8, NTHREADS = 512;
constexpr int DM = 2048, SEQ = 4096, NMETA = 16, TP = 4112, NBP = 2, SBN = 8, PAST = 16384, NPG = 128;
constexpr int XROW0 = 8192, SROW0 = 8224, NROWS = 8232, MPAD = 8448, FF = 8192, MAINM = 8192, XR = 48;
constexpr int NA_IN = 6144, NB_IN = 4176, NB_PAD = 4352, NC_IN = 12352, NC_PAD = 12544, DVW = 4096, CDIM = 8192;
constexpr float ALPHA = 1.6817928305074292f;
constexpr float LN_EPS = 1e-5f, RMS_EPS = 1e-6f;
constexpr int SCW = 4160, SCSW = 16448, KIROWS = 4128, NSKEY = PAST + 1;
constexpr int POS_SAMPLE_IDX = TP;

constexpr size_t O_YP = 0, O_YS = O_YP + (size_t)NBP * SEQ * DM, O_CAP = O_YS + (size_t)SBN * DM, O_CAS = O_CAP + 2 * NBP * 2 * DM,
                 O_KP = O_CAS + 2 * SBN * 2 * DM, O_VP = O_KP + (size_t)NBP * TP * 512, O_IKP = O_VP + (size_t)NBP * TP * 512,
                 O_KS = O_IKP + (size_t)NBP * TP * 64, O_VS = O_KS + SBN * 512, O_IKS = O_VS + SBN * 512, O_CCP = O_IKS + SBN * 64,
                 O_CCS = O_CCP + (size_t)NBP * 3 * CDIM, O_DP = O_CCS + (size_t)SBN * 3 * CDIM, O_DS = O_DP + (size_t)NBP * 32 * 128 * 128,
                 O_END = O_DS + (size_t)SBN * 32 * 128 * 128;

constexpr size_t MiB = 1u << 20;
constexpr size_t WS_CTL = 0, CTL_ZERO_BYTES = 1 * MiB;
constexpr size_t WS_TAB128 = 1 * MiB, WS_TAB64 = 4 * MiB, WS_WI = 6 * MiB, WS_G = 7 * MiB, WS_BETA = 9 * MiB, WS_CNT = 11 * MiB, WS_KIB = 12 * MiB,
                 WS_SCS = 14 * MiB, WS_IDXL = 16 * MiB, WS_X = 26 * MiB, WS_QR = 60 * MiB, WS_QI = 94 * MiB, WS_Z = 112 * MiB, WS_Y = 180 * MiB,
                 WS_BIG = 248 * MiB, WS_QKVC = 452 * MiB, WS_SC = 584 * MiB, WS_W = 716 * MiB;
constexpr size_t WSZ_A_IN = (size_t)NA_IN * DM * 2, WSZ_A_OUT = (size_t)DM * DM * 2, WSZ_B_IN = (size_t)NB_PAD * DM * 2, WSZ_B_OUT = (size_t)DM * DM * 2,
                 WSZ_C_IN = (size_t)NC_PAD * DM * 2, WSZ_C_OUT = (size_t)DM * DVW * 2, WSZ_W1 = (size_t)FF * DM * 2, WSZ_W2 = (size_t)DM * FF * 2;
constexpr size_t WS_WA_IN = WS_W, WS_WA_OUT = WS_WA_IN + 2 * WSZ_A_IN, WS_WB_IN = WS_WA_OUT + 2 * WSZ_A_OUT, WS_WB_OUT = WS_WB_IN + WSZ_B_IN,
                 WS_WC_IN = WS_WB_OUT + WSZ_B_OUT, WS_WC_OUT = WS_WC_IN + WSZ_C_IN, WS_W1 = WS_WC_OUT + WSZ_C_OUT, WS_W2 = WS_W1 + 4 * WSZ_W1,
                 WS_ZP = WS_W2 + 4 * WSZ_W2, WS_QKF = WS_ZP + 4 * MiB, WS_DWG = WS_QKF + 130 * MiB, WS_DUG = WS_DWG + 66 * MiB, WS_END = WS_DUG + 66 * MiB;
constexpr size_t WS_MASK = WS_IDXL, WS_KS = WS_Z, WS_VS = WS_Z + 9 * MiB;
constexpr size_t WS_DAF = WS_Z, WS_DTG = WS_Y, WS_DTB = WS_Y + 33 * MiB, WS_DPG = WS_QR, WS_DKT = WS_QKF, WS_DVT = WS_QKF + 33 * MiB, WS_DGC = WS_QI, WS_DBT = WS_QI + 2 * MiB;
constexpr int SP = 4352, SPAD = 240, MTW = 68;
constexpr int CW_BAR = 4096;

constexpr int RING_BYTES = 131072, LDSCTL_OFF = RING_BYTES, MISC_OFF = LDSCTL_OFF + 320, LDS_BYTES = 147456;

typedef unsigned short bf16;
typedef unsigned v4u __attribute__((ext_vector_type(4)));
typedef unsigned v2u __attribute__((ext_vector_type(2)));
typedef float f32x4 __attribute__((ext_vector_type(4)));
typedef float f32x2 __attribute__((ext_vector_type(2)));
typedef short bf16x8 __attribute__((ext_vector_type(8)));
typedef float f32x16 __attribute__((ext_vector_type(16)));
typedef __bf16 bf16x2_t __attribute__((ext_vector_type(2)));

#define LDS_WAIT() asm volatile("s_waitcnt lgkmcnt(0)" ::: "memory")
#define WAVE_SYNC() do { asm volatile("s_waitcnt lgkmcnt(0)" ::: "memory"); __builtin_amdgcn_wave_barrier(); } while (0)

__device__ __forceinline__ float bflo(unsigned w) { return __uint_as_float(w << 16); }
__device__ __forceinline__ float bfhi(unsigned w) { return __uint_as_float(w & 0xffff0000u); }
__device__ __forceinline__ float bf2f(bf16 h) { return __uint_as_float((unsigned)h << 16); }
__device__ __forceinline__ unsigned pk2(float lo, float hi) { f32x2 v = {lo, hi}; bf16x2_t b = __builtin_convertvector(v, bf16x2_t); return __builtin_bit_cast(unsigned, b); }
__device__ __forceinline__ bf16 f2bf(float f) { return (bf16)(pk2(f, 0.f) & 0xffffu); }
__device__ __forceinline__ float wave_sum(float v) {
#pragma unroll
    for (int o = 1; o < 64; o <<= 1) v += __shfl_xor(v, o);
    return v;
}
__device__ __forceinline__ float wave_max(float v) {
#pragma unroll
    for (int o = 1; o < 64; o <<= 1) v = fmaxf(v, __shfl_xor(v, o));
    return v;
}
__device__ __forceinline__ int wave_sum_i(int v) {
#pragma unroll
    for (int o = 1; o < 64; o <<= 1) v += __shfl_xor(v, o);
    return v;
}
__device__ __forceinline__ float wave_sum_dpp(float v) {
    v += __int_as_float(__builtin_amdgcn_update_dpp(0, __float_as_int(v), 0x128, 0xf, 0xf, false));
    v += __int_as_float(__builtin_amdgcn_update_dpp(0, __float_as_int(v), 0x124, 0xf, 0xf, false));
    v += __int_as_float(__builtin_amdgcn_update_dpp(0, __float_as_int(v), 0x122, 0xf, 0xf, false));
    v += __int_as_float(__builtin_amdgcn_update_dpp(0, __float_as_int(v), 0x121, 0xf, 0xf, false));
    const int iv = __float_as_int(v);
    return (__int_as_float(__builtin_amdgcn_readlane(iv, 0)) + __int_as_float(__builtin_amdgcn_readlane(iv, 16))) + (__int_as_float(__builtin_amdgcn_readlane(iv, 32)) + __int_as_float(__builtin_amdgcn_readlane(iv, 48)));
}
__device__ __forceinline__ int wave_sum_dpp_i(int v) {
    v += __builtin_amdgcn_update_dpp(0, v, 0x128, 0xf, 0xf, false);
    v += __builtin_amdgcn_update_dpp(0, v, 0x124, 0xf, 0xf, false);
    v += __builtin_amdgcn_update_dpp(0, v, 0x122, 0xf, 0xf, false);
    v += __builtin_amdgcn_update_dpp(0, v, 0x121, 0xf, 0xf, false);
    return __builtin_amdgcn_readlane(v, 0) + __builtin_amdgcn_readlane(v, 16) + __builtin_amdgcn_readlane(v, 32) + __builtin_amdgcn_readlane(v, 48);
}
__device__ __forceinline__ float row16_sum(float v) {
    v += __int_as_float(__builtin_amdgcn_update_dpp(0, __float_as_int(v), 0x128, 0xf, 0xf, false));
    v += __int_as_float(__builtin_amdgcn_update_dpp(0, __float_as_int(v), 0x124, 0xf, 0xf, false));
    v += __int_as_float(__builtin_amdgcn_update_dpp(0, __float_as_int(v), 0x122, 0xf, 0xf, false));
    v += __int_as_float(__builtin_amdgcn_update_dpp(0, __float_as_int(v), 0x121, 0xf, 0xf, false));
    return v;
}
__device__ __forceinline__ float silu_f(float x) { return x / (1.f + __expf(-x)); }
__device__ __forceinline__ int prow(int b, int t) { return t >= NMETA ? b * SEQ + (t - NMETA) : XROW0 + b * NMETA + t; }
__device__ __forceinline__ void row_bt(int r, int& b, int& t) { if (r < XROW0) { b = r >> 12; t = (r & 4095) + NMETA; } else { b = (r - XROW0) >> 4; t = (r - XROW0) & 15; } }
__device__ __forceinline__ void unpack8(const v4u w, float (&f)[8]) {
    f[0] = bflo(w.x); f[1] = bfhi(w.x); f[2] = bflo(w.y); f[3] = bfhi(w.y); f[4] = bflo(w.z); f[5] = bfhi(w.z); f[6] = bflo(w.w); f[7] = bfhi(w.w);
}
__device__ __forceinline__ v4u pack8(const float (&f)[8]) { v4u w; w.x = pk2(f[0], f[1]); w.y = pk2(f[2], f[3]); w.z = pk2(f[4], f[5]); w.w = pk2(f[6], f[7]); return w; }

struct TrJob { bf16* WT; int K, k0, n0; bool ok, valid; };
__device__ __forceinline__ void tr_issue(const float* W, int K, int N, int Npad, bf16* WT, int item, int lane, float (&wv_)[32], TrJob& J) {
    const int nblk = Npad / 32, kb = item / nblk, nb = item % nblk, k0 = 64 * kb, n0 = 32 * nb;
    const int n = n0 + (lane & 31); const bool ok = n < N;
#pragma unroll
    for (int i = 0; i < 32; ++i) { const int kk = 2 * i + (lane >> 5); wv_[i] = W[(size_t)(k0 + kk) * N + (ok ? n : N - 1)]; }
    J.WT = WT; J.K = K; J.k0 = k0; J.n0 = n0; J.ok = ok; J.valid = true;
}
__device__ __forceinline__ void tr_finish(const float (&wv_)[32], const TrJob& J, LAS float* scr, int lane) {
#pragma unroll
    for (int i = 0; i < 32; ++i) { const int kk = 2 * i + (lane >> 5); scr[kk * 33 + (lane & 31)] = J.ok ? wv_[i] : 0.f; }
    LDS_WAIT(); __builtin_amdgcn_wave_barrier();
    const int c = lane & 7;
#pragma unroll
    for (int j = 0; j < 4; ++j) { const int nn = (lane >> 3) + 8 * j; const LAS float* sp = scr + (8 * c) * 33 + nn;
        v4u o; o.x = pk2(sp[0 * 33], sp[1 * 33]); o.y = pk2(sp[2 * 33], sp[3 * 33]); o.z = pk2(sp[4 * 33], sp[5 * 33]); o.w = pk2(sp[6 * 33], sp[7 * 33]);
        *(v4u*)(J.WT + (size_t)(J.n0 + nn) * J.K + J.k0 + 8 * c) = o; }
    LDS_WAIT(); __builtin_amdgcn_wave_barrier();
}
__device__ __forceinline__ void transpose_item(const float* W, int K, int N, int Npad, bf16* WT, LAS float* scr, int item, int lane) {
    float wv_[32]; TrJob J; tr_issue(W, K, N, Npad, WT, item, lane, wv_, J); tr_finish(wv_, J, scr, lane);
}

struct Ptrs {
    const float *x_prompt, *x_sample, *state_conv_a, *cache_k, *cache_v, *cache_ik, *state_conv_c, *state_delta;
    const int* page_table;
    const float *meta, *w_in_a, *conv_w_a, *w_out_a, *w_in_b, *w_out_b, *w_in_c, *conv_w_c, *a_log, *dt_bias, *norm_w, *w_out_c, *ln1_g, *ln1_b, *w1, *w2, *ln2_g, *ln2_b;
    float* out; unsigned char* ws;
};

__device__ __forceinline__ void p0_prologue(const Ptrs& P, LAS unsigned char* lds, int gw, int NGW, int wave, int lane) {
    LAS float* scr = (LAS float*)(lds + wave * 16384);
    unsigned char* ws = P.ws;
    constexpr int I_A_IN = (DM / 64) * (NA_IN / 32), I_A_OUT = (DM / 64) * (DM / 32), I_B_IN = (DM / 64) * (NB_PAD / 32), I_B_OUT = I_A_OUT,
                  I_C_IN = (DM / 64) * (NC_PAD / 32), I_C_OUT = (DVW / 64) * (DM / 32), I_W1 = (DM / 64) * (FF / 32), I_W2 = (FF / 64) * (DM / 32);
    constexpr int NITEMS = I_A_IN + I_A_OUT + I_B_IN + I_W1 + I_W2;
#define TR_(cnt, Wp, Kk, Nn, Np, WTp) if (r < (cnt)) { transpose_item((Wp), (Kk), (Nn), (Np), (bf16*)(WTp), scr, r, lane); continue; } r -= (cnt);
    for (int it = gw; it < NITEMS; it += NGW) {
        int r = it;
        TR_(I_A_IN, P.w_in_a, DM, NA_IN, NA_IN, ws + WS_WA_IN)
        TR_(I_A_OUT, P.w_out_a, DM, DM, DM, ws + WS_WA_OUT)
        TR_(I_B_IN, P.w_in_b, DM, NB_IN, NB_PAD, ws + WS_WB_IN)
        TR_(I_W1, P.w1, DM, FF, FF, ws + WS_W1)
        transpose_item(P.w2, FF, DM, DM, (bf16*)(ws + WS_W2), scr, r, lane);
    }
#undef TR_
    bf16* X = (bf16*)(ws + WS_X);
    for (int r = gw; r < MPAD; r += NGW) {
        const float* src = nullptr;
        if (r < XROW0) src = P.x_prompt + (size_t)r * DM;
        else if (r < SROW0) src = P.meta + (size_t)((r - XROW0) & 15) * DM;
        else if (r < NROWS) src = P.x_sample + (size_t)(r - SROW0) * DM;
#pragma unroll
        for (int j = 0; j < 4; ++j) { const int c = 512 * j + 8 * lane; v4u o = {0u, 0u, 0u, 0u};
            if (src) { const f32x4 a = *(const f32x4*)(src + c), b = *(const f32x4*)(src + c + 4); o.x = pk2(a.x, a.y); o.y = pk2(a.z, a.w); o.z = pk2(b.x, b.y); o.w = pk2(b.z, b.w); }
            *(v4u*)(X + (size_t)r * DM + c) = o; }
    }
    f32x2* t128 = (f32x2*)(ws + WS_TAB128); f32x2* t64 = (f32x2*)(ws + WS_TAB64);
    const int gt = gw * 64 + lane, NGT = NGW * 64;
    for (int e = gt; e < (TP + 1) * 96; e += NGT) {
        const int pi = e / 96, i = e % 96; const float pos = (float)(pi == TP ? PAST : pi);
        const float ex = (i < 64) ? (float)(2 * i) * (1.f / 128.f) : (float)(2 * (i - 64)) * (1.f / 64.f);
        const float inv = __builtin_amdgcn_exp2f(-ex * 13.287712379549449f);
        const float angf = pos * inv;
        double rev = (double)angf * 0.15915494309189535; rev -= __builtin_rint(rev);
        const float rf = (float)rev; const float sn = __builtin_amdgcn_sinf(rf), cs = __builtin_amdgcn_cosf(rf);
        if (i < 64) t128[pi * 64 + i] = (f32x2){cs, sn}; else t64[pi * 32 + (i - 64)] = (f32x2){cs, sn};
    }
}

constexpr int NHOSTED = (DM / 64) * (FF / 32) + (DM / 64) * (NC_PAD / 32);
__device__ __forceinline__ void hosted_issue(const Ptrs& P, int it, int lane, float (&wv_)[32], TrJob& J) {
    unsigned char* ws = P.ws;
    constexpr int I_B_OUT = (DM / 64) * (DM / 32), I_C_IN = (DM / 64) * (NC_PAD / 32), I_W1 = (DM / 64) * (FF / 32), I_W2 = (FF / 64) * (DM / 32);
    J.valid = false;
    if (it >= NHOSTED) return;
    int r = it;
    (void)I_B_OUT; (void)I_W2;
    if (r < I_W1) { tr_issue(P.w1 + (size_t)DM * FF, DM, FF, FF, (bf16*)(ws + WS_W1 + WSZ_W1), r, lane, wv_, J); return; } r -= I_W1;
    (void)I_C_IN; tr_issue(P.w_in_c, DM, NC_IN, NC_PAD, (bf16*)(ws + WS_WC_IN), r, lane, wv_, J);
}
__device__ __forceinline__ void deferred_transposes(const Ptrs& P, LAS unsigned char* lds, int idx, int stride, int wave, int lane) {
    LAS float* scr = (LAS float*)(lds + wave * 16384);
    unsigned char* ws = P.ws;
    constexpr int I_A_IN = (DM / 64) * (NA_IN / 32), I_A_OUT = (DM / 64) * (DM / 32), I_C_OUT = (DVW / 64) * (DM / 32), I_W1 = (DM / 64) * (FF / 32), I_W2 = (FF / 64) * (DM / 32);
    constexpr int NITEMS = I_C_OUT + I_W1 + I_W2; (void)I_A_IN; (void)I_A_OUT;
#define TR_(cnt, Wp, Kk, Nn, Np, WTp) if (r < (cnt)) { transpose_item((Wp), (Kk), (Nn), (Np), (bf16*)(WTp), scr, r, lane); continue; } r -= (cnt);
    for (int it = idx; it < NITEMS; it += stride) {
        int r = it;
        TR_(I_C_OUT, P.w_out_c, DVW, DM, DM, ws + WS_WC_OUT)
        TR_(I_W1, P.w1 + 2 * (size_t)DM * FF, DM, FF, FF, ws + WS_W1 + 2 * WSZ_W1)
        transpose_item(P.w2 + 2 * (size_t)DM * FF, FF, DM, DM, (bf16*)(ws + WS_W2 + 2 * WSZ_W2), scr, r, lane);
    }
#undef TR_
}

__device__ __forceinline__ void ln_row_finish(float (&v)[32], float s, const f32x4 (&gq)[8], const f32x4 (&bq_)[8], bf16* xo, float* of, int lane) {
    const float mean = wave_sum_dpp(s) * (1.f / DM); float s2 = 0.f;
#pragma unroll
    for (int i = 0; i < 32; ++i) { v[i] -= mean; s2 += v[i] * v[i]; }
    const float rstd = 1.f / sqrtf(wave_sum_dpp(s2) * (1.f / DM) + LN_EPS);
#pragma unroll
    for (int j = 0; j < 4; ++j) { const int c = 512 * j + 8 * lane; const f32x4 g0 = gq[2 * j], g1 = gq[2 * j + 1], b0 = bq_[2 * j], b1 = bq_[2 * j + 1];
        float o[8];
        o[0] = v[8 * j + 0] * rstd * g0.x + b0.x; o[1] = v[8 * j + 1] * rstd * g0.y + b0.y; o[2] = v[8 * j + 2] * rstd * g0.z + b0.z; o[3] = v[8 * j + 3] * rstd * g0.w + b0.w;
        o[4] = v[8 * j + 4] * rstd * g1.x + b1.x; o[5] = v[8 * j + 5] * rstd * g1.y + b1.y; o[6] = v[8 * j + 6] * rstd * g1.z + b1.z; o[7] = v[8 * j + 7] * rstd * g1.w + b1.w;
        *(v4u*)(xo + c) = pack8(o);
        if (of) { *(f32x4*)(of + c) = (f32x4){o[0], o[1], o[2], o[3]}; *(f32x4*)(of + c + 4) = (f32x4){o[4], o[5], o[6], o[7]}; } }
}
__device__ __forceinline__ void ln_phase(const float* Z, const float* ZP, bf16* X, bf16* Xo, const float* gam, const float* bet, float* yp, float* ys, LAS unsigned char* lds, int gw, int NGW, int tid, int wave, int lane) {
    (void)Z;
    LAS float* red = (LAS float*)lds;
    for (int xr = blockIdx.x; xr < NROWS - XROW0; xr += gridDim.x) {
        const int r = XROW0 + xr, c = 256 * wave + 4 * lane;
        const v2u xv = *(const v2u*)(X + (size_t)r * DM + c);
        const float* zr = ZP + (size_t)xr * DM + c; f32x4 z = *(const f32x4*)zr;
#pragma unroll
        for (int sl = 1; sl < 8; ++sl) z += *(const f32x4*)(zr + (size_t)sl * XR * DM);
        float v4[4] = {ALPHA * bflo(xv.x) + z.x, ALPHA * bfhi(xv.x) + z.y, ALPHA * bflo(xv.y) + z.z, ALPHA * bfhi(xv.y) + z.w};
        const float ps = wave_sum_dpp((v4[0] + v4[1]) + (v4[2] + v4[3]));
        __syncthreads();
        if (lane == 0) red[wave] = ps;
        __syncthreads();
        float tot = 0.f;
#pragma unroll
        for (int w = 0; w < 8; ++w) tot += red[w];
        const float mean = tot * (1.f / DM); float q2 = 0.f;
#pragma unroll
        for (int i = 0; i < 4; ++i) { v4[i] -= mean; q2 += v4[i] * v4[i]; }
        const float pq = wave_sum_dpp(q2);
        if (lane == 0) red[8 + wave] = pq;
        __syncthreads();
        float tq = 0.f;
#pragma unroll
        for (int w = 0; w < 8; ++w) tq += red[8 + w];
        const float rstd = 1.f / sqrtf(tq * (1.f / DM) + LN_EPS);
        const f32x4 g = *(const f32x4*)(gam + c), be = *(const f32x4*)(bet + c);
        const float o0 = v4[0] * rstd * g.x + be.x, o1 = v4[1] * rstd * g.y + be.y, o2 = v4[2] * rstd * g.z + be.z, o3 = v4[3] * rstd * g.w + be.w;
        v2u ov; ov.x = pk2(o0, o1); ov.y = pk2(o2, o3); *(v2u*)(Xo + (size_t)r * DM + c) = ov;
        if (ys && r >= SROW0) *(f32x4*)(ys + (size_t)(r - SROW0) * DM + c) = (f32x4){o0, o1, o2, o3};
    }
    f32x4 gq[8], bq_[8];
#pragma unroll
    for (int j = 0; j < 4; ++j) { const int c = 512 * j + 8 * lane; gq[2 * j] = *(const f32x4*)(gam + c); gq[2 * j + 1] = *(const f32x4*)(gam + c + 4); bq_[2 * j] = *(const f32x4*)(bet + c); bq_[2 * j + 1] = *(const f32x4*)(bet + c + 4); }
    for (int r = gw; r < XROW0; r += 2 * NGW) {
        const int r2 = r + NGW; const bool two = r2 < XROW0;
        v4u xa[4], xb[4];
#pragma unroll
        for (int j = 0; j < 4; ++j) { const int c = 512 * j + 8 * lane; xa[j] = *(const v4u*)(X + (size_t)r * DM + c); xb[j] = *(const v4u*)(X + (size_t)(two ? r2 : r) * DM + c); }
        float va[32], vb[32]; float sa = 0.f, sb = 0.f;
#pragma unroll
        for (int j = 0; j < 4; ++j) { float t8[8]; unpack8(xa[j], t8);
#pragma unroll
            for (int i = 0; i < 8; ++i) { va[8 * j + i] = t8[i]; sa += t8[i]; }
            unpack8(xb[j], t8);
#pragma unroll
            for (int i = 0; i < 8; ++i) { vb[8 * j + i] = t8[i]; sb += t8[i]; } }
        ln_row_finish(va, sa, gq, bq_, Xo + (size_t)r * DM, yp ? yp + (size_t)r * DM : nullptr, lane);
        if (two) ln_row_finish(vb, sb, gq, bq_, Xo + (size_t)r2 * DM, yp ? yp + (size_t)r2 * DM : nullptr, lane);
    }
}

__device__ __forceinline__ void load_u(const bf16* BCH, int row, int c0, float (&u)[8]) {
    const v4u cg = *(const v4u*)(BCH + (size_t)row * NA_IN + DM + c0), hh = *(const v4u*)(BCH + (size_t)row * NA_IN + 2 * DM + c0);
    float a[8], b[8]; unpack8(cg, a); unpack8(hh, b);
#pragma unroll
    for (int i = 0; i < 8; ++i) u[i] = a[i] * b[i];
}
__device__ __forceinline__ void convA_phase(const bf16* BCH, bf16* Y, const float* cw, const float* hist, float* outp, float* outs, int gtid, int NT) {
    constexpr int RUN = 8, NRUN = SEQ / RUN;
    for (int it = gtid; it < (NBP * NRUN + NBP * NMETA + SBN) * 256; it += NT) {
        const int c0 = (it & 255) * 8, ru = it >> 8;
        float w0[8], w1[8], w2[8];
        { const f32x4 a = *(const f32x4*)(cw + c0), b = *(const f32x4*)(cw + c0 + 4); w0[0] = a.x; w0[1] = a.y; w0[2] = a.z; w0[3] = a.w; w0[4] = b.x; w0[5] = b.y; w0[6] = b.z; w0[7] = b.w; }
        { const f32x4 a = *(const f32x4*)(cw + DM + c0), b = *(const f32x4*)(cw + DM + c0 + 4); w1[0] = a.x; w1[1] = a.y; w1[2] = a.z; w1[3] = a.w; w1[4] = b.x; w1[5] = b.y; w1[6] = b.z; w1[7] = b.w; }
        { const f32x4 a = *(const f32x4*)(cw + 2 * DM + c0), b = *(const f32x4*)(cw + 2 * DM + c0 + 4); w2[0] = a.x; w2[1] = a.y; w2[2] = a.z; w2[3] = a.w; w2[4] = b.x; w2[5] = b.y; w2[6] = b.z; w2[7] = b.w; }
        float u0[8], u1[8], u2[8];
        if (ru < NBP * NRUN) {
            const int b = ru / NRUN, t0 = NMETA + (ru % NRUN) * RUN;
            if (t0 >= 1) load_u(BCH, prow(b, t0 - 1), c0, u1); else {
#pragma unroll
                for (int i = 0; i < 8; ++i) u1[i] = 0.f; }
            if (t0 >= 2) load_u(BCH, prow(b, t0 - 2), c0, u0); else {
#pragma unroll
                for (int i = 0; i < 8; ++i) u0[i] = 0.f; }
            const int r0 = prow(b, t0);
            v4u bq[RUN], cq[RUN], hq_[RUN];
#pragma unroll
            for (int k = 0; k < RUN; ++k) { const bf16* rp = BCH + (size_t)(r0 + k) * NA_IN + c0; bq[k] = *(const v4u*)rp; cq[k] = *(const v4u*)(rp + DM); hq_[k] = *(const v4u*)(rp + 2 * DM); }
#pragma unroll
            for (int k = 0; k < RUN; ++k) {
                const int r = r0 + k, t = t0 + k;
                { float ca[8], ha[8]; unpack8(cq[k], ca); unpack8(hq_[k], ha);
#pragma unroll
                  for (int i = 0; i < 8; ++i) u2[i] = ca[i] * ha[i]; }
                float bg[8]; unpack8(bq[k], bg);
                float y[8];
#pragma unroll
                for (int i = 0; i < 8; ++i) y[i] = bg[i] * (w0[i] * u0[i] + w1[i] * u1[i] + w2[i] * u2[i]);
                *(v4u*)(Y + (size_t)r * DM + c0) = pack8(y);
                if (t >= TP - 2) { float* o = outp + ((size_t)(b * 2 + (t - (TP - 2)))) * DM + c0; *(f32x4*)o = (f32x4){u2[0], u2[1], u2[2], u2[3]}; *(f32x4*)(o + 4) = (f32x4){u2[4], u2[5], u2[6], u2[7]}; }
#pragma unroll
                for (int i = 0; i < 8; ++i) { u0[i] = u1[i]; u1[i] = u2[i]; }
            }
        } else if (ru < NBP * NRUN + NBP * NMETA) {
            const int mi = ru - NBP * NRUN, b = mi / NMETA, t = mi % NMETA, r = XROW0 + mi;
            load_u(BCH, r, c0, u2);
            if (t >= 1) load_u(BCH, r - 1, c0, u1); else {
#pragma unroll
                for (int i = 0; i < 8; ++i) u1[i] = 0.f; }
            if (t >= 2) load_u(BCH, r - 2, c0, u0); else {
#pragma unroll
                for (int i = 0; i < 8; ++i) u0[i] = 0.f; }
            (void)b;
            float bg[8]; unpack8(*(const v4u*)(BCH + (size_t)r * NA_IN + c0), bg);
            float y[8];
#pragma unroll
            for (int i = 0; i < 8; ++i) y[i] = bg[i] * (w0[i] * u0[i] + w1[i] * u1[i] + w2[i] * u2[i]);
            *(v4u*)(Y + (size_t)r * DM + c0) = pack8(y);
        } else {
            const int sb = ru - NBP * NRUN - NBP * NMETA, r = SROW0 + sb;
            load_u(BCH, r, c0, u2);
            const float* h0 = hist + ((size_t)(sb * 2 + 0)) * DM + c0; const float* h1 = hist + ((size_t)(sb * 2 + 1)) * DM + c0;
            const f32x4 a0 = *(const f32x4*)h0, a1 = *(const f32x4*)(h0 + 4), b0 = *(const f32x4*)h1, b1 = *(const f32x4*)(h1 + 4);
            u0[0] = a0.x; u0[1] = a0.y; u0[2] = a0.z; u0[3] = a0.w; u0[4] = a1.x; u0[5] = a1.y; u0[6] = a1.z; u0[7] = a1.w;
            u1[0] = b0.x; u1[1] = b0.y; u1[2] = b0.z; u1[3] = b0.w; u1[4] = b1.x; u1[5] = b1.y; u1[6] = b1.z; u1[7] = b1.w;
            float* o0 = outs + ((size_t)(sb * 2 + 0)) * DM + c0; float* o1 = outs + ((size_t)(sb * 2 + 1)) * DM + c0;
            *(f32x4*)o0 = b0; *(f32x4*)(o0 + 4) = b1;
            *(f32x4*)o1 = (f32x4){u2[0], u2[1], u2[2], u2[3]}; *(f32x4*)(o1 + 4) = (f32x4){u2[4], u2[5], u2[6], u2[7]};
            float bg[8]; unpack8(*(const v4u*)(BCH + (size_t)r * NA_IN + c0), bg);
            float y[8];
#pragma unroll
            for (int i = 0; i < 8; ++i) y[i] = bg[i] * (w0[i] * u0[i] + w1[i] * u1[i] + w2[i] * u2[i]);
            *(v4u*)(Y + (size_t)r * DM + c0) = pack8(y);
        }
    }
}

constexpr float QSCALE = 0.08838834764831845f;
__device__ __forceinline__ void rope_phase(const bf16* PROJ, const Ptrs& P, int gw, int NGW, int lane) {
    unsigned char* ws = P.ws;
    const f32x2* t128 = (const f32x2*)(ws + WS_TAB128); const f32x2* t64 = (const f32x2*)(ws + WS_TAB64);
    bf16* Qr = (bf16*)(ws + WS_QR); bf16* QI = (bf16*)(ws + WS_QI); bf16* KIb = (bf16*)(ws + WS_KIB); float* WI = (float*)(ws + WS_WI);
    bf16* Ks = (bf16*)(ws + WS_KS); bf16* Vs = (bf16*)(ws + WS_VS);
    for (int pr_ = gw; pr_ < NBP * SPAD; pr_ += NGW) {
        const size_t o = ((size_t)((pr_ / SPAD) * SP + (pr_ % SPAD))) * 512 + 8 * lane; *(v4u*)(Ks + o) = (v4u){0u, 0u, 0u, 0u}; *(v4u*)(Vs + o) = (v4u){0u, 0u, 0u, 0u}; }
    for (int r = gw; r < NROWS; r += NGW) {
        const bf16* pr = PROJ + (size_t)r * NB_PAD;
        int pi; float *ko, *vo, *iko; bf16* kib = nullptr; bf16 *ksq = nullptr, *vsq = nullptr;
        if (r < SROW0) { int b, t; row_bt(r, b, t); pi = t; ksq = Ks + ((size_t)(b * SP + t + SPAD)) * 512; vsq = Vs + ((size_t)(b * SP + t + SPAD)) * 512; ko = P.out + O_KP + ((size_t)(b * TP + t)) * 512; vo = P.out + O_VP + ((size_t)(b * TP + t)) * 512; iko = P.out + O_IKP + ((size_t)(b * TP + t)) * 64; kib = KIb + ((size_t)(b * KIROWS + t)) * 64; }
        else { const int sb = r - SROW0; pi = POS_SAMPLE_IDX; ko = P.out + O_KS + (size_t)sb * 512; vo = P.out + O_VS + (size_t)sb * 512; iko = P.out + O_IKS + (size_t)sb * 64; }
        const f32x2* c128 = t128 + (size_t)pi * 64; const f32x2* c64 = t64 + (size_t)pi * 32;
        const int hd = lane >> 2, sub = lane & 3, hk = hd & 3;
        const v4u q1a = *(const v4u*)(pr + hd * 128 + 16 * sub), q1b = *(const v4u*)(pr + hd * 128 + 16 * sub + 8), q2a = *(const v4u*)(pr + hd * 128 + 64 + 16 * sub), q2b = *(const v4u*)(pr + hd * 128 + 64 + 16 * sub + 8);
        const v4u k1a = *(const v4u*)(pr + 2048 + hk * 128 + 16 * sub), k1b = *(const v4u*)(pr + 2048 + hk * 128 + 16 * sub + 8), k2a = *(const v4u*)(pr + 2048 + hk * 128 + 64 + 16 * sub), k2b = *(const v4u*)(pr + 2048 + hk * 128 + 64 + 16 * sub + 8);
        const v4u vv = *(const v4u*)(pr + 2560 + 8 * lane);
        const v4u i1 = *(const v4u*)(pr + 3072 + hd * 64 + 8 * sub), i2 = *(const v4u*)(pr + 3072 + hd * 64 + 32 + 8 * sub);
        const v4u j1 = *(const v4u*)(pr + 4096 + 8 * sub), j2 = *(const v4u*)(pr + 4096 + 32 + 8 * sub);
        const v4u wq = *(const v4u*)(pr + 4160 + 8 * (lane & 1));
        f32x4 csq[8], csi[4];
#pragma unroll
        for (int i = 0; i < 8; ++i) csq[i] = *(const f32x4*)(c128 + 16 * sub + 2 * i);
#pragma unroll
        for (int i = 0; i < 4; ++i) csi[i] = *(const f32x4*)(c64 + 8 * sub + 2 * i);
        {
            float x1[16], x2[16], o1[16], o2[16];
            { float t8[8]; unpack8(q1a, t8);
#pragma unroll
              for (int i = 0; i < 8; ++i) x1[i] = t8[i]; unpack8(q1b, t8);
#pragma unroll
              for (int i = 0; i < 8; ++i) x1[8 + i] = t8[i]; unpack8(q2a, t8);
#pragma unroll
              for (int i = 0; i < 8; ++i) x2[i] = t8[i]; unpack8(q2b, t8);
#pragma unroll
              for (int i = 0; i < 8; ++i) x2[8 + i] = t8[i]; }
#pragma unroll
            for (int i = 0; i < 16; i += 2) { const f32x4 cs = csq[i >> 1];
                o1[i] = (x1[i] * cs.x - x2[i] * cs.y) * QSCALE; o2[i] = (x2[i] * cs.x + x1[i] * cs.y) * QSCALE;
                o1[i + 1] = (x1[i + 1] * cs.z - x2[i + 1] * cs.w) * QSCALE; o2[i + 1] = (x2[i + 1] * cs.z + x1[i + 1] * cs.w) * QSCALE; }
            bf16* qo = Qr + (size_t)r * DM + hd * 128 + 16 * sub;
            { float t8[8];
#pragma unroll
              for (int i = 0; i < 8; ++i) t8[i] = o1[i]; *(v4u*)qo = pack8(t8);
#pragma unroll
              for (int i = 0; i < 8; ++i) t8[i] = o1[8 + i]; *(v4u*)(qo + 8) = pack8(t8);
#pragma unroll
              for (int i = 0; i < 8; ++i) t8[i] = o2[i]; *(v4u*)(qo + 64) = pack8(t8);
#pragma unroll
              for (int i = 0; i < 8; ++i) t8[i] = o2[8 + i]; *(v4u*)(qo + 72) = pack8(t8); }
        }
        if (lane < 16) {
#pragma unroll
            for (int hf = 0; hf < 2; ++hf) { float x1[8], x2[8], o1[8], o2[8]; unpack8(hf ? k1b : k1a, x1); unpack8(hf ? k2b : k2a, x2);
#pragma unroll
                for (int i = 0; i < 8; i += 2) { const f32x4 cs = csq[4 * hf + (i >> 1)];
                    o1[i] = x1[i] * cs.x - x2[i] * cs.y; o2[i] = x2[i] * cs.x + x1[i] * cs.y; o1[i + 1] = x1[i + 1] * cs.z - x2[i + 1] * cs.w; o2[i + 1] = x2[i + 1] * cs.z + x1[i + 1] * cs.w; }
                float* kq = ko + hk * 128 + 16 * sub + 8 * hf;
                *(f32x4*)kq = (f32x4){o1[0], o1[1], o1[2], o1[3]}; *(f32x4*)(kq + 4) = (f32x4){o1[4], o1[5], o1[6], o1[7]};
                *(f32x4*)(kq + 64) = (f32x4){o2[0], o2[1], o2[2], o2[3]}; *(f32x4*)(kq + 68) = (f32x4){o2[4], o2[5], o2[6], o2[7]};
                if (ksq) { *(v4u*)(ksq + hk * 128 + 16 * sub + 8 * hf) = pack8(o1); *(v4u*)(ksq + hk * 128 + 64 + 16 * sub + 8 * hf) = pack8(o2); } }
        }
        {
            float vf[8]; unpack8(vv, vf);
            *(f32x4*)(vo + 8 * lane) = (f32x4){vf[0], vf[1], vf[2], vf[3]}; *(f32x4*)(vo + 8 * lane + 4) = (f32x4){vf[4], vf[5], vf[6], vf[7]};
            if (vsq) *(v4u*)(vsq + 8 * lane) = vv;
        }
        {
            float x1[8], x2[8], o1[8], o2[8]; unpack8(i1, x1); unpack8(i2, x2);
#pragma unroll
            for (int i = 0; i < 8; i += 2) { const f32x4 cs = csi[i >> 1];
                o1[i] = x1[i] * cs.x - x2[i] * cs.y; o2[i] = x2[i] * cs.x + x1[i] * cs.y; o1[i + 1] = x1[i + 1] * cs.z - x2[i + 1] * cs.w; o2[i + 1] = x2[i + 1] * cs.z + x1[i + 1] * cs.w; }
            *(v4u*)(QI + (size_t)r * 1024 + hd * 64 + 8 * sub) = pack8(o1); *(v4u*)(QI + (size_t)r * 1024 + hd * 64 + 32 + 8 * sub) = pack8(o2);
        }
        if (lane < 4) {
            float x1[8], x2[8], o1[8], o2[8]; unpack8(j1, x1); unpack8(j2, x2);
#pragma unroll
            for (int i = 0; i < 8; i += 2) { const f32x4 cs = csi[i >> 1];
                o1[i] = x1[i] * cs.x - x2[i] * cs.y; o2[i] = x2[i] * cs.x + x1[i] * cs.y; o1[i + 1] = x1[i + 1] * cs.z - x2[i + 1] * cs.w; o2[i + 1] = x2[i + 1] * cs.z + x1[i + 1] * cs.w; }
            float* io = iko + 8 * sub;
            *(f32x4*)io = (f32x4){o1[0], o1[1], o1[2], o1[3]}; *(f32x4*)(io + 4) = (f32x4){o1[4], o1[5], o1[6], o1[7]};
            *(f32x4*)(io + 32) = (f32x4){o2[0], o2[1], o2[2], o2[3]}; *(f32x4*)(io + 36) = (f32x4){o2[4], o2[5], o2[6], o2[7]};
            if (kib) { *(v4u*)(kib + 8 * sub) = pack8(o1); *(v4u*)(kib + 32 + 8 * sub) = pack8(o2); }
        } else if (lane < 6) {
            float wv[8]; unpack8(wq, wv); float* wo = WI + (size_t)r * 16 + 8 * (lane - 4);
            *(f32x4*)wo = (f32x4){wv[0], wv[1], wv[2], wv[3]}; *(f32x4*)(wo + 4) = (f32x4){wv[4], wv[5], wv[6], wv[7]};
        }
    }
}

__device__ __forceinline__ void indexer_prompt(const Ptrs& P, LAS unsigned char* lds, int tid, int wave, int lane) {
    unsigned char* ws = P.ws;
    const bf16* QI = (const bf16*)(ws + WS_QI); const bf16* KIb = (const bf16*)(ws + WS_KIB); const float* WI = (const float*)(ws + WS_WI); float* SC = (float*)(ws + WS_SC);
    const int n = lane & 31, h8 = lane >> 5;
    const int qsel = (n >> 2) & 1, head = (n & 3) + 4 * (n >> 3);
    constexpr int NG = TP / 16;
    constexpr int KROW = 144, TBUF = 128 * KROW;
    LAS float* hscr = (LAS float*)(lds + 40960 + wave * 8448);
    int tit = blockIdx.x * 8 + wave;
    for (int it = blockIdx.x; it < 2 * NG; it += gridDim.x) {
        int b, qg;
        if (it < 256) { b = it & 1; qg = 1 + (it >> 1); } else if (it < 512) { b = it & 1; qg = 256 - ((it - 256) >> 1); } else { b = it - 512; qg = 0; }
        const int t0 = 16 * qg + 2 * wave;
        const bf16* qa = QI + (size_t)prow(b, t0 + qsel) * 1024 + head * 64 + 8 * h8;
        bf16x8 a[4];
#pragma unroll
        for (int kk = 0; kk < 4; ++kk) a[kk] = *(const bf16x8*)(qa + 16 * kk);
        const int tq = t0 + h8;
        const float* wp = WI + (size_t)prow(b, tq) * 16;
        float w[16];
#pragma unroll
        for (int i = 0; i < 4; ++i) { const f32x4 x = *(const f32x4*)(wp + 4 * i); w[4 * i] = x.x; w[4 * i + 1] = x.y; w[4 * i + 2] = x.z; w[4 * i + 3] = x.w; }
        const int ntile = ((16 * qg + 15) >> 5) + 1, ntrip = (ntile + 3) >> 2;
        float* scrow = SC + ((size_t)(b * TP + tq)) * SCW;
        const bf16* kbase = KIb + (size_t)b * KIROWS * 64;
        const int p0 = tid, p1 = tid + 512;
        const int l0 = (p0 >> 3) * KROW + (p0 & 7) * 16, l1 = (p1 >> 3) * KROW + (p1 & 7) * 16;
        asm volatile("s_waitcnt lgkmcnt(0)\n\ts_barrier" ::: "memory");
        v4u g0 = *(const v4u*)(kbase + (size_t)p0 * 8), g1 = *(const v4u*)(kbase + (size_t)p1 * 8);
        *(LAS v4u*)(lds + l0) = g0; *(LAS v4u*)(lds + l1) = g1;
        for (int tr = 0; tr < ntrip; ++tr) {
            const int cur = tr & 1;
            float hv[32]; TrJob HJ; hosted_issue(P, tit, lane, hv, HJ);
            if (tr + 1 < ntrip) { const size_t ko = (size_t)(tr + 1) * 128 * 64;
                const int kmax = KIROWS * 64 - 8;
                const size_t o0 = ko + (size_t)p0 * 8, o1 = ko + (size_t)p1 * 8;
                g0 = *(const v4u*)(kbase + (o0 <= (size_t)kmax ? o0 : (size_t)kmax)); g1 = *(const v4u*)(kbase + (o1 <= (size_t)kmax ? o1 : (size_t)kmax)); }
            asm volatile("s_waitcnt lgkmcnt(0)\n\ts_barrier" ::: "memory");
            const LAS unsigned char* kb = lds + cur * TBUF + n * KROW + h8 * 16;
#pragma unroll
            for (int u = 0; u < 4; ++u) {
                f32x16 acc;
#pragma unroll
                for (int i = 0; i < 16; ++i) acc[i] = 0.f;
#pragma unroll
                for (int kk = 0; kk < 4; ++kk) acc = __builtin_amdgcn_mfma_f32_32x32x16_bf16(a[kk], *(const LAS bf16x8*)(kb + u * 32 * KROW + kk * 32), acc, 0, 0, 0);
                float sc = 0.f;
#pragma unroll
                for (int i = 0; i < 16; ++i) sc += w[i] * fmaxf(acc[i], 0.f);
                const int s = 32 * (4 * tr + u) + n;
                if (s <= tq) scrow[s] = sc;
            }
            if (tr + 1 < ntrip) { *(LAS v4u*)(lds + (cur ^ 1) * TBUF + l0) = g0; *(LAS v4u*)(lds + (cur ^ 1) * TBUF + l1) = g1; }
            if (HJ.valid) { tr_finish(hv, HJ, hscr, lane); tit += gridDim.x * 8; }
        }
    }
    asm volatile("s_waitcnt lgkmcnt(0)\n\ts_barrier" ::: "memory");
    for (; tit < NHOSTED; tit += gridDim.x * 8) { float hv[32]; TrJob HJ; hosted_issue(P, tit, lane, hv, HJ); if (HJ.valid) tr_finish(hv, HJ, hscr, lane); }
}

__device__ __forceinline__ void indexer_sample(const Ptrs& P, LAS unsigned char* lds, int tid) {
    unsigned char* ws = P.ws;
    const bf16* QI = (const bf16*)(ws + WS_QI); const float* WI = (const float*)(ws + WS_WI); float* SCS = (float*)(ws + WS_SCS);
    LAS float* lq = (LAS float*)lds;
    LAS float* lw = lq + 1024;
    constexpr int NCH = (NSKEY + 511) / 512;
    for (int item = gridDim.x - 1 - blockIdx.x; item < SBN * NCH; item += gridDim.x) {
        const int sb = item / NCH, ch = item % NCH, r = SROW0 + sb;
        __syncthreads();
        for (int e = tid; e < 1024; e += NTHREADS) lq[e] = bf2f(QI[(size_t)r * 1024 + e]);
        if (tid < 16) lw[tid] = WI[(size_t)r * 16 + tid];
        __syncthreads();
        const int s = ch * 512 + tid;
        if (s < NSKEY) {
            const float* kr = (s < PAST) ? P.cache_ik + ((size_t)P.page_table[sb * NPG + (s >> 7)] * 128 + (s & 127)) * 64 : P.out + O_IKS + (size_t)sb * 64;
            f32x4 kv[16];
#pragma unroll
            for (int i = 0; i < 16; ++i) kv[i] = *(const f32x4*)(kr + 4 * i);
            float sc = 0.f;
            for (int h = 0; h < 16; ++h) { float d = 0.f;
#pragma unroll
                for (int i = 0; i < 16; ++i) { const f32x4 q = *(const LAS f32x4*)(lq + h * 64 + 4 * i); d += q.x * kv[i].x + q.y * kv[i].y + q.z * kv[i].z + q.w * kv[i].w; }
                sc += lw[h] * fmaxf(d, 0.f); }
            SCS[(size_t)sb * SCSW + s] = sc;
        }
    }
    __syncthreads();
}

__device__ __forceinline__ unsigned ordkey(float f) { const unsigned u = __float_as_uint(f); return (u & 0x80000000u) ? ~u : (u | 0x80000000u); }
constexpr int TOPK = 256;
__device__ __forceinline__ void topk_wave_mask(const float* sc, int n, unsigned long long* mrow, int lane) {
    constexpr int NS = MTW, M0 = SPAD / 64;
    static_assert(M0 == dattn::JLO, "first real key tile");
    unsigned key[NS];
#pragma unroll
    for (int m = M0; m < NS; ++m) { const int sidx = lane + 64 * m - SPAD; const int ci = sidx < 0 ? 0 : (sidx < n ? sidx : n - 1); const float v = sc[ci]; key[m] = (sidx >= 0 && sidx < n) ? ordkey(v) : 0u; }
    if (n <= TOPK) {
#pragma unroll
        for (int m = M0; m < NS; ++m) { const unsigned long long w = __ballot(key[m] != 0u); if (lane == 0) mrow[m] = w; }
        return;
    }
    unsigned T = 0u;
    for (int bit = 31; bit >= 0; --bit) {
        const unsigned cand = T | (1u << bit); int c = 0, cv = 0;
#pragma unroll
        for (int m = M0; m < NS; ++m) { if ((m & 1) != 0) c += __popcll(__ballot(key[m] >= cand)); else cv += (key[m] >= cand) ? 1 : 0; }
        c = __builtin_amdgcn_readfirstlane(c + wave_sum_dpp_i(cv));
        if (c >= TOPK) { T = cand; if (c == TOPK) break; }
    }
    int cg = 0;
#pragma unroll
    for (int m = M0; m < NS; ++m) cg += __popcll(__ballot(key[m] > T));
    const int need = TOPK - cg;
    int base_e = 0;
    const unsigned long long lt = (1ull << lane) - 1ull;
#pragma unroll
    for (int m = M0; m < NS; ++m) {
        const bool pg = key[m] > T, pe = key[m] == T;
        const unsigned long long me = __ballot(pe);
        const int pre_e = __popcll(me & lt);
        const unsigned long long w = __ballot(pg || (pe && (base_e + pre_e) < need));
        if (lane == 0) mrow[m] = w;
        base_e += __popcll(me);
    }
}
__device__ __forceinline__ void topk_block(const float* sc, int n, int* outIdx, int* outCnt, LAS unsigned* ls, int tid, int wave, int lane) {
    constexpr int NS = (NSKEY + NTHREADS - 1) / NTHREADS;
    unsigned key[NS];
#pragma unroll
    for (int m = 0; m < NS; ++m) { const int e = tid + NTHREADS * m; const float v = sc[e < n ? e : n - 1]; key[m] = (e < n) ? ordkey(v) : 0u; }
    unsigned T = 0u;
    for (int bit = 31; bit >= 0; --bit) {
        const unsigned cand = T | (1u << bit); int c = 0;
#pragma unroll
        for (int m = 0; m < NS; ++m) c += (key[m] >= cand) ? 1 : 0;
        c = wave_sum_dpp_i(c);
        LAS unsigned* buf = ls + (bit & 1) * 8;
        if (lane == 0) buf[wave] = (unsigned)c;
        __syncthreads();
        int tot = 0;
#pragma unroll
        for (int w = 0; w < 8; ++w) tot += (int)buf[w];
        if (tot >= TOPK) T = cand;
    }
    __syncthreads();
    if (tid == 0) { unsigned z_ = 0u; asm volatile("" : "+v"(z_)); ls[16] = z_; ls[17] = z_; }
    __syncthreads();
#pragma unroll
    for (int m = 0; m < NS; ++m) { const int e = tid + NTHREADS * m; if (key[m] > T) { const unsigned pos = atomicAdd((unsigned*)(ls + 16), 1u); if (pos < (unsigned)TOPK) outIdx[pos] = e; } }
    __syncthreads();
    const unsigned cg = ls[16];
    const unsigned need = (unsigned)TOPK - cg;
#pragma unroll
    for (int m = 0; m < NS; ++m) { const int e = tid + NTHREADS * m; if (key[m] == T) { const unsigned pos = atomicAdd((unsigned*)(ls + 17), 1u); if (pos < need) outIdx[cg + pos] = e; } }
    if (tid == 0) *outCnt = TOPK;
    __syncthreads();
}
__device__ __forceinline__ void select_phase(const Ptrs& P, LAS unsigned char* lds, int gw, int NGW, int tid, int wave, int lane) {
    unsigned char* ws = P.ws;
    const float* SC = (const float*)(ws + WS_SC); const float* SCS = (const float*)(ws + WS_SCS); int* IDXL = (int*)(ws + WS_IDXL); int* CNT = (int*)(ws + WS_CNT);
    for (int sb = blockIdx.x; sb < SBN; sb += gridDim.x) topk_block(SCS + (size_t)sb * SCSW, NSKEY, IDXL + (size_t)(SROW0 + sb) * TOPK, CNT + SROW0 + sb, (LAS unsigned*)lds, tid, wave, lane);
    unsigned long long* MASK = (unsigned long long*)(ws + WS_MASK);
    for (int r = gw; r < SROW0; r += NGW) { int b, t; row_bt(r, b, t);
        if (r < XROW0) topk_wave_mask(SC + ((size_t)(b * TP + t)) * SCW, t + 1, MASK + ((size_t)(b * SP + t + SPAD)) * MTW, lane);
        else { if (lane <= t) IDXL[(size_t)r * TOPK + lane] = lane; if (lane == 0) CNT[r] = t + 1; } }
}

__device__ __forceinline__ void attn_phase(const Ptrs& P, bf16* O, LAS unsigned char* lds, int tid, int wave, int lane) {
    unsigned char* ws = P.ws;
    const bf16* Qr = (const bf16*)(ws + WS_QR); const int* IDXL = (const int*)(ws + WS_IDXL); const int* CNT = (const int*)(ws + WS_CNT);
    LAS float* lq = (LAS float*)(lds + wave * 2048);
    LAS float* part = (LAS float*)(lds + 16384);
    LAS float* ml = (LAS float*)(lds + 32768);
    for (int item = blockIdx.x; item < (NROWS - XROW0) * 4; item += gridDim.x) {
        const int r = XROW0 + (item >> 2), n = item & 3;
        const int cnt = CNT[r];
        { float qf[8]; unpack8(*(const v4u*)(Qr + (size_t)r * DM + n * 512 + 8 * lane), qf);
          *(LAS f32x4*)(lq + 8 * lane) = (f32x4){qf[0], qf[1], qf[2], qf[3]}; *(LAS f32x4*)(lq + 8 * lane + 4) = (f32x4){qf[4], qf[5], qf[6], qf[7]}; }
        const int kl = lane & 31, hh = lane >> 5, e = wave * 32 + kl;
        const bool valid = e < cnt;
        const int s = valid ? IDXL[(size_t)r * TOPK + e] : 0;
        const float *kq, *vq;
        if (r < SROW0) { const int b = (r - XROW0) >> 4; kq = P.out + O_KP + ((size_t)(b * TP + s)) * 512; vq = P.out + O_VP + ((size_t)(b * TP + s)) * 512; }
        else { const int sb = r - SROW0;
            if (s < PAST) { const size_t off = ((size_t)P.page_table[sb * NPG + (s >> 7)] * 128 + (s & 127)) * 512; kq = P.cache_k + off; vq = P.cache_v + off; }
            else { kq = P.out + O_KS + (size_t)sb * 512; vq = P.out + O_VS + (size_t)sb * 512; } }
        kq += n * 128 + 64 * hh; vq += n * 128;
        f32x4 kv[16];
#pragma unroll
        for (int i = 0; i < 16; ++i) kv[i] = *(const f32x4*)(kq + 4 * i);
        WAVE_SYNC();
        float acc[4] = {0.f, 0.f, 0.f, 0.f};
#pragma unroll
        for (int i = 0; i < 16; ++i)
#pragma unroll
            for (int g = 0; g < 4; ++g) { const f32x4 qv = *(const LAS f32x4*)(lq + g * 128 + 64 * hh + 4 * i); acc[g] += qv.x * kv[i].x + qv.y * kv[i].y + qv.z * kv[i].z + qv.w * kv[i].w; }
        float pg[4], mw[4], lw[4];
#pragma unroll
        for (int g = 0; g < 4; ++g) { float a = acc[g] + __shfl_xor(acc[g], 32); a = valid ? a : -INFINITY;
            const float m = wave_max(a); const float pv = valid ? __expf(a - m) : 0.f;
            pg[g] = pv; mw[g] = m; lw[g] = wave_sum(hh == 0 ? pv : 0.f); }
        const unsigned long long va = (unsigned long long)vq; const int va_lo = (int)(unsigned)va, va_hi = (int)(unsigned)(va >> 32);
        f32x2 vv[32];
#pragma unroll
        for (int j = 0; j < 32; ++j) { const unsigned long long a = ((unsigned long long)(unsigned)__builtin_amdgcn_readlane(va_hi, j) << 32) | (unsigned)__builtin_amdgcn_readlane(va_lo, j);
            vv[j] = *(const f32x2*)((const float*)a + 2 * lane); }
        float o[4][2];
#pragma unroll
        for (int g = 0; g < 4; ++g) { o[g][0] = 0.f; o[g][1] = 0.f; }
#pragma unroll
        for (int j = 0; j < 32; ++j)
#pragma unroll
            for (int g = 0; g < 4; ++g) { const float pj = __int_as_float(__builtin_amdgcn_readlane(__float_as_int(pg[g]), j)); o[g][0] += pj * vv[j].x; o[g][1] += pj * vv[j].y; }
#pragma unroll
        for (int g = 0; g < 4; ++g) { *(LAS f32x2*)(part + (wave * 4 + g) * 128 + 2 * lane) = (f32x2){o[g][0], o[g][1]};
            if (lane == 0) { ml[(wave * 4 + g) * 2] = mw[g]; ml[(wave * 4 + g) * 2 + 1] = lw[g]; } }
        __syncthreads();
        { const int g = tid >> 7, d = tid & 127; float M = -INFINITY;
#pragma unroll
          for (int w = 0; w < 8; ++w) M = fmaxf(M, ml[(w * 4 + g) * 2]);
          float L = 0.f, a = 0.f;
#pragma unroll
          for (int w = 0; w < 8; ++w) { const float mv = ml[(w * 4 + g) * 2]; const float sc = (mv == -INFINITY) ? 0.f : __expf(mv - M); L += ml[(w * 4 + g) * 2 + 1] * sc; a += part[(w * 4 + g) * 128 + d] * sc; }
          O[(size_t)r * DM + (4 * n + g) * 128 + d] = f2bf(a / L); }
        __syncthreads();
    }
}

__device__ __forceinline__ void convC_finish(float (&acc)[8], int it) {
    float ss = 0.f;
#pragma unroll
    for (int i = 0; i < 8; ++i) { acc[i] = silu_f(acc[i]); ss += acc[i] * acc[i]; }
    if (it < 8) { ss = row16_sum(ss); float rn = 1.f / sqrtf(ss + RMS_EPS); if (it < 4) rn *= QSCALE;
#pragma unroll
        for (int i = 0; i < 8; ++i) acc[i] *= rn; }
}
__device__ __forceinline__ void convC_phase(const bf16* PROJC, const Ptrs& P, int gw, int NGW, int lane) {
    unsigned char* ws = P.ws;
    bf16* QKVC = (bf16*)(ws + WS_QKVC); float* QKF = (float*)(ws + WS_QKF); float* G = (float*)(ws + WS_G); float* BETA = (float*)(ws + WS_BETA);
    const float* cw = P.conv_w_c;
    constexpr int RUN = 8, NRUN = SEQ / RUN;
    for (int item = gw; item < 16 * NBP * NRUN; item += NGW) {
        const int it = item & 15, ru = item >> 4, b = ru / NRUN, t0 = NMETA + (ru % NRUN) * RUN, ch0 = it * 512 + 8 * lane;
        float w[4][8];
#pragma unroll
        for (int j = 0; j < 4; ++j) { const f32x4 w0 = *(const f32x4*)(cw + (size_t)j * CDIM + ch0), w1 = *(const f32x4*)(cw + (size_t)j * CDIM + ch0 + 4);
            w[j][0] = w0.x; w[j][1] = w0.y; w[j][2] = w0.z; w[j][3] = w0.w; w[j][4] = w1.x; w[j][5] = w1.y; w[j][6] = w1.z; w[j][7] = w1.w; }
        const int r0 = prow(b, t0);
        v4u xr[RUN + 3];
#pragma unroll
        for (int j = 0; j < 3; ++j) { const int tt = t0 - 3 + j; xr[j] = tt >= 0 ? *(const v4u*)(PROJC + (size_t)prow(b, tt) * NC_PAD + ch0) : (v4u){0u, 0u, 0u, 0u}; }
#pragma unroll
        for (int k = 0; k < RUN; ++k) xr[3 + k] = *(const v4u*)(PROJC + (size_t)(r0 + k) * NC_PAD + ch0);
        float x[RUN + 3][8];
#pragma unroll
        for (int j = 0; j < RUN + 3; ++j) unpack8(xr[j], x[j]);
#pragma unroll
        for (int k = 0; k < RUN; ++k) {
            float acc[8];
#pragma unroll
            for (int i = 0; i < 8; ++i) acc[i] = w[0][i] * x[k][i] + w[1][i] * x[k + 1][i] + w[2][i] * x[k + 2][i] + w[3][i] * x[k + 3][i];
            convC_finish(acc, it);
            *(v4u*)(QKVC + (size_t)(r0 + k) * CDIM + ch0) = pack8(acc);
            const int t = t0 + k;
            if (t >= TP - 3) { float* o = P.out + O_CCP + ((size_t)(b * 3 + (t - (TP - 3)))) * CDIM + ch0;
                *(f32x4*)o = (f32x4){x[k + 3][0], x[k + 3][1], x[k + 3][2], x[k + 3][3]}; *(f32x4*)(o + 4) = (f32x4){x[k + 3][4], x[k + 3][5], x[k + 3][6], x[k + 3][7]}; }
        }
    }
    for (int item = gw; item < 16 * NBP * NMETA; item += NGW) {
        const int it = item & 15, mi = item >> 4, t = mi % NMETA, r = XROW0 + mi, ch0 = it * 512 + 8 * lane;
        float x[4][8];
#pragma unroll
        for (int j = 0; j < 4; ++j) { const int tt = t - 3 + j; if (tt >= 0) unpack8(*(const v4u*)(PROJC + (size_t)(r - 3 + j) * NC_PAD + ch0), x[j]); else {
#pragma unroll
                for (int i = 0; i < 8; ++i) x[j][i] = 0.f; } }
        float acc[8];
#pragma unroll
        for (int i = 0; i < 8; ++i) acc[i] = 0.f;
#pragma unroll
        for (int j = 0; j < 4; ++j) { const f32x4 w0 = *(const f32x4*)(cw + (size_t)j * CDIM + ch0), w1 = *(const f32x4*)(cw + (size_t)j * CDIM + ch0 + 4);
            acc[0] += w0.x * x[j][0]; acc[1] += w0.y * x[j][1]; acc[2] += w0.z * x[j][2]; acc[3] += w0.w * x[j][3];
            acc[4] += w1.x * x[j][4]; acc[5] += w1.y * x[j][5]; acc[6] += w1.z * x[j][6]; acc[7] += w1.w * x[j][7]; }
        convC_finish(acc, it);
        *(v4u*)(QKVC + (size_t)r * CDIM + ch0) = pack8(acc);
    }
    for (int item = gw; item < 16 * SBN; item += NGW) {
        const int it = item & 15, sb = item >> 4, r = SROW0 + sb, ch0 = it * 512 + 8 * lane;
        float x[4][8];
#pragma unroll
        for (int j = 0; j < 3; ++j) { const float* hp = P.state_conv_c + ((size_t)(sb * 3 + j)) * CDIM + ch0; const f32x4 a = *(const f32x4*)hp, c = *(const f32x4*)(hp + 4);
            x[j][0] = a.x; x[j][1] = a.y; x[j][2] = a.z; x[j][3] = a.w; x[j][4] = c.x; x[j][5] = c.y; x[j][6] = c.z; x[j][7] = c.w; }
        unpack8(*(const v4u*)(PROJC + (size_t)r * NC_PAD + ch0), x[3]);
        float acc[8];
#pragma unroll
        for (int i = 0; i < 8; ++i) acc[i] = 0.f;
#pragma unroll
        for (int j = 0; j < 4; ++j) { const f32x4 w0 = *(const f32x4*)(cw + (size_t)j * CDIM + ch0), w1 = *(const f32x4*)(cw + (size_t)j * CDIM + ch0 + 4);
            acc[0] += w0.x * x[j][0]; acc[1] += w0.y * x[j][1]; acc[2] += w0.z * x[j][2]; acc[3] += w0.w * x[j][3];
            acc[4] += w1.x * x[j][4]; acc[5] += w1.y * x[j][5]; acc[6] += w1.z * x[j][6]; acc[7] += w1.w * x[j][7]; }
        convC_finish(acc, it);
        if (it < 8) { float* qk = QKF + (size_t)r * 4096 + ch0; *(f32x4*)qk = (f32x4){acc[0], acc[1], acc[2], acc[3]}; *(f32x4*)(qk + 4) = (f32x4){acc[4], acc[5], acc[6], acc[7]}; }
        *(v4u*)(QKVC + (size_t)r * CDIM + ch0) = pack8(acc);
        float* o = P.out + O_CCS + ((size_t)(sb * 3)) * CDIM + ch0;
#pragma unroll
        for (int j = 0; j < 3; ++j) { *(f32x4*)(o + (size_t)j * CDIM) = (f32x4){x[j + 1][0], x[j + 1][1], x[j + 1][2], x[j + 1][3]}; *(f32x4*)(o + (size_t)j * CDIM + 4) = (f32x4){x[j + 1][4], x[j + 1][5], x[j + 1][6], x[j + 1][7]}; }
    }
    for (int e = gw * 64 + lane; e < NROWS * 32; e += NGW * 64) {
        const int r = e >> 5, h = e & 31;
        const float braw = bf2f(PROJC[(size_t)r * NC_PAD + 12288 + h]), araw = bf2f(PROJC[(size_t)r * NC_PAD + 12320 + h]);
        const float xx = araw + P.dt_bias[h]; const float sp = xx > 20.f ? xx : __logf(1.f + __expf(xx));
        G[e] = -__expf(P.a_log[h]) * sp; BETA[e] = 1.f / (1.f + __expf(-braw));
    }
}

struct Tok { f32x4 k0, k1, q0, q1; unsigned v; float g, b; };
__device__ __forceinline__ void tok_load(Tok& T, const float* QKF, const bf16* QKVC, const float* G, const float* BETA, int row, int h, int rg, int col0) {
    const float* base = QKF + (size_t)row * 4096 + (h >> 1) * 128 + 8 * rg;
    T.q0 = *(const f32x4*)base; T.q1 = *(const f32x4*)(base + 4); T.k0 = *(const f32x4*)(base + 2048); T.k1 = *(const f32x4*)(base + 2052);
    T.v = *(const unsigned*)(QKVC + (size_t)row * CDIM + 4096 + h * 128 + col0);
    T.g = G[(size_t)row * 32 + h]; T.b = BETA[(size_t)row * 32 + h];
}
__device__ __forceinline__ f32x2 tok_step(f32x2 (&S)[8], const Tok& T) {
    const float kk[8] = {T.k0.x, T.k0.y, T.k0.z, T.k0.w, T.k1.x, T.k1.y, T.k1.z, T.k1.w};
    const float qq[8] = {T.q0.x, T.q0.y, T.q0.z, T.q0.w, T.q1.x, T.q1.y, T.q1.z, T.q1.w};
    const float a = __expf(T.g);
    f32x2 d0 = S[0] * kk[0], d1 = S[1] * kk[1];
#pragma unroll
    for (int i = 2; i < 8; i += 2) { d0 += S[i] * kk[i]; d1 += S[i + 1] * kk[i + 1]; }
    f32x2 d = d0 + d1;
    d.x = row16_sum(d.x); d.y = row16_sum(d.y);
    const f32x2 tv = {bflo(T.v), bfhi(T.v)};
    const f32x2 dl = (tv - d * a) * T.b;
    f32x2 o0 = {0.f, 0.f}, o1 = {0.f, 0.f};
#pragma unroll
    for (int i = 0; i < 8; i += 2) { S[i] = S[i] * a + dl * kk[i]; o0 += S[i] * qq[i]; S[i + 1] = S[i + 1] * a + dl * kk[i + 1]; o1 += S[i + 1] * qq[i + 1]; }
    f32x2 o = o0 + o1;
    o.x = row16_sum(o.x); o.y = row16_sum(o.y);
    return o;
}
__device__ __forceinline__ void delta_phase(const Ptrs& P, int idx, int stride, int lane) {
    unsigned char* ws = P.ws;
    const bf16* QKVC = (const bf16*)(ws + WS_QKVC); const float* QKF = (const float*)(ws + WS_QKF); const float* G = (const float*)(ws + WS_G); const float* BETA = (const float*)(ws + WS_BETA); bf16* OF = (bf16*)(ws + WS_SC);
    const int cg = lane >> 4, rg = lane & 15;
    {
        for (int item = idx; item < SBN * 32 * 16; item += stride) {
            const int sb = item >> 9, h = (item >> 4) & 31, col0 = 8 * (item & 15) + 2 * cg;
            const size_t so = ((size_t)((sb * 32 + h) * 128 + 8 * rg)) * 128 + col0;
            f32x2 S[8];
#pragma unroll
            for (int i = 0; i < 8; ++i) S[i] = *(const f32x2*)(P.state_delta + so + (size_t)i * 128);
            Tok T; tok_load(T, QKF, QKVC, G, BETA, SROW0 + sb, h, rg, col0);
            const f32x2 o = tok_step(S, T);
            if (rg == 0) *(unsigned*)(OF + (size_t)(SROW0 + sb) * DVW + h * 128 + col0) = pk2(o.x, o.y);
            float* op = P.out + O_DS + so;
#pragma unroll
            for (int i = 0; i < 8; ++i) *(f32x2*)(op + (size_t)i * 128) = S[i];
        }
    }
}
__device__ __forceinline__ void normC_piece(const v4u oq, const v4u zz, const float (&nw)[8], bf16* yo) {
    float o[8]; unpack8(oq, o);
    float ss = 0.f;
#pragma unroll
    for (int i = 0; i < 8; ++i) ss += o[i] * o[i];
    ss = row16_sum(ss);
    const float rs = 1.f / sqrtf(ss * (1.f / 128.f) + RMS_EPS);
    float z[8]; unpack8(zz, z);
#pragma unroll
    for (int i = 0; i < 8; ++i) o[i] = o[i] * rs * nw[i] * silu_f(z[i]);
    *(v4u*)yo = pack8(o);
}
__device__ __forceinline__ void normC_phase(const bf16* PROJC, bf16* Y, const Ptrs& P, int gw, int NGW, int lane) {
    const bf16* OF = (const bf16*)(P.ws + WS_SC);
    const int d0 = 8 * (lane & 15), hl = lane >> 4;
    float nw[8];
    { const f32x4 a = *(const f32x4*)(P.norm_w + d0), b = *(const f32x4*)(P.norm_w + d0 + 4); nw[0] = a.x; nw[1] = a.y; nw[2] = a.z; nw[3] = a.w; nw[4] = b.x; nw[5] = b.y; nw[6] = b.z; nw[7] = b.w; }
    for (int it = gw; it < (NROWS - XROW0) * 8; it += NGW) { const int r = XROW0 + (it >> 3), hd = (it & 7) * 4 + hl;
        const v4u oq = *(const v4u*)(OF + (size_t)r * DVW + hd * 128 + d0), zz = *(const v4u*)(PROJC + (size_t)r * NC_PAD + 8192 + hd * 128 + d0);
        normC_piece(oq, zz, nw, Y + (size_t)r * DVW + hd * 128 + d0); }
    for (int r = gw; r < XROW0; r += 2 * NGW) {
        const int r2 = (r + NGW < XROW0) ? r + NGW : r; const bool two = r + NGW < XROW0;
        v4u oa[8], za[8], ob[8], zb[8];
#pragma unroll
        for (int it = 0; it < 8; ++it) { const int hd = it * 4 + hl;
            oa[it] = *(const v4u*)(OF + (size_t)r * DVW + hd * 128 + d0); za[it] = *(const v4u*)(PROJC + (size_t)r * NC_PAD + 8192 + hd * 128 + d0);
            ob[it] = *(const v4u*)(OF + (size_t)r2 * DVW + hd * 128 + d0); zb[it] = *(const v4u*)(PROJC + (size_t)r2 * NC_PAD + 8192 + hd * 128 + d0); }
#pragma unroll
        for (int it = 0; it < 8; ++it) { const int hd = it * 4 + hl;
            normC_piece(oa[it], za[it], nw, Y + (size_t)r * DVW + hd * 128 + d0);
            if (two) normC_piece(ob[it], zb[it], nw, Y + (size_t)r2 * DVW + hd * 128 + d0); }
    }
}


constexpr int AH_I0 = (DM / 16) * (NA_IN / 32), AH_I1 = (DM / 16) * (DM / 32), AH_I2 = (DM / 16) * (FF / 32), AH_I3 = (FF / 16) * (DM / 32), AH_I4 = (DM / 16) * (DM / 32), AH_I5 = (FF / 16) * (DM / 32), AH_N = AH_I0 + AH_I1 + AH_I2 + AH_I3 + AH_I4 + AH_I5;
struct AttnHost {
    const float* w_in_a; const float* w_out_a; const float* w1; const float* w2; const float* w_out_b; unsigned char* ws;
    LAS float* scr; int item, stride, lane; float hv[8]; bool live;
    __device__ __forceinline__ void decode(int it, const float*& W, bf16*& WT, int& K, int& N, int& kb, int& nb) const {
        int r = it;
        if (r < AH_I0) { W = w_in_a + (size_t)DM * NA_IN; WT = (bf16*)(ws + WS_WA_IN + WSZ_A_IN); K = DM; N = NA_IN; }
        else if ((r -= AH_I0) < AH_I1) { W = w_out_a + (size_t)DM * DM; WT = (bf16*)(ws + WS_WA_OUT + WSZ_A_OUT); K = DM; N = DM; }
        else if ((r -= AH_I1) < AH_I2) { W = w1 + 3 * (size_t)DM * FF; WT = (bf16*)(ws + WS_W1 + 3 * WSZ_W1); K = DM; N = FF; }
        else if ((r -= AH_I2) < AH_I3) { W = w2 + 3 * (size_t)DM * FF; WT = (bf16*)(ws + WS_W2 + 3 * WSZ_W2); K = FF; N = DM; }
        else if ((r -= AH_I3) < AH_I4) { W = w_out_b; WT = (bf16*)(ws + WS_WB_OUT); K = DM; N = DM; }
        else { r -= AH_I4; W = w2 + (size_t)DM * FF; WT = (bf16*)(ws + WS_W2 + WSZ_W2); K = FF; N = DM; }
        const int nblk = N >> 5; kb = r / nblk; nb = r - kb * nblk;
    }
    __device__ __forceinline__ void issue() {
        live = item < AH_N; if (!live) return;
        const float* W; bf16* WT; int K, N, kb, nb; decode(item, W, WT, K, N, kb, nb);
        const float* src = W + (size_t)(16 * kb + (lane >> 5)) * N + 32 * nb + (lane & 31);
#pragma unroll
        for (int i = 0; i < 8; ++i) hv[i] = src[(size_t)(2 * i) * N];
    }
    __device__ __forceinline__ void finish() {
        if (!live) return;
        asm volatile("s_waitcnt vmcnt(0)" ::: "memory");
        const float* W; bf16* WT; int K, N, kb, nb; decode(item, W, WT, K, N, kb, nb);
#pragma unroll
        for (int i = 0; i < 8; ++i) scr[(2 * i + (lane >> 5)) * 33 + (lane & 31)] = hv[i];
        LDS_WAIT(); __builtin_amdgcn_wave_barrier();
        const int n = lane >> 1, kh = lane & 1; const LAS float* sp = scr + (8 * kh) * 33 + n;
        v4u o; o.x = pk2(sp[0 * 33], sp[1 * 33]); o.y = pk2(sp[2 * 33], sp[3 * 33]); o.z = pk2(sp[4 * 33], sp[5 * 33]); o.w = pk2(sp[6 * 33], sp[7 * 33]);
        *(v4u*)(WT + (size_t)(32 * nb + n) * K + 16 * kb + 8 * kh) = o;
        LDS_WAIT(); __builtin_amdgcn_wave_barrier();
        item += stride;
    }
};
template <int VAR = 0> __device__ __forceinline__ void dense_attn_phase(const Ptrs& P, bf16* O, char* lds, int wv) {
    unsigned char* ws = P.ws;
    const bf16* Qr = (const bf16*)(ws + WS_QR); const bf16* Ks = (const bf16*)(ws + WS_KS); const bf16* Vs = (const bf16*)(ws + WS_VS);
    const unsigned long long* MASK = (const unsigned long long*)(ws + WS_MASK);
    typedef dattn::BlockRef<bf16, bf16> BR;
    AttnHost H; { int tl = threadIdx.x; asm volatile("" : "+v"(tl)); const int wvh = __builtin_amdgcn_readfirstlane(tl >> 6);
        H.w_in_a = P.w_in_a; H.w_out_a = P.w_out_a; H.w1 = P.w1; H.w2 = P.w2; H.w_out_b = P.w_out_b; H.ws = ws; H.lane = tl & 63; H.live = false;
        H.scr = (LAS float*)((LAS unsigned char*)(unsigned)(size_t)lds + 69632 + wvh * 2304);
        H.item = (VAR == 0) ? (int)blockIdx.x * 8 + wvh : AH_N; H.stride = (int)gridDim.x * 8; }
    for (int it0 = blockIdx.x; it0 < 256; it0 += gridDim.x) {
        const int grp = it0 & 7, idx = it0 >> 3;
        const int b = grp >> 2, kvh = grp & 3, h = kvh * 4 + (idx >> 3), x = idx & 7;
        BR A, B;
        const int qa = 1 + x, qb = 16 - x;
        A.Q = Qr + ((size_t)(b * SEQ + 256 * (qa - 1))) * DM + h * 128; A.O = O + ((size_t)(b * SEQ + 256 * (qa - 1))) * DM + h * 128;
        B.Q = Qr + ((size_t)(b * SEQ + 256 * (qb - 1))) * DM + h * 128; B.O = O + ((size_t)(b * SEQ + 256 * (qb - 1))) * DM + h * 128;
        A.K = B.K = Ks + (size_t)b * SP * 512 + kvh * 128; A.V = B.V = Vs + (size_t)b * SP * 512 + kvh * 128;
        A.P0 = 256 * qa; B.P0 = 256 * qb;
        A.M = MASK + ((size_t)(b * SP + A.P0)) * MTW; B.M = MASK + ((size_t)(b * SP + B.P0)) * MTW;
        dattn::Seam<bf16> S;
        dattn::causal_swa_prime<bf16, bf16>(A, SP, lds, S, wv);
        dattn::causal_swa_block<bf16, bf16, VAR>(A, B, SP, SP, lds, S, wv, H);
        dattn::causal_swa_block<bf16, bf16, VAR>(B, B, SP, SP, lds, S, wv, H);
    }
    while (H.item < AH_N) { H.issue(); H.finish(); }
}

constexpr int NCH = 65, CPAD = 48;
constexpr int NUQ = NBP * 16 * NCH, NUH = NBP * 32 * NCH;
__device__ __forceinline__ int crow32(int r, int hi) { return (r & 3) + 8 * (r >> 2) + 4 * hi; }
__device__ __forceinline__ int chunk_row(int b, int c, int i) { const int t = 64 * c + i - CPAD; return t >= 0 ? prow(b, t) : -1; }
__device__ __forceinline__ float incl_scan64(float v, int lane) {
#pragma unroll
    for (int o = 1; o < 64; o <<= 1) { const float u = __shfl_up(v, o); if (lane >= o) v += u; }
    return v;
}
#define MFMA32(a, b, c) __builtin_amdgcn_mfma_f32_32x32x16_bf16((a), (b), (c), 0, 0, 0)
__device__ __forceinline__ bf16x8 sel8(bool ok, bf16x8 v) { const bf16x8 z = {0, 0, 0, 0, 0, 0, 0, 0}; return ok ? v : z; }
__device__ __forceinline__ int sw23(int x) { return (x & ~12) | ((x & 4) << 1) | ((x & 8) >> 1); }
__device__ __forceinline__ int fidx64(int row, int xs) { return ((((row >> 5) * 2 + (xs >> 5)) * 2 + ((xs >> 4) & 1)) * 64 + (row & 31) + 32 * ((xs >> 3) & 1)) * 8 + (xs & 7); }

__device__ __forceinline__ v4u pack_frag(const f32x16& x, int s) { v4u w; w.x = pk2(x[8 * s], x[8 * s + 1]); w.y = pk2(x[8 * s + 2], x[8 * s + 3]); w.z = pk2(x[8 * s + 4], x[8 * s + 5]); w.w = pk2(x[8 * s + 6], x[8 * s + 7]); return w; }
__device__ __forceinline__ void stage_out8k(LAS unsigned char* stg, bf16* gdst, int lane) {
    WAVE_SYNC();
#pragma unroll
    for (int k = 0; k < 8; ++k) *(v4u*)(gdst + k * 512 + lane * 8) = *(const LAS v4u*)(stg + k * 1024 + lane * 16);
    WAVE_SYNC();
}
__device__ __forceinline__ void delta_d1_unit(unsigned char* ws, LAS unsigned char* lds, int uq, int wave, int lane) {
    asm volatile("" : "+v"(lane));
    const bf16* QKVC = (const bf16*)(ws + WS_QKVC); const float* G = (const float*)(ws + WS_G); const float* BETA = (const float*)(ws + WS_BETA);
    float* AF = (float*)(ws + WS_DAF); bf16* PG = (bf16*)(ws + WS_DPG); bf16* KT = (bf16*)(ws + WS_DKT); bf16* VT = (bf16*)(ws + WS_DVT);
    float* GC = (float*)(ws + WS_DGC); float* BT = (float*)(ws + WS_DBT);
    LAS float* lg = (LAS float*)(lds + wave * 16384);
    LAS unsigned char* stg = lds + wave * 16384 + 2048; LAS bf16* st = (LAS bf16*)stg;
    const int m = lane & 31, half = lane >> 5;
    const bf16x8 zf = {0, 0, 0, 0, 0, 0, 0, 0};
    {
        const int c = uq % NCH, bh = uq / NCH, hq = bh & 15, b = bh >> 4;
        { const int row = chunk_row(b, c, lane);
#pragma unroll
          for (int hh = 0; hh < 2; ++hh) { const int h = 2 * hq + hh; const float g = row >= 0 ? G[(size_t)row * 32 + h] : 0.f, bt = row >= 0 ? BETA[(size_t)row * 32 + h] : 0.f;
              const float gc = incl_scan64(g, lane); lg[hh * 64 + lane] = gc; lg[128 + hh * 64 + lane] = bt;
              const size_t uh = ((size_t)(b * 32 + h)) * NCH + c; GC[uh * 64 + lane] = gc; BT[uh * 64 + lane] = bt; } }
        const int row0 = chunk_row(b, c, m), row1 = chunk_row(b, c, 32 + m);
        const bf16* r0 = QKVC + (size_t)(row0 < 0 ? 0 : row0) * CDIM; const bf16* r1 = QKVC + (size_t)(row1 < 0 ? 0 : row1) * CDIM;
        f32x16 kk00, kk10, kk11, qk00, qk10, qk11;
#pragma unroll
        for (int i = 0; i < 16; ++i) { kk00[i] = 0.f; kk10[i] = 0.f; kk11[i] = 0.f; qk00[i] = 0.f; qk10[i] = 0.f; qk11[i] = 0.f; }
        const int sm = sw23(m);
        const int ktl = half * 32 + ((sm >> 4) & 1) * 512 + ((sm >> 3) & 1) * 256 + (sm & 7);
#pragma unroll 1
        for (int kh = 0; kh < 2; ++kh) {
            bf16x8 kf0[4], kf1[4], qf0[4], qf1[4];
#pragma unroll
            for (int u = 0; u < 4; ++u) { const int off = hq * 128 + 16 * (4 * kh + u) + 8 * half;
                kf0[u] = sel8(row0 >= 0, *(const bf16x8*)(r0 + 2048 + off)); kf1[u] = sel8(row1 >= 0, *(const bf16x8*)(r1 + 2048 + off));
                qf0[u] = sel8(row0 >= 0, *(const bf16x8*)(r0 + off)); qf1[u] = sel8(row1 >= 0, *(const bf16x8*)(r1 + off)); }
#pragma unroll
            for (int u = 0; u < 4; ++u) { const int ks = 4 * kh + u; const bf16x8 k0 = kf0[u], k1 = kf1[u], q0 = qf0[u], q1 = qf1[u];
                kk00 = MFMA32(k0, k0, kk00); kk10 = MFMA32(k1, k0, kk10); kk11 = MFMA32(k1, k1, kk11);
                qk00 = MFMA32(q0, k0, qk00); qk10 = MFMA32(q1, k0, qk10); qk11 = MFMA32(q1, k1, qk11);
                LAS bf16* kb = st + ktl + ((ks >> 1) & 1) * 2048 + (ks & 1) * 128;
#pragma unroll
                for (int e = 0; e < 8; ++e) { kb[(8 * (e >> 2) + (e & 3)) * 8] = (bf16)k0[e]; kb[1024 + (8 * (e >> 2) + (e & 3)) * 8] = (bf16)k1[e]; } }
            stage_out8k(stg, KT + (size_t)uq * 8192 + kh * 4096, lane);
        }
#pragma unroll 1
        for (int hh = 0; hh < 2; ++hh) { const int h = 2 * hq + hh; bf16* vt = VT + (((size_t)(b * 32 + h)) * NCH + c) * 8192;
            const int vtl = half * 64 + ((sm >> 4) & 1) * 512 + ((sm >> 3) & 1) * 256 + (sm & 7);
            bf16x8 vf0[8], vf1[8];
#pragma unroll
            for (int ks = 0; ks < 8; ++ks) { const int off = 4096 + h * 128 + 16 * ks + 8 * half; vf0[ks] = sel8(row0 >= 0, *(const bf16x8*)(r0 + off)); vf1[ks] = sel8(row1 >= 0, *(const bf16x8*)(r1 + off)); }
#pragma unroll
            for (int kh = 0; kh < 2; ++kh) {
#pragma unroll
                for (int u = 0; u < 4; ++u) { const int ks = 4 * kh + u; LAS bf16* vb = st + vtl + ((ks >> 1) & 1) * 2048 + (ks & 1) * 128;
#pragma unroll
                    for (int e = 0; e < 8; ++e) { vb[e * 8] = (bf16)vf0[ks][e]; vb[1024 + e * 8] = (bf16)vf1[ks][e]; } }
                stage_out8k(stg, vt + kh * 4096, lane);
            } }
        WAVE_SYNC();
#pragma unroll 1
        for (int hh = 0; hh < 2; ++hh) { const int h = 2 * hq + hh; const size_t uh = ((size_t)(b * 32 + h)) * NCH + c;
            float* af = AF + uh * 4096 + half * 256 + m;
            LAS bf16* pg = st + ktl;
            const float gcj0 = lg[hh * 64 + m], gcj1 = lg[hh * 64 + 32 + m];
#pragma unroll
            for (int r = 0; r < 16; ++r) { const int ir = crow32(r, half), rc = (r & 3) + 8 * (r >> 2);
                const float gi0 = lg[hh * 64 + ir], gi1 = lg[hh * 64 + 32 + ir], bi0 = lg[128 + hh * 64 + ir], bi1 = lg[128 + hh * 64 + 32 + ir];
                { const int i = ir, j = m; const float dec = __expf(fminf(gi0 - gcj0, 0.f)); af[rc * 64] = (j < i) ? bi0 * dec * kk00[r] : 0.f; pg[rc * 8] = f2bf((j <= i) ? dec * qk00[r] : 0.f); }
                { const int i = 32 + ir, j = m; const float dec = __expf(fminf(gi1 - gcj0, 0.f)); af[2048 + rc * 64] = bi1 * dec * kk10[r]; pg[2048 + rc * 8] = f2bf(dec * qk10[r]); }
                { const int i = 32 + ir, j = 32 + m; const float dec = __expf(fminf(gi1 - gcj1, 0.f)); af[2048 + 32 + rc * 64] = (j < i) ? bi1 * dec * kk11[r] : 0.f; pg[2048 + 1024 + rc * 8] = f2bf((j <= i) ? dec * qk11[r] : 0.f); }
            }
            stage_out8k(stg, PG + uh * 4096, lane); }
        WAVE_SYNC();
    }
}
__device__ __forceinline__ void delta_d2_unit(unsigned char* ws, LAS unsigned char* lds, int uh, int wave, int lane) {
    asm volatile("" : "+v"(lane));
    const float* AF = (const float*)(ws + WS_DAF); const float* GC = (const float*)(ws + WS_DGC); const float* BT = (const float*)(ws + WS_DBT);
    bf16* TG = (bf16*)(ws + WS_DTG); bf16* TB = (bf16*)(ws + WS_DTB);
    {
        const float* af = AF + (size_t)uh * 4096;
        const float bc = BT[(size_t)uh * 64 + lane], gmc = __expf(GC[(size_t)uh * 64 + lane]);
        float T[64];
        const bool pad0 = (uh % NCH) == 0;
#pragma unroll
        for (int i0 = 0; i0 < 64; i0 += 16) {
            float ar[16];
#pragma unroll
            for (int u = 0; u < 16; ++u) ar[u] = af[(i0 + u) * 64 + lane];
            if (pad0 && i0 < 32) {
#pragma unroll
                for (int u = 0; u < 16; ++u) T[i0 + u] = (lane == i0 + u) ? 1.f : 0.f;
            } else {
#pragma unroll
                for (int u = 0; u < 16; ++u) { const int i = i0 + u; float pa[4] = {(lane == i) ? 1.f : 0.f, 0.f, 0.f, 0.f};
#pragma unroll
                    for (int j = 0; j < i; ++j) pa[j & 3] -= __int_as_float(__builtin_amdgcn_readlane(__float_as_int(ar[u]), j)) * T[j];
                    T[i] = (pa[0] + pa[1]) + (pa[2] + pa[3]); }
            }
        }
        bf16* tg = TG + (size_t)uh * 4096; bf16* tb = TB + (size_t)uh * 4096;
        const float sg = bc * gmc;
        const int cs = (lane & ~31) + sw23(lane & 31);
        const int lcol = (cs >> 4) * 512 + ((cs >> 3) & 1) * 256 + (cs & 7);
        LAS unsigned char* stg = lds + wave * 16384 + 2048; LAS bf16* st = (LAS bf16*)stg;
#pragma unroll
        for (int i = 0; i < 64; ++i) st[(i >> 5) * 2048 + (i & 31) * 8 + lcol] = f2bf(T[i] * sg);
        stage_out8k(stg, tg, lane);
#pragma unroll
        for (int i = 0; i < 64; ++i) st[(i >> 5) * 2048 + (i & 31) * 8 + lcol] = f2bf(T[i] * bc);
        stage_out8k(stg, tb, lane);
    }
}
__device__ __forceinline__ void delta_d3_unit(unsigned char* ws, int uh, int lane) {
    asm volatile("" : "+v"(lane));
    const bf16* TG = (const bf16*)(ws + WS_DTG); const bf16* TB = (const bf16*)(ws + WS_DTB); const bf16* KT = (const bf16*)(ws + WS_DKT); const bf16* VT = (const bf16*)(ws + WS_DVT);
    bf16* WG = (bf16*)(ws + WS_DWG); bf16* UG = (bf16*)(ws + WS_DUG);
    const int m = lane & 31, half = lane >> 5;
    const int c = uh % NCH, bh = uh / NCH, h = bh & 31, b = bh >> 5;
    const size_t uq = ((size_t)(b * 16 + (h >> 1))) * NCH + c;
    {
        const bf16* Tm = TG + (size_t)uh * 4096; const bf16* Kf = KT + uq * 8192;
        f32x16 acc[4][2];
#pragma unroll
        for (int dn = 0; dn < 4; ++dn)
#pragma unroll
            for (int ti = 0; ti < 2; ++ti)
#pragma unroll
                for (int i = 0; i < 16; ++i) acc[dn][ti][i] = 0.f;
#pragma unroll
        for (int ks = 0; ks < 4; ++ks) {
            bf16x8 a[4], bb[2];
#pragma unroll
            for (int dn = 0; dn < 4; ++dn) a[dn] = *(const bf16x8*)(Kf + ((size_t)(((dn * 2 + (ks >> 1)) * 2 + (ks & 1)) * 64 + lane)) * 8);
#pragma unroll
            for (int ti = 0; ti < 2; ++ti) bb[ti] = *(const bf16x8*)(Tm + ((size_t)((ti * 4 + ks) * 64 + lane)) * 8);
#pragma unroll
            for (int dn = 0; dn < 4; ++dn)
#pragma unroll
                for (int ti = 0; ti < 2; ++ti) acc[dn][ti] = MFMA32(a[dn], bb[ti], acc[dn][ti]);
        }
        bf16* wg = WG + (size_t)uh * 8192;
#pragma unroll
        for (int dn = 0; dn < 4; ++dn)
#pragma unroll
            for (int ti = 0; ti < 2; ++ti)
#pragma unroll
                for (int s2 = 0; s2 < 2; ++s2) *(v4u*)(wg + ((size_t)(((ti * 4 + dn) * 2 + s2) * 64 + lane)) * 8) = pack_frag(acc[dn][ti], s2);
    }
    {
        const bf16* Tm = TB + (size_t)uh * 4096; const bf16* Bt = VT + (size_t)uh * 8192;
        f32x16 acc[2][4];
#pragma unroll
        for (int ti = 0; ti < 2; ++ti)
#pragma unroll
            for (int dn = 0; dn < 4; ++dn)
#pragma unroll
                for (int i = 0; i < 16; ++i) acc[ti][dn][i] = 0.f;
#pragma unroll
        for (int ks = 0; ks < 4; ++ks) {
            bf16x8 a[2], bb[4];
#pragma unroll
            for (int ti = 0; ti < 2; ++ti) a[ti] = *(const bf16x8*)(Tm + ((size_t)((ti * 4 + ks) * 64 + lane)) * 8);
#pragma unroll
            for (int dn = 0; dn < 4; ++dn) bb[dn] = *(const bf16x8*)(Bt + ((size_t)((dn * 4 + ks) * 64 + lane)) * 8);
#pragma unroll
            for (int ti = 0; ti < 2; ++ti)
#pragma unroll
                for (int dn = 0; dn < 4; ++dn) acc[ti][dn] = MFMA32(a[ti], bb[dn], acc[ti][dn]);
        }
        bf16* ug = UG + (size_t)uh * 8192;
#pragma unroll
        for (int ti = 0; ti < 2; ++ti)
#pragma unroll
            for (int dn = 0; dn < 4; ++dn) { bf16* p = ug + ((size_t)((ti * 4 + dn) * 64 + lane)) * 16; *(v4u*)p = pack_frag(acc[ti][dn], 0); *(v4u*)(p + 8) = pack_frag(acc[ti][dn], 1); }
    }
}
__device__ __forceinline__ void delta_d23_unit(unsigned char* ws, LAS unsigned char* lds, int uh, int wave, int lane) {
    asm volatile("" : "+v"(lane));
    const float* AF = (const float*)(ws + WS_DAF); const float* GC = (const float*)(ws + WS_DGC); const float* BT = (const float*)(ws + WS_DBT);
    const bf16* KT = (const bf16*)(ws + WS_DKT); const bf16* VT = (const bf16*)(ws + WS_DVT);
    bf16* WG = (bf16*)(ws + WS_DWG); bf16* UG = (bf16*)(ws + WS_DUG);
    const float* af = AF + (size_t)uh * 4096;
    const float bc = BT[(size_t)uh * 64 + lane], gmc = __expf(GC[(size_t)uh * 64 + lane]);
    const int c = uh % NCH, bh = uh / NCH, h = bh & 31, b = bh >> 5;
    const size_t uq = ((size_t)(b * 16 + (h >> 1))) * NCH + c;
    float T[64];
    const bool pad0 = c == 0;
    float ar[16], an[16];
#pragma unroll
    for (int u = 0; u < 16; ++u) ar[u] = af[u * 64 + lane];
#pragma unroll
    for (int i0 = 0; i0 < 64; i0 += 16) {
        if (i0 + 16 < 64) {
#pragma unroll
            for (int u = 0; u < 16; ++u) an[u] = af[(i0 + 16 + u) * 64 + lane];
        }
        if (pad0 && i0 < 32) {
#pragma unroll
            for (int u = 0; u < 16; ++u) T[i0 + u] = (lane == i0 + u) ? 1.f : 0.f;
        } else {
#pragma unroll
            for (int u = 0; u < 16; ++u) { const int i = i0 + u; float pa[4] = {(lane == i) ? 1.f : 0.f, 0.f, 0.f, 0.f};
#pragma unroll
                for (int j = 0; j < i; ++j) pa[j & 3] -= __int_as_float(__builtin_amdgcn_readlane(__float_as_int(ar[u]), j)) * T[j];
                T[i] = (pa[0] + pa[1]) + (pa[2] + pa[3]); }
        }
#pragma unroll
        for (int u = 0; u < 16; ++u) ar[u] = an[u];
    }
    const bf16* Kf = KT + uq * 8192;
    bf16x8 ka[4][4];
    asm volatile("" ::: "memory");
#pragma unroll
    for (int ks = 0; ks < 4; ++ks)
#pragma unroll
        for (int dn = 0; dn < 2; ++dn) ka[ks][dn] = *(const bf16x8*)(Kf + ((size_t)(((dn * 2 + (ks >> 1)) * 2 + (ks & 1)) * 64 + lane)) * 8);
    const float sg = bc * gmc;
    const int cs = (lane & ~31) + sw23(lane & 31);
    const int lcol = (cs >> 4) * 512 + ((cs >> 3) & 1) * 256 + (cs & 7);
    LAS unsigned char* stg = lds + wave * 16384 + 2048; LAS bf16* st = (LAS bf16*)stg;
    bf16x8 tf[2][4];
    WAVE_SYNC();
#pragma unroll
    for (int i = 0; i < 64; ++i) st[(i >> 5) * 2048 + (i & 31) * 8 + lcol] = f2bf(T[i] * sg);
    WAVE_SYNC();
#pragma unroll
    for (int ti = 0; ti < 2; ++ti)
#pragma unroll
        for (int ks = 0; ks < 4; ++ks) tf[ti][ks] = *(const LAS bf16x8*)(st + ((ti * 4 + ks) * 64 + lane) * 8);
    WAVE_SYNC();
#pragma unroll
    for (int i = 0; i < 64; ++i) st[(i >> 5) * 2048 + (i & 31) * 8 + lcol] = f2bf(T[i] * bc);
    WAVE_SYNC();
    const bf16* Bt = VT + (size_t)uh * 8192;
    bf16x8 vb[4][4];
#pragma unroll
    for (int ks = 0; ks < 4; ++ks)
#pragma unroll
        for (int dn = 2; dn < 4; ++dn) ka[ks][dn] = *(const bf16x8*)(Kf + ((size_t)(((dn * 2 + (ks >> 1)) * 2 + (ks & 1)) * 64 + lane)) * 8);
    asm volatile("" ::: "memory");
    {
        bf16* wg = WG + (size_t)uh * 8192;
#pragma unroll
        for (int dp = 0; dp < 2; ++dp) {
            f32x16 acc[2][2];
#pragma unroll
            for (int d2 = 0; d2 < 2; ++d2)
#pragma unroll
                for (int ti = 0; ti < 2; ++ti)
#pragma unroll
                    for (int i = 0; i < 16; ++i) acc[d2][ti][i] = 0.f;
#pragma unroll
            for (int ks = 0; ks < 4; ++ks)
#pragma unroll
                for (int d2 = 0; d2 < 2; ++d2)
#pragma unroll
                    for (int ti = 0; ti < 2; ++ti) acc[d2][ti] = MFMA32(ka[ks][2 * dp + d2], tf[ti][ks], acc[d2][ti]);
#pragma unroll
            for (int d2 = 0; d2 < 2; ++d2)
#pragma unroll
                for (int ti = 0; ti < 2; ++ti)
#pragma unroll
                    for (int s2 = 0; s2 < 2; ++s2) *(v4u*)(wg + ((size_t)(((ti * 4 + 2 * dp + d2) * 2 + s2) * 64 + lane)) * 8) = pack_frag(acc[d2][ti], s2);
            if (dp == 0) {
                asm volatile("" ::: "memory");
#pragma unroll
                for (int ks = 0; ks < 2; ++ks)
#pragma unroll
                    for (int dn = 0; dn < 4; ++dn) vb[ks][dn] = *(const bf16x8*)(Bt + ((size_t)((dn * 4 + ks) * 64 + lane)) * 8);
                asm volatile("" ::: "memory");
            }
        }
    }
    asm volatile("" ::: "memory");
#pragma unroll
    for (int ks = 2; ks < 4; ++ks)
#pragma unroll
        for (int dn = 0; dn < 4; ++dn) vb[ks][dn] = *(const bf16x8*)(Bt + ((size_t)((dn * 4 + ks) * 64 + lane)) * 8);
#pragma unroll
    for (int ti = 0; ti < 2; ++ti)
#pragma unroll
        for (int ks = 0; ks < 4; ++ks) tf[ti][ks] = *(const LAS bf16x8*)(st + ((ti * 4 + ks) * 64 + lane) * 8);
    {
        bf16* ug = UG + (size_t)uh * 8192;
#pragma unroll
        for (int ti = 0; ti < 2; ++ti) {
            f32x16 acc[4];
#pragma unroll
            for (int dn = 0; dn < 4; ++dn)
#pragma unroll
                for (int i = 0; i < 16; ++i) acc[dn][i] = 0.f;
#pragma unroll
            for (int ks = 0; ks < 4; ++ks)
#pragma unroll
                for (int dn = 0; dn < 4; ++dn) acc[dn] = MFMA32(tf[ti][ks], vb[ks][dn], acc[dn]);
#pragma unroll
            for (int dn = 0; dn < 4; ++dn) { bf16* p = ug + ((size_t)((ti * 4 + dn) * 64 + lane)) * 16; *(v4u*)p = pack_frag(acc[dn], 0); *(v4u*)(p + 8) = pack_frag(acc[dn], 1); }
        }
    }
    WAVE_SYNC();
}
__device__ __forceinline__ void delta_pre(unsigned char* ws, LAS unsigned char* lds, int gw, int NGW, int wave, int lane) {
    const int nextra = (NUQ > NGW && NUQ < 2 * NGW) ? NUQ - NGW : 0;
    for (int rep = 0; rep < 2 || nextra == 0; ++rep) {
        int uq;
        if (nextra == 0) { uq = gw + rep * NGW; if (uq >= NUQ) break; }
        else if (rep == 0) uq = gw;
        else { if ((gw & 63) != 0 || (gw >> 6) >= nextra) break; uq = NGW + (gw >> 6); }
#ifndef NO_D1
        delta_d1_unit(ws, lds, uq, wave, lane);
#endif
#ifdef DUP_D1
        delta_d1_unit(ws, lds, uq, wave, lane);
#endif
        asm volatile("s_waitcnt vmcnt(0)" ::: "memory");
        const int c = uq % NCH, bh = uq / NCH, hq = bh & 15, b = bh >> 4;
#pragma unroll 1
        for (int hh = 0; hh < 2; ++hh) { const int uh = (b * 32 + 2 * hq + hh) * NCH + c;
#ifndef NO_D23FUSE
            delta_d23_unit(ws, lds, uh, wave, lane);
#ifdef DUP_D23
            delta_d23_unit(ws, lds, uh, wave, lane);
#endif
            continue;
#endif
#ifndef NO_D2
            delta_d2_unit(ws, lds, uh, wave, lane);
#endif
#ifdef DUP_D2
            delta_d2_unit(ws, lds, uh, wave, lane);
#endif
            asm volatile("s_waitcnt vmcnt(0)" ::: "memory");
#ifndef NO_D3
            delta_d3_unit(ws, uh, lane);
#endif
#ifdef DUP_D3
            delta_d3_unit(ws, uh, lane);
#endif
        }
    }
}
__device__ __forceinline__ bf16x8 afrag_perm(const bf16* rowp, int blk, int s, int half) {
    const v2u lo = *(const v2u*)(rowp + 32 * blk + 16 * s + 4 * half), hi2 = *(const v2u*)(rowp + 32 * blk + 16 * s + 8 + 4 * half);
    v4u w; w.x = lo.x; w.y = lo.y; w.z = hi2.x; w.w = hi2.y; return __builtin_bit_cast(bf16x8, w);
}
#define LBAR() asm volatile("s_waitcnt lgkmcnt(0)\n\ts_barrier" ::: "memory")
__device__ __forceinline__ void delta_d4(unsigned char* ws, float* out_state, LAS unsigned char* lds, int tid, int wave, int lane) {
    const bf16* QKVC = (const bf16*)(ws + WS_QKVC); const bf16* KT = (const bf16*)(ws + WS_DKT); const bf16* PG = (const bf16*)(ws + WS_DPG);
    const bf16* WG = (const bf16*)(ws + WS_DWG); const bf16* UG = (const bf16*)(ws + WS_DUG); const float* GC = (const float*)(ws + WS_DGC);
    bf16* OF = (bf16*)(ws + WS_SC);
    LAS v4u* Sfr = (LAS v4u*)lds;
    LAS v4u* Dfr = (LAS v4u*)(lds + 16384);
    LAS v4u* Dtf = (LAS v4u*)(lds + 16384 + 4096);
    LAS float* gam = (LAS float*)(lds + 16384 + 8192);
    const int m = lane & 31, half = lane >> 5;
    const bf16x8 zf = {0, 0, 0, 0, 0, 0, 0, 0};
    for (int item = blockIdx.x; item < NBP * 32 * 4; item += gridDim.x) {
        const int xg = item & 7, jj = item >> 3, pair = xg * 4 + (jj >> 3), q = jj & 3, h = 2 * (pair & 15) + ((jj >> 2) & 1), b = pair >> 4;
        const size_t uh0 = ((size_t)(b * 32 + h)) * NCH, uq0 = ((size_t)(b * 16 + (h >> 1))) * NCH;
        const int rt = wave & 1; const bool isq = wave >= 6;
#define ROT3(LOADM, STEPM) do { LOADM(0, 0); LOADM(1, 1); \
            for (int c = 0; c < NCH; c += 3) { \
                if (c + 2 < NCH) LOADM(c + 2, 2); \
                STEPM(c, 0); \
                if (c + 1 < NCH) { if (c + 3 < NCH) LOADM(c + 3, 0); STEPM(c + 1, 1); } \
                if (c + 2 < NCH) { if (c + 4 < NCH) LOADM(c + 4, 1); STEPM(c + 2, 2); } } } while (0)
#define ROT2(LOADM, STEPM) do { LOADM(0, 0); \
            for (int c = 0; c < NCH; c += 2) { \
                if (c + 1 < NCH) LOADM(c + 1, 1); \
                STEPM(c, 0); \
                if (c + 1 < NCH) { if (c + 2 < NCH) LOADM(c + 2, 0); STEPM(c + 1, 1); } } } while (0)
        LBAR();
        if (wave < 4) {
            int ll_ = lane; asm volatile("" : "+v"(ll_)); const int lane = ll_, m = lane & 31, half = lane >> 5; (void)m; (void)half;
            { const v4u z = {0u, 0u, 0u, 0u}; Sfr[(0 * 4 + wave) * 128 + lane] = z; Sfr[(0 * 4 + wave) * 128 + 64 + lane] = z; }
            bf16x8 kf[2][4];
            f32x16 S;
#pragma unroll
            for (int i = 0; i < 16; ++i) S[i] = 0.f;
#define LOAD_K(cc, B) do { const bf16* kr_ = KT + (uq0 + (cc)) * 8192; \
                _Pragma("unroll") for (int blk = 0; blk < 2; ++blk) _Pragma("unroll") for (int s_ = 0; s_ < 2; ++s_) kf[B][blk * 2 + s_] = *(const bf16x8*)(kr_ + ((size_t)(((wave * 2 + blk) * 2 + s_) * 64 + lane)) * 8); } while (0)
#define STEP_K(c, B) do { const int bufc = (c) & 1; LBAR(); LBAR(); \
                const float gl = gam[bufc * 64 + 63]; \
                _Pragma("unroll") for (int i = 0; i < 16; ++i) S[i] *= gl; \
                _Pragma("unroll") for (int blk = 0; blk < 2; ++blk) _Pragma("unroll") for (int s = 0; s < 2; ++s) S = MFMA32(kf[B][blk * 2 + s], __builtin_bit_cast(bf16x8, Dtf[(blk * 2 + s) * 64 + lane]), S); \
                _Pragma("unroll") for (int s = 0; s < 2; ++s) Sfr[((bufc ^ 1) * 4 + wave) * 128 + s * 64 + lane] = pack_frag(S, s); } while (0)
#ifndef NO_RK
            ROT2(LOAD_K, STEP_K);
#endif
            { float* o = out_state + ((size_t)((b * 32 + h) * 128 + 32 * wave)) * 128 + 32 * q + m;
#pragma unroll
              for (int r = 0; r < 16; ++r) o[(size_t)sw23(crow32(r, half)) * 128] = S[r]; }
#undef LOAD_K
#undef STEP_K
        } else if (!isq) {
            int ll_ = lane; asm volatile("" : "+v"(ll_)); const int lane = ll_, m = lane & 31, half = lane >> 5; (void)m; (void)half;
            bf16x8 wf[3][8], uf[3][2]; float gcv[3] = {0.f, 0.f, 0.f};
#define LOAD_W(cc, B) do { const bf16* wb_ = WG + (uh0 + (cc)) * 8192 + ((size_t)(rt * 512 + lane)) * 8; \
                _Pragma("unroll") for (int blk = 0; blk < 4; ++blk) _Pragma("unroll") for (int s_ = 0; s_ < 2; ++s_) wf[B][blk * 2 + s_] = *(const bf16x8*)(wb_ + blk * 1024 + s_ * 512); \
                const bf16* ub_ = UG + (uh0 + (cc)) * 8192 + ((size_t)((rt * 4 + q) * 64 + lane)) * 16; uf[B][0] = *(const bf16x8*)ub_; uf[B][1] = *(const bf16x8*)(ub_ + 8); \
                if (wave == 4) gcv[B] = GC[(uh0 + (cc)) * 64 + lane]; } while (0)
#define STEP_W(c, B) do { const int bufc = (c) & 1; LBAR(); \
                f32x16 acc; \
                _Pragma("unroll") for (int i = 0; i < 16; ++i) acc[i] = 0.f; \
                _Pragma("unroll") for (int blk = 0; blk < 4; ++blk) _Pragma("unroll") for (int s = 0; s < 2; ++s) \
                    acc = MFMA32(wf[B][blk * 2 + s], __builtin_bit_cast(bf16x8, Sfr[(bufc * 4 + blk) * 128 + s * 64 + lane]), acc); \
                { float t8[8]; unpack8(__builtin_bit_cast(v4u, uf[B][0]), t8); \
                    _Pragma("unroll") for (int i = 0; i < 8; ++i) acc[i] = t8[i] - acc[i]; unpack8(__builtin_bit_cast(v4u, uf[B][1]), t8); \
                    _Pragma("unroll") for (int i = 0; i < 8; ++i) acc[8 + i] = t8[i] - acc[8 + i]; } \
                _Pragma("unroll") for (int s = 0; s < 2; ++s) Dfr[(rt * 2 + s) * 64 + lane] = pack_frag(acc, s); \
                _Pragma("unroll") for (int r = 0; r < 16; ++r) acc[r] *= gam[128 + bufc * 64 + 32 * rt + crow32(r, half)]; \
                _Pragma("unroll") for (int s = 0; s < 2; ++s) Dtf[(rt * 2 + s) * 64 + lane] = pack_frag(acc, s); \
                LBAR(); \
                if (wave == 4 && (c) + 1 < NCH) { const float gn_ = gcv[((B) + 1) % 3], gl_ = __shfl(gn_, 63); gam[(bufc ^ 1) * 64 + lane] = __expf(gn_); gam[128 + (bufc ^ 1) * 64 + lane] = __expf(gl_ - gn_); } } while (0)
            if (wave == 4) { const float gc = GC[(uh0 + 0) * 64 + lane], gl = __shfl(gc, 63); gam[lane] = __expf(gc); gam[128 + lane] = __expf(gl - gc); }
#ifndef NO_RW
            ROT3(LOAD_W, STEP_W);
#endif
#undef LOAD_W
#undef STEP_W
        } else {
            int ll_ = lane; asm volatile("" : "+v"(ll_)); const int lane = ll_, m = lane & 31, half = lane >> 5; (void)m; (void)half;
            bf16x8 qf[1][8], pf[1][4];
#define LOAD_Q(cc, B) do { const int row_ = chunk_row(b, (cc), 32 * rt + m); const bool ok_ = row_ >= 0; \
                const bf16* qb_ = QKVC + (size_t)(row_ < 0 ? 0 : row_) * CDIM + (h >> 1) * 128 + 8 * half; \
                _Pragma("unroll") for (int blk = 0; blk < 4; ++blk) _Pragma("unroll") for (int s_ = 0; s_ < 2; ++s_) qf[B][blk * 2 + s_] = sel8(ok_, *(const bf16x8*)(qb_ + blk * 32 + s_ * 16)); \
                } while (0)
#define LOAD_P(cc, PB) do { const bf16* pb_ = PG + (uh0 + (cc)) * 4096 + ((size_t)(rt * 256 + lane)) * 8; \
                _Pragma("unroll") for (int blk = 0; blk < 2; ++blk) _Pragma("unroll") for (int s_ = 0; s_ < 2; ++s_) pf[PB][blk * 2 + s_] = sel8(blk <= rt, *(const bf16x8*)(pb_ + blk * 1024 + s_ * 512)); } while (0)
#define STEP_Q(c) do { const int bufc = (c) & 1; LBAR(); \
                LOAD_P((c), 0);                                                    \
                f32x16 acc; \
                _Pragma("unroll") for (int i = 0; i < 16; ++i) acc[i] = 0.f; \
                _Pragma("unroll") for (int blk = 0; blk < 4; ++blk) _Pragma("unroll") for (int s = 0; s < 2; ++s) \
                    acc = MFMA32(qf[0][blk * 2 + s], __builtin_bit_cast(bf16x8, Sfr[(bufc * 4 + blk) * 128 + s * 64 + lane]), acc); \
                if ((c) + 1 < NCH) LOAD_Q((c) + 1, 0);                             \
                LBAR(); \
                _Pragma("unroll") for (int r = 0; r < 16; ++r) acc[r] *= gam[bufc * 64 + 32 * rt + crow32(r, half)]; \
                _Pragma("unroll") for (int blk = 0; blk < 2; ++blk) _Pragma("unroll") for (int s = 0; s < 2; ++s) acc = MFMA32(pf[0][blk * 2 + s], __builtin_bit_cast(bf16x8, Dfr[(blk * 2 + s) * 64 + lane]), acc); \
                _Pragma("unroll") for (int r = 0; r < 16; ++r) { const int row = chunk_row(b, (c), 32 * rt + crow32(r, half)); if (row >= 0) OF[(size_t)row * DVW + h * 128 + 32 * q + m] = f2bf(acc[r]); } } while (0)
#ifndef NO_RQ
            LOAD_Q(0, 0);
            for (int c = 0; c < NCH; ++c) STEP_Q(c);
#endif
#undef LOAD_Q
#undef LOAD_P
#undef STEP_Q
        }
#undef ROT2
#undef ROT3
    }
    LBAR();
}
#undef LBAR
#undef MFMA32
template <int RT, int CT, int UNR = 4, class Epi>
__device__ __forceinline__ void small_gemm_unit(const bf16* A, int lda, const bf16* Bt, int ldb, int k0, int klen, LAS unsigned char* lds, const Epi& E, int tid, int wave, int lane) {
    const int r16 = lane & 15, q = lane >> 4;
    const int kw = klen >> 3;
    const bf16* ap = A + (size_t)r16 * lda + k0 + wave * kw + 8 * q;
    const bf16* bp = Bt + (size_t)r16 * ldb + k0 + wave * kw + 8 * q;
    pg8::f32x4 acc[RT][CT];
#pragma unroll
    for (int i = 0; i < RT; ++i)
#pragma unroll
        for (int j = 0; j < CT; ++j) acc[i][j] = (pg8::f32x4){0.f, 0.f, 0.f, 0.f};
#pragma unroll UNR
    for (int ks = 0; ks < kw; ks += 32) {
        bf16x8 a[RT], b[CT];
#pragma unroll
        for (int i = 0; i < RT; ++i) a[i] = *(const bf16x8*)(ap + (size_t)(16 * i) * lda + ks);
#pragma unroll
        for (int j = 0; j < CT; ++j) b[j] = *(const bf16x8*)(bp + (size_t)(16 * j) * ldb + ks);
#pragma unroll
        for (int i = 0; i < RT; ++i)
#pragma unroll
            for (int j = 0; j < CT; ++j) acc[i][j] = __builtin_amdgcn_mfma_f32_16x16x32_bf16(a[i], b[j], acc[i][j], 0, 0, 0);
    }
    constexpr int NOUT = 256 * RT * CT;
    LAS float* part = (LAS float*)lds + wave * NOUT;
#pragma unroll
    for (int i = 0; i < RT; ++i)
#pragma unroll
        for (int j = 0; j < CT; ++j)
#pragma unroll
            for (int e = 0; e < 4; ++e) part[(16 * i + 4 * q + e) * (16 * CT) + 16 * j + r16] = acc[i][j][e];
    __syncthreads();
    for (int o = tid; o < NOUT; o += NTHREADS) { float sum = 0.f;
#pragma unroll
        for (int w = 0; w < 8; ++w) sum += ((LAS float*)lds)[w * NOUT + o];
        E(o / (16 * CT), o % (16 * CT), sum); }
    __syncthreads();
}
template <int ACT> struct SEpiRowsBf16 { bf16* O; int ldc; __device__ __forceinline__ void operator()(int row, int col, float v) const { if (ACT == 2) { v = v > 0.f ? v : 0.f; v = v * v; } O[(size_t)row * ldc + col] = f2bf(v); } };
struct SEpiF32 { float* O; int ldc; __device__ __forceinline__ void operator()(int row, int col, float v) const { O[(size_t)row * ldc + col] = v; } };
struct SEpiColsBf16 { bf16* O; int ldc; __device__ __forceinline__ void operator()(int row, int col, float v) const { O[(size_t)col * ldc + row] = f2bf(v); } };
template <int ACT> __device__ __forceinline__ void skinny_rows_bf16(const bf16* A, const bf16* Wt, int K, int nunits, bf16* O, int ldc, LAS unsigned char* lds, int tid, int wave, int lane) {
    for (int u = blockIdx.x; u < 2 * nunits; u += gridDim.x) { SEpiRowsBf16<ACT> E{O + (size_t)XROW0 * ldc + u * 32, ldc};
        small_gemm_unit<3, 2, 8>(A + (size_t)XROW0 * K, K, Wt + (size_t)u * 32 * K, K, 0, K, lds, E, tid, wave, lane); }
}
__device__ __forceinline__ void skinny_rows_part(const bf16* A, const bf16* Wt, int K, float* ZP, LAS unsigned char* lds, int tid, int wave, int lane) {
    for (int u = blockIdx.x; u < 256; u += gridDim.x) { const int cgp = u & 31, ksl = u >> 5; SEpiF32 E{ZP + (size_t)ksl * XR * DM + cgp * 64, DM};
        small_gemm_unit<3, 4>(A + (size_t)XROW0 * K, K, Wt + (size_t)cgp * 64 * K, K, ksl * (K >> 3), K >> 3, lds, E, tid, wave, lane); }
}
template <int RT> __device__ __forceinline__ void tail_cols_bf16(const bf16* A, const bf16* Wt, int K, int c0, bf16* O, int ldc, LAS unsigned char* lds, int tid, int wave, int lane) {
    for (int u = blockIdx.x; u < MAINM / 32; u += gridDim.x) { SEpiColsBf16 E{O + (size_t)u * 32 * ldc + c0, ldc};
        small_gemm_unit<RT, 2>(Wt + (size_t)c0 * K, K, A + (size_t)u * 32 * K, K, 0, K, lds, E, tid, wave, lane); }
}

typedef __attribute__((address_space(4))) const unsigned long long* kargq_t;
#define KPF_(k) ((const float*)(const GAS float*)(q_[k]))
__device__ __forceinline__ void load_ptrs(Ptrs& P) {
    kargq_t q_ = (kargq_t)__builtin_amdgcn_kernarg_segment_ptr();
    asm volatile("" : "+s"(q_));
    P.x_prompt = KPF_(0); P.x_sample = KPF_(1); P.state_conv_a = KPF_(2); P.cache_k = KPF_(3);
    P.cache_v = KPF_(4); P.cache_ik = KPF_(5); P.state_conv_c = KPF_(6); P.state_delta = KPF_(7);
    P.page_table = ((const int*)(const GAS int*)(q_[8])); P.meta = KPF_(9); P.w_in_a = KPF_(10); P.conv_w_a = KPF_(11);
    P.w_out_a = KPF_(12); P.w_in_b = KPF_(13); P.w_out_b = KPF_(14); P.w_in_c = KPF_(15);
    P.conv_w_c = KPF_(16); P.a_log = KPF_(17); P.dt_bias = KPF_(18); P.norm_w = KPF_(19);
    P.w_out_c = KPF_(20); P.ln1_g = KPF_(21); P.ln1_b = KPF_(22); P.w1 = KPF_(23);
    P.w2 = KPF_(24); P.ln2_g = KPF_(25); P.ln2_b = KPF_(26);
    P.out = (float*)(GAS float*)(q_[27]); P.ws = (unsigned char*)(GAS unsigned char*)(q_[28]);
}
struct Args { const void* in[27]; float* out; unsigned char* ws; int ph_lo, ph_hi; };
constexpr int PH_PER_LAYER = 12, PH_END = 1 + 4 * PH_PER_LAYER;

__global__ void __launch_bounds__(NTHREADS, 2) mega_fwd(Args args) {
    extern __shared__ __attribute__((aligned(16))) unsigned char lds_raw[];
    LAS unsigned char* lds = (LAS unsigned char*)lds_raw;
    const int tid = threadIdx.x, lane = tid & 63, wave = __builtin_amdgcn_readfirstlane(tid >> 6);
    const int G_ = gridDim.x, NGW = G_ * NWAVES, NT = G_ * NTHREADS; (void)lane;
    unsigned char* ws = args.ws;
    const int lo = args.ph_lo, hi = args.ph_hi;
    const bool fused = (hi - lo) > 1;

    for (int u = tid; u < (LDS_BYTES - LDSCTL_OFF) / 4; u += NTHREADS) ((LAS unsigned*)(lds + LDSCTL_OFF))[u] = 0u;
    __syncthreads();
    volatile LAS unsigned* MISC = (volatile LAS unsigned*)(lds + MISC_OFF);
    XcdBarrier bar; bar.bar = (unsigned*)(ws + WS_CTL) + CW_BAR; bar.x = 0; bar.st = nullptr;
    if (fused) bar = xcd_barrier_post((unsigned*)(ws + WS_CTL) + CW_BAR, MISC + 8);
    bar.wv = wave;

#ifndef MK_SITES
#define MK_SITES 0xffffffffu
#endif
#define SITE(n) (((MK_SITES) >> (n)) & 1u)
#define IN(k) (lo <= (k) && (k) < hi)
#ifndef MK_DUP
#define MK_DUP 0u
#endif
#define NREP(n) ((((MK_DUP) >> (n)) & 1u) ? 2 : 1)
#ifdef MK_SKINNY2
#define SKREP 2
#else
#define SKREP 1
#endif
#define BEGIN_SITE(n, id) if (SITE(n) && IN(id)) { for (int rp_ = 0; rp_ < NREP(n); ++rp_) { Ptrs P; load_ptrs(P); unsigned char* ws = P.ws; (void)ws; \
    bf16* X = (bf16*)(P.ws + WS_X); float* Z = (float*)(P.ws + WS_Z); float* ZP = (float*)(P.ws + WS_ZP); bf16* Y = (bf16*)(P.ws + WS_Y); bf16* BIG = (bf16*)(P.ws + WS_BIG); (void)X; (void)Z; (void)ZP; (void)Y; (void)BIG;
#define END_SITE(id) SEAM(id); } }
#define LOCALS int tid_ = threadIdx.x; asm volatile("" : "+v"(tid_)); const int lane_ = tid_ & 63, wave_ = __builtin_amdgcn_readfirstlane(tid_ >> 6), gw_ = blockIdx.x * NWAVES + wave_, gtid_ = blockIdx.x * NTHREADS + tid_; (void)lane_; (void)wave_; (void)gw_; (void)gtid_
#define SEAM(k) do { if (fused && (k) + 1 < PH_END) xcd_barrier(bar); else __syncthreads(); } while (0)


    BEGIN_SITE(0, 0) LOCALS; p0_prologue(P, lds, gw_, NGW, wave_, lane_); END_SITE(0)
#ifdef MK_XBAR
    if (fused) { for (int xb_ = 0; xb_ < MK_XBAR; ++xb_) xcd_barrier(bar); }
#endif

    for (int layer = 0; layer < 4; ++layer) {
        const int kind = layer % 3, j = layer / 3, base = 1 + layer * PH_PER_LAYER;
        if (kind == 0) {
            BEGIN_SITE(1, base + 0)
                const bf16* Wt = (const bf16*)(ws + WS_WA_IN + (size_t)j * WSZ_A_IN); pg8::Gemm g{X, Wt, MAINM, NA_IN, DM}; pg8::StaticOrder S; S.init(MAINM, NA_IN, G_, (int)blockIdx.x);
                pg8::EpiBf16<0> E{BIG, NA_IN, nullptr, 0, 0, 1.f};
                pg8::gemm_phase<pg8::EpiBf16<0>, pg8::StaticOrder, true, true>(lds, g, S, E, wave);
                { LOCALS; for (int sk_ = 0; sk_ < SKREP; ++sk_) { skinny_rows_bf16<0>(X, Wt, DM, NA_IN / 64, BIG, NA_IN, lds, tid_, wave_, lane_); } }
                END_SITE(base + 0)
            BEGIN_SITE(2, base + 1)
                LOCALS; convA_phase(BIG, Y, P.conv_w_a + (size_t)j * 3 * DM, P.state_conv_a + (size_t)j * SBN * 2 * DM, P.out + O_CAP + (size_t)j * NBP * 2 * DM, P.out + O_CAS + (size_t)j * SBN * 2 * DM, gtid_, NT);
                END_SITE(base + 1)
            BEGIN_SITE(3, base + 2)
                const bf16* Wt = (const bf16*)(ws + WS_WA_OUT + (size_t)j * WSZ_A_OUT); pg8::Gemm g{Y, Wt, MAINM, DM, DM}; pg8::StaticOrder S; S.init(MAINM, DM, G_, (int)blockIdx.x);
                pg8::EpiResBf16 E{X, DM, ALPHA};
                pg8::gemm_phase<pg8::EpiResBf16, pg8::StaticOrder, true, true>(lds, g, S, E, wave);
                { LOCALS; for (int sk_ = 0; sk_ < SKREP; ++sk_) { skinny_rows_part(Y, Wt, DM, ZP, lds, tid_, wave_, lane_); } }
                END_SITE(base + 2)
        } else if (kind == 1) {
            BEGIN_SITE(4, base + 0)
                const bf16* Wt = (const bf16*)(ws + WS_WB_IN); pg8::Gemm g{X, Wt, MAINM, 4096, DM}; pg8::StaticOrder S; S.init(MAINM, 4096, G_, (int)blockIdx.x);
                pg8::EpiBf16<0> E{BIG, NB_PAD, nullptr, 0, 0, 1.f};
                pg8::gemm_phase<pg8::EpiBf16<0>, pg8::StaticOrder, true, true>(lds, g, S, E, wave);
                { LOCALS; for (int sk_ = 0; sk_ < SKREP; ++sk_) { tail_cols_bf16<5>(X, Wt, DM, 4096, BIG, NB_PAD, lds, tid_, wave_, lane_); skinny_rows_bf16<0>(X, Wt, DM, 4224 / 64, BIG, NB_PAD, lds, tid_, wave_, lane_); } }
                END_SITE(base + 0)
            BEGIN_SITE(5, base + 1) LOCALS; rope_phase(BIG, P, gw_, NGW, lane_); END_SITE(base + 1)
            BEGIN_SITE(6, base + 2) LOCALS; indexer_sample(P, lds, tid_); indexer_prompt(P, lds, tid_, wave_, lane_); END_SITE(base + 2)
            BEGIN_SITE(7, base + 3) LOCALS; select_phase(P, lds, gw_, NGW, tid_, wave_, lane_); END_SITE(base + 3)
#ifdef ATTN_PROBE
            if (IN(base + 4)) { Ptrs P; load_ptrs(P); bf16* Y = (bf16*)(P.ws + WS_Y); LOCALS; dense_attn_phase<ATTN_PROBE>(P, Y, (char*)lds_raw, wave_); __syncthreads(); }
#endif
            BEGIN_SITE(8, base + 4) LOCALS; dense_attn_phase(P, Y, (char*)lds_raw, wave_); attn_phase(P, Y, lds, tid_, wave_, lane_); END_SITE(base + 4)
            BEGIN_SITE(9, base + 5)
                const bf16* Wt = (const bf16*)(ws + WS_WB_OUT); pg8::Gemm g{Y, Wt, MAINM, DM, DM}; pg8::StaticOrder S; S.init(MAINM, DM, G_, (int)blockIdx.x);
                pg8::EpiResBf16 E{X, DM, ALPHA};
                pg8::gemm_phase<pg8::EpiResBf16, pg8::StaticOrder, true, true>(lds, g, S, E, wave);
                { LOCALS; for (int sk_ = 0; sk_ < SKREP; ++sk_) { skinny_rows_part(Y, Wt, DM, ZP, lds, tid_, wave_, lane_); } }
                END_SITE(base + 5)
        } else {
            BEGIN_SITE(10, base + 0)
                const bf16* Wt = (const bf16*)(ws + WS_WC_IN); pg8::Gemm g{X, Wt, MAINM, 12288, DM}; pg8::StaticOrder S; S.init(MAINM, 12288, G_, (int)blockIdx.x);
                pg8::EpiBf16<0> E{BIG, NC_PAD, nullptr, 0, 0, 1.f};
                pg8::gemm_phase<pg8::EpiBf16<0>, pg8::StaticOrder, true, true>(lds, g, S, E, wave);
                { LOCALS; for (int sk_ = 0; sk_ < SKREP; ++sk_) { tail_cols_bf16<4>(X, Wt, DM, 12288, BIG, NC_PAD, lds, tid_, wave_, lane_); skinny_rows_bf16<0>(X, Wt, DM, NC_IN / 64, BIG, NC_PAD, lds, tid_, wave_, lane_); } }
                END_SITE(base + 0)
            BEGIN_SITE(11, base + 1) LOCALS; convC_phase(BIG, P, gw_, NGW, lane_); END_SITE(base + 1)
            BEGIN_SITE(19, base + 2) LOCALS;
#pragma unroll 1
                for (int half_ = 0; half_ < 2; ++half_) {
                    if ((half_ == 0) == ((wave_ & 1) == 0)) delta_pre(P.ws, lds, gw_, NGW, wave_, lane_);
                    else { const int nbusy = (NUQ > NGW && NUQ < 2 * NGW) ? NUQ - NGW : 0;
                      const bool busy = nbusy > 0 && (gw_ & 63) == 0 && (gw_ >> 6) < nbusy; const int below = nbusy == 0 ? 0 : (((gw_ + 63) >> 6) < nbusy ? ((gw_ + 63) >> 6) : nbusy);
                      if (!busy) { delta_phase(P, gw_ - below, NGW - nbusy, lane_); deferred_transposes(P, lds, gw_ - below, NGW - nbusy, wave_, lane_); } }
                }
            END_SITE(base + 2)
            BEGIN_SITE(22, base + 5) LOCALS; delta_d4(P.ws, P.out + O_DP, lds, tid_, wave_, lane_); END_SITE(base + 5)
            BEGIN_SITE(13, base + 6) LOCALS; normC_phase(BIG, Y, P, gw_, NGW, lane_); END_SITE(base + 6)
            BEGIN_SITE(14, base + 7)
                const bf16* Wt = (const bf16*)(ws + WS_WC_OUT); pg8::Gemm g{Y, Wt, MAINM, DM, DVW}; pg8::StaticOrder S; S.init(MAINM, DM, G_, (int)blockIdx.x);
                pg8::EpiResBf16 E{X, DM, ALPHA};
                pg8::gemm_phase<pg8::EpiResBf16, pg8::StaticOrder, true, true>(lds, g, S, E, wave);
                { LOCALS; for (int sk_ = 0; sk_ < SKREP; ++sk_) { skinny_rows_part(Y, Wt, DVW, ZP, lds, tid_, wave_, lane_); } }
                END_SITE(base + 7)
        }
        BEGIN_SITE(15, base + 8) LOCALS; ln_phase(Z, ZP, X, rp_ == 0 ? X : (bf16*)(P.ws + WS_QR), P.ln1_g + (size_t)layer * DM, P.ln1_b + (size_t)layer * DM, nullptr, nullptr, lds, gw_, NGW, tid_, wave_, lane_); END_SITE(base + 8)
        BEGIN_SITE(16, base + 9)
            const bf16* Wt = (const bf16*)(ws + WS_W1 + (size_t)layer * WSZ_W1); pg8::Gemm g{X, Wt, MAINM, FF, DM}; pg8::StaticOrder S; S.init(MAINM, FF, G_, (int)blockIdx.x);
            pg8::EpiBf16<2> E{BIG, FF, nullptr, 0, 0, 1.f};
            pg8::gemm_phase<pg8::EpiBf16<2>, pg8::StaticOrder, true, true>(lds, g, S, E, wave);
            { LOCALS; for (int sk_ = 0; sk_ < SKREP; ++sk_) { skinny_rows_bf16<2>(X, Wt, DM, FF / 64, BIG, FF, lds, tid_, wave_, lane_); } }
            END_SITE(base + 9)
        BEGIN_SITE(17, base + 10)
            const bf16* Wt = (const bf16*)(ws + WS_W2 + (size_t)layer * WSZ_W2); pg8::Gemm g{BIG, Wt, MAINM, DM, FF}; pg8::StaticOrder S; S.init(MAINM, DM, G_, (int)blockIdx.x);
            pg8::EpiResBf16 E{X, DM, ALPHA};
            pg8::gemm_phase<pg8::EpiResBf16, pg8::StaticOrder, true, true>(lds, g, S, E, wave);
            { LOCALS; for (int sk_ = 0; sk_ < SKREP; ++sk_) { skinny_rows_part(BIG, Wt, FF, ZP, lds, tid_, wave_, lane_); } }
            END_SITE(base + 10)
        BEGIN_SITE(18, base + 11)
            const bool last = layer == 3;
            LOCALS; ln_phase(Z, ZP, X, rp_ == 0 ? X : (bf16*)(P.ws + WS_QR), P.ln2_g + (size_t)layer * DM, P.ln2_b + (size_t)layer * DM, last ? P.out + O_YP : nullptr, last ? P.out + O_YS : nullptr, lds, gw_, NGW, tid_, wave_, lane_);
            if (!last) SEAM(base + 11); } }
    }
#undef IN
#undef SEAM
}

#ifndef MK_SPLIT
#define MK_SPLIT 0
#endif
extern "C" void kernel_launch(void* const* d_in, const int* in_sizes, int n_in, void* d_out, int out_size, void* d_ws, size_t ws_size, hipStream_t stream) {
    static int grid = 0;
    if (grid == 0) {
        if (n_in != 27 || (size_t)out_size != O_END || ws_size < WS_END) { fprintf(stderr, "kernel_launch: unexpected shapes: n_in %d out %d (want %zu) ws %zu (want >= %zu)\n", n_in, out_size, (size_t)O_END, ws_size, (size_t)WS_END); grid = -1; return; }
        int dev = 0, cus = 0;
        if (hipGetDevice(&dev) != hipSuccess || hipDeviceGetAttribute(&cus, hipDeviceAttributeMultiprocessorCount, dev) != hipSuccess) { grid = -1; return; }
        if (hipFuncSetAttribute((const void*)mega_fwd, hipFuncAttributeMaxDynamicSharedMemorySize, LDS_BYTES) != hipSuccess) { fprintf(stderr, "kernel_launch: hipFuncSetAttribute failed\n"); grid = -1; return; }
        int per_cu = 0;
        if (hipOccupancyMaxActiveBlocksPerMultiprocessor(&per_cu, (const void*)mega_fwd, NTHREADS, LDS_BYTES) != hipSuccess || per_cu < 1) fprintf(stderr, "kernel_launch: occupancy query reports %d\n", per_cu);
        (void)hipGetLastError();
        grid = cus;
    }
    if (grid < 0) return;
    (void)hipMemsetAsync((char*)d_ws + WS_CTL, 0, CTL_ZERO_BYTES, stream);
    Args a{};
    for (int i = 0; i < 27; ++i) a.in[i] = d_in[i];
    a.out = (float*)d_out; a.ws = (unsigned char*)d_ws;
#if MK_SPLIT
    for (int ph = 0; ph < PH_END; ++ph) {
        bool exists = (ph == 0);
        if (ph > 0) { const int layer = (ph - 1) / PH_PER_LAYER, l = (ph - 1) % PH_PER_LAYER, kind = layer % 3; const int nmix = kind == 0 ? 3 : (kind == 1 ? 6 : 8); exists = (l < nmix) || (l >= 8 && l <= 11); }
        if (!exists) continue;
        a.ph_lo = ph; a.ph_hi = ph + 1;
        hipLaunchKernelGGL(mega_fwd, dim3(grid), dim3(NTHREADS), LDS_BYTES, stream, a);
    }
#else
    a.ph_lo = 0; a.ph_hi = PH_END;
    hipLaunchKernelGGL(mega_fwd, dim3(grid), dim3(NTHREADS), LDS_BYTES, stream, a);
#endif
    const hipError_t le = hipPeekAtLastError();
    if (le != hipSuccess) fprintf(stderr, "kernel_launch: launch failed: %s\n", hipGetErrorName(le));
}
```
